# Optimizing an MI355X kernel written in HIP

```python
import jax, jax.numpy as jnp
from jax import lax
import numpy as np

D_MODEL = 1024
BATCH = 2
SEQ = 8192
DEPTH = 2

N_MIXERS = 2
N_RWKV_LAYERS = (DEPTH + 1) // 2
N_SB_LAYERS = DEPTH // 2
HEAD_DIM = 64
N_HEADS = D_MODEL // HEAD_DIM
D_DECAY_LORA = 64
D_AAA_LORA = 64
D_GATE_LORA = 128
N_TOKEN_SHIFT_MIX = 6
LNX_EPS = 64e-5
Q_BLOCK = 128
N_EXPERTS = 64
TOP_K = 8
D_EXPERT = D_MODEL // 4
D_SHARED = D_MODEL // 4
ROUTED_SCALE = 2.5
EXPERT_BLOCK = 128
RMS_EPS = 1e-6
N_ADA = 6

kernel_name = 'hybrid_rwkv7_stickbreak_moe_block'


def rmsnorm(x, g):
    xf = x.astype(jnp.float32)
    y = xf * lax.rsqrt(jnp.mean(xf * xf, axis=-1, keepdims=True) + RMS_EPS)
    return (y * g.astype(jnp.float32)).astype(x.dtype)


def _wkv7_scan(r, decay, k, v, a_vec, b_vec):
    B, S, H, N = r.shape

    def step(state, inp):
        r_t, w_t, k_t, v_t, a_t, b_t = inp
        sa = jnp.einsum('bhij,bhj->bhi', state, a_t)
        state = (state * w_t[:, :, None, :]
                 + sa[..., None] * b_t[:, :, None, :]
                 + v_t[..., None] * k_t[:, :, None, :])
        return state, jnp.einsum('bhij,bhj->bhi', state, r_t)

    xs = tuple(jnp.moveaxis(t, 1, 0) for t in (r, decay, k, v, a_vec, b_vec))
    s0 = jnp.zeros((B, H, N, N), jnp.float32)
    _, out = lax.scan(step, s0, xs)
    return jnp.moveaxis(out, 0, 1)


def rwkv7_time_mix(h, mu, w_rkv, w_w1, w_w2, w0, w_a1, w_a2, a0, w_g1, w_g2,
                   k_k, k_a, r_k, lnx_g, lnx_b, w_o):
    B, S, D = h.shape
    xx = jnp.pad(h, ((0, 0), (1, 0), (0, 0)))[:, :-1] - h
    xs = h[None] + xx[None] * mu[:, None, None, :]
    rkv = jnp.einsum('nbsd,nde->nbse', xs[:3], w_rkv)
    r, k, v = rkv[0], rkv[1], rkv[2]
    xw, xa, xg = xs[3], xs[4], xs[5]
    w_log = -jax.nn.softplus(-(w0 + jnp.tanh(xw @ w_w1) @ w_w2)) - 0.5
    decay = jnp.exp(-jnp.exp(w_log.astype(jnp.float32)))
    a = jax.nn.sigmoid((a0 + (xa @ w_a1) @ w_a2).astype(jnp.float32))
    g = jax.nn.sigmoid(xg @ w_g1) @ w_g2

    hs = lambda t: t.astype(jnp.float32).reshape(B, S, N_HEADS, HEAD_DIM)
    kk = hs(k * k_k)
    kk = kk / jnp.maximum(jnp.sqrt(jnp.sum(kk * kk, axis=-1, keepdims=True)), 1e-12)
    k_f = k.astype(jnp.float32) * (1.0 + (a - 1.0) * k_a.astype(jnp.float32))
    a_h = hs(a)
    r_h, k_h, v_h, w_h = hs(r), hs(k_f), hs(v), hs(decay)

    o = _wkv7_scan(r_h, w_h, k_h, v_h, -kk, kk * a_h)
    mean = jnp.mean(o, axis=-1, keepdims=True)
    var = jnp.mean(jnp.square(o - mean), axis=-1, keepdims=True)
    o = ((o - mean) * lax.rsqrt(var + LNX_EPS)).reshape(B, S, D)
    o = o * lnx_g.astype(jnp.float32) + lnx_b.astype(jnp.float32)
    bonus = jnp.sum(r_h * k_h * r_k.astype(jnp.float32), axis=-1, keepdims=True) * v_h
    o = o + bonus.reshape(B, S, D)
    return (o.astype(h.dtype) * g) @ w_o


def stick_breaking_attention(h, w_qkv, w_o):
    B, S, D = h.shape
    qkv = (h @ w_qkv).reshape(B, S, 3, N_HEADS, HEAD_DIM)
    q = jnp.transpose(qkv[:, :, 0], (0, 2, 1, 3))
    k = jnp.transpose(qkv[:, :, 1], (0, 2, 1, 3))
    v = jnp.transpose(qkv[:, :, 2], (0, 2, 1, 3))
    n_blk = S // Q_BLOCK
    q_blocks = jnp.moveaxis(q.reshape(B, N_HEADS, n_blk, Q_BLOCK, HEAD_DIM), 2, 0)
    key_pos = jnp.arange(S)
    scale = 1.0 / float(np.sqrt(HEAD_DIM))

    def query_block(args):
        q_i, blk = args
        z = jnp.einsum('bhqd,bhkd->bhqk', q_i, k).astype(jnp.float32) * scale
        q_pos = blk * Q_BLOCK + jnp.arange(Q_BLOCK)
        causal = key_pos[None, :] < q_pos[:, None]
        log_beta = jax.nn.log_sigmoid(z)
        log_1m_beta = jnp.where(causal, jax.nn.log_sigmoid(-z), 0.0)
        tail = lax.cumsum(log_1m_beta, axis=3, reverse=True) - log_1m_beta
        weights = jnp.where(causal, jnp.exp(log_beta + tail), 0.0)
        return jnp.einsum('bhqk,bhkd->bhqd', weights.astype(v.dtype), v)

    o = lax.map(query_block, (q_blocks, jnp.arange(n_blk)))
    o = jnp.transpose(o, (1, 0, 3, 2, 4)).reshape(B, S, D)
    return o @ w_o


def moe_ffn(h, w_router, router_bias, w_gate, w_up, w_down, ws_gate, ws_up, ws_down):
    B, S, D = h.shape
    T = B * S
    xf = h.reshape(T, D)
    scores = jax.nn.sigmoid((xf @ w_router).astype(jnp.float32))
    _, idx = lax.top_k(scores + router_bias.astype(jnp.float32), TOP_K)
    sel = jnp.take_along_axis(scores, idx, axis=1)
    gates = ROUTED_SCALE * sel / jnp.sum(sel, axis=1, keepdims=True)

    A = T * TOP_K
    e_flat = idx.reshape(A).astype(jnp.int32)
    tok_flat = jnp.arange(A, dtype=jnp.int32) // TOP_K
    w_flat = gates.reshape(A)
    order = jnp.argsort(e_flat)
    e_s, tok_s, w_s = e_flat[order], tok_flat[order], w_flat[order]
    counts = jnp.bincount(e_flat, length=N_EXPERTS).astype(jnp.int32)
    padded = ((counts + EXPERT_BLOCK - 1) // EXPERT_BLOCK) * EXPERT_BLOCK
    start = jnp.cumsum(counts) - counts
    pend = jnp.cumsum(padded)
    pstart = pend - padded
    dest = pstart[e_s] + jnp.arange(A, dtype=jnp.int32) - start[e_s]
    n_blocks = (A + N_EXPERTS * (EXPERT_BLOCK - 1) + EXPERT_BLOCK - 1) // EXPERT_BLOCK
    P = n_blocks * EXPERT_BLOCK
    buf_tok = jnp.zeros((P,), jnp.int32).at[dest].set(tok_s)
    buf_w = jnp.zeros((P,), jnp.float32).at[dest].set(w_s)
    blk_start = jnp.arange(n_blocks, dtype=jnp.int32) * EXPERT_BLOCK
    blk_expert = jnp.minimum(jnp.searchsorted(pend, blk_start, side='right'), N_EXPERTS - 1)

    def expert_block(args):
        toks, wts, e = args
        xb = xf[toks]
        hb = jax.nn.silu(xb @ w_gate[e]) * (xb @ w_up[e])
        return (hb @ w_down[e]) * wts[:, None].astype(xb.dtype)

    yb = lax.map(expert_block, (buf_tok.reshape(n_blocks, EXPERT_BLOCK),
                                buf_w.reshape(n_blocks, EXPERT_BLOCK), blk_expert))
    routed = jnp.zeros_like(xf).at[buf_tok].add(yb.reshape(P, D))
    shared = (jax.nn.silu(xf @ ws_gate) * (xf @ ws_up)) @ ws_down
    return (routed + shared).reshape(B, S, D)


def setup_inputs(seed: int = 0) -> dict:
    key = jax.random.key(seed)
    ks = iter(jax.random.split(key, 48))
    nrm = lambda shape, s: jax.random.normal(next(ks), shape, jnp.float32) * s
    D, NR, NS, L = D_MODEL, N_RWKV_LAYERS, N_SB_LAYERS, DEPTH
    E, F, FS = N_EXPERTS, D_EXPERT, D_SHARED
    inv = lambda n: float(n) ** -0.5
    return {
        'x': nrm((BATCH, SEQ, D), 1.0),
        'c': nrm((BATCH, D), 1.0),
        'ada_w': nrm((L, D, N_ADA * D), 0.5 * inv(D)),
        'ada_b': nrm((L, N_ADA * D), 0.02),
        'norm_pre_mix': 1.0 + nrm((L, D), 0.05),
        'norm_post_mix': 1.0 + nrm((L, D), 0.05),
        'norm_pre_ffn': 1.0 + nrm((L, D), 0.05),
        'norm_post_ffn': 1.0 + nrm((L, D), 0.05),
        'rwkv_mu': jax.random.uniform(next(ks), (NR, N_TOKEN_SHIFT_MIX, D), jnp.float32),
        'rwkv_w_rkv': nrm((NR, 3, D, D), inv(D)),
        'rwkv_w_w1': nrm((NR, D, D_DECAY_LORA), inv(D)),
        'rwkv_w_w2': nrm((NR, D_DECAY_LORA, D), 0.5 * inv(D_DECAY_LORA)),
        'rwkv_w0': jax.random.uniform(next(ks), (NR, D), jnp.float32, -6.0, -1.0),
        'rwkv_w_a1': nrm((NR, D, D_AAA_LORA), inv(D)),
        'rwkv_w_a2': nrm((NR, D_AAA_LORA, D), 0.5 * inv(D_AAA_LORA)),
        'rwkv_a0': nrm((NR, D), 0.1),
        'rwkv_w_g1': nrm((NR, D, D_GATE_LORA), inv(D)),
        'rwkv_w_g2': nrm((NR, D_GATE_LORA, D), inv(D_GATE_LORA)),
        'rwkv_k_k': 0.85 + nrm((NR, D), 0.05),
        'rwkv_k_a': 1.0 + nrm((NR, D), 0.05),
        'rwkv_r_k': nrm((NR, N_HEADS, HEAD_DIM), 0.1),
        'rwkv_lnx_g': 1.0 + nrm((NR, D), 0.05),
        'rwkv_lnx_b': nrm((NR, D), 0.01),
        'rwkv_w_o': nrm((NR, D, D), inv(D)),
        'sb_w_qkv': nrm((NS, D, 3 * D), inv(D)),
        'sb_w_o': nrm((NS, D, D), inv(D)),
        'moe_w_router': nrm((L, D, E), inv(D)),
        'moe_router_bias': nrm((L, E), 0.01),
        'moe_w_gate': nrm((L, E, D, F), inv(D)),
        'moe_w_up': nrm((L, E, D, F), inv(D)),
        'moe_w_down': nrm((L, E, F, D), inv(F)),
        'moe_ws_gate': nrm((L, D, FS), inv(D)),
        'moe_ws_up': nrm((L, D, FS), inv(D)),
        'moe_ws_down': nrm((L, FS, D), inv(FS)),
    }


def reference(x, c, ada_w, ada_b, norm_pre_mix, norm_post_mix, norm_pre_ffn, norm_post_ffn,
              rwkv_mu, rwkv_w_rkv, rwkv_w_w1, rwkv_w_w2, rwkv_w0, rwkv_w_a1, rwkv_w_a2, rwkv_a0,
              rwkv_w_g1, rwkv_w_g2, rwkv_k_k, rwkv_k_a, rwkv_r_k, rwkv_lnx_g, rwkv_lnx_b, rwkv_w_o,
              sb_w_qkv, sb_w_o,
              moe_w_router, moe_router_bias, moe_w_gate, moe_w_up, moe_w_down,
              moe_ws_gate, moe_ws_up, moe_ws_down):
    mod_all = jnp.einsum('bd,lde->lbe', jax.nn.silu(c), ada_w) + ada_b[:, None, :]
    for layer in range(DEPTH):
        shift_m, scale_m, gate_m, shift_f, scale_f, gate_f = jnp.split(
            mod_all[layer][:, None, :], N_ADA, axis=-1)
        h = rmsnorm(x, norm_pre_mix[layer]) * (1.0 + scale_m) + shift_m
        i = layer // N_MIXERS
        if layer % N_MIXERS == 0:
            y = rwkv7_time_mix(h, rwkv_mu[i], rwkv_w_rkv[i], rwkv_w_w1[i], rwkv_w_w2[i], rwkv_w0[i],
                               rwkv_w_a1[i], rwkv_w_a2[i], rwkv_a0[i], rwkv_w_g1[i], rwkv_w_g2[i],
                               rwkv_k_k[i], rwkv_k_a[i], rwkv_r_k[i], rwkv_lnx_g[i], rwkv_lnx_b[i],
                               rwkv_w_o[i])
        else:
            y = stick_breaking_attention(h, sb_w_qkv[i], sb_w_o[i])
        x = x + gate_m * rmsnorm(y, norm_post_mix[layer])
        h = rmsnorm(x, norm_pre_ffn[layer]) * (1.0 + scale_f) + shift_f
        y = moe_ffn(h, moe_w_router[layer], moe_router_bias[layer], moe_w_gate[layer],
                    moe_w_up[layer], moe_w_down[layer], moe_ws_gate[layer], moe_ws_up[layer],
                    moe_ws_down[layer])
        x = x + gate_f * rmsnorm(y, norm_post_ffn[layer])
    return x
```

```cpp
#include <hip/hip_runtime.h>
#include <cstdio>
#include <cstdint>

#ifndef MK_N_LAUNCHES
#define MK_N_LAUNCHES 1
#endif

constexpr int T = 16384, D = 1024, SEQ = 8192, NB = 2, NH = 16, HD = 64;
constexpr int NE = 64, TOPK = 8, DE = 256;
constexpr int RP = 256;
constexpr int MAXROUTED = 147456;
constexpr int MAXROWS = MAXROUTED + T;
constexpr int NTHREADS = 512, NWAVES = 8;
constexpr int NPHASES = 24;
constexpr int LDS_BYTES = 144 * 1024;

typedef unsigned short bf16_t;
typedef float f32x4 __attribute__((ext_vector_type(4)));
typedef unsigned u32x4 __attribute__((ext_vector_type(4)));
typedef unsigned u32x2 __attribute__((ext_vector_type(2)));

__device__ __forceinline__ float bf2f(bf16_t b) { return __uint_as_float(((unsigned)b) << 16); }
__device__ __forceinline__ bf16_t f2bf(float f) { unsigned u = __float_as_uint(f); u += 0x7FFFu + ((u >> 16) & 1u); return (bf16_t)(u >> 16); }
__device__ __forceinline__ unsigned pack2(float a, float b) { return (unsigned)f2bf(a) | ((unsigned)f2bf(b) << 16); }
__device__ __forceinline__ float lo2f(unsigned u) { return __uint_as_float(u << 16); }
__device__ __forceinline__ float hi2f(unsigned u) { return __uint_as_float(u & 0xffff0000u); }
__device__ __forceinline__ float sigmoidf_(float x) { return 1.0f / (1.0f + __expf(-x)); }
__device__ __forceinline__ float softplusf_(float x) { return x > 20.f ? x : log1pf(__expf(x)); }
__device__ __forceinline__ float wave_sum(float v) {
#pragma unroll
    for (int o = 32; o >= 1; o >>= 1) v += __shfl_xor(v, o);
    return v;
}

constexpr size_t MiB = 1024 * 1024;
constexpr size_t WS_CTL    = 0;
constexpr size_t CTL_BYTES = 64 * 1024;
constexpr size_t WS_MOD    = 64 * 1024;
constexpr size_t WS_IDX    = 256 * 1024;
constexpr size_t WS_GATE   = WS_IDX + 512 * 1024;
constexpr size_t WS_RANK   = WS_GATE + 512 * 1024;
constexpr size_t WS_POS    = WS_RANK + 512 * 1024;
constexpr size_t WS_TOK    = WS_POS + 512 * 1024;
constexpr size_t WS_TILEE  = WS_TOK + 704 * 1024;
constexpr size_t WS_START  = WS_TILEE + 4096;
constexpr size_t WS_LOGITS = 4 * MiB;
constexpr size_t WS_BIG    = 8 * MiB;
constexpr size_t WS_XS   = WS_BIG;
constexpr size_t WS_RKV  = WS_BIG + 192 * MiB;
constexpr size_t WS_LORA = WS_BIG + 288 * MiB;
constexpr size_t WS_LD   = WS_BIG + 296 * MiB;
constexpr size_t WS_AA   = WS_BIG + 360 * MiB;
constexpr size_t WS_GG   = WS_BIG + 392 * MiB;
constexpr size_t WS_O    = WS_BIG;
constexpr size_t WS_OG   = WS_BIG + 64 * MiB;
constexpr size_t WS_Y1   = WS_BIG + 96 * MiB;
constexpr size_t WS_H2   = WS_BIG;
constexpr size_t WS_H2LO = WS_BIG + 32 * MiB;
constexpr size_t WS_YB   = WS_BIG;
constexpr size_t WS_HB   = WS_BIG + 320 * MiB;
constexpr size_t WS_H3   = WS_BIG + 320 * MiB;
constexpr size_t WS_Q    = WS_BIG;
constexpr size_t WS_AO   = WS_BIG + 96 * MiB;
constexpr size_t WS_Y1B  = WS_BIG + 128 * MiB;
constexpr size_t WS_END  = WS_BIG + 424 * MiB;

constexpr int CW_BAR = 0;
constexpr int CW_CNT = 4096;

#define XB_TMO      128
#define XB_XCNT(j)  (256  + 64 * (j))
#define XB_XSUB(j)  (1280 + 64 * (j))
#define XB_XGEN(j)  (2304 + 64 * (j))
#define XB_TOP      3328
#define XB_TOPGEN   3392
#define XCD_BAR_WORDS 3456
#define XB_SPIN_CAP (1u << 22)
#define LAS __attribute__((address_space(3)))

__device__ __forceinline__ unsigned xb_ld(unsigned* p)              { return __hip_atomic_load(p, __ATOMIC_RELAXED, __HIP_MEMORY_SCOPE_AGENT); }
__device__ __forceinline__ unsigned xb_add(unsigned* p, unsigned v) { return __hip_atomic_fetch_add(p, v, __ATOMIC_RELAXED, __HIP_MEMORY_SCOPE_AGENT); }
__device__ __forceinline__ unsigned xb_xcc_id() { return (unsigned)__builtin_amdgcn_s_getreg((3 << 11) | 20) & 0xFu; }
#define XB_SPIN(cond, bar) do { unsigned _sp = 0; while (cond) { __builtin_amdgcn_s_sleep(1); \
    if ((++_sp & 255u) == 0u) { if (xb_ld(&(bar)[XB_TMO])) break; if (_sp > XB_SPIN_CAP) { atomicAdd(&(bar)[XB_TMO], 1u); break; } } } } while (0)

struct XcdBarrier { unsigned* bar; unsigned x; volatile LAS unsigned* st; };

__device__ __forceinline__ XcdBarrier xcd_barrier_post(unsigned* bar, volatile LAS unsigned* st) {
    XcdBarrier b; b.bar = bar; b.x = xb_xcc_id(); b.st = st;
    if (threadIdx.x == 0) (void)xb_add(&bar[XB_XCNT(b.x)], 1u);
    return b;
}
__device__ __forceinline__ void xcd_barrier_complete(unsigned* bar, unsigned x, unsigned& nloc, unsigned& nx) {
    const unsigned G = gridDim.x * gridDim.y * gridDim.z;
    unsigned sum, cnt, mine, sp = 0u;
    for (;;) {
        sum = 0u; cnt = 0u; mine = 0u;
#pragma unroll
        for (unsigned j = 0; j < 16; ++j) { const unsigned c = xb_ld(&bar[XB_XCNT(j)]); sum += c; cnt += (c > 0u) ? 1u : 0u; mine = (j == x) ? c : mine; }
        if (sum == G) break;
        __builtin_amdgcn_s_sleep(1);
        if ((++sp & 255u) == 0u) { if (xb_ld(&bar[XB_TMO])) break; if (sp > XB_SPIN_CAP) { atomicAdd(&bar[XB_TMO], 1u); break; } }
    }
    nloc = mine > 0u ? mine : 1u; nx = cnt > 0u ? cnt : 1u;
}
__device__ __forceinline__ void xcd_barrier(const XcdBarrier& b) {
    asm volatile("s_waitcnt vmcnt(0)" ::: "memory");
    __syncthreads();
    if (threadIdx.x == 0) {
        unsigned* bar = b.bar;
        __builtin_amdgcn_s_waitcnt(0);
        unsigned nloc = b.st[0], nx = b.st[1];
        if (nloc == 0u) { xcd_barrier_complete(bar, b.x, nloc, nx); b.st[0] = nloc; b.st[1] = nx; }
        const unsigned old = xb_add(&bar[XB_XSUB(b.x)], 1u);
        const unsigned gen = old / nloc;
        if (old + 1u == (gen + 1u) * nloc) {
            __builtin_amdgcn_fence(__ATOMIC_RELEASE, "agent");
            asm volatile("s_waitcnt vmcnt(0)" ::: "memory");
            const unsigned og = xb_add(&bar[XB_TOP], 1u);
            const unsigned tg = og / nx;
            if (og + 1u == (tg + 1u) * nx) xb_add(&bar[XB_TOPGEN], 1u);
            else XB_SPIN(xb_ld(&bar[XB_TOPGEN]) == tg, bar);
            __builtin_amdgcn_fence(__ATOMIC_ACQUIRE, "agent");
            xb_add(&bar[XB_XGEN(b.x)], 1u);
            asm volatile("s_waitcnt vmcnt(0)" ::: "memory");
        } else {
            XB_SPIN(xb_ld(&bar[XB_XGEN(b.x)]) == gen, bar);
            __builtin_amdgcn_fence(__ATOMIC_ACQUIRE, "agent");
            asm volatile("s_waitcnt vmcnt(0)" ::: "memory");
        }
    }
    __syncthreads();
}

struct Args { const float* in[34]; float* out; unsigned char* ws; int ph_lo, ph_hi; };

struct Frame {
    const float* const* in; float* out; unsigned char* ws; unsigned* ctl;
    float* ldsf; int tid, lane, wave, bid, G;
};

enum { I_X = 0, I_C, I_ADAW, I_ADAB, I_NPM, I_NPOM, I_NPF, I_NPOF, I_MU, I_WRKV, I_WW1, I_WW2, I_W0, I_WA1, I_WA2, I_A0, I_WG1, I_WG2,
       I_KK, I_KA, I_RK, I_LNG, I_LNB, I_WO, I_SBQKV, I_SBO, I_ROUTER, I_RBIAS, I_MG, I_MU_, I_MD, I_SG, I_SU, I_SD };

template <class AF, class BF>
__device__ __forceinline__ void simt_tile(float (&acc)[4][4], const AF& af, const BF& bfn, int row0, int col0, int K, float* sm) {
    float* sA = sm; float* sB = sm + 16 * 132;
    const int tid = threadIdx.x, ty = tid >> 4, tx = tid & 15;
#pragma unroll
    for (int i = 0; i < 4; ++i)
#pragma unroll
        for (int j = 0; j < 4; ++j) acc[i][j] = 0.f;
    for (int k0 = 0; k0 < K; k0 += 16) {
#pragma unroll
        for (int q = 0; q < 4; ++q) { const int idx = tid + 512 * q, r = idx >> 4, kk = idx & 15; sA[kk * 132 + r] = af(row0 + r, k0 + kk); }
#pragma unroll
        for (int q = 0; q < 2; ++q) { const int idx = tid + 512 * q, kk = idx >> 6, c = idx & 63; sB[kk * 68 + c] = bfn(k0 + kk, col0 + c); }
        __syncthreads();
#pragma unroll
        for (int kk = 0; kk < 16; ++kk) {
            const f32x4 a = *(const f32x4*)&sA[kk * 132 + ty * 4];
            const f32x4 b = *(const f32x4*)&sB[kk * 68 + tx * 4];
#pragma unroll
            for (int i = 0; i < 4; ++i)
#pragma unroll
                for (int j = 0; j < 4; ++j) acc[i][j] += a[i] * b[j];
        }
        __syncthreads();
    }
}

__device__ __forceinline__ void ph_mod(const Frame& F) {
    const float* c = F.in[I_C]; const float* W = F.in[I_ADAW]; const float* bias = F.in[I_ADAB];
    float* MOD = (float*)(F.ws + WS_MOD);
    float* red = F.ldsf;
    for (int u = F.bid; u < 192; u += F.G) {
        const int l = u / 96, cg = u % 96, col = cg * 64 + F.lane;
        float s0 = 0.f, s1 = 0.f;
        const float* wp = W + ((size_t)l * D + F.wave * 128) * 6144 + col;
        for (int d = 0; d < 128; ++d) {
            const int dd = F.wave * 128 + d;
            const float c0 = c[dd], c1 = c[D + dd];
            const float w = wp[(size_t)d * 6144];
            s0 += (c0 * sigmoidf_(c0)) * w; s1 += (c1 * sigmoidf_(c1)) * w;
        }
        red[(F.wave * 2 + 0) * 64 + F.lane] = s0; red[(F.wave * 2 + 1) * 64 + F.lane] = s1;
        __syncthreads();
        if (F.tid < 128) {
            const int b = F.tid >> 6, cc = F.tid & 63; float s = 0.f;
#pragma unroll
            for (int w = 0; w < 8; ++w) s += red[(w * 2 + b) * 64 + cc];
            MOD[(l * 2 + b) * 6144 + cg * 64 + cc] = s + bias[l * 6144 + cg * 64 + cc];
        }
        __syncthreads();
    }
}

__device__ __forceinline__ void ph_prenorm_rwkv(const Frame& F) {
    const float* x = F.in[I_X]; const float* g = F.in[I_NPM]; const float* mu = F.in[I_MU];
    const float* MOD = (const float*)(F.ws + WS_MOD);
    bf16_t* XS = (bf16_t*)(F.ws + WS_XS);
    const int nunits = T / 8;
    for (int u = F.bid * NWAVES + F.wave; u < nunits; u += F.G * NWAVES) {
        const int t0 = u * 8, b = t0 / SEQ;
        const float* shift = MOD + (0 * 2 + b) * 6144; const float* scale = shift + 1024;
        f32x4 gm[4], sh[4];
#pragma unroll
        for (int i = 0; i < 4; ++i) { const int c = 4 * F.lane + 256 * i; const f32x4 gv = *(const f32x4*)(g + c), sc = *(const f32x4*)(scale + c); gm[i] = gv * (sc + 1.0f); sh[i] = *(const f32x4*)(shift + c); }
        f32x4 hp[4];
#pragma unroll
        for (int i = 0; i < 4; ++i) hp[i] = (f32x4){0.f, 0.f, 0.f, 0.f};
        const int tstart = (t0 % SEQ == 0) ? t0 : t0 - 1;
        for (int t = tstart; t < t0 + 8; ++t) {
            f32x4 xv[4]; float ss = 0.f;
#pragma unroll
            for (int i = 0; i < 4; ++i) { xv[i] = *(const f32x4*)(x + (size_t)t * D + 4 * F.lane + 256 * i); ss += xv[i][0] * xv[i][0] + xv[i][1] * xv[i][1] + xv[i][2] * xv[i][2] + xv[i][3] * xv[i][3]; }
            ss = wave_sum(ss);
            const float rs = rsqrtf(ss * (1.0f / D) + 1e-6f);
            f32x4 h[4];
#pragma unroll
            for (int i = 0; i < 4; ++i) h[i] = xv[i] * rs * gm[i] + sh[i];
            if (t >= t0) {
#pragma unroll
                for (int n = 0; n < 6; ++n) {
#pragma unroll
                    for (int i = 0; i < 4; ++i) {
                        const int c = 4 * F.lane + 256 * i;
                        const f32x4 m = *(const f32x4*)(mu + n * D + c);
                        const f32x4 v = h[i] + (hp[i] - h[i]) * m;
                        u32x2 w; w.x = pack2(v[0], v[1]); w.y = pack2(v[2], v[3]);
                        *(u32x2*)(XS + ((size_t)n * T + t) * D + c) = w;
                    }
                }
            }
#pragma unroll
            for (int i = 0; i < 4; ++i) hp[i] = h[i];
        }
    }
}

__device__ __forceinline__ void ph_rkv_lora_simt(const Frame& F) {
    const bf16_t* XS = (const bf16_t*)(F.ws + WS_XS);
    bf16_t* RKV = (bf16_t*)(F.ws + WS_RKV); bf16_t* LORA = (bf16_t*)(F.ws + WS_LORA);
    const int nct = 52, nunits = (T / 128) * nct;
    for (int u = F.bid; u < nunits; u += F.G) {
        const int rt = u / nct, ct = u % nct, row0 = rt * 128;
        float acc[4][4];
        const int ty = F.tid >> 4, tx = F.tid & 15;
        if (ct < 48) {
            const int n = ct / 16, col0 = (ct % 16) * 64;
            const bf16_t* A = XS + (size_t)n * T * D; const float* W = F.in[I_WRKV] + (size_t)n * D * D;
            simt_tile(acc, [&](int r, int k) { return bf2f(A[(size_t)r * D + k]); }, [&](int k, int c) { return W[(size_t)k * D + c]; }, row0, col0, D, F.ldsf);
#pragma unroll
            for (int i = 0; i < 4; ++i) { u32x2 w; w.x = pack2(acc[i][0], acc[i][1]); w.y = pack2(acc[i][2], acc[i][3]);
                *(u32x2*)(RKV + ((size_t)n * T + row0 + ty * 4 + i) * D + col0 + tx * 4) = w; }
        } else {
            const int j = ct - 48;
            const int n = (j == 0) ? 3 : (j == 1 ? 4 : 5);
            const bf16_t* A = XS + (size_t)n * T * D;
            const float* W = (j == 0) ? F.in[I_WW1] : (j == 1 ? F.in[I_WA1] : F.in[I_WG1]);
            const int ldw = (j >= 2) ? 128 : 64, coff = (j == 3) ? 64 : 0;
            simt_tile(acc, [&](int r, int k) { return bf2f(A[(size_t)r * D + k]); }, [&](int k, int c) { return W[(size_t)k * ldw + coff + c]; }, row0, 0, D, F.ldsf);
#pragma unroll
            for (int i = 0; i < 4; ++i) {
                float v[4];
#pragma unroll
                for (int q = 0; q < 4; ++q) { const float a = acc[i][q]; v[q] = (j == 0) ? tanhf(a) : (j == 1 ? a : sigmoidf_(a)); }
                u32x2 w; w.x = pack2(v[0], v[1]); w.y = pack2(v[2], v[3]);
                *(u32x2*)(LORA + (size_t)(row0 + ty * 4 + i) * 256 + j * 64 + tx * 4) = w;
            }
        }
    }
}

__device__ __forceinline__ void ph_lora_up_simt(const Frame& F) {
    const bf16_t* LORA = (const bf16_t*)(F.ws + WS_LORA);
    float* LD = (float*)(F.ws + WS_LD); bf16_t* AA = (bf16_t*)(F.ws + WS_AA); bf16_t* GG = (bf16_t*)(F.ws + WS_GG);
    const int nunits = (T / 128) * 48;
    for (int u = F.bid; u < nunits; u += F.G) {
        const int rt = u / 48, ct = u % 48, row0 = rt * 128, which = ct / 16, col0 = (ct % 16) * 64;
        const int ty = F.tid >> 4, tx = F.tid & 15;
        float acc[4][4];
        const float* W = which == 0 ? F.in[I_WW2] : (which == 1 ? F.in[I_WA2] : F.in[I_WG2]);
        const int K = which == 2 ? 128 : 64, koff = which * 64;
        simt_tile(acc, [&](int r, int k) { return bf2f(LORA[(size_t)r * 256 + koff + k]); }, [&](int k, int c) { return W[(size_t)k * D + c]; }, row0, col0, K, F.ldsf);
#pragma unroll
        for (int i = 0; i < 4; ++i) {
            const size_t o = (size_t)(row0 + ty * 4 + i) * D + col0 + tx * 4;
            if (which == 0) {
                f32x4 v;
#pragma unroll
                for (int q = 0; q < 4; ++q) { const float wl = F.in[I_W0][col0 + tx * 4 + q] + acc[i][q]; const float wlog = -softplusf_(-wl) - 0.5f; v[q] = -__expf(wlog); }
                *(f32x4*)(LD + o) = v;
            } else if (which == 1) {
                float v[4];
#pragma unroll
                for (int q = 0; q < 4; ++q) v[q] = sigmoidf_(F.in[I_A0][col0 + tx * 4 + q] + acc[i][q]);
                u32x2 w; w.x = pack2(v[0], v[1]); w.y = pack2(v[2], v[3]); *(u32x2*)(AA + o) = w;
            } else {
                u32x2 w; w.x = pack2(acc[i][0], acc[i][1]); w.y = pack2(acc[i][2], acc[i][3]); *(u32x2*)(GG + o) = w;
            }
        }
    }
}

__device__ __forceinline__ void ph_wkv_seq(const Frame& F) {
    const bf16_t* RKV = (const bf16_t*)(F.ws + WS_RKV); const float* LD = (const float*)(F.ws + WS_LD); const bf16_t* AA = (const bf16_t*)(F.ws + WS_AA);
    float* O = (float*)(F.ws + WS_O);
    const bf16_t* Rb = RKV; const bf16_t* Kb = RKV + (size_t)T * D; const bf16_t* Vb = RKV + (size_t)2 * T * D;
    for (int u = F.bid; u < NB * NH; u += F.G) {
        const int b = u / NH, h = u % NH, i = F.tid >> 3, js = F.tid & 7;
        const int cj = h * 64 + js * 8;
        float kkw[8], kaw[8];
#pragma unroll
        for (int e = 0; e < 8; ++e) { kkw[e] = F.in[I_KK][cj + e]; kaw[e] = F.in[I_KA][cj + e]; }
        float S[8];
#pragma unroll
        for (int e = 0; e < 8; ++e) S[e] = 0.f;
        size_t base = (size_t)(b * SEQ) * D;
        u32x4 kr = *(const u32x4*)(Kb + base + cj), rr = *(const u32x4*)(Rb + base + cj), ar = *(const u32x4*)(AA + base + cj);
        f32x4 l0 = *(const f32x4*)(LD + base + cj), l1 = *(const f32x4*)(LD + base + cj + 4);
        bf16_t vr = Vb[base + h * 64 + i];
        for (int t = 0; t < SEQ; ++t) {
            const u32x4 kc = kr, rc = rr, ac = ar; const f32x4 lc0 = l0, lc1 = l1; const bf16_t vc = vr;
            if (t + 1 < SEQ) { const size_t nb = base + D;
                kr = *(const u32x4*)(Kb + nb + cj); rr = *(const u32x4*)(Rb + nb + cj); ar = *(const u32x4*)(AA + nb + cj);
                l0 = *(const f32x4*)(LD + nb + cj); l1 = *(const f32x4*)(LD + nb + cj + 4); vr = Vb[nb + h * 64 + i]; }
            float k[8], r[8], a[8], ld[8];
#pragma unroll
            for (int q = 0; q < 4; ++q) { k[2 * q] = lo2f(kc[q]); k[2 * q + 1] = hi2f(kc[q]); r[2 * q] = lo2f(rc[q]); r[2 * q + 1] = hi2f(rc[q]); a[2 * q] = lo2f(ac[q]); a[2 * q + 1] = hi2f(ac[q]); }
#pragma unroll
            for (int q = 0; q < 4; ++q) { ld[q] = lc0[q]; ld[4 + q] = lc1[q]; }
            const float v = bf2f(vc);
            float kkv[8], ss = 0.f;
#pragma unroll
            for (int e = 0; e < 8; ++e) { kkv[e] = k[e] * kkw[e]; ss += kkv[e] * kkv[e]; }
            ss += __shfl_xor(ss, 1); ss += __shfl_xor(ss, 2); ss += __shfl_xor(ss, 4);
            const float inv = 1.0f / fmaxf(sqrtf(ss), 1e-12f);
            float sa = 0.f;
#pragma unroll
            for (int e = 0; e < 8; ++e) { kkv[e] *= inv; sa += S[e] * (-kkv[e]); }
            sa += __shfl_xor(sa, 1); sa += __shfl_xor(sa, 2); sa += __shfl_xor(sa, 4);
            float o = 0.f;
#pragma unroll
            for (int e = 0; e < 8; ++e) {
                const float kf = k[e] * (1.0f + (a[e] - 1.0f) * kaw[e]);
                S[e] = S[e] * __expf(ld[e]) + sa * (kkv[e] * a[e]) + v * kf;
                o += S[e] * r[e];
            }
            o += __shfl_xor(o, 1); o += __shfl_xor(o, 2); o += __shfl_xor(o, 4);
            if (js == 0) O[base + h * 64 + i] = o;
            base += D;
        }
    }
}

__device__ __forceinline__ void ld16bf(const bf16_t* p, float (&v)[16]) {
    const u32x4 a = *(const u32x4*)p, b = *(const u32x4*)(p + 8);
#pragma unroll
    for (int q = 0; q < 4; ++q) { v[2 * q] = lo2f(a[q]); v[2 * q + 1] = hi2f(a[q]); v[8 + 2 * q] = lo2f(b[q]); v[9 + 2 * q] = hi2f(b[q]); }
}
__device__ __forceinline__ void st16bf(bf16_t* p, const float (&v)[16]) {
    u32x4 a, b;
#pragma unroll
    for (int q = 0; q < 4; ++q) { a[q] = pack2(v[2 * q], v[2 * q + 1]); b[q] = pack2(v[8 + 2 * q], v[9 + 2 * q]); }
    *(u32x4*)p = a; *(u32x4*)(p + 8) = b;
}
__device__ __forceinline__ void ld16f(const float* p, float (&v)[16]) {
#pragma unroll
    for (int q = 0; q < 4; ++q) { const f32x4 a = *(const f32x4*)(p + 4 * q); v[4 * q] = a[0]; v[4 * q + 1] = a[1]; v[4 * q + 2] = a[2]; v[4 * q + 3] = a[3]; }
}
__device__ __forceinline__ void ph_wkv_post(const Frame& F) {
    const bf16_t* RKV = (const bf16_t*)(F.ws + WS_RKV); const bf16_t* AA = (const bf16_t*)(F.ws + WS_AA); const bf16_t* GG = (const bf16_t*)(F.ws + WS_GG);
    const float* O = (const float*)(F.ws + WS_O); bf16_t* OG = (bf16_t*)(F.ws + WS_OG);
    const int c0 = 16 * F.lane;
    float ka[16], rk[16], lg[16], lb[16];
    ld16f(F.in[I_KA] + c0, ka); ld16f(F.in[I_RK] + c0, rk); ld16f(F.in[I_LNG] + c0, lg); ld16f(F.in[I_LNB] + c0, lb);
    for (int t = F.bid * NWAVES + F.wave; t < T; t += F.G * NWAVES) {
        const size_t o = (size_t)t * D + c0;
        float ov[16], r[16], k[16], v[16], a[16], g[16];
        ld16f(O + o, ov); ld16bf(RKV + o, r); ld16bf(RKV + (size_t)T * D + o, k); ld16bf(RKV + (size_t)2 * T * D + o, v); ld16bf(AA + o, a); ld16bf(GG + o, g);
        float s = 0.f, bs = 0.f;
#pragma unroll
        for (int e = 0; e < 16; ++e) { s += ov[e]; const float kf = k[e] * (1.0f + (a[e] - 1.0f) * ka[e]); bs += r[e] * kf * rk[e]; }
        s += __shfl_xor(s, 1); s += __shfl_xor(s, 2); bs += __shfl_xor(bs, 1); bs += __shfl_xor(bs, 2);
        const float mean = s * (1.0f / 64.0f);
        float q = 0.f;
#pragma unroll
        for (int e = 0; e < 16; ++e) { const float d = ov[e] - mean; q += d * d; }
        q += __shfl_xor(q, 1); q += __shfl_xor(q, 2);
        const float rstd = rsqrtf(q * (1.0f / 64.0f) + 64e-5f);
        float res[16];
#pragma unroll
        for (int e = 0; e < 16; ++e) res[e] = (((ov[e] - mean) * rstd) * lg[e] + lb[e] + bs * v[e]) * g[e];
        st16bf(OG + o, res);
    }
}

template <int OUTMODE>
__device__ __forceinline__ void ph_dense_simt(const Frame& F, const bf16_t* A, const float* W, int N, int K, void* out) {
    const int nct = N / 64, nunits = (T / 128) * nct;
    for (int u = F.bid; u < nunits; u += F.G) {
        const int rt = u / nct, ct = u % nct, row0 = rt * 128, col0 = ct * 64;
        const int ty = F.tid >> 4, tx = F.tid & 15;
        float acc[4][4];
        simt_tile(acc, [&](int r, int k) { return bf2f(A[(size_t)r * K + k]); }, [&](int k, int c) { return W[(size_t)k * N + c]; }, row0, col0, K, F.ldsf);
#pragma unroll
        for (int i = 0; i < 4; ++i) {
            const int r = row0 + ty * 4 + i, c = col0 + tx * 4;
            if (OUTMODE == 0) { *(f32x4*)((float*)out + (size_t)r * N + c) = (f32x4){acc[i][0], acc[i][1], acc[i][2], acc[i][3]}; }
            else { u32x2 w; w.x = pack2(acc[i][0], acc[i][1]); w.y = pack2(acc[i][2], acc[i][3]);
                   *(u32x2*)((bf16_t*)out + (size_t)(c / D) * T * D + (size_t)r * D + (c % D)) = w; }
        }
    }
}

__device__ __forceinline__ void ph_postmix_preffn(const Frame& F, int layer, const float* xin, const float* Y) {
    const float* MOD = (const float*)(F.ws + WS_MOD);
    const float* gpo = F.in[I_NPOM] + layer * D; const float* gpf = F.in[I_NPF] + layer * D;
    bf16_t* H2 = (bf16_t*)(F.ws + WS_H2); bf16_t* H2LO = (bf16_t*)(F.ws + WS_H2LO);
    for (int t = F.bid * NWAVES + F.wave; t < T; t += F.G * NWAVES) {
        const int b = t / SEQ; const float* m = MOD + (layer * 2 + b) * 6144;
        f32x4 y[4]; float ss = 0.f;
#pragma unroll
        for (int i = 0; i < 4; ++i) { y[i] = *(const f32x4*)(Y + (size_t)t * D + 4 * F.lane + 256 * i); ss += y[i][0] * y[i][0] + y[i][1] * y[i][1] + y[i][2] * y[i][2] + y[i][3] * y[i][3]; }
        ss = wave_sum(ss);
        const float rs = rsqrtf(ss * (1.0f / D) + 1e-6f);
        f32x4 x1[4]; float s2 = 0.f;
#pragma unroll
        for (int i = 0; i < 4; ++i) { const int c = 4 * F.lane + 256 * i;
            const f32x4 xv = *(const f32x4*)(xin + (size_t)t * D + c), gm = *(const f32x4*)(m + 2048 + c), gp = *(const f32x4*)(gpo + c);
            x1[i] = xv + gm * (y[i] * rs * gp);
            *(f32x4*)(F.out + (size_t)t * D + c) = x1[i];
            s2 += x1[i][0] * x1[i][0] + x1[i][1] * x1[i][1] + x1[i][2] * x1[i][2] + x1[i][3] * x1[i][3]; }
        s2 = wave_sum(s2);
        const float rs2 = rsqrtf(s2 * (1.0f / D) + 1e-6f);
#pragma unroll
        for (int i = 0; i < 4; ++i) { const int c = 4 * F.lane + 256 * i;
            const f32x4 gf = *(const f32x4*)(gpf + c), sc = *(const f32x4*)(m + 4096 + c), sh = *(const f32x4*)(m + 3072 + c);
            const f32x4 h = x1[i] * rs2 * gf * (sc + 1.0f) + sh;
            u32x2 w; w.x = pack2(h[0], h[1]); w.y = pack2(h[2], h[3]);
            u32x2 wl; wl.x = pack2(h[0] - lo2f(w.x), h[1] - hi2f(w.x)); wl.y = pack2(h[2] - lo2f(w.y), h[3] - hi2f(w.y));
            *(u32x2*)(H2 + (size_t)t * D + c) = w; *(u32x2*)(H2LO + (size_t)t * D + c) = wl; }
    }
}

__device__ __forceinline__ void ph_router_simt(const Frame& F, int layer) {
    const bf16_t* H2 = (const bf16_t*)(F.ws + WS_H2); const bf16_t* H2LO = (const bf16_t*)(F.ws + WS_H2LO);
    const float* W = F.in[I_ROUTER] + (size_t)layer * D * NE; float* LOG = (float*)(F.ws + WS_LOGITS);
    for (int u = F.bid; u < T / 128; u += F.G) {
        const int row0 = u * 128, ty = F.tid >> 4, tx = F.tid & 15;
        float acc[4][4];
        simt_tile(acc, [&](int r, int k) { return bf2f(H2[(size_t)r * D + k]) + bf2f(H2LO[(size_t)r * D + k]); }, [&](int k, int c) { return W[(size_t)k * NE + c]; }, row0, 0, D, F.ldsf);
#pragma unroll
        for (int i = 0; i < 4; ++i) *(f32x4*)(LOG + (size_t)(row0 + ty * 4 + i) * NE + tx * 4) = (f32x4){acc[i][0], acc[i][1], acc[i][2], acc[i][3]};
    }
}

__device__ __forceinline__ void ph_topk(const Frame& F, int layer) {
    const float* LOG = (const float*)(F.ws + WS_LOGITS); const float* rb = F.in[I_RBIAS] + layer * NE;
    int* IDX = (int*)(F.ws + WS_IDX); float* GATE = (float*)(F.ws + WS_GATE); int* RANK = (int*)(F.ws + WS_RANK);
    unsigned* CNT = F.ctl + CW_CNT + layer * 64;
    const float bias = rb[F.lane];
    for (int t = F.bid * NWAVES + F.wave; t < T; t += F.G * NWAVES) {
        const float s = sigmoidf_(LOG[(size_t)t * NE + F.lane]);
        float sel = s + bias;
        int myidx = -1; float mysc = 0.f; float tot = 0.f;
#pragma unroll
        for (int k = 0; k < TOPK; ++k) {
            float bv = sel; int bi = F.lane;
#pragma unroll
            for (int o = 32; o >= 1; o >>= 1) { const float ov = __shfl_xor(bv, o); const int oi = __shfl_xor(bi, o); if (ov > bv || (ov == bv && oi < bi)) { bv = ov; bi = oi; } }
            const float sc = __shfl(s, bi);
            tot += sc;
            if (F.lane == k) { myidx = bi; mysc = sc; }
            if (F.lane == bi) sel = -1e30f;
        }
        if (F.lane < TOPK) {
            IDX[t * TOPK + F.lane] = myidx; GATE[t * TOPK + F.lane] = 2.5f * mysc / tot;
            RANK[t * TOPK + F.lane] = (int)atomicAdd(&CNT[myidx], 1u);
        }
    }
}

__device__ __forceinline__ void ph_offsets(const Frame& F, int layer) {
    const unsigned* CNT = F.ctl + CW_CNT + layer * 64;
    const int* IDX = (const int*)(F.ws + WS_IDX); const int* RANK = (const int*)(F.ws + WS_RANK);
    int* POS = (int*)(F.ws + WS_POS); int* TOK = (int*)(F.ws + WS_TOK); int* TILEE = (int*)(F.ws + WS_TILEE); int* START = (int*)(F.ws + WS_START);
    int* sst = (int*)F.ldsf;
    if (F.tid == 0) { int acc = 0; for (int e = 0; e < NE; ++e) { const int c = (int)CNT[e]; sst[e] = acc; sst[128 + e] = c; acc += ((c + RP - 1) / RP) * RP; } sst[64] = acc; }
    __syncthreads();
    if (F.bid == 0) {
        if (F.tid <= 64) START[F.tid] = sst[F.tid];
        if (F.tid == 65) START[65] = sst[64];
        const int ntile = sst[64] / RP;
        for (int i = F.tid; i < ntile; i += NTHREADS) { int e = 0; while (e < 63 && sst[e + 1] <= i * RP) ++e; TILEE[i] = e; }
    }
    for (int s = F.bid * NTHREADS + F.tid; s < T * TOPK; s += F.G * NTHREADS) {
        const int e = IDX[s], p = sst[e] + RANK[s];
        POS[s] = p; TOK[p] = s / TOPK;
    }
    for (int s = F.bid * NTHREADS + F.tid; s < NE * RP; s += F.G * NTHREADS) {
        const int e = s / RP, r = s % RP, c = sst[128 + e];
        if (sst[e] + c + r < sst[e + 1]) TOK[sst[e] + c + r] = 0;
    }
    __syncthreads();
}

__device__ __forceinline__ void ph_gateup_simt(const Frame& F, int layer) {
    const bf16_t* H2 = (const bf16_t*)(F.ws + WS_H2); bf16_t* HB = (bf16_t*)(F.ws + WS_HB);
    const int* TOK = (const int*)(F.ws + WS_TOK); const int* TILEE = (const int*)(F.ws + WS_TILEE); const int* START = (const int*)(F.ws + WS_START);
    const int routed = START[65], nrt = (routed + T) / 128, nunits = nrt * 4;
    for (int u = F.bid; u < nunits; u += F.G) {
        const int rt = u / 4, ct = u % 4, row0 = rt * 128, col0 = ct * 64, ty = F.tid >> 4, tx = F.tid & 15;
        const bool sh = row0 >= routed; const int e = sh ? 0 : TILEE[row0 / RP];
        const float* Wg = sh ? F.in[I_SG] + (size_t)layer * D * DE : F.in[I_MG] + ((size_t)layer * NE + e) * D * DE;
        const float* Wu = sh ? F.in[I_SU] + (size_t)layer * D * DE : F.in[I_MU_] + ((size_t)layer * NE + e) * D * DE;
        auto af = [&](int r, int k) { const int tok = sh ? (r - routed) : TOK[r]; return bf2f(H2[(size_t)tok * D + k]); };
        float ag[4][4], au[4][4];
        simt_tile(ag, af, [&](int k, int c) { return Wg[(size_t)k * DE + c]; }, row0, col0, D, F.ldsf);
        simt_tile(au, af, [&](int k, int c) { return Wu[(size_t)k * DE + c]; }, row0, col0, D, F.ldsf);
#pragma unroll
        for (int i = 0; i < 4; ++i) { float v[4];
#pragma unroll
            for (int q = 0; q < 4; ++q) { const float g = ag[i][q]; v[q] = g * sigmoidf_(g) * au[i][q]; }
            u32x2 w; w.x = pack2(v[0], v[1]); w.y = pack2(v[2], v[3]);
            *(u32x2*)(HB + (size_t)(row0 + ty * 4 + i) * DE + col0 + tx * 4) = w; }
    }
}
__device__ __forceinline__ void ph_down_simt(const Frame& F, int layer) {
    const bf16_t* HB = (const bf16_t*)(F.ws + WS_HB); bf16_t* YB = (bf16_t*)(F.ws + WS_YB);
    const int* TILEE = (const int*)(F.ws + WS_TILEE); const int* START = (const int*)(F.ws + WS_START);
    const int routed = START[65], nrt = (routed + T) / 128, nunits = nrt * 16;
    for (int u = F.bid; u < nunits; u += F.G) {
        const int rt = u / 16, ct = u % 16, row0 = rt * 128, col0 = ct * 64, ty = F.tid >> 4, tx = F.tid & 15;
        const bool sh = row0 >= routed; const int e = sh ? 0 : TILEE[row0 / RP];
        const float* Wd = sh ? F.in[I_SD] + (size_t)layer * DE * D : F.in[I_MD] + ((size_t)layer * NE + e) * DE * D;
        float acc[4][4];
        simt_tile(acc, [&](int r, int k) { return bf2f(HB[(size_t)r * DE + k]); }, [&](int k, int c) { return Wd[(size_t)k * D + c]; }, row0, col0, DE, F.ldsf);
#pragma unroll
        for (int i = 0; i < 4; ++i) { u32x2 w; w.x = pack2(acc[i][0], acc[i][1]); w.y = pack2(acc[i][2], acc[i][3]);
            *(u32x2*)(YB + (size_t)(row0 + ty * 4 + i) * D + col0 + tx * 4) = w; }
    }
}
__device__ __forceinline__ void ph_combine(const Frame& F, int layer, bool next) {
    const bf16_t* YB = (const bf16_t*)(F.ws + WS_YB); const int* POS = (const int*)(F.ws + WS_POS); const float* GATE = (const float*)(F.ws + WS_GATE);
    const int* START = (const int*)(F.ws + WS_START); const float* MOD = (const float*)(F.ws + WS_MOD);
    const float* gpo = F.in[I_NPOF] + layer * D;
    bf16_t* H3 = (bf16_t*)(F.ws + WS_H3);
    const int routed = START[65];
    for (int t = F.bid * NWAVES + F.wave; t < T; t += F.G * NWAVES) {
        const int b = t / SEQ; const float* m = MOD + (layer * 2 + b) * 6144;
        f32x4 y[4];
#pragma unroll
        for (int i = 0; i < 4; ++i) { const u32x2 w = *(const u32x2*)(YB + (size_t)(routed + t) * D + 4 * F.lane + 256 * i); y[i] = (f32x4){lo2f(w.x), hi2f(w.x), lo2f(w.y), hi2f(w.y)}; }
#pragma unroll
        for (int k = 0; k < TOPK; ++k) {
            const int p = POS[t * TOPK + k]; const float gk = GATE[t * TOPK + k];
#pragma unroll
            for (int i = 0; i < 4; ++i) { const u32x2 w = *(const u32x2*)(YB + (size_t)p * D + 4 * F.lane + 256 * i); y[i] += (f32x4){lo2f(w.x), hi2f(w.x), lo2f(w.y), hi2f(w.y)} * gk; }
        }
        float ss = 0.f;
#pragma unroll
        for (int i = 0; i < 4; ++i) ss += y[i][0] * y[i][0] + y[i][1] * y[i][1] + y[i][2] * y[i][2] + y[i][3] * y[i][3];
        ss = wave_sum(ss);
        const float rs = rsqrtf(ss * (1.0f / D) + 1e-6f);
        f32x4 x2[4]; float s2 = 0.f;
#pragma unroll
        for (int i = 0; i < 4; ++i) { const int c = 4 * F.lane + 256 * i;
            const f32x4 xv = *(const f32x4*)(F.out + (size_t)t * D + c), gm = *(const f32x4*)(m + 5120 + c), gp = *(const f32x4*)(gpo + c);
            x2[i] = xv + gm * (y[i] * rs * gp);
            *(f32x4*)(F.out + (size_t)t * D + c) = x2[i];
            s2 += x2[i][0] * x2[i][0] + x2[i][1] * x2[i][1] + x2[i][2] * x2[i][2] + x2[i][3] * x2[i][3]; }
        if (next) {
            s2 = wave_sum(s2);
            const float rs2 = rsqrtf(s2 * (1.0f / D) + 1e-6f);
            const float* m1 = MOD + ((layer + 1) * 2 + b) * 6144; const float* g1 = F.in[I_NPM] + (layer + 1) * D;
#pragma unroll
            for (int i = 0; i < 4; ++i) { const int c = 4 * F.lane + 256 * i;
                const f32x4 gf = *(const f32x4*)(g1 + c), sc = *(const f32x4*)(m1 + 1024 + c), sh = *(const f32x4*)(m1 + c);
                const f32x4 h = x2[i] * rs2 * gf * (sc + 1.0f) + sh;
                u32x2 w; w.x = pack2(h[0], h[1]); w.y = pack2(h[2], h[3]);
                *(u32x2*)(H3 + (size_t)t * D + c) = w; }
        }
    }
}

#define SB_EXIT 110.0f
__device__ __forceinline__ void ph_attn_ref(const Frame& F) {
    const bf16_t* Q = (const bf16_t*)(F.ws + WS_Q); const bf16_t* Kb = Q + (size_t)T * D; const bf16_t* Vb = Q + (size_t)2 * T * D;
    bf16_t* AO = (bf16_t*)(F.ws + WS_AO);
    float* Ks = F.ldsf; float* Vs = Ks + 64 * 65; float* Qs = Vs + 64 * 65; float* Ws = Qs + 64 * 64; float* Rm = Ws + 8 * 64;
    const int nunits = NB * NH * (SEQ / 64);
    for (int u = F.bid; u < nunits; u += F.G) {
        const int qt = (SEQ / 64 - 1) - (u / (NB * NH)), bh = u % (NB * NH), b = bh / NH, h = bh % NH;
        const size_t tb = (size_t)b * SEQ;
        for (int idx = F.tid; idx < 64 * 64; idx += NTHREADS) { const int r = idx >> 6, c = idx & 63; Qs[idx] = bf2f(Q[(tb + qt * 64 + r) * D + h * 64 + c]) * 0.125f; }
        float R[8], acc[8];
#pragma unroll
        for (int q = 0; q < 8; ++q) { R[q] = 0.f; acc[q] = 0.f; }
        for (int kt = qt; kt >= 0; --kt) {
            __syncthreads();
            for (int idx = F.tid; idx < 64 * 64; idx += NTHREADS) { const int r = idx >> 6, c = idx & 63; const size_t g = (tb + kt * 64 + r) * D + h * 64 + c; Ks[r * 65 + c] = bf2f(Kb[g]); Vs[r * 65 + c] = bf2f(Vb[g]); }
            __syncthreads();
#pragma unroll
            for (int q = 0; q < 8; ++q) {
                const int qi = F.wave * 8 + q;
                float z = 0.f;
#pragma unroll 16
                for (int d = 0; d < 64; ++d) z += Qs[qi * 64 + d] * Ks[F.lane * 65 + d];
                const bool valid = (kt < qt) || (F.lane < qi);
                const float sp = valid ? softplusf_(z) : 0.f;
                float suf = sp;
#pragma unroll
                for (int o = 1; o < 64; o <<= 1) { const float v = __shfl_down(suf, o); if (F.lane + o < 64) suf += v; }
                const float tail = R[q] + suf - sp;
                const float w = valid ? __expf(z - sp - tail) : 0.f;
                R[q] += __shfl(suf, 0);
                Ws[F.wave * 64 + F.lane] = w;
                float a = acc[q];
#pragma unroll 16
                for (int s = 0; s < 64; ++s) a += Ws[F.wave * 64 + s] * Vs[s * 65 + F.lane];
                acc[q] = a;
            }
            float mn = R[0];
#pragma unroll
            for (int q = 1; q < 8; ++q) mn = fminf(mn, R[q]);
            if (F.lane == 0) Rm[F.wave] = mn;
            __syncthreads();
            float allmin = Rm[0];
#pragma unroll
            for (int w = 1; w < 8; ++w) allmin = fminf(allmin, Rm[w]);
            if (allmin > SB_EXIT) break;
        }
#pragma unroll
        for (int q = 0; q < 8; ++q) AO[(tb + qt * 64 + F.wave * 8 + q) * D + h * 64 + F.lane] = f2bf(acc[q]);
        __syncthreads();
    }
}

__global__ void __launch_bounds__(NTHREADS, 2) mega(Args args) {
    extern __shared__ __attribute__((aligned(16))) unsigned char lds[];
    Frame F;
    F.in = args.in; F.out = args.out; F.ws = args.ws; F.ctl = (unsigned*)(args.ws + WS_CTL);
    F.ldsf = (float*)(lds + 64);
    F.tid = threadIdx.x; F.lane = F.tid & 63; F.wave = __builtin_amdgcn_readfirstlane(F.tid >> 6); F.bid = blockIdx.x; F.G = gridDim.x;
    if (F.tid < 4) ((unsigned*)lds)[F.tid] = 0u;
    __syncthreads();
    XcdBarrier bar; bar.bar = F.ctl + CW_BAR; bar.x = 0; bar.st = (volatile LAS unsigned*)lds;
#if MK_N_LAUNCHES == 1
    bar = xcd_barrier_post(F.ctl + CW_BAR, (volatile LAS unsigned*)lds);
#endif
    const int lo = args.ph_lo, hi = args.ph_hi;
#define IN(k) (lo <= (k) && (k) < hi)
#define SEAM(k) do { if (IN(k) && IN((k) + 1)) xcd_barrier(bar); } while (0)
    bf16_t* const wsb = (bf16_t*)args.ws;
    (void)wsb;
    if (IN(0)) { ph_mod(F); } SEAM(0);
    if (IN(1)) { ph_prenorm_rwkv(F); } SEAM(1);
    if (IN(2)) { ph_rkv_lora_simt(F); } SEAM(2);
    if (IN(3)) { ph_lora_up_simt(F); } SEAM(3);
    if (IN(4)) { ph_wkv_seq(F); } SEAM(4);
    if (IN(5)) { ph_wkv_post(F); } SEAM(5);
    if (IN(6)) { ph_dense_simt<0>(F, (const bf16_t*)(F.ws + WS_OG), F.in[I_WO], D, D, F.ws + WS_Y1); } SEAM(6);
    if (IN(7)) { ph_postmix_preffn(F, 0, F.in[I_X], (const float*)(F.ws + WS_Y1)); } SEAM(7);
    if (IN(8)) { ph_router_simt(F, 0); } SEAM(8);
    if (IN(9)) { ph_topk(F, 0); } SEAM(9);
    if (IN(10)) { ph_offsets(F, 0); } SEAM(10);
    if (IN(11)) { ph_gateup_simt(F, 0); } SEAM(11);
    if (IN(12)) { ph_down_simt(F, 0); } SEAM(12);
    if (IN(13)) { ph_combine(F, 0, true); } SEAM(13);
    if (IN(14)) { ph_dense_simt<1>(F, (const bf16_t*)(F.ws + WS_H3), F.in[I_SBQKV], 3 * D, D, F.ws + WS_Q); } SEAM(14);
    if (IN(15)) { ph_attn_ref(F); } SEAM(15);
    if (IN(16)) { ph_dense_simt<0>(F, (const bf16_t*)(F.ws + WS_AO), F.in[I_SBO], D, D, F.ws + WS_Y1B); } SEAM(16);
    if (IN(17)) { ph_postmix_preffn(F, 1, F.out, (const float*)(F.ws + WS_Y1B)); } SEAM(17);
    if (IN(18)) { ph_router_simt(F, 1); } SEAM(18);
    if (IN(19)) { ph_topk(F, 1); } SEAM(19);
    if (IN(20)) { ph_offsets(F, 1); } SEAM(20);
    if (IN(21)) { ph_gateup_simt(F, 1); } SEAM(21);
    if (IN(22)) { ph_down_simt(F, 1); } SEAM(22);
    if (IN(23)) { ph_combine(F, 1, false); }
#undef IN
#undef SEAM
}

extern "C" void kernel_launch(void* const* d_in, const int* in_sizes, int n_in, void* d_out, int out_size, void* d_ws, size_t ws_size, hipStream_t stream) {
    static int grid = 0;
    if (grid == 0) {
        if (n_in != 34 || in_sizes[0] != T * D || out_size != T * D || ws_size < WS_END) {
            fprintf(stderr, "kernel_launch: unexpected shapes: n_in %d in0 %d out %d ws %zu (need %zu)\n", n_in, n_in > 0 ? in_sizes[0] : -1, out_size, ws_size, (size_t)WS_END);
            grid = -1; return;
        }
        int dev = 0, cus = 0, per_cu = 0;
        if (hipGetDevice(&dev) != hipSuccess || hipDeviceGetAttribute(&cus, hipDeviceAttributeMultiprocessorCount, dev) != hipSuccess) { grid = -1; return; }
        if (hipFuncSetAttribute((const void*)mega, hipFuncAttributeMaxDynamicSharedMemorySize, LDS_BYTES) != hipSuccess) { fprintf(stderr, "kernel_launch: hipFuncSetAttribute failed\n"); grid = -1; return; }
        if (hipOccupancyMaxActiveBlocksPerMultiprocessor(&per_cu, (const void*)mega, NTHREADS, LDS_BYTES) != hipSuccess || per_cu < 1)
            fprintf(stderr, "kernel_launch: occupancy query reports %d blocks per CU\n", per_cu);
        (void)hipGetLastError();
        grid = cus;
    }
    if (grid < 0) return;
    if (hipMemsetAsync((char*)d_ws + WS_CTL, 0, CTL_BYTES, stream) != hipSuccess) { fprintf(stderr, "kernel_launch: memset failed\n"); return; }
    Args a{};
    for (int i = 0; i < 34; ++i) a.in[i] = (const float*)d_in[i];
    a.out = (float*)d_out; a.ws = (unsigned char*)d_ws;
#if MK_N_LAUNCHES == 1
    a.ph_lo = 0; a.ph_hi = NPHASES;
    hipLaunchKernelGGL(mega, dim3(grid), dim3(NTHREADS), LDS_BYTES, stream, a);
#else
    for (int p = 0; p < NPHASES; ++p) { a.ph_lo = p; a.ph_hi = p + 1; hipLaunchKernelGGL(mega, dim3(grid), dim3(NTHREADS), LDS_BYTES, stream, a); }
#endif
    const hipError_t le = hipPeekAtLastError();
    if (le != hipSuccess) fprintf(stderr, "kernel_launch: launch failed: %s\n", hipGetErrorName(le));
}
```

```cpp
#include <hip/hip_runtime.h>
#include <cstdio>
#include <cstdint>

#ifndef MK_N_LAUNCHES
#define MK_N_LAUNCHES 1
#endif

constexpr int T = 16384, D = 1024, SEQ = 8192, NB = 2, NH = 16, HD = 64;
constexpr int NE = 64, TOPK = 8, DE = 256;
constexpr int RP = 256;
constexpr int MAXROUTED = 147456;
constexpr int MAXROWS = MAXROUTED + T;
constexpr int NTHREADS = 512, NWAVES = 8;
constexpr int NPHASES = 24;
constexpr int LDS_BYTES = 144 * 1024;

typedef unsigned short bf16_t;
typedef float f32x4 __attribute__((ext_vector_type(4)));
typedef unsigned u32x4 __attribute__((ext_vector_type(4)));
typedef unsigned u32x2 __attribute__((ext_vector_type(2)));

__device__ __forceinline__ float bf2f(bf16_t b) { return __uint_as_float(((unsigned)b) << 16); }
__device__ __forceinline__ bf16_t f2bf(float f) { unsigned u = __float_as_uint(f); u += 0x7FFFu + ((u >> 16) & 1u); return (bf16_t)(u >> 16); }
__device__ __forceinline__ unsigned pack2(float a, float b) { return (unsigned)f2bf(a) | ((unsigned)f2bf(b) << 16); }
__device__ __forceinline__ float lo2f(unsigned u) { return __uint_as_float(u << 16); }
__device__ __forceinline__ float hi2f(unsigned u) { return __uint_as_float(u & 0xffff0000u); }
__device__ __forceinline__ float sigmoidf_(float x) { return 1.0f / (1.0f + __expf(-x)); }
__device__ __forceinline__ float softplusf_(float x) { return x > 20.f ? x : log1pf(__expf(x)); }
__device__ __forceinline__ float wave_sum(float v) {
#pragma unroll
    for (int o = 32; o >= 1; o >>= 1) v += __shfl_xor(v, o);
    return v;
}

constexpr size_t MiB = 1024 * 1024;
constexpr size_t WS_CTL    = 0;
constexpr size_t CTL_BYTES = 64 * 1024;
constexpr size_t WS_MOD    = 64 * 1024;
constexpr size_t WS_IDX    = 256 * 1024;
constexpr size_t WS_GATE   = WS_IDX + 512 * 1024;
constexpr size_t WS_RANK   = WS_GATE + 512 * 1024;
constexpr size_t WS_POS    = WS_RANK + 512 * 1024;
constexpr size_t WS_TOK    = WS_POS + 512 * 1024;
constexpr size_t WS_TILEE  = WS_TOK + 704 * 1024;
constexpr size_t WS_START  = WS_TILEE + 4096;
constexpr size_t WS_LOGITS = 4 * MiB;
constexpr size_t WS_BIG    = 8 * MiB;
constexpr size_t WS_XS   = WS_BIG;
constexpr size_t WS_RKV  = WS_BIG + 192 * MiB;
constexpr size_t WS_LORA = WS_BIG + 288 * MiB;
constexpr size_t WS_LD   = WS_BIG;
constexpr size_t WS_AA   = WS_BIG + 64 * MiB;
constexpr size_t WS_GG   = WS_BIG + 96 * MiB;
constexpr size_t WS_O    = WS_BIG + 128 * MiB;
constexpr size_t WS_OG   = WS_BIG + 296 * MiB;
constexpr size_t WS_Y1   = WS_BIG + 328 * MiB;
constexpr size_t WS_H2   = WS_BIG;
constexpr size_t WS_H2LO = WS_BIG + 32 * MiB;
constexpr size_t WS_YB   = WS_BIG;
constexpr size_t WS_HB   = WS_BIG + 320 * MiB;
constexpr size_t WS_H3   = WS_BIG + 320 * MiB;
constexpr size_t WS_Q    = WS_BIG;
constexpr size_t WS_AO   = WS_BIG + 96 * MiB;
constexpr size_t WS_Y1B  = WS_BIG + 128 * MiB;
constexpr size_t WS_W     = WS_BIG + 400 * MiB;
constexpr size_t WS_WGU   = WS_W;
constexpr size_t WS_WDN   = WS_WGU + (size_t)65 * 512 * 1024 * 2;
constexpr size_t WS_WRKV  = WS_WDN + (size_t)65 * 1024 * 256 * 2;
constexpr size_t WS_WO    = WS_WRKV + (size_t)3072 * 1024 * 2;
constexpr size_t WS_WQKV  = WS_WO + (size_t)1024 * 1024 * 2;
constexpr size_t WS_WSBO  = WS_WQKV + (size_t)3072 * 1024 * 2;
constexpr size_t WS_WLDN  = WS_WSBO + (size_t)1024 * 1024 * 2;
constexpr size_t WS_WLUP  = WS_WLDN + (size_t)256 * 1024 * 2;
constexpr size_t WS_WRT   = WS_WLUP + (size_t)1024 * 256 * 2;
constexpr size_t WS_END   = WS_WRT + (size_t)2 * 64 * 3072 * 2;

constexpr int CW_BAR = 0;
constexpr int CW_CNT = 4096;

#define XB_TMO      128
#define XB_XCNT(j)  (256  + 64 * (j))
#define XB_XSUB(j)  (1280 + 64 * (j))
#define XB_XGEN(j)  (2304 + 64 * (j))
#define XB_TOP      3328
#define XB_TOPGEN   3392
#define XCD_BAR_WORDS 3456
#define XB_SPIN_CAP (1u << 22)
#define LAS __attribute__((address_space(3)))

__device__ __forceinline__ unsigned xb_ld(unsigned* p)              { return __hip_atomic_load(p, __ATOMIC_RELAXED, __HIP_MEMORY_SCOPE_AGENT); }
__device__ __forceinline__ unsigned xb_add(unsigned* p, unsigned v) { return __hip_atomic_fetch_add(p, v, __ATOMIC_RELAXED, __HIP_MEMORY_SCOPE_AGENT); }
__device__ __forceinline__ unsigned xb_xcc_id() { return (unsigned)__builtin_amdgcn_s_getreg((3 << 11) | 20) & 0xFu; }
#define XB_SPIN(cond, bar) do { unsigned _sp = 0; while (cond) { __builtin_amdgcn_s_sleep(1); \
    if ((++_sp & 255u) == 0u) { if (xb_ld(&(bar)[XB_TMO])) break; if (_sp > XB_SPIN_CAP) { atomicAdd(&(bar)[XB_TMO], 1u); break; } } } } while (0)

struct XcdBarrier { unsigned* bar; unsigned x; volatile LAS unsigned* st; };

__device__ __forceinline__ XcdBarrier xcd_barrier_post(unsigned* bar, volatile LAS unsigned* st) {
    XcdBarrier b; b.bar = bar; b.x = xb_xcc_id(); b.st = st;
    if (threadIdx.x == 0) (void)xb_add(&bar[XB_XCNT(b.x)], 1u);
    return b;
}
__device__ __forceinline__ void xcd_barrier_complete(unsigned* bar, unsigned x, unsigned& nloc, unsigned& nx) {
    const unsigned G = gridDim.x * gridDim.y * gridDim.z;
    unsigned sum, cnt, mine, sp = 0u;
    for (;;) {
        sum = 0u; cnt = 0u; mine = 0u;
#pragma unroll
        for (unsigned j = 0; j < 16; ++j) { const unsigned c = xb_ld(&bar[XB_XCNT(j)]); sum += c; cnt += (c > 0u) ? 1u : 0u; mine = (j == x) ? c : mine; }
        if (sum == G) break;
        __builtin_amdgcn_s_sleep(1);
        if ((++sp & 255u) == 0u) { if (xb_ld(&bar[XB_TMO])) break; if (sp > XB_SPIN_CAP) { atomicAdd(&bar[XB_TMO], 1u); break; } }
    }
    nloc = mine > 0u ? mine : 1u; nx = cnt > 0u ? cnt : 1u;
}
__device__ __forceinline__ void xcd_barrier(const XcdBarrier& b) {
    asm volatile("s_waitcnt vmcnt(0)" ::: "memory");
    __syncthreads();
    if (threadIdx.x == 0) {
        unsigned* bar = b.bar;
        __builtin_amdgcn_s_waitcnt(0);
        unsigned nloc = b.st[0], nx = b.st[1];
        if (nloc == 0u) { xcd_barrier_complete(bar, b.x, nloc, nx); b.st[0] = nloc; b.st[1] = nx; }
        const unsigned old = xb_add(&bar[XB_XSUB(b.x)], 1u);
        const unsigned gen = old / nloc;
        if (old + 1u == (gen + 1u) * nloc) {
            __builtin_amdgcn_fence(__ATOMIC_RELEASE, "agent");
            asm volatile("s_waitcnt vmcnt(0)" ::: "memory");
            const unsigned og = xb_add(&bar[XB_TOP], 1u);
            const unsigned tg = og / nx;
            if (og + 1u == (tg + 1u) * nx) xb_add(&bar[XB_TOPGEN], 1u);
            else XB_SPIN(xb_ld(&bar[XB_TOPGEN]) == tg, bar);
            __builtin_amdgcn_fence(__ATOMIC_ACQUIRE, "agent");
            xb_add(&bar[XB_XGEN(b.x)], 1u);
            asm volatile("s_waitcnt vmcnt(0)" ::: "memory");
        } else {
            XB_SPIN(xb_ld(&bar[XB_XGEN(b.x)]) == gen, bar);
            __builtin_amdgcn_fence(__ATOMIC_ACQUIRE, "agent");
            asm volatile("s_waitcnt vmcnt(0)" ::: "memory");
        }
    }
    __syncthreads();
}

struct Args { const float* in[34]; float* out; unsigned char* ws; int ph_lo, ph_hi; };

struct Frame {
    const float* const* in; float* out; unsigned char* ws; unsigned* ctl;
    float* ldsf; LAS unsigned char* lds; int tid, lane, wave, bid, G;
};

enum { I_X = 0, I_C, I_ADAW, I_ADAB, I_NPM, I_NPOM, I_NPF, I_NPOF, I_MU, I_WRKV, I_WW1, I_WW2, I_W0, I_WA1, I_WA2, I_A0, I_WG1, I_WG2,
       I_KK, I_KA, I_RK, I_LNG, I_LNB, I_WO, I_SBQKV, I_SBO, I_ROUTER, I_RBIAS, I_MG, I_MU_, I_MD, I_SG, I_SU, I_SD };

template <class AF, class BF>
__device__ __forceinline__ void simt_tile(float (&acc)[4][4], const AF& af, const BF& bfn, int row0, int col0, int K, float* sm) {
    float* sA = sm; float* sB = sm + 16 * 132;
    const int tid = threadIdx.x, ty = tid >> 4, tx = tid & 15;
#pragma unroll
    for (int i = 0; i < 4; ++i)
#pragma unroll
        for (int j = 0; j < 4; ++j) acc[i][j] = 0.f;
    for (int k0 = 0; k0 < K; k0 += 16) {
#pragma unroll
        for (int q = 0; q < 4; ++q) { const int idx = tid + 512 * q, r = idx >> 4, kk = idx & 15; sA[kk * 132 + r] = af(row0 + r, k0 + kk); }
#pragma unroll
        for (int q = 0; q < 2; ++q) { const int idx = tid + 512 * q, kk = idx >> 6, c = idx & 63; sB[kk * 68 + c] = bfn(k0 + kk, col0 + c); }
        __syncthreads();
#pragma unroll
        for (int kk = 0; kk < 16; ++kk) {
            const f32x4 a = *(const f32x4*)&sA[kk * 132 + ty * 4];
            const f32x4 b = *(const f32x4*)&sB[kk * 68 + tx * 4];
#pragma unroll
            for (int i = 0; i < 4; ++i)
#pragma unroll
                for (int j = 0; j < 4; ++j) acc[i][j] += a[i] * b[j];
        }
        __syncthreads();
    }
}

typedef short bf16x8 __attribute__((ext_vector_type(8)));
constexpr int HTB = 128 * 64 * 2;
__device__ __forceinline__ int lds_byte(int r, int c) { const int st = (r >> 4) * 2 + (c >> 5), rr = r & 15, cc = c & 31, ob = rr * 64 + cc * 2; return st * 1024 + (ob ^ (((ob >> 9) & 1) << 5)); }
__device__ __forceinline__ void stage_rc(int b, int& R, int& C) { const int st = b / 1024, sb = b % 1024, swz = sb ^ (((sb >> 9) & 1) << 5); R = (st >> 1) * 16 + swz / 64; C = (st & 1) * 32 + (swz % 64) / 2; }
#define WAIT_V(n) asm volatile("s_waitcnt vmcnt(" #n ")" ::: "memory")
#define SBAR() do { asm volatile("" ::: "memory"); __builtin_amdgcn_s_barrier(); asm volatile("" ::: "memory"); } while (0)

struct ASeg { const bf16_t* p[3]; int segTiles; };

template <int BN, class ARow, class Epi>
__device__ __forceinline__ void sg_tile(LAS unsigned char* lds, const ASeg& A, const ARow& arow, const bf16_t* Bt, int ldb, int nt, const Epi& epi) {
    constexpr int WN = BN / 64, WM = 8 / WN, WR = 256 / WM, MT = WR / 16;
    const int tid = threadIdx.x, wid = __builtin_amdgcn_readfirstlane(tid >> 6), lane = tid & 63, fr = lane & 15, fq = lane >> 4;
    const int wm = wid / WN, wn = wid % WN;
    unsigned aoffs[2][2], boffs[2];
#pragma unroll
    for (int i = 0; i < 2; ++i) { int R, C; stage_rc(tid * 16 + i * 8192, R, C);
        aoffs[0][i] = arow(R) + (unsigned)C * 2u; aoffs[1][i] = arow(128 + R) + (unsigned)C * 2u; boffs[i] = (unsigned)(R * ldb + C) * 2u; }
    const unsigned ldsw = (unsigned)wid * 1024u;
    f32x4 acc[MT][4];
#pragma unroll
    for (int m = 0; m < MT; ++m)
#pragma unroll
        for (int n = 0; n < 4; ++n) acc[m][n] = (f32x4){0.f, 0.f, 0.f, 0.f};
    const int arow0 = wm * WR, ah = arow0 >> 7, ar = arow0 & 127;
    const int aoff = ah * HTB + lds_byte(ar + fr, fq * 8), boff = 2 * HTB + lds_byte(wn * 64 + fr, fq * 8);
#define SG_STAGE(kt, s) do { const int sg_ = (kt) / A.segTiles; const char* ab_ = (const char*)(sg_ == 0 ? A.p[0] : (sg_ == 1 ? A.p[1] : A.p[2])) + (size_t)((kt) - sg_ * A.segTiles) * 128; const char* bb_ = (const char*)Bt + (size_t)(kt) * 128; \
        _Pragma("unroll") for (int h_ = 0; h_ < 2; ++h_) _Pragma("unroll") for (int i_ = 0; i_ < 2; ++i_) \
            __builtin_amdgcn_global_load_lds((const unsigned*)(ab_ + aoffs[h_][i_]), (LAS unsigned*)(lds + ((s) * 3 + h_) * HTB + ldsw + i_ * 8192), 16, 0, 0); \
        _Pragma("unroll") for (int i_ = 0; i_ < WN; ++i_) \
            __builtin_amdgcn_global_load_lds((const unsigned*)(bb_ + boffs[i_]), (LAS unsigned*)(lds + ((s) * 3 + 2) * HTB + ldsw + i_ * 8192), 16, 0, 0); } while (0)
    SG_STAGE(0, 0);
    for (int t = 0; t < nt; ++t) {
        const int s = t & 1;
        if (t + 1 < nt) { SG_STAGE(t + 1, s ^ 1); if (WN == 2) WAIT_V(6); else WAIT_V(5); } else { WAIT_V(0); }
        SBAR();
        LAS unsigned char* base = lds + s * 3 * HTB;
#pragma unroll
        for (int k = 0; k < 2; ++k) {
            bf16x8 af[MT], bfr[4];
#pragma unroll
            for (int m = 0; m < MT; ++m) af[m] = *(const LAS bf16x8*)(base + aoff + m * 2048 + k * 1024);
#pragma unroll
            for (int n = 0; n < 4; ++n) bfr[n] = *(const LAS bf16x8*)(base + boff + n * 2048 + k * 1024);
#pragma unroll
            for (int m = 0; m < MT; ++m)
#pragma unroll
                for (int n = 0; n < 4; ++n) acc[m][n] = __builtin_amdgcn_mfma_f32_16x16x32_bf16(bfr[n], af[m], acc[m][n], 0, 0, 0);
        }
        SBAR();
    }
#undef SG_STAGE
    epi(acc, arow0, wn * 64, fr, fq);
}

__device__ __forceinline__ void conv_unit(const Frame& F, bf16_t* dst, int dstK, const float* src, int sld) {
    float* tl = F.ldsf;
#pragma unroll
    for (int q = 0; q < 16; ++q) { const int idx = F.tid + 512 * q, kk = idx >> 5, nn = idx & 31; tl[kk * 33 + nn] = src[(size_t)kk * sld + nn]; }
    __syncthreads();
    const int nn = F.tid >> 4, ks = (F.tid & 15) * 16;
    u32x4 a, b;
#pragma unroll
    for (int q = 0; q < 4; ++q) { a[q] = pack2(tl[(ks + 2 * q) * 33 + nn], tl[(ks + 2 * q + 1) * 33 + nn]); b[q] = pack2(tl[(ks + 8 + 2 * q) * 33 + nn], tl[(ks + 9 + 2 * q) * 33 + nn]); }
    *(u32x4*)(dst + (size_t)nn * dstK + ks) = a; *(u32x4*)(dst + (size_t)nn * dstK + ks + 8) = b;
    __syncthreads();
}
__device__ __forceinline__ void conv_moe(const Frame& F, int layer, int u0, int ustride) {
    bf16_t* WGU = (bf16_t*)(F.ws + WS_WGU); bf16_t* WDN = (bf16_t*)(F.ws + WS_WDN);
    const int nGU = 65 * 16 * 4, nDN = 65 * 32;
    for (int u = u0; u < nGU + nDN; u += ustride) {
        if (u < nGU) {
            const int e = u / 64, r = u % 64, rb = r / 4, kc = r % 4, blk = rb >> 1, up = rb & 1;
            const float* W = (e < 64) ? (up ? F.in[I_MU_] : F.in[I_MG]) + ((size_t)layer * NE + e) * D * DE : (up ? F.in[I_SU] : F.in[I_SG]) + (size_t)layer * D * DE;
            conv_unit(F, WGU + ((size_t)e * 512 + rb * 32) * D + kc * 256, D, W + (size_t)(kc * 256) * DE + blk * 32, DE);
        } else {
            const int v = u - nGU, e = v / 32, rb = v % 32;
            const float* W = (e < 64) ? F.in[I_MD] + ((size_t)layer * NE + e) * DE * D : F.in[I_SD] + (size_t)layer * DE * D;
            conv_unit(F, WDN + ((size_t)e * D + rb * 32) * DE, DE, W + rb * 32, D);
        }
    }
}
__device__ __forceinline__ void conv_dense(const Frame& F, int u0, int ustride) {
    bf16_t* WRKV = (bf16_t*)(F.ws + WS_WRKV); bf16_t* WO = (bf16_t*)(F.ws + WS_WO); bf16_t* WQKV = (bf16_t*)(F.ws + WS_WQKV); bf16_t* WSBO = (bf16_t*)(F.ws + WS_WSBO); bf16_t* WLDN = (bf16_t*)(F.ws + WS_WLDN);
    const int n0 = 96 * 4, n1 = n0 + 32 * 4, n2 = n1 + 96 * 4, n3 = n2 + 32 * 4, n4 = n3 + 8 * 4;
    for (int u = u0; u < n4; u += ustride) {
        if (u < n0) { const int rb = u / 4, kc = u % 4, n = rb / 32, c0 = (rb % 32) * 32; conv_unit(F, WRKV + (size_t)rb * 32 * D + kc * 256, D, F.in[I_WRKV] + (size_t)n * D * D + (size_t)kc * 256 * D + c0, D); }
        else if (u < n1) { const int v = u - n0, rb = v / 4, kc = v % 4; conv_unit(F, WO + (size_t)rb * 32 * D + kc * 256, D, F.in[I_WO] + (size_t)kc * 256 * D + rb * 32, D); }
        else if (u < n2) { const int v = u - n1, rb = v / 4, kc = v % 4; conv_unit(F, WQKV + (size_t)rb * 32 * D + kc * 256, D, F.in[I_SBQKV] + (size_t)kc * 256 * 3 * D + rb * 32, 3 * D); }
        else if (u < n3) { const int v = u - n2, rb = v / 4, kc = v % 4; conv_unit(F, WSBO + (size_t)rb * 32 * D + kc * 256, D, F.in[I_SBO] + (size_t)kc * 256 * D + rb * 32, D); }
        else { const int v = u - n3, rb = v / 4, kc = v % 4;
            const float* src = rb < 2 ? F.in[I_WW1] + (size_t)kc * 256 * 64 + rb * 32 : (rb < 4 ? F.in[I_WA1] + (size_t)kc * 256 * 64 + (rb - 2) * 32 : F.in[I_WG1] + (size_t)kc * 256 * 128 + (rb - 4) * 32);
            conv_unit(F, WLDN + (size_t)rb * 32 * D + kc * 256, D, src, rb < 4 ? 64 : 128); }
    }
    bf16_t* WLUP = (bf16_t*)(F.ws + WS_WLUP); bf16_t* WRT = (bf16_t*)(F.ws + WS_WRT);
    const int gtid = u0 * NTHREADS + F.tid, gstride = ustride * NTHREADS;
    for (int i = gtid; i < 1024 * 256; i += gstride) {
        float v;
        if (i < 1024 * 64) { const int n = i / 64, k = i % 64; v = F.in[I_WW2][k * D + n]; }
        else if (i < 2 * 1024 * 64) { const int j = i - 1024 * 64, n = j / 64, k = j % 64; v = F.in[I_WA2][k * D + n]; }
        else { const int j = i - 2 * 1024 * 64, n = j / 128, k = j % 128; v = F.in[I_WG2][k * D + n]; }
        WLUP[i] = f2bf(v);
    }
    for (int i = gtid; i < 2 * 64 * 1024; i += gstride) {
        const int l = i / (64 * 1024), j = i % (64 * 1024), e = j / 1024, k = j % 1024;
        const float w = F.in[I_ROUTER][((size_t)l * D + k) * NE + e]; const bf16_t hi = f2bf(w), lo = f2bf(w - bf2f(hi));
        bf16_t* row = WRT + ((size_t)l * 64 + e) * 3072; row[k] = hi; row[1024 + k] = lo; row[2048 + k] = hi;
    }
}

__device__ __forceinline__ void ph_mod(const Frame& F) {
    const float* c = F.in[I_C]; const float* W = F.in[I_ADAW]; const float* bias = F.in[I_ADAB];
    float* MOD = (float*)(F.ws + WS_MOD);
    float* red = F.ldsf;
    for (int u = F.bid; u < 192; u += F.G) {
        const int l = u / 96, cg = u % 96, col = cg * 64 + F.lane;
        float s0 = 0.f, s1 = 0.f;
        const float* wp = W + ((size_t)l * D + F.wave * 128) * 6144 + col;
        for (int d = 0; d < 128; ++d) {
            const int dd = F.wave * 128 + d;
            const float c0 = c[dd], c1 = c[D + dd];
            const float w = wp[(size_t)d * 6144];
            s0 += (c0 * sigmoidf_(c0)) * w; s1 += (c1 * sigmoidf_(c1)) * w;
        }
        red[(F.wave * 2 + 0) * 64 + F.lane] = s0; red[(F.wave * 2 + 1) * 64 + F.lane] = s1;
        __syncthreads();
        if (F.tid < 128) {
            const int b = F.tid >> 6, cc = F.tid & 63; float s = 0.f;
#pragma unroll
            for (int w = 0; w < 8; ++w) s += red[(w * 2 + b) * 64 + cc];
            MOD[(l * 2 + b) * 6144 + cg * 64 + cc] = s + bias[l * 6144 + cg * 64 + cc];
        }
        __syncthreads();
    }
}

__device__ __forceinline__ void ph_prenorm_rwkv(const Frame& F) {
    const float* x = F.in[I_X]; const float* g = F.in[I_NPM]; const float* mu = F.in[I_MU];
    const float* MOD = (const float*)(F.ws + WS_MOD);
    bf16_t* XS = (bf16_t*)(F.ws + WS_XS);
    const int nunits = T / 8;
    for (int u = F.bid * NWAVES + F.wave; u < nunits; u += F.G * NWAVES) {
        const int t0 = u * 8, b = t0 / SEQ;
        const float* shift = MOD + (0 * 2 + b) * 6144; const float* scale = shift + 1024;
        f32x4 gm[4], sh[4];
#pragma unroll
        for (int i = 0; i < 4; ++i) { const int c = 4 * F.lane + 256 * i; const f32x4 gv = *(const f32x4*)(g + c), sc = *(const f32x4*)(scale + c); gm[i] = gv * (sc + 1.0f); sh[i] = *(const f32x4*)(shift + c); }
        f32x4 hp[4];
#pragma unroll
        for (int i = 0; i < 4; ++i) hp[i] = (f32x4){0.f, 0.f, 0.f, 0.f};
        const int tstart = (t0 % SEQ == 0) ? t0 : t0 - 1;
        for (int t = tstart; t < t0 + 8; ++t) {
            f32x4 xv[4]; float ss = 0.f;
#pragma unroll
            for (int i = 0; i < 4; ++i) { xv[i] = *(const f32x4*)(x + (size_t)t * D + 4 * F.lane + 256 * i); ss += xv[i][0] * xv[i][0] + xv[i][1] * xv[i][1] + xv[i][2] * xv[i][2] + xv[i][3] * xv[i][3]; }
            ss = wave_sum(ss);
            const float rs = rsqrtf(ss * (1.0f / D) + 1e-6f);
            f32x4 h[4];
#pragma unroll
            for (int i = 0; i < 4; ++i) h[i] = xv[i] * rs * gm[i] + sh[i];
            if (t >= t0) {
#pragma unroll
                for (int n = 0; n < 6; ++n) {
#pragma unroll
                    for (int i = 0; i < 4; ++i) {
                        const int c = 4 * F.lane + 256 * i;
                        const f32x4 m = *(const f32x4*)(mu + n * D + c);
                        const f32x4 v = h[i] + (hp[i] - h[i]) * m;
                        u32x2 w; w.x = pack2(v[0], v[1]); w.y = pack2(v[2], v[3]);
                        *(u32x2*)(XS + ((size_t)n * T + t) * D + c) = w;
                    }
                }
            }
#pragma unroll
            for (int i = 0; i < 4; ++i) hp[i] = h[i];
        }
    }
}

__device__ __forceinline__ void ph_rkv_lora_simt(const Frame& F) {
    const bf16_t* XS = (const bf16_t*)(F.ws + WS_XS);
    bf16_t* RKV = (bf16_t*)(F.ws + WS_RKV); bf16_t* LORA = (bf16_t*)(F.ws + WS_LORA);
    const int nct = 52, nunits = (T / 128) * nct;
    for (int u = F.bid; u < nunits; u += F.G) {
        const int rt = u / nct, ct = u % nct, row0 = rt * 128;
        float acc[4][4];
        const int ty = F.tid >> 4, tx = F.tid & 15;
        if (ct < 48) {
            const int n = ct / 16, col0 = (ct % 16) * 64;
            const bf16_t* A = XS + (size_t)n * T * D; const float* W = F.in[I_WRKV] + (size_t)n * D * D;
            simt_tile(acc, [&](int r, int k) { return bf2f(A[(size_t)r * D + k]); }, [&](int k, int c) { return W[(size_t)k * D + c]; }, row0, col0, D, F.ldsf);
#pragma unroll
            for (int i = 0; i < 4; ++i) { u32x2 w; w.x = pack2(acc[i][0], acc[i][1]); w.y = pack2(acc[i][2], acc[i][3]);
                *(u32x2*)(RKV + ((size_t)n * T + row0 + ty * 4 + i) * D + col0 + tx * 4) = w; }
        } else {
            const int j = ct - 48;
            const int n = (j == 0) ? 3 : (j == 1 ? 4 : 5);
            const bf16_t* A = XS + (size_t)n * T * D;
            const float* W = (j == 0) ? F.in[I_WW1] : (j == 1 ? F.in[I_WA1] : F.in[I_WG1]);
            const int ldw = (j >= 2) ? 128 : 64, coff = (j == 3) ? 64 : 0;
            simt_tile(acc, [&](int r, int k) { return bf2f(A[(size_t)r * D + k]); }, [&](int k, int c) { return W[(size_t)k * ldw + coff + c]; }, row0, 0, D, F.ldsf);
#pragma unroll
            for (int i = 0; i < 4; ++i) {
                float v[4];
#pragma unroll
                for (int q = 0; q < 4; ++q) { const float a = acc[i][q]; v[q] = (j == 0) ? tanhf(a) : (j == 1 ? a : sigmoidf_(a)); }
                u32x2 w; w.x = pack2(v[0], v[1]); w.y = pack2(v[2], v[3]);
                *(u32x2*)(LORA + (size_t)(row0 + ty * 4 + i) * 256 + j * 64 + tx * 4) = w;
            }
        }
    }
}

__device__ __forceinline__ void ph_lora_up_simt(const Frame& F) {
    const bf16_t* LORA = (const bf16_t*)(F.ws + WS_LORA);
    float* LD = (float*)(F.ws + WS_LD); bf16_t* AA = (bf16_t*)(F.ws + WS_AA); bf16_t* GG = (bf16_t*)(F.ws + WS_GG);
    const int nunits = (T / 128) * 48;
    for (int u = F.bid; u < nunits; u += F.G) {
        const int rt = u / 48, ct = u % 48, row0 = rt * 128, which = ct / 16, col0 = (ct % 16) * 64;
        const int ty = F.tid >> 4, tx = F.tid & 15;
        float acc[4][4];
        const float* W = which == 0 ? F.in[I_WW2] : (which == 1 ? F.in[I_WA2] : F.in[I_WG2]);
        const int K = which == 2 ? 128 : 64, koff = which * 64;
        simt_tile(acc, [&](int r, int k) { return bf2f(LORA[(size_t)r * 256 + koff + k]); }, [&](int k, int c) { return W[(size_t)k * D + c]; }, row0, col0, K, F.ldsf);
#pragma unroll
        for (int i = 0; i < 4; ++i) {
            const size_t o = (size_t)(row0 + ty * 4 + i) * D + col0 + tx * 4;
            if (which == 0) {
                f32x4 v;
#pragma unroll
                for (int q = 0; q < 4; ++q) { const float wl = F.in[I_W0][col0 + tx * 4 + q] + acc[i][q]; const float wlog = -softplusf_(-wl) - 0.5f; v[q] = -__expf(wlog); }
                *(f32x4*)(LD + o) = v;
            } else if (which == 1) {
                float v[4];
#pragma unroll
                for (int q = 0; q < 4; ++q) v[q] = sigmoidf_(F.in[I_A0][col0 + tx * 4 + q] + acc[i][q]);
                u32x2 w; w.x = pack2(v[0], v[1]); w.y = pack2(v[2], v[3]); *(u32x2*)(AA + o) = w;
            } else {
                u32x2 w; w.x = pack2(acc[i][0], acc[i][1]); w.y = pack2(acc[i][2], acc[i][3]); *(u32x2*)(GG + o) = w;
            }
        }
    }
}

__device__ __forceinline__ void ph_wkv_seq(const Frame& F) {
    const bf16_t* RKV = (const bf16_t*)(F.ws + WS_RKV); const float* LD = (const float*)(F.ws + WS_LD); const bf16_t* AA = (const bf16_t*)(F.ws + WS_AA);
    float* O = (float*)(F.ws + WS_O);
    const bf16_t* Rb = RKV; const bf16_t* Kb = RKV + (size_t)T * D; const bf16_t* Vb = RKV + (size_t)2 * T * D;
    for (int u = F.bid; u < NB * NH; u += F.G) {
        const int b = u / NH, h = u % NH, i = F.tid >> 3, js = F.tid & 7;
        const int cj = h * 64 + js * 8;
        float kkw[8], kaw[8];
#pragma unroll
        for (int e = 0; e < 8; ++e) { kkw[e] = F.in[I_KK][cj + e]; kaw[e] = F.in[I_KA][cj + e]; }
        float S[8];
#pragma unroll
        for (int e = 0; e < 8; ++e) S[e] = 0.f;
        size_t base = (size_t)(b * SEQ) * D;
        u32x4 kr = *(const u32x4*)(Kb + base + cj), rr = *(const u32x4*)(Rb + base + cj), ar = *(const u32x4*)(AA + base + cj);
        f32x4 l0 = *(const f32x4*)(LD + base + cj), l1 = *(const f32x4*)(LD + base + cj + 4);
        bf16_t vr = Vb[base + h * 64 + i];
        for (int t = 0; t < SEQ; ++t) {
            const u32x4 kc = kr, rc = rr, ac = ar; const f32x4 lc0 = l0, lc1 = l1; const bf16_t vc = vr;
            if (t + 1 < SEQ) { const size_t nb = base + D;
                kr = *(const u32x4*)(Kb + nb + cj); rr = *(const u32x4*)(Rb + nb + cj); ar = *(const u32x4*)(AA + nb + cj);
                l0 = *(const f32x4*)(LD + nb + cj); l1 = *(const f32x4*)(LD + nb + cj + 4); vr = Vb[nb + h * 64 + i]; }
            float k[8], r[8], a[8], ld[8];
#pragma unroll
            for (int q = 0; q < 4; ++q) { k[2 * q] = lo2f(kc[q]); k[2 * q + 1] = hi2f(kc[q]); r[2 * q] = lo2f(rc[q]); r[2 * q + 1] = hi2f(rc[q]); a[2 * q] = lo2f(ac[q]); a[2 * q + 1] = hi2f(ac[q]); }
#pragma unroll
            for (int q = 0; q < 4; ++q) { ld[q] = lc0[q]; ld[4 + q] = lc1[q]; }
            const float v = bf2f(vc);
            float kkv[8], ss = 0.f;
#pragma unroll
            for (int e = 0; e < 8; ++e) { kkv[e] = k[e] * kkw[e]; ss += kkv[e] * kkv[e]; }
            ss += __shfl_xor(ss, 1); ss += __shfl_xor(ss, 2); ss += __shfl_xor(ss, 4);
            const float inv = 1.0f / fmaxf(sqrtf(ss), 1e-12f);
            float sa = 0.f;
#pragma unroll
            for (int e = 0; e < 8; ++e) { kkv[e] *= inv; sa += S[e] * (-kkv[e]); }
            sa += __shfl_xor(sa, 1); sa += __shfl_xor(sa, 2); sa += __shfl_xor(sa, 4);
            float o = 0.f;
#pragma unroll
            for (int e = 0; e < 8; ++e) {
                const float kf = k[e] * (1.0f + (a[e] - 1.0f) * kaw[e]);
                S[e] = S[e] * __expf(ld[e]) + sa * (kkv[e] * a[e]) + v * kf;
                o += S[e] * r[e];
            }
            o += __shfl_xor(o, 1); o += __shfl_xor(o, 2); o += __shfl_xor(o, 4);
            if (js == 0) O[base + h * 64 + i] = o;
            base += D;
        }
    }
}

__device__ __forceinline__ void ld16bf(const bf16_t* p, float (&v)[16]) {
    const u32x4 a = *(const u32x4*)p, b = *(const u32x4*)(p + 8);
#pragma unroll
    for (int q = 0; q < 4; ++q) { v[2 * q] = lo2f(a[q]); v[2 * q + 1] = hi2f(a[q]); v[8 + 2 * q] = lo2f(b[q]); v[9 + 2 * q] = hi2f(b[q]); }
}
__device__ __forceinline__ void st16bf(bf16_t* p, const float (&v)[16]) {
    u32x4 a, b;
#pragma unroll
    for (int q = 0; q < 4; ++q) { a[q] = pack2(v[2 * q], v[2 * q + 1]); b[q] = pack2(v[8 + 2 * q], v[9 + 2 * q]); }
    *(u32x4*)p = a; *(u32x4*)(p + 8) = b;
}
__device__ __forceinline__ void ld16f(const float* p, float (&v)[16]) {
#pragma unroll
    for (int q = 0; q < 4; ++q) { const f32x4 a = *(const f32x4*)(p + 4 * q); v[4 * q] = a[0]; v[4 * q + 1] = a[1]; v[4 * q + 2] = a[2]; v[4 * q + 3] = a[3]; }
}
__device__ __forceinline__ void ph_wkv_post(const Frame& F) {
    const bf16_t* RKV = (const bf16_t*)(F.ws + WS_RKV); const bf16_t* AA = (const bf16_t*)(F.ws + WS_AA); const bf16_t* GG = (const bf16_t*)(F.ws + WS_GG);
    const float* O = (const float*)(F.ws + WS_O); bf16_t* OG = (bf16_t*)(F.ws + WS_OG);
    const int c0 = 16 * F.lane;
    float ka[16], rk[16], lg[16], lb[16];
    ld16f(F.in[I_KA] + c0, ka); ld16f(F.in[I_RK] + c0, rk); ld16f(F.in[I_LNG] + c0, lg); ld16f(F.in[I_LNB] + c0, lb);
    for (int t = F.bid * NWAVES + F.wave; t < T; t += F.G * NWAVES) {
        const size_t o = (size_t)t * D + c0;
        float ov[16], r[16], k[16], v[16], a[16], g[16];
        ld16f(O + o, ov); ld16bf(RKV + o, r); ld16bf(RKV + (size_t)T * D + o, k); ld16bf(RKV + (size_t)2 * T * D + o, v); ld16bf(AA + o, a); ld16bf(GG + o, g);
        float s = 0.f, bs = 0.f;
#pragma unroll
        for (int e = 0; e < 16; ++e) { s += ov[e]; const float kf = k[e] * (1.0f + (a[e] - 1.0f) * ka[e]); bs += r[e] * kf * rk[e]; }
        s += __shfl_xor(s, 1); s += __shfl_xor(s, 2); bs += __shfl_xor(bs, 1); bs += __shfl_xor(bs, 2);
        const float mean = s * (1.0f / 64.0f);
        float q = 0.f;
#pragma unroll
        for (int e = 0; e < 16; ++e) { const float d = ov[e] - mean; q += d * d; }
        q += __shfl_xor(q, 1); q += __shfl_xor(q, 2);
        const float rstd = rsqrtf(q * (1.0f / 64.0f) + 64e-5f);
        float res[16];
#pragma unroll
        for (int e = 0; e < 16; ++e) res[e] = (((ov[e] - mean) * rstd) * lg[e] + lb[e] + bs * v[e]) * g[e];
        st16bf(OG + o, res);
    }
}

template <int OUTMODE>
__device__ __forceinline__ void ph_dense_simt(const Frame& F, const bf16_t* A, const float* W, int N, int K, void* out) {
    const int nct = N / 64, nunits = (T / 128) * nct;
    for (int u = F.bid; u < nunits; u += F.G) {
        const int rt = u / nct, ct = u % nct, row0 = rt * 128, col0 = ct * 64;
        const int ty = F.tid >> 4, tx = F.tid & 15;
        float acc[4][4];
        simt_tile(acc, [&](int r, int k) { return bf2f(A[(size_t)r * K + k]); }, [&](int k, int c) { return W[(size_t)k * N + c]; }, row0, col0, K, F.ldsf);
#pragma unroll
        for (int i = 0; i < 4; ++i) {
            const int r = row0 + ty * 4 + i, c = col0 + tx * 4;
            if (OUTMODE == 0) { *(f32x4*)((float*)out + (size_t)r * N + c) = (f32x4){acc[i][0], acc[i][1], acc[i][2], acc[i][3]}; }
            else { u32x2 w; w.x = pack2(acc[i][0], acc[i][1]); w.y = pack2(acc[i][2], acc[i][3]);
                   *(u32x2*)((bf16_t*)out + (size_t)(c / D) * T * D + (size_t)r * D + (c % D)) = w; }
        }
    }
}

__device__ __forceinline__ void ph_postmix_preffn(const Frame& F, int layer, const float* xin, const float* Y) {
    const float* MOD = (const float*)(F.ws + WS_MOD);
    const float* gpo = F.in[I_NPOM] + layer * D; const float* gpf = F.in[I_NPF] + layer * D;
    bf16_t* H2 = (bf16_t*)(F.ws + WS_H2); bf16_t* H2LO = (bf16_t*)(F.ws + WS_H2LO);
    for (int t = F.bid * NWAVES + F.wave; t < T; t += F.G * NWAVES) {
        const int b = t / SEQ; const float* m = MOD + (layer * 2 + b) * 6144;
        f32x4 y[4]; float ss = 0.f;
#pragma unroll
        for (int i = 0; i < 4; ++i) { y[i] = *(const f32x4*)(Y + (size_t)t * D + 4 * F.lane + 256 * i); ss += y[i][0] * y[i][0] + y[i][1] * y[i][1] + y[i][2] * y[i][2] + y[i][3] * y[i][3]; }
        ss = wave_sum(ss);
        const float rs = rsqrtf(ss * (1.0f / D) + 1e-6f);
        f32x4 x1[4]; float s2 = 0.f;
#pragma unroll
        for (int i = 0; i < 4; ++i) { const int c = 4 * F.lane + 256 * i;
            const f32x4 xv = *(const f32x4*)(xin + (size_t)t * D + c), gm = *(const f32x4*)(m + 2048 + c), gp = *(const f32x4*)(gpo + c);
            x1[i] = xv + gm * (y[i] * rs * gp);
            *(f32x4*)(F.out + (size_t)t * D + c) = x1[i];
            s2 += x1[i][0] * x1[i][0] + x1[i][1] * x1[i][1] + x1[i][2] * x1[i][2] + x1[i][3] * x1[i][3]; }
        s2 = wave_sum(s2);
        const float rs2 = rsqrtf(s2 * (1.0f / D) + 1e-6f);
#pragma unroll
        for (int i = 0; i < 4; ++i) { const int c = 4 * F.lane + 256 * i;
            const f32x4 gf = *(const f32x4*)(gpf + c), sc = *(const f32x4*)(m + 4096 + c), sh = *(const f32x4*)(m + 3072 + c);
            const f32x4 h = x1[i] * rs2 * gf * (sc + 1.0f) + sh;
            u32x2 w; w.x = pack2(h[0], h[1]); w.y = pack2(h[2], h[3]);
            u32x2 wl; wl.x = pack2(h[0] - lo2f(w.x), h[1] - hi2f(w.x)); wl.y = pack2(h[2] - lo2f(w.y), h[3] - hi2f(w.y));
            *(u32x2*)(H2 + (size_t)t * D + c) = w; *(u32x2*)(H2LO + (size_t)t * D + c) = wl; }
    }
}

__device__ __forceinline__ void ph_router_simt(const Frame& F, int layer) {
    const bf16_t* H2 = (const bf16_t*)(F.ws + WS_H2); const bf16_t* H2LO = (const bf16_t*)(F.ws + WS_H2LO);
    const float* W = F.in[I_ROUTER] + (size_t)layer * D * NE; float* LOG = (float*)(F.ws + WS_LOGITS);
    for (int u = F.bid; u < T / 128; u += F.G) {
        const int row0 = u * 128, ty = F.tid >> 4, tx = F.tid & 15;
        float acc[4][4];
        simt_tile(acc, [&](int r, int k) { return bf2f(H2[(size_t)r * D + k]) + bf2f(H2LO[(size_t)r * D + k]); }, [&](int k, int c) { return W[(size_t)k * NE + c]; }, row0, 0, D, F.ldsf);
#pragma unroll
        for (int i = 0; i < 4; ++i) *(f32x4*)(LOG + (size_t)(row0 + ty * 4 + i) * NE + tx * 4) = (f32x4){acc[i][0], acc[i][1], acc[i][2], acc[i][3]};
    }
}

__device__ __forceinline__ void ph_topk(const Frame& F, int layer) {
    const float* LOG = (const float*)(F.ws + WS_LOGITS); const float* rb = F.in[I_RBIAS] + layer * NE;
    int* IDX = (int*)(F.ws + WS_IDX); float* GATE = (float*)(F.ws + WS_GATE); int* RANK = (int*)(F.ws + WS_RANK);
    unsigned* CNT = F.ctl + CW_CNT + layer * 64;
    const float bias = rb[F.lane];
    for (int t = F.bid * NWAVES + F.wave; t < T; t += F.G * NWAVES) {
        const float s = sigmoidf_(LOG[(size_t)t * NE + F.lane]);
        float sel = s + bias;
        int myidx = -1; float mysc = 0.f; float tot = 0.f;
#pragma unroll
        for (int k = 0; k < TOPK; ++k) {
            float bv = sel; int bi = F.lane;
#pragma unroll
            for (int o = 32; o >= 1; o >>= 1) { const float ov = __shfl_xor(bv, o); const int oi = __shfl_xor(bi, o); if (ov > bv || (ov == bv && oi < bi)) { bv = ov; bi = oi; } }
            const float sc = __shfl(s, bi);
            tot += sc;
            if (F.lane == k) { myidx = bi; mysc = sc; }
            if (F.lane == bi) sel = -1e30f;
        }
        if (F.lane < TOPK) {
            IDX[t * TOPK + F.lane] = myidx; GATE[t * TOPK + F.lane] = 2.5f * mysc / tot;
            RANK[t * TOPK + F.lane] = (int)atomicAdd(&CNT[myidx], 1u);
        }
    }
}

__device__ __forceinline__ void ph_offsets(const Frame& F, int layer) {
    const unsigned* CNT = F.ctl + CW_CNT + layer * 64;
    const int* IDX = (const int*)(F.ws + WS_IDX); const int* RANK = (const int*)(F.ws + WS_RANK);
    int* POS = (int*)(F.ws + WS_POS); int* TOK = (int*)(F.ws + WS_TOK); int* TILEE = (int*)(F.ws + WS_TILEE); int* START = (int*)(F.ws + WS_START);
    int* sst = (int*)F.ldsf;
    if (F.tid == 0) { int acc = 0; for (int e = 0; e < NE; ++e) { const int c = (int)CNT[e]; sst[e] = acc; sst[128 + e] = c; acc += ((c + RP - 1) / RP) * RP; } sst[64] = acc; }
    __syncthreads();
    if (F.bid == 0) {
        if (F.tid <= 64) START[F.tid] = sst[F.tid];
        if (F.tid == 65) START[65] = sst[64];
        const int ntile = sst[64] / RP;
        for (int i = F.tid; i < ntile; i += NTHREADS) { int e = 0; while (e < 63 && sst[e + 1] <= i * RP) ++e; TILEE[i] = e; }
    }
    for (int s = F.bid * NTHREADS + F.tid; s < T * TOPK; s += F.G * NTHREADS) {
        const int e = IDX[s], p = sst[e] + RANK[s];
        POS[s] = p; TOK[p] = s / TOPK;
    }
    for (int s = F.bid * NTHREADS + F.tid; s < NE * RP; s += F.G * NTHREADS) {
        const int e = s / RP, r = s % RP, c = sst[128 + e];
        if (sst[e] + c + r < sst[e + 1]) TOK[sst[e] + c + r] = 0;
    }
    __syncthreads();
}

__device__ __forceinline__ void ph_gateup_simt(const Frame& F, int layer) {
    const bf16_t* H2 = (const bf16_t*)(F.ws + WS_H2); bf16_t* HB = (bf16_t*)(F.ws + WS_HB);
    const int* TOK = (const int*)(F.ws + WS_TOK); const int* TILEE = (const int*)(F.ws + WS_TILEE); const int* START = (const int*)(F.ws + WS_START);
    const int routed = START[65], nrt = (routed + T) / 128, nunits = nrt * 4;
    for (int u = F.bid; u < nunits; u += F.G) {
        const int rt = u / 4, ct = u % 4, row0 = rt * 128, col0 = ct * 64, ty = F.tid >> 4, tx = F.tid & 15;
        const bool sh = row0 >= routed; const int e = sh ? 0 : TILEE[row0 / RP];
        const float* Wg = sh ? F.in[I_SG] + (size_t)layer * D * DE : F.in[I_MG] + ((size_t)layer * NE + e) * D * DE;
        const float* Wu = sh ? F.in[I_SU] + (size_t)layer * D * DE : F.in[I_MU_] + ((size_t)layer * NE + e) * D * DE;
        auto af = [&](int r, int k) { const int tok = sh ? (r - routed) : TOK[r]; return bf2f(H2[(size_t)tok * D + k]); };
        float ag[4][4], au[4][4];
        simt_tile(ag, af, [&](int k, int c) { return Wg[(size_t)k * DE + c]; }, row0, col0, D, F.ldsf);
        simt_tile(au, af, [&](int k, int c) { return Wu[(size_t)k * DE + c]; }, row0, col0, D, F.ldsf);
#pragma unroll
        for (int i = 0; i < 4; ++i) { float v[4];
#pragma unroll
            for (int q = 0; q < 4; ++q) { const float g = ag[i][q]; v[q] = g * sigmoidf_(g) * au[i][q]; }
            u32x2 w; w.x = pack2(v[0], v[1]); w.y = pack2(v[2], v[3]);
            *(u32x2*)(HB + (size_t)(row0 + ty * 4 + i) * DE + col0 + tx * 4) = w; }
    }
}
__device__ __forceinline__ void ph_down_simt(const Frame& F, int layer) {
    const bf16_t* HB = (const bf16_t*)(F.ws + WS_HB); bf16_t* YB = (bf16_t*)(F.ws + WS_YB);
    const int* TILEE = (const int*)(F.ws + WS_TILEE); const int* START = (const int*)(F.ws + WS_START);
    const int routed = START[65], nrt = (routed + T) / 128, nunits = nrt * 16;
    for (int u = F.bid; u < nunits; u += F.G) {
        const int rt = u / 16, ct = u % 16, row0 = rt * 128, col0 = ct * 64, ty = F.tid >> 4, tx = F.tid & 15;
        const bool sh = row0 >= routed; const int e = sh ? 0 : TILEE[row0 / RP];
        const float* Wd = sh ? F.in[I_SD] + (size_t)layer * DE * D : F.in[I_MD] + ((size_t)layer * NE + e) * DE * D;
        float acc[4][4];
        simt_tile(acc, [&](int r, int k) { return bf2f(HB[(size_t)r * DE + k]); }, [&](int k, int c) { return Wd[(size_t)k * D + c]; }, row0, col0, DE, F.ldsf);
#pragma unroll
        for (int i = 0; i < 4; ++i) { u32x2 w; w.x = pack2(acc[i][0], acc[i][1]); w.y = pack2(acc[i][2], acc[i][3]);
            *(u32x2*)(YB + (size_t)(row0 + ty * 4 + i) * D + col0 + tx * 4) = w; }
    }
}
__device__ __forceinline__ void ph_combine(const Frame& F, int layer, bool next) {
    const bf16_t* YB = (const bf16_t*)(F.ws + WS_YB); const int* POS = (const int*)(F.ws + WS_POS); const float* GATE = (const float*)(F.ws + WS_GATE);
    const int* START = (const int*)(F.ws + WS_START); const float* MOD = (const float*)(F.ws + WS_MOD);
    const float* gpo = F.in[I_NPOF] + layer * D;
    bf16_t* H3 = (bf16_t*)(F.ws + WS_H3);
    const int routed = START[65];
    for (int t = F.bid * NWAVES + F.wave; t < T; t += F.G * NWAVES) {
        const int b = t / SEQ; const float* m = MOD + (layer * 2 + b) * 6144;
        f32x4 y[4];
#pragma unroll
        for (int i = 0; i < 4; ++i) { const u32x2 w = *(const u32x2*)(YB + (size_t)(routed + t) * D + 4 * F.lane + 256 * i); y[i] = (f32x4){lo2f(w.x), hi2f(w.x), lo2f(w.y), hi2f(w.y)}; }
#pragma unroll
        for (int k = 0; k < TOPK; ++k) {
            const int p = POS[t * TOPK + k]; const float gk = GATE[t * TOPK + k];
#pragma unroll
            for (int i = 0; i < 4; ++i) { const u32x2 w = *(const u32x2*)(YB + (size_t)p * D + 4 * F.lane + 256 * i); y[i] += (f32x4){lo2f(w.x), hi2f(w.x), lo2f(w.y), hi2f(w.y)} * gk; }
        }
        float ss = 0.f;
#pragma unroll
        for (int i = 0; i < 4; ++i) ss += y[i][0] * y[i][0] + y[i][1] * y[i][1] + y[i][2] * y[i][2] + y[i][3] * y[i][3];
        ss = wave_sum(ss);
        const float rs = rsqrtf(ss * (1.0f / D) + 1e-6f);
        f32x4 x2[4]; float s2 = 0.f;
#pragma unroll
        for (int i = 0; i < 4; ++i) { const int c = 4 * F.lane + 256 * i;
            const f32x4 xv = *(const f32x4*)(F.out + (size_t)t * D + c), gm = *(const f32x4*)(m + 5120 + c), gp = *(const f32x4*)(gpo + c);
            x2[i] = xv + gm * (y[i] * rs * gp);
            *(f32x4*)(F.out + (size_t)t * D + c) = x2[i];
            s2 += x2[i][0] * x2[i][0] + x2[i][1] * x2[i][1] + x2[i][2] * x2[i][2] + x2[i][3] * x2[i][3]; }
        if (next) {
            s2 = wave_sum(s2);
            const float rs2 = rsqrtf(s2 * (1.0f / D) + 1e-6f);
            const float* m1 = MOD + ((layer + 1) * 2 + b) * 6144; const float* g1 = F.in[I_NPM] + (layer + 1) * D;
#pragma unroll
            for (int i = 0; i < 4; ++i) { const int c = 4 * F.lane + 256 * i;
                const f32x4 gf = *(const f32x4*)(g1 + c), sc = *(const f32x4*)(m1 + 1024 + c), sh = *(const f32x4*)(m1 + c);
                const f32x4 h = x2[i] * rs2 * gf * (sc + 1.0f) + sh;
                u32x2 w; w.x = pack2(h[0], h[1]); w.y = pack2(h[2], h[3]);
                *(u32x2*)(H3 + (size_t)t * D + c) = w; }
        }
    }
}

#define SB_EXIT 110.0f
__device__ __forceinline__ void ph_attn_ref(const Frame& F) {
    const bf16_t* Q = (const bf16_t*)(F.ws + WS_Q); const bf16_t* Kb = Q + (size_t)T * D; const bf16_t* Vb = Q + (size_t)2 * T * D;
    bf16_t* AO = (bf16_t*)(F.ws + WS_AO);
    float* Ks = F.ldsf; float* Vs = Ks + 64 * 65; float* Qs = Vs + 64 * 65; float* Ws = Qs + 64 * 64; float* Rm = Ws + 8 * 64;
    const int nunits = NB * NH * (SEQ / 64);
    for (int u = F.bid; u < nunits; u += F.G) {
        const int qt = (SEQ / 64 - 1) - (u / (NB * NH)), bh = u % (NB * NH), b = bh / NH, h = bh % NH;
        const size_t tb = (size_t)b * SEQ;
        for (int idx = F.tid; idx < 64 * 64; idx += NTHREADS) { const int r = idx >> 6, c = idx & 63; Qs[idx] = bf2f(Q[(tb + qt * 64 + r) * D + h * 64 + c]) * 0.125f; }
        float R[8], acc[8];
#pragma unroll
        for (int q = 0; q < 8; ++q) { R[q] = 0.f; acc[q] = 0.f; }
        for (int kt = qt; kt >= 0; --kt) {
            __syncthreads();
            for (int idx = F.tid; idx < 64 * 64; idx += NTHREADS) { const int r = idx >> 6, c = idx & 63; const size_t g = (tb + kt * 64 + r) * D + h * 64 + c; Ks[r * 65 + c] = bf2f(Kb[g]); Vs[r * 65 + c] = bf2f(Vb[g]); }
            __syncthreads();
#pragma unroll
            for (int q = 0; q < 8; ++q) {
                const int qi = F.wave * 8 + q;
                float z = 0.f;
#pragma unroll 16
                for (int d = 0; d < 64; ++d) z += Qs[qi * 64 + d] * Ks[F.lane * 65 + d];
                const bool valid = (kt < qt) || (F.lane < qi);
                const float sp = valid ? softplusf_(z) : 0.f;
                float suf = sp;
#pragma unroll
                for (int o = 1; o < 64; o <<= 1) { const float v = __shfl_down(suf, o); if (F.lane + o < 64) suf += v; }
                const float tail = R[q] + suf - sp;
                const float w = valid ? __expf(z - sp - tail) : 0.f;
                R[q] += __shfl(suf, 0);
                Ws[F.wave * 64 + F.lane] = w;
                float a = acc[q];
#pragma unroll 16
                for (int s = 0; s < 64; ++s) a += Ws[F.wave * 64 + s] * Vs[s * 65 + F.lane];
                acc[q] = a;
            }
            float mn = R[0];
#pragma unroll
            for (int q = 1; q < 8; ++q) mn = fminf(mn, R[q]);
            if (F.lane == 0) Rm[F.wave] = mn;
            __syncthreads();
            float allmin = Rm[0];
#pragma unroll
            for (int w = 1; w < 8; ++w) allmin = fminf(allmin, Rm[w]);
            if (allmin > SB_EXIT) break;
        }
#pragma unroll
        for (int q = 0; q < 8; ++q) AO[(tb + qt * 64 + F.wave * 8 + q) * D + h * 64 + F.lane] = f2bf(acc[q]);
        __syncthreads();
    }
}

#define EPI_MT(acc) (int)(sizeof(acc) / sizeof(acc[0]))
__device__ __forceinline__ void st_bf4(bf16_t* p, const f32x4& v) { u32x2 w; w.x = pack2(v[0], v[1]); w.y = pack2(v[2], v[3]); *(u32x2*)p = w; }

__device__ __forceinline__ void ph_rkv_lora_sg(const Frame& F) {
    const bf16_t* XS = (const bf16_t*)(F.ws + WS_XS); const bf16_t* WRKV = (const bf16_t*)(F.ws + WS_WRKV); const bf16_t* WLDN = (const bf16_t*)(F.ws + WS_WLDN);
    bf16_t* RKV = (bf16_t*)(F.ws + WS_RKV); bf16_t* LORA = (bf16_t*)(F.ws + WS_LORA);
    for (int u = F.bid; u < 64 * 24; u += F.G) {
        const int mt = u / 24, ct = u % 24, n = ct / 8, col0 = (ct % 8) * 128;
        ASeg A; A.p[0] = XS + ((size_t)n * T + mt * 256) * D; A.p[1] = A.p[0]; A.p[2] = A.p[0]; A.segTiles = 16;
        bf16_t* out = RKV + ((size_t)n * T + mt * 256) * D + col0;
        sg_tile<128>(F.lds, A, [](int R) { return (unsigned)R * (D * 2); }, WRKV + (size_t)(n * D + col0) * D, D, 16,
            [&](auto& acc, int r0, int c0, int fr, int fq) {
#pragma unroll
                for (int m = 0; m < EPI_MT(acc); ++m)
#pragma unroll
                    for (int q = 0; q < 4; ++q) st_bf4(out + (size_t)(r0 + 16 * m + fr) * D + c0 + 16 * q + 4 * fq, acc[m][q]);
            });
    }
    for (int u = F.bid; u < 64 * 4; u += F.G) {
        const int mt = u / 4, j = u % 4, n = (j == 0) ? 3 : (j == 1 ? 4 : 5);
        ASeg A; A.p[0] = XS + ((size_t)n * T + mt * 256) * D; A.p[1] = A.p[0]; A.p[2] = A.p[0]; A.segTiles = 16;
        bf16_t* out = LORA + (size_t)mt * 256 * 256 + j * 64;
        sg_tile<64>(F.lds, A, [](int R) { return (unsigned)R * (D * 2); }, WLDN + (size_t)(j * 64) * D, D, 16,
            [&](auto& acc, int r0, int c0, int fr, int fq) {
#pragma unroll
                for (int m = 0; m < EPI_MT(acc); ++m)
#pragma unroll
                    for (int q = 0; q < 4; ++q) { f32x4 v = acc[m][q];
#pragma unroll
                        for (int e = 0; e < 4; ++e) v[e] = (j == 0) ? tanhf(v[e]) : (j == 1 ? v[e] : sigmoidf_(v[e]));
                        st_bf4(out + (size_t)(r0 + 16 * m + fr) * 256 + c0 + 16 * q + 4 * fq, v); }
            });
    }
}
__device__ __forceinline__ void ph_lora_up_sg(const Frame& F) {
    const bf16_t* LORA = (const bf16_t*)(F.ws + WS_LORA); const bf16_t* WLUP = (const bf16_t*)(F.ws + WS_WLUP);
    float* LD = (float*)(F.ws + WS_LD); bf16_t* AA = (bf16_t*)(F.ws + WS_AA); bf16_t* GG = (bf16_t*)(F.ws + WS_GG);
    for (int u = F.bid; u < 3 * 64 * 8; u += F.G) {
        const int which = u / 512, v = u % 512, mt = v / 8, col0 = (v % 8) * 128;
        const int K = which == 2 ? 128 : 64, koff = which * 64;
        ASeg A; A.p[0] = LORA + (size_t)mt * 256 * 256 + koff; A.p[1] = A.p[0]; A.p[2] = A.p[0]; A.segTiles = 4;
        const bf16_t* Bt = WLUP + (which == 0 ? 0 : (which == 1 ? 1024 * 64 : 2 * 1024 * 64)) + (size_t)col0 * K;
        const size_t obase = (size_t)mt * 256 * D + col0;
        sg_tile<128>(F.lds, A, [](int R) { return (unsigned)R * 512u; }, Bt, K, K / 64,
            [&](auto& acc, int r0, int c0, int fr, int fq) {
#pragma unroll
                for (int m = 0; m < EPI_MT(acc); ++m)
#pragma unroll
                    for (int q = 0; q < 4; ++q) {
                        const int c = c0 + 16 * q + 4 * fq; const size_t o = obase + (size_t)(r0 + 16 * m + fr) * D + c;
                        if (which == 0) { const f32x4 w0 = *(const f32x4*)(F.in[I_W0] + col0 + c); f32x4 r;
#pragma unroll
                            for (int e = 0; e < 4; ++e) { const float wl = w0[e] + acc[m][q][e]; r[e] = -__expf(-softplusf_(-wl) - 0.5f); }
                            *(f32x4*)(LD + o) = r; }
                        else if (which == 1) { const f32x4 a0 = *(const f32x4*)(F.in[I_A0] + col0 + c); f32x4 r;
#pragma unroll
                            for (int e = 0; e < 4; ++e) r[e] = sigmoidf_(a0[e] + acc[m][q][e]);
                            st_bf4(AA + o, r); }
                        else st_bf4(GG + o, acc[m][q]);
                    }
            });
    }
}
template <int OUTMODE>
__device__ __forceinline__ void ph_dense_sg(const Frame& F, const bf16_t* Ain, const bf16_t* Wt, int N, void* outp) {
    const int nct = N / 128;
    for (int u = F.bid; u < 64 * nct; u += F.G) {
        const int mt = u / nct, col0 = (u % nct) * 128;
        ASeg A; A.p[0] = Ain + (size_t)mt * 256 * D; A.p[1] = A.p[0]; A.p[2] = A.p[0]; A.segTiles = 16;
        sg_tile<128>(F.lds, A, [](int R) { return (unsigned)R * (D * 2); }, Wt + (size_t)col0 * D, D, 16,
            [&](auto& acc, int r0, int c0, int fr, int fq) {
#pragma unroll
                for (int m = 0; m < EPI_MT(acc); ++m)
#pragma unroll
                    for (int q = 0; q < 4; ++q) {
                        const int r = mt * 256 + r0 + 16 * m + fr, c = col0 + c0 + 16 * q + 4 * fq;
                        if (OUTMODE == 0) *(f32x4*)((float*)outp + (size_t)r * N + c) = acc[m][q];
                        else st_bf4((bf16_t*)outp + (size_t)(c / D) * T * D + (size_t)r * D + (c % D), acc[m][q]);
                    }
            });
    }
}
__device__ __forceinline__ void ph_router_sg(const Frame& F, int layer) {
    const bf16_t* H2 = (const bf16_t*)(F.ws + WS_H2); const bf16_t* H2LO = (const bf16_t*)(F.ws + WS_H2LO);
    const bf16_t* WRT = (const bf16_t*)(F.ws + WS_WRT) + (size_t)layer * 64 * 3072; float* LOG = (float*)(F.ws + WS_LOGITS);
    for (int mt = F.bid; mt < 64; mt += F.G) {
        ASeg A; A.p[0] = H2 + (size_t)mt * 256 * D; A.p[1] = A.p[0]; A.p[2] = H2LO + (size_t)mt * 256 * D; A.segTiles = 16;
        sg_tile<64>(F.lds, A, [](int R) { return (unsigned)R * (D * 2); }, WRT, 3072, 48,
            [&](auto& acc, int r0, int c0, int fr, int fq) {
#pragma unroll
                for (int m = 0; m < EPI_MT(acc); ++m)
#pragma unroll
                    for (int q = 0; q < 4; ++q) *(f32x4*)(LOG + (size_t)(mt * 256 + r0 + 16 * m + fr) * NE + c0 + 16 * q + 4 * fq) = acc[m][q];
            });
    }
}
__device__ __forceinline__ void ph_gateup_sg(const Frame& F) {
    const bf16_t* H2 = (const bf16_t*)(F.ws + WS_H2); bf16_t* HB = (bf16_t*)(F.ws + WS_HB); const bf16_t* WGU = (const bf16_t*)(F.ws + WS_WGU);
    const int* TOK = (const int*)(F.ws + WS_TOK); const int* TILEE = (const int*)(F.ws + WS_TILEE); const int* START = (const int*)(F.ws + WS_START);
    const int routed = START[65], nmt = (routed + T) / 256;
    for (int u = F.bid; u < nmt * 4; u += F.G) {
        const int mt = u / 4, nt4 = u % 4, row0 = mt * 256; const bool sh = row0 >= routed; const int e = sh ? 64 : TILEE[mt];
        ASeg A; A.p[0] = H2; A.p[1] = H2; A.p[2] = H2; A.segTiles = 16;
        bf16_t* out = HB + (size_t)row0 * DE + nt4 * 64;
        sg_tile<128>(F.lds, A, [&](int R) { const int tok = sh ? (row0 - routed + R) : TOK[row0 + R]; return (unsigned)tok * (D * 2); },
            WGU + ((size_t)e * 512 + nt4 * 128) * D, D, 16,
            [&](auto& acc, int r0, int c0, int fr, int fq) {
#pragma unroll
                for (int m = 0; m < EPI_MT(acc); ++m)
#pragma unroll
                    for (int q = 0; q < 2; ++q) { f32x4 v;
#pragma unroll
                        for (int e2 = 0; e2 < 4; ++e2) { const float g = acc[m][q][e2]; v[e2] = g * sigmoidf_(g) * acc[m][q + 2][e2]; }
                        st_bf4(out + (size_t)(r0 + 16 * m + fr) * DE + (c0 >> 1) + 16 * q + 4 * fq, v); }
            });
    }
}
__device__ __forceinline__ void ph_down_sg(const Frame& F) {
    const bf16_t* HB = (const bf16_t*)(F.ws + WS_HB); bf16_t* YB = (bf16_t*)(F.ws + WS_YB); const bf16_t* WDN = (const bf16_t*)(F.ws + WS_WDN);
    const int* TILEE = (const int*)(F.ws + WS_TILEE); const int* START = (const int*)(F.ws + WS_START);
    const int routed = START[65], nmt = (routed + T) / 256;
    for (int u = F.bid; u < nmt * 8; u += F.G) {
        const int mt = u / 8, col0 = (u % 8) * 128, row0 = mt * 256; const bool sh = row0 >= routed; const int e = sh ? 64 : TILEE[mt];
        ASeg A; A.p[0] = HB + (size_t)row0 * DE; A.p[1] = A.p[0]; A.p[2] = A.p[0]; A.segTiles = 4;
        bf16_t* out = YB + (size_t)row0 * D + col0;
        sg_tile<128>(F.lds, A, [](int R) { return (unsigned)R * (DE * 2); }, WDN + ((size_t)e * D + col0) * DE, DE, 4,
            [&](auto& acc, int r0, int c0, int fr, int fq) {
#pragma unroll
                for (int m = 0; m < EPI_MT(acc); ++m)
#pragma unroll
                    for (int q = 0; q < 4; ++q) st_bf4(out + (size_t)(r0 + 16 * m + fr) * D + c0 + 16 * q + 4 * fq, acc[m][q]);
            });
    }
}

__global__ void __launch_bounds__(NTHREADS, 2) mega(Args args) {
    extern __shared__ __attribute__((aligned(16))) unsigned char lds[];
    Frame F;
    F.in = args.in; F.out = args.out; F.ws = args.ws; F.ctl = (unsigned*)(args.ws + WS_CTL);
    F.ldsf = (float*)lds; F.lds = (LAS unsigned char*)lds;
    F.tid = threadIdx.x; F.lane = F.tid & 63; F.wave = __builtin_amdgcn_readfirstlane(F.tid >> 6); F.bid = blockIdx.x; F.G = gridDim.x;
    if (F.tid < 4) ((unsigned*)(lds + LDS_BYTES - 64))[F.tid] = 0u;
    __syncthreads();
    XcdBarrier bar; bar.bar = F.ctl + CW_BAR; bar.x = 0; bar.st = (volatile LAS unsigned*)(lds + LDS_BYTES - 64);
#if MK_N_LAUNCHES == 1
    bar = xcd_barrier_post(F.ctl + CW_BAR, (volatile LAS unsigned*)(lds + LDS_BYTES - 64));
#endif
    const int lo = args.ph_lo, hi = args.ph_hi;
#define IN(k) (lo <= (k) && (k) < hi)
#define SEAM(k) do { if (IN(k) && IN((k) + 1)) xcd_barrier(bar); } while (0)
    bf16_t* const wsb = (bf16_t*)args.ws;
    (void)wsb;
    if (IN(0)) { ph_mod(F); conv_dense(F, F.bid, F.G); conv_moe(F, 0, F.bid, F.G); } SEAM(0);
    if (IN(1)) { ph_prenorm_rwkv(F); } SEAM(1);
    if (IN(2)) { ph_rkv_lora_sg(F); } SEAM(2);
    if (IN(3)) { ph_lora_up_sg(F); } SEAM(3);
    if (IN(4)) { ph_wkv_seq(F); } SEAM(4);
    if (IN(5)) { ph_wkv_post(F); } SEAM(5);
    if (IN(6)) { ph_dense_sg<0>(F, (const bf16_t*)(F.ws + WS_OG), (const bf16_t*)(F.ws + WS_WO), D, F.ws + WS_Y1); } SEAM(6);
    if (IN(7)) { ph_postmix_preffn(F, 0, F.in[I_X], (const float*)(F.ws + WS_Y1)); } SEAM(7);
    if (IN(8)) { ph_router_sg(F, 0); } SEAM(8);
    if (IN(9)) { ph_topk(F, 0); } SEAM(9);
    if (IN(10)) { ph_offsets(F, 0); } SEAM(10);
    if (IN(11)) { ph_gateup_sg(F); } SEAM(11);
    if (IN(12)) { ph_down_sg(F); } SEAM(12);
    if (IN(13)) { ph_combine(F, 0, true); conv_moe(F, 1, F.bid, F.G); } SEAM(13);
    if (IN(14)) { ph_dense_sg<1>(F, (const bf16_t*)(F.ws + WS_H3), (const bf16_t*)(F.ws + WS_WQKV), 3 * D, F.ws + WS_Q); } SEAM(14);
    if (IN(15)) { ph_attn_ref(F); } SEAM(15);
    if (IN(16)) { ph_dense_sg<0>(F, (const bf16_t*)(F.ws + WS_AO), (const bf16_t*)(F.ws + WS_WSBO), D, F.ws + WS_Y1B); } SEAM(16);
    if (IN(17)) { ph_postmix_preffn(F, 1, F.out, (const float*)(F.ws + WS_Y1B)); } SEAM(17);
    if (IN(18)) { ph_router_sg(F, 1); } SEAM(18);
    if (IN(19)) { ph_topk(F, 1); } SEAM(19);
    if (IN(20)) { ph_offsets(F, 1); } SEAM(20);
    if (IN(21)) { ph_gateup_sg(F); } SEAM(21);
    if (IN(22)) { ph_down_sg(F); } SEAM(22);
    if (IN(23)) { ph_combine(F, 1, false); }
#undef IN
#undef SEAM
}

extern "C" void kernel_launch(void* const* d_in, const int* in_sizes, int n_in, void* d_out, int out_size, void* d_ws, size_t ws_size, hipStream_t stream) {
    static int grid = 0;
    if (grid == 0) {
        if (n_in != 34 || in_sizes[0] != T * D || out_size != T * D || ws_size < WS_END) {
            fprintf(stderr, "kernel_launch: unexpected shapes: n_in %d in0 %d out %d ws %zu (need %zu)\n", n_in, n_in > 0 ? in_sizes[0] : -1, out_size, ws_size, (size_t)WS_END);
            grid = -1; return;
        }
        int dev = 0, cus = 0, per_cu = 0;
        if (hipGetDevice(&dev) != hipSuccess || hipDeviceGetAttribute(&cus, hipDeviceAttributeMultiprocessorCount, dev) != hipSuccess) { grid = -1; return; }
        if (hipFuncSetAttribute((const void*)mega, hipFuncAttributeMaxDynamicSharedMemorySize, LDS_BYTES) != hipSuccess) { fprintf(stderr, "kernel_launch: hipFuncSetAttribute failed\n"); grid = -1; return; }
        if (hipOccupancyMaxActiveBlocksPerMultiprocessor(&per_cu, (const void*)mega, NTHREADS, LDS_BYTES) != hipSuccess || per_cu < 1)
            fprintf(stderr, "kernel_launch: occupancy query reports %d blocks per CU\n", per_cu);
        (void)hipGetLastError();
        grid = cus;
    }
    if (grid < 0) return;
    if (hipMemsetAsync((char*)d_ws + WS_CTL, 0, CTL_BYTES, stream) != hipSuccess) { fprintf(stderr, "kernel_launch: memset failed\n"); return; }
    Args a{};
    for (int i = 0; i < 34; ++i) a.in[i] = (const float*)d_in[i];
    a.out = (float*)d_out; a.ws = (unsigned char*)d_ws;
#if MK_N_LAUNCHES == 1
    a.ph_lo = 0; a.ph_hi = NPHASES;
    hipLaunchKernelGGL(mega, dim3(grid), dim3(NTHREADS), LDS_BYTES, stream, a);
#else
    for (int p = 0; p < NPHASES; ++p) { a.ph_lo = p; a.ph_hi = p + 1; hipLaunchKernelGGL(mega, dim3(grid), dim3(NTHREADS), LDS_BYTES, stream, a); }
#endif
    const hipError_t le = hipPeekAtLastError();
    if (le != hipSuccess) fprintf(stderr, "kernel_launch: launch failed: %s\n", hipGetErrorName(le));
}
```

```cpp
#include <hip/hip_runtime.h>
#include <cstdio>
#include <cstdint>

#ifndef MK_N_LAUNCHES
#define MK_N_LAUNCHES 1
#endif

constexpr int T = 16384, D = 1024, SEQ = 8192, NB = 2, NH = 16, HD = 64;
constexpr int NE = 64, TOPK = 8, DE = 256;
constexpr int RP = 256;
constexpr int MAXROUTED = 147456;
constexpr int MAXROWS = MAXROUTED + T;
constexpr int NTHREADS = 512, NWAVES = 8;
constexpr int NPHASES = 25;
constexpr int LDS_BYTES = 144 * 1024;

typedef unsigned short bf16_t;
typedef float f32x4 __attribute__((ext_vector_type(4)));
typedef unsigned u32x4 __attribute__((ext_vector_type(4)));
typedef unsigned u32x2 __attribute__((ext_vector_type(2)));

__device__ __forceinline__ float bf2f(bf16_t b) { return __uint_as_float(((unsigned)b) << 16); }
__device__ __forceinline__ bf16_t f2bf(float f) { unsigned u = __float_as_uint(f); u += 0x7FFFu + ((u >> 16) & 1u); return (bf16_t)(u >> 16); }
__device__ __forceinline__ unsigned pack2(float a, float b) { return (unsigned)f2bf(a) | ((unsigned)f2bf(b) << 16); }
__device__ __forceinline__ float lo2f(unsigned u) { return __uint_as_float(u << 16); }
__device__ __forceinline__ float hi2f(unsigned u) { return __uint_as_float(u & 0xffff0000u); }
__device__ __forceinline__ float sigmoidf_(float x) { return 1.0f / (1.0f + __expf(-x)); }
__device__ __forceinline__ float softplusf_(float x) { return x > 20.f ? x : log1pf(__expf(x)); }
__device__ __forceinline__ float wave_sum(float v) {
#pragma unroll
    for (int o = 32; o >= 1; o >>= 1) v += __shfl_xor(v, o);
    return v;
}

constexpr size_t MiB = 1024 * 1024;
constexpr size_t WS_CTL    = 0;
constexpr size_t CTL_BYTES = 64 * 1024;
constexpr size_t WS_MOD    = 64 * 1024;
constexpr size_t WS_IDX    = 256 * 1024;
constexpr size_t WS_GATE   = WS_IDX + 512 * 1024;
constexpr size_t WS_RANK   = WS_GATE + 512 * 1024;
constexpr size_t WS_POS    = WS_RANK + 512 * 1024;
constexpr size_t WS_TOK    = WS_POS + 512 * 1024;
constexpr size_t WS_TILEE  = WS_TOK + 704 * 1024;
constexpr size_t WS_START  = WS_TILEE + 4096;
constexpr size_t WS_LOGITS = 4 * MiB;
constexpr size_t WS_BIG    = 8 * MiB;
constexpr size_t WS_XS   = WS_BIG;
constexpr size_t WS_RKV  = WS_BIG + 192 * MiB;
constexpr size_t WS_LORA = WS_BIG + 288 * MiB;
constexpr size_t WS_LD   = WS_BIG;
constexpr size_t WS_AA   = WS_BIG + 64 * MiB;
constexpr size_t WS_GG   = WS_BIG + 96 * MiB;
constexpr size_t WS_O    = WS_BIG + 128 * MiB;
constexpr size_t WS_OG   = WS_BIG + 296 * MiB;
constexpr size_t WS_Y1   = WS_BIG + 328 * MiB;
constexpr size_t WS_H2   = WS_BIG;
constexpr size_t WS_H2LO = WS_BIG + 32 * MiB;
constexpr size_t WS_YB   = WS_BIG;
constexpr size_t WS_HB   = WS_BIG + 320 * MiB;
constexpr size_t WS_H3   = WS_BIG + 320 * MiB;
constexpr size_t WS_Q    = WS_BIG;
constexpr size_t WS_AO   = WS_BIG + 96 * MiB;
constexpr size_t WS_Y1B  = WS_BIG + 128 * MiB;
constexpr size_t WS_W     = WS_BIG + 400 * MiB;
constexpr size_t WS_WGU   = WS_W;
constexpr size_t WS_WDN   = WS_WGU + (size_t)65 * 512 * 1024 * 2;
constexpr size_t WS_WRKV  = WS_WDN + (size_t)65 * 1024 * 256 * 2;
constexpr size_t WS_WO    = WS_WRKV + (size_t)3072 * 1024 * 2;
constexpr size_t WS_WQKV  = WS_WO + (size_t)1024 * 1024 * 2;
constexpr size_t WS_WSBO  = WS_WQKV + (size_t)3072 * 1024 * 2;
constexpr size_t WS_WLDN  = WS_WSBO + (size_t)1024 * 1024 * 2;
constexpr size_t WS_WLUP  = WS_WLDN + (size_t)256 * 1024 * 2;
constexpr size_t WS_WRT   = WS_WLUP + (size_t)1024 * 256 * 2;
constexpr size_t WS_END   = WS_WRT + (size_t)2 * 64 * 3072 * 2;

constexpr int CW_BAR = 0;
constexpr int CW_CNT = 4096;

#define XB_TMO      128
#define XB_XCNT(j)  (256  + 64 * (j))
#define XB_XSUB(j)  (1280 + 64 * (j))
#define XB_XGEN(j)  (2304 + 64 * (j))
#define XB_TOP      3328
#define XB_TOPGEN   3392
#define XCD_BAR_WORDS 3456
#define XB_SPIN_CAP (1u << 22)
#define LAS __attribute__((address_space(3)))

__device__ __forceinline__ unsigned xb_ld(unsigned* p)              { return __hip_atomic_load(p, __ATOMIC_RELAXED, __HIP_MEMORY_SCOPE_AGENT); }
__device__ __forceinline__ unsigned xb_add(unsigned* p, unsigned v) { return __hip_atomic_fetch_add(p, v, __ATOMIC_RELAXED, __HIP_MEMORY_SCOPE_AGENT); }
__device__ __forceinline__ unsigned xb_xcc_id() { return (unsigned)__builtin_amdgcn_s_getreg((3 << 11) | 20) & 0xFu; }
#define XB_SPIN(cond, bar) do { unsigned _sp = 0; while (cond) { __builtin_amdgcn_s_sleep(1); \
    if ((++_sp & 255u) == 0u) { if (xb_ld(&(bar)[XB_TMO])) break; if (_sp > XB_SPIN_CAP) { atomicAdd(&(bar)[XB_TMO], 1u); break; } } } } while (0)

struct XcdBarrier { unsigned* bar; unsigned x; volatile LAS unsigned* st; };

__device__ __forceinline__ XcdBarrier xcd_barrier_post(unsigned* bar, volatile LAS unsigned* st) {
    XcdBarrier b; b.bar = bar; b.x = xb_xcc_id(); b.st = st;
    if (threadIdx.x == 0) (void)xb_add(&bar[XB_XCNT(b.x)], 1u);
    return b;
}
__device__ __forceinline__ void xcd_barrier_complete(unsigned* bar, unsigned x, unsigned& nloc, unsigned& nx) {
    const unsigned G = gridDim.x * gridDim.y * gridDim.z;
    unsigned sum, cnt, mine, sp = 0u;
    for (;;) {
        sum = 0u; cnt = 0u; mine = 0u;
#pragma unroll
        for (unsigned j = 0; j < 16; ++j) { const unsigned c = xb_ld(&bar[XB_XCNT(j)]); sum += c; cnt += (c > 0u) ? 1u : 0u; mine = (j == x) ? c : mine; }
        if (sum == G) break;
        __builtin_amdgcn_s_sleep(1);
        if ((++sp & 255u) == 0u) { if (xb_ld(&bar[XB_TMO])) break; if (sp > XB_SPIN_CAP) { atomicAdd(&bar[XB_TMO], 1u); break; } }
    }
    nloc = mine > 0u ? mine : 1u; nx = cnt > 0u ? cnt : 1u;
}
__device__ __forceinline__ void xcd_barrier(const XcdBarrier& b) {
    asm volatile("s_waitcnt vmcnt(0)" ::: "memory");
    __syncthreads();
    if (threadIdx.x == 0) {
        unsigned* bar = b.bar;
        __builtin_amdgcn_s_waitcnt(0);
        unsigned nloc = b.st[0], nx = b.st[1];
        if (nloc == 0u) { xcd_barrier_complete(bar, b.x, nloc, nx); b.st[0] = nloc; b.st[1] = nx; }
        const unsigned old = xb_add(&bar[XB_XSUB(b.x)], 1u);
        const unsigned gen = old / nloc;
        if (old + 1u == (gen + 1u) * nloc) {
            __builtin_amdgcn_fence(__ATOMIC_RELEASE, "agent");
            asm volatile("s_waitcnt vmcnt(0)" ::: "memory");
            const unsigned og = xb_add(&bar[XB_TOP], 1u);
            const unsigned tg = og / nx;
            if (og + 1u == (tg + 1u) * nx) xb_add(&bar[XB_TOPGEN], 1u);
            else XB_SPIN(xb_ld(&bar[XB_TOPGEN]) == tg, bar);
            __builtin_amdgcn_fence(__ATOMIC_ACQUIRE, "agent");
            xb_add(&bar[XB_XGEN(b.x)], 1u);
            asm volatile("s_waitcnt vmcnt(0)" ::: "memory");
        } else {
            XB_SPIN(xb_ld(&bar[XB_XGEN(b.x)]) == gen, bar);
            __builtin_amdgcn_fence(__ATOMIC_ACQUIRE, "agent");
            asm volatile("s_waitcnt vmcnt(0)" ::: "memory");
        }
    }
    __syncthreads();
}

struct Args { const float* in[34]; float* out; unsigned char* ws; int ph_lo, ph_hi; };

struct Frame {
    const float* const* in; float* out; unsigned char* ws; unsigned* ctl;
    float* ldsf; LAS unsigned char* lds; int tid, lane, wave, bid, G;
};

enum { I_X = 0, I_C, I_ADAW, I_ADAB, I_NPM, I_NPOM, I_NPF, I_NPOF, I_MU, I_WRKV, I_WW1, I_WW2, I_W0, I_WA1, I_WA2, I_A0, I_WG1, I_WG2,
       I_KK, I_KA, I_RK, I_LNG, I_LNB, I_WO, I_SBQKV, I_SBO, I_ROUTER, I_RBIAS, I_MG, I_MU_, I_MD, I_SG, I_SU, I_SD };

template <class AF, class BF>
__device__ __forceinline__ void simt_tile(float (&acc)[4][4], const AF& af, const BF& bfn, int row0, int col0, int K, float* sm) {
    float* sA = sm; float* sB = sm + 16 * 132;
    const int tid = threadIdx.x, ty = tid >> 4, tx = tid & 15;
#pragma unroll
    for (int i = 0; i < 4; ++i)
#pragma unroll
        for (int j = 0; j < 4; ++j) acc[i][j] = 0.f;
    for (int k0 = 0; k0 < K; k0 += 16) {
#pragma unroll
        for (int q = 0; q < 4; ++q) { const int idx = tid + 512 * q, r = idx >> 4, kk = idx & 15; sA[kk * 132 + r] = af(row0 + r, k0 + kk); }
#pragma unroll
        for (int q = 0; q < 2; ++q) { const int idx = tid + 512 * q, kk = idx >> 6, c = idx & 63; sB[kk * 68 + c] = bfn(k0 + kk, col0 + c); }
        __syncthreads();
#pragma unroll
        for (int kk = 0; kk < 16; ++kk) {
            const f32x4 a = *(const f32x4*)&sA[kk * 132 + ty * 4];
            const f32x4 b = *(const f32x4*)&sB[kk * 68 + tx * 4];
#pragma unroll
            for (int i = 0; i < 4; ++i)
#pragma unroll
                for (int j = 0; j < 4; ++j) acc[i][j] += a[i] * b[j];
        }
        __syncthreads();
    }
}

typedef short bf16x8 __attribute__((ext_vector_type(8)));
constexpr int HTB = 128 * 64 * 2;
__device__ __forceinline__ int lds_byte(int r, int c) { const int st = (r >> 4) * 2 + (c >> 5), rr = r & 15, cc = c & 31, ob = rr * 64 + cc * 2; return st * 1024 + (ob ^ (((ob >> 9) & 1) << 5)); }
__device__ __forceinline__ void stage_rc(int b, int& R, int& C) { const int st = b / 1024, sb = b % 1024, swz = sb ^ (((sb >> 9) & 1) << 5); R = (st >> 1) * 16 + swz / 64; C = (st & 1) * 32 + (swz % 64) / 2; }
#define WAIT_V(n) asm volatile("s_waitcnt vmcnt(" #n ")" ::: "memory")
#define SBAR() do { asm volatile("" ::: "memory"); __builtin_amdgcn_s_barrier(); asm volatile("" ::: "memory"); } while (0)

struct ASeg { const bf16_t* p[3]; int segTiles; };

template <int BN, bool NSW = false, class ARow, class Epi>
__device__ __forceinline__ void sg_tile(LAS unsigned char* lds, const ASeg& A, const ARow& arow, const bf16_t* Bt, int ldb, int nt, const Epi& epi) {
    constexpr int WN = BN / 64, WM = 8 / WN, WR = 256 / WM, MT = WR / 16;
    const int tid = threadIdx.x, wid = __builtin_amdgcn_readfirstlane(tid >> 6), lane = tid & 63, fr = lane & 15, fq = lane >> 4;
    const int wm = wid / WN, wn = wid % WN;
    unsigned aoffs[2][2], boffs[2];
#pragma unroll
    for (int i = 0; i < 2; ++i) { int R, C; stage_rc(tid * 16 + i * 8192, R, C);
        aoffs[0][i] = arow(R) + (unsigned)C * 2u; aoffs[1][i] = arow(128 + R) + (unsigned)C * 2u; boffs[i] = (unsigned)(R * ldb + C) * 2u; }
    const unsigned ldsw = (unsigned)wid * 1024u;
    f32x4 acc[MT][4];
#pragma unroll
    for (int m = 0; m < MT; ++m)
#pragma unroll
        for (int n = 0; n < 4; ++n) acc[m][n] = (f32x4){0.f, 0.f, 0.f, 0.f};
    const int arow0 = wm * WR, ah = arow0 >> 7, ar = arow0 & 127;
    const int aoff = ah * HTB + lds_byte(ar + fr, fq * 8), boff = 2 * HTB + lds_byte(wn * 64 + fr, fq * 8);
#define SG_STAGE(kt, s) do { const int sg_ = (kt) / A.segTiles; const char* ab_ = (const char*)(sg_ == 0 ? A.p[0] : (sg_ == 1 ? A.p[1] : A.p[2])) + (size_t)((kt) - sg_ * A.segTiles) * 128; const char* bb_ = (const char*)Bt + (size_t)(kt) * 128; \
        _Pragma("unroll") for (int h_ = 0; h_ < 2; ++h_) _Pragma("unroll") for (int i_ = 0; i_ < 2; ++i_) \
            __builtin_amdgcn_global_load_lds((const unsigned*)(ab_ + aoffs[h_][i_]), (LAS unsigned*)(lds + ((s) * 3 + h_) * HTB + ldsw + i_ * 8192), 16, 0, 0); \
        _Pragma("unroll") for (int i_ = 0; i_ < WN; ++i_) \
            __builtin_amdgcn_global_load_lds((const unsigned*)(bb_ + boffs[i_]), (LAS unsigned*)(lds + ((s) * 3 + 2) * HTB + ldsw + i_ * 8192), 16, 0, 0); } while (0)
    SG_STAGE(0, 0);
    for (int t = 0; t < nt; ++t) {
        const int s = t & 1;
        if (t + 1 < nt) { SG_STAGE(t + 1, s ^ 1); if (WN == 2) WAIT_V(6); else WAIT_V(5); } else { WAIT_V(0); }
        SBAR();
        LAS unsigned char* base = lds + s * 3 * HTB;
#pragma unroll
        for (int k = 0; k < 2; ++k) {
            bf16x8 af[MT], bfr[4];
#pragma unroll
            for (int m = 0; m < MT; ++m) af[m] = *(const LAS bf16x8*)(base + aoff + m * 2048 + k * 1024);
#pragma unroll
            for (int n = 0; n < 4; ++n) bfr[n] = *(const LAS bf16x8*)(base + boff + n * 2048 + k * 1024);
#pragma unroll
            for (int m = 0; m < MT; ++m)
#pragma unroll
                for (int n = 0; n < 4; ++n) acc[m][n] = NSW ? __builtin_amdgcn_mfma_f32_16x16x32_bf16(af[m], bfr[n], acc[m][n], 0, 0, 0) : __builtin_amdgcn_mfma_f32_16x16x32_bf16(bfr[n], af[m], acc[m][n], 0, 0, 0);
        }
        SBAR();
    }
#undef SG_STAGE
    epi(acc, arow0, wn * 64, fr, fq);
}

__device__ __forceinline__ void conv_unit(const Frame& F, bf16_t* dst, int dstK, const float* src, int sld) {
    float* tl = F.ldsf;
#pragma unroll
    for (int q = 0; q < 16; ++q) { const int idx = F.tid + 512 * q, kk = idx >> 5, nn = idx & 31; tl[kk * 33 + nn] = src[(size_t)kk * sld + nn]; }
    __syncthreads();
    const int nn = F.tid >> 4, ks = (F.tid & 15) * 16;
    u32x4 a, b;
#pragma unroll
    for (int q = 0; q < 4; ++q) { a[q] = pack2(tl[(ks + 2 * q) * 33 + nn], tl[(ks + 2 * q + 1) * 33 + nn]); b[q] = pack2(tl[(ks + 8 + 2 * q) * 33 + nn], tl[(ks + 9 + 2 * q) * 33 + nn]); }
    *(u32x4*)(dst + (size_t)nn * dstK + ks) = a; *(u32x4*)(dst + (size_t)nn * dstK + ks + 8) = b;
    __syncthreads();
}
__device__ __forceinline__ void conv_moe(const Frame& F, int layer, int u0, int ustride) {
    bf16_t* WGU = (bf16_t*)(F.ws + WS_WGU); bf16_t* WDN = (bf16_t*)(F.ws + WS_WDN);
    const int nGU = 65 * 16 * 4, nDN = 65 * 32;
    for (int u = u0; u < nGU + nDN; u += ustride) {
        if (u < nGU) {
            const int e = u / 64, r = u % 64, rb = r / 4, kc = r % 4, blk = rb >> 1, up = rb & 1;
            const float* W = (e < 64) ? (up ? F.in[I_MU_] : F.in[I_MG]) + ((size_t)layer * NE + e) * D * DE : (up ? F.in[I_SU] : F.in[I_SG]) + (size_t)layer * D * DE;
            conv_unit(F, WGU + ((size_t)e * 512 + rb * 32) * D + kc * 256, D, W + (size_t)(kc * 256) * DE + blk * 32, DE);
        } else {
            const int v = u - nGU, e = v / 32, rb = v % 32;
            const float* W = (e < 64) ? F.in[I_MD] + ((size_t)layer * NE + e) * DE * D : F.in[I_SD] + (size_t)layer * DE * D;
            conv_unit(F, WDN + ((size_t)e * D + rb * 32) * DE, DE, W + rb * 32, D);
        }
    }
}
__device__ __forceinline__ void conv_dense(const Frame& F, int u0, int ustride) {
    bf16_t* WRKV = (bf16_t*)(F.ws + WS_WRKV); bf16_t* WO = (bf16_t*)(F.ws + WS_WO); bf16_t* WQKV = (bf16_t*)(F.ws + WS_WQKV); bf16_t* WSBO = (bf16_t*)(F.ws + WS_WSBO); bf16_t* WLDN = (bf16_t*)(F.ws + WS_WLDN);
    const int n0 = 96 * 4, n1 = n0 + 32 * 4, n2 = n1 + 96 * 4, n3 = n2 + 32 * 4, n4 = n3 + 8 * 4;
    for (int u = u0; u < n4; u += ustride) {
        if (u < n0) { const int rb = u / 4, kc = u % 4, n = rb / 32, c0 = (rb % 32) * 32; conv_unit(F, WRKV + (size_t)rb * 32 * D + kc * 256, D, F.in[I_WRKV] + (size_t)n * D * D + (size_t)kc * 256 * D + c0, D); }
        else if (u < n1) { const int v = u - n0, rb = v / 4, kc = v % 4; conv_unit(F, WO + (size_t)rb * 32 * D + kc * 256, D, F.in[I_WO] + (size_t)kc * 256 * D + rb * 32, D); }
        else if (u < n2) { const int v = u - n1, rb = v / 4, kc = v % 4; conv_unit(F, WQKV + (size_t)rb * 32 * D + kc * 256, D, F.in[I_SBQKV] + (size_t)kc * 256 * 3 * D + rb * 32, 3 * D); }
        else if (u < n3) { const int v = u - n2, rb = v / 4, kc = v % 4; conv_unit(F, WSBO + (size_t)rb * 32 * D + kc * 256, D, F.in[I_SBO] + (size_t)kc * 256 * D + rb * 32, D); }
        else { const int v = u - n3, rb = v / 4, kc = v % 4;
            const float* src = rb < 2 ? F.in[I_WW1] + (size_t)kc * 256 * 64 + rb * 32 : (rb < 4 ? F.in[I_WA1] + (size_t)kc * 256 * 64 + (rb - 2) * 32 : F.in[I_WG1] + (size_t)kc * 256 * 128 + (rb - 4) * 32);
            conv_unit(F, WLDN + (size_t)rb * 32 * D + kc * 256, D, src, rb < 4 ? 64 : 128); }
    }
    bf16_t* WLUP = (bf16_t*)(F.ws + WS_WLUP); bf16_t* WRT = (bf16_t*)(F.ws + WS_WRT);
    const int gtid = u0 * NTHREADS + F.tid, gstride = ustride * NTHREADS;
    for (int i = gtid; i < 1024 * 256; i += gstride) {
        float v;
        if (i < 1024 * 64) { const int n = i / 64, k = i % 64; v = F.in[I_WW2][k * D + n]; }
        else if (i < 2 * 1024 * 64) { const int j = i - 1024 * 64, n = j / 64, k = j % 64; v = F.in[I_WA2][k * D + n]; }
        else { const int j = i - 2 * 1024 * 64, n = j / 128, k = j % 128; v = F.in[I_WG2][k * D + n]; }
        WLUP[i] = f2bf(v);
    }
    for (int i = gtid; i < 2 * 64 * 1024; i += gstride) {
        const int l = i / (64 * 1024), j = i % (64 * 1024), e = j / 1024, k = j % 1024;
        const float w = F.in[I_ROUTER][((size_t)l * D + k) * NE + e]; const bf16_t hi = f2bf(w), lo = f2bf(w - bf2f(hi));
        bf16_t* row = WRT + ((size_t)l * 64 + e) * 3072; row[k] = hi; row[1024 + k] = lo; row[2048 + k] = hi;
    }
}

__device__ __forceinline__ void ph_mod(const Frame& F) {
    const float* c = F.in[I_C]; const float* W = F.in[I_ADAW]; const float* bias = F.in[I_ADAB];
    float* MOD = (float*)(F.ws + WS_MOD);
    float* red = F.ldsf;
    for (int u = F.bid; u < 192; u += F.G) {
        const int l = u / 96, cg = u % 96, col = cg * 64 + F.lane;
        float s0 = 0.f, s1 = 0.f;
        const float* wp = W + ((size_t)l * D + F.wave * 128) * 6144 + col;
        for (int d = 0; d < 128; ++d) {
            const int dd = F.wave * 128 + d;
            const float c0 = c[dd], c1 = c[D + dd];
            const float w = wp[(size_t)d * 6144];
            s0 += (c0 * sigmoidf_(c0)) * w; s1 += (c1 * sigmoidf_(c1)) * w;
        }
        red[(F.wave * 2 + 0) * 64 + F.lane] = s0; red[(F.wave * 2 + 1) * 64 + F.lane] = s1;
        __syncthreads();
        if (F.tid < 128) {
            const int b = F.tid >> 6, cc = F.tid & 63; float s = 0.f;
#pragma unroll
            for (int w = 0; w < 8; ++w) s += red[(w * 2 + b) * 64 + cc];
            MOD[(l * 2 + b) * 6144 + cg * 64 + cc] = s + bias[l * 6144 + cg * 64 + cc];
        }
        __syncthreads();
    }
}

__device__ __forceinline__ void ph_prenorm_rwkv(const Frame& F) {
    const float* x = F.in[I_X]; const float* g = F.in[I_NPM]; const float* mu = F.in[I_MU];
    const float* MOD = (const float*)(F.ws + WS_MOD);
    bf16_t* XS = (bf16_t*)(F.ws + WS_XS);
    const int nunits = T / 8;
    for (int u = F.bid * NWAVES + F.wave; u < nunits; u += F.G * NWAVES) {
        const int t0 = u * 8, b = t0 / SEQ;
        const float* shift = MOD + (0 * 2 + b) * 6144; const float* scale = shift + 1024;
        f32x4 gm[4], sh[4];
#pragma unroll
        for (int i = 0; i < 4; ++i) { const int c = 4 * F.lane + 256 * i; const f32x4 gv = *(const f32x4*)(g + c), sc = *(const f32x4*)(scale + c); gm[i] = gv * (sc + 1.0f); sh[i] = *(const f32x4*)(shift + c); }
        f32x4 hp[4];
#pragma unroll
        for (int i = 0; i < 4; ++i) hp[i] = (f32x4){0.f, 0.f, 0.f, 0.f};
        const int tstart = (t0 % SEQ == 0) ? t0 : t0 - 1;
        for (int t = tstart; t < t0 + 8; ++t) {
            f32x4 xv[4]; float ss = 0.f;
#pragma unroll
            for (int i = 0; i < 4; ++i) { xv[i] = *(const f32x4*)(x + (size_t)t * D + 4 * F.lane + 256 * i); ss += xv[i][0] * xv[i][0] + xv[i][1] * xv[i][1] + xv[i][2] * xv[i][2] + xv[i][3] * xv[i][3]; }
            ss = wave_sum(ss);
            const float rs = rsqrtf(ss * (1.0f / D) + 1e-6f);
            f32x4 h[4];
#pragma unroll
            for (int i = 0; i < 4; ++i) h[i] = xv[i] * rs * gm[i] + sh[i];
            if (t >= t0) {
#pragma unroll
                for (int n = 0; n < 6; ++n) {
#pragma unroll
                    for (int i = 0; i < 4; ++i) {
                        const int c = 4 * F.lane + 256 * i;
                        const f32x4 m = *(const f32x4*)(mu + n * D + c);
                        const f32x4 v = h[i] + (hp[i] - h[i]) * m;
                        u32x2 w; w.x = pack2(v[0], v[1]); w.y = pack2(v[2], v[3]);
                        *(u32x2*)(XS + ((size_t)n * T + t) * D + c) = w;
                    }
                }
            }
#pragma unroll
            for (int i = 0; i < 4; ++i) hp[i] = h[i];
        }
    }
}

__device__ __forceinline__ void ph_rkv_lora_simt(const Frame& F) {
    const bf16_t* XS = (const bf16_t*)(F.ws + WS_XS);
    bf16_t* RKV = (bf16_t*)(F.ws + WS_RKV); bf16_t* LORA = (bf16_t*)(F.ws + WS_LORA);
    const int nct = 52, nunits = (T / 128) * nct;
    for (int u = F.bid; u < nunits; u += F.G) {
        const int rt = u / nct, ct = u % nct, row0 = rt * 128;
        float acc[4][4];
        const int ty = F.tid >> 4, tx = F.tid & 15;
        if (ct < 48) {
            const int n = ct / 16, col0 = (ct % 16) * 64;
            const bf16_t* A = XS + (size_t)n * T * D; const float* W = F.in[I_WRKV] + (size_t)n * D * D;
            simt_tile(acc, [&](int r, int k) { return bf2f(A[(size_t)r * D + k]); }, [&](int k, int c) { return W[(size_t)k * D + c]; }, row0, col0, D, F.ldsf);
#pragma unroll
            for (int i = 0; i < 4; ++i) { u32x2 w; w.x = pack2(acc[i][0], acc[i][1]); w.y = pack2(acc[i][2], acc[i][3]);
                *(u32x2*)(RKV + ((size_t)n * T + row0 + ty * 4 + i) * D + col0 + tx * 4) = w; }
        } else {
            const int j = ct - 48;
            const int n = (j == 0) ? 3 : (j == 1 ? 4 : 5);
            const bf16_t* A = XS + (size_t)n * T * D;
            const float* W = (j == 0) ? F.in[I_WW1] : (j == 1 ? F.in[I_WA1] : F.in[I_WG1]);
            const int ldw = (j >= 2) ? 128 : 64, coff = (j == 3) ? 64 : 0;
            simt_tile(acc, [&](int r, int k) { return bf2f(A[(size_t)r * D + k]); }, [&](int k, int c) { return W[(size_t)k * ldw + coff + c]; }, row0, 0, D, F.ldsf);
#pragma unroll
            for (int i = 0; i < 4; ++i) {
                float v[4];
#pragma unroll
                for (int q = 0; q < 4; ++q) { const float a = acc[i][q]; v[q] = (j == 0) ? tanhf(a) : (j == 1 ? a : sigmoidf_(a)); }
                u32x2 w; w.x = pack2(v[0], v[1]); w.y = pack2(v[2], v[3]);
                *(u32x2*)(LORA + (size_t)(row0 + ty * 4 + i) * 256 + j * 64 + tx * 4) = w;
            }
        }
    }
}

__device__ __forceinline__ void ph_lora_up_simt(const Frame& F) {
    const bf16_t* LORA = (const bf16_t*)(F.ws + WS_LORA);
    float* LD = (float*)(F.ws + WS_LD); bf16_t* AA = (bf16_t*)(F.ws + WS_AA); bf16_t* GG = (bf16_t*)(F.ws + WS_GG);
    const int nunits = (T / 128) * 48;
    for (int u = F.bid; u < nunits; u += F.G) {
        const int rt = u / 48, ct = u % 48, row0 = rt * 128, which = ct / 16, col0 = (ct % 16) * 64;
        const int ty = F.tid >> 4, tx = F.tid & 15;
        float acc[4][4];
        const float* W = which == 0 ? F.in[I_WW2] : (which == 1 ? F.in[I_WA2] : F.in[I_WG2]);
        const int K = which == 2 ? 128 : 64, koff = which * 64;
        simt_tile(acc, [&](int r, int k) { return bf2f(LORA[(size_t)r * 256 + koff + k]); }, [&](int k, int c) { return W[(size_t)k * D + c]; }, row0, col0, K, F.ldsf);
#pragma unroll
        for (int i = 0; i < 4; ++i) {
            const size_t o = (size_t)(row0 + ty * 4 + i) * D + col0 + tx * 4;
            if (which == 0) {
                f32x4 v;
#pragma unroll
                for (int q = 0; q < 4; ++q) { const float wl = F.in[I_W0][col0 + tx * 4 + q] + acc[i][q]; const float wlog = -softplusf_(-wl) - 0.5f; v[q] = -__expf(wlog); }
                *(f32x4*)(LD + o) = v;
            } else if (which == 1) {
                float v[4];
#pragma unroll
                for (int q = 0; q < 4; ++q) v[q] = sigmoidf_(F.in[I_A0][col0 + tx * 4 + q] + acc[i][q]);
                u32x2 w; w.x = pack2(v[0], v[1]); w.y = pack2(v[2], v[3]); *(u32x2*)(AA + o) = w;
            } else {
                u32x2 w; w.x = pack2(acc[i][0], acc[i][1]); w.y = pack2(acc[i][2], acc[i][3]); *(u32x2*)(GG + o) = w;
            }
        }
    }
}

__device__ __forceinline__ void ph_wkv_seq(const Frame& F) {
    const bf16_t* RKV = (const bf16_t*)(F.ws + WS_RKV); const float* LD = (const float*)(F.ws + WS_LD); const bf16_t* AA = (const bf16_t*)(F.ws + WS_AA);
    float* O = (float*)(F.ws + WS_O);
    const bf16_t* Rb = RKV; const bf16_t* Kb = RKV + (size_t)T * D; const bf16_t* Vb = RKV + (size_t)2 * T * D;
    for (int u = F.bid; u < NB * NH; u += F.G) {
        const int b = u / NH, h = u % NH, i = F.tid >> 3, js = F.tid & 7;
        const int cj = h * 64 + js * 8;
        float kkw[8], kaw[8];
#pragma unroll
        for (int e = 0; e < 8; ++e) { kkw[e] = F.in[I_KK][cj + e]; kaw[e] = F.in[I_KA][cj + e]; }
        float S[8];
#pragma unroll
        for (int e = 0; e < 8; ++e) S[e] = 0.f;
        size_t base = (size_t)(b * SEQ) * D;
        u32x4 kr = *(const u32x4*)(Kb + base + cj), rr = *(const u32x4*)(Rb + base + cj), ar = *(const u32x4*)(AA + base + cj);
        f32x4 l0 = *(const f32x4*)(LD + base + cj), l1 = *(const f32x4*)(LD + base + cj + 4);
        bf16_t vr = Vb[base + h * 64 + i];
        for (int t = 0; t < SEQ; ++t) {
            const u32x4 kc = kr, rc = rr, ac = ar; const f32x4 lc0 = l0, lc1 = l1; const bf16_t vc = vr;
            if (t + 1 < SEQ) { const size_t nb = base + D;
                kr = *(const u32x4*)(Kb + nb + cj); rr = *(const u32x4*)(Rb + nb + cj); ar = *(const u32x4*)(AA + nb + cj);
                l0 = *(const f32x4*)(LD + nb + cj); l1 = *(const f32x4*)(LD + nb + cj + 4); vr = Vb[nb + h * 64 + i]; }
            float k[8], r[8], a[8], ld[8];
#pragma unroll
            for (int q = 0; q < 4; ++q) { k[2 * q] = lo2f(kc[q]); k[2 * q + 1] = hi2f(kc[q]); r[2 * q] = lo2f(rc[q]); r[2 * q + 1] = hi2f(rc[q]); a[2 * q] = lo2f(ac[q]); a[2 * q + 1] = hi2f(ac[q]); }
#pragma unroll
            for (int q = 0; q < 4; ++q) { ld[q] = lc0[q]; ld[4 + q] = lc1[q]; }
            const float v = bf2f(vc);
            float kkv[8], ss = 0.f;
#pragma unroll
            for (int e = 0; e < 8; ++e) { kkv[e] = k[e] * kkw[e]; ss += kkv[e] * kkv[e]; }
            ss += __shfl_xor(ss, 1); ss += __shfl_xor(ss, 2); ss += __shfl_xor(ss, 4);
            const float inv = 1.0f / fmaxf(sqrtf(ss), 1e-12f);
            float sa = 0.f;
#pragma unroll
            for (int e = 0; e < 8; ++e) { kkv[e] *= inv; sa += S[e] * (-kkv[e]); }
            sa += __shfl_xor(sa, 1); sa += __shfl_xor(sa, 2); sa += __shfl_xor(sa, 4);
            float o = 0.f;
#pragma unroll
            for (int e = 0; e < 8; ++e) {
                const float kf = k[e] * (1.0f + (a[e] - 1.0f) * kaw[e]);
                S[e] = S[e] * __expf(ld[e]) + sa * (kkv[e] * a[e]) + v * kf;
                o += S[e] * r[e];
            }
            o += __shfl_xor(o, 1); o += __shfl_xor(o, 2); o += __shfl_xor(o, 4);
            if (js == 0) O[base + h * 64 + i] = o;
            base += D;
        }
    }
}

__device__ __forceinline__ void ld16bf(const bf16_t* p, float (&v)[16]) {
    const u32x4 a = *(const u32x4*)p, b = *(const u32x4*)(p + 8);
#pragma unroll
    for (int q = 0; q < 4; ++q) { v[2 * q] = lo2f(a[q]); v[2 * q + 1] = hi2f(a[q]); v[8 + 2 * q] = lo2f(b[q]); v[9 + 2 * q] = hi2f(b[q]); }
}
__device__ __forceinline__ void st16bf(bf16_t* p, const float (&v)[16]) {
    u32x4 a, b;
#pragma unroll
    for (int q = 0; q < 4; ++q) { a[q] = pack2(v[2 * q], v[2 * q + 1]); b[q] = pack2(v[8 + 2 * q], v[9 + 2 * q]); }
    *(u32x4*)p = a; *(u32x4*)(p + 8) = b;
}
__device__ __forceinline__ void ld16f(const float* p, float (&v)[16]) {
#pragma unroll
    for (int q = 0; q < 4; ++q) { const f32x4 a = *(const f32x4*)(p + 4 * q); v[4 * q] = a[0]; v[4 * q + 1] = a[1]; v[4 * q + 2] = a[2]; v[4 * q + 3] = a[3]; }
}
__device__ __forceinline__ void ph_wkv_post(const Frame& F) {
    const bf16_t* RKV = (const bf16_t*)(F.ws + WS_RKV); const bf16_t* AA = (const bf16_t*)(F.ws + WS_AA); const bf16_t* GG = (const bf16_t*)(F.ws + WS_GG);
    const float* O = (const float*)(F.ws + WS_O); bf16_t* OG = (bf16_t*)(F.ws + WS_OG);
    const int c0 = 16 * F.lane;
    float ka[16], rk[16], lg[16], lb[16];
    ld16f(F.in[I_KA] + c0, ka); ld16f(F.in[I_RK] + c0, rk); ld16f(F.in[I_LNG] + c0, lg); ld16f(F.in[I_LNB] + c0, lb);
    for (int t = F.bid * NWAVES + F.wave; t < T; t += F.G * NWAVES) {
        const size_t o = (size_t)t * D + c0;
        float ov[16], r[16], k[16], v[16], a[16], g[16];
        ld16f(O + o, ov); ld16bf(RKV + o, r); ld16bf(RKV + (size_t)T * D + o, k); ld16bf(RKV + (size_t)2 * T * D + o, v); ld16bf(AA + o, a); ld16bf(GG + o, g);
        float s = 0.f, bs = 0.f;
#pragma unroll
        for (int e = 0; e < 16; ++e) { s += ov[e]; const float kf = k[e] * (1.0f + (a[e] - 1.0f) * ka[e]); bs += r[e] * kf * rk[e]; }
        s += __shfl_xor(s, 1); s += __shfl_xor(s, 2); bs += __shfl_xor(bs, 1); bs += __shfl_xor(bs, 2);
        const float mean = s * (1.0f / 64.0f);
        float q = 0.f;
#pragma unroll
        for (int e = 0; e < 16; ++e) { const float d = ov[e] - mean; q += d * d; }
        q += __shfl_xor(q, 1); q += __shfl_xor(q, 2);
        const float rstd = rsqrtf(q * (1.0f / 64.0f) + 64e-5f);
        float res[16];
#pragma unroll
        for (int e = 0; e < 16; ++e) res[e] = (((ov[e] - mean) * rstd) * lg[e] + lb[e] + bs * v[e]) * g[e];
        st16bf(OG + o, res);
    }
}

template <int OUTMODE>
__device__ __forceinline__ void ph_dense_simt(const Frame& F, const bf16_t* A, const float* W, int N, int K, void* out) {
    const int nct = N / 64, nunits = (T / 128) * nct;
    for (int u = F.bid; u < nunits; u += F.G) {
        const int rt = u / nct, ct = u % nct, row0 = rt * 128, col0 = ct * 64;
        const int ty = F.tid >> 4, tx = F.tid & 15;
        float acc[4][4];
        simt_tile(acc, [&](int r, int k) { return bf2f(A[(size_t)r * K + k]); }, [&](int k, int c) { return W[(size_t)k * N + c]; }, row0, col0, K, F.ldsf);
#pragma unroll
        for (int i = 0; i < 4; ++i) {
            const int r = row0 + ty * 4 + i, c = col0 + tx * 4;
            if (OUTMODE == 0) { *(f32x4*)((float*)out + (size_t)r * N + c) = (f32x4){acc[i][0], acc[i][1], acc[i][2], acc[i][3]}; }
            else { u32x2 w; w.x = pack2(acc[i][0], acc[i][1]); w.y = pack2(acc[i][2], acc[i][3]);
                   *(u32x2*)((bf16_t*)out + (size_t)(c / D) * T * D + (size_t)r * D + (c % D)) = w; }
        }
    }
}

__device__ __forceinline__ void ph_postmix_preffn(const Frame& F, int layer, const float* xin, const float* Y) {
    const float* MOD = (const float*)(F.ws + WS_MOD);
    const float* gpo = F.in[I_NPOM] + layer * D; const float* gpf = F.in[I_NPF] + layer * D;
    bf16_t* H2 = (bf16_t*)(F.ws + WS_H2); bf16_t* H2LO = (bf16_t*)(F.ws + WS_H2LO);
    for (int t = F.bid * NWAVES + F.wave; t < T; t += F.G * NWAVES) {
        const int b = t / SEQ; const float* m = MOD + (layer * 2 + b) * 6144;
        f32x4 y[4]; float ss = 0.f;
#pragma unroll
        for (int i = 0; i < 4; ++i) { y[i] = *(const f32x4*)(Y + (size_t)t * D + 4 * F.lane + 256 * i); ss += y[i][0] * y[i][0] + y[i][1] * y[i][1] + y[i][2] * y[i][2] + y[i][3] * y[i][3]; }
        ss = wave_sum(ss);
        const float rs = rsqrtf(ss * (1.0f / D) + 1e-6f);
        f32x4 x1[4]; float s2 = 0.f;
#pragma unroll
        for (int i = 0; i < 4; ++i) { const int c = 4 * F.lane + 256 * i;
            const f32x4 xv = *(const f32x4*)(xin + (size_t)t * D + c), gm = *(const f32x4*)(m + 2048 + c), gp = *(const f32x4*)(gpo + c);
            x1[i] = xv + gm * (y[i] * rs * gp);
            *(f32x4*)(F.out + (size_t)t * D + c) = x1[i];
            s2 += x1[i][0] * x1[i][0] + x1[i][1] * x1[i][1] + x1[i][2] * x1[i][2] + x1[i][3] * x1[i][3]; }
        s2 = wave_sum(s2);
        const float rs2 = rsqrtf(s2 * (1.0f / D) + 1e-6f);
#pragma unroll
        for (int i = 0; i < 4; ++i) { const int c = 4 * F.lane + 256 * i;
            const f32x4 gf = *(const f32x4*)(gpf + c), sc = *(const f32x4*)(m + 4096 + c), sh = *(const f32x4*)(m + 3072 + c);
            const f32x4 h = x1[i] * rs2 * gf * (sc + 1.0f) + sh;
            u32x2 w; w.x = pack2(h[0], h[1]); w.y = pack2(h[2], h[3]);
            u32x2 wl; wl.x = pack2(h[0] - lo2f(w.x), h[1] - hi2f(w.x)); wl.y = pack2(h[2] - lo2f(w.y), h[3] - hi2f(w.y));
            *(u32x2*)(H2 + (size_t)t * D + c) = w; *(u32x2*)(H2LO + (size_t)t * D + c) = wl; }
    }
}

__device__ __forceinline__ void ph_router_simt(const Frame& F, int layer) {
    const bf16_t* H2 = (const bf16_t*)(F.ws + WS_H2); const bf16_t* H2LO = (const bf16_t*)(F.ws + WS_H2LO);
    const float* W = F.in[I_ROUTER] + (size_t)layer * D * NE; float* LOG = (float*)(F.ws + WS_LOGITS);
    for (int u = F.bid; u < T / 128; u += F.G) {
        const int row0 = u * 128, ty = F.tid >> 4, tx = F.tid & 15;
        float acc[4][4];
        simt_tile(acc, [&](int r, int k) { return bf2f(H2[(size_t)r * D + k]) + bf2f(H2LO[(size_t)r * D + k]); }, [&](int k, int c) { return W[(size_t)k * NE + c]; }, row0, 0, D, F.ldsf);
#pragma unroll
        for (int i = 0; i < 4; ++i) *(f32x4*)(LOG + (size_t)(row0 + ty * 4 + i) * NE + tx * 4) = (f32x4){acc[i][0], acc[i][1], acc[i][2], acc[i][3]};
    }
}

__device__ __forceinline__ void ph_topk(const Frame& F, int layer) {
    const float* LOG = (const float*)(F.ws + WS_LOGITS); const float* rb = F.in[I_RBIAS] + layer * NE;
    int* IDX = (int*)(F.ws + WS_IDX); float* GATE = (float*)(F.ws + WS_GATE); int* RANK = (int*)(F.ws + WS_RANK);
    unsigned* CNT = F.ctl + CW_CNT + layer * 64;
    const float bias = rb[F.lane];
    for (int t = F.bid * NWAVES + F.wave; t < T; t += F.G * NWAVES) {
        const float s = sigmoidf_(LOG[(size_t)t * NE + F.lane]);
        float sel = s + bias;
        int myidx = -1; float mysc = 0.f; float tot = 0.f;
#pragma unroll
        for (int k = 0; k < TOPK; ++k) {
            float bv = sel; int bi = F.lane;
#pragma unroll
            for (int o = 32; o >= 1; o >>= 1) { const float ov = __shfl_xor(bv, o); const int oi = __shfl_xor(bi, o); if (ov > bv || (ov == bv && oi < bi)) { bv = ov; bi = oi; } }
            const float sc = __shfl(s, bi);
            tot += sc;
            if (F.lane == k) { myidx = bi; mysc = sc; }
            if (F.lane == bi) sel = -1e30f;
        }
        if (F.lane < TOPK) {
            IDX[t * TOPK + F.lane] = myidx; GATE[t * TOPK + F.lane] = 2.5f * mysc / tot;
            RANK[t * TOPK + F.lane] = (int)atomicAdd(&CNT[myidx], 1u);
        }
    }
}

__device__ __forceinline__ void ph_offsets(const Frame& F, int layer) {
    const unsigned* CNT = F.ctl + CW_CNT + layer * 64;
    const int* IDX = (const int*)(F.ws + WS_IDX); const int* RANK = (const int*)(F.ws + WS_RANK);
    int* POS = (int*)(F.ws + WS_POS); int* TOK = (int*)(F.ws + WS_TOK); int* TILEE = (int*)(F.ws + WS_TILEE); int* START = (int*)(F.ws + WS_START);
    int* sst = (int*)F.ldsf;
    if (F.tid == 0) { int acc = 0; for (int e = 0; e < NE; ++e) { const int c = (int)CNT[e]; sst[e] = acc; sst[128 + e] = c; acc += ((c + RP - 1) / RP) * RP; } sst[64] = acc; }
    __syncthreads();
    if (F.bid == 0) {
        if (F.tid <= 64) START[F.tid] = sst[F.tid];
        if (F.tid == 65) START[65] = sst[64];
        const int ntile = sst[64] / RP;
        for (int i = F.tid; i < ntile; i += NTHREADS) { int e = 0; while (e < 63 && sst[e + 1] <= i * RP) ++e; TILEE[i] = e; }
    }
    for (int s = F.bid * NTHREADS + F.tid; s < T * TOPK; s += F.G * NTHREADS) {
        const int e = IDX[s], p = sst[e] + RANK[s];
        POS[s] = p; TOK[p] = s / TOPK;
    }
    for (int s = F.bid * NTHREADS + F.tid; s < NE * RP; s += F.G * NTHREADS) {
        const int e = s / RP, r = s % RP, c = sst[128 + e];
        if (sst[e] + c + r < sst[e + 1]) TOK[sst[e] + c + r] = 0;
    }
    __syncthreads();
}

__device__ __forceinline__ void ph_gateup_simt(const Frame& F, int layer) {
    const bf16_t* H2 = (const bf16_t*)(F.ws + WS_H2); bf16_t* HB = (bf16_t*)(F.ws + WS_HB);
    const int* TOK = (const int*)(F.ws + WS_TOK); const int* TILEE = (const int*)(F.ws + WS_TILEE); const int* START = (const int*)(F.ws + WS_START);
    const int routed = START[65], nrt = (routed + T) / 128, nunits = nrt * 4;
    for (int u = F.bid; u < nunits; u += F.G) {
        const int rt = u / 4, ct = u % 4, row0 = rt * 128, col0 = ct * 64, ty = F.tid >> 4, tx = F.tid & 15;
        const bool sh = row0 >= routed; const int e = sh ? 0 : TILEE[row0 / RP];
        const float* Wg = sh ? F.in[I_SG] + (size_t)layer * D * DE : F.in[I_MG] + ((size_t)layer * NE + e) * D * DE;
        const float* Wu = sh ? F.in[I_SU] + (size_t)layer * D * DE : F.in[I_MU_] + ((size_t)layer * NE + e) * D * DE;
        auto af = [&](int r, int k) { const int tok = sh ? (r - routed) : TOK[r]; return bf2f(H2[(size_t)tok * D + k]); };
        float ag[4][4], au[4][4];
        simt_tile(ag, af, [&](int k, int c) { return Wg[(size_t)k * DE + c]; }, row0, col0, D, F.ldsf);
        simt_tile(au, af, [&](int k, int c) { return Wu[(size_t)k * DE + c]; }, row0, col0, D, F.ldsf);
#pragma unroll
        for (int i = 0; i < 4; ++i) { float v[4];
#pragma unroll
            for (int q = 0; q < 4; ++q) { const float g = ag[i][q]; v[q] = g * sigmoidf_(g) * au[i][q]; }
            u32x2 w; w.x = pack2(v[0], v[1]); w.y = pack2(v[2], v[3]);
            *(u32x2*)(HB + (size_t)(row0 + ty * 4 + i) * DE + col0 + tx * 4) = w; }
    }
}
__device__ __forceinline__ void ph_down_simt(const Frame& F, int layer) {
    const bf16_t* HB = (const bf16_t*)(F.ws + WS_HB); bf16_t* YB = (bf16_t*)(F.ws + WS_YB);
    const int* TILEE = (const int*)(F.ws + WS_TILEE); const int* START = (const int*)(F.ws + WS_START);
    const int routed = START[65], nrt = (routed + T) / 128, nunits = nrt * 16;
    for (int u = F.bid; u < nunits; u += F.G) {
        const int rt = u / 16, ct = u % 16, row0 = rt * 128, col0 = ct * 64, ty = F.tid >> 4, tx = F.tid & 15;
        const bool sh = row0 >= routed; const int e = sh ? 0 : TILEE[row0 / RP];
        const float* Wd = sh ? F.in[I_SD] + (size_t)layer * DE * D : F.in[I_MD] + ((size_t)layer * NE + e) * DE * D;
        float acc[4][4];
        simt_tile(acc, [&](int r, int k) { return bf2f(HB[(size_t)r * DE + k]); }, [&](int k, int c) { return Wd[(size_t)k * D + c]; }, row0, col0, DE, F.ldsf);
#pragma unroll
        for (int i = 0; i < 4; ++i) { u32x2 w; w.x = pack2(acc[i][0], acc[i][1]); w.y = pack2(acc[i][2], acc[i][3]);
            *(u32x2*)(YB + (size_t)(row0 + ty * 4 + i) * D + col0 + tx * 4) = w; }
    }
}
__device__ __forceinline__ void ph_combine(const Frame& F, int layer, bool next) {
    const bf16_t* YB = (const bf16_t*)(F.ws + WS_YB); const int* POS = (const int*)(F.ws + WS_POS); const float* GATE = (const float*)(F.ws + WS_GATE);
    const int* START = (const int*)(F.ws + WS_START); const float* MOD = (const float*)(F.ws + WS_MOD);
    const float* gpo = F.in[I_NPOF] + layer * D;
    bf16_t* H3 = (bf16_t*)(F.ws + WS_H3);
    const int routed = START[65];
    for (int t = F.bid * NWAVES + F.wave; t < T; t += F.G * NWAVES) {
        const int b = t / SEQ; const float* m = MOD + (layer * 2 + b) * 6144;
        f32x4 y[4];
#pragma unroll
        for (int i = 0; i < 4; ++i) { const u32x2 w = *(const u32x2*)(YB + (size_t)(routed + t) * D + 4 * F.lane + 256 * i); y[i] = (f32x4){lo2f(w.x), hi2f(w.x), lo2f(w.y), hi2f(w.y)}; }
#pragma unroll
        for (int k = 0; k < TOPK; ++k) {
            const int p = POS[t * TOPK + k]; const float gk = GATE[t * TOPK + k];
#pragma unroll
            for (int i = 0; i < 4; ++i) { const u32x2 w = *(const u32x2*)(YB + (size_t)p * D + 4 * F.lane + 256 * i); y[i] += (f32x4){lo2f(w.x), hi2f(w.x), lo2f(w.y), hi2f(w.y)} * gk; }
        }
        float ss = 0.f;
#pragma unroll
        for (int i = 0; i < 4; ++i) ss += y[i][0] * y[i][0] + y[i][1] * y[i][1] + y[i][2] * y[i][2] + y[i][3] * y[i][3];
        ss = wave_sum(ss);
        const float rs = rsqrtf(ss * (1.0f / D) + 1e-6f);
        f32x4 x2[4]; float s2 = 0.f;
#pragma unroll
        for (int i = 0; i < 4; ++i) { const int c = 4 * F.lane + 256 * i;
            const f32x4 xv = *(const f32x4*)(F.out + (size_t)t * D + c), gm = *(const f32x4*)(m + 5120 + c), gp = *(const f32x4*)(gpo + c);
            x2[i] = xv + gm * (y[i] * rs * gp);
            *(f32x4*)(F.out + (size_t)t * D + c) = x2[i];
            s2 += x2[i][0] * x2[i][0] + x2[i][1] * x2[i][1] + x2[i][2] * x2[i][2] + x2[i][3] * x2[i][3]; }
        if (next) {
            s2 = wave_sum(s2);
            const float rs2 = rsqrtf(s2 * (1.0f / D) + 1e-6f);
            const float* m1 = MOD + ((layer + 1) * 2 + b) * 6144; const float* g1 = F.in[I_NPM] + (layer + 1) * D;
#pragma unroll
            for (int i = 0; i < 4; ++i) { const int c = 4 * F.lane + 256 * i;
                const f32x4 gf = *(const f32x4*)(g1 + c), sc = *(const f32x4*)(m1 + 1024 + c), sh = *(const f32x4*)(m1 + c);
                const f32x4 h = x2[i] * rs2 * gf * (sc + 1.0f) + sh;
                u32x2 w; w.x = pack2(h[0], h[1]); w.y = pack2(h[2], h[3]);
                *(u32x2*)(H3 + (size_t)t * D + c) = w; }
        }
    }
}

#define SB_EXIT 110.0f
__device__ __forceinline__ void ph_attn_ref(const Frame& F) {
    const bf16_t* Q = (const bf16_t*)(F.ws + WS_Q); const bf16_t* Kb = Q + (size_t)T * D; const bf16_t* Vb = Q + (size_t)2 * T * D;
    bf16_t* AO = (bf16_t*)(F.ws + WS_AO);
    float* Ks = F.ldsf; float* Vs = Ks + 64 * 65; float* Qs = Vs + 64 * 65; float* Ws = Qs + 64 * 64; float* Rm = Ws + 8 * 64;
    const int nunits = NB * NH * (SEQ / 64);
    for (int u = F.bid; u < nunits; u += F.G) {
        const int qt = (SEQ / 64 - 1) - (u / (NB * NH)), bh = u % (NB * NH), b = bh / NH, h = bh % NH;
        const size_t tb = (size_t)b * SEQ;
        for (int idx = F.tid; idx < 64 * 64; idx += NTHREADS) { const int r = idx >> 6, c = idx & 63; Qs[idx] = bf2f(Q[(tb + qt * 64 + r) * D + h * 64 + c]) * 0.125f; }
        float R[8], acc[8];
#pragma unroll
        for (int q = 0; q < 8; ++q) { R[q] = 0.f; acc[q] = 0.f; }
        for (int kt = qt; kt >= 0; --kt) {
            __syncthreads();
            for (int idx = F.tid; idx < 64 * 64; idx += NTHREADS) { const int r = idx >> 6, c = idx & 63; const size_t g = (tb + kt * 64 + r) * D + h * 64 + c; Ks[r * 65 + c] = bf2f(Kb[g]); Vs[r * 65 + c] = bf2f(Vb[g]); }
            __syncthreads();
#pragma unroll
            for (int q = 0; q < 8; ++q) {
                const int qi = F.wave * 8 + q;
                float z = 0.f;
#pragma unroll 16
                for (int d = 0; d < 64; ++d) z += Qs[qi * 64 + d] * Ks[F.lane * 65 + d];
                const bool valid = (kt < qt) || (F.lane < qi);
                const float sp = valid ? softplusf_(z) : 0.f;
                float suf = sp;
#pragma unroll
                for (int o = 1; o < 64; o <<= 1) { const float v = __shfl_down(suf, o); if (F.lane + o < 64) suf += v; }
                const float tail = R[q] + suf - sp;
                const float w = valid ? __expf(z - sp - tail) : 0.f;
                R[q] += __shfl(suf, 0);
                Ws[F.wave * 64 + F.lane] = w;
                float a = acc[q];
#pragma unroll 16
                for (int s = 0; s < 64; ++s) a += Ws[F.wave * 64 + s] * Vs[s * 65 + F.lane];
                acc[q] = a;
            }
            float mn = R[0];
#pragma unroll
            for (int q = 1; q < 8; ++q) mn = fminf(mn, R[q]);
            if (F.lane == 0) Rm[F.wave] = mn;
            __syncthreads();
            float allmin = Rm[0];
#pragma unroll
            for (int w = 1; w < 8; ++w) allmin = fminf(allmin, Rm[w]);
            if (allmin > SB_EXIT) break;
        }
#pragma unroll
        for (int q = 0; q < 8; ++q) AO[(tb + qt * 64 + F.wave * 8 + q) * D + h * 64 + F.lane] = f2bf(acc[q]);
        __syncthreads();
    }
}

#define EPI_MT(acc) (int)(sizeof(acc) / sizeof(acc[0]))
__device__ __forceinline__ void st_bf4(bf16_t* p, const f32x4& v) { u32x2 w; w.x = pack2(v[0], v[1]); w.y = pack2(v[2], v[3]); *(u32x2*)p = w; }

__device__ __forceinline__ void ph_rkv_lora_sg(const Frame& F) {
    const bf16_t* XS = (const bf16_t*)(F.ws + WS_XS); const bf16_t* WRKV = (const bf16_t*)(F.ws + WS_WRKV); const bf16_t* WLDN = (const bf16_t*)(F.ws + WS_WLDN);
    bf16_t* RKV = (bf16_t*)(F.ws + WS_RKV); bf16_t* LORA = (bf16_t*)(F.ws + WS_LORA);
    for (int u = F.bid; u < 64 * 24; u += F.G) {
        const int mt = u / 24, ct = u % 24, n = ct / 8, col0 = (ct % 8) * 128;
        ASeg A; A.p[0] = XS + ((size_t)n * T + mt * 256) * D; A.p[1] = A.p[0]; A.p[2] = A.p[0]; A.segTiles = 16;
        bf16_t* out = RKV + ((size_t)n * T + mt * 256) * D + col0;
        sg_tile<128>(F.lds, A, [](int R) { return (unsigned)R * (D * 2); }, WRKV + (size_t)(n * D + col0) * D, D, 16,
            [&](auto& acc, int r0, int c0, int fr, int fq) {
#pragma unroll
                for (int m = 0; m < EPI_MT(acc); ++m)
#pragma unroll
                    for (int q = 0; q < 4; ++q) st_bf4(out + (size_t)(r0 + 16 * m + fr) * D + c0 + 16 * q + 4 * fq, acc[m][q]);
            });
    }
    for (int u = F.bid; u < 64 * 4; u += F.G) {
        const int mt = u / 4, j = u % 4, n = (j == 0) ? 3 : (j == 1 ? 4 : 5);
        ASeg A; A.p[0] = XS + ((size_t)n * T + mt * 256) * D; A.p[1] = A.p[0]; A.p[2] = A.p[0]; A.segTiles = 16;
        bf16_t* out = LORA + (size_t)mt * 256 * 256 + j * 64;
        sg_tile<64>(F.lds, A, [](int R) { return (unsigned)R * (D * 2); }, WLDN + (size_t)(j * 64) * D, D, 16,
            [&](auto& acc, int r0, int c0, int fr, int fq) {
#pragma unroll
                for (int m = 0; m < EPI_MT(acc); ++m)
#pragma unroll
                    for (int q = 0; q < 4; ++q) { f32x4 v = acc[m][q];
#pragma unroll
                        for (int e = 0; e < 4; ++e) v[e] = (j == 0) ? tanhf(v[e]) : (j == 1 ? v[e] : sigmoidf_(v[e]));
                        st_bf4(out + (size_t)(r0 + 16 * m + fr) * 256 + c0 + 16 * q + 4 * fq, v); }
            });
    }
}
__device__ __forceinline__ void ph_lora_up_sg(const Frame& F) {
    const bf16_t* LORA = (const bf16_t*)(F.ws + WS_LORA); const bf16_t* WLUP = (const bf16_t*)(F.ws + WS_WLUP);
    float* LD = (float*)(F.ws + WS_LD); bf16_t* AA = (bf16_t*)(F.ws + WS_AA); bf16_t* GG = (bf16_t*)(F.ws + WS_GG);
    for (int u = F.bid; u < 3 * 64 * 8; u += F.G) {
        const int which = u / 512, v = u % 512, mt = v / 8, col0 = (v % 8) * 128;
        const int K = which == 2 ? 128 : 64, koff = which * 64;
        ASeg A; A.p[0] = LORA + (size_t)mt * 256 * 256 + koff; A.p[1] = A.p[0]; A.p[2] = A.p[0]; A.segTiles = 4;
        const bf16_t* Bt = WLUP + (which == 0 ? 0 : (which == 1 ? 1024 * 64 : 2 * 1024 * 64)) + (size_t)col0 * K;
        const size_t obase = (size_t)mt * 256 * D + col0;
        sg_tile<128>(F.lds, A, [](int R) { return (unsigned)R * 512u; }, Bt, K, K / 64,
            [&](auto& acc, int r0, int c0, int fr, int fq) {
#pragma unroll
                for (int m = 0; m < EPI_MT(acc); ++m)
#pragma unroll
                    for (int q = 0; q < 4; ++q) {
                        const int c = c0 + 16 * q + 4 * fq; const size_t o = obase + (size_t)(r0 + 16 * m + fr) * D + c;
                        if (which == 0) { const f32x4 w0 = *(const f32x4*)(F.in[I_W0] + col0 + c); f32x4 r;
#pragma unroll
                            for (int e = 0; e < 4; ++e) { const float wl = w0[e] + acc[m][q][e]; r[e] = -__expf(-softplusf_(-wl) - 0.5f); }
                            *(f32x4*)(LD + o) = r; }
                        else if (which == 1) { const f32x4 a0 = *(const f32x4*)(F.in[I_A0] + col0 + c); f32x4 r;
#pragma unroll
                            for (int e = 0; e < 4; ++e) r[e] = sigmoidf_(a0[e] + acc[m][q][e]);
                            st_bf4(AA + o, r); }
                        else st_bf4(GG + o, acc[m][q]);
                    }
            });
    }
}
template <int OUTMODE>
__device__ __forceinline__ void ph_dense_sg(const Frame& F, const bf16_t* Ain, const bf16_t* Wt, int N, void* outp) {
    const int nct = N / 128;
    for (int u = F.bid; u < 64 * nct; u += F.G) {
        const int mt = u / nct, col0 = (u % nct) * 128;
        ASeg A; A.p[0] = Ain + (size_t)mt * 256 * D; A.p[1] = A.p[0]; A.p[2] = A.p[0]; A.segTiles = 16;
        sg_tile<128>(F.lds, A, [](int R) { return (unsigned)R * (D * 2); }, Wt + (size_t)col0 * D, D, 16,
            [&](auto& acc, int r0, int c0, int fr, int fq) {
#pragma unroll
                for (int m = 0; m < EPI_MT(acc); ++m)
#pragma unroll
                    for (int q = 0; q < 4; ++q) {
                        const int r = mt * 256 + r0 + 16 * m + fr, c = col0 + c0 + 16 * q + 4 * fq;
                        if (OUTMODE == 0) *(f32x4*)((float*)outp + (size_t)r * N + c) = acc[m][q];
                        else st_bf4((bf16_t*)outp + (size_t)(c / D) * T * D + (size_t)r * D + (c % D), acc[m][q]);
                    }
            });
    }
}
__device__ __forceinline__ void ph_router_sg(const Frame& F, int layer) {
    const bf16_t* H2 = (const bf16_t*)(F.ws + WS_H2); const bf16_t* H2LO = (const bf16_t*)(F.ws + WS_H2LO);
    const bf16_t* WRT = (const bf16_t*)(F.ws + WS_WRT) + (size_t)layer * 64 * 3072; float* LOG = (float*)(F.ws + WS_LOGITS);
    for (int mt = F.bid; mt < 64; mt += F.G) {
        ASeg A; A.p[0] = H2 + (size_t)mt * 256 * D; A.p[1] = A.p[0]; A.p[2] = H2LO + (size_t)mt * 256 * D; A.segTiles = 16;
        sg_tile<64>(F.lds, A, [](int R) { return (unsigned)R * (D * 2); }, WRT, 3072, 48,
            [&](auto& acc, int r0, int c0, int fr, int fq) {
#pragma unroll
                for (int m = 0; m < EPI_MT(acc); ++m)
#pragma unroll
                    for (int q = 0; q < 4; ++q) *(f32x4*)(LOG + (size_t)(mt * 256 + r0 + 16 * m + fr) * NE + c0 + 16 * q + 4 * fq) = acc[m][q];
            });
    }
}
__device__ __forceinline__ void ph_gateup_sg(const Frame& F) {
    const bf16_t* H2 = (const bf16_t*)(F.ws + WS_H2); bf16_t* HB = (bf16_t*)(F.ws + WS_HB); const bf16_t* WGU = (const bf16_t*)(F.ws + WS_WGU);
    const int* TOK = (const int*)(F.ws + WS_TOK); const int* TILEE = (const int*)(F.ws + WS_TILEE); const int* START = (const int*)(F.ws + WS_START);
    const int routed = START[65], nmt = (routed + T) / 256;
    for (int u = F.bid; u < nmt * 4; u += F.G) {
        const int mt = u / 4, nt4 = u % 4, row0 = mt * 256; const bool sh = row0 >= routed; const int e = sh ? 64 : TILEE[mt];
        ASeg A; A.p[0] = H2; A.p[1] = H2; A.p[2] = H2; A.segTiles = 16;
        bf16_t* out = HB + (size_t)row0 * DE + nt4 * 64;
        sg_tile<128>(F.lds, A, [&](int R) { const int tok = sh ? (row0 - routed + R) : TOK[row0 + R]; return (unsigned)tok * (D * 2); },
            WGU + ((size_t)e * 512 + nt4 * 128) * D, D, 16,
            [&](auto& acc, int r0, int c0, int fr, int fq) {
#pragma unroll
                for (int m = 0; m < EPI_MT(acc); ++m)
#pragma unroll
                    for (int q = 0; q < 2; ++q) { f32x4 v;
#pragma unroll
                        for (int e2 = 0; e2 < 4; ++e2) { const float g = acc[m][q][e2]; v[e2] = g * sigmoidf_(g) * acc[m][q + 2][e2]; }
                        st_bf4(out + (size_t)(r0 + 16 * m + fr) * DE + (c0 >> 1) + 16 * q + 4 * fq, v); }
            });
    }
}
__device__ __forceinline__ void ph_down_sg(const Frame& F) {
    const bf16_t* HB = (const bf16_t*)(F.ws + WS_HB); bf16_t* YB = (bf16_t*)(F.ws + WS_YB); const bf16_t* WDN = (const bf16_t*)(F.ws + WS_WDN);
    const int* TILEE = (const int*)(F.ws + WS_TILEE); const int* START = (const int*)(F.ws + WS_START);
    const int routed = START[65], nmt = (routed + T) / 256;
    for (int u = F.bid; u < nmt * 8; u += F.G) {
        const int mt = u / 8, col0 = (u % 8) * 128, row0 = mt * 256; const bool sh = row0 >= routed; const int e = sh ? 64 : TILEE[mt];
        ASeg A; A.p[0] = HB + (size_t)row0 * DE; A.p[1] = A.p[0]; A.p[2] = A.p[0]; A.segTiles = 4;
        bf16_t* out = YB + (size_t)row0 * D + col0;
        sg_tile<128>(F.lds, A, [](int R) { return (unsigned)R * (DE * 2); }, WDN + ((size_t)e * D + col0) * DE, DE, 4,
            [&](auto& acc, int r0, int c0, int fr, int fq) {
#pragma unroll
                for (int m = 0; m < EPI_MT(acc); ++m)
#pragma unroll
                    for (int q = 0; q < 4; ++q) st_bf4(out + (size_t)(r0 + 16 * m + fr) * D + c0 + 16 * q + 4 * fq, acc[m][q]);
            });
    }
}

constexpr int MS = 72;
constexpr int SLOT = 64 * MS * 2;
constexpr size_t WS_BONUS = 3 * MiB;
constexpr size_t WS_RP = WS_BIG + 128 * MiB;
constexpr size_t WS_OL = WS_BIG + 160 * MiB;
constexpr size_t WS_G2 = WS_BIG + 296 * MiB;
constexpr size_t WS_DM = WS_BIG + 328 * MiB;
constexpr size_t WS_ST = WS_BIG + 360 * MiB;

__device__ __forceinline__ bf16x8 ldfrag(const LAS bf16_t* M, int row, int kofs) { return *(const LAS bf16x8*)(M + row * MS + kofs); }
template <bool SW>
__device__ __forceinline__ void mm64(f32x4& acc, const LAS bf16_t* X, int xr0, const LAS bf16_t* Y, int yr0, int fr, int fq) {
#pragma unroll
    for (int ks = 0; ks < 2; ++ks) {
        const bf16x8 xf = ldfrag(X, xr0 + fr, ks * 32 + fq * 8), yf = ldfrag(Y, yr0 + fr, ks * 32 + fq * 8);
        acc = SW ? __builtin_amdgcn_mfma_f32_16x16x32_bf16(yf, xf, acc, 0, 0, 0) : __builtin_amdgcn_mfma_f32_16x16x32_bf16(xf, yf, acc, 0, 0, 0);
    }
}
__device__ __forceinline__ void st4_lds(LAS bf16_t* p, const f32x4& v) { u32x2 w; w.x = pack2(v[0], v[1]); w.y = pack2(v[2], v[3]); *(LAS u32x2*)p = w; }
__device__ __forceinline__ f32x4 ld4_lds(const LAS bf16_t* p) { const u32x2 w = *(const LAS u32x2*)p; return (f32x4){lo2f(w.x), hi2f(w.x), lo2f(w.y), hi2f(w.y)}; }
__device__ __forceinline__ f32x4 ld4_g(const bf16_t* p) { const u32x2 w = *(const u32x2*)p; return (f32x4){lo2f(w.x), hi2f(w.x), lo2f(w.y), hi2f(w.y)}; }

__device__ __forceinline__ void ph_wkv_chunk(const Frame& F) {
    const bf16_t* RKV = (const bf16_t*)(F.ws + WS_RKV); const float* LD = (const float*)(F.ws + WS_LD); const bf16_t* AA = (const bf16_t*)(F.ws + WS_AA);
    const bf16_t* Rb = RKV; const bf16_t* Kb = RKV + (size_t)T * D; const bf16_t* Vb = RKV + (size_t)2 * T * D;
    bf16_t* RP = (bf16_t*)(F.ws + WS_RP); bf16_t* OL = (bf16_t*)(F.ws + WS_OL); bf16_t* G2 = (bf16_t*)(F.ws + WS_G2); bf16_t* DM = (bf16_t*)(F.ws + WS_DM);
    float* BONUS = (float*)(F.ws + WS_BONUS);
#define SL(k) ((LAS bf16_t*)(F.lds + (k) * SLOT))
    LAS float* segtot = (LAS float*)(F.lds + 15 * SLOT);
    LAS float* WCs = segtot + 512;
    const int w = F.wave, lane = F.lane, fr = lane & 15, fq = lane >> 4, mt = w >> 1, ntb = 2 * (w & 1);
    for (int cid = F.bid; cid < NB * NH * (SEQ / 64); cid += F.G) {
        const int bh = cid / (SEQ / 64), c = cid % (SEQ / 64), b = bh / NH, h = bh % NH;
        const size_t tok0 = (size_t)b * SEQ + (size_t)c * 64;
        {
            const int j = lane, ch = h * 64 + j;
            const float kkw = F.in[I_KK][ch], kaw = F.in[I_KA][ch], rkw = F.in[I_RK][ch];
            float r[8], k[8], v[8], a[8], ld[8];
#pragma unroll
            for (int e = 0; e < 8; ++e) { const size_t o = (tok0 + 8 * w + e) * D + ch; r[e] = bf2f(Rb[o]); k[e] = bf2f(Kb[o]); v[e] = bf2f(Vb[o]); a[e] = bf2f(AA[o]); ld[e] = LD[o]; }
            float cum[8]; float run = 0.f;
#pragma unroll
            for (int e = 0; e < 8; ++e) { run += ld[e]; cum[e] = run; }
            segtot[w * 64 + j] = run;
            __syncthreads();
            float pre = 0.f, tot = 0.f;
#pragma unroll
            for (int ww = 0; ww < 8; ++ww) { const float sgt = segtot[ww * 64 + j]; tot += sgt; if (ww < w) pre += sgt; }
            if (w == 0) WCs[j] = __expf(tot);
            float av[8], bv[8], kv[8], rv[8];
#pragma unroll
            for (int e = 0; e < 8; ++e) {
                const float cm = pre + cum[e];
                const float kkr = k[e] * kkw; const float ss = wave_sum(kkr * kkr);
                const float kk = kkr / fmaxf(sqrtf(ss), 1e-12f);
                const float kf = k[e] * (1.0f + (a[e] - 1.0f) * kaw);
                const float bon = wave_sum(r[e] * kf * rkw);
                if (lane == 0) BONUS[(tok0 + 8 * w + e) * NH + h] = bon;
                const float en = __expf(-cm);
                av[e] = -kk * __expf(cm - ld[e]); bv[e] = kk * a[e] * en; kv[e] = kf * en; rv[e] = r[e] * __expf(cm);
                const int t = 8 * w + e;
                SL(0)[t * MS + j] = f2bf(av[e]); SL(2)[t * MS + j] = f2bf(rv[e]); SL(3)[t * MS + j] = f2bf(bv[e]); SL(5)[t * MS + j] = f2bf(kv[e]);
            }
            u32x4 pa, pb, pk, pv;
#pragma unroll
            for (int q = 0; q < 4; ++q) { pa[q] = pack2(av[2 * q], av[2 * q + 1]); pb[q] = pack2(bv[2 * q], bv[2 * q + 1]); pk[q] = pack2(kv[2 * q], kv[2 * q + 1]); pv[q] = pack2(v[2 * q], v[2 * q + 1]); }
            *(LAS u32x4*)(SL(1) + j * MS + 8 * w) = pa; *(LAS u32x4*)(SL(4) + j * MS + 8 * w) = pb; *(LAS u32x4*)(SL(6) + j * MS + 8 * w) = pk; *(LAS u32x4*)(SL(7) + j * MS + 8 * w) = pv;
        }
        __syncthreads();
#pragma unroll
        for (int q2 = 0; q2 < 2; ++q2) {
            const int nt = ntb + q2;
            { f32x4 acc = {0.f, 0.f, 0.f, 0.f}; mm64<false>(acc, SL(0), 16 * mt, SL(3), 16 * nt, fr, fq);
              const int sidx = 16 * nt + fr, t0 = 16 * mt + 4 * fq;
#pragma unroll
              for (int e = 0; e < 4; ++e) { if (!(sidx < t0 + e)) acc[e] = 0.f; SL(8)[(t0 + e) * MS + sidx] = f2bf(acc[e]); }
              st4_lds(SL(9) + sidx * MS + t0, acc); }
            const int tt = 16 * mt + fr, s0 = 16 * nt + 4 * fq;
            { f32x4 acc = {0.f, 0.f, 0.f, 0.f}; mm64<true>(acc, SL(0), 16 * mt, SL(5), 16 * nt, fr, fq);
#pragma unroll
              for (int e = 0; e < 4; ++e) if (!(s0 + e < tt)) acc[e] = 0.f;
              st4_lds(SL(10) + tt * MS + s0, acc); }
            { f32x4 acc = {0.f, 0.f, 0.f, 0.f}; mm64<true>(acc, SL(2), 16 * mt, SL(3), 16 * nt, fr, fq);
#pragma unroll
              for (int e = 0; e < 4; ++e) if (!(s0 + e <= tt)) acc[e] = 0.f;
              st4_lds(SL(11) + tt * MS + s0, acc); }
            { f32x4 acc = {0.f, 0.f, 0.f, 0.f}; mm64<true>(acc, SL(2), 16 * mt, SL(5), 16 * nt, fr, fq);
#pragma unroll
              for (int e = 0; e < 4; ++e) if (!(s0 + e <= tt)) acc[e] = 0.f;
              st4_lds(SL(12) + tt * MS + s0, acc); }
        }
        __syncthreads();
#define WKV_SQ(xi, ti, xo, to) do { _Pragma("unroll") for (int q2 = 0; q2 < 2; ++q2) { const int nt = ntb + q2; f32x4 acc = {0.f, 0.f, 0.f, 0.f}; \
            mm64<false>(acc, SL(xi), 16 * mt, SL(ti), 16 * nt, fr, fq); const int n_ = 16 * nt + fr, m0_ = 16 * mt + 4 * fq; \
            _Pragma("unroll") for (int e = 0; e < 4; ++e) SL(xo)[(m0_ + e) * MS + n_] = f2bf(acc[e]); st4_lds(SL(to) + n_ * MS + m0_, acc); } } while (0)
#define WKV_PM(pi, ti, po) do { _Pragma("unroll") for (int q2 = 0; q2 < 2; ++q2) { const int nt = ntb + q2; const int m_ = 16 * mt + fr, n0_ = 16 * nt + 4 * fq; \
            f32x4 acc = ld4_lds(SL(pi) + m_ * MS + n0_); mm64<true>(acc, SL(pi), 16 * mt, SL(ti), 16 * nt, fr, fq); st4_lds(SL(po) + m_ * MS + n0_, acc); } } while (0)
        WKV_SQ(8, 9, 0, 3);
        for (int idx = F.tid; idx < 64 * 64; idx += NTHREADS) { const int t = idx >> 6, s2 = idx & 63; SL(13)[t * MS + s2] = (t == s2) ? (bf16_t)0x3F80 : SL(8)[t * MS + s2]; }
        __syncthreads();
        WKV_PM(13, 3, 14); WKV_SQ(0, 3, 8, 9); __syncthreads();
        WKV_PM(14, 9, 13); WKV_SQ(8, 9, 0, 3); __syncthreads();
        WKV_PM(13, 3, 14); WKV_SQ(0, 3, 8, 9); __syncthreads();
        WKV_PM(14, 9, 13); WKV_SQ(8, 9, 0, 3); __syncthreads();
        WKV_PM(13, 3, 14); __syncthreads();
#pragma unroll
        for (int q2 = 0; q2 < 2; ++q2) {
            const int nt = ntb + q2, n_ = 16 * nt + fr, m0_ = 16 * mt + 4 * fq;
            { f32x4 acc = {0.f, 0.f, 0.f, 0.f}; mm64<false>(acc, SL(14), 16 * mt, SL(1), 16 * nt, fr, fq); st4_lds(SL(9) + n_ * MS + m0_, acc); }
            { f32x4 acc = {0.f, 0.f, 0.f, 0.f}; mm64<false>(acc, SL(10), 16 * mt, SL(7), 16 * nt, fr, fq); st4_lds(SL(8) + n_ * MS + m0_, acc); }
        }
        __syncthreads();
#pragma unroll
        for (int q2 = 0; q2 < 2; ++q2) {
            const int nt = ntb + q2;
            { const int n_ = 16 * nt + fr, m0_ = 16 * mt + 4 * fq; f32x4 acc = {0.f, 0.f, 0.f, 0.f}; mm64<false>(acc, SL(14), 16 * mt, SL(8), 16 * nt, fr, fq); st4_lds(SL(0) + n_ * MS + m0_, acc); }
            { const int m_ = 16 * mt + fr, n0_ = 16 * nt + 4 * fq; f32x4 acc = ld4_lds(SL(2) + m_ * MS + n0_); mm64<true>(acc, SL(11), 16 * mt, SL(9), 16 * nt, fr, fq);
              st_bf4(RP + (size_t)cid * 4096 + m_ * 64 + n0_, acc); }
        }
        __syncthreads();
#pragma unroll
        for (int q2 = 0; q2 < 2; ++q2) {
            const int nt = ntb + q2;
            { const int m_ = 16 * mt + fr, n0_ = 16 * nt + 4 * fq; f32x4 acc = {0.f, 0.f, 0.f, 0.f};
              mm64<true>(acc, SL(11), 16 * mt, SL(0), 16 * nt, fr, fq); mm64<true>(acc, SL(12), 16 * mt, SL(7), 16 * nt, fr, fq);
              st_bf4(OL + (size_t)cid * 4096 + m_ * 64 + n0_, acc); }
            { const int jp = 16 * nt + fr, j0 = 16 * mt + 4 * fq; f32x4 acc = {0.f, 0.f, 0.f, 0.f}; mm64<false>(acc, SL(9), 16 * mt, SL(4), 16 * nt, fr, fq);
              const float wc = WCs[jp];
#pragma unroll
              for (int e = 0; e < 4; ++e) acc[e] = (acc[e] + ((j0 + e == jp) ? 1.0f : 0.0f)) * wc;
              st_bf4(G2 + (size_t)cid * 4096 + (nt * 2 + (mt >> 1)) * 512 + lane * 8 + (mt & 1) * 4, acc); }
            { const int i_ = 16 * mt + fr, jp0 = 16 * nt + 4 * fq; f32x4 acc = {0.f, 0.f, 0.f, 0.f};
              mm64<true>(acc, SL(0), 16 * mt, SL(4), 16 * nt, fr, fq); mm64<true>(acc, SL(7), 16 * mt, SL(6), 16 * nt, fr, fq);
#pragma unroll
              for (int e = 0; e < 4; ++e) acc[e] *= WCs[jp0 + e];
              st_bf4(DM + (size_t)cid * 4096 + i_ * 64 + jp0, acc); }
        }
        __syncthreads();
    }
#undef WKV_SQ
#undef WKV_PM
#undef SL
}

__device__ __forceinline__ void ph_wkv_carry(const Frame& F) {
    const bf16_t* G2 = (const bf16_t*)(F.ws + WS_G2); const bf16_t* DM = (const bf16_t*)(F.ws + WS_DM); bf16_t* ST = (bf16_t*)(F.ws + WS_ST);
    if (F.wave >= 4) return;
    const int lane = F.lane, fr = lane & 15, fq = lane >> 4, i = 16 * F.wave + fr;
    for (int ch = F.bid; ch < NB * NH; ch += F.G) {
        f32x4 st[4];
#pragma unroll
        for (int r = 0; r < 4; ++r) st[r] = (f32x4){0.f, 0.f, 0.f, 0.f};
        const size_t cbase = (size_t)ch * (SEQ / 64);
        bf16x8 gf[8]; f32x4 dm[4];
#pragma unroll
        for (int f = 0; f < 8; ++f) gf[f] = *(const bf16x8*)(G2 + cbase * 4096 + f * 512 + lane * 8);
#pragma unroll
        for (int r = 0; r < 4; ++r) dm[r] = ld4_g(DM + cbase * 4096 + i * 64 + 16 * r + 4 * fq);
        for (int c = 0; c < SEQ / 64; ++c) {
            const size_t cid = cbase + c;
            bf16x8 gc[8]; f32x4 acc[4];
#pragma unroll
            for (int f = 0; f < 8; ++f) gc[f] = gf[f];
#pragma unroll
            for (int r = 0; r < 4; ++r) acc[r] = dm[r];
            if (c + 1 < SEQ / 64) {
#pragma unroll
                for (int f = 0; f < 8; ++f) gf[f] = *(const bf16x8*)(G2 + (cid + 1) * 4096 + f * 512 + lane * 8);
#pragma unroll
                for (int r = 0; r < 4; ++r) dm[r] = ld4_g(DM + (cid + 1) * 4096 + i * 64 + 16 * r + 4 * fq);
            }
            union { bf16x8 v; unsigned u[4]; } b0, b1;
#pragma unroll
            for (int r = 0; r < 4; ++r) st_bf4(ST + cid * 4096 + i * 64 + 16 * r + 4 * fq, st[r]);
            b0.u[0] = pack2(st[0][0], st[0][1]); b0.u[1] = pack2(st[0][2], st[0][3]); b0.u[2] = pack2(st[1][0], st[1][1]); b0.u[3] = pack2(st[1][2], st[1][3]);
            b1.u[0] = pack2(st[2][0], st[2][1]); b1.u[1] = pack2(st[2][2], st[2][3]); b1.u[2] = pack2(st[3][0], st[3][1]); b1.u[3] = pack2(st[3][2], st[3][3]);
#pragma unroll
            for (int r = 0; r < 4; ++r) {
                acc[r] = __builtin_amdgcn_mfma_f32_16x16x32_bf16(gc[r * 2 + 0], b0.v, acc[r], 0, 0, 0);
                acc[r] = __builtin_amdgcn_mfma_f32_16x16x32_bf16(gc[r * 2 + 1], b1.v, acc[r], 0, 0, 0);
            }
#pragma unroll
            for (int r = 0; r < 4; ++r) st[r] = acc[r];
        }
    }
}

__device__ __forceinline__ void ph_wkv_out(const Frame& F) {
    const bf16_t* RP = (const bf16_t*)(F.ws + WS_RP); const bf16_t* OL = (const bf16_t*)(F.ws + WS_OL); const bf16_t* ST = (const bf16_t*)(F.ws + WS_ST);
    const bf16_t* Vb = (const bf16_t*)(F.ws + WS_RKV) + (size_t)2 * T * D; const bf16_t* GG = (const bf16_t*)(F.ws + WS_GG); const float* BONUS = (const float*)(F.ws + WS_BONUS);
    bf16_t* OG = (bf16_t*)(F.ws + WS_OG);
    const int lane = F.lane, fr = lane & 15, fq = lane >> 4;
    const int nunits = NB * NH * (SEQ / 64) * 4;
    for (int u = F.bid * NWAVES + F.wave; u < nunits; u += F.G * NWAVES) {
        const int cid = u >> 2, tt = u & 3, bh = cid / (SEQ / 64), c = cid % (SEQ / 64), b = bh / NH, h = bh % NH;
        const int t = 16 * tt + fr; const size_t tok = (size_t)b * SEQ + (size_t)c * 64 + t;
        bf16x8 rf[2];
#pragma unroll
        for (int ks = 0; ks < 2; ++ks) rf[ks] = *(const bf16x8*)(RP + (size_t)cid * 4096 + t * 64 + ks * 32 + fq * 8);
        f32x4 acc[4];
#pragma unroll
        for (int n = 0; n < 4; ++n) {
            acc[n] = ld4_g(OL + (size_t)cid * 4096 + t * 64 + 16 * n + 4 * fq);
#pragma unroll
            for (int ks = 0; ks < 2; ++ks) { const bf16x8 sf = *(const bf16x8*)(ST + (size_t)cid * 4096 + (16 * n + fr) * 64 + ks * 32 + fq * 8);
                acc[n] = __builtin_amdgcn_mfma_f32_16x16x32_bf16(sf, rf[ks], acc[n], 0, 0, 0); }
        }
        float s = 0.f;
#pragma unroll
        for (int n = 0; n < 4; ++n) s += (acc[n][0] + acc[n][1]) + (acc[n][2] + acc[n][3]);
        s += __shfl_xor(s, 16); s += __shfl_xor(s, 32);
        const float mean = s * (1.0f / 64.0f);
        float q = 0.f;
#pragma unroll
        for (int n = 0; n < 4; ++n)
#pragma unroll
            for (int e = 0; e < 4; ++e) { const float d = acc[n][e] - mean; q += d * d; }
        q += __shfl_xor(q, 16); q += __shfl_xor(q, 32);
        const float rstd = rsqrtf(q * (1.0f / 64.0f) + 64e-5f), bon = BONUS[tok * NH + h];
#pragma unroll
        for (int n = 0; n < 4; ++n) {
            const int chn = h * 64 + 16 * n + 4 * fq; const size_t o = tok * D + chn;
            const f32x4 lg = *(const f32x4*)(F.in[I_LNG] + chn), lb = *(const f32x4*)(F.in[I_LNB] + chn), vv = ld4_g(Vb + o), gg = ld4_g(GG + o);
            const f32x4 res = (((acc[n] - mean) * rstd) * lg + lb + vv * bon) * gg;
            st_bf4(OG + o, res);
        }
    }
}

__device__ __forceinline__ void ph_qkv_sg(const Frame& F) {
    const bf16_t* Ain = (const bf16_t*)(F.ws + WS_H3); const bf16_t* Wt = (const bf16_t*)(F.ws + WS_WQKV);
    bf16_t* QK = (bf16_t*)(F.ws + WS_Q); bf16_t* VT = QK + (size_t)2 * T * D;
    for (int u = F.bid; u < 64 * 24; u += F.G) {
        const int mt = u / 24, ct = u % 24, col0 = ct * 128;
        ASeg A; A.p[0] = Ain + (size_t)mt * 256 * D; A.p[1] = A.p[0]; A.p[2] = A.p[0]; A.segTiles = 16;
        if (ct < 16) {
            sg_tile<128>(F.lds, A, [](int R) { return (unsigned)R * (D * 2); }, Wt + (size_t)col0 * D, D, 16,
                [&](auto& acc, int r0, int c0, int fr, int fq) {
#pragma unroll
                    for (int m = 0; m < EPI_MT(acc); ++m)
#pragma unroll
                        for (int q = 0; q < 4; ++q) { const int r = mt * 256 + r0 + 16 * m + fr, c = col0 + c0 + 16 * q + 4 * fq;
                            st_bf4(QK + (size_t)(c / D) * T * D + (size_t)r * D + (c % D), acc[m][q]); }
                });
        } else {
            sg_tile<128, true>(F.lds, A, [](int R) { return (unsigned)R * (D * 2); }, Wt + (size_t)col0 * D, D, 16,
                [&](auto& acc, int r0, int c0, int fr, int fq) {
#pragma unroll
                    for (int m = 0; m < EPI_MT(acc); ++m)
#pragma unroll
                        for (int q = 0; q < 4; ++q) { const int t = mt * 256 + r0 + 16 * m + 4 * fq, c = col0 - 2 * D + c0 + 16 * q + fr;
                            const int b = t / SEQ, sidx = t % SEQ, h = c >> 6, d = c & 63;
                            st_bf4(VT + ((size_t)((b * NH + h) * 64 + d)) * SEQ + sidx, acc[m][q]); }
                });
        }
    }
}
__device__ __forceinline__ void ph_attn(const Frame& F) {
    const bf16_t* Q = (const bf16_t*)(F.ws + WS_Q); const bf16_t* Kb = Q + (size_t)T * D; const bf16_t* VT = Q + (size_t)2 * T * D;
    bf16_t* AO = (bf16_t*)(F.ws + WS_AO);
    const int lane = F.lane, fr = lane & 15, fq = lane >> 4;
    const int nunits = NB * NH * (SEQ / 16);
    for (int u = F.bid * NWAVES + F.wave; u < nunits; u += F.G * NWAVES) {
        const int bh = u / (SEQ / 16), qt = u % (SEQ / 16), b = bh / NH, h = bh % NH;
        const int q0 = qt * 16, qpos = q0 + fr;
        const size_t tb = (size_t)b * SEQ;
        bf16x8 qf[2];
#pragma unroll
        for (int ks = 0; ks < 2; ++ks) qf[ks] = *(const bf16x8*)(Q + (tb + qpos) * D + h * 64 + ks * 32 + fq * 8);
        f32x4 o[4];
#pragma unroll
        for (int dt = 0; dt < 4; ++dt) o[dt] = (f32x4){0.f, 0.f, 0.f, 0.f};
        float R = 0.f;
        const bf16_t* vt = VT + (size_t)bh * 64 * SEQ;
        for (int kt0 = (q0 + 15) / 64; kt0 >= 0; --kt0) {
            const int key0 = kt0 * 64;
            f32x4 z[4];
#pragma unroll
            for (int kt = 0; kt < 4; ++kt) {
                z[kt] = (f32x4){0.f, 0.f, 0.f, 0.f};
#pragma unroll
                for (int ks = 0; ks < 2; ++ks) { const bf16x8 kf = *(const bf16x8*)(Kb + (tb + key0 + 16 * kt + fr) * D + h * 64 + ks * 32 + fq * 8);
                    z[kt] = __builtin_amdgcn_mfma_f32_16x16x32_bf16(kf, qf[ks], z[kt], 0, 0, 0); }
            }
            float sp[4][4], G[4];
#pragma unroll
            for (int kt = 0; kt < 4; ++kt) { G[kt] = 0.f;
#pragma unroll
                for (int e = 0; e < 4; ++e) { const float zz = z[kt][e] * 0.125f; z[kt][e] = zz; const bool valid = (key0 + 16 * kt + 4 * fq + e) < qpos;
                    const float spv = valid ? (zz > 15.f ? zz : __logf(1.0f + __expf(zz))) : 0.f; sp[kt][e] = spv; G[kt] += spv; } }
            float sufg[4], tot[4];
#pragma unroll
            for (int kt = 0; kt < 4; ++kt) {
                const float g1 = __shfl_xor(G[kt], 16), g2 = __shfl_xor(G[kt], 32), g3 = __shfl_xor(G[kt], 48);
                tot[kt] = G[kt] + g1 + g2 + g3;
                sufg[kt] = (((fq ^ 1) > fq) ? g1 : 0.f) + (((fq ^ 2) > fq) ? g2 : 0.f) + (((fq ^ 3) > fq) ? g3 : 0.f);
            }
            float later = 0.f;
            unsigned pk[4][2];
#pragma unroll
            for (int kt = 3; kt >= 0; --kt) {
                float run = R + later + sufg[kt];
                float wv[4];
#pragma unroll
                for (int e = 3; e >= 0; --e) { const bool valid = (key0 + 16 * kt + 4 * fq + e) < qpos;
                    wv[e] = valid ? __expf(z[kt][e] - sp[kt][e] - run) : 0.f; run += sp[kt][e]; }
                pk[kt][0] = pack2(wv[0], wv[1]); pk[kt][1] = pack2(wv[2], wv[3]);
                later += tot[kt];
            }
            R += later;
            union { bf16x8 v; unsigned w[4]; } p0, p1;
            p0.w[0] = pk[0][0]; p0.w[1] = pk[0][1]; p0.w[2] = pk[1][0]; p0.w[3] = pk[1][1];
            p1.w[0] = pk[2][0]; p1.w[1] = pk[2][1]; p1.w[2] = pk[3][0]; p1.w[3] = pk[3][1];
#pragma unroll
            for (int dt = 0; dt < 4; ++dt) {
                const bf16_t* vr = vt + (size_t)(16 * dt + fr) * SEQ + key0 + 4 * fq;
                union { bf16x8 v; u32x2 h[2]; } v0, v1;
                v0.h[0] = *(const u32x2*)(vr); v0.h[1] = *(const u32x2*)(vr + 16); v1.h[0] = *(const u32x2*)(vr + 32); v1.h[1] = *(const u32x2*)(vr + 48);
                o[dt] = __builtin_amdgcn_mfma_f32_16x16x32_bf16(v0.v, p0.v, o[dt], 0, 0, 0);
                o[dt] = __builtin_amdgcn_mfma_f32_16x16x32_bf16(v1.v, p1.v, o[dt], 0, 0, 0);
            }
            if (__all(R > SB_EXIT)) break;
        }
#pragma unroll
        for (int dt = 0; dt < 4; ++dt) st_bf4(AO + (tb + qpos) * D + h * 64 + 16 * dt + 4 * fq, o[dt]);
    }
}

__global__ void __launch_bounds__(NTHREADS, 2) mega(Args args) {
    extern __shared__ __attribute__((aligned(16))) unsigned char lds[];
    Frame F;
    F.in = args.in; F.out = args.out; F.ws = args.ws; F.ctl = (unsigned*)(args.ws + WS_CTL);
    F.ldsf = (float*)lds; F.lds = (LAS unsigned char*)lds;
    F.tid = threadIdx.x; F.lane = F.tid & 63; F.wave = __builtin_amdgcn_readfirstlane(F.tid >> 6); F.bid = blockIdx.x; F.G = gridDim.x;
    if (F.tid < 4) ((unsigned*)(lds + LDS_BYTES - 64))[F.tid] = 0u;
    __syncthreads();
    XcdBarrier bar; bar.bar = F.ctl + CW_BAR; bar.x = 0; bar.st = (volatile LAS unsigned*)(lds + LDS_BYTES - 64);
#if MK_N_LAUNCHES == 1
    bar = xcd_barrier_post(F.ctl + CW_BAR, (volatile LAS unsigned*)(lds + LDS_BYTES - 64));
#endif
    const int lo = args.ph_lo, hi = args.ph_hi;
#define IN(k) (lo <= (k) && (k) < hi)
#define SEAM(k) do { if (IN(k) && IN((k) + 1)) xcd_barrier(bar); } while (0)
    bf16_t* const wsb = (bf16_t*)args.ws;
    (void)wsb;
    if (IN(0)) { ph_mod(F); conv_dense(F, F.bid, F.G); conv_moe(F, 0, F.bid, F.G); } SEAM(0);
    if (IN(1)) { ph_prenorm_rwkv(F); } SEAM(1);
    if (IN(2)) { ph_rkv_lora_sg(F); } SEAM(2);
    if (IN(3)) { ph_lora_up_sg(F); } SEAM(3);
    if (IN(4)) { ph_wkv_chunk(F); } SEAM(4);
    if (IN(5)) { ph_wkv_carry(F); } SEAM(5);
    if (IN(6)) { ph_wkv_out(F); } SEAM(6);
    if (IN(7)) { ph_dense_sg<0>(F, (const bf16_t*)(F.ws + WS_OG), (const bf16_t*)(F.ws + WS_WO), D, F.ws + WS_Y1); } SEAM(7);
    if (IN(8)) { ph_postmix_preffn(F, 0, F.in[I_X], (const float*)(F.ws + WS_Y1)); } SEAM(8);
    if (IN(9)) { ph_router_sg(F, 0); } SEAM(9);
    if (IN(10)) { ph_topk(F, 0); } SEAM(10);
    if (IN(11)) { ph_offsets(F, 0); } SEAM(11);
    if (IN(12)) { ph_gateup_sg(F); } SEAM(12);
    if (IN(13)) { ph_down_sg(F); } SEAM(13);
    if (IN(14)) { ph_combine(F, 0, true); conv_moe(F, 1, F.bid, F.G); } SEAM(14);
    if (IN(15)) { ph_qkv_sg(F); } SEAM(15);
    if (IN(16)) { ph_attn(F); } SEAM(16);
    if (IN(17)) { ph_dense_sg<0>(F, (const bf16_t*)(F.ws + WS_AO), (const bf16_t*)(F.ws + WS_WSBO), D, F.ws + WS_Y1B); } SEAM(17);
    if (IN(18)) { ph_postmix_preffn(F, 1, F.out, (const float*)(F.ws + WS_Y1B)); } SEAM(18);
    if (IN(19)) { ph_router_sg(F, 1); } SEAM(19);
    if (IN(20)) { ph_topk(F, 1); } SEAM(20);
    if (IN(21)) { ph_offsets(F, 1); } SEAM(21);
    if (IN(22)) { ph_gateup_sg(F); } SEAM(22);
    if (IN(23)) { ph_down_sg(F); } SEAM(23);
    if (IN(24)) { ph_combine(F, 1, false); }
#undef IN
#undef SEAM
}

extern "C" void kernel_launch(void* const* d_in, const int* in_sizes, int n_in, void* d_out, int out_size, void* d_ws, size_t ws_size, hipStream_t stream) {
    static int grid = 0;
    if (grid == 0) {
        if (n_in != 34 || in_sizes[0] != T * D || out_size != T * D || ws_size < WS_END) {
            fprintf(stderr, "kernel_launch: unexpected shapes: n_in %d in0 %d out %d ws %zu (need %zu)\n", n_in, n_in > 0 ? in_sizes[0] : -1, out_size, ws_size, (size_t)WS_END);
            grid = -1; return;
        }
        int dev = 0, cus = 0, per_cu = 0;
        if (hipGetDevice(&dev) != hipSuccess || hipDeviceGetAttribute(&cus, hipDeviceAttributeMultiprocessorCount, dev) != hipSuccess) { grid = -1; return; }
        if (hipFuncSetAttribute((const void*)mega, hipFuncAttributeMaxDynamicSharedMemorySize, LDS_BYTES) != hipSuccess) { fprintf(stderr, "kernel_launch: hipFuncSetAttribute failed\n"); grid = -1; return; }
        if (hipOccupancyMaxActiveBlocksPerMultiprocessor(&per_cu, (const void*)mega, NTHREADS, LDS_BYTES) != hipSuccess || per_cu < 1)
            fprintf(stderr, "kernel_launch: occupancy query reports %d blocks per CU\n", per_cu);
        (void)hipGetLastError();
        grid = cus;
    }
    if (grid < 0) return;
    if (hipMemsetAsync((char*)d_ws + WS_CTL, 0, CTL_BYTES, stream) != hipSuccess) { fprintf(stderr, "kernel_launch: memset failed\n"); return; }
    Args a{};
    for (int i = 0; i < 34; ++i) a.in[i] = (const float*)d_in[i];
    a.out = (float*)d_out; a.ws = (unsigned char*)d_ws;
#if MK_N_LAUNCHES == 1
    a.ph_lo = 0; a.ph_hi = NPHASES;
    hipLaunchKernelGGL(mega, dim3(grid), dim3(NTHREADS), LDS_BYTES, stream, a);
#else
    for (int p = 0; p < NPHASES; ++p) { a.ph_lo = p; a.ph_hi = p + 1; hipLaunchKernelGGL(mega, dim3(grid), dim3(NTHREADS), LDS_BYTES, stream, a); }
#endif
    const hipError_t le = hipPeekAtLastError();
    if (le != hipSuccess) fprintf(stderr, "kernel_launch: launch failed: %s\n", hipGetErrorName(le));
}
```

```cpp
#include <hip/hip_runtime.h>
#include <cstdio>
#include <cstdint>

#ifndef MK_N_LAUNCHES
#define MK_N_LAUNCHES 1
#endif

constexpr int T = 16384, D = 1024, SEQ = 8192, NB = 2, NH = 16, HD = 64;
constexpr int NE = 64, TOPK = 8, DE = 256;
constexpr int RP = 256;
constexpr int MAXROUTED = 147456;
constexpr int MAXROWS = MAXROUTED + T;
constexpr int NTHREADS = 512, NWAVES = 8;
constexpr int NPHASES = 25;
constexpr int LDS_BYTES = 144 * 1024;

typedef unsigned short bf16_t;
typedef float f32x4 __attribute__((ext_vector_type(4)));
typedef unsigned u32x4 __attribute__((ext_vector_type(4)));
typedef unsigned u32x2 __attribute__((ext_vector_type(2)));

__device__ __forceinline__ float bf2f(bf16_t b) { return __uint_as_float(((unsigned)b) << 16); }
__device__ __forceinline__ bf16_t f2bf(float f) { unsigned u = __float_as_uint(f); u += 0x7FFFu + ((u >> 16) & 1u); return (bf16_t)(u >> 16); }
__device__ __forceinline__ unsigned pack2(float a, float b) { return (unsigned)f2bf(a) | ((unsigned)f2bf(b) << 16); }
__device__ __forceinline__ float lo2f(unsigned u) { return __uint_as_float(u << 16); }
__device__ __forceinline__ float hi2f(unsigned u) { return __uint_as_float(u & 0xffff0000u); }
__device__ __forceinline__ float sigmoidf_(float x) { return 1.0f / (1.0f + __expf(-x)); }
__device__ __forceinline__ float softplusf_(float x) { return x > 20.f ? x : log1pf(__expf(x)); }
__device__ __forceinline__ float wave_sum(float v) {
#pragma unroll
    for (int o = 32; o >= 1; o >>= 1) v += __shfl_xor(v, o);
    return v;
}

constexpr size_t MiB = 1024 * 1024;
constexpr size_t WS_CTL    = 0;
constexpr size_t CTL_BYTES = 64 * 1024;
constexpr size_t WS_MOD    = 64 * 1024;
constexpr size_t WS_IDX    = 256 * 1024;
constexpr size_t WS_GATE   = WS_IDX + 512 * 1024;
constexpr size_t WS_RANK   = WS_GATE + 512 * 1024;
constexpr size_t WS_POS    = WS_RANK + 512 * 1024;
constexpr size_t WS_TOK    = WS_POS + 512 * 1024;
constexpr size_t WS_TILEE  = WS_TOK + 704 * 1024;
constexpr size_t WS_START  = WS_TILEE + 4096;
constexpr size_t WS_LOGITS = 4 * MiB;
constexpr size_t WS_BIG    = 8 * MiB;
constexpr size_t WS_XS   = WS_BIG;
constexpr size_t WS_RKV  = WS_BIG + 192 * MiB;
constexpr size_t WS_LORA = WS_BIG + 288 * MiB;
constexpr size_t WS_LD   = WS_BIG;
constexpr size_t WS_AA   = WS_BIG + 64 * MiB;
constexpr size_t WS_GG   = WS_BIG + 96 * MiB;
constexpr size_t WS_O    = WS_BIG + 128 * MiB;
constexpr size_t WS_OG   = WS_BIG + 296 * MiB;
constexpr size_t WS_Y1   = WS_BIG + 328 * MiB;
constexpr size_t WS_H2   = WS_BIG;
constexpr size_t WS_H2LO = WS_BIG + 32 * MiB;
constexpr size_t WS_YB   = WS_BIG;
constexpr size_t WS_HB   = WS_BIG + 320 * MiB;
constexpr size_t WS_H3   = WS_BIG + 320 * MiB;
constexpr size_t WS_Q    = WS_BIG;
constexpr size_t WS_AO   = WS_BIG + 96 * MiB;
constexpr size_t WS_Y1B  = WS_BIG + 128 * MiB;
constexpr size_t WS_W     = WS_BIG + 400 * MiB;
constexpr size_t WS_WGU   = WS_W;
constexpr size_t WS_WDN   = WS_WGU + (size_t)65 * 512 * 1024 * 2;
constexpr size_t WS_WRKV  = WS_WDN + (size_t)65 * 1024 * 256 * 2;
constexpr size_t WS_WO    = WS_WRKV + (size_t)3072 * 1024 * 2;
constexpr size_t WS_WQKV  = WS_WO + (size_t)1024 * 1024 * 2;
constexpr size_t WS_WSBO  = WS_WQKV + (size_t)3072 * 1024 * 2;
constexpr size_t WS_WLDN  = WS_WSBO + (size_t)1024 * 1024 * 2;
constexpr size_t WS_WLUP  = WS_WLDN + (size_t)256 * 1024 * 2;
constexpr size_t WS_WRT   = WS_WLUP + (size_t)1024 * 256 * 2;
constexpr size_t WS_END   = WS_WRT + (size_t)2 * 64 * 3072 * 2;

constexpr int CW_BAR = 0;
constexpr int CW_CNT = 4096;

#define XB_TMO      128
#define XB_XCNT(j)  (256  + 64 * (j))
#define XB_XSUB(j)  (1280 + 64 * (j))
#define XB_XGEN(j)  (2304 + 64 * (j))
#define XB_TOP      3328
#define XB_TOPGEN   3392
#define XCD_BAR_WORDS 3456
#define XB_SPIN_CAP (1u << 22)
#define LAS __attribute__((address_space(3)))

__device__ __forceinline__ unsigned xb_ld(unsigned* p)              { return __hip_atomic_load(p, __ATOMIC_RELAXED, __HIP_MEMORY_SCOPE_AGENT); }
__device__ __forceinline__ unsigned xb_add(unsigned* p, unsigned v) { return __hip_atomic_fetch_add(p, v, __ATOMIC_RELAXED, __HIP_MEMORY_SCOPE_AGENT); }
__device__ __forceinline__ unsigned xb_xcc_id() { return (unsigned)__builtin_amdgcn_s_getreg((3 << 11) | 20) & 0xFu; }
#define XB_SPIN(cond, bar) do { unsigned _sp = 0; while (cond) { __builtin_amdgcn_s_sleep(1); \
    if ((++_sp & 255u) == 0u) { if (xb_ld(&(bar)[XB_TMO])) break; if (_sp > XB_SPIN_CAP) { atomicAdd(&(bar)[XB_TMO], 1u); break; } } } } while (0)

struct XcdBarrier { unsigned* bar; unsigned x; volatile LAS unsigned* st; };

__device__ __forceinline__ XcdBarrier xcd_barrier_post(unsigned* bar, volatile LAS unsigned* st) {
    XcdBarrier b; b.bar = bar; b.x = xb_xcc_id(); b.st = st;
    if (threadIdx.x == 0) (void)xb_add(&bar[XB_XCNT(b.x)], 1u);
    return b;
}
__device__ __forceinline__ void xcd_barrier_complete(unsigned* bar, unsigned x, unsigned& nloc, unsigned& nx) {
    const unsigned G = gridDim.x * gridDim.y * gridDim.z;
    unsigned sum, cnt, mine, sp = 0u;
    for (;;) {
        sum = 0u; cnt = 0u; mine = 0u;
#pragma unroll
        for (unsigned j = 0; j < 16; ++j) { const unsigned c = xb_ld(&bar[XB_XCNT(j)]); sum += c; cnt += (c > 0u) ? 1u : 0u; mine = (j == x) ? c : mine; }
        if (sum == G) break;
        __builtin_amdgcn_s_sleep(1);
        if ((++sp & 255u) == 0u) { if (xb_ld(&bar[XB_TMO])) break; if (sp > XB_SPIN_CAP) { atomicAdd(&bar[XB_TMO], 1u); break; } }
    }
    nloc = mine > 0u ? mine : 1u; nx = cnt > 0u ? cnt : 1u;
}
__device__ __forceinline__ void xcd_barrier(const XcdBarrier& b) {
    asm volatile("s_waitcnt vmcnt(0)" ::: "memory");
    __syncthreads();
    if (threadIdx.x == 0) {
        unsigned* bar = b.bar;
        __builtin_amdgcn_s_waitcnt(0);
        unsigned nloc = b.st[0], nx = b.st[1];
        if (nloc == 0u) { xcd_barrier_complete(bar, b.x, nloc, nx); b.st[0] = nloc; b.st[1] = nx; }
        const unsigned old = xb_add(&bar[XB_XSUB(b.x)], 1u);
        const unsigned gen = old / nloc;
        if (old + 1u == (gen + 1u) * nloc) {
            __builtin_amdgcn_fence(__ATOMIC_RELEASE, "agent");
            asm volatile("s_waitcnt vmcnt(0)" ::: "memory");
            const unsigned og = xb_add(&bar[XB_TOP], 1u);
            const unsigned tg = og / nx;
            if (og + 1u == (tg + 1u) * nx) xb_add(&bar[XB_TOPGEN], 1u);
            else XB_SPIN(xb_ld(&bar[XB_TOPGEN]) == tg, bar);
            __builtin_amdgcn_fence(__ATOMIC_ACQUIRE, "agent");
            xb_add(&bar[XB_XGEN(b.x)], 1u);
            asm volatile("s_waitcnt vmcnt(0)" ::: "memory");
        } else {
            XB_SPIN(xb_ld(&bar[XB_XGEN(b.x)]) == gen, bar);
            __builtin_amdgcn_fence(__ATOMIC_ACQUIRE, "agent");
            asm volatile("s_waitcnt vmcnt(0)" ::: "memory");
        }
    }
    __syncthreads();
}

struct Args { const float* in[34]; float* out; unsigned char* ws; int ph_lo, ph_hi; };

struct Frame {
    const float* const* in; float* out; unsigned char* ws; unsigned* ctl;
    float* ldsf; LAS unsigned char* lds; int tid, lane, wave, bid, G;
};

enum { I_X = 0, I_C, I_ADAW, I_ADAB, I_NPM, I_NPOM, I_NPF, I_NPOF, I_MU, I_WRKV, I_WW1, I_WW2, I_W0, I_WA1, I_WA2, I_A0, I_WG1, I_WG2,
       I_KK, I_KA, I_RK, I_LNG, I_LNB, I_WO, I_SBQKV, I_SBO, I_ROUTER, I_RBIAS, I_MG, I_MU_, I_MD, I_SG, I_SU, I_SD };

template <class AF, class BF>
__device__ __forceinline__ void simt_tile(float (&acc)[4][4], const AF& af, const BF& bfn, int row0, int col0, int K, float* sm) {
    float* sA = sm; float* sB = sm + 16 * 132;
    const int tid = threadIdx.x, ty = tid >> 4, tx = tid & 15;
#pragma unroll
    for (int i = 0; i < 4; ++i)
#pragma unroll
        for (int j = 0; j < 4; ++j) acc[i][j] = 0.f;
    for (int k0 = 0; k0 < K; k0 += 16) {
#pragma unroll
        for (int q = 0; q < 4; ++q) { const int idx = tid + 512 * q, r = idx >> 4, kk = idx & 15; sA[kk * 132 + r] = af(row0 + r, k0 + kk); }
#pragma unroll
        for (int q = 0; q < 2; ++q) { const int idx = tid + 512 * q, kk = idx >> 6, c = idx & 63; sB[kk * 68 + c] = bfn(k0 + kk, col0 + c); }
        __syncthreads();
#pragma unroll
        for (int kk = 0; kk < 16; ++kk) {
            const f32x4 a = *(const f32x4*)&sA[kk * 132 + ty * 4];
            const f32x4 b = *(const f32x4*)&sB[kk * 68 + tx * 4];
#pragma unroll
            for (int i = 0; i < 4; ++i)
#pragma unroll
                for (int j = 0; j < 4; ++j) acc[i][j] += a[i] * b[j];
        }
        __syncthreads();
    }
}

typedef short bf16x8 __attribute__((ext_vector_type(8)));
constexpr int HTB = 128 * 64 * 2;
__device__ __forceinline__ int lds_byte(int r, int c) { const int st = (r >> 4) * 2 + (c >> 5), rr = r & 15, cc = c & 31, ob = rr * 64 + cc * 2; return st * 1024 + (ob ^ (((ob >> 9) & 1) << 5)); }
__device__ __forceinline__ void stage_rc(int b, int& R, int& C) { const int st = b / 1024, sb = b % 1024, swz = sb ^ (((sb >> 9) & 1) << 5); R = (st >> 1) * 16 + swz / 64; C = (st & 1) * 32 + (swz % 64) / 2; }
#define WAIT_V(n) asm volatile("s_waitcnt vmcnt(" #n ")" ::: "memory")
#define SBAR() do { asm volatile("" ::: "memory"); __builtin_amdgcn_s_barrier(); asm volatile("" ::: "memory"); } while (0)

struct ASeg { const bf16_t* p[3]; int segTiles; };

struct BRowId { __device__ __forceinline__ int operator()(int R) const { return R; } };
template <int BN, bool NSW = false, class ARow, class Epi, class BRow = BRowId>
__device__ __forceinline__ void sg_tile(LAS unsigned char* lds, const ASeg& A, const ARow& arow, const bf16_t* Bt, int ldb, int nt, const Epi& epi, const BRow& brow = BRow()) {
    constexpr int WN = BN / 64, WM = 8 / WN, WR = 256 / WM, MT = WR / 16;
    const int tid = threadIdx.x, wid = __builtin_amdgcn_readfirstlane(tid >> 6), lane = tid & 63, fr = lane & 15, fq = lane >> 4;
    const int wm = wid / WN, wn = wid % WN;
    unsigned aoffs[2][2], boffs[2];
#pragma unroll
    for (int i = 0; i < 2; ++i) { int R, C; stage_rc(tid * 16 + i * 8192, R, C);
        aoffs[0][i] = arow(R) + (unsigned)C * 2u; aoffs[1][i] = arow(128 + R) + (unsigned)C * 2u; boffs[i] = (unsigned)(brow(R) * ldb + C) * 2u; }
    const unsigned ldsw = (unsigned)wid * 1024u;
    f32x4 acc[MT][4];
#pragma unroll
    for (int m = 0; m < MT; ++m)
#pragma unroll
        for (int n = 0; n < 4; ++n) acc[m][n] = (f32x4){0.f, 0.f, 0.f, 0.f};
    const int arow0 = wm * WR, ah = arow0 >> 7, ar = arow0 & 127;
    const int aoff = ah * HTB + lds_byte(ar + fr, fq * 8), boff = 2 * HTB + lds_byte(wn * 64 + fr, fq * 8);
#define SG_STAGE(kt, s) do { const int sg_ = (kt) / A.segTiles; const char* ab_ = (const char*)(sg_ == 0 ? A.p[0] : (sg_ == 1 ? A.p[1] : A.p[2])) + (size_t)((kt) - sg_ * A.segTiles) * 128; const char* bb_ = (const char*)Bt + (size_t)(kt) * 128; \
        _Pragma("unroll") for (int h_ = 0; h_ < 2; ++h_) _Pragma("unroll") for (int i_ = 0; i_ < 2; ++i_) \
            __builtin_amdgcn_global_load_lds((const unsigned*)(ab_ + aoffs[h_][i_]), (LAS unsigned*)(lds + ((s) * 3 + h_) * HTB + ldsw + i_ * 8192), 16, 0, 0); \
        _Pragma("unroll") for (int i_ = 0; i_ < WN; ++i_) \
            __builtin_amdgcn_global_load_lds((const unsigned*)(bb_ + boffs[i_]), (LAS unsigned*)(lds + ((s) * 3 + 2) * HTB + ldsw + i_ * 8192), 16, 0, 0); } while (0)
    SG_STAGE(0, 0);
    for (int t = 0; t < nt; ++t) {
        const int s = t & 1;
        if (t + 1 < nt) { SG_STAGE(t + 1, s ^ 1); if (WN == 2) WAIT_V(6); else WAIT_V(5); } else { WAIT_V(0); }
        SBAR();
        LAS unsigned char* base = lds + s * 3 * HTB;
#pragma unroll
        for (int k = 0; k < 2; ++k) {
            bf16x8 af[MT], bfr[4];
#pragma unroll
            for (int m = 0; m < MT; ++m) af[m] = *(const LAS bf16x8*)(base + aoff + m * 2048 + k * 1024);
#pragma unroll
            for (int n = 0; n < 4; ++n) bfr[n] = *(const LAS bf16x8*)(base + boff + n * 2048 + k * 1024);
#pragma unroll
            for (int m = 0; m < MT; ++m)
#pragma unroll
                for (int n = 0; n < 4; ++n) acc[m][n] = NSW ? __builtin_amdgcn_mfma_f32_16x16x32_bf16(af[m], bfr[n], acc[m][n], 0, 0, 0) : __builtin_amdgcn_mfma_f32_16x16x32_bf16(bfr[n], af[m], acc[m][n], 0, 0, 0);
        }
        SBAR();
    }
#undef SG_STAGE
    epi(acc, arow0, wn * 64, fr, fq);
}

struct CTile { bf16_t* dst; const float* src; int dld, sld, ncols; };
template <class TF>
__device__ __forceinline__ void conv_tiles(const Frame& F, int ntiles, int u0, int ustride, const TF& tf) {
    unsigned* tl = (unsigned*)F.ldsf;
    const int i = F.tid & 31, kp0 = F.tid >> 5;
    if (u0 >= ntiles) return;
    CTile ct = tf(u0);
    f32x4 a[4], b[4];
#define CV_LOAD() do { _Pragma("unroll") for (int q = 0; q < 4; ++q) { const int kp = kp0 + 16 * q; \
        if (4 * i < ct.ncols) { a[q] = *(const f32x4*)(ct.src + (size_t)(2 * kp) * ct.sld + 4 * i); b[q] = *(const f32x4*)(ct.src + (size_t)(2 * kp + 1) * ct.sld + 4 * i); } } } while (0)
    CV_LOAD();
    for (int u = u0; u < ntiles; u += ustride) {
        const CTile cur = ct;
        if (4 * i < cur.ncols) {
#pragma unroll
            for (int q = 0; q < 4; ++q) { const int kp = kp0 + 16 * q;
#pragma unroll
                for (int e = 0; e < 4; ++e) tl[(4 * i + e) * 65 + kp] = pack2(a[q][e], b[q][e]); }
        }
        __syncthreads();
        if (u + ustride < ntiles) { ct = tf(u + ustride); CV_LOAD(); }
        const int nb = F.tid >> 4, sgm = F.tid & 15;
#pragma unroll
        for (int q = 0; q < 4; ++q) { const int n = nb + 32 * q;
            if (n < cur.ncols) { u32x4 v;
#pragma unroll
                for (int e = 0; e < 4; ++e) v[e] = tl[n * 65 + sgm * 4 + e];
                *(u32x4*)(cur.dst + (size_t)n * cur.dld + sgm * 8) = v; } }
        __syncthreads();
    }
#undef CV_LOAD
}
__device__ __forceinline__ void conv_moe(const Frame& F, int layer, int u0, int ustride) {
    bf16_t* WGU = (bf16_t*)(F.ws + WS_WGU); bf16_t* WDN = (bf16_t*)(F.ws + WS_WDN);
    const float* const* in = F.in;
    conv_tiles(F, 65 * 48, u0, ustride, [=](int u) {
        CTile c; const int e = u / 48, r = u % 48;
        if (r < 32) { const int up = r >> 4, kt = (r >> 1) & 7, nt = r & 1;
            const float* W = (e < 64) ? (up ? in[I_MU_] : in[I_MG]) + ((size_t)layer * NE + e) * D * DE : (up ? in[I_SU] : in[I_SG]) + (size_t)layer * D * DE;
            c.src = W + (size_t)kt * 128 * DE + nt * 128; c.sld = DE; c.dst = WGU + ((size_t)e * 512 + nt * 256 + up * 128) * D + kt * 128; c.dld = D; c.ncols = 128; }
        else { const int v = r - 32, kt = v >> 3, nt = v & 7;
            const float* W = (e < 64) ? in[I_MD] + ((size_t)layer * NE + e) * DE * D : in[I_SD] + (size_t)layer * DE * D;
            c.src = W + (size_t)kt * 128 * D + nt * 128; c.sld = D; c.dst = WDN + ((size_t)e * D + nt * 128) * DE + kt * 128; c.dld = DE; c.ncols = 128; }
        return c; });
}
__device__ __forceinline__ void conv_dense(const Frame& F, int u0, int ustride) {
    bf16_t* WRKV = (bf16_t*)(F.ws + WS_WRKV); bf16_t* WO = (bf16_t*)(F.ws + WS_WO); bf16_t* WQKV = (bf16_t*)(F.ws + WS_WQKV); bf16_t* WSBO = (bf16_t*)(F.ws + WS_WSBO); bf16_t* WLDN = (bf16_t*)(F.ws + WS_WLDN);
    const float* const* in = F.in;
    conv_tiles(F, 192 + 64 + 192 + 64 + 24, u0, ustride, [=](int u) {
        CTile c; c.dld = D; c.ncols = 128;
        if (u < 192) { const int n = u / 64, kt = (u >> 3) & 7, nt = u & 7; c.src = in[I_WRKV] + (size_t)n * D * D + (size_t)kt * 128 * D + nt * 128; c.sld = D; c.dst = WRKV + ((size_t)n * D + nt * 128) * D + kt * 128; }
        else if (u < 256) { const int v = u - 192, kt = v >> 3, nt = v & 7; c.src = in[I_WO] + (size_t)kt * 128 * D + nt * 128; c.sld = D; c.dst = WO + (size_t)nt * 128 * D + kt * 128; }
        else if (u < 448) { const int v = u - 256, kt = v / 24, nt = v % 24; c.src = in[I_SBQKV] + (size_t)kt * 128 * 3 * D + nt * 128; c.sld = 3 * D; c.dst = WQKV + (size_t)nt * 128 * D + kt * 128; }
        else if (u < 512) { const int v = u - 448, kt = v >> 3, nt = v & 7; c.src = in[I_SBO] + (size_t)kt * 128 * D + nt * 128; c.sld = D; c.dst = WSBO + (size_t)nt * 128 * D + kt * 128; }
        else { const int v = u - 512, kt = v / 3, j = v % 3;
            if (j == 0) { c.src = in[I_WW1] + (size_t)kt * 128 * 64; c.sld = 64; c.dst = WLDN + kt * 128; c.ncols = 64; }
            else if (j == 1) { c.src = in[I_WA1] + (size_t)kt * 128 * 64; c.sld = 64; c.dst = WLDN + (size_t)64 * D + kt * 128; c.ncols = 64; }
            else { c.src = in[I_WG1] + (size_t)kt * 128 * 128; c.sld = 128; c.dst = WLDN + (size_t)128 * D + kt * 128; } }
        return c; });
    bf16_t* WLUP = (bf16_t*)(F.ws + WS_WLUP); bf16_t* WRT = (bf16_t*)(F.ws + WS_WRT);
    const int gtid = u0 * NTHREADS + F.tid, gstride = ustride * NTHREADS;
    for (int i = gtid; i < 1024 * 256; i += gstride) {
        float v;
        if (i < 1024 * 64) { const int n = i / 64, k = i % 64; v = F.in[I_WW2][k * D + n]; }
        else if (i < 2 * 1024 * 64) { const int j = i - 1024 * 64, n = j / 64, k = j % 64; v = F.in[I_WA2][k * D + n]; }
        else { const int j = i - 2 * 1024 * 64, n = j / 128, k = j % 128; v = F.in[I_WG2][k * D + n]; }
        WLUP[i] = f2bf(v);
    }
    for (int i = gtid; i < 2 * 64 * 1024; i += gstride) {
        const int l = i / (64 * 1024), j = i % (64 * 1024), e = j / 1024, k = j % 1024;
        const float w = F.in[I_ROUTER][((size_t)l * D + k) * NE + e]; const bf16_t hi = f2bf(w), lo = f2bf(w - bf2f(hi));
        bf16_t* row = WRT + ((size_t)l * 64 + e) * 3072; row[k] = hi; row[1024 + k] = lo; row[2048 + k] = hi;
    }
}

__device__ __forceinline__ void ph_mod(const Frame& F) {
    const float* c = F.in[I_C]; const float* W = F.in[I_ADAW]; const float* bias = F.in[I_ADAB];
    float* MOD = (float*)(F.ws + WS_MOD);
    float* red = F.ldsf;
    float* sc = F.ldsf + 1024;
    for (int i = F.tid; i < 2 * D; i += NTHREADS) { const float v = c[i]; sc[i] = v * sigmoidf_(v); }
    __syncthreads();
    for (int u = F.bid; u < 192; u += F.G) {
        const int l = u / 96, cg = u % 96, col = cg * 64 + F.lane;
        float s0 = 0.f, s1 = 0.f;
        const float* wp = W + ((size_t)l * D + F.wave * 128) * 6144 + col;
#pragma unroll 1
        for (int d0 = 0; d0 < 128; d0 += 32) {
            float wv[32];
#pragma unroll
            for (int d = 0; d < 32; ++d) wv[d] = wp[(size_t)(d0 + d) * 6144];
#pragma unroll
            for (int d = 0; d < 32; ++d) { const int dd = F.wave * 128 + d0 + d; s0 += sc[dd] * wv[d]; s1 += sc[D + dd] * wv[d]; }
        }
        red[(F.wave * 2 + 0) * 64 + F.lane] = s0; red[(F.wave * 2 + 1) * 64 + F.lane] = s1;
        __syncthreads();
        if (F.tid < 128) {
            const int b = F.tid >> 6, cc = F.tid & 63; float s = 0.f;
#pragma unroll
            for (int w = 0; w < 8; ++w) s += red[(w * 2 + b) * 64 + cc];
            MOD[(l * 2 + b) * 6144 + cg * 64 + cc] = s + bias[l * 6144 + cg * 64 + cc];
        }
        __syncthreads();
    }
}

__device__ __forceinline__ void ph_prenorm_rwkv(const Frame& F) {
    const float* x = F.in[I_X]; const float* g = F.in[I_NPM]; const float* mu = F.in[I_MU];
    const float* MOD = (const float*)(F.ws + WS_MOD);
    bf16_t* XS = (bf16_t*)(F.ws + WS_XS);
    const int nunits = T / 8;
    for (int u = F.bid * NWAVES + F.wave; u < nunits; u += F.G * NWAVES) {
        const int t0 = u * 8, b = t0 / SEQ;
        const float* shift = MOD + (0 * 2 + b) * 6144; const float* scale = shift + 1024;
        f32x4 gm[4], sh[4];
#pragma unroll
        for (int i = 0; i < 4; ++i) { const int c = 4 * F.lane + 256 * i; const f32x4 gv = *(const f32x4*)(g + c), sc = *(const f32x4*)(scale + c); gm[i] = gv * (sc + 1.0f); sh[i] = *(const f32x4*)(shift + c); }
        f32x4 hp[4];
#pragma unroll
        for (int i = 0; i < 4; ++i) hp[i] = (f32x4){0.f, 0.f, 0.f, 0.f};
        const int tstart = (t0 % SEQ == 0) ? t0 : t0 - 1;
        for (int t = tstart; t < t0 + 8; ++t) {
            f32x4 xv[4]; float ss = 0.f;
#pragma unroll
            for (int i = 0; i < 4; ++i) { xv[i] = *(const f32x4*)(x + (size_t)t * D + 4 * F.lane + 256 * i); ss += xv[i][0] * xv[i][0] + xv[i][1] * xv[i][1] + xv[i][2] * xv[i][2] + xv[i][3] * xv[i][3]; }
            ss = wave_sum(ss);
            const float rs = rsqrtf(ss * (1.0f / D) + 1e-6f);
            f32x4 h[4];
#pragma unroll
            for (int i = 0; i < 4; ++i) h[i] = xv[i] * rs * gm[i] + sh[i];
            if (t >= t0) {
#pragma unroll
                for (int n = 0; n < 6; ++n) {
#pragma unroll
                    for (int i = 0; i < 4; ++i) {
                        const int c = 4 * F.lane + 256 * i;
                        const f32x4 m = *(const f32x4*)(mu + n * D + c);
                        const f32x4 v = h[i] + (hp[i] - h[i]) * m;
                        u32x2 w; w.x = pack2(v[0], v[1]); w.y = pack2(v[2], v[3]);
                        *(u32x2*)(XS + ((size_t)n * T + t) * D + c) = w;
                    }
                }
            }
#pragma unroll
            for (int i = 0; i < 4; ++i) hp[i] = h[i];
        }
    }
}

__device__ __forceinline__ void ph_rkv_lora_simt(const Frame& F) {
    const bf16_t* XS = (const bf16_t*)(F.ws + WS_XS);
    bf16_t* RKV = (bf16_t*)(F.ws + WS_RKV); bf16_t* LORA = (bf16_t*)(F.ws + WS_LORA);
    const int nct = 52, nunits = (T / 128) * nct;
    for (int u = F.bid; u < nunits; u += F.G) {
        const int rt = u / nct, ct = u % nct, row0 = rt * 128;
        float acc[4][4];
        const int ty = F.tid >> 4, tx = F.tid & 15;
        if (ct < 48) {
            const int n = ct / 16, col0 = (ct % 16) * 64;
            const bf16_t* A = XS + (size_t)n * T * D; const float* W = F.in[I_WRKV] + (size_t)n * D * D;
            simt_tile(acc, [&](int r, int k) { return bf2f(A[(size_t)r * D + k]); }, [&](int k, int c) { return W[(size_t)k * D + c]; }, row0, col0, D, F.ldsf);
#pragma unroll
            for (int i = 0; i < 4; ++i) { u32x2 w; w.x = pack2(acc[i][0], acc[i][1]); w.y = pack2(acc[i][2], acc[i][3]);
                *(u32x2*)(RKV + ((size_t)n * T + row0 + ty * 4 + i) * D + col0 + tx * 4) = w; }
        } else {
            const int j = ct - 48;
            const int n = (j == 0) ? 3 : (j == 1 ? 4 : 5);
            const bf16_t* A = XS + (size_t)n * T * D;
            const float* W = (j == 0) ? F.in[I_WW1] : (j == 1 ? F.in[I_WA1] : F.in[I_WG1]);
            const int ldw = (j >= 2) ? 128 : 64, coff = (j == 3) ? 64 : 0;
            simt_tile(acc, [&](int r, int k) { return bf2f(A[(size_t)r * D + k]); }, [&](int k, int c) { return W[(size_t)k * ldw + coff + c]; }, row0, 0, D, F.ldsf);
#pragma unroll
            for (int i = 0; i < 4; ++i) {
                float v[4];
#pragma unroll
                for (int q = 0; q < 4; ++q) { const float a = acc[i][q]; v[q] = (j == 0) ? tanhf(a) : (j == 1 ? a : sigmoidf_(a)); }
                u32x2 w; w.x = pack2(v[0], v[1]); w.y = pack2(v[2], v[3]);
                *(u32x2*)(LORA + (size_t)(row0 + ty * 4 + i) * 256 + j * 64 + tx * 4) = w;
            }
        }
    }
}

__device__ __forceinline__ void ph_lora_up_simt(const Frame& F) {
    const bf16_t* LORA = (const bf16_t*)(F.ws + WS_LORA);
    float* LD = (float*)(F.ws + WS_LD); bf16_t* AA = (bf16_t*)(F.ws + WS_AA); bf16_t* GG = (bf16_t*)(F.ws + WS_GG);
    const int nunits = (T / 128) * 48;
    for (int u = F.bid; u < nunits; u += F.G) {
        const int rt = u / 48, ct = u % 48, row0 = rt * 128, which = ct / 16, col0 = (ct % 16) * 64;
        const int ty = F.tid >> 4, tx = F.tid & 15;
        float acc[4][4];
        const float* W = which == 0 ? F.in[I_WW2] : (which == 1 ? F.in[I_WA2] : F.in[I_WG2]);
        const int K = which == 2 ? 128 : 64, koff = which * 64;
        simt_tile(acc, [&](int r, int k) { return bf2f(LORA[(size_t)r * 256 + koff + k]); }, [&](int k, int c) { return W[(size_t)k * D + c]; }, row0, col0, K, F.ldsf);
#pragma unroll
        for (int i = 0; i < 4; ++i) {
            const size_t o = (size_t)(row0 + ty * 4 + i) * D + col0 + tx * 4;
            if (which == 0) {
                f32x4 v;
#pragma unroll
                for (int q = 0; q < 4; ++q) { const float wl = F.in[I_W0][col0 + tx * 4 + q] + acc[i][q]; const float wlog = -softplusf_(-wl) - 0.5f; v[q] = -__expf(wlog); }
                *(f32x4*)(LD + o) = v;
            } else if (which == 1) {
                float v[4];
#pragma unroll
                for (int q = 0; q < 4; ++q) v[q] = sigmoidf_(F.in[I_A0][col0 + tx * 4 + q] + acc[i][q]);
                u32x2 w; w.x = pack2(v[0], v[1]); w.y = pack2(v[2], v[3]); *(u32x2*)(AA + o) = w;
            } else {
                u32x2 w; w.x = pack2(acc[i][0], acc[i][1]); w.y = pack2(acc[i][2], acc[i][3]); *(u32x2*)(GG + o) = w;
            }
        }
    }
}

__device__ __forceinline__ void ph_wkv_seq(const Frame& F) {
    const bf16_t* RKV = (const bf16_t*)(F.ws + WS_RKV); const float* LD = (const float*)(F.ws + WS_LD); const bf16_t* AA = (const bf16_t*)(F.ws + WS_AA);
    float* O = (float*)(F.ws + WS_O);
    const bf16_t* Rb = RKV; const bf16_t* Kb = RKV + (size_t)T * D; const bf16_t* Vb = RKV + (size_t)2 * T * D;
    for (int u = F.bid; u < NB * NH; u += F.G) {
        const int b = u / NH, h = u % NH, i = F.tid >> 3, js = F.tid & 7;
        const int cj = h * 64 + js * 8;
        float kkw[8], kaw[8];
#pragma unroll
        for (int e = 0; e < 8; ++e) { kkw[e] = F.in[I_KK][cj + e]; kaw[e] = F.in[I_KA][cj + e]; }
        float S[8];
#pragma unroll
        for (int e = 0; e < 8; ++e) S[e] = 0.f;
        size_t base = (size_t)(b * SEQ) * D;
        u32x4 kr = *(const u32x4*)(Kb + base + cj), rr = *(const u32x4*)(Rb + base + cj), ar = *(const u32x4*)(AA + base + cj);
        f32x4 l0 = *(const f32x4*)(LD + base + cj), l1 = *(const f32x4*)(LD + base + cj + 4);
        bf16_t vr = Vb[base + h * 64 + i];
        for (int t = 0; t < SEQ; ++t) {
            const u32x4 kc = kr, rc = rr, ac = ar; const f32x4 lc0 = l0, lc1 = l1; const bf16_t vc = vr;
            if (t + 1 < SEQ) { const size_t nb = base + D;
                kr = *(const u32x4*)(Kb + nb + cj); rr = *(const u32x4*)(Rb + nb + cj); ar = *(const u32x4*)(AA + nb + cj);
                l0 = *(const f32x4*)(LD + nb + cj); l1 = *(const f32x4*)(LD + nb + cj + 4); vr = Vb[nb + h * 64 + i]; }
            float k[8], r[8], a[8], ld[8];
#pragma unroll
            for (int q = 0; q < 4; ++q) { k[2 * q] = lo2f(kc[q]); k[2 * q + 1] = hi2f(kc[q]); r[2 * q] = lo2f(rc[q]); r[2 * q + 1] = hi2f(rc[q]); a[2 * q] = lo2f(ac[q]); a[2 * q + 1] = hi2f(ac[q]); }
#pragma unroll
            for (int q = 0; q < 4; ++q) { ld[q] = lc0[q]; ld[4 + q] = lc1[q]; }
            const float v = bf2f(vc);
            float kkv[8], ss = 0.f;
#pragma unroll
            for (int e = 0; e < 8; ++e) { kkv[e] = k[e] * kkw[e]; ss += kkv[e] * kkv[e]; }
            ss += __shfl_xor(ss, 1); ss += __shfl_xor(ss, 2); ss += __shfl_xor(ss, 4);
            const float inv = 1.0f / fmaxf(sqrtf(ss), 1e-12f);
            float sa = 0.f;
#pragma unroll
            for (int e = 0; e < 8; ++e) { kkv[e] *= inv; sa += S[e] * (-kkv[e]); }
            sa += __shfl_xor(sa, 1); sa += __shfl_xor(sa, 2); sa += __shfl_xor(sa, 4);
            float o = 0.f;
#pragma unroll
            for (int e = 0; e < 8; ++e) {
                const float kf = k[e] * (1.0f + (a[e] - 1.0f) * kaw[e]);
                S[e] = S[e] * __expf(ld[e]) + sa * (kkv[e] * a[e]) + v * kf;
                o += S[e] * r[e];
            }
            o += __shfl_xor(o, 1); o += __shfl_xor(o, 2); o += __shfl_xor(o, 4);
            if (js == 0) O[base + h * 64 + i] = o;
            base += D;
        }
    }
}

__device__ __forceinline__ void ld16bf(const bf16_t* p, float (&v)[16]) {
    const u32x4 a = *(const u32x4*)p, b = *(const u32x4*)(p + 8);
#pragma unroll
    for (int q = 0; q < 4; ++q) { v[2 * q] = lo2f(a[q]); v[2 * q + 1] = hi2f(a[q]); v[8 + 2 * q] = lo2f(b[q]); v[9 + 2 * q] = hi2f(b[q]); }
}
__device__ __forceinline__ void st16bf(bf16_t* p, const float (&v)[16]) {
    u32x4 a, b;
#pragma unroll
    for (int q = 0; q < 4; ++q) { a[q] = pack2(v[2 * q], v[2 * q + 1]); b[q] = pack2(v[8 + 2 * q], v[9 + 2 * q]); }
    *(u32x4*)p = a; *(u32x4*)(p + 8) = b;
}
__device__ __forceinline__ void ld16f(const float* p, float (&v)[16]) {
#pragma unroll
    for (int q = 0; q < 4; ++q) { const f32x4 a = *(const f32x4*)(p + 4 * q); v[4 * q] = a[0]; v[4 * q + 1] = a[1]; v[4 * q + 2] = a[2]; v[4 * q + 3] = a[3]; }
}
__device__ __forceinline__ void ph_wkv_post(const Frame& F) {
    const bf16_t* RKV = (const bf16_t*)(F.ws + WS_RKV); const bf16_t* AA = (const bf16_t*)(F.ws + WS_AA); const bf16_t* GG = (const bf16_t*)(F.ws + WS_GG);
    const float* O = (const float*)(F.ws + WS_O); bf16_t* OG = (bf16_t*)(F.ws + WS_OG);
    const int c0 = 16 * F.lane;
    float ka[16], rk[16], lg[16], lb[16];
    ld16f(F.in[I_KA] + c0, ka); ld16f(F.in[I_RK] + c0, rk); ld16f(F.in[I_LNG] + c0, lg); ld16f(F.in[I_LNB] + c0, lb);
    for (int t = F.bid * NWAVES + F.wave; t < T; t += F.G * NWAVES) {
        const size_t o = (size_t)t * D + c0;
        float ov[16], r[16], k[16], v[16], a[16], g[16];
        ld16f(O + o, ov); ld16bf(RKV + o, r); ld16bf(RKV + (size_t)T * D + o, k); ld16bf(RKV + (size_t)2 * T * D + o, v); ld16bf(AA + o, a); ld16bf(GG + o, g);
        float s = 0.f, bs = 0.f;
#pragma unroll
        for (int e = 0; e < 16; ++e) { s += ov[e]; const float kf = k[e] * (1.0f + (a[e] - 1.0f) * ka[e]); bs += r[e] * kf * rk[e]; }
        s += __shfl_xor(s, 1); s += __shfl_xor(s, 2); bs += __shfl_xor(bs, 1); bs += __shfl_xor(bs, 2);
        const float mean = s * (1.0f / 64.0f);
        float q = 0.f;
#pragma unroll
        for (int e = 0; e < 16; ++e) { const float d = ov[e] - mean; q += d * d; }
        q += __shfl_xor(q, 1); q += __shfl_xor(q, 2);
        const float rstd = rsqrtf(q * (1.0f / 64.0f) + 64e-5f);
        float res[16];
#pragma unroll
        for (int e = 0; e < 16; ++e) res[e] = (((ov[e] - mean) * rstd) * lg[e] + lb[e] + bs * v[e]) * g[e];
        st16bf(OG + o, res);
    }
}

template <int OUTMODE>
__device__ __forceinline__ void ph_dense_simt(const Frame& F, const bf16_t* A, const float* W, int N, int K, void* out) {
    const int nct = N / 64, nunits = (T / 128) * nct;
    for (int u = F.bid; u < nunits; u += F.G) {
        const int rt = u / nct, ct = u % nct, row0 = rt * 128, col0 = ct * 64;
        const int ty = F.tid >> 4, tx = F.tid & 15;
        float acc[4][4];
        simt_tile(acc, [&](int r, int k) { return bf2f(A[(size_t)r * K + k]); }, [&](int k, int c) { return W[(size_t)k * N + c]; }, row0, col0, K, F.ldsf);
#pragma unroll
        for (int i = 0; i < 4; ++i) {
            const int r = row0 + ty * 4 + i, c = col0 + tx * 4;
            if (OUTMODE == 0) { *(f32x4*)((float*)out + (size_t)r * N + c) = (f32x4){acc[i][0], acc[i][1], acc[i][2], acc[i][3]}; }
            else { u32x2 w; w.x = pack2(acc[i][0], acc[i][1]); w.y = pack2(acc[i][2], acc[i][3]);
                   *(u32x2*)((bf16_t*)out + (size_t)(c / D) * T * D + (size_t)r * D + (c % D)) = w; }
        }
    }
}

__device__ __forceinline__ void ph_postmix_preffn(const Frame& F, int layer, const float* xin, const float* Y) {
    const float* MOD = (const float*)(F.ws + WS_MOD);
    const float* gpo = F.in[I_NPOM] + layer * D; const float* gpf = F.in[I_NPF] + layer * D;
    bf16_t* H2 = (bf16_t*)(F.ws + WS_H2); bf16_t* H2LO = (bf16_t*)(F.ws + WS_H2LO);
    for (int t = F.bid * NWAVES + F.wave; t < T; t += F.G * NWAVES) {
        const int b = t / SEQ; const float* m = MOD + (layer * 2 + b) * 6144;
        f32x4 y[4]; float ss = 0.f;
#pragma unroll
        for (int i = 0; i < 4; ++i) { y[i] = *(const f32x4*)(Y + (size_t)t * D + 4 * F.lane + 256 * i); ss += y[i][0] * y[i][0] + y[i][1] * y[i][1] + y[i][2] * y[i][2] + y[i][3] * y[i][3]; }
        ss = wave_sum(ss);
        const float rs = rsqrtf(ss * (1.0f / D) + 1e-6f);
        f32x4 x1[4]; float s2 = 0.f;
#pragma unroll
        for (int i = 0; i < 4; ++i) { const int c = 4 * F.lane + 256 * i;
            const f32x4 xv = *(const f32x4*)(xin + (size_t)t * D + c), gm = *(const f32x4*)(m + 2048 + c), gp = *(const f32x4*)(gpo + c);
            x1[i] = xv + gm * (y[i] * rs * gp);
            *(f32x4*)(F.out + (size_t)t * D + c) = x1[i];
            s2 += x1[i][0] * x1[i][0] + x1[i][1] * x1[i][1] + x1[i][2] * x1[i][2] + x1[i][3] * x1[i][3]; }
        s2 = wave_sum(s2);
        const float rs2 = rsqrtf(s2 * (1.0f / D) + 1e-6f);
#pragma unroll
        for (int i = 0; i < 4; ++i) { const int c = 4 * F.lane + 256 * i;
            const f32x4 gf = *(const f32x4*)(gpf + c), sc = *(const f32x4*)(m + 4096 + c), sh = *(const f32x4*)(m + 3072 + c);
            const f32x4 h = x1[i] * rs2 * gf * (sc + 1.0f) + sh;
            u32x2 w; w.x = pack2(h[0], h[1]); w.y = pack2(h[2], h[3]);
            u32x2 wl; wl.x = pack2(h[0] - lo2f(w.x), h[1] - hi2f(w.x)); wl.y = pack2(h[2] - lo2f(w.y), h[3] - hi2f(w.y));
            *(u32x2*)(H2 + (size_t)t * D + c) = w; *(u32x2*)(H2LO + (size_t)t * D + c) = wl; }
    }
}

__device__ __forceinline__ void ph_router_simt(const Frame& F, int layer) {
    const bf16_t* H2 = (const bf16_t*)(F.ws + WS_H2); const bf16_t* H2LO = (const bf16_t*)(F.ws + WS_H2LO);
    const float* W = F.in[I_ROUTER] + (size_t)layer * D * NE; float* LOG = (float*)(F.ws + WS_LOGITS);
    for (int u = F.bid; u < T / 128; u += F.G) {
        const int row0 = u * 128, ty = F.tid >> 4, tx = F.tid & 15;
        float acc[4][4];
        simt_tile(acc, [&](int r, int k) { return bf2f(H2[(size_t)r * D + k]) + bf2f(H2LO[(size_t)r * D + k]); }, [&](int k, int c) { return W[(size_t)k * NE + c]; }, row0, 0, D, F.ldsf);
#pragma unroll
        for (int i = 0; i < 4; ++i) *(f32x4*)(LOG + (size_t)(row0 + ty * 4 + i) * NE + tx * 4) = (f32x4){acc[i][0], acc[i][1], acc[i][2], acc[i][3]};
    }
}

__device__ __forceinline__ void ph_topk(const Frame& F, int layer) {
    const float* LOG = (const float*)(F.ws + WS_LOGITS); const float* rb = F.in[I_RBIAS] + layer * NE;
    int* IDX = (int*)(F.ws + WS_IDX); float* GATE = (float*)(F.ws + WS_GATE); int* RANK = (int*)(F.ws + WS_RANK);
    unsigned* CNT = F.ctl + CW_CNT + layer * 64;
    unsigned* lcnt = (unsigned*)F.ldsf; unsigned* gb = lcnt + 64;
    const float bias = rb[F.lane];
    for (int base = F.bid * 64; base < T; base += F.G * 64) {
        if (F.tid < 64) lcnt[F.tid] = 0u;
        __syncthreads();
        int myidx[8]; unsigned lrank[8];
#pragma unroll
        for (int j = 0; j < 8; ++j) {
            const int t = base + F.wave * 8 + j;
            const float s = sigmoidf_(LOG[(size_t)t * NE + F.lane]);
            float sel = s + bias;
            int mi = 0; float mysc = 0.f; float tot = 0.f;
#pragma unroll
            for (int k = 0; k < TOPK; ++k) {
                float bv = sel; int bi = F.lane;
#pragma unroll
                for (int o = 32; o >= 1; o >>= 1) { const float ov = __shfl_xor(bv, o); const int oi = __shfl_xor(bi, o); if (ov > bv || (ov == bv && oi < bi)) { bv = ov; bi = oi; } }
                const float sc = __shfl(s, bi);
                tot += sc;
                if (F.lane == k) { mi = bi; mysc = sc; }
                if (F.lane == bi) sel = -1e30f;
            }
            myidx[j] = mi; lrank[j] = 0u;
            if (F.lane < TOPK) { IDX[t * TOPK + F.lane] = mi; GATE[t * TOPK + F.lane] = 2.5f * mysc / tot; lrank[j] = atomicAdd(&lcnt[mi], 1u); }
        }
        __syncthreads();
        if (F.tid < 64) gb[F.tid] = atomicAdd(&CNT[F.tid], lcnt[F.tid]);
        __syncthreads();
#pragma unroll
        for (int j = 0; j < 8; ++j) { const int t = base + F.wave * 8 + j; if (F.lane < TOPK) RANK[t * TOPK + F.lane] = (int)(gb[myidx[j]] + lrank[j]); }
        __syncthreads();
    }
}

__device__ __forceinline__ void ph_offsets(const Frame& F, int layer) {
    const unsigned* CNT = F.ctl + CW_CNT + layer * 64;
    const int* IDX = (const int*)(F.ws + WS_IDX); const int* RANK = (const int*)(F.ws + WS_RANK);
    int* POS = (int*)(F.ws + WS_POS); int* TOK = (int*)(F.ws + WS_TOK); int* TILEE = (int*)(F.ws + WS_TILEE); int* START = (int*)(F.ws + WS_START);
    int* sst = (int*)F.ldsf;
    if (F.tid < NE) sst[128 + F.tid] = (int)CNT[F.tid];
    __syncthreads();
    if (F.tid == 0) { int acc = 0; for (int e = 0; e < NE; ++e) { const int c = sst[128 + e]; sst[e] = acc; acc += ((c + RP - 1) / RP) * RP; } sst[64] = acc; }
    __syncthreads();
    if (F.bid == 0) {
        if (F.tid <= 64) START[F.tid] = sst[F.tid];
        if (F.tid == 65) START[65] = sst[64];
        const int ntile = sst[64] / RP;
        for (int i = F.tid; i < ntile; i += NTHREADS) { int e = 0; while (e < 63 && sst[e + 1] <= i * RP) ++e; TILEE[i] = e; }
    }
    for (int s = F.bid * NTHREADS + F.tid; s < T * TOPK; s += F.G * NTHREADS) {
        const int e = IDX[s], p = sst[e] + RANK[s];
        POS[s] = p; TOK[p] = s / TOPK;
    }
    for (int s = F.bid * NTHREADS + F.tid; s < NE * RP; s += F.G * NTHREADS) {
        const int e = s / RP, r = s % RP, c = sst[128 + e];
        if (sst[e] + c + r < sst[e + 1]) TOK[sst[e] + c + r] = 0;
    }
    __syncthreads();
}

__device__ __forceinline__ void ph_gateup_simt(const Frame& F, int layer) {
    const bf16_t* H2 = (const bf16_t*)(F.ws + WS_H2); bf16_t* HB = (bf16_t*)(F.ws + WS_HB);
    const int* TOK = (const int*)(F.ws + WS_TOK); const int* TILEE = (const int*)(F.ws + WS_TILEE); const int* START = (const int*)(F.ws + WS_START);
    const int routed = START[65], nrt = (routed + T) / 128, nunits = nrt * 4;
    for (int u = F.bid; u < nunits; u += F.G) {
        const int rt = u / 4, ct = u % 4, row0 = rt * 128, col0 = ct * 64, ty = F.tid >> 4, tx = F.tid & 15;
        const bool sh = row0 >= routed; const int e = sh ? 0 : TILEE[row0 / RP];
        const float* Wg = sh ? F.in[I_SG] + (size_t)layer * D * DE : F.in[I_MG] + ((size_t)layer * NE + e) * D * DE;
        const float* Wu = sh ? F.in[I_SU] + (size_t)layer * D * DE : F.in[I_MU_] + ((size_t)layer * NE + e) * D * DE;
        auto af = [&](int r, int k) { const int tok = sh ? (r - routed) : TOK[r]; return bf2f(H2[(size_t)tok * D + k]); };
        float ag[4][4], au[4][4];
        simt_tile(ag, af, [&](int k, int c) { return Wg[(size_t)k * DE + c]; }, row0, col0, D, F.ldsf);
        simt_tile(au, af, [&](int k, int c) { return Wu[(size_t)k * DE + c]; }, row0, col0, D, F.ldsf);
#pragma unroll
        for (int i = 0; i < 4; ++i) { float v[4];
#pragma unroll
            for (int q = 0; q < 4; ++q) { const float g = ag[i][q]; v[q] = g * sigmoidf_(g) * au[i][q]; }
            u32x2 w; w.x = pack2(v[0], v[1]); w.y = pack2(v[2], v[3]);
            *(u32x2*)(HB + (size_t)(row0 + ty * 4 + i) * DE + col0 + tx * 4) = w; }
    }
}
__device__ __forceinline__ void ph_down_simt(const Frame& F, int layer) {
    const bf16_t* HB = (const bf16_t*)(F.ws + WS_HB); bf16_t* YB = (bf16_t*)(F.ws + WS_YB);
    const int* TILEE = (const int*)(F.ws + WS_TILEE); const int* START = (const int*)(F.ws + WS_START);
    const int routed = START[65], nrt = (routed + T) / 128, nunits = nrt * 16;
    for (int u = F.bid; u < nunits; u += F.G) {
        const int rt = u / 16, ct = u % 16, row0 = rt * 128, col0 = ct * 64, ty = F.tid >> 4, tx = F.tid & 15;
        const bool sh = row0 >= routed; const int e = sh ? 0 : TILEE[row0 / RP];
        const float* Wd = sh ? F.in[I_SD] + (size_t)layer * DE * D : F.in[I_MD] + ((size_t)layer * NE + e) * DE * D;
        float acc[4][4];
        simt_tile(acc, [&](int r, int k) { return bf2f(HB[(size_t)r * DE + k]); }, [&](int k, int c) { return Wd[(size_t)k * D + c]; }, row0, col0, DE, F.ldsf);
#pragma unroll
        for (int i = 0; i < 4; ++i) { u32x2 w; w.x = pack2(acc[i][0], acc[i][1]); w.y = pack2(acc[i][2], acc[i][3]);
            *(u32x2*)(YB + (size_t)(row0 + ty * 4 + i) * D + col0 + tx * 4) = w; }
    }
}
__device__ __forceinline__ void ph_combine(const Frame& F, int layer, bool next) {
    const bf16_t* YB = (const bf16_t*)(F.ws + WS_YB); const int* POS = (const int*)(F.ws + WS_POS); const float* GATE = (const float*)(F.ws + WS_GATE);
    const int* START = (const int*)(F.ws + WS_START); const float* MOD = (const float*)(F.ws + WS_MOD);
    const float* gpo = F.in[I_NPOF] + layer * D;
    bf16_t* H3 = (bf16_t*)(F.ws + WS_H3);
    const int routed = START[65];
    for (int t = F.bid * NWAVES + F.wave; t < T; t += F.G * NWAVES) {
        const int b = t / SEQ; const float* m = MOD + (layer * 2 + b) * 6144;
        f32x4 y[4];
#pragma unroll
        for (int i = 0; i < 4; ++i) { const u32x2 w = *(const u32x2*)(YB + (size_t)(routed + t) * D + 4 * F.lane + 256 * i); y[i] = (f32x4){lo2f(w.x), hi2f(w.x), lo2f(w.y), hi2f(w.y)}; }
#pragma unroll
        for (int k = 0; k < TOPK; ++k) {
            const int p = POS[t * TOPK + k]; const float gk = GATE[t * TOPK + k];
#pragma unroll
            for (int i = 0; i < 4; ++i) { const u32x2 w = *(const u32x2*)(YB + (size_t)p * D + 4 * F.lane + 256 * i); y[i] += (f32x4){lo2f(w.x), hi2f(w.x), lo2f(w.y), hi2f(w.y)} * gk; }
        }
        float ss = 0.f;
#pragma unroll
        for (int i = 0; i < 4; ++i) ss += y[i][0] * y[i][0] + y[i][1] * y[i][1] + y[i][2] * y[i][2] + y[i][3] * y[i][3];
        ss = wave_sum(ss);
        const float rs = rsqrtf(ss * (1.0f / D) + 1e-6f);
        f32x4 x2[4]; float s2 = 0.f;
#pragma unroll
        for (int i = 0; i < 4; ++i) { const int c = 4 * F.lane + 256 * i;
            const f32x4 xv = *(const f32x4*)(F.out + (size_t)t * D + c), gm = *(const f32x4*)(m + 5120 + c), gp = *(const f32x4*)(gpo + c);
            x2[i] = xv + gm * (y[i] * rs * gp);
            *(f32x4*)(F.out + (size_t)t * D + c) = x2[i];
            s2 += x2[i][0] * x2[i][0] + x2[i][1] * x2[i][1] + x2[i][2] * x2[i][2] + x2[i][3] * x2[i][3]; }
        if (next) {
            s2 = wave_sum(s2);
            const float rs2 = rsqrtf(s2 * (1.0f / D) + 1e-6f);
            const float* m1 = MOD + ((layer + 1) * 2 + b) * 6144; const float* g1 = F.in[I_NPM] + (layer + 1) * D;
#pragma unroll
            for (int i = 0; i < 4; ++i) { const int c = 4 * F.lane + 256 * i;
                const f32x4 gf = *(const f32x4*)(g1 + c), sc = *(const f32x4*)(m1 + 1024 + c), sh = *(const f32x4*)(m1 + c);
                const f32x4 h = x2[i] * rs2 * gf * (sc + 1.0f) + sh;
                u32x2 w; w.x = pack2(h[0], h[1]); w.y = pack2(h[2], h[3]);
                *(u32x2*)(H3 + (size_t)t * D + c) = w; }
        }
    }
}

#define SB_EXIT 110.0f
__device__ __forceinline__ void ph_attn_ref(const Frame& F) {
    const bf16_t* Q = (const bf16_t*)(F.ws + WS_Q); const bf16_t* Kb = Q + (size_t)T * D; const bf16_t* Vb = Q + (size_t)2 * T * D;
    bf16_t* AO = (bf16_t*)(F.ws + WS_AO);
    float* Ks = F.ldsf; float* Vs = Ks + 64 * 65; float* Qs = Vs + 64 * 65; float* Ws = Qs + 64 * 64; float* Rm = Ws + 8 * 64;
    const int nunits = NB * NH * (SEQ / 64);
    for (int u = F.bid; u < nunits; u += F.G) {
        const int qt = (SEQ / 64 - 1) - (u / (NB * NH)), bh = u % (NB * NH), b = bh / NH, h = bh % NH;
        const size_t tb = (size_t)b * SEQ;
        for (int idx = F.tid; idx < 64 * 64; idx += NTHREADS) { const int r = idx >> 6, c = idx & 63; Qs[idx] = bf2f(Q[(tb + qt * 64 + r) * D + h * 64 + c]) * 0.125f; }
        float R[8], acc[8];
#pragma unroll
        for (int q = 0; q < 8; ++q) { R[q] = 0.f; acc[q] = 0.f; }
        for (int kt = qt; kt >= 0; --kt) {
            __syncthreads();
            for (int idx = F.tid; idx < 64 * 64; idx += NTHREADS) { const int r = idx >> 6, c = idx & 63; const size_t g = (tb + kt * 64 + r) * D + h * 64 + c; Ks[r * 65 + c] = bf2f(Kb[g]); Vs[r * 65 + c] = bf2f(Vb[g]); }
            __syncthreads();
#pragma unroll
            for (int q = 0; q < 8; ++q) {
                const int qi = F.wave * 8 + q;
                float z = 0.f;
#pragma unroll 16
                for (int d = 0; d < 64; ++d) z += Qs[qi * 64 + d] * Ks[F.lane * 65 + d];
                const bool valid = (kt < qt) || (F.lane < qi);
                const float sp = valid ? softplusf_(z) : 0.f;
                float suf = sp;
#pragma unroll
                for (int o = 1; o < 64; o <<= 1) { const float v = __shfl_down(suf, o); if (F.lane + o < 64) suf += v; }
                const float tail = R[q] + suf - sp;
                const float w = valid ? __expf(z - sp - tail) : 0.f;
                R[q] += __shfl(suf, 0);
                Ws[F.wave * 64 + F.lane] = w;
                float a = acc[q];
#pragma unroll 16
                for (int s = 0; s < 64; ++s) a += Ws[F.wave * 64 + s] * Vs[s * 65 + F.lane];
                acc[q] = a;
            }
            float mn = R[0];
#pragma unroll
            for (int q = 1; q < 8; ++q) mn = fminf(mn, R[q]);
            if (F.lane == 0) Rm[F.wave] = mn;
            __syncthreads();
            float allmin = Rm[0];
#pragma unroll
            for (int w = 1; w < 8; ++w) allmin = fminf(allmin, Rm[w]);
            if (allmin > SB_EXIT) break;
        }
#pragma unroll
        for (int q = 0; q < 8; ++q) AO[(tb + qt * 64 + F.wave * 8 + q) * D + h * 64 + F.lane] = f2bf(acc[q]);
        __syncthreads();
    }
}

#define EPI_MT(acc) (int)(sizeof(acc) / sizeof(acc[0]))
__device__ __forceinline__ void st_bf4(bf16_t* p, const f32x4& v) { u32x2 w; w.x = pack2(v[0], v[1]); w.y = pack2(v[2], v[3]); *(u32x2*)p = w; }

__device__ __forceinline__ void ph_rkv_lora_sg(const Frame& F) {
    const bf16_t* XS = (const bf16_t*)(F.ws + WS_XS); const bf16_t* WRKV = (const bf16_t*)(F.ws + WS_WRKV); const bf16_t* WLDN = (const bf16_t*)(F.ws + WS_WLDN);
    bf16_t* RKV = (bf16_t*)(F.ws + WS_RKV); bf16_t* LORA = (bf16_t*)(F.ws + WS_LORA);
    for (int u = F.bid; u < 64 * 24; u += F.G) {
        const int mt = u / 24, ct = u % 24, n = ct / 8, col0 = (ct % 8) * 128;
        ASeg A; A.p[0] = XS + ((size_t)n * T + mt * 256) * D; A.p[1] = A.p[0]; A.p[2] = A.p[0]; A.segTiles = 16;
        bf16_t* out = RKV + ((size_t)n * T + mt * 256) * D + col0;
        sg_tile<128>(F.lds, A, [](int R) { return (unsigned)R * (D * 2); }, WRKV + (size_t)(n * D + col0) * D, D, 16,
            [&](auto& acc, int r0, int c0, int fr, int fq) {
#pragma unroll
                for (int m = 0; m < EPI_MT(acc); ++m)
#pragma unroll
                    for (int q = 0; q < 4; ++q) st_bf4(out + (size_t)(r0 + 16 * m + fr) * D + c0 + 16 * q + 4 * fq, acc[m][q]);
            });
    }
    for (int u = F.bid; u < 64 * 4; u += F.G) {
        const int mt = u / 4, j = u % 4, n = (j == 0) ? 3 : (j == 1 ? 4 : 5);
        ASeg A; A.p[0] = XS + ((size_t)n * T + mt * 256) * D; A.p[1] = A.p[0]; A.p[2] = A.p[0]; A.segTiles = 16;
        bf16_t* out = LORA + (size_t)mt * 256 * 256 + j * 64;
        sg_tile<64>(F.lds, A, [](int R) { return (unsigned)R * (D * 2); }, WLDN + (size_t)(j * 64) * D, D, 16,
            [&](auto& acc, int r0, int c0, int fr, int fq) {
#pragma unroll
                for (int m = 0; m < EPI_MT(acc); ++m)
#pragma unroll
                    for (int q = 0; q < 4; ++q) { f32x4 v = acc[m][q];
#pragma unroll
                        for (int e = 0; e < 4; ++e) v[e] = (j == 0) ? tanhf(v[e]) : (j == 1 ? v[e] : sigmoidf_(v[e]));
                        st_bf4(out + (size_t)(r0 + 16 * m + fr) * 256 + c0 + 16 * q + 4 * fq, v); }
            });
    }
}
__device__ __forceinline__ void ph_lora_up_sg(const Frame& F) {
    const bf16_t* LORA = (const bf16_t*)(F.ws + WS_LORA); const bf16_t* WLUP = (const bf16_t*)(F.ws + WS_WLUP);
    float* LD = (float*)(F.ws + WS_LD); bf16_t* AA = (bf16_t*)(F.ws + WS_AA); bf16_t* GG = (bf16_t*)(F.ws + WS_GG);
    for (int u = F.bid; u < 3 * 64 * 8; u += F.G) {
        const int which = u / 512, v = u % 512, mt = v / 8, col0 = (v % 8) * 128;
        const int K = which == 2 ? 128 : 64, koff = which * 64;
        ASeg A; A.p[0] = LORA + (size_t)mt * 256 * 256 + koff; A.p[1] = A.p[0]; A.p[2] = A.p[0]; A.segTiles = 4;
        const bf16_t* Bt = WLUP + (which == 0 ? 0 : (which == 1 ? 1024 * 64 : 2 * 1024 * 64)) + (size_t)col0 * K;
        const size_t obase = (size_t)mt * 256 * D + col0;
        sg_tile<128>(F.lds, A, [](int R) { return (unsigned)R * 512u; }, Bt, K, K / 64,
            [&](auto& acc, int r0, int c0, int fr, int fq) {
#pragma unroll
                for (int m = 0; m < EPI_MT(acc); ++m)
#pragma unroll
                    for (int q = 0; q < 4; ++q) {
                        const int c = c0 + 16 * q + 4 * fq; const size_t o = obase + (size_t)(r0 + 16 * m + fr) * D + c;
                        if (which == 0) { const f32x4 w0 = *(const f32x4*)(F.in[I_W0] + col0 + c); f32x4 r;
#pragma unroll
                            for (int e = 0; e < 4; ++e) { const float wl = w0[e] + acc[m][q][e]; r[e] = -__expf(-softplusf_(-wl) - 0.5f); }
                            *(f32x4*)(LD + o) = r; }
                        else if (which == 1) { const f32x4 a0 = *(const f32x4*)(F.in[I_A0] + col0 + c); f32x4 r;
#pragma unroll
                            for (int e = 0; e < 4; ++e) r[e] = sigmoidf_(a0[e] + acc[m][q][e]);
                            st_bf4(AA + o, r); }
                        else st_bf4(GG + o, acc[m][q]);
                    }
            });
    }
}
template <int OUTMODE>
__device__ __forceinline__ void ph_dense_sg(const Frame& F, const bf16_t* Ain, const bf16_t* Wt, int N, void* outp) {
    const int nct = N / 128;
    for (int u = F.bid; u < 64 * nct; u += F.G) {
        const int mt = u / nct, col0 = (u % nct) * 128;
        ASeg A; A.p[0] = Ain + (size_t)mt * 256 * D; A.p[1] = A.p[0]; A.p[2] = A.p[0]; A.segTiles = 16;
        sg_tile<128>(F.lds, A, [](int R) { return (unsigned)R * (D * 2); }, Wt + (size_t)col0 * D, D, 16,
            [&](auto& acc, int r0, int c0, int fr, int fq) {
#pragma unroll
                for (int m = 0; m < EPI_MT(acc); ++m)
#pragma unroll
                    for (int q = 0; q < 4; ++q) {
                        const int r = mt * 256 + r0 + 16 * m + fr, c = col0 + c0 + 16 * q + 4 * fq;
                        if (OUTMODE == 0) *(f32x4*)((float*)outp + (size_t)r * N + c) = acc[m][q];
                        else st_bf4((bf16_t*)outp + (size_t)(c / D) * T * D + (size_t)r * D + (c % D), acc[m][q]);
                    }
            });
    }
}
__device__ __forceinline__ void ph_router_sg(const Frame& F, int layer) {
    const bf16_t* H2 = (const bf16_t*)(F.ws + WS_H2); const bf16_t* H2LO = (const bf16_t*)(F.ws + WS_H2LO);
    const bf16_t* WRT = (const bf16_t*)(F.ws + WS_WRT) + (size_t)layer * 64 * 3072; float* LOG = (float*)(F.ws + WS_LOGITS);
    for (int mt = F.bid; mt < 64; mt += F.G) {
        ASeg A; A.p[0] = H2 + (size_t)mt * 256 * D; A.p[1] = A.p[0]; A.p[2] = H2LO + (size_t)mt * 256 * D; A.segTiles = 16;
        sg_tile<64>(F.lds, A, [](int R) { return (unsigned)R * (D * 2); }, WRT, 3072, 48,
            [&](auto& acc, int r0, int c0, int fr, int fq) {
#pragma unroll
                for (int m = 0; m < EPI_MT(acc); ++m)
#pragma unroll
                    for (int q = 0; q < 4; ++q) *(f32x4*)(LOG + (size_t)(mt * 256 + r0 + 16 * m + fr) * NE + c0 + 16 * q + 4 * fq) = acc[m][q];
            });
    }
}
__device__ __forceinline__ void ph_gateup_sg(const Frame& F) {
    const bf16_t* H2 = (const bf16_t*)(F.ws + WS_H2); bf16_t* HB = (bf16_t*)(F.ws + WS_HB); const bf16_t* WGU = (const bf16_t*)(F.ws + WS_WGU);
    const int* TOK = (const int*)(F.ws + WS_TOK); const int* TILEE = (const int*)(F.ws + WS_TILEE); const int* START = (const int*)(F.ws + WS_START);
    const int routed = START[65], nmt = (routed + T) / 256;
    for (int u = F.bid; u < nmt * 4; u += F.G) {
        const int mt = u / 4, nt4 = u % 4, row0 = mt * 256; const bool sh = row0 >= routed; const int e = sh ? 64 : TILEE[mt];
        ASeg A; A.p[0] = H2; A.p[1] = H2; A.p[2] = H2; A.segTiles = 16;
        bf16_t* out = HB + (size_t)row0 * DE + nt4 * 64;
        sg_tile<128>(F.lds, A, [&](int R) { const int tok = sh ? (row0 - routed + R) : TOK[row0 + R]; return (unsigned)tok * (D * 2); },
            WGU + (size_t)e * 512 * D, D, 16,
            [&](auto& acc, int r0, int c0, int fr, int fq) {
#pragma unroll
                for (int m = 0; m < EPI_MT(acc); ++m)
#pragma unroll
                    for (int q = 0; q < 2; ++q) { f32x4 v;
#pragma unroll
                        for (int e2 = 0; e2 < 4; ++e2) { const float g = acc[m][q][e2]; v[e2] = g * sigmoidf_(g) * acc[m][q + 2][e2]; }
                        st_bf4(out + (size_t)(r0 + 16 * m + fr) * DE + (c0 >> 1) + 16 * q + 4 * fq, v); }
            },
            [=](int R) { const int col = nt4 * 64 + (R >> 6) * 32 + (R & 31), up = (R >> 5) & 1; return (col >> 7) * 256 + up * 128 + (col & 127); });
    }
}
__device__ __forceinline__ void ph_down_sg(const Frame& F) {
    const bf16_t* HB = (const bf16_t*)(F.ws + WS_HB); bf16_t* YB = (bf16_t*)(F.ws + WS_YB); const bf16_t* WDN = (const bf16_t*)(F.ws + WS_WDN);
    const int* TILEE = (const int*)(F.ws + WS_TILEE); const int* START = (const int*)(F.ws + WS_START);
    const int routed = START[65], nmt = (routed + T) / 256;
    for (int u = F.bid; u < nmt * 8; u += F.G) {
        const int mt = u / 8, col0 = (u % 8) * 128, row0 = mt * 256; const bool sh = row0 >= routed; const int e = sh ? 64 : TILEE[mt];
        ASeg A; A.p[0] = HB + (size_t)row0 * DE; A.p[1] = A.p[0]; A.p[2] = A.p[0]; A.segTiles = 4;
        bf16_t* out = YB + (size_t)row0 * D + col0;
        sg_tile<128>(F.lds, A, [](int R) { return (unsigned)R * (DE * 2); }, WDN + ((size_t)e * D + col0) * DE, DE, 4,
            [&](auto& acc, int r0, int c0, int fr, int fq) {
#pragma unroll
                for (int m = 0; m < EPI_MT(acc); ++m)
#pragma unroll
                    for (int q = 0; q < 4; ++q) st_bf4(out + (size_t)(r0 + 16 * m + fr) * D + c0 + 16 * q + 4 * fq, acc[m][q]);
            });
    }
}

constexpr int MS = 72;
constexpr int SLOT = 64 * MS * 2;
constexpr size_t WS_BONUS = 3 * MiB;
constexpr size_t WS_RP = WS_BIG + 128 * MiB;
constexpr size_t WS_OL = WS_BIG + 160 * MiB;
constexpr size_t WS_G2 = WS_BIG + 296 * MiB;
constexpr size_t WS_DM = WS_BIG + 328 * MiB;
constexpr size_t WS_ST = WS_BIG + 360 * MiB;

__device__ __forceinline__ bf16x8 ldfrag(const LAS bf16_t* M, int row, int kofs) { return *(const LAS bf16x8*)(M + row * MS + kofs); }
template <bool SW>
__device__ __forceinline__ void mm64(f32x4& acc, const LAS bf16_t* X, int xr0, const LAS bf16_t* Y, int yr0, int fr, int fq) {
#pragma unroll
    for (int ks = 0; ks < 2; ++ks) {
        const bf16x8 xf = ldfrag(X, xr0 + fr, ks * 32 + fq * 8), yf = ldfrag(Y, yr0 + fr, ks * 32 + fq * 8);
        acc = SW ? __builtin_amdgcn_mfma_f32_16x16x32_bf16(yf, xf, acc, 0, 0, 0) : __builtin_amdgcn_mfma_f32_16x16x32_bf16(xf, yf, acc, 0, 0, 0);
    }
}
__device__ __forceinline__ void st4_lds(LAS bf16_t* p, const f32x4& v) { u32x2 w; w.x = pack2(v[0], v[1]); w.y = pack2(v[2], v[3]); *(LAS u32x2*)p = w; }
__device__ __forceinline__ f32x4 ld4_lds(const LAS bf16_t* p) { const u32x2 w = *(const LAS u32x2*)p; return (f32x4){lo2f(w.x), hi2f(w.x), lo2f(w.y), hi2f(w.y)}; }
__device__ __forceinline__ f32x4 ld4_g(const bf16_t* p) { const u32x2 w = *(const u32x2*)p; return (f32x4){lo2f(w.x), hi2f(w.x), lo2f(w.y), hi2f(w.y)}; }

__device__ __forceinline__ void ph_wkv_chunk(const Frame& F) {
    const bf16_t* RKV = (const bf16_t*)(F.ws + WS_RKV); const float* LD = (const float*)(F.ws + WS_LD); const bf16_t* AA = (const bf16_t*)(F.ws + WS_AA);
    const bf16_t* Rb = RKV; const bf16_t* Kb = RKV + (size_t)T * D; const bf16_t* Vb = RKV + (size_t)2 * T * D;
    bf16_t* RP = (bf16_t*)(F.ws + WS_RP); bf16_t* OL = (bf16_t*)(F.ws + WS_OL); bf16_t* G2 = (bf16_t*)(F.ws + WS_G2); bf16_t* DM = (bf16_t*)(F.ws + WS_DM);
    float* BONUS = (float*)(F.ws + WS_BONUS);
#define SL(k) ((LAS bf16_t*)(F.lds + (k) * SLOT))
    LAS float* segtot = (LAS float*)(F.lds + 15 * SLOT);
    LAS float* WCs = segtot + 512;
    const int w = F.wave, lane = F.lane, fr = lane & 15, fq = lane >> 4, mt = w >> 1, ntb = 2 * (w & 1);
    for (int cid = F.bid; cid < NB * NH * (SEQ / 64); cid += F.G) {
        const int bh = cid / (SEQ / 64), c = cid % (SEQ / 64), b = bh / NH, h = bh % NH;
        const size_t tok0 = (size_t)b * SEQ + (size_t)c * 64;
        {
            const int j = lane, ch = h * 64 + j;
            const float kkw = F.in[I_KK][ch], kaw = F.in[I_KA][ch], rkw = F.in[I_RK][ch];
            float r[8], k[8], v[8], a[8], ld[8];
#pragma unroll
            for (int e = 0; e < 8; ++e) { const size_t o = (tok0 + 8 * w + e) * D + ch; r[e] = bf2f(Rb[o]); k[e] = bf2f(Kb[o]); v[e] = bf2f(Vb[o]); a[e] = bf2f(AA[o]); ld[e] = LD[o]; }
            float cum[8]; float run = 0.f;
#pragma unroll
            for (int e = 0; e < 8; ++e) { run += ld[e]; cum[e] = run; }
            segtot[w * 64 + j] = run;
            __syncthreads();
            float pre = 0.f, tot = 0.f;
#pragma unroll
            for (int ww = 0; ww < 8; ++ww) { const float sgt = segtot[ww * 64 + j]; tot += sgt; if (ww < w) pre += sgt; }
            if (w == 0) WCs[j] = __expf(tot);
            float av[8], bv[8], kv[8], rv[8];
#pragma unroll
            for (int e = 0; e < 8; ++e) {
                const float cm = pre + cum[e];
                const float kkr = k[e] * kkw; const float ss = wave_sum(kkr * kkr);
                const float kk = kkr / fmaxf(sqrtf(ss), 1e-12f);
                const float kf = k[e] * (1.0f + (a[e] - 1.0f) * kaw);
                const float bon = wave_sum(r[e] * kf * rkw);
                if (lane == 0) BONUS[(tok0 + 8 * w + e) * NH + h] = bon;
                const float en = __expf(-cm);
                av[e] = -kk * __expf(cm - ld[e]); bv[e] = kk * a[e] * en; kv[e] = kf * en; rv[e] = r[e] * __expf(cm);
                const int t = 8 * w + e;
                SL(0)[t * MS + j] = f2bf(av[e]); SL(2)[t * MS + j] = f2bf(rv[e]); SL(3)[t * MS + j] = f2bf(bv[e]); SL(5)[t * MS + j] = f2bf(kv[e]);
            }
            u32x4 pa, pb, pk, pv;
#pragma unroll
            for (int q = 0; q < 4; ++q) { pa[q] = pack2(av[2 * q], av[2 * q + 1]); pb[q] = pack2(bv[2 * q], bv[2 * q + 1]); pk[q] = pack2(kv[2 * q], kv[2 * q + 1]); pv[q] = pack2(v[2 * q], v[2 * q + 1]); }
            *(LAS u32x4*)(SL(1) + j * MS + 8 * w) = pa; *(LAS u32x4*)(SL(4) + j * MS + 8 * w) = pb; *(LAS u32x4*)(SL(6) + j * MS + 8 * w) = pk; *(LAS u32x4*)(SL(7) + j * MS + 8 * w) = pv;
        }
        __syncthreads();
#pragma unroll
        for (int q2 = 0; q2 < 2; ++q2) {
            const int nt = ntb + q2;
            { f32x4 acc = {0.f, 0.f, 0.f, 0.f}; mm64<false>(acc, SL(0), 16 * mt, SL(3), 16 * nt, fr, fq);
              const int sidx = 16 * nt + fr, t0 = 16 * mt + 4 * fq;
#pragma unroll
              for (int e = 0; e < 4; ++e) { if (!(sidx < t0 + e)) acc[e] = 0.f; SL(8)[(t0 + e) * MS + sidx] = f2bf(acc[e]); }
              st4_lds(SL(9) + sidx * MS + t0, acc); }
            const int tt = 16 * mt + fr, s0 = 16 * nt + 4 * fq;
            { f32x4 acc = {0.f, 0.f, 0.f, 0.f}; mm64<true>(acc, SL(0), 16 * mt, SL(5), 16 * nt, fr, fq);
#pragma unroll
              for (int e = 0; e < 4; ++e) if (!(s0 + e < tt)) acc[e] = 0.f;
              st4_lds(SL(10) + tt * MS + s0, acc); }
            { f32x4 acc = {0.f, 0.f, 0.f, 0.f}; mm64<true>(acc, SL(2), 16 * mt, SL(3), 16 * nt, fr, fq);
#pragma unroll
              for (int e = 0; e < 4; ++e) if (!(s0 + e <= tt)) acc[e] = 0.f;
              st4_lds(SL(11) + tt * MS + s0, acc); }
            { f32x4 acc = {0.f, 0.f, 0.f, 0.f}; mm64<true>(acc, SL(2), 16 * mt, SL(5), 16 * nt, fr, fq);
#pragma unroll
              for (int e = 0; e < 4; ++e) if (!(s0 + e <= tt)) acc[e] = 0.f;
              st4_lds(SL(12) + tt * MS + s0, acc); }
        }
        __syncthreads();
#define WKV_SQ(xi, ti, xo, to) do { _Pragma("unroll") for (int q2 = 0; q2 < 2; ++q2) { const int nt = ntb + q2; f32x4 acc = {0.f, 0.f, 0.f, 0.f}; \
            mm64<false>(acc, SL(xi), 16 * mt, SL(ti), 16 * nt, fr, fq); const int n_ = 16 * nt + fr, m0_ = 16 * mt + 4 * fq; \
            _Pragma("unroll") for (int e = 0; e < 4; ++e) SL(xo)[(m0_ + e) * MS + n_] = f2bf(acc[e]); st4_lds(SL(to) + n_ * MS + m0_, acc); } } while (0)
#define WKV_PM(pi, ti, po) do { _Pragma("unroll") for (int q2 = 0; q2 < 2; ++q2) { const int nt = ntb + q2; const int m_ = 16 * mt + fr, n0_ = 16 * nt + 4 * fq; \
            f32x4 acc = ld4_lds(SL(pi) + m_ * MS + n0_); mm64<true>(acc, SL(pi), 16 * mt, SL(ti), 16 * nt, fr, fq); st4_lds(SL(po) + m_ * MS + n0_, acc); } } while (0)
        WKV_SQ(8, 9, 0, 3);
        for (int idx = F.tid; idx < 64 * 64; idx += NTHREADS) { const int t = idx >> 6, s2 = idx & 63; SL(13)[t * MS + s2] = (t == s2) ? (bf16_t)0x3F80 : SL(8)[t * MS + s2]; }
        __syncthreads();
        WKV_PM(13, 3, 14); WKV_SQ(0, 3, 8, 9); __syncthreads();
        WKV_PM(14, 9, 13); WKV_SQ(8, 9, 0, 3); __syncthreads();
        WKV_PM(13, 3, 14); WKV_SQ(0, 3, 8, 9); __syncthreads();
        WKV_PM(14, 9, 13); WKV_SQ(8, 9, 0, 3); __syncthreads();
        WKV_PM(13, 3, 14); __syncthreads();
#pragma unroll
        for (int q2 = 0; q2 < 2; ++q2) {
            const int nt = ntb + q2, n_ = 16 * nt + fr, m0_ = 16 * mt + 4 * fq;
            { f32x4 acc = {0.f, 0.f, 0.f, 0.f}; mm64<false>(acc, SL(14), 16 * mt, SL(1), 16 * nt, fr, fq); st4_lds(SL(9) + n_ * MS + m0_, acc); }
            { f32x4 acc = {0.f, 0.f, 0.f, 0.f}; mm64<false>(acc, SL(10), 16 * mt, SL(7), 16 * nt, fr, fq); st4_lds(SL(8) + n_ * MS + m0_, acc); }
        }
        __syncthreads();
#pragma unroll
        for (int q2 = 0; q2 < 2; ++q2) {
            const int nt = ntb + q2;
            { const int n_ = 16 * nt + fr, m0_ = 16 * mt + 4 * fq; f32x4 acc = {0.f, 0.f, 0.f, 0.f}; mm64<false>(acc, SL(14), 16 * mt, SL(8), 16 * nt, fr, fq); st4_lds(SL(0) + n_ * MS + m0_, acc); }
            { const int m_ = 16 * mt + fr, n0_ = 16 * nt + 4 * fq; f32x4 acc = ld4_lds(SL(2) + m_ * MS + n0_); mm64<true>(acc, SL(11), 16 * mt, SL(9), 16 * nt, fr, fq);
              st_bf4(RP + (size_t)cid * 4096 + m_ * 64 + n0_, acc); }
        }
        __syncthreads();
#pragma unroll
        for (int q2 = 0; q2 < 2; ++q2) {
            const int nt = ntb + q2;
            { const int m_ = 16 * mt + fr, n0_ = 16 * nt + 4 * fq; f32x4 acc = {0.f, 0.f, 0.f, 0.f};
              mm64<true>(acc, SL(11), 16 * mt, SL(0), 16 * nt, fr, fq); mm64<true>(acc, SL(12), 16 * mt, SL(7), 16 * nt, fr, fq);
              st_bf4(OL + (size_t)cid * 4096 + m_ * 64 + n0_, acc); }
            { const int jp = 16 * nt + fr, j0 = 16 * mt + 4 * fq; f32x4 acc = {0.f, 0.f, 0.f, 0.f}; mm64<false>(acc, SL(9), 16 * mt, SL(4), 16 * nt, fr, fq);
              const float wc = WCs[jp];
#pragma unroll
              for (int e = 0; e < 4; ++e) acc[e] = (acc[e] + ((j0 + e == jp) ? 1.0f : 0.0f)) * wc;
              st_bf4(G2 + (size_t)cid * 4096 + (nt * 2 + (mt >> 1)) * 512 + lane * 8 + (mt & 1) * 4, acc); }
            { const int i_ = 16 * mt + fr, jp0 = 16 * nt + 4 * fq; f32x4 acc = {0.f, 0.f, 0.f, 0.f};
              mm64<true>(acc, SL(0), 16 * mt, SL(4), 16 * nt, fr, fq); mm64<true>(acc, SL(7), 16 * mt, SL(6), 16 * nt, fr, fq);
#pragma unroll
              for (int e = 0; e < 4; ++e) acc[e] *= WCs[jp0 + e];
              st_bf4(DM + (size_t)cid * 4096 + i_ * 64 + jp0, acc); }
        }
        __syncthreads();
    }
#undef WKV_SQ
#undef WKV_PM
#undef SL
}

__device__ __forceinline__ void ph_wkv_carry(const Frame& F) {
    const bf16_t* G2 = (const bf16_t*)(F.ws + WS_G2); const bf16_t* DM = (const bf16_t*)(F.ws + WS_DM); bf16_t* ST = (bf16_t*)(F.ws + WS_ST);
    if (F.wave >= 4) return;
    const int lane = F.lane, fr = lane & 15, fq = lane >> 4, i = 16 * F.wave + fr;
    for (int ch = F.bid; ch < NB * NH; ch += F.G) {
        f32x4 st[4];
#pragma unroll
        for (int r = 0; r < 4; ++r) st[r] = (f32x4){0.f, 0.f, 0.f, 0.f};
        const size_t cbase = (size_t)ch * (SEQ / 64);
        bf16x8 gf[8]; f32x4 dm[4];
#pragma unroll
        for (int f = 0; f < 8; ++f) gf[f] = *(const bf16x8*)(G2 + cbase * 4096 + f * 512 + lane * 8);
#pragma unroll
        for (int r = 0; r < 4; ++r) dm[r] = ld4_g(DM + cbase * 4096 + i * 64 + 16 * r + 4 * fq);
        for (int c = 0; c < SEQ / 64; ++c) {
            const size_t cid = cbase + c;
            bf16x8 gc[8]; f32x4 acc[4];
#pragma unroll
            for (int f = 0; f < 8; ++f) gc[f] = gf[f];
#pragma unroll
            for (int r = 0; r < 4; ++r) acc[r] = dm[r];
            if (c + 1 < SEQ / 64) {
#pragma unroll
                for (int f = 0; f < 8; ++f) gf[f] = *(const bf16x8*)(G2 + (cid + 1) * 4096 + f * 512 + lane * 8);
#pragma unroll
                for (int r = 0; r < 4; ++r) dm[r] = ld4_g(DM + (cid + 1) * 4096 + i * 64 + 16 * r + 4 * fq);
            }
            union { bf16x8 v; unsigned u[4]; } b0, b1;
#pragma unroll
            for (int r = 0; r < 4; ++r) st_bf4(ST + cid * 4096 + i * 64 + 16 * r + 4 * fq, st[r]);
            b0.u[0] = pack2(st[0][0], st[0][1]); b0.u[1] = pack2(st[0][2], st[0][3]); b0.u[2] = pack2(st[1][0], st[1][1]); b0.u[3] = pack2(st[1][2], st[1][3]);
            b1.u[0] = pack2(st[2][0], st[2][1]); b1.u[1] = pack2(st[2][2], st[2][3]); b1.u[2] = pack2(st[3][0], st[3][1]); b1.u[3] = pack2(st[3][2], st[3][3]);
#pragma unroll
            for (int r = 0; r < 4; ++r) {
                acc[r] = __builtin_amdgcn_mfma_f32_16x16x32_bf16(gc[r * 2 + 0], b0.v, acc[r], 0, 0, 0);
                acc[r] = __builtin_amdgcn_mfma_f32_16x16x32_bf16(gc[r * 2 + 1], b1.v, acc[r], 0, 0, 0);
            }
#pragma unroll
            for (int r = 0; r < 4; ++r) st[r] = acc[r];
        }
    }
}

__device__ __forceinline__ void ph_wkv_out(const Frame& F) {
    const bf16_t* RP = (const bf16_t*)(F.ws + WS_RP); const bf16_t* OL = (const bf16_t*)(F.ws + WS_OL); const bf16_t* ST = (const bf16_t*)(F.ws + WS_ST);
    const bf16_t* Vb = (const bf16_t*)(F.ws + WS_RKV) + (size_t)2 * T * D; const bf16_t* GG = (const bf16_t*)(F.ws + WS_GG); const float* BONUS = (const float*)(F.ws + WS_BONUS);
    bf16_t* OG = (bf16_t*)(F.ws + WS_OG);
    const int lane = F.lane, fr = lane & 15, fq = lane >> 4;
    const int nunits = NB * NH * (SEQ / 64) * 4;
    for (int u = F.bid * NWAVES + F.wave; u < nunits; u += F.G * NWAVES) {
        const int cid = u >> 2, tt = u & 3, bh = cid / (SEQ / 64), c = cid % (SEQ / 64), b = bh / NH, h = bh % NH;
        const int t = 16 * tt + fr; const size_t tok = (size_t)b * SEQ + (size_t)c * 64 + t;
        bf16x8 rf[2];
#pragma unroll
        for (int ks = 0; ks < 2; ++ks) rf[ks] = *(const bf16x8*)(RP + (size_t)cid * 4096 + t * 64 + ks * 32 + fq * 8);
        f32x4 acc[4];
#pragma unroll
        for (int n = 0; n < 4; ++n) {
            acc[n] = ld4_g(OL + (size_t)cid * 4096 + t * 64 + 16 * n + 4 * fq);
#pragma unroll
            for (int ks = 0; ks < 2; ++ks) { const bf16x8 sf = *(const bf16x8*)(ST + (size_t)cid * 4096 + (16 * n + fr) * 64 + ks * 32 + fq * 8);
                acc[n] = __builtin_amdgcn_mfma_f32_16x16x32_bf16(sf, rf[ks], acc[n], 0, 0, 0); }
        }
        float s = 0.f;
#pragma unroll
        for (int n = 0; n < 4; ++n) s += (acc[n][0] + acc[n][1]) + (acc[n][2] + acc[n][3]);
        s += __shfl_xor(s, 16); s += __shfl_xor(s, 32);
        const float mean = s * (1.0f / 64.0f);
        float q = 0.f;
#pragma unroll
        for (int n = 0; n < 4; ++n)
#pragma unroll
            for (int e = 0; e < 4; ++e) { const float d = acc[n][e] - mean; q += d * d; }
        q += __shfl_xor(q, 16); q += __shfl_xor(q, 32);
        const float rstd = rsqrtf(q * (1.0f / 64.0f) + 64e-5f), bon = BONUS[tok * NH + h];
#pragma unroll
        for (int n = 0; n < 4; ++n) {
            const int chn = h * 64 + 16 * n + 4 * fq; const size_t o = tok * D + chn;
            const f32x4 lg = *(const f32x4*)(F.in[I_LNG] + chn), lb = *(const f32x4*)(F.in[I_LNB] + chn), vv = ld4_g(Vb + o), gg = ld4_g(GG + o);
            const f32x4 res = (((acc[n] - mean) * rstd) * lg + lb + vv * bon) * gg;
            st_bf4(OG + o, res);
        }
    }
}

__device__ __forceinline__ void ph_qkv_sg(const Frame& F) {
    const bf16_t* Ain = (const bf16_t*)(F.ws + WS_H3); const bf16_t* Wt = (const bf16_t*)(F.ws + WS_WQKV);
    bf16_t* QK = (bf16_t*)(F.ws + WS_Q); bf16_t* VT = QK + (size_t)2 * T * D;
    for (int u = F.bid; u < 64 * 24; u += F.G) {
        const int mt = u / 24, ct = u % 24, col0 = ct * 128;
        ASeg A; A.p[0] = Ain + (size_t)mt * 256 * D; A.p[1] = A.p[0]; A.p[2] = A.p[0]; A.segTiles = 16;
        if (ct < 16) {
            sg_tile<128>(F.lds, A, [](int R) { return (unsigned)R * (D * 2); }, Wt + (size_t)col0 * D, D, 16,
                [&](auto& acc, int r0, int c0, int fr, int fq) {
#pragma unroll
                    for (int m = 0; m < EPI_MT(acc); ++m)
#pragma unroll
                        for (int q = 0; q < 4; ++q) { const int r = mt * 256 + r0 + 16 * m + fr, c = col0 + c0 + 16 * q + 4 * fq;
                            st_bf4(QK + (size_t)(c / D) * T * D + (size_t)r * D + (c % D), acc[m][q]); }
                });
        } else {
            sg_tile<128, true>(F.lds, A, [](int R) { return (unsigned)R * (D * 2); }, Wt + (size_t)col0 * D, D, 16,
                [&](auto& acc, int r0, int c0, int fr, int fq) {
#pragma unroll
                    for (int m = 0; m < EPI_MT(acc); ++m)
#pragma unroll
                        for (int q = 0; q < 4; ++q) { const int t = mt * 256 + r0 + 16 * m + 4 * fq, c = col0 - 2 * D + c0 + 16 * q + fr;
                            const int b = t / SEQ, sidx = t % SEQ, h = c >> 6, d = c & 63;
                            st_bf4(VT + ((size_t)((b * NH + h) * 64 + d)) * SEQ + sidx, acc[m][q]); }
                });
        }
    }
}
__device__ __forceinline__ void ph_attn(const Frame& F) {
    const bf16_t* Q = (const bf16_t*)(F.ws + WS_Q); const bf16_t* Kb = Q + (size_t)T * D; const bf16_t* VT = Q + (size_t)2 * T * D;
    bf16_t* AO = (bf16_t*)(F.ws + WS_AO);
    const int lane = F.lane, fr = lane & 15, fq = lane >> 4;
    const int nunits = NB * NH * (SEQ / 16);
    for (int u = F.bid * NWAVES + F.wave; u < nunits; u += F.G * NWAVES) {
        const int bh = u / (SEQ / 16), qt = u % (SEQ / 16), b = bh / NH, h = bh % NH;
        const int q0 = qt * 16, qpos = q0 + fr;
        const size_t tb = (size_t)b * SEQ;
        bf16x8 qf[2];
#pragma unroll
        for (int ks = 0; ks < 2; ++ks) qf[ks] = *(const bf16x8*)(Q + (tb + qpos) * D + h * 64 + ks * 32 + fq * 8);
        f32x4 o[4];
#pragma unroll
        for (int dt = 0; dt < 4; ++dt) o[dt] = (f32x4){0.f, 0.f, 0.f, 0.f};
        float R = 0.f;
        const bf16_t* vt = VT + (size_t)bh * 64 * SEQ;
        for (int kt0 = (q0 + 15) / 64; kt0 >= 0; --kt0) {
            const int key0 = kt0 * 64;
            f32x4 z[4];
#pragma unroll
            for (int kt = 0; kt < 4; ++kt) {
                z[kt] = (f32x4){0.f, 0.f, 0.f, 0.f};
#pragma unroll
                for (int ks = 0; ks < 2; ++ks) { const bf16x8 kf = *(const bf16x8*)(Kb + (tb + key0 + 16 * kt + fr) * D + h * 64 + ks * 32 + fq * 8);
                    z[kt] = __builtin_amdgcn_mfma_f32_16x16x32_bf16(kf, qf[ks], z[kt], 0, 0, 0); }
            }
            float sp[4][4], G[4];
#pragma unroll
            for (int kt = 0; kt < 4; ++kt) { G[kt] = 0.f;
#pragma unroll
                for (int e = 0; e < 4; ++e) { const float zz = z[kt][e] * 0.125f; z[kt][e] = zz; const bool valid = (key0 + 16 * kt + 4 * fq + e) < qpos;
                    const float spv = valid ? (zz > 15.f ? zz : __logf(1.0f + __expf(zz))) : 0.f; sp[kt][e] = spv; G[kt] += spv; } }
            float sufg[4], tot[4];
#pragma unroll
            for (int kt = 0; kt < 4; ++kt) {
                const float g1 = __shfl_xor(G[kt], 16), g2 = __shfl_xor(G[kt], 32), g3 = __shfl_xor(G[kt], 48);
                tot[kt] = G[kt] + g1 + g2 + g3;
                sufg[kt] = (((fq ^ 1) > fq) ? g1 : 0.f) + (((fq ^ 2) > fq) ? g2 : 0.f) + (((fq ^ 3) > fq) ? g3 : 0.f);
            }
            float later = 0.f;
            unsigned pk[4][2];
#pragma unroll
            for (int kt = 3; kt >= 0; --kt) {
                float run = R + later + sufg[kt];
                float wv[4];
#pragma unroll
                for (int e = 3; e >= 0; --e) { const bool valid = (key0 + 16 * kt + 4 * fq + e) < qpos;
                    wv[e] = valid ? __expf(z[kt][e] - sp[kt][e] - run) : 0.f; run += sp[kt][e]; }
                pk[kt][0] = pack2(wv[0], wv[1]); pk[kt][1] = pack2(wv[2], wv[3]);
                later += tot[kt];
            }
            R += later;
            union { bf16x8 v; unsigned w[4]; } p0, p1;
            p0.w[0] = pk[0][0]; p0.w[1] = pk[0][1]; p0.w[2] = pk[1][0]; p0.w[3] = pk[1][1];
            p1.w[0] = pk[2][0]; p1.w[1] = pk[2][1]; p1.w[2] = pk[3][0]; p1.w[3] = pk[3][1];
#pragma unroll
            for (int dt = 0; dt < 4; ++dt) {
                const bf16_t* vr = vt + (size_t)(16 * dt + fr) * SEQ + key0 + 4 * fq;
                union { bf16x8 v; u32x2 h[2]; } v0, v1;
                v0.h[0] = *(const u32x2*)(vr); v0.h[1] = *(const u32x2*)(vr + 16); v1.h[0] = *(const u32x2*)(vr + 32); v1.h[1] = *(const u32x2*)(vr + 48);
                o[dt] = __builtin_amdgcn_mfma_f32_16x16x32_bf16(v0.v, p0.v, o[dt], 0, 0, 0);
                o[dt] = __builtin_amdgcn_mfma_f32_16x16x32_bf16(v1.v, p1.v, o[dt], 0, 0, 0);
            }
            if (__all(R > SB_EXIT)) break;
        }
#pragma unroll
        for (int dt = 0; dt < 4; ++dt) st_bf4(AO + (tb + qpos) * D + h * 64 + 16 * dt + 4 * fq, o[dt]);
    }
}

__global__ void __launch_bounds__(NTHREADS, 2) mega(Args args) {
    extern __shared__ __attribute__((aligned(16))) unsigned char lds[];
    Frame F;
    F.in = args.in; F.out = args.out; F.ws = args.ws; F.ctl = (unsigned*)(args.ws + WS_CTL);
    F.ldsf = (float*)lds; F.lds = (LAS unsigned char*)lds;
    F.tid = threadIdx.x; F.lane = F.tid & 63; F.wave = __builtin_amdgcn_readfirstlane(F.tid >> 6); F.bid = blockIdx.x; F.G = gridDim.x;
    if (F.tid < 4) ((unsigned*)(lds + LDS_BYTES - 64))[F.tid] = 0u;
    __syncthreads();
    XcdBarrier bar; bar.bar = F.ctl + CW_BAR; bar.x = 0; bar.st = (volatile LAS unsigned*)(lds + LDS_BYTES - 64);
#if MK_N_LAUNCHES == 1
    bar = xcd_barrier_post(F.ctl + CW_BAR, (volatile LAS unsigned*)(lds + LDS_BYTES - 64));
#endif
    const int lo = args.ph_lo, hi = args.ph_hi;
#define IN(k) (lo <= (k) && (k) < hi)
#define SEAM(k) do { if (IN(k) && IN((k) + 1)) xcd_barrier(bar); } while (0)
    bf16_t* const wsb = (bf16_t*)args.ws;
    (void)wsb;
#ifndef REP_A
#define REP_A 1
#endif
#ifndef REP_B
#define REP_B 1
#endif
#ifndef REP_C
#define REP_C 1
#endif
#ifndef REP_D
#define REP_D 1
#endif
#ifndef REP_E
#define REP_E 1
#endif
#ifndef REP_F
#define REP_F 1
#endif
#ifndef REP_G
#define REP_G 1
#endif
#ifndef REP_H
#define REP_H 1
#endif
#define RUN(n, body) for (int r_ = 0; r_ < (n); ++r_) { body; }
    if (IN(0)) { RUN(REP_D, ph_mod(F)) RUN(REP_G, conv_dense(F, F.bid, F.G)) } SEAM(0);
    if (IN(1)) { RUN(REP_E, ph_prenorm_rwkv(F)) } SEAM(1);
    if (IN(2)) { RUN(REP_A, ph_rkv_lora_sg(F)) } SEAM(2);
    if (IN(3)) { RUN(REP_F, ph_lora_up_sg(F)) } SEAM(3);
    if (IN(4)) { RUN(REP_B, ph_wkv_chunk(F)) } SEAM(4);
    if (IN(5)) { if (F.bid < NB * NH && F.G > 2 * NB * NH) { RUN(REP_B, ph_wkv_carry(F)) } else if (F.G > 2 * NB * NH) { RUN(REP_D, conv_moe(F, 0, F.bid - NB * NH, F.G - NB * NH)) } else { ph_wkv_carry(F); conv_moe(F, 0, F.bid, F.G); } } SEAM(5);
    if (IN(6)) { RUN(REP_B, ph_wkv_out(F)) } SEAM(6);
    if (IN(7)) { RUN(REP_A, ph_dense_sg<0>(F, (const bf16_t*)(F.ws + WS_OG), (const bf16_t*)(F.ws + WS_WO), D, F.ws + WS_Y1)) } SEAM(7);
    if (IN(8)) { RUN(REP_E, ph_postmix_preffn(F, 0, F.in[I_X], (const float*)(F.ws + WS_Y1))) } SEAM(8);
    if (IN(9)) { RUN(REP_F, ph_router_sg(F, 0)) } SEAM(9);
    if (IN(10)) { ph_topk(F, 0); } SEAM(10);
    if (IN(11)) { ph_offsets(F, 0); } SEAM(11);
    if (IN(12)) { RUN(REP_A, ph_gateup_sg(F)) } SEAM(12);
    if (IN(13)) { RUN(REP_A, ph_down_sg(F)) } SEAM(13);
    if (IN(14)) { RUN(1, ph_combine(F, 0, true)) RUN(REP_H, conv_moe(F, 1, F.bid, F.G)) } SEAM(14);
    if (IN(15)) { RUN(REP_A, ph_qkv_sg(F)) } SEAM(15);
    if (IN(16)) { RUN(REP_C, ph_attn(F)) } SEAM(16);
    if (IN(17)) { RUN(REP_A, ph_dense_sg<0>(F, (const bf16_t*)(F.ws + WS_AO), (const bf16_t*)(F.ws + WS_WSBO), D, F.ws + WS_Y1B)) } SEAM(17);
    if (IN(18)) { ph_postmix_preffn(F, 1, F.out, (const float*)(F.ws + WS_Y1B)); } SEAM(18);
    if (IN(19)) { RUN(REP_F, ph_router_sg(F, 1)) } SEAM(19);
    if (IN(20)) { ph_topk(F, 1); } SEAM(20);
    if (IN(21)) { ph_offsets(F, 1); } SEAM(21);
    if (IN(22)) { RUN(REP_A, ph_gateup_sg(F)) } SEAM(22);
    if (IN(23)) { RUN(REP_A, ph_down_sg(F)) } SEAM(23);
    if (IN(24)) { ph_combine(F, 1, false); }
#undef IN
#undef SEAM
}

extern "C" void kernel_launch(void* const* d_in, const int* in_sizes, int n_in, void* d_out, int out_size, void* d_ws, size_t ws_size, hipStream_t stream) {
    static int grid = 0;
    if (grid == 0) {
        if (n_in != 34 || in_sizes[0] != T * D || out_size != T * D || ws_size < WS_END) {
            fprintf(stderr, "kernel_launch: unexpected shapes: n_in %d in0 %d out %d ws %zu (need %zu)\n", n_in, n_in > 0 ? in_sizes[0] : -1, out_size, ws_size, (size_t)WS_END);
            grid = -1; return;
        }
        int dev = 0, cus = 0, per_cu = 0;
        if (hipGetDevice(&dev) != hipSuccess || hipDeviceGetAttribute(&cus, hipDeviceAttributeMultiprocessorCount, dev) != hipSuccess) { grid = -1; return; }
        if (hipFuncSetAttribute((const void*)mega, hipFuncAttributeMaxDynamicSharedMemorySize, LDS_BYTES) != hipSuccess) { fprintf(stderr, "kernel_launch: hipFuncSetAttribute failed\n"); grid = -1; return; }
        if (hipOccupancyMaxActiveBlocksPerMultiprocessor(&per_cu, (const void*)mega, NTHREADS, LDS_BYTES) != hipSuccess || per_cu < 1)
            fprintf(stderr, "kernel_launch: occupancy query reports %d blocks per CU\n", per_cu);
        (void)hipGetLastError();
        grid = cus;
    }
    if (grid < 0) return;
    if (hipMemsetAsync((char*)d_ws + WS_CTL, 0, CTL_BYTES, stream) != hipSuccess) { fprintf(stderr, "kernel_launch: memset failed\n"); return; }
    Args a{};
    for (int i = 0; i < 34; ++i) a.in[i] = (const float*)d_in[i];
    a.out = (float*)d_out; a.ws = (unsigned char*)d_ws;
#if MK_N_LAUNCHES == 1
    a.ph_lo = 0; a.ph_hi = NPHASES;
    hipLaunchKernelGGL(mega, dim3(grid), dim3(NTHREADS), LDS_BYTES, stream, a);
#else
    for (int p = 0; p < NPHASES; ++p) { a.ph_lo = p; a.ph_hi = p + 1; hipLaunchKernelGGL(mega, dim3(grid), dim3(NTHREADS), LDS_BYTES, stream, a); }
#endif
    const hipError_t le = hipPeekAtLastError();
    if (le != hipSuccess) fprintf(stderr, "kernel_launch: launch failed: %s\n", hipGetErrorName(le));
}
```

```cpp
#include <hip/hip_runtime.h>
#include <cstdio>
#include <cstdint>

#ifndef MK_N_LAUNCHES
#define MK_N_LAUNCHES 1
#endif

constexpr int T = 16384, D = 1024, SEQ = 8192, NB = 2, NH = 16, HD = 64;
constexpr int NE = 64, TOPK = 8, DE = 256;
constexpr int RP = 256;
constexpr int MAXROUTED = 147456;
constexpr int MAXROWS = MAXROUTED + T;
constexpr int NTHREADS = 512, NWAVES = 8;
constexpr int NPHASES = 25;
constexpr int LDS_BYTES = 144 * 1024;

typedef unsigned short bf16_t;
typedef float f32x4 __attribute__((ext_vector_type(4)));
typedef unsigned u32x4 __attribute__((ext_vector_type(4)));
typedef unsigned u32x2 __attribute__((ext_vector_type(2)));

__device__ __forceinline__ float bf2f(bf16_t b) { return __uint_as_float(((unsigned)b) << 16); }
__device__ __forceinline__ bf16_t f2bf(float f) { unsigned u = __float_as_uint(f); u += 0x7FFFu + ((u >> 16) & 1u); return (bf16_t)(u >> 16); }
__device__ __forceinline__ unsigned pack2(float a, float b) { return (unsigned)f2bf(a) | ((unsigned)f2bf(b) << 16); }
__device__ __forceinline__ float lo2f(unsigned u) { return __uint_as_float(u << 16); }
__device__ __forceinline__ float hi2f(unsigned u) { return __uint_as_float(u & 0xffff0000u); }
__device__ __forceinline__ float sigmoidf_(float x) { return 1.0f / (1.0f + __expf(-x)); }
__device__ __forceinline__ float softplusf_(float x) { return x > 20.f ? x : log1pf(__expf(x)); }
__device__ __forceinline__ float wave_sum(float v) {
#pragma unroll
    for (int o = 32; o >= 1; o >>= 1) v += __shfl_xor(v, o);
    return v;
}

constexpr size_t MiB = 1024 * 1024;
constexpr size_t WS_CTL    = 0;
constexpr size_t CTL_BYTES = 64 * 1024;
constexpr size_t WS_MOD    = 64 * 1024;
constexpr size_t WS_IDX    = 256 * 1024;
constexpr size_t WS_GATE   = WS_IDX + 512 * 1024;
constexpr size_t WS_RANK   = WS_GATE + 512 * 1024;
constexpr size_t WS_POS    = WS_RANK + 512 * 1024;
constexpr size_t WS_TOK    = WS_POS + 512 * 1024;
constexpr size_t WS_TILEE  = WS_TOK + 704 * 1024;
constexpr size_t WS_START  = WS_TILEE + 4096;
constexpr size_t WS_LOGITS = 4 * MiB;
constexpr size_t WS_BIG    = 8 * MiB;
constexpr size_t WS_XS   = WS_BIG;
constexpr size_t WS_RKV  = WS_BIG + 192 * MiB;
constexpr size_t WS_LORA = WS_BIG + 288 * MiB;
constexpr size_t WS_LD   = WS_BIG;
constexpr size_t WS_AA   = WS_BIG + 64 * MiB;
constexpr size_t WS_GG   = WS_BIG + 96 * MiB;
constexpr size_t WS_O    = WS_BIG + 128 * MiB;
constexpr size_t WS_OG   = WS_BIG + 296 * MiB;
constexpr size_t WS_Y1   = WS_BIG + 328 * MiB;
constexpr size_t WS_H2   = WS_BIG;
constexpr size_t WS_H2LO = WS_BIG + 32 * MiB;
constexpr size_t WS_YB   = WS_BIG;
constexpr size_t WS_HB   = WS_BIG + 320 * MiB;
constexpr size_t WS_H3   = WS_BIG + 320 * MiB;
constexpr size_t WS_Q    = WS_BIG;
constexpr size_t WS_AO   = WS_BIG + 96 * MiB;
constexpr size_t WS_Y1B  = WS_BIG + 128 * MiB;
constexpr size_t WS_W     = WS_BIG + 400 * MiB;
constexpr size_t WS_WGU   = WS_W;
constexpr size_t WS_WDN   = WS_WGU + (size_t)65 * 512 * 1024 * 2;
constexpr size_t WS_WRKV  = WS_WDN + (size_t)65 * 1024 * 256 * 2;
constexpr size_t WS_WO    = WS_WRKV + (size_t)3072 * 1024 * 2;
constexpr size_t WS_WQKV  = WS_WO + (size_t)1024 * 1024 * 2;
constexpr size_t WS_WSBO  = WS_WQKV + (size_t)3072 * 1024 * 2;
constexpr size_t WS_WLDN  = WS_WSBO + (size_t)1024 * 1024 * 2;
constexpr size_t WS_WLUP  = WS_WLDN + (size_t)256 * 1024 * 2;
constexpr size_t WS_WRT   = WS_WLUP + (size_t)1024 * 256 * 2;
constexpr size_t WS_END   = WS_WRT + (size_t)2 * 64 * 3072 * 2;

constexpr int CW_BAR = 0;
constexpr int CW_CNT = 4096;

#define XB_TMO      128
#define XB_XCNT(j)  (256  + 64 * (j))
#define XB_XSUB(j)  (1280 + 64 * (j))
#define XB_XGEN(j)  (2304 + 64 * (j))
#define XB_TOP      3328
#define XB_TOPGEN   3392
#define XCD_BAR_WORDS 3456
#define XB_SPIN_CAP (1u << 22)
#define LAS __attribute__((address_space(3)))

__device__ __forceinline__ unsigned xb_ld(unsigned* p)              { return __hip_atomic_load(p, __ATOMIC_RELAXED, __HIP_MEMORY_SCOPE_AGENT); }
__device__ __forceinline__ unsigned xb_add(unsigned* p, unsigned v) { return __hip_atomic_fetch_add(p, v, __ATOMIC_RELAXED, __HIP_MEMORY_SCOPE_AGENT); }
__device__ __forceinline__ unsigned xb_xcc_id() { return (unsigned)__builtin_amdgcn_s_getreg((3 << 11) | 20) & 0xFu; }
#define XB_SPIN(cond, bar) do { unsigned _sp = 0; while (cond) { __builtin_amdgcn_s_sleep(1); \
    if ((++_sp & 255u) == 0u) { if (xb_ld(&(bar)[XB_TMO])) break; if (_sp > XB_SPIN_CAP) { atomicAdd(&(bar)[XB_TMO], 1u); break; } } } } while (0)

struct XcdBarrier { unsigned* bar; unsigned x; volatile LAS unsigned* st; };

__device__ __forceinline__ XcdBarrier xcd_barrier_post(unsigned* bar, volatile LAS unsigned* st) {
    XcdBarrier b; b.bar = bar; b.x = xb_xcc_id(); b.st = st;
    if (threadIdx.x == 0) (void)xb_add(&bar[XB_XCNT(b.x)], 1u);
    return b;
}
__device__ __forceinline__ void xcd_barrier_complete(unsigned* bar, unsigned x, unsigned& nloc, unsigned& nx) {
    const unsigned G = gridDim.x * gridDim.y * gridDim.z;
    unsigned sum, cnt, mine, sp = 0u;
    for (;;) {
        sum = 0u; cnt = 0u; mine = 0u;
#pragma unroll
        for (unsigned j = 0; j < 16; ++j) { const unsigned c = xb_ld(&bar[XB_XCNT(j)]); sum += c; cnt += (c > 0u) ? 1u : 0u; mine = (j == x) ? c : mine; }
        if (sum == G) break;
        __builtin_amdgcn_s_sleep(1);
        if ((++sp & 255u) == 0u) { if (xb_ld(&bar[XB_TMO])) break; if (sp > XB_SPIN_CAP) { atomicAdd(&bar[XB_TMO], 1u); break; } }
    }
    nloc = mine > 0u ? mine : 1u; nx = cnt > 0u ? cnt : 1u;
}
__device__ __forceinline__ void xcd_barrier(const XcdBarrier& b) {
    asm volatile("s_waitcnt vmcnt(0)" ::: "memory");
    __syncthreads();
    if (threadIdx.x == 0) {
        unsigned* bar = b.bar;
        __builtin_amdgcn_s_waitcnt(0);
        unsigned nloc = b.st[0], nx = b.st[1];
        if (nloc == 0u) { xcd_barrier_complete(bar, b.x, nloc, nx); b.st[0] = nloc; b.st[1] = nx; }
        const unsigned old = xb_add(&bar[XB_XSUB(b.x)], 1u);
        const unsigned gen = old / nloc;
        if (old + 1u == (gen + 1u) * nloc) {
            __builtin_amdgcn_fence(__ATOMIC_RELEASE, "agent");
            asm volatile("s_waitcnt vmcnt(0)" ::: "memory");
            const unsigned og = xb_add(&bar[XB_TOP], 1u);
            const unsigned tg = og / nx;
            if (og + 1u == (tg + 1u) * nx) xb_add(&bar[XB_TOPGEN], 1u);
            else XB_SPIN(xb_ld(&bar[XB_TOPGEN]) == tg, bar);
            __builtin_amdgcn_fence(__ATOMIC_ACQUIRE, "agent");
            xb_add(&bar[XB_XGEN(b.x)], 1u);
            asm volatile("s_waitcnt vmcnt(0)" ::: "memory");
        } else {
            XB_SPIN(xb_ld(&bar[XB_XGEN(b.x)]) == gen, bar);
            __builtin_amdgcn_fence(__ATOMIC_ACQUIRE, "agent");
            asm volatile("s_waitcnt vmcnt(0)" ::: "memory");
        }
    }
    __syncthreads();
}

struct Args { const float* in[34]; float* out; unsigned char* ws; int ph_lo, ph_hi; };

struct Frame {
    const float* const* in; float* out; unsigned char* ws; unsigned* ctl;
    float* ldsf; LAS unsigned char* lds; int tid, lane, wave, bid, G;
};

enum { I_X = 0, I_C, I_ADAW, I_ADAB, I_NPM, I_NPOM, I_NPF, I_NPOF, I_MU, I_WRKV, I_WW1, I_WW2, I_W0, I_WA1, I_WA2, I_A0, I_WG1, I_WG2,
       I_KK, I_KA, I_RK, I_LNG, I_LNB, I_WO, I_SBQKV, I_SBO, I_ROUTER, I_RBIAS, I_MG, I_MU_, I_MD, I_SG, I_SU, I_SD };

template <class AF, class BF>
__device__ __forceinline__ void simt_tile(float (&acc)[4][4], const AF& af, const BF& bfn, int row0, int col0, int K, float* sm) {
    float* sA = sm; float* sB = sm + 16 * 132;
    const int tid = threadIdx.x, ty = tid >> 4, tx = tid & 15;
#pragma unroll
    for (int i = 0; i < 4; ++i)
#pragma unroll
        for (int j = 0; j < 4; ++j) acc[i][j] = 0.f;
    for (int k0 = 0; k0 < K; k0 += 16) {
#pragma unroll
        for (int q = 0; q < 4; ++q) { const int idx = tid + 512 * q, r = idx >> 4, kk = idx & 15; sA[kk * 132 + r] = af(row0 + r, k0 + kk); }
#pragma unroll
        for (int q = 0; q < 2; ++q) { const int idx = tid + 512 * q, kk = idx >> 6, c = idx & 63; sB[kk * 68 + c] = bfn(k0 + kk, col0 + c); }
        __syncthreads();
#pragma unroll
        for (int kk = 0; kk < 16; ++kk) {
            const f32x4 a = *(const f32x4*)&sA[kk * 132 + ty * 4];
            const f32x4 b = *(const f32x4*)&sB[kk * 68 + tx * 4];
#pragma unroll
            for (int i = 0; i < 4; ++i)
#pragma unroll
                for (int j = 0; j < 4; ++j) acc[i][j] += a[i] * b[j];
        }
        __syncthreads();
    }
}

typedef short bf16x8 __attribute__((ext_vector_type(8)));
constexpr int HTB = 128 * 64 * 2;
__device__ __forceinline__ int lds_byte(int r, int c) { const int st = (r >> 4) * 2 + (c >> 5), rr = r & 15, cc = c & 31, ob = rr * 64 + cc * 2; return st * 1024 + (ob ^ (((ob >> 9) & 1) << 5)); }
__device__ __forceinline__ void stage_rc(int b, int& R, int& C) { const int st = b / 1024, sb = b % 1024, swz = sb ^ (((sb >> 9) & 1) << 5); R = (st >> 1) * 16 + swz / 64; C = (st & 1) * 32 + (swz % 64) / 2; }
#define WAIT_V(n) asm volatile("s_waitcnt vmcnt(" #n ")" ::: "memory")
#define SBAR() do { asm volatile("" ::: "memory"); __builtin_amdgcn_s_barrier(); asm volatile("" ::: "memory"); } while (0)

struct ASeg { const bf16_t* p[3]; int segTiles; };

struct BRowId { __device__ __forceinline__ int operator()(int R) const { return R; } };
template <int BN, bool NSW = false, class ARow, class Epi, class BRow = BRowId>
__device__ __forceinline__ void sg_tile(LAS unsigned char* lds, const ASeg& A, const ARow& arow, const bf16_t* Bt, int ldb, int nt, const Epi& epi, const BRow& brow = BRow()) {
    constexpr int WN = BN / 64, WM = 8 / WN, WR = 256 / WM, MT = WR / 16;
    const int tid = threadIdx.x, wid = __builtin_amdgcn_readfirstlane(tid >> 6), lane = tid & 63, fr = lane & 15, fq = lane >> 4;
    const int wm = wid / WN, wn = wid % WN;
    unsigned aoffs[2][2], boffs[2];
#pragma unroll
    for (int i = 0; i < 2; ++i) { int R, C; stage_rc(tid * 16 + i * 8192, R, C);
        aoffs[0][i] = arow(R) + (unsigned)C * 2u; aoffs[1][i] = arow(128 + R) + (unsigned)C * 2u; boffs[i] = (unsigned)(brow(R) * ldb + C) * 2u; }
    const unsigned ldsw = (unsigned)wid * 1024u;
    f32x4 acc[MT][4];
#pragma unroll
    for (int m = 0; m < MT; ++m)
#pragma unroll
        for (int n = 0; n < 4; ++n) acc[m][n] = (f32x4){0.f, 0.f, 0.f, 0.f};
    const int arow0 = wm * WR, ah = arow0 >> 7, ar = arow0 & 127;
    const int aoff = ah * HTB + lds_byte(ar + fr, fq * 8), boff = 2 * HTB + lds_byte(wn * 64 + fr, fq * 8);
#define SG_STAGE(kt, s) do { const int sg_ = (kt) / A.segTiles; const char* ab_ = (const char*)(sg_ == 0 ? A.p[0] : (sg_ == 1 ? A.p[1] : A.p[2])) + (size_t)((kt) - sg_ * A.segTiles) * 128; const char* bb_ = (const char*)Bt + (size_t)(kt) * 128; \
        _Pragma("unroll") for (int h_ = 0; h_ < 2; ++h_) _Pragma("unroll") for (int i_ = 0; i_ < 2; ++i_) \
            __builtin_amdgcn_global_load_lds((const unsigned*)(ab_ + aoffs[h_][i_]), (LAS unsigned*)(lds + ((s) * 3 + h_) * HTB + ldsw + i_ * 8192), 16, 0, 0); \
        _Pragma("unroll") for (int i_ = 0; i_ < WN; ++i_) \
            __builtin_amdgcn_global_load_lds((const unsigned*)(bb_ + boffs[i_]), (LAS unsigned*)(lds + ((s) * 3 + 2) * HTB + ldsw + i_ * 8192), 16, 0, 0); } while (0)
    SG_STAGE(0, 0);
    for (int t = 0; t < nt; ++t) {
        const int s = t & 1;
        if (t + 1 < nt) { SG_STAGE(t + 1, s ^ 1); if (WN == 2) WAIT_V(6); else WAIT_V(5); } else { WAIT_V(0); }
        SBAR();
        LAS unsigned char* base = lds + s * 3 * HTB;
#pragma unroll
        for (int k = 0; k < 2; ++k) {
            bf16x8 af[MT], bfr[4];
#pragma unroll
            for (int m = 0; m < MT; ++m) af[m] = *(const LAS bf16x8*)(base + aoff + m * 2048 + k * 1024);
#pragma unroll
            for (int n = 0; n < 4; ++n) bfr[n] = *(const LAS bf16x8*)(base + boff + n * 2048 + k * 1024);
#pragma unroll
            for (int m = 0; m < MT; ++m)
#pragma unroll
                for (int n = 0; n < 4; ++n) acc[m][n] = NSW ? __builtin_amdgcn_mfma_f32_16x16x32_bf16(af[m], bfr[n], acc[m][n], 0, 0, 0) : __builtin_amdgcn_mfma_f32_16x16x32_bf16(bfr[n], af[m], acc[m][n], 0, 0, 0);
        }
        SBAR();
    }
#undef SG_STAGE
    epi(acc, arow0, wn * 64, fr, fq);
}

struct CTile { bf16_t* dst; const float* src; int dld, sld, ncols; };
template <class TF>
__device__ __forceinline__ void conv_tiles(const Frame& F, int ntiles, int u0, int ustride, const TF& tf) {
    unsigned* tl = (unsigned*)F.ldsf;
    const int i = F.tid & 31, kp0 = F.tid >> 5;
    if (u0 >= ntiles) return;
    CTile ct = tf(u0);
    f32x4 a[4], b[4];
#define CV_LOAD() do { _Pragma("unroll") for (int q = 0; q < 4; ++q) { const int kp = kp0 + 16 * q; \
        if (4 * i < ct.ncols) { a[q] = *(const f32x4*)(ct.src + (size_t)(2 * kp) * ct.sld + 4 * i); b[q] = *(const f32x4*)(ct.src + (size_t)(2 * kp + 1) * ct.sld + 4 * i); } } } while (0)
    CV_LOAD();
    for (int u = u0; u < ntiles; u += ustride) {
        const CTile cur = ct;
        if (4 * i < cur.ncols) {
#pragma unroll
            for (int q = 0; q < 4; ++q) { const int kp = kp0 + 16 * q;
#pragma unroll
                for (int e = 0; e < 4; ++e) tl[(4 * i + e) * 65 + kp] = pack2(a[q][e], b[q][e]); }
        }
        __syncthreads();
        if (u + ustride < ntiles) { ct = tf(u + ustride); CV_LOAD(); }
        const int nb = F.tid >> 4, sgm = F.tid & 15;
#pragma unroll
        for (int q = 0; q < 4; ++q) { const int n = nb + 32 * q;
            if (n < cur.ncols) { u32x4 v;
#pragma unroll
                for (int e = 0; e < 4; ++e) v[e] = tl[n * 65 + sgm * 4 + e];
                *(u32x4*)(cur.dst + (size_t)n * cur.dld + sgm * 8) = v; } }
        __syncthreads();
    }
#undef CV_LOAD
}
__device__ __forceinline__ void conv_moe(const Frame& F, int layer, int u0, int ustride) {
    bf16_t* WGU = (bf16_t*)(F.ws + WS_WGU); bf16_t* WDN = (bf16_t*)(F.ws + WS_WDN);
    const float* const* in = F.in;
    conv_tiles(F, 65 * 48, u0, ustride, [=](int u) {
        CTile c; const int e = u / 48, r = u % 48;
        if (r < 32) { const int up = r >> 4, kt = (r >> 1) & 7, nt = r & 1;
            const float* W = (e < 64) ? (up ? in[I_MU_] : in[I_MG]) + ((size_t)layer * NE + e) * D * DE : (up ? in[I_SU] : in[I_SG]) + (size_t)layer * D * DE;
            c.src = W + (size_t)kt * 128 * DE + nt * 128; c.sld = DE; c.dst = WGU + ((size_t)e * 512 + nt * 256 + up * 128) * D + kt * 128; c.dld = D; c.ncols = 128; }
        else { const int v = r - 32, kt = v >> 3, nt = v & 7;
            const float* W = (e < 64) ? in[I_MD] + ((size_t)layer * NE + e) * DE * D : in[I_SD] + (size_t)layer * DE * D;
            c.src = W + (size_t)kt * 128 * D + nt * 128; c.sld = D; c.dst = WDN + ((size_t)e * D + nt * 128) * DE + kt * 128; c.dld = DE; c.ncols = 128; }
        return c; });
}
__device__ __forceinline__ void conv_dense(const Frame& F, int u0, int ustride) {
    bf16_t* WRKV = (bf16_t*)(F.ws + WS_WRKV); bf16_t* WO = (bf16_t*)(F.ws + WS_WO); bf16_t* WQKV = (bf16_t*)(F.ws + WS_WQKV); bf16_t* WSBO = (bf16_t*)(F.ws + WS_WSBO); bf16_t* WLDN = (bf16_t*)(F.ws + WS_WLDN);
    const float* const* in = F.in;
    conv_tiles(F, 192 + 64 + 192 + 64 + 24, u0, ustride, [=](int u) {
        CTile c; c.dld = D; c.ncols = 128;
        if (u < 192) { const int n = u / 64, kt = (u >> 3) & 7, nt = u & 7; c.src = in[I_WRKV] + (size_t)n * D * D + (size_t)kt * 128 * D + nt * 128; c.sld = D; c.dst = WRKV + ((size_t)n * D + nt * 128) * D + kt * 128; }
        else if (u < 256) { const int v = u - 192, kt = v >> 3, nt = v & 7; c.src = in[I_WO] + (size_t)kt * 128 * D + nt * 128; c.sld = D; c.dst = WO + (size_t)nt * 128 * D + kt * 128; }
        else if (u < 448) { const int v = u - 256, kt = v / 24, nt = v % 24; c.src = in[I_SBQKV] + (size_t)kt * 128 * 3 * D + nt * 128; c.sld = 3 * D; c.dst = WQKV + (size_t)nt * 128 * D + kt * 128; }
        else if (u < 512) { const int v = u - 448, kt = v >> 3, nt = v & 7; c.src = in[I_SBO] + (size_t)kt * 128 * D + nt * 128; c.sld = D; c.dst = WSBO + (size_t)nt * 128 * D + kt * 128; }
        else { const int v = u - 512, kt = v / 3, j = v % 3;
            if (j == 0) { c.src = in[I_WW1] + (size_t)kt * 128 * 64; c.sld = 64; c.dst = WLDN + kt * 128; c.ncols = 64; }
            else if (j == 1) { c.src = in[I_WA1] + (size_t)kt * 128 * 64; c.sld = 64; c.dst = WLDN + (size_t)64 * D + kt * 128; c.ncols = 64; }
            else { c.src = in[I_WG1] + (size_t)kt * 128 * 128; c.sld = 128; c.dst = WLDN + (size_t)128 * D + kt * 128; } }
        return c; });
    bf16_t* WLUP = (bf16_t*)(F.ws + WS_WLUP); bf16_t* WRT = (bf16_t*)(F.ws + WS_WRT);
    const int gtid = u0 * NTHREADS + F.tid, gstride = ustride * NTHREADS;
    for (int i = gtid; i < 1024 * 256; i += gstride) {
        float v;
        if (i < 1024 * 64) { const int n = i / 64, k = i % 64; v = F.in[I_WW2][k * D + n]; }
        else if (i < 2 * 1024 * 64) { const int j = i - 1024 * 64, n = j / 64, k = j % 64; v = F.in[I_WA2][k * D + n]; }
        else { const int j = i - 2 * 1024 * 64, n = j / 128, k = j % 128; v = F.in[I_WG2][k * D + n]; }
        WLUP[i] = f2bf(v);
    }
    for (int i = gtid; i < 2 * 64 * 1024; i += gstride) {
        const int l = i / (64 * 1024), j = i % (64 * 1024), e = j / 1024, k = j % 1024;
        const float w = F.in[I_ROUTER][((size_t)l * D + k) * NE + e]; const bf16_t hi = f2bf(w), lo = f2bf(w - bf2f(hi));
        bf16_t* row = WRT + ((size_t)l * 64 + e) * 3072; row[k] = hi; row[1024 + k] = lo; row[2048 + k] = hi;
    }
}

__device__ __forceinline__ void ph_mod(const Frame& F) {
    const float* c = F.in[I_C]; const float* W = F.in[I_ADAW]; const float* bias = F.in[I_ADAB];
    float* MOD = (float*)(F.ws + WS_MOD);
    float* red = F.ldsf;
    float* sc = F.ldsf + 1024;
    for (int i = F.tid; i < 2 * D; i += NTHREADS) { const float v = c[i]; sc[i] = v * sigmoidf_(v); }
    __syncthreads();
    for (int u = F.bid; u < 192; u += F.G) {
        const int l = u / 96, cg = u % 96, col = cg * 64 + F.lane;
        float s0 = 0.f, s1 = 0.f;
        const float* wp = W + ((size_t)l * D + F.wave * 128) * 6144 + col;
#pragma unroll 1
        for (int d0 = 0; d0 < 128; d0 += 32) {
            float wv[32];
#pragma unroll
            for (int d = 0; d < 32; ++d) wv[d] = wp[(size_t)(d0 + d) * 6144];
#pragma unroll
            for (int d = 0; d < 32; ++d) { const int dd = F.wave * 128 + d0 + d; s0 += sc[dd] * wv[d]; s1 += sc[D + dd] * wv[d]; }
        }
        red[(F.wave * 2 + 0) * 64 + F.lane] = s0; red[(F.wave * 2 + 1) * 64 + F.lane] = s1;
        __syncthreads();
        if (F.tid < 128) {
            const int b = F.tid >> 6, cc = F.tid & 63; float s = 0.f;
#pragma unroll
            for (int w = 0; w < 8; ++w) s += red[(w * 2 + b) * 64 + cc];
            MOD[(l * 2 + b) * 6144 + cg * 64 + cc] = s + bias[l * 6144 + cg * 64 + cc];
        }
        __syncthreads();
    }
}

__device__ __forceinline__ void ph_prenorm_rwkv(const Frame& F) {
    const float* x = F.in[I_X]; const float* g = F.in[I_NPM]; const float* mu = F.in[I_MU];
    const float* MOD = (const float*)(F.ws + WS_MOD);
    bf16_t* XS = (bf16_t*)(F.ws + WS_XS);
    const int nunits = T / 8;
    for (int u = F.bid * NWAVES + F.wave; u < nunits; u += F.G * NWAVES) {
        const int t0 = u * 8, b = t0 / SEQ;
        const float* shift = MOD + (0 * 2 + b) * 6144; const float* scale = shift + 1024;
        f32x4 gm[4], sh[4];
#pragma unroll
        for (int i = 0; i < 4; ++i) { const int c = 4 * F.lane + 256 * i; const f32x4 gv = *(const f32x4*)(g + c), sc = *(const f32x4*)(scale + c); gm[i] = gv * (sc + 1.0f); sh[i] = *(const f32x4*)(shift + c); }
        f32x4 hp[4];
#pragma unroll
        for (int i = 0; i < 4; ++i) hp[i] = (f32x4){0.f, 0.f, 0.f, 0.f};
        const int tstart = (t0 % SEQ == 0) ? t0 : t0 - 1;
        for (int t = tstart; t < t0 + 8; ++t) {
            f32x4 xv[4]; float ss = 0.f;
#pragma unroll
            for (int i = 0; i < 4; ++i) { xv[i] = *(const f32x4*)(x + (size_t)t * D + 4 * F.lane + 256 * i); ss += xv[i][0] * xv[i][0] + xv[i][1] * xv[i][1] + xv[i][2] * xv[i][2] + xv[i][3] * xv[i][3]; }
            ss = wave_sum(ss);
            const float rs = rsqrtf(ss * (1.0f / D) + 1e-6f);
            f32x4 h[4];
#pragma unroll
            for (int i = 0; i < 4; ++i) h[i] = xv[i] * rs * gm[i] + sh[i];
            if (t >= t0) {
#pragma unroll
                for (int n = 0; n < 6; ++n) {
#pragma unroll
                    for (int i = 0; i < 4; ++i) {
                        const int c = 4 * F.lane + 256 * i;
                        const f32x4 m = *(const f32x4*)(mu + n * D + c);
                        const f32x4 v = h[i] + (hp[i] - h[i]) * m;
                        u32x2 w; w.x = pack2(v[0], v[1]); w.y = pack2(v[2], v[3]);
                        *(u32x2*)(XS + ((size_t)n * T + t) * D + c) = w;
                    }
                }
            }
#pragma unroll
            for (int i = 0; i < 4; ++i) hp[i] = h[i];
        }
    }
}

__device__ __forceinline__ void ph_rkv_lora_simt(const Frame& F) {
    const bf16_t* XS = (const bf16_t*)(F.ws + WS_XS);
    bf16_t* RKV = (bf16_t*)(F.ws + WS_RKV); bf16_t* LORA = (bf16_t*)(F.ws + WS_LORA);
    const int nct = 52, nunits = (T / 128) * nct;
    for (int u = F.bid; u < nunits; u += F.G) {
        const int rt = u / nct, ct = u % nct, row0 = rt * 128;
        float acc[4][4];
        const int ty = F.tid >> 4, tx = F.tid & 15;
        if (ct < 48) {
            const int n = ct / 16, col0 = (ct % 16) * 64;
            const bf16_t* A = XS + (size_t)n * T * D; const float* W = F.in[I_WRKV] + (size_t)n * D * D;
            simt_tile(acc, [&](int r, int k) { return bf2f(A[(size_t)r * D + k]); }, [&](int k, int c) { return W[(size_t)k * D + c]; }, row0, col0, D, F.ldsf);
#pragma unroll
            for (int i = 0; i < 4; ++i) { u32x2 w; w.x = pack2(acc[i][0], acc[i][1]); w.y = pack2(acc[i][2], acc[i][3]);
                *(u32x2*)(RKV + ((size_t)n * T + row0 + ty * 4 + i) * D + col0 + tx * 4) = w; }
        } else {
            const int j = ct - 48;
            const int n = (j == 0) ? 3 : (j == 1 ? 4 : 5);
            const bf16_t* A = XS + (size_t)n * T * D;
            const float* W = (j == 0) ? F.in[I_WW1] : (j == 1 ? F.in[I_WA1] : F.in[I_WG1]);
            const int ldw = (j >= 2) ? 128 : 64, coff = (j == 3) ? 64 : 0;
            simt_tile(acc, [&](int r, int k) { return bf2f(A[(size_t)r * D + k]); }, [&](int k, int c) { return W[(size_t)k * ldw + coff + c]; }, row0, 0, D, F.ldsf);
#pragma unroll
            for (int i = 0; i < 4; ++i) {
                float v[4];
#pragma unroll
                for (int q = 0; q < 4; ++q) { const float a = acc[i][q]; v[q] = (j == 0) ? tanhf(a) : (j == 1 ? a : sigmoidf_(a)); }
                u32x2 w; w.x = pack2(v[0], v[1]); w.y = pack2(v[2], v[3]);
                *(u32x2*)(LORA + (size_t)(row0 + ty * 4 + i) * 256 + j * 64 + tx * 4) = w;
            }
        }
    }
}

__device__ __forceinline__ void ph_lora_up_simt(const Frame& F) {
    const bf16_t* LORA = (const bf16_t*)(F.ws + WS_LORA);
    float* LD = (float*)(F.ws + WS_LD); bf16_t* AA = (bf16_t*)(F.ws + WS_AA); bf16_t* GG = (bf16_t*)(F.ws + WS_GG);
    const int nunits = (T / 128) * 48;
    for (int u = F.bid; u < nunits; u += F.G) {
        const int rt = u / 48, ct = u % 48, row0 = rt * 128, which = ct / 16, col0 = (ct % 16) * 64;
        const int ty = F.tid >> 4, tx = F.tid & 15;
        float acc[4][4];
        const float* W = which == 0 ? F.in[I_WW2] : (which == 1 ? F.in[I_WA2] : F.in[I_WG2]);
        const int K = which == 2 ? 128 : 64, koff = which * 64;
        simt_tile(acc, [&](int r, int k) { return bf2f(LORA[(size_t)r * 256 + koff + k]); }, [&](int k, int c) { return W[(size_t)k * D + c]; }, row0, col0, K, F.ldsf);
#pragma unroll
        for (int i = 0; i < 4; ++i) {
            const size_t o = (size_t)(row0 + ty * 4 + i) * D + col0 + tx * 4;
            if (which == 0) {
                f32x4 v;
#pragma unroll
                for (int q = 0; q < 4; ++q) { const float wl = F.in[I_W0][col0 + tx * 4 + q] + acc[i][q]; const float wlog = -softplusf_(-wl) - 0.5f; v[q] = -__expf(wlog); }
                *(f32x4*)(LD + o) = v;
            } else if (which == 1) {
                float v[4];
#pragma unroll
                for (int q = 0; q < 4; ++q) v[q] = sigmoidf_(F.in[I_A0][col0 + tx * 4 + q] + acc[i][q]);
                u32x2 w; w.x = pack2(v[0], v[1]); w.y = pack2(v[2], v[3]); *(u32x2*)(AA + o) = w;
            } else {
                u32x2 w; w.x = pack2(acc[i][0], acc[i][1]); w.y = pack2(acc[i][2], acc[i][3]); *(u32x2*)(GG + o) = w;
            }
        }
    }
}

__device__ __forceinline__ void ph_wkv_seq(const Frame& F) {
    const bf16_t* RKV = (const bf16_t*)(F.ws + WS_RKV); const float* LD = (const float*)(F.ws + WS_LD); const bf16_t* AA = (const bf16_t*)(F.ws + WS_AA);
    float* O = (float*)(F.ws + WS_O);
    const bf16_t* Rb = RKV; const bf16_t* Kb = RKV + (size_t)T * D; const bf16_t* Vb = RKV + (size_t)2 * T * D;
    for (int u = F.bid; u < NB * NH; u += F.G) {
        const int b = u / NH, h = u % NH, i = F.tid >> 3, js = F.tid & 7;
        const int cj = h * 64 + js * 8;
        float kkw[8], kaw[8];
#pragma unroll
        for (int e = 0; e < 8; ++e) { kkw[e] = F.in[I_KK][cj + e]; kaw[e] = F.in[I_KA][cj + e]; }
        float S[8];
#pragma unroll
        for (int e = 0; e < 8; ++e) S[e] = 0.f;
        size_t base = (size_t)(b * SEQ) * D;
        u32x4 kr = *(const u32x4*)(Kb + base + cj), rr = *(const u32x4*)(Rb + base + cj), ar = *(const u32x4*)(AA + base + cj);
        f32x4 l0 = *(const f32x4*)(LD + base + cj), l1 = *(const f32x4*)(LD + base + cj + 4);
        bf16_t vr = Vb[base + h * 64 + i];
        for (int t = 0; t < SEQ; ++t) {
            const u32x4 kc = kr, rc = rr, ac = ar; const f32x4 lc0 = l0, lc1 = l1; const bf16_t vc = vr;
            if (t + 1 < SEQ) { const size_t nb = base + D;
                kr = *(const u32x4*)(Kb + nb + cj); rr = *(const u32x4*)(Rb + nb + cj); ar = *(const u32x4*)(AA + nb + cj);
                l0 = *(const f32x4*)(LD + nb + cj); l1 = *(const f32x4*)(LD + nb + cj + 4); vr = Vb[nb + h * 64 + i]; }
            float k[8], r[8], a[8], ld[8];
#pragma unroll
            for (int q = 0; q < 4; ++q) { k[2 * q] = lo2f(kc[q]); k[2 * q + 1] = hi2f(kc[q]); r[2 * q] = lo2f(rc[q]); r[2 * q + 1] = hi2f(rc[q]); a[2 * q] = lo2f(ac[q]); a[2 * q + 1] = hi2f(ac[q]); }
#pragma unroll
            for (int q = 0; q < 4; ++q) { ld[q] = lc0[q]; ld[4 + q] = lc1[q]; }
            const float v = bf2f(vc);
            float kkv[8], ss = 0.f;
#pragma unroll
            for (int e = 0; e < 8; ++e) { kkv[e] = k[e] * kkw[e]; ss += kkv[e] * kkv[e]; }
            ss += __shfl_xor(ss, 1); ss += __shfl_xor(ss, 2); ss += __shfl_xor(ss, 4);
            const float inv = 1.0f / fmaxf(sqrtf(ss), 1e-12f);
            float sa = 0.f;
#pragma unroll
            for (int e = 0; e < 8; ++e) { kkv[e] *= inv; sa += S[e] * (-kkv[e]); }
            sa += __shfl_xor(sa, 1); sa += __shfl_xor(sa, 2); sa += __shfl_xor(sa, 4);
            float o = 0.f;
#pragma unroll
            for (int e = 0; e < 8; ++e) {
                const float kf = k[e] * (1.0f + (a[e] - 1.0f) * kaw[e]);
                S[e] = S[e] * __expf(ld[e]) + sa * (kkv[e] * a[e]) + v * kf;
                o += S[e] * r[e];
            }
            o += __shfl_xor(o, 1); o += __shfl_xor(o, 2); o += __shfl_xor(o, 4);
            if (js == 0) O[base + h * 64 + i] = o;
            base += D;
        }
    }
}

__device__ __forceinline__ void ld16bf(const bf16_t* p, float (&v)[16]) {
    const u32x4 a = *(const u32x4*)p, b = *(const u32x4*)(p + 8);
#pragma unroll
    for (int q = 0; q < 4; ++q) { v[2 * q] = lo2f(a[q]); v[2 * q + 1] = hi2f(a[q]); v[8 + 2 * q] = lo2f(b[q]); v[9 + 2 * q] = hi2f(b[q]); }
}
__device__ __forceinline__ void st16bf(bf16_t* p, const float (&v)[16]) {
    u32x4 a, b;
#pragma unroll
    for (int q = 0; q < 4; ++q) { a[q] = pack2(v[2 * q], v[2 * q + 1]); b[q] = pack2(v[8 + 2 * q], v[9 + 2 * q]); }
    *(u32x4*)p = a; *(u32x4*)(p + 8) = b;
}
__device__ __forceinline__ void ld16f(const float* p, float (&v)[16]) {
#pragma unroll
    for (int q = 0; q < 4; ++q) { const f32x4 a = *(const f32x4*)(p + 4 * q); v[4 * q] = a[0]; v[4 * q + 1] = a[1]; v[4 * q + 2] = a[2]; v[4 * q + 3] = a[3]; }
}
__device__ __forceinline__ void ph_wkv_post(const Frame& F) {
    const bf16_t* RKV = (const bf16_t*)(F.ws + WS_RKV); const bf16_t* AA = (const bf16_t*)(F.ws + WS_AA); const bf16_t* GG = (const bf16_t*)(F.ws + WS_GG);
    const float* O = (const float*)(F.ws + WS_O); bf16_t* OG = (bf16_t*)(F.ws + WS_OG);
    const int c0 = 16 * F.lane;
    float ka[16], rk[16], lg[16], lb[16];
    ld16f(F.in[I_KA] + c0, ka); ld16f(F.in[I_RK] + c0, rk); ld16f(F.in[I_LNG] + c0, lg); ld16f(F.in[I_LNB] + c0, lb);
    for (int t = F.bid * NWAVES + F.wave; t < T; t += F.G * NWAVES) {
        const size_t o = (size_t)t * D + c0;
        float ov[16], r[16], k[16], v[16], a[16], g[16];
        ld16f(O + o, ov); ld16bf(RKV + o, r); ld16bf(RKV + (size_t)T * D + o, k); ld16bf(RKV + (size_t)2 * T * D + o, v); ld16bf(AA + o, a); ld16bf(GG + o, g);
        float s = 0.f, bs = 0.f;
#pragma unroll
        for (int e = 0; e < 16; ++e) { s += ov[e]; const float kf = k[e] * (1.0f + (a[e] - 1.0f) * ka[e]); bs += r[e] * kf * rk[e]; }
        s += __shfl_xor(s, 1); s += __shfl_xor(s, 2); bs += __shfl_xor(bs, 1); bs += __shfl_xor(bs, 2);
        const float mean = s * (1.0f / 64.0f);
        float q = 0.f;
#pragma unroll
        for (int e = 0; e < 16; ++e) { const float d = ov[e] - mean; q += d * d; }
        q += __shfl_xor(q, 1); q += __shfl_xor(q, 2);
        const float rstd = rsqrtf(q * (1.0f / 64.0f) + 64e-5f);
        float res[16];
#pragma unroll
        for (int e = 0; e < 16; ++e) res[e] = (((ov[e] - mean) * rstd) * lg[e] + lb[e] + bs * v[e]) * g[e];
        st16bf(OG + o, res);
    }
}

template <int OUTMODE>
__device__ __forceinline__ void ph_dense_simt(const Frame& F, const bf16_t* A, const float* W, int N, int K, void* out) {
    const int nct = N / 64, nunits = (T / 128) * nct;
    for (int u = F.bid; u < nunits; u += F.G) {
        const int rt = u / nct, ct = u % nct, row0 = rt * 128, col0 = ct * 64;
        const int ty = F.tid >> 4, tx = F.tid & 15;
        float acc[4][4];
        simt_tile(acc, [&](int r, int k) { return bf2f(A[(size_t)r * K + k]); }, [&](int k, int c) { return W[(size_t)k * N + c]; }, row0, col0, K, F.ldsf);
#pragma unroll
        for (int i = 0; i < 4; ++i) {
            const int r = row0 + ty * 4 + i, c = col0 + tx * 4;
            if (OUTMODE == 0) { *(f32x4*)((float*)out + (size_t)r * N + c) = (f32x4){acc[i][0], acc[i][1], acc[i][2], acc[i][3]}; }
            else { u32x2 w; w.x = pack2(acc[i][0], acc[i][1]); w.y = pack2(acc[i][2], acc[i][3]);
                   *(u32x2*)((bf16_t*)out + (size_t)(c / D) * T * D + (size_t)r * D + (c % D)) = w; }
        }
    }
}

__device__ __forceinline__ void ph_postmix_preffn(const Frame& F, int layer, const float* xin, const float* Y) {
    const float* MOD = (const float*)(F.ws + WS_MOD);
    const float* gpo = F.in[I_NPOM] + layer * D; const float* gpf = F.in[I_NPF] + layer * D;
    bf16_t* H2 = (bf16_t*)(F.ws + WS_H2); bf16_t* H2LO = (bf16_t*)(F.ws + WS_H2LO);
    for (int t = F.bid * NWAVES + F.wave; t < T; t += F.G * NWAVES) {
        const int b = t / SEQ; const float* m = MOD + (layer * 2 + b) * 6144;
        f32x4 y[4]; float ss = 0.f;
#pragma unroll
        for (int i = 0; i < 4; ++i) { y[i] = *(const f32x4*)(Y + (size_t)t * D + 4 * F.lane + 256 * i); ss += y[i][0] * y[i][0] + y[i][1] * y[i][1] + y[i][2] * y[i][2] + y[i][3] * y[i][3]; }
        ss = wave_sum(ss);
        const float rs = rsqrtf(ss * (1.0f / D) + 1e-6f);
        f32x4 x1[4]; float s2 = 0.f;
#pragma unroll
        for (int i = 0; i < 4; ++i) { const int c = 4 * F.lane + 256 * i;
            const f32x4 xv = *(const f32x4*)(xin + (size_t)t * D + c), gm = *(const f32x4*)(m + 2048 + c), gp = *(const f32x4*)(gpo + c);
            x1[i] = xv + gm * (y[i] * rs * gp);
            *(f32x4*)(F.out + (size_t)t * D + c) = x1[i];
            s2 += x1[i][0] * x1[i][0] + x1[i][1] * x1[i][1] + x1[i][2] * x1[i][2] + x1[i][3] * x1[i][3]; }
        s2 = wave_sum(s2);
        const float rs2 = rsqrtf(s2 * (1.0f / D) + 1e-6f);
#pragma unroll
        for (int i = 0; i < 4; ++i) { const int c = 4 * F.lane + 256 * i;
            const f32x4 gf = *(const f32x4*)(gpf + c), sc = *(const f32x4*)(m + 4096 + c), sh = *(const f32x4*)(m + 3072 + c);
            const f32x4 h = x1[i] * rs2 * gf * (sc + 1.0f) + sh;
            u32x2 w; w.x = pack2(h[0], h[1]); w.y = pack2(h[2], h[3]);
            u32x2 wl; wl.x = pack2(h[0] - lo2f(w.x), h[1] - hi2f(w.x)); wl.y = pack2(h[2] - lo2f(w.y), h[3] - hi2f(w.y));
            *(u32x2*)(H2 + (size_t)t * D + c) = w; *(u32x2*)(H2LO + (size_t)t * D + c) = wl; }
    }
}

__device__ __forceinline__ void ph_router_simt(const Frame& F, int layer) {
    const bf16_t* H2 = (const bf16_t*)(F.ws + WS_H2); const bf16_t* H2LO = (const bf16_t*)(F.ws + WS_H2LO);
    const float* W = F.in[I_ROUTER] + (size_t)layer * D * NE; float* LOG = (float*)(F.ws + WS_LOGITS);
    for (int u = F.bid; u < T / 128; u += F.G) {
        const int row0 = u * 128, ty = F.tid >> 4, tx = F.tid & 15;
        float acc[4][4];
        simt_tile(acc, [&](int r, int k) { return bf2f(H2[(size_t)r * D + k]) + bf2f(H2LO[(size_t)r * D + k]); }, [&](int k, int c) { return W[(size_t)k * NE + c]; }, row0, 0, D, F.ldsf);
#pragma unroll
        for (int i = 0; i < 4; ++i) *(f32x4*)(LOG + (size_t)(row0 + ty * 4 + i) * NE + tx * 4) = (f32x4){acc[i][0], acc[i][1], acc[i][2], acc[i][3]};
    }
}

__device__ __forceinline__ void ph_topk(const Frame& F, int layer) {
    const float* LOG = (const float*)(F.ws + WS_LOGITS); const float* rb = F.in[I_RBIAS] + layer * NE;
    int* IDX = (int*)(F.ws + WS_IDX); float* GATE = (float*)(F.ws + WS_GATE); int* RANK = (int*)(F.ws + WS_RANK);
    unsigned* CNT = F.ctl + CW_CNT + layer * 64;
    unsigned* lcnt = (unsigned*)F.ldsf; unsigned* gb = lcnt + 64;
    const float bias = rb[F.lane];
    for (int base = F.bid * 64; base < T; base += F.G * 64) {
        if (F.tid < 64) lcnt[F.tid] = 0u;
        __syncthreads();
        int myidx[8]; unsigned lrank[8];
#pragma unroll
        for (int j = 0; j < 8; ++j) {
            const int t = base + F.wave * 8 + j;
            const float s = sigmoidf_(LOG[(size_t)t * NE + F.lane]);
            float sel = s + bias;
            int mi = 0; float mysc = 0.f; float tot = 0.f;
#pragma unroll
            for (int k = 0; k < TOPK; ++k) {
                float bv = sel; int bi = F.lane;
#pragma unroll
                for (int o = 32; o >= 1; o >>= 1) { const float ov = __shfl_xor(bv, o); const int oi = __shfl_xor(bi, o); if (ov > bv || (ov == bv && oi < bi)) { bv = ov; bi = oi; } }
                const float sc = __shfl(s, bi);
                tot += sc;
                if (F.lane == k) { mi = bi; mysc = sc; }
                if (F.lane == bi) sel = -1e30f;
            }
            myidx[j] = mi; lrank[j] = 0u;
            if (F.lane < TOPK) { IDX[t * TOPK + F.lane] = mi; GATE[t * TOPK + F.lane] = 2.5f * mysc / tot; lrank[j] = atomicAdd(&lcnt[mi], 1u); }
        }
        __syncthreads();
        if (F.tid < 64) gb[F.tid] = atomicAdd(&CNT[F.tid], lcnt[F.tid]);
        __syncthreads();
#pragma unroll
        for (int j = 0; j < 8; ++j) { const int t = base + F.wave * 8 + j; if (F.lane < TOPK) RANK[t * TOPK + F.lane] = (int)(gb[myidx[j]] + lrank[j]); }
        __syncthreads();
    }
}

__device__ __forceinline__ void ph_offsets(const Frame& F, int layer) {
    const unsigned* CNT = F.ctl + CW_CNT + layer * 64;
    const int* IDX = (const int*)(F.ws + WS_IDX); const int* RANK = (const int*)(F.ws + WS_RANK);
    int* POS = (int*)(F.ws + WS_POS); int* TOK = (int*)(F.ws + WS_TOK); int* TILEE = (int*)(F.ws + WS_TILEE); int* START = (int*)(F.ws + WS_START);
    int* sst = (int*)F.ldsf;
    if (F.tid < NE) sst[128 + F.tid] = (int)CNT[F.tid];
    __syncthreads();
    if (F.tid == 0) { int acc = 0; for (int e = 0; e < NE; ++e) { const int c = sst[128 + e]; sst[e] = acc; acc += ((c + RP - 1) / RP) * RP; } sst[64] = acc; }
    __syncthreads();
    if (F.bid == 0) {
        if (F.tid <= 64) START[F.tid] = sst[F.tid];
        if (F.tid == 65) START[65] = sst[64];
        const int ntile = sst[64] / RP;
        for (int i = F.tid; i < ntile; i += NTHREADS) { int e = 0; while (e < 63 && sst[e + 1] <= i * RP) ++e; TILEE[i] = e; }
    }
    for (int s = F.bid * NTHREADS + F.tid; s < T * TOPK; s += F.G * NTHREADS) {
        const int e = IDX[s], p = sst[e] + RANK[s];
        POS[s] = p; TOK[p] = s / TOPK;
    }
    for (int s = F.bid * NTHREADS + F.tid; s < NE * RP; s += F.G * NTHREADS) {
        const int e = s / RP, r = s % RP, c = sst[128 + e];
        if (sst[e] + c + r < sst[e + 1]) TOK[sst[e] + c + r] = 0;
    }
    __syncthreads();
}

__device__ __forceinline__ void ph_gateup_simt(const Frame& F, int layer) {
    const bf16_t* H2 = (const bf16_t*)(F.ws + WS_H2); bf16_t* HB = (bf16_t*)(F.ws + WS_HB);
    const int* TOK = (const int*)(F.ws + WS_TOK); const int* TILEE = (const int*)(F.ws + WS_TILEE); const int* START = (const int*)(F.ws + WS_START);
    const int routed = START[65], nrt = (routed + T) / 128, nunits = nrt * 4;
    for (int u = F.bid; u < nunits; u += F.G) {
        const int rt = u / 4, ct = u % 4, row0 = rt * 128, col0 = ct * 64, ty = F.tid >> 4, tx = F.tid & 15;
        const bool sh = row0 >= routed; const int e = sh ? 0 : TILEE[row0 / RP];
        const float* Wg = sh ? F.in[I_SG] + (size_t)layer * D * DE : F.in[I_MG] + ((size_t)layer * NE + e) * D * DE;
        const float* Wu = sh ? F.in[I_SU] + (size_t)layer * D * DE : F.in[I_MU_] + ((size_t)layer * NE + e) * D * DE;
        auto af = [&](int r, int k) { const int tok = sh ? (r - routed) : TOK[r]; return bf2f(H2[(size_t)tok * D + k]); };
        float ag[4][4], au[4][4];
        simt_tile(ag, af, [&](int k, int c) { return Wg[(size_t)k * DE + c]; }, row0, col0, D, F.ldsf);
        simt_tile(au, af, [&](int k, int c) { return Wu[(size_t)k * DE + c]; }, row0, col0, D, F.ldsf);
#pragma unroll
        for (int i = 0; i < 4; ++i) { float v[4];
#pragma unroll
            for (int q = 0; q < 4; ++q) { const float g = ag[i][q]; v[q] = g * sigmoidf_(g) * au[i][q]; }
            u32x2 w; w.x = pack2(v[0], v[1]); w.y = pack2(v[2], v[3]);
            *(u32x2*)(HB + (size_t)(row0 + ty * 4 + i) * DE + col0 + tx * 4) = w; }
    }
}
__device__ __forceinline__ void ph_down_simt(const Frame& F, int layer) {
    const bf16_t* HB = (const bf16_t*)(F.ws + WS_HB); bf16_t* YB = (bf16_t*)(F.ws + WS_YB);
    const int* TILEE = (const int*)(F.ws + WS_TILEE); const int* START = (const int*)(F.ws + WS_START);
    const int routed = START[65], nrt = (routed + T) / 128, nunits = nrt * 16;
    for (int u = F.bid; u < nunits; u += F.G) {
        const int rt = u / 16, ct = u % 16, row0 = rt * 128, col0 = ct * 64, ty = F.tid >> 4, tx = F.tid & 15;
        const bool sh = row0 >= routed; const int e = sh ? 0 : TILEE[row0 / RP];
        const float* Wd = sh ? F.in[I_SD] + (size_t)layer * DE * D : F.in[I_MD] + ((size_t)layer * NE + e) * DE * D;
        float acc[4][4];
        simt_tile(acc, [&](int r, int k) { return bf2f(HB[(size_t)r * DE + k]); }, [&](int k, int c) { return Wd[(size_t)k * D + c]; }, row0, col0, DE, F.ldsf);
#pragma unroll
        for (int i = 0; i < 4; ++i) { u32x2 w; w.x = pack2(acc[i][0], acc[i][1]); w.y = pack2(acc[i][2], acc[i][3]);
            *(u32x2*)(YB + (size_t)(row0 + ty * 4 + i) * D + col0 + tx * 4) = w; }
    }
}
__device__ __forceinline__ void ph_combine(const Frame& F, int layer, bool next) {
    const bf16_t* YB = (const bf16_t*)(F.ws + WS_YB); const int* POS = (const int*)(F.ws + WS_POS); const float* GATE = (const float*)(F.ws + WS_GATE);
    const int* START = (const int*)(F.ws + WS_START); const float* MOD = (const float*)(F.ws + WS_MOD);
    const float* gpo = F.in[I_NPOF] + layer * D;
    bf16_t* H3 = (bf16_t*)(F.ws + WS_H3);
    const int routed = START[65];
    for (int t = F.bid * NWAVES + F.wave; t < T; t += F.G * NWAVES) {
        const int b = t / SEQ; const float* m = MOD + (layer * 2 + b) * 6144;
        f32x4 y[4];
#pragma unroll
        for (int i = 0; i < 4; ++i) { const u32x2 w = *(const u32x2*)(YB + (size_t)(routed + t) * D + 4 * F.lane + 256 * i); y[i] = (f32x4){lo2f(w.x), hi2f(w.x), lo2f(w.y), hi2f(w.y)}; }
#pragma unroll
        for (int k = 0; k < TOPK; ++k) {
            const int p = POS[t * TOPK + k]; const float gk = GATE[t * TOPK + k];
#pragma unroll
            for (int i = 0; i < 4; ++i) { const u32x2 w = *(const u32x2*)(YB + (size_t)p * D + 4 * F.lane + 256 * i); y[i] += (f32x4){lo2f(w.x), hi2f(w.x), lo2f(w.y), hi2f(w.y)} * gk; }
        }
        float ss = 0.f;
#pragma unroll
        for (int i = 0; i < 4; ++i) ss += y[i][0] * y[i][0] + y[i][1] * y[i][1] + y[i][2] * y[i][2] + y[i][3] * y[i][3];
        ss = wave_sum(ss);
        const float rs = rsqrtf(ss * (1.0f / D) + 1e-6f);
        f32x4 x2[4]; float s2 = 0.f;
#pragma unroll
        for (int i = 0; i < 4; ++i) { const int c = 4 * F.lane + 256 * i;
            const f32x4 xv = *(const f32x4*)(F.out + (size_t)t * D + c), gm = *(const f32x4*)(m + 5120 + c), gp = *(const f32x4*)(gpo + c);
            x2[i] = xv + gm * (y[i] * rs * gp);
            *(f32x4*)(F.out + (size_t)t * D + c) = x2[i];
            s2 += x2[i][0] * x2[i][0] + x2[i][1] * x2[i][1] + x2[i][2] * x2[i][2] + x2[i][3] * x2[i][3]; }
        if (next) {
            s2 = wave_sum(s2);
            const float rs2 = rsqrtf(s2 * (1.0f / D) + 1e-6f);
            const float* m1 = MOD + ((layer + 1) * 2 + b) * 6144; const float* g1 = F.in[I_NPM] + (layer + 1) * D;
#pragma unroll
            for (int i = 0; i < 4; ++i) { const int c = 4 * F.lane + 256 * i;
                const f32x4 gf = *(const f32x4*)(g1 + c), sc = *(const f32x4*)(m1 + 1024 + c), sh = *(const f32x4*)(m1 + c);
                const f32x4 h = x2[i] * rs2 * gf * (sc + 1.0f) + sh;
                u32x2 w; w.x = pack2(h[0], h[1]); w.y = pack2(h[2], h[3]);
                *(u32x2*)(H3 + (size_t)t * D + c) = w; }
        }
    }
}

#define SB_EXIT 110.0f
__device__ __forceinline__ void ph_attn_ref(const Frame& F) {
    const bf16_t* Q = (const bf16_t*)(F.ws + WS_Q); const bf16_t* Kb = Q + (size_t)T * D; const bf16_t* Vb = Q + (size_t)2 * T * D;
    bf16_t* AO = (bf16_t*)(F.ws + WS_AO);
    float* Ks = F.ldsf; float* Vs = Ks + 64 * 65; float* Qs = Vs + 64 * 65; float* Ws = Qs + 64 * 64; float* Rm = Ws + 8 * 64;
    const int nunits = NB * NH * (SEQ / 64);
    for (int u = F.bid; u < nunits; u += F.G) {
        const int qt = (SEQ / 64 - 1) - (u / (NB * NH)), bh = u % (NB * NH), b = bh / NH, h = bh % NH;
        const size_t tb = (size_t)b * SEQ;
        for (int idx = F.tid; idx < 64 * 64; idx += NTHREADS) { const int r = idx >> 6, c = idx & 63; Qs[idx] = bf2f(Q[(tb + qt * 64 + r) * D + h * 64 + c]) * 0.125f; }
        float R[8], acc[8];
#pragma unroll
        for (int q = 0; q < 8; ++q) { R[q] = 0.f; acc[q] = 0.f; }
        for (int kt = qt; kt >= 0; --kt) {
            __syncthreads();
            for (int idx = F.tid; idx < 64 * 64; idx += NTHREADS) { const int r = idx >> 6, c = idx & 63; const size_t g = (tb + kt * 64 + r) * D + h * 64 + c; Ks[r * 65 + c] = bf2f(Kb[g]); Vs[r * 65 + c] = bf2f(Vb[g]); }
            __syncthreads();
#pragma unroll
            for (int q = 0; q < 8; ++q) {
                const int qi = F.wave * 8 + q;
                float z = 0.f;
#pragma unroll 16
                for (int d = 0; d < 64; ++d) z += Qs[qi * 64 + d] * Ks[F.lane * 65 + d];
                const bool valid = (kt < qt) || (F.lane < qi);
                const float sp = valid ? softplusf_(z) : 0.f;
                float suf = sp;
#pragma unroll
                for (int o = 1; o < 64; o <<= 1) { const float v = __shfl_down(suf, o); if (F.lane + o < 64) suf += v; }
                const float tail = R[q] + suf - sp;
                const float w = valid ? __expf(z - sp - tail) : 0.f;
                R[q] += __shfl(suf, 0);
                Ws[F.wave * 64 + F.lane] = w;
                float a = acc[q];
#pragma unroll 16
                for (int s = 0; s < 64; ++s) a += Ws[F.wave * 64 + s] * Vs[s * 65 + F.lane];
                acc[q] = a;
            }
            float mn = R[0];
#pragma unroll
            for (int q = 1; q < 8; ++q) mn = fminf(mn, R[q]);
            if (F.lane == 0) Rm[F.wave] = mn;
            __syncthreads();
            float allmin = Rm[0];
#pragma unroll
            for (int w = 1; w < 8; ++w) allmin = fminf(allmin, Rm[w]);
            if (allmin > SB_EXIT) break;
        }
#pragma unroll
        for (int q = 0; q < 8; ++q) AO[(tb + qt * 64 + F.wave * 8 + q) * D + h * 64 + F.lane] = f2bf(acc[q]);
        __syncthreads();
    }
}

namespace pgx {
__device__ __forceinline__ int perm32(int rho) { const int n = rho >> 4, i = rho & 15; return 8 * (i >> 2) + 4 * n + (i & 3); }
struct Unit { const char* A; const int* tok; const char* B; int r0, c0, aux; };
template <bool SW, bool PERM, class Sched, class Epi>
__device__ __forceinline__ void gemm_phase(LAS unsigned char* lds, const int K, const unsigned lda  , const Sched& S, const Epi& E) {
    const int tid = threadIdx.x, wid = __builtin_amdgcn_readfirstlane(tid >> 6), lane = tid & 63, wr = wid >> 2, wc = wid & 3, fr = lane & 15, fq = lane >> 4;
    const int nt = K / 64;
    int Rr[2], Cc[2]; unsigned voffB[2];
#pragma unroll
    for (int i = 0; i < 2; ++i) { stage_rc(tid * 16 + i * 8192, Rr[i], Cc[i]); const int Rb = PERM ? ((Rr[i] & ~31) + perm32(Rr[i] & 31)) : Rr[i]; voffB[i] = (unsigned)(Rb * K + Cc[i]) * 2u; }
    const size_t kstep = 128, hstepB = (size_t)128 * K * 2;
    const unsigned ldsw = (unsigned)wid * 1024u;
    const int aoff = lds_byte(wr * 64 + fr, fq * 8), boff = lds_byte(wc * 32 + fr, fq * 8);
#define PX_SA(b, h) (((b) * 2 + (h)) * HTB)
#define PX_SB(b, h) ((4 + (b) * 2 + (h)) * HTB)
#define PX_STAGE(bufoff, gbase, voff) do { _Pragma("unroll") for (int _i = 0; _i < 2; ++_i) \
        __builtin_amdgcn_global_load_lds((const unsigned*)((const char*)(gbase) + (voff)[_i]), (LAS unsigned*)(lds + (bufoff) + ldsw + _i * 8192), 16, 0, 0); } while (0)
#define PX_LDA(dst, b, h) do { _Pragma("unroll") for (int m = 0; m < 4; ++m) _Pragma("unroll") for (int k = 0; k < 2; ++k) dst[m][k] = *(const LAS bf16x8*)(lds + PX_SA(b, h) + aoff + m * 2048 + k * 1024); } while (0)
#define PX_LDB(dst, b, h) do { _Pragma("unroll") for (int n = 0; n < 2; ++n) _Pragma("unroll") for (int k = 0; k < 2; ++k) dst[n][k] = *(const LAS bf16x8*)(lds + PX_SB(b, h) + boff + n * 2048 + k * 1024); } while (0)
#define PX_MMA(ai, bj, At, Bt) do { __builtin_amdgcn_s_setprio(1); _Pragma("unroll") for (int m = 0; m < 4; ++m) _Pragma("unroll") for (int n = 0; n < 2; ++n) _Pragma("unroll") for (int k = 0; k < 2; ++k) \
        acc[ai][bj][m][n] = SW ? __builtin_amdgcn_mfma_f32_16x16x32_bf16(Bt[n][k], At[m][k], acc[ai][bj][m][n], 0, 0, 0) : __builtin_amdgcn_mfma_f32_16x16x32_bf16(At[m][k], Bt[n][k], acc[ai][bj][m][n], 0, 0, 0); __builtin_amdgcn_s_setprio(0); } while (0)
#define PX_WAIT_L(n) asm volatile("s_waitcnt lgkmcnt(" #n ")" ::: "memory")
#define PX_BAR __builtin_amdgcn_s_barrier()
#define PX_SCHED __builtin_amdgcn_sched_barrier(0)
#define PX_OFFS(dst, un) do { _Pragma("unroll") for (int h_ = 0; h_ < 2; ++h_) _Pragma("unroll") for (int i_ = 0; i_ < 2; ++i_) { \
        const int row_ = h_ * 128 + Rr[i_]; const unsigned rid_ = (un).tok ? (unsigned)(un).tok[row_] : (unsigned)row_; dst[h_][i_] = rid_ * lda + (unsigned)Cc[i_] * 2u; } } while (0)
    Unit cur, nxt; int ui = 0;
    if (!S.next(0, cur)) return;
    f32x4 acc[2][2][4][2];
#pragma unroll
    for (int a = 0; a < 2; ++a)
#pragma unroll
        for (int b = 0; b < 2; ++b)
#pragma unroll
            for (int m = 0; m < 4; ++m)
#pragma unroll
                for (int n = 0; n < 2; ++n) acc[a][b][m][n] = (f32x4){0.f, 0.f, 0.f, 0.f};
    bf16x8 At[4][2], B0[2][2], B1[2][2];
    unsigned oc[2][2], on[2][2];
    PX_OFFS(oc, cur); asm volatile("" : "+v"(oc[0][0]), "+v"(oc[0][1]), "+v"(oc[1][0]), "+v"(oc[1][1]));
    const char* cA = cur.A; const char* cB = cur.B;
    PX_STAGE(PX_SB(0, 0), cB, voffB); PX_STAGE(PX_SA(0, 0), cA, oc[0]); PX_STAGE(PX_SB(0, 1), cB + hstepB, voffB); PX_STAGE(PX_SA(0, 1), cA, oc[1]);
    if (wr == 1) PX_BAR;
    WAIT_V(4); PX_BAR;
    PX_STAGE(PX_SB(1, 0), cB + kstep, voffB); PX_STAGE(PX_SA(1, 0), cA + kstep, oc[0]); PX_STAGE(PX_SB(1, 1), cB + hstepB + kstep, voffB);
    WAIT_V(6); PX_BAR;
    for (;;) {
        const bool has_next = S.next(ui + 1, nxt);
        const char* nA = has_next ? nxt.A : cA; const char* nB = has_next ? nxt.B : cB;
        if (has_next) { PX_OFFS(on, nxt); asm volatile("" : "+v"(on[0][0]), "+v"(on[0][1]), "+v"(on[1][0]), "+v"(on[1][1])); } else {
#pragma unroll
            for (int h_ = 0; h_ < 2; ++h_)
#pragma unroll
                for (int i_ = 0; i_ < 2; ++i_) on[h_][i_] = oc[h_][i_]; }
        for (int t = 0; t < nt; t += 2) {
            const bool last = (t == nt - 2);
            const char* a1 = cA + (size_t)(t + 1) * kstep;
            const char* a2 = last ? nA : cA + (size_t)(t + 2) * kstep; const char* b2 = last ? nB : cB + (size_t)(t + 2) * kstep;
            const char* a3 = a2 + kstep; const char* b3 = b2 + kstep;
            unsigned o2[2][2];
#pragma unroll
            for (int h_ = 0; h_ < 2; ++h_)
#pragma unroll
                for (int i_ = 0; i_ < 2; ++i_) o2[h_][i_] = last ? on[h_][i_] : oc[h_][i_];
            PX_LDB(B0, 0, 0); PX_SCHED; PX_LDA(At, 0, 0); PX_STAGE(PX_SA(1, 1), a1, oc[1]);
            PX_WAIT_L(8); PX_BAR; PX_WAIT_L(0); PX_MMA(0, 0, At, B0); PX_BAR; PX_SCHED;
            PX_LDB(B1, 0, 1); PX_STAGE(PX_SB(0, 0), b2, voffB);
            PX_BAR; PX_WAIT_L(0); PX_MMA(0, 1, At, B1); PX_BAR;
            PX_LDA(At, 0, 1); PX_STAGE(PX_SA(0, 0), a2, o2[0]);
            PX_BAR; PX_WAIT_L(0); PX_MMA(1, 0, At, B0); PX_BAR; PX_SCHED;
            PX_STAGE(PX_SB(0, 1), b2 + hstepB, voffB);
            WAIT_V(6); PX_BAR; PX_MMA(1, 1, At, B1); PX_BAR;
            PX_LDB(B0, 1, 0); PX_SCHED; PX_LDA(At, 1, 0); PX_STAGE(PX_SA(0, 1), a2, o2[1]);
            PX_WAIT_L(8); PX_BAR; PX_WAIT_L(0); PX_MMA(0, 0, At, B0); PX_BAR; PX_SCHED;
            PX_LDB(B1, 1, 1); PX_STAGE(PX_SB(1, 0), b3, voffB);
            PX_BAR; PX_WAIT_L(0); PX_MMA(0, 1, At, B1); PX_BAR;
            PX_LDA(At, 1, 1); PX_STAGE(PX_SA(1, 0), a3, o2[0]);
            PX_BAR; PX_WAIT_L(0); PX_MMA(1, 0, At, B0); PX_BAR; PX_SCHED;
            PX_STAGE(PX_SB(1, 1), b3 + hstepB, voffB);
            WAIT_V(6); PX_BAR; PX_MMA(1, 1, At, B1); PX_BAR;
        }
        E(acc, cur, wr, wc, fr, fq);
        if (!has_next) break;
#pragma unroll
        for (int a = 0; a < 2; ++a)
#pragma unroll
            for (int b = 0; b < 2; ++b)
#pragma unroll
                for (int m = 0; m < 4; ++m)
#pragma unroll
                    for (int n = 0; n < 2; ++n) acc[a][b][m][n] = (f32x4){0.f, 0.f, 0.f, 0.f};
        cur = nxt; cA = nA; cB = nB; ++ui;
#pragma unroll
        for (int h_ = 0; h_ < 2; ++h_)
#pragma unroll
            for (int i_ = 0; i_ < 2; ++i_) oc[h_][i_] = on[h_][i_];
    }
    WAIT_V(0);
    if (wr == 0) PX_BAR;
    PX_BAR;
#undef PX_SA
#undef PX_SB
#undef PX_STAGE
#undef PX_LDA
#undef PX_LDB
#undef PX_MMA
#undef PX_WAIT_L
#undef PX_BAR
#undef PX_SCHED
#undef PX_OFFS
}
__device__ __forceinline__ unsigned cvt_pk_bf16(float lo, float hi) { unsigned r; asm volatile("v_cvt_pk_bf16_f32 %0, %1, %2" : "=v"(r) : "v"(lo), "v"(hi)); return r; }
}

#define EPI_MT(acc) (int)(sizeof(acc) / sizeof(acc[0]))
__device__ __forceinline__ void st_bf4(bf16_t* p, const f32x4& v) { u32x2 w; w.x = pack2(v[0], v[1]); w.y = pack2(v[2], v[3]); *(u32x2*)p = w; }

__device__ __forceinline__ void ph_rkv_lora_sg(const Frame& F) {
    const bf16_t* XS = (const bf16_t*)(F.ws + WS_XS); const bf16_t* WRKV = (const bf16_t*)(F.ws + WS_WRKV); const bf16_t* WLDN = (const bf16_t*)(F.ws + WS_WLDN);
    bf16_t* RKV = (bf16_t*)(F.ws + WS_RKV); bf16_t* LORA = (bf16_t*)(F.ws + WS_LORA);
    for (int u = F.bid; u < 64 * 24; u += F.G) {
        const int mt = u / 24, ct = u % 24, n = ct / 8, col0 = (ct % 8) * 128;
        ASeg A; A.p[0] = XS + ((size_t)n * T + mt * 256) * D; A.p[1] = A.p[0]; A.p[2] = A.p[0]; A.segTiles = 16;
        bf16_t* out = RKV + ((size_t)n * T + mt * 256) * D + col0;
        sg_tile<128>(F.lds, A, [](int R) { return (unsigned)R * (D * 2); }, WRKV + (size_t)(n * D + col0) * D, D, 16,
            [&](auto& acc, int r0, int c0, int fr, int fq) {
#pragma unroll
                for (int m = 0; m < EPI_MT(acc); ++m)
#pragma unroll
                    for (int q = 0; q < 4; ++q) st_bf4(out + (size_t)(r0 + 16 * m + fr) * D + c0 + 16 * q + 4 * fq, acc[m][q]);
            });
    }
    for (int u = F.bid; u < 64 * 4; u += F.G) {
        const int mt = u / 4, j = u % 4, n = (j == 0) ? 3 : (j == 1 ? 4 : 5);
        ASeg A; A.p[0] = XS + ((size_t)n * T + mt * 256) * D; A.p[1] = A.p[0]; A.p[2] = A.p[0]; A.segTiles = 16;
        bf16_t* out = LORA + (size_t)mt * 256 * 256 + j * 64;
        sg_tile<64>(F.lds, A, [](int R) { return (unsigned)R * (D * 2); }, WLDN + (size_t)(j * 64) * D, D, 16,
            [&](auto& acc, int r0, int c0, int fr, int fq) {
#pragma unroll
                for (int m = 0; m < EPI_MT(acc); ++m)
#pragma unroll
                    for (int q = 0; q < 4; ++q) { f32x4 v = acc[m][q];
#pragma unroll
                        for (int e = 0; e < 4; ++e) v[e] = (j == 0) ? tanhf(v[e]) : (j == 1 ? v[e] : sigmoidf_(v[e]));
                        st_bf4(out + (size_t)(r0 + 16 * m + fr) * 256 + c0 + 16 * q + 4 * fq, v); }
            });
    }
}
__device__ __forceinline__ void ph_lora_up_sg(const Frame& F) {
    const bf16_t* LORA = (const bf16_t*)(F.ws + WS_LORA); const bf16_t* WLUP = (const bf16_t*)(F.ws + WS_WLUP);
    float* LD = (float*)(F.ws + WS_LD); bf16_t* AA = (bf16_t*)(F.ws + WS_AA); bf16_t* GG = (bf16_t*)(F.ws + WS_GG);
    for (int u = F.bid; u < 3 * 64 * 8; u += F.G) {
        const int which = u / 512, v = u % 512, mt = v / 8, col0 = (v % 8) * 128;
        const int K = which == 2 ? 128 : 64, koff = which * 64;
        ASeg A; A.p[0] = LORA + (size_t)mt * 256 * 256 + koff; A.p[1] = A.p[0]; A.p[2] = A.p[0]; A.segTiles = 4;
        const bf16_t* Bt = WLUP + (which == 0 ? 0 : (which == 1 ? 1024 * 64 : 2 * 1024 * 64)) + (size_t)col0 * K;
        const size_t obase = (size_t)mt * 256 * D + col0;
        sg_tile<128>(F.lds, A, [](int R) { return (unsigned)R * 512u; }, Bt, K, K / 64,
            [&](auto& acc, int r0, int c0, int fr, int fq) {
#pragma unroll
                for (int m = 0; m < EPI_MT(acc); ++m)
#pragma unroll
                    for (int q = 0; q < 4; ++q) {
                        const int c = c0 + 16 * q + 4 * fq; const size_t o = obase + (size_t)(r0 + 16 * m + fr) * D + c;
                        if (which == 0) { const f32x4 w0 = *(const f32x4*)(F.in[I_W0] + col0 + c); f32x4 r;
#pragma unroll
                            for (int e = 0; e < 4; ++e) { const float wl = w0[e] + acc[m][q][e]; r[e] = -__expf(-softplusf_(-wl) - 0.5f); }
                            *(f32x4*)(LD + o) = r; }
                        else if (which == 1) { const f32x4 a0 = *(const f32x4*)(F.in[I_A0] + col0 + c); f32x4 r;
#pragma unroll
                            for (int e = 0; e < 4; ++e) r[e] = sigmoidf_(a0[e] + acc[m][q][e]);
                            st_bf4(AA + o, r); }
                        else st_bf4(GG + o, acc[m][q]);
                    }
            });
    }
}
template <int OUTMODE>
__device__ __forceinline__ void ph_dense_sg(const Frame& F, const bf16_t* Ain, const bf16_t* Wt, int N, void* outp) {
    const int nct = N / 128;
    for (int u = F.bid; u < 64 * nct; u += F.G) {
        const int mt = u / nct, col0 = (u % nct) * 128;
        ASeg A; A.p[0] = Ain + (size_t)mt * 256 * D; A.p[1] = A.p[0]; A.p[2] = A.p[0]; A.segTiles = 16;
        sg_tile<128>(F.lds, A, [](int R) { return (unsigned)R * (D * 2); }, Wt + (size_t)col0 * D, D, 16,
            [&](auto& acc, int r0, int c0, int fr, int fq) {
#pragma unroll
                for (int m = 0; m < EPI_MT(acc); ++m)
#pragma unroll
                    for (int q = 0; q < 4; ++q) {
                        const int r = mt * 256 + r0 + 16 * m + fr, c = col0 + c0 + 16 * q + 4 * fq;
                        if (OUTMODE == 0) *(f32x4*)((float*)outp + (size_t)r * N + c) = acc[m][q];
                        else st_bf4((bf16_t*)outp + (size_t)(c / D) * T * D + (size_t)r * D + (c % D), acc[m][q]);
                    }
            });
    }
}
__device__ __forceinline__ void ph_router_sg(const Frame& F, int layer) {
    const bf16_t* H2 = (const bf16_t*)(F.ws + WS_H2); const bf16_t* H2LO = (const bf16_t*)(F.ws + WS_H2LO);
    const bf16_t* WRT = (const bf16_t*)(F.ws + WS_WRT) + (size_t)layer * 64 * 3072; float* LOG = (float*)(F.ws + WS_LOGITS);
    for (int mt = F.bid; mt < 64; mt += F.G) {
        ASeg A; A.p[0] = H2 + (size_t)mt * 256 * D; A.p[1] = A.p[0]; A.p[2] = H2LO + (size_t)mt * 256 * D; A.segTiles = 16;
        sg_tile<64>(F.lds, A, [](int R) { return (unsigned)R * (D * 2); }, WRT, 3072, 48,
            [&](auto& acc, int r0, int c0, int fr, int fq) {
#pragma unroll
                for (int m = 0; m < EPI_MT(acc); ++m)
#pragma unroll
                    for (int q = 0; q < 4; ++q) *(f32x4*)(LOG + (size_t)(mt * 256 + r0 + 16 * m + fr) * NE + c0 + 16 * q + 4 * fq) = acc[m][q];
            });
    }
}
__device__ __forceinline__ void ph_gateup_sg(const Frame& F) {
    const bf16_t* H2 = (const bf16_t*)(F.ws + WS_H2); bf16_t* HB = (bf16_t*)(F.ws + WS_HB); const bf16_t* WGU = (const bf16_t*)(F.ws + WS_WGU);
    const int* TOK = (const int*)(F.ws + WS_TOK); const int* TILEE = (const int*)(F.ws + WS_TILEE); const int* START = (const int*)(F.ws + WS_START);
    const int routed = START[65], nmt = (routed + T) / 256;
    for (int u = F.bid; u < nmt * 4; u += F.G) {
        const int mt = u / 4, nt4 = u % 4, row0 = mt * 256; const bool sh = row0 >= routed; const int e = sh ? 64 : TILEE[mt];
        ASeg A; A.p[0] = H2; A.p[1] = H2; A.p[2] = H2; A.segTiles = 16;
        bf16_t* out = HB + (size_t)row0 * DE + nt4 * 64;
        sg_tile<128>(F.lds, A, [&](int R) { const int tok = sh ? (row0 - routed + R) : TOK[row0 + R]; return (unsigned)tok * (D * 2); },
            WGU + (size_t)e * 512 * D, D, 16,
            [&](auto& acc, int r0, int c0, int fr, int fq) {
#pragma unroll
                for (int m = 0; m < EPI_MT(acc); ++m)
#pragma unroll
                    for (int q = 0; q < 2; ++q) { f32x4 v;
#pragma unroll
                        for (int e2 = 0; e2 < 4; ++e2) { const float g = acc[m][q][e2]; v[e2] = g * sigmoidf_(g) * acc[m][q + 2][e2]; }
                        st_bf4(out + (size_t)(r0 + 16 * m + fr) * DE + (c0 >> 1) + 16 * q + 4 * fq, v); }
            },
            [=](int R) { const int col = nt4 * 64 + (R >> 6) * 32 + (R & 31), up = (R >> 5) & 1; return (col >> 7) * 256 + up * 128 + (col & 127); });
    }
}
__device__ __forceinline__ void ph_down_sg(const Frame& F) {
    const bf16_t* HB = (const bf16_t*)(F.ws + WS_HB); bf16_t* YB = (bf16_t*)(F.ws + WS_YB); const bf16_t* WDN = (const bf16_t*)(F.ws + WS_WDN);
    const int* TILEE = (const int*)(F.ws + WS_TILEE); const int* START = (const int*)(F.ws + WS_START);
    const int routed = START[65], nmt = (routed + T) / 256;
    for (int u = F.bid; u < nmt * 8; u += F.G) {
        const int mt = u / 8, col0 = (u % 8) * 128, row0 = mt * 256; const bool sh = row0 >= routed; const int e = sh ? 64 : TILEE[mt];
        ASeg A; A.p[0] = HB + (size_t)row0 * DE; A.p[1] = A.p[0]; A.p[2] = A.p[0]; A.segTiles = 4;
        bf16_t* out = YB + (size_t)row0 * D + col0;
        sg_tile<128>(F.lds, A, [](int R) { return (unsigned)R * (DE * 2); }, WDN + ((size_t)e * D + col0) * DE, DE, 4,
            [&](auto& acc, int r0, int c0, int fr, int fq) {
#pragma unroll
                for (int m = 0; m < EPI_MT(acc); ++m)
#pragma unroll
                    for (int q = 0; q < 4; ++q) st_bf4(out + (size_t)(r0 + 16 * m + fr) * D + c0 + 16 * q + 4 * fq, acc[m][q]);
            });
    }
}

constexpr int MS = 72;
constexpr int SLOT = 64 * MS * 2;
constexpr size_t WS_BONUS = 3 * MiB;
constexpr size_t WS_RP = WS_BIG + 128 * MiB;
constexpr size_t WS_OL = WS_BIG + 160 * MiB;
constexpr size_t WS_G2 = WS_BIG + 296 * MiB;
constexpr size_t WS_DM = WS_BIG + 328 * MiB;
constexpr size_t WS_ST = WS_BIG + 360 * MiB;

__device__ __forceinline__ bf16x8 ldfrag(const LAS bf16_t* M, int row, int kofs) { return *(const LAS bf16x8*)(M + row * MS + kofs); }
template <bool SW>
__device__ __forceinline__ void mm64(f32x4& acc, const LAS bf16_t* X, int xr0, const LAS bf16_t* Y, int yr0, int fr, int fq) {
#pragma unroll
    for (int ks = 0; ks < 2; ++ks) {
        const bf16x8 xf = ldfrag(X, xr0 + fr, ks * 32 + fq * 8), yf = ldfrag(Y, yr0 + fr, ks * 32 + fq * 8);
        acc = SW ? __builtin_amdgcn_mfma_f32_16x16x32_bf16(yf, xf, acc, 0, 0, 0) : __builtin_amdgcn_mfma_f32_16x16x32_bf16(xf, yf, acc, 0, 0, 0);
    }
}
__device__ __forceinline__ void st4_lds(LAS bf16_t* p, const f32x4& v) { u32x2 w; w.x = pack2(v[0], v[1]); w.y = pack2(v[2], v[3]); *(LAS u32x2*)p = w; }
__device__ __forceinline__ f32x4 ld4_lds(const LAS bf16_t* p) { const u32x2 w = *(const LAS u32x2*)p; return (f32x4){lo2f(w.x), hi2f(w.x), lo2f(w.y), hi2f(w.y)}; }
__device__ __forceinline__ f32x4 ld4_g(const bf16_t* p) { const u32x2 w = *(const u32x2*)p; return (f32x4){lo2f(w.x), hi2f(w.x), lo2f(w.y), hi2f(w.y)}; }

__device__ __forceinline__ void ph_wkv_chunk(const Frame& F) {
    const bf16_t* RKV = (const bf16_t*)(F.ws + WS_RKV); const float* LD = (const float*)(F.ws + WS_LD); const bf16_t* AA = (const bf16_t*)(F.ws + WS_AA);
    const bf16_t* Rb = RKV; const bf16_t* Kb = RKV + (size_t)T * D; const bf16_t* Vb = RKV + (size_t)2 * T * D;
    bf16_t* RP = (bf16_t*)(F.ws + WS_RP); bf16_t* OL = (bf16_t*)(F.ws + WS_OL); bf16_t* G2 = (bf16_t*)(F.ws + WS_G2); bf16_t* DM = (bf16_t*)(F.ws + WS_DM);
    float* BONUS = (float*)(F.ws + WS_BONUS);
#define SL(k) ((LAS bf16_t*)(F.lds + (k) * SLOT))
    LAS float* segtot = (LAS float*)(F.lds + 15 * SLOT);
    LAS float* WCs = segtot + 512;
    const int w = F.wave, lane = F.lane, fr = lane & 15, fq = lane >> 4, mt = w >> 1, ntb = 2 * (w & 1);
    for (int cid = F.bid; cid < NB * NH * (SEQ / 64); cid += F.G) {
        const int bh = cid / (SEQ / 64), c = cid % (SEQ / 64), b = bh / NH, h = bh % NH;
        const size_t tok0 = (size_t)b * SEQ + (size_t)c * 64;
        {
            const int j = lane, ch = h * 64 + j;
            const float kkw = F.in[I_KK][ch], kaw = F.in[I_KA][ch], rkw = F.in[I_RK][ch];
            float r[8], k[8], v[8], a[8], ld[8];
#pragma unroll
            for (int e = 0; e < 8; ++e) { const size_t o = (tok0 + 8 * w + e) * D + ch; r[e] = bf2f(Rb[o]); k[e] = bf2f(Kb[o]); v[e] = bf2f(Vb[o]); a[e] = bf2f(AA[o]); ld[e] = LD[o]; }
            float cum[8]; float run = 0.f;
#pragma unroll
            for (int e = 0; e < 8; ++e) { run += ld[e]; cum[e] = run; }
            segtot[w * 64 + j] = run;
            __syncthreads();
            float pre = 0.f, tot = 0.f;
#pragma unroll
            for (int ww = 0; ww < 8; ++ww) { const float sgt = segtot[ww * 64 + j]; tot += sgt; if (ww < w) pre += sgt; }
            if (w == 0) WCs[j] = __expf(tot);
            float av[8], bv[8], kv[8], rv[8];
#pragma unroll
            for (int e = 0; e < 8; ++e) {
                const float cm = pre + cum[e];
                const float kkr = k[e] * kkw; const float ss = wave_sum(kkr * kkr);
                const float kk = kkr / fmaxf(sqrtf(ss), 1e-12f);
                const float kf = k[e] * (1.0f + (a[e] - 1.0f) * kaw);
                const float bon = wave_sum(r[e] * kf * rkw);
                if (lane == 0) BONUS[(tok0 + 8 * w + e) * NH + h] = bon;
                const float en = __expf(-cm);
                av[e] = -kk * __expf(cm - ld[e]); bv[e] = kk * a[e] * en; kv[e] = kf * en; rv[e] = r[e] * __expf(cm);
                const int t = 8 * w + e;
                SL(0)[t * MS + j] = f2bf(av[e]); SL(2)[t * MS + j] = f2bf(rv[e]); SL(3)[t * MS + j] = f2bf(bv[e]); SL(5)[t * MS + j] = f2bf(kv[e]);
            }
            u32x4 pa, pb, pk, pv;
#pragma unroll
            for (int q = 0; q < 4; ++q) { pa[q] = pack2(av[2 * q], av[2 * q + 1]); pb[q] = pack2(bv[2 * q], bv[2 * q + 1]); pk[q] = pack2(kv[2 * q], kv[2 * q + 1]); pv[q] = pack2(v[2 * q], v[2 * q + 1]); }
            *(LAS u32x4*)(SL(1) + j * MS + 8 * w) = pa; *(LAS u32x4*)(SL(4) + j * MS + 8 * w) = pb; *(LAS u32x4*)(SL(6) + j * MS + 8 * w) = pk; *(LAS u32x4*)(SL(7) + j * MS + 8 * w) = pv;
        }
        __syncthreads();
#pragma unroll
        for (int q2 = 0; q2 < 2; ++q2) {
            const int nt = ntb + q2;
            { f32x4 acc = {0.f, 0.f, 0.f, 0.f}; mm64<false>(acc, SL(0), 16 * mt, SL(3), 16 * nt, fr, fq);
              const int sidx = 16 * nt + fr, t0 = 16 * mt + 4 * fq;
#pragma unroll
              for (int e = 0; e < 4; ++e) { if (!(sidx < t0 + e)) acc[e] = 0.f; SL(8)[(t0 + e) * MS + sidx] = f2bf(acc[e]); }
              st4_lds(SL(9) + sidx * MS + t0, acc); }
            const int tt = 16 * mt + fr, s0 = 16 * nt + 4 * fq;
            { f32x4 acc = {0.f, 0.f, 0.f, 0.f}; mm64<true>(acc, SL(0), 16 * mt, SL(5), 16 * nt, fr, fq);
#pragma unroll
              for (int e = 0; e < 4; ++e) if (!(s0 + e < tt)) acc[e] = 0.f;
              st4_lds(SL(10) + tt * MS + s0, acc); }
            { f32x4 acc = {0.f, 0.f, 0.f, 0.f}; mm64<true>(acc, SL(2), 16 * mt, SL(3), 16 * nt, fr, fq);
#pragma unroll
              for (int e = 0; e < 4; ++e) if (!(s0 + e <= tt)) acc[e] = 0.f;
              st4_lds(SL(11) + tt * MS + s0, acc); }
            { f32x4 acc = {0.f, 0.f, 0.f, 0.f}; mm64<true>(acc, SL(2), 16 * mt, SL(5), 16 * nt, fr, fq);
#pragma unroll
              for (int e = 0; e < 4; ++e) if (!(s0 + e <= tt)) acc[e] = 0.f;
              st4_lds(SL(12) + tt * MS + s0, acc); }
        }
        __syncthreads();
#define WKV_SQ(xi, ti, xo, to) do { _Pragma("unroll") for (int q2 = 0; q2 < 2; ++q2) { const int nt = ntb + q2; f32x4 acc = {0.f, 0.f, 0.f, 0.f}; \
            mm64<false>(acc, SL(xi), 16 * mt, SL(ti), 16 * nt, fr, fq); const int n_ = 16 * nt + fr, m0_ = 16 * mt + 4 * fq; \
            _Pragma("unroll") for (int e = 0; e < 4; ++e) SL(xo)[(m0_ + e) * MS + n_] = f2bf(acc[e]); st4_lds(SL(to) + n_ * MS + m0_, acc); } } while (0)
#define WKV_PM(pi, ti, po) do { _Pragma("unroll") for (int q2 = 0; q2 < 2; ++q2) { const int nt = ntb + q2; const int m_ = 16 * mt + fr, n0_ = 16 * nt + 4 * fq; \
            f32x4 acc = ld4_lds(SL(pi) + m_ * MS + n0_); mm64<true>(acc, SL(pi), 16 * mt, SL(ti), 16 * nt, fr, fq); st4_lds(SL(po) + m_ * MS + n0_, acc); } } while (0)
        WKV_SQ(8, 9, 0, 3);
        for (int idx = F.tid; idx < 64 * 64; idx += NTHREADS) { const int t = idx >> 6, s2 = idx & 63; SL(13)[t * MS + s2] = (t == s2) ? (bf16_t)0x3F80 : SL(8)[t * MS + s2]; }
        __syncthreads();
        WKV_PM(13, 3, 14); WKV_SQ(0, 3, 8, 9); __syncthreads();
        WKV_PM(14, 9, 13); WKV_SQ(8, 9, 0, 3); __syncthreads();
        WKV_PM(13, 3, 14); WKV_SQ(0, 3, 8, 9); __syncthreads();
        WKV_PM(14, 9, 13); WKV_SQ(8, 9, 0, 3); __syncthreads();
        WKV_PM(13, 3, 14); __syncthreads();
#pragma unroll
        for (int q2 = 0; q2 < 2; ++q2) {
            const int nt = ntb + q2, n_ = 16 * nt + fr, m0_ = 16 * mt + 4 * fq;
            { f32x4 acc = {0.f, 0.f, 0.f, 0.f}; mm64<false>(acc, SL(14), 16 * mt, SL(1), 16 * nt, fr, fq); st4_lds(SL(9) + n_ * MS + m0_, acc); }
            { f32x4 acc = {0.f, 0.f, 0.f, 0.f}; mm64<false>(acc, SL(10), 16 * mt, SL(7), 16 * nt, fr, fq); st4_lds(SL(8) + n_ * MS + m0_, acc); }
        }
        __syncthreads();
#pragma unroll
        for (int q2 = 0; q2 < 2; ++q2) {
            const int nt = ntb + q2;
            { const int n_ = 16 * nt + fr, m0_ = 16 * mt + 4 * fq; f32x4 acc = {0.f, 0.f, 0.f, 0.f}; mm64<false>(acc, SL(14), 16 * mt, SL(8), 16 * nt, fr, fq); st4_lds(SL(0) + n_ * MS + m0_, acc); }
            { const int m_ = 16 * mt + fr, n0_ = 16 * nt + 4 * fq; f32x4 acc = ld4_lds(SL(2) + m_ * MS + n0_); mm64<true>(acc, SL(11), 16 * mt, SL(9), 16 * nt, fr, fq);
              st_bf4(RP + (size_t)cid * 4096 + m_ * 64 + n0_, acc); }
        }
        __syncthreads();
#pragma unroll
        for (int q2 = 0; q2 < 2; ++q2) {
            const int nt = ntb + q2;
            { const int m_ = 16 * mt + fr, n0_ = 16 * nt + 4 * fq; f32x4 acc = {0.f, 0.f, 0.f, 0.f};
              mm64<true>(acc, SL(11), 16 * mt, SL(0), 16 * nt, fr, fq); mm64<true>(acc, SL(12), 16 * mt, SL(7), 16 * nt, fr, fq);
              st_bf4(OL + (size_t)cid * 4096 + m_ * 64 + n0_, acc); }
            { const int jp = 16 * nt + fr, j0 = 16 * mt + 4 * fq; f32x4 acc = {0.f, 0.f, 0.f, 0.f}; mm64<false>(acc, SL(9), 16 * mt, SL(4), 16 * nt, fr, fq);
              const float wc = WCs[jp];
#pragma unroll
              for (int e = 0; e < 4; ++e) acc[e] = (acc[e] + ((j0 + e == jp) ? 1.0f : 0.0f)) * wc;
              st_bf4(G2 + (size_t)cid * 4096 + (nt * 2 + (mt >> 1)) * 512 + lane * 8 + (mt & 1) * 4, acc); }
            { const int i_ = 16 * mt + fr, jp0 = 16 * nt + 4 * fq; f32x4 acc = {0.f, 0.f, 0.f, 0.f};
              mm64<true>(acc, SL(0), 16 * mt, SL(4), 16 * nt, fr, fq); mm64<true>(acc, SL(7), 16 * mt, SL(6), 16 * nt, fr, fq);
#pragma unroll
              for (int e = 0; e < 4; ++e) acc[e] *= WCs[jp0 + e];
              st_bf4(DM + (size_t)cid * 4096 + i_ * 64 + jp0, acc); }
        }
        __syncthreads();
    }
#undef WKV_SQ
#undef WKV_PM
#undef SL
}

__device__ __forceinline__ void ph_wkv_carry(const Frame& F) {
    const bf16_t* G2 = (const bf16_t*)(F.ws + WS_G2); const bf16_t* DM = (const bf16_t*)(F.ws + WS_DM); bf16_t* ST = (bf16_t*)(F.ws + WS_ST);
    if (F.wave >= 4) return;
    const int lane = F.lane, fr = lane & 15, fq = lane >> 4, i = 16 * F.wave + fr;
    for (int ch = F.bid; ch < NB * NH; ch += F.G) {
        f32x4 st[4];
#pragma unroll
        for (int r = 0; r < 4; ++r) st[r] = (f32x4){0.f, 0.f, 0.f, 0.f};
        const size_t cbase = (size_t)ch * (SEQ / 64);
        bf16x8 gf[8]; f32x4 dm[4];
#pragma unroll
        for (int f = 0; f < 8; ++f) gf[f] = *(const bf16x8*)(G2 + cbase * 4096 + f * 512 + lane * 8);
#pragma unroll
        for (int r = 0; r < 4; ++r) dm[r] = ld4_g(DM + cbase * 4096 + i * 64 + 16 * r + 4 * fq);
        for (int c = 0; c < SEQ / 64; ++c) {
            const size_t cid = cbase + c;
            bf16x8 gc[8]; f32x4 acc[4];
#pragma unroll
            for (int f = 0; f < 8; ++f) gc[f] = gf[f];
#pragma unroll
            for (int r = 0; r < 4; ++r) acc[r] = dm[r];
            if (c + 1 < SEQ / 64) {
#pragma unroll
                for (int f = 0; f < 8; ++f) gf[f] = *(const bf16x8*)(G2 + (cid + 1) * 4096 + f * 512 + lane * 8);
#pragma unroll
                for (int r = 0; r < 4; ++r) dm[r] = ld4_g(DM + (cid + 1) * 4096 + i * 64 + 16 * r + 4 * fq);
            }
            union { bf16x8 v; unsigned u[4]; } b0, b1;
#pragma unroll
            for (int r = 0; r < 4; ++r) st_bf4(ST + cid * 4096 + i * 64 + 16 * r + 4 * fq, st[r]);
            b0.u[0] = pack2(st[0][0], st[0][1]); b0.u[1] = pack2(st[0][2], st[0][3]); b0.u[2] = pack2(st[1][0], st[1][1]); b0.u[3] = pack2(st[1][2], st[1][3]);
            b1.u[0] = pack2(st[2][0], st[2][1]); b1.u[1] = pack2(st[2][2], st[2][3]); b1.u[2] = pack2(st[3][0], st[3][1]); b1.u[3] = pack2(st[3][2], st[3][3]);
#pragma unroll
            for (int r = 0; r < 4; ++r) {
                acc[r] = __builtin_amdgcn_mfma_f32_16x16x32_bf16(gc[r * 2 + 0], b0.v, acc[r], 0, 0, 0);
                acc[r] = __builtin_amdgcn_mfma_f32_16x16x32_bf16(gc[r * 2 + 1], b1.v, acc[r], 0, 0, 0);
            }
#pragma unroll
            for (int r = 0; r < 4; ++r) st[r] = acc[r];
        }
    }
}

__device__ __forceinline__ void ph_wkv_out(const Frame& F) {
    const bf16_t* RP = (const bf16_t*)(F.ws + WS_RP); const bf16_t* OL = (const bf16_t*)(F.ws + WS_OL); const bf16_t* ST = (const bf16_t*)(F.ws + WS_ST);
    const bf16_t* Vb = (const bf16_t*)(F.ws + WS_RKV) + (size_t)2 * T * D; const bf16_t* GG = (const bf16_t*)(F.ws + WS_GG); const float* BONUS = (const float*)(F.ws + WS_BONUS);
    bf16_t* OG = (bf16_t*)(F.ws + WS_OG);
    const int lane = F.lane, fr = lane & 15, fq = lane >> 4;
    const int nunits = NB * NH * (SEQ / 64) * 4;
    for (int u = F.bid * NWAVES + F.wave; u < nunits; u += F.G * NWAVES) {
        const int cid = u >> 2, tt = u & 3, bh = cid / (SEQ / 64), c = cid % (SEQ / 64), b = bh / NH, h = bh % NH;
        const int t = 16 * tt + fr; const size_t tok = (size_t)b * SEQ + (size_t)c * 64 + t;
        bf16x8 rf[2];
#pragma unroll
        for (int ks = 0; ks < 2; ++ks) rf[ks] = *(const bf16x8*)(RP + (size_t)cid * 4096 + t * 64 + ks * 32 + fq * 8);
        f32x4 acc[4];
#pragma unroll
        for (int n = 0; n < 4; ++n) {
            acc[n] = ld4_g(OL + (size_t)cid * 4096 + t * 64 + 16 * n + 4 * fq);
#pragma unroll
            for (int ks = 0; ks < 2; ++ks) { const bf16x8 sf = *(const bf16x8*)(ST + (size_t)cid * 4096 + (16 * n + fr) * 64 + ks * 32 + fq * 8);
                acc[n] = __builtin_amdgcn_mfma_f32_16x16x32_bf16(sf, rf[ks], acc[n], 0, 0, 0); }
        }
        float s = 0.f;
#pragma unroll
        for (int n = 0; n < 4; ++n) s += (acc[n][0] + acc[n][1]) + (acc[n][2] + acc[n][3]);
        s += __shfl_xor(s, 16); s += __shfl_xor(s, 32);
        const float mean = s * (1.0f / 64.0f);
        float q = 0.f;
#pragma unroll
        for (int n = 0; n < 4; ++n)
#pragma unroll
            for (int e = 0; e < 4; ++e) { const float d = acc[n][e] - mean; q += d * d; }
        q += __shfl_xor(q, 16); q += __shfl_xor(q, 32);
        const float rstd = rsqrtf(q * (1.0f / 64.0f) + 64e-5f), bon = BONUS[tok * NH + h];
#pragma unroll
        for (int n = 0; n < 4; ++n) {
            const int chn = h * 64 + 16 * n + 4 * fq; const size_t o = tok * D + chn;
            const f32x4 lg = *(const f32x4*)(F.in[I_LNG] + chn), lb = *(const f32x4*)(F.in[I_LNB] + chn), vv = ld4_g(Vb + o), gg = ld4_g(GG + o);
            const f32x4 res = (((acc[n] - mean) * rstd) * lg + lb + vv * bon) * gg;
            st_bf4(OG + o, res);
        }
    }
}

__device__ __forceinline__ void ph_qkv_sg(const Frame& F) {
    const bf16_t* Ain = (const bf16_t*)(F.ws + WS_H3); const bf16_t* Wt = (const bf16_t*)(F.ws + WS_WQKV);
    bf16_t* QK = (bf16_t*)(F.ws + WS_Q); bf16_t* VT = QK + (size_t)2 * T * D;
    for (int u = F.bid; u < 64 * 24; u += F.G) {
        const int mt = u / 24, ct = u % 24, col0 = ct * 128;
        ASeg A; A.p[0] = Ain + (size_t)mt * 256 * D; A.p[1] = A.p[0]; A.p[2] = A.p[0]; A.segTiles = 16;
        if (ct < 16) {
            sg_tile<128>(F.lds, A, [](int R) { return (unsigned)R * (D * 2); }, Wt + (size_t)col0 * D, D, 16,
                [&](auto& acc, int r0, int c0, int fr, int fq) {
#pragma unroll
                    for (int m = 0; m < EPI_MT(acc); ++m)
#pragma unroll
                        for (int q = 0; q < 4; ++q) { const int r = mt * 256 + r0 + 16 * m + fr, c = col0 + c0 + 16 * q + 4 * fq;
                            st_bf4(QK + (size_t)(c / D) * T * D + (size_t)r * D + (c % D), acc[m][q]); }
                });
        } else {
            sg_tile<128, true>(F.lds, A, [](int R) { return (unsigned)R * (D * 2); }, Wt + (size_t)col0 * D, D, 16,
                [&](auto& acc, int r0, int c0, int fr, int fq) {
#pragma unroll
                    for (int m = 0; m < EPI_MT(acc); ++m)
#pragma unroll
                        for (int q = 0; q < 4; ++q) { const int t = mt * 256 + r0 + 16 * m + 4 * fq, c = col0 - 2 * D + c0 + 16 * q + fr;
                            const int b = t / SEQ, sidx = t % SEQ, h = c >> 6, d = c & 63;
                            st_bf4(VT + ((size_t)((b * NH + h) * 64 + d)) * SEQ + sidx, acc[m][q]); }
                });
        }
    }
}
__device__ __forceinline__ void ph_attn(const Frame& F) {
    const bf16_t* Q = (const bf16_t*)(F.ws + WS_Q); const bf16_t* Kb = Q + (size_t)T * D; const bf16_t* VT = Q + (size_t)2 * T * D;
    bf16_t* AO = (bf16_t*)(F.ws + WS_AO);
    const int lane = F.lane, fr = lane & 15, fq = lane >> 4;
    const int nunits = NB * NH * (SEQ / 16);
    for (int u = F.bid * NWAVES + F.wave; u < nunits; u += F.G * NWAVES) {
        const int bh = u / (SEQ / 16), qt = u % (SEQ / 16), b = bh / NH, h = bh % NH;
        const int q0 = qt * 16, qpos = q0 + fr;
        const size_t tb = (size_t)b * SEQ;
        bf16x8 qf[2];
#pragma unroll
        for (int ks = 0; ks < 2; ++ks) qf[ks] = *(const bf16x8*)(Q + (tb + qpos) * D + h * 64 + ks * 32 + fq * 8);
        f32x4 o[4];
#pragma unroll
        for (int dt = 0; dt < 4; ++dt) o[dt] = (f32x4){0.f, 0.f, 0.f, 0.f};
        float R = 0.f;
        const bf16_t* vt = VT + (size_t)bh * 64 * SEQ;
        for (int kt0 = (q0 + 15) / 64; kt0 >= 0; --kt0) {
            const int key0 = kt0 * 64;
            f32x4 z[4];
#pragma unroll
            for (int kt = 0; kt < 4; ++kt) {
                z[kt] = (f32x4){0.f, 0.f, 0.f, 0.f};
#pragma unroll
                for (int ks = 0; ks < 2; ++ks) { const bf16x8 kf = *(const bf16x8*)(Kb + (tb + key0 + 16 * kt + fr) * D + h * 64 + ks * 32 + fq * 8);
                    z[kt] = __builtin_amdgcn_mfma_f32_16x16x32_bf16(kf, qf[ks], z[kt], 0, 0, 0); }
            }
            float sp[4][4], G[4];
#pragma unroll
            for (int kt = 0; kt < 4; ++kt) { G[kt] = 0.f;
#pragma unroll
                for (int e = 0; e < 4; ++e) { const float zz = z[kt][e] * 0.125f; z[kt][e] = zz; const bool valid = (key0 + 16 * kt + 4 * fq + e) < qpos;
                    const float spv = valid ? (zz > 15.f ? zz : __logf(1.0f + __expf(zz))) : 0.f; sp[kt][e] = spv; G[kt] += spv; } }
            float sufg[4], tot[4];
#pragma unroll
            for (int kt = 0; kt < 4; ++kt) {
                const float g1 = __shfl_xor(G[kt], 16), g2 = __shfl_xor(G[kt], 32), g3 = __shfl_xor(G[kt], 48);
                tot[kt] = G[kt] + g1 + g2 + g3;
                sufg[kt] = (((fq ^ 1) > fq) ? g1 : 0.f) + (((fq ^ 2) > fq) ? g2 : 0.f) + (((fq ^ 3) > fq) ? g3 : 0.f);
            }
            float later = 0.f;
            unsigned pk[4][2];
#pragma unroll
            for (int kt = 3; kt >= 0; --kt) {
                float run = R + later + sufg[kt];
                float wv[4];
#pragma unroll
                for (int e = 3; e >= 0; --e) { const bool valid = (key0 + 16 * kt + 4 * fq + e) < qpos;
                    wv[e] = valid ? __expf(z[kt][e] - sp[kt][e] - run) : 0.f; run += sp[kt][e]; }
                pk[kt][0] = pack2(wv[0], wv[1]); pk[kt][1] = pack2(wv[2], wv[3]);
                later += tot[kt];
            }
            R += later;
            union { bf16x8 v; unsigned w[4]; } p0, p1;
            p0.w[0] = pk[0][0]; p0.w[1] = pk[0][1]; p0.w[2] = pk[1][0]; p0.w[3] = pk[1][1];
            p1.w[0] = pk[2][0]; p1.w[1] = pk[2][1]; p1.w[2] = pk[3][0]; p1.w[3] = pk[3][1];
#pragma unroll
            for (int dt = 0; dt < 4; ++dt) {
                const bf16_t* vr = vt + (size_t)(16 * dt + fr) * SEQ + key0 + 4 * fq;
                union { bf16x8 v; u32x2 h[2]; } v0, v1;
                v0.h[0] = *(const u32x2*)(vr); v0.h[1] = *(const u32x2*)(vr + 16); v1.h[0] = *(const u32x2*)(vr + 32); v1.h[1] = *(const u32x2*)(vr + 48);
                o[dt] = __builtin_amdgcn_mfma_f32_16x16x32_bf16(v0.v, p0.v, o[dt], 0, 0, 0);
                o[dt] = __builtin_amdgcn_mfma_f32_16x16x32_bf16(v1.v, p1.v, o[dt], 0, 0, 0);
            }
            if (__all(R > SB_EXIT)) break;
        }
#pragma unroll
        for (int dt = 0; dt < 4; ++dt) st_bf4(AO + (tb + qpos) * D + h * 64 + 16 * dt + 4 * fq, o[dt]);
    }
}

#ifndef USE_PGX
#define USE_PGX 0x1f
#endif
__device__ __forceinline__ int px_unit_index(int i, int G, int c, int nwg) {
    const long L = (long)i * G + c; if (L >= nwg) return -1;
    const int w = (int)L, q = nwg / 8, r = nwg % 8, xcd = w % 8, off = w / 8;
    return (xcd < r ? xcd * (q + 1) : r * (q + 1) + (xcd - r) * q) + off;
}
struct PxDense {
    const char* A; const char* B; int nM, nN, K, G, c; unsigned lda; int a_div; size_t a_stride;
    __device__ __forceinline__ bool next(int i, pgx::Unit& u) const {
        const int w = px_unit_index(i, G, c, nM * nN); if (w < 0) return false;
        const int pm = w / nN, pn = w % nN;
        u.A = A + (size_t)(pn / a_div) * a_stride + (size_t)pm * 256 * lda; u.tok = nullptr; u.B = B + (size_t)pn * 256 * K * 2; u.r0 = pm * 256; u.c0 = pn * 256; u.aux = 0; return true;
    }
};
__device__ __forceinline__ void px_store_bf16_perm(bf16_t* rowp, const f32x4& v0, const f32x4& v1) {
    u32x4 w; w.x = pgx::cvt_pk_bf16(v0[0], v0[1]); w.y = pgx::cvt_pk_bf16(v0[2], v0[3]); w.z = pgx::cvt_pk_bf16(v1[0], v1[1]); w.w = pgx::cvt_pk_bf16(v1[2], v1[3]); *(u32x4*)rowp = w;
}
__device__ __forceinline__ void ph_rkv_px(const Frame& F) {
    bf16_t* RKV = (bf16_t*)(F.ws + WS_RKV);
    PxDense S{(const char*)(F.ws + WS_XS), (const char*)(F.ws + WS_WRKV), 64, 12, D, F.G, F.bid, (unsigned)(D * 2), 4, (size_t)T * D * 2};
    pgx::gemm_phase<true, true>(F.lds, D, D * 2, S, [&](const f32x4 (&acc)[2][2][4][2], const pgx::Unit& u, int wr, int wc, int fr, int fq) {
        bf16_t* base = RKV + (size_t)(u.c0 / D) * T * D + (u.c0 % D) + wc * 32 + 8 * fq;
#pragma unroll
        for (int ai = 0; ai < 2; ++ai)
#pragma unroll
            for (int m = 0; m < 4; ++m) { bf16_t* rowp = base + (size_t)(u.r0 + ai * 128 + wr * 64 + m * 16 + fr) * D;
#pragma unroll
                for (int bj = 0; bj < 2; ++bj) px_store_bf16_perm(rowp + bj * 128, acc[ai][bj][m][0], acc[ai][bj][m][1]); }
    });
}
__device__ __forceinline__ void ph_lora_dn_sg(const Frame& F) {
    const bf16_t* XS = (const bf16_t*)(F.ws + WS_XS); const bf16_t* WLDN = (const bf16_t*)(F.ws + WS_WLDN); bf16_t* LORA = (bf16_t*)(F.ws + WS_LORA);
    for (int u = F.bid; u < 64 * 4; u += F.G) {
        const int mt = u / 4, j = u % 4, n = (j == 0) ? 3 : (j == 1 ? 4 : 5);
        ASeg A; A.p[0] = XS + ((size_t)n * T + mt * 256) * D; A.p[1] = A.p[0]; A.p[2] = A.p[0]; A.segTiles = 16;
        bf16_t* out = LORA + (size_t)mt * 256 * 256 + j * 64;
        sg_tile<64>(F.lds, A, [](int R) { return (unsigned)R * (D * 2); }, WLDN + (size_t)(j * 64) * D, D, 16,
            [&](auto& acc, int r0, int c0, int fr, int fq) {
#pragma unroll
                for (int m = 0; m < EPI_MT(acc); ++m)
#pragma unroll
                    for (int q = 0; q < 4; ++q) { f32x4 v = acc[m][q];
#pragma unroll
                        for (int e = 0; e < 4; ++e) v[e] = (j == 0) ? tanhf(v[e]) : (j == 1 ? v[e] : sigmoidf_(v[e]));
                        st_bf4(out + (size_t)(r0 + 16 * m + fr) * 256 + c0 + 16 * q + 4 * fq, v); }
            });
    }
}
__device__ __forceinline__ void ph_dense_f32_px(const Frame& F, const bf16_t* Ain, const bf16_t* Wt, float* out) {
    PxDense S{(const char*)Ain, (const char*)Wt, 64, 4, D, F.G, F.bid, (unsigned)(D * 2), 4, 0};
    pgx::gemm_phase<true, false>(F.lds, D, D * 2, S, [&](const f32x4 (&acc)[2][2][4][2], const pgx::Unit& u, int wr, int wc, int fr, int fq) {
        float* base = out + u.c0 + wc * 32 + 4 * fq;
#pragma unroll
        for (int ai = 0; ai < 2; ++ai)
#pragma unroll
            for (int m = 0; m < 4; ++m) { float* rowp = base + (size_t)(u.r0 + ai * 128 + wr * 64 + m * 16 + fr) * D;
#pragma unroll
                for (int bj = 0; bj < 2; ++bj)
#pragma unroll
                    for (int n = 0; n < 2; ++n) *(f32x4*)(rowp + bj * 128 + n * 16) = acc[ai][bj][m][n]; }
    });
}
__device__ __forceinline__ void ph_qkv_px(const Frame& F) {
    bf16_t* QK = (bf16_t*)(F.ws + WS_Q); bf16_t* VT = QK + (size_t)2 * T * D;
    { PxDense S{(const char*)(F.ws + WS_H3), (const char*)(F.ws + WS_WQKV), 64, 8, D, F.G, F.bid, (unsigned)(D * 2), 8, 0};
      pgx::gemm_phase<true, true>(F.lds, D, D * 2, S, [&](const f32x4 (&acc)[2][2][4][2], const pgx::Unit& u, int wr, int wc, int fr, int fq) {
        bf16_t* base = QK + (size_t)(u.c0 / D) * T * D + (u.c0 % D) + wc * 32 + 8 * fq;
#pragma unroll
        for (int ai = 0; ai < 2; ++ai)
#pragma unroll
            for (int m = 0; m < 4; ++m) { bf16_t* rowp = base + (size_t)(u.r0 + ai * 128 + wr * 64 + m * 16 + fr) * D;
#pragma unroll
                for (int bj = 0; bj < 2; ++bj) px_store_bf16_perm(rowp + bj * 128, acc[ai][bj][m][0], acc[ai][bj][m][1]); }
      }); }
    { PxDense S{(const char*)(F.ws + WS_H3), (const char*)(F.ws + WS_WQKV) + (size_t)2 * D * D * 2, 64, 4, D, F.G, F.bid, (unsigned)(D * 2), 4, 0};
      pgx::gemm_phase<false, false>(F.lds, D, D * 2, S, [&](const f32x4 (&acc)[2][2][4][2], const pgx::Unit& u, int wr, int wc, int fr, int fq) {
#pragma unroll
        for (int ai = 0; ai < 2; ++ai)
#pragma unroll
            for (int m = 0; m < 4; ++m) { const int t = u.r0 + ai * 128 + wr * 64 + m * 16 + 4 * fq, b = t / SEQ, sidx = t % SEQ;
#pragma unroll
                for (int bj = 0; bj < 2; ++bj)
#pragma unroll
                    for (int n = 0; n < 2; ++n) { const int c = u.c0 + bj * 128 + wc * 32 + n * 16 + fr, h = c >> 6, d = c & 63;
                        st_bf4(VT + ((size_t)((b * NH + h) * 64 + d)) * SEQ + sidx, acc[ai][bj][m][n]); } }
      }); }
}
struct PxMoe {
    const char* Asrc; const int* TOK; const int* TILEE; const char* W; int routed, nmt, nN, K, G, c; unsigned lda; size_t wexp; bool gather;
    __device__ __forceinline__ bool next(int i, pgx::Unit& u) const {
        const int w = px_unit_index(i, G, c, nmt * nN); if (w < 0) return false;
        const int mt = w / nN, pn = w % nN, row0 = mt * 256; const bool sh = row0 >= routed; const int e = sh ? 64 : TILEE[mt];
        if (gather) { if (sh) { u.A = Asrc + (size_t)(row0 - routed) * lda; u.tok = nullptr; } else { u.A = Asrc; u.tok = TOK + row0; } }
        else { u.A = Asrc + (size_t)row0 * lda; u.tok = nullptr; }
        u.B = W + (size_t)e * wexp + (size_t)pn * 256 * K * 2; u.r0 = row0; u.c0 = pn * 256; u.aux = 0; return true;
    }
};
__device__ __forceinline__ void ph_gateup_px(const Frame& F) {
    bf16_t* HB = (bf16_t*)(F.ws + WS_HB); const int* START = (const int*)(F.ws + WS_START);
    const int routed = START[65], nmt = (routed + T) / 256;
    PxMoe S{(const char*)(F.ws + WS_H2), (const int*)(F.ws + WS_TOK), (const int*)(F.ws + WS_TILEE), (const char*)(F.ws + WS_WGU), routed, nmt, 2, D, F.G, F.bid, (unsigned)(D * 2), (size_t)512 * D * 2, true};
    pgx::gemm_phase<true, true>(F.lds, D, D * 2, S, [&](const f32x4 (&acc)[2][2][4][2], const pgx::Unit& u, int wr, int wc, int fr, int fq) {
        bf16_t* base = HB + (u.c0 >> 1) + wc * 32 + 8 * fq;
#pragma unroll
        for (int ai = 0; ai < 2; ++ai)
#pragma unroll
            for (int m = 0; m < 4; ++m) { f32x4 v[2];
#pragma unroll
                for (int n = 0; n < 2; ++n)
#pragma unroll
                    for (int e = 0; e < 4; ++e) { const float g = acc[ai][0][m][n][e]; v[n][e] = g * sigmoidf_(g) * acc[ai][1][m][n][e]; }
                px_store_bf16_perm(base + (size_t)(u.r0 + ai * 128 + wr * 64 + m * 16 + fr) * DE, v[0], v[1]); }
    });
}
__device__ __forceinline__ void ph_down_px(const Frame& F) {
    bf16_t* YB = (bf16_t*)(F.ws + WS_YB); const int* START = (const int*)(F.ws + WS_START);
    const int routed = START[65], nmt = (routed + T) / 256;
    PxMoe S{(const char*)(F.ws + WS_HB), nullptr, (const int*)(F.ws + WS_TILEE), (const char*)(F.ws + WS_WDN), routed, nmt, 4, DE, F.G, F.bid, (unsigned)(DE * 2), (size_t)D * DE * 2, false};
    pgx::gemm_phase<true, true>(F.lds, DE, DE * 2, S, [&](const f32x4 (&acc)[2][2][4][2], const pgx::Unit& u, int wr, int wc, int fr, int fq) {
        bf16_t* base = YB + u.c0 + wc * 32 + 8 * fq;
#pragma unroll
        for (int ai = 0; ai < 2; ++ai)
#pragma unroll
            for (int m = 0; m < 4; ++m) { bf16_t* rowp = base + (size_t)(u.r0 + ai * 128 + wr * 64 + m * 16 + fr) * D;
#pragma unroll
                for (int bj = 0; bj < 2; ++bj) px_store_bf16_perm(rowp + bj * 128, acc[ai][bj][m][0], acc[ai][bj][m][1]); }
    });
}

__global__ void __launch_bounds__(NTHREADS, 2) mega(Args args) {
    extern __shared__ __attribute__((aligned(16))) unsigned char lds[];
    Frame F;
    F.in = args.in; F.out = args.out; F.ws = args.ws; F.ctl = (unsigned*)(args.ws + WS_CTL);
    F.ldsf = (float*)lds; F.lds = (LAS unsigned char*)lds;
    F.tid = threadIdx.x; F.lane = F.tid & 63; F.wave = __builtin_amdgcn_readfirstlane(F.tid >> 6); F.bid = blockIdx.x; F.G = gridDim.x;
    if (F.tid < 4) ((unsigned*)(lds + LDS_BYTES - 64))[F.tid] = 0u;
    __syncthreads();
    XcdBarrier bar; bar.bar = F.ctl + CW_BAR; bar.x = 0; bar.st = (volatile LAS unsigned*)(lds + LDS_BYTES - 64);
#if MK_N_LAUNCHES == 1
    bar = xcd_barrier_post(F.ctl + CW_BAR, (volatile LAS unsigned*)(lds + LDS_BYTES - 64));
#endif
    const int lo = args.ph_lo, hi = args.ph_hi;
#define IN(k) (lo <= (k) && (k) < hi)
#define SEAM(k) do { if (IN(k) && IN((k) + 1)) xcd_barrier(bar); } while (0)
    bf16_t* const wsb = (bf16_t*)args.ws;
    (void)wsb;
#ifndef REP_A
#define REP_A 1
#endif
#ifndef REP_B
#define REP_B 1
#endif
#ifndef REP_C
#define REP_C 1
#endif
#ifndef REP_D
#define REP_D 1
#endif
#ifndef REP_E
#define REP_E 1
#endif
#ifndef REP_F
#define REP_F 1
#endif
#ifndef REP_G
#define REP_G 1
#endif
#ifndef REP_H
#define REP_H 1
#endif
#define RUN(n, body) for (int r_ = 0; r_ < (n); ++r_) { body; }
    if (IN(0)) { RUN(REP_D, ph_mod(F)) RUN(REP_G, conv_dense(F, F.bid, F.G)) } SEAM(0);
    if (IN(1)) { RUN(REP_E, ph_prenorm_rwkv(F)) } SEAM(1);
    if (IN(2)) { if (USE_PGX & 1) { RUN(REP_A, ph_rkv_px(F); ph_lora_dn_sg(F)) } else { RUN(REP_A, ph_rkv_lora_sg(F)) } } SEAM(2);
    if (IN(3)) { RUN(REP_F, ph_lora_up_sg(F)) } SEAM(3);
    if (IN(4)) { RUN(REP_B, ph_wkv_chunk(F)) } SEAM(4);
    if (IN(5)) { if (F.bid < NB * NH && F.G > 2 * NB * NH) { RUN(REP_B, ph_wkv_carry(F)) } else if (F.G > 2 * NB * NH) { RUN(REP_D, conv_moe(F, 0, F.bid - NB * NH, F.G - NB * NH)) } else { ph_wkv_carry(F); conv_moe(F, 0, F.bid, F.G); } } SEAM(5);
    if (IN(6)) { RUN(REP_B, ph_wkv_out(F)) } SEAM(6);
    if (IN(7)) { if (USE_PGX & 2) { RUN(REP_A, ph_dense_f32_px(F, (const bf16_t*)(F.ws + WS_OG), (const bf16_t*)(F.ws + WS_WO), (float*)(F.ws + WS_Y1))) } else { RUN(REP_A, ph_dense_sg<0>(F, (const bf16_t*)(F.ws + WS_OG), (const bf16_t*)(F.ws + WS_WO), D, F.ws + WS_Y1)) } } SEAM(7);
    if (IN(8)) { RUN(REP_E, ph_postmix_preffn(F, 0, F.in[I_X], (const float*)(F.ws + WS_Y1))) } SEAM(8);
    if (IN(9)) { RUN(REP_F, ph_router_sg(F, 0)) } SEAM(9);
    if (IN(10)) { ph_topk(F, 0); } SEAM(10);
    if (IN(11)) { ph_offsets(F, 0); } SEAM(11);
    if (IN(12)) { if (USE_PGX & 4) { RUN(REP_A, ph_gateup_px(F)) } else { RUN(REP_A, ph_gateup_sg(F)) } } SEAM(12);
    if (IN(13)) { if (USE_PGX & 8) { RUN(REP_A, ph_down_px(F)) } else { RUN(REP_A, ph_down_sg(F)) } } SEAM(13);
    if (IN(14)) { RUN(1, ph_combine(F, 0, true)) RUN(REP_H, conv_moe(F, 1, F.bid, F.G)) } SEAM(14);
    if (IN(15)) { if (USE_PGX & 16) { RUN(REP_A, ph_qkv_px(F)) } else { RUN(REP_A, ph_qkv_sg(F)) } } SEAM(15);
    if (IN(16)) { RUN(REP_C, ph_attn(F)) } SEAM(16);
    if (IN(17)) { if (USE_PGX & 2) { RUN(REP_A, ph_dense_f32_px(F, (const bf16_t*)(F.ws + WS_AO), (const bf16_t*)(F.ws + WS_WSBO), (float*)(F.ws + WS_Y1B))) } else { RUN(REP_A, ph_dense_sg<0>(F, (const bf16_t*)(F.ws + WS_AO), (const bf16_t*)(F.ws + WS_WSBO), D, F.ws + WS_Y1B)) } } SEAM(17);
    if (IN(18)) { ph_postmix_preffn(F, 1, F.out, (const float*)(F.ws + WS_Y1B)); } SEAM(18);
    if (IN(19)) { RUN(REP_F, ph_router_sg(F, 1)) } SEAM(19);
    if (IN(20)) { ph_topk(F, 1); } SEAM(20);
    if (IN(21)) { ph_offsets(F, 1); } SEAM(21);
    if (IN(22)) { if (USE_PGX & 4) { RUN(REP_A, ph_gateup_px(F)) } else { RUN(REP_A, ph_gateup_sg(F)) } } SEAM(22);
    if (IN(23)) { if (USE_PGX & 8) { RUN(REP_A, ph_down_px(F)) } else { RUN(REP_A, ph_down_sg(F)) } } SEAM(23);
    if (IN(24)) { ph_combine(F, 1, false); }
#undef IN
#undef SEAM
}

extern "C" void kernel_launch(void* const* d_in, const int* in_sizes, int n_in, void* d_out, int out_size, void* d_ws, size_t ws_size, hipStream_t stream) {
    static int grid = 0;
    if (grid == 0) {
        if (n_in != 34 || in_sizes[0] != T * D || out_size != T * D || ws_size < WS_END) {
            fprintf(stderr, "kernel_launch: unexpected shapes: n_in %d in0 %d out %d ws %zu (need %zu)\n", n_in, n_in > 0 ? in_sizes[0] : -1, out_size, ws_size, (size_t)WS_END);
            grid = -1; return;
        }
        int dev = 0, cus = 0, per_cu = 0;
        if (hipGetDevice(&dev) != hipSuccess || hipDeviceGetAttribute(&cus, hipDeviceAttributeMultiprocessorCount, dev) != hipSuccess) { grid = -1; return; }
        if (hipFuncSetAttribute((const void*)mega, hipFuncAttributeMaxDynamicSharedMemorySize, LDS_BYTES) != hipSuccess) { fprintf(stderr, "kernel_launch: hipFuncSetAttribute failed\n"); grid = -1; return; }
        if (hipOccupancyMaxActiveBlocksPerMultiprocessor(&per_cu, (const void*)mega, NTHREADS, LDS_BYTES) != hipSuccess || per_cu < 1)
            fprintf(stderr, "kernel_launch: occupancy query reports %d blocks per CU\n", per_cu);
        (void)hipGetLastError();
        grid = cus;
    }
    if (grid < 0) return;
    if (hipMemsetAsync((char*)d_ws + WS_CTL, 0, CTL_BYTES, stream) != hipSuccess) { fprintf(stderr, "kernel_launch: memset failed\n"); return; }
    Args a{};
    for (int i = 0; i < 34; ++i) a.in[i] = (const float*)d_in[i];
    a.out = (float*)d_out; a.ws = (unsigned char*)d_ws;
#if MK_N_LAUNCHES == 1
    a.ph_lo = 0; a.ph_hi = NPHASES;
    hipLaunchKernelGGL(mega, dim3(grid), dim3(NTHREADS), LDS_BYTES, stream, a);
#else
    for (int p = 0; p < NPHASES; ++p) { a.ph_lo = p; a.ph_hi = p + 1; hipLaunchKernelGGL(mega, dim3(grid), dim3(NTHREADS), LDS_BYTES, stream, a); }
#endif
    const hipError_t le = hipPeekAtLastError();
    if (le != hipSuccess) fprintf(stderr, "kernel_launch: launch failed: %s\n", hipGetErrorName(le));
}
```

```cpp
#include <hip/hip_runtime.h>
#include <cstdio>
#include <cstdint>

#ifndef MK_N_LAUNCHES
#define MK_N_LAUNCHES 1
#endif

constexpr int T = 16384, D = 1024, SEQ = 8192, NB = 2, NH = 16, HD = 64;
constexpr int NE = 64, TOPK = 8, DE = 256;
constexpr int RP = 256;
constexpr int MAXROUTED = 147456;
constexpr int MAXROWS = MAXROUTED + T;
constexpr int NTHREADS = 512, NWAVES = 8;
constexpr int NPHASES = 25;
constexpr int LDS_BYTES = 144 * 1024;

typedef unsigned short bf16_t;
typedef float f32x4 __attribute__((ext_vector_type(4)));
typedef unsigned u32x4 __attribute__((ext_vector_type(4)));
typedef unsigned u32x2 __attribute__((ext_vector_type(2)));

__device__ __forceinline__ float bf2f(bf16_t b) { return __uint_as_float(((unsigned)b) << 16); }
typedef __bf16 bf16x2_t __attribute__((ext_vector_type(2)));
typedef float f32x2 __attribute__((ext_vector_type(2)));
__device__ __forceinline__ unsigned pack2(float a, float b) { const f32x2 v = {a, b}; const bf16x2_t r = __builtin_convertvector(v, bf16x2_t); return __builtin_bit_cast(unsigned, r); }
__device__ __forceinline__ bf16_t f2bf(float f) { return (bf16_t)(pack2(f, 0.f) & 0xffffu); }
__device__ __forceinline__ float lo2f(unsigned u) { return __uint_as_float(u << 16); }
__device__ __forceinline__ float hi2f(unsigned u) { return __uint_as_float(u & 0xffff0000u); }
__device__ __forceinline__ float fexp_(float x) { return __builtin_amdgcn_exp2f(x * 1.4426950408889634f); }
__device__ __forceinline__ float sigmoidf_(float x) { return __builtin_amdgcn_rcpf(1.0f + fexp_(-x)); }
__device__ __forceinline__ float tanhf_(float x) { return 1.0f - 2.0f * __builtin_amdgcn_rcpf(1.0f + fexp_(2.0f * x)); }
__device__ __forceinline__ float softplusf_(float x) { const float e = fexp_(x); const float l = __builtin_amdgcn_logf(1.0f + e) * 0.6931471805599453f; return x > 15.f ? x : (x < -8.f ? e : l); }
__device__ __forceinline__ float wave_sum(float v) {
#pragma unroll
    for (int o = 32; o >= 1; o >>= 1) v += __shfl_xor(v, o);
    return v;
}

constexpr size_t MiB = 1024 * 1024;
constexpr size_t WS_CTL    = 0;
constexpr size_t CTL_BYTES = 64 * 1024;
constexpr size_t WS_MOD    = 64 * 1024;
constexpr size_t WS_IDX    = 256 * 1024;
constexpr size_t WS_GATE   = WS_IDX + 512 * 1024;
constexpr size_t WS_RANK   = WS_GATE + 512 * 1024;
constexpr size_t WS_POS    = WS_RANK + 512 * 1024;
constexpr size_t WS_TOK    = WS_POS + 512 * 1024;
constexpr size_t WS_TILEE  = WS_TOK + 704 * 1024;
constexpr size_t WS_START  = WS_TILEE + 4096;
constexpr size_t WS_LOGITS = 4 * MiB;
constexpr size_t WS_BIG    = 8 * MiB;
constexpr size_t WS_XS   = WS_BIG;
constexpr size_t WS_RKV  = WS_BIG + 192 * MiB;
constexpr size_t WS_LORA = WS_BIG + 288 * MiB;
constexpr size_t WS_LD   = WS_BIG;
constexpr size_t WS_AA   = WS_BIG + 64 * MiB;
constexpr size_t WS_GG   = WS_BIG + 96 * MiB;
constexpr size_t WS_O    = WS_BIG + 128 * MiB;
constexpr size_t WS_OG   = WS_BIG + 296 * MiB;
constexpr size_t WS_Y1   = WS_BIG + 328 * MiB;
constexpr size_t WS_H2   = WS_BIG;
constexpr size_t WS_H2LO = WS_BIG + 32 * MiB;
constexpr size_t WS_YB   = WS_BIG;
constexpr size_t WS_HB   = WS_BIG + 320 * MiB;
constexpr size_t WS_H3   = WS_BIG + 320 * MiB;
constexpr size_t WS_Q    = WS_BIG;
constexpr size_t WS_AO   = WS_BIG + 96 * MiB;
constexpr size_t WS_Y1B  = WS_BIG + 128 * MiB;
constexpr size_t WS_W     = WS_BIG + 400 * MiB;
constexpr size_t WS_WGU   = WS_W;
constexpr size_t WS_WDN   = WS_WGU + (size_t)65 * 512 * 1024 * 2;
constexpr size_t WS_WRKV  = WS_WDN + (size_t)65 * 1024 * 256 * 2;
constexpr size_t WS_WO    = WS_WRKV + (size_t)3072 * 1024 * 2;
constexpr size_t WS_WQKV  = WS_WO + (size_t)1024 * 1024 * 2;
constexpr size_t WS_WSBO  = WS_WQKV + (size_t)3072 * 1024 * 2;
constexpr size_t WS_WLDN  = WS_WSBO + (size_t)1024 * 1024 * 2;
constexpr size_t WS_WLUP  = WS_WLDN + (size_t)256 * 1024 * 2;
constexpr size_t WS_WRT   = WS_WLUP + (size_t)1024 * 256 * 2;
constexpr size_t WS_END   = WS_WRT + (size_t)2 * 64 * 3072 * 2;

constexpr int CW_BAR = 0;
constexpr int CW_CNT = 4096;
constexpr int CW_AQ = 4608;

#define XB_TMO      128
#define XB_XCNT(j)  (256  + 64 * (j))
#define XB_XSUB(j)  (1280 + 64 * (j))
#define XB_XGEN(j)  (2304 + 64 * (j))
#define XB_TOP      3328
#define XB_TOPGEN   3392
#define XCD_BAR_WORDS 3456
#define XB_SPIN_CAP (1u << 22)
#define LAS __attribute__((address_space(3)))

__device__ __forceinline__ unsigned xb_ld(unsigned* p)              { return __hip_atomic_load(p, __ATOMIC_RELAXED, __HIP_MEMORY_SCOPE_AGENT); }
__device__ __forceinline__ unsigned xb_add(unsigned* p, unsigned v) { return __hip_atomic_fetch_add(p, v, __ATOMIC_RELAXED, __HIP_MEMORY_SCOPE_AGENT); }
__device__ __forceinline__ unsigned xb_xcc_id() { return (unsigned)__builtin_amdgcn_s_getreg((3 << 11) | 20) & 0xFu; }
#define XB_SPIN(cond, bar) do { unsigned _sp = 0; while (cond) { __builtin_amdgcn_s_sleep(1); \
    if ((++_sp & 255u) == 0u) { if (xb_ld(&(bar)[XB_TMO])) break; if (_sp > XB_SPIN_CAP) { atomicAdd(&(bar)[XB_TMO], 1u); break; } } } } while (0)

struct XcdBarrier { unsigned* bar; unsigned x; volatile LAS unsigned* st; };

__device__ __forceinline__ XcdBarrier xcd_barrier_post(unsigned* bar, volatile LAS unsigned* st) {
    XcdBarrier b; b.bar = bar; b.x = xb_xcc_id(); b.st = st;
    if (threadIdx.x == 0) (void)xb_add(&bar[XB_XCNT(b.x)], 1u);
    return b;
}
__device__ __forceinline__ void xcd_barrier_complete(unsigned* bar, unsigned x, unsigned& nloc, unsigned& nx) {
    const unsigned G = gridDim.x * gridDim.y * gridDim.z;
    unsigned sum, cnt, mine, sp = 0u;
    for (;;) {
        sum = 0u; cnt = 0u; mine = 0u;
#pragma unroll
        for (unsigned j = 0; j < 16; ++j) { const unsigned c = xb_ld(&bar[XB_XCNT(j)]); sum += c; cnt += (c > 0u) ? 1u : 0u; mine = (j == x) ? c : mine; }
        if (sum == G) break;
        __builtin_amdgcn_s_sleep(1);
        if ((++sp & 255u) == 0u) { if (xb_ld(&bar[XB_TMO])) break; if (sp > XB_SPIN_CAP) { atomicAdd(&bar[XB_TMO], 1u); break; } }
    }
    nloc = mine > 0u ? mine : 1u; nx = cnt > 0u ? cnt : 1u;
}
__device__ __forceinline__ void xcd_barrier(const XcdBarrier& b) {
    asm volatile("s_waitcnt vmcnt(0)" ::: "memory");
    __syncthreads();
    if (threadIdx.x == 0) {
        unsigned* bar = b.bar;
        __builtin_amdgcn_s_waitcnt(0);
        unsigned nloc = b.st[0], nx = b.st[1];
        if (nloc == 0u) { xcd_barrier_complete(bar, b.x, nloc, nx); b.st[0] = nloc; b.st[1] = nx; }
        const unsigned old = xb_add(&bar[XB_XSUB(b.x)], 1u);
        const unsigned gen = old / nloc;
        if (old + 1u == (gen + 1u) * nloc) {
            __builtin_amdgcn_fence(__ATOMIC_RELEASE, "agent");
            asm volatile("s_waitcnt vmcnt(0)" ::: "memory");
            const unsigned og = xb_add(&bar[XB_TOP], 1u);
            const unsigned tg = og / nx;
            if (og + 1u == (tg + 1u) * nx) xb_add(&bar[XB_TOPGEN], 1u);
            else XB_SPIN(xb_ld(&bar[XB_TOPGEN]) == tg, bar);
            __builtin_amdgcn_fence(__ATOMIC_ACQUIRE, "agent");
            xb_add(&bar[XB_XGEN(b.x)], 1u);
            asm volatile("s_waitcnt vmcnt(0)" ::: "memory");
        } else {
            XB_SPIN(xb_ld(&bar[XB_XGEN(b.x)]) == gen, bar);
            __builtin_amdgcn_fence(__ATOMIC_ACQUIRE, "agent");
            asm volatile("s_waitcnt vmcnt(0)" ::: "memory");
        }
    }
    __syncthreads();
}

struct Args { const float* in[34]; float* out; unsigned char* ws; int ph_lo, ph_hi; };

struct Frame {
    const float* const* in; float* out; unsigned char* ws; unsigned* ctl;
    float* ldsf; LAS unsigned char* lds; int tid, lane, wave, bid, G;
};

enum { I_X = 0, I_C, I_ADAW, I_ADAB, I_NPM, I_NPOM, I_NPF, I_NPOF, I_MU, I_WRKV, I_WW1, I_WW2, I_W0, I_WA1, I_WA2, I_A0, I_WG1, I_WG2,
       I_KK, I_KA, I_RK, I_LNG, I_LNB, I_WO, I_SBQKV, I_SBO, I_ROUTER, I_RBIAS, I_MG, I_MU_, I_MD, I_SG, I_SU, I_SD };

template <class AF, class BF>
__device__ __forceinline__ void simt_tile(float (&acc)[4][4], const AF& af, const BF& bfn, int row0, int col0, int K, float* sm) {
    float* sA = sm; float* sB = sm + 16 * 132;
    const int tid = threadIdx.x, ty = tid >> 4, tx = tid & 15;
#pragma unroll
    for (int i = 0; i < 4; ++i)
#pragma unroll
        for (int j = 0; j < 4; ++j) acc[i][j] = 0.f;
    for (int k0 = 0; k0 < K; k0 += 16) {
#pragma unroll
        for (int q = 0; q < 4; ++q) { const int idx = tid + 512 * q, r = idx >> 4, kk = idx & 15; sA[kk * 132 + r] = af(row0 + r, k0 + kk); }
#pragma unroll
        for (int q = 0; q < 2; ++q) { const int idx = tid + 512 * q, kk = idx >> 6, c = idx & 63; sB[kk * 68 + c] = bfn(k0 + kk, col0 + c); }
        __syncthreads();
#pragma unroll
        for (int kk = 0; kk < 16; ++kk) {
            const f32x4 a = *(const f32x4*)&sA[kk * 132 + ty * 4];
            const f32x4 b = *(const f32x4*)&sB[kk * 68 + tx * 4];
#pragma unroll
            for (int i = 0; i < 4; ++i)
#pragma unroll
                for (int j = 0; j < 4; ++j) acc[i][j] += a[i] * b[j];
        }
        __syncthreads();
    }
}

typedef short bf16x8 __attribute__((ext_vector_type(8)));
constexpr int HTB = 128 * 64 * 2;
__device__ __forceinline__ int lds_byte(int r, int c) { const int st = (r >> 4) * 2 + (c >> 5), rr = r & 15, cc = c & 31, ob = rr * 64 + cc * 2; return st * 1024 + (ob ^ (((ob >> 9) & 1) << 5)); }
__device__ __forceinline__ void stage_rc(int b, int& R, int& C) { const int st = b / 1024, sb = b % 1024, swz = sb ^ (((sb >> 9) & 1) << 5); R = (st >> 1) * 16 + swz / 64; C = (st & 1) * 32 + (swz % 64) / 2; }
#define WAIT_V(n) asm volatile("s_waitcnt vmcnt(" #n ")" ::: "memory")
#define SBAR() do { asm volatile("" ::: "memory"); __builtin_amdgcn_s_barrier(); asm volatile("" ::: "memory"); } while (0)

struct ASeg { const bf16_t* p[3]; int segTiles; };

struct BRowId { __device__ __forceinline__ int operator()(int R) const { return R; } };
template <int BN, bool NSW = false, class ARow, class Epi, class BRow = BRowId>
__device__ __forceinline__ void sg_tile(LAS unsigned char* lds, const ASeg& A, const ARow& arow, const bf16_t* Bt, int ldb, int nt, const Epi& epi, const BRow& brow = BRow()) {
    constexpr int WN = BN / 64, WM = 8 / WN, WR = 256 / WM, MT = WR / 16;
    const int tid = threadIdx.x, wid = __builtin_amdgcn_readfirstlane(tid >> 6), lane = tid & 63, fr = lane & 15, fq = lane >> 4;
    const int wm = wid / WN, wn = wid % WN;
    unsigned aoffs[2][2], boffs[2];
#pragma unroll
    for (int i = 0; i < 2; ++i) { int R, C; stage_rc(tid * 16 + i * 8192, R, C);
        aoffs[0][i] = arow(R) + (unsigned)C * 2u; aoffs[1][i] = arow(128 + R) + (unsigned)C * 2u; boffs[i] = (unsigned)(brow(R) * ldb + C) * 2u; }
    const unsigned ldsw = (unsigned)wid * 1024u;
    f32x4 acc[MT][4];
#pragma unroll
    for (int m = 0; m < MT; ++m)
#pragma unroll
        for (int n = 0; n < 4; ++n) acc[m][n] = (f32x4){0.f, 0.f, 0.f, 0.f};
    const int arow0 = wm * WR, ah = arow0 >> 7, ar = arow0 & 127;
    const int aoff = ah * HTB + lds_byte(ar + fr, fq * 8), boff = 2 * HTB + lds_byte(wn * 64 + fr, fq * 8);
#define SG_STAGE(kt, s) do { const int sg_ = (kt) / A.segTiles; const char* ab_ = (const char*)(sg_ == 0 ? A.p[0] : (sg_ == 1 ? A.p[1] : A.p[2])) + (size_t)((kt) - sg_ * A.segTiles) * 128; const char* bb_ = (const char*)Bt + (size_t)(kt) * 128; \
        _Pragma("unroll") for (int h_ = 0; h_ < 2; ++h_) _Pragma("unroll") for (int i_ = 0; i_ < 2; ++i_) \
            __builtin_amdgcn_global_load_lds((const unsigned*)(ab_ + aoffs[h_][i_]), (LAS unsigned*)(lds + ((s) * 3 + h_) * HTB + ldsw + i_ * 8192), 16, 0, 0); \
        _Pragma("unroll") for (int i_ = 0; i_ < WN; ++i_) \
            __builtin_amdgcn_global_load_lds((const unsigned*)(bb_ + boffs[i_]), (LAS unsigned*)(lds + ((s) * 3 + 2) * HTB + ldsw + i_ * 8192), 16, 0, 0); } while (0)
    SG_STAGE(0, 0);
    for (int t = 0; t < nt; ++t) {
        const int s = t & 1;
        if (t + 1 < nt) { SG_STAGE(t + 1, s ^ 1); if (WN == 2) WAIT_V(6); else WAIT_V(5); } else { WAIT_V(0); }
        SBAR();
        LAS unsigned char* base = lds + s * 3 * HTB;
#pragma unroll
        for (int k = 0; k < 2; ++k) {
            bf16x8 af[MT], bfr[4];
#pragma unroll
            for (int m = 0; m < MT; ++m) af[m] = *(const LAS bf16x8*)(base + aoff + m * 2048 + k * 1024);
#pragma unroll
            for (int n = 0; n < 4; ++n) bfr[n] = *(const LAS bf16x8*)(base + boff + n * 2048 + k * 1024);
#pragma unroll
            for (int m = 0; m < MT; ++m)
#pragma unroll
                for (int n = 0; n < 4; ++n) acc[m][n] = NSW ? __builtin_amdgcn_mfma_f32_16x16x32_bf16(af[m], bfr[n], acc[m][n], 0, 0, 0) : __builtin_amdgcn_mfma_f32_16x16x32_bf16(bfr[n], af[m], acc[m][n], 0, 0, 0);
        }
        SBAR();
    }
#undef SG_STAGE
    epi(acc, arow0, wn * 64, fr, fq);
}

struct CTile { bf16_t* dst; const float* src; int dld, sld, ncols; };
template <class TF>
__device__ __forceinline__ void conv_tiles(const Frame& F, int ntiles, int u0, int ustride, const TF& tf) {
    unsigned* tl = (unsigned*)F.ldsf;
    const int i = F.tid & 31, kp0 = F.tid >> 5;
    if (u0 >= ntiles) return;
    CTile ct = tf(u0);
    f32x4 a[4], b[4];
#define CV_LOAD() do { _Pragma("unroll") for (int q = 0; q < 4; ++q) { const int kp = kp0 + 16 * q; \
        if (4 * i < ct.ncols) { a[q] = *(const f32x4*)(ct.src + (size_t)(2 * kp) * ct.sld + 4 * i); b[q] = *(const f32x4*)(ct.src + (size_t)(2 * kp + 1) * ct.sld + 4 * i); } } } while (0)
    CV_LOAD();
    for (int u = u0; u < ntiles; u += ustride) {
        const CTile cur = ct;
        if (4 * i < cur.ncols) {
#pragma unroll
            for (int q = 0; q < 4; ++q) { const int kp = kp0 + 16 * q;
#pragma unroll
                for (int e = 0; e < 4; ++e) tl[(4 * i + e) * 65 + kp] = pack2(a[q][e], b[q][e]); }
        }
        __syncthreads();
        if (u + ustride < ntiles) { ct = tf(u + ustride); CV_LOAD(); }
        const int nb = F.tid >> 4, sgm = F.tid & 15;
#pragma unroll
        for (int q = 0; q < 4; ++q) { const int n = nb + 32 * q;
            if (n < cur.ncols) { u32x4 v;
#pragma unroll
                for (int e = 0; e < 4; ++e) v[e] = tl[n * 65 + sgm * 4 + e];
                *(u32x4*)(cur.dst + (size_t)n * cur.dld + sgm * 8) = v; } }
        __syncthreads();
    }
#undef CV_LOAD
}
__device__ __forceinline__ void conv_moe(const Frame& F, int layer, int u0, int ustride) {
    bf16_t* WGU = (bf16_t*)(F.ws + WS_WGU); bf16_t* WDN = (bf16_t*)(F.ws + WS_WDN);
    const float* const* in = F.in;
    conv_tiles(F, 65 * 48, u0, ustride, [=](int u) {
        CTile c; const int e = u / 48, r = u % 48;
        if (r < 32) { const int up = r >> 4, kt = (r >> 1) & 7, nt = r & 1;
            const float* W = (e < 64) ? (up ? in[I_MU_] : in[I_MG]) + ((size_t)layer * NE + e) * D * DE : (up ? in[I_SU] : in[I_SG]) + (size_t)layer * D * DE;
            c.src = W + (size_t)kt * 128 * DE + nt * 128; c.sld = DE; c.dst = WGU + ((size_t)e * 512 + nt * 256 + up * 128) * D + kt * 128; c.dld = D; c.ncols = 128; }
        else { const int v = r - 32, kt = v >> 3, nt = v & 7;
            const float* W = (e < 64) ? in[I_MD] + ((size_t)layer * NE + e) * DE * D : in[I_SD] + (size_t)layer * DE * D;
            c.src = W + (size_t)kt * 128 * D + nt * 128; c.sld = D; c.dst = WDN + ((size_t)e * D + nt * 128) * DE + kt * 128; c.dld = DE; c.ncols = 128; }
        return c; });
}
__device__ __forceinline__ void conv_dense(const Frame& F, int u0, int ustride) {
    bf16_t* WRKV = (bf16_t*)(F.ws + WS_WRKV); bf16_t* WO = (bf16_t*)(F.ws + WS_WO); bf16_t* WQKV = (bf16_t*)(F.ws + WS_WQKV); bf16_t* WSBO = (bf16_t*)(F.ws + WS_WSBO); bf16_t* WLDN = (bf16_t*)(F.ws + WS_WLDN);
    const float* const* in = F.in;
    conv_tiles(F, 192 + 64 + 192 + 64 + 24, u0, ustride, [=](int u) {
        CTile c; c.dld = D; c.ncols = 128;
        if (u < 192) { const int n = u / 64, kt = (u >> 3) & 7, nt = u & 7; c.src = in[I_WRKV] + (size_t)n * D * D + (size_t)kt * 128 * D + nt * 128; c.sld = D; c.dst = WRKV + ((size_t)n * D + nt * 128) * D + kt * 128; }
        else if (u < 256) { const int v = u - 192, kt = v >> 3, nt = v & 7; c.src = in[I_WO] + (size_t)kt * 128 * D + nt * 128; c.sld = D; c.dst = WO + (size_t)nt * 128 * D + kt * 128; }
        else if (u < 448) { const int v = u - 256, kt = v / 24, nt = v % 24; c.src = in[I_SBQKV] + (size_t)kt * 128 * 3 * D + nt * 128; c.sld = 3 * D; c.dst = WQKV + (size_t)nt * 128 * D + kt * 128; }
        else if (u < 512) { const int v = u - 448, kt = v >> 3, nt = v & 7; c.src = in[I_SBO] + (size_t)kt * 128 * D + nt * 128; c.sld = D; c.dst = WSBO + (size_t)nt * 128 * D + kt * 128; }
        else { const int v = u - 512, kt = v / 3, j = v % 3;
            if (j == 0) { c.src = in[I_WW1] + (size_t)kt * 128 * 64; c.sld = 64; c.dst = WLDN + kt * 128; c.ncols = 64; }
            else if (j == 1) { c.src = in[I_WA1] + (size_t)kt * 128 * 64; c.sld = 64; c.dst = WLDN + (size_t)64 * D + kt * 128; c.ncols = 64; }
            else { c.src = in[I_WG1] + (size_t)kt * 128 * 128; c.sld = 128; c.dst = WLDN + (size_t)128 * D + kt * 128; } }
        return c; });
    bf16_t* WLUP = (bf16_t*)(F.ws + WS_WLUP); bf16_t* WRT = (bf16_t*)(F.ws + WS_WRT);
    const int gtid = u0 * NTHREADS + F.tid, gstride = ustride * NTHREADS;
    for (int i = gtid; i < 1024 * 256; i += gstride) {
        float v;
        if (i < 1024 * 64) { const int n = i / 64, k = i % 64; v = F.in[I_WW2][k * D + n]; }
        else if (i < 2 * 1024 * 64) { const int j = i - 1024 * 64, n = j / 64, k = j % 64; v = F.in[I_WA2][k * D + n]; }
        else { const int j = i - 2 * 1024 * 64, n = j / 128, k = j % 128; v = F.in[I_WG2][k * D + n]; }
        WLUP[i] = f2bf(v);
    }
    for (int i = gtid; i < 2 * 64 * 1024; i += gstride) {
        const int l = i / (64 * 1024), j = i % (64 * 1024), e = j / 1024, k = j % 1024;
        const float w = F.in[I_ROUTER][((size_t)l * D + k) * NE + e]; const bf16_t hi = f2bf(w), lo = f2bf(w - bf2f(hi));
        bf16_t* row = WRT + ((size_t)l * 64 + e) * 3072; row[k] = hi; row[1024 + k] = lo; row[2048 + k] = hi;
    }
}

__device__ __forceinline__ void ph_mod(const Frame& F) {
    const float* c = F.in[I_C]; const float* W = F.in[I_ADAW]; const float* bias = F.in[I_ADAB];
    float* MOD = (float*)(F.ws + WS_MOD);
    float* red = F.ldsf;
    float* sc = F.ldsf + 1024;
    for (int i = F.tid; i < 2 * D; i += NTHREADS) { const float v = c[i]; sc[i] = v * sigmoidf_(v); }
    __syncthreads();
    for (int u = F.bid; u < 192; u += F.G) {
        const int l = u / 96, cg = u % 96, col = cg * 64 + F.lane;
        float s0 = 0.f, s1 = 0.f;
        const float* wp = W + ((size_t)l * D + F.wave * 128) * 6144 + col;
#pragma unroll 1
        for (int d0 = 0; d0 < 128; d0 += 32) {
            float wv[32];
#pragma unroll
            for (int d = 0; d < 32; ++d) wv[d] = wp[(size_t)(d0 + d) * 6144];
#pragma unroll
            for (int d = 0; d < 32; ++d) { const int dd = F.wave * 128 + d0 + d; s0 += sc[dd] * wv[d]; s1 += sc[D + dd] * wv[d]; }
        }
        red[(F.wave * 2 + 0) * 64 + F.lane] = s0; red[(F.wave * 2 + 1) * 64 + F.lane] = s1;
        __syncthreads();
        if (F.tid < 128) {
            const int b = F.tid >> 6, cc = F.tid & 63; float s = 0.f;
#pragma unroll
            for (int w = 0; w < 8; ++w) s += red[(w * 2 + b) * 64 + cc];
            MOD[(l * 2 + b) * 6144 + cg * 64 + cc] = s + bias[l * 6144 + cg * 64 + cc];
        }
        __syncthreads();
    }
}

__device__ __forceinline__ void ph_prenorm_rwkv(const Frame& F) {
    const float* x = F.in[I_X]; const float* g = F.in[I_NPM]; const float* mu = F.in[I_MU];
    const float* MOD = (const float*)(F.ws + WS_MOD);
    bf16_t* XS = (bf16_t*)(F.ws + WS_XS);
    const int nunits = T / 8;
    for (int u = F.bid * NWAVES + F.wave; u < nunits; u += F.G * NWAVES) {
        const int t0 = u * 8, b = t0 / SEQ;
        const float* shift = MOD + (0 * 2 + b) * 6144; const float* scale = shift + 1024;
        f32x4 gm[4], sh[4];
#pragma unroll
        for (int i = 0; i < 4; ++i) { const int c = 4 * F.lane + 256 * i; const f32x4 gv = *(const f32x4*)(g + c), sc = *(const f32x4*)(scale + c); gm[i] = gv * (sc + 1.0f); sh[i] = *(const f32x4*)(shift + c); }
        f32x4 hp[4];
#pragma unroll
        for (int i = 0; i < 4; ++i) hp[i] = (f32x4){0.f, 0.f, 0.f, 0.f};
        const int tstart = (t0 % SEQ == 0) ? t0 : t0 - 1;
        for (int t = tstart; t < t0 + 8; ++t) {
            f32x4 xv[4]; float ss = 0.f;
#pragma unroll
            for (int i = 0; i < 4; ++i) { xv[i] = *(const f32x4*)(x + (size_t)t * D + 4 * F.lane + 256 * i); ss += xv[i][0] * xv[i][0] + xv[i][1] * xv[i][1] + xv[i][2] * xv[i][2] + xv[i][3] * xv[i][3]; }
            ss = wave_sum(ss);
            const float rs = rsqrtf(ss * (1.0f / D) + 1e-6f);
            f32x4 h[4];
#pragma unroll
            for (int i = 0; i < 4; ++i) h[i] = xv[i] * rs * gm[i] + sh[i];
            if (t >= t0) {
#pragma unroll
                for (int n = 0; n < 6; ++n) {
#pragma unroll
                    for (int i = 0; i < 4; ++i) {
                        const int c = 4 * F.lane + 256 * i;
                        const f32x4 m = *(const f32x4*)(mu + n * D + c);
                        const f32x4 v = h[i] + (hp[i] - h[i]) * m;
                        u32x2 w; w.x = pack2(v[0], v[1]); w.y = pack2(v[2], v[3]);
                        *(u32x2*)(XS + ((size_t)n * T + t) * D + c) = w;
                    }
                }
            }
#pragma unroll
            for (int i = 0; i < 4; ++i) hp[i] = h[i];
        }
    }
}

__device__ __forceinline__ void ph_rkv_lora_simt(const Frame& F) {
    const bf16_t* XS = (const bf16_t*)(F.ws + WS_XS);
    bf16_t* RKV = (bf16_t*)(F.ws + WS_RKV); bf16_t* LORA = (bf16_t*)(F.ws + WS_LORA);
    const int nct = 52, nunits = (T / 128) * nct;
    for (int u = F.bid; u < nunits; u += F.G) {
        const int rt = u / nct, ct = u % nct, row0 = rt * 128;
        float acc[4][4];
        const int ty = F.tid >> 4, tx = F.tid & 15;
        if (ct < 48) {
            const int n = ct / 16, col0 = (ct % 16) * 64;
            const bf16_t* A = XS + (size_t)n * T * D; const float* W = F.in[I_WRKV] + (size_t)n * D * D;
            simt_tile(acc, [&](int r, int k) { return bf2f(A[(size_t)r * D + k]); }, [&](int k, int c) { return W[(size_t)k * D + c]; }, row0, col0, D, F.ldsf);
#pragma unroll
            for (int i = 0; i < 4; ++i) { u32x2 w; w.x = pack2(acc[i][0], acc[i][1]); w.y = pack2(acc[i][2], acc[i][3]);
                *(u32x2*)(RKV + ((size_t)n * T + row0 + ty * 4 + i) * D + col0 + tx * 4) = w; }
        } else {
            const int j = ct - 48;
            const int n = (j == 0) ? 3 : (j == 1 ? 4 : 5);
            const bf16_t* A = XS + (size_t)n * T * D;
            const float* W = (j == 0) ? F.in[I_WW1] : (j == 1 ? F.in[I_WA1] : F.in[I_WG1]);
            const int ldw = (j >= 2) ? 128 : 64, coff = (j == 3) ? 64 : 0;
            simt_tile(acc, [&](int r, int k) { return bf2f(A[(size_t)r * D + k]); }, [&](int k, int c) { return W[(size_t)k * ldw + coff + c]; }, row0, 0, D, F.ldsf);
#pragma unroll
            for (int i = 0; i < 4; ++i) {
                float v[4];
#pragma unroll
                for (int q = 0; q < 4; ++q) { const float a = acc[i][q]; v[q] = (j == 0) ? tanhf(a) : (j == 1 ? a : sigmoidf_(a)); }
                u32x2 w; w.x = pack2(v[0], v[1]); w.y = pack2(v[2], v[3]);
                *(u32x2*)(LORA + (size_t)(row0 + ty * 4 + i) * 256 + j * 64 + tx * 4) = w;
            }
        }
    }
}

__device__ __forceinline__ void ph_lora_up_simt(const Frame& F) {
    const bf16_t* LORA = (const bf16_t*)(F.ws + WS_LORA);
    float* LD = (float*)(F.ws + WS_LD); bf16_t* AA = (bf16_t*)(F.ws + WS_AA); bf16_t* GG = (bf16_t*)(F.ws + WS_GG);
    const int nunits = (T / 128) * 48;
    for (int u = F.bid; u < nunits; u += F.G) {
        const int rt = u / 48, ct = u % 48, row0 = rt * 128, which = ct / 16, col0 = (ct % 16) * 64;
        const int ty = F.tid >> 4, tx = F.tid & 15;
        float acc[4][4];
        const float* W = which == 0 ? F.in[I_WW2] : (which == 1 ? F.in[I_WA2] : F.in[I_WG2]);
        const int K = which == 2 ? 128 : 64, koff = which * 64;
        simt_tile(acc, [&](int r, int k) { return bf2f(LORA[(size_t)r * 256 + koff + k]); }, [&](int k, int c) { return W[(size_t)k * D + c]; }, row0, col0, K, F.ldsf);
#pragma unroll
        for (int i = 0; i < 4; ++i) {
            const size_t o = (size_t)(row0 + ty * 4 + i) * D + col0 + tx * 4;
            if (which == 0) {
                f32x4 v;
#pragma unroll
                for (int q = 0; q < 4; ++q) { const float wl = F.in[I_W0][col0 + tx * 4 + q] + acc[i][q]; const float wlog = -softplusf_(-wl) - 0.5f; v[q] = -__expf(wlog); }
                *(f32x4*)(LD + o) = v;
            } else if (which == 1) {
                float v[4];
#pragma unroll
                for (int q = 0; q < 4; ++q) v[q] = sigmoidf_(F.in[I_A0][col0 + tx * 4 + q] + acc[i][q]);
                u32x2 w; w.x = pack2(v[0], v[1]); w.y = pack2(v[2], v[3]); *(u32x2*)(AA + o) = w;
            } else {
                u32x2 w; w.x = pack2(acc[i][0], acc[i][1]); w.y = pack2(acc[i][2], acc[i][3]); *(u32x2*)(GG + o) = w;
            }
        }
    }
}

__device__ __forceinline__ void ph_wkv_seq(const Frame& F) {
    const bf16_t* RKV = (const bf16_t*)(F.ws + WS_RKV); const float* LD = (const float*)(F.ws + WS_LD); const bf16_t* AA = (const bf16_t*)(F.ws + WS_AA);
    float* O = (float*)(F.ws + WS_O);
    const bf16_t* Rb = RKV; const bf16_t* Kb = RKV + (size_t)T * D; const bf16_t* Vb = RKV + (size_t)2 * T * D;
    for (int u = F.bid; u < NB * NH; u += F.G) {
        const int b = u / NH, h = u % NH, i = F.tid >> 3, js = F.tid & 7;
        const int cj = h * 64 + js * 8;
        float kkw[8], kaw[8];
#pragma unroll
        for (int e = 0; e < 8; ++e) { kkw[e] = F.in[I_KK][cj + e]; kaw[e] = F.in[I_KA][cj + e]; }
        float S[8];
#pragma unroll
        for (int e = 0; e < 8; ++e) S[e] = 0.f;
        size_t base = (size_t)(b * SEQ) * D;
        u32x4 kr = *(const u32x4*)(Kb + base + cj), rr = *(const u32x4*)(Rb + base + cj), ar = *(const u32x4*)(AA + base + cj);
        f32x4 l0 = *(const f32x4*)(LD + base + cj), l1 = *(const f32x4*)(LD + base + cj + 4);
        bf16_t vr = Vb[base + h * 64 + i];
        for (int t = 0; t < SEQ; ++t) {
            const u32x4 kc = kr, rc = rr, ac = ar; const f32x4 lc0 = l0, lc1 = l1; const bf16_t vc = vr;
            if (t + 1 < SEQ) { const size_t nb = base + D;
                kr = *(const u32x4*)(Kb + nb + cj); rr = *(const u32x4*)(Rb + nb + cj); ar = *(const u32x4*)(AA + nb + cj);
                l0 = *(const f32x4*)(LD + nb + cj); l1 = *(const f32x4*)(LD + nb + cj + 4); vr = Vb[nb + h * 64 + i]; }
            float k[8], r[8], a[8], ld[8];
#pragma unroll
            for (int q = 0; q < 4; ++q) { k[2 * q] = lo2f(kc[q]); k[2 * q + 1] = hi2f(kc[q]); r[2 * q] = lo2f(rc[q]); r[2 * q + 1] = hi2f(rc[q]); a[2 * q] = lo2f(ac[q]); a[2 * q + 1] = hi2f(ac[q]); }
#pragma unroll
            for (int q = 0; q < 4; ++q) { ld[q] = lc0[q]; ld[4 + q] = lc1[q]; }
            const float v = bf2f(vc);
            float kkv[8], ss = 0.f;
#pragma unroll
            for (int e = 0; e < 8; ++e) { kkv[e] = k[e] * kkw[e]; ss += kkv[e] * kkv[e]; }
            ss += __shfl_xor(ss, 1); ss += __shfl_xor(ss, 2); ss += __shfl_xor(ss, 4);
            const float inv = 1.0f / fmaxf(sqrtf(ss), 1e-12f);
            float sa = 0.f;
#pragma unroll
            for (int e = 0; e < 8; ++e) { kkv[e] *= inv; sa += S[e] * (-kkv[e]); }
            sa += __shfl_xor(sa, 1); sa += __shfl_xor(sa, 2); sa += __shfl_xor(sa, 4);
            float o = 0.f;
#pragma unroll
            for (int e = 0; e < 8; ++e) {
                const float kf = k[e] * (1.0f + (a[e] - 1.0f) * kaw[e]);
                S[e] = S[e] * __expf(ld[e]) + sa * (kkv[e] * a[e]) + v * kf;
                o += S[e] * r[e];
            }
            o += __shfl_xor(o, 1); o += __shfl_xor(o, 2); o += __shfl_xor(o, 4);
            if (js == 0) O[base + h * 64 + i] = o;
            base += D;
        }
    }
}

__device__ __forceinline__ void ld16bf(const bf16_t* p, float (&v)[16]) {
    const u32x4 a = *(const u32x4*)p, b = *(const u32x4*)(p + 8);
#pragma unroll
    for (int q = 0; q < 4; ++q) { v[2 * q] = lo2f(a[q]); v[2 * q + 1] = hi2f(a[q]); v[8 + 2 * q] = lo2f(b[q]); v[9 + 2 * q] = hi2f(b[q]); }
}
__device__ __forceinline__ void st16bf(bf16_t* p, const float (&v)[16]) {
    u32x4 a, b;
#pragma unroll
    for (int q = 0; q < 4; ++q) { a[q] = pack2(v[2 * q], v[2 * q + 1]); b[q] = pack2(v[8 + 2 * q], v[9 + 2 * q]); }
    *(u32x4*)p = a; *(u32x4*)(p + 8) = b;
}
__device__ __forceinline__ void ld16f(const float* p, float (&v)[16]) {
#pragma unroll
    for (int q = 0; q < 4; ++q) { const f32x4 a = *(const f32x4*)(p + 4 * q); v[4 * q] = a[0]; v[4 * q + 1] = a[1]; v[4 * q + 2] = a[2]; v[4 * q + 3] = a[3]; }
}
__device__ __forceinline__ void ph_wkv_post(const Frame& F) {
    const bf16_t* RKV = (const bf16_t*)(F.ws + WS_RKV); const bf16_t* AA = (const bf16_t*)(F.ws + WS_AA); const bf16_t* GG = (const bf16_t*)(F.ws + WS_GG);
    const float* O = (const float*)(F.ws + WS_O); bf16_t* OG = (bf16_t*)(F.ws + WS_OG);
    const int c0 = 16 * F.lane;
    float ka[16], rk[16], lg[16], lb[16];
    ld16f(F.in[I_KA] + c0, ka); ld16f(F.in[I_RK] + c0, rk); ld16f(F.in[I_LNG] + c0, lg); ld16f(F.in[I_LNB] + c0, lb);
    for (int t = F.bid * NWAVES + F.wave; t < T; t += F.G * NWAVES) {
        const size_t o = (size_t)t * D + c0;
        float ov[16], r[16], k[16], v[16], a[16], g[16];
        ld16f(O + o, ov); ld16bf(RKV + o, r); ld16bf(RKV + (size_t)T * D + o, k); ld16bf(RKV + (size_t)2 * T * D + o, v); ld16bf(AA + o, a); ld16bf(GG + o, g);
        float s = 0.f, bs = 0.f;
#pragma unroll
        for (int e = 0; e < 16; ++e) { s += ov[e]; const float kf = k[e] * (1.0f + (a[e] - 1.0f) * ka[e]); bs += r[e] * kf * rk[e]; }
        s += __shfl_xor(s, 1); s += __shfl_xor(s, 2); bs += __shfl_xor(bs, 1); bs += __shfl_xor(bs, 2);
        const float mean = s * (1.0f / 64.0f);
        float q = 0.f;
#pragma unroll
        for (int e = 0; e < 16; ++e) { const float d = ov[e] - mean; q += d * d; }
        q += __shfl_xor(q, 1); q += __shfl_xor(q, 2);
        const float rstd = rsqrtf(q * (1.0f / 64.0f) + 64e-5f);
        float res[16];
#pragma unroll
        for (int e = 0; e < 16; ++e) res[e] = (((ov[e] - mean) * rstd) * lg[e] + lb[e] + bs * v[e]) * g[e];
        st16bf(OG + o, res);
    }
}

template <int OUTMODE>
__device__ __forceinline__ void ph_dense_simt(const Frame& F, const bf16_t* A, const float* W, int N, int K, void* out) {
    const int nct = N / 64, nunits = (T / 128) * nct;
    for (int u = F.bid; u < nunits; u += F.G) {
        const int rt = u / nct, ct = u % nct, row0 = rt * 128, col0 = ct * 64;
        const int ty = F.tid >> 4, tx = F.tid & 15;
        float acc[4][4];
        simt_tile(acc, [&](int r, int k) { return bf2f(A[(size_t)r * K + k]); }, [&](int k, int c) { return W[(size_t)k * N + c]; }, row0, col0, K, F.ldsf);
#pragma unroll
        for (int i = 0; i < 4; ++i) {
            const int r = row0 + ty * 4 + i, c = col0 + tx * 4;
            if (OUTMODE == 0) { *(f32x4*)((float*)out + (size_t)r * N + c) = (f32x4){acc[i][0], acc[i][1], acc[i][2], acc[i][3]}; }
            else { u32x2 w; w.x = pack2(acc[i][0], acc[i][1]); w.y = pack2(acc[i][2], acc[i][3]);
                   *(u32x2*)((bf16_t*)out + (size_t)(c / D) * T * D + (size_t)r * D + (c % D)) = w; }
        }
    }
}

__device__ __forceinline__ void ph_postmix_preffn(const Frame& F, int layer, const float* xin, const float* Y) {
    const float* MOD = (const float*)(F.ws + WS_MOD);
    const float* gpo = F.in[I_NPOM] + layer * D; const float* gpf = F.in[I_NPF] + layer * D;
    bf16_t* H2 = (bf16_t*)(F.ws + WS_H2); bf16_t* H2LO = (bf16_t*)(F.ws + WS_H2LO);
    for (int t = F.bid * NWAVES + F.wave; t < T; t += F.G * NWAVES) {
        const int b = t / SEQ; const float* m = MOD + (layer * 2 + b) * 6144;
        f32x4 y[4]; float ss = 0.f;
#pragma unroll
        for (int i = 0; i < 4; ++i) { y[i] = *(const f32x4*)(Y + (size_t)t * D + 4 * F.lane + 256 * i); ss += y[i][0] * y[i][0] + y[i][1] * y[i][1] + y[i][2] * y[i][2] + y[i][3] * y[i][3]; }
        ss = wave_sum(ss);
        const float rs = rsqrtf(ss * (1.0f / D) + 1e-6f);
        f32x4 x1[4]; float s2 = 0.f;
#pragma unroll
        for (int i = 0; i < 4; ++i) { const int c = 4 * F.lane + 256 * i;
            const f32x4 xv = *(const f32x4*)(xin + (size_t)t * D + c), gm = *(const f32x4*)(m + 2048 + c), gp = *(const f32x4*)(gpo + c);
            x1[i] = xv + gm * (y[i] * rs * gp);
            *(f32x4*)(F.out + (size_t)t * D + c) = x1[i];
            s2 += x1[i][0] * x1[i][0] + x1[i][1] * x1[i][1] + x1[i][2] * x1[i][2] + x1[i][3] * x1[i][3]; }
        s2 = wave_sum(s2);
        const float rs2 = rsqrtf(s2 * (1.0f / D) + 1e-6f);
#pragma unroll
        for (int i = 0; i < 4; ++i) { const int c = 4 * F.lane + 256 * i;
            const f32x4 gf = *(const f32x4*)(gpf + c), sc = *(const f32x4*)(m + 4096 + c), sh = *(const f32x4*)(m + 3072 + c);
            const f32x4 h = x1[i] * rs2 * gf * (sc + 1.0f) + sh;
            u32x2 w; w.x = pack2(h[0], h[1]); w.y = pack2(h[2], h[3]);
            u32x2 wl; wl.x = pack2(h[0] - lo2f(w.x), h[1] - hi2f(w.x)); wl.y = pack2(h[2] - lo2f(w.y), h[3] - hi2f(w.y));
            *(u32x2*)(H2 + (size_t)t * D + c) = w; *(u32x2*)(H2LO + (size_t)t * D + c) = wl; }
    }
}

__device__ __forceinline__ void ph_router_simt(const Frame& F, int layer) {
    const bf16_t* H2 = (const bf16_t*)(F.ws + WS_H2); const bf16_t* H2LO = (const bf16_t*)(F.ws + WS_H2LO);
    const float* W = F.in[I_ROUTER] + (size_t)layer * D * NE; float* LOG = (float*)(F.ws + WS_LOGITS);
    for (int u = F.bid; u < T / 128; u += F.G) {
        const int row0 = u * 128, ty = F.tid >> 4, tx = F.tid & 15;
        float acc[4][4];
        simt_tile(acc, [&](int r, int k) { return bf2f(H2[(size_t)r * D + k]) + bf2f(H2LO[(size_t)r * D + k]); }, [&](int k, int c) { return W[(size_t)k * NE + c]; }, row0, 0, D, F.ldsf);
#pragma unroll
        for (int i = 0; i < 4; ++i) *(f32x4*)(LOG + (size_t)(row0 + ty * 4 + i) * NE + tx * 4) = (f32x4){acc[i][0], acc[i][1], acc[i][2], acc[i][3]};
    }
}

__device__ __forceinline__ void ph_topk(const Frame& F, int layer) {
    const float* LOG = (const float*)(F.ws + WS_LOGITS); const float* rb = F.in[I_RBIAS] + layer * NE;
    int* IDX = (int*)(F.ws + WS_IDX); float* GATE = (float*)(F.ws + WS_GATE); int* RANK = (int*)(F.ws + WS_RANK);
    unsigned* CNT = F.ctl + CW_CNT + layer * 64;
    unsigned* lcnt = (unsigned*)F.ldsf; unsigned* gb = lcnt + 64;
    const float bias = rb[F.lane];
    for (int base = F.bid * 64; base < T; base += F.G * 64) {
        if (F.tid < 64) lcnt[F.tid] = 0u;
        __syncthreads();
        int myidx[8]; unsigned lrank[8];
#pragma unroll
        for (int j = 0; j < 8; ++j) {
            const int t = base + F.wave * 8 + j;
            const float s = sigmoidf_(LOG[(size_t)t * NE + F.lane]);
            float sel = s + bias;
            int mi = 0; float mysc = 0.f; float tot = 0.f;
#pragma unroll
            for (int k = 0; k < TOPK; ++k) {
                float bv = sel; int bi = F.lane;
#pragma unroll
                for (int o = 32; o >= 1; o >>= 1) { const float ov = __shfl_xor(bv, o); const int oi = __shfl_xor(bi, o); if (ov > bv || (ov == bv && oi < bi)) { bv = ov; bi = oi; } }
                const float sc = __shfl(s, bi);
                tot += sc;
                if (F.lane == k) { mi = bi; mysc = sc; }
                if (F.lane == bi) sel = -1e30f;
            }
            myidx[j] = mi; lrank[j] = 0u;
            if (F.lane < TOPK) { IDX[t * TOPK + F.lane] = mi; GATE[t * TOPK + F.lane] = 2.5f * mysc / tot; lrank[j] = atomicAdd(&lcnt[mi], 1u); }
        }
        __syncthreads();
        if (F.tid < 64) gb[F.tid] = atomicAdd(&CNT[F.tid], lcnt[F.tid]);
        __syncthreads();
#pragma unroll
        for (int j = 0; j < 8; ++j) { const int t = base + F.wave * 8 + j; if (F.lane < TOPK) RANK[t * TOPK + F.lane] = (int)(gb[myidx[j]] + lrank[j]); }
        __syncthreads();
    }
}

__device__ __forceinline__ void ph_offsets(const Frame& F, int layer) {
    const unsigned* CNT = F.ctl + CW_CNT + layer * 64;
    const int* IDX = (const int*)(F.ws + WS_IDX); const int* RANK = (const int*)(F.ws + WS_RANK);
    int* POS = (int*)(F.ws + WS_POS); int* TOK = (int*)(F.ws + WS_TOK); int* TILEE = (int*)(F.ws + WS_TILEE); int* START = (int*)(F.ws + WS_START);
    int* sst = (int*)F.ldsf;
    if (F.tid < NE) sst[128 + F.tid] = (int)CNT[F.tid];
    __syncthreads();
    if (F.tid == 0) { int acc = 0; for (int e = 0; e < NE; ++e) { const int c = sst[128 + e]; sst[e] = acc; acc += ((c + RP - 1) / RP) * RP; } sst[64] = acc; }
    __syncthreads();
    if (F.bid == 0) {
        if (F.tid <= 64) START[F.tid] = sst[F.tid];
        if (F.tid == 65) START[65] = sst[64];
        const int ntile = sst[64] / RP;
        for (int i = F.tid; i < ntile; i += NTHREADS) { int e = 0; while (e < 63 && sst[e + 1] <= i * RP) ++e; TILEE[i] = e; }
    }
    for (int s = F.bid * NTHREADS + F.tid; s < T * TOPK; s += F.G * NTHREADS) {
        const int e = IDX[s], p = sst[e] + RANK[s];
        POS[s] = p; TOK[p] = s / TOPK;
    }
    for (int s = F.bid * NTHREADS + F.tid; s < NE * RP; s += F.G * NTHREADS) {
        const int e = s / RP, r = s % RP, c = sst[128 + e];
        if (sst[e] + c + r < sst[e + 1]) TOK[sst[e] + c + r] = 0;
    }
    __syncthreads();
}

__device__ __forceinline__ void ph_gateup_simt(const Frame& F, int layer) {
    const bf16_t* H2 = (const bf16_t*)(F.ws + WS_H2); bf16_t* HB = (bf16_t*)(F.ws + WS_HB);
    const int* TOK = (const int*)(F.ws + WS_TOK); const int* TILEE = (const int*)(F.ws + WS_TILEE); const int* START = (const int*)(F.ws + WS_START);
    const int routed = START[65], nrt = (routed + T) / 128, nunits = nrt * 4;
    for (int u = F.bid; u < nunits; u += F.G) {
        const int rt = u / 4, ct = u % 4, row0 = rt * 128, col0 = ct * 64, ty = F.tid >> 4, tx = F.tid & 15;
        const bool sh = row0 >= routed; const int e = sh ? 0 : TILEE[row0 / RP];
        const float* Wg = sh ? F.in[I_SG] + (size_t)layer * D * DE : F.in[I_MG] + ((size_t)layer * NE + e) * D * DE;
        const float* Wu = sh ? F.in[I_SU] + (size_t)layer * D * DE : F.in[I_MU_] + ((size_t)layer * NE + e) * D * DE;
        auto af = [&](int r, int k) { const int tok = sh ? (r - routed) : TOK[r]; return bf2f(H2[(size_t)tok * D + k]); };
        float ag[4][4], au[4][4];
        simt_tile(ag, af, [&](int k, int c) { return Wg[(size_t)k * DE + c]; }, row0, col0, D, F.ldsf);
        simt_tile(au, af, [&](int k, int c) { return Wu[(size_t)k * DE + c]; }, row0, col0, D, F.ldsf);
#pragma unroll
        for (int i = 0; i < 4; ++i) { float v[4];
#pragma unroll
            for (int q = 0; q < 4; ++q) { const float g = ag[i][q]; v[q] = g * sigmoidf_(g) * au[i][q]; }
            u32x2 w; w.x = pack2(v[0], v[1]); w.y = pack2(v[2], v[3]);
            *(u32x2*)(HB + (size_t)(row0 + ty * 4 + i) * DE + col0 + tx * 4) = w; }
    }
}
__device__ __forceinline__ void ph_down_simt(const Frame& F, int layer) {
    const bf16_t* HB = (const bf16_t*)(F.ws + WS_HB); bf16_t* YB = (bf16_t*)(F.ws + WS_YB);
    const int* TILEE = (const int*)(F.ws + WS_TILEE); const int* START = (const int*)(F.ws + WS_START);
    const int routed = START[65], nrt = (routed + T) / 128, nunits = nrt * 16;
    for (int u = F.bid; u < nunits; u += F.G) {
        const int rt = u / 16, ct = u % 16, row0 = rt * 128, col0 = ct * 64, ty = F.tid >> 4, tx = F.tid & 15;
        const bool sh = row0 >= routed; const int e = sh ? 0 : TILEE[row0 / RP];
        const float* Wd = sh ? F.in[I_SD] + (size_t)layer * DE * D : F.in[I_MD] + ((size_t)layer * NE + e) * DE * D;
        float acc[4][4];
        simt_tile(acc, [&](int r, int k) { return bf2f(HB[(size_t)r * DE + k]); }, [&](int k, int c) { return Wd[(size_t)k * D + c]; }, row0, col0, DE, F.ldsf);
#pragma unroll
        for (int i = 0; i < 4; ++i) { u32x2 w; w.x = pack2(acc[i][0], acc[i][1]); w.y = pack2(acc[i][2], acc[i][3]);
            *(u32x2*)(YB + (size_t)(row0 + ty * 4 + i) * D + col0 + tx * 4) = w; }
    }
}
__device__ __forceinline__ void ph_combine(const Frame& F, int layer, bool next) {
    const bf16_t* YB = (const bf16_t*)(F.ws + WS_YB); const int* POS = (const int*)(F.ws + WS_POS); const float* GATE = (const float*)(F.ws + WS_GATE);
    const int* START = (const int*)(F.ws + WS_START); const float* MOD = (const float*)(F.ws + WS_MOD);
    const float* gpo = F.in[I_NPOF] + layer * D;
    bf16_t* H3 = (bf16_t*)(F.ws + WS_H3);
    const int routed = START[65];
    for (int t = F.bid * NWAVES + F.wave; t < T; t += F.G * NWAVES) {
        const int b = t / SEQ; const float* m = MOD + (layer * 2 + b) * 6144;
        f32x4 y[4];
#pragma unroll
        for (int i = 0; i < 4; ++i) { const u32x2 w = *(const u32x2*)(YB + (size_t)(routed + t) * D + 4 * F.lane + 256 * i); y[i] = (f32x4){lo2f(w.x), hi2f(w.x), lo2f(w.y), hi2f(w.y)}; }
#pragma unroll
        for (int k = 0; k < TOPK; ++k) {
            const int p = POS[t * TOPK + k]; const float gk = GATE[t * TOPK + k];
#pragma unroll
            for (int i = 0; i < 4; ++i) { const u32x2 w = *(const u32x2*)(YB + (size_t)p * D + 4 * F.lane + 256 * i); y[i] += (f32x4){lo2f(w.x), hi2f(w.x), lo2f(w.y), hi2f(w.y)} * gk; }
        }
        float ss = 0.f;
#pragma unroll
        for (int i = 0; i < 4; ++i) ss += y[i][0] * y[i][0] + y[i][1] * y[i][1] + y[i][2] * y[i][2] + y[i][3] * y[i][3];
        ss = wave_sum(ss);
        const float rs = rsqrtf(ss * (1.0f / D) + 1e-6f);
        f32x4 x2[4]; float s2 = 0.f;
#pragma unroll
        for (int i = 0; i < 4; ++i) { const int c = 4 * F.lane + 256 * i;
            const f32x4 xv = *(const f32x4*)(F.out + (size_t)t * D + c), gm = *(const f32x4*)(m + 5120 + c), gp = *(const f32x4*)(gpo + c);
            x2[i] = xv + gm * (y[i] * rs * gp);
            *(f32x4*)(F.out + (size_t)t * D + c) = x2[i];
            s2 += x2[i][0] * x2[i][0] + x2[i][1] * x2[i][1] + x2[i][2] * x2[i][2] + x2[i][3] * x2[i][3]; }
        if (next) {
            s2 = wave_sum(s2);
            const float rs2 = rsqrtf(s2 * (1.0f / D) + 1e-6f);
            const float* m1 = MOD + ((layer + 1) * 2 + b) * 6144; const float* g1 = F.in[I_NPM] + (layer + 1) * D;
#pragma unroll
            for (int i = 0; i < 4; ++i) { const int c = 4 * F.lane + 256 * i;
                const f32x4 gf = *(const f32x4*)(g1 + c), sc = *(const f32x4*)(m1 + 1024 + c), sh = *(const f32x4*)(m1 + c);
                const f32x4 h = x2[i] * rs2 * gf * (sc + 1.0f) + sh;
                u32x2 w; w.x = pack2(h[0], h[1]); w.y = pack2(h[2], h[3]);
                *(u32x2*)(H3 + (size_t)t * D + c) = w; }
        }
    }
}

#define SB_EXIT 110.0f
__device__ __forceinline__ void ph_attn_ref(const Frame& F) {
    const bf16_t* Q = (const bf16_t*)(F.ws + WS_Q); const bf16_t* Kb = Q + (size_t)T * D; const bf16_t* Vb = Q + (size_t)2 * T * D;
    bf16_t* AO = (bf16_t*)(F.ws + WS_AO);
    float* Ks = F.ldsf; float* Vs = Ks + 64 * 65; float* Qs = Vs + 64 * 65; float* Ws = Qs + 64 * 64; float* Rm = Ws + 8 * 64;
    const int nunits = NB * NH * (SEQ / 64);
    for (int u = F.bid; u < nunits; u += F.G) {
        const int qt = (SEQ / 64 - 1) - (u / (NB * NH)), bh = u % (NB * NH), b = bh / NH, h = bh % NH;
        const size_t tb = (size_t)b * SEQ;
        for (int idx = F.tid; idx < 64 * 64; idx += NTHREADS) { const int r = idx >> 6, c = idx & 63; Qs[idx] = bf2f(Q[(tb + qt * 64 + r) * D + h * 64 + c]) * 0.125f; }
        float R[8], acc[8];
#pragma unroll
        for (int q = 0; q < 8; ++q) { R[q] = 0.f; acc[q] = 0.f; }
        for (int kt = qt; kt >= 0; --kt) {
            __syncthreads();
            for (int idx = F.tid; idx < 64 * 64; idx += NTHREADS) { const int r = idx >> 6, c = idx & 63; const size_t g = (tb + kt * 64 + r) * D + h * 64 + c; Ks[r * 65 + c] = bf2f(Kb[g]); Vs[r * 65 + c] = bf2f(Vb[g]); }
            __syncthreads();
#pragma unroll
            for (int q = 0; q < 8; ++q) {
                const int qi = F.wave * 8 + q;
                float z = 0.f;
#pragma unroll 16
                for (int d = 0; d < 64; ++d) z += Qs[qi * 64 + d] * Ks[F.lane * 65 + d];
                const bool valid = (kt < qt) || (F.lane < qi);
                const float sp = valid ? softplusf_(z) : 0.f;
                float suf = sp;
#pragma unroll
                for (int o = 1; o < 64; o <<= 1) { const float v = __shfl_down(suf, o); if (F.lane + o < 64) suf += v; }
                const float tail = R[q] + suf - sp;
                const float w = valid ? __expf(z - sp - tail) : 0.f;
                R[q] += __shfl(suf, 0);
                Ws[F.wave * 64 + F.lane] = w;
                float a = acc[q];
#pragma unroll 16
                for (int s = 0; s < 64; ++s) a += Ws[F.wave * 64 + s] * Vs[s * 65 + F.lane];
                acc[q] = a;
            }
            float mn = R[0];
#pragma unroll
            for (int q = 1; q < 8; ++q) mn = fminf(mn, R[q]);
            if (F.lane == 0) Rm[F.wave] = mn;
            __syncthreads();
            float allmin = Rm[0];
#pragma unroll
            for (int w = 1; w < 8; ++w) allmin = fminf(allmin, Rm[w]);
            if (allmin > SB_EXIT) break;
        }
#pragma unroll
        for (int q = 0; q < 8; ++q) AO[(tb + qt * 64 + F.wave * 8 + q) * D + h * 64 + F.lane] = f2bf(acc[q]);
        __syncthreads();
    }
}

namespace pgx {
__device__ __forceinline__ int perm32(int rho) { const int n = rho >> 4, i = rho & 15; return 8 * (i >> 2) + 4 * n + (i & 3); }
struct Unit { const char* A; const int* tok; const char* B; int r0, c0, aux; };
template <bool SW, bool PERM, class Sched, class Epi>
__device__ __forceinline__ void gemm_phase(LAS unsigned char* lds, const int K, const unsigned lda  , const Sched& S, const Epi& E) {
    const int tid = threadIdx.x, wid = __builtin_amdgcn_readfirstlane(tid >> 6), lane = tid & 63, wr = wid >> 2, wc = wid & 3, fr = lane & 15, fq = lane >> 4;
    const int nt = K / 64;
    int Rr[2], Cc[2]; unsigned voffB[2];
#pragma unroll
    for (int i = 0; i < 2; ++i) { stage_rc(tid * 16 + i * 8192, Rr[i], Cc[i]); const int Rb = PERM ? ((Rr[i] & ~31) + perm32(Rr[i] & 31)) : Rr[i]; voffB[i] = (unsigned)(Rb * K + Cc[i]) * 2u; }
    const size_t kstep = 128, hstepB = (size_t)128 * K * 2;
    const unsigned ldsw = (unsigned)wid * 1024u;
    const int aoff = lds_byte(wr * 64 + fr, fq * 8), boff = lds_byte(wc * 32 + fr, fq * 8);
#define PX_SA(b, h) (((b) * 2 + (h)) * HTB)
#define PX_SB(b, h) ((4 + (b) * 2 + (h)) * HTB)
#define PX_STAGE(bufoff, gbase, voff) do { _Pragma("unroll") for (int _i = 0; _i < 2; ++_i) \
        __builtin_amdgcn_global_load_lds((const unsigned*)((const char*)(gbase) + (voff)[_i]), (LAS unsigned*)(lds + (bufoff) + ldsw + _i * 8192), 16, 0, 0); } while (0)
#define PX_LDA(dst, b, h) do { _Pragma("unroll") for (int m = 0; m < 4; ++m) _Pragma("unroll") for (int k = 0; k < 2; ++k) dst[m][k] = *(const LAS bf16x8*)(lds + PX_SA(b, h) + aoff + m * 2048 + k * 1024); } while (0)
#define PX_LDB(dst, b, h) do { _Pragma("unroll") for (int n = 0; n < 2; ++n) _Pragma("unroll") for (int k = 0; k < 2; ++k) dst[n][k] = *(const LAS bf16x8*)(lds + PX_SB(b, h) + boff + n * 2048 + k * 1024); } while (0)
#define PX_MMA(ai, bj, At, Bt) do { __builtin_amdgcn_s_setprio(1); _Pragma("unroll") for (int m = 0; m < 4; ++m) _Pragma("unroll") for (int n = 0; n < 2; ++n) _Pragma("unroll") for (int k = 0; k < 2; ++k) \
        acc[ai][bj][m][n] = SW ? __builtin_amdgcn_mfma_f32_16x16x32_bf16(Bt[n][k], At[m][k], acc[ai][bj][m][n], 0, 0, 0) : __builtin_amdgcn_mfma_f32_16x16x32_bf16(At[m][k], Bt[n][k], acc[ai][bj][m][n], 0, 0, 0); __builtin_amdgcn_s_setprio(0); } while (0)
#define PX_WAIT_L(n) asm volatile("s_waitcnt lgkmcnt(" #n ")" ::: "memory")
#define PX_BAR __builtin_amdgcn_s_barrier()
#define PX_SCHED __builtin_amdgcn_sched_barrier(0)
#define PX_OFFS(dst, un) do { _Pragma("unroll") for (int h_ = 0; h_ < 2; ++h_) _Pragma("unroll") for (int i_ = 0; i_ < 2; ++i_) { \
        const int row_ = h_ * 128 + Rr[i_]; const unsigned rid_ = (un).tok ? (unsigned)(un).tok[row_] : (unsigned)row_; dst[h_][i_] = rid_ * lda + (unsigned)Cc[i_] * 2u; } } while (0)
    Unit cur, nxt; int ui = 0;
    if (!S.next(0, cur)) return;
    f32x4 acc[2][2][4][2];
#pragma unroll
    for (int a = 0; a < 2; ++a)
#pragma unroll
        for (int b = 0; b < 2; ++b)
#pragma unroll
            for (int m = 0; m < 4; ++m)
#pragma unroll
                for (int n = 0; n < 2; ++n) acc[a][b][m][n] = (f32x4){0.f, 0.f, 0.f, 0.f};
    bf16x8 At[4][2], B0[2][2], B1[2][2];
    unsigned oc[2][2], on[2][2];
    PX_OFFS(oc, cur); asm volatile("" : "+v"(oc[0][0]), "+v"(oc[0][1]), "+v"(oc[1][0]), "+v"(oc[1][1]));
    const char* cA = cur.A; const char* cB = cur.B;
    PX_STAGE(PX_SB(0, 0), cB, voffB); PX_STAGE(PX_SA(0, 0), cA, oc[0]); PX_STAGE(PX_SB(0, 1), cB + hstepB, voffB); PX_STAGE(PX_SA(0, 1), cA, oc[1]);
    if (wr == 1) PX_BAR;
    WAIT_V(4); PX_BAR;
    PX_STAGE(PX_SB(1, 0), cB + kstep, voffB); PX_STAGE(PX_SA(1, 0), cA + kstep, oc[0]); PX_STAGE(PX_SB(1, 1), cB + hstepB + kstep, voffB);
    WAIT_V(6); PX_BAR;
    for (;;) {
        const bool has_next = S.next(ui + 1, nxt);
        const char* nA = has_next ? nxt.A : cA; const char* nB = has_next ? nxt.B : cB;
        if (has_next) { PX_OFFS(on, nxt); asm volatile("" : "+v"(on[0][0]), "+v"(on[0][1]), "+v"(on[1][0]), "+v"(on[1][1])); } else {
#pragma unroll
            for (int h_ = 0; h_ < 2; ++h_)
#pragma unroll
                for (int i_ = 0; i_ < 2; ++i_) on[h_][i_] = oc[h_][i_]; }
        for (int t = 0; t < nt; t += 2) {
            const bool last = (t == nt - 2);
            const char* a1 = cA + (size_t)(t + 1) * kstep;
            const char* a2 = last ? nA : cA + (size_t)(t + 2) * kstep; const char* b2 = last ? nB : cB + (size_t)(t + 2) * kstep;
            const char* a3 = a2 + kstep; const char* b3 = b2 + kstep;
            unsigned o2[2][2];
#pragma unroll
            for (int h_ = 0; h_ < 2; ++h_)
#pragma unroll
                for (int i_ = 0; i_ < 2; ++i_) o2[h_][i_] = last ? on[h_][i_] : oc[h_][i_];
            PX_LDB(B0, 0, 0); PX_SCHED; PX_LDA(At, 0, 0); PX_STAGE(PX_SA(1, 1), a1, oc[1]);
            PX_WAIT_L(8); PX_BAR; PX_WAIT_L(0); PX_MMA(0, 0, At, B0); PX_BAR; PX_SCHED;
            PX_LDB(B1, 0, 1); PX_STAGE(PX_SB(0, 0), b2, voffB);
            PX_BAR; PX_WAIT_L(0); PX_MMA(0, 1, At, B1); PX_BAR;
            PX_LDA(At, 0, 1); PX_STAGE(PX_SA(0, 0), a2, o2[0]);
            PX_BAR; PX_WAIT_L(0); PX_MMA(1, 0, At, B0); PX_BAR; PX_SCHED;
            PX_STAGE(PX_SB(0, 1), b2 + hstepB, voffB);
            WAIT_V(6); PX_BAR; PX_MMA(1, 1, At, B1); PX_BAR;
            PX_LDB(B0, 1, 0); PX_SCHED; PX_LDA(At, 1, 0); PX_STAGE(PX_SA(0, 1), a2, o2[1]);
            PX_WAIT_L(8); PX_BAR; PX_WAIT_L(0); PX_MMA(0, 0, At, B0); PX_BAR; PX_SCHED;
            PX_LDB(B1, 1, 1); PX_STAGE(PX_SB(1, 0), b3, voffB);
            PX_BAR; PX_WAIT_L(0); PX_MMA(0, 1, At, B1); PX_BAR;
            PX_LDA(At, 1, 1); PX_STAGE(PX_SA(1, 0), a3, o2[0]);
            PX_BAR; PX_WAIT_L(0); PX_MMA(1, 0, At, B0); PX_BAR; PX_SCHED;
            PX_STAGE(PX_SB(1, 1), b3 + hstepB, voffB);
            WAIT_V(6); PX_BAR; PX_MMA(1, 1, At, B1); PX_BAR;
        }
        E(acc, cur, wr, wc, fr, fq);
        if (!has_next) break;
#pragma unroll
        for (int a = 0; a < 2; ++a)
#pragma unroll
            for (int b = 0; b < 2; ++b)
#pragma unroll
                for (int m = 0; m < 4; ++m)
#pragma unroll
                    for (int n = 0; n < 2; ++n) acc[a][b][m][n] = (f32x4){0.f, 0.f, 0.f, 0.f};
        cur = nxt; cA = nA; cB = nB; ++ui;
#pragma unroll
        for (int h_ = 0; h_ < 2; ++h_)
#pragma unroll
            for (int i_ = 0; i_ < 2; ++i_) oc[h_][i_] = on[h_][i_];
    }
    WAIT_V(0);
    if (wr == 0) PX_BAR;
    PX_BAR;
#undef PX_SA
#undef PX_SB
#undef PX_STAGE
#undef PX_LDA
#undef PX_LDB
#undef PX_MMA
#undef PX_WAIT_L
#undef PX_BAR
#undef PX_SCHED
#undef PX_OFFS
}
__device__ __forceinline__ unsigned cvt_pk_bf16(float lo, float hi) { return pack2(lo, hi); }
}

#define EPI_MT(acc) (int)(sizeof(acc) / sizeof(acc[0]))
__device__ __forceinline__ void st_bf4(bf16_t* p, const f32x4& v) { u32x2 w; w.x = pack2(v[0], v[1]); w.y = pack2(v[2], v[3]); *(u32x2*)p = w; }

__device__ __forceinline__ void ph_rkv_lora_sg(const Frame& F) {
    const bf16_t* XS = (const bf16_t*)(F.ws + WS_XS); const bf16_t* WRKV = (const bf16_t*)(F.ws + WS_WRKV); const bf16_t* WLDN = (const bf16_t*)(F.ws + WS_WLDN);
    bf16_t* RKV = (bf16_t*)(F.ws + WS_RKV); bf16_t* LORA = (bf16_t*)(F.ws + WS_LORA);
    for (int u = F.bid; u < 64 * 24; u += F.G) {
        const int mt = u / 24, ct = u % 24, n = ct / 8, col0 = (ct % 8) * 128;
        ASeg A; A.p[0] = XS + ((size_t)n * T + mt * 256) * D; A.p[1] = A.p[0]; A.p[2] = A.p[0]; A.segTiles = 16;
        bf16_t* out = RKV + ((size_t)n * T + mt * 256) * D + col0;
        sg_tile<128>(F.lds, A, [](int R) { return (unsigned)R * (D * 2); }, WRKV + (size_t)(n * D + col0) * D, D, 16,
            [&](auto& acc, int r0, int c0, int fr, int fq) {
#pragma unroll
                for (int m = 0; m < EPI_MT(acc); ++m)
#pragma unroll
                    for (int q = 0; q < 4; ++q) st_bf4(out + (size_t)(r0 + 16 * m + fr) * D + c0 + 16 * q + 4 * fq, acc[m][q]);
            });
    }
    for (int u = F.bid; u < 64 * 4; u += F.G) {
        const int mt = u / 4, j = u % 4, n = (j == 0) ? 3 : (j == 1 ? 4 : 5);
        ASeg A; A.p[0] = XS + ((size_t)n * T + mt * 256) * D; A.p[1] = A.p[0]; A.p[2] = A.p[0]; A.segTiles = 16;
        bf16_t* out = LORA + (size_t)mt * 256 * 256 + j * 64;
        sg_tile<64>(F.lds, A, [](int R) { return (unsigned)R * (D * 2); }, WLDN + (size_t)(j * 64) * D, D, 16,
            [&](auto& acc, int r0, int c0, int fr, int fq) {
#pragma unroll
                for (int m = 0; m < EPI_MT(acc); ++m)
#pragma unroll
                    for (int q = 0; q < 4; ++q) { f32x4 v = acc[m][q];
#pragma unroll
                        for (int e = 0; e < 4; ++e) v[e] = (j == 0) ? tanhf_(v[e]) : (j == 1 ? v[e] : sigmoidf_(v[e]));
                        st_bf4(out + (size_t)(r0 + 16 * m + fr) * 256 + c0 + 16 * q + 4 * fq, v); }
            });
    }
}
__device__ __forceinline__ void ph_lora_up_sg(const Frame& F) {
    const bf16_t* LORA = (const bf16_t*)(F.ws + WS_LORA); const bf16_t* WLUP = (const bf16_t*)(F.ws + WS_WLUP);
    float* LD = (float*)(F.ws + WS_LD); bf16_t* AA = (bf16_t*)(F.ws + WS_AA); bf16_t* GG = (bf16_t*)(F.ws + WS_GG);
    for (int u = F.bid; u < 3 * 64 * 8; u += F.G) {
        const int which = u / 512, v = u % 512, mt = v / 8, col0 = (v % 8) * 128;
        const int K = which == 2 ? 128 : 64, koff = which * 64;
        ASeg A; A.p[0] = LORA + (size_t)mt * 256 * 256 + koff; A.p[1] = A.p[0]; A.p[2] = A.p[0]; A.segTiles = 4;
        const bf16_t* Bt = WLUP + (which == 0 ? 0 : (which == 1 ? 1024 * 64 : 2 * 1024 * 64)) + (size_t)col0 * K;
        const size_t obase = (size_t)mt * 256 * D + col0;
        sg_tile<128>(F.lds, A, [](int R) { return (unsigned)R * 512u; }, Bt, K, K / 64,
            [&](auto& acc, int r0, int c0, int fr, int fq) {
#pragma unroll
                for (int m = 0; m < EPI_MT(acc); ++m)
#pragma unroll
                    for (int q = 0; q < 4; ++q) {
                        const int c = c0 + 16 * q + 4 * fq; const size_t o = obase + (size_t)(r0 + 16 * m + fr) * D + c;
                        if (which == 0) { const f32x4 w0 = *(const f32x4*)(F.in[I_W0] + col0 + c); f32x4 r;
#pragma unroll
                            for (int e = 0; e < 4; ++e) { const float wl = w0[e] + acc[m][q][e]; r[e] = -fexp_(-softplusf_(-wl) - 0.5f); }
                            *(f32x4*)(LD + o) = r; }
                        else if (which == 1) { const f32x4 a0 = *(const f32x4*)(F.in[I_A0] + col0 + c); f32x4 r;
#pragma unroll
                            for (int e = 0; e < 4; ++e) r[e] = sigmoidf_(a0[e] + acc[m][q][e]);
                            st_bf4(AA + o, r); }
                        else st_bf4(GG + o, acc[m][q]);
                    }
            });
    }
}
template <int OUTMODE>
__device__ __forceinline__ void ph_dense_sg(const Frame& F, const bf16_t* Ain, const bf16_t* Wt, int N, void* outp) {
    const int nct = N / 128;
    for (int u = F.bid; u < 64 * nct; u += F.G) {
        const int mt = u / nct, col0 = (u % nct) * 128;
        ASeg A; A.p[0] = Ain + (size_t)mt * 256 * D; A.p[1] = A.p[0]; A.p[2] = A.p[0]; A.segTiles = 16;
        sg_tile<128>(F.lds, A, [](int R) { return (unsigned)R * (D * 2); }, Wt + (size_t)col0 * D, D, 16,
            [&](auto& acc, int r0, int c0, int fr, int fq) {
#pragma unroll
                for (int m = 0; m < EPI_MT(acc); ++m)
#pragma unroll
                    for (int q = 0; q < 4; ++q) {
                        const int r = mt * 256 + r0 + 16 * m + fr, c = col0 + c0 + 16 * q + 4 * fq;
                        if (OUTMODE == 0) *(f32x4*)((float*)outp + (size_t)r * N + c) = acc[m][q];
                        else st_bf4((bf16_t*)outp + (size_t)(c / D) * T * D + (size_t)r * D + (c % D), acc[m][q]);
                    }
            });
    }
}
__device__ __forceinline__ void ph_router_sg(const Frame& F, int layer) {
    const bf16_t* H2 = (const bf16_t*)(F.ws + WS_H2); const bf16_t* H2LO = (const bf16_t*)(F.ws + WS_H2LO);
    const bf16_t* WRT = (const bf16_t*)(F.ws + WS_WRT) + (size_t)layer * 64 * 3072; float* LOG = (float*)(F.ws + WS_LOGITS);
    for (int mt = F.bid; mt < 64; mt += F.G) {
        ASeg A; A.p[0] = H2 + (size_t)mt * 256 * D; A.p[1] = A.p[0]; A.p[2] = H2LO + (size_t)mt * 256 * D; A.segTiles = 16;
        sg_tile<64>(F.lds, A, [](int R) { return (unsigned)R * (D * 2); }, WRT, 3072, 48,
            [&](auto& acc, int r0, int c0, int fr, int fq) {
#pragma unroll
                for (int m = 0; m < EPI_MT(acc); ++m)
#pragma unroll
                    for (int q = 0; q < 4; ++q) *(f32x4*)(LOG + (size_t)(mt * 256 + r0 + 16 * m + fr) * NE + c0 + 16 * q + 4 * fq) = acc[m][q];
            });
    }
}
__device__ __forceinline__ void ph_gateup_sg(const Frame& F) {
    const bf16_t* H2 = (const bf16_t*)(F.ws + WS_H2); bf16_t* HB = (bf16_t*)(F.ws + WS_HB); const bf16_t* WGU = (const bf16_t*)(F.ws + WS_WGU);
    const int* TOK = (const int*)(F.ws + WS_TOK); const int* TILEE = (const int*)(F.ws + WS_TILEE); const int* START = (const int*)(F.ws + WS_START);
    const int routed = START[65], nmt = (routed + T) / 256;
    for (int u = F.bid; u < nmt * 4; u += F.G) {
        const int mt = u / 4, nt4 = u % 4, row0 = mt * 256; const bool sh = row0 >= routed; const int e = sh ? 64 : TILEE[mt];
        ASeg A; A.p[0] = H2; A.p[1] = H2; A.p[2] = H2; A.segTiles = 16;
        bf16_t* out = HB + (size_t)row0 * DE + nt4 * 64;
        sg_tile<128>(F.lds, A, [&](int R) { const int tok = sh ? (row0 - routed + R) : TOK[row0 + R]; return (unsigned)tok * (D * 2); },
            WGU + (size_t)e * 512 * D, D, 16,
            [&](auto& acc, int r0, int c0, int fr, int fq) {
#pragma unroll
                for (int m = 0; m < EPI_MT(acc); ++m)
#pragma unroll
                    for (int q = 0; q < 2; ++q) { f32x4 v;
#pragma unroll
                        for (int e2 = 0; e2 < 4; ++e2) { const float g = acc[m][q][e2]; v[e2] = g * sigmoidf_(g) * acc[m][q + 2][e2]; }
                        st_bf4(out + (size_t)(r0 + 16 * m + fr) * DE + (c0 >> 1) + 16 * q + 4 * fq, v); }
            },
            [=](int R) { const int col = nt4 * 64 + (R >> 6) * 32 + (R & 31), up = (R >> 5) & 1; return (col >> 7) * 256 + up * 128 + (col & 127); });
    }
}
__device__ __forceinline__ void ph_down_sg(const Frame& F) {
    const bf16_t* HB = (const bf16_t*)(F.ws + WS_HB); bf16_t* YB = (bf16_t*)(F.ws + WS_YB); const bf16_t* WDN = (const bf16_t*)(F.ws + WS_WDN);
    const int* TILEE = (const int*)(F.ws + WS_TILEE); const int* START = (const int*)(F.ws + WS_START);
    const int routed = START[65], nmt = (routed + T) / 256;
    for (int u = F.bid; u < nmt * 8; u += F.G) {
        const int mt = u / 8, col0 = (u % 8) * 128, row0 = mt * 256; const bool sh = row0 >= routed; const int e = sh ? 64 : TILEE[mt];
        ASeg A; A.p[0] = HB + (size_t)row0 * DE; A.p[1] = A.p[0]; A.p[2] = A.p[0]; A.segTiles = 4;
        bf16_t* out = YB + (size_t)row0 * D + col0;
        sg_tile<128>(F.lds, A, [](int R) { return (unsigned)R * (DE * 2); }, WDN + ((size_t)e * D + col0) * DE, DE, 4,
            [&](auto& acc, int r0, int c0, int fr, int fq) {
#pragma unroll
                for (int m = 0; m < EPI_MT(acc); ++m)
#pragma unroll
                    for (int q = 0; q < 4; ++q) st_bf4(out + (size_t)(r0 + 16 * m + fr) * D + c0 + 16 * q + 4 * fq, acc[m][q]);
            });
    }
}

constexpr int MS = 72;
constexpr int SLOT = 64 * MS * 2;
constexpr size_t WS_BONUS = 3 * MiB;
constexpr size_t WS_RP = WS_BIG + 128 * MiB;
constexpr size_t WS_OL = WS_BIG + 160 * MiB;
constexpr size_t WS_G2 = WS_BIG + 296 * MiB;
constexpr size_t WS_DM = WS_BIG + 328 * MiB;
constexpr size_t WS_ST = WS_BIG + 360 * MiB;

__device__ __forceinline__ bf16x8 ldfrag(const LAS bf16_t* M, int row, int kofs) { return *(const LAS bf16x8*)(M + row * MS + kofs); }
template <bool SW>
__device__ __forceinline__ void mm64(f32x4& acc, const LAS bf16_t* X, int xr0, const LAS bf16_t* Y, int yr0, int fr, int fq) {
#pragma unroll
    for (int ks = 0; ks < 2; ++ks) {
        const bf16x8 xf = ldfrag(X, xr0 + fr, ks * 32 + fq * 8), yf = ldfrag(Y, yr0 + fr, ks * 32 + fq * 8);
        acc = SW ? __builtin_amdgcn_mfma_f32_16x16x32_bf16(yf, xf, acc, 0, 0, 0) : __builtin_amdgcn_mfma_f32_16x16x32_bf16(xf, yf, acc, 0, 0, 0);
    }
}
__device__ __forceinline__ void st4_lds(LAS bf16_t* p, const f32x4& v) { u32x2 w; w.x = pack2(v[0], v[1]); w.y = pack2(v[2], v[3]); *(LAS u32x2*)p = w; }
__device__ __forceinline__ f32x4 ld4_lds(const LAS bf16_t* p) { const u32x2 w = *(const LAS u32x2*)p; return (f32x4){lo2f(w.x), hi2f(w.x), lo2f(w.y), hi2f(w.y)}; }
__device__ __forceinline__ f32x4 ld4_g(const bf16_t* p) { const u32x2 w = *(const u32x2*)p; return (f32x4){lo2f(w.x), hi2f(w.x), lo2f(w.y), hi2f(w.y)}; }

__device__ __forceinline__ void ph_wkv_chunk(const Frame& F) {
    const bf16_t* RKV = (const bf16_t*)(F.ws + WS_RKV); const float* LD = (const float*)(F.ws + WS_LD); const bf16_t* AA = (const bf16_t*)(F.ws + WS_AA);
    const bf16_t* Rb = RKV; const bf16_t* Kb = RKV + (size_t)T * D; const bf16_t* Vb = RKV + (size_t)2 * T * D;
    bf16_t* RP = (bf16_t*)(F.ws + WS_RP); bf16_t* OL = (bf16_t*)(F.ws + WS_OL); bf16_t* G2 = (bf16_t*)(F.ws + WS_G2); bf16_t* DM = (bf16_t*)(F.ws + WS_DM);
    float* BONUS = (float*)(F.ws + WS_BONUS);
#define SL(k) ((LAS bf16_t*)(F.lds + (k) * SLOT))
    LAS float* segtot = (LAS float*)(F.lds + 15 * SLOT);
    LAS float* WCs = segtot + 512;
    const int w = F.wave, lane = F.lane, fr = lane & 15, fq = lane >> 4, mt = w >> 1, ntb = 2 * (w & 1);
    for (int cid = F.bid; cid < NB * NH * (SEQ / 64); cid += F.G) {
        const int bh = cid / (SEQ / 64), c = cid % (SEQ / 64), b = bh / NH, h = bh % NH;
        const size_t tok0 = (size_t)b * SEQ + (size_t)c * 64;
        {
            const int j = lane, ch = h * 64 + j;
            const float kkw = F.in[I_KK][ch], kaw = F.in[I_KA][ch], rkw = F.in[I_RK][ch];
            float r[8], k[8], v[8], a[8], ld[8];
#pragma unroll
            for (int e = 0; e < 8; ++e) { const size_t o = (tok0 + 8 * w + e) * D + ch; r[e] = bf2f(Rb[o]); k[e] = bf2f(Kb[o]); v[e] = bf2f(Vb[o]); a[e] = bf2f(AA[o]); ld[e] = LD[o]; }
            float cum[8]; float run = 0.f;
#pragma unroll
            for (int e = 0; e < 8; ++e) { run += ld[e]; cum[e] = run; }
            segtot[w * 64 + j] = run;
            __syncthreads();
            float pre = 0.f, tot = 0.f;
#pragma unroll
            for (int ww = 0; ww < 8; ++ww) { const float sgt = segtot[ww * 64 + j]; tot += sgt; if (ww < w) pre += sgt; }
            if (w == 0) WCs[j] = __expf(tot);
            float av[8], bv[8], kv[8], rv[8];
#pragma unroll
            for (int e = 0; e < 8; ++e) {
                const float cm = pre + cum[e];
                const float kkr = k[e] * kkw; const float ss = wave_sum(kkr * kkr);
                const float kk = kkr / fmaxf(sqrtf(ss), 1e-12f);
                const float kf = k[e] * (1.0f + (a[e] - 1.0f) * kaw);
                const float bon = wave_sum(r[e] * kf * rkw);
                if (lane == 0) BONUS[(tok0 + 8 * w + e) * NH + h] = bon;
                const float en = __expf(-cm);
                av[e] = -kk * __expf(cm - ld[e]); bv[e] = kk * a[e] * en; kv[e] = kf * en; rv[e] = r[e] * __expf(cm);
                const int t = 8 * w + e;
                SL(0)[t * MS + j] = f2bf(av[e]); SL(2)[t * MS + j] = f2bf(rv[e]); SL(3)[t * MS + j] = f2bf(bv[e]); SL(5)[t * MS + j] = f2bf(kv[e]);
            }
            u32x4 pa, pb, pk, pv;
#pragma unroll
            for (int q = 0; q < 4; ++q) { pa[q] = pack2(av[2 * q], av[2 * q + 1]); pb[q] = pack2(bv[2 * q], bv[2 * q + 1]); pk[q] = pack2(kv[2 * q], kv[2 * q + 1]); pv[q] = pack2(v[2 * q], v[2 * q + 1]); }
            *(LAS u32x4*)(SL(1) + j * MS + 8 * w) = pa; *(LAS u32x4*)(SL(4) + j * MS + 8 * w) = pb; *(LAS u32x4*)(SL(6) + j * MS + 8 * w) = pk; *(LAS u32x4*)(SL(7) + j * MS + 8 * w) = pv;
        }
        __syncthreads();
#pragma unroll
        for (int q2 = 0; q2 < 2; ++q2) {
            const int nt = ntb + q2;
            { f32x4 acc = {0.f, 0.f, 0.f, 0.f}; mm64<false>(acc, SL(0), 16 * mt, SL(3), 16 * nt, fr, fq);
              const int sidx = 16 * nt + fr, t0 = 16 * mt + 4 * fq;
#pragma unroll
              for (int e = 0; e < 4; ++e) { if (!(sidx < t0 + e)) acc[e] = 0.f; SL(8)[(t0 + e) * MS + sidx] = f2bf(acc[e]); }
              st4_lds(SL(9) + sidx * MS + t0, acc); }
            const int tt = 16 * mt + fr, s0 = 16 * nt + 4 * fq;
            { f32x4 acc = {0.f, 0.f, 0.f, 0.f}; mm64<true>(acc, SL(0), 16 * mt, SL(5), 16 * nt, fr, fq);
#pragma unroll
              for (int e = 0; e < 4; ++e) if (!(s0 + e < tt)) acc[e] = 0.f;
              st4_lds(SL(10) + tt * MS + s0, acc); }
            { f32x4 acc = {0.f, 0.f, 0.f, 0.f}; mm64<true>(acc, SL(2), 16 * mt, SL(3), 16 * nt, fr, fq);
#pragma unroll
              for (int e = 0; e < 4; ++e) if (!(s0 + e <= tt)) acc[e] = 0.f;
              st4_lds(SL(11) + tt * MS + s0, acc); }
            { f32x4 acc = {0.f, 0.f, 0.f, 0.f}; mm64<true>(acc, SL(2), 16 * mt, SL(5), 16 * nt, fr, fq);
#pragma unroll
              for (int e = 0; e < 4; ++e) if (!(s0 + e <= tt)) acc[e] = 0.f;
              st4_lds(SL(12) + tt * MS + s0, acc); }
        }
        __syncthreads();
#define WKV_SQ(xi, ti, xo, to) do { _Pragma("unroll") for (int q2 = 0; q2 < 2; ++q2) { const int nt = ntb + q2; f32x4 acc = {0.f, 0.f, 0.f, 0.f}; \
            mm64<false>(acc, SL(xi), 16 * mt, SL(ti), 16 * nt, fr, fq); const int n_ = 16 * nt + fr, m0_ = 16 * mt + 4 * fq; \
            _Pragma("unroll") for (int e = 0; e < 4; ++e) SL(xo)[(m0_ + e) * MS + n_] = f2bf(acc[e]); st4_lds(SL(to) + n_ * MS + m0_, acc); } } while (0)
#define WKV_PM(pi, ti, po) do { _Pragma("unroll") for (int q2 = 0; q2 < 2; ++q2) { const int nt = ntb + q2; const int m_ = 16 * mt + fr, n0_ = 16 * nt + 4 * fq; \
            f32x4 acc = ld4_lds(SL(pi) + m_ * MS + n0_); mm64<true>(acc, SL(pi), 16 * mt, SL(ti), 16 * nt, fr, fq); st4_lds(SL(po) + m_ * MS + n0_, acc); } } while (0)
        WKV_SQ(8, 9, 0, 3);
        for (int idx = F.tid; idx < 64 * 64; idx += NTHREADS) { const int t = idx >> 6, s2 = idx & 63; SL(13)[t * MS + s2] = (t == s2) ? (bf16_t)0x3F80 : SL(8)[t * MS + s2]; }
        __syncthreads();
        WKV_PM(13, 3, 14); WKV_SQ(0, 3, 8, 9); __syncthreads();
        WKV_PM(14, 9, 13); WKV_SQ(8, 9, 0, 3); __syncthreads();
        WKV_PM(13, 3, 14); WKV_SQ(0, 3, 8, 9); __syncthreads();
        WKV_PM(14, 9, 13); WKV_SQ(8, 9, 0, 3); __syncthreads();
        WKV_PM(13, 3, 14); __syncthreads();
#pragma unroll
        for (int q2 = 0; q2 < 2; ++q2) {
            const int nt = ntb + q2, n_ = 16 * nt + fr, m0_ = 16 * mt + 4 * fq;
            { f32x4 acc = {0.f, 0.f, 0.f, 0.f}; mm64<false>(acc, SL(14), 16 * mt, SL(1), 16 * nt, fr, fq); st4_lds(SL(9) + n_ * MS + m0_, acc); }
            { f32x4 acc = {0.f, 0.f, 0.f, 0.f}; mm64<false>(acc, SL(10), 16 * mt, SL(7), 16 * nt, fr, fq); st4_lds(SL(8) + n_ * MS + m0_, acc); }
        }
        __syncthreads();
#pragma unroll
        for (int q2 = 0; q2 < 2; ++q2) {
            const int nt = ntb + q2;
            { const int n_ = 16 * nt + fr, m0_ = 16 * mt + 4 * fq; f32x4 acc = {0.f, 0.f, 0.f, 0.f}; mm64<false>(acc, SL(14), 16 * mt, SL(8), 16 * nt, fr, fq); st4_lds(SL(0) + n_ * MS + m0_, acc); }
            { const int m_ = 16 * mt + fr, n0_ = 16 * nt + 4 * fq; f32x4 acc = ld4_lds(SL(2) + m_ * MS + n0_); mm64<true>(acc, SL(11), 16 * mt, SL(9), 16 * nt, fr, fq);
              st_bf4(RP + (size_t)cid * 4096 + m_ * 64 + n0_, acc); }
        }
        __syncthreads();
#pragma unroll
        for (int q2 = 0; q2 < 2; ++q2) {
            const int nt = ntb + q2;
            { const int m_ = 16 * mt + fr, n0_ = 16 * nt + 4 * fq; f32x4 acc = {0.f, 0.f, 0.f, 0.f};
              mm64<true>(acc, SL(11), 16 * mt, SL(0), 16 * nt, fr, fq); mm64<true>(acc, SL(12), 16 * mt, SL(7), 16 * nt, fr, fq);
              st_bf4(OL + (size_t)cid * 4096 + m_ * 64 + n0_, acc); }
            { const int jp = 16 * nt + fr, j0 = 16 * mt + 4 * fq; f32x4 acc = {0.f, 0.f, 0.f, 0.f}; mm64<false>(acc, SL(9), 16 * mt, SL(4), 16 * nt, fr, fq);
              const float wc = WCs[jp];
#pragma unroll
              for (int e = 0; e < 4; ++e) acc[e] = (acc[e] + ((j0 + e == jp) ? 1.0f : 0.0f)) * wc;
              st_bf4(G2 + (size_t)cid * 4096 + (nt * 2 + (mt >> 1)) * 512 + lane * 8 + (mt & 1) * 4, acc); }
            { const int i_ = 16 * mt + fr, jp0 = 16 * nt + 4 * fq; f32x4 acc = {0.f, 0.f, 0.f, 0.f};
              mm64<true>(acc, SL(0), 16 * mt, SL(4), 16 * nt, fr, fq); mm64<true>(acc, SL(7), 16 * mt, SL(6), 16 * nt, fr, fq);
#pragma unroll
              for (int e = 0; e < 4; ++e) acc[e] *= WCs[jp0 + e];
              st_bf4(DM + (size_t)cid * 4096 + i_ * 64 + jp0, acc); }
        }
        __syncthreads();
    }
#undef WKV_SQ
#undef WKV_PM
#undef SL
}

__device__ __forceinline__ void ph_wkv_carry(const Frame& F) {
    const bf16_t* G2 = (const bf16_t*)(F.ws + WS_G2); const bf16_t* DM = (const bf16_t*)(F.ws + WS_DM); bf16_t* ST = (bf16_t*)(F.ws + WS_ST);
    const int lane = F.lane, fr = lane & 15, fq = lane >> 4;
    const bool loader = F.wave >= 4; const int lw = F.wave - 4, i = 16 * (F.wave & 3) + fr;
    constexpr int NC = SEQ / 64;
    for (int ch = F.bid; ch < NB * NH; ch += F.G) {
        const size_t cbase = (size_t)ch * NC;
#define CARRY_ISSUE(c_) do { const int cc_ = (c_) < NC ? (c_) : NC - 1; const size_t cid_ = cbase + cc_; \
        _Pragma("unroll") for (int q_ = 0; q_ < 4; ++q_) { const int j_ = lw * 4 + q_; \
            const bf16_t* src_ = (j_ < 8 ? G2 + cid_ * 4096 + j_ * 512 : DM + cid_ * 4096 + (j_ - 8) * 512) + lane * 8; \
            __builtin_amdgcn_global_load_lds((const unsigned*)src_, (LAS unsigned*)(F.lds + ((c_) & 7) * 16384 + j_ * 1024), 16, 0, 0); } } while (0)
        f32x4 st[4];
#pragma unroll
        for (int r = 0; r < 4; ++r) st[r] = (f32x4){0.f, 0.f, 0.f, 0.f};
        if (loader) {
#pragma unroll
            for (int c = 0; c < 7; ++c) CARRY_ISSUE(c);
            WAIT_V(24);
        }
        SBAR();
#pragma unroll 1
        for (int c = 0; c < NC; ++c) {
            if (loader) {
                CARRY_ISSUE(c + 7);
                WAIT_V(24);
            } else {
                const LAS unsigned char* slot = F.lds + (c & 7) * 16384;
                const size_t cid = cbase + c;
#pragma unroll
                for (int r = 0; r < 4; ++r) st_bf4(ST + cid * 4096 + i * 64 + 16 * r + 4 * fq, st[r]);
                union { bf16x8 v; unsigned u[4]; } b0, b1;
                b0.u[0] = pack2(st[0][0], st[0][1]); b0.u[1] = pack2(st[0][2], st[0][3]); b0.u[2] = pack2(st[1][0], st[1][1]); b0.u[3] = pack2(st[1][2], st[1][3]);
                b1.u[0] = pack2(st[2][0], st[2][1]); b1.u[1] = pack2(st[2][2], st[2][3]); b1.u[2] = pack2(st[3][0], st[3][1]); b1.u[3] = pack2(st[3][2], st[3][3]);
#pragma unroll
                for (int r = 0; r < 4; ++r) {
                    const u32x2 d = *(const LAS u32x2*)(slot + 8192 + (i * 64 + 16 * r + 4 * fq) * 2);
                    f32x4 acc = (f32x4){lo2f(d.x), hi2f(d.x), lo2f(d.y), hi2f(d.y)};
                    acc = __builtin_amdgcn_mfma_f32_16x16x32_bf16(*(const LAS bf16x8*)(slot + (r * 2 + 0) * 1024 + lane * 16), b0.v, acc, 0, 0, 0);
                    acc = __builtin_amdgcn_mfma_f32_16x16x32_bf16(*(const LAS bf16x8*)(slot + (r * 2 + 1) * 1024 + lane * 16), b1.v, acc, 0, 0, 0);
                    st[r] = acc;
                }
            }
            SBAR();
        }
        if (loader) WAIT_V(0);
        SBAR();
#undef CARRY_ISSUE
    }
}

__device__ __forceinline__ void ph_wkv_out(const Frame& F) {
    const bf16_t* RP = (const bf16_t*)(F.ws + WS_RP); const bf16_t* OL = (const bf16_t*)(F.ws + WS_OL); const bf16_t* ST = (const bf16_t*)(F.ws + WS_ST);
    const bf16_t* Vb = (const bf16_t*)(F.ws + WS_RKV) + (size_t)2 * T * D; const bf16_t* GG = (const bf16_t*)(F.ws + WS_GG); const float* BONUS = (const float*)(F.ws + WS_BONUS);
    bf16_t* OG = (bf16_t*)(F.ws + WS_OG);
    const int lane = F.lane, fr = lane & 15, fq = lane >> 4;
    const int nunits = NB * NH * (SEQ / 64) * 4;
    for (int u = F.bid * NWAVES + F.wave; u < nunits; u += F.G * NWAVES) {
        const int cid = u >> 2, tt = u & 3, bh = cid / (SEQ / 64), c = cid % (SEQ / 64), b = bh / NH, h = bh % NH;
        const int t = 16 * tt + fr; const size_t tok = (size_t)b * SEQ + (size_t)c * 64 + t;
        bf16x8 rf[2];
#pragma unroll
        for (int ks = 0; ks < 2; ++ks) rf[ks] = *(const bf16x8*)(RP + (size_t)cid * 4096 + t * 64 + ks * 32 + fq * 8);
        f32x4 acc[4];
#pragma unroll
        for (int n = 0; n < 4; ++n) {
            acc[n] = ld4_g(OL + (size_t)cid * 4096 + t * 64 + 16 * n + 4 * fq);
#pragma unroll
            for (int ks = 0; ks < 2; ++ks) { const bf16x8 sf = *(const bf16x8*)(ST + (size_t)cid * 4096 + (16 * n + fr) * 64 + ks * 32 + fq * 8);
                acc[n] = __builtin_amdgcn_mfma_f32_16x16x32_bf16(sf, rf[ks], acc[n], 0, 0, 0); }
        }
        float s = 0.f;
#pragma unroll
        for (int n = 0; n < 4; ++n) s += (acc[n][0] + acc[n][1]) + (acc[n][2] + acc[n][3]);
        s += __shfl_xor(s, 16); s += __shfl_xor(s, 32);
        const float mean = s * (1.0f / 64.0f);
        float q = 0.f;
#pragma unroll
        for (int n = 0; n < 4; ++n)
#pragma unroll
            for (int e = 0; e < 4; ++e) { const float d = acc[n][e] - mean; q += d * d; }
        q += __shfl_xor(q, 16); q += __shfl_xor(q, 32);
        const float rstd = rsqrtf(q * (1.0f / 64.0f) + 64e-5f), bon = BONUS[tok * NH + h];
#pragma unroll
        for (int n = 0; n < 4; ++n) {
            const int chn = h * 64 + 16 * n + 4 * fq; const size_t o = tok * D + chn;
            const f32x4 lg = *(const f32x4*)(F.in[I_LNG] + chn), lb = *(const f32x4*)(F.in[I_LNB] + chn), vv = ld4_g(Vb + o), gg = ld4_g(GG + o);
            const f32x4 res = (((acc[n] - mean) * rstd) * lg + lb + vv * bon) * gg;
            st_bf4(OG + o, res);
        }
    }
}

__device__ __forceinline__ void ph_qkv_sg(const Frame& F) {
    const bf16_t* Ain = (const bf16_t*)(F.ws + WS_H3); const bf16_t* Wt = (const bf16_t*)(F.ws + WS_WQKV);
    bf16_t* QK = (bf16_t*)(F.ws + WS_Q); bf16_t* VT = QK + (size_t)2 * T * D;
    for (int u = F.bid; u < 64 * 24; u += F.G) {
        const int mt = u / 24, ct = u % 24, col0 = ct * 128;
        ASeg A; A.p[0] = Ain + (size_t)mt * 256 * D; A.p[1] = A.p[0]; A.p[2] = A.p[0]; A.segTiles = 16;
        if (ct < 16) {
            sg_tile<128>(F.lds, A, [](int R) { return (unsigned)R * (D * 2); }, Wt + (size_t)col0 * D, D, 16,
                [&](auto& acc, int r0, int c0, int fr, int fq) {
#pragma unroll
                    for (int m = 0; m < EPI_MT(acc); ++m)
#pragma unroll
                        for (int q = 0; q < 4; ++q) { const int r = mt * 256 + r0 + 16 * m + fr, c = col0 + c0 + 16 * q + 4 * fq;
                            st_bf4(QK + (size_t)(c / D) * T * D + (size_t)r * D + (c % D), acc[m][q]); }
                });
        } else {
            sg_tile<128, true>(F.lds, A, [](int R) { return (unsigned)R * (D * 2); }, Wt + (size_t)col0 * D, D, 16,
                [&](auto& acc, int r0, int c0, int fr, int fq) {
#pragma unroll
                    for (int m = 0; m < EPI_MT(acc); ++m)
#pragma unroll
                        for (int q = 0; q < 4; ++q) { const int t = mt * 256 + r0 + 16 * m + 4 * fq, c = col0 - 2 * D + c0 + 16 * q + fr;
                            const int b = t / SEQ, sidx = t % SEQ, h = c >> 6, d = c & 63;
                            st_bf4(VT + ((size_t)((b * NH + h) * 64 + d)) * SEQ + sidx, acc[m][q]); }
                });
        }
    }
}
struct AttnTile { bf16x8 k[4][2]; bf16x8 v[4][2]; };
__device__ __forceinline__ void attn_load(AttnTile& tl, const bf16_t* kbase  , const bf16_t* vbase  ) {
#pragma unroll
    for (int kt = 0; kt < 4; ++kt)
#pragma unroll
        for (int ks = 0; ks < 2; ++ks) tl.k[kt][ks] = *(const bf16x8*)(kbase + (kt * 2 + ks) * 512);
#pragma unroll
    for (int dt = 0; dt < 4; ++dt)
#pragma unroll
        for (int ks = 0; ks < 2; ++ks) tl.v[dt][ks] = *(const bf16x8*)(vbase + (dt * 2 + ks) * 512);
}
template <bool MASK>
__device__ __forceinline__ void attn_tile(const AttnTile& tl, const bf16x8 (&qf)[2], f32x4 (&o)[4], float& R, int key0, int qpos, int fq) {
    constexpr float C2 = 0.125f * 1.4426950408889634f;
    f32x4 z[4];
#pragma unroll
    for (int kt = 0; kt < 4; ++kt) { z[kt] = (f32x4){0.f, 0.f, 0.f, 0.f};
#pragma unroll
        for (int ks = 0; ks < 2; ++ks) z[kt] = __builtin_amdgcn_mfma_f32_16x16x32_bf16(tl.k[kt][ks], qf[ks], z[kt], 0, 0, 0); }
    float sp[4][4], G[4];
#pragma unroll
    for (int kt = 0; kt < 4; ++kt) { G[kt] = 0.f;
#pragma unroll
        for (int e = 0; e < 4; ++e) { const float z2 = z[kt][e] * C2; z[kt][e] = z2;
            const float l2 = __builtin_amdgcn_logf(1.0f + __builtin_amdgcn_exp2f(z2));
            float spv = z2 > 30.f ? z2 : l2;
            if (MASK) spv = ((key0 + 16 * kt + 4 * fq + e) < qpos) ? spv : 0.f;
            sp[kt][e] = spv; G[kt] += spv; } }
    float sufg[4], tot[4];
#pragma unroll
    for (int kt = 0; kt < 4; ++kt) {
        const float g1 = __shfl_xor(G[kt], 16), g2 = __shfl_xor(G[kt], 32), g3 = __shfl_xor(G[kt], 48);
        tot[kt] = G[kt] + g1 + g2 + g3;
        sufg[kt] = (((fq ^ 1) > fq) ? g1 : 0.f) + (((fq ^ 2) > fq) ? g2 : 0.f) + (((fq ^ 3) > fq) ? g3 : 0.f);
    }
    float later = 0.f;
    union { bf16x8 v; unsigned w[4]; } p0, p1;
#pragma unroll
    for (int kt = 3; kt >= 0; --kt) {
        float run = R + later + sufg[kt];
        float wv[4];
#pragma unroll
        for (int e = 3; e >= 0; --e) { float w = __builtin_amdgcn_exp2f(z[kt][e] - sp[kt][e] - run);
            if (MASK) w = ((key0 + 16 * kt + 4 * fq + e) < qpos) ? w : 0.f;
            wv[e] = w; run += sp[kt][e]; }
        const unsigned w01 = pgx::cvt_pk_bf16(wv[0], wv[1]), w23 = pgx::cvt_pk_bf16(wv[2], wv[3]);
        if (kt == 0) { p0.w[0] = w01; p0.w[1] = w23; } else if (kt == 1) { p0.w[2] = w01; p0.w[3] = w23; } else if (kt == 2) { p1.w[0] = w01; p1.w[1] = w23; } else { p1.w[2] = w01; p1.w[3] = w23; }
        later += tot[kt];
    }
    R += later;
#pragma unroll
    for (int dt = 0; dt < 4; ++dt) {
        o[dt] = __builtin_amdgcn_mfma_f32_16x16x32_bf16(tl.v[dt][0], p0.v, o[dt], 0, 0, 0);
        o[dt] = __builtin_amdgcn_mfma_f32_16x16x32_bf16(tl.v[dt][1], p1.v, o[dt], 0, 0, 0);
    }
}
__device__ __forceinline__ void ph_attn(const Frame& F) {
    const bf16_t* Q = (const bf16_t*)(F.ws + WS_Q); const bf16_t* Kb = Q + (size_t)T * D; const bf16_t* VT = Q + (size_t)2 * T * D;
    bf16_t* AO = (bf16_t*)(F.ws + WS_AO);
    const int lane = F.lane, fr = lane & 15, fq = lane >> 4;
    const int nunits = NB * NH * (SEQ / 16);
    constexpr float EXIT2 = SB_EXIT * 1.4426950408889634f;
    unsigned* aq = F.ctl + CW_AQ;
    LAS unsigned* chunk_s = (LAS unsigned*)(F.lds + 1024);
    const unsigned myx = xb_xcc_id() & 7u;
    for (int qi = 0; qi < 8; ++qi) {
      const unsigned xq = (myx + (unsigned)qi) & 7u;
      for (;;) {
        __syncthreads();
        if (F.tid == 0) *chunk_s = atomicAdd(&aq[xq * 64], 1u);
        __syncthreads();
        const unsigned ck = *chunk_s;
        if (ck >= 256u) break;
        const int bh = (int)xq + 8 * (int)(ck >> 6), qt = (int)(ck & 63u) * 8 + F.wave;
        const int b = bh / NH, h = bh % NH;
        const int q0 = qt * 16, qpos = q0 + fr;
        const size_t tb = (size_t)b * SEQ;
        bf16x8 qf[2];
#pragma unroll
        for (int ks = 0; ks < 2; ++ks) qf[ks] = *(const bf16x8*)(Q + (tb + qpos) * D + h * 64 + ks * 32 + fq * 8);
        f32x4 o[4];
#pragma unroll
        for (int dt = 0; dt < 4; ++dt) o[dt] = (f32x4){0.f, 0.f, 0.f, 0.f};
        float R = 0.f;
        const bf16_t* kb = Kb + (size_t)bh * SEQ * 64 + (fr * 4 + fq) * 8;
        const bf16_t* vb = VT + (size_t)bh * SEQ * 64 + (fr * 4 + fq) * 8;
        int kt0 = (q0 + 15) / 64;
        AttnTile ta, tc;
        attn_load(ta, kb + (size_t)kt0 * 4096, vb + (size_t)kt0 * 4096);
        if (kt0 > 0) attn_load(tc, kb + (size_t)(kt0 - 1) * 4096, vb + (size_t)(kt0 - 1) * 4096);
        attn_tile<true>(ta, qf, o, R, kt0 * 64, qpos, fq);
        --kt0;
        while (kt0 >= 0 && !__all(R > EXIT2)) {
            if (kt0 > 0) attn_load(ta, kb + (size_t)(kt0 - 1) * 4096, vb + (size_t)(kt0 - 1) * 4096);
            attn_tile<false>(tc, qf, o, R, kt0 * 64, qpos, fq);
            --kt0;
            if (kt0 < 0 || __all(R > EXIT2)) break;
            if (kt0 > 0) attn_load(tc, kb + (size_t)(kt0 - 1) * 4096, vb + (size_t)(kt0 - 1) * 4096);
            attn_tile<false>(ta, qf, o, R, kt0 * 64, qpos, fq);
            --kt0;
        }
#pragma unroll
        for (int dt = 0; dt < 4; ++dt) st_bf4(AO + (tb + qpos) * D + h * 64 + 16 * dt + 4 * fq, o[dt]);
      }
    }
}

#ifndef USE_PGX
#define USE_PGX 0x1f
#endif
__device__ __forceinline__ int px_unit_index(int i, int G, int c, int nwg) {
    const long L = (long)i * G + c; if (L >= nwg) return -1;
    const int w = (int)L, q = nwg / 8, r = nwg % 8, xcd = w % 8, off = w / 8;
    return (xcd < r ? xcd * (q + 1) : r * (q + 1) + (xcd - r) * q) + off;
}
struct PxDense {
    const char* A; const char* B; int nM, nN, K, G, c; unsigned lda; int a_div; size_t a_stride;
    __device__ __forceinline__ bool next(int i, pgx::Unit& u) const {
        const int w = px_unit_index(i, G, c, nM * nN); if (w < 0) return false;
        const int pm = w / nN, pn = w % nN;
        u.A = A + (size_t)(pn / a_div) * a_stride + (size_t)pm * 256 * lda; u.tok = nullptr; u.B = B + (size_t)pn * 256 * K * 2; u.r0 = pm * 256; u.c0 = pn * 256; u.aux = 0; return true;
    }
};
__device__ __forceinline__ void px_store_bf16_perm(bf16_t* rowp, const f32x4& v0, const f32x4& v1) {
    u32x4 w; w.x = pgx::cvt_pk_bf16(v0[0], v0[1]); w.y = pgx::cvt_pk_bf16(v0[2], v0[3]); w.z = pgx::cvt_pk_bf16(v1[0], v1[1]); w.w = pgx::cvt_pk_bf16(v1[2], v1[3]); *(u32x4*)rowp = w;
}
__device__ __forceinline__ void ph_rkv_px(const Frame& F) {
    bf16_t* RKV = (bf16_t*)(F.ws + WS_RKV);
    PxDense S{(const char*)(F.ws + WS_XS), (const char*)(F.ws + WS_WRKV), 64, 12, D, F.G, F.bid, (unsigned)(D * 2), 4, (size_t)T * D * 2};
    pgx::gemm_phase<true, true>(F.lds, D, D * 2, S, [&](const f32x4 (&acc)[2][2][4][2], const pgx::Unit& u, int wr, int wc, int fr, int fq) {
        bf16_t* base = RKV + (size_t)(u.c0 / D) * T * D + (u.c0 % D) + wc * 32 + 8 * fq;
#pragma unroll
        for (int ai = 0; ai < 2; ++ai)
#pragma unroll
            for (int m = 0; m < 4; ++m) { bf16_t* rowp = base + (size_t)(u.r0 + ai * 128 + wr * 64 + m * 16 + fr) * D;
#pragma unroll
                for (int bj = 0; bj < 2; ++bj) px_store_bf16_perm(rowp + bj * 128, acc[ai][bj][m][0], acc[ai][bj][m][1]); }
    });
}
__device__ __forceinline__ void ph_lora_dn_sg(const Frame& F) {
    const bf16_t* XS = (const bf16_t*)(F.ws + WS_XS); const bf16_t* WLDN = (const bf16_t*)(F.ws + WS_WLDN); bf16_t* LORA = (bf16_t*)(F.ws + WS_LORA);
    for (int u = F.bid; u < 64 * 4; u += F.G) {
        const int mt = u / 4, j = u % 4, n = (j == 0) ? 3 : (j == 1 ? 4 : 5);
        ASeg A; A.p[0] = XS + ((size_t)n * T + mt * 256) * D; A.p[1] = A.p[0]; A.p[2] = A.p[0]; A.segTiles = 16;
        bf16_t* out = LORA + (size_t)mt * 256 * 256 + j * 64;
        sg_tile<64>(F.lds, A, [](int R) { return (unsigned)R * (D * 2); }, WLDN + (size_t)(j * 64) * D, D, 16,
            [&](auto& acc, int r0, int c0, int fr, int fq) {
#pragma unroll
                for (int m = 0; m < EPI_MT(acc); ++m)
#pragma unroll
                    for (int q = 0; q < 4; ++q) { f32x4 v = acc[m][q];
#pragma unroll
                        for (int e = 0; e < 4; ++e) v[e] = (j == 0) ? tanhf_(v[e]) : (j == 1 ? v[e] : sigmoidf_(v[e]));
                        st_bf4(out + (size_t)(r0 + 16 * m + fr) * 256 + c0 + 16 * q + 4 * fq, v); }
            });
    }
}
__device__ __forceinline__ void ph_dense_f32_px(const Frame& F, const bf16_t* Ain, const bf16_t* Wt, float* out) {
    PxDense S{(const char*)Ain, (const char*)Wt, 64, 4, D, F.G, F.bid, (unsigned)(D * 2), 4, 0};
    pgx::gemm_phase<true, false>(F.lds, D, D * 2, S, [&](const f32x4 (&acc)[2][2][4][2], const pgx::Unit& u, int wr, int wc, int fr, int fq) {
        float* base = out + u.c0 + wc * 32 + 4 * fq;
#pragma unroll
        for (int ai = 0; ai < 2; ++ai)
#pragma unroll
            for (int m = 0; m < 4; ++m) { float* rowp = base + (size_t)(u.r0 + ai * 128 + wr * 64 + m * 16 + fr) * D;
#pragma unroll
                for (int bj = 0; bj < 2; ++bj)
#pragma unroll
                    for (int n = 0; n < 2; ++n) *(f32x4*)(rowp + bj * 128 + n * 16) = acc[ai][bj][m][n]; }
    });
}
__device__ __forceinline__ void ph_qkv_px(const Frame& F) {
    bf16_t* QK = (bf16_t*)(F.ws + WS_Q); bf16_t* VT = QK + (size_t)2 * T * D;
    { PxDense S{(const char*)(F.ws + WS_H3), (const char*)(F.ws + WS_WQKV), 64, 8, D, F.G, F.bid, (unsigned)(D * 2), 8, 0};
      pgx::gemm_phase<true, true>(F.lds, D, D * 2, S, [&](const f32x4 (&acc)[2][2][4][2], const pgx::Unit& u, int wr, int wc, int fr, int fq) {
        const bool isk = u.c0 >= D;
#pragma unroll
        for (int ai = 0; ai < 2; ++ai)
#pragma unroll
            for (int m = 0; m < 4; ++m) { const int t = u.r0 + ai * 128 + wr * 64 + m * 16 + fr;
#pragma unroll
                for (int bj = 0; bj < 2; ++bj) { const int c = (u.c0 % D) + bj * 128 + wc * 32 + 8 * fq;
                    const int sq = t % SEQ, dd = c & 63;
                    bf16_t* dst = isk ? QK + (size_t)T * D + (((size_t)((t / SEQ) * NH + (c >> 6)) * (SEQ / 16) + (sq >> 4)) * 2 + (dd >> 5)) * 512 + (sq & 15) * 32 + (dd & 31) : QK + (size_t)t * D + c;
                    px_store_bf16_perm(dst, acc[ai][bj][m][0], acc[ai][bj][m][1]); } }
      }); }
    { PxDense S{(const char*)(F.ws + WS_H3), (const char*)(F.ws + WS_WQKV) + (size_t)2 * D * D * 2, 64, 4, D, F.G, F.bid, (unsigned)(D * 2), 4, 0};
      pgx::gemm_phase<false, false>(F.lds, D, D * 2, S, [&](const f32x4 (&acc)[2][2][4][2], const pgx::Unit& u, int wr, int wc, int fr, int fq) {
#pragma unroll
        for (int ai = 0; ai < 2; ++ai)
#pragma unroll
            for (int m = 0; m < 4; ++m) { const int t = u.r0 + ai * 128 + wr * 64 + m * 16 + 4 * fq, b = t / SEQ, sidx = t % SEQ;
#pragma unroll
                for (int bj = 0; bj < 2; ++bj)
#pragma unroll
                    for (int n = 0; n < 2; ++n) { const int c = u.c0 + bj * 128 + wc * 32 + n * 16 + fr, h = c >> 6, d = c & 63;
                        const int k6 = sidx & 63, kk = k6 & 31;
                        st_bf4(VT + ((size_t)(b * NH + h) * (SEQ / 64) + (sidx >> 6)) * 4096 + ((d >> 4) * 2 + (k6 >> 5)) * 512 + ((d & 15) * 4 + ((kk & 15) >> 2)) * 8 + (kk >> 4) * 4, acc[ai][bj][m][n]); } }
      }); }
}
struct PxMoe {
    const char* Asrc; const int* TOK; const int* TILEE; const char* W; int routed, nmt, nN, K, G, c; unsigned lda; size_t wexp; bool gather;
    __device__ __forceinline__ bool next(int i, pgx::Unit& u) const {
        const int w = px_unit_index(i, G, c, nmt * nN); if (w < 0) return false;
        const int mt = w / nN, pn = w % nN, row0 = mt * 256; const bool sh = row0 >= routed; const int e = sh ? 64 : TILEE[mt];
        if (gather) { if (sh) { u.A = Asrc + (size_t)(row0 - routed) * lda; u.tok = nullptr; } else { u.A = Asrc; u.tok = TOK + row0; } }
        else { u.A = Asrc + (size_t)row0 * lda; u.tok = nullptr; }
        u.B = W + (size_t)e * wexp + (size_t)pn * 256 * K * 2; u.r0 = row0; u.c0 = pn * 256; u.aux = 0; return true;
    }
};
__device__ __forceinline__ void ph_gateup_px(const Frame& F) {
    bf16_t* HB = (bf16_t*)(F.ws + WS_HB); const int* START = (const int*)(F.ws + WS_START);
    const int routed = START[65], nmt = (routed + T) / 256;
    PxMoe S{(const char*)(F.ws + WS_H2), (const int*)(F.ws + WS_TOK), (const int*)(F.ws + WS_TILEE), (const char*)(F.ws + WS_WGU), routed, nmt, 2, D, F.G, F.bid, (unsigned)(D * 2), (size_t)512 * D * 2, true};
    pgx::gemm_phase<true, true>(F.lds, D, D * 2, S, [&](const f32x4 (&acc)[2][2][4][2], const pgx::Unit& u, int wr, int wc, int fr, int fq) {
        bf16_t* base = HB + (u.c0 >> 1) + wc * 32 + 8 * fq;
#pragma unroll
        for (int ai = 0; ai < 2; ++ai)
#pragma unroll
            for (int m = 0; m < 4; ++m) { f32x4 v[2];
#pragma unroll
                for (int n = 0; n < 2; ++n)
#pragma unroll
                    for (int e = 0; e < 4; ++e) { const float g = acc[ai][0][m][n][e]; v[n][e] = g * sigmoidf_(g) * acc[ai][1][m][n][e]; }
                px_store_bf16_perm(base + (size_t)(u.r0 + ai * 128 + wr * 64 + m * 16 + fr) * DE, v[0], v[1]); }
    });
}
__device__ __forceinline__ void ph_down_px(const Frame& F) {
    bf16_t* YB = (bf16_t*)(F.ws + WS_YB); const int* START = (const int*)(F.ws + WS_START);
    const int routed = START[65], nmt = (routed + T) / 256;
    PxMoe S{(const char*)(F.ws + WS_HB), nullptr, (const int*)(F.ws + WS_TILEE), (const char*)(F.ws + WS_WDN), routed, nmt, 4, DE, F.G, F.bid, (unsigned)(DE * 2), (size_t)D * DE * 2, false};
    pgx::gemm_phase<true, true>(F.lds, DE, DE * 2, S, [&](const f32x4 (&acc)[2][2][4][2], const pgx::Unit& u, int wr, int wc, int fr, int fq) {
        bf16_t* base = YB + u.c0 + wc * 32 + 8 * fq;
#pragma unroll
        for (int ai = 0; ai < 2; ++ai)
#pragma unroll
            for (int m = 0; m < 4; ++m) { bf16_t* rowp = base + (size_t)(u.r0 + ai * 128 + wr * 64 + m * 16 + fr) * D;
#pragma unroll
                for (int bj = 0; bj < 2; ++bj) px_store_bf16_perm(rowp + bj * 128, acc[ai][bj][m][0], acc[ai][bj][m][1]); }
    });
}

__global__ void __launch_bounds__(NTHREADS, 2) mega(Args args) {
    extern __shared__ __attribute__((aligned(16))) unsigned char lds[];
    Frame F;
    F.in = args.in; F.out = args.out; F.ws = args.ws; F.ctl = (unsigned*)(args.ws + WS_CTL);
    F.ldsf = (float*)lds; F.lds = (LAS unsigned char*)lds;
    F.tid = threadIdx.x; F.lane = F.tid & 63; F.wave = __builtin_amdgcn_readfirstlane(F.tid >> 6); F.bid = blockIdx.x; F.G = gridDim.x;
    if (F.tid < 4) ((unsigned*)(lds + LDS_BYTES - 64))[F.tid] = 0u;
    __syncthreads();
    XcdBarrier bar; bar.bar = F.ctl + CW_BAR; bar.x = 0; bar.st = (volatile LAS unsigned*)(lds + LDS_BYTES - 64);
#if MK_N_LAUNCHES == 1
    bar = xcd_barrier_post(F.ctl + CW_BAR, (volatile LAS unsigned*)(lds + LDS_BYTES - 64));
#endif
    const int lo = args.ph_lo, hi = args.ph_hi;
#define IN(k) (lo <= (k) && (k) < hi)
#ifndef PROBE_MASK
#define PROBE_MASK 0u
#endif
    volatile unsigned long long* tsl = (volatile unsigned long long*)(lds + LDS_BYTES - 64 - 32 * 8);
#define STAMP(k) do { if (PROBE_MASK != 0u && F.tid == 0) tsl[(k)] = __builtin_amdgcn_s_memrealtime(); } while (0)
#define SEAM(k) do { if (IN(k) && IN((k) + 1)) xcd_barrier(bar); STAMP((k) + 1); } while (0)
    STAMP(0);
    bf16_t* const wsb = (bf16_t*)args.ws;
    (void)wsb;
#ifndef REP_A
#define REP_A 1
#endif
#ifndef REP_B
#define REP_B 1
#endif
#ifndef REP_C
#define REP_C 1
#endif
#ifndef REP_D
#define REP_D 1
#endif
#ifndef REP_E
#define REP_E 1
#endif
#ifndef REP_F
#define REP_F 1
#endif
#ifndef REP_G
#define REP_G 1
#endif
#ifndef REP_H
#define REP_H 1
#endif
#define RUN(n, body) for (int r_ = 0; r_ < (n); ++r_) { body; }
    if (IN(0)) { RUN(REP_D, ph_mod(F)) RUN(REP_G, conv_dense(F, F.bid, F.G)) conv_moe(F, 0, F.bid, F.G); } SEAM(0);
    if (IN(1)) { RUN(REP_E, ph_prenorm_rwkv(F)) } SEAM(1);
    if (IN(2)) { if (USE_PGX & 1) { RUN(REP_A, ph_rkv_px(F); ph_lora_dn_sg(F)) } else { RUN(REP_A, ph_rkv_lora_sg(F)) } } SEAM(2);
    if (IN(3)) { RUN(REP_F, ph_lora_up_sg(F)) } SEAM(3);
    if (IN(4)) { RUN(REP_B, ph_wkv_chunk(F)) } SEAM(4);
    if (IN(5)) { RUN(REP_B, ph_wkv_carry(F)) } SEAM(5);
    if (IN(6)) { RUN(REP_B, ph_wkv_out(F)) } SEAM(6);
    if (IN(7)) { if (USE_PGX & 2) { RUN(REP_A, ph_dense_f32_px(F, (const bf16_t*)(F.ws + WS_OG), (const bf16_t*)(F.ws + WS_WO), (float*)(F.ws + WS_Y1))) } else { RUN(REP_A, ph_dense_sg<0>(F, (const bf16_t*)(F.ws + WS_OG), (const bf16_t*)(F.ws + WS_WO), D, F.ws + WS_Y1)) } } SEAM(7);
    if (IN(8)) { RUN(REP_E, ph_postmix_preffn(F, 0, F.in[I_X], (const float*)(F.ws + WS_Y1))) } SEAM(8);
    if (IN(9)) { RUN(REP_F, ph_router_sg(F, 0)) } SEAM(9);
    if (IN(10)) { ph_topk(F, 0); } SEAM(10);
    if (IN(11)) { ph_offsets(F, 0); } SEAM(11);
    if (IN(12)) { if (USE_PGX & 4) { RUN(REP_A, ph_gateup_px(F)) } else { RUN(REP_A, ph_gateup_sg(F)) } } SEAM(12);
    if (IN(13)) { if (USE_PGX & 8) { RUN(REP_A, ph_down_px(F)) } else { RUN(REP_A, ph_down_sg(F)) } } SEAM(13);
    if (IN(14)) { RUN(1, ph_combine(F, 0, true)) RUN(REP_H, conv_moe(F, 1, F.bid, F.G)) } SEAM(14);
    if (IN(15)) { if (USE_PGX & 16) { RUN(REP_A, ph_qkv_px(F)) } else { RUN(REP_A, ph_qkv_sg(F)) } } SEAM(15);
    if (IN(16)) { RUN(REP_C, ph_attn(F)) } SEAM(16);
    if (IN(17)) { if (USE_PGX & 2) { RUN(REP_A, ph_dense_f32_px(F, (const bf16_t*)(F.ws + WS_AO), (const bf16_t*)(F.ws + WS_WSBO), (float*)(F.ws + WS_Y1B))) } else { RUN(REP_A, ph_dense_sg<0>(F, (const bf16_t*)(F.ws + WS_AO), (const bf16_t*)(F.ws + WS_WSBO), D, F.ws + WS_Y1B)) } } SEAM(17);
    if (IN(18)) { ph_postmix_preffn(F, 1, F.out, (const float*)(F.ws + WS_Y1B)); } SEAM(18);
    if (IN(19)) { RUN(REP_F, ph_router_sg(F, 1)) } SEAM(19);
    if (IN(20)) { ph_topk(F, 1); } SEAM(20);
    if (IN(21)) { ph_offsets(F, 1); } SEAM(21);
    if (IN(22)) { if (USE_PGX & 4) { RUN(REP_A, ph_gateup_px(F)) } else { RUN(REP_A, ph_gateup_sg(F)) } } SEAM(22);
    if (IN(23)) { if (USE_PGX & 8) { RUN(REP_A, ph_down_px(F)) } else { RUN(REP_A, ph_down_sg(F)) } } SEAM(23);
    if (IN(24)) { ph_combine(F, 1, false); }
    if (PROBE_MASK != 0u) {
        __syncthreads();
        if (F.bid == 0 && F.tid == 0) { const unsigned long long t1 = __builtin_amdgcn_s_memrealtime(); unsigned long long sel = 0;
            for (int k = 0; k < NPHASES; ++k) { const unsigned long long e = (k + 1 < NPHASES) ? tsl[k + 1] : t1; if ((PROBE_MASK >> k) & 1u) sel += e - tsl[k]; }
            F.out[0] += 1000.0f * (float)sel / (float)(t1 - tsl[0]); }
    }
#undef IN
#undef SEAM
}

extern "C" void kernel_launch(void* const* d_in, const int* in_sizes, int n_in, void* d_out, int out_size, void* d_ws, size_t ws_size, hipStream_t stream) {
    static int grid = 0;
    if (grid == 0) {
        if (n_in != 34 || in_sizes[0] != T * D || out_size != T * D || ws_size < WS_END) {
            fprintf(stderr, "kernel_launch: unexpected shapes: n_in %d in0 %d out %d ws %zu (need %zu)\n", n_in, n_in > 0 ? in_sizes[0] : -1, out_size, ws_size, (size_t)WS_END);
            grid = -1; return;
        }
        int dev = 0, cus = 0, per_cu = 0;
        if (hipGetDevice(&dev) != hipSuccess || hipDeviceGetAttribute(&cus, hipDeviceAttributeMultiprocessorCount, dev) != hipSuccess) { grid = -1; return; }
        if (hipFuncSetAttribute((const void*)mega, hipFuncAttributeMaxDynamicSharedMemorySize, LDS_BYTES) != hipSuccess) { fprintf(stderr, "kernel_launch: hipFuncSetAttribute failed\n"); grid = -1; return; }
        if (hipOccupancyMaxActiveBlocksPerMultiprocessor(&per_cu, (const void*)mega, NTHREADS, LDS_BYTES) != hipSuccess || per_cu < 1)
            fprintf(stderr, "kernel_launch: occupancy query reports %d blocks per CU\n", per_cu);
        (void)hipGetLastError();
        grid = cus;
    }
    if (grid < 0) return;
    if (hipMemsetAsync((char*)d_ws + WS_CTL, 0, CTL_BYTES, stream) != hipSuccess) { fprintf(stderr, "kernel_launch: memset failed\n"); return; }
    Args a{};
    for (int i = 0; i < 34; ++i) a.in[i] = (const float*)d_in[i];
    a.out = (float*)d_out; a.ws = (unsigned char*)d_ws;
#if MK_N_LAUNCHES == 1
    a.ph_lo = 0; a.ph_hi = NPHASES;
    hipLaunchKernelGGL(mega, dim3(grid), dim3(NTHREADS), LDS_BYTES, stream, a);
#else
    for (int p = 0; p < NPHASES; ++p) { a.ph_lo = p; a.ph_hi = p + 1; hipLaunchKernelGGL(mega, dim3(grid), dim3(NTHREADS), LDS_BYTES, stream, a); }
#endif
    const hipError_t le = hipPeekAtLastError();
    if (le != hipSuccess) fprintf(stderr, "kernel_launch: launch failed: %s\n", hipGetErrorName(le));
}
```

```cpp
#include <hip/hip_runtime.h>
#include <cstdio>
#include <cstdint>

#ifndef MK_N_LAUNCHES
#define MK_N_LAUNCHES 1
#endif

constexpr int T = 16384, D = 1024, SEQ = 8192, NB = 2, NH = 16, HD = 64;
constexpr int NE = 64, TOPK = 8, DE = 256;
constexpr int RP = 256;
constexpr int MAXROUTED = 147456;
constexpr int MAXROWS = MAXROUTED + T;
constexpr int NTHREADS = 512, NWAVES = 8;
constexpr int NPHASES = 25;
constexpr int LDS_BYTES = 144 * 1024;
constexpr float YB_SCALE = 16.0f;

typedef unsigned short bf16_t;
typedef float f32x4 __attribute__((ext_vector_type(4)));
typedef unsigned u32x4 __attribute__((ext_vector_type(4)));
typedef unsigned u32x2 __attribute__((ext_vector_type(2)));

__device__ __forceinline__ float bf2f(bf16_t b) { return __uint_as_float(((unsigned)b) << 16); }
typedef __bf16 bf16x2_t __attribute__((ext_vector_type(2)));
typedef float f32x2 __attribute__((ext_vector_type(2)));
__device__ __forceinline__ unsigned pack2(float a, float b) { const f32x2 v = {a, b}; const bf16x2_t r = __builtin_convertvector(v, bf16x2_t); return __builtin_bit_cast(unsigned, r); }
__device__ __forceinline__ bf16_t f2bf(float f) { return (bf16_t)(pack2(f, 0.f) & 0xffffu); }
__device__ __forceinline__ float lo2f(unsigned u) { return __uint_as_float(u << 16); }
__device__ __forceinline__ float hi2f(unsigned u) { return __uint_as_float(u & 0xffff0000u); }
__device__ __forceinline__ float fexp_(float x) { return __builtin_amdgcn_exp2f(x * 1.4426950408889634f); }
__device__ __forceinline__ float sigmoidf_(float x) { return __builtin_amdgcn_rcpf(1.0f + fexp_(-x)); }
__device__ __forceinline__ float tanhf_(float x) { return 1.0f - 2.0f * __builtin_amdgcn_rcpf(1.0f + fexp_(2.0f * x)); }
__device__ __forceinline__ float softplusf_(float x) { const float e = fexp_(x); const float l = __builtin_amdgcn_logf(1.0f + e) * 0.6931471805599453f; return x > 15.f ? x : (x < -8.f ? e : l); }
__device__ __forceinline__ float wave_sum(float v) {
#pragma unroll
    for (int o = 32; o >= 1; o >>= 1) v += __shfl_xor(v, o);
    return v;
}

constexpr size_t MiB = 1024 * 1024;
constexpr size_t WS_CTL    = 0;
constexpr size_t CTL_BYTES = 64 * 1024;
constexpr size_t WS_MOD    = 64 * 1024;
constexpr size_t WS_IDX    = 256 * 1024;
constexpr size_t WS_GATE   = WS_IDX + 512 * 1024;
constexpr size_t WS_RANK   = WS_GATE + 512 * 1024;
constexpr size_t WS_POS    = WS_RANK + 512 * 1024;
constexpr size_t WS_TOK    = WS_POS + 512 * 1024;
constexpr size_t WS_TILEE  = WS_TOK + 704 * 1024;
constexpr size_t WS_START  = WS_TILEE + 4096;
constexpr size_t WS_LOGITS = 8 * MiB + 64 * MiB;
constexpr size_t WS_BC     = 4 * MiB;
constexpr size_t WS_BIG    = 8 * MiB;
constexpr size_t WS_XS   = WS_BIG;
constexpr size_t WS_RKV  = WS_BIG + 192 * MiB;
constexpr size_t WS_LORA = WS_BIG + 288 * MiB;
constexpr size_t WS_LD   = WS_BIG;
constexpr size_t WS_AA   = WS_BIG + 64 * MiB;
constexpr size_t WS_GG   = WS_BIG + 96 * MiB;
constexpr size_t WS_O    = WS_BIG + 128 * MiB;
constexpr size_t WS_OG   = WS_BIG + 296 * MiB;
constexpr size_t WS_Y1   = WS_BIG + 328 * MiB;
constexpr size_t WS_H2   = WS_BIG;
constexpr size_t WS_H2LO = WS_BIG + 32 * MiB;
constexpr size_t WS_YB   = WS_BIG;
constexpr size_t WS_HB   = WS_BIG + 320 * MiB;
constexpr size_t WS_H3   = WS_BIG + 320 * MiB;
constexpr size_t WS_Q    = WS_BIG;
constexpr size_t WS_AO   = WS_BIG + 96 * MiB;
constexpr size_t WS_Y1B  = WS_BIG + 128 * MiB;
constexpr size_t WS_W     = WS_BIG + 400 * MiB;
constexpr size_t WS_WGU   = WS_W;
constexpr size_t WS_WDN   = WS_WGU + (size_t)65 * 512 * 1024 * 2;
constexpr size_t WS_WRKV  = WS_WDN + (size_t)65 * 1024 * 256 * 2;
constexpr size_t WS_WO    = WS_WRKV + (size_t)3072 * 1024 * 2;
constexpr size_t WS_WQKV  = WS_WO + (size_t)1024 * 1024 * 2;
constexpr size_t WS_WSBO  = WS_WQKV + (size_t)3072 * 1024 * 2;
constexpr size_t WS_WLDN  = WS_WSBO + (size_t)1024 * 1024 * 2;
constexpr size_t WS_WLUP  = WS_WLDN + (size_t)256 * 1024 * 2;
constexpr size_t WS_WRT   = WS_WLUP + (size_t)1024 * 256 * 2;
constexpr size_t WS_END   = WS_WRT + (size_t)2 * 64 * 3072 * 2;

constexpr int CW_BAR = 0;
constexpr int CW_CNT = 4096;
constexpr int CW_AQ = 4608;

#define XB_TMO      128
#define XB_XCNT(j)  (256  + 64 * (j))
#define XB_XSUB(j)  (1280 + 64 * (j))
#define XB_XGEN(j)  (2304 + 64 * (j))
#define XB_TOP      3328
#define XB_TOPGEN   3392
#define XCD_BAR_WORDS 3456
#define XB_SPIN_CAP (1u << 22)
#define LAS __attribute__((address_space(3)))

__device__ __forceinline__ unsigned xb_ld(unsigned* p)              { return __hip_atomic_load(p, __ATOMIC_RELAXED, __HIP_MEMORY_SCOPE_AGENT); }
__device__ __forceinline__ unsigned xb_add(unsigned* p, unsigned v) { return __hip_atomic_fetch_add(p, v, __ATOMIC_RELAXED, __HIP_MEMORY_SCOPE_AGENT); }
__device__ __forceinline__ unsigned xb_xcc_id() { return (unsigned)__builtin_amdgcn_s_getreg((3 << 11) | 20) & 0xFu; }
#define XB_SPIN(cond, bar) do { unsigned _sp = 0; while (cond) { __builtin_amdgcn_s_sleep(1); \
    if ((++_sp & 255u) == 0u) { if (xb_ld(&(bar)[XB_TMO])) break; if (_sp > XB_SPIN_CAP) { atomicAdd(&(bar)[XB_TMO], 1u); break; } } } } while (0)

struct XcdBarrier { unsigned* bar; unsigned x; volatile LAS unsigned* st; };

__device__ __forceinline__ XcdBarrier xcd_barrier_post(unsigned* bar, volatile LAS unsigned* st) {
    XcdBarrier b; b.bar = bar; b.x = xb_xcc_id(); b.st = st;
    if (threadIdx.x == 0) (void)xb_add(&bar[XB_XCNT(b.x)], 1u);
    return b;
}
__device__ __forceinline__ void xcd_barrier_complete(unsigned* bar, unsigned x, unsigned& nloc, unsigned& nx) {
    const unsigned G = gridDim.x * gridDim.y * gridDim.z;
    unsigned sum, cnt, mine, sp = 0u;
    for (;;) {
        sum = 0u; cnt = 0u; mine = 0u;
#pragma unroll
        for (unsigned j = 0; j < 16; ++j) { const unsigned c = xb_ld(&bar[XB_XCNT(j)]); sum += c; cnt += (c > 0u) ? 1u : 0u; mine = (j == x) ? c : mine; }
        if (sum == G) break;
        __builtin_amdgcn_s_sleep(1);
        if ((++sp & 255u) == 0u) { if (xb_ld(&bar[XB_TMO])) break; if (sp > XB_SPIN_CAP) { atomicAdd(&bar[XB_TMO], 1u); break; } }
    }
    nloc = mine > 0u ? mine : 1u; nx = cnt > 0u ? cnt : 1u;
}
__device__ __forceinline__ void xcd_barrier(const XcdBarrier& b) {
    asm volatile("s_waitcnt vmcnt(0)" ::: "memory");
    __syncthreads();
    if (threadIdx.x == 0) {
        unsigned* bar = b.bar;
        __builtin_amdgcn_s_waitcnt(0);
        unsigned nloc = b.st[0], nx = b.st[1];
        if (nloc == 0u) { xcd_barrier_complete(bar, b.x, nloc, nx); b.st[0] = nloc; b.st[1] = nx; }
        const unsigned old = xb_add(&bar[XB_XSUB(b.x)], 1u);
        const unsigned gen = old / nloc;
        if (old + 1u == (gen + 1u) * nloc) {
            __builtin_amdgcn_fence(__ATOMIC_RELEASE, "agent");
            asm volatile("s_waitcnt vmcnt(0)" ::: "memory");
            const unsigned og = xb_add(&bar[XB_TOP], 1u);
            const unsigned tg = og / nx;
            if (og + 1u == (tg + 1u) * nx) xb_add(&bar[XB_TOPGEN], 1u);
            else XB_SPIN(xb_ld(&bar[XB_TOPGEN]) == tg, bar);
            __builtin_amdgcn_fence(__ATOMIC_ACQUIRE, "agent");
            xb_add(&bar[XB_XGEN(b.x)], 1u);
            asm volatile("s_waitcnt vmcnt(0)" ::: "memory");
        } else {
            XB_SPIN(xb_ld(&bar[XB_XGEN(b.x)]) == gen, bar);
            __builtin_amdgcn_fence(__ATOMIC_ACQUIRE, "agent");
            asm volatile("s_waitcnt vmcnt(0)" ::: "memory");
        }
    }
    __syncthreads();
}

struct Args { const float* in[34]; float* out; unsigned char* ws; int ph_lo, ph_hi; };

struct Frame {
    const float* const* in; float* out; unsigned char* ws; unsigned* ctl;
    float* ldsf; LAS unsigned char* lds; int tid, lane, wave, bid, G;
};

enum { I_X = 0, I_C, I_ADAW, I_ADAB, I_NPM, I_NPOM, I_NPF, I_NPOF, I_MU, I_WRKV, I_WW1, I_WW2, I_W0, I_WA1, I_WA2, I_A0, I_WG1, I_WG2,
       I_KK, I_KA, I_RK, I_LNG, I_LNB, I_WO, I_SBQKV, I_SBO, I_ROUTER, I_RBIAS, I_MG, I_MU_, I_MD, I_SG, I_SU, I_SD };


typedef short bf16x8 __attribute__((ext_vector_type(8)));
constexpr int HTB = 128 * 64 * 2;
__device__ __forceinline__ int lds_byte(int r, int c) { const int st = (r >> 4) * 2 + (c >> 5), rr = r & 15, cc = c & 31, ob = rr * 64 + cc * 2; return st * 1024 + (ob ^ (((ob >> 9) & 1) << 5)); }
__device__ __forceinline__ void stage_rc(int b, int& R, int& C) { const int st = b / 1024, sb = b % 1024, swz = sb ^ (((sb >> 9) & 1) << 5); R = (st >> 1) * 16 + swz / 64; C = (st & 1) * 32 + (swz % 64) / 2; }
#define WAIT_V(n) asm volatile("s_waitcnt vmcnt(" #n ")" ::: "memory")
#define SBAR() do { asm volatile("" ::: "memory"); __builtin_amdgcn_s_barrier(); asm volatile("" ::: "memory"); } while (0)

struct ASeg { const bf16_t* p[3]; int segTiles; };

struct BRowId { __device__ __forceinline__ int operator()(int R) const { return R; } };
template <int BN, bool NSW = false, class ARow, class Epi, class BRow = BRowId>
__device__ __forceinline__ void sg_tile(LAS unsigned char* lds, const ASeg& A, const ARow& arow, const bf16_t* Bt, int ldb, int nt, const Epi& epi, const BRow& brow = BRow()) {
    constexpr int WN = BN / 64, WM = 8 / WN, WR = 256 / WM, MT = WR / 16;
    int tid_ = threadIdx.x; asm volatile("" : "+v"(tid_));
    const int tid = tid_, wid = __builtin_amdgcn_readfirstlane(tid >> 6), lane = tid & 63, fr = lane & 15, fq = lane >> 4;
    const int wm = wid / WN, wn = wid % WN;
    unsigned aoffs[2][2], boffs[2];
#pragma unroll
    for (int i = 0; i < 2; ++i) { int R, C; stage_rc(tid * 16 + i * 8192, R, C);
        aoffs[0][i] = arow(R) + (unsigned)C * 2u; aoffs[1][i] = arow(128 + R) + (unsigned)C * 2u; boffs[i] = (unsigned)(brow(R) * ldb + C) * 2u; }
    const unsigned ldsw = (unsigned)wid * 1024u;
    f32x4 acc[MT][4];
#pragma unroll
    for (int m = 0; m < MT; ++m)
#pragma unroll
        for (int n = 0; n < 4; ++n) acc[m][n] = (f32x4){0.f, 0.f, 0.f, 0.f};
    const int arow0 = wm * WR, ah = arow0 >> 7, ar = arow0 & 127;
    const int aoff = ah * HTB + lds_byte(ar + fr, fq * 8), boff = 2 * HTB + lds_byte(wn * 64 + fr, fq * 8);
#define SG_STAGE(kt, s) do { const int sg_ = (kt) / A.segTiles; const char* ab_ = (const char*)(sg_ == 0 ? A.p[0] : (sg_ == 1 ? A.p[1] : A.p[2])) + (size_t)((kt) - sg_ * A.segTiles) * 128; const char* bb_ = (const char*)Bt + (size_t)(kt) * 128; \
        _Pragma("unroll") for (int h_ = 0; h_ < 2; ++h_) _Pragma("unroll") for (int i_ = 0; i_ < 2; ++i_) \
            __builtin_amdgcn_global_load_lds((const unsigned*)(ab_ + aoffs[h_][i_]), (LAS unsigned*)(lds + ((s) * 3 + h_) * HTB + ldsw + i_ * 8192), 16, 0, 0); \
        _Pragma("unroll") for (int i_ = 0; i_ < WN; ++i_) \
            __builtin_amdgcn_global_load_lds((const unsigned*)(bb_ + boffs[i_]), (LAS unsigned*)(lds + ((s) * 3 + 2) * HTB + ldsw + i_ * 8192), 16, 0, 0); } while (0)
    SG_STAGE(0, 0);
    for (int t = 0; t < nt; ++t) {
        const int s = t & 1;
        if (t + 1 < nt) { SG_STAGE(t + 1, s ^ 1); if (WN == 2) WAIT_V(6); else WAIT_V(5); } else { WAIT_V(0); }
        SBAR();
        LAS unsigned char* base = lds + s * 3 * HTB;
#pragma unroll
        for (int k = 0; k < 2; ++k) {
            bf16x8 af[MT], bfr[4];
#pragma unroll
            for (int m = 0; m < MT; ++m) af[m] = *(const LAS bf16x8*)(base + aoff + m * 2048 + k * 1024);
#pragma unroll
            for (int n = 0; n < 4; ++n) bfr[n] = *(const LAS bf16x8*)(base + boff + n * 2048 + k * 1024);
#pragma unroll
            for (int m = 0; m < MT; ++m)
#pragma unroll
                for (int n = 0; n < 4; ++n) acc[m][n] = NSW ? __builtin_amdgcn_mfma_f32_16x16x32_bf16(af[m], bfr[n], acc[m][n], 0, 0, 0) : __builtin_amdgcn_mfma_f32_16x16x32_bf16(bfr[n], af[m], acc[m][n], 0, 0, 0);
        }
        SBAR();
    }
#undef SG_STAGE
    epi(acc, arow0, wn * 64, fr, fq);
}

struct CTile { bf16_t* dst; const float* src; int dld, sld, ncols; float scale; };
template <class TF>
__device__ __forceinline__ void conv_tiles(const Frame& F, int ntiles, int u0, int ustride, const TF& tf) {
    unsigned* tl = (unsigned*)F.ldsf;
    const int i = F.tid & 31, kp0 = F.tid >> 5;
    if (u0 >= ntiles) return;
    CTile ct = tf(u0);
    f32x4 a[4], b[4];
#define CV_LOAD() do { _Pragma("unroll") for (int q = 0; q < 4; ++q) { const int kp = kp0 + 16 * q; \
        if (4 * i < ct.ncols) { a[q] = *(const f32x4*)(ct.src + (size_t)(2 * kp) * ct.sld + 4 * i); b[q] = *(const f32x4*)(ct.src + (size_t)(2 * kp + 1) * ct.sld + 4 * i); } } } while (0)
    CV_LOAD();
    for (int u = u0; u < ntiles; u += ustride) {
        const CTile cur = ct;
        if (4 * i < cur.ncols) {
#pragma unroll
            for (int q = 0; q < 4; ++q) { const int kp = kp0 + 16 * q;
#pragma unroll
                for (int e = 0; e < 4; ++e) tl[(4 * i + e) * 65 + kp] = pack2(a[q][e] * cur.scale, b[q][e] * cur.scale); }
        }
        __syncthreads();
        if (u + ustride < ntiles) { ct = tf(u + ustride); CV_LOAD(); }
        const int nb = F.tid >> 4, sgm = F.tid & 15;
#pragma unroll
        for (int q = 0; q < 4; ++q) { const int n = nb + 32 * q;
            if (n < cur.ncols) { u32x4 v;
#pragma unroll
                for (int e = 0; e < 4; ++e) v[e] = tl[n * 65 + sgm * 4 + e];
                *(u32x4*)(cur.dst + (size_t)n * cur.dld + sgm * 8) = v; } }
        __syncthreads();
    }
#undef CV_LOAD
}
__device__ __forceinline__ void conv_moe(const Frame& F, int layer, int u0, int ustride) {
    bf16_t* WGU = (bf16_t*)(F.ws + WS_WGU); bf16_t* WDN = (bf16_t*)(F.ws + WS_WDN);
    const float* const* in = F.in;
    conv_tiles(F, 65 * 48, u0, ustride, [=](int u) {
        CTile c; const int e = u / 48, r = u % 48;
        if (r < 32) { const int up = r >> 4, kt = (r >> 1) & 7, nt = r & 1;
            const float* W = (e < 64) ? (up ? in[I_MU_] : in[I_MG]) + ((size_t)layer * NE + e) * D * DE : (up ? in[I_SU] : in[I_SG]) + (size_t)layer * D * DE;
            c.src = W + (size_t)kt * 128 * DE + nt * 128; c.sld = DE; c.dst = WGU + ((size_t)e * 512 + nt * 256 + up * 128) * D + kt * 128; c.dld = D; c.ncols = 128; c.scale = 1.0f; }
        else { const int v = r - 32, kt = v >> 3, nt = v & 7;
            const float* W = (e < 64) ? in[I_MD] + ((size_t)layer * NE + e) * DE * D : in[I_SD] + (size_t)layer * DE * D;
            c.src = W + (size_t)kt * 128 * D + nt * 128; c.sld = D; c.dst = WDN + ((size_t)e * D + nt * 128) * DE + kt * 128; c.dld = DE; c.ncols = 128; c.scale = YB_SCALE; }
        return c; });
}
__device__ __forceinline__ void conv_dense(const Frame& F, int u0, int ustride) {
    bf16_t* WRKV = (bf16_t*)(F.ws + WS_WRKV); bf16_t* WO = (bf16_t*)(F.ws + WS_WO); bf16_t* WQKV = (bf16_t*)(F.ws + WS_WQKV); bf16_t* WSBO = (bf16_t*)(F.ws + WS_WSBO); bf16_t* WLDN = (bf16_t*)(F.ws + WS_WLDN);
    const float* const* in = F.in;
    conv_tiles(F, 192 + 64 + 192 + 64 + 24, u0, ustride, [=](int u) {
        CTile c; c.dld = D; c.ncols = 128; c.scale = 1.0f;
        if (u < 192) { const int n = u / 64, kt = (u >> 3) & 7, nt = u & 7; c.src = in[I_WRKV] + (size_t)n * D * D + (size_t)kt * 128 * D + nt * 128; c.sld = D; c.dst = WRKV + ((size_t)n * D + nt * 128) * D + kt * 128; }
        else if (u < 256) { const int v = u - 192, kt = v >> 3, nt = v & 7; c.src = in[I_WO] + (size_t)kt * 128 * D + nt * 128; c.sld = D; c.dst = WO + (size_t)nt * 128 * D + kt * 128; }
        else if (u < 448) { const int v = u - 256, kt = v / 24, nt = v % 24; c.src = in[I_SBQKV] + (size_t)kt * 128 * 3 * D + nt * 128; c.sld = 3 * D; c.dst = WQKV + (size_t)nt * 128 * D + kt * 128; }
        else if (u < 512) { const int v = u - 448, kt = v >> 3, nt = v & 7; c.src = in[I_SBO] + (size_t)kt * 128 * D + nt * 128; c.sld = D; c.dst = WSBO + (size_t)nt * 128 * D + kt * 128; }
        else { const int v = u - 512, kt = v / 3, j = v % 3;
            if (j == 0) { c.src = in[I_WW1] + (size_t)kt * 128 * 64; c.sld = 64; c.dst = WLDN + kt * 128; c.ncols = 64; }
            else if (j == 1) { c.src = in[I_WA1] + (size_t)kt * 128 * 64; c.sld = 64; c.dst = WLDN + (size_t)64 * D + kt * 128; c.ncols = 64; }
            else { c.src = in[I_WG1] + (size_t)kt * 128 * 128; c.sld = 128; c.dst = WLDN + (size_t)128 * D + kt * 128; } }
        return c; });
    bf16_t* WLUP = (bf16_t*)(F.ws + WS_WLUP); bf16_t* WRT = (bf16_t*)(F.ws + WS_WRT);
    const int gtid = u0 * NTHREADS + F.tid, gstride = ustride * NTHREADS;
    for (int i = gtid; i < 1024 * 256; i += gstride) {
        float v;
        if (i < 1024 * 64) { const int n = i / 64, k = i % 64; v = F.in[I_WW2][k * D + n]; }
        else if (i < 2 * 1024 * 64) { const int j = i - 1024 * 64, n = j / 64, k = j % 64; v = F.in[I_WA2][k * D + n]; }
        else { const int j = i - 2 * 1024 * 64, n = j / 128, k = j % 128; v = F.in[I_WG2][k * D + n]; }
        WLUP[i] = f2bf(v);
    }
    for (int i = gtid; i < 2 * 64 * 1024; i += gstride) {
        const int l = i / (64 * 1024), j = i % (64 * 1024), e = j / 1024, k = j % 1024;
        const float w = F.in[I_ROUTER][((size_t)l * D + k) * NE + e]; const bf16_t hi = f2bf(w), lo = f2bf(w - bf2f(hi));
        bf16_t* row = WRT + ((size_t)l * 64 + e) * 3072; row[k] = hi; row[1024 + k] = lo; row[2048 + k] = hi;
    }
}

__device__ __forceinline__ unsigned pack_fp8x4(const f32x4& v) {
    const float lim = 440.0f;
    const float a = __builtin_amdgcn_fmed3f(v[0], -lim, lim), b = __builtin_amdgcn_fmed3f(v[1], -lim, lim), c = __builtin_amdgcn_fmed3f(v[2], -lim, lim), d = __builtin_amdgcn_fmed3f(v[3], -lim, lim);
    int w = __builtin_amdgcn_cvt_pk_fp8_f32(a, b, 0, false); w = __builtin_amdgcn_cvt_pk_fp8_f32(c, d, w, true); return (unsigned)w;
}
__device__ __forceinline__ void acc_fp8x16(float (&y)[16], const u32x4& w, float g) {
#pragma unroll
    for (int q = 0; q < 4; ++q) { const f32x2 lo = __builtin_amdgcn_cvt_pk_f32_fp8((int)w[q], false), hi = __builtin_amdgcn_cvt_pk_f32_fp8((int)w[q], true);
        y[4 * q] += g * lo.x; y[4 * q + 1] += g * lo.y; y[4 * q + 2] += g * hi.x; y[4 * q + 3] += g * hi.y; }
}
__device__ __forceinline__ void ph_mod(const Frame& F) {
    const float* c = F.in[I_C]; const float* W = F.in[I_ADAW]; const float* bias = F.in[I_ADAB];
    float* MOD = (float*)(F.ws + WS_MOD);
    float* red = F.ldsf;
    float* sc = F.ldsf + 1024;
    for (int i = F.tid; i < 2 * D; i += NTHREADS) { const float v = c[i]; sc[i] = v * sigmoidf_(v); }
    __syncthreads();
    for (int u = F.bid; u < 192; u += F.G) {
        const int l = u / 96, cg = u % 96, col = cg * 64 + F.lane;
        float s0 = 0.f, s1 = 0.f;
        const float* wp = W + ((size_t)l * D + F.wave * 128) * 6144 + col;
#pragma unroll 1
        for (int d0 = 0; d0 < 128; d0 += 32) {
            float wv[32];
#pragma unroll
            for (int d = 0; d < 32; ++d) wv[d] = wp[(size_t)(d0 + d) * 6144];
#pragma unroll
            for (int d = 0; d < 32; ++d) { const int dd = F.wave * 128 + d0 + d; s0 += sc[dd] * wv[d]; s1 += sc[D + dd] * wv[d]; }
        }
        red[(F.wave * 2 + 0) * 64 + F.lane] = s0; red[(F.wave * 2 + 1) * 64 + F.lane] = s1;
        __syncthreads();
        if (F.tid < 128) {
            const int b = F.tid >> 6, cc = F.tid & 63; float s = 0.f;
#pragma unroll
            for (int w = 0; w < 8; ++w) s += red[(w * 2 + b) * 64 + cc];
            MOD[(l * 2 + b) * 6144 + cg * 64 + cc] = s + bias[l * 6144 + cg * 64 + cc];
        }
        __syncthreads();
    }
}

__device__ __forceinline__ void ph_prenorm_rwkv(const Frame& F) {
    const float* x = F.in[I_X]; const float* g = F.in[I_NPM]; const float* mu = F.in[I_MU];
    const float* MOD = (const float*)(F.ws + WS_MOD);
    bf16_t* XS = (bf16_t*)(F.ws + WS_XS);
    const int nunits = T / 8;
    for (int u = F.bid * NWAVES + F.wave; u < nunits; u += F.G * NWAVES) {
        const int t0 = u * 8, b = t0 / SEQ;
        const float* shift = MOD + (0 * 2 + b) * 6144; const float* scale = shift + 1024;
        f32x4 gm[4], sh[4];
#pragma unroll
        for (int i = 0; i < 4; ++i) { const int c = 4 * F.lane + 256 * i; const f32x4 gv = *(const f32x4*)(g + c), sc = *(const f32x4*)(scale + c); gm[i] = gv * (sc + 1.0f); sh[i] = *(const f32x4*)(shift + c); }
        f32x4 hp[4];
#pragma unroll
        for (int i = 0; i < 4; ++i) hp[i] = (f32x4){0.f, 0.f, 0.f, 0.f};
        const int tstart = (t0 % SEQ == 0) ? t0 : t0 - 1;
        for (int t = tstart; t < t0 + 8; ++t) {
            f32x4 xv[4]; float ss = 0.f;
#pragma unroll
            for (int i = 0; i < 4; ++i) { xv[i] = *(const f32x4*)(x + (size_t)t * D + 4 * F.lane + 256 * i); ss += xv[i][0] * xv[i][0] + xv[i][1] * xv[i][1] + xv[i][2] * xv[i][2] + xv[i][3] * xv[i][3]; }
            ss = wave_sum(ss);
            const float rs = rsqrtf(ss * (1.0f / D) + 1e-6f);
            f32x4 h[4];
#pragma unroll
            for (int i = 0; i < 4; ++i) h[i] = xv[i] * rs * gm[i] + sh[i];
            if (t >= t0) {
#pragma unroll
                for (int n = 0; n < 6; ++n) {
#pragma unroll
                    for (int i = 0; i < 4; ++i) {
                        const int c = 4 * F.lane + 256 * i;
                        const f32x4 m = *(const f32x4*)(mu + n * D + c);
                        const f32x4 v = h[i] + (hp[i] - h[i]) * m;
                        u32x2 w; w.x = pack2(v[0], v[1]); w.y = pack2(v[2], v[3]);
                        *(u32x2*)(XS + ((size_t)n * T + t) * D + c) = w;
                    }
                }
            }
#pragma unroll
            for (int i = 0; i < 4; ++i) hp[i] = h[i];
        }
    }
}


__device__ __forceinline__ void ph_postmix_preffn(const Frame& F, int layer, const float* xin, const float* Y) {
    const float* MOD = (const float*)(F.ws + WS_MOD);
    const float* gpo = F.in[I_NPOM] + layer * D; const float* gpf = F.in[I_NPF] + layer * D;
    bf16_t* H2 = (bf16_t*)(F.ws + WS_H2); bf16_t* H2LO = (bf16_t*)(F.ws + WS_H2LO);
    for (int t = F.bid * NWAVES + F.wave; t < T; t += F.G * NWAVES) {
        const int b = t / SEQ; const float* m = MOD + (layer * 2 + b) * 6144;
        f32x4 y[4]; float ss = 0.f;
#pragma unroll
        for (int i = 0; i < 4; ++i) { y[i] = *(const f32x4*)(Y + (size_t)t * D + 4 * F.lane + 256 * i); ss += y[i][0] * y[i][0] + y[i][1] * y[i][1] + y[i][2] * y[i][2] + y[i][3] * y[i][3]; }
        ss = wave_sum(ss);
        const float rs = rsqrtf(ss * (1.0f / D) + 1e-6f);
        f32x4 x1[4]; float s2 = 0.f;
#pragma unroll
        for (int i = 0; i < 4; ++i) { const int c = 4 * F.lane + 256 * i;
            const f32x4 xv = *(const f32x4*)(xin + (size_t)t * D + c), gm = *(const f32x4*)(m + 2048 + c), gp = *(const f32x4*)(gpo + c);
            x1[i] = xv + gm * (y[i] * rs * gp);
            *(f32x4*)(F.out + (size_t)t * D + c) = x1[i];
            s2 += x1[i][0] * x1[i][0] + x1[i][1] * x1[i][1] + x1[i][2] * x1[i][2] + x1[i][3] * x1[i][3]; }
        s2 = wave_sum(s2);
        const float rs2 = rsqrtf(s2 * (1.0f / D) + 1e-6f);
#pragma unroll
        for (int i = 0; i < 4; ++i) { const int c = 4 * F.lane + 256 * i;
            const f32x4 gf = *(const f32x4*)(gpf + c), sc = *(const f32x4*)(m + 4096 + c), sh = *(const f32x4*)(m + 3072 + c);
            const f32x4 h = x1[i] * rs2 * gf * (sc + 1.0f) + sh;
            u32x2 w; w.x = pack2(h[0], h[1]); w.y = pack2(h[2], h[3]);
            u32x2 wl; wl.x = pack2(h[0] - lo2f(w.x), h[1] - hi2f(w.x)); wl.y = pack2(h[2] - lo2f(w.y), h[3] - hi2f(w.y));
            *(u32x2*)(H2 + (size_t)t * D + c) = w; *(u32x2*)(H2LO + (size_t)t * D + c) = wl; }
    }
}


__device__ __forceinline__ void ph_topk(const Frame& F, int layer) {
    const float* LOG = (const float*)(F.ws + WS_LOGITS); const float* rb = F.in[I_RBIAS] + layer * NE;
    int* IDX = (int*)(F.ws + WS_IDX); float* GATE = (float*)(F.ws + WS_GATE); int* RANK = (int*)(F.ws + WS_RANK);
    unsigned* BC = (unsigned*)(F.ws + WS_BC);
    unsigned* lcnt = (unsigned*)F.ldsf;
    const float bias = rb[F.lane];
    for (int base = F.bid * 64; base < T; base += F.G * 64) {
        if (F.tid < 64) lcnt[F.tid] = 0u;
        __syncthreads();
        float s[8], sel[8], tot[8], mysc[8]; int myidx[8]; unsigned lrank[8];
#pragma unroll
        for (int j = 0; j < 8; ++j) { const size_t o = (size_t)(base + F.wave * 8 + j) * NE + F.lane;
            s[j] = sigmoidf_(LOG[o] + LOG[(size_t)T * NE + o] + LOG[(size_t)2 * T * NE + o]); sel[j] = s[j] + bias; tot[j] = 0.f; mysc[j] = 0.f; myidx[j] = 0; }
#pragma unroll
        for (int k = 0; k < TOPK; ++k) {
            float bv[8]; int bi[8];
#pragma unroll
            for (int j = 0; j < 8; ++j) { bv[j] = sel[j]; bi[j] = F.lane; }
#pragma unroll
            for (int o = 32; o >= 1; o >>= 1) {
#pragma unroll
                for (int j = 0; j < 8; ++j) { const float ov = __shfl_xor(bv[j], o); const int oi = __shfl_xor(bi[j], o); const bool take = (ov > bv[j]) | ((ov == bv[j]) & (oi < bi[j]));     bv[j] = take ? ov : bv[j]; bi[j] = take ? oi : bi[j]; }
            }
#pragma unroll
            for (int j = 0; j < 8; ++j) { const float sc = __shfl(s[j], bi[j]); tot[j] += sc; const bool me = (F.lane == k); myidx[j] = me ? bi[j] : myidx[j]; mysc[j] = me ? sc : mysc[j]; sel[j] = (F.lane == bi[j]) ? -1e30f : sel[j]; }
        }
#pragma unroll
        for (int j = 0; j < 8; ++j) { const int t = base + F.wave * 8 + j; lrank[j] = 0u;
            if (F.lane < TOPK) { IDX[t * TOPK + F.lane] = myidx[j]; GATE[t * TOPK + F.lane] = 2.5f * mysc[j] / tot[j]; lrank[j] = atomicAdd(&lcnt[myidx[j]], 1u); } }
        __syncthreads();
        if (F.tid < 64) BC[(base >> 6) * 64 + F.tid] = lcnt[F.tid];
#pragma unroll
        for (int j = 0; j < 8; ++j) { const int t = base + F.wave * 8 + j; if (F.lane < TOPK) RANK[t * TOPK + F.lane] = (int)lrank[j]; }
        __syncthreads();
    }
}

__device__ __forceinline__ void ph_offsets(const Frame& F, int layer) {
    const unsigned* BC = (const unsigned*)(F.ws + WS_BC);
    const int* IDX = (const int*)(F.ws + WS_IDX); const int* RANK = (const int*)(F.ws + WS_RANK);
    int* POS = (int*)(F.ws + WS_POS); int* TOK = (int*)(F.ws + WS_TOK); int* TILEE = (int*)(F.ws + WS_TILEE); int* START = (int*)(F.ws + WS_START);
    int* sst = (int*)F.ldsf;
    constexpr int NG = T / 64;
    for (int g = F.bid; g < NG; g += F.G) {
        { const int e = F.tid & 63, part = F.tid >> 6; int tot = 0, pre = 0;
          for (int gg = part; gg < NG; gg += 8) { const int v = (int)BC[gg * 64 + e]; tot += v; if (gg < g) pre += v; }
          sst[512 + part * 64 + e] = tot; sst[1024 + part * 64 + e] = pre; }
        __syncthreads();
        if (F.tid < 64) { int tot = 0, pre = 0;
#pragma unroll
            for (int q = 0; q < 8; ++q) { tot += sst[512 + q * 64 + F.tid]; pre += sst[1024 + q * 64 + F.tid]; }
            sst[128 + F.tid] = tot; sst[256 + F.tid] = pre; }
        __syncthreads();
        if (F.tid == 0) { int acc = 0; for (int e = 0; e < NE; ++e) { const int c = sst[128 + e]; sst[e] = acc; acc += ((c + RP - 1) / RP) * RP; } sst[64] = acc; }
        __syncthreads();
        if (g == 0) {
            if (F.tid <= 64) START[F.tid] = sst[F.tid];
            if (F.tid == 65) START[65] = sst[64];
            const int ntile = sst[64] / RP;
            for (int i = F.tid; i < ntile; i += NTHREADS) { int e = 0; while (e < 63 && sst[e + 1] <= i * RP) ++e; TILEE[i] = e; }
            for (int q = F.tid; q < NE * RP; q += NTHREADS) { const int e = q / RP, r = q % RP, c = sst[128 + e]; if (sst[e] + c + r < sst[e + 1]) TOK[sst[e] + c + r] = 0; }
        }
        { const int sl = g * 64 * TOPK + F.tid;
          const int e = IDX[sl], p = sst[e] + sst[256 + e] + RANK[sl];
          POS[sl] = p; TOK[p] = sl / TOPK; }
        __syncthreads();
    }
}

__device__ __forceinline__ void ph_combine(const Frame& F, int layer, bool next) {
    const unsigned char* YB = (const unsigned char*)(F.ws + WS_YB); const int* POS = (const int*)(F.ws + WS_POS); const float* GATE = (const float*)(F.ws + WS_GATE);
    const int* START = (const int*)(F.ws + WS_START); const float* MOD = (const float*)(F.ws + WS_MOD);
    const float* gpo = F.in[I_NPOF] + layer * D;
    bf16_t* H3 = (bf16_t*)(F.ws + WS_H3);
    const int routed = START[65], c0 = 16 * F.lane;
    for (int t = F.bid * NWAVES + F.wave; t < T; t += F.G * NWAVES) {
        const int b = t / SEQ; const float* m = MOD + (layer * 2 + b) * 6144;
        int pos[TOPK]; float gk[TOPK];
        { const u32x4 p0 = *(const u32x4*)(POS + t * TOPK), p1 = *(const u32x4*)(POS + t * TOPK + 4); const f32x4 g0 = *(const f32x4*)(GATE + t * TOPK), g1 = *(const f32x4*)(GATE + t * TOPK + 4);
#pragma unroll
          for (int k = 0; k < 4; ++k) { pos[k] = (int)p0[k]; pos[4 + k] = (int)p1[k]; gk[k] = g0[k]; gk[4 + k] = g1[k]; } }
        u32x4 rw[TOPK + 1];
        rw[TOPK] = *(const u32x4*)(YB + (size_t)(routed + t) * D + c0);
#pragma unroll
        for (int k = 0; k < TOPK; ++k) rw[k] = *(const u32x4*)(YB + (size_t)pos[k] * D + c0);
        float y[16];
#pragma unroll
        for (int e = 0; e < 16; ++e) y[e] = 0.f;
        acc_fp8x16(y, rw[TOPK], 1.0f / YB_SCALE);
#pragma unroll
        for (int k = 0; k < TOPK; ++k) acc_fp8x16(y, rw[k], gk[k] * (1.0f / YB_SCALE));
        float ss = 0.f;
#pragma unroll
        for (int e = 0; e < 16; ++e) ss += y[e] * y[e];
        ss = wave_sum(ss);
        const float rs = rsqrtf(ss * (1.0f / D) + 1e-6f);
        f32x4 x2[4]; float s2 = 0.f;
#pragma unroll
        for (int i = 0; i < 4; ++i) { const int c = c0 + 4 * i;
            const f32x4 xv = *(const f32x4*)(F.out + (size_t)t * D + c), gm = *(const f32x4*)(m + 5120 + c), gp = *(const f32x4*)(gpo + c);
            const f32x4 yv = {y[4 * i], y[4 * i + 1], y[4 * i + 2], y[4 * i + 3]};
            x2[i] = xv + gm * (yv * rs * gp);
            *(f32x4*)(F.out + (size_t)t * D + c) = x2[i];
            s2 += x2[i][0] * x2[i][0] + x2[i][1] * x2[i][1] + x2[i][2] * x2[i][2] + x2[i][3] * x2[i][3]; }
        if (next) {
            s2 = wave_sum(s2);
            const float rs2 = rsqrtf(s2 * (1.0f / D) + 1e-6f);
            const float* m1 = MOD + ((layer + 1) * 2 + b) * 6144; const float* g1 = F.in[I_NPM] + (layer + 1) * D;
            u32x4 h0, h1;
#pragma unroll
            for (int i = 0; i < 4; ++i) { const int c = c0 + 4 * i;
                const f32x4 gf = *(const f32x4*)(g1 + c), sc = *(const f32x4*)(m1 + 1024 + c), sh = *(const f32x4*)(m1 + c);
                const f32x4 h = x2[i] * rs2 * gf * (sc + 1.0f) + sh;
                const unsigned w0 = pack2(h[0], h[1]), w1 = pack2(h[2], h[3]);
                if (i == 0) { h0[0] = w0; h0[1] = w1; } else if (i == 1) { h0[2] = w0; h0[3] = w1; } else if (i == 2) { h1[0] = w0; h1[1] = w1; } else { h1[2] = w0; h1[3] = w1; } }
            *(u32x4*)(H3 + (size_t)t * D + c0) = h0; *(u32x4*)(H3 + (size_t)t * D + c0 + 8) = h1;
        }
    }
}

#define SB_EXIT 110.0f

namespace pgx {
__device__ __forceinline__ int perm32(int rho) { const int n = rho >> 4, i = rho & 15; return 8 * (i >> 2) + 4 * n + (i & 3); }
struct Unit { const char* A; const int* tok; const char* B; int r0, c0, aux; };
template <bool SW, bool PERM, class Sched, class Epi>
__device__ __forceinline__ void gemm_phase(LAS unsigned char* lds, const int K, const unsigned lda  , const Sched& S, const Epi& E) {
    int tid_ = threadIdx.x; asm volatile("" : "+v"(tid_));
    const int tid = tid_, wid = __builtin_amdgcn_readfirstlane(tid >> 6), lane = tid & 63, wr = wid >> 2, wc = wid & 3, fr = lane & 15, fq = lane >> 4;
    const int nt = K / 64;
    int Rr[2], Cc[2]; unsigned voffB[2];
#pragma unroll
    for (int i = 0; i < 2; ++i) { stage_rc(tid * 16 + i * 8192, Rr[i], Cc[i]); const int Rb = PERM ? ((Rr[i] & ~31) + perm32(Rr[i] & 31)) : Rr[i]; voffB[i] = (unsigned)(Rb * K + Cc[i]) * 2u; }
    const size_t kstep = 128, hstepB = (size_t)128 * K * 2;
    const unsigned ldsw = (unsigned)wid * 1024u;
    const int aoff = lds_byte(wr * 64 + fr, fq * 8), boff = lds_byte(wc * 32 + fr, fq * 8);
#define PX_SA(b, h) (((b) * 2 + (h)) * HTB)
#define PX_SB(b, h) ((4 + (b) * 2 + (h)) * HTB)
#define PX_STAGE(bufoff, gbase, voff) do { _Pragma("unroll") for (int _i = 0; _i < 2; ++_i) \
        __builtin_amdgcn_global_load_lds((const unsigned*)((const char*)(gbase) + (voff)[_i]), (LAS unsigned*)(lds + (bufoff) + ldsw + _i * 8192), 16, 0, 0); } while (0)
#define PX_LDA(dst, b, h) do { _Pragma("unroll") for (int m = 0; m < 4; ++m) _Pragma("unroll") for (int k = 0; k < 2; ++k) dst[m][k] = *(const LAS bf16x8*)(lds + PX_SA(b, h) + aoff + m * 2048 + k * 1024); } while (0)
#define PX_LDB(dst, b, h) do { _Pragma("unroll") for (int n = 0; n < 2; ++n) _Pragma("unroll") for (int k = 0; k < 2; ++k) dst[n][k] = *(const LAS bf16x8*)(lds + PX_SB(b, h) + boff + n * 2048 + k * 1024); } while (0)
#define PX_MMA(ai, bj, At, Bt) do { __builtin_amdgcn_s_setprio(1); _Pragma("unroll") for (int m = 0; m < 4; ++m) _Pragma("unroll") for (int n = 0; n < 2; ++n) _Pragma("unroll") for (int k = 0; k < 2; ++k) \
        acc[ai][bj][m][n] = SW ? __builtin_amdgcn_mfma_f32_16x16x32_bf16(Bt[n][k], At[m][k], acc[ai][bj][m][n], 0, 0, 0) : __builtin_amdgcn_mfma_f32_16x16x32_bf16(At[m][k], Bt[n][k], acc[ai][bj][m][n], 0, 0, 0); __builtin_amdgcn_s_setprio(0); } while (0)
#define PX_WAIT_L(n) asm volatile("s_waitcnt lgkmcnt(" #n ")" ::: "memory")
#define PX_BAR __builtin_amdgcn_s_barrier()
#define PX_SCHED __builtin_amdgcn_sched_barrier(0)
#define PX_OFFS(dst, un) do { _Pragma("unroll") for (int h_ = 0; h_ < 2; ++h_) _Pragma("unroll") for (int i_ = 0; i_ < 2; ++i_) { \
        const int row_ = h_ * 128 + Rr[i_]; const unsigned rid_ = (un).tok ? (unsigned)(un).tok[row_] : (unsigned)row_; dst[h_][i_] = rid_ * lda + (unsigned)Cc[i_] * 2u; } } while (0)
    Unit cur, nxt; int ui = 0;
    if (!S.next(0, cur)) return;
    f32x4 acc[2][2][4][2];
#pragma unroll
    for (int a = 0; a < 2; ++a)
#pragma unroll
        for (int b = 0; b < 2; ++b)
#pragma unroll
            for (int m = 0; m < 4; ++m)
#pragma unroll
                for (int n = 0; n < 2; ++n) acc[a][b][m][n] = (f32x4){0.f, 0.f, 0.f, 0.f};
    bf16x8 At[4][2], B0[2][2], B1[2][2];
    unsigned oc[2][2], on[2][2];
    PX_OFFS(oc, cur); asm volatile("" : "+v"(oc[0][0]), "+v"(oc[0][1]), "+v"(oc[1][0]), "+v"(oc[1][1]));
    const char* cA = cur.A; const char* cB = cur.B;
    PX_STAGE(PX_SB(0, 0), cB, voffB); PX_STAGE(PX_SA(0, 0), cA, oc[0]); PX_STAGE(PX_SB(0, 1), cB + hstepB, voffB); PX_STAGE(PX_SA(0, 1), cA, oc[1]);
    if (wr == 1) PX_BAR;
    WAIT_V(4); PX_BAR;
    PX_STAGE(PX_SB(1, 0), cB + kstep, voffB); PX_STAGE(PX_SA(1, 0), cA + kstep, oc[0]); PX_STAGE(PX_SB(1, 1), cB + hstepB + kstep, voffB);
    WAIT_V(6); PX_BAR;
    for (;;) {
        const bool has_next = S.next(ui + 1, nxt);
        const char* nA = has_next ? nxt.A : cA; const char* nB = has_next ? nxt.B : cB;
        if (has_next) { PX_OFFS(on, nxt); asm volatile("" : "+v"(on[0][0]), "+v"(on[0][1]), "+v"(on[1][0]), "+v"(on[1][1])); } else {
#pragma unroll
            for (int h_ = 0; h_ < 2; ++h_)
#pragma unroll
                for (int i_ = 0; i_ < 2; ++i_) on[h_][i_] = oc[h_][i_]; }
#pragma unroll 1
        for (int t = 0; t < nt; t += 2) {
            const bool last = (t == nt - 2);
            const char* a1 = cA + (size_t)(t + 1) * kstep;
            const char* a2 = last ? nA : cA + (size_t)(t + 2) * kstep; const char* b2 = last ? nB : cB + (size_t)(t + 2) * kstep;
            const char* a3 = a2 + kstep; const char* b3 = b2 + kstep;
            unsigned o2[2][2];
#pragma unroll
            for (int h_ = 0; h_ < 2; ++h_)
#pragma unroll
                for (int i_ = 0; i_ < 2; ++i_) o2[h_][i_] = last ? on[h_][i_] : oc[h_][i_];
            PX_LDB(B0, 0, 0); PX_SCHED; PX_LDA(At, 0, 0); PX_STAGE(PX_SA(1, 1), a1, oc[1]);
            PX_WAIT_L(8); PX_BAR; PX_WAIT_L(0); PX_MMA(0, 0, At, B0); PX_BAR; PX_SCHED;
            PX_LDB(B1, 0, 1); PX_STAGE(PX_SB(0, 0), b2, voffB);
            PX_BAR; PX_WAIT_L(0); PX_MMA(0, 1, At, B1); PX_BAR;
            PX_LDA(At, 0, 1); PX_STAGE(PX_SA(0, 0), a2, o2[0]);
            PX_BAR; PX_WAIT_L(0); PX_MMA(1, 0, At, B0); PX_BAR; PX_SCHED;
            PX_STAGE(PX_SB(0, 1), b2 + hstepB, voffB);
            WAIT_V(6); PX_BAR; PX_MMA(1, 1, At, B1); PX_BAR;
            PX_LDB(B0, 1, 0); PX_SCHED; PX_LDA(At, 1, 0); PX_STAGE(PX_SA(0, 1), a2, o2[1]);
            PX_WAIT_L(8); PX_BAR; PX_WAIT_L(0); PX_MMA(0, 0, At, B0); PX_BAR; PX_SCHED;
            PX_LDB(B1, 1, 1); PX_STAGE(PX_SB(1, 0), b3, voffB);
            PX_BAR; PX_WAIT_L(0); PX_MMA(0, 1, At, B1); PX_BAR;
            PX_LDA(At, 1, 1); PX_STAGE(PX_SA(1, 0), a3, o2[0]);
            PX_BAR; PX_WAIT_L(0); PX_MMA(1, 0, At, B0); PX_BAR; PX_SCHED;
            PX_STAGE(PX_SB(1, 1), b3 + hstepB, voffB);
            WAIT_V(6); PX_BAR; PX_MMA(1, 1, At, B1); PX_BAR;
        }
        E(acc, cur, wr, wc, fr, fq);
        if (!has_next) break;
#pragma unroll
        for (int a = 0; a < 2; ++a)
#pragma unroll
            for (int b = 0; b < 2; ++b)
#pragma unroll
                for (int m = 0; m < 4; ++m)
#pragma unroll
                    for (int n = 0; n < 2; ++n) acc[a][b][m][n] = (f32x4){0.f, 0.f, 0.f, 0.f};
        cur = nxt; cA = nA; cB = nB; ++ui;
#pragma unroll
        for (int h_ = 0; h_ < 2; ++h_)
#pragma unroll
            for (int i_ = 0; i_ < 2; ++i_) oc[h_][i_] = on[h_][i_];
    }
    WAIT_V(0);
    if (wr == 0) PX_BAR;
    PX_BAR;
#undef PX_SA
#undef PX_SB
#undef PX_STAGE
#undef PX_LDA
#undef PX_LDB
#undef PX_MMA
#undef PX_WAIT_L
#undef PX_BAR
#undef PX_SCHED
#undef PX_OFFS
}
__device__ __forceinline__ unsigned cvt_pk_bf16(float lo, float hi) { return pack2(lo, hi); }
}

__device__ __forceinline__ size_t hm_off(int t, int c) { return ((size_t)((t / SEQ) * NH + (c >> 6)) * SEQ + (t % SEQ)) * 64 + (c & 63); }
#define EPI_MT(acc) (int)(sizeof(acc) / sizeof(acc[0]))
__device__ __forceinline__ void st_bf4(bf16_t* p, const f32x4& v) { u32x2 w; w.x = pack2(v[0], v[1]); w.y = pack2(v[2], v[3]); *(u32x2*)p = w; }

__device__ __forceinline__ void ph_lora_up_sg(const Frame& F) {
    const bf16_t* LORA = (const bf16_t*)(F.ws + WS_LORA); const bf16_t* WLUP = (const bf16_t*)(F.ws + WS_WLUP);
    float* LD = (float*)(F.ws + WS_LD); bf16_t* AA = (bf16_t*)(F.ws + WS_AA); bf16_t* GG = (bf16_t*)(F.ws + WS_GG);
    for (int u = F.bid; u < 3 * 64 * 8; u += F.G) {
        const int which = u / 512, v = u % 512, mt = v / 8, col0 = (v % 8) * 128;
        const int K = which == 2 ? 128 : 64, koff = which * 64;
        ASeg A; A.p[0] = LORA + (size_t)mt * 256 * 256 + koff; A.p[1] = A.p[0]; A.p[2] = A.p[0]; A.segTiles = 4;
        const bf16_t* Bt = WLUP + (which == 0 ? 0 : (which == 1 ? 1024 * 64 : 2 * 1024 * 64)) + (size_t)col0 * K;
        const size_t obase = (size_t)mt * 256 * D + col0;
        sg_tile<128>(F.lds, A, [](int R) { return (unsigned)R * 512u; }, Bt, K, K / 64,
            [&](auto& acc, int r0, int c0, int fr, int fq) {
#pragma unroll
                for (int m = 0; m < EPI_MT(acc); ++m)
#pragma unroll
                    for (int q = 0; q < 4; ++q) {
                        const int c = c0 + 16 * q + 4 * fq; const size_t o = hm_off(mt * 256 + r0 + 16 * m + fr, col0 + c);
                        if (which == 0) { const f32x4 w0 = *(const f32x4*)(F.in[I_W0] + col0 + c); f32x4 r;
#pragma unroll
                            for (int e = 0; e < 4; ++e) { const float wl = w0[e] + acc[m][q][e]; r[e] = -fexp_(-softplusf_(-wl) - 0.5f); }
                            *(f32x4*)(LD + o) = r; }
                        else if (which == 1) { const f32x4 a0 = *(const f32x4*)(F.in[I_A0] + col0 + c); f32x4 r;
#pragma unroll
                            for (int e = 0; e < 4; ++e) r[e] = sigmoidf_(a0[e] + acc[m][q][e]);
                            st_bf4(AA + o, r); }
                        else st_bf4(GG + o, acc[m][q]);
                    }
            });
    }
}
__device__ __forceinline__ void ph_router_sg(const Frame& F, int layer) {
    const bf16_t* H2 = (const bf16_t*)(F.ws + WS_H2); const bf16_t* H2LO = (const bf16_t*)(F.ws + WS_H2LO);
    const bf16_t* WRT = (const bf16_t*)(F.ws + WS_WRT) + (size_t)layer * 64 * 3072; float* LOG = (float*)(F.ws + WS_LOGITS);
    for (int u = F.bid; u < 64 * 3; u += F.G) {
        const int mt = u / 3, sgi = u % 3;
        ASeg A; A.p[0] = (sgi == 2 ? H2LO : H2) + (size_t)mt * 256 * D; A.p[1] = A.p[0]; A.p[2] = A.p[0]; A.segTiles = 16;
        float* out = LOG + (size_t)sgi * T * NE;
        sg_tile<64>(F.lds, A, [](int R) { return (unsigned)R * (D * 2); }, WRT + sgi * 1024, 3072, 16,
            [&](auto& acc, int r0, int c0, int fr, int fq) {
#pragma unroll
                for (int m = 0; m < EPI_MT(acc); ++m)
#pragma unroll
                    for (int q = 0; q < 4; ++q) *(f32x4*)(out + (size_t)(mt * 256 + r0 + 16 * m + fr) * NE + c0 + 16 * q + 4 * fq) = acc[m][q];
            });
    }
}

constexpr int MS = 72;
constexpr int SLOT = 64 * MS * 2;
__device__ __forceinline__ int ms_off(int row, int col) { return row * MS + col; }
constexpr size_t WS_BONUS = 3 * MiB;
constexpr size_t WS_RP = WS_BIG + 128 * MiB;
constexpr size_t WS_OL = WS_BIG + 160 * MiB;
constexpr size_t WS_G2 = WS_BIG + 296 * MiB;
constexpr size_t WS_DM = WS_BIG + 328 * MiB;
constexpr size_t WS_ST = WS_BIG + 360 * MiB;

__device__ __forceinline__ void st4_lds(LAS bf16_t* p, const f32x4& v) { u32x2 w; w.x = pack2(v[0], v[1]); w.y = pack2(v[2], v[3]); *(LAS u32x2*)p = w; }
__device__ __forceinline__ f32x4 ld4_lds(const LAS bf16_t* p) { const u32x2 w = *(const LAS u32x2*)p; return (f32x4){lo2f(w.x), hi2f(w.x), lo2f(w.y), hi2f(w.y)}; }
__device__ __forceinline__ f32x4 ld4_g(const bf16_t* p) { const u32x2 w = *(const u32x2*)p; return (f32x4){lo2f(w.x), hi2f(w.x), lo2f(w.y), hi2f(w.y)}; }

__device__ __forceinline__ void ph_wkv_chunk(const Frame& F) {
    const bf16_t* RKV = (const bf16_t*)(F.ws + WS_RKV); const float* LD = (const float*)(F.ws + WS_LD); const bf16_t* AA = (const bf16_t*)(F.ws + WS_AA);
    const bf16_t* Rb = RKV; const bf16_t* Kb = RKV + (size_t)T * D; const bf16_t* Vb = RKV + (size_t)2 * T * D;
    bf16_t* RP = (bf16_t*)(F.ws + WS_RP); bf16_t* OL = (bf16_t*)(F.ws + WS_OL); bf16_t* G2 = (bf16_t*)(F.ws + WS_G2); bf16_t* DM = (bf16_t*)(F.ws + WS_DM);
    float* BONUS = (float*)(F.ws + WS_BONUS);
#define SL(k) ((LAS bf16_t*)(F.lds + (k) * SLOT))
#define AT(k, r, c) (SL(k) + ms_off((r), (c)))
    LAS float* segtot = (LAS float*)(F.lds + 15 * SLOT);
    LAS float* WCs = segtot + 512;
    const int w = F.wave, lane = F.lane, fr = lane & 15, fq = lane >> 4, mt = w >> 1, ntb = 2 * (w & 1);
    for (int cid = F.bid; cid < NB * NH * (SEQ / 64); cid += F.G) {
        const int bh = cid / (SEQ / 64), c = cid % (SEQ / 64), b = bh / NH, h = bh % NH;
        const size_t tok0 = (size_t)b * SEQ + (size_t)c * 64;
        {
            const int t = F.tid >> 3, jg = lane & 7, tl = lane >> 3, ch0 = h * 64 + 8 * jg;
            const size_t o = ((size_t)bh * SEQ + (size_t)c * 64 + t) * 64 + 8 * jg;
            const u32x4 rr = *(const u32x4*)(Rb + o), kr = *(const u32x4*)(Kb + o), vr = *(const u32x4*)(Vb + o), ar = *(const u32x4*)(AA + o);
            const f32x4 l0 = *(const f32x4*)(LD + o), l1 = *(const f32x4*)(LD + o + 4);
            float r[8], k[8], a[8], ld[8], cum[8];
#pragma unroll
            for (int q = 0; q < 4; ++q) { r[2 * q] = lo2f(rr[q]); r[2 * q + 1] = hi2f(rr[q]); k[2 * q] = lo2f(kr[q]); k[2 * q + 1] = hi2f(kr[q]); a[2 * q] = lo2f(ar[q]); a[2 * q + 1] = hi2f(ar[q]); ld[q] = l0[q]; ld[4 + q] = l1[q]; }
#pragma unroll
            for (int e = 0; e < 8; ++e) { float v = ld[e];
                float u1 = __shfl_up(v, 8);  if (tl >= 1) v += u1;
                float u2 = __shfl_up(v, 16); if (tl >= 2) v += u2;
                float u4 = __shfl_up(v, 32); if (tl >= 4) v += u4;
                cum[e] = v; }
            if (tl == 7) {
#pragma unroll
                for (int e = 0; e < 8; ++e) segtot[w * 64 + 8 * jg + e] = cum[e]; }
            __syncthreads();
            float tot[8];
#pragma unroll
            for (int e = 0; e < 8; ++e) tot[e] = 0.f;
#pragma unroll
            for (int ww = 0; ww < 8; ++ww) {
                const f32x4 s0 = *(const LAS f32x4*)(segtot + ww * 64 + 8 * jg), s1 = *(const LAS f32x4*)(segtot + ww * 64 + 8 * jg + 4);
#pragma unroll
                for (int q = 0; q < 4; ++q) { tot[q] += s0[q]; tot[4 + q] += s1[q]; if (ww < w) { cum[q] += s0[q]; cum[4 + q] += s1[q]; } }
            }
            if (t == 0) {
#pragma unroll
                for (int e = 0; e < 8; ++e) WCs[8 * jg + e] = fexp_(tot[e]); }
            float kkr[8], kf[8], ss = 0.f, bon = 0.f;
#pragma unroll
            for (int e = 0; e < 8; ++e) { kkr[e] = k[e] * F.in[I_KK][ch0 + e]; ss += kkr[e] * kkr[e]; kf[e] = k[e] * (1.0f + (a[e] - 1.0f) * F.in[I_KA][ch0 + e]); bon += r[e] * kf[e] * F.in[I_RK][ch0 + e]; }
            ss += __shfl_xor(ss, 1); ss += __shfl_xor(ss, 2); ss += __shfl_xor(ss, 4);
            bon += __shfl_xor(bon, 1); bon += __shfl_xor(bon, 2); bon += __shfl_xor(bon, 4);
            if (jg == 0) BONUS[(tok0 + t) * NH + h] = bon;
            const float inv = 1.0f / fmaxf(sqrtf(ss), 1e-12f);
            float av[8], bv[8], kv[8], rv[8];
#pragma unroll
            for (int e = 0; e < 8; ++e) { const float kk = kkr[e] * inv, en = fexp_(-cum[e]);
                av[e] = -kk * fexp_(cum[e] - ld[e]); bv[e] = kk * a[e] * en; kv[e] = kf[e] * en; rv[e] = r[e] * fexp_(cum[e]); }
            u32x4 pa, pr, pb, pk;
#pragma unroll
            for (int q = 0; q < 4; ++q) { pa[q] = pack2(av[2 * q], av[2 * q + 1]); pr[q] = pack2(rv[2 * q], rv[2 * q + 1]); pb[q] = pack2(bv[2 * q], bv[2 * q + 1]); pk[q] = pack2(kv[2 * q], kv[2 * q + 1]); }
            *(LAS u32x4*)AT(0, t, 8 * jg) = pa; *(LAS u32x4*)AT(2, t, 8 * jg) = pr; *(LAS u32x4*)AT(3, t, 8 * jg) = pb; *(LAS u32x4*)AT(5, t, 8 * jg) = pk;
#pragma unroll
            for (int q = 0; q < 4; ++q) {
                *AT(1, 8 * jg + 2 * q, t) = (bf16_t)(pa[q] & 0xffffu); *AT(1, 8 * jg + 2 * q + 1, t) = (bf16_t)(pa[q] >> 16);
                *AT(4, 8 * jg + 2 * q, t) = (bf16_t)(pb[q] & 0xffffu); *AT(4, 8 * jg + 2 * q + 1, t) = (bf16_t)(pb[q] >> 16);
                *AT(6, 8 * jg + 2 * q, t) = (bf16_t)(pk[q] & 0xffffu); *AT(6, 8 * jg + 2 * q + 1, t) = (bf16_t)(pk[q] >> 16);
                *AT(7, 8 * jg + 2 * q, t) = (bf16_t)(vr[q] & 0xffffu); *AT(7, 8 * jg + 2 * q + 1, t) = (bf16_t)(vr[q] >> 16);
            }
        }
        __syncthreads();
#define LF2(dst, k, r0) do { dst[0] = *(const LAS bf16x8*)AT(k, (r0) + fr, fq * 8); dst[1] = *(const LAS bf16x8*)AT(k, (r0) + fr, 32 + fq * 8); } while (0)
#define MMA2(acc, xf, yf) do { acc = __builtin_amdgcn_mfma_f32_16x16x32_bf16(xf[0], yf[0], acc, 0, 0, 0); acc = __builtin_amdgcn_mfma_f32_16x16x32_bf16(xf[1], yf[1], acc, 0, 0, 0); } while (0)
        {
            bf16x8 xa[2], xr[2]; LF2(xa, 0, 16 * mt); LF2(xr, 2, 16 * mt);
#pragma unroll
            for (int q2 = 0; q2 < 2; ++q2) {
                const int nt = ntb + q2;
                bf16x8 yb[2], yk[2]; LF2(yb, 3, 16 * nt); LF2(yk, 5, 16 * nt);
                { f32x4 acc = {0.f, 0.f, 0.f, 0.f}; MMA2(acc, xa, yb);
                  const int sidx = 16 * nt + fr, t0 = 16 * mt + 4 * fq;
#pragma unroll
                  for (int e = 0; e < 4; ++e) { if (!(sidx < t0 + e)) acc[e] = 0.f; *AT(8, t0 + e, sidx) = f2bf(acc[e]); }
                  st4_lds(AT(9, sidx, t0), acc); }
                const int tt = 16 * mt + fr, s0 = 16 * nt + 4 * fq;
                { f32x4 acc = {0.f, 0.f, 0.f, 0.f}; MMA2(acc, yk, xa);
#pragma unroll
                  for (int e = 0; e < 4; ++e) if (!(s0 + e < tt)) acc[e] = 0.f;
                  st4_lds(AT(10, tt, s0), acc); }
                { f32x4 acc = {0.f, 0.f, 0.f, 0.f}; MMA2(acc, yb, xr);
#pragma unroll
                  for (int e = 0; e < 4; ++e) if (!(s0 + e <= tt)) acc[e] = 0.f;
                  st4_lds(AT(11, tt, s0), acc); }
                { f32x4 acc = {0.f, 0.f, 0.f, 0.f}; MMA2(acc, yk, xr);
#pragma unroll
                  for (int e = 0; e < 4; ++e) if (!(s0 + e <= tt)) acc[e] = 0.f;
                  st4_lds(AT(12, tt, s0), acc); }
            }
        }
        __syncthreads();
#define WKV_SQ(xi, ti, xo, to) do { bf16x8 xl[2]; LF2(xl, xi, 16 * mt); _Pragma("unroll") for (int q2 = 0; q2 < 2; ++q2) { const int nt = ntb + q2; bf16x8 yl[2]; LF2(yl, ti, 16 * nt); \
            f32x4 acc = {0.f, 0.f, 0.f, 0.f}; MMA2(acc, xl, yl); const int n_ = 16 * nt + fr, m0_ = 16 * mt + 4 * fq; \
            _Pragma("unroll") for (int e = 0; e < 4; ++e) *AT(xo, m0_ + e, n_) = f2bf(acc[e]); st4_lds(AT(to, n_, m0_), acc); } } while (0)
#define WKV_PM(pi, ti, po) do { bf16x8 xp[2]; LF2(xp, pi, 16 * mt); _Pragma("unroll") for (int q2 = 0; q2 < 2; ++q2) { const int nt = ntb + q2; bf16x8 yl[2]; LF2(yl, ti, 16 * nt); \
            const int m_ = 16 * mt + fr, n0_ = 16 * nt + 4 * fq; f32x4 acc = ld4_lds(AT(pi, m_, n0_)); MMA2(acc, yl, xp); st4_lds(AT(po, m_, n0_), acc); } } while (0)
#define WKV_PMSQ(pi, xi, ti, po, xo, to) do { bf16x8 xp[2], xl[2]; LF2(xp, pi, 16 * mt); LF2(xl, xi, 16 * mt); _Pragma("unroll") for (int q2 = 0; q2 < 2; ++q2) { const int nt = ntb + q2; bf16x8 yl[2]; LF2(yl, ti, 16 * nt); \
            { const int m_ = 16 * mt + fr, n0_ = 16 * nt + 4 * fq; f32x4 acc = ld4_lds(AT(pi, m_, n0_)); MMA2(acc, yl, xp); st4_lds(AT(po, m_, n0_), acc); } \
            { f32x4 acc = {0.f, 0.f, 0.f, 0.f}; MMA2(acc, xl, yl); const int n_ = 16 * nt + fr, m0_ = 16 * mt + 4 * fq; \
              _Pragma("unroll") for (int e = 0; e < 4; ++e) *AT(xo, m0_ + e, n_) = f2bf(acc[e]); st4_lds(AT(to, n_, m0_), acc); } } } while (0)
        WKV_SQ(8, 9, 0, 3);
        for (int idx = F.tid; idx < 64 * 16; idx += NTHREADS) { const int t = idx >> 4, s4 = (idx & 15) * 4; u32x2 v = *(const LAS u32x2*)AT(8, t, s4);
            if ((t >> 2) == (s4 >> 2)) { const unsigned one = 0x3F80u; const int e = t & 3; if (e == 0) v.x = (v.x & 0xffff0000u) | one; else if (e == 1) v.x = (v.x & 0xffffu) | (one << 16); else if (e == 2) v.y = (v.y & 0xffff0000u) | one; else v.y = (v.y & 0xffffu) | (one << 16); }
            *(LAS u32x2*)AT(13, t, s4) = v; }
        __syncthreads();
        WKV_PMSQ(13, 0, 3, 14, 8, 9); __syncthreads();
        WKV_PMSQ(14, 8, 9, 13, 0, 3); __syncthreads();
        WKV_PMSQ(13, 0, 3, 14, 8, 9); __syncthreads();
        WKV_PMSQ(14, 8, 9, 13, 0, 3); __syncthreads();
        WKV_PM(13, 3, 14); __syncthreads();
        {
            bf16x8 xt[2], xm[2]; LF2(xt, 14, 16 * mt); LF2(xm, 10, 16 * mt);
#pragma unroll
            for (int q2 = 0; q2 < 2; ++q2) {
                const int nt = ntb + q2, n_ = 16 * nt + fr, m0_ = 16 * mt + 4 * fq;
                bf16x8 ya[2], yv[2]; LF2(ya, 1, 16 * nt); LF2(yv, 7, 16 * nt);
                { f32x4 acc = {0.f, 0.f, 0.f, 0.f}; MMA2(acc, xt, ya); st4_lds(AT(9, n_, m0_), acc); }
                { f32x4 acc = {0.f, 0.f, 0.f, 0.f}; MMA2(acc, xm, yv); st4_lds(AT(8, n_, m0_), acc); }
            }
        }
        __syncthreads();
        {
            bf16x8 xt[2], xb[2]; LF2(xt, 14, 16 * mt); LF2(xb, 11, 16 * mt);
#pragma unroll
            for (int q2 = 0; q2 < 2; ++q2) {
                const int nt = ntb + q2;
                bf16x8 yz[2], yp[2]; LF2(yz, 8, 16 * nt); LF2(yp, 9, 16 * nt);
                { const int n_ = 16 * nt + fr, m0_ = 16 * mt + 4 * fq; f32x4 acc = {0.f, 0.f, 0.f, 0.f}; MMA2(acc, xt, yz); st4_lds(AT(0, n_, m0_), acc); }
                { const int m_ = 16 * mt + fr, n0_ = 16 * nt + 4 * fq; f32x4 acc = ld4_lds(AT(2, m_, n0_)); MMA2(acc, yp, xb);
                  st_bf4(RP + (size_t)cid * 4096 + (unsigned)((mt * 2 + (nt >> 1)) * 512 + (fr * 4 + 2 * (nt & 1) + (fq >> 1)) * 8 + 4 * (fq & 1)), acc); }
            }
        }
        __syncthreads();
        {
            bf16x8 xb[2], xk[2], xp[2], xu[2], xv[2]; LF2(xb, 11, 16 * mt); LF2(xk, 12, 16 * mt); LF2(xp, 9, 16 * mt); LF2(xu, 0, 16 * mt); LF2(xv, 7, 16 * mt);
#pragma unroll
            for (int q2 = 0; q2 < 2; ++q2) {
                const int nt = ntb + q2;
                bf16x8 yu[2], yv[2], yb[2], yk[2]; LF2(yu, 0, 16 * nt); LF2(yv, 7, 16 * nt); LF2(yb, 4, 16 * nt); LF2(yk, 6, 16 * nt);
                { f32x4 acc = {0.f, 0.f, 0.f, 0.f}; MMA2(acc, yu, xb); MMA2(acc, yv, xk);
                  st_bf4(OL + (size_t)cid * 4096 + (unsigned)((16 * mt + fr) * 64 + 16 * nt + 4 * fq), acc); }
                { const int jp = 16 * nt + fr, j0 = 16 * mt + 4 * fq; f32x4 acc = {0.f, 0.f, 0.f, 0.f}; MMA2(acc, xp, yb);
                  const float wc = WCs[jp];
#pragma unroll
                  for (int e = 0; e < 4; ++e) acc[e] = (acc[e] + ((j0 + e == jp) ? 1.0f : 0.0f)) * wc;
                  st_bf4(G2 + (size_t)cid * 4096 + (unsigned)((nt * 2 + (mt >> 1)) * 512 + lane * 8 + (mt & 1) * 4), acc); }
                { const int i_ = 16 * mt + fr, jp0 = 16 * nt + 4 * fq; f32x4 acc = {0.f, 0.f, 0.f, 0.f}; MMA2(acc, yb, xu); MMA2(acc, yk, xv);
#pragma unroll
                  for (int e = 0; e < 4; ++e) acc[e] *= WCs[jp0 + e];
                  st_bf4(DM + (size_t)cid * 4096 + (unsigned)(i_ * 64 + jp0), acc); }
            }
        }
        __syncthreads();
    }
#undef LF2
#undef MMA2
#undef WKV_PMSQ
#undef WKV_SQ
#undef WKV_PM
#undef AT
#undef SL
}

__device__ __forceinline__ void ph_wkv_carry(const Frame& F) {
    const bf16_t* G2 = (const bf16_t*)(F.ws + WS_G2); const bf16_t* DM = (const bf16_t*)(F.ws + WS_DM); bf16_t* ST = (bf16_t*)(F.ws + WS_ST);
    const int lane = F.lane, fr = lane & 15, fq = lane >> 4;
    const bool loader = F.wave >= 4; const int lw = F.wave - 4, i = 16 * (F.wave & 3) + fr;
    constexpr int NC = SEQ / 64;
    for (int ch = F.bid; ch < NB * NH; ch += F.G) {
        const size_t cbase = (size_t)ch * NC;
#define CARRY_ISSUE(c_) do { const int cc_ = (c_) < NC ? (c_) : NC - 1; const size_t cid_ = cbase + cc_; \
        _Pragma("unroll") for (int q_ = 0; q_ < 4; ++q_) { const int j_ = lw * 4 + q_; \
            const bf16_t* src_ = (j_ < 8 ? G2 + cid_ * 4096 + j_ * 512 : DM + cid_ * 4096 + (j_ - 8) * 512) + lane * 8; \
            __builtin_amdgcn_global_load_lds((const unsigned*)src_, (LAS unsigned*)(F.lds + ((c_) & 7) * 16384 + j_ * 1024), 16, 0, 0); } } while (0)
        f32x4 st[4];
#pragma unroll
        for (int r = 0; r < 4; ++r) st[r] = (f32x4){0.f, 0.f, 0.f, 0.f};
        if (loader) {
#pragma unroll
            for (int c = 0; c < 7; ++c) CARRY_ISSUE(c);
            WAIT_V(24);
        }
        SBAR();
#pragma unroll 1
        for (int c = 0; c < NC; ++c) {
            if (loader) {
                CARRY_ISSUE(c + 7);
                WAIT_V(24);
            } else {
                const LAS unsigned char* slot = F.lds + (c & 7) * 16384;
                const size_t cid = cbase + c;
#pragma unroll
                for (int r = 0; r < 4; ++r) st_bf4(ST + cid * 4096 + ((fr >> 2) * 2 + (r >> 1)) * 512 + ((4 * (F.wave & 3) + (fr & 3)) * 4 + 2 * (r & 1) + (fq >> 1)) * 8 + 4 * (fq & 1), st[r]);
                union { bf16x8 v; unsigned u[4]; } b0, b1;
                b0.u[0] = pack2(st[0][0], st[0][1]); b0.u[1] = pack2(st[0][2], st[0][3]); b0.u[2] = pack2(st[1][0], st[1][1]); b0.u[3] = pack2(st[1][2], st[1][3]);
                b1.u[0] = pack2(st[2][0], st[2][1]); b1.u[1] = pack2(st[2][2], st[2][3]); b1.u[2] = pack2(st[3][0], st[3][1]); b1.u[3] = pack2(st[3][2], st[3][3]);
#pragma unroll
                for (int r = 0; r < 4; ++r) {
                    const u32x2 d = *(const LAS u32x2*)(slot + 8192 + (i * 64 + 16 * r + 4 * fq) * 2);
                    f32x4 acc = (f32x4){lo2f(d.x), hi2f(d.x), lo2f(d.y), hi2f(d.y)};
                    acc = __builtin_amdgcn_mfma_f32_16x16x32_bf16(*(const LAS bf16x8*)(slot + (r * 2 + 0) * 1024 + lane * 16), b0.v, acc, 0, 0, 0);
                    acc = __builtin_amdgcn_mfma_f32_16x16x32_bf16(*(const LAS bf16x8*)(slot + (r * 2 + 1) * 1024 + lane * 16), b1.v, acc, 0, 0, 0);
                    st[r] = acc;
                }
            }
            SBAR();
        }
        if (loader) WAIT_V(0);
        SBAR();
#undef CARRY_ISSUE
    }
}

__device__ __forceinline__ void ph_wkv_out(const Frame& F) {
    const bf16_t* RP = (const bf16_t*)(F.ws + WS_RP); const bf16_t* OL = (const bf16_t*)(F.ws + WS_OL); const bf16_t* ST = (const bf16_t*)(F.ws + WS_ST);
    const bf16_t* Vb = (const bf16_t*)(F.ws + WS_RKV) + (size_t)2 * T * D; const bf16_t* GG = (const bf16_t*)(F.ws + WS_GG); const float* BONUS = (const float*)(F.ws + WS_BONUS);
    bf16_t* OG = (bf16_t*)(F.ws + WS_OG);
    const int lane = F.lane, fr = lane & 15, fq = lane >> 4;
    const int nunits = NB * NH * (SEQ / 64) * 4;
    for (int u = F.bid * NWAVES + F.wave; u < nunits; u += F.G * NWAVES) {
        const int cid = u >> 2, tt = u & 3, bh = cid / (SEQ / 64), c = cid % (SEQ / 64), b = bh / NH, h = bh % NH;
        const int t = 16 * tt + fr; const size_t tok = (size_t)b * SEQ + (size_t)c * 64 + t;
        const size_t oh = ((size_t)bh * SEQ + (size_t)c * 64 + t) * 64 + 16 * fq;
        bf16x8 rf[2], sf[4][2];
#pragma unroll
        for (int ks = 0; ks < 2; ++ks) rf[ks] = *(const bf16x8*)(RP + (size_t)cid * 4096 + (tt * 2 + ks) * 512 + (fr * 4 + fq) * 8);
#pragma unroll
        for (int n = 0; n < 4; ++n)
#pragma unroll
            for (int ks = 0; ks < 2; ++ks) sf[n][ks] = *(const bf16x8*)(ST + (size_t)cid * 4096 + (n * 2 + ks) * 512 + (fr * 4 + fq) * 8);
        const u32x4 ol0 = *(const u32x4*)(OL + (size_t)cid * 4096 + t * 64 + 16 * fq), ol1 = *(const u32x4*)(OL + (size_t)cid * 4096 + t * 64 + 16 * fq + 8);
        const u32x4 v0 = *(const u32x4*)(Vb + oh), v1 = *(const u32x4*)(Vb + oh + 8), g0 = *(const u32x4*)(GG + oh), g1 = *(const u32x4*)(GG + oh + 8);
        const float bon = BONUS[tok * NH + h];
        f32x4 acc[4];
        acc[0] = (f32x4){lo2f(ol0[0]), hi2f(ol0[0]), lo2f(ol0[1]), hi2f(ol0[1])}; acc[1] = (f32x4){lo2f(ol0[2]), hi2f(ol0[2]), lo2f(ol0[3]), hi2f(ol0[3])};
        acc[2] = (f32x4){lo2f(ol1[0]), hi2f(ol1[0]), lo2f(ol1[1]), hi2f(ol1[1])}; acc[3] = (f32x4){lo2f(ol1[2]), hi2f(ol1[2]), lo2f(ol1[3]), hi2f(ol1[3])};
#pragma unroll
        for (int n = 0; n < 4; ++n)
#pragma unroll
            for (int ks = 0; ks < 2; ++ks) acc[n] = __builtin_amdgcn_mfma_f32_16x16x32_bf16(sf[n][ks], rf[ks], acc[n], 0, 0, 0);
        float s = 0.f;
#pragma unroll
        for (int n = 0; n < 4; ++n) s += (acc[n][0] + acc[n][1]) + (acc[n][2] + acc[n][3]);
        s += __shfl_xor(s, 16); s += __shfl_xor(s, 32);
        const float mean = s * (1.0f / 64.0f);
        float q = 0.f;
#pragma unroll
        for (int n = 0; n < 4; ++n)
#pragma unroll
            for (int e = 0; e < 4; ++e) { const float d = acc[n][e] - mean; q += d * d; }
        q += __shfl_xor(q, 16); q += __shfl_xor(q, 32);
        const float rstd = rsqrtf(q * (1.0f / 64.0f) + 64e-5f);
        const int chn = h * 64 + 16 * fq;
        u32x4 o0, o1;
#pragma unroll
        for (int n = 0; n < 4; ++n) {
            const f32x4 lg = *(const f32x4*)(F.in[I_LNG] + chn + 4 * n), lb = *(const f32x4*)(F.in[I_LNB] + chn + 4 * n);
            const unsigned vw0 = n < 2 ? v0[2 * n] : v1[2 * n - 4], vw1 = n < 2 ? v0[2 * n + 1] : v1[2 * n - 3], gw0 = n < 2 ? g0[2 * n] : g1[2 * n - 4], gw1 = n < 2 ? g0[2 * n + 1] : g1[2 * n - 3];
            const f32x4 vv = {lo2f(vw0), hi2f(vw0), lo2f(vw1), hi2f(vw1)}, gg = {lo2f(gw0), hi2f(gw0), lo2f(gw1), hi2f(gw1)};
            const f32x4 res = (((acc[n] - mean) * rstd) * lg + lb + vv * bon) * gg;
            const unsigned w0 = pack2(res[0], res[1]), w1 = pack2(res[2], res[3]);
            if (n == 0) { o0[0] = w0; o0[1] = w1; } else if (n == 1) { o0[2] = w0; o0[3] = w1; } else if (n == 2) { o1[0] = w0; o1[1] = w1; } else { o1[2] = w0; o1[3] = w1; }
        }
        *(u32x4*)(OG + tok * D + chn) = o0; *(u32x4*)(OG + tok * D + chn + 8) = o1;
    }
}

struct AttnTile { bf16x8 k[4][2]; bf16x8 v[4][2]; };
__device__ __forceinline__ void attn_load(AttnTile& tl, const bf16_t* kbase  , const bf16_t* vbase  ) {
#pragma unroll
    for (int kt = 0; kt < 4; ++kt)
#pragma unroll
        for (int ks = 0; ks < 2; ++ks) tl.k[kt][ks] = *(const bf16x8*)(kbase + (kt * 2 + ks) * 512);
#pragma unroll
    for (int dt = 0; dt < 4; ++dt)
#pragma unroll
        for (int ks = 0; ks < 2; ++ks) tl.v[dt][ks] = *(const bf16x8*)(vbase + (dt * 2 + ks) * 512);
}
template <bool MASK>
__device__ __forceinline__ void attn_tile(const AttnTile& tl, const bf16x8 (&qf)[2], f32x4 (&o)[4], float& R, int key0, int qpos, int fq) {
    constexpr float C2 = 0.125f * 1.4426950408889634f;
    f32x4 z[4];
#pragma unroll
    for (int kt = 0; kt < 4; ++kt) { z[kt] = (f32x4){0.f, 0.f, 0.f, 0.f};
#pragma unroll
        for (int ks = 0; ks < 2; ++ks) z[kt] = __builtin_amdgcn_mfma_f32_16x16x32_bf16(tl.k[kt][ks], qf[ks], z[kt], 0, 0, 0); }
    float sp[4][4], G[4];
#pragma unroll
    for (int kt = 0; kt < 4; ++kt) { G[kt] = 0.f;
#pragma unroll
        for (int e = 0; e < 4; ++e) { const float z2 = z[kt][e] * C2; z[kt][e] = z2;
            const float l2 = __builtin_amdgcn_logf(1.0f + __builtin_amdgcn_exp2f(z2));
            float spv = z2 > 30.f ? z2 : l2;
            if (MASK) spv = ((key0 + 16 * kt + 4 * fq + e) < qpos) ? spv : 0.f;
            sp[kt][e] = spv; G[kt] += spv; } }
    float sufg[4], tot[4];
#pragma unroll
    for (int kt = 0; kt < 4; ++kt) {
        const float g1 = __shfl_xor(G[kt], 16), g2 = __shfl_xor(G[kt], 32), g3 = __shfl_xor(G[kt], 48);
        tot[kt] = G[kt] + g1 + g2 + g3;
        sufg[kt] = (((fq ^ 1) > fq) ? g1 : 0.f) + (((fq ^ 2) > fq) ? g2 : 0.f) + (((fq ^ 3) > fq) ? g3 : 0.f);
    }
    float later = 0.f;
    union { bf16x8 v; unsigned w[4]; } p0, p1;
#pragma unroll
    for (int kt = 3; kt >= 0; --kt) {
        float run = R + later + sufg[kt];
        float wv[4];
#pragma unroll
        for (int e = 3; e >= 0; --e) { float w = __builtin_amdgcn_exp2f(z[kt][e] - sp[kt][e] - run);
            if (MASK) w = ((key0 + 16 * kt + 4 * fq + e) < qpos) ? w : 0.f;
            wv[e] = w; run += sp[kt][e]; }
        const unsigned w01 = pgx::cvt_pk_bf16(wv[0], wv[1]), w23 = pgx::cvt_pk_bf16(wv[2], wv[3]);
        if (kt == 0) { p0.w[0] = w01; p0.w[1] = w23; } else if (kt == 1) { p0.w[2] = w01; p0.w[3] = w23; } else if (kt == 2) { p1.w[0] = w01; p1.w[1] = w23; } else { p1.w[2] = w01; p1.w[3] = w23; }
        later += tot[kt];
    }
    R += later;
#pragma unroll
    for (int dt = 0; dt < 4; ++dt) {
        o[dt] = __builtin_amdgcn_mfma_f32_16x16x32_bf16(tl.v[dt][0], p0.v, o[dt], 0, 0, 0);
        o[dt] = __builtin_amdgcn_mfma_f32_16x16x32_bf16(tl.v[dt][1], p1.v, o[dt], 0, 0, 0);
    }
}
__device__ __forceinline__ void ph_attn(const Frame& F) {
    const bf16_t* Q = (const bf16_t*)(F.ws + WS_Q); const bf16_t* Kb = Q + (size_t)T * D; const bf16_t* VT = Q + (size_t)2 * T * D;
    bf16_t* AO = (bf16_t*)(F.ws + WS_AO);
    const int lane = F.lane, fr = lane & 15, fq = lane >> 4;
    const int nunits = NB * NH * (SEQ / 16);
    constexpr float EXIT2 = SB_EXIT * 1.4426950408889634f;
    unsigned* aq = F.ctl + CW_AQ;
    LAS unsigned* chunk_s = (LAS unsigned*)(F.lds + 1024);
    const unsigned myx = xb_xcc_id() & 7u;
    for (int qi = 0; qi < 8; ++qi) {
      const unsigned xq = (myx + (unsigned)qi) & 7u;
      for (;;) {
        __syncthreads();
        if (F.tid == 0) *chunk_s = atomicAdd(&aq[xq * 64], 1u);
        __syncthreads();
        const unsigned ck = *chunk_s;
        if (ck >= 256u) break;
        const int bh = (int)xq + 8 * (int)(ck >> 6), qt = (int)(ck & 63u) * 8 + F.wave;
        const int b = bh / NH, h = bh % NH;
        const int q0 = qt * 16, qpos = q0 + fr;
        const size_t tb = (size_t)b * SEQ;
        bf16x8 qf[2];
#pragma unroll
        for (int ks = 0; ks < 2; ++ks) qf[ks] = *(const bf16x8*)(Q + (tb + qpos) * D + h * 64 + ks * 32 + fq * 8);
        f32x4 o[4];
#pragma unroll
        for (int dt = 0; dt < 4; ++dt) o[dt] = (f32x4){0.f, 0.f, 0.f, 0.f};
        float R = 0.f;
        const bf16_t* kb = Kb + (size_t)bh * SEQ * 64 + (fr * 4 + fq) * 8;
        const bf16_t* vb = VT + (size_t)bh * SEQ * 64 + (fr * 4 + fq) * 8;
        int kt0 = (q0 + 15) / 64;
        AttnTile ta, tc;
        attn_load(ta, kb + (size_t)kt0 * 4096, vb + (size_t)kt0 * 4096);
        if (kt0 > 0) attn_load(tc, kb + (size_t)(kt0 - 1) * 4096, vb + (size_t)(kt0 - 1) * 4096);
        attn_tile<true>(ta, qf, o, R, kt0 * 64, qpos, fq);
        --kt0;
        while (kt0 >= 0 && !__all(R > EXIT2)) {
            if (kt0 > 0) attn_load(ta, kb + (size_t)(kt0 - 1) * 4096, vb + (size_t)(kt0 - 1) * 4096);
            attn_tile<false>(tc, qf, o, R, kt0 * 64, qpos, fq);
            --kt0;
            if (kt0 < 0 || __all(R > EXIT2)) break;
            if (kt0 > 0) attn_load(tc, kb + (size_t)(kt0 - 1) * 4096, vb + (size_t)(kt0 - 1) * 4096);
            attn_tile<false>(ta, qf, o, R, kt0 * 64, qpos, fq);
            --kt0;
        }
#pragma unroll
        for (int dt = 0; dt < 4; ++dt) st_bf4(AO + (tb + qpos) * D + h * 64 + 16 * dt + 4 * fq, o[dt]);
      }
    }
}

#ifndef USE_PGX
#define USE_PGX 0x1f
#endif
__device__ __forceinline__ int px_unit_index(int i, int G, int c, int nwg) {
    const long L = (long)i * G + c; if (L >= nwg) return -1;
    const int w = (int)L, q = nwg / 8, r = nwg % 8, xcd = w % 8, off = w / 8;
    return (xcd < r ? xcd * (q + 1) : r * (q + 1) + (xcd - r) * q) + off;
}
struct PxDense {
    const char* A; const char* B; int nM, nN, K, G, c; unsigned lda; int a_div; size_t a_stride;
    __device__ __forceinline__ bool next(int i, pgx::Unit& u) const {
        const int w = px_unit_index(i, G, c, nM * nN); if (w < 0) return false;
        const int pm = w / nN, pn = w % nN;
        u.A = A + (size_t)(pn / a_div) * a_stride + (size_t)pm * 256 * lda; u.tok = nullptr; u.B = B + (size_t)pn * 256 * K * 2; u.r0 = pm * 256; u.c0 = pn * 256; u.aux = 0; return true;
    }
};
__device__ __forceinline__ void px_store_bf16_perm(bf16_t* rowp, const f32x4& v0, const f32x4& v1) {
    u32x4 w; w.x = pgx::cvt_pk_bf16(v0[0], v0[1]); w.y = pgx::cvt_pk_bf16(v0[2], v0[3]); w.z = pgx::cvt_pk_bf16(v1[0], v1[1]); w.w = pgx::cvt_pk_bf16(v1[2], v1[3]); *(u32x4*)rowp = w;
}
__device__ __forceinline__ void ph_rkv_px(const Frame& F) {
    bf16_t* RKV = (bf16_t*)(F.ws + WS_RKV);
    PxDense S{(const char*)(F.ws + WS_XS), (const char*)(F.ws + WS_WRKV), 64, 12, D, F.G, F.bid, (unsigned)(D * 2), 4, (size_t)T * D * 2};
    pgx::gemm_phase<true, true>(F.lds, D, D * 2, S, [&](const f32x4 (&acc)[2][2][4][2], const pgx::Unit& u, int wr, int wc, int fr, int fq) {
        bf16_t* base = RKV + (size_t)(u.c0 / D) * T * D;
#pragma unroll
        for (int ai = 0; ai < 2; ++ai)
#pragma unroll
            for (int m = 0; m < 4; ++m) { const int t = u.r0 + ai * 128 + wr * 64 + m * 16 + fr;
#pragma unroll
                for (int bj = 0; bj < 2; ++bj) px_store_bf16_perm(base + hm_off(t, (u.c0 % D) + bj * 128 + wc * 32 + 8 * fq), acc[ai][bj][m][0], acc[ai][bj][m][1]); }
    });
}
__device__ __forceinline__ void ph_lora_dn_sg(const Frame& F) {
    const bf16_t* XS = (const bf16_t*)(F.ws + WS_XS); const bf16_t* WLDN = (const bf16_t*)(F.ws + WS_WLDN); bf16_t* LORA = (bf16_t*)(F.ws + WS_LORA);
    for (int u = F.bid; u < 64 * 4; u += F.G) {
        const int mt = u / 4, j = u % 4, n = (j == 0) ? 3 : (j == 1 ? 4 : 5);
        ASeg A; A.p[0] = XS + ((size_t)n * T + mt * 256) * D; A.p[1] = A.p[0]; A.p[2] = A.p[0]; A.segTiles = 16;
        bf16_t* out = LORA + (size_t)mt * 256 * 256 + j * 64;
        sg_tile<64>(F.lds, A, [](int R) { return (unsigned)R * (D * 2); }, WLDN + (size_t)(j * 64) * D, D, 16,
            [&](auto& acc, int r0, int c0, int fr, int fq) {
#pragma unroll
                for (int m = 0; m < EPI_MT(acc); ++m)
#pragma unroll
                    for (int q = 0; q < 4; ++q) { f32x4 v = acc[m][q];
                        if (j == 0) {
#pragma unroll
                            for (int e = 0; e < 4; ++e) v[e] = tanhf_(v[e]); }
                        else if (j >= 2) {
#pragma unroll
                            for (int e = 0; e < 4; ++e) v[e] = sigmoidf_(v[e]); }
                        st_bf4(out + (size_t)(r0 + 16 * m + fr) * 256 + c0 + 16 * q + 4 * fq, v); }
            });
    }
}
__device__ __forceinline__ void ph_dense_f32_px(const Frame& F, const bf16_t* Ain, const bf16_t* Wt, float* out) {
    PxDense S{(const char*)Ain, (const char*)Wt, 64, 4, D, F.G, F.bid, (unsigned)(D * 2), 4, 0};
    pgx::gemm_phase<true, false>(F.lds, D, D * 2, S, [&](const f32x4 (&acc)[2][2][4][2], const pgx::Unit& u, int wr, int wc, int fr, int fq) {
        float* base = out + u.c0 + wc * 32 + 4 * fq;
#pragma unroll
        for (int ai = 0; ai < 2; ++ai)
#pragma unroll
            for (int m = 0; m < 4; ++m) { float* rowp = base + (size_t)(u.r0 + ai * 128 + wr * 64 + m * 16 + fr) * D;
#pragma unroll
                for (int bj = 0; bj < 2; ++bj)
#pragma unroll
                    for (int n = 0; n < 2; ++n) *(f32x4*)(rowp + bj * 128 + n * 16) = acc[ai][bj][m][n]; }
    });
}
__device__ __forceinline__ void ph_qkv_px(const Frame& F) {
    bf16_t* QK = (bf16_t*)(F.ws + WS_Q); bf16_t* VT = QK + (size_t)2 * T * D;
    { PxDense S{(const char*)(F.ws + WS_H3), (const char*)(F.ws + WS_WQKV), 64, 8, D, F.G, F.bid, (unsigned)(D * 2), 8, 0};
      pgx::gemm_phase<true, true>(F.lds, D, D * 2, S, [&](const f32x4 (&acc)[2][2][4][2], const pgx::Unit& u, int wr, int wc, int fr, int fq) {
        const bool isk = u.c0 >= D;
#pragma unroll
        for (int ai = 0; ai < 2; ++ai)
#pragma unroll
            for (int m = 0; m < 4; ++m) { const int t = u.r0 + ai * 128 + wr * 64 + m * 16 + fr;
#pragma unroll
                for (int bj = 0; bj < 2; ++bj) { const int c = (u.c0 % D) + bj * 128 + wc * 32 + 8 * fq;
                    const int sq = t % SEQ, dd = c & 63;
                    bf16_t* dst = isk ? QK + (size_t)T * D + (((size_t)((t / SEQ) * NH + (c >> 6)) * (SEQ / 16) + (sq >> 4)) * 2 + (dd >> 5)) * 512 + (sq & 15) * 32 + (dd & 31) : QK + (size_t)t * D + c;
                    px_store_bf16_perm(dst, acc[ai][bj][m][0], acc[ai][bj][m][1]); } }
      }); }
    { PxDense S{(const char*)(F.ws + WS_H3), (const char*)(F.ws + WS_WQKV) + (size_t)2 * D * D * 2, 64, 4, D, F.G, F.bid, (unsigned)(D * 2), 4, 0};
      pgx::gemm_phase<false, false>(F.lds, D, D * 2, S, [&](const f32x4 (&acc)[2][2][4][2], const pgx::Unit& u, int wr, int wc, int fr, int fq) {
#pragma unroll
        for (int ai = 0; ai < 2; ++ai)
#pragma unroll
            for (int m = 0; m < 4; ++m) { const int t = u.r0 + ai * 128 + wr * 64 + m * 16 + 4 * fq, b = t / SEQ, sidx = t % SEQ;
#pragma unroll
                for (int bj = 0; bj < 2; ++bj)
#pragma unroll
                    for (int n = 0; n < 2; ++n) { const int c = u.c0 + bj * 128 + wc * 32 + n * 16 + fr, h = c >> 6, d = c & 63;
                        const int k6 = sidx & 63, kk = k6 & 31;
                        st_bf4(VT + ((size_t)(b * NH + h) * (SEQ / 64) + (sidx >> 6)) * 4096 + ((d >> 4) * 2 + (k6 >> 5)) * 512 + ((d & 15) * 4 + ((kk & 15) >> 2)) * 8 + (kk >> 4) * 4, acc[ai][bj][m][n]); } }
      }); }
}
struct PxMoe {
    const char* Asrc; const int* TOK; const int* TILEE; const char* W; int routed, nmt, nN, K, G, c; unsigned lda; size_t wexp; bool gather;
    __device__ __forceinline__ bool next(int i, pgx::Unit& u) const {
        const int w = px_unit_index(i, G, c, nmt * nN); if (w < 0) return false;
        const int mt = w / nN, pn = w % nN, row0 = mt * 256; const bool sh = row0 >= routed; const int e = sh ? 64 : TILEE[mt];
        if (gather) { if (sh) { u.A = Asrc + (size_t)(row0 - routed) * lda; u.tok = nullptr; } else { u.A = Asrc; u.tok = TOK + row0; } }
        else { u.A = Asrc + (size_t)row0 * lda; u.tok = nullptr; }
        u.B = W + (size_t)e * wexp + (size_t)pn * 256 * K * 2; u.r0 = row0; u.c0 = pn * 256; u.aux = 0; return true;
    }
};
__device__ __forceinline__ void ph_gateup_px(const Frame& F) {
    bf16_t* HB = (bf16_t*)(F.ws + WS_HB); const int* START = (const int*)(F.ws + WS_START);
    const int routed = START[65], nmt = (routed + T) / 256;
    PxMoe S{(const char*)(F.ws + WS_H2), (const int*)(F.ws + WS_TOK), (const int*)(F.ws + WS_TILEE), (const char*)(F.ws + WS_WGU), routed, nmt, 2, D, F.G, F.bid, (unsigned)(D * 2), (size_t)512 * D * 2, true};
    pgx::gemm_phase<true, true>(F.lds, D, D * 2, S, [&](const f32x4 (&acc)[2][2][4][2], const pgx::Unit& u, int wr, int wc, int fr, int fq) {
        bf16_t* base = HB + (u.c0 >> 1) + wc * 32 + 8 * fq;
#pragma unroll
        for (int ai = 0; ai < 2; ++ai)
#pragma unroll
            for (int m = 0; m < 4; ++m) { f32x4 v[2];
#pragma unroll
                for (int n = 0; n < 2; ++n)
#pragma unroll
                    for (int e = 0; e < 4; ++e) { const float g = acc[ai][0][m][n][e]; v[n][e] = g * sigmoidf_(g) * acc[ai][1][m][n][e]; }
                px_store_bf16_perm(base + (size_t)(u.r0 + ai * 128 + wr * 64 + m * 16 + fr) * DE, v[0], v[1]); }
    });
}
__device__ __forceinline__ void ph_down_px(const Frame& F) {
    bf16_t* YB = (bf16_t*)(F.ws + WS_YB); const int* START = (const int*)(F.ws + WS_START);
    const int routed = START[65], nmt = (routed + T) / 256;
    PxMoe S{(const char*)(F.ws + WS_HB), nullptr, (const int*)(F.ws + WS_TILEE), (const char*)(F.ws + WS_WDN), routed, nmt, 4, DE, F.G, F.bid, (unsigned)(DE * 2), (size_t)D * DE * 2, false};
    pgx::gemm_phase<true, true>(F.lds, DE, DE * 2, S, [&](const f32x4 (&acc)[2][2][4][2], const pgx::Unit& u, int wr, int wc, int fr, int fq) {
        unsigned char* base = (unsigned char*)YB + u.c0 + wc * 32 + 8 * fq;
#pragma unroll
        for (int ai = 0; ai < 2; ++ai)
#pragma unroll
            for (int m = 0; m < 4; ++m) { unsigned char* rowp = base + (size_t)(u.r0 + ai * 128 + wr * 64 + m * 16 + fr) * D;
#pragma unroll
                for (int bj = 0; bj < 2; ++bj) { u32x2 w;
                    w.x = pack_fp8x4(acc[ai][bj][m][0]); w.y = pack_fp8x4(acc[ai][bj][m][1]);
                    *(u32x2*)(rowp + bj * 128) = w; }
                asm volatile("" ::: "memory"); }
    });
}

__global__ void __launch_bounds__(NTHREADS, 2) mega(Args args) {
    extern __shared__ __attribute__((aligned(16))) unsigned char lds[];
    Frame F;
    F.in = args.in; F.out = args.out; F.ws = args.ws; F.ctl = (unsigned*)(args.ws + WS_CTL);
    F.ldsf = (float*)lds; F.lds = (LAS unsigned char*)lds;
    F.tid = threadIdx.x; F.lane = F.tid & 63; F.wave = __builtin_amdgcn_readfirstlane(F.tid >> 6); F.bid = blockIdx.x; F.G = gridDim.x;
    if (F.tid < 4) ((unsigned*)(lds + LDS_BYTES - 64))[F.tid] = 0u;
    __syncthreads();
    XcdBarrier bar; bar.bar = F.ctl + CW_BAR; bar.x = 0; bar.st = (volatile LAS unsigned*)(lds + LDS_BYTES - 64);
#if MK_N_LAUNCHES == 1
    bar = xcd_barrier_post(F.ctl + CW_BAR, (volatile LAS unsigned*)(lds + LDS_BYTES - 64));
#endif
    const int lo = args.ph_lo, hi = args.ph_hi;
#define IN(k) (lo <= (k) && (k) < hi)
#ifndef PROBE_MASK
#define PROBE_MASK 0u
#endif
    volatile unsigned long long* tsl = (volatile unsigned long long*)(lds + LDS_BYTES - 64 - 32 * 8);
#define STAMP(k) do { if (PROBE_MASK != 0u && F.tid == 0) tsl[(k)] = __builtin_amdgcn_s_memrealtime(); } while (0)
#define SEAM(k) do { if (IN(k) && IN((k) + 1)) xcd_barrier(bar); STAMP((k) + 1); } while (0)
    STAMP(0);
    bf16_t* const wsb = (bf16_t*)args.ws;
    (void)wsb;
#ifndef REP_A
#define REP_A 1
#endif
#ifndef REP_B
#define REP_B 1
#endif
#ifndef REP_C
#define REP_C 1
#endif
#ifndef REP_D
#define REP_D 1
#endif
#ifndef REP_E
#define REP_E 1
#endif
#ifndef REP_F
#define REP_F 1
#endif
#ifndef REP_G
#define REP_G 1
#endif
#ifndef REP_H
#define REP_H 1
#endif
#define RUN(n, body) for (int r_ = 0; r_ < (n); ++r_) { body; }
    if (IN(0)) { RUN(REP_D, ph_mod(F)) RUN(REP_G, conv_dense(F, F.bid, F.G)) conv_moe(F, 0, F.bid, F.G); } SEAM(0);
    if (IN(1)) { RUN(REP_E, ph_prenorm_rwkv(F)) } SEAM(1);
    if (IN(2)) { RUN(REP_A, ph_rkv_px(F); ph_lora_dn_sg(F)) } SEAM(2);
    if (IN(3)) { RUN(REP_F, ph_lora_up_sg(F)) } SEAM(3);
    if (IN(4)) { RUN(REP_B, ph_wkv_chunk(F)) } SEAM(4);
    if (IN(5)) { RUN(REP_B, ph_wkv_carry(F)) } SEAM(5);
    if (IN(6)) { RUN(REP_B, ph_wkv_out(F)) } SEAM(6);
    if (IN(7)) { RUN(REP_A, ph_dense_f32_px(F, (const bf16_t*)(F.ws + WS_OG), (const bf16_t*)(F.ws + WS_WO), (float*)(F.ws + WS_Y1))) } SEAM(7);
    if (IN(8)) { RUN(REP_E, ph_postmix_preffn(F, 0, F.in[I_X], (const float*)(F.ws + WS_Y1))) } SEAM(8);
    if (IN(9)) { RUN(REP_F, ph_router_sg(F, 0)) } SEAM(9);
    if (IN(10)) { ph_topk(F, 0); } SEAM(10);
    if (IN(11)) { ph_offsets(F, 0); } SEAM(11);
    if (IN(12)) { RUN(REP_A, ph_gateup_px(F)) } SEAM(12);
    if (IN(13)) { RUN(REP_A, ph_down_px(F)) } SEAM(13);
    if (IN(14)) { RUN(1, ph_combine(F, 0, true)) RUN(REP_H, conv_moe(F, 1, F.bid, F.G)) } SEAM(14);
    if (IN(15)) { RUN(REP_A, ph_qkv_px(F)) } SEAM(15);
    if (IN(16)) { RUN(REP_C, ph_attn(F)) } SEAM(16);
    if (IN(17)) { RUN(REP_A, ph_dense_f32_px(F, (const bf16_t*)(F.ws + WS_AO), (const bf16_t*)(F.ws + WS_WSBO), (float*)(F.ws + WS_Y1B))) } SEAM(17);
    if (IN(18)) { ph_postmix_preffn(F, 1, F.out, (const float*)(F.ws + WS_Y1B)); } SEAM(18);
    if (IN(19)) { RUN(REP_F, ph_router_sg(F, 1)) } SEAM(19);
    if (IN(20)) { ph_topk(F, 1); } SEAM(20);
    if (IN(21)) { ph_offsets(F, 1); } SEAM(21);
    if (IN(22)) { RUN(REP_A, ph_gateup_px(F)) } SEAM(22);
    if (IN(23)) { RUN(REP_A, ph_down_px(F)) } SEAM(23);
    if (IN(24)) { ph_combine(F, 1, false); }
    if (PROBE_MASK != 0u) {
        __syncthreads();
        if (F.bid == 0 && F.tid == 0) { const unsigned long long t1 = __builtin_amdgcn_s_memrealtime(); unsigned long long sel = 0;
            for (int k = 0; k < NPHASES; ++k) { const unsigned long long e = (k + 1 < NPHASES) ? tsl[k + 1] : t1; if ((PROBE_MASK >> k) & 1u) sel += e - tsl[k]; }
            F.out[0] += 1000.0f * (float)sel / (float)(t1 - tsl[0]); }
    }
#undef IN
#undef SEAM
}

extern "C" void kernel_launch(void* const* d_in, const int* in_sizes, int n_in, void* d_out, int out_size, void* d_ws, size_t ws_size, hipStream_t stream) {
    static int grid = 0;
    if (grid == 0) {
        if (n_in != 34 || in_sizes[0] != T * D || out_size != T * D || ws_size < WS_END) {
            fprintf(stderr, "kernel_launch: unexpected shapes: n_in %d in0 %d out %d ws %zu (need %zu)\n", n_in, n_in > 0 ? in_sizes[0] : -1, out_size, ws_size, (size_t)WS_END);
            grid = -1; return;
        }
        int dev = 0, cus = 0, per_cu = 0;
        if (hipGetDevice(&dev) != hipSuccess || hipDeviceGetAttribute(&cus, hipDeviceAttributeMultiprocessorCount, dev) != hipSuccess) { grid = -1; return; }
        if (hipFuncSetAttribute((const void*)mega, hipFuncAttributeMaxDynamicSharedMemorySize, LDS_BYTES) != hipSuccess) { fprintf(stderr, "kernel_launch: hipFuncSetAttribute failed\n"); grid = -1; return; }
        if (hipOccupancyMaxActiveBlocksPerMultiprocessor(&per_cu, (const void*)mega, NTHREADS, LDS_BYTES) != hipSuccess || per_cu < 1)
            fprintf(stderr, "kernel_launch: occupancy query reports %d blocks per CU\n", per_cu);
        (void)hipGetLastError();
        grid = cus;
    }
    if (grid < 0) return;
    if (hipMemsetAsync((char*)d_ws + WS_CTL, 0, CTL_BYTES, stream) != hipSuccess) { fprintf(stderr, "kernel_launch: memset failed\n"); return; }
    Args a{};
    for (int i = 0; i < 34; ++i) a.in[i] = (const float*)d_in[i];
    a.out = (float*)d_out; a.ws = (unsigned char*)d_ws;
#if MK_N_LAUNCHES == 1
    a.ph_lo = 0; a.ph_hi = NPHASES;
    hipLaunchKernelGGL(mega, dim3(grid), dim3(NTHREADS), LDS_BYTES, stream, a);
#else
    for (int p = 0; p < NPHASES; ++p) { a.ph_lo = p; a.ph_hi = p + 1; hipLaunchKernelGGL(mega, dim3(grid), dim3(NTHREADS), LDS_BYTES, stream, a); }
#endif
    const hipError_t le = hipPeekAtLastError();
    if (le != hipSuccess) fprintf(stderr, "kernel_launch: launch failed: %s\n", hipGetErrorName(le));
}
```

```cpp
#include <hip/hip_runtime.h>
#include <cstdio>
#include <cstdint>

#ifndef MK_N_LAUNCHES
#define MK_N_LAUNCHES 1
#endif

constexpr int T = 16384, D = 1024, SEQ = 8192, NB = 2, NH = 16, HD = 64;
constexpr int NE = 64, TOPK = 8, DE = 256;
constexpr int RP = 256;
constexpr int MAXROUTED = 147456;
constexpr int MAXROWS = MAXROUTED + T;
constexpr int NTHREADS = 512, NWAVES = 8;
constexpr int NPHASES = 25;
constexpr int LDS_BYTES = 144 * 1024;
constexpr float YB_SCALE = 16.0f;

typedef unsigned short bf16_t;
typedef float f32x4 __attribute__((ext_vector_type(4)));
typedef unsigned u32x4 __attribute__((ext_vector_type(4)));
typedef unsigned u32x2 __attribute__((ext_vector_type(2)));

__device__ __forceinline__ float bf2f(bf16_t b) { return __uint_as_float(((unsigned)b) << 16); }
typedef __bf16 bf16x2_t __attribute__((ext_vector_type(2)));
typedef float f32x2 __attribute__((ext_vector_type(2)));
__device__ __forceinline__ unsigned pack2(float a, float b) { const f32x2 v = {a, b}; const bf16x2_t r = __builtin_convertvector(v, bf16x2_t); return __builtin_bit_cast(unsigned, r); }
__device__ __forceinline__ bf16_t f2bf(float f) { return (bf16_t)(pack2(f, 0.f) & 0xffffu); }
__device__ __forceinline__ float lo2f(unsigned u) { return __uint_as_float(u << 16); }
__device__ __forceinline__ float hi2f(unsigned u) { return __uint_as_float(u & 0xffff0000u); }
__device__ __forceinline__ f32x4 ld4_g(const bf16_t* p) { const u32x2 w = *(const u32x2*)p; return (f32x4){lo2f(w.x), hi2f(w.x), lo2f(w.y), hi2f(w.y)}; }
__device__ __forceinline__ float fexp_(float x) { return __builtin_amdgcn_exp2f(x * 1.4426950408889634f); }
__device__ __forceinline__ float sigmoidf_(float x) { return __builtin_amdgcn_rcpf(1.0f + fexp_(-x)); }
__device__ __forceinline__ float tanhf_(float x) { return 1.0f - 2.0f * __builtin_amdgcn_rcpf(1.0f + fexp_(2.0f * x)); }
__device__ __forceinline__ float softplusf_(float x) { const float e = fexp_(x); const float l = __builtin_amdgcn_logf(1.0f + e) * 0.6931471805599453f; return x > 15.f ? x : (x < -8.f ? e : l); }
__device__ __forceinline__ float wave_sum(float v) {
#pragma unroll
    for (int o = 32; o >= 1; o >>= 1) v += __shfl_xor(v, o);
    return v;
}

constexpr size_t MiB = 1024 * 1024;
constexpr size_t WS_CTL    = 0;
constexpr size_t CTL_BYTES = 64 * 1024;
constexpr size_t WS_MOD    = 64 * 1024;
constexpr size_t WS_IDX    = 256 * 1024;
constexpr size_t WS_GATE   = WS_IDX + 512 * 1024;
constexpr size_t WS_RANK   = WS_GATE + 512 * 1024;
constexpr size_t WS_POS    = WS_RANK + 512 * 1024;
constexpr size_t WS_TOK    = WS_POS + 512 * 1024;
constexpr size_t WS_TILEE  = WS_TOK + 704 * 1024;
constexpr size_t WS_START  = WS_TILEE + 4096;
constexpr size_t WS_LOGITS = 8 * MiB + 64 * MiB;
constexpr size_t WS_BC     = 4 * MiB;
constexpr size_t WS_BIG    = 8 * MiB;
constexpr size_t WS_XS   = WS_BIG;
constexpr size_t WS_RKV  = WS_BIG + 192 * MiB;
constexpr size_t WS_LORA = WS_BIG + 288 * MiB;
constexpr size_t WS_LD   = WS_BIG;
constexpr size_t WS_AA   = WS_BIG + 64 * MiB;
constexpr size_t WS_GG   = WS_BIG + 96 * MiB;
constexpr size_t WS_O    = WS_BIG + 128 * MiB;
constexpr size_t WS_OG   = WS_BIG + 296 * MiB;
constexpr size_t WS_Y1   = WS_BIG + 328 * MiB;
constexpr size_t WS_H2   = WS_BIG;
constexpr size_t WS_H2LO = WS_BIG + 32 * MiB;
constexpr size_t WS_YB   = WS_BIG;
constexpr size_t WS_HB   = WS_BIG + 320 * MiB;
constexpr size_t WS_H3   = WS_BIG + 320 * MiB;
constexpr size_t WS_Q    = WS_BIG;
constexpr size_t WS_AO   = WS_BIG + 96 * MiB;
constexpr size_t WS_Y1B  = WS_BIG + 128 * MiB;
constexpr size_t WS_W     = WS_BIG + 400 * MiB;
constexpr size_t WS_WGU   = WS_W;
constexpr size_t WS_WDN   = WS_WGU + (size_t)65 * 512 * 1024 * 2;
constexpr size_t WS_WRKV  = WS_WDN + (size_t)65 * 1024 * 256 * 2;
constexpr size_t WS_WO    = WS_WRKV + (size_t)3072 * 1024 * 2;
constexpr size_t WS_WQKV  = WS_WO + (size_t)1024 * 1024 * 2;
constexpr size_t WS_WSBO  = WS_WQKV + (size_t)3072 * 1024 * 2;
constexpr size_t WS_WLDN  = WS_WSBO + (size_t)1024 * 1024 * 2;
constexpr size_t WS_WLUP  = WS_WLDN + (size_t)256 * 1024 * 2;
constexpr size_t WS_WRT   = WS_WLUP + (size_t)1024 * 256 * 2;
constexpr size_t WS_END   = WS_WRT + (size_t)2 * 64 * 3072 * 2;

constexpr int CW_BAR = 0;
constexpr int CW_CNT = 4096;
constexpr int CW_AQ = 4608;

#define XB_TMO      128
#define XB_XCNT(j)  (256  + 64 * (j))
#define XB_XSUB(j)  (1280 + 64 * (j))
#define XB_XGEN(j)  (2304 + 64 * (j))
#define XB_TOP      3328
#define XB_TOPGEN   3392
#define XCD_BAR_WORDS 3456
#define XB_SPIN_CAP (1u << 22)
#define LAS __attribute__((address_space(3)))

__device__ __forceinline__ unsigned xb_ld(unsigned* p)              { return __hip_atomic_load(p, __ATOMIC_RELAXED, __HIP_MEMORY_SCOPE_AGENT); }
__device__ __forceinline__ unsigned xb_add(unsigned* p, unsigned v) { return __hip_atomic_fetch_add(p, v, __ATOMIC_RELAXED, __HIP_MEMORY_SCOPE_AGENT); }
__device__ __forceinline__ unsigned xb_xcc_id() { return (unsigned)__builtin_amdgcn_s_getreg((3 << 11) | 20) & 0xFu; }
#define XB_SPIN(cond, bar) do { unsigned _sp = 0; while (cond) { __builtin_amdgcn_s_sleep(1); \
    if ((++_sp & 255u) == 0u) { if (xb_ld(&(bar)[XB_TMO])) break; if (_sp > XB_SPIN_CAP) { atomicAdd(&(bar)[XB_TMO], 1u); break; } } } } while (0)

struct XcdBarrier { unsigned* bar; unsigned x; volatile LAS unsigned* st; };

__device__ __forceinline__ XcdBarrier xcd_barrier_post(unsigned* bar, volatile LAS unsigned* st) {
    XcdBarrier b; b.bar = bar; b.x = xb_xcc_id(); b.st = st;
    if (threadIdx.x == 0) (void)xb_add(&bar[XB_XCNT(b.x)], 1u);
    return b;
}
__device__ __forceinline__ void xcd_barrier_complete(unsigned* bar, unsigned x, unsigned& nloc, unsigned& nx) {
    const unsigned G = gridDim.x * gridDim.y * gridDim.z;
    unsigned sum, cnt, mine, sp = 0u;
    for (;;) {
        sum = 0u; cnt = 0u; mine = 0u;
#pragma unroll
        for (unsigned j = 0; j < 16; ++j) { const unsigned c = xb_ld(&bar[XB_XCNT(j)]); sum += c; cnt += (c > 0u) ? 1u : 0u; mine = (j == x) ? c : mine; }
        if (sum == G) break;
        __builtin_amdgcn_s_sleep(1);
        if ((++sp & 255u) == 0u) { if (xb_ld(&bar[XB_TMO])) break; if (sp > XB_SPIN_CAP) { atomicAdd(&bar[XB_TMO], 1u); break; } }
    }
    nloc = mine > 0u ? mine : 1u; nx = cnt > 0u ? cnt : 1u;
}
__device__ __forceinline__ void xcd_barrier(const XcdBarrier& b) {
    asm volatile("s_waitcnt vmcnt(0)" ::: "memory");
    __syncthreads();
    if (threadIdx.x == 0) {
        unsigned* bar = b.bar;
        __builtin_amdgcn_s_waitcnt(0);
        unsigned nloc = b.st[0], nx = b.st[1];
        if (nloc == 0u) { xcd_barrier_complete(bar, b.x, nloc, nx); b.st[0] = nloc; b.st[1] = nx; }
        const unsigned old = xb_add(&bar[XB_XSUB(b.x)], 1u);
        const unsigned gen = old / nloc;
        if (old + 1u == (gen + 1u) * nloc) {
            __builtin_amdgcn_fence(__ATOMIC_RELEASE, "agent");
            asm volatile("s_waitcnt vmcnt(0)" ::: "memory");
            const unsigned og = xb_add(&bar[XB_TOP], 1u);
            const unsigned tg = og / nx;
            if (og + 1u == (tg + 1u) * nx) xb_add(&bar[XB_TOPGEN], 1u);
            else XB_SPIN(xb_ld(&bar[XB_TOPGEN]) == tg, bar);
            __builtin_amdgcn_fence(__ATOMIC_ACQUIRE, "agent");
            xb_add(&bar[XB_XGEN(b.x)], 1u);
            asm volatile("s_waitcnt vmcnt(0)" ::: "memory");
        } else {
            XB_SPIN(xb_ld(&bar[XB_XGEN(b.x)]) == gen, bar);
            __builtin_amdgcn_fence(__ATOMIC_ACQUIRE, "agent");
            asm volatile("s_waitcnt vmcnt(0)" ::: "memory");
        }
    }
    __syncthreads();
}

struct Args { const float* in[34]; float* out; unsigned char* ws; int ph_lo, ph_hi; };

struct Frame {
    const float* const* in; float* out; unsigned char* ws; unsigned* ctl;
    float* ldsf; LAS unsigned char* lds; int tid, lane, wave, bid, G;
};

enum { I_X = 0, I_C, I_ADAW, I_ADAB, I_NPM, I_NPOM, I_NPF, I_NPOF, I_MU, I_WRKV, I_WW1, I_WW2, I_W0, I_WA1, I_WA2, I_A0, I_WG1, I_WG2,
       I_KK, I_KA, I_RK, I_LNG, I_LNB, I_WO, I_SBQKV, I_SBO, I_ROUTER, I_RBIAS, I_MG, I_MU_, I_MD, I_SG, I_SU, I_SD };


typedef short bf16x8 __attribute__((ext_vector_type(8)));
constexpr int HTB = 128 * 64 * 2;
__device__ __forceinline__ int lds_byte(int r, int c) { const int st = (r >> 4) * 2 + (c >> 5), rr = r & 15, cc = c & 31, ob = rr * 64 + cc * 2; return st * 1024 + (ob ^ (((ob >> 9) & 1) << 5)); }
__device__ __forceinline__ void stage_rc(int b, int& R, int& C) { const int st = b / 1024, sb = b % 1024, swz = sb ^ (((sb >> 9) & 1) << 5); R = (st >> 1) * 16 + swz / 64; C = (st & 1) * 32 + (swz % 64) / 2; }
#define WAIT_V(n) asm volatile("s_waitcnt vmcnt(" #n ")" ::: "memory")
#define SBAR() do { asm volatile("" ::: "memory"); __builtin_amdgcn_s_barrier(); asm volatile("" ::: "memory"); } while (0)

struct ASeg { const bf16_t* p[3]; int segTiles; };

struct BRowId { __device__ __forceinline__ int operator()(int R) const { return R; } };
template <int BN, bool NSW = false, class ARow, class Epi, class BRow = BRowId>
__device__ __forceinline__ void sg_tile(LAS unsigned char* lds, const ASeg& A, const ARow& arow, const bf16_t* Bt, int ldb, int nt, const Epi& epi, const BRow& brow = BRow()) {
    constexpr int WN = BN / 64, WM = 8 / WN, WR = 256 / WM, MT = WR / 16;
    int tid_ = threadIdx.x; asm volatile("" : "+v"(tid_));
    const int tid = tid_, wid = __builtin_amdgcn_readfirstlane(tid >> 6), lane = tid & 63, fr = lane & 15, fq = lane >> 4;
    const int wm = wid / WN, wn = wid % WN;
    unsigned aoffs[2][2], boffs[2];
#pragma unroll
    for (int i = 0; i < 2; ++i) { int R, C; stage_rc(tid * 16 + i * 8192, R, C);
        aoffs[0][i] = arow(R) + (unsigned)C * 2u; aoffs[1][i] = arow(128 + R) + (unsigned)C * 2u; boffs[i] = (unsigned)(brow(R) * ldb + C) * 2u; }
    const unsigned ldsw = (unsigned)wid * 1024u;
    f32x4 acc[MT][4];
#pragma unroll
    for (int m = 0; m < MT; ++m)
#pragma unroll
        for (int n = 0; n < 4; ++n) acc[m][n] = (f32x4){0.f, 0.f, 0.f, 0.f};
    const int arow0 = wm * WR, ah = arow0 >> 7, ar = arow0 & 127;
    const int aoff = ah * HTB + lds_byte(ar + fr, fq * 8), boff = 2 * HTB + lds_byte(wn * 64 + fr, fq * 8);
#define SG_STAGE(kt, s) do { const int sg_ = (kt) / A.segTiles; const char* ab_ = (const char*)(sg_ == 0 ? A.p[0] : (sg_ == 1 ? A.p[1] : A.p[2])) + (size_t)((kt) - sg_ * A.segTiles) * 128; const char* bb_ = (const char*)Bt + (size_t)(kt) * 128; \
        _Pragma("unroll") for (int h_ = 0; h_ < 2; ++h_) _Pragma("unroll") for (int i_ = 0; i_ < 2; ++i_) \
            __builtin_amdgcn_global_load_lds((const unsigned*)(ab_ + aoffs[h_][i_]), (LAS unsigned*)(lds + ((s) * 3 + h_) * HTB + ldsw + i_ * 8192), 16, 0, 0); \
        _Pragma("unroll") for (int i_ = 0; i_ < WN; ++i_) \
            __builtin_amdgcn_global_load_lds((const unsigned*)(bb_ + boffs[i_]), (LAS unsigned*)(lds + ((s) * 3 + 2) * HTB + ldsw + i_ * 8192), 16, 0, 0); } while (0)
    SG_STAGE(0, 0);
    for (int t = 0; t < nt; ++t) {
        const int s = t & 1;
        if (t + 1 < nt) { SG_STAGE(t + 1, s ^ 1); if (WN == 2) WAIT_V(6); else WAIT_V(5); } else { WAIT_V(0); }
        SBAR();
        LAS unsigned char* base = lds + s * 3 * HTB;
#pragma unroll
        for (int k = 0; k < 2; ++k) {
            bf16x8 af[MT], bfr[4];
#pragma unroll
            for (int m = 0; m < MT; ++m) af[m] = *(const LAS bf16x8*)(base + aoff + m * 2048 + k * 1024);
#pragma unroll
            for (int n = 0; n < 4; ++n) bfr[n] = *(const LAS bf16x8*)(base + boff + n * 2048 + k * 1024);
#pragma unroll
            for (int m = 0; m < MT; ++m)
#pragma unroll
                for (int n = 0; n < 4; ++n) acc[m][n] = NSW ? __builtin_amdgcn_mfma_f32_16x16x32_bf16(af[m], bfr[n], acc[m][n], 0, 0, 0) : __builtin_amdgcn_mfma_f32_16x16x32_bf16(bfr[n], af[m], acc[m][n], 0, 0, 0);
        }
        SBAR();
    }
#undef SG_STAGE
    epi(acc, arow0, wn * 64, fr, fq);
}

struct CTile { bf16_t* dst; const float* src; int dld, sld, ncols; float scale; };
template <class TF>
__device__ __forceinline__ void conv_tiles(const Frame& F, int ntiles, int u0, int ustride, const TF& tf) {
    unsigned* tl = (unsigned*)F.ldsf;
    const int i = F.tid & 31, kp0 = F.tid >> 5;
    if (u0 >= ntiles) return;
    CTile ct = tf(u0);
    f32x4 a[4], b[4];
#define CV_LOAD() do { _Pragma("unroll") for (int q = 0; q < 4; ++q) { const int kp = kp0 + 16 * q; \
        if (4 * i < ct.ncols) { a[q] = *(const f32x4*)(ct.src + (size_t)(2 * kp) * ct.sld + 4 * i); b[q] = *(const f32x4*)(ct.src + (size_t)(2 * kp + 1) * ct.sld + 4 * i); } } } while (0)
    CV_LOAD();
    for (int u = u0; u < ntiles; u += ustride) {
        const CTile cur = ct;
        if (4 * i < cur.ncols) {
#pragma unroll
            for (int q = 0; q < 4; ++q) { const int kp = kp0 + 16 * q;
#pragma unroll
                for (int e = 0; e < 4; ++e) tl[(4 * i + e) * 65 + kp] = pack2(a[q][e] * cur.scale, b[q][e] * cur.scale); }
        }
        __syncthreads();
        if (u + ustride < ntiles) { ct = tf(u + ustride); CV_LOAD(); }
        const int nb = F.tid >> 4, sgm = F.tid & 15;
#pragma unroll
        for (int q = 0; q < 4; ++q) { const int n = nb + 32 * q;
            if (n < cur.ncols) { u32x4 v;
#pragma unroll
                for (int e = 0; e < 4; ++e) v[e] = tl[n * 65 + sgm * 4 + e];
                *(u32x4*)(cur.dst + (size_t)n * cur.dld + sgm * 8) = v; } }
        __syncthreads();
    }
#undef CV_LOAD
}
__device__ __forceinline__ void conv_moe(const Frame& F, int layer, int u0, int ustride) {
    bf16_t* WGU = (bf16_t*)(F.ws + WS_WGU); bf16_t* WDN = (bf16_t*)(F.ws + WS_WDN);
    const float* const* in = F.in;
    conv_tiles(F, 65 * 48, u0, ustride, [=](int u) {
        CTile c; const int e = u / 48, r = u % 48;
        if (r < 32) { const int up = r >> 4, kt = (r >> 1) & 7, nt = r & 1;
            const float* W = (e < 64) ? (up ? in[I_MU_] : in[I_MG]) + ((size_t)layer * NE + e) * D * DE : (up ? in[I_SU] : in[I_SG]) + (size_t)layer * D * DE;
            c.src = W + (size_t)kt * 128 * DE + nt * 128; c.sld = DE; c.dst = WGU + ((size_t)e * 512 + nt * 256 + up * 128) * D + kt * 128; c.dld = D; c.ncols = 128; c.scale = 1.0f; }
        else { const int v = r - 32, kt = v >> 3, nt = v & 7;
            const float* W = (e < 64) ? in[I_MD] + ((size_t)layer * NE + e) * DE * D : in[I_SD] + (size_t)layer * DE * D;
            c.src = W + (size_t)kt * 128 * D + nt * 128; c.sld = D; c.dst = WDN + ((size_t)e * D + nt * 128) * DE + kt * 128; c.dld = DE; c.ncols = 128; c.scale = YB_SCALE; }
        return c; });
}
__device__ __forceinline__ void conv_dense(const Frame& F, int u0, int ustride) {
    bf16_t* WRKV = (bf16_t*)(F.ws + WS_WRKV); bf16_t* WO = (bf16_t*)(F.ws + WS_WO); bf16_t* WQKV = (bf16_t*)(F.ws + WS_WQKV); bf16_t* WSBO = (bf16_t*)(F.ws + WS_WSBO); bf16_t* WLDN = (bf16_t*)(F.ws + WS_WLDN);
    const float* const* in = F.in;
    conv_tiles(F, 192 + 64 + 192 + 64 + 24, u0, ustride, [=](int u) {
        CTile c; c.dld = D; c.ncols = 128; c.scale = 1.0f;
        if (u < 192) { const int n = u / 64, kt = (u >> 3) & 7, nt = u & 7; c.src = in[I_WRKV] + (size_t)n * D * D + (size_t)kt * 128 * D + nt * 128; c.sld = D; c.dst = WRKV + ((size_t)n * D + nt * 128) * D + kt * 128; }
        else if (u < 256) { const int v = u - 192, kt = v >> 3, nt = v & 7; c.src = in[I_WO] + (size_t)kt * 128 * D + nt * 128; c.sld = D; c.dst = WO + (size_t)nt * 128 * D + kt * 128; }
        else if (u < 448) { const int v = u - 256, kt = v / 24, nt = v % 24; c.src = in[I_SBQKV] + (size_t)kt * 128 * 3 * D + nt * 128; c.sld = 3 * D; c.dst = WQKV + (size_t)nt * 128 * D + kt * 128; }
        else if (u < 512) { const int v = u - 448, kt = v >> 3, nt = v & 7; c.src = in[I_SBO] + (size_t)kt * 128 * D + nt * 128; c.sld = D; c.dst = WSBO + (size_t)nt * 128 * D + kt * 128; }
        else { const int v = u - 512, kt = v / 3, j = v % 3;
            if (j == 0) { c.src = in[I_WW1] + (size_t)kt * 128 * 64; c.sld = 64; c.dst = WLDN + kt * 128; c.ncols = 64; }
            else if (j == 1) { c.src = in[I_WA1] + (size_t)kt * 128 * 64; c.sld = 64; c.dst = WLDN + (size_t)64 * D + kt * 128; c.ncols = 64; }
            else { c.src = in[I_WG1] + (size_t)kt * 128 * 128; c.sld = 128; c.dst = WLDN + (size_t)128 * D + kt * 128; } }
        return c; });
    bf16_t* WLUP = (bf16_t*)(F.ws + WS_WLUP); bf16_t* WRT = (bf16_t*)(F.ws + WS_WRT);
    const int gtid = u0 * NTHREADS + F.tid, gstride = ustride * NTHREADS;
    for (int i = gtid; i < 1024 * 256; i += gstride) {
        float v;
        if (i < 1024 * 64) { const int n = i / 64, k = i % 64; v = F.in[I_WW2][k * D + n]; }
        else if (i < 2 * 1024 * 64) { const int j = i - 1024 * 64, n = j / 64, k = j % 64; v = F.in[I_WA2][k * D + n]; }
        else { const int j = i - 2 * 1024 * 64, n = j / 128, k = j % 128; v = F.in[I_WG2][k * D + n]; }
        WLUP[i] = f2bf(v);
    }
    for (int i = gtid; i < 2 * 64 * 1024; i += gstride) {
        const int l = i / (64 * 1024), j = i % (64 * 1024), e = j / 1024, k = j % 1024;
        const float w = F.in[I_ROUTER][((size_t)l * D + k) * NE + e]; const bf16_t hi = f2bf(w), lo = f2bf(w - bf2f(hi));
        bf16_t* row = WRT + ((size_t)l * 64 + e) * 3072; row[k] = hi; row[1024 + k] = lo; row[2048 + k] = hi;
    }
}

__device__ __forceinline__ unsigned pack_fp8x4(const f32x4& v) {
    const float lim = 440.0f;
    const float a = __builtin_amdgcn_fmed3f(v[0], -lim, lim), b = __builtin_amdgcn_fmed3f(v[1], -lim, lim), c = __builtin_amdgcn_fmed3f(v[2], -lim, lim), d = __builtin_amdgcn_fmed3f(v[3], -lim, lim);
    int w = __builtin_amdgcn_cvt_pk_fp8_f32(a, b, 0, false); w = __builtin_amdgcn_cvt_pk_fp8_f32(c, d, w, true); return (unsigned)w;
}
__device__ __forceinline__ void acc_fp8x16(float (&y)[16], const u32x4& w, float g) {
#pragma unroll
    for (int q = 0; q < 4; ++q) { const f32x2 lo = __builtin_amdgcn_cvt_pk_f32_fp8((int)w[q], false), hi = __builtin_amdgcn_cvt_pk_f32_fp8((int)w[q], true);
        y[4 * q] += g * lo.x; y[4 * q + 1] += g * lo.y; y[4 * q + 2] += g * hi.x; y[4 * q + 3] += g * hi.y; }
}
__device__ __forceinline__ void ph_mod(const Frame& F) {
    const float* c = F.in[I_C]; const float* W = F.in[I_ADAW]; const float* bias = F.in[I_ADAB];
    float* MOD = (float*)(F.ws + WS_MOD);
    float* red = F.ldsf;
    float* sc = F.ldsf + 1024;
    for (int i = F.tid; i < 2 * D; i += NTHREADS) { const float v = c[i]; sc[i] = v * sigmoidf_(v); }
    __syncthreads();
    for (int u = F.bid; u < 192; u += F.G) {
        const int l = u / 96, cg = u % 96, col = cg * 64 + F.lane;
        float s0 = 0.f, s1 = 0.f;
        const float* wp = W + ((size_t)l * D + F.wave * 128) * 6144 + col;
#pragma unroll 1
        for (int d0 = 0; d0 < 128; d0 += 32) {
            float wv[32];
#pragma unroll
            for (int d = 0; d < 32; ++d) wv[d] = wp[(size_t)(d0 + d) * 6144];
#pragma unroll
            for (int d = 0; d < 32; ++d) { const int dd = F.wave * 128 + d0 + d; s0 += sc[dd] * wv[d]; s1 += sc[D + dd] * wv[d]; }
        }
        red[(F.wave * 2 + 0) * 64 + F.lane] = s0; red[(F.wave * 2 + 1) * 64 + F.lane] = s1;
        __syncthreads();
        if (F.tid < 128) {
            const int b = F.tid >> 6, cc = F.tid & 63; float s = 0.f;
#pragma unroll
            for (int w = 0; w < 8; ++w) s += red[(w * 2 + b) * 64 + cc];
            MOD[(l * 2 + b) * 6144 + cg * 64 + cc] = s + bias[l * 6144 + cg * 64 + cc];
        }
        __syncthreads();
    }
}

__device__ __forceinline__ void ph_prenorm_rwkv(const Frame& F) {
    const float* x = F.in[I_X]; const float* g = F.in[I_NPM]; const float* mu = F.in[I_MU];
    const float* MOD = (const float*)(F.ws + WS_MOD);
    bf16_t* XS = (bf16_t*)(F.ws + WS_XS);
    const int nunits = T / 8;
    for (int u = F.bid * NWAVES + F.wave; u < nunits; u += F.G * NWAVES) {
        const int t0 = u * 8, b = t0 / SEQ;
        const float* shift = MOD + (0 * 2 + b) * 6144; const float* scale = shift + 1024;
        f32x4 gm[4], sh[4];
#pragma unroll
        for (int i = 0; i < 4; ++i) { const int c = 4 * F.lane + 256 * i; const f32x4 gv = *(const f32x4*)(g + c), sc = *(const f32x4*)(scale + c); gm[i] = gv * (sc + 1.0f); sh[i] = *(const f32x4*)(shift + c); }
        f32x4 hp[4];
#pragma unroll
        for (int i = 0; i < 4; ++i) hp[i] = (f32x4){0.f, 0.f, 0.f, 0.f};
        const int tstart = (t0 % SEQ == 0) ? t0 : t0 - 1;
        for (int t = tstart; t < t0 + 8; ++t) {
            f32x4 xv[4]; float ss = 0.f;
#pragma unroll
            for (int i = 0; i < 4; ++i) { xv[i] = *(const f32x4*)(x + (size_t)t * D + 4 * F.lane + 256 * i); ss += xv[i][0] * xv[i][0] + xv[i][1] * xv[i][1] + xv[i][2] * xv[i][2] + xv[i][3] * xv[i][3]; }
            ss = wave_sum(ss);
            const float rs = rsqrtf(ss * (1.0f / D) + 1e-6f);
            f32x4 h[4];
#pragma unroll
            for (int i = 0; i < 4; ++i) h[i] = xv[i] * rs * gm[i] + sh[i];
            if (t >= t0) {
#pragma unroll
                for (int n = 0; n < 6; ++n) {
#pragma unroll
                    for (int i = 0; i < 4; ++i) {
                        const int c = 4 * F.lane + 256 * i;
                        const f32x4 m = *(const f32x4*)(mu + n * D + c);
                        const f32x4 v = h[i] + (hp[i] - h[i]) * m;
                        u32x2 w; w.x = pack2(v[0], v[1]); w.y = pack2(v[2], v[3]);
                        *(u32x2*)(XS + ((size_t)n * T + t) * D + c) = w;
                    }
                }
            }
#pragma unroll
            for (int i = 0; i < 4; ++i) hp[i] = h[i];
        }
    }
}


__device__ __forceinline__ void ph_postmix_preffn(const Frame& F, int layer, const float* xin, const bf16_t* Y) {
    const float* MOD = (const float*)(F.ws + WS_MOD);
    const float* gpo = F.in[I_NPOM] + layer * D; const float* gpf = F.in[I_NPF] + layer * D;
    bf16_t* H2 = (bf16_t*)(F.ws + WS_H2); bf16_t* H2LO = (bf16_t*)(F.ws + WS_H2LO);
    for (int t = F.bid * NWAVES + F.wave; t < T; t += F.G * NWAVES) {
        const int b = t / SEQ; const float* m = MOD + (layer * 2 + b) * 6144;
        f32x4 y[4]; float ss = 0.f;
#pragma unroll
        for (int i = 0; i < 4; ++i) { y[i] = ld4_g(Y + (size_t)t * D + 4 * F.lane + 256 * i); ss += y[i][0] * y[i][0] + y[i][1] * y[i][1] + y[i][2] * y[i][2] + y[i][3] * y[i][3]; }
        ss = wave_sum(ss);
        const float rs = rsqrtf(ss * (1.0f / D) + 1e-6f);
        f32x4 x1[4]; float s2 = 0.f;
#pragma unroll
        for (int i = 0; i < 4; ++i) { const int c = 4 * F.lane + 256 * i;
            const f32x4 xv = *(const f32x4*)(xin + (size_t)t * D + c), gm = *(const f32x4*)(m + 2048 + c), gp = *(const f32x4*)(gpo + c);
            x1[i] = xv + gm * (y[i] * rs * gp);
            *(f32x4*)(F.out + (size_t)t * D + c) = x1[i];
            s2 += x1[i][0] * x1[i][0] + x1[i][1] * x1[i][1] + x1[i][2] * x1[i][2] + x1[i][3] * x1[i][3]; }
        s2 = wave_sum(s2);
        const float rs2 = rsqrtf(s2 * (1.0f / D) + 1e-6f);
#pragma unroll
        for (int i = 0; i < 4; ++i) { const int c = 4 * F.lane + 256 * i;
            const f32x4 gf = *(const f32x4*)(gpf + c), sc = *(const f32x4*)(m + 4096 + c), sh = *(const f32x4*)(m + 3072 + c);
            const f32x4 h = x1[i] * rs2 * gf * (sc + 1.0f) + sh;
            u32x2 w; w.x = pack2(h[0], h[1]); w.y = pack2(h[2], h[3]);
            u32x2 wl; wl.x = pack2(h[0] - lo2f(w.x), h[1] - hi2f(w.x)); wl.y = pack2(h[2] - lo2f(w.y), h[3] - hi2f(w.y));
            *(u32x2*)(H2 + (size_t)t * D + c) = w; *(u32x2*)(H2LO + (size_t)t * D + c) = wl; }
    }
}


__device__ __forceinline__ void ph_topk(const Frame& F, int layer) {
    const float* LOG = (const float*)(F.ws + WS_LOGITS); const float* rb = F.in[I_RBIAS] + layer * NE;
    int* IDX = (int*)(F.ws + WS_IDX); float* GATE = (float*)(F.ws + WS_GATE); int* RANK = (int*)(F.ws + WS_RANK);
    unsigned* BC = (unsigned*)(F.ws + WS_BC);
    unsigned* lcnt = (unsigned*)F.ldsf;
    const float bias = rb[F.lane];
    for (int base = F.bid * 64; base < T; base += F.G * 64) {
        if (F.tid < 64) lcnt[F.tid] = 0u;
        __syncthreads();
        float s[8], sel[8], tot[8], mysc[8]; int myidx[8]; unsigned lrank[8];
#pragma unroll
        for (int j = 0; j < 8; ++j) { const size_t o = (size_t)(base + F.wave * 8 + j) * NE + F.lane;
            s[j] = sigmoidf_(LOG[o] + LOG[(size_t)T * NE + o] + LOG[(size_t)2 * T * NE + o]); sel[j] = s[j] + bias; tot[j] = 0.f; mysc[j] = 0.f; myidx[j] = 0; }
#pragma unroll
        for (int k = 0; k < TOPK; ++k) {
            float bv[8]; int bi[8];
#pragma unroll
            for (int j = 0; j < 8; ++j) { bv[j] = sel[j]; bi[j] = F.lane; }
#pragma unroll
            for (int o = 32; o >= 1; o >>= 1) {
#pragma unroll
                for (int j = 0; j < 8; ++j) { const float ov = __shfl_xor(bv[j], o); const int oi = __shfl_xor(bi[j], o); const bool take = (ov > bv[j]) | ((ov == bv[j]) & (oi < bi[j]));     bv[j] = take ? ov : bv[j]; bi[j] = take ? oi : bi[j]; }
            }
#pragma unroll
            for (int j = 0; j < 8; ++j) { const float sc = __shfl(s[j], bi[j]); tot[j] += sc; const bool me = (F.lane == k); myidx[j] = me ? bi[j] : myidx[j]; mysc[j] = me ? sc : mysc[j]; sel[j] = (F.lane == bi[j]) ? -1e30f : sel[j]; }
        }
#pragma unroll
        for (int j = 0; j < 8; ++j) { const int t = base + F.wave * 8 + j; lrank[j] = 0u;
            if (F.lane < TOPK) { IDX[t * TOPK + F.lane] = myidx[j]; GATE[t * TOPK + F.lane] = 2.5f * mysc[j] / tot[j]; lrank[j] = atomicAdd(&lcnt[myidx[j]], 1u); } }
        __syncthreads();
        if (F.tid < 64) BC[(base >> 6) * 64 + F.tid] = lcnt[F.tid];
#pragma unroll
        for (int j = 0; j < 8; ++j) { const int t = base + F.wave * 8 + j; if (F.lane < TOPK) RANK[t * TOPK + F.lane] = (int)lrank[j]; }
        __syncthreads();
    }
}

__device__ __forceinline__ void ph_offsets(const Frame& F, int layer) {
    const unsigned* BC = (const unsigned*)(F.ws + WS_BC);
    const int* IDX = (const int*)(F.ws + WS_IDX); const int* RANK = (const int*)(F.ws + WS_RANK);
    int* POS = (int*)(F.ws + WS_POS); int* TOK = (int*)(F.ws + WS_TOK); int* TILEE = (int*)(F.ws + WS_TILEE); int* START = (int*)(F.ws + WS_START);
    int* sst = (int*)F.ldsf;
    constexpr int NG = T / 64;
    for (int g = F.bid; g < NG; g += F.G) {
        { const int e = F.tid & 63, part = F.tid >> 6; int tot = 0, pre = 0;
          for (int gg = part; gg < NG; gg += 8) { const int v = (int)BC[gg * 64 + e]; tot += v; if (gg < g) pre += v; }
          sst[512 + part * 64 + e] = tot; sst[1024 + part * 64 + e] = pre; }
        __syncthreads();
        if (F.tid < 64) { int tot = 0, pre = 0;
#pragma unroll
            for (int q = 0; q < 8; ++q) { tot += sst[512 + q * 64 + F.tid]; pre += sst[1024 + q * 64 + F.tid]; }
            sst[128 + F.tid] = tot; sst[256 + F.tid] = pre; }
        __syncthreads();
        if (F.tid == 0) { int acc = 0; for (int e = 0; e < NE; ++e) { const int c = sst[128 + e]; sst[e] = acc; acc += ((c + RP - 1) / RP) * RP; } sst[64] = acc; }
        __syncthreads();
        if (g == 0) {
            if (F.tid <= 64) START[F.tid] = sst[F.tid];
            if (F.tid == 65) START[65] = sst[64];
            const int ntile = sst[64] / RP;
            for (int i = F.tid; i < ntile; i += NTHREADS) { int e = 0; while (e < 63 && sst[e + 1] <= i * RP) ++e; TILEE[i] = e; }
            for (int q = F.tid; q < NE * RP; q += NTHREADS) { const int e = q / RP, r = q % RP, c = sst[128 + e]; if (sst[e] + c + r < sst[e + 1]) TOK[sst[e] + c + r] = 0; }
        }
        { const int sl = g * 64 * TOPK + F.tid;
          const int e = IDX[sl], p = sst[e] + sst[256 + e] + RANK[sl];
          POS[sl] = p; TOK[p] = sl / TOPK; }
        __syncthreads();
    }
}

__device__ __forceinline__ void ph_combine(const Frame& F, int layer, bool next) {
    const unsigned char* YB = (const unsigned char*)(F.ws + WS_YB); const int* POS = (const int*)(F.ws + WS_POS); const float* GATE = (const float*)(F.ws + WS_GATE);
    const int* START = (const int*)(F.ws + WS_START); const float* MOD = (const float*)(F.ws + WS_MOD);
    const float* gpo = F.in[I_NPOF] + layer * D;
    bf16_t* H3 = (bf16_t*)(F.ws + WS_H3);
    const int routed = START[65], c0 = 16 * F.lane;
    for (int t = F.bid * NWAVES + F.wave; t < T; t += F.G * NWAVES) {
        const int b = t / SEQ; const float* m = MOD + (layer * 2 + b) * 6144;
        int pos[TOPK]; float gk[TOPK];
        { const u32x4 p0 = *(const u32x4*)(POS + t * TOPK), p1 = *(const u32x4*)(POS + t * TOPK + 4); const f32x4 g0 = *(const f32x4*)(GATE + t * TOPK), g1 = *(const f32x4*)(GATE + t * TOPK + 4);
#pragma unroll
          for (int k = 0; k < 4; ++k) { pos[k] = (int)p0[k]; pos[4 + k] = (int)p1[k]; gk[k] = g0[k]; gk[4 + k] = g1[k]; } }
        u32x4 rw[TOPK + 1];
        rw[TOPK] = *(const u32x4*)(YB + (size_t)(routed + t) * D + c0);
#pragma unroll
        for (int k = 0; k < TOPK; ++k) rw[k] = *(const u32x4*)(YB + (size_t)pos[k] * D + c0);
        float y[16];
#pragma unroll
        for (int e = 0; e < 16; ++e) y[e] = 0.f;
        acc_fp8x16(y, rw[TOPK], 1.0f / YB_SCALE);
#pragma unroll
        for (int k = 0; k < TOPK; ++k) acc_fp8x16(y, rw[k], gk[k] * (1.0f / YB_SCALE));
        float ss = 0.f;
#pragma unroll
        for (int e = 0; e < 16; ++e) ss += y[e] * y[e];
        ss = wave_sum(ss);
        const float rs = rsqrtf(ss * (1.0f / D) + 1e-6f);
        f32x4 x2[4]; float s2 = 0.f;
#pragma unroll
        for (int i = 0; i < 4; ++i) { const int c = c0 + 4 * i;
            const f32x4 xv = *(const f32x4*)(F.out + (size_t)t * D + c), gm = *(const f32x4*)(m + 5120 + c), gp = *(const f32x4*)(gpo + c);
            const f32x4 yv = {y[4 * i], y[4 * i + 1], y[4 * i + 2], y[4 * i + 3]};
            x2[i] = xv + gm * (yv * rs * gp);
            *(f32x4*)(F.out + (size_t)t * D + c) = x2[i];
            s2 += x2[i][0] * x2[i][0] + x2[i][1] * x2[i][1] + x2[i][2] * x2[i][2] + x2[i][3] * x2[i][3]; }
        if (next) {
            s2 = wave_sum(s2);
            const float rs2 = rsqrtf(s2 * (1.0f / D) + 1e-6f);
            const float* m1 = MOD + ((layer + 1) * 2 + b) * 6144; const float* g1 = F.in[I_NPM] + (layer + 1) * D;
            u32x4 h0, h1;
#pragma unroll
            for (int i = 0; i < 4; ++i) { const int c = c0 + 4 * i;
                const f32x4 gf = *(const f32x4*)(g1 + c), sc = *(const f32x4*)(m1 + 1024 + c), sh = *(const f32x4*)(m1 + c);
                const f32x4 h = x2[i] * rs2 * gf * (sc + 1.0f) + sh;
                const unsigned w0 = pack2(h[0], h[1]), w1 = pack2(h[2], h[3]);
                if (i == 0) { h0[0] = w0; h0[1] = w1; } else if (i == 1) { h0[2] = w0; h0[3] = w1; } else if (i == 2) { h1[0] = w0; h1[1] = w1; } else { h1[2] = w0; h1[3] = w1; } }
            *(u32x4*)(H3 + (size_t)t * D + c0) = h0; *(u32x4*)(H3 + (size_t)t * D + c0 + 8) = h1;
        }
    }
}

#define SB_EXIT 110.0f

namespace pgx {
__device__ __forceinline__ int perm32(int rho) { const int n = rho >> 4, i = rho & 15; return 8 * (i >> 2) + 4 * n + (i & 3); }
struct Unit { const char* A; const int* tok; const char* B; int r0, c0, aux; };
template <bool SW, bool PERM, class Sched, class Epi>
__device__ __forceinline__ void gemm_phase(LAS unsigned char* lds, const int K, const unsigned lda  , const Sched& S, const Epi& E) {
    int tid_ = threadIdx.x; asm volatile("" : "+v"(tid_));
    const int tid = tid_, wid = __builtin_amdgcn_readfirstlane(tid >> 6), lane = tid & 63, wr = wid >> 2, wc = wid & 3, fr = lane & 15, fq = lane >> 4;
    const int nt = K / 64;
    int Rr[2], Cc[2]; unsigned voffB[2];
#pragma unroll
    for (int i = 0; i < 2; ++i) { stage_rc(tid * 16 + i * 8192, Rr[i], Cc[i]); const int Rb = PERM ? ((Rr[i] & ~31) + perm32(Rr[i] & 31)) : Rr[i]; voffB[i] = (unsigned)(Rb * K + Cc[i]) * 2u; }
    const size_t kstep = 128, hstepB = (size_t)128 * K * 2;
    const unsigned ldsw = (unsigned)wid * 1024u;
    const int aoff = lds_byte(wr * 64 + fr, fq * 8), boff = lds_byte(wc * 32 + fr, fq * 8);
#define PX_SA(b, h) (((b) * 2 + (h)) * HTB)
#define PX_SB(b, h) ((4 + (b) * 2 + (h)) * HTB)
#define PX_STAGE(bufoff, gbase, voff) do { _Pragma("unroll") for (int _i = 0; _i < 2; ++_i) \
        __builtin_amdgcn_global_load_lds((const unsigned*)((const char*)(gbase) + (voff)[_i]), (LAS unsigned*)(lds + (bufoff) + ldsw + _i * 8192), 16, 0, 0); } while (0)
#define PX_LDA(dst, b, h) do { _Pragma("unroll") for (int m = 0; m < 4; ++m) _Pragma("unroll") for (int k = 0; k < 2; ++k) dst[m][k] = *(const LAS bf16x8*)(lds + PX_SA(b, h) + aoff + m * 2048 + k * 1024); } while (0)
#define PX_LDB(dst, b, h) do { _Pragma("unroll") for (int n = 0; n < 2; ++n) _Pragma("unroll") for (int k = 0; k < 2; ++k) dst[n][k] = *(const LAS bf16x8*)(lds + PX_SB(b, h) + boff + n * 2048 + k * 1024); } while (0)
#define PX_MMA(ai, bj, At, Bt) do { __builtin_amdgcn_s_setprio(1); _Pragma("unroll") for (int m = 0; m < 4; ++m) _Pragma("unroll") for (int n = 0; n < 2; ++n) _Pragma("unroll") for (int k = 0; k < 2; ++k) \
        acc[ai][bj][m][n] = SW ? __builtin_amdgcn_mfma_f32_16x16x32_bf16(Bt[n][k], At[m][k], acc[ai][bj][m][n], 0, 0, 0) : __builtin_amdgcn_mfma_f32_16x16x32_bf16(At[m][k], Bt[n][k], acc[ai][bj][m][n], 0, 0, 0); __builtin_amdgcn_s_setprio(0); } while (0)
#define PX_WAIT_L(n) asm volatile("s_waitcnt lgkmcnt(" #n ")" ::: "memory")
#define PX_BAR __builtin_amdgcn_s_barrier()
#define PX_SCHED __builtin_amdgcn_sched_barrier(0)
#define PX_OFFS(dst, un) do { _Pragma("unroll") for (int h_ = 0; h_ < 2; ++h_) _Pragma("unroll") for (int i_ = 0; i_ < 2; ++i_) { \
        const int row_ = h_ * 128 + Rr[i_]; const unsigned rid_ = (un).tok ? (unsigned)(un).tok[row_] : (unsigned)row_; dst[h_][i_] = rid_ * lda + (unsigned)Cc[i_] * 2u; } } while (0)
    Unit cur, nxt; int ui = 0;
    if (!S.next(0, cur)) return;
    f32x4 acc[2][2][4][2];
#pragma unroll
    for (int a = 0; a < 2; ++a)
#pragma unroll
        for (int b = 0; b < 2; ++b)
#pragma unroll
            for (int m = 0; m < 4; ++m)
#pragma unroll
                for (int n = 0; n < 2; ++n) acc[a][b][m][n] = (f32x4){0.f, 0.f, 0.f, 0.f};
    bf16x8 At[4][2], B0[2][2], B1[2][2];
    unsigned oc[2][2], on[2][2];
    PX_OFFS(oc, cur); asm volatile("" : "+v"(oc[0][0]), "+v"(oc[0][1]), "+v"(oc[1][0]), "+v"(oc[1][1]));
    const char* cA = cur.A; const char* cB = cur.B;
    PX_STAGE(PX_SB(0, 0), cB, voffB); PX_STAGE(PX_SA(0, 0), cA, oc[0]); PX_STAGE(PX_SB(0, 1), cB + hstepB, voffB); PX_STAGE(PX_SA(0, 1), cA, oc[1]);
    if (wr == 1) PX_BAR;
    WAIT_V(4); PX_BAR;
    PX_STAGE(PX_SB(1, 0), cB + kstep, voffB); PX_STAGE(PX_SA(1, 0), cA + kstep, oc[0]); PX_STAGE(PX_SB(1, 1), cB + hstepB + kstep, voffB);
    WAIT_V(6); PX_BAR;
    for (;;) {
        const bool has_next = S.next(ui + 1, nxt);
        const char* nA = has_next ? nxt.A : cA; const char* nB = has_next ? nxt.B : cB;
        if (has_next) { PX_OFFS(on, nxt); asm volatile("" : "+v"(on[0][0]), "+v"(on[0][1]), "+v"(on[1][0]), "+v"(on[1][1])); } else {
#pragma unroll
            for (int h_ = 0; h_ < 2; ++h_)
#pragma unroll
                for (int i_ = 0; i_ < 2; ++i_) on[h_][i_] = oc[h_][i_]; }
#pragma unroll 1
        for (int t = 0; t < nt; t += 2) {
            const bool last = (t == nt - 2);
            const char* a1 = cA + (size_t)(t + 1) * kstep;
            const char* a2 = last ? nA : cA + (size_t)(t + 2) * kstep; const char* b2 = last ? nB : cB + (size_t)(t + 2) * kstep;
            const char* a3 = a2 + kstep; const char* b3 = b2 + kstep;
            unsigned o2[2][2];
#pragma unroll
            for (int h_ = 0; h_ < 2; ++h_)
#pragma unroll
                for (int i_ = 0; i_ < 2; ++i_) o2[h_][i_] = last ? on[h_][i_] : oc[h_][i_];
            PX_LDB(B0, 0, 0); PX_SCHED; PX_LDA(At, 0, 0); PX_STAGE(PX_SA(1, 1), a1, oc[1]);
            PX_WAIT_L(8); PX_BAR; PX_WAIT_L(0); PX_MMA(0, 0, At, B0); PX_BAR; PX_SCHED;
            PX_LDB(B1, 0, 1); PX_STAGE(PX_SB(0, 0), b2, voffB);
            PX_BAR; PX_WAIT_L(0); PX_MMA(0, 1, At, B1); PX_BAR;
            PX_LDA(At, 0, 1); PX_STAGE(PX_SA(0, 0), a2, o2[0]);
            PX_BAR; PX_WAIT_L(0); PX_MMA(1, 0, At, B0); PX_BAR; PX_SCHED;
            PX_STAGE(PX_SB(0, 1), b2 + hstepB, voffB);
            WAIT_V(6); PX_BAR; PX_MMA(1, 1, At, B1); PX_BAR;
            PX_LDB(B0, 1, 0); PX_SCHED; PX_LDA(At, 1, 0); PX_STAGE(PX_SA(0, 1), a2, o2[1]);
            PX_WAIT_L(8); PX_BAR; PX_WAIT_L(0); PX_MMA(0, 0, At, B0); PX_BAR; PX_SCHED;
            PX_LDB(B1, 1, 1); PX_STAGE(PX_SB(1, 0), b3, voffB);
            PX_BAR; PX_WAIT_L(0); PX_MMA(0, 1, At, B1); PX_BAR;
            PX_LDA(At, 1, 1); PX_STAGE(PX_SA(1, 0), a3, o2[0]);
            PX_BAR; PX_WAIT_L(0); PX_MMA(1, 0, At, B0); PX_BAR; PX_SCHED;
            PX_STAGE(PX_SB(1, 1), b3 + hstepB, voffB);
            WAIT_V(6); PX_BAR; PX_MMA(1, 1, At, B1); PX_BAR;
        }
        E(acc, cur, wr, wc, fr, fq);
        if (!has_next) break;
#pragma unroll
        for (int a = 0; a < 2; ++a)
#pragma unroll
            for (int b = 0; b < 2; ++b)
#pragma unroll
                for (int m = 0; m < 4; ++m)
#pragma unroll
                    for (int n = 0; n < 2; ++n) acc[a][b][m][n] = (f32x4){0.f, 0.f, 0.f, 0.f};
        cur = nxt; cA = nA; cB = nB; ++ui;
#pragma unroll
        for (int h_ = 0; h_ < 2; ++h_)
#pragma unroll
            for (int i_ = 0; i_ < 2; ++i_) oc[h_][i_] = on[h_][i_];
    }
    WAIT_V(0);
    if (wr == 0) PX_BAR;
    PX_BAR;
#undef PX_SA
#undef PX_SB
#undef PX_STAGE
#undef PX_LDA
#undef PX_LDB
#undef PX_MMA
#undef PX_WAIT_L
#undef PX_BAR
#undef PX_SCHED
#undef PX_OFFS
}
__device__ __forceinline__ unsigned cvt_pk_bf16(float lo, float hi) { return pack2(lo, hi); }
}

__device__ __forceinline__ size_t hm_off(int t, int c) { return ((size_t)((t / SEQ) * NH + (c >> 6)) * SEQ + (t % SEQ)) * 64 + (c & 63); }
#define EPI_MT(acc) (int)(sizeof(acc) / sizeof(acc[0]))
__device__ __forceinline__ void st_bf4(bf16_t* p, const f32x4& v) { u32x2 w; w.x = pack2(v[0], v[1]); w.y = pack2(v[2], v[3]); *(u32x2*)p = w; }

__device__ __forceinline__ void ph_lora_up_sg(const Frame& F) {
    const bf16_t* LORA = (const bf16_t*)(F.ws + WS_LORA); const bf16_t* WLUP = (const bf16_t*)(F.ws + WS_WLUP);
    float* LD = (float*)(F.ws + WS_LD); bf16_t* AA = (bf16_t*)(F.ws + WS_AA); bf16_t* GG = (bf16_t*)(F.ws + WS_GG);
    for (int u = F.bid; u < 3 * 64 * 8; u += F.G) {
        const int which = u / 512, v = u % 512, mt = v / 8, col0 = (v % 8) * 128;
        const int K = which == 2 ? 128 : 64, koff = which * 64;
        ASeg A; A.p[0] = LORA + (size_t)mt * 256 * 256 + koff; A.p[1] = A.p[0]; A.p[2] = A.p[0]; A.segTiles = 4;
        const bf16_t* Bt = WLUP + (which == 0 ? 0 : (which == 1 ? 1024 * 64 : 2 * 1024 * 64)) + (size_t)col0 * K;
        const size_t obase = (size_t)mt * 256 * D + col0;
        sg_tile<128>(F.lds, A, [](int R) { return (unsigned)R * 512u; }, Bt, K, K / 64,
            [&](auto& acc, int r0, int c0, int fr, int fq) {
#pragma unroll
                for (int m = 0; m < EPI_MT(acc); ++m)
#pragma unroll
                    for (int q = 0; q < 4; ++q) {
                        const int c = c0 + 16 * q + 4 * fq; const size_t o = hm_off(mt * 256 + r0 + 16 * m + fr, col0 + c);
                        if (which == 0) { const f32x4 w0 = *(const f32x4*)(F.in[I_W0] + col0 + c); f32x4 r;
#pragma unroll
                            for (int e = 0; e < 4; ++e) { const float wl = w0[e] + acc[m][q][e]; r[e] = -fexp_(-softplusf_(-wl) - 0.5f); }
                            *(f32x4*)(LD + o) = r; }
                        else if (which == 1) { const f32x4 a0 = *(const f32x4*)(F.in[I_A0] + col0 + c); f32x4 r;
#pragma unroll
                            for (int e = 0; e < 4; ++e) r[e] = sigmoidf_(a0[e] + acc[m][q][e]);
                            st_bf4(AA + o, r); }
                        else st_bf4(GG + o, acc[m][q]);
                    }
            });
    }
}
__device__ __forceinline__ void ph_router_sg(const Frame& F, int layer) {
    const bf16_t* H2 = (const bf16_t*)(F.ws + WS_H2); const bf16_t* H2LO = (const bf16_t*)(F.ws + WS_H2LO);
    const bf16_t* WRT = (const bf16_t*)(F.ws + WS_WRT) + (size_t)layer * 64 * 3072; float* LOG = (float*)(F.ws + WS_LOGITS);
    for (int u = F.bid; u < 64 * 3; u += F.G) {
        const int mt = u / 3, sgi = u % 3;
        ASeg A; A.p[0] = (sgi == 2 ? H2LO : H2) + (size_t)mt * 256 * D; A.p[1] = A.p[0]; A.p[2] = A.p[0]; A.segTiles = 16;
        float* out = LOG + (size_t)sgi * T * NE;
        sg_tile<64>(F.lds, A, [](int R) { return (unsigned)R * (D * 2); }, WRT + sgi * 1024, 3072, 16,
            [&](auto& acc, int r0, int c0, int fr, int fq) {
#pragma unroll
                for (int m = 0; m < EPI_MT(acc); ++m)
#pragma unroll
                    for (int q = 0; q < 4; ++q) *(f32x4*)(out + (size_t)(mt * 256 + r0 + 16 * m + fr) * NE + c0 + 16 * q + 4 * fq) = acc[m][q];
            });
    }
}

constexpr int MS = 72;
constexpr int SLOT = 64 * MS * 2;
__device__ __forceinline__ int ms_off(int row, int col) { return row * MS + col; }
constexpr size_t WS_BONUS = 3 * MiB;
constexpr size_t WS_RP = WS_BIG + 128 * MiB;
constexpr size_t WS_OL = WS_BIG + 160 * MiB;
constexpr size_t WS_G2 = WS_BIG + 296 * MiB;
constexpr size_t WS_DM = WS_BIG + 328 * MiB;
constexpr size_t WS_ST = WS_BIG + 360 * MiB;

__device__ __forceinline__ void st4_lds(LAS bf16_t* p, const f32x4& v) { u32x2 w; w.x = pack2(v[0], v[1]); w.y = pack2(v[2], v[3]); *(LAS u32x2*)p = w; }
__device__ __forceinline__ f32x4 ld4_lds(const LAS bf16_t* p) { const u32x2 w = *(const LAS u32x2*)p; return (f32x4){lo2f(w.x), hi2f(w.x), lo2f(w.y), hi2f(w.y)}; }

__device__ __forceinline__ void ph_wkv_chunk(const Frame& F) {
    const bf16_t* RKV = (const bf16_t*)(F.ws + WS_RKV); const float* LD = (const float*)(F.ws + WS_LD); const bf16_t* AA = (const bf16_t*)(F.ws + WS_AA);
    const bf16_t* Rb = RKV; const bf16_t* Kb = RKV + (size_t)T * D; const bf16_t* Vb = RKV + (size_t)2 * T * D;
    bf16_t* RP = (bf16_t*)(F.ws + WS_RP); bf16_t* OL = (bf16_t*)(F.ws + WS_OL); bf16_t* G2 = (bf16_t*)(F.ws + WS_G2); bf16_t* DM = (bf16_t*)(F.ws + WS_DM);
    float* BONUS = (float*)(F.ws + WS_BONUS);
#define SL(k) ((LAS bf16_t*)(F.lds + (k) * SLOT))
#define AT(k, r, c) (SL(k) + ms_off((r), (c)))
    LAS float* segtot = (LAS float*)(F.lds + 15 * SLOT);
    LAS float* WCs = segtot + 512;
    const int w = F.wave, lane = F.lane, fr = lane & 15, fq = lane >> 4, mt = w >> 1, ntb = 2 * (w & 1);
    for (int cid = F.bid; cid < NB * NH * (SEQ / 64); cid += F.G) {
        const int bh = cid / (SEQ / 64), c = cid % (SEQ / 64), b = bh / NH, h = bh % NH;
        const size_t tok0 = (size_t)b * SEQ + (size_t)c * 64;
        {
            const int t = F.tid >> 3, jg = lane & 7, tl = lane >> 3, ch0 = h * 64 + 8 * jg;
            const size_t o = ((size_t)bh * SEQ + (size_t)c * 64 + t) * 64 + 8 * jg;
            const u32x4 rr = *(const u32x4*)(Rb + o), kr = *(const u32x4*)(Kb + o), vr = *(const u32x4*)(Vb + o), ar = *(const u32x4*)(AA + o);
            const f32x4 l0 = *(const f32x4*)(LD + o), l1 = *(const f32x4*)(LD + o + 4);
            float r[8], k[8], a[8], ld[8], cum[8];
#pragma unroll
            for (int q = 0; q < 4; ++q) { r[2 * q] = lo2f(rr[q]); r[2 * q + 1] = hi2f(rr[q]); k[2 * q] = lo2f(kr[q]); k[2 * q + 1] = hi2f(kr[q]); a[2 * q] = lo2f(ar[q]); a[2 * q + 1] = hi2f(ar[q]); ld[q] = l0[q]; ld[4 + q] = l1[q]; }
#pragma unroll
            for (int e = 0; e < 8; ++e) { float v = ld[e];
                float u1 = __shfl_up(v, 8);  if (tl >= 1) v += u1;
                float u2 = __shfl_up(v, 16); if (tl >= 2) v += u2;
                float u4 = __shfl_up(v, 32); if (tl >= 4) v += u4;
                cum[e] = v; }
            if (tl == 7) {
#pragma unroll
                for (int e = 0; e < 8; ++e) segtot[w * 64 + 8 * jg + e] = cum[e]; }
            __syncthreads();
            float tot[8];
#pragma unroll
            for (int e = 0; e < 8; ++e) tot[e] = 0.f;
#pragma unroll
            for (int ww = 0; ww < 8; ++ww) {
                const f32x4 s0 = *(const LAS f32x4*)(segtot + ww * 64 + 8 * jg), s1 = *(const LAS f32x4*)(segtot + ww * 64 + 8 * jg + 4);
#pragma unroll
                for (int q = 0; q < 4; ++q) { tot[q] += s0[q]; tot[4 + q] += s1[q]; if (ww < w) { cum[q] += s0[q]; cum[4 + q] += s1[q]; } }
            }
            if (t == 0) {
#pragma unroll
                for (int e = 0; e < 8; ++e) WCs[8 * jg + e] = fexp_(tot[e]); }
            float kkr[8], kf[8], ss = 0.f, bon = 0.f;
#pragma unroll
            for (int e = 0; e < 8; ++e) { kkr[e] = k[e] * F.in[I_KK][ch0 + e]; ss += kkr[e] * kkr[e]; kf[e] = k[e] * (1.0f + (a[e] - 1.0f) * F.in[I_KA][ch0 + e]); bon += r[e] * kf[e] * F.in[I_RK][ch0 + e]; }
            ss += __shfl_xor(ss, 1); ss += __shfl_xor(ss, 2); ss += __shfl_xor(ss, 4);
            bon += __shfl_xor(bon, 1); bon += __shfl_xor(bon, 2); bon += __shfl_xor(bon, 4);
            if (jg == 0) BONUS[(tok0 + t) * NH + h] = bon;
            const float inv = 1.0f / fmaxf(sqrtf(ss), 1e-12f);
            float av[8], bv[8], kv[8], rv[8];
#pragma unroll
            for (int e = 0; e < 8; ++e) { const float kk = kkr[e] * inv, en = fexp_(-cum[e]);
                av[e] = -kk * fexp_(cum[e] - ld[e]); bv[e] = kk * a[e] * en; kv[e] = kf[e] * en; rv[e] = r[e] * fexp_(cum[e]); }
            u32x4 pa, pr, pb, pk;
#pragma unroll
            for (int q = 0; q < 4; ++q) { pa[q] = pack2(av[2 * q], av[2 * q + 1]); pr[q] = pack2(rv[2 * q], rv[2 * q + 1]); pb[q] = pack2(bv[2 * q], bv[2 * q + 1]); pk[q] = pack2(kv[2 * q], kv[2 * q + 1]); }
            *(LAS u32x4*)AT(0, t, 8 * jg) = pa; *(LAS u32x4*)AT(2, t, 8 * jg) = pr; *(LAS u32x4*)AT(3, t, 8 * jg) = pb; *(LAS u32x4*)AT(5, t, 8 * jg) = pk;
#pragma unroll
            for (int q = 0; q < 4; ++q) {
                *AT(1, 8 * jg + 2 * q, t) = (bf16_t)(pa[q] & 0xffffu); *AT(1, 8 * jg + 2 * q + 1, t) = (bf16_t)(pa[q] >> 16);
                *AT(4, 8 * jg + 2 * q, t) = (bf16_t)(pb[q] & 0xffffu); *AT(4, 8 * jg + 2 * q + 1, t) = (bf16_t)(pb[q] >> 16);
                *AT(6, 8 * jg + 2 * q, t) = (bf16_t)(pk[q] & 0xffffu); *AT(6, 8 * jg + 2 * q + 1, t) = (bf16_t)(pk[q] >> 16);
                *AT(7, 8 * jg + 2 * q, t) = (bf16_t)(vr[q] & 0xffffu); *AT(7, 8 * jg + 2 * q + 1, t) = (bf16_t)(vr[q] >> 16);
            }
        }
        __syncthreads();
#define LF2(dst, k, r0) do { dst[0] = *(const LAS bf16x8*)AT(k, (r0) + fr, fq * 8); dst[1] = *(const LAS bf16x8*)AT(k, (r0) + fr, 32 + fq * 8); } while (0)
#define MMA2(acc, xf, yf) do { acc = __builtin_amdgcn_mfma_f32_16x16x32_bf16(xf[0], yf[0], acc, 0, 0, 0); acc = __builtin_amdgcn_mfma_f32_16x16x32_bf16(xf[1], yf[1], acc, 0, 0, 0); } while (0)
        {
            bf16x8 xa[2], xr[2]; LF2(xa, 0, 16 * mt); LF2(xr, 2, 16 * mt);
#pragma unroll
            for (int q2 = 0; q2 < 2; ++q2) {
                const int nt = ntb + q2;
                bf16x8 yb[2], yk[2]; LF2(yb, 3, 16 * nt); LF2(yk, 5, 16 * nt);
                { f32x4 acc = {0.f, 0.f, 0.f, 0.f}; MMA2(acc, xa, yb);
                  const int sidx = 16 * nt + fr, t0 = 16 * mt + 4 * fq;
#pragma unroll
                  for (int e = 0; e < 4; ++e) { if (!(sidx < t0 + e)) acc[e] = 0.f; *AT(8, t0 + e, sidx) = f2bf(acc[e]); }
                  st4_lds(AT(9, sidx, t0), acc); }
                const int tt = 16 * mt + fr, s0 = 16 * nt + 4 * fq;
                { f32x4 acc = {0.f, 0.f, 0.f, 0.f}; MMA2(acc, yk, xa);
#pragma unroll
                  for (int e = 0; e < 4; ++e) if (!(s0 + e < tt)) acc[e] = 0.f;
                  st4_lds(AT(10, tt, s0), acc); }
                { f32x4 acc = {0.f, 0.f, 0.f, 0.f}; MMA2(acc, yb, xr);
#pragma unroll
                  for (int e = 0; e < 4; ++e) if (!(s0 + e <= tt)) acc[e] = 0.f;
                  st4_lds(AT(11, tt, s0), acc); }
                { f32x4 acc = {0.f, 0.f, 0.f, 0.f}; MMA2(acc, yk, xr);
#pragma unroll
                  for (int e = 0; e < 4; ++e) if (!(s0 + e <= tt)) acc[e] = 0.f;
                  st4_lds(AT(12, tt, s0), acc); }
            }
        }
        __syncthreads();
#define WKV_SQ(xi, ti, xo, to) do { bf16x8 xl[2]; LF2(xl, xi, 16 * mt); _Pragma("unroll") for (int q2 = 0; q2 < 2; ++q2) { const int nt = ntb + q2; bf16x8 yl[2]; LF2(yl, ti, 16 * nt); \
            f32x4 acc = {0.f, 0.f, 0.f, 0.f}; MMA2(acc, xl, yl); const int n_ = 16 * nt + fr, m0_ = 16 * mt + 4 * fq; \
            _Pragma("unroll") for (int e = 0; e < 4; ++e) *AT(xo, m0_ + e, n_) = f2bf(acc[e]); st4_lds(AT(to, n_, m0_), acc); } } while (0)
#define WKV_PM(pi, ti, po) do { bf16x8 xp[2]; LF2(xp, pi, 16 * mt); _Pragma("unroll") for (int q2 = 0; q2 < 2; ++q2) { const int nt = ntb + q2; bf16x8 yl[2]; LF2(yl, ti, 16 * nt); \
            const int m_ = 16 * mt + fr, n0_ = 16 * nt + 4 * fq; f32x4 acc = ld4_lds(AT(pi, m_, n0_)); MMA2(acc, yl, xp); st4_lds(AT(po, m_, n0_), acc); } } while (0)
#define WKV_PMSQ(pi, xi, ti, po, xo, to) do { bf16x8 xp[2], xl[2]; LF2(xp, pi, 16 * mt); LF2(xl, xi, 16 * mt); _Pragma("unroll") for (int q2 = 0; q2 < 2; ++q2) { const int nt = ntb + q2; bf16x8 yl[2]; LF2(yl, ti, 16 * nt); \
            { const int m_ = 16 * mt + fr, n0_ = 16 * nt + 4 * fq; f32x4 acc = ld4_lds(AT(pi, m_, n0_)); MMA2(acc, yl, xp); st4_lds(AT(po, m_, n0_), acc); } \
            { f32x4 acc = {0.f, 0.f, 0.f, 0.f}; MMA2(acc, xl, yl); const int n_ = 16 * nt + fr, m0_ = 16 * mt + 4 * fq; \
              _Pragma("unroll") for (int e = 0; e < 4; ++e) *AT(xo, m0_ + e, n_) = f2bf(acc[e]); st4_lds(AT(to, n_, m0_), acc); } } } while (0)
        WKV_SQ(8, 9, 0, 3);
        for (int idx = F.tid; idx < 64 * 16; idx += NTHREADS) { const int t = idx >> 4, s4 = (idx & 15) * 4; u32x2 v = *(const LAS u32x2*)AT(8, t, s4);
            if ((t >> 2) == (s4 >> 2)) { const unsigned one = 0x3F80u; const int e = t & 3; if (e == 0) v.x = (v.x & 0xffff0000u) | one; else if (e == 1) v.x = (v.x & 0xffffu) | (one << 16); else if (e == 2) v.y = (v.y & 0xffff0000u) | one; else v.y = (v.y & 0xffffu) | (one << 16); }
            *(LAS u32x2*)AT(13, t, s4) = v; }
        __syncthreads();
        WKV_PMSQ(13, 0, 3, 14, 8, 9); __syncthreads();
        WKV_PMSQ(14, 8, 9, 13, 0, 3); __syncthreads();
        WKV_PMSQ(13, 0, 3, 14, 8, 9); __syncthreads();
        WKV_PMSQ(14, 8, 9, 13, 0, 3); __syncthreads();
        WKV_PM(13, 3, 14); __syncthreads();
        {
            bf16x8 xt[2], xm[2]; LF2(xt, 14, 16 * mt); LF2(xm, 10, 16 * mt);
#pragma unroll
            for (int q2 = 0; q2 < 2; ++q2) {
                const int nt = ntb + q2, n_ = 16 * nt + fr, m0_ = 16 * mt + 4 * fq;
                bf16x8 ya[2], yv[2]; LF2(ya, 1, 16 * nt); LF2(yv, 7, 16 * nt);
                { f32x4 acc = {0.f, 0.f, 0.f, 0.f}; MMA2(acc, xt, ya); st4_lds(AT(9, n_, m0_), acc); }
                { f32x4 acc = {0.f, 0.f, 0.f, 0.f}; MMA2(acc, xm, yv); st4_lds(AT(8, n_, m0_), acc); }
            }
        }
        __syncthreads();
        {
            bf16x8 xt[2], xb[2]; LF2(xt, 14, 16 * mt); LF2(xb, 11, 16 * mt);
#pragma unroll
            for (int q2 = 0; q2 < 2; ++q2) {
                const int nt = ntb + q2;
                bf16x8 yz[2], yp[2]; LF2(yz, 8, 16 * nt); LF2(yp, 9, 16 * nt);
                { const int n_ = 16 * nt + fr, m0_ = 16 * mt + 4 * fq; f32x4 acc = {0.f, 0.f, 0.f, 0.f}; MMA2(acc, xt, yz); st4_lds(AT(0, n_, m0_), acc); }
                { const int m_ = 16 * mt + fr, n0_ = 16 * nt + 4 * fq; f32x4 acc = ld4_lds(AT(2, m_, n0_)); MMA2(acc, yp, xb);
                  st_bf4(RP + (size_t)cid * 4096 + (unsigned)((mt * 2 + (nt >> 1)) * 512 + (fr * 4 + 2 * (nt & 1) + (fq >> 1)) * 8 + 4 * (fq & 1)), acc); }
            }
        }
        __syncthreads();
        {
            bf16x8 xb[2], xk[2], xp[2], xu[2], xv[2]; LF2(xb, 11, 16 * mt); LF2(xk, 12, 16 * mt); LF2(xp, 9, 16 * mt); LF2(xu, 0, 16 * mt); LF2(xv, 7, 16 * mt);
#pragma unroll
            for (int q2 = 0; q2 < 2; ++q2) {
                const int nt = ntb + q2;
                bf16x8 yu[2], yv[2], yb[2], yk[2]; LF2(yu, 0, 16 * nt); LF2(yv, 7, 16 * nt); LF2(yb, 4, 16 * nt); LF2(yk, 6, 16 * nt);
                { f32x4 acc = {0.f, 0.f, 0.f, 0.f}; MMA2(acc, yu, xb); MMA2(acc, yv, xk);
                  st_bf4(OL + (size_t)cid * 4096 + (unsigned)((16 * mt + fr) * 64 + 16 * nt + 4 * fq), acc); }
                { const int jp = 16 * nt + fr, j0 = 16 * mt + 4 * fq; f32x4 acc = {0.f, 0.f, 0.f, 0.f}; MMA2(acc, xp, yb);
                  const float wc = WCs[jp];
#pragma unroll
                  for (int e = 0; e < 4; ++e) acc[e] = (acc[e] + ((j0 + e == jp) ? 1.0f : 0.0f)) * wc;
                  st_bf4(G2 + (size_t)cid * 4096 + (unsigned)((nt * 2 + (mt >> 1)) * 512 + lane * 8 + (mt & 1) * 4), acc); }
                { const int i_ = 16 * mt + fr, jp0 = 16 * nt + 4 * fq; f32x4 acc = {0.f, 0.f, 0.f, 0.f}; MMA2(acc, yb, xu); MMA2(acc, yk, xv);
#pragma unroll
                  for (int e = 0; e < 4; ++e) acc[e] *= WCs[jp0 + e];
                  st_bf4(DM + (size_t)cid * 4096 + (unsigned)(i_ * 64 + jp0), acc); }
            }
        }
        __syncthreads();
    }
#undef LF2
#undef MMA2
#undef WKV_PMSQ
#undef WKV_SQ
#undef WKV_PM
#undef AT
#undef SL
}

__device__ __forceinline__ void ph_wkv_carry(const Frame& F) {
    const bf16_t* G2 = (const bf16_t*)(F.ws + WS_G2); const bf16_t* DM = (const bf16_t*)(F.ws + WS_DM); bf16_t* ST = (bf16_t*)(F.ws + WS_ST);
    const int lane = F.lane, fr = lane & 15, fq = lane >> 4;
    const bool loader = F.wave >= 4; const int lw = F.wave - 4, i = 16 * (F.wave & 3) + fr;
    constexpr int NC = SEQ / 64;
    for (int ch = F.bid; ch < NB * NH; ch += F.G) {
        const size_t cbase = (size_t)ch * NC;
#define CARRY_ISSUE(c_) do { const int cc_ = (c_) < NC ? (c_) : NC - 1; const size_t cid_ = cbase + cc_; \
        _Pragma("unroll") for (int q_ = 0; q_ < 4; ++q_) { const int j_ = lw * 4 + q_; \
            const bf16_t* src_ = (j_ < 8 ? G2 + cid_ * 4096 + j_ * 512 : DM + cid_ * 4096 + (j_ - 8) * 512) + lane * 8; \
            __builtin_amdgcn_global_load_lds((const unsigned*)src_, (LAS unsigned*)(F.lds + ((c_) & 7) * 16384 + j_ * 1024), 16, 0, 0); } } while (0)
        f32x4 st[4];
#pragma unroll
        for (int r = 0; r < 4; ++r) st[r] = (f32x4){0.f, 0.f, 0.f, 0.f};
        bf16x8 gc[8]; u32x2 dc[4];
#define CARRY_RING_READ(c_) do { const LAS unsigned char* slot_ = F.lds + ((c_) & 7) * 16384; \
        _Pragma("unroll") for (int f = 0; f < 8; ++f) gc[f] = *(const LAS bf16x8*)(slot_ + f * 1024 + lane * 16); \
        _Pragma("unroll") for (int r = 0; r < 4; ++r) dc[r] = *(const LAS u32x2*)(slot_ + 8192 + (i * 64 + 16 * r + 4 * fq) * 2); } while (0)
        if (loader) {
#pragma unroll
            for (int c = 0; c < 7; ++c) CARRY_ISSUE(c);
            WAIT_V(20);
        }
        SBAR();
        if (!loader) CARRY_RING_READ(0);
#pragma unroll 1
        for (int c = 0; c < NC; ++c) {
            if (loader) {
                CARRY_ISSUE(c + 7);
                WAIT_V(20);
            } else {
                const size_t cid = cbase + c;
                union { bf16x8 v; unsigned u[4]; } b0, b1;
                b0.u[0] = pack2(st[0][0], st[0][1]); b0.u[1] = pack2(st[0][2], st[0][3]); b0.u[2] = pack2(st[1][0], st[1][1]); b0.u[3] = pack2(st[1][2], st[1][3]);
                b1.u[0] = pack2(st[2][0], st[2][1]); b1.u[1] = pack2(st[2][2], st[2][3]); b1.u[2] = pack2(st[3][0], st[3][1]); b1.u[3] = pack2(st[3][2], st[3][3]);
                f32x4 acc[4];
#pragma unroll
                for (int r = 0; r < 4; ++r) { acc[r] = (f32x4){lo2f(dc[r].x), hi2f(dc[r].x), lo2f(dc[r].y), hi2f(dc[r].y)};
                    acc[r] = __builtin_amdgcn_mfma_f32_16x16x32_bf16(gc[r * 2 + 0], b0.v, acc[r], 0, 0, 0); }
#pragma unroll
                for (int r = 0; r < 4; ++r) acc[r] = __builtin_amdgcn_mfma_f32_16x16x32_bf16(gc[r * 2 + 1], b1.v, acc[r], 0, 0, 0);
                { const unsigned wsl = (unsigned)(F.wave & 3);
                  bf16_t* stp = ST + cid * 4096;
                  const unsigned ob = (unsigned)(((fr >> 2) * 2) * 512 + ((4 * wsl + (fr & 3)) * 4 + (fq >> 1)) * 8 + 4 * (fq & 1));
                  u32x2 w0; w0.x = b0.u[0]; w0.y = b0.u[1]; *(u32x2*)(stp + ob) = w0;
                  u32x2 w1; w1.x = b0.u[2]; w1.y = b0.u[3]; *(u32x2*)(stp + ob + 16) = w1;
                  u32x2 w2; w2.x = b1.u[0]; w2.y = b1.u[1]; *(u32x2*)(stp + ob + 512) = w2;
                  u32x2 w3; w3.x = b1.u[2]; w3.y = b1.u[3]; *(u32x2*)(stp + ob + 512 + 16) = w3; }
                if (c + 1 < NC) CARRY_RING_READ(c + 1);
#pragma unroll
                for (int r = 0; r < 4; ++r) st[r] = acc[r];
            }
            SBAR();
        }
        if (loader) WAIT_V(0);
        SBAR();
#undef CARRY_RING_READ
#undef CARRY_ISSUE
    }
}

__device__ __forceinline__ void ph_wkv_out(const Frame& F) {
    const bf16_t* RP = (const bf16_t*)(F.ws + WS_RP); const bf16_t* OL = (const bf16_t*)(F.ws + WS_OL); const bf16_t* ST = (const bf16_t*)(F.ws + WS_ST);
    const bf16_t* Vb = (const bf16_t*)(F.ws + WS_RKV) + (size_t)2 * T * D; const bf16_t* GG = (const bf16_t*)(F.ws + WS_GG); const float* BONUS = (const float*)(F.ws + WS_BONUS);
    bf16_t* OG = (bf16_t*)(F.ws + WS_OG);
    const int lane = F.lane, fr = lane & 15, fq = lane >> 4;
    const int nunits = NB * NH * (SEQ / 64) * 4;
    for (int u = F.bid * NWAVES + F.wave; u < nunits; u += F.G * NWAVES) {
        const int cid = u >> 2, tt = u & 3, bh = cid / (SEQ / 64), c = cid % (SEQ / 64), b = bh / NH, h = bh % NH;
        const int t = 16 * tt + fr; const size_t tok = (size_t)b * SEQ + (size_t)c * 64 + t;
        const size_t oh = ((size_t)bh * SEQ + (size_t)c * 64 + t) * 64 + 16 * fq;
        bf16x8 rf[2], sf[4][2];
#pragma unroll
        for (int ks = 0; ks < 2; ++ks) rf[ks] = *(const bf16x8*)(RP + (size_t)cid * 4096 + (tt * 2 + ks) * 512 + (fr * 4 + fq) * 8);
#pragma unroll
        for (int n = 0; n < 4; ++n)
#pragma unroll
            for (int ks = 0; ks < 2; ++ks) sf[n][ks] = *(const bf16x8*)(ST + (size_t)cid * 4096 + (n * 2 + ks) * 512 + (fr * 4 + fq) * 8);
        const u32x4 ol0 = *(const u32x4*)(OL + (size_t)cid * 4096 + t * 64 + 16 * fq), ol1 = *(const u32x4*)(OL + (size_t)cid * 4096 + t * 64 + 16 * fq + 8);
        const u32x4 v0 = *(const u32x4*)(Vb + oh), v1 = *(const u32x4*)(Vb + oh + 8), g0 = *(const u32x4*)(GG + oh), g1 = *(const u32x4*)(GG + oh + 8);
        const float bon = BONUS[tok * NH + h];
        f32x4 acc[4];
        acc[0] = (f32x4){lo2f(ol0[0]), hi2f(ol0[0]), lo2f(ol0[1]), hi2f(ol0[1])}; acc[1] = (f32x4){lo2f(ol0[2]), hi2f(ol0[2]), lo2f(ol0[3]), hi2f(ol0[3])};
        acc[2] = (f32x4){lo2f(ol1[0]), hi2f(ol1[0]), lo2f(ol1[1]), hi2f(ol1[1])}; acc[3] = (f32x4){lo2f(ol1[2]), hi2f(ol1[2]), lo2f(ol1[3]), hi2f(ol1[3])};
#pragma unroll
        for (int n = 0; n < 4; ++n)
#pragma unroll
            for (int ks = 0; ks < 2; ++ks) acc[n] = __builtin_amdgcn_mfma_f32_16x16x32_bf16(sf[n][ks], rf[ks], acc[n], 0, 0, 0);
        float s = 0.f;
#pragma unroll
        for (int n = 0; n < 4; ++n) s += (acc[n][0] + acc[n][1]) + (acc[n][2] + acc[n][3]);
        s += __shfl_xor(s, 16); s += __shfl_xor(s, 32);
        const float mean = s * (1.0f / 64.0f);
        float q = 0.f;
#pragma unroll
        for (int n = 0; n < 4; ++n)
#pragma unroll
            for (int e = 0; e < 4; ++e) { const float d = acc[n][e] - mean; q += d * d; }
        q += __shfl_xor(q, 16); q += __shfl_xor(q, 32);
        const float rstd = rsqrtf(q * (1.0f / 64.0f) + 64e-5f);
        const int chn = h * 64 + 16 * fq;
        u32x4 o0, o1;
#pragma unroll
        for (int n = 0; n < 4; ++n) {
            const f32x4 lg = *(const f32x4*)(F.in[I_LNG] + chn + 4 * n), lb = *(const f32x4*)(F.in[I_LNB] + chn + 4 * n);
            const unsigned vw0 = n < 2 ? v0[2 * n] : v1[2 * n - 4], vw1 = n < 2 ? v0[2 * n + 1] : v1[2 * n - 3], gw0 = n < 2 ? g0[2 * n] : g1[2 * n - 4], gw1 = n < 2 ? g0[2 * n + 1] : g1[2 * n - 3];
            const f32x4 vv = {lo2f(vw0), hi2f(vw0), lo2f(vw1), hi2f(vw1)}, gg = {lo2f(gw0), hi2f(gw0), lo2f(gw1), hi2f(gw1)};
            const f32x4 res = (((acc[n] - mean) * rstd) * lg + lb + vv * bon) * gg;
            const unsigned w0 = pack2(res[0], res[1]), w1 = pack2(res[2], res[3]);
            if (n == 0) { o0[0] = w0; o0[1] = w1; } else if (n == 1) { o0[2] = w0; o0[3] = w1; } else if (n == 2) { o1[0] = w0; o1[1] = w1; } else { o1[2] = w0; o1[3] = w1; }
        }
        *(u32x4*)(OG + tok * D + chn) = o0; *(u32x4*)(OG + tok * D + chn + 8) = o1;
    }
}

struct AttnTile { bf16x8 k[4][2]; bf16x8 v[4][2]; };
__device__ __forceinline__ void attn_load(AttnTile& tl, const bf16_t* kbase  , const bf16_t* vbase  ) {
#pragma unroll
    for (int kt = 0; kt < 4; ++kt)
#pragma unroll
        for (int ks = 0; ks < 2; ++ks) tl.k[kt][ks] = *(const bf16x8*)(kbase + (kt * 2 + ks) * 512);
#pragma unroll
    for (int dt = 0; dt < 4; ++dt)
#pragma unroll
        for (int ks = 0; ks < 2; ++ks) tl.v[dt][ks] = *(const bf16x8*)(vbase + (dt * 2 + ks) * 512);
}
template <bool MASK>
__device__ __forceinline__ void attn_tile(const AttnTile& tl, const bf16x8 (&qf)[2], f32x4 (&o)[4], float& R, int key0, int qpos, int fq) {
    constexpr float C2 = 0.125f * 1.4426950408889634f;
    f32x4 z[4];
#pragma unroll
    for (int kt = 0; kt < 4; ++kt) { z[kt] = (f32x4){0.f, 0.f, 0.f, 0.f};
#pragma unroll
        for (int ks = 0; ks < 2; ++ks) z[kt] = __builtin_amdgcn_mfma_f32_16x16x32_bf16(tl.k[kt][ks], qf[ks], z[kt], 0, 0, 0); }
    float sp[4][4], G[4];
#pragma unroll
    for (int kt = 0; kt < 4; ++kt) { G[kt] = 0.f;
#pragma unroll
        for (int e = 0; e < 4; ++e) { const float z2 = z[kt][e] * C2; z[kt][e] = z2;
            const float l2 = __builtin_amdgcn_logf(1.0f + __builtin_amdgcn_exp2f(z2));
            float spv = z2 > 30.f ? z2 : l2;
            if (MASK) spv = ((key0 + 16 * kt + 4 * fq + e) < qpos) ? spv : 0.f;
            sp[kt][e] = spv; G[kt] += spv; } }
    float sufg[4], tot[4];
#pragma unroll
    for (int kt = 0; kt < 4; ++kt) {
        const float g1 = __shfl_xor(G[kt], 16), g2 = __shfl_xor(G[kt], 32), g3 = __shfl_xor(G[kt], 48);
        tot[kt] = G[kt] + g1 + g2 + g3;
        sufg[kt] = (((fq ^ 1) > fq) ? g1 : 0.f) + (((fq ^ 2) > fq) ? g2 : 0.f) + (((fq ^ 3) > fq) ? g3 : 0.f);
    }
    float later = 0.f;
    union { bf16x8 v; unsigned w[4]; } p0, p1;
#pragma unroll
    for (int kt = 3; kt >= 0; --kt) {
        float run = R + later + sufg[kt];
        float wv[4];
#pragma unroll
        for (int e = 3; e >= 0; --e) { float w = __builtin_amdgcn_exp2f(z[kt][e] - sp[kt][e] - run);
            if (MASK) w = ((key0 + 16 * kt + 4 * fq + e) < qpos) ? w : 0.f;
            wv[e] = w; run += sp[kt][e]; }
        const unsigned w01 = pgx::cvt_pk_bf16(wv[0], wv[1]), w23 = pgx::cvt_pk_bf16(wv[2], wv[3]);
        if (kt == 0) { p0.w[0] = w01; p0.w[1] = w23; } else if (kt == 1) { p0.w[2] = w01; p0.w[3] = w23; } else if (kt == 2) { p1.w[0] = w01; p1.w[1] = w23; } else { p1.w[2] = w01; p1.w[3] = w23; }
        later += tot[kt];
    }
    R += later;
#pragma unroll
    for (int dt = 0; dt < 4; ++dt) {
        o[dt] = __builtin_amdgcn_mfma_f32_16x16x32_bf16(tl.v[dt][0], p0.v, o[dt], 0, 0, 0);
        o[dt] = __builtin_amdgcn_mfma_f32_16x16x32_bf16(tl.v[dt][1], p1.v, o[dt], 0, 0, 0);
    }
}
__device__ __forceinline__ void ph_attn(const Frame& F) {
    const bf16_t* Q = (const bf16_t*)(F.ws + WS_Q); const bf16_t* Kb = Q + (size_t)T * D; const bf16_t* VT = Q + (size_t)2 * T * D;
    bf16_t* AO = (bf16_t*)(F.ws + WS_AO);
    const int lane = F.lane, fr = lane & 15, fq = lane >> 4;
    const int nunits = NB * NH * (SEQ / 16);
    constexpr float EXIT2 = SB_EXIT * 1.4426950408889634f;
    unsigned* aq = F.ctl + CW_AQ;
    LAS unsigned* chunk_s = (LAS unsigned*)(F.lds + 1024);
    const unsigned myx = xb_xcc_id() & 7u;
    for (int qi = 0; qi < 8; ++qi) {
      const unsigned xq = (myx + (unsigned)qi) & 7u;
      for (;;) {
        __syncthreads();
        if (F.tid == 0) *chunk_s = atomicAdd(&aq[xq * 64], 1u);
        __syncthreads();
        const unsigned ck = *chunk_s;
        if (ck >= 256u) break;
        const int bh = (int)xq + 8 * (int)(ck >> 6), qt = (int)(ck & 63u) * 8 + F.wave;
        const int b = bh / NH, h = bh % NH;
        const int q0 = qt * 16, qpos = q0 + fr;
        const size_t tb = (size_t)b * SEQ;
        bf16x8 qf[2];
#pragma unroll
        for (int ks = 0; ks < 2; ++ks) qf[ks] = *(const bf16x8*)(Q + (tb + qpos) * D + h * 64 + ks * 32 + fq * 8);
        f32x4 o[4];
#pragma unroll
        for (int dt = 0; dt < 4; ++dt) o[dt] = (f32x4){0.f, 0.f, 0.f, 0.f};
        float R = 0.f;
        const bf16_t* kb = Kb + (size_t)bh * SEQ * 64 + (fr * 4 + fq) * 8;
        const bf16_t* vb = VT + (size_t)bh * SEQ * 64 + (fr * 4 + fq) * 8;
        int kt0 = (q0 + 15) / 64;
        AttnTile ta, tc;
        attn_load(ta, kb + (size_t)kt0 * 4096, vb + (size_t)kt0 * 4096);
        if (kt0 > 0) attn_load(tc, kb + (size_t)(kt0 - 1) * 4096, vb + (size_t)(kt0 - 1) * 4096);
        attn_tile<true>(ta, qf, o, R, kt0 * 64, qpos, fq);
        --kt0;
        while (kt0 >= 0 && !__all(R > EXIT2)) {
            if (kt0 > 0) attn_load(ta, kb + (size_t)(kt0 - 1) * 4096, vb + (size_t)(kt0 - 1) * 4096);
            attn_tile<false>(tc, qf, o, R, kt0 * 64, qpos, fq);
            --kt0;
            if (kt0 < 0 || __all(R > EXIT2)) break;
            if (kt0 > 0) attn_load(tc, kb + (size_t)(kt0 - 1) * 4096, vb + (size_t)(kt0 - 1) * 4096);
            attn_tile<false>(ta, qf, o, R, kt0 * 64, qpos, fq);
            --kt0;
        }
#pragma unroll
        for (int dt = 0; dt < 4; ++dt) st_bf4(AO + (tb + qpos) * D + h * 64 + 16 * dt + 4 * fq, o[dt]);
      }
    }
}

#ifndef USE_PGX
#define USE_PGX 0x1f
#endif
__device__ __forceinline__ int px_unit_index(int i, int G, int c, int nwg) {
    const long L = (long)i * G + c; if (L >= nwg) return -1;
    const int w = (int)L, q = nwg / 8, r = nwg % 8, xcd = w % 8, off = w / 8;
    return (xcd < r ? xcd * (q + 1) : r * (q + 1) + (xcd - r) * q) + off;
}
struct PxDense {
    const char* A; const char* B; int nM, nN, K, G, c; unsigned lda; int a_div; size_t a_stride;
    __device__ __forceinline__ bool next(int i, pgx::Unit& u) const {
        const int w = px_unit_index(i, G, c, nM * nN); if (w < 0) return false;
        const int pm = w / nN, pn = w % nN;
        u.A = A + (size_t)(pn / a_div) * a_stride + (size_t)pm * 256 * lda; u.tok = nullptr; u.B = B + (size_t)pn * 256 * K * 2; u.r0 = pm * 256; u.c0 = pn * 256; u.aux = 0; return true;
    }
};
__device__ __forceinline__ void px_store_bf16_perm(bf16_t* rowp, const f32x4& v0, const f32x4& v1) {
    u32x4 w; w.x = pgx::cvt_pk_bf16(v0[0], v0[1]); w.y = pgx::cvt_pk_bf16(v0[2], v0[3]); w.z = pgx::cvt_pk_bf16(v1[0], v1[1]); w.w = pgx::cvt_pk_bf16(v1[2], v1[3]); *(u32x4*)rowp = w;
}
__device__ __forceinline__ void ph_rkv_px(const Frame& F) {
    bf16_t* RKV = (bf16_t*)(F.ws + WS_RKV);
    PxDense S{(const char*)(F.ws + WS_XS), (const char*)(F.ws + WS_WRKV), 64, 12, D, F.G, F.bid, (unsigned)(D * 2), 4, (size_t)T * D * 2};
    pgx::gemm_phase<true, true>(F.lds, D, D * 2, S, [&](const f32x4 (&acc)[2][2][4][2], const pgx::Unit& u, int wr, int wc, int fr, int fq) {
        bf16_t* base = RKV + (size_t)(u.c0 / D) * T * D;
#pragma unroll
        for (int ai = 0; ai < 2; ++ai)
#pragma unroll
            for (int m = 0; m < 4; ++m) { const int t = u.r0 + ai * 128 + wr * 64 + m * 16 + fr;
#pragma unroll
                for (int bj = 0; bj < 2; ++bj) px_store_bf16_perm(base + hm_off(t, (u.c0 % D) + bj * 128 + wc * 32 + 8 * fq), acc[ai][bj][m][0], acc[ai][bj][m][1]); }
    });
}
__device__ __forceinline__ void ph_lora_dn_sg(const Frame& F) {
    const bf16_t* XS = (const bf16_t*)(F.ws + WS_XS); const bf16_t* WLDN = (const bf16_t*)(F.ws + WS_WLDN); bf16_t* LORA = (bf16_t*)(F.ws + WS_LORA);
    for (int u = F.bid; u < 64 * 4; u += F.G) {
        const int mt = u / 4, j = u % 4, n = (j == 0) ? 3 : (j == 1 ? 4 : 5);
        ASeg A; A.p[0] = XS + ((size_t)n * T + mt * 256) * D; A.p[1] = A.p[0]; A.p[2] = A.p[0]; A.segTiles = 16;
        bf16_t* out = LORA + (size_t)mt * 256 * 256 + j * 64;
        sg_tile<64>(F.lds, A, [](int R) { return (unsigned)R * (D * 2); }, WLDN + (size_t)(j * 64) * D, D, 16,
            [&](auto& acc, int r0, int c0, int fr, int fq) {
#pragma unroll
                for (int m = 0; m < EPI_MT(acc); ++m)
#pragma unroll
                    for (int q = 0; q < 4; ++q) { f32x4 v = acc[m][q];
                        if (j == 0) {
#pragma unroll
                            for (int e = 0; e < 4; ++e) v[e] = tanhf_(v[e]); }
                        else if (j >= 2) {
#pragma unroll
                            for (int e = 0; e < 4; ++e) v[e] = sigmoidf_(v[e]); }
                        st_bf4(out + (size_t)(r0 + 16 * m + fr) * 256 + c0 + 16 * q + 4 * fq, v); }
            });
    }
}
__device__ __forceinline__ void ph_dense_bf16_px(const Frame& F, const bf16_t* Ain, const bf16_t* Wt, bf16_t* out) {
    PxDense S{(const char*)Ain, (const char*)Wt, 64, 4, D, F.G, F.bid, (unsigned)(D * 2), 4, 0};
    pgx::gemm_phase<true, true>(F.lds, D, D * 2, S, [&](const f32x4 (&acc)[2][2][4][2], const pgx::Unit& u, int wr, int wc, int fr, int fq) {
        bf16_t* base = out + u.c0 + wc * 32 + 8 * fq;
#pragma unroll
        for (int ai = 0; ai < 2; ++ai)
#pragma unroll
            for (int m = 0; m < 4; ++m) { bf16_t* rowp = base + (size_t)(u.r0 + ai * 128 + wr * 64 + m * 16 + fr) * D;
#pragma unroll
                for (int bj = 0; bj < 2; ++bj) px_store_bf16_perm(rowp + bj * 128, acc[ai][bj][m][0], acc[ai][bj][m][1]); }
    });
}
__device__ __forceinline__ void ph_qkv_px(const Frame& F) {
    bf16_t* QK = (bf16_t*)(F.ws + WS_Q); bf16_t* VT = QK + (size_t)2 * T * D;
    { PxDense S{(const char*)(F.ws + WS_H3), (const char*)(F.ws + WS_WQKV), 64, 8, D, F.G, F.bid, (unsigned)(D * 2), 8, 0};
      pgx::gemm_phase<true, true>(F.lds, D, D * 2, S, [&](const f32x4 (&acc)[2][2][4][2], const pgx::Unit& u, int wr, int wc, int fr, int fq) {
        const bool isk = u.c0 >= D;
#pragma unroll
        for (int ai = 0; ai < 2; ++ai)
#pragma unroll
            for (int m = 0; m < 4; ++m) { const int t = u.r0 + ai * 128 + wr * 64 + m * 16 + fr;
#pragma unroll
                for (int bj = 0; bj < 2; ++bj) { const int c = (u.c0 % D) + bj * 128 + wc * 32 + 8 * fq;
                    const int sq = t % SEQ, dd = c & 63;
                    bf16_t* dst = isk ? QK + (size_t)T * D + (((size_t)((t / SEQ) * NH + (c >> 6)) * (SEQ / 16) + (sq >> 4)) * 2 + (dd >> 5)) * 512 + (sq & 15) * 32 + (dd & 31) : QK + (size_t)t * D + c;
                    px_store_bf16_perm(dst, acc[ai][bj][m][0], acc[ai][bj][m][1]); } }
      }); }
    { PxDense S{(const char*)(F.ws + WS_H3), (const char*)(F.ws + WS_WQKV) + (size_t)2 * D * D * 2, 64, 4, D, F.G, F.bid, (unsigned)(D * 2), 4, 0};
      pgx::gemm_phase<false, false>(F.lds, D, D * 2, S, [&](const f32x4 (&acc)[2][2][4][2], const pgx::Unit& u, int wr, int wc, int fr, int fq) {
#pragma unroll
        for (int ai = 0; ai < 2; ++ai)
#pragma unroll
            for (int m = 0; m < 4; ++m) { const int t = u.r0 + ai * 128 + wr * 64 + m * 16 + 4 * fq, b = t / SEQ, sidx = t % SEQ;
#pragma unroll
                for (int bj = 0; bj < 2; ++bj)
#pragma unroll
                    for (int n = 0; n < 2; ++n) { const int c = u.c0 + bj * 128 + wc * 32 + n * 16 + fr, h = c >> 6, d = c & 63;
                        const int k6 = sidx & 63, kk = k6 & 31;
                        st_bf4(VT + ((size_t)(b * NH + h) * (SEQ / 64) + (sidx >> 6)) * 4096 + ((d >> 4) * 2 + (k6 >> 5)) * 512 + ((d & 15) * 4 + ((kk & 15) >> 2)) * 8 + (kk >> 4) * 4, acc[ai][bj][m][n]); } }
      }); }
}
struct PxMoe {
    const char* Asrc; const int* TOK; const int* TILEE; const char* W; int routed, nmt, nN, K, G, c; unsigned lda; size_t wexp; bool gather;
    __device__ __forceinline__ bool next(int i, pgx::Unit& u) const {
        const int w = px_unit_index(i, G, c, nmt * nN); if (w < 0) return false;
        const int mt = w / nN, pn = w % nN, row0 = mt * 256; const bool sh = row0 >= routed; const int e = sh ? 64 : TILEE[mt];
        if (gather) { if (sh) { u.A = Asrc + (size_t)(row0 - routed) * lda; u.tok = nullptr; } else { u.A = Asrc; u.tok = TOK + row0; } }
        else { u.A = Asrc + (size_t)row0 * lda; u.tok = nullptr; }
        u.B = W + (size_t)e * wexp + (size_t)pn * 256 * K * 2; u.r0 = row0; u.c0 = pn * 256; u.aux = 0; return true;
    }
};
__device__ __forceinline__ void ph_gateup_px(const Frame& F) {
    bf16_t* HB = (bf16_t*)(F.ws + WS_HB); const int* START = (const int*)(F.ws + WS_START);
    const int routed = START[65], nmt = (routed + T) / 256;
    PxMoe S{(const char*)(F.ws + WS_H2), (const int*)(F.ws + WS_TOK), (const int*)(F.ws + WS_TILEE), (const char*)(F.ws + WS_WGU), routed, nmt, 2, D, F.G, F.bid, (unsigned)(D * 2), (size_t)512 * D * 2, true};
    pgx::gemm_phase<true, true>(F.lds, D, D * 2, S, [&](const f32x4 (&acc)[2][2][4][2], const pgx::Unit& u, int wr, int wc, int fr, int fq) {
        bf16_t* base = HB + (u.c0 >> 1) + wc * 32 + 8 * fq;
#pragma unroll
        for (int ai = 0; ai < 2; ++ai)
#pragma unroll
            for (int m = 0; m < 4; ++m) { f32x4 v[2];
#pragma unroll
                for (int n = 0; n < 2; ++n)
#pragma unroll
                    for (int e = 0; e < 4; ++e) { const float g = acc[ai][0][m][n][e]; v[n][e] = g * sigmoidf_(g) * acc[ai][1][m][n][e]; }
                px_store_bf16_perm(base + (size_t)(u.r0 + ai * 128 + wr * 64 + m * 16 + fr) * DE, v[0], v[1]); }
    });
}
__device__ __forceinline__ void ph_down_px(const Frame& F) {
    bf16_t* YB = (bf16_t*)(F.ws + WS_YB); const int* START = (const int*)(F.ws + WS_START);
    const int routed = START[65], nmt = (routed + T) / 256;
    PxMoe S{(const char*)(F.ws + WS_HB), nullptr, (const int*)(F.ws + WS_TILEE), (const char*)(F.ws + WS_WDN), routed, nmt, 4, DE, F.G, F.bid, (unsigned)(DE * 2), (size_t)D * DE * 2, false};
    pgx::gemm_phase<true, true>(F.lds, DE, DE * 2, S, [&](const f32x4 (&acc)[2][2][4][2], const pgx::Unit& u, int wr, int wc, int fr, int fq) {
        unsigned char* base = (unsigned char*)YB + u.c0 + wc * 32 + 8 * fq;
#pragma unroll
        for (int ai = 0; ai < 2; ++ai)
#pragma unroll
            for (int m = 0; m < 4; ++m) { unsigned char* rowp = base + (size_t)(u.r0 + ai * 128 + wr * 64 + m * 16 + fr) * D;
#pragma unroll
                for (int bj = 0; bj < 2; ++bj) { u32x2 w;
                    w.x = pack_fp8x4(acc[ai][bj][m][0]); w.y = pack_fp8x4(acc[ai][bj][m][1]);
                    *(u32x2*)(rowp + bj * 128) = w; }
                asm volatile("" ::: "memory"); }
    });
}

__global__ void __launch_bounds__(NTHREADS, 2) mega(Args args) {
    extern __shared__ __attribute__((aligned(16))) unsigned char lds[];
    Frame F;
    F.in = args.in; F.out = args.out; F.ws = args.ws; F.ctl = (unsigned*)(args.ws + WS_CTL);
    F.ldsf = (float*)lds; F.lds = (LAS unsigned char*)lds;
    F.tid = threadIdx.x; F.lane = F.tid & 63; F.wave = __builtin_amdgcn_readfirstlane(F.tid >> 6); F.bid = blockIdx.x; F.G = gridDim.x;
    if (F.tid < 4) ((unsigned*)(lds + LDS_BYTES - 64))[F.tid] = 0u;
    __syncthreads();
    XcdBarrier bar; bar.bar = F.ctl + CW_BAR; bar.x = 0; bar.st = (volatile LAS unsigned*)(lds + LDS_BYTES - 64);
#if MK_N_LAUNCHES == 1
    bar = xcd_barrier_post(F.ctl + CW_BAR, (volatile LAS unsigned*)(lds + LDS_BYTES - 64));
#endif
    const int lo = args.ph_lo, hi = args.ph_hi;
#define IN(k) (lo <= (k) && (k) < hi)
#ifndef PROBE_MASK
#define PROBE_MASK 0u
#endif
    volatile unsigned long long* tsl = (volatile unsigned long long*)(lds + LDS_BYTES - 64 - 32 * 8);
#define STAMP(k) do { if (PROBE_MASK != 0u && F.tid == 0) tsl[(k)] = __builtin_amdgcn_s_memrealtime(); } while (0)
#define SEAM(k) do { if (IN(k) && IN((k) + 1)) xcd_barrier(bar); STAMP((k) + 1); } while (0)
    STAMP(0);
    bf16_t* const wsb = (bf16_t*)args.ws;
    (void)wsb;
#ifndef REP_A
#define REP_A 1
#endif
#ifndef REP_B
#define REP_B 1
#endif
#ifndef REP_C
#define REP_C 1
#endif
#ifndef REP_D
#define REP_D 1
#endif
#ifndef REP_E
#define REP_E 1
#endif
#ifndef REP_F
#define REP_F 1
#endif
#ifndef REP_G
#define REP_G 1
#endif
#ifndef REP_H
#define REP_H 1
#endif
#define RUN(n, body) for (int r_ = 0; r_ < (n); ++r_) { body; }
    if (IN(0)) { RUN(REP_D, ph_mod(F)) RUN(REP_G, conv_dense(F, F.bid, F.G)) if (F.G <= 2 * NB * NH) conv_moe(F, 0, F.bid, F.G); } SEAM(0);
    if (IN(1)) { RUN(REP_E, ph_prenorm_rwkv(F)) } SEAM(1);
    if (IN(2)) { RUN(REP_A, ph_rkv_px(F); ph_lora_dn_sg(F)) } SEAM(2);
    if (IN(3)) { RUN(REP_F, ph_lora_up_sg(F)) } SEAM(3);
    if (IN(4)) { RUN(REP_B, ph_wkv_chunk(F)) } SEAM(4);
    if (IN(5)) { if (F.bid < NB * NH || F.G <= 2 * NB * NH) { RUN(REP_B, ph_wkv_carry(F)) } else conv_moe(F, 0, F.bid - NB * NH, F.G - NB * NH); } SEAM(5);
    if (IN(6)) { RUN(REP_B, ph_wkv_out(F)) } SEAM(6);
    if (IN(7)) { RUN(REP_A, ph_dense_bf16_px(F, (const bf16_t*)(F.ws + WS_OG), (const bf16_t*)(F.ws + WS_WO), (bf16_t*)(F.ws + WS_Y1))) } SEAM(7);
    if (IN(8)) { RUN(REP_E, ph_postmix_preffn(F, 0, F.in[I_X], (const bf16_t*)(F.ws + WS_Y1))) } SEAM(8);
    if (IN(9)) { RUN(REP_F, ph_router_sg(F, 0)) } SEAM(9);
    if (IN(10)) { ph_topk(F, 0); } SEAM(10);
    if (IN(11)) { ph_offsets(F, 0); } SEAM(11);
    if (IN(12)) { RUN(REP_A, ph_gateup_px(F)) } SEAM(12);
    if (IN(13)) { RUN(REP_A, ph_down_px(F)) } SEAM(13);
    if (IN(14)) { RUN(1, ph_combine(F, 0, true)) RUN(REP_H, conv_moe(F, 1, F.bid, F.G)) } SEAM(14);
    if (IN(15)) { RUN(REP_A, ph_qkv_px(F)) } SEAM(15);
    if (IN(16)) { RUN(REP_C, ph_attn(F)) } SEAM(16);
    if (IN(17)) { RUN(REP_A, ph_dense_bf16_px(F, (const bf16_t*)(F.ws + WS_AO), (const bf16_t*)(F.ws + WS_WSBO), (bf16_t*)(F.ws + WS_Y1B))) } SEAM(17);
    if (IN(18)) { ph_postmix_preffn(F, 1, F.out, (const bf16_t*)(F.ws + WS_Y1B)); } SEAM(18);
    if (IN(19)) { RUN(REP_F, ph_router_sg(F, 1)) } SEAM(19);
    if (IN(20)) { ph_topk(F, 1); } SEAM(20);
    if (IN(21)) { ph_offsets(F, 1); } SEAM(21);
    if (IN(22)) { RUN(REP_A, ph_gateup_px(F)) } SEAM(22);
    if (IN(23)) { RUN(REP_A, ph_down_px(F)) } SEAM(23);
    if (IN(24)) { ph_combine(F, 1, false); }
    if (PROBE_MASK != 0u) {
        __syncthreads();
        if (F.bid == 0 && F.tid == 0) { const unsigned long long t1 = __builtin_amdgcn_s_memrealtime(); unsigned long long sel = 0;
            for (int k = 0; k < NPHASES; ++k) { const unsigned long long e = (k + 1 < NPHASES) ? tsl[k + 1] : t1; if ((PROBE_MASK >> k) & 1u) sel += e - tsl[k]; }
            F.out[0] += 1000.0f * (float)sel / (float)(t1 - tsl[0]); }
    }
#undef IN
#undef SEAM
}

extern "C" void kernel_launch(void* const* d_in, const int* in_sizes, int n_in, void* d_out, int out_size, void* d_ws, size_t ws_size, hipStream_t stream) {
    static int grid = 0;
    if (grid == 0) {
        if (n_in != 34 || in_sizes[0] != T * D || out_size != T * D || ws_size < WS_END) {
            fprintf(stderr, "kernel_launch: unexpected shapes: n_in %d in0 %d out %d ws %zu (need %zu)\n", n_in, n_in > 0 ? in_sizes[0] : -1, out_size, ws_size, (size_t)WS_END);
            grid = -1; return;
        }
        int dev = 0, cus = 0, per_cu = 0;
        if (hipGetDevice(&dev) != hipSuccess || hipDeviceGetAttribute(&cus, hipDeviceAttributeMultiprocessorCount, dev) != hipSuccess) { grid = -1; return; }
        if (hipFuncSetAttribute((const void*)mega, hipFuncAttributeMaxDynamicSharedMemorySize, LDS_BYTES) != hipSuccess) { fprintf(stderr, "kernel_launch: hipFuncSetAttribute failed\n"); grid = -1; return; }
        if (hipOccupancyMaxActiveBlocksPerMultiprocessor(&per_cu, (const void*)mega, NTHREADS, LDS_BYTES) != hipSuccess || per_cu < 1)
            fprintf(stderr, "kernel_launch: occupancy query reports %d blocks per CU\n", per_cu);
        (void)hipGetLastError();
        grid = cus;
    }
    if (grid < 0) return;
    if (hipMemsetAsync((char*)d_ws + WS_CTL, 0, CTL_BYTES, stream) != hipSuccess) { fprintf(stderr, "kernel_launch: memset failed\n"); return; }
    Args a{};
    for (int i = 0; i < 34; ++i) a.in[i] = (const float*)d_in[i];
    a.out = (float*)d_out; a.ws = (unsigned char*)d_ws;
#if MK_N_LAUNCHES == 1
    a.ph_lo = 0; a.ph_hi = NPHASES;
    hipLaunchKernelGGL(mega, dim3(grid), dim3(NTHREADS), LDS_BYTES, stream, a);
#else
    for (int p = 0; p < NPHASES; ++p) { a.ph_lo = p; a.ph_hi = p + 1; hipLaunchKernelGGL(mega, dim3(grid), dim3(NTHREADS), LDS_BYTES, stream, a); }
#endif
    const hipError_t le = hipPeekAtLastError();
    if (le != hipSuccess) fprintf(stderr, "kernel_launch: launch failed: %s\n", hipGetErrorName(le));
}
```

```cpp
#include <hip/hip_runtime.h>
#include <cstdio>
#include <cstdint>

#ifndef MK_N_LAUNCHES
#define MK_N_LAUNCHES 1
#endif

constexpr int T = 16384, D = 1024, SEQ = 8192, NB = 2, NH = 16, HD = 64;
constexpr int NE = 64, TOPK = 8, DE = 256;
constexpr int RP = 256;
constexpr int MAXROUTED = 147456;
constexpr int MAXROWS = MAXROUTED + T;
constexpr int NTHREADS = 512, NWAVES = 8;
constexpr int NPHASES = 25;
constexpr int LDS_BYTES = 144 * 1024;
constexpr float YB_SCALE = 16.0f;

typedef unsigned short bf16_t;
typedef float f32x4 __attribute__((ext_vector_type(4)));
typedef unsigned u32x4 __attribute__((ext_vector_type(4)));
typedef unsigned u32x2 __attribute__((ext_vector_type(2)));

__device__ __forceinline__ float bf2f(bf16_t b) { return __uint_as_float(((unsigned)b) << 16); }
typedef __bf16 bf16x2_t __attribute__((ext_vector_type(2)));
typedef float f32x2 __attribute__((ext_vector_type(2)));
__device__ __forceinline__ unsigned pack2(float a, float b) { const f32x2 v = {a, b}; const bf16x2_t r = __builtin_convertvector(v, bf16x2_t); return __builtin_bit_cast(unsigned, r); }
__device__ __forceinline__ bf16_t f2bf(float f) { return (bf16_t)(pack2(f, 0.f) & 0xffffu); }
__device__ __forceinline__ float lo2f(unsigned u) { return __uint_as_float(u << 16); }
__device__ __forceinline__ float hi2f(unsigned u) { return __uint_as_float(u & 0xffff0000u); }
__device__ __forceinline__ f32x4 ld4_g(const bf16_t* p) { const u32x2 w = *(const u32x2*)p; return (f32x4){lo2f(w.x), hi2f(w.x), lo2f(w.y), hi2f(w.y)}; }
__device__ __forceinline__ float fexp_(float x) { return __builtin_amdgcn_exp2f(x * 1.4426950408889634f); }
__device__ __forceinline__ float sigmoidf_(float x) { return __builtin_amdgcn_rcpf(1.0f + fexp_(-x)); }
__device__ __forceinline__ float tanhf_(float x) { return 1.0f - 2.0f * __builtin_amdgcn_rcpf(1.0f + fexp_(2.0f * x)); }
__device__ __forceinline__ float softplusf_(float x) { const float e = fexp_(x); const float l = __builtin_amdgcn_logf(1.0f + e) * 0.6931471805599453f; return x > 15.f ? x : (x < -8.f ? e : l); }
__device__ __forceinline__ float wave_sum(float v) {
#pragma unroll
    for (int o = 32; o >= 1; o >>= 1) v += __shfl_xor(v, o);
    return v;
}

constexpr size_t MiB = 1024 * 1024;
constexpr size_t WS_CTL    = 0;
constexpr size_t CTL_BYTES = 64 * 1024;
constexpr size_t WS_MOD    = 64 * 1024;
constexpr size_t WS_IDX    = 256 * 1024;
constexpr size_t WS_GATE   = WS_IDX + 512 * 1024;
constexpr size_t WS_RANK   = WS_GATE + 512 * 1024;
constexpr size_t WS_POS    = WS_RANK + 512 * 1024;
constexpr size_t WS_TOK    = WS_POS + 512 * 1024;
constexpr size_t WS_TILEE  = WS_TOK + 704 * 1024;
constexpr size_t WS_START  = WS_TILEE + 4096;
constexpr size_t WS_LOGITS = 8 * MiB + 64 * MiB;
constexpr size_t WS_BC     = 4 * MiB;
constexpr size_t WS_BIG    = 8 * MiB;
constexpr size_t WS_XS   = WS_BIG;
constexpr size_t WS_RKV  = WS_BIG + 192 * MiB;
constexpr size_t WS_LORA = WS_BIG + 288 * MiB;
constexpr size_t WS_LD   = WS_BIG;
constexpr size_t WS_AA   = WS_BIG + 64 * MiB;
constexpr size_t WS_GG   = WS_BIG + 96 * MiB;
constexpr size_t WS_O    = WS_BIG + 128 * MiB;
constexpr size_t WS_OG   = WS_BIG + 296 * MiB;
constexpr size_t WS_Y1   = WS_BIG + 328 * MiB;
constexpr size_t WS_H2   = WS_BIG;
constexpr size_t WS_H2LO = WS_BIG + 32 * MiB;
constexpr size_t WS_YB   = WS_BIG;
constexpr size_t WS_HB   = WS_BIG + 320 * MiB;
constexpr size_t WS_H3   = WS_BIG + 320 * MiB;
constexpr size_t WS_Q    = WS_BIG;
constexpr size_t WS_AO   = WS_BIG + 96 * MiB;
constexpr size_t WS_Y1B  = WS_BIG + 128 * MiB;
constexpr size_t WS_W     = WS_BIG + 400 * MiB;
constexpr size_t WS_WGU   = WS_W;
constexpr size_t WS_WDN   = WS_WGU + (size_t)65 * 512 * 1024 * 2;
constexpr size_t WS_WRKV  = WS_WDN + (size_t)65 * 1024 * 256 * 2;
constexpr size_t WS_WO    = WS_WRKV + (size_t)3072 * 1024 * 2;
constexpr size_t WS_WQKV  = WS_WO + (size_t)1024 * 1024 * 2;
constexpr size_t WS_WSBO  = WS_WQKV + (size_t)3072 * 1024 * 2;
constexpr size_t WS_WLDN  = WS_WSBO + (size_t)1024 * 1024 * 2;
constexpr size_t WS_WLUP  = WS_WLDN + (size_t)256 * 1024 * 2;
constexpr size_t WS_WRT   = WS_WLUP + (size_t)1024 * 256 * 2;
constexpr size_t WS_END   = WS_WRT + (size_t)2 * 64 * 3072 * 2;

constexpr int CW_BAR = 0;
constexpr int CW_CNT = 4096;
constexpr int CW_AQ = 4608;

#define XB_TMO      128
#define XB_XCNT(j)  (256  + 64 * (j))
#define XB_XSUB(j)  (1280 + 64 * (j))
#define XB_XGEN(j)  (2304 + 64 * (j))
#define XB_TOP      3328
#define XB_TOPGEN   3392
#define XCD_BAR_WORDS 3456
#define XB_SPIN_CAP (1u << 22)
#define LAS __attribute__((address_space(3)))

__device__ __forceinline__ unsigned xb_ld(unsigned* p)              { return __hip_atomic_load(p, __ATOMIC_RELAXED, __HIP_MEMORY_SCOPE_AGENT); }
__device__ __forceinline__ unsigned xb_add(unsigned* p, unsigned v) { return __hip_atomic_fetch_add(p, v, __ATOMIC_RELAXED, __HIP_MEMORY_SCOPE_AGENT); }
__device__ __forceinline__ unsigned xb_xcc_id() { return (unsigned)__builtin_amdgcn_s_getreg((3 << 11) | 20) & 0xFu; }
#define XB_SPIN(cond, bar) do { unsigned _sp = 0; while (cond) { __builtin_amdgcn_s_sleep(1); \
    if ((++_sp & 255u) == 0u) { if (xb_ld(&(bar)[XB_TMO])) break; if (_sp > XB_SPIN_CAP) { atomicAdd(&(bar)[XB_TMO], 1u); break; } } } } while (0)

struct XcdBarrier { unsigned* bar; unsigned x; volatile LAS unsigned* st; };

__device__ __forceinline__ XcdBarrier xcd_barrier_post(unsigned* bar, volatile LAS unsigned* st) {
    XcdBarrier b; b.bar = bar; b.x = xb_xcc_id(); b.st = st;
    if (threadIdx.x == 0) (void)xb_add(&bar[XB_XCNT(b.x)], 1u);
    return b;
}
__device__ __forceinline__ void xcd_barrier_complete(unsigned* bar, unsigned x, unsigned& nloc, unsigned& nx) {
    const unsigned G = gridDim.x * gridDim.y * gridDim.z;
    unsigned sum, cnt, mine, sp = 0u;
    for (;;) {
        sum = 0u; cnt = 0u; mine = 0u;
#pragma unroll
        for (unsigned j = 0; j < 16; ++j) { const unsigned c = xb_ld(&bar[XB_XCNT(j)]); sum += c; cnt += (c > 0u) ? 1u : 0u; mine = (j == x) ? c : mine; }
        if (sum == G) break;
        __builtin_amdgcn_s_sleep(1);
        if ((++sp & 255u) == 0u) { if (xb_ld(&bar[XB_TMO])) break; if (sp > XB_SPIN_CAP) { atomicAdd(&bar[XB_TMO], 1u); break; } }
    }
    nloc = mine > 0u ? mine : 1u; nx = cnt > 0u ? cnt : 1u;
}
__device__ __forceinline__ void xcd_barrier(const XcdBarrier& b) {
    asm volatile("s_waitcnt vmcnt(0)" ::: "memory");
    __syncthreads();
    if (threadIdx.x == 0) {
        unsigned* bar = b.bar;
        __builtin_amdgcn_s_waitcnt(0);
        unsigned nloc = b.st[0], nx = b.st[1];
        if (nloc == 0u) { xcd_barrier_complete(bar, b.x, nloc, nx); b.st[0] = nloc; b.st[1] = nx; }
        const unsigned old = xb_add(&bar[XB_XSUB(b.x)], 1u);
        const unsigned gen = old / nloc;
        if (old + 1u == (gen + 1u) * nloc) {
            __builtin_amdgcn_fence(__ATOMIC_RELEASE, "agent");
            asm volatile("s_waitcnt vmcnt(0)" ::: "memory");
            const unsigned og = xb_add(&bar[XB_TOP], 1u);
            const unsigned tg = og / nx;
            if (og + 1u == (tg + 1u) * nx) xb_add(&bar[XB_TOPGEN], 1u);
            else XB_SPIN(xb_ld(&bar[XB_TOPGEN]) == tg, bar);
            __builtin_amdgcn_fence(__ATOMIC_ACQUIRE, "agent");
            xb_add(&bar[XB_XGEN(b.x)], 1u);
            asm volatile("s_waitcnt vmcnt(0)" ::: "memory");
        } else {
            XB_SPIN(xb_ld(&bar[XB_XGEN(b.x)]) == gen, bar);
            __builtin_amdgcn_fence(__ATOMIC_ACQUIRE, "agent");
            asm volatile("s_waitcnt vmcnt(0)" ::: "memory");
        }
    }
    __syncthreads();
}

struct Args { const float* in[34]; float* out; unsigned char* ws; int ph_lo, ph_hi; };

struct Frame {
    const float* const* in; float* out; unsigned char* ws; unsigned* ctl;
    float* ldsf; LAS unsigned char* lds; int tid, lane, wave, bid, G;
};

enum { I_X = 0, I_C, I_ADAW, I_ADAB, I_NPM, I_NPOM, I_NPF, I_NPOF, I_MU, I_WRKV, I_WW1, I_WW2, I_W0, I_WA1, I_WA2, I_A0, I_WG1, I_WG2,
       I_KK, I_KA, I_RK, I_LNG, I_LNB, I_WO, I_SBQKV, I_SBO, I_ROUTER, I_RBIAS, I_MG, I_MU_, I_MD, I_SG, I_SU, I_SD };


typedef short bf16x8 __attribute__((ext_vector_type(8)));
constexpr int HTB = 128 * 64 * 2;
__device__ __forceinline__ int lds_byte(int r, int c) { const int st = (r >> 4) * 2 + (c >> 5), rr = r & 15, cc = c & 31, ob = rr * 64 + cc * 2; return st * 1024 + (ob ^ (((ob >> 9) & 1) << 5)); }
__device__ __forceinline__ void stage_rc(int b, int& R, int& C) { const int st = b / 1024, sb = b % 1024, swz = sb ^ (((sb >> 9) & 1) << 5); R = (st >> 1) * 16 + swz / 64; C = (st & 1) * 32 + (swz % 64) / 2; }
#define WAIT_V(n) asm volatile("s_waitcnt vmcnt(" #n ")" ::: "memory")
#define SBAR() do { asm volatile("" ::: "memory"); __builtin_amdgcn_s_barrier(); asm volatile("" ::: "memory"); } while (0)

struct ASeg { const bf16_t* p[3]; int segTiles; };

struct BRowId { __device__ __forceinline__ int operator()(int R) const { return R; } };
template <int BN, bool NSW = false, class ARow, class Epi, class BRow = BRowId>
__device__ __forceinline__ void sg_tile(LAS unsigned char* lds, const ASeg& A, const ARow& arow, const bf16_t* Bt, int ldb, int nt, const Epi& epi, const BRow& brow = BRow()) {
    constexpr int WN = BN / 64, WM = 8 / WN, WR = 256 / WM, MT = WR / 16;
    int tid_ = threadIdx.x; asm volatile("" : "+v"(tid_));
    const int tid = tid_, wid = __builtin_amdgcn_readfirstlane(tid >> 6), lane = tid & 63, fr = lane & 15, fq = lane >> 4;
    const int wm = wid / WN, wn = wid % WN;
    unsigned aoffs[2][2], boffs[2];
#pragma unroll
    for (int i = 0; i < 2; ++i) { int R, C; stage_rc(tid * 16 + i * 8192, R, C);
        aoffs[0][i] = arow(R) + (unsigned)C * 2u; aoffs[1][i] = arow(128 + R) + (unsigned)C * 2u; boffs[i] = (unsigned)(brow(R) * ldb + C) * 2u; }
    const unsigned ldsw = (unsigned)wid * 1024u;
    f32x4 acc[MT][4];
#pragma unroll
    for (int m = 0; m < MT; ++m)
#pragma unroll
        for (int n = 0; n < 4; ++n) acc[m][n] = (f32x4){0.f, 0.f, 0.f, 0.f};
    const int arow0 = wm * WR, ah = arow0 >> 7, ar = arow0 & 127;
    const int aoff = ah * HTB + lds_byte(ar + fr, fq * 8), boff = 2 * HTB + lds_byte(wn * 64 + fr, fq * 8);
#define SG_STAGE(kt, s) do { const int sg_ = (kt) / A.segTiles; const char* ab_ = (const char*)(sg_ == 0 ? A.p[0] : (sg_ == 1 ? A.p[1] : A.p[2])) + (size_t)((kt) - sg_ * A.segTiles) * 128; const char* bb_ = (const char*)Bt + (size_t)(kt) * 128; \
        _Pragma("unroll") for (int h_ = 0; h_ < 2; ++h_) _Pragma("unroll") for (int i_ = 0; i_ < 2; ++i_) \
            __builtin_amdgcn_global_load_lds((const unsigned*)(ab_ + aoffs[h_][i_]), (LAS unsigned*)(lds + ((s) * 3 + h_) * HTB + ldsw + i_ * 8192), 16, 0, 0); \
        _Pragma("unroll") for (int i_ = 0; i_ < WN; ++i_) \
            __builtin_amdgcn_global_load_lds((const unsigned*)(bb_ + boffs[i_]), (LAS unsigned*)(lds + ((s) * 3 + 2) * HTB + ldsw + i_ * 8192), 16, 0, 0); } while (0)
    SG_STAGE(0, 0);
    for (int t = 0; t < nt; ++t) {
        const int s = t & 1;
        if (t + 1 < nt) { SG_STAGE(t + 1, s ^ 1); if (WN == 2) WAIT_V(6); else WAIT_V(5); } else { WAIT_V(0); }
        SBAR();
        LAS unsigned char* base = lds + s * 3 * HTB;
#pragma unroll
        for (int k = 0; k < 2; ++k) {
            bf16x8 af[MT], bfr[4];
#pragma unroll
            for (int m = 0; m < MT; ++m) af[m] = *(const LAS bf16x8*)(base + aoff + m * 2048 + k * 1024);
#pragma unroll
            for (int n = 0; n < 4; ++n) bfr[n] = *(const LAS bf16x8*)(base + boff + n * 2048 + k * 1024);
#pragma unroll
            for (int m = 0; m < MT; ++m)
#pragma unroll
                for (int n = 0; n < 4; ++n) acc[m][n] = NSW ? __builtin_amdgcn_mfma_f32_16x16x32_bf16(af[m], bfr[n], acc[m][n], 0, 0, 0) : __builtin_amdgcn_mfma_f32_16x16x32_bf16(bfr[n], af[m], acc[m][n], 0, 0, 0);
        }
        SBAR();
    }
#undef SG_STAGE
    epi(acc, arow0, wn * 64, fr, fq);
}

struct CTile { bf16_t* dst; const float* src; int dld, sld, ncols; float scale; };
template <class TF>
__device__ __forceinline__ void conv_tiles(const Frame& F, int ntiles, int u0, int ustride, const TF& tf) {
    unsigned* tl = (unsigned*)F.ldsf;
    const int i = F.tid & 31, kp0 = F.tid >> 5;
    if (u0 >= ntiles) return;
    CTile ct = tf(u0);
    f32x4 a[4], b[4];
#define CV_LOAD() do { _Pragma("unroll") for (int q = 0; q < 4; ++q) { const int kp = kp0 + 16 * q; \
        if (4 * i < ct.ncols) { a[q] = *(const f32x4*)(ct.src + (size_t)(2 * kp) * ct.sld + 4 * i); b[q] = *(const f32x4*)(ct.src + (size_t)(2 * kp + 1) * ct.sld + 4 * i); } } } while (0)
    CV_LOAD();
    for (int u = u0; u < ntiles; u += ustride) {
        const CTile cur = ct;
        if (4 * i < cur.ncols) {
#pragma unroll
            for (int q = 0; q < 4; ++q) { const int kp = kp0 + 16 * q;
#pragma unroll
                for (int e = 0; e < 4; ++e) tl[(4 * i + e) * 65 + kp] = pack2(a[q][e] * cur.scale, b[q][e] * cur.scale); }
        }
        __syncthreads();
        if (u + ustride < ntiles) { ct = tf(u + ustride); CV_LOAD(); }
        const int nb = F.tid >> 4, sgm = F.tid & 15;
#pragma unroll
        for (int q = 0; q < 4; ++q) { const int n = nb + 32 * q;
            if (n < cur.ncols) { u32x4 v;
#pragma unroll
                for (int e = 0; e < 4; ++e) v[e] = tl[n * 65 + sgm * 4 + e];
                *(u32x4*)(cur.dst + (size_t)n * cur.dld + sgm * 8) = v; } }
        __syncthreads();
    }
#undef CV_LOAD
}
__device__ __forceinline__ void conv_moe(const Frame& F, int layer, int u0, int ustride) {
    bf16_t* WGU = (bf16_t*)(F.ws + WS_WGU); bf16_t* WDN = (bf16_t*)(F.ws + WS_WDN);
    const float* const* in = F.in;
    conv_tiles(F, 65 * 48, u0, ustride, [=](int u) {
        CTile c; const int e = u / 48, r = u % 48;
        if (r < 32) { const int up = r >> 4, kt = (r >> 1) & 7, nt = r & 1;
            const float* W = (e < 64) ? (up ? in[I_MU_] : in[I_MG]) + ((size_t)layer * NE + e) * D * DE : (up ? in[I_SU] : in[I_SG]) + (size_t)layer * D * DE;
            c.src = W + (size_t)kt * 128 * DE + nt * 128; c.sld = DE; c.dst = WGU + ((size_t)e * 512 + nt * 256 + up * 128) * D + kt * 128; c.dld = D; c.ncols = 128; c.scale = 1.0f; }
        else { const int v = r - 32, kt = v >> 3, nt = v & 7;
            const float* W = (e < 64) ? in[I_MD] + ((size_t)layer * NE + e) * DE * D : in[I_SD] + (size_t)layer * DE * D;
            c.src = W + (size_t)kt * 128 * D + nt * 128; c.sld = D; c.dst = WDN + ((size_t)e * D + nt * 128) * DE + kt * 128; c.dld = DE; c.ncols = 128; c.scale = YB_SCALE; }
        return c; });
}
__device__ __forceinline__ void conv_dense(const Frame& F, int u0, int ustride) {
    bf16_t* WRKV = (bf16_t*)(F.ws + WS_WRKV); bf16_t* WO = (bf16_t*)(F.ws + WS_WO); bf16_t* WQKV = (bf16_t*)(F.ws + WS_WQKV); bf16_t* WSBO = (bf16_t*)(F.ws + WS_WSBO); bf16_t* WLDN = (bf16_t*)(F.ws + WS_WLDN);
    const float* const* in = F.in;
    conv_tiles(F, 192 + 64 + 192 + 64 + 24, u0, ustride, [=](int u) {
        CTile c; c.dld = D; c.ncols = 128; c.scale = 1.0f;
        if (u < 192) { const int n = u / 64, kt = (u >> 3) & 7, nt = u & 7; c.src = in[I_WRKV] + (size_t)n * D * D + (size_t)kt * 128 * D + nt * 128; c.sld = D; c.dst = WRKV + ((size_t)n * D + nt * 128) * D + kt * 128; }
        else if (u < 256) { const int v = u - 192, kt = v >> 3, nt = v & 7; c.src = in[I_WO] + (size_t)kt * 128 * D + nt * 128; c.sld = D; c.dst = WO + (size_t)nt * 128 * D + kt * 128; }
        else if (u < 448) { const int v = u - 256, kt = v / 24, nt = v % 24; c.src = in[I_SBQKV] + (size_t)kt * 128 * 3 * D + nt * 128; c.sld = 3 * D; c.dst = WQKV + (size_t)nt * 128 * D + kt * 128; }
        else if (u < 512) { const int v = u - 448, kt = v >> 3, nt = v & 7; c.src = in[I_SBO] + (size_t)kt * 128 * D + nt * 128; c.sld = D; c.dst = WSBO + (size_t)nt * 128 * D + kt * 128; }
        else { const int v = u - 512, kt = v / 3, j = v % 3;
            if (j == 0) { c.src = in[I_WW1] + (size_t)kt * 128 * 64; c.sld = 64; c.dst = WLDN + kt * 128; c.ncols = 64; }
            else if (j == 1) { c.src = in[I_WA1] + (size_t)kt * 128 * 64; c.sld = 64; c.dst = WLDN + (size_t)64 * D + kt * 128; c.ncols = 64; }
            else { c.src = in[I_WG1] + (size_t)kt * 128 * 128; c.sld = 128; c.dst = WLDN + (size_t)128 * D + kt * 128; } }
        return c; });
    bf16_t* WLUP = (bf16_t*)(F.ws + WS_WLUP); bf16_t* WRT = (bf16_t*)(F.ws + WS_WRT);
    const int gtid = u0 * NTHREADS + F.tid, gstride = ustride * NTHREADS;
    for (int i = gtid; i < 1024 * 256; i += gstride) {
        float v;
        if (i < 1024 * 64) { const int n = i / 64, k = i % 64; v = F.in[I_WW2][k * D + n]; }
        else if (i < 2 * 1024 * 64) { const int j = i - 1024 * 64, n = j / 64, k = j % 64; v = F.in[I_WA2][k * D + n]; }
        else { const int j = i - 2 * 1024 * 64, n = j / 128, k = j % 128; v = F.in[I_WG2][k * D + n]; }
        WLUP[i] = f2bf(v);
    }
    for (int i = gtid; i < 2 * 64 * 1024; i += gstride) {
        const int l = i / (64 * 1024), j = i % (64 * 1024), e = j / 1024, k = j % 1024;
        const float w = F.in[I_ROUTER][((size_t)l * D + k) * NE + e]; const bf16_t hi = f2bf(w), lo = f2bf(w - bf2f(hi));
        bf16_t* row = WRT + ((size_t)l * 64 + e) * 3072; row[k] = hi; row[1024 + k] = lo; row[2048 + k] = hi;
    }
}

__device__ __forceinline__ unsigned pack_fp8x4(const f32x4& v) {
    const float lim = 440.0f;
    const float a = __builtin_amdgcn_fmed3f(v[0], -lim, lim), b = __builtin_amdgcn_fmed3f(v[1], -lim, lim), c = __builtin_amdgcn_fmed3f(v[2], -lim, lim), d = __builtin_amdgcn_fmed3f(v[3], -lim, lim);
    int w = __builtin_amdgcn_cvt_pk_fp8_f32(a, b, 0, false); w = __builtin_amdgcn_cvt_pk_fp8_f32(c, d, w, true); return (unsigned)w;
}
__device__ __forceinline__ void acc_fp8x16(float (&y)[16], const u32x4& w, float g) {
#pragma unroll
    for (int q = 0; q < 4; ++q) { const f32x2 lo = __builtin_amdgcn_cvt_pk_f32_fp8((int)w[q], false), hi = __builtin_amdgcn_cvt_pk_f32_fp8((int)w[q], true);
        y[4 * q] += g * lo.x; y[4 * q + 1] += g * lo.y; y[4 * q + 2] += g * hi.x; y[4 * q + 3] += g * hi.y; }
}
__device__ __forceinline__ void ph_mod(const Frame& F) {
    const float* c = F.in[I_C]; const float* W = F.in[I_ADAW]; const float* bias = F.in[I_ADAB];
    float* MOD = (float*)(F.ws + WS_MOD);
    float* red = F.ldsf;
    float* sc = F.ldsf + 1024;
    for (int i = F.tid; i < 2 * D; i += NTHREADS) { const float v = c[i]; sc[i] = v * sigmoidf_(v); }
    __syncthreads();
    for (int u = F.bid; u < 192; u += F.G) {
        const int l = u / 96, cg = u % 96, col = cg * 64 + F.lane;
        float s0 = 0.f, s1 = 0.f;
        const float* wp = W + ((size_t)l * D + F.wave * 128) * 6144 + col;
#pragma unroll 1
        for (int d0 = 0; d0 < 128; d0 += 32) {
            float wv[32];
#pragma unroll
            for (int d = 0; d < 32; ++d) wv[d] = wp[(size_t)(d0 + d) * 6144];
#pragma unroll
            for (int d = 0; d < 32; ++d) { const int dd = F.wave * 128 + d0 + d; s0 += sc[dd] * wv[d]; s1 += sc[D + dd] * wv[d]; }
        }
        red[(F.wave * 2 + 0) * 64 + F.lane] = s0; red[(F.wave * 2 + 1) * 64 + F.lane] = s1;
        __syncthreads();
        if (F.tid < 128) {
            const int b = F.tid >> 6, cc = F.tid & 63; float s = 0.f;
#pragma unroll
            for (int w = 0; w < 8; ++w) s += red[(w * 2 + b) * 64 + cc];
            MOD[(l * 2 + b) * 6144 + cg * 64 + cc] = s + bias[l * 6144 + cg * 64 + cc];
        }
        __syncthreads();
    }
}

__device__ __forceinline__ void ph_prenorm_rwkv(const Frame& F) {
    const float* x = F.in[I_X]; const float* g = F.in[I_NPM]; const float* mu = F.in[I_MU];
    const float* MOD = (const float*)(F.ws + WS_MOD);
    bf16_t* XS = (bf16_t*)(F.ws + WS_XS);
    constexpr int RUN_T = 8;
    const int nunits = T / RUN_T, c0 = 16 * F.lane;
    f32x4 m[6][4];
#pragma unroll
    for (int n = 0; n < 6; ++n)
#pragma unroll
        for (int i = 0; i < 4; ++i) m[n][i] = *(const f32x4*)(mu + n * D + c0 + 4 * i);
    for (int u = F.bid * NWAVES + F.wave; u < nunits; u += F.G * NWAVES) {
        const int t0 = u * RUN_T, b = t0 / SEQ;
        const float* shift = MOD + (0 * 2 + b) * 6144; const float* scale = shift + 1024;
        f32x4 gm[4], sh[4];
#pragma unroll
        for (int i = 0; i < 4; ++i) { const int c = c0 + 4 * i; const f32x4 gv = *(const f32x4*)(g + c), sc = *(const f32x4*)(scale + c); gm[i] = gv * (sc + 1.0f); sh[i] = *(const f32x4*)(shift + c); }
        f32x4 hp[4];
#pragma unroll
        for (int i = 0; i < 4; ++i) hp[i] = (f32x4){0.f, 0.f, 0.f, 0.f};
        const int tstart = (t0 % SEQ == 0) ? t0 : t0 - 1;
        for (int t = tstart; t < t0 + RUN_T; ++t) {
            f32x4 xv[4]; float ss = 0.f;
#pragma unroll
            for (int i = 0; i < 4; ++i) { xv[i] = *(const f32x4*)(x + (size_t)t * D + c0 + 4 * i); ss += xv[i][0] * xv[i][0] + xv[i][1] * xv[i][1] + xv[i][2] * xv[i][2] + xv[i][3] * xv[i][3]; }
            ss = wave_sum(ss);
            const float rs = rsqrtf(ss * (1.0f / D) + 1e-6f);
            f32x4 h[4];
#pragma unroll
            for (int i = 0; i < 4; ++i) h[i] = xv[i] * rs * gm[i] + sh[i];
            if (t >= t0) {
#pragma unroll
                for (int n = 0; n < 6; ++n) {
                    u32x4 w0, w1;
#pragma unroll
                    for (int i = 0; i < 4; ++i) {
                        const f32x4 v = h[i] + (hp[i] - h[i]) * m[n][i];
                        const unsigned a0 = pack2(v[0], v[1]), a1 = pack2(v[2], v[3]);
                        if (i == 0) { w0[0] = a0; w0[1] = a1; } else if (i == 1) { w0[2] = a0; w0[3] = a1; } else if (i == 2) { w1[0] = a0; w1[1] = a1; } else { w1[2] = a0; w1[3] = a1; }
                    }
                    bf16_t* dst = XS + ((size_t)n * T + t) * D + c0;
                    *(u32x4*)dst = w0; *(u32x4*)(dst + 8) = w1;
                }
            }
#pragma unroll
            for (int i = 0; i < 4; ++i) hp[i] = h[i];
        }
    }
}


__device__ __forceinline__ void ph_postmix_preffn(const Frame& F, int layer, const float* xin, const bf16_t* Y) {
    const float* MOD = (const float*)(F.ws + WS_MOD);
    const float* gpo = F.in[I_NPOM] + layer * D; const float* gpf = F.in[I_NPF] + layer * D;
    bf16_t* H2 = (bf16_t*)(F.ws + WS_H2); bf16_t* H2LO = (bf16_t*)(F.ws + WS_H2LO);
    for (int t = F.bid * NWAVES + F.wave; t < T; t += F.G * NWAVES) {
        const int b = t / SEQ; const float* m = MOD + (layer * 2 + b) * 6144;
        f32x4 y[4]; float ss = 0.f;
#pragma unroll
        for (int i = 0; i < 4; ++i) { y[i] = ld4_g(Y + (size_t)t * D + 4 * F.lane + 256 * i); ss += y[i][0] * y[i][0] + y[i][1] * y[i][1] + y[i][2] * y[i][2] + y[i][3] * y[i][3]; }
        ss = wave_sum(ss);
        const float rs = rsqrtf(ss * (1.0f / D) + 1e-6f);
        f32x4 x1[4]; float s2 = 0.f;
#pragma unroll
        for (int i = 0; i < 4; ++i) { const int c = 4 * F.lane + 256 * i;
            const f32x4 xv = *(const f32x4*)(xin + (size_t)t * D + c), gm = *(const f32x4*)(m + 2048 + c), gp = *(const f32x4*)(gpo + c);
            x1[i] = xv + gm * (y[i] * rs * gp);
            *(f32x4*)(F.out + (size_t)t * D + c) = x1[i];
            s2 += x1[i][0] * x1[i][0] + x1[i][1] * x1[i][1] + x1[i][2] * x1[i][2] + x1[i][3] * x1[i][3]; }
        s2 = wave_sum(s2);
        const float rs2 = rsqrtf(s2 * (1.0f / D) + 1e-6f);
#pragma unroll
        for (int i = 0; i < 4; ++i) { const int c = 4 * F.lane + 256 * i;
            const f32x4 gf = *(const f32x4*)(gpf + c), sc = *(const f32x4*)(m + 4096 + c), sh = *(const f32x4*)(m + 3072 + c);
            const f32x4 h = x1[i] * rs2 * gf * (sc + 1.0f) + sh;
            u32x2 w; w.x = pack2(h[0], h[1]); w.y = pack2(h[2], h[3]);
            u32x2 wl; wl.x = pack2(h[0] - lo2f(w.x), h[1] - hi2f(w.x)); wl.y = pack2(h[2] - lo2f(w.y), h[3] - hi2f(w.y));
            *(u32x2*)(H2 + (size_t)t * D + c) = w; *(u32x2*)(H2LO + (size_t)t * D + c) = wl; }
    }
}


__device__ __forceinline__ void ph_topk(const Frame& F, int layer) {
    const float* LOG = (const float*)(F.ws + WS_LOGITS); const float* rb = F.in[I_RBIAS] + layer * NE;
    int* IDX = (int*)(F.ws + WS_IDX); float* GATE = (float*)(F.ws + WS_GATE); int* RANK = (int*)(F.ws + WS_RANK);
    unsigned* BC = (unsigned*)(F.ws + WS_BC);
    unsigned* lcnt = (unsigned*)F.ldsf;
    const float bias = rb[F.lane];
    for (int base = F.bid * 64; base < T; base += F.G * 64) {
        if (F.tid < 64) lcnt[F.tid] = 0u;
        __syncthreads();
        float s[8], sel[8], tot[8], mysc[8]; int myidx[8]; unsigned lrank[8];
#pragma unroll
        for (int j = 0; j < 8; ++j) { const size_t o = (size_t)(base + F.wave * 8 + j) * NE + F.lane;
            s[j] = sigmoidf_(LOG[o] + LOG[(size_t)T * NE + o] + LOG[(size_t)2 * T * NE + o]); sel[j] = s[j] + bias; tot[j] = 0.f; mysc[j] = 0.f; myidx[j] = 0; }
#pragma unroll
        for (int k = 0; k < TOPK; ++k) {
            float bv[8]; int bi[8];
#pragma unroll
            for (int j = 0; j < 8; ++j) { bv[j] = sel[j]; bi[j] = F.lane; }
#pragma unroll
            for (int o = 32; o >= 1; o >>= 1) {
#pragma unroll
                for (int j = 0; j < 8; ++j) { const float ov = __shfl_xor(bv[j], o); const int oi = __shfl_xor(bi[j], o); const bool take = (ov > bv[j]) | ((ov == bv[j]) & (oi < bi[j]));     bv[j] = take ? ov : bv[j]; bi[j] = take ? oi : bi[j]; }
            }
#pragma unroll
            for (int j = 0; j < 8; ++j) { const float sc = __shfl(s[j], bi[j]); tot[j] += sc; const bool me = (F.lane == k); myidx[j] = me ? bi[j] : myidx[j]; mysc[j] = me ? sc : mysc[j]; sel[j] = (F.lane == bi[j]) ? -1e30f : sel[j]; }
        }
#pragma unroll
        for (int j = 0; j < 8; ++j) { const int t = base + F.wave * 8 + j; lrank[j] = 0u;
            if (F.lane < TOPK) { IDX[t * TOPK + F.lane] = myidx[j]; GATE[t * TOPK + F.lane] = 2.5f * mysc[j] / tot[j]; lrank[j] = atomicAdd(&lcnt[myidx[j]], 1u); } }
        __syncthreads();
        if (F.tid < 64) BC[(base >> 6) * 64 + F.tid] = lcnt[F.tid];
#pragma unroll
        for (int j = 0; j < 8; ++j) { const int t = base + F.wave * 8 + j; if (F.lane < TOPK) RANK[t * TOPK + F.lane] = (int)lrank[j]; }
        __syncthreads();
    }
}

__device__ __forceinline__ void ph_offsets(const Frame& F, int layer) {
    const unsigned* BC = (const unsigned*)(F.ws + WS_BC);
    const int* IDX = (const int*)(F.ws + WS_IDX); const int* RANK = (const int*)(F.ws + WS_RANK);
    int* POS = (int*)(F.ws + WS_POS); int* TOK = (int*)(F.ws + WS_TOK); int* TILEE = (int*)(F.ws + WS_TILEE); int* START = (int*)(F.ws + WS_START);
    int* sst = (int*)F.ldsf;
    constexpr int NG = T / 64;
    for (int g = F.bid; g < NG; g += F.G) {
        { const int e = F.tid & 63, part = F.tid >> 6; int tot = 0, pre = 0;
          for (int gg = part; gg < NG; gg += 8) { const int v = (int)BC[gg * 64 + e]; tot += v; if (gg < g) pre += v; }
          sst[512 + part * 64 + e] = tot; sst[1024 + part * 64 + e] = pre; }
        __syncthreads();
        if (F.tid < 64) { int tot = 0, pre = 0;
#pragma unroll
            for (int q = 0; q < 8; ++q) { tot += sst[512 + q * 64 + F.tid]; pre += sst[1024 + q * 64 + F.tid]; }
            sst[128 + F.tid] = tot; sst[256 + F.tid] = pre; }
        __syncthreads();
        if (F.tid == 0) { int acc = 0; for (int e = 0; e < NE; ++e) { const int c = sst[128 + e]; sst[e] = acc; acc += ((c + RP - 1) / RP) * RP; } sst[64] = acc; }
        __syncthreads();
        if (g == 0) {
            if (F.tid <= 64) START[F.tid] = sst[F.tid];
            if (F.tid == 65) START[65] = sst[64];
            const int ntile = sst[64] / RP;
            for (int i = F.tid; i < ntile; i += NTHREADS) { int e = 0; while (e < 63 && sst[e + 1] <= i * RP) ++e; TILEE[i] = e; }
            for (int q = F.tid; q < NE * RP; q += NTHREADS) { const int e = q / RP, r = q % RP, c = sst[128 + e]; if (sst[e] + c + r < sst[e + 1]) TOK[sst[e] + c + r] = 0; }
        }
        { const int sl = g * 64 * TOPK + F.tid;
          const int e = IDX[sl], p = sst[e] + sst[256 + e] + RANK[sl];
          POS[sl] = p; TOK[p] = sl / TOPK; }
        __syncthreads();
    }
}

__device__ __forceinline__ void ph_combine(const Frame& F, int layer, bool next) {
    const unsigned char* YB = (const unsigned char*)(F.ws + WS_YB); const int* POS = (const int*)(F.ws + WS_POS); const float* GATE = (const float*)(F.ws + WS_GATE);
    const int* START = (const int*)(F.ws + WS_START); const float* MOD = (const float*)(F.ws + WS_MOD);
    const float* gpo = F.in[I_NPOF] + layer * D;
    bf16_t* H3 = (bf16_t*)(F.ws + WS_H3);
    const int routed = START[65], c0 = 16 * F.lane;
    for (int t = F.bid * NWAVES + F.wave; t < T; t += F.G * NWAVES) {
        const int b = t / SEQ; const float* m = MOD + (layer * 2 + b) * 6144;
        int pos[TOPK]; float gk[TOPK];
        { const u32x4 p0 = *(const u32x4*)(POS + t * TOPK), p1 = *(const u32x4*)(POS + t * TOPK + 4); const f32x4 g0 = *(const f32x4*)(GATE + t * TOPK), g1 = *(const f32x4*)(GATE + t * TOPK + 4);
#pragma unroll
          for (int k = 0; k < 4; ++k) { pos[k] = (int)p0[k]; pos[4 + k] = (int)p1[k]; gk[k] = g0[k]; gk[4 + k] = g1[k]; } }
        u32x4 rw[TOPK + 1];
        rw[TOPK] = *(const u32x4*)(YB + (size_t)(routed + t) * D + c0);
#pragma unroll
        for (int k = 0; k < TOPK; ++k) rw[k] = *(const u32x4*)(YB + (size_t)pos[k] * D + c0);
        float y[16];
#pragma unroll
        for (int e = 0; e < 16; ++e) y[e] = 0.f;
        acc_fp8x16(y, rw[TOPK], 1.0f / YB_SCALE);
#pragma unroll
        for (int k = 0; k < TOPK; ++k) acc_fp8x16(y, rw[k], gk[k] * (1.0f / YB_SCALE));
        float ss = 0.f;
#pragma unroll
        for (int e = 0; e < 16; ++e) ss += y[e] * y[e];
        ss = wave_sum(ss);
        const float rs = rsqrtf(ss * (1.0f / D) + 1e-6f);
        f32x4 x2[4]; float s2 = 0.f;
#pragma unroll
        for (int i = 0; i < 4; ++i) { const int c = c0 + 4 * i;
            const f32x4 xv = *(const f32x4*)(F.out + (size_t)t * D + c), gm = *(const f32x4*)(m + 5120 + c), gp = *(const f32x4*)(gpo + c);
            const f32x4 yv = {y[4 * i], y[4 * i + 1], y[4 * i + 2], y[4 * i + 3]};
            x2[i] = xv + gm * (yv * rs * gp);
            *(f32x4*)(F.out + (size_t)t * D + c) = x2[i];
            s2 += x2[i][0] * x2[i][0] + x2[i][1] * x2[i][1] + x2[i][2] * x2[i][2] + x2[i][3] * x2[i][3]; }
        if (next) {
            s2 = wave_sum(s2);
            const float rs2 = rsqrtf(s2 * (1.0f / D) + 1e-6f);
            const float* m1 = MOD + ((layer + 1) * 2 + b) * 6144; const float* g1 = F.in[I_NPM] + (layer + 1) * D;
            u32x4 h0, h1;
#pragma unroll
            for (int i = 0; i < 4; ++i) { const int c = c0 + 4 * i;
                const f32x4 gf = *(const f32x4*)(g1 + c), sc = *(const f32x4*)(m1 + 1024 + c), sh = *(const f32x4*)(m1 + c);
                const f32x4 h = x2[i] * rs2 * gf * (sc + 1.0f) + sh;
                const unsigned w0 = pack2(h[0], h[1]), w1 = pack2(h[2], h[3]);
                if (i == 0) { h0[0] = w0; h0[1] = w1; } else if (i == 1) { h0[2] = w0; h0[3] = w1; } else if (i == 2) { h1[0] = w0; h1[1] = w1; } else { h1[2] = w0; h1[3] = w1; } }
            *(u32x4*)(H3 + (size_t)t * D + c0) = h0; *(u32x4*)(H3 + (size_t)t * D + c0 + 8) = h1;
        }
    }
}

#define SB_EXIT 110.0f

namespace pgx {
__device__ __forceinline__ int perm32(int rho) { const int n = rho >> 4, i = rho & 15; return 8 * (i >> 2) + 4 * n + (i & 3); }
struct Unit { const char* A; const int* tok; const char* B; int r0, c0, aux; };
template <bool SW, bool PERM, class Sched, class Epi>
__device__ __forceinline__ void gemm_phase(LAS unsigned char* lds, const int K, const unsigned lda  , const Sched& S, const Epi& E) {
    int tid_ = threadIdx.x; asm volatile("" : "+v"(tid_));
    const int tid = tid_, wid = __builtin_amdgcn_readfirstlane(tid >> 6), lane = tid & 63, wr = wid >> 2, wc = wid & 3, fr = lane & 15, fq = lane >> 4;
    const int nt = K / 64;
    int Rr[2], Cc[2]; unsigned voffB[2];
#pragma unroll
    for (int i = 0; i < 2; ++i) { stage_rc(tid * 16 + i * 8192, Rr[i], Cc[i]); const int Rb = PERM ? ((Rr[i] & ~31) + perm32(Rr[i] & 31)) : Rr[i]; voffB[i] = (unsigned)(Rb * K + Cc[i]) * 2u; }
    const size_t kstep = 128, hstepB = (size_t)128 * K * 2;
    const unsigned ldsw = (unsigned)wid * 1024u;
    const int aoff = lds_byte(wr * 64 + fr, fq * 8), boff = lds_byte(wc * 32 + fr, fq * 8);
#define PX_SA(b, h) (((b) * 2 + (h)) * HTB)
#define PX_SB(b, h) ((4 + (b) * 2 + (h)) * HTB)
#define PX_STAGE(bufoff, gbase, voff) do { _Pragma("unroll") for (int _i = 0; _i < 2; ++_i) \
        __builtin_amdgcn_global_load_lds((const unsigned*)((const char*)(gbase) + (voff)[_i]), (LAS unsigned*)(lds + (bufoff) + ldsw + _i * 8192), 16, 0, 0); } while (0)
#define PX_LDA(dst, b, h) do { _Pragma("unroll") for (int m = 0; m < 4; ++m) _Pragma("unroll") for (int k = 0; k < 2; ++k) dst[m][k] = *(const LAS bf16x8*)(lds + PX_SA(b, h) + aoff + m * 2048 + k * 1024); } while (0)
#define PX_LDB(dst, b, h) do { _Pragma("unroll") for (int n = 0; n < 2; ++n) _Pragma("unroll") for (int k = 0; k < 2; ++k) dst[n][k] = *(const LAS bf16x8*)(lds + PX_SB(b, h) + boff + n * 2048 + k * 1024); } while (0)
#define PX_MMA(ai, bj, At, Bt) do { __builtin_amdgcn_s_setprio(1); _Pragma("unroll") for (int m = 0; m < 4; ++m) _Pragma("unroll") for (int n = 0; n < 2; ++n) _Pragma("unroll") for (int k = 0; k < 2; ++k) \
        acc[ai][bj][m][n] = SW ? __builtin_amdgcn_mfma_f32_16x16x32_bf16(Bt[n][k], At[m][k], acc[ai][bj][m][n], 0, 0, 0) : __builtin_amdgcn_mfma_f32_16x16x32_bf16(At[m][k], Bt[n][k], acc[ai][bj][m][n], 0, 0, 0); __builtin_amdgcn_s_setprio(0); } while (0)
#define PX_WAIT_L(n) asm volatile("s_waitcnt lgkmcnt(" #n ")" ::: "memory")
#define PX_BAR __builtin_amdgcn_s_barrier()
#define PX_SCHED __builtin_amdgcn_sched_barrier(0)
#define PX_OFFS(dst, un) do { _Pragma("unroll") for (int h_ = 0; h_ < 2; ++h_) _Pragma("unroll") for (int i_ = 0; i_ < 2; ++i_) { \
        const int row_ = h_ * 128 + Rr[i_]; const unsigned rid_ = (un).tok ? (unsigned)(un).tok[row_] : (unsigned)row_; dst[h_][i_] = rid_ * lda + (unsigned)Cc[i_] * 2u; } } while (0)
    Unit cur, nxt; int ui = 0;
    if (!S.next(0, cur)) return;
    f32x4 acc[2][2][4][2];
#pragma unroll
    for (int a = 0; a < 2; ++a)
#pragma unroll
        for (int b = 0; b < 2; ++b)
#pragma unroll
            for (int m = 0; m < 4; ++m)
#pragma unroll
                for (int n = 0; n < 2; ++n) acc[a][b][m][n] = (f32x4){0.f, 0.f, 0.f, 0.f};
    bf16x8 At[4][2], B0[2][2], B1[2][2];
    unsigned oc[2][2], on[2][2];
    PX_OFFS(oc, cur); asm volatile("" : "+v"(oc[0][0]), "+v"(oc[0][1]), "+v"(oc[1][0]), "+v"(oc[1][1]));
    const char* cA = cur.A; const char* cB = cur.B;
    PX_STAGE(PX_SB(0, 0), cB, voffB); PX_STAGE(PX_SA(0, 0), cA, oc[0]); PX_STAGE(PX_SB(0, 1), cB + hstepB, voffB); PX_STAGE(PX_SA(0, 1), cA, oc[1]);
    if (wr == 1) PX_BAR;
    WAIT_V(4); PX_BAR;
    PX_STAGE(PX_SB(1, 0), cB + kstep, voffB); PX_STAGE(PX_SA(1, 0), cA + kstep, oc[0]); PX_STAGE(PX_SB(1, 1), cB + hstepB + kstep, voffB);
    WAIT_V(6); PX_BAR;
    for (;;) {
        const bool has_next = S.next(ui + 1, nxt);
        const char* nA = has_next ? nxt.A : cA; const char* nB = has_next ? nxt.B : cB;
        if (has_next) { PX_OFFS(on, nxt); asm volatile("" : "+v"(on[0][0]), "+v"(on[0][1]), "+v"(on[1][0]), "+v"(on[1][1])); } else {
#pragma unroll
            for (int h_ = 0; h_ < 2; ++h_)
#pragma unroll
                for (int i_ = 0; i_ < 2; ++i_) on[h_][i_] = oc[h_][i_]; }
#pragma unroll 1
        for (int t = 0; t < nt; t += 2) {
            const bool last = (t == nt - 2);
            const char* a1 = cA + (size_t)(t + 1) * kstep;
            const char* a2 = last ? nA : cA + (size_t)(t + 2) * kstep; const char* b2 = last ? nB : cB + (size_t)(t + 2) * kstep;
            const char* a3 = a2 + kstep; const char* b3 = b2 + kstep;
            unsigned o2[2][2];
#pragma unroll
            for (int h_ = 0; h_ < 2; ++h_)
#pragma unroll
                for (int i_ = 0; i_ < 2; ++i_) o2[h_][i_] = last ? on[h_][i_] : oc[h_][i_];
            PX_LDB(B0, 0, 0); PX_SCHED; PX_LDA(At, 0, 0); PX_STAGE(PX_SA(1, 1), a1, oc[1]);
            PX_WAIT_L(8); PX_BAR; PX_WAIT_L(0); PX_MMA(0, 0, At, B0); PX_BAR; PX_SCHED;
            PX_LDB(B1, 0, 1); PX_STAGE(PX_SB(0, 0), b2, voffB);
            PX_BAR; PX_WAIT_L(0); PX_MMA(0, 1, At, B1); PX_BAR;
            PX_LDA(At, 0, 1); PX_STAGE(PX_SA(0, 0), a2, o2[0]);
            PX_BAR; PX_WAIT_L(0); PX_MMA(1, 0, At, B0); PX_BAR; PX_SCHED;
            PX_STAGE(PX_SB(0, 1), b2 + hstepB, voffB);
            WAIT_V(6); PX_BAR; PX_MMA(1, 1, At, B1); PX_BAR;
            PX_LDB(B0, 1, 0); PX_SCHED; PX_LDA(At, 1, 0); PX_STAGE(PX_SA(0, 1), a2, o2[1]);
            PX_WAIT_L(8); PX_BAR; PX_WAIT_L(0); PX_MMA(0, 0, At, B0); PX_BAR; PX_SCHED;
            PX_LDB(B1, 1, 1); PX_STAGE(PX_SB(1, 0), b3, voffB);
            PX_BAR; PX_WAIT_L(0); PX_MMA(0, 1, At, B1); PX_BAR;
            PX_LDA(At, 1, 1); PX_STAGE(PX_SA(1, 0), a3, o2[0]);
            PX_BAR; PX_WAIT_L(0); PX_MMA(1, 0, At, B0); PX_BAR; PX_SCHED;
            PX_STAGE(PX_SB(1, 1), b3 + hstepB, voffB);
            WAIT_V(6); PX_BAR; PX_MMA(1, 1, At, B1); PX_BAR;
        }
        E(acc, cur, wr, wc, fr, fq);
        if (!has_next) break;
#pragma unroll
        for (int a = 0; a < 2; ++a)
#pragma unroll
            for (int b = 0; b < 2; ++b)
#pragma unroll
                for (int m = 0; m < 4; ++m)
#pragma unroll
                    for (int n = 0; n < 2; ++n) acc[a][b][m][n] = (f32x4){0.f, 0.f, 0.f, 0.f};
        cur = nxt; cA = nA; cB = nB; ++ui;
#pragma unroll
        for (int h_ = 0; h_ < 2; ++h_)
#pragma unroll
            for (int i_ = 0; i_ < 2; ++i_) oc[h_][i_] = on[h_][i_];
    }
    WAIT_V(0);
    if (wr == 0) PX_BAR;
    PX_BAR;
#undef PX_SA
#undef PX_SB
#undef PX_STAGE
#undef PX_LDA
#undef PX_LDB
#undef PX_MMA
#undef PX_WAIT_L
#undef PX_BAR
#undef PX_SCHED
#undef PX_OFFS
}
__device__ __forceinline__ unsigned cvt_pk_bf16(float lo, float hi) { return pack2(lo, hi); }
}

__device__ __forceinline__ size_t hm_off(int t, int c) { return ((size_t)((t / SEQ) * NH + (c >> 6)) * SEQ + (t % SEQ)) * 64 + (c & 63); }
#define EPI_MT(acc) (int)(sizeof(acc) / sizeof(acc[0]))
__device__ __forceinline__ void st_bf4(bf16_t* p, const f32x4& v) { u32x2 w; w.x = pack2(v[0], v[1]); w.y = pack2(v[2], v[3]); *(u32x2*)p = w; }

__device__ __forceinline__ void ph_lora_up_sg(const Frame& F) {
    const bf16_t* LORA = (const bf16_t*)(F.ws + WS_LORA); const bf16_t* WLUP = (const bf16_t*)(F.ws + WS_WLUP);
    bf16_t* LD = (bf16_t*)(F.ws + WS_LD); bf16_t* AA = (bf16_t*)(F.ws + WS_AA); bf16_t* GG = (bf16_t*)(F.ws + WS_GG);
    for (int u = F.bid; u < 3 * 64 * 8; u += F.G) {
        const int which = u / 512, v = u % 512, mt = v / 8, col0 = (v % 8) * 128;
        const int K = which == 2 ? 128 : 64, koff = which * 64;
        ASeg A; A.p[0] = LORA + (size_t)mt * 256 * 256 + koff; A.p[1] = A.p[0]; A.p[2] = A.p[0]; A.segTiles = 4;
        const bf16_t* Bt = WLUP + (which == 0 ? 0 : (which == 1 ? 1024 * 64 : 2 * 1024 * 64)) + (size_t)col0 * K;
        const size_t obase = (size_t)mt * 256 * D + col0;
        sg_tile<128>(F.lds, A, [](int R) { return (unsigned)R * 512u; }, Bt, K, K / 64,
            [&](auto& acc, int r0, int c0, int fr, int fq) {
#pragma unroll
                for (int m = 0; m < EPI_MT(acc); ++m)
#pragma unroll
                    for (int q = 0; q < 4; ++q) {
                        const int c = c0 + 16 * q + 4 * fq; const size_t o = hm_off(mt * 256 + r0 + 16 * m + fr, col0 + c);
                        if (which == 0) { const f32x4 w0 = *(const f32x4*)(F.in[I_W0] + col0 + c); f32x4 r;
#pragma unroll
                            for (int e = 0; e < 4; ++e) { const float wl = w0[e] + acc[m][q][e]; r[e] = -fexp_(-softplusf_(-wl) - 0.5f); }
                            st_bf4(LD + o, r); }
                        else if (which == 1) { const f32x4 a0 = *(const f32x4*)(F.in[I_A0] + col0 + c); f32x4 r;
#pragma unroll
                            for (int e = 0; e < 4; ++e) r[e] = sigmoidf_(a0[e] + acc[m][q][e]);
                            st_bf4(AA + o, r); }
                        else st_bf4(GG + o, acc[m][q]);
                    }
            });
    }
}
__device__ __forceinline__ void ph_router_sg(const Frame& F, int layer) {
    const bf16_t* H2 = (const bf16_t*)(F.ws + WS_H2); const bf16_t* H2LO = (const bf16_t*)(F.ws + WS_H2LO);
    const bf16_t* WRT = (const bf16_t*)(F.ws + WS_WRT) + (size_t)layer * 64 * 3072; float* LOG = (float*)(F.ws + WS_LOGITS);
    for (int u = F.bid; u < 64 * 3; u += F.G) {
        const int mt = u / 3, sgi = u % 3;
        ASeg A; A.p[0] = (sgi == 2 ? H2LO : H2) + (size_t)mt * 256 * D; A.p[1] = A.p[0]; A.p[2] = A.p[0]; A.segTiles = 16;
        float* out = LOG + (size_t)sgi * T * NE;
        sg_tile<64>(F.lds, A, [](int R) { return (unsigned)R * (D * 2); }, WRT + sgi * 1024, 3072, 16,
            [&](auto& acc, int r0, int c0, int fr, int fq) {
#pragma unroll
                for (int m = 0; m < EPI_MT(acc); ++m)
#pragma unroll
                    for (int q = 0; q < 4; ++q) *(f32x4*)(out + (size_t)(mt * 256 + r0 + 16 * m + fr) * NE + c0 + 16 * q + 4 * fq) = acc[m][q];
            });
    }
}

constexpr int MS = 72;
constexpr int SLOT = 64 * MS * 2;
__device__ __forceinline__ int ms_off(int row, int col) { return row * MS + col; }
constexpr size_t WS_BONUS = 3 * MiB;
constexpr size_t WS_RP = WS_BIG + 128 * MiB;
constexpr size_t WS_OL = WS_BIG + 160 * MiB;
constexpr size_t WS_G2 = WS_BIG + 296 * MiB;
constexpr size_t WS_DM = WS_BIG + 328 * MiB;
constexpr size_t WS_ST = WS_BIG + 360 * MiB;

__device__ __forceinline__ void st4_lds(LAS bf16_t* p, const f32x4& v) { u32x2 w; w.x = pack2(v[0], v[1]); w.y = pack2(v[2], v[3]); *(LAS u32x2*)p = w; }
__device__ __forceinline__ f32x4 ld4_lds(const LAS bf16_t* p) { const u32x2 w = *(const LAS u32x2*)p; return (f32x4){lo2f(w.x), hi2f(w.x), lo2f(w.y), hi2f(w.y)}; }

__device__ __forceinline__ void ph_wkv_chunk(const Frame& F) {
    const bf16_t* RKV = (const bf16_t*)(F.ws + WS_RKV); const bf16_t* LD = (const bf16_t*)(F.ws + WS_LD); const bf16_t* AA = (const bf16_t*)(F.ws + WS_AA);
    const bf16_t* Rb = RKV; const bf16_t* Kb = RKV + (size_t)T * D; const bf16_t* Vb = RKV + (size_t)2 * T * D;
    bf16_t* RP = (bf16_t*)(F.ws + WS_RP); bf16_t* OL = (bf16_t*)(F.ws + WS_OL); bf16_t* G2 = (bf16_t*)(F.ws + WS_G2); bf16_t* DM = (bf16_t*)(F.ws + WS_DM);
    float* BONUS = (float*)(F.ws + WS_BONUS);
#define SL(k) ((LAS bf16_t*)(F.lds + (k) * SLOT))
#define AT(k, r, c) (SL(k) + ms_off((r), (c)))
    LAS float* segtot = (LAS float*)(F.lds + 15 * SLOT);
    LAS float* WCs = segtot + 512;
    const int w = F.wave, lane = F.lane, fr = lane & 15, fq = lane >> 4, mt = w >> 1, ntb = 2 * (w & 1);
    for (int cid = F.bid; cid < NB * NH * (SEQ / 64); cid += F.G) {
        const int bh = cid / (SEQ / 64), c = cid % (SEQ / 64), b = bh / NH, h = bh % NH;
        const size_t tok0 = (size_t)b * SEQ + (size_t)c * 64;
        {
            const int t = F.tid >> 3, jg = lane & 7, tl = lane >> 3, ch0 = h * 64 + 8 * jg;
            const size_t o = ((size_t)bh * SEQ + (size_t)c * 64 + t) * 64 + 8 * jg;
            const u32x4 rr = *(const u32x4*)(Rb + o), kr = *(const u32x4*)(Kb + o), vr = *(const u32x4*)(Vb + o), ar = *(const u32x4*)(AA + o);
            const u32x4 lr = *(const u32x4*)(LD + o);
            float r[8], k[8], a[8], ld[8], cum[8];
#pragma unroll
            for (int q = 0; q < 4; ++q) { r[2 * q] = lo2f(rr[q]); r[2 * q + 1] = hi2f(rr[q]); k[2 * q] = lo2f(kr[q]); k[2 * q + 1] = hi2f(kr[q]); a[2 * q] = lo2f(ar[q]); a[2 * q + 1] = hi2f(ar[q]); ld[2 * q] = lo2f(lr[q]); ld[2 * q + 1] = hi2f(lr[q]); }
#pragma unroll
            for (int e = 0; e < 8; ++e) { float v = ld[e];
                float u1 = __shfl_up(v, 8);  if (tl >= 1) v += u1;
                float u2 = __shfl_up(v, 16); if (tl >= 2) v += u2;
                float u4 = __shfl_up(v, 32); if (tl >= 4) v += u4;
                cum[e] = v; }
            if (tl == 7) {
#pragma unroll
                for (int e = 0; e < 8; ++e) segtot[w * 64 + 8 * jg + e] = cum[e]; }
            __syncthreads();
            float tot[8];
#pragma unroll
            for (int e = 0; e < 8; ++e) tot[e] = 0.f;
#pragma unroll
            for (int ww = 0; ww < 8; ++ww) {
                const f32x4 s0 = *(const LAS f32x4*)(segtot + ww * 64 + 8 * jg), s1 = *(const LAS f32x4*)(segtot + ww * 64 + 8 * jg + 4);
#pragma unroll
                for (int q = 0; q < 4; ++q) { tot[q] += s0[q]; tot[4 + q] += s1[q]; if (ww < w) { cum[q] += s0[q]; cum[4 + q] += s1[q]; } }
            }
            if (t == 0) {
#pragma unroll
                for (int e = 0; e < 8; ++e) WCs[8 * jg + e] = fexp_(tot[e]); }
            float kkr[8], kf[8], ss = 0.f, bon = 0.f;
#pragma unroll
            for (int e = 0; e < 8; ++e) { kkr[e] = k[e] * F.in[I_KK][ch0 + e]; ss += kkr[e] * kkr[e]; kf[e] = k[e] * (1.0f + (a[e] - 1.0f) * F.in[I_KA][ch0 + e]); bon += r[e] * kf[e] * F.in[I_RK][ch0 + e]; }
            ss += __shfl_xor(ss, 1); ss += __shfl_xor(ss, 2); ss += __shfl_xor(ss, 4);
            bon += __shfl_xor(bon, 1); bon += __shfl_xor(bon, 2); bon += __shfl_xor(bon, 4);
            if (jg == 0) BONUS[(tok0 + t) * NH + h] = bon;
            const float inv = 1.0f / fmaxf(sqrtf(ss), 1e-12f);
            float av[8], bv[8], kv[8], rv[8];
#pragma unroll
            for (int e = 0; e < 8; ++e) { const float kk = kkr[e] * inv, en = fexp_(-cum[e]);
                av[e] = -kk * fexp_(cum[e] - ld[e]); bv[e] = kk * a[e] * en; kv[e] = kf[e] * en; rv[e] = r[e] * fexp_(cum[e]); }
            u32x4 pa, pr, pb, pk;
#pragma unroll
            for (int q = 0; q < 4; ++q) { pa[q] = pack2(av[2 * q], av[2 * q + 1]); pr[q] = pack2(rv[2 * q], rv[2 * q + 1]); pb[q] = pack2(bv[2 * q], bv[2 * q + 1]); pk[q] = pack2(kv[2 * q], kv[2 * q + 1]); }
            *(LAS u32x4*)AT(0, t, 8 * jg) = pa; *(LAS u32x4*)AT(2, t, 8 * jg) = pr; *(LAS u32x4*)AT(3, t, 8 * jg) = pb; *(LAS u32x4*)AT(5, t, 8 * jg) = pk;
#pragma unroll
            for (int q = 0; q < 4; ++q) {
                *AT(1, 8 * jg + 2 * q, t) = (bf16_t)(pa[q] & 0xffffu); *AT(1, 8 * jg + 2 * q + 1, t) = (bf16_t)(pa[q] >> 16);
                *AT(4, 8 * jg + 2 * q, t) = (bf16_t)(pb[q] & 0xffffu); *AT(4, 8 * jg + 2 * q + 1, t) = (bf16_t)(pb[q] >> 16);
                *AT(6, 8 * jg + 2 * q, t) = (bf16_t)(pk[q] & 0xffffu); *AT(6, 8 * jg + 2 * q + 1, t) = (bf16_t)(pk[q] >> 16);
                *AT(7, 8 * jg + 2 * q, t) = (bf16_t)(vr[q] & 0xffffu); *AT(7, 8 * jg + 2 * q + 1, t) = (bf16_t)(vr[q] >> 16);
            }
        }
        __syncthreads();
#define LF2(dst, k, r0) do { dst[0] = *(const LAS bf16x8*)AT(k, (r0) + fr, fq * 8); dst[1] = *(const LAS bf16x8*)AT(k, (r0) + fr, 32 + fq * 8); } while (0)
#define MMA2(acc, xf, yf) do { acc = __builtin_amdgcn_mfma_f32_16x16x32_bf16(xf[0], yf[0], acc, 0, 0, 0); acc = __builtin_amdgcn_mfma_f32_16x16x32_bf16(xf[1], yf[1], acc, 0, 0, 0); } while (0)
        {
            bf16x8 xa[2], xr[2]; LF2(xa, 0, 16 * mt); LF2(xr, 2, 16 * mt);
#pragma unroll
            for (int q2 = 0; q2 < 2; ++q2) {
                const int nt = ntb + q2;
                bf16x8 yb[2], yk[2]; LF2(yb, 3, 16 * nt); LF2(yk, 5, 16 * nt);
                { f32x4 acc = {0.f, 0.f, 0.f, 0.f}; MMA2(acc, xa, yb);
                  const int sidx = 16 * nt + fr, t0 = 16 * mt + 4 * fq;
#pragma unroll
                  for (int e = 0; e < 4; ++e) { if (!(sidx < t0 + e)) acc[e] = 0.f; *AT(8, t0 + e, sidx) = f2bf(acc[e]); }
                  st4_lds(AT(9, sidx, t0), acc); }
                const int tt = 16 * mt + fr, s0 = 16 * nt + 4 * fq;
                { f32x4 acc = {0.f, 0.f, 0.f, 0.f}; MMA2(acc, yk, xa);
#pragma unroll
                  for (int e = 0; e < 4; ++e) if (!(s0 + e < tt)) acc[e] = 0.f;
                  st4_lds(AT(10, tt, s0), acc); }
                { f32x4 acc = {0.f, 0.f, 0.f, 0.f}; MMA2(acc, yb, xr);
#pragma unroll
                  for (int e = 0; e < 4; ++e) if (!(s0 + e <= tt)) acc[e] = 0.f;
                  st4_lds(AT(11, tt, s0), acc); }
                { f32x4 acc = {0.f, 0.f, 0.f, 0.f}; MMA2(acc, yk, xr);
#pragma unroll
                  for (int e = 0; e < 4; ++e) if (!(s0 + e <= tt)) acc[e] = 0.f;
                  st4_lds(AT(12, tt, s0), acc); }
            }
        }
        __syncthreads();
#define WKV_SQ(xi, ti, xo, to) do { bf16x8 xl[2]; LF2(xl, xi, 16 * mt); _Pragma("unroll") for (int q2 = 0; q2 < 2; ++q2) { const int nt = ntb + q2; bf16x8 yl[2]; LF2(yl, ti, 16 * nt); \
            f32x4 acc = {0.f, 0.f, 0.f, 0.f}; MMA2(acc, xl, yl); const int n_ = 16 * nt + fr, m0_ = 16 * mt + 4 * fq; \
            _Pragma("unroll") for (int e = 0; e < 4; ++e) *AT(xo, m0_ + e, n_) = f2bf(acc[e]); st4_lds(AT(to, n_, m0_), acc); } } while (0)
#define WKV_PM(pi, ti, po) do { bf16x8 xp[2]; LF2(xp, pi, 16 * mt); _Pragma("unroll") for (int q2 = 0; q2 < 2; ++q2) { const int nt = ntb + q2; bf16x8 yl[2]; LF2(yl, ti, 16 * nt); \
            const int m_ = 16 * mt + fr, n0_ = 16 * nt + 4 * fq; f32x4 acc = ld4_lds(AT(pi, m_, n0_)); MMA2(acc, yl, xp); st4_lds(AT(po, m_, n0_), acc); } } while (0)
#define WKV_PMSQ(pi, xi, ti, po, xo, to) do { bf16x8 xp[2], xl[2]; LF2(xp, pi, 16 * mt); LF2(xl, xi, 16 * mt); _Pragma("unroll") for (int q2 = 0; q2 < 2; ++q2) { const int nt = ntb + q2; bf16x8 yl[2]; LF2(yl, ti, 16 * nt); \
            { const int m_ = 16 * mt + fr, n0_ = 16 * nt + 4 * fq; f32x4 acc = ld4_lds(AT(pi, m_, n0_)); MMA2(acc, yl, xp); st4_lds(AT(po, m_, n0_), acc); } \
            { f32x4 acc = {0.f, 0.f, 0.f, 0.f}; MMA2(acc, xl, yl); const int n_ = 16 * nt + fr, m0_ = 16 * mt + 4 * fq; \
              _Pragma("unroll") for (int e = 0; e < 4; ++e) *AT(xo, m0_ + e, n_) = f2bf(acc[e]); st4_lds(AT(to, n_, m0_), acc); } } } while (0)
        WKV_SQ(8, 9, 0, 3);
        for (int idx = F.tid; idx < 64 * 16; idx += NTHREADS) { const int t = idx >> 4, s4 = (idx & 15) * 4; u32x2 v = *(const LAS u32x2*)AT(8, t, s4);
            if ((t >> 2) == (s4 >> 2)) { const unsigned one = 0x3F80u; const int e = t & 3; if (e == 0) v.x = (v.x & 0xffff0000u) | one; else if (e == 1) v.x = (v.x & 0xffffu) | (one << 16); else if (e == 2) v.y = (v.y & 0xffff0000u) | one; else v.y = (v.y & 0xffffu) | (one << 16); }
            *(LAS u32x2*)AT(13, t, s4) = v; }
        __syncthreads();
        WKV_PMSQ(13, 0, 3, 14, 8, 9); __syncthreads();
        WKV_PMSQ(14, 8, 9, 13, 0, 3); __syncthreads();
        WKV_PMSQ(13, 0, 3, 14, 8, 9); __syncthreads();
        WKV_PMSQ(14, 8, 9, 13, 0, 3); __syncthreads();
        WKV_PM(13, 3, 14); __syncthreads();
        {
            bf16x8 xt[2], xm[2]; LF2(xt, 14, 16 * mt); LF2(xm, 10, 16 * mt);
#pragma unroll
            for (int q2 = 0; q2 < 2; ++q2) {
                const int nt = ntb + q2, n_ = 16 * nt + fr, m0_ = 16 * mt + 4 * fq;
                bf16x8 ya[2], yv[2]; LF2(ya, 1, 16 * nt); LF2(yv, 7, 16 * nt);
                { f32x4 acc = {0.f, 0.f, 0.f, 0.f}; MMA2(acc, xt, ya); st4_lds(AT(9, n_, m0_), acc); }
                { f32x4 acc = {0.f, 0.f, 0.f, 0.f}; MMA2(acc, xm, yv); st4_lds(AT(8, n_, m0_), acc); }
            }
        }
        __syncthreads();
        {
            bf16x8 xt[2], xb[2]; LF2(xt, 14, 16 * mt); LF2(xb, 11, 16 * mt);
#pragma unroll
            for (int q2 = 0; q2 < 2; ++q2) {
                const int nt = ntb + q2;
                bf16x8 yz[2], yp[2]; LF2(yz, 8, 16 * nt); LF2(yp, 9, 16 * nt);
                { const int n_ = 16 * nt + fr, m0_ = 16 * mt + 4 * fq; f32x4 acc = {0.f, 0.f, 0.f, 0.f}; MMA2(acc, xt, yz); st4_lds(AT(0, n_, m0_), acc); }
                { const int m_ = 16 * mt + fr, n0_ = 16 * nt + 4 * fq; f32x4 acc = ld4_lds(AT(2, m_, n0_)); MMA2(acc, yp, xb);
                  st_bf4(RP + (size_t)cid * 4096 + (unsigned)((mt * 2 + (nt >> 1)) * 512 + (fr * 4 + 2 * (nt & 1) + (fq >> 1)) * 8 + 4 * (fq & 1)), acc); }
            }
        }
        __syncthreads();
        {
            bf16x8 xb[2], xk[2], xp[2], xu[2], xv[2]; LF2(xb, 11, 16 * mt); LF2(xk, 12, 16 * mt); LF2(xp, 9, 16 * mt); LF2(xu, 0, 16 * mt); LF2(xv, 7, 16 * mt);
#pragma unroll
            for (int q2 = 0; q2 < 2; ++q2) {
                const int nt = ntb + q2;
                bf16x8 yu[2], yv[2], yb[2], yk[2]; LF2(yu, 0, 16 * nt); LF2(yv, 7, 16 * nt); LF2(yb, 4, 16 * nt); LF2(yk, 6, 16 * nt);
                { f32x4 acc = {0.f, 0.f, 0.f, 0.f}; MMA2(acc, yu, xb); MMA2(acc, yv, xk);
                  st_bf4(OL + (size_t)cid * 4096 + (unsigned)((16 * mt + fr) * 64 + 16 * nt + 4 * fq), acc); }
                { const int jp = 16 * nt + fr, j0 = 16 * mt + 4 * fq; f32x4 acc = {0.f, 0.f, 0.f, 0.f}; MMA2(acc, xp, yb);
                  const float wc = WCs[jp];
#pragma unroll
                  for (int e = 0; e < 4; ++e) acc[e] = (acc[e] + ((j0 + e == jp) ? 1.0f : 0.0f)) * wc;
                  st_bf4(G2 + (size_t)cid * 4096 + (unsigned)((nt * 2 + (mt >> 1)) * 512 + lane * 8 + (mt & 1) * 4), acc); }
                { const int i_ = 16 * mt + fr, jp0 = 16 * nt + 4 * fq; f32x4 acc = {0.f, 0.f, 0.f, 0.f}; MMA2(acc, yb, xu); MMA2(acc, yk, xv);
#pragma unroll
                  for (int e = 0; e < 4; ++e) acc[e] *= WCs[jp0 + e];
                  st_bf4(DM + (size_t)cid * 4096 + (unsigned)(i_ * 64 + jp0), acc); }
            }
        }
        __syncthreads();
    }
#undef LF2
#undef MMA2
#undef WKV_PMSQ
#undef WKV_SQ
#undef WKV_PM
#undef AT
#undef SL
}

__device__ __forceinline__ void ph_wkv_carry(const Frame& F) {
    const bf16_t* G2 = (const bf16_t*)(F.ws + WS_G2); const bf16_t* DM = (const bf16_t*)(F.ws + WS_DM); bf16_t* ST = (bf16_t*)(F.ws + WS_ST);
    const int lane = F.lane, fr = lane & 15, fq = lane >> 4;
    const bool loader = F.wave >= 4; const int lw = F.wave - 4, i = 16 * (F.wave & 3) + fr;
    constexpr int NC = SEQ / 64;
    for (int ch = F.bid; ch < NB * NH; ch += F.G) {
        const size_t cbase = (size_t)ch * NC;
#define CARRY_ISSUE(c_) do { const int cc_ = (c_) < NC ? (c_) : NC - 1; const size_t cid_ = cbase + cc_; \
        _Pragma("unroll") for (int q_ = 0; q_ < 4; ++q_) { const int j_ = lw * 4 + q_; \
            const bf16_t* src_ = (j_ < 8 ? G2 + cid_ * 4096 + j_ * 512 : DM + cid_ * 4096 + (j_ - 8) * 512) + lane * 8; \
            __builtin_amdgcn_global_load_lds((const unsigned*)src_, (LAS unsigned*)(F.lds + ((c_) & 7) * 16384 + j_ * 1024), 16, 0, 0); } } while (0)
        f32x4 st[4];
#pragma unroll
        for (int r = 0; r < 4; ++r) st[r] = (f32x4){0.f, 0.f, 0.f, 0.f};
        bf16x8 gc[8]; u32x2 dc[4];
#define CARRY_RING_READ(c_) do { const LAS unsigned char* slot_ = F.lds + ((c_) & 7) * 16384; \
        _Pragma("unroll") for (int f = 0; f < 8; ++f) gc[f] = *(const LAS bf16x8*)(slot_ + f * 1024 + lane * 16); \
        _Pragma("unroll") for (int r = 0; r < 4; ++r) dc[r] = *(const LAS u32x2*)(slot_ + 8192 + (i * 64 + 16 * r + 4 * fq) * 2); } while (0)
        if (loader) {
#pragma unroll
            for (int c = 0; c < 7; ++c) CARRY_ISSUE(c);
            WAIT_V(20);
        }
        SBAR();
        if (!loader) CARRY_RING_READ(0);
#pragma unroll 1
        for (int c = 0; c < NC; ++c) {
            if (loader) {
                CARRY_ISSUE(c + 7);
                WAIT_V(20);
            } else {
                const size_t cid = cbase + c;
                union { bf16x8 v; unsigned u[4]; } b0, b1;
                b0.u[0] = pack2(st[0][0], st[0][1]); b0.u[1] = pack2(st[0][2], st[0][3]); b0.u[2] = pack2(st[1][0], st[1][1]); b0.u[3] = pack2(st[1][2], st[1][3]);
                b1.u[0] = pack2(st[2][0], st[2][1]); b1.u[1] = pack2(st[2][2], st[2][3]); b1.u[2] = pack2(st[3][0], st[3][1]); b1.u[3] = pack2(st[3][2], st[3][3]);
                f32x4 acc[4];
#pragma unroll
                for (int r = 0; r < 4; ++r) { acc[r] = (f32x4){lo2f(dc[r].x), hi2f(dc[r].x), lo2f(dc[r].y), hi2f(dc[r].y)};
                    acc[r] = __builtin_amdgcn_mfma_f32_16x16x32_bf16(gc[r * 2 + 0], b0.v, acc[r], 0, 0, 0); }
#pragma unroll
                for (int r = 0; r < 4; ++r) acc[r] = __builtin_amdgcn_mfma_f32_16x16x32_bf16(gc[r * 2 + 1], b1.v, acc[r], 0, 0, 0);
                { const unsigned wsl = (unsigned)(F.wave & 3);
                  bf16_t* stp = ST + cid * 4096;
                  const unsigned ob = (unsigned)(((fr >> 2) * 2) * 512 + ((4 * wsl + (fr & 3)) * 4 + (fq >> 1)) * 8 + 4 * (fq & 1));
                  u32x2 w0; w0.x = b0.u[0]; w0.y = b0.u[1]; *(u32x2*)(stp + ob) = w0;
                  u32x2 w1; w1.x = b0.u[2]; w1.y = b0.u[3]; *(u32x2*)(stp + ob + 16) = w1;
                  u32x2 w2; w2.x = b1.u[0]; w2.y = b1.u[1]; *(u32x2*)(stp + ob + 512) = w2;
                  u32x2 w3; w3.x = b1.u[2]; w3.y = b1.u[3]; *(u32x2*)(stp + ob + 512 + 16) = w3; }
                if (c + 1 < NC) CARRY_RING_READ(c + 1);
#pragma unroll
                for (int r = 0; r < 4; ++r) st[r] = acc[r];
            }
            SBAR();
        }
        if (loader) WAIT_V(0);
        SBAR();
#undef CARRY_RING_READ
#undef CARRY_ISSUE
    }
}

__device__ __forceinline__ void ph_wkv_out(const Frame& F) {
    const bf16_t* RP = (const bf16_t*)(F.ws + WS_RP); const bf16_t* OL = (const bf16_t*)(F.ws + WS_OL); const bf16_t* ST = (const bf16_t*)(F.ws + WS_ST);
    const bf16_t* Vb = (const bf16_t*)(F.ws + WS_RKV) + (size_t)2 * T * D; const bf16_t* GG = (const bf16_t*)(F.ws + WS_GG); const float* BONUS = (const float*)(F.ws + WS_BONUS);
    bf16_t* OG = (bf16_t*)(F.ws + WS_OG);
    const int lane = F.lane, fr = lane & 15, fq = lane >> 4;
    const int nunits = NB * NH * (SEQ / 64) * 4;
    for (int u = F.bid * NWAVES + F.wave; u < nunits; u += F.G * NWAVES) {
        const int cid = u >> 2, tt = u & 3, bh = cid / (SEQ / 64), c = cid % (SEQ / 64), b = bh / NH, h = bh % NH;
        const int t = 16 * tt + fr; const size_t tok = (size_t)b * SEQ + (size_t)c * 64 + t;
        const size_t oh = ((size_t)bh * SEQ + (size_t)c * 64 + t) * 64 + 16 * fq;
        bf16x8 rf[2], sf[4][2];
#pragma unroll
        for (int ks = 0; ks < 2; ++ks) rf[ks] = *(const bf16x8*)(RP + (size_t)cid * 4096 + (tt * 2 + ks) * 512 + (fr * 4 + fq) * 8);
#pragma unroll
        for (int n = 0; n < 4; ++n)
#pragma unroll
            for (int ks = 0; ks < 2; ++ks) sf[n][ks] = *(const bf16x8*)(ST + (size_t)cid * 4096 + (n * 2 + ks) * 512 + (fr * 4 + fq) * 8);
        const u32x4 ol0 = *(const u32x4*)(OL + (size_t)cid * 4096 + t * 64 + 16 * fq), ol1 = *(const u32x4*)(OL + (size_t)cid * 4096 + t * 64 + 16 * fq + 8);
        const u32x4 v0 = *(const u32x4*)(Vb + oh), v1 = *(const u32x4*)(Vb + oh + 8), g0 = *(const u32x4*)(GG + oh), g1 = *(const u32x4*)(GG + oh + 8);
        const float bon = BONUS[tok * NH + h];
        f32x4 acc[4];
        acc[0] = (f32x4){lo2f(ol0[0]), hi2f(ol0[0]), lo2f(ol0[1]), hi2f(ol0[1])}; acc[1] = (f32x4){lo2f(ol0[2]), hi2f(ol0[2]), lo2f(ol0[3]), hi2f(ol0[3])};
        acc[2] = (f32x4){lo2f(ol1[0]), hi2f(ol1[0]), lo2f(ol1[1]), hi2f(ol1[1])}; acc[3] = (f32x4){lo2f(ol1[2]), hi2f(ol1[2]), lo2f(ol1[3]), hi2f(ol1[3])};
#pragma unroll
        for (int n = 0; n < 4; ++n)
#pragma unroll
            for (int ks = 0; ks < 2; ++ks) acc[n] = __builtin_amdgcn_mfma_f32_16x16x32_bf16(sf[n][ks], rf[ks], acc[n], 0, 0, 0);
        float s = 0.f;
#pragma unroll
        for (int n = 0; n < 4; ++n) s += (acc[n][0] + acc[n][1]) + (acc[n][2] + acc[n][3]);
        s += __shfl_xor(s, 16); s += __shfl_xor(s, 32);
        const float mean = s * (1.0f / 64.0f);
        float q = 0.f;
#pragma unroll
        for (int n = 0; n < 4; ++n)
#pragma unroll
            for (int e = 0; e < 4; ++e) { const float d = acc[n][e] - mean; q += d * d; }
        q += __shfl_xor(q, 16); q += __shfl_xor(q, 32);
        const float rstd = rsqrtf(q * (1.0f / 64.0f) + 64e-5f);
        const int chn = h * 64 + 16 * fq;
        u32x4 o0, o1;
#pragma unroll
        for (int n = 0; n < 4; ++n) {
            const f32x4 lg = *(const f32x4*)(F.in[I_LNG] + chn + 4 * n), lb = *(const f32x4*)(F.in[I_LNB] + chn + 4 * n);
            const unsigned vw0 = n < 2 ? v0[2 * n] : v1[2 * n - 4], vw1 = n < 2 ? v0[2 * n + 1] : v1[2 * n - 3], gw0 = n < 2 ? g0[2 * n] : g1[2 * n - 4], gw1 = n < 2 ? g0[2 * n + 1] : g1[2 * n - 3];
            const f32x4 vv = {lo2f(vw0), hi2f(vw0), lo2f(vw1), hi2f(vw1)}, gg = {lo2f(gw0), hi2f(gw0), lo2f(gw1), hi2f(gw1)};
            const f32x4 res = (((acc[n] - mean) * rstd) * lg + lb + vv * bon) * gg;
            const unsigned w0 = pack2(res[0], res[1]), w1 = pack2(res[2], res[3]);
            if (n == 0) { o0[0] = w0; o0[1] = w1; } else if (n == 1) { o0[2] = w0; o0[3] = w1; } else if (n == 2) { o1[0] = w0; o1[1] = w1; } else { o1[2] = w0; o1[3] = w1; }
        }
        *(u32x4*)(OG + tok * D + chn) = o0; *(u32x4*)(OG + tok * D + chn + 8) = o1;
    }
}

struct AttnTile { bf16x8 k[4][2]; bf16x8 v[4][2]; };
__device__ __forceinline__ void attn_load(AttnTile& tl, const bf16_t* kbase  , const bf16_t* vbase  ) {
#pragma unroll
    for (int kt = 0; kt < 4; ++kt)
#pragma unroll
        for (int ks = 0; ks < 2; ++ks) tl.k[kt][ks] = *(const bf16x8*)(kbase + (kt * 2 + ks) * 512);
#pragma unroll
    for (int dt = 0; dt < 4; ++dt)
#pragma unroll
        for (int ks = 0; ks < 2; ++ks) tl.v[dt][ks] = *(const bf16x8*)(vbase + (dt * 2 + ks) * 512);
}
template <bool MASK>
__device__ __forceinline__ void attn_tile(const AttnTile& tl, const bf16x8 (&qf)[2], f32x4 (&o)[4], float& R, int key0, int qpos, int fq) {
    constexpr float C2 = 0.125f * 1.4426950408889634f;
    f32x4 z[4];
#pragma unroll
    for (int kt = 0; kt < 4; ++kt) { z[kt] = (f32x4){0.f, 0.f, 0.f, 0.f};
#pragma unroll
        for (int ks = 0; ks < 2; ++ks) z[kt] = __builtin_amdgcn_mfma_f32_16x16x32_bf16(tl.k[kt][ks], qf[ks], z[kt], 0, 0, 0); }
    float sp[4][4], G[4];
#pragma unroll
    for (int kt = 0; kt < 4; ++kt) { G[kt] = 0.f;
#pragma unroll
        for (int e = 0; e < 4; ++e) { const float z2 = z[kt][e] * C2; z[kt][e] = z2;
            const float l2 = __builtin_amdgcn_logf(1.0f + __builtin_amdgcn_exp2f(z2));
            float spv = z2 > 30.f ? z2 : l2;
            if (MASK) spv = ((key0 + 16 * kt + 4 * fq + e) < qpos) ? spv : 0.f;
            sp[kt][e] = spv; G[kt] += spv; } }
    float sufg[4], tot[4];
#pragma unroll
    for (int kt = 0; kt < 4; ++kt) {
        const float g1 = __shfl_xor(G[kt], 16), g2 = __shfl_xor(G[kt], 32), g3 = __shfl_xor(G[kt], 48);
        tot[kt] = G[kt] + g1 + g2 + g3;
        sufg[kt] = (((fq ^ 1) > fq) ? g1 : 0.f) + (((fq ^ 2) > fq) ? g2 : 0.f) + (((fq ^ 3) > fq) ? g3 : 0.f);
    }
    float later = 0.f;
    union { bf16x8 v; unsigned w[4]; } p0, p1;
#pragma unroll
    for (int kt = 3; kt >= 0; --kt) {
        float run = R + later + sufg[kt];
        float wv[4];
#pragma unroll
        for (int e = 3; e >= 0; --e) { float w = __builtin_amdgcn_exp2f(z[kt][e] - sp[kt][e] - run);
            if (MASK) w = ((key0 + 16 * kt + 4 * fq + e) < qpos) ? w : 0.f;
            wv[e] = w; run += sp[kt][e]; }
        const unsigned w01 = pgx::cvt_pk_bf16(wv[0], wv[1]), w23 = pgx::cvt_pk_bf16(wv[2], wv[3]);
        if (kt == 0) { p0.w[0] = w01; p0.w[1] = w23; } else if (kt == 1) { p0.w[2] = w01; p0.w[3] = w23; } else if (kt == 2) { p1.w[0] = w01; p1.w[1] = w23; } else { p1.w[2] = w01; p1.w[3] = w23; }
        later += tot[kt];
    }
    R += later;
#pragma unroll
    for (int dt = 0; dt < 4; ++dt) {
        o[dt] = __builtin_amdgcn_mfma_f32_16x16x32_bf16(tl.v[dt][0], p0.v, o[dt], 0, 0, 0);
        o[dt] = __builtin_amdgcn_mfma_f32_16x16x32_bf16(tl.v[dt][1], p1.v, o[dt], 0, 0, 0);
    }
}
__device__ __forceinline__ void ph_attn(const Frame& F) {
    const bf16_t* Q = (const bf16_t*)(F.ws + WS_Q); const bf16_t* Kb = Q + (size_t)T * D; const bf16_t* VT = Q + (size_t)2 * T * D;
    bf16_t* AO = (bf16_t*)(F.ws + WS_AO);
    const int lane = F.lane, fr = lane & 15, fq = lane >> 4;
    const int nunits = NB * NH * (SEQ / 16);
    constexpr float EXIT2 = SB_EXIT * 1.4426950408889634f;
    unsigned* aq = F.ctl + CW_AQ;
    LAS unsigned* chunk_s = (LAS unsigned*)(F.lds + 1024);
    const unsigned myx = xb_xcc_id() & 7u;
    for (int qi = 0; qi < 8; ++qi) {
      const unsigned xq = (myx + (unsigned)qi) & 7u;
      for (;;) {
        __syncthreads();
        if (F.tid == 0) *chunk_s = atomicAdd(&aq[xq * 64], 1u);
        __syncthreads();
        const unsigned ck = *chunk_s;
        if (ck >= 256u) break;
        const int bh = (int)xq + 8 * (int)(ck >> 6), qt = (int)(ck & 63u) * 8 + F.wave;
        const int b = bh / NH, h = bh % NH;
        const int q0 = qt * 16, qpos = q0 + fr;
        const size_t tb = (size_t)b * SEQ;
        bf16x8 qf[2];
#pragma unroll
        for (int ks = 0; ks < 2; ++ks) qf[ks] = *(const bf16x8*)(Q + (tb + qpos) * D + h * 64 + ks * 32 + fq * 8);
        f32x4 o[4];
#pragma unroll
        for (int dt = 0; dt < 4; ++dt) o[dt] = (f32x4){0.f, 0.f, 0.f, 0.f};
        float R = 0.f;
        const bf16_t* kb = Kb + (size_t)bh * SEQ * 64 + (fr * 4 + fq) * 8;
        const bf16_t* vb = VT + (size_t)bh * SEQ * 64 + (fr * 4 + fq) * 8;
        int kt0 = (q0 + 15) / 64;
        AttnTile ta, tc;
        attn_load(ta, kb + (size_t)kt0 * 4096, vb + (size_t)kt0 * 4096);
        if (kt0 > 0) attn_load(tc, kb + (size_t)(kt0 - 1) * 4096, vb + (size_t)(kt0 - 1) * 4096);
        attn_tile<true>(ta, qf, o, R, kt0 * 64, qpos, fq);
        --kt0;
        while (kt0 >= 0 && !__all(R > EXIT2)) {
            if (kt0 > 0) attn_load(ta, kb + (size_t)(kt0 - 1) * 4096, vb + (size_t)(kt0 - 1) * 4096);
            attn_tile<false>(tc, qf, o, R, kt0 * 64, qpos, fq);
            --kt0;
            if (kt0 < 0 || __all(R > EXIT2)) break;
            if (kt0 > 0) attn_load(tc, kb + (size_t)(kt0 - 1) * 4096, vb + (size_t)(kt0 - 1) * 4096);
            attn_tile<false>(ta, qf, o, R, kt0 * 64, qpos, fq);
            --kt0;
        }
#pragma unroll
        for (int dt = 0; dt < 4; ++dt) st_bf4(AO + (tb + qpos) * D + h * 64 + 16 * dt + 4 * fq, o[dt]);
      }
    }
}

#ifndef USE_PGX
#define USE_PGX 0x1f
#endif
__device__ __forceinline__ int px_unit_index(int i, int G, int c, int nwg) {
    const long L = (long)i * G + c; if (L >= nwg) return -1;
    const int w = (int)L, q = nwg / 8, r = nwg % 8, xcd = w % 8, off = w / 8;
    return (xcd < r ? xcd * (q + 1) : r * (q + 1) + (xcd - r) * q) + off;
}
struct PxDense {
    const char* A; const char* B; int nM, nN, K, G, c; unsigned lda; int a_div; size_t a_stride;
    __device__ __forceinline__ bool next(int i, pgx::Unit& u) const {
        const int w = px_unit_index(i, G, c, nM * nN); if (w < 0) return false;
        const int pm = w / nN, pn = w % nN;
        u.A = A + (size_t)(pn / a_div) * a_stride + (size_t)pm * 256 * lda; u.tok = nullptr; u.B = B + (size_t)pn * 256 * K * 2; u.r0 = pm * 256; u.c0 = pn * 256; u.aux = 0; return true;
    }
};
__device__ __forceinline__ void px_store_bf16_perm(bf16_t* rowp, const f32x4& v0, const f32x4& v1) {
    u32x4 w; w.x = pgx::cvt_pk_bf16(v0[0], v0[1]); w.y = pgx::cvt_pk_bf16(v0[2], v0[3]); w.z = pgx::cvt_pk_bf16(v1[0], v1[1]); w.w = pgx::cvt_pk_bf16(v1[2], v1[3]); *(u32x4*)rowp = w;
}
__device__ __forceinline__ void ph_rkv_px(const Frame& F) {
    bf16_t* RKV = (bf16_t*)(F.ws + WS_RKV);
    PxDense S{(const char*)(F.ws + WS_XS), (const char*)(F.ws + WS_WRKV), 64, 12, D, F.G, F.bid, (unsigned)(D * 2), 4, (size_t)T * D * 2};
    pgx::gemm_phase<true, true>(F.lds, D, D * 2, S, [&](const f32x4 (&acc)[2][2][4][2], const pgx::Unit& u, int wr, int wc, int fr, int fq) {
        bf16_t* base = RKV + (size_t)(u.c0 / D) * T * D;
#pragma unroll
        for (int ai = 0; ai < 2; ++ai)
#pragma unroll
            for (int m = 0; m < 4; ++m) { const int t = u.r0 + ai * 128 + wr * 64 + m * 16 + fr;
#pragma unroll
                for (int bj = 0; bj < 2; ++bj) px_store_bf16_perm(base + hm_off(t, (u.c0 % D) + bj * 128 + wc * 32 + 8 * fq), acc[ai][bj][m][0], acc[ai][bj][m][1]); }
    });
}
__device__ __forceinline__ void ph_lora_dn_sg(const Frame& F) {
    const bf16_t* XS = (const bf16_t*)(F.ws + WS_XS); const bf16_t* WLDN = (const bf16_t*)(F.ws + WS_WLDN); bf16_t* LORA = (bf16_t*)(F.ws + WS_LORA);
    for (int u = F.bid; u < 64 * 4; u += F.G) {
        const int mt = u / 4, j = u % 4, n = (j == 0) ? 3 : (j == 1 ? 4 : 5);
        ASeg A; A.p[0] = XS + ((size_t)n * T + mt * 256) * D; A.p[1] = A.p[0]; A.p[2] = A.p[0]; A.segTiles = 16;
        bf16_t* out = LORA + (size_t)mt * 256 * 256 + j * 64;
        sg_tile<64>(F.lds, A, [](int R) { return (unsigned)R * (D * 2); }, WLDN + (size_t)(j * 64) * D, D, 16,
            [&](auto& acc, int r0, int c0, int fr, int fq) {
#pragma unroll
                for (int m = 0; m < EPI_MT(acc); ++m)
#pragma unroll
                    for (int q = 0; q < 4; ++q) { f32x4 v = acc[m][q];
                        if (j == 0) {
#pragma unroll
                            for (int e = 0; e < 4; ++e) v[e] = tanhf_(v[e]); }
                        else if (j >= 2) {
#pragma unroll
                            for (int e = 0; e < 4; ++e) v[e] = sigmoidf_(v[e]); }
                        st_bf4(out + (size_t)(r0 + 16 * m + fr) * 256 + c0 + 16 * q + 4 * fq, v); }
            });
    }
}
__device__ __forceinline__ void ph_dense_bf16_px(const Frame& F, const bf16_t* Ain, const bf16_t* Wt, bf16_t* out) {
    PxDense S{(const char*)Ain, (const char*)Wt, 64, 4, D, F.G, F.bid, (unsigned)(D * 2), 4, 0};
    pgx::gemm_phase<true, true>(F.lds, D, D * 2, S, [&](const f32x4 (&acc)[2][2][4][2], const pgx::Unit& u, int wr, int wc, int fr, int fq) {
        bf16_t* base = out + u.c0 + wc * 32 + 8 * fq;
#pragma unroll
        for (int ai = 0; ai < 2; ++ai)
#pragma unroll
            for (int m = 0; m < 4; ++m) { bf16_t* rowp = base + (size_t)(u.r0 + ai * 128 + wr * 64 + m * 16 + fr) * D;
#pragma unroll
                for (int bj = 0; bj < 2; ++bj) px_store_bf16_perm(rowp + bj * 128, acc[ai][bj][m][0], acc[ai][bj][m][1]); }
    });
}
__device__ __forceinline__ void ph_qkv_px(const Frame& F) {
    bf16_t* QK = (bf16_t*)(F.ws + WS_Q); bf16_t* VT = QK + (size_t)2 * T * D;
    { PxDense S{(const char*)(F.ws + WS_H3), (const char*)(F.ws + WS_WQKV), 64, 8, D, F.G, F.bid, (unsigned)(D * 2), 8, 0};
      pgx::gemm_phase<true, true>(F.lds, D, D * 2, S, [&](const f32x4 (&acc)[2][2][4][2], const pgx::Unit& u, int wr, int wc, int fr, int fq) {
        const bool isk = u.c0 >= D;
#pragma unroll
        for (int ai = 0; ai < 2; ++ai)
#pragma unroll
            for (int m = 0; m < 4; ++m) { const int t = u.r0 + ai * 128 + wr * 64 + m * 16 + fr;
#pragma unroll
                for (int bj = 0; bj < 2; ++bj) { const int c = (u.c0 % D) + bj * 128 + wc * 32 + 8 * fq;
                    const int sq = t % SEQ, dd = c & 63;
                    bf16_t* dst = isk ? QK + (size_t)T * D + (((size_t)((t / SEQ) * NH + (c >> 6)) * (SEQ / 16) + (sq >> 4)) * 2 + (dd >> 5)) * 512 + (sq & 15) * 32 + (dd & 31) : QK + (size_t)t * D + c;
                    px_store_bf16_perm(dst, acc[ai][bj][m][0], acc[ai][bj][m][1]); } }
      }); }
    { PxDense S{(const char*)(F.ws + WS_H3), (const char*)(F.ws + WS_WQKV) + (size_t)2 * D * D * 2, 64, 4, D, F.G, F.bid, (unsigned)(D * 2), 4, 0};
      pgx::gemm_phase<false, false>(F.lds, D, D * 2, S, [&](const f32x4 (&acc)[2][2][4][2], const pgx::Unit& u, int wr, int wc, int fr, int fq) {
#pragma unroll
        for (int ai = 0; ai < 2; ++ai)
#pragma unroll
            for (int m = 0; m < 4; ++m) { const int t = u.r0 + ai * 128 + wr * 64 + m * 16 + 4 * fq, b = t / SEQ, sidx = t % SEQ;
#pragma unroll
                for (int bj = 0; bj < 2; ++bj)
#pragma unroll
                    for (int n = 0; n < 2; ++n) { const int c = u.c0 + bj * 128 + wc * 32 + n * 16 + fr, h = c >> 6, d = c & 63;
                        const int k6 = sidx & 63, kk = k6 & 31;
                        st_bf4(VT + ((size_t)(b * NH + h) * (SEQ / 64) + (sidx >> 6)) * 4096 + ((d >> 4) * 2 + (k6 >> 5)) * 512 + ((d & 15) * 4 + ((kk & 15) >> 2)) * 8 + (kk >> 4) * 4, acc[ai][bj][m][n]); } }
      }); }
}
struct PxMoe {
    const char* Asrc; const int* TOK; const int* TILEE; const char* W; int routed, nmt, nN, K, G, c; unsigned lda; size_t wexp; bool gather;
    __device__ __forceinline__ bool next(int i, pgx::Unit& u) const {
        const int w = px_unit_index(i, G, c, nmt * nN); if (w < 0) return false;
        const int mt = w / nN, pn = w % nN, row0 = mt * 256; const bool sh = row0 >= routed; const int e = sh ? 64 : TILEE[mt];
        if (gather) { if (sh) { u.A = Asrc + (size_t)(row0 - routed) * lda; u.tok = nullptr; } else { u.A = Asrc; u.tok = TOK + row0; } }
        else { u.A = Asrc + (size_t)row0 * lda; u.tok = nullptr; }
        u.B = W + (size_t)e * wexp + (size_t)pn * 256 * K * 2; u.r0 = row0; u.c0 = pn * 256; u.aux = 0; return true;
    }
};
__device__ __forceinline__ void ph_gateup_px(const Frame& F) {
    bf16_t* HB = (bf16_t*)(F.ws + WS_HB); const int* START = (const int*)(F.ws + WS_START);
    const int routed = START[65], nmt = (routed + T) / 256;
    PxMoe S{(const char*)(F.ws + WS_H2), (const int*)(F.ws + WS_TOK), (const int*)(F.ws + WS_TILEE), (const char*)(F.ws + WS_WGU), routed, nmt, 2, D, F.G, F.bid, (unsigned)(D * 2), (size_t)512 * D * 2, true};
    pgx::gemm_phase<true, true>(F.lds, D, D * 2, S, [&](const f32x4 (&acc)[2][2][4][2], const pgx::Unit& u, int wr, int wc, int fr, int fq) {
        bf16_t* base = HB + (u.c0 >> 1) + wc * 32 + 8 * fq;
#pragma unroll
        for (int ai = 0; ai < 2; ++ai)
#pragma unroll
            for (int m = 0; m < 4; ++m) { f32x4 v[2];
#pragma unroll
                for (int n = 0; n < 2; ++n)
#pragma unroll
                    for (int e = 0; e < 4; ++e) { const float g = acc[ai][0][m][n][e]; v[n][e] = g * sigmoidf_(g) * acc[ai][1][m][n][e]; }
                px_store_bf16_perm(base + (size_t)(u.r0 + ai * 128 + wr * 64 + m * 16 + fr) * DE, v[0], v[1]); }
    });
}
__device__ __forceinline__ void ph_down_px(const Frame& F) {
    bf16_t* YB = (bf16_t*)(F.ws + WS_YB); const int* START = (const int*)(F.ws + WS_START);
    const int routed = START[65], nmt = (routed + T) / 256;
    PxMoe S{(const char*)(F.ws + WS_HB), nullptr, (const int*)(F.ws + WS_TILEE), (const char*)(F.ws + WS_WDN), routed, nmt, 4, DE, F.G, F.bid, (unsigned)(DE * 2), (size_t)D * DE * 2, false};
    pgx::gemm_phase<true, true>(F.lds, DE, DE * 2, S, [&](const f32x4 (&acc)[2][2][4][2], const pgx::Unit& u, int wr, int wc, int fr, int fq) {
        unsigned char* base = (unsigned char*)YB + u.c0 + wc * 32 + 8 * fq;
#pragma unroll
        for (int ai = 0; ai < 2; ++ai)
#pragma unroll
            for (int m = 0; m < 4; ++m) { unsigned char* rowp = base + (size_t)(u.r0 + ai * 128 + wr * 64 + m * 16 + fr) * D;
#pragma unroll
                for (int bj = 0; bj < 2; ++bj) { u32x2 w;
                    w.x = pack_fp8x4(acc[ai][bj][m][0]); w.y = pack_fp8x4(acc[ai][bj][m][1]);
                    *(u32x2*)(rowp + bj * 128) = w; }
                asm volatile("" ::: "memory"); }
    });
}

__global__ void __launch_bounds__(NTHREADS, 2) mega(Args args) {
    extern __shared__ __attribute__((aligned(16))) unsigned char lds[];
    Frame F;
    F.in = args.in; F.out = args.out; F.ws = args.ws; F.ctl = (unsigned*)(args.ws + WS_CTL);
    F.ldsf = (float*)lds; F.lds = (LAS unsigned char*)lds;
    F.tid = threadIdx.x; F.lane = F.tid & 63; F.wave = __builtin_amdgcn_readfirstlane(F.tid >> 6); F.bid = blockIdx.x; F.G = gridDim.x;
    if (F.tid < 4) ((unsigned*)(lds + LDS_BYTES - 64))[F.tid] = 0u;
    __syncthreads();
    XcdBarrier bar; bar.bar = F.ctl + CW_BAR; bar.x = 0; bar.st = (volatile LAS unsigned*)(lds + LDS_BYTES - 64);
#if MK_N_LAUNCHES == 1
    bar = xcd_barrier_post(F.ctl + CW_BAR, (volatile LAS unsigned*)(lds + LDS_BYTES - 64));
#endif
    const int lo = args.ph_lo, hi = args.ph_hi;
#define IN(k) (lo <= (k) && (k) < hi)
#ifndef PROBE_MASK
#define PROBE_MASK 0u
#endif
    volatile unsigned long long* tsl = (volatile unsigned long long*)(lds + LDS_BYTES - 64 - 32 * 8);
#define STAMP(k) do { if (PROBE_MASK != 0u && F.tid == 0) tsl[(k)] = __builtin_amdgcn_s_memrealtime(); } while (0)
#define SEAM(k) do { if (IN(k) && IN((k) + 1)) xcd_barrier(bar); STAMP((k) + 1); } while (0)
    STAMP(0);
    bf16_t* const wsb = (bf16_t*)args.ws;
    (void)wsb;
#ifndef REP_A
#define REP_A 1
#endif
#ifndef REP_B
#define REP_B 1
#endif
#ifndef REP_C
#define REP_C 1
#endif
#ifndef REP_D
#define REP_D 1
#endif
#ifndef REP_E
#define REP_E 1
#endif
#ifndef REP_F
#define REP_F 1
#endif
#ifndef REP_G
#define REP_G 1
#endif
#ifndef REP_H
#define REP_H 1
#endif
#define RUN(n, body) for (int r_ = 0; r_ < (n); ++r_) { body; }
    if (IN(0)) { RUN(REP_D, ph_mod(F)) RUN(REP_G, conv_dense(F, F.bid, F.G)) if (F.G <= 2 * NB * NH) conv_moe(F, 0, F.bid, F.G); } SEAM(0);
    if (IN(1)) { RUN(REP_E, ph_prenorm_rwkv(F)) } SEAM(1);
    if (IN(2)) { RUN(REP_A, ph_rkv_px(F); ph_lora_dn_sg(F)) } SEAM(2);
    if (IN(3)) { RUN(REP_F, ph_lora_up_sg(F)) } SEAM(3);
    if (IN(4)) { RUN(REP_B, ph_wkv_chunk(F)) } SEAM(4);
    if (IN(5)) { if (F.bid < NB * NH || F.G <= 2 * NB * NH) { RUN(REP_B, ph_wkv_carry(F)) } else conv_moe(F, 0, F.bid - NB * NH, F.G - NB * NH); } SEAM(5);
    if (IN(6)) { RUN(REP_B, ph_wkv_out(F)) } SEAM(6);
    if (IN(7)) { RUN(REP_A, ph_dense_bf16_px(F, (const bf16_t*)(F.ws + WS_OG), (const bf16_t*)(F.ws + WS_WO), (bf16_t*)(F.ws + WS_Y1))) } SEAM(7);
    if (IN(8)) { RUN(REP_E, ph_postmix_preffn(F, 0, F.in[I_X], (const bf16_t*)(F.ws + WS_Y1))) } SEAM(8);
    if (IN(9)) { RUN(REP_F, ph_router_sg(F, 0)) } SEAM(9);
    if (IN(10)) { ph_topk(F, 0); } SEAM(10);
    if (IN(11)) { ph_offsets(F, 0); } SEAM(11);
    if (IN(12)) { RUN(REP_A, ph_gateup_px(F)) } SEAM(12);
    if (IN(13)) { RUN(REP_A, ph_down_px(F)) } SEAM(13);
    if (IN(14)) { RUN(1, ph_combine(F, 0, true)) RUN(REP_H, conv_moe(F, 1, F.bid, F.G)) } SEAM(14);
    if (IN(15)) { RUN(REP_A, ph_qkv_px(F)) } SEAM(15);
    if (IN(16)) { RUN(REP_C, ph_attn(F)) } SEAM(16);
    if (IN(17)) { RUN(REP_A, ph_dense_bf16_px(F, (const bf16_t*)(F.ws + WS_AO), (const bf16_t*)(F.ws + WS_WSBO), (bf16_t*)(F.ws + WS_Y1B))) } SEAM(17);
    if (IN(18)) { ph_postmix_preffn(F, 1, F.out, (const bf16_t*)(F.ws + WS_Y1B)); } SEAM(18);
    if (IN(19)) { RUN(REP_F, ph_router_sg(F, 1)) } SEAM(19);
    if (IN(20)) { ph_topk(F, 1); } SEAM(20);
    if (IN(21)) { ph_offsets(F, 1); } SEAM(21);
    if (IN(22)) { RUN(REP_A, ph_gateup_px(F)) } SEAM(22);
    if (IN(23)) { RUN(REP_A, ph_down_px(F)) } SEAM(23);
    if (IN(24)) { ph_combine(F, 1, false); }
    if (PROBE_MASK != 0u) {
        __syncthreads();
        if (F.bid == 0 && F.tid == 0) { const unsigned long long t1 = __builtin_amdgcn_s_memrealtime(); unsigned long long sel = 0;
            for (int k = 0; k < NPHASES; ++k) { const unsigned long long e = (k + 1 < NPHASES) ? tsl[k + 1] : t1; if ((PROBE_MASK >> k) & 1u) sel += e - tsl[k]; }
            F.out[0] += 1000.0f * (float)sel / (float)(t1 - tsl[0]); }
    }
#undef IN
#undef SEAM
}

extern "C" void kernel_launch(void* const* d_in, const int* in_sizes, int n_in, void* d_out, int out_size, void* d_ws, size_t ws_size, hipStream_t stream) {
    static int grid = 0;
    if (grid == 0) {
        if (n_in != 34 || in_sizes[0] != T * D || out_size != T * D || ws_size < WS_END) {
            fprintf(stderr, "kernel_launch: unexpected shapes: n_in %d in0 %d out %d ws %zu (need %zu)\n", n_in, n_in > 0 ? in_sizes[0] : -1, out_size, ws_size, (size_t)WS_END);
            grid = -1; return;
        }
        int dev = 0, cus = 0, per_cu = 0;
        if (hipGetDevice(&dev) != hipSuccess || hipDeviceGetAttribute(&cus, hipDeviceAttributeMultiprocessorCount, dev) != hipSuccess) { grid = -1; return; }
        if (hipFuncSetAttribute((const void*)mega, hipFuncAttributeMaxDynamicSharedMemorySize, LDS_BYTES) != hipSuccess) { fprintf(stderr, "kernel_launch: hipFuncSetAttribute failed\n"); grid = -1; return; }
        if (hipOccupancyMaxActiveBlocksPerMultiprocessor(&per_cu, (const void*)mega, NTHREADS, LDS_BYTES) != hipSuccess || per_cu < 1)
            fprintf(stderr, "kernel_launch: occupancy query reports %d blocks per CU\n", per_cu);
        (void)hipGetLastError();
        grid = cus;
    }
    if (grid < 0) return;
    if (hipMemsetAsync((char*)d_ws + WS_CTL, 0, CTL_BYTES, stream) != hipSuccess) { fprintf(stderr, "kernel_launch: memset failed\n"); return; }
    Args a{};
    for (int i = 0; i < 34; ++i) a.in[i] = (const float*)d_in[i];
    a.out = (float*)d_out; a.ws = (unsigned char*)d_ws;
#if MK_N_LAUNCHES == 1
    a.ph_lo = 0; a.ph_hi = NPHASES;
    hipLaunchKernelGGL(mega, dim3(grid), dim3(NTHREADS), LDS_BYTES, stream, a);
#else
    for (int p = 0; p < NPHASES; ++p) { a.ph_lo = p; a.ph_hi = p + 1; hipLaunchKernelGGL(mega, dim3(grid), dim3(NTHREADS), LDS_BYTES, stream, a); }
#endif
    const hipError_t le = hipPeekAtLastError();
    if (le != hipSuccess) fprintf(stderr, "kernel_launch: launch failed: %s\n", hipGetErrorName(le));
}
```

```cpp
#include <hip/hip_runtime.h>
#include <cstdio>
#include <cstdint>

#ifndef MK_N_LAUNCHES
#define MK_N_LAUNCHES 1
#endif

constexpr int T = 16384, D = 1024, SEQ = 8192, NB = 2, NH = 16, HD = 64;
constexpr int NE = 64, TOPK = 8, DE = 256;
constexpr int RP = 256;
constexpr int MAXROUTED = 147456;
constexpr int MAXROWS = MAXROUTED + T;
constexpr int NTHREADS = 512, NWAVES = 8;
constexpr int NPHASES = 25;
constexpr int LDS_BYTES = 144 * 1024;
constexpr float YB_SCALE = 16.0f;

typedef unsigned short bf16_t;
typedef float f32x4 __attribute__((ext_vector_type(4)));
typedef unsigned u32x4 __attribute__((ext_vector_type(4)));
typedef unsigned u32x2 __attribute__((ext_vector_type(2)));

__device__ __forceinline__ float bf2f(bf16_t b) { return __uint_as_float(((unsigned)b) << 16); }
typedef __bf16 bf16x2_t __attribute__((ext_vector_type(2)));
typedef float f32x2 __attribute__((ext_vector_type(2)));
__device__ __forceinline__ unsigned pack2(float a, float b) { const f32x2 v = {a, b}; const bf16x2_t r = __builtin_convertvector(v, bf16x2_t); return __builtin_bit_cast(unsigned, r); }
__device__ __forceinline__ bf16_t f2bf(float f) { return (bf16_t)(pack2(f, 0.f) & 0xffffu); }
__device__ __forceinline__ float lo2f(unsigned u) { return __uint_as_float(u << 16); }
__device__ __forceinline__ float hi2f(unsigned u) { return __uint_as_float(u & 0xffff0000u); }
__device__ __forceinline__ f32x4 ld4_g(const bf16_t* p) { const u32x2 w = *(const u32x2*)p; return (f32x4){lo2f(w.x), hi2f(w.x), lo2f(w.y), hi2f(w.y)}; }
__device__ __forceinline__ float fexp_(float x) { return __builtin_amdgcn_exp2f(x * 1.4426950408889634f); }
__device__ __forceinline__ float sigmoidf_(float x) { return __builtin_amdgcn_rcpf(1.0f + fexp_(-x)); }
__device__ __forceinline__ float tanhf_(float x) { return 1.0f - 2.0f * __builtin_amdgcn_rcpf(1.0f + fexp_(2.0f * x)); }
__device__ __forceinline__ float softplusf_(float x) { const float e = fexp_(x); const float l = __builtin_amdgcn_logf(1.0f + e) * 0.6931471805599453f; return x > 15.f ? x : (x < -8.f ? e : l); }
__device__ __forceinline__ float wave_sum(float v) {
#pragma unroll
    for (int o = 32; o >= 1; o >>= 1) v += __shfl_xor(v, o);
    return v;
}

constexpr size_t MiB = 1024 * 1024;
constexpr size_t WS_CTL    = 0;
constexpr size_t CTL_BYTES = 64 * 1024;
constexpr size_t WS_MOD    = 64 * 1024;
constexpr size_t WS_IDX    = 256 * 1024;
constexpr size_t WS_GATE   = WS_IDX + 512 * 1024;
constexpr size_t WS_RANK   = WS_GATE + 512 * 1024;
constexpr size_t WS_POS    = WS_RANK + 512 * 1024;
constexpr size_t WS_TOK    = WS_POS + 512 * 1024;
constexpr size_t WS_TILEE  = WS_TOK + 704 * 1024;
constexpr size_t WS_START  = WS_TILEE + 4096;
constexpr size_t WS_LOGITS = 8 * MiB + 64 * MiB;
constexpr size_t WS_BC     = 4 * MiB;
constexpr size_t WS_BIG    = 8 * MiB;
constexpr size_t WS_XS   = WS_BIG;
constexpr size_t WS_RKV  = WS_BIG + 192 * MiB;
constexpr size_t WS_LORA = WS_BIG + 288 * MiB;
constexpr size_t WS_LD   = WS_BIG;
constexpr size_t WS_AA   = WS_BIG + 64 * MiB;
constexpr size_t WS_GG   = WS_BIG + 96 * MiB;
constexpr size_t WS_O    = WS_BIG + 128 * MiB;
constexpr size_t WS_OG   = WS_BIG + 296 * MiB;
constexpr size_t WS_Y1   = WS_BIG + 328 * MiB;
constexpr size_t WS_H2   = WS_BIG;
constexpr size_t WS_H2LO = WS_BIG + 32 * MiB;
constexpr size_t WS_YB   = WS_BIG;
constexpr size_t WS_HB   = WS_BIG + 320 * MiB;
constexpr size_t WS_H3   = WS_BIG + 320 * MiB;
constexpr size_t WS_Q    = WS_BIG;
constexpr size_t WS_AO   = WS_BIG + 96 * MiB;
constexpr size_t WS_Y1B  = WS_BIG + 128 * MiB;
constexpr size_t WS_W     = WS_BIG + 400 * MiB;
constexpr size_t WS_WGU   = WS_W;
constexpr size_t WS_WDN   = WS_WGU + (size_t)65 * 512 * 1024 * 2;
constexpr size_t WS_WRKV  = WS_WDN + (size_t)65 * 1024 * 256 * 2;
constexpr size_t WS_WO    = WS_WRKV + (size_t)3072 * 1024 * 2;
constexpr size_t WS_WQKV  = WS_WO + (size_t)1024 * 1024 * 2;
constexpr size_t WS_WSBO  = WS_WQKV + (size_t)3072 * 1024 * 2;
constexpr size_t WS_WLDN  = WS_WSBO + (size_t)1024 * 1024 * 2;
constexpr size_t WS_WLUP  = WS_WLDN + (size_t)256 * 1024 * 2;
constexpr size_t WS_WRT   = WS_WLUP + (size_t)1024 * 256 * 2;
constexpr size_t WS_END   = WS_WRT + (size_t)2 * 64 * 3072 * 2;

constexpr int CW_BAR = 0;
constexpr int CW_CNT = 4096;
constexpr int CW_AQ = 4608;

#define XB_TMO      128
#define XB_XCNT(j)  (256  + 64 * (j))
#define XB_XSUB(j)  (1280 + 64 * (j))
#define XB_XGEN(j)  (2304 + 64 * (j))
#define XB_TOP      3328
#define XB_TOPGEN   3392
#define XCD_BAR_WORDS 3456
#define XB_SPIN_CAP (1u << 22)
#define LAS __attribute__((address_space(3)))

__device__ __forceinline__ unsigned xb_ld(unsigned* p)              { return __hip_atomic_load(p, __ATOMIC_RELAXED, __HIP_MEMORY_SCOPE_AGENT); }
__device__ __forceinline__ unsigned xb_add(unsigned* p, unsigned v) { return __hip_atomic_fetch_add(p, v, __ATOMIC_RELAXED, __HIP_MEMORY_SCOPE_AGENT); }
__device__ __forceinline__ unsigned xb_xcc_id() { return (unsigned)__builtin_amdgcn_s_getreg((3 << 11) | 20) & 0xFu; }
#define XB_SPIN(cond, bar) do { unsigned _sp = 0; while (cond) { __builtin_amdgcn_s_sleep(1); \
    if ((++_sp & 255u) == 0u) { if (xb_ld(&(bar)[XB_TMO])) break; if (_sp > XB_SPIN_CAP) { atomicAdd(&(bar)[XB_TMO], 1u); break; } } } } while (0)

struct XcdBarrier { unsigned* bar; unsigned x; volatile LAS unsigned* st; };

__device__ __forceinline__ XcdBarrier xcd_barrier_post(unsigned* bar, volatile LAS unsigned* st) {
    XcdBarrier b; b.bar = bar; b.x = xb_xcc_id(); b.st = st;
    if (threadIdx.x == 0) (void)xb_add(&bar[XB_XCNT(b.x)], 1u);
    return b;
}
__device__ __forceinline__ void xcd_barrier_complete(unsigned* bar, unsigned x, unsigned& nloc, unsigned& nx) {
    const unsigned G = gridDim.x * gridDim.y * gridDim.z;
    unsigned sum, cnt, mine, sp = 0u;
    for (;;) {
        sum = 0u; cnt = 0u; mine = 0u;
#pragma unroll
        for (unsigned j = 0; j < 16; ++j) { const unsigned c = xb_ld(&bar[XB_XCNT(j)]); sum += c; cnt += (c > 0u) ? 1u : 0u; mine = (j == x) ? c : mine; }
        if (sum == G) break;
        __builtin_amdgcn_s_sleep(1);
        if ((++sp & 255u) == 0u) { if (xb_ld(&bar[XB_TMO])) break; if (sp > XB_SPIN_CAP) { atomicAdd(&bar[XB_TMO], 1u); break; } }
    }
    nloc = mine > 0u ? mine : 1u; nx = cnt > 0u ? cnt : 1u;
}
__device__ __forceinline__ void xcd_barrier(const XcdBarrier& b) {
    asm volatile("s_waitcnt vmcnt(0)" ::: "memory");
    __syncthreads();
    if (threadIdx.x == 0) {
        unsigned* bar = b.bar;
        __builtin_amdgcn_s_waitcnt(0);
        unsigned nloc = b.st[0], nx = b.st[1];
        if (nloc == 0u) { xcd_barrier_complete(bar, b.x, nloc, nx); b.st[0] = nloc; b.st[1] = nx; }
        const unsigned old = xb_add(&bar[XB_XSUB(b.x)], 1u);
        const unsigned gen = old / nloc;
        if (old + 1u == (gen + 1u) * nloc) {
            __builtin_amdgcn_fence(__ATOMIC_RELEASE, "agent");
            asm volatile("s_waitcnt vmcnt(0)" ::: "memory");
            const unsigned og = xb_add(&bar[XB_TOP], 1u);
            const unsigned tg = og / nx;
            if (og + 1u == (tg + 1u) * nx) xb_add(&bar[XB_TOPGEN], 1u);
            else XB_SPIN(xb_ld(&bar[XB_TOPGEN]) == tg, bar);
            __builtin_amdgcn_fence(__ATOMIC_ACQUIRE, "agent");
            xb_add(&bar[XB_XGEN(b.x)], 1u);
            asm volatile("s_waitcnt vmcnt(0)" ::: "memory");
        } else {
            XB_SPIN(xb_ld(&bar[XB_XGEN(b.x)]) == gen, bar);
            __builtin_amdgcn_fence(__ATOMIC_ACQUIRE, "agent");
            asm volatile("s_waitcnt vmcnt(0)" ::: "memory");
        }
    }
    __syncthreads();
}

struct Args { const float* in[34]; float* out; unsigned char* ws; int ph_lo, ph_hi; };

struct Frame {
    const float* const* in; float* out; unsigned char* ws; unsigned* ctl;
    float* ldsf; LAS unsigned char* lds; int tid, lane, wave, bid, G;
};

enum { I_X = 0, I_C, I_ADAW, I_ADAB, I_NPM, I_NPOM, I_NPF, I_NPOF, I_MU, I_WRKV, I_WW1, I_WW2, I_W0, I_WA1, I_WA2, I_A0, I_WG1, I_WG2,
       I_KK, I_KA, I_RK, I_LNG, I_LNB, I_WO, I_SBQKV, I_SBO, I_ROUTER, I_RBIAS, I_MG, I_MU_, I_MD, I_SG, I_SU, I_SD };


typedef short bf16x8 __attribute__((ext_vector_type(8)));
constexpr int HTB = 128 * 64 * 2;
__device__ __forceinline__ int lds_byte(int r, int c) { const int st = (r >> 4) * 2 + (c >> 5), rr = r & 15, cc = c & 31, ob = rr * 64 + cc * 2; return st * 1024 + (ob ^ (((ob >> 9) & 1) << 5)); }
__device__ __forceinline__ void stage_rc(int b, int& R, int& C) { const int st = b / 1024, sb = b % 1024, swz = sb ^ (((sb >> 9) & 1) << 5); R = (st >> 1) * 16 + swz / 64; C = (st & 1) * 32 + (swz % 64) / 2; }
#define WAIT_V(n) asm volatile("s_waitcnt vmcnt(" #n ")" ::: "memory")
#define SBAR() do { asm volatile("" ::: "memory"); __builtin_amdgcn_s_barrier(); asm volatile("" ::: "memory"); } while (0)

struct ASeg { const bf16_t* p[3]; int segTiles; };

struct BRowId { __device__ __forceinline__ int operator()(int R) const { return R; } };
template <int BN, bool NSW = false, class ARow, class Epi, class BRow = BRowId>
__device__ __forceinline__ void sg_tile(LAS unsigned char* lds, const ASeg& A, const ARow& arow, const bf16_t* Bt, int ldb, int nt, const Epi& epi, const BRow& brow = BRow()) {
    constexpr int WN = BN / 64, WM = 8 / WN, WR = 256 / WM, MT = WR / 16;
    int tid_ = threadIdx.x; asm volatile("" : "+v"(tid_));
    const int tid = tid_, wid = __builtin_amdgcn_readfirstlane(tid >> 6), lane = tid & 63, fr = lane & 15, fq = lane >> 4;
    const int wm = wid / WN, wn = wid % WN;
    unsigned aoffs[2][2], boffs[2];
#pragma unroll
    for (int i = 0; i < 2; ++i) { int R, C; stage_rc(tid * 16 + i * 8192, R, C);
        aoffs[0][i] = arow(R) + (unsigned)C * 2u; aoffs[1][i] = arow(128 + R) + (unsigned)C * 2u; boffs[i] = (unsigned)(brow(R) * ldb + C) * 2u; }
    const unsigned ldsw = (unsigned)wid * 1024u;
    f32x4 acc[MT][4];
#pragma unroll
    for (int m = 0; m < MT; ++m)
#pragma unroll
        for (int n = 0; n < 4; ++n) acc[m][n] = (f32x4){0.f, 0.f, 0.f, 0.f};
    const int arow0 = wm * WR, ah = arow0 >> 7, ar = arow0 & 127;
    const int aoff = ah * HTB + lds_byte(ar + fr, fq * 8), boff = 2 * HTB + lds_byte(wn * 64 + fr, fq * 8);
#define SG_STAGE(kt, s) do { const int sg_ = (kt) / A.segTiles; const char* ab_ = (const char*)(sg_ == 0 ? A.p[0] : (sg_ == 1 ? A.p[1] : A.p[2])) + (size_t)((kt) - sg_ * A.segTiles) * 128; const char* bb_ = (const char*)Bt + (size_t)(kt) * 128; \
        _Pragma("unroll") for (int h_ = 0; h_ < 2; ++h_) _Pragma("unroll") for (int i_ = 0; i_ < 2; ++i_) \
            __builtin_amdgcn_global_load_lds((const unsigned*)(ab_ + aoffs[h_][i_]), (LAS unsigned*)(lds + ((s) * 3 + h_) * HTB + ldsw + i_ * 8192), 16, 0, 0); \
        _Pragma("unroll") for (int i_ = 0; i_ < WN; ++i_) \
            __builtin_amdgcn_global_load_lds((const unsigned*)(bb_ + boffs[i_]), (LAS unsigned*)(lds + ((s) * 3 + 2) * HTB + ldsw + i_ * 8192), 16, 0, 0); } while (0)
    SG_STAGE(0, 0);
    for (int t = 0; t < nt; ++t) {
        const int s = t & 1;
        if (t + 1 < nt) { SG_STAGE(t + 1, s ^ 1); if (WN == 2) WAIT_V(6); else WAIT_V(5); } else { WAIT_V(0); }
        SBAR();
        LAS unsigned char* base = lds + s * 3 * HTB;
#pragma unroll
        for (int k = 0; k < 2; ++k) {
            bf16x8 af[MT], bfr[4];
#pragma unroll
            for (int m = 0; m < MT; ++m) af[m] = *(const LAS bf16x8*)(base + aoff + m * 2048 + k * 1024);
#pragma unroll
            for (int n = 0; n < 4; ++n) bfr[n] = *(const LAS bf16x8*)(base + boff + n * 2048 + k * 1024);
#pragma unroll
            for (int m = 0; m < MT; ++m)
#pragma unroll
                for (int n = 0; n < 4; ++n) acc[m][n] = NSW ? __builtin_amdgcn_mfma_f32_16x16x32_bf16(af[m], bfr[n], acc[m][n], 0, 0, 0) : __builtin_amdgcn_mfma_f32_16x16x32_bf16(bfr[n], af[m], acc[m][n], 0, 0, 0);
        }
        SBAR();
    }
#undef SG_STAGE
    epi(acc, arow0, wn * 64, fr, fq);
}

struct CTile { bf16_t* dst; const float* src; int dld, sld, ncols; float scale; };
template <class TF>
__device__ __forceinline__ void conv_tiles(const Frame& F, int ntiles, int u0, int ustride, const TF& tf) {
    unsigned* tl = (unsigned*)F.ldsf;
    const int i = F.tid & 31, kp0 = F.tid >> 5;
    if (u0 >= ntiles) return;
    CTile ct = tf(u0);
    f32x4 a[4], b[4];
#define CV_LOAD() do { _Pragma("unroll") for (int q = 0; q < 4; ++q) { const int kp = kp0 + 16 * q; \
        if (4 * i < ct.ncols) { a[q] = *(const f32x4*)(ct.src + (size_t)(2 * kp) * ct.sld + 4 * i); b[q] = *(const f32x4*)(ct.src + (size_t)(2 * kp + 1) * ct.sld + 4 * i); } } } while (0)
    CV_LOAD();
    for (int u = u0; u < ntiles; u += ustride) {
        const CTile cur = ct;
        if (4 * i < cur.ncols) {
#pragma unroll
            for (int q = 0; q < 4; ++q) { const int kp = kp0 + 16 * q;
#pragma unroll
                for (int e = 0; e < 4; ++e) tl[(4 * i + e) * 65 + kp] = pack2(a[q][e] * cur.scale, b[q][e] * cur.scale); }
        }
        __syncthreads();
        if (u + ustride < ntiles) { ct = tf(u + ustride); CV_LOAD(); }
        const int nb = F.tid >> 4, sgm = F.tid & 15;
#pragma unroll
        for (int q = 0; q < 4; ++q) { const int n = nb + 32 * q;
            if (n < cur.ncols) { u32x4 v;
#pragma unroll
                for (int e = 0; e < 4; ++e) v[e] = tl[n * 65 + sgm * 4 + e];
                *(u32x4*)(cur.dst + (size_t)n * cur.dld + sgm * 8) = v; } }
        __syncthreads();
    }
#undef CV_LOAD
}
__device__ __forceinline__ void conv_moe(const Frame& F, int layer, int u0, int ustride) {
    bf16_t* WGU = (bf16_t*)(F.ws + WS_WGU); bf16_t* WDN = (bf16_t*)(F.ws + WS_WDN);
    const float* const* in = F.in;
    conv_tiles(F, 65 * 48, u0, ustride, [=](int u) {
        CTile c; const int e = u / 48, r = u % 48;
        if (r < 32) { const int up = r >> 4, kt = (r >> 1) & 7, nt = r & 1;
            const float* W = (e < 64) ? (up ? in[I_MU_] : in[I_MG]) + ((size_t)layer * NE + e) * D * DE : (up ? in[I_SU] : in[I_SG]) + (size_t)layer * D * DE;
            c.src = W + (size_t)kt * 128 * DE + nt * 128; c.sld = DE; c.dst = WGU + ((size_t)e * 512 + nt * 256 + up * 128) * D + kt * 128; c.dld = D; c.ncols = 128; c.scale = 1.0f; }
        else { const int v = r - 32, kt = v >> 3, nt = v & 7;
            const float* W = (e < 64) ? in[I_MD] + ((size_t)layer * NE + e) * DE * D : in[I_SD] + (size_t)layer * DE * D;
            c.src = W + (size_t)kt * 128 * D + nt * 128; c.sld = D; c.dst = WDN + ((size_t)e * D + nt * 128) * DE + kt * 128; c.dld = DE; c.ncols = 128; c.scale = YB_SCALE; }
        return c; });
}
__device__ __forceinline__ void conv_dense(const Frame& F, int u0, int ustride) {
    bf16_t* WRKV = (bf16_t*)(F.ws + WS_WRKV); bf16_t* WO = (bf16_t*)(F.ws + WS_WO); bf16_t* WQKV = (bf16_t*)(F.ws + WS_WQKV); bf16_t* WSBO = (bf16_t*)(F.ws + WS_WSBO); bf16_t* WLDN = (bf16_t*)(F.ws + WS_WLDN);
    const float* const* in = F.in;
    conv_tiles(F, 192 + 64 + 192 + 64 + 24, u0, ustride, [=](int u) {
        CTile c; c.dld = D; c.ncols = 128; c.scale = 1.0f;
        if (u < 192) { const int n = u / 64, kt = (u >> 3) & 7, nt = u & 7; c.src = in[I_WRKV] + (size_t)n * D * D + (size_t)kt * 128 * D + nt * 128; c.sld = D; c.dst = WRKV + ((size_t)n * D + nt * 128) * D + kt * 128; }
        else if (u < 256) { const int v = u - 192, kt = v >> 3, nt = v & 7; c.src = in[I_WO] + (size_t)kt * 128 * D + nt * 128; c.sld = D; c.dst = WO + (size_t)nt * 128 * D + kt * 128; }
        else if (u < 448) { const int v = u - 256, kt = v / 24, nt = v % 24; c.src = in[I_SBQKV] + (size_t)kt * 128 * 3 * D + nt * 128; c.sld = 3 * D; c.dst = WQKV + (size_t)nt * 128 * D + kt * 128; }
        else if (u < 512) { const int v = u - 448, kt = v >> 3, nt = v & 7; c.src = in[I_SBO] + (size_t)kt * 128 * D + nt * 128; c.sld = D; c.dst = WSBO + (size_t)nt * 128 * D + kt * 128; }
        else { const int v = u - 512, kt = v / 3, j = v % 3;
            if (j == 0) { c.src = in[I_WW1] + (size_t)kt * 128 * 64; c.sld = 64; c.dst = WLDN + kt * 128; c.ncols = 64; }
            else if (j == 1) { c.src = in[I_WA1] + (size_t)kt * 128 * 64; c.sld = 64; c.dst = WLDN + (size_t)64 * D + kt * 128; c.ncols = 64; }
            else { c.src = in[I_WG1] + (size_t)kt * 128 * 128; c.sld = 128; c.dst = WLDN + (size_t)128 * D + kt * 128; } }
        return c; });
    bf16_t* WLUP = (bf16_t*)(F.ws + WS_WLUP); bf16_t* WRT = (bf16_t*)(F.ws + WS_WRT);
    const int gtid = u0 * NTHREADS + F.tid, gstride = ustride * NTHREADS;
    for (int i = gtid; i < 1024 * 256; i += gstride) {
        float v;
        if (i < 1024 * 64) { const int n = i / 64, k = i % 64; v = F.in[I_WW2][k * D + n]; }
        else if (i < 2 * 1024 * 64) { const int j = i - 1024 * 64, n = j / 64, k = j % 64; v = F.in[I_WA2][k * D + n]; }
        else { const int j = i - 2 * 1024 * 64, n = j / 128, k = j % 128; v = F.in[I_WG2][k * D + n]; }
        WLUP[i] = f2bf(v);
    }
    for (int i = gtid; i < 2 * 64 * 1024; i += gstride) {
        const int l = i / (64 * 1024), j = i % (64 * 1024), e = j / 1024, k = j % 1024;
        const float w = F.in[I_ROUTER][((size_t)l * D + k) * NE + e]; const bf16_t hi = f2bf(w), lo = f2bf(w - bf2f(hi));
        bf16_t* row = WRT + ((size_t)l * 64 + e) * 3072; row[k] = hi; row[1024 + k] = lo; row[2048 + k] = hi;
    }
}

__device__ __forceinline__ unsigned pack_fp8x4(const f32x4& v) {
    const float lim = 440.0f;
    const float a = __builtin_amdgcn_fmed3f(v[0], -lim, lim), b = __builtin_amdgcn_fmed3f(v[1], -lim, lim), c = __builtin_amdgcn_fmed3f(v[2], -lim, lim), d = __builtin_amdgcn_fmed3f(v[3], -lim, lim);
    int w = __builtin_amdgcn_cvt_pk_fp8_f32(a, b, 0, false); w = __builtin_amdgcn_cvt_pk_fp8_f32(c, d, w, true); return (unsigned)w;
}
__device__ __forceinline__ void acc_fp8x16(float (&y)[16], const u32x4& w, float g) {
#pragma unroll
    for (int q = 0; q < 4; ++q) { const f32x2 lo = __builtin_amdgcn_cvt_pk_f32_fp8((int)w[q], false), hi = __builtin_amdgcn_cvt_pk_f32_fp8((int)w[q], true);
        y[4 * q] += g * lo.x; y[4 * q + 1] += g * lo.y; y[4 * q + 2] += g * hi.x; y[4 * q + 3] += g * hi.y; }
}
__device__ __forceinline__ void ph_mod(const Frame& F) {
    const float* c = F.in[I_C]; const float* W = F.in[I_ADAW]; const float* bias = F.in[I_ADAB];
    float* MOD = (float*)(F.ws + WS_MOD);
    float* red = F.ldsf;
    float* sc = F.ldsf + 1024;
    for (int i = F.tid; i < 2 * D; i += NTHREADS) { const float v = c[i]; sc[i] = v * sigmoidf_(v); }
    __syncthreads();
    for (int u = F.bid; u < 192; u += F.G) {
        const int l = u / 96, cg = u % 96, col = cg * 64 + F.lane;
        float s0 = 0.f, s1 = 0.f;
        const float* wp = W + ((size_t)l * D + F.wave * 128) * 6144 + col;
#pragma unroll 1
        for (int d0 = 0; d0 < 128; d0 += 32) {
            float wv[32];
#pragma unroll
            for (int d = 0; d < 32; ++d) wv[d] = wp[(size_t)(d0 + d) * 6144];
#pragma unroll
            for (int d = 0; d < 32; ++d) { const int dd = F.wave * 128 + d0 + d; s0 += sc[dd] * wv[d]; s1 += sc[D + dd] * wv[d]; }
        }
        red[(F.wave * 2 + 0) * 64 + F.lane] = s0; red[(F.wave * 2 + 1) * 64 + F.lane] = s1;
        __syncthreads();
        if (F.tid < 128) {
            const int b = F.tid >> 6, cc = F.tid & 63; float s = 0.f;
#pragma unroll
            for (int w = 0; w < 8; ++w) s += red[(w * 2 + b) * 64 + cc];
            MOD[(l * 2 + b) * 6144 + cg * 64 + cc] = s + bias[l * 6144 + cg * 64 + cc];
        }
        __syncthreads();
    }
}

__device__ __forceinline__ void ph_prenorm_rwkv(const Frame& F) {
    const float* x = F.in[I_X]; const float* g = F.in[I_NPM]; const float* mu = F.in[I_MU];
    const float* MOD = (const float*)(F.ws + WS_MOD);
    bf16_t* XS = (bf16_t*)(F.ws + WS_XS);
    constexpr int RUN_T = 8;
    const int nunits = T / RUN_T, c0 = 16 * F.lane;
    f32x4 m[6][4];
#pragma unroll
    for (int n = 0; n < 6; ++n)
#pragma unroll
        for (int i = 0; i < 4; ++i) m[n][i] = *(const f32x4*)(mu + n * D + c0 + 4 * i);
    for (int u = F.bid * NWAVES + F.wave; u < nunits; u += F.G * NWAVES) {
        const int t0 = u * RUN_T, b = t0 / SEQ;
        const float* shift = MOD + (0 * 2 + b) * 6144; const float* scale = shift + 1024;
        f32x4 gm[4], sh[4];
#pragma unroll
        for (int i = 0; i < 4; ++i) { const int c = c0 + 4 * i; const f32x4 gv = *(const f32x4*)(g + c), sc = *(const f32x4*)(scale + c); gm[i] = gv * (sc + 1.0f); sh[i] = *(const f32x4*)(shift + c); }
        f32x4 hp[4];
#pragma unroll
        for (int i = 0; i < 4; ++i) hp[i] = (f32x4){0.f, 0.f, 0.f, 0.f};
        const int tstart = (t0 % SEQ == 0) ? t0 : t0 - 1;
        for (int t = tstart; t < t0 + RUN_T; ++t) {
            f32x4 xv[4]; float ss = 0.f;
#pragma unroll
            for (int i = 0; i < 4; ++i) { xv[i] = *(const f32x4*)(x + (size_t)t * D + c0 + 4 * i); ss += xv[i][0] * xv[i][0] + xv[i][1] * xv[i][1] + xv[i][2] * xv[i][2] + xv[i][3] * xv[i][3]; }
            ss = wave_sum(ss);
            const float rs = rsqrtf(ss * (1.0f / D) + 1e-6f);
            f32x4 h[4];
#pragma unroll
            for (int i = 0; i < 4; ++i) h[i] = xv[i] * rs * gm[i] + sh[i];
            if (t >= t0) {
#pragma unroll
                for (int n = 0; n < 6; ++n) {
                    u32x4 w0, w1;
#pragma unroll
                    for (int i = 0; i < 4; ++i) {
                        const f32x4 v = h[i] + (hp[i] - h[i]) * m[n][i];
                        const unsigned a0 = pack2(v[0], v[1]), a1 = pack2(v[2], v[3]);
                        if (i == 0) { w0[0] = a0; w0[1] = a1; } else if (i == 1) { w0[2] = a0; w0[3] = a1; } else if (i == 2) { w1[0] = a0; w1[1] = a1; } else { w1[2] = a0; w1[3] = a1; }
                    }
                    bf16_t* dst = XS + ((size_t)n * T + t) * D + c0;
                    *(u32x4*)dst = w0; *(u32x4*)(dst + 8) = w1;
                }
            }
#pragma unroll
            for (int i = 0; i < 4; ++i) hp[i] = h[i];
        }
    }
}


__device__ __forceinline__ void ph_postmix_preffn(const Frame& F, int layer, const float* xin, const bf16_t* Y) {
    const float* MOD = (const float*)(F.ws + WS_MOD);
    const float* gpo = F.in[I_NPOM] + layer * D; const float* gpf = F.in[I_NPF] + layer * D;
    bf16_t* H2 = (bf16_t*)(F.ws + WS_H2); bf16_t* H2LO = (bf16_t*)(F.ws + WS_H2LO);
    const int c0 = 16 * F.lane;
    f32x4 gmp[4], gfs[4], shf[4]; int bcur = -1;
    for (int t = F.bid * NWAVES + F.wave; t < T; t += F.G * NWAVES) {
        const int b = t / SEQ;
        if (b != bcur) { bcur = b; const float* m = MOD + (layer * 2 + b) * 6144;
#pragma unroll
            for (int i = 0; i < 4; ++i) { const int c = c0 + 4 * i;
                gmp[i] = *(const f32x4*)(m + 2048 + c) * *(const f32x4*)(gpo + c);
                gfs[i] = *(const f32x4*)(gpf + c) * (*(const f32x4*)(m + 4096 + c) + 1.0f);
                shf[i] = *(const f32x4*)(m + 3072 + c); } }
        const u32x4 y0 = *(const u32x4*)(Y + (size_t)t * D + c0), y1 = *(const u32x4*)(Y + (size_t)t * D + c0 + 8);
        f32x4 xv[4];
#pragma unroll
        for (int i = 0; i < 4; ++i) xv[i] = *(const f32x4*)(xin + (size_t)t * D + c0 + 4 * i);
        f32x4 y[4];
        y[0] = (f32x4){lo2f(y0[0]), hi2f(y0[0]), lo2f(y0[1]), hi2f(y0[1])}; y[1] = (f32x4){lo2f(y0[2]), hi2f(y0[2]), lo2f(y0[3]), hi2f(y0[3])};
        y[2] = (f32x4){lo2f(y1[0]), hi2f(y1[0]), lo2f(y1[1]), hi2f(y1[1])}; y[3] = (f32x4){lo2f(y1[2]), hi2f(y1[2]), lo2f(y1[3]), hi2f(y1[3])};
        float ss = 0.f;
#pragma unroll
        for (int i = 0; i < 4; ++i) ss += y[i][0] * y[i][0] + y[i][1] * y[i][1] + y[i][2] * y[i][2] + y[i][3] * y[i][3];
        ss = wave_sum(ss);
        const float rs = rsqrtf(ss * (1.0f / D) + 1e-6f);
        f32x4 x1[4]; float s2 = 0.f;
#pragma unroll
        for (int i = 0; i < 4; ++i) { const int c = c0 + 4 * i;
            x1[i] = xv[i] + gmp[i] * (y[i] * rs);
            *(f32x4*)(F.out + (size_t)t * D + c) = x1[i];
            s2 += x1[i][0] * x1[i][0] + x1[i][1] * x1[i][1] + x1[i][2] * x1[i][2] + x1[i][3] * x1[i][3]; }
        s2 = wave_sum(s2);
        const float rs2 = rsqrtf(s2 * (1.0f / D) + 1e-6f);
        u32x4 h0, h1, l0, l1;
#pragma unroll
        for (int i = 0; i < 4; ++i) {
            const f32x4 h = x1[i] * rs2 * gfs[i] + shf[i];
            const unsigned w0 = pack2(h[0], h[1]), w1 = pack2(h[2], h[3]);
            const unsigned v0 = pack2(h[0] - lo2f(w0), h[1] - hi2f(w0)), v1 = pack2(h[2] - lo2f(w1), h[3] - hi2f(w1));
            if (i == 0) { h0[0] = w0; h0[1] = w1; l0[0] = v0; l0[1] = v1; } else if (i == 1) { h0[2] = w0; h0[3] = w1; l0[2] = v0; l0[3] = v1; }
            else if (i == 2) { h1[0] = w0; h1[1] = w1; l1[0] = v0; l1[1] = v1; } else { h1[2] = w0; h1[3] = w1; l1[2] = v0; l1[3] = v1; }
        }
        *(u32x4*)(H2 + (size_t)t * D + c0) = h0; *(u32x4*)(H2 + (size_t)t * D + c0 + 8) = h1;
        *(u32x4*)(H2LO + (size_t)t * D + c0) = l0; *(u32x4*)(H2LO + (size_t)t * D + c0 + 8) = l1;
    }
}


__device__ __forceinline__ void ph_topk(const Frame& F, int layer) {
    const float* LOG = (const float*)(F.ws + WS_LOGITS); const float* rb = F.in[I_RBIAS] + layer * NE;
    int* IDX = (int*)(F.ws + WS_IDX); float* GATE = (float*)(F.ws + WS_GATE); int* RANK = (int*)(F.ws + WS_RANK);
    unsigned* BC = (unsigned*)(F.ws + WS_BC);
    unsigned* lcnt = (unsigned*)F.ldsf;
    const float bias = rb[F.lane];
    for (int base = F.bid * 64; base < T; base += F.G * 64) {
        if (F.tid < 64) lcnt[F.tid] = 0u;
        __syncthreads();
        float s[8], sel[8], tot[8], mysc[8]; int myidx[8]; unsigned lrank[8];
#pragma unroll
        for (int j = 0; j < 8; ++j) { const size_t o = (size_t)(base + F.wave * 8 + j) * NE + F.lane;
            s[j] = sigmoidf_(LOG[o] + LOG[(size_t)T * NE + o] + LOG[(size_t)2 * T * NE + o]); sel[j] = s[j] + bias; tot[j] = 0.f; mysc[j] = 0.f; myidx[j] = 0; }
#pragma unroll
        for (int k = 0; k < TOPK; ++k) {
            float bv[8]; int bi[8];
#pragma unroll
            for (int j = 0; j < 8; ++j) { bv[j] = sel[j]; bi[j] = F.lane; }
#pragma unroll
            for (int o = 32; o >= 1; o >>= 1) {
#pragma unroll
                for (int j = 0; j < 8; ++j) { const float ov = __shfl_xor(bv[j], o); const int oi = __shfl_xor(bi[j], o); const bool take = (ov > bv[j]) | ((ov == bv[j]) & (oi < bi[j]));     bv[j] = take ? ov : bv[j]; bi[j] = take ? oi : bi[j]; }
            }
#pragma unroll
            for (int j = 0; j < 8; ++j) { const float sc = __shfl(s[j], bi[j]); tot[j] += sc; const bool me = (F.lane == k); myidx[j] = me ? bi[j] : myidx[j]; mysc[j] = me ? sc : mysc[j]; sel[j] = (F.lane == bi[j]) ? -1e30f : sel[j]; }
        }
#pragma unroll
        for (int j = 0; j < 8; ++j) { const int t = base + F.wave * 8 + j; lrank[j] = 0u;
            if (F.lane < TOPK) { IDX[t * TOPK + F.lane] = myidx[j]; GATE[t * TOPK + F.lane] = 2.5f * mysc[j] / tot[j]; lrank[j] = atomicAdd(&lcnt[myidx[j]], 1u); } }
        __syncthreads();
        if (F.tid < 64) BC[(base >> 6) * 64 + F.tid] = lcnt[F.tid];
#pragma unroll
        for (int j = 0; j < 8; ++j) { const int t = base + F.wave * 8 + j; if (F.lane < TOPK) RANK[t * TOPK + F.lane] = (int)lrank[j]; }
        __syncthreads();
    }
}

__device__ __forceinline__ void ph_offsets(const Frame& F, int layer) {
    const unsigned* BC = (const unsigned*)(F.ws + WS_BC);
    const int* IDX = (const int*)(F.ws + WS_IDX); const int* RANK = (const int*)(F.ws + WS_RANK);
    int* POS = (int*)(F.ws + WS_POS); int* TOK = (int*)(F.ws + WS_TOK); int* TILEE = (int*)(F.ws + WS_TILEE); int* START = (int*)(F.ws + WS_START);
    int* sst = (int*)F.ldsf;
    constexpr int NG = T / 64;
    for (int g = F.bid; g < NG; g += F.G) {
        { const int e = F.tid & 63, part = F.tid >> 6; int tot = 0, pre = 0;
          for (int gg = part; gg < NG; gg += 8) { const int v = (int)BC[gg * 64 + e]; tot += v; if (gg < g) pre += v; }
          sst[512 + part * 64 + e] = tot; sst[1024 + part * 64 + e] = pre; }
        __syncthreads();
        if (F.tid < 64) { int tot = 0, pre = 0;
#pragma unroll
            for (int q = 0; q < 8; ++q) { tot += sst[512 + q * 64 + F.tid]; pre += sst[1024 + q * 64 + F.tid]; }
            sst[128 + F.tid] = tot; sst[256 + F.tid] = pre; }
        __syncthreads();
        if (F.tid == 0) { int acc = 0; for (int e = 0; e < NE; ++e) { const int c = sst[128 + e]; sst[e] = acc; acc += ((c + RP - 1) / RP) * RP; } sst[64] = acc; }
        __syncthreads();
        if (g == 0) {
            if (F.tid <= 64) START[F.tid] = sst[F.tid];
            if (F.tid == 65) START[65] = sst[64];
            const int ntile = sst[64] / RP;
            for (int i = F.tid; i < ntile; i += NTHREADS) { int e = 0; while (e < 63 && sst[e + 1] <= i * RP) ++e; TILEE[i] = e; }
            for (int q = F.tid; q < NE * RP; q += NTHREADS) { const int e = q / RP, r = q % RP, c = sst[128 + e]; if (sst[e] + c + r < sst[e + 1]) TOK[sst[e] + c + r] = 0; }
        }
        { const int sl = g * 64 * TOPK + F.tid;
          const int e = IDX[sl], p = sst[e] + sst[256 + e] + RANK[sl];
          POS[sl] = p; TOK[p] = sl / TOPK; }
        __syncthreads();
    }
}

__device__ __forceinline__ void ph_combine(const Frame& F, int layer, bool next) {
    const unsigned char* YB = (const unsigned char*)(F.ws + WS_YB); const int* POS = (const int*)(F.ws + WS_POS); const float* GATE = (const float*)(F.ws + WS_GATE);
    const int* START = (const int*)(F.ws + WS_START); const float* MOD = (const float*)(F.ws + WS_MOD);
    const float* gpo = F.in[I_NPOF] + layer * D;
    bf16_t* H3 = (bf16_t*)(F.ws + WS_H3);
    const int routed = START[65], c0 = 16 * F.lane;
    f32x4 gmp[4], gfs[4], shf[4]; int bcur = -1;
    for (int t = F.bid * NWAVES + F.wave; t < T; t += F.G * NWAVES) {
        const int b = t / SEQ;
        if (b != bcur) { bcur = b; const float* m = MOD + (layer * 2 + b) * 6144;
#pragma unroll
            for (int i = 0; i < 4; ++i) { const int c = c0 + 4 * i; gmp[i] = *(const f32x4*)(m + 5120 + c) * *(const f32x4*)(gpo + c);
                if (next) { const float* m1 = MOD + ((layer + 1) * 2 + b) * 6144; const float* g1 = F.in[I_NPM] + (layer + 1) * D;
                    gfs[i] = *(const f32x4*)(g1 + c) * (*(const f32x4*)(m1 + 1024 + c) + 1.0f); shf[i] = *(const f32x4*)(m1 + c); } } }
        int pos[TOPK]; float gk[TOPK];
        { const u32x4 p0 = *(const u32x4*)(POS + t * TOPK), p1 = *(const u32x4*)(POS + t * TOPK + 4); const f32x4 g0 = *(const f32x4*)(GATE + t * TOPK), g1 = *(const f32x4*)(GATE + t * TOPK + 4);
#pragma unroll
          for (int k = 0; k < 4; ++k) { pos[k] = (int)p0[k]; pos[4 + k] = (int)p1[k]; gk[k] = g0[k]; gk[4 + k] = g1[k]; } }
        u32x4 rw[TOPK + 1];
        rw[TOPK] = *(const u32x4*)(YB + (size_t)(routed + t) * D + c0);
#pragma unroll
        for (int k = 0; k < TOPK; ++k) rw[k] = *(const u32x4*)(YB + (size_t)pos[k] * D + c0);
        float y[16];
#pragma unroll
        for (int e = 0; e < 16; ++e) y[e] = 0.f;
        acc_fp8x16(y, rw[TOPK], 1.0f / YB_SCALE);
#pragma unroll
        for (int k = 0; k < TOPK; ++k) acc_fp8x16(y, rw[k], gk[k] * (1.0f / YB_SCALE));
        float ss = 0.f;
#pragma unroll
        for (int e = 0; e < 16; ++e) ss += y[e] * y[e];
        ss = wave_sum(ss);
        const float rs = rsqrtf(ss * (1.0f / D) + 1e-6f);
        f32x4 x2[4]; float s2 = 0.f;
#pragma unroll
        for (int i = 0; i < 4; ++i) { const int c = c0 + 4 * i;
            const f32x4 xv = *(const f32x4*)(F.out + (size_t)t * D + c);
            const f32x4 yv = {y[4 * i], y[4 * i + 1], y[4 * i + 2], y[4 * i + 3]};
            x2[i] = xv + gmp[i] * (yv * rs);
            *(f32x4*)(F.out + (size_t)t * D + c) = x2[i];
            s2 += x2[i][0] * x2[i][0] + x2[i][1] * x2[i][1] + x2[i][2] * x2[i][2] + x2[i][3] * x2[i][3]; }
        if (next) {
            s2 = wave_sum(s2);
            const float rs2 = rsqrtf(s2 * (1.0f / D) + 1e-6f);
            u32x4 h0, h1;
#pragma unroll
            for (int i = 0; i < 4; ++i) {
                const f32x4 h = x2[i] * rs2 * gfs[i] + shf[i];
                const unsigned w0 = pack2(h[0], h[1]), w1 = pack2(h[2], h[3]);
                if (i == 0) { h0[0] = w0; h0[1] = w1; } else if (i == 1) { h0[2] = w0; h0[3] = w1; } else if (i == 2) { h1[0] = w0; h1[1] = w1; } else { h1[2] = w0; h1[3] = w1; } }
            *(u32x4*)(H3 + (size_t)t * D + c0) = h0; *(u32x4*)(H3 + (size_t)t * D + c0 + 8) = h1;
        }
    }
}

#define SB_EXIT 110.0f

namespace pgx {
__device__ __forceinline__ int perm32(int rho) { const int n = rho >> 4, i = rho & 15; return 8 * (i >> 2) + 4 * n + (i & 3); }
struct Unit { const char* A; const int* tok; const char* B; int r0, c0, aux; };
template <bool SW, bool PERM, class Sched, class Epi>
__device__ __forceinline__ void gemm_phase(LAS unsigned char* lds, const int K, const unsigned lda  , const Sched& S, const Epi& E) {
    int tid_ = threadIdx.x; asm volatile("" : "+v"(tid_));
    const int tid = tid_, wid = __builtin_amdgcn_readfirstlane(tid >> 6), lane = tid & 63, wr = wid >> 2, wc = wid & 3, fr = lane & 15, fq = lane >> 4;
    const int nt = K / 64;
    int Rr[2], Cc[2]; unsigned voffB[2];
#pragma unroll
    for (int i = 0; i < 2; ++i) { stage_rc(tid * 16 + i * 8192, Rr[i], Cc[i]); const int Rb = PERM ? ((Rr[i] & ~31) + perm32(Rr[i] & 31)) : Rr[i]; voffB[i] = (unsigned)(Rb * K + Cc[i]) * 2u; }
    const size_t kstep = 128, hstepB = (size_t)128 * K * 2;
    const unsigned ldsw = (unsigned)wid * 1024u;
    const int aoff = lds_byte(wr * 64 + fr, fq * 8), boff = lds_byte(wc * 32 + fr, fq * 8);
#define PX_SA(b, h) (((b) * 2 + (h)) * HTB)
#define PX_SB(b, h) ((4 + (b) * 2 + (h)) * HTB)
#define PX_STAGE(bufoff, gbase, voff) do { _Pragma("unroll") for (int _i = 0; _i < 2; ++_i) \
        __builtin_amdgcn_global_load_lds((const unsigned*)((const char*)(gbase) + (voff)[_i]), (LAS unsigned*)(lds + (bufoff) + ldsw + _i * 8192), 16, 0, 0); } while (0)
#define PX_LDA(dst, b, h) do { _Pragma("unroll") for (int m = 0; m < 4; ++m) _Pragma("unroll") for (int k = 0; k < 2; ++k) dst[m][k] = *(const LAS bf16x8*)(lds + PX_SA(b, h) + aoff + m * 2048 + k * 1024); } while (0)
#define PX_LDB(dst, b, h) do { _Pragma("unroll") for (int n = 0; n < 2; ++n) _Pragma("unroll") for (int k = 0; k < 2; ++k) dst[n][k] = *(const LAS bf16x8*)(lds + PX_SB(b, h) + boff + n * 2048 + k * 1024); } while (0)
#define PX_MMA(ai, bj, At, Bt) do { __builtin_amdgcn_s_setprio(1); _Pragma("unroll") for (int m = 0; m < 4; ++m) _Pragma("unroll") for (int n = 0; n < 2; ++n) _Pragma("unroll") for (int k = 0; k < 2; ++k) \
        acc[ai][bj][m][n] = SW ? __builtin_amdgcn_mfma_f32_16x16x32_bf16(Bt[n][k], At[m][k], acc[ai][bj][m][n], 0, 0, 0) : __builtin_amdgcn_mfma_f32_16x16x32_bf16(At[m][k], Bt[n][k], acc[ai][bj][m][n], 0, 0, 0); __builtin_amdgcn_s_setprio(0); } while (0)
#define PX_WAIT_L(n) asm volatile("s_waitcnt lgkmcnt(" #n ")" ::: "memory")
#define PX_BAR __builtin_amdgcn_s_barrier()
#define PX_SCHED __builtin_amdgcn_sched_barrier(0)
#define PX_OFFS(dst, un) do { _Pragma("unroll") for (int h_ = 0; h_ < 2; ++h_) _Pragma("unroll") for (int i_ = 0; i_ < 2; ++i_) { \
        const int row_ = h_ * 128 + Rr[i_]; const unsigned rid_ = (un).tok ? (unsigned)(un).tok[row_] : (unsigned)row_; dst[h_][i_] = rid_ * lda + (unsigned)Cc[i_] * 2u; } } while (0)
    Unit cur, nxt; int ui = 0;
    if (!S.next(0, cur)) return;
    f32x4 acc[2][2][4][2];
#pragma unroll
    for (int a = 0; a < 2; ++a)
#pragma unroll
        for (int b = 0; b < 2; ++b)
#pragma unroll
            for (int m = 0; m < 4; ++m)
#pragma unroll
                for (int n = 0; n < 2; ++n) acc[a][b][m][n] = (f32x4){0.f, 0.f, 0.f, 0.f};
    bf16x8 At[4][2], B0[2][2], B1[2][2];
    unsigned oc[2][2], on[2][2];
    PX_OFFS(oc, cur); asm volatile("" : "+v"(oc[0][0]), "+v"(oc[0][1]), "+v"(oc[1][0]), "+v"(oc[1][1]));
    const char* cA = cur.A; const char* cB = cur.B;
    PX_STAGE(PX_SB(0, 0), cB, voffB); PX_STAGE(PX_SA(0, 0), cA, oc[0]); PX_STAGE(PX_SB(0, 1), cB + hstepB, voffB); PX_STAGE(PX_SA(0, 1), cA, oc[1]);
    if (wr == 1) PX_BAR;
    WAIT_V(4); PX_BAR;
    PX_STAGE(PX_SB(1, 0), cB + kstep, voffB); PX_STAGE(PX_SA(1, 0), cA + kstep, oc[0]); PX_STAGE(PX_SB(1, 1), cB + hstepB + kstep, voffB);
    WAIT_V(6); PX_BAR;
    for (;;) {
        const bool has_next = S.next(ui + 1, nxt);
        const char* nA = has_next ? nxt.A : cA; const char* nB = has_next ? nxt.B : cB;
        if (has_next) { PX_OFFS(on, nxt); asm volatile("" : "+v"(on[0][0]), "+v"(on[0][1]), "+v"(on[1][0]), "+v"(on[1][1])); } else {
#pragma unroll
            for (int h_ = 0; h_ < 2; ++h_)
#pragma unroll
                for (int i_ = 0; i_ < 2; ++i_) on[h_][i_] = oc[h_][i_]; }
#pragma unroll 1
        for (int t = 0; t < nt; t += 2) {
            const bool last = (t == nt - 2);
            const char* a1 = cA + (size_t)(t + 1) * kstep;
            const char* a2 = last ? nA : cA + (size_t)(t + 2) * kstep; const char* b2 = last ? nB : cB + (size_t)(t + 2) * kstep;
            const char* a3 = a2 + kstep; const char* b3 = b2 + kstep;
            unsigned o2[2][2];
#pragma unroll
            for (int h_ = 0; h_ < 2; ++h_)
#pragma unroll
                for (int i_ = 0; i_ < 2; ++i_) o2[h_][i_] = last ? on[h_][i_] : oc[h_][i_];
            PX_LDB(B0, 0, 0); PX_SCHED; PX_LDA(At, 0, 0); PX_STAGE(PX_SA(1, 1), a1, oc[1]);
            PX_WAIT_L(8); PX_BAR; PX_WAIT_L(0); PX_MMA(0, 0, At, B0); PX_BAR; PX_SCHED;
            PX_LDB(B1, 0, 1); PX_STAGE(PX_SB(0, 0), b2, voffB);
            PX_BAR; PX_WAIT_L(0); PX_MMA(0, 1, At, B1); PX_BAR;
            PX_LDA(At, 0, 1); PX_STAGE(PX_SA(0, 0), a2, o2[0]);
            PX_BAR; PX_WAIT_L(0); PX_MMA(1, 0, At, B0); PX_BAR; PX_SCHED;
            PX_STAGE(PX_SB(0, 1), b2 + hstepB, voffB);
            WAIT_V(6); PX_BAR; PX_MMA(1, 1, At, B1); PX_BAR;
            PX_LDB(B0, 1, 0); PX_SCHED; PX_LDA(At, 1, 0); PX_STAGE(PX_SA(0, 1), a2, o2[1]);
            PX_WAIT_L(8); PX_BAR; PX_WAIT_L(0); PX_MMA(0, 0, At, B0); PX_BAR; PX_SCHED;
            PX_LDB(B1, 1, 1); PX_STAGE(PX_SB(1, 0), b3, voffB);
            PX_BAR; PX_WAIT_L(0); PX_MMA(0, 1, At, B1); PX_BAR;
            PX_LDA(At, 1, 1); PX_STAGE(PX_SA(1, 0), a3, o2[0]);
            PX_BAR; PX_WAIT_L(0); PX_MMA(1, 0, At, B0); PX_BAR; PX_SCHED;
            PX_STAGE(PX_SB(1, 1), b3 + hstepB, voffB);
            WAIT_V(6); PX_BAR; PX_MMA(1, 1, At, B1); PX_BAR;
        }
        E(acc, cur, wr, wc, fr, fq);
        if (!has_next) break;
#pragma unroll
        for (int a = 0; a < 2; ++a)
#pragma unroll
            for (int b = 0; b < 2; ++b)
#pragma unroll
                for (int m = 0; m < 4; ++m)
#pragma unroll
                    for (int n = 0; n < 2; ++n) acc[a][b][m][n] = (f32x4){0.f, 0.f, 0.f, 0.f};
        cur = nxt; cA = nA; cB = nB; ++ui;
#pragma unroll
        for (int h_ = 0; h_ < 2; ++h_)
#pragma unroll
            for (int i_ = 0; i_ < 2; ++i_) oc[h_][i_] = on[h_][i_];
    }
    WAIT_V(0);
    if (wr == 0) PX_BAR;
    PX_BAR;
#undef PX_SA
#undef PX_SB
#undef PX_STAGE
#undef PX_LDA
#undef PX_LDB
#undef PX_MMA
#undef PX_WAIT_L
#undef PX_BAR
#undef PX_SCHED
#undef PX_OFFS
}
__device__ __forceinline__ unsigned cvt_pk_bf16(float lo, float hi) { return pack2(lo, hi); }
}

__device__ __forceinline__ size_t hm_off(int t, int c) { return ((size_t)((t / SEQ) * NH + (c >> 6)) * SEQ + (t % SEQ)) * 64 + (c & 63); }
#define EPI_MT(acc) (int)(sizeof(acc) / sizeof(acc[0]))
__device__ __forceinline__ void st_bf4(bf16_t* p, const f32x4& v) { u32x2 w; w.x = pack2(v[0], v[1]); w.y = pack2(v[2], v[3]); *(u32x2*)p = w; }

__device__ __forceinline__ void ph_lora_up_sg(const Frame& F) {
    const bf16_t* LORA = (const bf16_t*)(F.ws + WS_LORA); const bf16_t* WLUP = (const bf16_t*)(F.ws + WS_WLUP);
    bf16_t* LD = (bf16_t*)(F.ws + WS_LD); bf16_t* AA = (bf16_t*)(F.ws + WS_AA); bf16_t* GG = (bf16_t*)(F.ws + WS_GG);
    for (int u = F.bid; u < 3 * 64 * 8; u += F.G) {
        const int which = u / 512, v = u % 512, mt = v / 8, col0 = (v % 8) * 128;
        const int K = which == 2 ? 128 : 64, koff = which * 64;
        ASeg A; A.p[0] = LORA + (size_t)mt * 256 * 256 + koff; A.p[1] = A.p[0]; A.p[2] = A.p[0]; A.segTiles = 4;
        const bf16_t* Bt = WLUP + (which == 0 ? 0 : (which == 1 ? 1024 * 64 : 2 * 1024 * 64)) + (size_t)col0 * K;
        const size_t obase = (size_t)mt * 256 * D + col0;
        sg_tile<128>(F.lds, A, [](int R) { return (unsigned)R * 512u; }, Bt, K, K / 64,
            [&](auto& acc, int r0, int c0, int fr, int fq) {
#pragma unroll
                for (int m = 0; m < EPI_MT(acc); ++m)
#pragma unroll
                    for (int q = 0; q < 4; ++q) {
                        const int c = c0 + 16 * q + 4 * fq; const size_t o = hm_off(mt * 256 + r0 + 16 * m + fr, col0 + c);
                        if (which == 0) { const f32x4 w0 = *(const f32x4*)(F.in[I_W0] + col0 + c); f32x4 r;
#pragma unroll
                            for (int e = 0; e < 4; ++e) { const float wl = w0[e] + acc[m][q][e]; r[e] = -fexp_(-softplusf_(-wl) - 0.5f); }
                            st_bf4(LD + o, r); }
                        else if (which == 1) { const f32x4 a0 = *(const f32x4*)(F.in[I_A0] + col0 + c); f32x4 r;
#pragma unroll
                            for (int e = 0; e < 4; ++e) r[e] = sigmoidf_(a0[e] + acc[m][q][e]);
                            st_bf4(AA + o, r); }
                        else st_bf4(GG + o, acc[m][q]);
                    }
            });
    }
}
__device__ __forceinline__ void ph_router_sg(const Frame& F, int layer) {
    const bf16_t* H2 = (const bf16_t*)(F.ws + WS_H2); const bf16_t* H2LO = (const bf16_t*)(F.ws + WS_H2LO);
    const bf16_t* WRT = (const bf16_t*)(F.ws + WS_WRT) + (size_t)layer * 64 * 3072; float* LOG = (float*)(F.ws + WS_LOGITS);
    for (int u = F.bid; u < 64 * 3; u += F.G) {
        const int mt = u / 3, sgi = u % 3;
        ASeg A; A.p[0] = (sgi == 2 ? H2LO : H2) + (size_t)mt * 256 * D; A.p[1] = A.p[0]; A.p[2] = A.p[0]; A.segTiles = 16;
        float* out = LOG + (size_t)sgi * T * NE;
        sg_tile<64>(F.lds, A, [](int R) { return (unsigned)R * (D * 2); }, WRT + sgi * 1024, 3072, 16,
            [&](auto& acc, int r0, int c0, int fr, int fq) {
#pragma unroll
                for (int m = 0; m < EPI_MT(acc); ++m)
#pragma unroll
                    for (int q = 0; q < 4; ++q) *(f32x4*)(out + (size_t)(mt * 256 + r0 + 16 * m + fr) * NE + c0 + 16 * q + 4 * fq) = acc[m][q];
            });
    }
}

constexpr int MS = 72;
constexpr int SLOT = 64 * MS * 2;
__device__ __forceinline__ int ms_off(int row, int col) { return row * MS + col; }
constexpr size_t WS_BONUS = 3 * MiB;
constexpr size_t WS_RP = WS_BIG + 128 * MiB;
constexpr size_t WS_OL = WS_BIG + 160 * MiB;
constexpr size_t WS_G2 = WS_BIG + 296 * MiB;
constexpr size_t WS_DM = WS_BIG + 328 * MiB;
constexpr size_t WS_ST = WS_BIG + 360 * MiB;

__device__ __forceinline__ void st4_lds(LAS bf16_t* p, const f32x4& v) { u32x2 w; w.x = pack2(v[0], v[1]); w.y = pack2(v[2], v[3]); *(LAS u32x2*)p = w; }
__device__ __forceinline__ f32x4 ld4_lds(const LAS bf16_t* p) { const u32x2 w = *(const LAS u32x2*)p; return (f32x4){lo2f(w.x), hi2f(w.x), lo2f(w.y), hi2f(w.y)}; }

__device__ __forceinline__ void ph_wkv_chunk(const Frame& F) {
    const bf16_t* RKV = (const bf16_t*)(F.ws + WS_RKV); const bf16_t* LD = (const bf16_t*)(F.ws + WS_LD); const bf16_t* AA = (const bf16_t*)(F.ws + WS_AA);
    const bf16_t* Rb = RKV; const bf16_t* Kb = RKV + (size_t)T * D; const bf16_t* Vb = RKV + (size_t)2 * T * D;
    bf16_t* RP = (bf16_t*)(F.ws + WS_RP); bf16_t* OL = (bf16_t*)(F.ws + WS_OL); bf16_t* G2 = (bf16_t*)(F.ws + WS_G2); bf16_t* DM = (bf16_t*)(F.ws + WS_DM);
    float* BONUS = (float*)(F.ws + WS_BONUS);
#define SL(k) ((LAS bf16_t*)(F.lds + (k) * SLOT))
#define AT(k, r, c) (SL(k) + ms_off((r), (c)))
    LAS float* segtot = (LAS float*)(F.lds + 15 * SLOT);
    LAS float* WCs = segtot + 512;
    const int w = F.wave, lane = F.lane, fr = lane & 15, fq = lane >> 4, mt = w >> 1, ntb = 2 * (w & 1);
    for (int cid = F.bid; cid < NB * NH * (SEQ / 64); cid += F.G) {
        const int bh = cid / (SEQ / 64), c = cid % (SEQ / 64), b = bh / NH, h = bh % NH;
        const size_t tok0 = (size_t)b * SEQ + (size_t)c * 64;
        {
            const int t = F.tid >> 3, jg = lane & 7, tl = lane >> 3, ch0 = h * 64 + 8 * jg;
            const size_t o = ((size_t)bh * SEQ + (size_t)c * 64 + t) * 64 + 8 * jg;
            const u32x4 rr = *(const u32x4*)(Rb + o), kr = *(const u32x4*)(Kb + o), vr = *(const u32x4*)(Vb + o), ar = *(const u32x4*)(AA + o);
            const u32x4 lr = *(const u32x4*)(LD + o);
            float r[8], k[8], a[8], ld[8], cum[8];
#pragma unroll
            for (int q = 0; q < 4; ++q) { r[2 * q] = lo2f(rr[q]); r[2 * q + 1] = hi2f(rr[q]); k[2 * q] = lo2f(kr[q]); k[2 * q + 1] = hi2f(kr[q]); a[2 * q] = lo2f(ar[q]); a[2 * q + 1] = hi2f(ar[q]); ld[2 * q] = lo2f(lr[q]); ld[2 * q + 1] = hi2f(lr[q]); }
#pragma unroll
            for (int e = 0; e < 8; ++e) { float v = ld[e];
                float u1 = __shfl_up(v, 8);  if (tl >= 1) v += u1;
                float u2 = __shfl_up(v, 16); if (tl >= 2) v += u2;
                float u4 = __shfl_up(v, 32); if (tl >= 4) v += u4;
                cum[e] = v; }
            if (tl == 7) {
#pragma unroll
                for (int e = 0; e < 8; ++e) segtot[w * 64 + 8 * jg + e] = cum[e]; }
            __syncthreads();
            float tot[8];
#pragma unroll
            for (int e = 0; e < 8; ++e) tot[e] = 0.f;
#pragma unroll
            for (int ww = 0; ww < 8; ++ww) {
                const f32x4 s0 = *(const LAS f32x4*)(segtot + ww * 64 + 8 * jg), s1 = *(const LAS f32x4*)(segtot + ww * 64 + 8 * jg + 4);
#pragma unroll
                for (int q = 0; q < 4; ++q) { tot[q] += s0[q]; tot[4 + q] += s1[q]; if (ww < w) { cum[q] += s0[q]; cum[4 + q] += s1[q]; } }
            }
            if (t == 0) {
#pragma unroll
                for (int e = 0; e < 8; ++e) WCs[8 * jg + e] = fexp_(tot[e]); }
            float kkr[8], kf[8], ss = 0.f, bon = 0.f;
#pragma unroll
            for (int e = 0; e < 8; ++e) { kkr[e] = k[e] * F.in[I_KK][ch0 + e]; ss += kkr[e] * kkr[e]; kf[e] = k[e] * (1.0f + (a[e] - 1.0f) * F.in[I_KA][ch0 + e]); bon += r[e] * kf[e] * F.in[I_RK][ch0 + e]; }
            ss += __shfl_xor(ss, 1); ss += __shfl_xor(ss, 2); ss += __shfl_xor(ss, 4);
            bon += __shfl_xor(bon, 1); bon += __shfl_xor(bon, 2); bon += __shfl_xor(bon, 4);
            if (jg == 0) BONUS[(tok0 + t) * NH + h] = bon;
            const float inv = 1.0f / fmaxf(sqrtf(ss), 1e-12f);
            float av[8], bv[8], kv[8], rv[8];
#pragma unroll
            for (int e = 0; e < 8; ++e) { const float kk = kkr[e] * inv, en = fexp_(-cum[e]);
                av[e] = -kk * fexp_(cum[e] - ld[e]); bv[e] = kk * a[e] * en; kv[e] = kf[e] * en; rv[e] = r[e] * fexp_(cum[e]); }
            u32x4 pa, pr, pb, pk;
#pragma unroll
            for (int q = 0; q < 4; ++q) { pa[q] = pack2(av[2 * q], av[2 * q + 1]); pr[q] = pack2(rv[2 * q], rv[2 * q + 1]); pb[q] = pack2(bv[2 * q], bv[2 * q + 1]); pk[q] = pack2(kv[2 * q], kv[2 * q + 1]); }
            *(LAS u32x4*)AT(0, t, 8 * jg) = pa; *(LAS u32x4*)AT(2, t, 8 * jg) = pr; *(LAS u32x4*)AT(3, t, 8 * jg) = pb; *(LAS u32x4*)AT(5, t, 8 * jg) = pk;
#pragma unroll
            for (int q = 0; q < 4; ++q) {
                *AT(1, 8 * jg + 2 * q, t) = (bf16_t)(pa[q] & 0xffffu); *AT(1, 8 * jg + 2 * q + 1, t) = (bf16_t)(pa[q] >> 16);
                *AT(4, 8 * jg + 2 * q, t) = (bf16_t)(pb[q] & 0xffffu); *AT(4, 8 * jg + 2 * q + 1, t) = (bf16_t)(pb[q] >> 16);
                *AT(6, 8 * jg + 2 * q, t) = (bf16_t)(pk[q] & 0xffffu); *AT(6, 8 * jg + 2 * q + 1, t) = (bf16_t)(pk[q] >> 16);
                *AT(7, 8 * jg + 2 * q, t) = (bf16_t)(vr[q] & 0xffffu); *AT(7, 8 * jg + 2 * q + 1, t) = (bf16_t)(vr[q] >> 16);
            }
        }
        __syncthreads();
#define LF2(dst, k, r0) do { dst[0] = *(const LAS bf16x8*)AT(k, (r0) + fr, fq * 8); dst[1] = *(const LAS bf16x8*)AT(k, (r0) + fr, 32 + fq * 8); } while (0)
#define MMA2(acc, xf, yf) do { acc = __builtin_amdgcn_mfma_f32_16x16x32_bf16(xf[0], yf[0], acc, 0, 0, 0); acc = __builtin_amdgcn_mfma_f32_16x16x32_bf16(xf[1], yf[1], acc, 0, 0, 0); } while (0)
        {
            bf16x8 xa[2], xr[2]; LF2(xa, 0, 16 * mt); LF2(xr, 2, 16 * mt);
#pragma unroll
            for (int q2 = 0; q2 < 2; ++q2) {
                const int nt = ntb + q2;
                bf16x8 yb[2], yk[2]; LF2(yb, 3, 16 * nt); LF2(yk, 5, 16 * nt);
                { f32x4 acc = {0.f, 0.f, 0.f, 0.f}; MMA2(acc, xa, yb);
                  const int sidx = 16 * nt + fr, t0 = 16 * mt + 4 * fq;
#pragma unroll
                  for (int e = 0; e < 4; ++e) { if (!(sidx < t0 + e)) acc[e] = 0.f; *AT(8, t0 + e, sidx) = f2bf(acc[e]); }
                  st4_lds(AT(9, sidx, t0), acc); }
                const int tt = 16 * mt + fr, s0 = 16 * nt + 4 * fq;
                { f32x4 acc = {0.f, 0.f, 0.f, 0.f}; MMA2(acc, yk, xa);
#pragma unroll
                  for (int e = 0; e < 4; ++e) if (!(s0 + e < tt)) acc[e] = 0.f;
                  st4_lds(AT(10, tt, s0), acc); }
                { f32x4 acc = {0.f, 0.f, 0.f, 0.f}; MMA2(acc, yb, xr);
#pragma unroll
                  for (int e = 0; e < 4; ++e) if (!(s0 + e <= tt)) acc[e] = 0.f;
                  st4_lds(AT(11, tt, s0), acc); }
                { f32x4 acc = {0.f, 0.f, 0.f, 0.f}; MMA2(acc, yk, xr);
#pragma unroll
                  for (int e = 0; e < 4; ++e) if (!(s0 + e <= tt)) acc[e] = 0.f;
                  st4_lds(AT(12, tt, s0), acc); }
            }
        }
        __syncthreads();
#define WKV_SQ(xi, ti, xo, to) do { bf16x8 xl[2]; LF2(xl, xi, 16 * mt); _Pragma("unroll") for (int q2 = 0; q2 < 2; ++q2) { const int nt = ntb + q2; bf16x8 yl[2]; LF2(yl, ti, 16 * nt); \
            f32x4 acc = {0.f, 0.f, 0.f, 0.f}; MMA2(acc, xl, yl); const int n_ = 16 * nt + fr, m0_ = 16 * mt + 4 * fq; \
            _Pragma("unroll") for (int e = 0; e < 4; ++e) *AT(xo, m0_ + e, n_) = f2bf(acc[e]); st4_lds(AT(to, n_, m0_), acc); } } while (0)
#define WKV_PM(pi, ti, po) do { bf16x8 xp[2]; LF2(xp, pi, 16 * mt); _Pragma("unroll") for (int q2 = 0; q2 < 2; ++q2) { const int nt = ntb + q2; bf16x8 yl[2]; LF2(yl, ti, 16 * nt); \
            const int m_ = 16 * mt + fr, n0_ = 16 * nt + 4 * fq; f32x4 acc = ld4_lds(AT(pi, m_, n0_)); MMA2(acc, yl, xp); st4_lds(AT(po, m_, n0_), acc); } } while (0)
#define WKV_PMSQ(pi, xi, ti, po, xo, to) do { bf16x8 xp[2], xl[2]; LF2(xp, pi, 16 * mt); LF2(xl, xi, 16 * mt); _Pragma("unroll") for (int q2 = 0; q2 < 2; ++q2) { const int nt = ntb + q2; bf16x8 yl[2]; LF2(yl, ti, 16 * nt); \
            { const int m_ = 16 * mt + fr, n0_ = 16 * nt + 4 * fq; f32x4 acc = ld4_lds(AT(pi, m_, n0_)); MMA2(acc, yl, xp); st4_lds(AT(po, m_, n0_), acc); } \
            { f32x4 acc = {0.f, 0.f, 0.f, 0.f}; MMA2(acc, xl, yl); const int n_ = 16 * nt + fr, m0_ = 16 * mt + 4 * fq; \
              _Pragma("unroll") for (int e = 0; e < 4; ++e) *AT(xo, m0_ + e, n_) = f2bf(acc[e]); st4_lds(AT(to, n_, m0_), acc); } } } while (0)
        WKV_SQ(8, 9, 0, 3);
        for (int idx = F.tid; idx < 64 * 16; idx += NTHREADS) { const int t = idx >> 4, s4 = (idx & 15) * 4; u32x2 v = *(const LAS u32x2*)AT(8, t, s4);
            if ((t >> 2) == (s4 >> 2)) { const unsigned one = 0x3F80u; const int e = t & 3; if (e == 0) v.x = (v.x & 0xffff0000u) | one; else if (e == 1) v.x = (v.x & 0xffffu) | (one << 16); else if (e == 2) v.y = (v.y & 0xffff0000u) | one; else v.y = (v.y & 0xffffu) | (one << 16); }
            *(LAS u32x2*)AT(13, t, s4) = v; }
        __syncthreads();
        WKV_PMSQ(13, 0, 3, 14, 8, 9); __syncthreads();
        WKV_PMSQ(14, 8, 9, 13, 0, 3); __syncthreads();
        WKV_PMSQ(13, 0, 3, 14, 8, 9); __syncthreads();
        WKV_PMSQ(14, 8, 9, 13, 0, 3); __syncthreads();
        WKV_PM(13, 3, 14); __syncthreads();
        {
            bf16x8 xt[2], xm[2]; LF2(xt, 14, 16 * mt); LF2(xm, 10, 16 * mt);
#pragma unroll
            for (int q2 = 0; q2 < 2; ++q2) {
                const int nt = ntb + q2, n_ = 16 * nt + fr, m0_ = 16 * mt + 4 * fq;
                bf16x8 ya[2], yv[2]; LF2(ya, 1, 16 * nt); LF2(yv, 7, 16 * nt);
                { f32x4 acc = {0.f, 0.f, 0.f, 0.f}; MMA2(acc, xt, ya); st4_lds(AT(9, n_, m0_), acc); }
                { f32x4 acc = {0.f, 0.f, 0.f, 0.f}; MMA2(acc, xm, yv); st4_lds(AT(8, n_, m0_), acc); }
            }
        }
        __syncthreads();
        {
            bf16x8 xt[2], xb[2]; LF2(xt, 14, 16 * mt); LF2(xb, 11, 16 * mt);
#pragma unroll
            for (int q2 = 0; q2 < 2; ++q2) {
                const int nt = ntb + q2;
                bf16x8 yz[2], yp[2]; LF2(yz, 8, 16 * nt); LF2(yp, 9, 16 * nt);
                { const int n_ = 16 * nt + fr, m0_ = 16 * mt + 4 * fq; f32x4 acc = {0.f, 0.f, 0.f, 0.f}; MMA2(acc, xt, yz); st4_lds(AT(0, n_, m0_), acc); }
                { const int m_ = 16 * mt + fr, n0_ = 16 * nt + 4 * fq; f32x4 acc = ld4_lds(AT(2, m_, n0_)); MMA2(acc, yp, xb);
                  st_bf4(RP + (size_t)cid * 4096 + (unsigned)((mt * 2 + (nt >> 1)) * 512 + (fr * 4 + 2 * (nt & 1) + (fq >> 1)) * 8 + 4 * (fq & 1)), acc); }
            }
        }
        __syncthreads();
        {
            bf16x8 xb[2], xk[2], xp[2], xu[2], xv[2]; LF2(xb, 11, 16 * mt); LF2(xk, 12, 16 * mt); LF2(xp, 9, 16 * mt); LF2(xu, 0, 16 * mt); LF2(xv, 7, 16 * mt);
#pragma unroll
            for (int q2 = 0; q2 < 2; ++q2) {
                const int nt = ntb + q2;
                bf16x8 yu[2], yv[2], yb[2], yk[2]; LF2(yu, 0, 16 * nt); LF2(yv, 7, 16 * nt); LF2(yb, 4, 16 * nt); LF2(yk, 6, 16 * nt);
                { f32x4 acc = {0.f, 0.f, 0.f, 0.f}; MMA2(acc, yu, xb); MMA2(acc, yv, xk);
                  st_bf4(OL + (size_t)cid * 4096 + (unsigned)((16 * mt + fr) * 64 + 16 * nt + 4 * fq), acc); }
                { const int jp = 16 * nt + fr, j0 = 16 * mt + 4 * fq; f32x4 acc = {0.f, 0.f, 0.f, 0.f}; MMA2(acc, xp, yb);
                  const float wc = WCs[jp];
#pragma unroll
                  for (int e = 0; e < 4; ++e) acc[e] = (acc[e] + ((j0 + e == jp) ? 1.0f : 0.0f)) * wc;
                  st_bf4(G2 + (size_t)cid * 4096 + (unsigned)((nt * 2 + (mt >> 1)) * 512 + lane * 8 + (mt & 1) * 4), acc); }
                { const int i_ = 16 * mt + fr, jp0 = 16 * nt + 4 * fq; f32x4 acc = {0.f, 0.f, 0.f, 0.f}; MMA2(acc, yb, xu); MMA2(acc, yk, xv);
#pragma unroll
                  for (int e = 0; e < 4; ++e) acc[e] *= WCs[jp0 + e];
                  st_bf4(DM + (size_t)cid * 4096 + (unsigned)(i_ * 64 + jp0), acc); }
            }
        }
        __syncthreads();
    }
#undef LF2
#undef MMA2
#undef WKV_PMSQ
#undef WKV_SQ
#undef WKV_PM
#undef AT
#undef SL
}

__device__ __forceinline__ void ph_wkv_carry(const Frame& F) {
    const bf16_t* G2 = (const bf16_t*)(F.ws + WS_G2); const bf16_t* DM = (const bf16_t*)(F.ws + WS_DM); bf16_t* ST = (bf16_t*)(F.ws + WS_ST);
    const int lane = F.lane, fr = lane & 15, fq = lane >> 4;
    const bool loader = F.wave >= 4; const int lw = F.wave - 4, i = 16 * (F.wave & 3) + fr;
    constexpr int NC = SEQ / 64;
    for (int ch = F.bid; ch < NB * NH; ch += F.G) {
        const size_t cbase = (size_t)ch * NC;
#define CARRY_ISSUE(c_) do { const int cc_ = (c_) < NC ? (c_) : NC - 1; const size_t cid_ = cbase + cc_; \
        _Pragma("unroll") for (int q_ = 0; q_ < 4; ++q_) { const int j_ = lw * 4 + q_; \
            const bf16_t* src_ = (j_ < 8 ? G2 + cid_ * 4096 + j_ * 512 : DM + cid_ * 4096 + (j_ - 8) * 512) + lane * 8; \
            __builtin_amdgcn_global_load_lds((const unsigned*)src_, (LAS unsigned*)(F.lds + ((c_) & 7) * 16384 + j_ * 1024), 16, 0, 0); } } while (0)
        f32x4 st[4];
#pragma unroll
        for (int r = 0; r < 4; ++r) st[r] = (f32x4){0.f, 0.f, 0.f, 0.f};
        bf16x8 gc[8]; u32x2 dc[4];
#define CARRY_RING_READ(c_) do { const LAS unsigned char* slot_ = F.lds + ((c_) & 7) * 16384; \
        _Pragma("unroll") for (int f = 0; f < 8; ++f) gc[f] = *(const LAS bf16x8*)(slot_ + f * 1024 + lane * 16); \
        _Pragma("unroll") for (int r = 0; r < 4; ++r) dc[r] = *(const LAS u32x2*)(slot_ + 8192 + (i * 64 + 16 * r + 4 * fq) * 2); } while (0)
        if (loader) {
#pragma unroll
            for (int c = 0; c < 7; ++c) CARRY_ISSUE(c);
            WAIT_V(20);
        }
        SBAR();
        if (!loader) CARRY_RING_READ(0);
#pragma unroll 1
        for (int c = 0; c < NC; ++c) {
            if (loader) {
                CARRY_ISSUE(c + 7);
                WAIT_V(20);
            } else {
                const size_t cid = cbase + c;
                union { bf16x8 v; unsigned u[4]; } b0, b1;
                b0.u[0] = pack2(st[0][0], st[0][1]); b0.u[1] = pack2(st[0][2], st[0][3]); b0.u[2] = pack2(st[1][0], st[1][1]); b0.u[3] = pack2(st[1][2], st[1][3]);
                b1.u[0] = pack2(st[2][0], st[2][1]); b1.u[1] = pack2(st[2][2], st[2][3]); b1.u[2] = pack2(st[3][0], st[3][1]); b1.u[3] = pack2(st[3][2], st[3][3]);
                f32x4 acc[4];
#pragma unroll
                for (int r = 0; r < 4; ++r) { acc[r] = (f32x4){lo2f(dc[r].x), hi2f(dc[r].x), lo2f(dc[r].y), hi2f(dc[r].y)};
                    acc[r] = __builtin_amdgcn_mfma_f32_16x16x32_bf16(gc[r * 2 + 0], b0.v, acc[r], 0, 0, 0); }
#pragma unroll
                for (int r = 0; r < 4; ++r) acc[r] = __builtin_amdgcn_mfma_f32_16x16x32_bf16(gc[r * 2 + 1], b1.v, acc[r], 0, 0, 0);
                { const unsigned wsl = (unsigned)(F.wave & 3);
                  bf16_t* stp = ST + cid * 4096;
                  const unsigned ob = (unsigned)(((fr >> 2) * 2) * 512 + ((4 * wsl + (fr & 3)) * 4 + (fq >> 1)) * 8 + 4 * (fq & 1));
                  u32x2 w0; w0.x = b0.u[0]; w0.y = b0.u[1]; *(u32x2*)(stp + ob) = w0;
                  u32x2 w1; w1.x = b0.u[2]; w1.y = b0.u[3]; *(u32x2*)(stp + ob + 16) = w1;
                  u32x2 w2; w2.x = b1.u[0]; w2.y = b1.u[1]; *(u32x2*)(stp + ob + 512) = w2;
                  u32x2 w3; w3.x = b1.u[2]; w3.y = b1.u[3]; *(u32x2*)(stp + ob + 512 + 16) = w3; }
                if (c + 1 < NC) CARRY_RING_READ(c + 1);
#pragma unroll
                for (int r = 0; r < 4; ++r) st[r] = acc[r];
            }
            SBAR();
        }
        if (loader) WAIT_V(0);
        SBAR();
#undef CARRY_RING_READ
#undef CARRY_ISSUE
    }
}

__device__ __forceinline__ void ph_wkv_out(const Frame& F) {
    const bf16_t* RP = (const bf16_t*)(F.ws + WS_RP); const bf16_t* OL = (const bf16_t*)(F.ws + WS_OL); const bf16_t* ST = (const bf16_t*)(F.ws + WS_ST);
    const bf16_t* Vb = (const bf16_t*)(F.ws + WS_RKV) + (size_t)2 * T * D; const bf16_t* GG = (const bf16_t*)(F.ws + WS_GG); const float* BONUS = (const float*)(F.ws + WS_BONUS);
    bf16_t* OG = (bf16_t*)(F.ws + WS_OG);
    const int lane = F.lane, fr = lane & 15, fq = lane >> 4;
    const int nunits = NB * NH * (SEQ / 64) * 4;
    for (int u = F.bid * NWAVES + F.wave; u < nunits; u += F.G * NWAVES) {
        const int cid = u >> 2, tt = u & 3, bh = cid / (SEQ / 64), c = cid % (SEQ / 64), b = bh / NH, h = bh % NH;
        const int t = 16 * tt + fr; const size_t tok = (size_t)b * SEQ + (size_t)c * 64 + t;
        const size_t oh = ((size_t)bh * SEQ + (size_t)c * 64 + t) * 64 + 16 * fq;
        bf16x8 rf[2], sf[4][2];
#pragma unroll
        for (int ks = 0; ks < 2; ++ks) rf[ks] = *(const bf16x8*)(RP + (size_t)cid * 4096 + (tt * 2 + ks) * 512 + (fr * 4 + fq) * 8);
#pragma unroll
        for (int n = 0; n < 4; ++n)
#pragma unroll
            for (int ks = 0; ks < 2; ++ks) sf[n][ks] = *(const bf16x8*)(ST + (size_t)cid * 4096 + (n * 2 + ks) * 512 + (fr * 4 + fq) * 8);
        const u32x4 ol0 = *(const u32x4*)(OL + (size_t)cid * 4096 + t * 64 + 16 * fq), ol1 = *(const u32x4*)(OL + (size_t)cid * 4096 + t * 64 + 16 * fq + 8);
        const u32x4 v0 = *(const u32x4*)(Vb + oh), v1 = *(const u32x4*)(Vb + oh + 8), g0 = *(const u32x4*)(GG + oh), g1 = *(const u32x4*)(GG + oh + 8);
        const float bon = BONUS[tok * NH + h];
        f32x4 acc[4];
        acc[0] = (f32x4){lo2f(ol0[0]), hi2f(ol0[0]), lo2f(ol0[1]), hi2f(ol0[1])}; acc[1] = (f32x4){lo2f(ol0[2]), hi2f(ol0[2]), lo2f(ol0[3]), hi2f(ol0[3])};
        acc[2] = (f32x4){lo2f(ol1[0]), hi2f(ol1[0]), lo2f(ol1[1]), hi2f(ol1[1])}; acc[3] = (f32x4){lo2f(ol1[2]), hi2f(ol1[2]), lo2f(ol1[3]), hi2f(ol1[3])};
#pragma unroll
        for (int n = 0; n < 4; ++n)
#pragma unroll
            for (int ks = 0; ks < 2; ++ks) acc[n] = __builtin_amdgcn_mfma_f32_16x16x32_bf16(sf[n][ks], rf[ks], acc[n], 0, 0, 0);
        float s = 0.f;
#pragma unroll
        for (int n = 0; n < 4; ++n) s += (acc[n][0] + acc[n][1]) + (acc[n][2] + acc[n][3]);
        s += __shfl_xor(s, 16); s += __shfl_xor(s, 32);
        const float mean = s * (1.0f / 64.0f);
        float q = 0.f;
#pragma unroll
        for (int n = 0; n < 4; ++n)
#pragma unroll
            for (int e = 0; e < 4; ++e) { const float d = acc[n][e] - mean; q += d * d; }
        q += __shfl_xor(q, 16); q += __shfl_xor(q, 32);
        const float rstd = rsqrtf(q * (1.0f / 64.0f) + 64e-5f);
        const int chn = h * 64 + 16 * fq;
        u32x4 o0, o1;
#pragma unroll
        for (int n = 0; n < 4; ++n) {
            const f32x4 lg = *(const f32x4*)(F.in[I_LNG] + chn + 4 * n), lb = *(const f32x4*)(F.in[I_LNB] + chn + 4 * n);
            const unsigned vw0 = n < 2 ? v0[2 * n] : v1[2 * n - 4], vw1 = n < 2 ? v0[2 * n + 1] : v1[2 * n - 3], gw0 = n < 2 ? g0[2 * n] : g1[2 * n - 4], gw1 = n < 2 ? g0[2 * n + 1] : g1[2 * n - 3];
            const f32x4 vv = {lo2f(vw0), hi2f(vw0), lo2f(vw1), hi2f(vw1)}, gg = {lo2f(gw0), hi2f(gw0), lo2f(gw1), hi2f(gw1)};
            const f32x4 res = (((acc[n] - mean) * rstd) * lg + lb + vv * bon) * gg;
            const unsigned w0 = pack2(res[0], res[1]), w1 = pack2(res[2], res[3]);
            if (n == 0) { o0[0] = w0; o0[1] = w1; } else if (n == 1) { o0[2] = w0; o0[3] = w1; } else if (n == 2) { o1[0] = w0; o1[1] = w1; } else { o1[2] = w0; o1[3] = w1; }
        }
        *(u32x4*)(OG + tok * D + chn) = o0; *(u32x4*)(OG + tok * D + chn + 8) = o1;
    }
}

struct AttnTile { bf16x8 k[4][2]; bf16x8 v[4][2]; };
__device__ __forceinline__ void attn_load(AttnTile& tl, const bf16_t* kbase  , const bf16_t* vbase  ) {
#pragma unroll
    for (int kt = 0; kt < 4; ++kt)
#pragma unroll
        for (int ks = 0; ks < 2; ++ks) tl.k[kt][ks] = *(const bf16x8*)(kbase + (kt * 2 + ks) * 512);
#pragma unroll
    for (int dt = 0; dt < 4; ++dt)
#pragma unroll
        for (int ks = 0; ks < 2; ++ks) tl.v[dt][ks] = *(const bf16x8*)(vbase + (dt * 2 + ks) * 512);
}
template <bool MASK>
__device__ __forceinline__ void attn_tile(const AttnTile& tl, const bf16x8 (&qf)[2], f32x4 (&o)[4], float& R, int key0, int qpos, int fq) {
    constexpr float C2 = 0.125f * 1.4426950408889634f;
    f32x4 z[4];
#pragma unroll
    for (int kt = 0; kt < 4; ++kt) { z[kt] = (f32x4){0.f, 0.f, 0.f, 0.f};
#pragma unroll
        for (int ks = 0; ks < 2; ++ks) z[kt] = __builtin_amdgcn_mfma_f32_16x16x32_bf16(tl.k[kt][ks], qf[ks], z[kt], 0, 0, 0); }
    float sp[4][4], G[4];
#pragma unroll
    for (int kt = 0; kt < 4; ++kt) { G[kt] = 0.f;
#pragma unroll
        for (int e = 0; e < 4; ++e) { const float z2 = z[kt][e] * C2; z[kt][e] = z2;
            const float l2 = __builtin_amdgcn_logf(1.0f + __builtin_amdgcn_exp2f(z2));
            float spv = z2 > 30.f ? z2 : l2;
            if (MASK) spv = ((key0 + 16 * kt + 4 * fq + e) < qpos) ? spv : 0.f;
            sp[kt][e] = spv; G[kt] += spv; } }
    float sufg[4], tot[4];
#pragma unroll
    for (int kt = 0; kt < 4; ++kt) {
        const float g1 = __shfl_xor(G[kt], 16), g2 = __shfl_xor(G[kt], 32), g3 = __shfl_xor(G[kt], 48);
        tot[kt] = G[kt] + g1 + g2 + g3;
        sufg[kt] = (((fq ^ 1) > fq) ? g1 : 0.f) + (((fq ^ 2) > fq) ? g2 : 0.f) + (((fq ^ 3) > fq) ? g3 : 0.f);
    }
    float later = 0.f;
    union { bf16x8 v; unsigned w[4]; } p0, p1;
#pragma unroll
    for (int kt = 3; kt >= 0; --kt) {
        float run = R + later + sufg[kt];
        float wv[4];
#pragma unroll
        for (int e = 3; e >= 0; --e) { float w = __builtin_amdgcn_exp2f(z[kt][e] - sp[kt][e] - run);
            if (MASK) w = ((key0 + 16 * kt + 4 * fq + e) < qpos) ? w : 0.f;
            wv[e] = w; run += sp[kt][e]; }
        const unsigned w01 = pgx::cvt_pk_bf16(wv[0], wv[1]), w23 = pgx::cvt_pk_bf16(wv[2], wv[3]);
        if (kt == 0) { p0.w[0] = w01; p0.w[1] = w23; } else if (kt == 1) { p0.w[2] = w01; p0.w[3] = w23; } else if (kt == 2) { p1.w[0] = w01; p1.w[1] = w23; } else { p1.w[2] = w01; p1.w[3] = w23; }
        later += tot[kt];
    }
    R += later;
#pragma unroll
    for (int dt = 0; dt < 4; ++dt) {
        o[dt] = __builtin_amdgcn_mfma_f32_16x16x32_bf16(tl.v[dt][0], p0.v, o[dt], 0, 0, 0);
        o[dt] = __builtin_amdgcn_mfma_f32_16x16x32_bf16(tl.v[dt][1], p1.v, o[dt], 0, 0, 0);
    }
}
__device__ __forceinline__ void ph_attn(const Frame& F) {
    const bf16_t* Q = (const bf16_t*)(F.ws + WS_Q); const bf16_t* Kb = Q + (size_t)T * D; const bf16_t* VT = Q + (size_t)2 * T * D;
    bf16_t* AO = (bf16_t*)(F.ws + WS_AO);
    const int lane = F.lane, fr = lane & 15, fq = lane >> 4;
    const int nunits = NB * NH * (SEQ / 16);
    constexpr float EXIT2 = SB_EXIT * 1.4426950408889634f;
    unsigned* aq = F.ctl + CW_AQ;
    LAS unsigned* chunk_s = (LAS unsigned*)(F.lds + 1024);
    const unsigned myx = xb_xcc_id() & 7u;
    for (int qi = 0; qi < 8; ++qi) {
      const unsigned xq = (myx + (unsigned)qi) & 7u;
      for (;;) {
        __syncthreads();
        if (F.tid == 0) *chunk_s = atomicAdd(&aq[xq * 64], 1u);
        __syncthreads();
        const unsigned ck = *chunk_s;
        if (ck >= 256u) break;
        const int bh = (int)xq + 8 * (int)(ck >> 6), qt = (int)(ck & 63u) * 8 + F.wave;
        const int b = bh / NH, h = bh % NH;
        const int q0 = qt * 16, qpos = q0 + fr;
        const size_t tb = (size_t)b * SEQ;
        bf16x8 qf[2];
#pragma unroll
        for (int ks = 0; ks < 2; ++ks) qf[ks] = *(const bf16x8*)(Q + (tb + qpos) * D + h * 64 + ks * 32 + fq * 8);
        f32x4 o[4];
#pragma unroll
        for (int dt = 0; dt < 4; ++dt) o[dt] = (f32x4){0.f, 0.f, 0.f, 0.f};
        float R = 0.f;
        const bf16_t* kb = Kb + (size_t)bh * SEQ * 64 + (fr * 4 + fq) * 8;
        const bf16_t* vb = VT + (size_t)bh * SEQ * 64 + (fr * 4 + fq) * 8;
        int kt0 = (q0 + 15) / 64;
        AttnTile ta, tc;
        attn_load(ta, kb + (size_t)kt0 * 4096, vb + (size_t)kt0 * 4096);
        if (kt0 > 0) attn_load(tc, kb + (size_t)(kt0 - 1) * 4096, vb + (size_t)(kt0 - 1) * 4096);
        attn_tile<true>(ta, qf, o, R, kt0 * 64, qpos, fq);
        --kt0;
        while (kt0 >= 0 && !__all(R > EXIT2)) {
            if (kt0 > 0) attn_load(ta, kb + (size_t)(kt0 - 1) * 4096, vb + (size_t)(kt0 - 1) * 4096);
            attn_tile<false>(tc, qf, o, R, kt0 * 64, qpos, fq);
            --kt0;
            if (kt0 < 0 || __all(R > EXIT2)) break;
            if (kt0 > 0) attn_load(tc, kb + (size_t)(kt0 - 1) * 4096, vb + (size_t)(kt0 - 1) * 4096);
            attn_tile<false>(ta, qf, o, R, kt0 * 64, qpos, fq);
            --kt0;
        }
#pragma unroll
        for (int dt = 0; dt < 4; ++dt) st_bf4(AO + (tb + qpos) * D + h * 64 + 16 * dt + 4 * fq, o[dt]);
      }
    }
}

#ifndef USE_PGX
#define USE_PGX 0x1f
#endif
__device__ __forceinline__ int px_unit_index(int i, int G, int c, int nwg) {
    const long L = (long)i * G + c; if (L >= nwg) return -1;
    const int w = (int)L, q = nwg / 8, r = nwg % 8, xcd = w % 8, off = w / 8;
    return (xcd < r ? xcd * (q + 1) : r * (q + 1) + (xcd - r) * q) + off;
}
struct PxDense {
    const char* A; const char* B; int nM, nN, K, G, c; unsigned lda; int a_div; size_t a_stride;
    __device__ __forceinline__ bool next(int i, pgx::Unit& u) const {
        const int w = px_unit_index(i, G, c, nM * nN); if (w < 0) return false;
        const int pm = w / nN, pn = w % nN;
        u.A = A + (size_t)(pn / a_div) * a_stride + (size_t)pm * 256 * lda; u.tok = nullptr; u.B = B + (size_t)pn * 256 * K * 2; u.r0 = pm * 256; u.c0 = pn * 256; u.aux = 0; return true;
    }
};
__device__ __forceinline__ void px_store_bf16_perm(bf16_t* rowp, const f32x4& v0, const f32x4& v1) {
    u32x4 w; w.x = pgx::cvt_pk_bf16(v0[0], v0[1]); w.y = pgx::cvt_pk_bf16(v0[2], v0[3]); w.z = pgx::cvt_pk_bf16(v1[0], v1[1]); w.w = pgx::cvt_pk_bf16(v1[2], v1[3]); *(u32x4*)rowp = w;
}
__device__ __forceinline__ void ph_rkv_px(const Frame& F) {
    bf16_t* RKV = (bf16_t*)(F.ws + WS_RKV);
    PxDense S{(const char*)(F.ws + WS_XS), (const char*)(F.ws + WS_WRKV), 64, 12, D, F.G, F.bid, (unsigned)(D * 2), 4, (size_t)T * D * 2};
    pgx::gemm_phase<true, true>(F.lds, D, D * 2, S, [&](const f32x4 (&acc)[2][2][4][2], const pgx::Unit& u, int wr, int wc, int fr, int fq) {
        bf16_t* base = RKV + (size_t)(u.c0 / D) * T * D;
#pragma unroll
        for (int ai = 0; ai < 2; ++ai)
#pragma unroll
            for (int m = 0; m < 4; ++m) { const int t = u.r0 + ai * 128 + wr * 64 + m * 16 + fr;
#pragma unroll
                for (int bj = 0; bj < 2; ++bj) px_store_bf16_perm(base + hm_off(t, (u.c0 % D) + bj * 128 + wc * 32 + 8 * fq), acc[ai][bj][m][0], acc[ai][bj][m][1]); }
    });
}
__device__ __forceinline__ void ph_lora_dn_sg(const Frame& F) {
    const bf16_t* XS = (const bf16_t*)(F.ws + WS_XS); const bf16_t* WLDN = (const bf16_t*)(F.ws + WS_WLDN); bf16_t* LORA = (bf16_t*)(F.ws + WS_LORA);
    for (int u = F.bid; u < 64 * 4; u += F.G) {
        const int mt = u / 4, j = u % 4, n = (j == 0) ? 3 : (j == 1 ? 4 : 5);
        ASeg A; A.p[0] = XS + ((size_t)n * T + mt * 256) * D; A.p[1] = A.p[0]; A.p[2] = A.p[0]; A.segTiles = 16;
        bf16_t* out = LORA + (size_t)mt * 256 * 256 + j * 64;
        sg_tile<64>(F.lds, A, [](int R) { return (unsigned)R * (D * 2); }, WLDN + (size_t)(j * 64) * D, D, 16,
            [&](auto& acc, int r0, int c0, int fr, int fq) {
#pragma unroll
                for (int m = 0; m < EPI_MT(acc); ++m)
#pragma unroll
                    for (int q = 0; q < 4; ++q) { f32x4 v = acc[m][q];
                        if (j == 0) {
#pragma unroll
                            for (int e = 0; e < 4; ++e) v[e] = tanhf_(v[e]); }
                        else if (j >= 2) {
#pragma unroll
                            for (int e = 0; e < 4; ++e) v[e] = sigmoidf_(v[e]); }
                        st_bf4(out + (size_t)(r0 + 16 * m + fr) * 256 + c0 + 16 * q + 4 * fq, v); }
            });
    }
}
__device__ __forceinline__ void ph_dense_bf16_px(const Frame& F, const bf16_t* Ain, const bf16_t* Wt, bf16_t* out) {
    PxDense S{(const char*)Ain, (const char*)Wt, 64, 4, D, F.G, F.bid, (unsigned)(D * 2), 4, 0};
    pgx::gemm_phase<true, true>(F.lds, D, D * 2, S, [&](const f32x4 (&acc)[2][2][4][2], const pgx::Unit& u, int wr, int wc, int fr, int fq) {
        bf16_t* base = out + u.c0 + wc * 32 + 8 * fq;
#pragma unroll
        for (int ai = 0; ai < 2; ++ai)
#pragma unroll
            for (int m = 0; m < 4; ++m) { bf16_t* rowp = base + (size_t)(u.r0 + ai * 128 + wr * 64 + m * 16 + fr) * D;
#pragma unroll
                for (int bj = 0; bj < 2; ++bj) px_store_bf16_perm(rowp + bj * 128, acc[ai][bj][m][0], acc[ai][bj][m][1]); }
    });
}
__device__ __forceinline__ void ph_qkv_px(const Frame& F) {
    bf16_t* QK = (bf16_t*)(F.ws + WS_Q); bf16_t* VT = QK + (size_t)2 * T * D;
    { PxDense S{(const char*)(F.ws + WS_H3), (const char*)(F.ws + WS_WQKV), 64, 8, D, F.G, F.bid, (unsigned)(D * 2), 8, 0};
      pgx::gemm_phase<true, true>(F.lds, D, D * 2, S, [&](const f32x4 (&acc)[2][2][4][2], const pgx::Unit& u, int wr, int wc, int fr, int fq) {
        const bool isk = u.c0 >= D;
#pragma unroll
        for (int ai = 0; ai < 2; ++ai)
#pragma unroll
            for (int m = 0; m < 4; ++m) { const int t = u.r0 + ai * 128 + wr * 64 + m * 16 + fr;
#pragma unroll
                for (int bj = 0; bj < 2; ++bj) { const int c = (u.c0 % D) + bj * 128 + wc * 32 + 8 * fq;
                    const int sq = t % SEQ, dd = c & 63;
                    bf16_t* dst = isk ? QK + (size_t)T * D + (((size_t)((t / SEQ) * NH + (c >> 6)) * (SEQ / 16) + (sq >> 4)) * 2 + (dd >> 5)) * 512 + (sq & 15) * 32 + (dd & 31) : QK + (size_t)t * D + c;
                    px_store_bf16_perm(dst, acc[ai][bj][m][0], acc[ai][bj][m][1]); } }
      }); }
    { PxDense S{(const char*)(F.ws + WS_H3), (const char*)(F.ws + WS_WQKV) + (size_t)2 * D * D * 2, 64, 4, D, F.G, F.bid, (unsigned)(D * 2), 4, 0};
      pgx::gemm_phase<false, false>(F.lds, D, D * 2, S, [&](const f32x4 (&acc)[2][2][4][2], const pgx::Unit& u, int wr, int wc, int fr, int fq) {
#pragma unroll
        for (int ai = 0; ai < 2; ++ai)
#pragma unroll
            for (int m = 0; m < 4; ++m) { const int t = u.r0 + ai * 128 + wr * 64 + m * 16 + 4 * fq, b = t / SEQ, sidx = t % SEQ;
#pragma unroll
                for (int bj = 0; bj < 2; ++bj)
#pragma unroll
                    for (int n = 0; n < 2; ++n) { const int c = u.c0 + bj * 128 + wc * 32 + n * 16 + fr, h = c >> 6, d = c & 63;
                        const int k6 = sidx & 63, kk = k6 & 31;
                        st_bf4(VT + ((size_t)(b * NH + h) * (SEQ / 64) + (sidx >> 6)) * 4096 + ((d >> 4) * 2 + (k6 >> 5)) * 512 + ((d & 15) * 4 + ((kk & 15) >> 2)) * 8 + (kk >> 4) * 4, acc[ai][bj][m][n]); } }
      }); }
}
struct PxMoe {
    const char* Asrc; const int* TOK; const int* TILEE; const char* W; int routed, nmt, nN, K, G, c; unsigned lda; size_t wexp; bool gather;
    __device__ __forceinline__ bool next(int i, pgx::Unit& u) const {
        const int w = px_unit_index(i, G, c, nmt * nN); if (w < 0) return false;
        const int mt = w / nN, pn = w % nN, row0 = mt * 256; const bool sh = row0 >= routed; const int e = sh ? 64 : TILEE[mt];
        if (gather) { if (sh) { u.A = Asrc + (size_t)(row0 - routed) * lda; u.tok = nullptr; } else { u.A = Asrc; u.tok = TOK + row0; } }
        else { u.A = Asrc + (size_t)row0 * lda; u.tok = nullptr; }
        u.B = W + (size_t)e * wexp + (size_t)pn * 256 * K * 2; u.r0 = row0; u.c0 = pn * 256; u.aux = 0; return true;
    }
};
__device__ __forceinline__ void ph_gateup_px(const Frame& F) {
    bf16_t* HB = (bf16_t*)(F.ws + WS_HB); const int* START = (const int*)(F.ws + WS_START);
    const int routed = START[65], nmt = (routed + T) / 256;
    PxMoe S{(const char*)(F.ws + WS_H2), (const int*)(F.ws + WS_TOK), (const int*)(F.ws + WS_TILEE), (const char*)(F.ws + WS_WGU), routed, nmt, 2, D, F.G, F.bid, (unsigned)(D * 2), (size_t)512 * D * 2, true};
    pgx::gemm_phase<true, true>(F.lds, D, D * 2, S, [&](const f32x4 (&acc)[2][2][4][2], const pgx::Unit& u, int wr, int wc, int fr, int fq) {
        bf16_t* base = HB + (u.c0 >> 1) + wc * 32 + 8 * fq;
#pragma unroll
        for (int ai = 0; ai < 2; ++ai)
#pragma unroll
            for (int m = 0; m < 4; ++m) { f32x4 v[2];
#pragma unroll
                for (int n = 0; n < 2; ++n)
#pragma unroll
                    for (int e = 0; e < 4; ++e) { const float g = acc[ai][0][m][n][e]; v[n][e] = g * sigmoidf_(g) * acc[ai][1][m][n][e]; }
                px_store_bf16_perm(base + (size_t)(u.r0 + ai * 128 + wr * 64 + m * 16 + fr) * DE, v[0], v[1]); }
    });
}
__device__ __forceinline__ void ph_down_px(const Frame& F) {
    bf16_t* YB = (bf16_t*)(F.ws + WS_YB); const int* START = (const int*)(F.ws + WS_START);
    const int routed = START[65], nmt = (routed + T) / 256;
    PxMoe S{(const char*)(F.ws + WS_HB), nullptr, (const int*)(F.ws + WS_TILEE), (const char*)(F.ws + WS_WDN), routed, nmt, 4, DE, F.G, F.bid, (unsigned)(DE * 2), (size_t)D * DE * 2, false};
    pgx::gemm_phase<true, true>(F.lds, DE, DE * 2, S, [&](const f32x4 (&acc)[2][2][4][2], const pgx::Unit& u, int wr, int wc, int fr, int fq) {
        unsigned char* base = (unsigned char*)YB + u.c0 + wc * 32 + 8 * fq;
#pragma unroll
        for (int ai = 0; ai < 2; ++ai)
#pragma unroll
            for (int m = 0; m < 4; ++m) { unsigned char* rowp = base + (size_t)(u.r0 + ai * 128 + wr * 64 + m * 16 + fr) * D;
#pragma unroll
                for (int bj = 0; bj < 2; ++bj) { u32x2 w;
                    w.x = pack_fp8x4(acc[ai][bj][m][0]); w.y = pack_fp8x4(acc[ai][bj][m][1]);
                    *(u32x2*)(rowp + bj * 128) = w; }
                asm volatile("" ::: "memory"); }
    });
}

__global__ void __launch_bounds__(NTHREADS, 2) mega(Args args) {
    extern __shared__ __attribute__((aligned(16))) unsigned char lds[];
    Frame F;
    F.in = args.in; F.out = args.out; F.ws = args.ws; F.ctl = (unsigned*)(args.ws + WS_CTL);
    F.ldsf = (float*)lds; F.lds = (LAS unsigned char*)lds;
    F.tid = threadIdx.x; F.lane = F.tid & 63; F.wave = __builtin_amdgcn_readfirstlane(F.tid >> 6); F.bid = blockIdx.x; F.G = gridDim.x;
    if (F.tid < 4) ((unsigned*)(lds + LDS_BYTES - 64))[F.tid] = 0u;
    __syncthreads();
    XcdBarrier bar; bar.bar = F.ctl + CW_BAR; bar.x = 0; bar.st = (volatile LAS unsigned*)(lds + LDS_BYTES - 64);
#if MK_N_LAUNCHES == 1
    bar = xcd_barrier_post(F.ctl + CW_BAR, (volatile LAS unsigned*)(lds + LDS_BYTES - 64));
#endif
    const int lo = args.ph_lo, hi = args.ph_hi;
#define IN(k) (lo <= (k) && (k) < hi)
#ifndef PROBE_MASK
#define PROBE_MASK 0u
#endif
    volatile unsigned long long* tsl = (volatile unsigned long long*)(lds + LDS_BYTES - 64 - 32 * 8);
#define STAMP(k) do { if (PROBE_MASK != 0u && F.tid == 0) tsl[(k)] = __builtin_amdgcn_s_memrealtime(); } while (0)
#define SEAM(k) do { if (IN(k) && IN((k) + 1)) xcd_barrier(bar); STAMP((k) + 1); } while (0)
    STAMP(0);
    bf16_t* const wsb = (bf16_t*)args.ws;
    (void)wsb;
#ifndef REP_A
#define REP_A 1
#endif
#ifndef REP_B
#define REP_B 1
#endif
#ifndef REP_C
#define REP_C 1
#endif
#ifndef REP_D
#define REP_D 1
#endif
#ifndef REP_E
#define REP_E 1
#endif
#ifndef REP_F
#define REP_F 1
#endif
#ifndef REP_G
#define REP_G 1
#endif
#ifndef REP_H
#define REP_H 1
#endif
#define RUN(n, body) for (int r_ = 0; r_ < (n); ++r_) { body; }
    if (IN(0)) { RUN(REP_D, ph_mod(F)) RUN(REP_G, conv_dense(F, F.bid, F.G)) if (F.G <= 2 * NB * NH) conv_moe(F, 0, F.bid, F.G); } SEAM(0);
    if (IN(1)) { RUN(REP_E, ph_prenorm_rwkv(F)) } SEAM(1);
    if (IN(2)) { RUN(REP_A, ph_rkv_px(F); ph_lora_dn_sg(F)) } SEAM(2);
    if (IN(3)) { RUN(REP_F, ph_lora_up_sg(F)) } SEAM(3);
    if (IN(4)) { RUN(REP_B, ph_wkv_chunk(F)) } SEAM(4);
    if (IN(5)) { if (F.bid < NB * NH || F.G <= 2 * NB * NH) { RUN(REP_B, ph_wkv_carry(F)) } else conv_moe(F, 0, F.bid - NB * NH, F.G - NB * NH); } SEAM(5);
    if (IN(6)) { RUN(REP_B, ph_wkv_out(F)) } SEAM(6);
    if (IN(7)) { RUN(REP_A, ph_dense_bf16_px(F, (const bf16_t*)(F.ws + WS_OG), (const bf16_t*)(F.ws + WS_WO), (bf16_t*)(F.ws + WS_Y1))) } SEAM(7);
    if (IN(8)) { RUN(REP_E, ph_postmix_preffn(F, 0, F.in[I_X], (const bf16_t*)(F.ws + WS_Y1))) } SEAM(8);
    if (IN(9)) { RUN(REP_F, ph_router_sg(F, 0)) } SEAM(9);
    if (IN(10)) { ph_topk(F, 0); } SEAM(10);
    if (IN(11)) { ph_offsets(F, 0); } SEAM(11);
    if (IN(12)) { RUN(REP_A, ph_gateup_px(F)) } SEAM(12);
    if (IN(13)) { RUN(REP_A, ph_down_px(F)) } SEAM(13);
    if (IN(14)) { RUN(1, ph_combine(F, 0, true)) RUN(REP_H, conv_moe(F, 1, F.bid, F.G)) } SEAM(14);
    if (IN(15)) { RUN(REP_A, ph_qkv_px(F)) } SEAM(15);
    if (IN(16)) { RUN(REP_C, ph_attn(F)) } SEAM(16);
    if (IN(17)) { RUN(REP_A, ph_dense_bf16_px(F, (const bf16_t*)(F.ws + WS_AO), (const bf16_t*)(F.ws + WS_WSBO), (bf16_t*)(F.ws + WS_Y1B))) } SEAM(17);
    if (IN(18)) { ph_postmix_preffn(F, 1, F.out, (const bf16_t*)(F.ws + WS_Y1B)); } SEAM(18);
    if (IN(19)) { RUN(REP_F, ph_router_sg(F, 1)) } SEAM(19);
    if (IN(20)) { ph_topk(F, 1); } SEAM(20);
    if (IN(21)) { ph_offsets(F, 1); } SEAM(21);
    if (IN(22)) { RUN(REP_A, ph_gateup_px(F)) } SEAM(22);
    if (IN(23)) { RUN(REP_A, ph_down_px(F)) } SEAM(23);
    if (IN(24)) { ph_combine(F, 1, false); }
    if (PROBE_MASK != 0u) {
        __syncthreads();
        if (F.bid == 0 && F.tid == 0) { const unsigned long long t1 = __builtin_amdgcn_s_memrealtime(); unsigned long long sel = 0;
            for (int k = 0; k < NPHASES; ++k) { const unsigned long long e = (k + 1 < NPHASES) ? tsl[k + 1] : t1; if ((PROBE_MASK >> k) & 1u) sel += e - tsl[k]; }
            F.out[0] += 1000.0f * (float)sel / (float)(t1 - tsl[0]); }
    }
#undef IN
#undef SEAM
}

extern "C" void kernel_launch(void* const* d_in, const int* in_sizes, int n_in, void* d_out, int out_size, void* d_ws, size_t ws_size, hipStream_t stream) {
    static int grid = 0;
    if (grid == 0) {
        if (n_in != 34 || in_sizes[0] != T * D || out_size != T * D || ws_size < WS_END) {
            fprintf(stderr, "kernel_launch: unexpected shapes: n_in %d in0 %d out %d ws %zu (need %zu)\n", n_in, n_in > 0 ? in_sizes[0] : -1, out_size, ws_size, (size_t)WS_END);
            grid = -1; return;
        }
        int dev = 0, cus = 0, per_cu = 0;
        if (hipGetDevice(&dev) != hipSuccess || hipDeviceGetAttribute(&cus, hipDeviceAttributeMultiprocessorCount, dev) != hipSuccess) { grid = -1; return; }
        if (hipFuncSetAttribute((const void*)mega, hipFuncAttributeMaxDynamicSharedMemorySize, LDS_BYTES) != hipSuccess) { fprintf(stderr, "kernel_launch: hipFuncSetAttribute failed\n"); grid = -1; return; }
        if (hipOccupancyMaxActiveBlocksPerMultiprocessor(&per_cu, (const void*)mega, NTHREADS, LDS_BYTES) != hipSuccess || per_cu < 1)
            fprintf(stderr, "kernel_launch: occupancy query reports %d blocks per CU\n", per_cu);
        (void)hipGetLastError();
        grid = cus;
    }
    if (grid < 0) return;
    if (hipMemsetAsync((char*)d_ws + WS_CTL, 0, CTL_BYTES, stream) != hipSuccess) { fprintf(stderr, "kernel_launch: memset failed\n"); return; }
    Args a{};
    for (int i = 0; i < 34; ++i) a.in[i] = (const float*)d_in[i];
    a.out = (float*)d_out; a.ws = (unsigned char*)d_ws;
#if MK_N_LAUNCHES == 1
    a.ph_lo = 0; a.ph_hi = NPHASES;
    hipLaunchKernelGGL(mega, dim3(grid), dim3(NTHREADS), LDS_BYTES, stream, a);
#else
    for (int p = 0; p < NPHASES; ++p) { a.ph_lo = p; a.ph_hi = p + 1; hipLaunchKernelGGL(mega, dim3(grid), dim3(NTHREADS), LDS_BYTES, stream, a); }
#endif
    const hipError_t le = hipPeekAtLastError();
    if (le != hipSuccess) fprintf(stderr, "kernel_launch: launch failed: %s\n", hipGetErrorName(le));
}
```

```cpp
#include <hip/hip_runtime.h>
#include <cstdio>
#include <cstdint>

#ifndef MK_N_LAUNCHES
#define MK_N_LAUNCHES 1
#endif

constexpr int T = 16384, D = 1024, SEQ = 8192, NB = 2, NH = 16, HD = 64;
constexpr int NE = 64, TOPK = 8, DE = 256;
constexpr int RP = 256;
constexpr int MAXROUTED = 147456;
constexpr int MAXROWS = MAXROUTED + T;
constexpr int NTHREADS = 512, NWAVES = 8;
constexpr int NPHASES = 25;
constexpr int LDS_BYTES = 144 * 1024;
constexpr float YB_SCALE = 16.0f;

typedef unsigned short bf16_t;
typedef float f32x4 __attribute__((ext_vector_type(4)));
typedef unsigned u32x4 __attribute__((ext_vector_type(4)));
typedef unsigned u32x2 __attribute__((ext_vector_type(2)));

__device__ __forceinline__ float bf2f(bf16_t b) { return __uint_as_float(((unsigned)b) << 16); }
typedef __bf16 bf16x2_t __attribute__((ext_vector_type(2)));
typedef float f32x2 __attribute__((ext_vector_type(2)));
__device__ __forceinline__ unsigned pack2(float a, float b) { const f32x2 v = {a, b}; const bf16x2_t r = __builtin_convertvector(v, bf16x2_t); return __builtin_bit_cast(unsigned, r); }
__device__ __forceinline__ bf16_t f2bf(float f) { return (bf16_t)(pack2(f, 0.f) & 0xffffu); }
__device__ __forceinline__ float lo2f(unsigned u) { return __uint_as_float(u << 16); }
__device__ __forceinline__ float hi2f(unsigned u) { return __uint_as_float(u & 0xffff0000u); }
__device__ __forceinline__ f32x4 ld4_g(const bf16_t* p) { const u32x2 w = *(const u32x2*)p; return (f32x4){lo2f(w.x), hi2f(w.x), lo2f(w.y), hi2f(w.y)}; }
__device__ __forceinline__ float fexp_(float x) { return __builtin_amdgcn_exp2f(x * 1.4426950408889634f); }
__device__ __forceinline__ float sigmoidf_(float x) { return __builtin_amdgcn_rcpf(1.0f + fexp_(-x)); }
__device__ __forceinline__ float tanhf_(float x) { return 1.0f - 2.0f * __builtin_amdgcn_rcpf(1.0f + fexp_(2.0f * x)); }
__device__ __forceinline__ float softplusf_(float x) { const float e = fexp_(x); const float l = __builtin_amdgcn_logf(1.0f + e) * 0.6931471805599453f; return x > 15.f ? x : (x < -8.f ? e : l); }
__device__ __forceinline__ float wave_sum(float v) {
#pragma unroll
    for (int o = 32; o >= 1; o >>= 1) v += __shfl_xor(v, o);
    return v;
}

constexpr size_t MiB = 1024 * 1024;
constexpr size_t WS_CTL    = 0;
constexpr size_t CTL_BYTES = 64 * 1024;
constexpr size_t WS_MOD    = 64 * 1024;
constexpr size_t WS_IDX    = 256 * 1024;
constexpr size_t WS_GATE   = WS_IDX + 512 * 1024;
constexpr size_t WS_RANK   = WS_GATE + 512 * 1024;
constexpr size_t WS_POS    = WS_RANK + 512 * 1024;
constexpr size_t WS_TOK    = WS_POS + 512 * 1024;
constexpr size_t WS_TILEE  = WS_TOK + 704 * 1024;
constexpr size_t WS_START  = WS_TILEE + 4096;
constexpr size_t WS_LOGITS = 8 * MiB + 64 * MiB;
constexpr size_t WS_BC     = 4 * MiB;
constexpr size_t WS_BIG    = 8 * MiB;
constexpr size_t WS_XS   = WS_BIG;
constexpr size_t WS_RKV  = WS_BIG + 192 * MiB;
constexpr size_t WS_LORA = WS_BIG + 288 * MiB;
constexpr size_t WS_LD   = WS_BIG;
constexpr size_t WS_AA   = WS_BIG + 64 * MiB;
constexpr size_t WS_GG   = WS_BIG + 96 * MiB;
constexpr size_t WS_O    = WS_BIG + 128 * MiB;
constexpr size_t WS_OG   = WS_BIG + 296 * MiB;
constexpr size_t WS_Y1   = WS_BIG + 328 * MiB;
constexpr size_t WS_H2   = WS_BIG;
constexpr size_t WS_H2LO = WS_BIG + 32 * MiB;
constexpr size_t WS_YB   = WS_BIG;
constexpr size_t WS_HB   = WS_BIG + 320 * MiB;
constexpr size_t WS_H3   = WS_BIG + 320 * MiB;
constexpr size_t WS_Q    = WS_BIG;
constexpr size_t WS_AO   = WS_BIG + 96 * MiB;
constexpr size_t WS_XR   = WS_BIG + 256 * MiB;
constexpr size_t WS_Y1B  = WS_BIG + 128 * MiB;
constexpr size_t WS_W     = WS_BIG + 400 * MiB;
constexpr size_t WS_WGU1  = WS_BIG + 192 * MiB;
constexpr size_t WS_WGU   = WS_W;
constexpr size_t WS_WDN   = WS_WGU + (size_t)65 * 512 * 1024 * 2;
constexpr size_t WS_WRKV  = WS_WDN + (size_t)65 * 1024 * 256 * 2;
constexpr size_t WS_WO    = WS_WRKV + (size_t)3072 * 1024 * 2;
constexpr size_t WS_WQKV  = WS_WO + (size_t)1024 * 1024 * 2;
constexpr size_t WS_WSBO  = WS_WQKV + (size_t)3072 * 1024 * 2;
constexpr size_t WS_WLDN  = WS_WSBO + (size_t)1024 * 1024 * 2;
constexpr size_t WS_WLUP  = WS_WLDN + (size_t)256 * 1024 * 2;
constexpr size_t WS_WRT   = WS_WLUP + (size_t)1024 * 256 * 2;
constexpr size_t WS_END   = WS_WRT + (size_t)2 * 64 * 3072 * 2;

constexpr int CW_BAR = 0;
constexpr int CW_CNT = 4096;
constexpr int CW_AQ = 4608;

#define XB_TMO      128
#define XB_XCNT(j)  (256  + 64 * (j))
#define XB_XSUB(j)  (1280 + 64 * (j))
#define XB_XGEN(j)  (2304 + 64 * (j))
#define XB_TOP      3328
#define XB_TOPGEN   3392
#define XCD_BAR_WORDS 3456
#define XB_SPIN_CAP (1u << 22)
#define LAS __attribute__((address_space(3)))

__device__ __forceinline__ unsigned xb_ld(unsigned* p)              { return __hip_atomic_load(p, __ATOMIC_RELAXED, __HIP_MEMORY_SCOPE_AGENT); }
__device__ __forceinline__ unsigned xb_add(unsigned* p, unsigned v) { return __hip_atomic_fetch_add(p, v, __ATOMIC_RELAXED, __HIP_MEMORY_SCOPE_AGENT); }
__device__ __forceinline__ unsigned xb_xcc_id() { return (unsigned)__builtin_amdgcn_s_getreg((3 << 11) | 20) & 0xFu; }
#define XB_SPIN(cond, bar) do { unsigned _sp = 0; while (cond) { __builtin_amdgcn_s_sleep(1); \
    if ((++_sp & 255u) == 0u) { if (xb_ld(&(bar)[XB_TMO])) break; if (_sp > XB_SPIN_CAP) { atomicAdd(&(bar)[XB_TMO], 1u); break; } } } } while (0)

struct XcdBarrier { unsigned* bar; unsigned x; volatile LAS unsigned* st; };

__device__ __forceinline__ XcdBarrier xcd_barrier_post(unsigned* bar, volatile LAS unsigned* st) {
    XcdBarrier b; b.bar = bar; b.x = xb_xcc_id(); b.st = st;
    if (threadIdx.x == 0) (void)xb_add(&bar[XB_XCNT(b.x)], 1u);
    return b;
}
__device__ __forceinline__ void xcd_barrier_complete(unsigned* bar, unsigned x, unsigned& nloc, unsigned& nx) {
    const unsigned G = gridDim.x * gridDim.y * gridDim.z;
    unsigned sum, cnt, mine, sp = 0u;
    for (;;) {
        sum = 0u; cnt = 0u; mine = 0u;
#pragma unroll
        for (unsigned j = 0; j < 16; ++j) { const unsigned c = xb_ld(&bar[XB_XCNT(j)]); sum += c; cnt += (c > 0u) ? 1u : 0u; mine = (j == x) ? c : mine; }
        if (sum == G) break;
        __builtin_amdgcn_s_sleep(1);
        if ((++sp & 255u) == 0u) { if (xb_ld(&bar[XB_TMO])) break; if (sp > XB_SPIN_CAP) { atomicAdd(&bar[XB_TMO], 1u); break; } }
    }
    nloc = mine > 0u ? mine : 1u; nx = cnt > 0u ? cnt : 1u;
}
__device__ __forceinline__ void xcd_barrier(const XcdBarrier& b) {
    asm volatile("s_waitcnt vmcnt(0)" ::: "memory");
    __syncthreads();
    if (threadIdx.x == 0) {
        unsigned* bar = b.bar;
        __builtin_amdgcn_s_waitcnt(0);
        unsigned nloc = b.st[0], nx = b.st[1];
        if (nloc == 0u) { xcd_barrier_complete(bar, b.x, nloc, nx); b.st[0] = nloc; b.st[1] = nx; }
        const unsigned old = xb_add(&bar[XB_XSUB(b.x)], 1u);
        const unsigned gen = old / nloc;
        if (old + 1u == (gen + 1u) * nloc) {
            __builtin_amdgcn_fence(__ATOMIC_RELEASE, "agent");
            asm volatile("s_waitcnt vmcnt(0)" ::: "memory");
            const unsigned og = xb_add(&bar[XB_TOP], 1u);
            const unsigned tg = og / nx;
            if (og + 1u == (tg + 1u) * nx) xb_add(&bar[XB_TOPGEN], 1u);
            else XB_SPIN(xb_ld(&bar[XB_TOPGEN]) == tg, bar);
            __builtin_amdgcn_fence(__ATOMIC_ACQUIRE, "agent");
            xb_add(&bar[XB_XGEN(b.x)], 1u);
            asm volatile("s_waitcnt vmcnt(0)" ::: "memory");
        } else {
            XB_SPIN(xb_ld(&bar[XB_XGEN(b.x)]) == gen, bar);
            __builtin_amdgcn_fence(__ATOMIC_ACQUIRE, "agent");
            asm volatile("s_waitcnt vmcnt(0)" ::: "memory");
        }
    }
    __syncthreads();
}

struct Args { const float* in[34]; float* out; unsigned char* ws; int ph_lo, ph_hi; };

struct Frame {
    const float* const* in; float* out; unsigned char* ws; unsigned* ctl;
    float* ldsf; LAS unsigned char* lds; int tid, lane, wave, bid, G;
};

enum { I_X = 0, I_C, I_ADAW, I_ADAB, I_NPM, I_NPOM, I_NPF, I_NPOF, I_MU, I_WRKV, I_WW1, I_WW2, I_W0, I_WA1, I_WA2, I_A0, I_WG1, I_WG2,
       I_KK, I_KA, I_RK, I_LNG, I_LNB, I_WO, I_SBQKV, I_SBO, I_ROUTER, I_RBIAS, I_MG, I_MU_, I_MD, I_SG, I_SU, I_SD };


typedef short bf16x8 __attribute__((ext_vector_type(8)));
typedef short s16x4 __attribute__((ext_vector_type(4)));
constexpr int HTB = 128 * 64 * 2;
__device__ __forceinline__ int lds_byte(int r, int c) { const int st = (r >> 4) * 2 + (c >> 5), rr = r & 15, cc = c & 31, ob = rr * 64 + cc * 2; return st * 1024 + (ob ^ (((ob >> 9) & 1) << 5)); }
__device__ __forceinline__ void stage_rc(int b, int& R, int& C) { const int st = b / 1024, sb = b % 1024, swz = sb ^ (((sb >> 9) & 1) << 5); R = (st >> 1) * 16 + swz / 64; C = (st & 1) * 32 + (swz % 64) / 2; }
#define WAIT_V(n) asm volatile("s_waitcnt vmcnt(" #n ")" ::: "memory")
#define SBAR() do { asm volatile("" ::: "memory"); __builtin_amdgcn_s_barrier(); asm volatile("" ::: "memory"); } while (0)

struct ASeg { const bf16_t* p[3]; int segTiles; };

struct BRowId { __device__ __forceinline__ int operator()(int R) const { return R; } };
struct SgChain { int ph; bool pre; bool nvalid; ASeg nA; const bf16_t* nBt; int nldb; };
template <int BN, bool NSW = false, class ARow, class Epi, class BRow = BRowId>
__device__ __forceinline__ void sg_tile(LAS unsigned char* lds, const ASeg& A, const ARow& arow, const bf16_t* Bt, int ldb, int nt, const Epi& epi, const BRow& brow = BRow(), SgChain* ch = nullptr) {
    constexpr int WN = BN / 64, WM = 8 / WN, WR = 256 / WM, MT = WR / 16;
    int tid_ = threadIdx.x; asm volatile("" : "+v"(tid_));
    const int tid = tid_, wid = __builtin_amdgcn_readfirstlane(tid >> 6), lane = tid & 63, fr = lane & 15, fq = lane >> 4;
    const int wm = wid / WN, wn = wid % WN;
    unsigned aoffs[2][2], boffs[2];
#pragma unroll
    for (int i = 0; i < 2; ++i) { int R, C; stage_rc(tid * 16 + i * 8192, R, C);
        aoffs[0][i] = arow(R) + (unsigned)C * 2u; aoffs[1][i] = arow(128 + R) + (unsigned)C * 2u; boffs[i] = (unsigned)(brow(R) * ldb + C) * 2u; }
    const unsigned ldsw = (unsigned)wid * 1024u;
    f32x4 acc[MT][4];
#pragma unroll
    for (int m = 0; m < MT; ++m)
#pragma unroll
        for (int n = 0; n < 4; ++n) acc[m][n] = (f32x4){0.f, 0.f, 0.f, 0.f};
    const int arow0 = wm * WR, ah = arow0 >> 7, ar = arow0 & 127;
    const int aoff = ah * HTB + lds_byte(ar + fr, fq * 8), boff = 2 * HTB + lds_byte(wn * 64 + fr, fq * 8);
#define SG_STAGE_X(AX, BX, BO, kt, s) do { const int sg_ = (kt) / (AX).segTiles; const char* ab_ = (const char*)(sg_ == 0 ? (AX).p[0] : (sg_ == 1 ? (AX).p[1] : (AX).p[2])) + (size_t)((kt) - sg_ * (AX).segTiles) * 128; const char* bb_ = (const char*)(BX) + (size_t)(kt) * 128; \
        _Pragma("unroll") for (int h_ = 0; h_ < 2; ++h_) _Pragma("unroll") for (int i_ = 0; i_ < 2; ++i_) \
            __builtin_amdgcn_global_load_lds((const unsigned*)(ab_ + aoffs[h_][i_]), (LAS unsigned*)(lds + ((s) * 3 + h_) * HTB + ldsw + i_ * 8192), 16, 0, 0); \
        _Pragma("unroll") for (int i_ = 0; i_ < WN; ++i_) \
            __builtin_amdgcn_global_load_lds((const unsigned*)(bb_ + (BO)[i_]), (LAS unsigned*)(lds + ((s) * 3 + 2) * HTB + ldsw + i_ * 8192), 16, 0, 0); } while (0)
#define SG_STAGE(kt, s) SG_STAGE_X(A, Bt, boffs, kt, s)
    const int ph0 = ch ? ch->ph : 0;
    if (!(ch && ch->pre)) SG_STAGE(0, ph0);
    for (int t = 0; t < nt; ++t) {
        const int s = (ph0 + t) & 1;
        if (t + 1 < nt) { SG_STAGE(t + 1, s ^ 1); if (WN == 2) WAIT_V(6); else WAIT_V(5); }
        else if (ch && ch->nvalid) { unsigned nbo[2];
#pragma unroll
            for (int i = 0; i < 2; ++i) { int R, C; stage_rc(tid * 16 + i * 8192, R, C); nbo[i] = (unsigned)(brow(R) * ch->nldb + C) * 2u; }
            SG_STAGE_X(ch->nA, ch->nBt, nbo, 0, s ^ 1); if (WN == 2) WAIT_V(6); else WAIT_V(5); }
        else { WAIT_V(0); }
        SBAR();
        LAS unsigned char* base = lds + s * 3 * HTB;
#pragma unroll
        for (int k = 0; k < 2; ++k) {
            bf16x8 af[MT], bfr[4];
#pragma unroll
            for (int m = 0; m < MT; ++m) af[m] = *(const LAS bf16x8*)(base + aoff + m * 2048 + k * 1024);
#pragma unroll
            for (int n = 0; n < 4; ++n) bfr[n] = *(const LAS bf16x8*)(base + boff + n * 2048 + k * 1024);
#pragma unroll
            for (int m = 0; m < MT; ++m)
#pragma unroll
                for (int n = 0; n < 4; ++n) acc[m][n] = NSW ? __builtin_amdgcn_mfma_f32_16x16x32_bf16(af[m], bfr[n], acc[m][n], 0, 0, 0) : __builtin_amdgcn_mfma_f32_16x16x32_bf16(bfr[n], af[m], acc[m][n], 0, 0, 0);
        }
        SBAR();
    }
#undef SG_STAGE
#undef SG_STAGE_X
    if (ch) { ch->ph = (ph0 + nt) & 1; ch->pre = ch->nvalid; }
    epi(acc, arow0, wn * 64, fr, fq);
}

struct CTile { bf16_t* dst; const float* src; int dld, sld, ncols; float scale; };
template <class TF>
__device__ __forceinline__ void conv_tiles(const Frame& F, int ntiles, int u0, int ustride, const TF& tf) {
    unsigned* tl = (unsigned*)F.ldsf;
    const int i = F.tid & 31, kp0 = F.tid >> 5;
    if (u0 >= ntiles) return;
    CTile ct = tf(u0);
    f32x4 a[4], b[4];
#define CV_LOAD() do { _Pragma("unroll") for (int q = 0; q < 4; ++q) { const int kp = kp0 + 16 * q; \
        if (4 * i < ct.ncols) { a[q] = *(const f32x4*)(ct.src + (size_t)(2 * kp) * ct.sld + 4 * i); b[q] = *(const f32x4*)(ct.src + (size_t)(2 * kp + 1) * ct.sld + 4 * i); } } } while (0)
    CV_LOAD();
    for (int u = u0; u < ntiles; u += ustride) {
        const CTile cur = ct;
        if (4 * i < cur.ncols) {
#pragma unroll
            for (int q = 0; q < 4; ++q) { const int kp = kp0 + 16 * q;
#pragma unroll
                for (int e = 0; e < 4; ++e) tl[(4 * i + e) * 65 + kp] = pack2(a[q][e] * cur.scale, b[q][e] * cur.scale); }
        }
        __syncthreads();
        if (u + ustride < ntiles) { ct = tf(u + ustride); CV_LOAD(); }
        const int nb = F.tid >> 4, sgm = F.tid & 15;
#pragma unroll
        for (int q = 0; q < 4; ++q) { const int n = nb + 32 * q;
            if (n < cur.ncols) { u32x4 v;
#pragma unroll
                for (int e = 0; e < 4; ++e) v[e] = tl[n * 65 + sgm * 4 + e];
                *(u32x4*)(cur.dst + (size_t)n * cur.dld + sgm * 8) = v; } }
        __syncthreads();
    }
#undef CV_LOAD
}
__device__ __forceinline__ void conv_moe(const Frame& F, int layer, int parts, int u0, int ustride) {
    bf16_t* WGUr = (bf16_t*)(F.ws + (layer == 0 ? WS_WGU : WS_WGU1)); bf16_t* WGUs = (bf16_t*)(F.ws + WS_WGU) + (size_t)64 * 512 * D; bf16_t* WDN = (bf16_t*)(F.ws + WS_WDN);
    const float* const* in = F.in;
    const int nA = (parts & 1) ? 64 * 32 : 0, nB = (parts & 2) ? 32 + 65 * 16 : 0;
    conv_tiles(F, nA + nB, u0, ustride, [=](int u) {
        CTile c; c.ncols = 128;
        if (u < nA) { const int e = u >> 5, r = u & 31, up = r >> 4, kt = (r >> 1) & 7, nt = r & 1;
            const float* W = (up ? in[I_MU_] : in[I_MG]) + ((size_t)layer * NE + e) * D * DE;
            c.src = W + (size_t)kt * 128 * DE + nt * 128; c.sld = DE; c.dst = WGUr + ((size_t)e * 512 + nt * 256 + up * 128) * D + kt * 128; c.dld = D; c.scale = 1.0f; }
        else { const int v0 = u - nA;
            if (v0 < 32) { const int up = v0 >> 4, kt = (v0 >> 1) & 7, nt = v0 & 1;
                const float* W = (up ? in[I_SU] : in[I_SG]) + (size_t)layer * D * DE;
                c.src = W + (size_t)kt * 128 * DE + nt * 128; c.sld = DE; c.dst = WGUs + ((size_t)nt * 256 + up * 128) * D + kt * 128; c.dld = D; c.scale = 1.0f; }
            else { const int v1 = v0 - 32, e = v1 >> 4, v = v1 & 15, kt = v >> 3, nt = v & 7;
                const float* W = (e < 64) ? in[I_MD] + ((size_t)layer * NE + e) * DE * D : in[I_SD] + (size_t)layer * DE * D;
                c.src = W + (size_t)kt * 128 * D + nt * 128; c.sld = D; c.dst = WDN + ((size_t)e * D + nt * 128) * DE + kt * 128; c.dld = DE; c.scale = YB_SCALE; } }
        return c; });
}
__device__ __forceinline__ void conv_dense(const Frame& F, int part, int u0, int ustride) {
    bf16_t* WRKV = (bf16_t*)(F.ws + WS_WRKV); bf16_t* WO = (bf16_t*)(F.ws + WS_WO); bf16_t* WQKV = (bf16_t*)(F.ws + WS_WQKV); bf16_t* WSBO = (bf16_t*)(F.ws + WS_WSBO); bf16_t* WLDN = (bf16_t*)(F.ws + WS_WLDN);
    const float* const* in = F.in;
    const int gtid = u0 * NTHREADS + F.tid, gstride = ustride * NTHREADS;
    if (part == 0) {
        conv_tiles(F, 192 + 24, u0, ustride, [=](int u) {
            CTile c; c.dld = D; c.ncols = 128; c.scale = 1.0f;
            if (u < 192) { const int n = u / 64, kt = (u >> 3) & 7, nt = u & 7; c.src = in[I_WRKV] + (size_t)n * D * D + (size_t)kt * 128 * D + nt * 128; c.sld = D; c.dst = WRKV + ((size_t)n * D + nt * 128) * D + kt * 128; }
            else { const int v = u - 192, kt = v / 3, j = v % 3;
                if (j == 0) { c.src = in[I_WW1] + (size_t)kt * 128 * 64; c.sld = 64; c.dst = WLDN + kt * 128; c.ncols = 64; }
                else if (j == 1) { c.src = in[I_WA1] + (size_t)kt * 128 * 64; c.sld = 64; c.dst = WLDN + (size_t)64 * D + kt * 128; c.ncols = 64; }
                else { c.src = in[I_WG1] + (size_t)kt * 128 * 128; c.sld = 128; c.dst = WLDN + (size_t)128 * D + kt * 128; } }
            return c; });
        bf16_t* WLUP = (bf16_t*)(F.ws + WS_WLUP);
        for (int i = gtid; i < 1024 * 256; i += gstride) {
            float v;
            if (i < 1024 * 64) { const int n = i / 64, k = i % 64; v = F.in[I_WW2][k * D + n]; }
            else if (i < 2 * 1024 * 64) { const int j = i - 1024 * 64, n = j / 64, k = j % 64; v = F.in[I_WA2][k * D + n]; }
            else { const int j = i - 2 * 1024 * 64, n = j / 128, k = j % 128; v = F.in[I_WG2][k * D + n]; }
            WLUP[i] = f2bf(v);
        }
    } else {
        conv_tiles(F, 64 + 192 + 64, u0, ustride, [=](int u) {
            CTile c; c.dld = D; c.ncols = 128; c.scale = 1.0f;
            if (u < 64) { const int kt = u >> 3, nt = u & 7; c.src = in[I_WO] + (size_t)kt * 128 * D + nt * 128; c.sld = D; c.dst = WO + (size_t)nt * 128 * D + kt * 128; }
            else if (u < 256) { const int v = u - 64, kt = v / 24, nt = v % 24; c.src = in[I_SBQKV] + (size_t)kt * 128 * 3 * D + nt * 128; c.sld = 3 * D; c.dst = WQKV + (size_t)nt * 128 * D + kt * 128; }
            else { const int v = u - 256, kt = v >> 3, nt = v & 7; c.src = in[I_SBO] + (size_t)kt * 128 * D + nt * 128; c.sld = D; c.dst = WSBO + (size_t)nt * 128 * D + kt * 128; }
            return c; });
        bf16_t* WRT = (bf16_t*)(F.ws + WS_WRT);
        for (int i = gtid; i < 2 * 64 * 1024; i += gstride) {
            const int l = i / (64 * 1024), j = i % (64 * 1024), e = j / 1024, k = j % 1024;
            const float w = F.in[I_ROUTER][((size_t)l * D + k) * NE + e]; const bf16_t hi = f2bf(w), lo = f2bf(w - bf2f(hi));
            bf16_t* row = WRT + ((size_t)l * 64 + e) * 3072; row[k] = hi; row[1024 + k] = lo; row[2048 + k] = hi;
        }
    }
}

__device__ __forceinline__ unsigned pack_fp8x4(const f32x4& v) {
    const float lim = 440.0f;
    const float a = __builtin_amdgcn_fmed3f(v[0], -lim, lim), b = __builtin_amdgcn_fmed3f(v[1], -lim, lim), c = __builtin_amdgcn_fmed3f(v[2], -lim, lim), d = __builtin_amdgcn_fmed3f(v[3], -lim, lim);
    int w = __builtin_amdgcn_cvt_pk_fp8_f32(a, b, 0, false); w = __builtin_amdgcn_cvt_pk_fp8_f32(c, d, w, true); return (unsigned)w;
}
__device__ __forceinline__ void acc_fp8x16(float (&y)[16], const u32x4& w, float g) {
#pragma unroll
    for (int q = 0; q < 4; ++q) { const f32x2 lo = __builtin_amdgcn_cvt_pk_f32_fp8((int)w[q], false), hi = __builtin_amdgcn_cvt_pk_f32_fp8((int)w[q], true);
        y[4 * q] += g * lo.x; y[4 * q + 1] += g * lo.y; y[4 * q + 2] += g * hi.x; y[4 * q + 3] += g * hi.y; }
}
__device__ __forceinline__ void ph_mod(const Frame& F) {
    const float* c = F.in[I_C]; const float* W = F.in[I_ADAW]; const float* bias = F.in[I_ADAB];
    float* MOD = (float*)(F.ws + WS_MOD);
    float* red = F.ldsf;
    float* sc = F.ldsf + 1024;
    for (int i = F.tid; i < 2 * D; i += NTHREADS) { const float v = c[i]; sc[i] = v * sigmoidf_(v); }
    __syncthreads();
    for (int u = F.bid; u < 192; u += F.G) {
        const int l = u / 96, cg = u % 96, col = cg * 64 + F.lane;
        float s0 = 0.f, s1 = 0.f;
        const float* wp = W + ((size_t)l * D + F.wave * 128) * 6144 + col;
#pragma unroll 1
        for (int d0 = 0; d0 < 128; d0 += 32) {
            float wv[32];
#pragma unroll
            for (int d = 0; d < 32; ++d) wv[d] = wp[(size_t)(d0 + d) * 6144];
#pragma unroll
            for (int d = 0; d < 32; ++d) { const int dd = F.wave * 128 + d0 + d; s0 += sc[dd] * wv[d]; s1 += sc[D + dd] * wv[d]; }
        }
        red[(F.wave * 2 + 0) * 64 + F.lane] = s0; red[(F.wave * 2 + 1) * 64 + F.lane] = s1;
        __syncthreads();
        if (F.tid < 128) {
            const int b = F.tid >> 6, cc = F.tid & 63; float s = 0.f;
#pragma unroll
            for (int w = 0; w < 8; ++w) s += red[(w * 2 + b) * 64 + cc];
            MOD[(l * 2 + b) * 6144 + cg * 64 + cc] = s + bias[l * 6144 + cg * 64 + cc];
        }
        __syncthreads();
    }
}

__device__ __forceinline__ void ph_prenorm_rwkv(const Frame& F) {
    const float* x = F.in[I_X]; const float* g = F.in[I_NPM]; const float* mu = F.in[I_MU];
    const float* MOD = (const float*)(F.ws + WS_MOD);
    bf16_t* XS = (bf16_t*)(F.ws + WS_XS);
    constexpr int RUN_T = 8;
    const int nunits = T / RUN_T, c0 = 16 * F.lane;
    f32x4 m[6][4];
#pragma unroll
    for (int n = 0; n < 6; ++n)
#pragma unroll
        for (int i = 0; i < 4; ++i) m[n][i] = *(const f32x4*)(mu + n * D + c0 + 4 * i);
    for (int u = F.bid * NWAVES + F.wave; u < nunits; u += F.G * NWAVES) {
        const int t0 = u * RUN_T, b = t0 / SEQ;
        const float* shift = MOD + (0 * 2 + b) * 6144; const float* scale = shift + 1024;
        f32x4 gm[4], sh[4];
#pragma unroll
        for (int i = 0; i < 4; ++i) { const int c = c0 + 4 * i; const f32x4 gv = *(const f32x4*)(g + c), sc = *(const f32x4*)(scale + c); gm[i] = gv * (sc + 1.0f); sh[i] = *(const f32x4*)(shift + c); }
        f32x4 hp[4];
#pragma unroll
        for (int i = 0; i < 4; ++i) hp[i] = (f32x4){0.f, 0.f, 0.f, 0.f};
        const int tstart = (t0 % SEQ == 0) ? t0 : t0 - 1;
        for (int t = tstart; t < t0 + RUN_T; ++t) {
            f32x4 xv[4]; float ss = 0.f;
#pragma unroll
            for (int i = 0; i < 4; ++i) { xv[i] = *(const f32x4*)(x + (size_t)t * D + c0 + 4 * i); ss += xv[i][0] * xv[i][0] + xv[i][1] * xv[i][1] + xv[i][2] * xv[i][2] + xv[i][3] * xv[i][3]; }
            ss = wave_sum(ss);
            const float rs = rsqrtf(ss * (1.0f / D) + 1e-6f);
            f32x4 h[4];
#pragma unroll
            for (int i = 0; i < 4; ++i) h[i] = xv[i] * rs * gm[i] + sh[i];
            if (t >= t0) {
#pragma unroll
                for (int n = 0; n < 6; ++n) {
                    u32x4 w0, w1;
#pragma unroll
                    for (int i = 0; i < 4; ++i) {
                        const f32x4 v = h[i] + (hp[i] - h[i]) * m[n][i];
                        const unsigned a0 = pack2(v[0], v[1]), a1 = pack2(v[2], v[3]);
                        if (i == 0) { w0[0] = a0; w0[1] = a1; } else if (i == 1) { w0[2] = a0; w0[3] = a1; } else if (i == 2) { w1[0] = a0; w1[1] = a1; } else { w1[2] = a0; w1[3] = a1; }
                    }
                    bf16_t* dst = XS + ((size_t)n * T + t) * D + c0;
                    *(u32x4*)dst = w0; *(u32x4*)(dst + 8) = w1;
                }
            }
#pragma unroll
            for (int i = 0; i < 4; ++i) hp[i] = h[i];
        }
    }
}


template <bool XBF>
__device__ __forceinline__ void ph_postmix_preffn(const Frame& F, int layer, const float* xin, const bf16_t* Y) {
    const float* MOD = (const float*)(F.ws + WS_MOD);
    const float* gpo = F.in[I_NPOM] + layer * D; const float* gpf = F.in[I_NPF] + layer * D;
    bf16_t* H2 = (bf16_t*)(F.ws + WS_H2); bf16_t* H2LO = (bf16_t*)(F.ws + WS_H2LO); bf16_t* XR = (bf16_t*)(F.ws + WS_XR);
    const int c0 = 16 * F.lane;
    f32x4 gmp[4], gfs[4], shf[4]; int bcur = -1;
    for (int t = F.bid * NWAVES + F.wave; t < T; t += F.G * NWAVES) {
        const int b = t / SEQ;
        if (b != bcur) { bcur = b; const float* m = MOD + (layer * 2 + b) * 6144;
#pragma unroll
            for (int i = 0; i < 4; ++i) { const int c = c0 + 4 * i;
                gmp[i] = *(const f32x4*)(m + 2048 + c) * *(const f32x4*)(gpo + c);
                gfs[i] = *(const f32x4*)(gpf + c) * (*(const f32x4*)(m + 4096 + c) + 1.0f);
                shf[i] = *(const f32x4*)(m + 3072 + c); } }
        const u32x4 y0 = *(const u32x4*)(Y + (size_t)t * D + c0), y1 = *(const u32x4*)(Y + (size_t)t * D + c0 + 8);
        f32x4 xv[4];
        if (XBF) { const u32x4 a0 = *(const u32x4*)(XR + (size_t)t * D + c0), a1 = *(const u32x4*)(XR + (size_t)t * D + c0 + 8);
            xv[0] = (f32x4){lo2f(a0[0]), hi2f(a0[0]), lo2f(a0[1]), hi2f(a0[1])}; xv[1] = (f32x4){lo2f(a0[2]), hi2f(a0[2]), lo2f(a0[3]), hi2f(a0[3])};
            xv[2] = (f32x4){lo2f(a1[0]), hi2f(a1[0]), lo2f(a1[1]), hi2f(a1[1])}; xv[3] = (f32x4){lo2f(a1[2]), hi2f(a1[2]), lo2f(a1[3]), hi2f(a1[3])}; }
        else {
#pragma unroll
            for (int i = 0; i < 4; ++i) xv[i] = *(const f32x4*)(xin + (size_t)t * D + c0 + 4 * i); }
        f32x4 y[4];
        y[0] = (f32x4){lo2f(y0[0]), hi2f(y0[0]), lo2f(y0[1]), hi2f(y0[1])}; y[1] = (f32x4){lo2f(y0[2]), hi2f(y0[2]), lo2f(y0[3]), hi2f(y0[3])};
        y[2] = (f32x4){lo2f(y1[0]), hi2f(y1[0]), lo2f(y1[1]), hi2f(y1[1])}; y[3] = (f32x4){lo2f(y1[2]), hi2f(y1[2]), lo2f(y1[3]), hi2f(y1[3])};
        float ss = 0.f;
#pragma unroll
        for (int i = 0; i < 4; ++i) ss += y[i][0] * y[i][0] + y[i][1] * y[i][1] + y[i][2] * y[i][2] + y[i][3] * y[i][3];
        ss = wave_sum(ss);
        const float rs = rsqrtf(ss * (1.0f / D) + 1e-6f);
        f32x4 x1[4]; float s2 = 0.f;
#pragma unroll
        for (int i = 0; i < 4; ++i) { const int c = c0 + 4 * i;
            x1[i] = xv[i] + gmp[i] * (y[i] * rs);
            s2 += x1[i][0] * x1[i][0] + x1[i][1] * x1[i][1] + x1[i][2] * x1[i][2] + x1[i][3] * x1[i][3]; }
        { u32x4 r0, r1;
          r0[0] = pack2(x1[0][0], x1[0][1]); r0[1] = pack2(x1[0][2], x1[0][3]); r0[2] = pack2(x1[1][0], x1[1][1]); r0[3] = pack2(x1[1][2], x1[1][3]);
          r1[0] = pack2(x1[2][0], x1[2][1]); r1[1] = pack2(x1[2][2], x1[2][3]); r1[2] = pack2(x1[3][0], x1[3][1]); r1[3] = pack2(x1[3][2], x1[3][3]);
          *(u32x4*)(XR + (size_t)t * D + c0) = r0; *(u32x4*)(XR + (size_t)t * D + c0 + 8) = r1; }
        s2 = wave_sum(s2);
        const float rs2 = rsqrtf(s2 * (1.0f / D) + 1e-6f);
        u32x4 h0, h1, l0, l1;
#pragma unroll
        for (int i = 0; i < 4; ++i) {
            const f32x4 h = x1[i] * rs2 * gfs[i] + shf[i];
            const unsigned w0 = pack2(h[0], h[1]), w1 = pack2(h[2], h[3]);
            const unsigned v0 = pack2(h[0] - lo2f(w0), h[1] - hi2f(w0)), v1 = pack2(h[2] - lo2f(w1), h[3] - hi2f(w1));
            if (i == 0) { h0[0] = w0; h0[1] = w1; l0[0] = v0; l0[1] = v1; } else if (i == 1) { h0[2] = w0; h0[3] = w1; l0[2] = v0; l0[3] = v1; }
            else if (i == 2) { h1[0] = w0; h1[1] = w1; l1[0] = v0; l1[1] = v1; } else { h1[2] = w0; h1[3] = w1; l1[2] = v0; l1[3] = v1; }
        }
        *(u32x4*)(H2 + (size_t)t * D + c0) = h0; *(u32x4*)(H2 + (size_t)t * D + c0 + 8) = h1;
        *(u32x4*)(H2LO + (size_t)t * D + c0) = l0; *(u32x4*)(H2LO + (size_t)t * D + c0 + 8) = l1;
    }
}


__device__ __forceinline__ void ph_topk(const Frame& F, int layer) {
    const float* LOG = (const float*)(F.ws + WS_LOGITS); const float* rb = F.in[I_RBIAS] + layer * NE;
    int* IDX = (int*)(F.ws + WS_IDX); float* GATE = (float*)(F.ws + WS_GATE); int* RANK = (int*)(F.ws + WS_RANK);
    unsigned* BC = (unsigned*)(F.ws + WS_BC);
    unsigned* lcnt = (unsigned*)F.ldsf;
    const float bias = rb[F.lane];
    for (int base = F.bid * 64; base < T; base += F.G * 64) {
        if (F.tid < 64) lcnt[F.tid] = 0u;
        __syncthreads();
        float s[8], sel[8], tot[8], mysc[8]; int myidx[8]; unsigned lrank[8];
#pragma unroll
        for (int j = 0; j < 8; ++j) { const size_t o = (size_t)(base + F.wave * 8 + j) * NE + F.lane;
            s[j] = sigmoidf_(LOG[o] + LOG[(size_t)T * NE + o] + LOG[(size_t)2 * T * NE + o]); sel[j] = s[j] + bias; tot[j] = 0.f; mysc[j] = 0.f; myidx[j] = 0; }
#pragma unroll
        for (int k = 0; k < TOPK; ++k) {
            float bv[8]; int bi[8];
#pragma unroll
            for (int j = 0; j < 8; ++j) { bv[j] = sel[j]; bi[j] = F.lane; }
#pragma unroll
            for (int o = 32; o >= 1; o >>= 1) {
#pragma unroll
                for (int j = 0; j < 8; ++j) { const float ov = __shfl_xor(bv[j], o); const int oi = __shfl_xor(bi[j], o); const bool take = (ov > bv[j]) | ((ov == bv[j]) & (oi < bi[j]));     bv[j] = take ? ov : bv[j]; bi[j] = take ? oi : bi[j]; }
            }
#pragma unroll
            for (int j = 0; j < 8; ++j) { const float sc = __shfl(s[j], bi[j]); tot[j] += sc; const bool me = (F.lane == k); myidx[j] = me ? bi[j] : myidx[j]; mysc[j] = me ? sc : mysc[j]; sel[j] = (F.lane == bi[j]) ? -1e30f : sel[j]; }
        }
#pragma unroll
        for (int j = 0; j < 8; ++j) { const int t = base + F.wave * 8 + j; lrank[j] = 0u;
            if (F.lane < TOPK) { IDX[t * TOPK + F.lane] = myidx[j]; GATE[t * TOPK + F.lane] = 2.5f * mysc[j] / tot[j]; lrank[j] = atomicAdd(&lcnt[myidx[j]], 1u); } }
        __syncthreads();
        if (F.tid < 64) BC[(base >> 6) * 64 + F.tid] = lcnt[F.tid];
#pragma unroll
        for (int j = 0; j < 8; ++j) { const int t = base + F.wave * 8 + j; if (F.lane < TOPK) RANK[t * TOPK + F.lane] = (int)lrank[j]; }
        __syncthreads();
    }
}

__device__ __forceinline__ void ph_offsets(const Frame& F, int layer) {
    const unsigned* BC = (const unsigned*)(F.ws + WS_BC);
    const int* IDX = (const int*)(F.ws + WS_IDX); const int* RANK = (const int*)(F.ws + WS_RANK);
    int* POS = (int*)(F.ws + WS_POS); int* TOK = (int*)(F.ws + WS_TOK); int* TILEE = (int*)(F.ws + WS_TILEE); int* START = (int*)(F.ws + WS_START);
    int* sst = (int*)F.ldsf;
    constexpr int NG = T / 64;
    for (int g = F.bid; g < NG; g += F.G) {
        { const int e = F.tid & 63, part = F.tid >> 6; int tot = 0, pre = 0;
          for (int gg = part; gg < NG; gg += 8) { const int v = (int)BC[gg * 64 + e]; tot += v; if (gg < g) pre += v; }
          sst[512 + part * 64 + e] = tot; sst[1024 + part * 64 + e] = pre; }
        __syncthreads();
        if (F.tid < 64) { int tot = 0, pre = 0;
#pragma unroll
            for (int q = 0; q < 8; ++q) { tot += sst[512 + q * 64 + F.tid]; pre += sst[1024 + q * 64 + F.tid]; }
            sst[128 + F.tid] = tot; sst[256 + F.tid] = pre; }
        __syncthreads();
        if (F.tid == 0) { int acc = 0; for (int e = 0; e < NE; ++e) { const int c = sst[128 + e]; sst[e] = acc; acc += ((c + RP - 1) / RP) * RP; } sst[64] = acc; }
        __syncthreads();
        if (g == 0) {
            if (F.tid <= 64) START[F.tid] = sst[F.tid];
            if (F.tid == 65) START[65] = sst[64];
            const int ntile = sst[64] / RP;
            for (int i = F.tid; i < ntile; i += NTHREADS) { int e = 0; while (e < 63 && sst[e + 1] <= i * RP) ++e; TILEE[i] = e; }
            for (int q = F.tid; q < NE * RP; q += NTHREADS) { const int e = q / RP, r = q % RP, c = sst[128 + e]; if (sst[e] + c + r < sst[e + 1]) TOK[sst[e] + c + r] = 0; }
        }
        { const int sl = g * 64 * TOPK + F.tid;
          const int e = IDX[sl], p = sst[e] + sst[256 + e] + RANK[sl];
          POS[sl] = p; TOK[p] = sl / TOPK; }
        __syncthreads();
    }
}

__device__ __forceinline__ void ph_combine(const Frame& F, int layer, bool next) {
    const unsigned char* YB = (const unsigned char*)(F.ws + WS_YB); const int* POS = (const int*)(F.ws + WS_POS); const float* GATE = (const float*)(F.ws + WS_GATE);
    const int* START = (const int*)(F.ws + WS_START); const float* MOD = (const float*)(F.ws + WS_MOD);
    const float* gpo = F.in[I_NPOF] + layer * D;
    bf16_t* H3 = (bf16_t*)(F.ws + WS_H3); bf16_t* XR = (bf16_t*)(F.ws + WS_XR);
    const int routed = START[65], c0 = 16 * F.lane;
    f32x4 gmp[4], gfs[4], shf[4]; int bcur = -1;
    for (int t = F.bid * NWAVES + F.wave; t < T; t += F.G * NWAVES) {
        const int b = t / SEQ;
        if (b != bcur) { bcur = b; const float* m = MOD + (layer * 2 + b) * 6144;
#pragma unroll
            for (int i = 0; i < 4; ++i) { const int c = c0 + 4 * i; gmp[i] = *(const f32x4*)(m + 5120 + c) * *(const f32x4*)(gpo + c);
                if (next) { const float* m1 = MOD + ((layer + 1) * 2 + b) * 6144; const float* g1 = F.in[I_NPM] + (layer + 1) * D;
                    gfs[i] = *(const f32x4*)(g1 + c) * (*(const f32x4*)(m1 + 1024 + c) + 1.0f); shf[i] = *(const f32x4*)(m1 + c); } } }
        int pos[TOPK]; float gk[TOPK];
        { const u32x4 p0 = *(const u32x4*)(POS + t * TOPK), p1 = *(const u32x4*)(POS + t * TOPK + 4); const f32x4 g0 = *(const f32x4*)(GATE + t * TOPK), g1 = *(const f32x4*)(GATE + t * TOPK + 4);
#pragma unroll
          for (int k = 0; k < 4; ++k) { pos[k] = (int)p0[k]; pos[4 + k] = (int)p1[k]; gk[k] = g0[k]; gk[4 + k] = g1[k]; } }
        u32x4 rw[TOPK + 1];
        rw[TOPK] = *(const u32x4*)(YB + (size_t)(routed + t) * D + c0);
#pragma unroll
        for (int k = 0; k < TOPK; ++k) rw[k] = *(const u32x4*)(YB + (size_t)pos[k] * D + c0);
        float y[16];
#pragma unroll
        for (int e = 0; e < 16; ++e) y[e] = 0.f;
        acc_fp8x16(y, rw[TOPK], 1.0f / YB_SCALE);
#pragma unroll
        for (int k = 0; k < TOPK; ++k) acc_fp8x16(y, rw[k], gk[k] * (1.0f / YB_SCALE));
        float ss = 0.f;
#pragma unroll
        for (int e = 0; e < 16; ++e) ss += y[e] * y[e];
        ss = wave_sum(ss);
        const float rs = rsqrtf(ss * (1.0f / D) + 1e-6f);
        f32x4 x2[4]; float s2 = 0.f;
        const u32x4 a0 = *(const u32x4*)(XR + (size_t)t * D + c0), a1 = *(const u32x4*)(XR + (size_t)t * D + c0 + 8);
#pragma unroll
        for (int i = 0; i < 4; ++i) { const int c = c0 + 4 * i;
            const unsigned wa = (i < 2) ? a0[2 * (i & 1)] : a1[2 * (i & 1)], wb = (i < 2) ? a0[2 * (i & 1) + 1] : a1[2 * (i & 1) + 1];
            const f32x4 xv = {lo2f(wa), hi2f(wa), lo2f(wb), hi2f(wb)};
            const f32x4 yv = {y[4 * i], y[4 * i + 1], y[4 * i + 2], y[4 * i + 3]};
            x2[i] = xv + gmp[i] * (yv * rs);
            if (!next) *(f32x4*)(F.out + (size_t)t * D + c) = x2[i];
            s2 += x2[i][0] * x2[i][0] + x2[i][1] * x2[i][1] + x2[i][2] * x2[i][2] + x2[i][3] * x2[i][3]; }
        if (next) {
            { u32x4 r0, r1;
              r0[0] = pack2(x2[0][0], x2[0][1]); r0[1] = pack2(x2[0][2], x2[0][3]); r0[2] = pack2(x2[1][0], x2[1][1]); r0[3] = pack2(x2[1][2], x2[1][3]);
              r1[0] = pack2(x2[2][0], x2[2][1]); r1[1] = pack2(x2[2][2], x2[2][3]); r1[2] = pack2(x2[3][0], x2[3][1]); r1[3] = pack2(x2[3][2], x2[3][3]);
              *(u32x4*)(XR + (size_t)t * D + c0) = r0; *(u32x4*)(XR + (size_t)t * D + c0 + 8) = r1; }
            s2 = wave_sum(s2);
            const float rs2 = rsqrtf(s2 * (1.0f / D) + 1e-6f);
            u32x4 h0, h1;
#pragma unroll
            for (int i = 0; i < 4; ++i) {
                const f32x4 h = x2[i] * rs2 * gfs[i] + shf[i];
                const unsigned w0 = pack2(h[0], h[1]), w1 = pack2(h[2], h[3]);
                if (i == 0) { h0[0] = w0; h0[1] = w1; } else if (i == 1) { h0[2] = w0; h0[3] = w1; } else if (i == 2) { h1[0] = w0; h1[1] = w1; } else { h1[2] = w0; h1[3] = w1; } }
            *(u32x4*)(H3 + (size_t)t * D + c0) = h0; *(u32x4*)(H3 + (size_t)t * D + c0 + 8) = h1;
        }
    }
}

#define SB_EXIT 110.0f

namespace pgx {
__device__ __forceinline__ int perm32(int rho) { const int n = rho >> 4, i = rho & 15; return 8 * (i >> 2) + 4 * n + (i & 3); }
struct Unit { const char* A; const int* tok; const char* B; int r0, c0, aux; };
template <bool SW, bool PERM, class Sched, class Epi>
__device__ __forceinline__ void gemm_phase(LAS unsigned char* lds, const int K, const unsigned lda  , const Sched& S, const Epi& E) {
    int tid_ = threadIdx.x; asm volatile("" : "+v"(tid_));
    const int tid = tid_, wid = __builtin_amdgcn_readfirstlane(tid >> 6), lane = tid & 63, wr = wid >> 2, wc = wid & 3, fr = lane & 15, fq = lane >> 4;
    const int nt = K / 64;
    int Rr[2], Cc[2]; unsigned voffB[2];
#pragma unroll
    for (int i = 0; i < 2; ++i) { stage_rc(tid * 16 + i * 8192, Rr[i], Cc[i]); const int Rb = PERM ? ((Rr[i] & ~31) + perm32(Rr[i] & 31)) : Rr[i]; voffB[i] = (unsigned)(Rb * K + Cc[i]) * 2u; }
    const size_t kstep = 128, hstepB = (size_t)128 * K * 2;
    const unsigned ldsw = (unsigned)wid * 1024u;
    const int aoff = lds_byte(wr * 64 + fr, fq * 8), boff = lds_byte(wc * 32 + fr, fq * 8);
#define PX_SA(b, h) (((b) * 2 + (h)) * HTB)
#define PX_SB(b, h) ((4 + (b) * 2 + (h)) * HTB)
#define PX_STAGE(bufoff, gbase, voff) do { _Pragma("unroll") for (int _i = 0; _i < 2; ++_i) \
        __builtin_amdgcn_global_load_lds((const unsigned*)((const char*)(gbase) + (voff)[_i]), (LAS unsigned*)(lds + (bufoff) + ldsw + _i * 8192), 16, 0, 0); } while (0)
#define PX_LDA(dst, b, h) do { _Pragma("unroll") for (int m = 0; m < 4; ++m) _Pragma("unroll") for (int k = 0; k < 2; ++k) dst[m][k] = *(const LAS bf16x8*)(lds + PX_SA(b, h) + aoff + m * 2048 + k * 1024); } while (0)
#define PX_LDB(dst, b, h) do { _Pragma("unroll") for (int n = 0; n < 2; ++n) _Pragma("unroll") for (int k = 0; k < 2; ++k) dst[n][k] = *(const LAS bf16x8*)(lds + PX_SB(b, h) + boff + n * 2048 + k * 1024); } while (0)
#define PX_MMA(ai, bj, At, Bt) do { __builtin_amdgcn_s_setprio(1); _Pragma("unroll") for (int m = 0; m < 4; ++m) _Pragma("unroll") for (int n = 0; n < 2; ++n) _Pragma("unroll") for (int k = 0; k < 2; ++k) \
        acc[ai][bj][m][n] = SW ? __builtin_amdgcn_mfma_f32_16x16x32_bf16(Bt[n][k], At[m][k], acc[ai][bj][m][n], 0, 0, 0) : __builtin_amdgcn_mfma_f32_16x16x32_bf16(At[m][k], Bt[n][k], acc[ai][bj][m][n], 0, 0, 0); __builtin_amdgcn_s_setprio(0); } while (0)
#define PX_WAIT_L(n) asm volatile("s_waitcnt lgkmcnt(" #n ")" ::: "memory")
#define PX_BAR __builtin_amdgcn_s_barrier()
#define PX_SCHED __builtin_amdgcn_sched_barrier(0)
#define PX_OFFS(dst, un) do { _Pragma("unroll") for (int h_ = 0; h_ < 2; ++h_) _Pragma("unroll") for (int i_ = 0; i_ < 2; ++i_) { \
        const int row_ = h_ * 128 + Rr[i_]; const unsigned rid_ = (un).tok ? (unsigned)(un).tok[row_] : (unsigned)row_; dst[h_][i_] = rid_ * lda + (unsigned)Cc[i_] * 2u; } } while (0)
    Unit cur, nxt; int ui = 0;
    if (!S.next(0, cur)) return;
    f32x4 acc[2][2][4][2];
#pragma unroll
    for (int a = 0; a < 2; ++a)
#pragma unroll
        for (int b = 0; b < 2; ++b)
#pragma unroll
            for (int m = 0; m < 4; ++m)
#pragma unroll
                for (int n = 0; n < 2; ++n) acc[a][b][m][n] = (f32x4){0.f, 0.f, 0.f, 0.f};
    bf16x8 At[4][2], B0[2][2], B1[2][2];
    unsigned oc[2][2], on[2][2];
    PX_OFFS(oc, cur); asm volatile("" : "+v"(oc[0][0]), "+v"(oc[0][1]), "+v"(oc[1][0]), "+v"(oc[1][1]));
    const char* cA = cur.A; const char* cB = cur.B;
    PX_STAGE(PX_SB(0, 0), cB, voffB); PX_STAGE(PX_SA(0, 0), cA, oc[0]); PX_STAGE(PX_SB(0, 1), cB + hstepB, voffB); PX_STAGE(PX_SA(0, 1), cA, oc[1]);
    if (wr == 1) PX_BAR;
    WAIT_V(4); PX_BAR;
    PX_STAGE(PX_SB(1, 0), cB + kstep, voffB); PX_STAGE(PX_SA(1, 0), cA + kstep, oc[0]); PX_STAGE(PX_SB(1, 1), cB + hstepB + kstep, voffB);
    WAIT_V(6); PX_BAR;
    for (;;) {
        const bool has_next = S.next(ui + 1, nxt);
        const char* nA = has_next ? nxt.A : cA; const char* nB = has_next ? nxt.B : cB;
        if (has_next) { PX_OFFS(on, nxt); asm volatile("" : "+v"(on[0][0]), "+v"(on[0][1]), "+v"(on[1][0]), "+v"(on[1][1])); } else {
#pragma unroll
            for (int h_ = 0; h_ < 2; ++h_)
#pragma unroll
                for (int i_ = 0; i_ < 2; ++i_) on[h_][i_] = oc[h_][i_]; }
#pragma unroll 1
        for (int t = 0; t < nt; t += 2) {
            const bool last = (t == nt - 2);
            const char* a1 = cA + (size_t)(t + 1) * kstep;
            const char* a2 = last ? nA : cA + (size_t)(t + 2) * kstep; const char* b2 = last ? nB : cB + (size_t)(t + 2) * kstep;
            const char* a3 = a2 + kstep; const char* b3 = b2 + kstep;
            unsigned o2[2][2];
#pragma unroll
            for (int h_ = 0; h_ < 2; ++h_)
#pragma unroll
                for (int i_ = 0; i_ < 2; ++i_) o2[h_][i_] = last ? on[h_][i_] : oc[h_][i_];
            PX_LDB(B0, 0, 0); PX_SCHED; PX_LDA(At, 0, 0); PX_STAGE(PX_SA(1, 1), a1, oc[1]);
            PX_WAIT_L(8); PX_BAR; PX_WAIT_L(0); PX_MMA(0, 0, At, B0); PX_BAR; PX_SCHED;
            PX_LDB(B1, 0, 1); PX_STAGE(PX_SB(0, 0), b2, voffB);
            PX_BAR; PX_WAIT_L(0); PX_MMA(0, 1, At, B1); PX_BAR;
            PX_LDA(At, 0, 1); PX_STAGE(PX_SA(0, 0), a2, o2[0]);
            PX_BAR; PX_WAIT_L(0); PX_MMA(1, 0, At, B0); PX_BAR; PX_SCHED;
            PX_STAGE(PX_SB(0, 1), b2 + hstepB, voffB);
            WAIT_V(6); PX_BAR; PX_MMA(1, 1, At, B1); PX_BAR;
            PX_LDB(B0, 1, 0); PX_SCHED; PX_LDA(At, 1, 0); PX_STAGE(PX_SA(0, 1), a2, o2[1]);
            PX_WAIT_L(8); PX_BAR; PX_WAIT_L(0); PX_MMA(0, 0, At, B0); PX_BAR; PX_SCHED;
            PX_LDB(B1, 1, 1); PX_STAGE(PX_SB(1, 0), b3, voffB);
            PX_BAR; PX_WAIT_L(0); PX_MMA(0, 1, At, B1); PX_BAR;
            PX_LDA(At, 1, 1); PX_STAGE(PX_SA(1, 0), a3, o2[0]);
            PX_BAR; PX_WAIT_L(0); PX_MMA(1, 0, At, B0); PX_BAR; PX_SCHED;
            PX_STAGE(PX_SB(1, 1), b3 + hstepB, voffB);
            WAIT_V(6); PX_BAR; PX_MMA(1, 1, At, B1); PX_BAR;
        }
        E(acc, cur, wr, wc, fr, fq);
        if (!has_next) break;
#pragma unroll
        for (int a = 0; a < 2; ++a)
#pragma unroll
            for (int b = 0; b < 2; ++b)
#pragma unroll
                for (int m = 0; m < 4; ++m)
#pragma unroll
                    for (int n = 0; n < 2; ++n) acc[a][b][m][n] = (f32x4){0.f, 0.f, 0.f, 0.f};
        cur = nxt; cA = nA; cB = nB; ++ui;
#pragma unroll
        for (int h_ = 0; h_ < 2; ++h_)
#pragma unroll
            for (int i_ = 0; i_ < 2; ++i_) oc[h_][i_] = on[h_][i_];
    }
    WAIT_V(0);
    if (wr == 0) PX_BAR;
    PX_BAR;
#undef PX_SA
#undef PX_SB
#undef PX_STAGE
#undef PX_LDA
#undef PX_LDB
#undef PX_MMA
#undef PX_WAIT_L
#undef PX_BAR
#undef PX_SCHED
#undef PX_OFFS
}
__device__ __forceinline__ unsigned cvt_pk_bf16(float lo, float hi) { return pack2(lo, hi); }
}

__device__ __forceinline__ size_t hm_off(int t, int c) { return ((size_t)((t / SEQ) * NH + (c >> 6)) * SEQ + (t % SEQ)) * 64 + (c & 63); }
#define EPI_MT(acc) (int)(sizeof(acc) / sizeof(acc[0]))
__device__ __forceinline__ void st_bf4(bf16_t* p, const f32x4& v) { u32x2 w; w.x = pack2(v[0], v[1]); w.y = pack2(v[2], v[3]); *(u32x2*)p = w; }

__device__ __forceinline__ void ph_lora_up_sg(const Frame& F) {
    const bf16_t* LORA = (const bf16_t*)(F.ws + WS_LORA); const bf16_t* WLUP = (const bf16_t*)(F.ws + WS_WLUP);
    bf16_t* LD = (bf16_t*)(F.ws + WS_LD); bf16_t* AA = (bf16_t*)(F.ws + WS_AA); bf16_t* GG = (bf16_t*)(F.ws + WS_GG);
    f32x4 w0v[4], a0v[4]; int pcol = -1;
    SgChain ch; ch.ph = 0; ch.pre = false;
    for (int u = F.bid; u < 3 * 64 * 8; u += F.G) {
        const int which = u / 512, v = u % 512, mt = v / 8, col0 = (v % 8) * 128;
        if (col0 != pcol) { pcol = col0;
#pragma unroll
            for (int q = 0; q < 4; ++q) { const int c = (F.wave & 1) * 64 + 16 * q + 4 * (F.lane >> 4); w0v[q] = *(const f32x4*)(F.in[I_W0] + col0 + c); a0v[q] = *(const f32x4*)(F.in[I_A0] + col0 + c); } }
        const int K = which == 2 ? 128 : 64, koff = which * 64;
        ASeg A; A.p[0] = LORA + (size_t)mt * 256 * 256 + koff; A.p[1] = A.p[0]; A.p[2] = A.p[0]; A.segTiles = 4;
        const bf16_t* Bt = WLUP + (which == 0 ? 0 : (which == 1 ? 1024 * 64 : 2 * 1024 * 64)) + (size_t)col0 * K;
        bf16_t* const outp = which == 0 ? LD : (which == 1 ? AA : GG);
        { const int un = u + F.G; ch.nvalid = un < 3 * 64 * 8;
          const int wn_ = un / 512, vn = un % 512, mn = vn / 8, cn = (vn % 8) * 128, Kn = wn_ == 2 ? 128 : 64;
          ch.nA.p[0] = LORA + (size_t)mn * 256 * 256 + wn_ * 64; ch.nA.p[1] = ch.nA.p[0]; ch.nA.p[2] = ch.nA.p[0]; ch.nA.segTiles = 4;
          ch.nBt = WLUP + (wn_ == 0 ? 0 : (wn_ == 1 ? 1024 * 64 : 2 * 1024 * 64)) + (size_t)cn * Kn; ch.nldb = Kn; }
        sg_tile<128>(F.lds, A, [](int R) { return (unsigned)R * 512u; }, Bt, K, K / 64,
            [&](auto& acc, int r0, int c0, int fr, int fq) {
                bf16_t* const ob = outp + hm_off(mt * 256 + r0 + fr, col0 + c0 + 4 * fq);
                if (which == 0) {
#pragma unroll
                    for (int m = 0; m < EPI_MT(acc); ++m)
#pragma unroll
                        for (int q = 0; q < 4; ++q) { f32x4 r;
#pragma unroll
                            for (int e = 0; e < 4; ++e) r[e] = -0.6065306597126334f * sigmoidf_(w0v[q][e] + acc[m][q][e]);
                            st_bf4(ob + m * 1024 + q * 16, r); }
                } else if (which == 1) {
#pragma unroll
                    for (int m = 0; m < EPI_MT(acc); ++m)
#pragma unroll
                        for (int q = 0; q < 4; ++q) { f32x4 r;
#pragma unroll
                            for (int e = 0; e < 4; ++e) r[e] = sigmoidf_(a0v[q][e] + acc[m][q][e]);
                            st_bf4(ob + m * 1024 + q * 16, r); }
                } else {
#pragma unroll
                    for (int m = 0; m < EPI_MT(acc); ++m)
#pragma unroll
                        for (int q = 0; q < 4; ++q) st_bf4(ob + m * 1024 + q * 16, acc[m][q]);
                }
            }, BRowId(), &ch);
    }
}
__device__ __forceinline__ void ph_router_sg(const Frame& F, int layer) {
    const bf16_t* H2 = (const bf16_t*)(F.ws + WS_H2); const bf16_t* H2LO = (const bf16_t*)(F.ws + WS_H2LO);
    const bf16_t* WRT = (const bf16_t*)(F.ws + WS_WRT) + (size_t)layer * 64 * 3072; float* LOG = (float*)(F.ws + WS_LOGITS);
    for (int u = F.bid; u < 64 * 3; u += F.G) {
        const int mt = u / 3, sgi = u % 3;
        ASeg A; A.p[0] = (sgi == 2 ? H2LO : H2) + (size_t)mt * 256 * D; A.p[1] = A.p[0]; A.p[2] = A.p[0]; A.segTiles = 16;
        float* out = LOG + (size_t)sgi * T * NE;
        sg_tile<64>(F.lds, A, [](int R) { return (unsigned)R * (D * 2); }, WRT + sgi * 1024, 3072, 16,
            [&](auto& acc, int r0, int c0, int fr, int fq) {
#pragma unroll
                for (int m = 0; m < EPI_MT(acc); ++m)
#pragma unroll
                    for (int q = 0; q < 4; ++q) *(f32x4*)(out + (size_t)(mt * 256 + r0 + 16 * m + fr) * NE + c0 + 16 * q + 4 * fq) = acc[m][q];
            });
    }
}

constexpr int MS = 72;
constexpr int SLOT = 64 * MS * 2;
__device__ __forceinline__ int ms_off(int row, int col) { return row * MS + col; }
constexpr size_t WS_BONUS = 3 * MiB;
constexpr size_t WS_RP = WS_BIG + 128 * MiB;
constexpr size_t WS_OL = WS_BIG + 160 * MiB;
constexpr size_t WS_G2 = WS_BIG + 296 * MiB;
constexpr size_t WS_DM = WS_BIG + 328 * MiB;
constexpr size_t WS_ST = WS_BIG + 360 * MiB;

__device__ __forceinline__ void st4_lds(LAS bf16_t* p, const f32x4& v) { u32x2 w; w.x = pack2(v[0], v[1]); w.y = pack2(v[2], v[3]); *(LAS u32x2*)p = w; }
__device__ __forceinline__ f32x4 ld4_lds(const LAS bf16_t* p) { const u32x2 w = *(const LAS u32x2*)p; return (f32x4){lo2f(w.x), hi2f(w.x), lo2f(w.y), hi2f(w.y)}; }

__device__ __forceinline__ void ph_wkv_chunk(const Frame& F) {
    const bf16_t* RKV = (const bf16_t*)(F.ws + WS_RKV); const bf16_t* LD = (const bf16_t*)(F.ws + WS_LD); const bf16_t* AA = (const bf16_t*)(F.ws + WS_AA);
    const bf16_t* Rb = RKV; const bf16_t* Kb = RKV + (size_t)T * D; const bf16_t* Vb = RKV + (size_t)2 * T * D;
    bf16_t* RP = (bf16_t*)(F.ws + WS_RP); bf16_t* OL = (bf16_t*)(F.ws + WS_OL); bf16_t* G2 = (bf16_t*)(F.ws + WS_G2); bf16_t* DM = (bf16_t*)(F.ws + WS_DM);
    float* BONUS = (float*)(F.ws + WS_BONUS);
#define SL(k) ((LAS bf16_t*)(F.lds + (k) * SLOT))
#define AT(k, r, c) (SL(k) + ms_off((r), (c)))
    LAS float* segtot = (LAS float*)(F.lds + 15 * SLOT);
    LAS float* WCs = segtot + 512;
    const int w = F.wave, lane = F.lane, fr = lane & 15, fq = lane >> 4, mt = w >> 1, ntb = 2 * (w & 1);
#define W1_ISSUE(cn_) do { const size_t on_ = (size_t)(cn_) * 4096 + (size_t)F.tid * 8; const unsigned lw_ = (unsigned)w * 1024u; \
        __builtin_amdgcn_global_load_lds((const unsigned*)(Rb + on_), (LAS unsigned*)(F.lds + 1 * SLOT + lw_), 16, 0, 0); \
        __builtin_amdgcn_global_load_lds((const unsigned*)(Kb + on_), (LAS unsigned*)(F.lds + 4 * SLOT + lw_), 16, 0, 0); \
        __builtin_amdgcn_global_load_lds((const unsigned*)(Vb + on_), (LAS unsigned*)(F.lds + 6 * SLOT + lw_), 16, 0, 0); \
        __builtin_amdgcn_global_load_lds((const unsigned*)(AA + on_), (LAS unsigned*)(F.lds + 10 * SLOT + lw_), 16, 0, 0); \
        __builtin_amdgcn_global_load_lds((const unsigned*)(LD + on_), (LAS unsigned*)(F.lds + 13 * SLOT + lw_), 16, 0, 0); } while (0)
#define SBARL() do { asm volatile("s_waitcnt lgkmcnt(0)" ::: "memory"); __builtin_amdgcn_s_barrier(); asm volatile("" ::: "memory"); } while (0)
    if (F.bid < NB * NH * (SEQ / 64)) W1_ISSUE(F.bid);
    for (int cid = F.bid; cid < NB * NH * (SEQ / 64); cid += F.G) {
        const int bh = cid / (SEQ / 64), c = cid % (SEQ / 64), b = bh / NH, h = bh % NH;
        const size_t tok0 = (size_t)b * SEQ + (size_t)c * 64;
        {
            const int t = F.tid >> 3, jg = lane & 7, tl = lane >> 3, ch0 = h * 64 + 8 * jg;
            WAIT_V(0);
            const unsigned ro = (unsigned)F.tid * 16u;
            const u32x4 rr = *(const LAS u32x4*)(F.lds + 1 * SLOT + ro), kr = *(const LAS u32x4*)(F.lds + 4 * SLOT + ro), vr = *(const LAS u32x4*)(F.lds + 6 * SLOT + ro), ar = *(const LAS u32x4*)(F.lds + 10 * SLOT + ro);
            const u32x4 lr = *(const LAS u32x4*)(F.lds + 13 * SLOT + ro);
            float r[8], k[8], a[8], ld[8], cum[8];
#pragma unroll
            for (int q = 0; q < 4; ++q) { r[2 * q] = lo2f(rr[q]); r[2 * q + 1] = hi2f(rr[q]); k[2 * q] = lo2f(kr[q]); k[2 * q + 1] = hi2f(kr[q]); a[2 * q] = lo2f(ar[q]); a[2 * q + 1] = hi2f(ar[q]); ld[2 * q] = lo2f(lr[q]); ld[2 * q + 1] = hi2f(lr[q]); }
#pragma unroll
            for (int e = 0; e < 8; ++e) { float v = ld[e];
                float u1 = __shfl_up(v, 8);  if (tl >= 1) v += u1;
                float u2 = __shfl_up(v, 16); if (tl >= 2) v += u2;
                float u4 = __shfl_up(v, 32); if (tl >= 4) v += u4;
                cum[e] = v; }
            if (tl == 7) {
#pragma unroll
                for (int e = 0; e < 8; ++e) segtot[w * 64 + 8 * jg + e] = cum[e]; }
            __syncthreads();
            float tot[8];
#pragma unroll
            for (int e = 0; e < 8; ++e) tot[e] = 0.f;
#pragma unroll
            for (int ww = 0; ww < 8; ++ww) {
                const f32x4 s0 = *(const LAS f32x4*)(segtot + ww * 64 + 8 * jg), s1 = *(const LAS f32x4*)(segtot + ww * 64 + 8 * jg + 4);
#pragma unroll
                for (int q = 0; q < 4; ++q) { tot[q] += s0[q]; tot[4 + q] += s1[q]; if (ww < w) { cum[q] += s0[q]; cum[4 + q] += s1[q]; } }
            }
            if (t == 0) {
#pragma unroll
                for (int e = 0; e < 8; ++e) WCs[8 * jg + e] = fexp_(tot[e]); }
            float kkr[8], kf[8], ss = 0.f, bon = 0.f;
#pragma unroll
            for (int e = 0; e < 8; ++e) { kkr[e] = k[e] * F.in[I_KK][ch0 + e]; ss += kkr[e] * kkr[e]; kf[e] = k[e] * (1.0f + (a[e] - 1.0f) * F.in[I_KA][ch0 + e]); bon += r[e] * kf[e] * F.in[I_RK][ch0 + e]; }
            ss += __shfl_xor(ss, 1); ss += __shfl_xor(ss, 2); ss += __shfl_xor(ss, 4);
            bon += __shfl_xor(bon, 1); bon += __shfl_xor(bon, 2); bon += __shfl_xor(bon, 4);
            if (jg == 0) BONUS[(tok0 + t) * NH + h] = bon;
            const float inv = 1.0f / fmaxf(sqrtf(ss), 1e-12f);
            float av[8], bv[8], kv[8], rv[8];
#pragma unroll
            for (int e = 0; e < 8; ++e) { const float kk = kkr[e] * inv, en = fexp_(-cum[e]);
                av[e] = -kk * fexp_(cum[e] - ld[e]); bv[e] = kk * a[e] * en; kv[e] = kf[e] * en; rv[e] = r[e] * fexp_(cum[e]); }
            u32x4 pa, pr, pb, pk;
#pragma unroll
            for (int q = 0; q < 4; ++q) { pa[q] = pack2(av[2 * q], av[2 * q + 1]); pr[q] = pack2(rv[2 * q], rv[2 * q + 1]); pb[q] = pack2(bv[2 * q], bv[2 * q + 1]); pk[q] = pack2(kv[2 * q], kv[2 * q + 1]); }
            *(LAS u32x4*)AT(0, t, 8 * jg) = pa; *(LAS u32x4*)AT(2, t, 8 * jg) = pr; *(LAS u32x4*)AT(3, t, 8 * jg) = pb; *(LAS u32x4*)AT(5, t, 8 * jg) = pk; *(LAS u32x4*)AT(7, t, 8 * jg) = vr;
        }
        __syncthreads();
#define LF2(dst, k, r0) do { dst[0] = *(const LAS bf16x8*)AT(k, (r0) + fr, fq * 8); dst[1] = *(const LAS bf16x8*)AT(k, (r0) + fr, 32 + fq * 8); } while (0)
#define TR2(dst, k, c0) do { const LAS bf16_t* b_ = AT(k, 8 * fq + (fr >> 2), (c0) + 4 * (fr & 3)); \
            const s16x4 t0_ = __builtin_amdgcn_ds_read_tr16_b64_v4i16((LAS s16x4*)(b_)), t1_ = __builtin_amdgcn_ds_read_tr16_b64_v4i16((LAS s16x4*)(b_ + 4 * MS)); \
            const s16x4 t2_ = __builtin_amdgcn_ds_read_tr16_b64_v4i16((LAS s16x4*)(b_ + 32 * MS)), t3_ = __builtin_amdgcn_ds_read_tr16_b64_v4i16((LAS s16x4*)(b_ + 36 * MS)); \
            dst[0] = __builtin_bit_cast(bf16x8, __builtin_shufflevector(t0_, t1_, 0, 1, 2, 3, 4, 5, 6, 7)); dst[1] = __builtin_bit_cast(bf16x8, __builtin_shufflevector(t2_, t3_, 0, 1, 2, 3, 4, 5, 6, 7)); } while (0)
#define MMA2(acc, xf, yf) do { acc = __builtin_amdgcn_mfma_f32_16x16x32_bf16(xf[0], yf[0], acc, 0, 0, 0); acc = __builtin_amdgcn_mfma_f32_16x16x32_bf16(xf[1], yf[1], acc, 0, 0, 0); } while (0)
        {
            bf16x8 xa[2], xr[2]; LF2(xa, 0, 16 * mt); LF2(xr, 2, 16 * mt);
#pragma unroll
            for (int q2 = 0; q2 < 2; ++q2) {
                const int nt = ntb + q2;
                bf16x8 yb[2], yk[2]; LF2(yb, 3, 16 * nt); LF2(yk, 5, 16 * nt);
                const int tt = 16 * mt + fr, s0 = 16 * nt + 4 * fq;
                { f32x4 acc = {0.f, 0.f, 0.f, 0.f}; MMA2(acc, yb, xa);
#pragma unroll
                  for (int e = 0; e < 4; ++e) if (!(s0 + e < tt)) acc[e] = 0.f;
                  st4_lds(AT(8, tt, s0), acc); }
                { f32x4 acc = {0.f, 0.f, 0.f, 0.f}; MMA2(acc, yk, xa);
#pragma unroll
                  for (int e = 0; e < 4; ++e) if (!(s0 + e < tt)) acc[e] = 0.f;
                  st4_lds(AT(10, tt, s0), acc); }
                { f32x4 acc = {0.f, 0.f, 0.f, 0.f}; MMA2(acc, yb, xr);
#pragma unroll
                  for (int e = 0; e < 4; ++e) if (!(s0 + e <= tt)) acc[e] = 0.f;
                  st4_lds(AT(11, tt, s0), acc); }
                { f32x4 acc = {0.f, 0.f, 0.f, 0.f}; MMA2(acc, yk, xr);
#pragma unroll
                  for (int e = 0; e < 4; ++e) if (!(s0 + e <= tt)) acc[e] = 0.f;
                  st4_lds(AT(12, tt, s0), acc); }
            }
        }
        __syncthreads();
#define WKV_SQ(xi, xo) do { bf16x8 xl[2]; LF2(xl, xi, 16 * mt); _Pragma("unroll") for (int q2 = 0; q2 < 2; ++q2) { const int nt = ntb + q2; bf16x8 yl[2]; TR2(yl, xi, 16 * nt); \
            f32x4 acc = {0.f, 0.f, 0.f, 0.f}; MMA2(acc, yl, xl); st4_lds(AT(xo, 16 * mt + fr, 16 * nt + 4 * fq), acc); } } while (0)
#define WKV_PM(pi, xi, po) do { bf16x8 xp[2]; LF2(xp, pi, 16 * mt); _Pragma("unroll") for (int q2 = 0; q2 < 2; ++q2) { const int nt = ntb + q2; bf16x8 yl[2]; TR2(yl, xi, 16 * nt); \
            const int m_ = 16 * mt + fr, n0_ = 16 * nt + 4 * fq; f32x4 acc = ld4_lds(AT(pi, m_, n0_)); MMA2(acc, yl, xp); st4_lds(AT(po, m_, n0_), acc); } } while (0)
#define WKV_PMSQ(pi, xi, po, xo) do { bf16x8 xp[2], xl[2]; LF2(xp, pi, 16 * mt); LF2(xl, xi, 16 * mt); _Pragma("unroll") for (int q2 = 0; q2 < 2; ++q2) { const int nt = ntb + q2; bf16x8 yl[2]; TR2(yl, xi, 16 * nt); \
            const int m_ = 16 * mt + fr, n0_ = 16 * nt + 4 * fq; \
            { f32x4 acc = ld4_lds(AT(pi, m_, n0_)); MMA2(acc, yl, xp); st4_lds(AT(po, m_, n0_), acc); } \
            { f32x4 acc = {0.f, 0.f, 0.f, 0.f}; MMA2(acc, yl, xl); st4_lds(AT(xo, m_, n0_), acc); } } } while (0)
        WKV_SQ(8, 1);
        for (int idx = F.tid; idx < 64 * 16; idx += NTHREADS) { const int t = idx >> 4, s4 = (idx & 15) * 4; u32x2 v = *(const LAS u32x2*)AT(8, t, s4);
            if ((t >> 2) == (s4 >> 2)) { const unsigned one = 0x3F80u; const int e = t & 3; if (e == 0) v.x = (v.x & 0xffff0000u) | one; else if (e == 1) v.x = (v.x & 0xffffu) | (one << 16); else if (e == 2) v.y = (v.y & 0xffff0000u) | one; else v.y = (v.y & 0xffffu) | (one << 16); }
            *(LAS u32x2*)AT(13, t, s4) = v; }
        { bf16x8 xm[2]; LF2(xm, 10, 16 * mt);
#pragma unroll
          for (int q2 = 0; q2 < 2; ++q2) { const int nt = ntb + q2, n_ = 16 * nt + fr, m0_ = 16 * mt + 4 * fq; bf16x8 yv[2]; TR2(yv, 7, 16 * nt);
              f32x4 acc = {0.f, 0.f, 0.f, 0.f}; MMA2(acc, xm, yv); st4_lds(AT(6, n_, m0_), acc); } }
        __syncthreads();
        WKV_PMSQ(13, 1, 14, 8); __syncthreads();
        WKV_PMSQ(14, 8, 13, 1); __syncthreads();
        WKV_PMSQ(13, 1, 14, 8); __syncthreads();
        WKV_PMSQ(14, 8, 13, 1); __syncthreads();
        WKV_PM(13, 1, 14); __syncthreads();
        {
            bf16x8 xt[2]; LF2(xt, 14, 16 * mt);
#pragma unroll
            for (int q2 = 0; q2 < 2; ++q2) {
                const int nt = ntb + q2, n_ = 16 * nt + fr, m0_ = 16 * mt + 4 * fq;
                bf16x8 ya[2], yz[2]; TR2(ya, 0, 16 * nt); LF2(yz, 6, 16 * nt);
                { f32x4 acc = {0.f, 0.f, 0.f, 0.f}; MMA2(acc, xt, ya); st4_lds(AT(9, n_, m0_), acc); }
                { f32x4 acc = {0.f, 0.f, 0.f, 0.f}; MMA2(acc, xt, yz); st4_lds(AT(8, n_, m0_), acc); }
            }
        }
        __syncthreads();
        if (cid + F.G < NB * NH * (SEQ / 64)) W1_ISSUE(cid + F.G);
        {
            bf16x8 xb[2]; LF2(xb, 11, 16 * mt);
#pragma unroll
            for (int q2 = 0; q2 < 2; ++q2) {
                const int nt = ntb + q2;
                bf16x8 yp[2]; LF2(yp, 9, 16 * nt);
                { const int m_ = 16 * mt + fr, n0_ = 16 * nt + 4 * fq; f32x4 acc = ld4_lds(AT(2, m_, n0_)); MMA2(acc, yp, xb);
                  st_bf4(RP + (size_t)cid * 4096 + (unsigned)((mt * 2 + (nt >> 1)) * 512 + (fr * 4 + 2 * (nt & 1) + (fq >> 1)) * 8 + 4 * (fq & 1)), acc); }
            }
        }
        {
            bf16x8 xb[2], xk[2], xp[2], xu[2], xv[2]; LF2(xb, 11, 16 * mt); LF2(xk, 12, 16 * mt); LF2(xp, 9, 16 * mt); LF2(xu, 8, 16 * mt); TR2(xv, 7, 16 * mt);
#pragma unroll
            for (int q2 = 0; q2 < 2; ++q2) {
                const int nt = ntb + q2;
                bf16x8 yu[2], yv[2], yb[2], yk[2]; LF2(yu, 8, 16 * nt); TR2(yv, 7, 16 * nt); TR2(yb, 3, 16 * nt); TR2(yk, 5, 16 * nt);
                { f32x4 acc = {0.f, 0.f, 0.f, 0.f}; MMA2(acc, yu, xb); MMA2(acc, yv, xk);
                  st_bf4(OL + (size_t)cid * 4096 + (unsigned)((16 * mt + fr) * 64 + 16 * nt + 4 * fq), acc); }
                { const int jp = 16 * nt + fr, j0 = 16 * mt + 4 * fq; f32x4 acc = {0.f, 0.f, 0.f, 0.f}; MMA2(acc, xp, yb);
                  const float wc = WCs[jp];
#pragma unroll
                  for (int e = 0; e < 4; ++e) acc[e] = (acc[e] + ((j0 + e == jp) ? 1.0f : 0.0f)) * wc;
                  st_bf4(G2 + (size_t)cid * 4096 + (unsigned)((nt * 2 + (mt >> 1)) * 512 + lane * 8 + (mt & 1) * 4), acc); }
                { const int i_ = 16 * mt + fr, jp0 = 16 * nt + 4 * fq; f32x4 acc = {0.f, 0.f, 0.f, 0.f}; MMA2(acc, yb, xu); MMA2(acc, yk, xv);
#pragma unroll
                  for (int e = 0; e < 4; ++e) acc[e] *= WCs[jp0 + e];
                  st_bf4(DM + (size_t)cid * 4096 + (unsigned)(i_ * 64 + jp0), acc); }
            }
        }
        SBARL();
    }
#undef W1_ISSUE
#undef LF2
#undef TR2
#undef MMA2
#undef WKV_PMSQ
#undef WKV_SQ
#undef WKV_PM
#undef AT
#undef SL
}

__device__ __forceinline__ void ph_wkv_carry(const Frame& F) {
    const bf16_t* G2 = (const bf16_t*)(F.ws + WS_G2); const bf16_t* DM = (const bf16_t*)(F.ws + WS_DM); bf16_t* ST = (bf16_t*)(F.ws + WS_ST);
    const int lane = F.lane, fr = lane & 15, fq = lane >> 4;
    const bool loader = F.wave >= 4; const int lw = F.wave - 4, i = 16 * (F.wave & 3) + fr;
    constexpr int NC = SEQ / 64;
    for (int ch = F.bid; ch < NB * NH; ch += F.G) {
        const size_t cbase = (size_t)ch * NC;
#define CARRY_ISSUE(c_) do { const int cc_ = (c_) < NC ? (c_) : NC - 1; const size_t cid_ = cbase + cc_; \
        _Pragma("unroll") for (int q_ = 0; q_ < 4; ++q_) { const int j_ = lw * 4 + q_; \
            const bf16_t* src_ = (j_ < 8 ? G2 + cid_ * 4096 + j_ * 512 : DM + cid_ * 4096 + (j_ - 8) * 512) + lane * 8; \
            __builtin_amdgcn_global_load_lds((const unsigned*)src_, (LAS unsigned*)(F.lds + ((c_) & 7) * 16384 + j_ * 1024), 16, 0, 0); } } while (0)
        f32x4 st[4];
#pragma unroll
        for (int r = 0; r < 4; ++r) st[r] = (f32x4){0.f, 0.f, 0.f, 0.f};
        bf16x8 gc[8]; u32x2 dc[4];
#define CARRY_RING_READ(c_) do { const LAS unsigned char* slot_ = F.lds + ((c_) & 7) * 16384; \
        _Pragma("unroll") for (int f = 0; f < 8; ++f) gc[f] = *(const LAS bf16x8*)(slot_ + f * 1024 + lane * 16); \
        _Pragma("unroll") for (int r = 0; r < 4; ++r) dc[r] = *(const LAS u32x2*)(slot_ + 8192 + (i * 64 + 16 * r + 4 * fq) * 2); } while (0)
        if (loader) {
#pragma unroll
            for (int c = 0; c < 7; ++c) CARRY_ISSUE(c);
            WAIT_V(20);
        }
        SBAR();
        if (!loader) CARRY_RING_READ(0);
#pragma unroll 1
        for (int c = 0; c < NC; ++c) {
            if (loader) {
                CARRY_ISSUE(c + 7);
                WAIT_V(20);
            } else {
                const size_t cid = cbase + c;
                union { bf16x8 v; unsigned u[4]; } b0, b1;
                b0.u[0] = pack2(st[0][0], st[0][1]); b0.u[1] = pack2(st[0][2], st[0][3]); b0.u[2] = pack2(st[1][0], st[1][1]); b0.u[3] = pack2(st[1][2], st[1][3]);
                b1.u[0] = pack2(st[2][0], st[2][1]); b1.u[1] = pack2(st[2][2], st[2][3]); b1.u[2] = pack2(st[3][0], st[3][1]); b1.u[3] = pack2(st[3][2], st[3][3]);
                f32x4 acc[4];
#pragma unroll
                for (int r = 0; r < 4; ++r) { acc[r] = (f32x4){lo2f(dc[r].x), hi2f(dc[r].x), lo2f(dc[r].y), hi2f(dc[r].y)};
                    acc[r] = __builtin_amdgcn_mfma_f32_16x16x32_bf16(gc[r * 2 + 0], b0.v, acc[r], 0, 0, 0); }
#pragma unroll
                for (int r = 0; r < 4; ++r) acc[r] = __builtin_amdgcn_mfma_f32_16x16x32_bf16(gc[r * 2 + 1], b1.v, acc[r], 0, 0, 0);
                { const unsigned wsl = (unsigned)(F.wave & 3);
                  bf16_t* stp = ST + cid * 4096;
                  const unsigned ob = (unsigned)(((fr >> 2) * 2) * 512 + ((4 * wsl + (fr & 3)) * 4 + (fq >> 1)) * 8 + 4 * (fq & 1));
                  u32x2 w0; w0.x = b0.u[0]; w0.y = b0.u[1]; *(u32x2*)(stp + ob) = w0;
                  u32x2 w1; w1.x = b0.u[2]; w1.y = b0.u[3]; *(u32x2*)(stp + ob + 16) = w1;
                  u32x2 w2; w2.x = b1.u[0]; w2.y = b1.u[1]; *(u32x2*)(stp + ob + 512) = w2;
                  u32x2 w3; w3.x = b1.u[2]; w3.y = b1.u[3]; *(u32x2*)(stp + ob + 512 + 16) = w3; }
                if (c + 1 < NC) CARRY_RING_READ(c + 1);
#pragma unroll
                for (int r = 0; r < 4; ++r) st[r] = acc[r];
            }
            SBAR();
        }
        if (loader) WAIT_V(0);
        SBAR();
#undef CARRY_RING_READ
#undef CARRY_ISSUE
    }
}

__device__ __forceinline__ void ph_wkv_out(const Frame& F) {
    const bf16_t* RP = (const bf16_t*)(F.ws + WS_RP); const bf16_t* OL = (const bf16_t*)(F.ws + WS_OL); const bf16_t* ST = (const bf16_t*)(F.ws + WS_ST);
    const bf16_t* Vb = (const bf16_t*)(F.ws + WS_RKV) + (size_t)2 * T * D; const bf16_t* GG = (const bf16_t*)(F.ws + WS_GG); const float* BONUS = (const float*)(F.ws + WS_BONUS);
    bf16_t* OG = (bf16_t*)(F.ws + WS_OG);
    const int lane = F.lane, fr = lane & 15, fq = lane >> 4;
    const int nunits = NB * NH * (SEQ / 64) * 4;
    for (int u0 = F.bid * NWAVES + F.wave; u0 < nunits; u0 += 2 * F.G * NWAVES) {
        bf16x8 rf[2][2], sf[2][4][2]; u32x4 ol0[2], ol1[2], v0[2], v1[2], g0[2], g1[2]; float bon[2]; f32x4 lg[2][4], lb[2][4];
        size_t tokv[2]; int chnv[2]; bool live[2];
#pragma unroll
        for (int j = 0; j < 2; ++j) {
            const int uj = u0 + j * F.G * NWAVES; live[j] = uj < nunits; const int u = live[j] ? uj : u0;
            const int cid = u >> 2, tt = u & 3, bh = cid / (SEQ / 64), c = cid % (SEQ / 64), b = bh / NH, h = bh % NH;
            const int t = 16 * tt + fr; const size_t tok = (size_t)b * SEQ + (size_t)c * 64 + t;
            const size_t oh = ((size_t)bh * SEQ + (size_t)c * 64 + t) * 64 + 16 * fq;
#pragma unroll
            for (int ks = 0; ks < 2; ++ks) rf[j][ks] = *(const bf16x8*)(RP + (size_t)cid * 4096 + (tt * 2 + ks) * 512 + (fr * 4 + fq) * 8);
#pragma unroll
            for (int n = 0; n < 4; ++n)
#pragma unroll
                for (int ks = 0; ks < 2; ++ks) sf[j][n][ks] = *(const bf16x8*)(ST + (size_t)cid * 4096 + (n * 2 + ks) * 512 + (fr * 4 + fq) * 8);
            ol0[j] = *(const u32x4*)(OL + (size_t)cid * 4096 + t * 64 + 16 * fq); ol1[j] = *(const u32x4*)(OL + (size_t)cid * 4096 + t * 64 + 16 * fq + 8);
            v0[j] = *(const u32x4*)(Vb + oh); v1[j] = *(const u32x4*)(Vb + oh + 8); g0[j] = *(const u32x4*)(GG + oh); g1[j] = *(const u32x4*)(GG + oh + 8);
            bon[j] = BONUS[tok * NH + h];
            tokv[j] = tok; chnv[j] = h * 64 + 16 * fq;
#pragma unroll
            for (int n = 0; n < 4; ++n) { lg[j][n] = *(const f32x4*)(F.in[I_LNG] + chnv[j] + 4 * n); lb[j][n] = *(const f32x4*)(F.in[I_LNB] + chnv[j] + 4 * n); }
        }
#pragma unroll
        for (int j = 0; j < 2; ++j) {
            f32x4 acc[4];
            acc[0] = (f32x4){lo2f(ol0[j][0]), hi2f(ol0[j][0]), lo2f(ol0[j][1]), hi2f(ol0[j][1])}; acc[1] = (f32x4){lo2f(ol0[j][2]), hi2f(ol0[j][2]), lo2f(ol0[j][3]), hi2f(ol0[j][3])};
            acc[2] = (f32x4){lo2f(ol1[j][0]), hi2f(ol1[j][0]), lo2f(ol1[j][1]), hi2f(ol1[j][1])}; acc[3] = (f32x4){lo2f(ol1[j][2]), hi2f(ol1[j][2]), lo2f(ol1[j][3]), hi2f(ol1[j][3])};
#pragma unroll
            for (int n = 0; n < 4; ++n)
#pragma unroll
                for (int ks = 0; ks < 2; ++ks) acc[n] = __builtin_amdgcn_mfma_f32_16x16x32_bf16(sf[j][n][ks], rf[j][ks], acc[n], 0, 0, 0);
            float s = 0.f;
#pragma unroll
            for (int n = 0; n < 4; ++n) s += (acc[n][0] + acc[n][1]) + (acc[n][2] + acc[n][3]);
            s += __shfl_xor(s, 16); s += __shfl_xor(s, 32);
            const float mean = s * (1.0f / 64.0f);
            float q = 0.f;
#pragma unroll
            for (int n = 0; n < 4; ++n)
#pragma unroll
                for (int e = 0; e < 4; ++e) { const float d = acc[n][e] - mean; q += d * d; }
            q += __shfl_xor(q, 16); q += __shfl_xor(q, 32);
            const float rstd = rsqrtf(q * (1.0f / 64.0f) + 64e-5f);
            u32x4 o0, o1;
#pragma unroll
            for (int n = 0; n < 4; ++n) {
                const unsigned vw0 = n < 2 ? v0[j][2 * n] : v1[j][2 * n - 4], vw1 = n < 2 ? v0[j][2 * n + 1] : v1[j][2 * n - 3], gw0 = n < 2 ? g0[j][2 * n] : g1[j][2 * n - 4], gw1 = n < 2 ? g0[j][2 * n + 1] : g1[j][2 * n - 3];
                const f32x4 vv = {lo2f(vw0), hi2f(vw0), lo2f(vw1), hi2f(vw1)}, gg = {lo2f(gw0), hi2f(gw0), lo2f(gw1), hi2f(gw1)};
                const f32x4 res = (((acc[n] - mean) * rstd) * lg[j][n] + lb[j][n] + vv * bon[j]) * gg;
                const unsigned w0 = pack2(res[0], res[1]), w1 = pack2(res[2], res[3]);
                if (n == 0) { o0[0] = w0; o0[1] = w1; } else if (n == 1) { o0[2] = w0; o0[3] = w1; } else if (n == 2) { o1[0] = w0; o1[1] = w1; } else { o1[2] = w0; o1[3] = w1; }
            }
            if (live[j]) { *(u32x4*)(OG + tokv[j] * D + chnv[j]) = o0; *(u32x4*)(OG + tokv[j] * D + chnv[j] + 8) = o1; }
        }
    }
}

struct AttnTile { bf16x8 k[4][2]; bf16x8 v[4][2]; };
__device__ __forceinline__ void attn_load(AttnTile& tl, const bf16_t* kbase  , const bf16_t* vbase  ) {
#pragma unroll
    for (int kt = 0; kt < 4; ++kt)
#pragma unroll
        for (int ks = 0; ks < 2; ++ks) tl.k[kt][ks] = *(const bf16x8*)(kbase + (kt * 2 + ks) * 512);
#pragma unroll
    for (int dt = 0; dt < 4; ++dt)
#pragma unroll
        for (int ks = 0; ks < 2; ++ks) tl.v[dt][ks] = *(const bf16x8*)(vbase + (dt * 2 + ks) * 512);
}
template <bool MASK>
__device__ __forceinline__ void attn_tile(const AttnTile& tl, const bf16x8 (&qf)[2], f32x4 (&o)[4], float& R, int key0, int qpos, int fq) {
    constexpr float C2 = 0.125f * 1.4426950408889634f;
    f32x4 z[4];
#pragma unroll
    for (int kt = 0; kt < 4; ++kt) { z[kt] = (f32x4){0.f, 0.f, 0.f, 0.f};
#pragma unroll
        for (int ks = 0; ks < 2; ++ks) z[kt] = __builtin_amdgcn_mfma_f32_16x16x32_bf16(tl.k[kt][ks], qf[ks], z[kt], 0, 0, 0); }
    float sp[4][4], G[4];
#pragma unroll
    for (int kt = 0; kt < 4; ++kt) { G[kt] = 0.f;
#pragma unroll
        for (int e = 0; e < 4; ++e) { const float z2 = z[kt][e] * C2; z[kt][e] = z2;
            const float l2 = __builtin_amdgcn_logf(1.0f + __builtin_amdgcn_exp2f(z2));
            float spv = z2 > 30.f ? z2 : l2;
            if (MASK) spv = ((key0 + 16 * kt + 4 * fq + e) < qpos) ? spv : 0.f;
            sp[kt][e] = spv; G[kt] += spv; } }
    float sufg[4], tot[4];
#pragma unroll
    for (int kt = 0; kt < 4; ++kt) {
        const float g1 = __shfl_xor(G[kt], 16), g2 = __shfl_xor(G[kt], 32), g3 = __shfl_xor(G[kt], 48);
        tot[kt] = G[kt] + g1 + g2 + g3;
        sufg[kt] = (((fq ^ 1) > fq) ? g1 : 0.f) + (((fq ^ 2) > fq) ? g2 : 0.f) + (((fq ^ 3) > fq) ? g3 : 0.f);
    }
    float later = 0.f;
    union { bf16x8 v; unsigned w[4]; } p0, p1;
#pragma unroll
    for (int kt = 3; kt >= 0; --kt) {
        float run = R + later + sufg[kt];
        float wv[4];
#pragma unroll
        for (int e = 3; e >= 0; --e) { float w = __builtin_amdgcn_exp2f(z[kt][e] - sp[kt][e] - run);
            if (MASK) w = ((key0 + 16 * kt + 4 * fq + e) < qpos) ? w : 0.f;
            wv[e] = w; run += sp[kt][e]; }
        const unsigned w01 = pgx::cvt_pk_bf16(wv[0], wv[1]), w23 = pgx::cvt_pk_bf16(wv[2], wv[3]);
        if (kt == 0) { p0.w[0] = w01; p0.w[1] = w23; } else if (kt == 1) { p0.w[2] = w01; p0.w[3] = w23; } else if (kt == 2) { p1.w[0] = w01; p1.w[1] = w23; } else { p1.w[2] = w01; p1.w[3] = w23; }
        later += tot[kt];
    }
    R += later;
#pragma unroll
    for (int dt = 0; dt < 4; ++dt) {
        o[dt] = __builtin_amdgcn_mfma_f32_16x16x32_bf16(tl.v[dt][0], p0.v, o[dt], 0, 0, 0);
        o[dt] = __builtin_amdgcn_mfma_f32_16x16x32_bf16(tl.v[dt][1], p1.v, o[dt], 0, 0, 0);
    }
}
__device__ __forceinline__ void attn_unit(const Frame& F, const int bh, const int qt) {
    const bf16_t* Q = (const bf16_t*)(F.ws + WS_Q); const bf16_t* Kb = Q + (size_t)T * D; const bf16_t* VT = Q + (size_t)2 * T * D;
    bf16_t* AO = (bf16_t*)(F.ws + WS_AO);
    const int lane = F.lane, fr = lane & 15, fq = lane >> 4;
    constexpr float EXIT2 = SB_EXIT * 1.4426950408889634f;
    const int b = bh / NH, h = bh % NH;
    const int q0 = qt * 16, qpos = q0 + fr;
    const size_t tb = (size_t)b * SEQ;
    bf16x8 qf[2];
#pragma unroll
    for (int ks = 0; ks < 2; ++ks) qf[ks] = *(const bf16x8*)(Q + (tb + qpos) * D + h * 64 + ks * 32 + fq * 8);
    f32x4 o[4];
#pragma unroll
    for (int dt = 0; dt < 4; ++dt) o[dt] = (f32x4){0.f, 0.f, 0.f, 0.f};
    float R = 0.f;
    const bf16_t* kb = Kb + (size_t)bh * SEQ * 64 + (fr * 4 + fq) * 8;
    const bf16_t* vb = VT + (size_t)bh * SEQ * 64 + (fr * 4 + fq) * 8;
    int kt0 = (q0 + 15) / 64;
    AttnTile ta, tc;
    attn_load(ta, kb + (size_t)kt0 * 4096, vb + (size_t)kt0 * 4096);
    if (kt0 > 0) attn_load(tc, kb + (size_t)(kt0 - 1) * 4096, vb + (size_t)(kt0 - 1) * 4096);
    attn_tile<true>(ta, qf, o, R, kt0 * 64, qpos, fq);
    --kt0;
    while (kt0 >= 0 && !__all(R > EXIT2)) {
        if (kt0 > 0) attn_load(ta, kb + (size_t)(kt0 - 1) * 4096, vb + (size_t)(kt0 - 1) * 4096);
        attn_tile<false>(tc, qf, o, R, kt0 * 64, qpos, fq);
        --kt0;
        if (kt0 < 0 || __all(R > EXIT2)) break;
        if (kt0 > 0) attn_load(tc, kb + (size_t)(kt0 - 1) * 4096, vb + (size_t)(kt0 - 1) * 4096);
        attn_tile<false>(ta, qf, o, R, kt0 * 64, qpos, fq);
        --kt0;
    }
#pragma unroll
    for (int dt = 0; dt < 4; ++dt) st_bf4(AO + (tb + qpos) * D + h * 64 + 16 * dt + 4 * fq, o[dt]);
}
__device__ __forceinline__ void ph_attn(const Frame& F) {
    if (F.G == 256) {
        const int xq = F.bid & 7, lb = F.bid >> 3;
#pragma unroll 1
        for (int it = 0; it < 8; ++it) { const int ck = it * 32 + lb; attn_unit(F, xq + 8 * (ck >> 6), (ck & 63) * 8 + F.wave); }
    } else {
        unsigned* aq = F.ctl + CW_AQ;
        LAS unsigned* chunk_s = (LAS unsigned*)(F.lds + 1024);
        const unsigned myx = xb_xcc_id() & 7u;
        for (int qi = 0; qi < 8; ++qi) {
            const unsigned xq = (myx + (unsigned)qi) & 7u;
            for (;;) {
                __syncthreads();
                if (F.tid == 0) *chunk_s = atomicAdd(&aq[xq * 64], 1u);
                __syncthreads();
                const unsigned ck = *chunk_s;
                if (ck >= 256u) break;
                attn_unit(F, (int)xq + 8 * (int)(ck >> 6), (int)(ck & 63u) * 8 + F.wave);
            }
        }
    }
}

#ifndef USE_PGX
#define USE_PGX 0x1f
#endif
__device__ __forceinline__ int px_unit_index(int i, int G, int c, int nwg) {
    const long L = (long)i * G + c; if (L >= nwg) return -1;
    const int w = (int)L, q = nwg / 8, r = nwg % 8, xcd = w % 8, off = w / 8;
    return (xcd < r ? xcd * (q + 1) : r * (q + 1) + (xcd - r) * q) + off;
}
struct PxDense {
    const char* A; const char* B; int nM, nN, K, G, c; unsigned lda; int a_div; size_t a_stride;
    __device__ __forceinline__ bool next(int i, pgx::Unit& u) const {
        const int w = px_unit_index(i, G, c, nM * nN); if (w < 0) return false;
        const int pm = w / nN, pn = w % nN;
        u.A = A + (size_t)(pn / a_div) * a_stride + (size_t)pm * 256 * lda; u.tok = nullptr; u.B = B + (size_t)pn * 256 * K * 2; u.r0 = pm * 256; u.c0 = pn * 256; u.aux = 0; return true;
    }
};
__device__ __forceinline__ void px_store_bf16_perm(bf16_t* rowp, const f32x4& v0, const f32x4& v1) {
    u32x4 w; w.x = pgx::cvt_pk_bf16(v0[0], v0[1]); w.y = pgx::cvt_pk_bf16(v0[2], v0[3]); w.z = pgx::cvt_pk_bf16(v1[0], v1[1]); w.w = pgx::cvt_pk_bf16(v1[2], v1[3]); *(u32x4*)rowp = w;
}
__device__ __forceinline__ void ph_rkv_px(const Frame& F) {
    bf16_t* RKV = (bf16_t*)(F.ws + WS_RKV);
    PxDense S{(const char*)(F.ws + WS_XS), (const char*)(F.ws + WS_WRKV), 64, 12, D, F.G, F.bid, (unsigned)(D * 2), 4, (size_t)T * D * 2};
    pgx::gemm_phase<true, true>(F.lds, D, D * 2, S, [&](const f32x4 (&acc)[2][2][4][2], const pgx::Unit& u, int wr, int wc, int fr, int fq) {
        bf16_t* base = RKV + (size_t)(u.c0 / D) * T * D;
#pragma unroll
        for (int ai = 0; ai < 2; ++ai)
#pragma unroll
            for (int m = 0; m < 4; ++m) { const int t = u.r0 + ai * 128 + wr * 64 + m * 16 + fr;
#pragma unroll
                for (int bj = 0; bj < 2; ++bj) px_store_bf16_perm(base + hm_off(t, (u.c0 % D) + bj * 128 + wc * 32 + 8 * fq), acc[ai][bj][m][0], acc[ai][bj][m][1]); }
    });
}
__device__ __forceinline__ void ph_lora_dn_sg(const Frame& F) {
    const bf16_t* XS = (const bf16_t*)(F.ws + WS_XS); const bf16_t* WLDN = (const bf16_t*)(F.ws + WS_WLDN); bf16_t* LORA = (bf16_t*)(F.ws + WS_LORA);
    for (int u = F.bid; u < 64 * 4; u += F.G) {
        const int mt = u / 4, j = u % 4, n = (j == 0) ? 3 : (j == 1 ? 4 : 5);
        ASeg A; A.p[0] = XS + ((size_t)n * T + mt * 256) * D; A.p[1] = A.p[0]; A.p[2] = A.p[0]; A.segTiles = 16;
        bf16_t* out = LORA + (size_t)mt * 256 * 256 + j * 64;
        sg_tile<64>(F.lds, A, [](int R) { return (unsigned)R * (D * 2); }, WLDN + (size_t)(j * 64) * D, D, 16,
            [&](auto& acc, int r0, int c0, int fr, int fq) {
#pragma unroll
                for (int m = 0; m < EPI_MT(acc); ++m)
#pragma unroll
                    for (int q = 0; q < 4; ++q) { f32x4 v = acc[m][q];
                        if (j == 0) {
#pragma unroll
                            for (int e = 0; e < 4; ++e) v[e] = tanhf_(v[e]); }
                        else if (j >= 2) {
#pragma unroll
                            for (int e = 0; e < 4; ++e) v[e] = sigmoidf_(v[e]); }
                        st_bf4(out + (size_t)(r0 + 16 * m + fr) * 256 + c0 + 16 * q + 4 * fq, v); }
            });
    }
}
__device__ __forceinline__ void ph_dense_bf16_px(const Frame& F, const bf16_t* Ain, const bf16_t* Wt, bf16_t* out) {
    PxDense S{(const char*)Ain, (const char*)Wt, 64, 4, D, F.G, F.bid, (unsigned)(D * 2), 4, 0};
    pgx::gemm_phase<true, true>(F.lds, D, D * 2, S, [&](const f32x4 (&acc)[2][2][4][2], const pgx::Unit& u, int wr, int wc, int fr, int fq) {
        bf16_t* base = out + u.c0 + wc * 32 + 8 * fq;
#pragma unroll
        for (int ai = 0; ai < 2; ++ai)
#pragma unroll
            for (int m = 0; m < 4; ++m) { bf16_t* rowp = base + (size_t)(u.r0 + ai * 128 + wr * 64 + m * 16 + fr) * D;
#pragma unroll
                for (int bj = 0; bj < 2; ++bj) px_store_bf16_perm(rowp + bj * 128, acc[ai][bj][m][0], acc[ai][bj][m][1]); }
    });
}
__device__ __forceinline__ void ph_qkv_px(const Frame& F) {
    bf16_t* QK = (bf16_t*)(F.ws + WS_Q); bf16_t* VT = QK + (size_t)2 * T * D;
    { PxDense S{(const char*)(F.ws + WS_H3), (const char*)(F.ws + WS_WQKV), 64, 8, D, F.G, F.bid, (unsigned)(D * 2), 8, 0};
      pgx::gemm_phase<true, true>(F.lds, D, D * 2, S, [&](const f32x4 (&acc)[2][2][4][2], const pgx::Unit& u, int wr, int wc, int fr, int fq) {
        const bool isk = u.c0 >= D;
#pragma unroll
        for (int ai = 0; ai < 2; ++ai)
#pragma unroll
            for (int m = 0; m < 4; ++m) { const int t = u.r0 + ai * 128 + wr * 64 + m * 16 + fr;
#pragma unroll
                for (int bj = 0; bj < 2; ++bj) { const int c = (u.c0 % D) + bj * 128 + wc * 32 + 8 * fq;
                    const int sq = t % SEQ, dd = c & 63;
                    bf16_t* dst = isk ? QK + (size_t)T * D + (((size_t)((t / SEQ) * NH + (c >> 6)) * (SEQ / 16) + (sq >> 4)) * 2 + (dd >> 5)) * 512 + (sq & 15) * 32 + (dd & 31) : QK + (size_t)t * D + c;
                    px_store_bf16_perm(dst, acc[ai][bj][m][0], acc[ai][bj][m][1]); } }
      }); }
    { PxDense S{(const char*)(F.ws + WS_H3), (const char*)(F.ws + WS_WQKV) + (size_t)2 * D * D * 2, 64, 4, D, F.G, F.bid, (unsigned)(D * 2), 4, 0};
      pgx::gemm_phase<false, false>(F.lds, D, D * 2, S, [&](const f32x4 (&acc)[2][2][4][2], const pgx::Unit& u, int wr, int wc, int fr, int fq) {
#pragma unroll
        for (int ai = 0; ai < 2; ++ai)
#pragma unroll
            for (int m = 0; m < 4; ++m) { const int t = u.r0 + ai * 128 + wr * 64 + m * 16 + 4 * fq, b = t / SEQ, sidx = t % SEQ;
#pragma unroll
                for (int bj = 0; bj < 2; ++bj)
#pragma unroll
                    for (int n = 0; n < 2; ++n) { const int c = u.c0 + bj * 128 + wc * 32 + n * 16 + fr, h = c >> 6, d = c & 63;
                        const int k6 = sidx & 63, kk = k6 & 31;
                        st_bf4(VT + ((size_t)(b * NH + h) * (SEQ / 64) + (sidx >> 6)) * 4096 + ((d >> 4) * 2 + (k6 >> 5)) * 512 + ((d & 15) * 4 + ((kk & 15) >> 2)) * 8 + (kk >> 4) * 4, acc[ai][bj][m][n]); } }
      }); }
}
struct PxMoe {
    const char* Asrc; const int* TOK; const int* TILEE; const char* W; const char* Wsh; int routed, nmt, nN, K, G, c; unsigned lda; size_t wexp; bool gather;
    __device__ __forceinline__ bool next(int i, pgx::Unit& u) const {
        const int w = px_unit_index(i, G, c, nmt * nN); if (w < 0) return false;
        const int mt = w / nN, pn = w % nN, row0 = mt * 256; const bool sh = row0 >= routed; const int e = sh ? 64 : TILEE[mt];
        if (gather) { if (sh) { u.A = Asrc + (size_t)(row0 - routed) * lda; u.tok = nullptr; } else { u.A = Asrc; u.tok = TOK + row0; } }
        else { u.A = Asrc + (size_t)row0 * lda; u.tok = nullptr; }
        u.B = (sh ? Wsh : W + (size_t)e * wexp) + (size_t)pn * 256 * K * 2; u.r0 = row0; u.c0 = pn * 256; u.aux = 0; return true;
    }
};
__device__ __forceinline__ void ph_gateup_px(const Frame& F, int layer) {
    bf16_t* HB = (bf16_t*)(F.ws + WS_HB); const int* START = (const int*)(F.ws + WS_START);
    const int routed = START[65], nmt = (routed + T) / 256;
    PxMoe S{(const char*)(F.ws + WS_H2), (const int*)(F.ws + WS_TOK), (const int*)(F.ws + WS_TILEE), (const char*)(F.ws + (layer == 0 ? WS_WGU : WS_WGU1)), (const char*)(F.ws + WS_WGU) + (size_t)64 * 512 * D * 2, routed, nmt, 2, D, F.G, F.bid, (unsigned)(D * 2), (size_t)512 * D * 2, true};
    pgx::gemm_phase<true, true>(F.lds, D, D * 2, S, [&](const f32x4 (&acc)[2][2][4][2], const pgx::Unit& u, int wr, int wc, int fr, int fq) {
        bf16_t* base = HB + (u.c0 >> 1) + wc * 32 + 8 * fq;
#pragma unroll
        for (int ai = 0; ai < 2; ++ai)
#pragma unroll
            for (int m = 0; m < 4; ++m) { f32x4 v[2];
#pragma unroll
                for (int n = 0; n < 2; ++n)
#pragma unroll
                    for (int e = 0; e < 4; ++e) { const float g = acc[ai][0][m][n][e]; v[n][e] = g * sigmoidf_(g) * acc[ai][1][m][n][e]; }
                px_store_bf16_perm(base + (size_t)(u.r0 + ai * 128 + wr * 64 + m * 16 + fr) * DE, v[0], v[1]); }
    });
}
__device__ __forceinline__ void ph_down_px(const Frame& F) {
    bf16_t* YB = (bf16_t*)(F.ws + WS_YB); const int* START = (const int*)(F.ws + WS_START);
    const int routed = START[65], nmt = (routed + T) / 256;
    PxMoe S{(const char*)(F.ws + WS_HB), nullptr, (const int*)(F.ws + WS_TILEE), (const char*)(F.ws + WS_WDN), (const char*)(F.ws + WS_WDN) + (size_t)64 * D * DE * 2, routed, nmt, 4, DE, F.G, F.bid, (unsigned)(DE * 2), (size_t)D * DE * 2, false};
    pgx::gemm_phase<true, true>(F.lds, DE, DE * 2, S, [&](const f32x4 (&acc)[2][2][4][2], const pgx::Unit& u, int wr, int wc, int fr, int fq) {
        unsigned char* base = (unsigned char*)YB + u.c0 + wc * 32 + 8 * fq;
#pragma unroll
        for (int ai = 0; ai < 2; ++ai)
#pragma unroll
            for (int m = 0; m < 4; ++m) { unsigned char* rowp = base + (size_t)(u.r0 + ai * 128 + wr * 64 + m * 16 + fr) * D;
#pragma unroll
                for (int bj = 0; bj < 2; ++bj) { u32x2 w;
                    w.x = pack_fp8x4(acc[ai][bj][m][0]); w.y = pack_fp8x4(acc[ai][bj][m][1]);
                    *(u32x2*)(rowp + bj * 128) = w; }
                asm volatile("" ::: "memory"); }
    });
}

__global__ void __launch_bounds__(NTHREADS, 2) mega(Args args) {
    extern __shared__ __attribute__((aligned(16))) unsigned char lds[];
    Frame F;
    F.in = args.in; F.out = args.out; F.ws = args.ws; F.ctl = (unsigned*)(args.ws + WS_CTL);
    F.ldsf = (float*)lds; F.lds = (LAS unsigned char*)lds;
    F.tid = threadIdx.x; F.lane = F.tid & 63; F.wave = __builtin_amdgcn_readfirstlane(F.tid >> 6); F.bid = blockIdx.x; F.G = gridDim.x;
    if (F.tid < 4) ((unsigned*)(lds + LDS_BYTES - 64))[F.tid] = 0u;
    __syncthreads();
    XcdBarrier bar; bar.bar = F.ctl + CW_BAR; bar.x = 0; bar.st = (volatile LAS unsigned*)(lds + LDS_BYTES - 64);
#if MK_N_LAUNCHES == 1
    bar = xcd_barrier_post(F.ctl + CW_BAR, (volatile LAS unsigned*)(lds + LDS_BYTES - 64));
#endif
    const int lo = args.ph_lo, hi = args.ph_hi;
#define IN(k) (lo <= (k) && (k) < hi)
#define SEAM(k) do { if (IN(k) && IN((k) + 1)) xcd_barrier(bar); } while (0)
    bf16_t* const wsb = (bf16_t*)args.ws;
    (void)wsb;
    if (IN(0)) { ph_mod(F); conv_dense(F, 0, F.bid, F.G); if (F.G <= 2 * NB * NH) { conv_dense(F, 1, F.bid, F.G); conv_moe(F, 0, 3, F.bid, F.G); } } SEAM(0);
    if (IN(1)) { ph_prenorm_rwkv(F); } SEAM(1);
    if (IN(2)) { ph_rkv_px(F); ph_lora_dn_sg(F); } SEAM(2);
    if (IN(3)) { ph_lora_up_sg(F); } SEAM(3);
    if (IN(4)) { ph_wkv_chunk(F); } SEAM(4);
    if (IN(5)) { if (F.bid < NB * NH || F.G <= 2 * NB * NH) { ph_wkv_carry(F); } else { conv_dense(F, 1, F.bid - NB * NH, F.G - NB * NH); conv_moe(F, 0, 3, F.bid - NB * NH, F.G - NB * NH); conv_moe(F, 1, 1, F.bid - NB * NH, F.G - NB * NH); } } SEAM(5);
    if (IN(6)) { ph_wkv_out(F); } SEAM(6);
    if (IN(7)) { ph_dense_bf16_px(F, (const bf16_t*)(F.ws + WS_OG), (const bf16_t*)(F.ws + WS_WO), (bf16_t*)(F.ws + WS_Y1)); } SEAM(7);
    if (IN(8)) { ph_postmix_preffn<false>(F, 0, F.in[I_X], (const bf16_t*)(F.ws + WS_Y1)); } SEAM(8);
    if (IN(9)) { ph_router_sg(F, 0); } SEAM(9);
    if (IN(10)) { ph_topk(F, 0); } SEAM(10);
    if (IN(11)) { ph_offsets(F, 0); } SEAM(11);
    if (IN(12)) { ph_gateup_px(F, 0); } SEAM(12);
    if (IN(13)) { ph_down_px(F); } SEAM(13);
    if (IN(14)) { ph_combine(F, 0, true); conv_moe(F, 1, (F.G <= 2 * NB * NH) ? 3 : 2, F.bid, F.G); } SEAM(14);
    if (IN(15)) { ph_qkv_px(F); } SEAM(15);
    if (IN(16)) { ph_attn(F); } SEAM(16);
    if (IN(17)) { ph_dense_bf16_px(F, (const bf16_t*)(F.ws + WS_AO), (const bf16_t*)(F.ws + WS_WSBO), (bf16_t*)(F.ws + WS_Y1B)); } SEAM(17);
    if (IN(18)) { ph_postmix_preffn<true>(F, 1, nullptr, (const bf16_t*)(F.ws + WS_Y1B)); } SEAM(18);
    if (IN(19)) { ph_router_sg(F, 1); } SEAM(19);
    if (IN(20)) { ph_topk(F, 1); } SEAM(20);
    if (IN(21)) { ph_offsets(F, 1); } SEAM(21);
    if (IN(22)) { ph_gateup_px(F, 1); } SEAM(22);
    if (IN(23)) { ph_down_px(F); } SEAM(23);
    if (IN(24)) { ph_combine(F, 1, false); }
#undef IN
#undef SEAM
}

extern "C" void kernel_launch(void* const* d_in, const int* in_sizes, int n_in, void* d_out, int out_size, void* d_ws, size_t ws_size, hipStream_t stream) {
    static int grid = 0;
    if (grid == 0) {
        if (n_in != 34 || in_sizes[0] != T * D || out_size != T * D || ws_size < WS_END) {
            fprintf(stderr, "kernel_launch: unexpected shapes: n_in %d in0 %d out %d ws %zu (need %zu)\n", n_in, n_in > 0 ? in_sizes[0] : -1, out_size, ws_size, (size_t)WS_END);
            grid = -1; return;
        }
        int dev = 0, cus = 0, per_cu = 0;
        if (hipGetDevice(&dev) != hipSuccess || hipDeviceGetAttribute(&cus, hipDeviceAttributeMultiprocessorCount, dev) != hipSuccess) { grid = -1; return; }
        if (hipFuncSetAttribute((const void*)mega, hipFuncAttributeMaxDynamicSharedMemorySize, LDS_BYTES) != hipSuccess) { fprintf(stderr, "kernel_launch: hipFuncSetAttribute failed\n"); grid = -1; return; }
        if (hipOccupancyMaxActiveBlocksPerMultiprocessor(&per_cu, (const void*)mega, NTHREADS, LDS_BYTES) != hipSuccess || per_cu < 1)
            fprintf(stderr, "kernel_launch: occupancy query reports %d blocks per CU\n", per_cu);
        (void)hipGetLastError();
        grid = cus;
    }
    if (grid < 0) return;
    if (hipMemsetAsync((char*)d_ws + WS_CTL, 0, CTL_BYTES, stream) != hipSuccess) { fprintf(stderr, "kernel_launch: memset failed\n"); return; }
    Args a{};
    for (int i = 0; i < 34; ++i) a.in[i] = (const float*)d_in[i];
    a.out = (float*)d_out; a.ws = (unsigned char*)d_ws;
#if MK_N_LAUNCHES == 1
    a.ph_lo = 0; a.ph_hi = NPHASES;
    hipLaunchKernelGGL(mega, dim3(grid), dim3(NTHREADS), LDS_BYTES, stream, a);
#else
    for (int p = 0; p < NPHASES; ++p) { a.ph_lo = p; a.ph_hi = p + 1; hipLaunchKernelGGL(mega, dim3(grid), dim3(NTHREADS), LDS_BYTES, stream, a); }
#endif
    const hipError_t le = hipPeekAtLastError();
    if (le != hipSuccess) fprintf(stderr, "kernel_launch: launch failed: %s\n", hipGetErrorName(le));
}
```

```cpp
#include <hip/hip_runtime.h>
#include <cstdio>
#include <cstdint>

#ifndef MK_N_LAUNCHES
#define MK_N_LAUNCHES 1
#endif

constexpr int T = 16384, D = 1024, SEQ = 8192, NB = 2, NH = 16, HD = 64;
constexpr int NE = 64, TOPK = 8, DE = 256;
constexpr int RP = 256;
constexpr int MAXROUTED = 147456;
constexpr int MAXROWS = MAXROUTED + T;
constexpr int NTHREADS = 512, NWAVES = 8;
constexpr int NPHASES = 25;
constexpr int LDS_BYTES = 144 * 1024;
constexpr float YB_SCALE = 16.0f;

typedef unsigned short bf16_t;
typedef float f32x4 __attribute__((ext_vector_type(4)));
typedef unsigned u32x4 __attribute__((ext_vector_type(4)));
typedef unsigned u32x2 __attribute__((ext_vector_type(2)));

__device__ __forceinline__ float bf2f(bf16_t b) { return __uint_as_float(((unsigned)b) << 16); }
typedef __bf16 bf16x2_t __attribute__((ext_vector_type(2)));
typedef float f32x2 __attribute__((ext_vector_type(2)));
__device__ __forceinline__ unsigned pack2(float a, float b) { const f32x2 v = {a, b}; const bf16x2_t r = __builtin_convertvector(v, bf16x2_t); return __builtin_bit_cast(unsigned, r); }
__device__ __forceinline__ bf16_t f2bf(float f) { return (bf16_t)(pack2(f, 0.f) & 0xffffu); }
__device__ __forceinline__ float lo2f(unsigned u) { return __uint_as_float(u << 16); }
__device__ __forceinline__ float hi2f(unsigned u) { return __uint_as_float(u & 0xffff0000u); }
__device__ __forceinline__ f32x4 ld4_g(const bf16_t* p) { const u32x2 w = *(const u32x2*)p; return (f32x4){lo2f(w.x), hi2f(w.x), lo2f(w.y), hi2f(w.y)}; }
__device__ __forceinline__ float fexp_(float x) { return __builtin_amdgcn_exp2f(x * 1.4426950408889634f); }
__device__ __forceinline__ float sigmoidf_(float x) { return __builtin_amdgcn_rcpf(1.0f + fexp_(-x)); }
__device__ __forceinline__ float tanhf_(float x) { return 1.0f - 2.0f * __builtin_amdgcn_rcpf(1.0f + fexp_(2.0f * x)); }
__device__ __forceinline__ float softplusf_(float x) { const float e = fexp_(x); const float l = __builtin_amdgcn_logf(1.0f + e) * 0.6931471805599453f; return x > 15.f ? x : (x < -8.f ? e : l); }
__device__ __forceinline__ float wave_sum(float v) {
#pragma unroll
    for (int o = 32; o >= 1; o >>= 1) v += __shfl_xor(v, o);
    return v;
}

constexpr size_t MiB = 1024 * 1024;
constexpr size_t WS_CTL    = 0;
constexpr size_t CTL_BYTES = 64 * 1024;
constexpr size_t WS_MOD    = 64 * 1024;
constexpr size_t WS_IDX    = 256 * 1024;
constexpr size_t WS_GATE   = WS_IDX + 512 * 1024;
constexpr size_t WS_RANK   = WS_GATE + 512 * 1024;
constexpr size_t WS_POS    = WS_RANK + 512 * 1024;
constexpr size_t WS_TOK    = WS_POS + 512 * 1024;
constexpr size_t WS_TILEE  = WS_TOK + 704 * 1024;
constexpr size_t WS_START  = WS_TILEE + 4096;
constexpr size_t WS_LOGITS = 8 * MiB + 64 * MiB;
constexpr size_t WS_BC     = 4 * MiB;
constexpr size_t WS_BIG    = 8 * MiB;
constexpr size_t WS_XS   = WS_BIG;
constexpr size_t WS_RKV  = WS_BIG + 192 * MiB;
constexpr size_t WS_LORA = WS_BIG + 288 * MiB;
constexpr size_t WS_LD   = WS_BIG;
constexpr size_t WS_AA   = WS_BIG + 64 * MiB;
constexpr size_t WS_GG   = WS_BIG + 96 * MiB;
constexpr size_t WS_O    = WS_BIG + 128 * MiB;
constexpr size_t WS_OG   = WS_BIG + 296 * MiB;
constexpr size_t WS_Y1   = WS_BIG + 328 * MiB;
constexpr size_t WS_H2   = WS_BIG;
constexpr size_t WS_H2LO = WS_BIG + 32 * MiB;
constexpr size_t WS_YB   = WS_BIG;
constexpr size_t WS_HB   = WS_BIG + 320 * MiB;
constexpr size_t WS_H3   = WS_BIG + 320 * MiB;
constexpr size_t WS_Q    = WS_BIG;
constexpr size_t WS_AO   = WS_BIG + 96 * MiB;
constexpr size_t WS_XR   = WS_BIG + 256 * MiB;
constexpr size_t WS_Y1B  = WS_BIG + 128 * MiB;
constexpr size_t WS_W     = WS_BIG + 400 * MiB;
constexpr size_t WS_WGU1  = WS_BIG + 192 * MiB;
constexpr size_t WS_WGU   = WS_W;
constexpr size_t WS_WDN   = WS_WGU + (size_t)65 * 512 * 1024 * 2;
constexpr size_t WS_WRKV  = WS_WDN + (size_t)65 * 1024 * 256 * 2;
constexpr size_t WS_WO    = WS_WRKV + (size_t)3072 * 1024 * 2;
constexpr size_t WS_WQKV  = WS_WO + (size_t)1024 * 1024 * 2;
constexpr size_t WS_WSBO  = WS_WQKV + (size_t)3072 * 1024 * 2;
constexpr size_t WS_WLDN  = WS_WSBO + (size_t)1024 * 1024 * 2;
constexpr size_t WS_WLUP  = WS_WLDN + (size_t)256 * 1024 * 2;
constexpr size_t WS_WRT   = WS_WLUP + (size_t)1024 * 256 * 2;
constexpr size_t WS_END   = WS_WRT + (size_t)2 * 64 * 3072 * 2;

constexpr int CW_BAR = 0;
constexpr int CW_CNT = 4096;
constexpr int CW_AQ = 4608;

#define XB_TMO      128
#define XB_XCNT(j)  (256  + 64 * (j))
#define XB_XSUB(j)  (1280 + 64 * (j))
#define XB_XGEN(j)  (2304 + 64 * (j))
#define XB_TOP      3328
#define XB_TOPGEN   3392
#define XCD_BAR_WORDS 3456
#define XB_SPIN_CAP (1u << 22)
#define LAS __attribute__((address_space(3)))

__device__ __forceinline__ unsigned xb_ld(unsigned* p)              { return __hip_atomic_load(p, __ATOMIC_RELAXED, __HIP_MEMORY_SCOPE_AGENT); }
__device__ __forceinline__ unsigned xb_add(unsigned* p, unsigned v) { return __hip_atomic_fetch_add(p, v, __ATOMIC_RELAXED, __HIP_MEMORY_SCOPE_AGENT); }
__device__ __forceinline__ unsigned xb_xcc_id() { return (unsigned)__builtin_amdgcn_s_getreg((3 << 11) | 20) & 0xFu; }
#define XB_SPIN(cond, bar) do { unsigned _sp = 0; while (cond) { __builtin_amdgcn_s_sleep(1); \
    if ((++_sp & 255u) == 0u) { if (xb_ld(&(bar)[XB_TMO])) break; if (_sp > XB_SPIN_CAP) { atomicAdd(&(bar)[XB_TMO], 1u); break; } } } } while (0)

struct XcdBarrier { unsigned* bar; unsigned x; volatile LAS unsigned* st; };

__device__ __forceinline__ XcdBarrier xcd_barrier_post(unsigned* bar, volatile LAS unsigned* st) {
    XcdBarrier b; b.bar = bar; b.x = xb_xcc_id(); b.st = st;
    if (threadIdx.x == 0) (void)xb_add(&bar[XB_XCNT(b.x)], 1u);
    return b;
}
__device__ __forceinline__ void xcd_barrier_complete(unsigned* bar, unsigned x, unsigned& nloc, unsigned& nx) {
    const unsigned G = gridDim.x * gridDim.y * gridDim.z;
    unsigned sum, cnt, mine, sp = 0u;
    for (;;) {
        sum = 0u; cnt = 0u; mine = 0u;
#pragma unroll
        for (unsigned j = 0; j < 16; ++j) { const unsigned c = xb_ld(&bar[XB_XCNT(j)]); sum += c; cnt += (c > 0u) ? 1u : 0u; mine = (j == x) ? c : mine; }
        if (sum == G) break;
        __builtin_amdgcn_s_sleep(1);
        if ((++sp & 255u) == 0u) { if (xb_ld(&bar[XB_TMO])) break; if (sp > XB_SPIN_CAP) { atomicAdd(&bar[XB_TMO], 1u); break; } }
    }
    nloc = mine > 0u ? mine : 1u; nx = cnt > 0u ? cnt : 1u;
}
__device__ __forceinline__ void xcd_barrier(const XcdBarrier& b) {
    asm volatile("s_waitcnt vmcnt(0)" ::: "memory");
    __syncthreads();
    if (threadIdx.x == 0) {
        unsigned* bar = b.bar;
        __builtin_amdgcn_s_waitcnt(0);
        unsigned nloc = b.st[0], nx = b.st[1];
        if (nloc == 0u) { xcd_barrier_complete(bar, b.x, nloc, nx); b.st[0] = nloc; b.st[1] = nx; }
        const unsigned old = xb_add(&bar[XB_XSUB(b.x)], 1u);
        const unsigned gen = old / nloc;
        if (old + 1u == (gen + 1u) * nloc) {
            __builtin_amdgcn_fence(__ATOMIC_RELEASE, "agent");
            asm volatile("s_waitcnt vmcnt(0)" ::: "memory");
            const unsigned og = xb_add(&bar[XB_TOP], 1u);
            const unsigned tg = og / nx;
            if (og + 1u == (tg + 1u) * nx) xb_add(&bar[XB_TOPGEN], 1u);
            else XB_SPIN(xb_ld(&bar[XB_TOPGEN]) == tg, bar);
            __builtin_amdgcn_fence(__ATOMIC_ACQUIRE, "agent");
            xb_add(&bar[XB_XGEN(b.x)], 1u);
            asm volatile("s_waitcnt vmcnt(0)" ::: "memory");
        } else {
            XB_SPIN(xb_ld(&bar[XB_XGEN(b.x)]) == gen, bar);
            __builtin_amdgcn_fence(__ATOMIC_ACQUIRE, "agent");
            asm volatile("s_waitcnt vmcnt(0)" ::: "memory");
        }
    }
    __syncthreads();
}

struct Args { const float* in[34]; float* out; unsigned char* ws; int ph_lo, ph_hi; };

struct Frame {
    const float* const* in; float* out; unsigned char* ws; unsigned* ctl;
    float* ldsf; LAS unsigned char* lds; int tid, lane, wave, bid, G;
};

enum { I_X = 0, I_C, I_ADAW, I_ADAB, I_NPM, I_NPOM, I_NPF, I_NPOF, I_MU, I_WRKV, I_WW1, I_WW2, I_W0, I_WA1, I_WA2, I_A0, I_WG1, I_WG2,
       I_KK, I_KA, I_RK, I_LNG, I_LNB, I_WO, I_SBQKV, I_SBO, I_ROUTER, I_RBIAS, I_MG, I_MU_, I_MD, I_SG, I_SU, I_SD };


typedef short bf16x8 __attribute__((ext_vector_type(8)));
typedef short s16x4 __attribute__((ext_vector_type(4)));
constexpr int HTB = 128 * 64 * 2;
__device__ __forceinline__ int lds_byte(int r, int c) { const int st = (r >> 4) * 2 + (c >> 5), rr = r & 15, cc = c & 31, ob = rr * 64 + cc * 2; return st * 1024 + (ob ^ (((ob >> 9) & 1) << 5)); }
__device__ __forceinline__ void stage_rc(int b, int& R, int& C) { const int st = b / 1024, sb = b % 1024, swz = sb ^ (((sb >> 9) & 1) << 5); R = (st >> 1) * 16 + swz / 64; C = (st & 1) * 32 + (swz % 64) / 2; }
#define WAIT_V(n) asm volatile("s_waitcnt vmcnt(" #n ")" ::: "memory")
#define SBAR() do { asm volatile("" ::: "memory"); __builtin_amdgcn_s_barrier(); asm volatile("" ::: "memory"); } while (0)

struct ASeg { const bf16_t* p[3]; int segTiles; };

struct BRowId { __device__ __forceinline__ int operator()(int R) const { return R; } };
struct SgChain { int ph; bool pre; bool nvalid; ASeg nA; const bf16_t* nBt; int nldb; };
template <int BN, bool NSW = false, class ARow, class Epi, class BRow = BRowId>
__device__ __forceinline__ void sg_tile(LAS unsigned char* lds, const ASeg& A, const ARow& arow, const bf16_t* Bt, int ldb, int nt, const Epi& epi, const BRow& brow = BRow(), SgChain* ch = nullptr) {
    constexpr int WN = BN / 64, WM = 8 / WN, WR = 256 / WM, MT = WR / 16;
    int tid_ = threadIdx.x; asm volatile("" : "+v"(tid_));
    const int tid = tid_, wid = __builtin_amdgcn_readfirstlane(tid >> 6), lane = tid & 63, fr = lane & 15, fq = lane >> 4;
    const int wm = wid / WN, wn = wid % WN;
    unsigned aoffs[2][2], boffs[2];
#pragma unroll
    for (int i = 0; i < 2; ++i) { int R, C; stage_rc(tid * 16 + i * 8192, R, C);
        aoffs[0][i] = arow(R) + (unsigned)C * 2u; aoffs[1][i] = arow(128 + R) + (unsigned)C * 2u; boffs[i] = (unsigned)(brow(R) * ldb + C) * 2u; }
    const unsigned ldsw = (unsigned)wid * 1024u;
    f32x4 acc[MT][4];
#pragma unroll
    for (int m = 0; m < MT; ++m)
#pragma unroll
        for (int n = 0; n < 4; ++n) acc[m][n] = (f32x4){0.f, 0.f, 0.f, 0.f};
    const int arow0 = wm * WR, ah = arow0 >> 7, ar = arow0 & 127;
    const int aoff = ah * HTB + lds_byte(ar + fr, fq * 8), boff = 2 * HTB + lds_byte(wn * 64 + fr, fq * 8);
#define SG_STAGE_X(AX, BX, BO, kt, s) do { const int sg_ = (kt) / (AX).segTiles; const char* ab_ = (const char*)(sg_ == 0 ? (AX).p[0] : (sg_ == 1 ? (AX).p[1] : (AX).p[2])) + (size_t)((kt) - sg_ * (AX).segTiles) * 128; const char* bb_ = (const char*)(BX) + (size_t)(kt) * 128; \
        _Pragma("unroll") for (int h_ = 0; h_ < 2; ++h_) _Pragma("unroll") for (int i_ = 0; i_ < 2; ++i_) \
            __builtin_amdgcn_global_load_lds((const unsigned*)(ab_ + aoffs[h_][i_]), (LAS unsigned*)(lds + ((s) * 3 + h_) * HTB + ldsw + i_ * 8192), 16, 0, 0); \
        _Pragma("unroll") for (int i_ = 0; i_ < WN; ++i_) \
            __builtin_amdgcn_global_load_lds((const unsigned*)(bb_ + (BO)[i_]), (LAS unsigned*)(lds + ((s) * 3 + 2) * HTB + ldsw + i_ * 8192), 16, 0, 0); } while (0)
#define SG_STAGE(kt, s) SG_STAGE_X(A, Bt, boffs, kt, s)
    const int ph0 = ch ? ch->ph : 0;
    if (!(ch && ch->pre)) SG_STAGE(0, ph0);
    for (int t = 0; t < nt; ++t) {
        const int s = (ph0 + t) & 1;
        if (t + 1 < nt) { SG_STAGE(t + 1, s ^ 1); if (WN == 2) WAIT_V(6); else WAIT_V(5); }
        else if (ch && ch->nvalid) { unsigned nbo[2];
#pragma unroll
            for (int i = 0; i < 2; ++i) { int R, C; stage_rc(tid * 16 + i * 8192, R, C); nbo[i] = (unsigned)(brow(R) * ch->nldb + C) * 2u; }
            SG_STAGE_X(ch->nA, ch->nBt, nbo, 0, s ^ 1); if (WN == 2) WAIT_V(6); else WAIT_V(5); }
        else { WAIT_V(0); }
        SBAR();
        LAS unsigned char* base = lds + s * 3 * HTB;
#pragma unroll
        for (int k = 0; k < 2; ++k) {
            bf16x8 af[MT], bfr[4];
#pragma unroll
            for (int m = 0; m < MT; ++m) af[m] = *(const LAS bf16x8*)(base + aoff + m * 2048 + k * 1024);
#pragma unroll
            for (int n = 0; n < 4; ++n) bfr[n] = *(const LAS bf16x8*)(base + boff + n * 2048 + k * 1024);
#pragma unroll
            for (int m = 0; m < MT; ++m)
#pragma unroll
                for (int n = 0; n < 4; ++n) acc[m][n] = NSW ? __builtin_amdgcn_mfma_f32_16x16x32_bf16(af[m], bfr[n], acc[m][n], 0, 0, 0) : __builtin_amdgcn_mfma_f32_16x16x32_bf16(bfr[n], af[m], acc[m][n], 0, 0, 0);
        }
        SBAR();
    }
#undef SG_STAGE
#undef SG_STAGE_X
    if (ch) { ch->ph = (ph0 + nt) & 1; ch->pre = ch->nvalid; }
    epi(acc, arow0, wn * 64, fr, fq);
}

struct CTile { bf16_t* dst; const float* src; int dld, sld, ncols; float scale; };
template <class TF>
__device__ __forceinline__ void conv_tiles(const Frame& F, int ntiles, int u0, int ustride, const TF& tf) {
    unsigned* tl = (unsigned*)F.ldsf;
    const int i = F.tid & 31, kp0 = F.tid >> 5;
    if (u0 >= ntiles) return;
    CTile ct = tf(u0);
    f32x4 a[4], b[4];
#define CV_LOAD() do { _Pragma("unroll") for (int q = 0; q < 4; ++q) { const int kp = kp0 + 16 * q; \
        if (4 * i < ct.ncols) { a[q] = *(const f32x4*)(ct.src + (size_t)(2 * kp) * ct.sld + 4 * i); b[q] = *(const f32x4*)(ct.src + (size_t)(2 * kp + 1) * ct.sld + 4 * i); } } } while (0)
    CV_LOAD();
    for (int u = u0; u < ntiles; u += ustride) {
        const CTile cur = ct;
        if (4 * i < cur.ncols) {
#pragma unroll
            for (int q = 0; q < 4; ++q) { const int kp = kp0 + 16 * q;
#pragma unroll
                for (int e = 0; e < 4; ++e) tl[(4 * i + e) * 65 + kp] = pack2(a[q][e] * cur.scale, b[q][e] * cur.scale); }
        }
        __syncthreads();
        if (u + ustride < ntiles) { ct = tf(u + ustride); CV_LOAD(); }
        const int nb = F.tid >> 4, sgm = F.tid & 15;
#pragma unroll
        for (int q = 0; q < 4; ++q) { const int n = nb + 32 * q;
            if (n < cur.ncols) { u32x4 v;
#pragma unroll
                for (int e = 0; e < 4; ++e) v[e] = tl[n * 65 + sgm * 4 + e];
                *(u32x4*)(cur.dst + (size_t)n * cur.dld + sgm * 8) = v; } }
        __syncthreads();
    }
#undef CV_LOAD
}
__device__ __forceinline__ void conv_moe(const Frame& F, int layer, int parts, int u0, int ustride) {
    bf16_t* WGUr = (bf16_t*)(F.ws + (layer == 0 ? WS_WGU : WS_WGU1)); bf16_t* WGUs = (bf16_t*)(F.ws + WS_WGU) + (size_t)64 * 512 * D; bf16_t* WDN = (bf16_t*)(F.ws + WS_WDN);
    const float* const* in = F.in;
    const int nA = (parts & 1) ? 64 * 32 : 0, nB = (parts & 2) ? 32 + 65 * 16 : 0;
    conv_tiles(F, nA + nB, u0, ustride, [=](int u) {
        CTile c; c.ncols = 128;
        if (u < nA) { const int e = u >> 5, r = u & 31, up = r >> 4, kt = (r >> 1) & 7, nt = r & 1;
            const float* W = (up ? in[I_MU_] : in[I_MG]) + ((size_t)layer * NE + e) * D * DE;
            c.src = W + (size_t)kt * 128 * DE + nt * 128; c.sld = DE; c.dst = WGUr + ((size_t)e * 512 + nt * 256 + up * 128) * D + kt * 128; c.dld = D; c.scale = 1.0f; }
        else { const int v0 = u - nA;
            if (v0 < 32) { const int up = v0 >> 4, kt = (v0 >> 1) & 7, nt = v0 & 1;
                const float* W = (up ? in[I_SU] : in[I_SG]) + (size_t)layer * D * DE;
                c.src = W + (size_t)kt * 128 * DE + nt * 128; c.sld = DE; c.dst = WGUs + ((size_t)nt * 256 + up * 128) * D + kt * 128; c.dld = D; c.scale = 1.0f; }
            else { const int v1 = v0 - 32, e = v1 >> 4, v = v1 & 15, kt = v >> 3, nt = v & 7;
                const float* W = (e < 64) ? in[I_MD] + ((size_t)layer * NE + e) * DE * D : in[I_SD] + (size_t)layer * DE * D;
                c.src = W + (size_t)kt * 128 * D + nt * 128; c.sld = D; c.dst = WDN + ((size_t)e * D + nt * 128) * DE + kt * 128; c.dld = DE; c.scale = YB_SCALE; } }
        return c; });
}
__device__ __forceinline__ void conv_dense(const Frame& F, int part, int u0, int ustride) {
    bf16_t* WRKV = (bf16_t*)(F.ws + WS_WRKV); bf16_t* WO = (bf16_t*)(F.ws + WS_WO); bf16_t* WQKV = (bf16_t*)(F.ws + WS_WQKV); bf16_t* WSBO = (bf16_t*)(F.ws + WS_WSBO); bf16_t* WLDN = (bf16_t*)(F.ws + WS_WLDN);
    const float* const* in = F.in;
    const int gtid = u0 * NTHREADS + F.tid, gstride = ustride * NTHREADS;
    if (part == 0) {
        conv_tiles(F, 192 + 24, u0, ustride, [=](int u) {
            CTile c; c.dld = D; c.ncols = 128; c.scale = 1.0f;
            if (u < 192) { const int n = u / 64, kt = (u >> 3) & 7, nt = u & 7; c.src = in[I_WRKV] + (size_t)n * D * D + (size_t)kt * 128 * D + nt * 128; c.sld = D; c.dst = WRKV + ((size_t)n * D + nt * 128) * D + kt * 128; }
            else { const int v = u - 192, kt = v / 3, j = v % 3;
                if (j == 0) { c.src = in[I_WW1] + (size_t)kt * 128 * 64; c.sld = 64; c.dst = WLDN + kt * 128; c.ncols = 64; }
                else if (j == 1) { c.src = in[I_WA1] + (size_t)kt * 128 * 64; c.sld = 64; c.dst = WLDN + (size_t)64 * D + kt * 128; c.ncols = 64; }
                else { c.src = in[I_WG1] + (size_t)kt * 128 * 128; c.sld = 128; c.dst = WLDN + (size_t)128 * D + kt * 128; } }
            return c; });
        bf16_t* WLUP = (bf16_t*)(F.ws + WS_WLUP);
        for (int i = gtid; i < 1024 * 256; i += gstride) {
            float v;
            if (i < 1024 * 64) { const int n = i / 64, k = i % 64; v = F.in[I_WW2][k * D + n]; }
            else if (i < 2 * 1024 * 64) { const int j = i - 1024 * 64, n = j / 64, k = j % 64; v = F.in[I_WA2][k * D + n]; }
            else { const int j = i - 2 * 1024 * 64, n = j / 128, k = j % 128; v = F.in[I_WG2][k * D + n]; }
            WLUP[i] = f2bf(v);
        }
    } else {
        conv_tiles(F, 64 + 192 + 64, u0, ustride, [=](int u) {
            CTile c; c.dld = D; c.ncols = 128; c.scale = 1.0f;
            if (u < 64) { const int kt = u >> 3, nt = u & 7; c.src = in[I_WO] + (size_t)kt * 128 * D + nt * 128; c.sld = D; c.dst = WO + (size_t)nt * 128 * D + kt * 128; }
            else if (u < 256) { const int v = u - 64, kt = v / 24, nt = v % 24; c.src = in[I_SBQKV] + (size_t)kt * 128 * 3 * D + nt * 128; c.sld = 3 * D; c.dst = WQKV + (size_t)nt * 128 * D + kt * 128; }
            else { const int v = u - 256, kt = v >> 3, nt = v & 7; c.src = in[I_SBO] + (size_t)kt * 128 * D + nt * 128; c.sld = D; c.dst = WSBO + (size_t)nt * 128 * D + kt * 128; }
            return c; });
        bf16_t* WRT = (bf16_t*)(F.ws + WS_WRT);
        for (int i = gtid; i < 2 * 64 * 1024; i += gstride) {
            const int l = i / (64 * 1024), j = i % (64 * 1024), e = j / 1024, k = j % 1024;
            const float w = F.in[I_ROUTER][((size_t)l * D + k) * NE + e]; const bf16_t hi = f2bf(w), lo = f2bf(w - bf2f(hi));
            bf16_t* row = WRT + ((size_t)l * 64 + e) * 3072; row[k] = hi; row[1024 + k] = lo; row[2048 + k] = hi;
        }
    }
}

__device__ __forceinline__ unsigned pack_fp8x4(const f32x4& v) {
    const float lim = 440.0f;
    const float a = __builtin_amdgcn_fmed3f(v[0], -lim, lim), b = __builtin_amdgcn_fmed3f(v[1], -lim, lim), c = __builtin_amdgcn_fmed3f(v[2], -lim, lim), d = __builtin_amdgcn_fmed3f(v[3], -lim, lim);
    int w = __builtin_amdgcn_cvt_pk_fp8_f32(a, b, 0, false); w = __builtin_amdgcn_cvt_pk_fp8_f32(c, d, w, true); return (unsigned)w;
}
__device__ __forceinline__ void acc_fp8x16(float (&y)[16], const u32x4& w, float g) {
#pragma unroll
    for (int q = 0; q < 4; ++q) { const f32x2 lo = __builtin_amdgcn_cvt_pk_f32_fp8((int)w[q], false), hi = __builtin_amdgcn_cvt_pk_f32_fp8((int)w[q], true);
        y[4 * q] += g * lo.x; y[4 * q + 1] += g * lo.y; y[4 * q + 2] += g * hi.x; y[4 * q + 3] += g * hi.y; }
}
__device__ __forceinline__ void ph_mod(const Frame& F) {
    const float* c = F.in[I_C]; const float* W = F.in[I_ADAW]; const float* bias = F.in[I_ADAB];
    float* MOD = (float*)(F.ws + WS_MOD);
    float* red = F.ldsf;
    float* sc = F.ldsf + 1024;
    for (int i = F.tid; i < 2 * D; i += NTHREADS) { const float v = c[i]; sc[i] = v * sigmoidf_(v); }
    __syncthreads();
    for (int u = F.bid; u < 192; u += F.G) {
        const int l = u / 96, cg = u % 96, col = cg * 64 + F.lane;
        float s0 = 0.f, s1 = 0.f;
        const float* wp = W + ((size_t)l * D + F.wave * 128) * 6144 + col;
#pragma unroll 1
        for (int d0 = 0; d0 < 128; d0 += 32) {
            float wv[32];
#pragma unroll
            for (int d = 0; d < 32; ++d) wv[d] = wp[(size_t)(d0 + d) * 6144];
#pragma unroll
            for (int d = 0; d < 32; ++d) { const int dd = F.wave * 128 + d0 + d; s0 += sc[dd] * wv[d]; s1 += sc[D + dd] * wv[d]; }
        }
        red[(F.wave * 2 + 0) * 64 + F.lane] = s0; red[(F.wave * 2 + 1) * 64 + F.lane] = s1;
        __syncthreads();
        if (F.tid < 128) {
            const int b = F.tid >> 6, cc = F.tid & 63; float s = 0.f;
#pragma unroll
            for (int w = 0; w < 8; ++w) s += red[(w * 2 + b) * 64 + cc];
            MOD[(l * 2 + b) * 6144 + cg * 64 + cc] = s + bias[l * 6144 + cg * 64 + cc];
        }
        __syncthreads();
    }
}

__device__ __forceinline__ void ph_prenorm_rwkv(const Frame& F) {
    const float* x = F.in[I_X]; const float* g = F.in[I_NPM]; const float* mu = F.in[I_MU];
    const float* MOD = (const float*)(F.ws + WS_MOD);
    bf16_t* XS = (bf16_t*)(F.ws + WS_XS);
    constexpr int RUN_T = 8;
    const int nunits = T / RUN_T, c0 = 16 * F.lane;
    f32x4 m[6][4];
#pragma unroll
    for (int n = 0; n < 6; ++n)
#pragma unroll
        for (int i = 0; i < 4; ++i) m[n][i] = *(const f32x4*)(mu + n * D + c0 + 4 * i);
    for (int u = F.bid * NWAVES + F.wave; u < nunits; u += F.G * NWAVES) {
        const int t0 = u * RUN_T, b = t0 / SEQ;
        const float* shift = MOD + (0 * 2 + b) * 6144; const float* scale = shift + 1024;
        f32x4 gm[4], sh[4];
#pragma unroll
        for (int i = 0; i < 4; ++i) { const int c = c0 + 4 * i; const f32x4 gv = *(const f32x4*)(g + c), sc = *(const f32x4*)(scale + c); gm[i] = gv * (sc + 1.0f); sh[i] = *(const f32x4*)(shift + c); }
        f32x4 hp[4];
#pragma unroll
        for (int i = 0; i < 4; ++i) hp[i] = (f32x4){0.f, 0.f, 0.f, 0.f};
        const int tstart = (t0 % SEQ == 0) ? t0 : t0 - 1;
        for (int t = tstart; t < t0 + RUN_T; ++t) {
            f32x4 xv[4]; float ss = 0.f;
#pragma unroll
            for (int i = 0; i < 4; ++i) { xv[i] = *(const f32x4*)(x + (size_t)t * D + c0 + 4 * i); ss += xv[i][0] * xv[i][0] + xv[i][1] * xv[i][1] + xv[i][2] * xv[i][2] + xv[i][3] * xv[i][3]; }
            ss = wave_sum(ss);
            const float rs = rsqrtf(ss * (1.0f / D) + 1e-6f);
            f32x4 h[4];
#pragma unroll
            for (int i = 0; i < 4; ++i) h[i] = xv[i] * rs * gm[i] + sh[i];
            if (t >= t0) {
#pragma unroll
                for (int n = 0; n < 6; ++n) {
                    u32x4 w0, w1;
#pragma unroll
                    for (int i = 0; i < 4; ++i) {
                        const f32x4 v = h[i] + (hp[i] - h[i]) * m[n][i];
                        const unsigned a0 = pack2(v[0], v[1]), a1 = pack2(v[2], v[3]);
                        if (i == 0) { w0[0] = a0; w0[1] = a1; } else if (i == 1) { w0[2] = a0; w0[3] = a1; } else if (i == 2) { w1[0] = a0; w1[1] = a1; } else { w1[2] = a0; w1[3] = a1; }
                    }
                    bf16_t* dst = XS + ((size_t)n * T + t) * D + c0;
                    *(u32x4*)dst = w0; *(u32x4*)(dst + 8) = w1;
                }
            }
#pragma unroll
            for (int i = 0; i < 4; ++i) hp[i] = h[i];
        }
    }
}


template <bool XBF>
__device__ __forceinline__ void ph_postmix_preffn(const Frame& F, int layer, const float* xin, const bf16_t* Y) {
    const float* MOD = (const float*)(F.ws + WS_MOD);
    const float* gpo = F.in[I_NPOM] + layer * D; const float* gpf = F.in[I_NPF] + layer * D;
    bf16_t* H2 = (bf16_t*)(F.ws + WS_H2); bf16_t* H2LO = (bf16_t*)(F.ws + WS_H2LO); bf16_t* XR = (bf16_t*)(F.ws + WS_XR);
    const int c0 = 16 * F.lane;
    f32x4 gmp[4], gfs[4], shf[4]; int bcur = -1;
    for (int t = F.bid * NWAVES + F.wave; t < T; t += F.G * NWAVES) {
        const int b = t / SEQ;
        if (b != bcur) { bcur = b; const float* m = MOD + (layer * 2 + b) * 6144;
#pragma unroll
            for (int i = 0; i < 4; ++i) { const int c = c0 + 4 * i;
                gmp[i] = *(const f32x4*)(m + 2048 + c) * *(const f32x4*)(gpo + c);
                gfs[i] = *(const f32x4*)(gpf + c) * (*(const f32x4*)(m + 4096 + c) + 1.0f);
                shf[i] = *(const f32x4*)(m + 3072 + c); } }
        const u32x4 y0 = *(const u32x4*)(Y + (size_t)t * D + c0), y1 = *(const u32x4*)(Y + (size_t)t * D + c0 + 8);
        f32x4 xv[4];
        if (XBF) { const u32x4 a0 = *(const u32x4*)(XR + (size_t)t * D + c0), a1 = *(const u32x4*)(XR + (size_t)t * D + c0 + 8);
            xv[0] = (f32x4){lo2f(a0[0]), hi2f(a0[0]), lo2f(a0[1]), hi2f(a0[1])}; xv[1] = (f32x4){lo2f(a0[2]), hi2f(a0[2]), lo2f(a0[3]), hi2f(a0[3])};
            xv[2] = (f32x4){lo2f(a1[0]), hi2f(a1[0]), lo2f(a1[1]), hi2f(a1[1])}; xv[3] = (f32x4){lo2f(a1[2]), hi2f(a1[2]), lo2f(a1[3]), hi2f(a1[3])}; }
        else {
#pragma unroll
            for (int i = 0; i < 4; ++i) xv[i] = *(const f32x4*)(xin + (size_t)t * D + c0 + 4 * i); }
        f32x4 y[4];
        y[0] = (f32x4){lo2f(y0[0]), hi2f(y0[0]), lo2f(y0[1]), hi2f(y0[1])}; y[1] = (f32x4){lo2f(y0[2]), hi2f(y0[2]), lo2f(y0[3]), hi2f(y0[3])};
        y[2] = (f32x4){lo2f(y1[0]), hi2f(y1[0]), lo2f(y1[1]), hi2f(y1[1])}; y[3] = (f32x4){lo2f(y1[2]), hi2f(y1[2]), lo2f(y1[3]), hi2f(y1[3])};
        float ss = 0.f;
#pragma unroll
        for (int i = 0; i < 4; ++i) ss += y[i][0] * y[i][0] + y[i][1] * y[i][1] + y[i][2] * y[i][2] + y[i][3] * y[i][3];
        ss = wave_sum(ss);
        const float rs = rsqrtf(ss * (1.0f / D) + 1e-6f);
        f32x4 x1[4]; float s2 = 0.f;
#pragma unroll
        for (int i = 0; i < 4; ++i) { const int c = c0 + 4 * i;
            x1[i] = xv[i] + gmp[i] * (y[i] * rs);
            s2 += x1[i][0] * x1[i][0] + x1[i][1] * x1[i][1] + x1[i][2] * x1[i][2] + x1[i][3] * x1[i][3]; }
        { u32x4 r0, r1;
          r0[0] = pack2(x1[0][0], x1[0][1]); r0[1] = pack2(x1[0][2], x1[0][3]); r0[2] = pack2(x1[1][0], x1[1][1]); r0[3] = pack2(x1[1][2], x1[1][3]);
          r1[0] = pack2(x1[2][0], x1[2][1]); r1[1] = pack2(x1[2][2], x1[2][3]); r1[2] = pack2(x1[3][0], x1[3][1]); r1[3] = pack2(x1[3][2], x1[3][3]);
          *(u32x4*)(XR + (size_t)t * D + c0) = r0; *(u32x4*)(XR + (size_t)t * D + c0 + 8) = r1; }
        s2 = wave_sum(s2);
        const float rs2 = rsqrtf(s2 * (1.0f / D) + 1e-6f);
        u32x4 h0, h1, l0, l1;
#pragma unroll
        for (int i = 0; i < 4; ++i) {
            const f32x4 h = x1[i] * rs2 * gfs[i] + shf[i];
            const unsigned w0 = pack2(h[0], h[1]), w1 = pack2(h[2], h[3]);
            const unsigned v0 = pack2(h[0] - lo2f(w0), h[1] - hi2f(w0)), v1 = pack2(h[2] - lo2f(w1), h[3] - hi2f(w1));
            if (i == 0) { h0[0] = w0; h0[1] = w1; l0[0] = v0; l0[1] = v1; } else if (i == 1) { h0[2] = w0; h0[3] = w1; l0[2] = v0; l0[3] = v1; }
            else if (i == 2) { h1[0] = w0; h1[1] = w1; l1[0] = v0; l1[1] = v1; } else { h1[2] = w0; h1[3] = w1; l1[2] = v0; l1[3] = v1; }
        }
        *(u32x4*)(H2 + (size_t)t * D + c0) = h0; *(u32x4*)(H2 + (size_t)t * D + c0 + 8) = h1;
        *(u32x4*)(H2LO + (size_t)t * D + c0) = l0; *(u32x4*)(H2LO + (size_t)t * D + c0 + 8) = l1;
    }
}


__device__ __forceinline__ void ph_topk(const Frame& F, int layer) {
    const float* LOG = (const float*)(F.ws + WS_LOGITS); const float* rb = F.in[I_RBIAS] + layer * NE;
    int* IDX = (int*)(F.ws + WS_IDX); float* GATE = (float*)(F.ws + WS_GATE); int* RANK = (int*)(F.ws + WS_RANK);
    unsigned* BC = (unsigned*)(F.ws + WS_BC);
    unsigned* lcnt = (unsigned*)F.ldsf;
    const float bias = rb[F.lane];
    for (int base = F.bid * 64; base < T; base += F.G * 64) {
        if (F.tid < 64) lcnt[F.tid] = 0u;
        __syncthreads();
        float s[8], sel[8], tot[8], mysc[8]; int myidx[8]; unsigned lrank[8];
#pragma unroll
        for (int j = 0; j < 8; ++j) { const size_t o = (size_t)(base + F.wave * 8 + j) * NE + F.lane;
            s[j] = sigmoidf_(LOG[o] + LOG[(size_t)T * NE + o] + LOG[(size_t)2 * T * NE + o]); sel[j] = s[j] + bias; tot[j] = 0.f; mysc[j] = 0.f; myidx[j] = 0; }
#pragma unroll
        for (int k = 0; k < TOPK; ++k) {
            float bv[8]; int bi[8];
#pragma unroll
            for (int j = 0; j < 8; ++j) { bv[j] = sel[j]; bi[j] = F.lane; }
#pragma unroll
            for (int o = 32; o >= 1; o >>= 1) {
#pragma unroll
                for (int j = 0; j < 8; ++j) { const float ov = __shfl_xor(bv[j], o); const int oi = __shfl_xor(bi[j], o); const bool take = (ov > bv[j]) | ((ov == bv[j]) & (oi < bi[j]));     bv[j] = take ? ov : bv[j]; bi[j] = take ? oi : bi[j]; }
            }
#pragma unroll
            for (int j = 0; j < 8; ++j) { const float sc = __shfl(s[j], bi[j]); tot[j] += sc; const bool me = (F.lane == k); myidx[j] = me ? bi[j] : myidx[j]; mysc[j] = me ? sc : mysc[j]; sel[j] = (F.lane == bi[j]) ? -1e30f : sel[j]; }
        }
#pragma unroll
        for (int j = 0; j < 8; ++j) { const int t = base + F.wave * 8 + j; lrank[j] = 0u;
            if (F.lane < TOPK) { IDX[t * TOPK + F.lane] = myidx[j]; GATE[t * TOPK + F.lane] = 2.5f * mysc[j] / tot[j]; lrank[j] = atomicAdd(&lcnt[myidx[j]], 1u); } }
        __syncthreads();
        if (F.tid < 64) BC[(base >> 6) * 64 + F.tid] = lcnt[F.tid];
#pragma unroll
        for (int j = 0; j < 8; ++j) { const int t = base + F.wave * 8 + j; if (F.lane < TOPK) RANK[t * TOPK + F.lane] = (int)lrank[j]; }
        __syncthreads();
    }
}

__device__ __forceinline__ void ph_offsets(const Frame& F, int layer) {
    const unsigned* BC = (const unsigned*)(F.ws + WS_BC);
    const int* IDX = (const int*)(F.ws + WS_IDX); const int* RANK = (const int*)(F.ws + WS_RANK);
    int* POS = (int*)(F.ws + WS_POS); int* TOK = (int*)(F.ws + WS_TOK); int* TILEE = (int*)(F.ws + WS_TILEE); int* START = (int*)(F.ws + WS_START);
    int* sst = (int*)F.ldsf;
    constexpr int NG = T / 64;
    for (int g = F.bid; g < NG; g += F.G) {
        { const int e = F.tid & 63, part = F.tid >> 6; int tot = 0, pre = 0;
          for (int gg = part; gg < NG; gg += 8) { const int v = (int)BC[gg * 64 + e]; tot += v; if (gg < g) pre += v; }
          sst[512 + part * 64 + e] = tot; sst[1024 + part * 64 + e] = pre; }
        __syncthreads();
        if (F.tid < 64) { int tot = 0, pre = 0;
#pragma unroll
            for (int q = 0; q < 8; ++q) { tot += sst[512 + q * 64 + F.tid]; pre += sst[1024 + q * 64 + F.tid]; }
            sst[128 + F.tid] = tot; sst[256 + F.tid] = pre; }
        __syncthreads();
        if (F.tid == 0) { int acc = 0; for (int e = 0; e < NE; ++e) { const int c = sst[128 + e]; sst[e] = acc; acc += ((c + RP - 1) / RP) * RP; } sst[64] = acc; }
        __syncthreads();
        if (g == 0) {
            if (F.tid <= 64) START[F.tid] = sst[F.tid];
            if (F.tid == 65) START[65] = sst[64];
        }
        if (g == (NG > 1 ? 1 : 0)) { if (F.tid < NE) for (int i = sst[F.tid] / RP; i < sst[F.tid + 1] / RP; ++i) TILEE[i] = F.tid; }
        for (int e = (g + NG - 2) % NG; e < NE; e += NG) { const int c = sst[128 + e], lo = sst[e] + c, hi = sst[e + 1]; for (int r = lo + F.tid; r < hi; r += NTHREADS) TOK[r] = 0; }
        { const int sl = g * 64 * TOPK + F.tid;
          const int e = IDX[sl], p = sst[e] + sst[256 + e] + RANK[sl];
          POS[sl] = p; TOK[p] = sl / TOPK; }
        __syncthreads();
    }
}

__device__ __forceinline__ void ph_combine(const Frame& F, int layer, bool next) {
    const unsigned char* YB = (const unsigned char*)(F.ws + WS_YB); const int* POS = (const int*)(F.ws + WS_POS); const float* GATE = (const float*)(F.ws + WS_GATE);
    const int* START = (const int*)(F.ws + WS_START); const float* MOD = (const float*)(F.ws + WS_MOD);
    const float* gpo = F.in[I_NPOF] + layer * D;
    bf16_t* H3 = (bf16_t*)(F.ws + WS_H3); bf16_t* XR = (bf16_t*)(F.ws + WS_XR);
    const int routed = START[65], c0 = 16 * F.lane;
    f32x4 gmp[4], gfs[4], shf[4]; int bcur = -1;
    for (int t = F.bid * NWAVES + F.wave; t < T; t += F.G * NWAVES) {
        const int b = t / SEQ;
        if (b != bcur) { bcur = b; const float* m = MOD + (layer * 2 + b) * 6144;
#pragma unroll
            for (int i = 0; i < 4; ++i) { const int c = c0 + 4 * i; gmp[i] = *(const f32x4*)(m + 5120 + c) * *(const f32x4*)(gpo + c);
                if (next) { const float* m1 = MOD + ((layer + 1) * 2 + b) * 6144; const float* g1 = F.in[I_NPM] + (layer + 1) * D;
                    gfs[i] = *(const f32x4*)(g1 + c) * (*(const f32x4*)(m1 + 1024 + c) + 1.0f); shf[i] = *(const f32x4*)(m1 + c); } } }
        int pos[TOPK]; float gk[TOPK];
        { const u32x4 p0 = *(const u32x4*)(POS + t * TOPK), p1 = *(const u32x4*)(POS + t * TOPK + 4); const f32x4 g0 = *(const f32x4*)(GATE + t * TOPK), g1 = *(const f32x4*)(GATE + t * TOPK + 4);
#pragma unroll
          for (int k = 0; k < 4; ++k) { pos[k] = (int)p0[k]; pos[4 + k] = (int)p1[k]; gk[k] = g0[k]; gk[4 + k] = g1[k]; } }
        u32x4 rw[TOPK + 1];
        rw[TOPK] = *(const u32x4*)(YB + (size_t)(routed + t) * D + c0);
#pragma unroll
        for (int k = 0; k < TOPK; ++k) rw[k] = *(const u32x4*)(YB + (size_t)pos[k] * D + c0);
        float y[16];
#pragma unroll
        for (int e = 0; e < 16; ++e) y[e] = 0.f;
        acc_fp8x16(y, rw[TOPK], 1.0f / YB_SCALE);
#pragma unroll
        for (int k = 0; k < TOPK; ++k) acc_fp8x16(y, rw[k], gk[k] * (1.0f / YB_SCALE));
        float ss = 0.f;
#pragma unroll
        for (int e = 0; e < 16; ++e) ss += y[e] * y[e];
        ss = wave_sum(ss);
        const float rs = rsqrtf(ss * (1.0f / D) + 1e-6f);
        f32x4 x2[4]; float s2 = 0.f;
        const u32x4 a0 = *(const u32x4*)(XR + (size_t)t * D + c0), a1 = *(const u32x4*)(XR + (size_t)t * D + c0 + 8);
#pragma unroll
        for (int i = 0; i < 4; ++i) { const int c = c0 + 4 * i;
            const unsigned wa = (i < 2) ? a0[2 * (i & 1)] : a1[2 * (i & 1)], wb = (i < 2) ? a0[2 * (i & 1) + 1] : a1[2 * (i & 1) + 1];
            const f32x4 xv = {lo2f(wa), hi2f(wa), lo2f(wb), hi2f(wb)};
            const f32x4 yv = {y[4 * i], y[4 * i + 1], y[4 * i + 2], y[4 * i + 3]};
            x2[i] = xv + gmp[i] * (yv * rs);
            if (!next) *(f32x4*)(F.out + (size_t)t * D + c) = x2[i];
            s2 += x2[i][0] * x2[i][0] + x2[i][1] * x2[i][1] + x2[i][2] * x2[i][2] + x2[i][3] * x2[i][3]; }
        if (next) {
            { u32x4 r0, r1;
              r0[0] = pack2(x2[0][0], x2[0][1]); r0[1] = pack2(x2[0][2], x2[0][3]); r0[2] = pack2(x2[1][0], x2[1][1]); r0[3] = pack2(x2[1][2], x2[1][3]);
              r1[0] = pack2(x2[2][0], x2[2][1]); r1[1] = pack2(x2[2][2], x2[2][3]); r1[2] = pack2(x2[3][0], x2[3][1]); r1[3] = pack2(x2[3][2], x2[3][3]);
              *(u32x4*)(XR + (size_t)t * D + c0) = r0; *(u32x4*)(XR + (size_t)t * D + c0 + 8) = r1; }
            s2 = wave_sum(s2);
            const float rs2 = rsqrtf(s2 * (1.0f / D) + 1e-6f);
            u32x4 h0, h1;
#pragma unroll
            for (int i = 0; i < 4; ++i) {
                const f32x4 h = x2[i] * rs2 * gfs[i] + shf[i];
                const unsigned w0 = pack2(h[0], h[1]), w1 = pack2(h[2], h[3]);
                if (i == 0) { h0[0] = w0; h0[1] = w1; } else if (i == 1) { h0[2] = w0; h0[3] = w1; } else if (i == 2) { h1[0] = w0; h1[1] = w1; } else { h1[2] = w0; h1[3] = w1; } }
            *(u32x4*)(H3 + (size_t)t * D + c0) = h0; *(u32x4*)(H3 + (size_t)t * D + c0 + 8) = h1;
        }
    }
}

#define SB_EXIT 110.0f

namespace pgx {
__device__ __forceinline__ int perm32(int rho) { const int n = rho >> 4, i = rho & 15; return 8 * (i >> 2) + 4 * n + (i & 3); }
struct Unit { const char* A; const int* tok; const char* B; int r0, c0, aux; };
template <bool SW, bool PERM, class Sched, class Epi>
__device__ __forceinline__ void gemm_phase(LAS unsigned char* lds, const int K, const unsigned lda  , const Sched& S, const Epi& E) {
    int tid_ = threadIdx.x; asm volatile("" : "+v"(tid_));
    const int tid = tid_, wid = __builtin_amdgcn_readfirstlane(tid >> 6), lane = tid & 63, wr = wid >> 2, wc = wid & 3, fr = lane & 15, fq = lane >> 4;
    const int nt = K / 64;
    int Rr[2], Cc[2]; unsigned voffB[2];
#pragma unroll
    for (int i = 0; i < 2; ++i) { stage_rc(tid * 16 + i * 8192, Rr[i], Cc[i]); const int Rb = PERM ? ((Rr[i] & ~31) + perm32(Rr[i] & 31)) : Rr[i]; voffB[i] = (unsigned)(Rb * K + Cc[i]) * 2u; }
    const size_t kstep = 128, hstepB = (size_t)128 * K * 2;
    const unsigned ldsw = (unsigned)wid * 1024u;
    const int aoff = lds_byte(wr * 64 + fr, fq * 8), boff = lds_byte(wc * 32 + fr, fq * 8);
#define PX_SA(b, h) (((b) * 2 + (h)) * HTB)
#define PX_SB(b, h) ((4 + (b) * 2 + (h)) * HTB)
#define PX_STAGE(bufoff, gbase, voff) do { _Pragma("unroll") for (int _i = 0; _i < 2; ++_i) \
        __builtin_amdgcn_global_load_lds((const unsigned*)((const char*)(gbase) + (voff)[_i]), (LAS unsigned*)(lds + (bufoff) + ldsw + _i * 8192), 16, 0, 0); } while (0)
#define PX_LDA(dst, b, h) do { _Pragma("unroll") for (int m = 0; m < 4; ++m) _Pragma("unroll") for (int k = 0; k < 2; ++k) dst[m][k] = *(const LAS bf16x8*)(lds + PX_SA(b, h) + aoff + m * 2048 + k * 1024); } while (0)
#define PX_LDB(dst, b, h) do { _Pragma("unroll") for (int n = 0; n < 2; ++n) _Pragma("unroll") for (int k = 0; k < 2; ++k) dst[n][k] = *(const LAS bf16x8*)(lds + PX_SB(b, h) + boff + n * 2048 + k * 1024); } while (0)
#define PX_MMA(ai, bj, At, Bt) do { __builtin_amdgcn_s_setprio(1); _Pragma("unroll") for (int m = 0; m < 4; ++m) _Pragma("unroll") for (int n = 0; n < 2; ++n) _Pragma("unroll") for (int k = 0; k < 2; ++k) \
        acc[ai][bj][m][n] = SW ? __builtin_amdgcn_mfma_f32_16x16x32_bf16(Bt[n][k], At[m][k], acc[ai][bj][m][n], 0, 0, 0) : __builtin_amdgcn_mfma_f32_16x16x32_bf16(At[m][k], Bt[n][k], acc[ai][bj][m][n], 0, 0, 0); __builtin_amdgcn_s_setprio(0); } while (0)
#define PX_WAIT_L(n) asm volatile("s_waitcnt lgkmcnt(" #n ")" ::: "memory")
#define PX_BAR __builtin_amdgcn_s_barrier()
#define PX_SCHED __builtin_amdgcn_sched_barrier(0)
#define PX_OFFS(dst, un) do { _Pragma("unroll") for (int h_ = 0; h_ < 2; ++h_) _Pragma("unroll") for (int i_ = 0; i_ < 2; ++i_) { \
        const int row_ = h_ * 128 + Rr[i_]; const unsigned rid_ = (un).tok ? (unsigned)(un).tok[row_] : (unsigned)row_; dst[h_][i_] = rid_ * lda + (unsigned)Cc[i_] * 2u; } } while (0)
    Unit cur, nxt; int ui = 0;
    if (!S.next(0, cur)) return;
    f32x4 acc[2][2][4][2];
#pragma unroll
    for (int a = 0; a < 2; ++a)
#pragma unroll
        for (int b = 0; b < 2; ++b)
#pragma unroll
            for (int m = 0; m < 4; ++m)
#pragma unroll
                for (int n = 0; n < 2; ++n) acc[a][b][m][n] = (f32x4){0.f, 0.f, 0.f, 0.f};
    bf16x8 At[4][2], B0[2][2], B1[2][2];
    unsigned oc[2][2], on[2][2];
    PX_OFFS(oc, cur); asm volatile("" : "+v"(oc[0][0]), "+v"(oc[0][1]), "+v"(oc[1][0]), "+v"(oc[1][1]));
    const char* cA = cur.A; const char* cB = cur.B;
    PX_STAGE(PX_SB(0, 0), cB, voffB); PX_STAGE(PX_SA(0, 0), cA, oc[0]); PX_STAGE(PX_SB(0, 1), cB + hstepB, voffB); PX_STAGE(PX_SA(0, 1), cA, oc[1]);
    if (wr == 1) PX_BAR;
    WAIT_V(4); PX_BAR;
    PX_STAGE(PX_SB(1, 0), cB + kstep, voffB); PX_STAGE(PX_SA(1, 0), cA + kstep, oc[0]); PX_STAGE(PX_SB(1, 1), cB + hstepB + kstep, voffB);
    WAIT_V(6); PX_BAR;
    for (;;) {
        const bool has_next = S.next(ui + 1, nxt);
        const char* nA = has_next ? nxt.A : cA; const char* nB = has_next ? nxt.B : cB;
        if (has_next) { PX_OFFS(on, nxt); asm volatile("" : "+v"(on[0][0]), "+v"(on[0][1]), "+v"(on[1][0]), "+v"(on[1][1])); } else {
#pragma unroll
            for (int h_ = 0; h_ < 2; ++h_)
#pragma unroll
                for (int i_ = 0; i_ < 2; ++i_) on[h_][i_] = oc[h_][i_]; }
#pragma unroll 1
        for (int t = 0; t < nt; t += 2) {
            const bool last = (t == nt - 2);
            const char* a1 = cA + (size_t)(t + 1) * kstep;
            const char* a2 = last ? nA : cA + (size_t)(t + 2) * kstep; const char* b2 = last ? nB : cB + (size_t)(t + 2) * kstep;
            const char* a3 = a2 + kstep; const char* b3 = b2 + kstep;
            unsigned o2[2][2];
#pragma unroll
            for (int h_ = 0; h_ < 2; ++h_)
#pragma unroll
                for (int i_ = 0; i_ < 2; ++i_) o2[h_][i_] = last ? on[h_][i_] : oc[h_][i_];
            PX_LDB(B0, 0, 0); PX_SCHED; PX_LDA(At, 0, 0); PX_STAGE(PX_SA(1, 1), a1, oc[1]);
            PX_WAIT_L(8); PX_BAR; PX_WAIT_L(0); PX_MMA(0, 0, At, B0); PX_BAR; PX_SCHED;
            PX_LDB(B1, 0, 1); PX_STAGE(PX_SB(0, 0), b2, voffB);
            PX_BAR; PX_WAIT_L(0); PX_MMA(0, 1, At, B1); PX_BAR;
            PX_LDA(At, 0, 1); PX_STAGE(PX_SA(0, 0), a2, o2[0]);
            PX_BAR; PX_WAIT_L(0); PX_MMA(1, 0, At, B0); PX_BAR; PX_SCHED;
            PX_STAGE(PX_SB(0, 1), b2 + hstepB, voffB);
            WAIT_V(6); PX_BAR; PX_MMA(1, 1, At, B1); PX_BAR;
            PX_LDB(B0, 1, 0); PX_SCHED; PX_LDA(At, 1, 0); PX_STAGE(PX_SA(0, 1), a2, o2[1]);
            PX_WAIT_L(8); PX_BAR; PX_WAIT_L(0); PX_MMA(0, 0, At, B0); PX_BAR; PX_SCHED;
            PX_LDB(B1, 1, 1); PX_STAGE(PX_SB(1, 0), b3, voffB);
            PX_BAR; PX_WAIT_L(0); PX_MMA(0, 1, At, B1); PX_BAR;
            PX_LDA(At, 1, 1); PX_STAGE(PX_SA(1, 0), a3, o2[0]);
            PX_BAR; PX_WAIT_L(0); PX_MMA(1, 0, At, B0); PX_BAR; PX_SCHED;
            PX_STAGE(PX_SB(1, 1), b3 + hstepB, voffB);
            WAIT_V(6); PX_BAR; PX_MMA(1, 1, At, B1); PX_BAR;
        }
        E(acc, cur, wr, wc, fr, fq);
        if (!has_next) break;
#pragma unroll
        for (int a = 0; a < 2; ++a)
#pragma unroll
            for (int b = 0; b < 2; ++b)
#pragma unroll
                for (int m = 0; m < 4; ++m)
#pragma unroll
                    for (int n = 0; n < 2; ++n) acc[a][b][m][n] = (f32x4){0.f, 0.f, 0.f, 0.f};
        cur = nxt; cA = nA; cB = nB; ++ui;
#pragma unroll
        for (int h_ = 0; h_ < 2; ++h_)
#pragma unroll
            for (int i_ = 0; i_ < 2; ++i_) oc[h_][i_] = on[h_][i_];
    }
    WAIT_V(0);
    if (wr == 0) PX_BAR;
    PX_BAR;
#undef PX_SA
#undef PX_SB
#undef PX_STAGE
#undef PX_LDA
#undef PX_LDB
#undef PX_MMA
#undef PX_WAIT_L
#undef PX_BAR
#undef PX_SCHED
#undef PX_OFFS
}
__device__ __forceinline__ unsigned cvt_pk_bf16(float lo, float hi) { return pack2(lo, hi); }
}

__device__ __forceinline__ size_t hm_off(int t, int c) { return ((size_t)((t / SEQ) * NH + (c >> 6)) * SEQ + (t % SEQ)) * 64 + (c & 63); }
#define EPI_MT(acc) (int)(sizeof(acc) / sizeof(acc[0]))
__device__ __forceinline__ void st_bf4(bf16_t* p, const f32x4& v) { u32x2 w; w.x = pack2(v[0], v[1]); w.y = pack2(v[2], v[3]); *(u32x2*)p = w; }

__device__ __forceinline__ void ph_lora_up_sg(const Frame& F) {
    const bf16_t* LORA = (const bf16_t*)(F.ws + WS_LORA); const bf16_t* WLUP = (const bf16_t*)(F.ws + WS_WLUP);
    bf16_t* LD = (bf16_t*)(F.ws + WS_LD); bf16_t* AA = (bf16_t*)(F.ws + WS_AA); bf16_t* GG = (bf16_t*)(F.ws + WS_GG);
    f32x4 w0v[4], a0v[4]; int pcol = -1;
    SgChain ch; ch.ph = 0; ch.pre = false;
    for (int u = F.bid; u < 3 * 64 * 8; u += F.G) {
        const int which = u / 512, v = u % 512, mt = v / 8, col0 = (v % 8) * 128;
        if (col0 != pcol) { pcol = col0;
#pragma unroll
            for (int q = 0; q < 4; ++q) { const int c = (F.wave & 1) * 64 + 16 * q + 4 * (F.lane >> 4); w0v[q] = *(const f32x4*)(F.in[I_W0] + col0 + c); a0v[q] = *(const f32x4*)(F.in[I_A0] + col0 + c); } }
        const int K = which == 2 ? 128 : 64, koff = which * 64;
        ASeg A; A.p[0] = LORA + (size_t)mt * 256 * 256 + koff; A.p[1] = A.p[0]; A.p[2] = A.p[0]; A.segTiles = 4;
        const bf16_t* Bt = WLUP + (which == 0 ? 0 : (which == 1 ? 1024 * 64 : 2 * 1024 * 64)) + (size_t)col0 * K;
        bf16_t* const outp = which == 0 ? LD : (which == 1 ? AA : GG);
        { const int un = u + F.G; ch.nvalid = un < 3 * 64 * 8;
          const int wn_ = un / 512, vn = un % 512, mn = vn / 8, cn = (vn % 8) * 128, Kn = wn_ == 2 ? 128 : 64;
          ch.nA.p[0] = LORA + (size_t)mn * 256 * 256 + wn_ * 64; ch.nA.p[1] = ch.nA.p[0]; ch.nA.p[2] = ch.nA.p[0]; ch.nA.segTiles = 4;
          ch.nBt = WLUP + (wn_ == 0 ? 0 : (wn_ == 1 ? 1024 * 64 : 2 * 1024 * 64)) + (size_t)cn * Kn; ch.nldb = Kn; }
        sg_tile<128>(F.lds, A, [](int R) { return (unsigned)R * 512u; }, Bt, K, K / 64,
            [&](auto& acc, int r0, int c0, int fr, int fq) {
                bf16_t* const ob = outp + hm_off(mt * 256 + r0 + fr, col0 + c0 + 4 * fq);
                if (which == 0) {
#pragma unroll
                    for (int m = 0; m < EPI_MT(acc); ++m)
#pragma unroll
                        for (int q = 0; q < 4; ++q) { f32x4 r;
#pragma unroll
                            for (int e = 0; e < 4; ++e) r[e] = -0.6065306597126334f * sigmoidf_(w0v[q][e] + acc[m][q][e]);
                            st_bf4(ob + m * 1024 + q * 16, r); }
                } else if (which == 1) {
#pragma unroll
                    for (int m = 0; m < EPI_MT(acc); ++m)
#pragma unroll
                        for (int q = 0; q < 4; ++q) { f32x4 r;
#pragma unroll
                            for (int e = 0; e < 4; ++e) r[e] = sigmoidf_(a0v[q][e] + acc[m][q][e]);
                            st_bf4(ob + m * 1024 + q * 16, r); }
                } else {
#pragma unroll
                    for (int m = 0; m < EPI_MT(acc); ++m)
#pragma unroll
                        for (int q = 0; q < 4; ++q) st_bf4(ob + m * 1024 + q * 16, acc[m][q]);
                }
            }, BRowId(), &ch);
    }
}
__device__ __forceinline__ void ph_router_sg(const Frame& F, int layer) {
    const bf16_t* H2 = (const bf16_t*)(F.ws + WS_H2); const bf16_t* H2LO = (const bf16_t*)(F.ws + WS_H2LO);
    const bf16_t* WRT = (const bf16_t*)(F.ws + WS_WRT) + (size_t)layer * 64 * 3072; float* LOG = (float*)(F.ws + WS_LOGITS);
    for (int u = F.bid; u < 64 * 3; u += F.G) {
        const int mt = u / 3, sgi = u % 3;
        ASeg A; A.p[0] = (sgi == 2 ? H2LO : H2) + (size_t)mt * 256 * D; A.p[1] = A.p[0]; A.p[2] = A.p[0]; A.segTiles = 16;
        float* out = LOG + (size_t)sgi * T * NE;
        sg_tile<64>(F.lds, A, [](int R) { return (unsigned)R * (D * 2); }, WRT + sgi * 1024, 3072, 16,
            [&](auto& acc, int r0, int c0, int fr, int fq) {
#pragma unroll
                for (int m = 0; m < EPI_MT(acc); ++m)
#pragma unroll
                    for (int q = 0; q < 4; ++q) *(f32x4*)(out + (size_t)(mt * 256 + r0 + 16 * m + fr) * NE + c0 + 16 * q + 4 * fq) = acc[m][q];
            });
    }
}

constexpr int MS = 72;
constexpr int SLOT = 64 * MS * 2;
__device__ __forceinline__ int ms_off(int row, int col) { return row * MS + col; }
constexpr size_t WS_BONUS = 3 * MiB;
constexpr size_t WS_RP = WS_BIG + 128 * MiB;
constexpr size_t WS_OL = WS_BIG + 160 * MiB;
constexpr size_t WS_G2 = WS_BIG + 296 * MiB;
constexpr size_t WS_DM = WS_BIG + 328 * MiB;
constexpr size_t WS_ST = WS_BIG + 360 * MiB;

__device__ __forceinline__ void st4_lds(LAS bf16_t* p, const f32x4& v) { u32x2 w; w.x = pack2(v[0], v[1]); w.y = pack2(v[2], v[3]); *(LAS u32x2*)p = w; }
__device__ __forceinline__ f32x4 ld4_lds(const LAS bf16_t* p) { const u32x2 w = *(const LAS u32x2*)p; return (f32x4){lo2f(w.x), hi2f(w.x), lo2f(w.y), hi2f(w.y)}; }

__device__ __forceinline__ void ph_wkv_chunk(const Frame& F) {
    const bf16_t* RKV = (const bf16_t*)(F.ws + WS_RKV); const bf16_t* LD = (const bf16_t*)(F.ws + WS_LD); const bf16_t* AA = (const bf16_t*)(F.ws + WS_AA);
    const bf16_t* Rb = RKV; const bf16_t* Kb = RKV + (size_t)T * D; const bf16_t* Vb = RKV + (size_t)2 * T * D;
    bf16_t* RP = (bf16_t*)(F.ws + WS_RP); bf16_t* OL = (bf16_t*)(F.ws + WS_OL); bf16_t* G2 = (bf16_t*)(F.ws + WS_G2); bf16_t* DM = (bf16_t*)(F.ws + WS_DM);
    float* BONUS = (float*)(F.ws + WS_BONUS);
#define SL(k) ((LAS bf16_t*)(F.lds + (k) * SLOT))
#define AT(k, r, c) (SL(k) + ms_off((r), (c)))
    LAS float* segtot = (LAS float*)(F.lds + 15 * SLOT);
    LAS float* WCs = segtot + 512;
    const int w = F.wave, lane = F.lane, fr = lane & 15, fq = lane >> 4, mt = w >> 1, ntb = 2 * (w & 1);
#define W1_ISSUE(cn_) do { const size_t on_ = (size_t)(cn_) * 4096 + (size_t)F.tid * 8; const unsigned lw_ = (unsigned)w * 1024u; \
        __builtin_amdgcn_global_load_lds((const unsigned*)(Rb + on_), (LAS unsigned*)(F.lds + 1 * SLOT + lw_), 16, 0, 0); \
        __builtin_amdgcn_global_load_lds((const unsigned*)(Kb + on_), (LAS unsigned*)(F.lds + 4 * SLOT + lw_), 16, 0, 0); \
        __builtin_amdgcn_global_load_lds((const unsigned*)(Vb + on_), (LAS unsigned*)(F.lds + 6 * SLOT + lw_), 16, 0, 0); \
        __builtin_amdgcn_global_load_lds((const unsigned*)(AA + on_), (LAS unsigned*)(F.lds + 10 * SLOT + lw_), 16, 0, 0); \
        __builtin_amdgcn_global_load_lds((const unsigned*)(LD + on_), (LAS unsigned*)(F.lds + 13 * SLOT + lw_), 16, 0, 0); } while (0)
#define SBARL() do { asm volatile("s_waitcnt lgkmcnt(0)" ::: "memory"); __builtin_amdgcn_s_barrier(); asm volatile("" ::: "memory"); } while (0)
    if (F.bid < NB * NH * (SEQ / 64)) W1_ISSUE(F.bid);
    for (int cid = F.bid; cid < NB * NH * (SEQ / 64); cid += F.G) {
        const int bh = cid / (SEQ / 64), c = cid % (SEQ / 64), b = bh / NH, h = bh % NH;
        const size_t tok0 = (size_t)b * SEQ + (size_t)c * 64;
        {
            const int t = F.tid >> 3, jg = lane & 7, tl = lane >> 3, ch0 = h * 64 + 8 * jg;
            WAIT_V(0);
            const unsigned ro = (unsigned)F.tid * 16u;
            const u32x4 rr = *(const LAS u32x4*)(F.lds + 1 * SLOT + ro), kr = *(const LAS u32x4*)(F.lds + 4 * SLOT + ro), vr = *(const LAS u32x4*)(F.lds + 6 * SLOT + ro), ar = *(const LAS u32x4*)(F.lds + 10 * SLOT + ro);
            const u32x4 lr = *(const LAS u32x4*)(F.lds + 13 * SLOT + ro);
            float r[8], k[8], a[8], ld[8], cum[8];
#pragma unroll
            for (int q = 0; q < 4; ++q) { r[2 * q] = lo2f(rr[q]); r[2 * q + 1] = hi2f(rr[q]); k[2 * q] = lo2f(kr[q]); k[2 * q + 1] = hi2f(kr[q]); a[2 * q] = lo2f(ar[q]); a[2 * q + 1] = hi2f(ar[q]); ld[2 * q] = lo2f(lr[q]); ld[2 * q + 1] = hi2f(lr[q]); }
#pragma unroll
            for (int e = 0; e < 8; ++e) { float v = ld[e];
                float u1 = __shfl_up(v, 8);  if (tl >= 1) v += u1;
                float u2 = __shfl_up(v, 16); if (tl >= 2) v += u2;
                float u4 = __shfl_up(v, 32); if (tl >= 4) v += u4;
                cum[e] = v; }
            if (tl == 7) {
#pragma unroll
                for (int e = 0; e < 8; ++e) segtot[w * 64 + 8 * jg + e] = cum[e]; }
            __syncthreads();
            float tot[8];
#pragma unroll
            for (int e = 0; e < 8; ++e) tot[e] = 0.f;
#pragma unroll
            for (int ww = 0; ww < 8; ++ww) {
                const f32x4 s0 = *(const LAS f32x4*)(segtot + ww * 64 + 8 * jg), s1 = *(const LAS f32x4*)(segtot + ww * 64 + 8 * jg + 4);
#pragma unroll
                for (int q = 0; q < 4; ++q) { tot[q] += s0[q]; tot[4 + q] += s1[q]; if (ww < w) { cum[q] += s0[q]; cum[4 + q] += s1[q]; } }
            }
            if (t == 0) {
#pragma unroll
                for (int e = 0; e < 8; ++e) WCs[8 * jg + e] = fexp_(tot[e]); }
            float kkr[8], kf[8], ss = 0.f, bon = 0.f;
#pragma unroll
            for (int e = 0; e < 8; ++e) { kkr[e] = k[e] * F.in[I_KK][ch0 + e]; ss += kkr[e] * kkr[e]; kf[e] = k[e] * (1.0f + (a[e] - 1.0f) * F.in[I_KA][ch0 + e]); bon += r[e] * kf[e] * F.in[I_RK][ch0 + e]; }
            ss += __shfl_xor(ss, 1); ss += __shfl_xor(ss, 2); ss += __shfl_xor(ss, 4);
            bon += __shfl_xor(bon, 1); bon += __shfl_xor(bon, 2); bon += __shfl_xor(bon, 4);
            if (jg == 0) BONUS[(tok0 + t) * NH + h] = bon;
            const float inv = 1.0f / fmaxf(sqrtf(ss), 1e-12f);
            float av[8], bv[8], kv[8], rv[8];
#pragma unroll
            for (int e = 0; e < 8; ++e) { const float kk = kkr[e] * inv, en = fexp_(-cum[e]);
                av[e] = -kk * fexp_(cum[e] - ld[e]); bv[e] = kk * a[e] * en; kv[e] = kf[e] * en; rv[e] = r[e] * fexp_(cum[e]); }
            u32x4 pa, pr, pb, pk;
#pragma unroll
            for (int q = 0; q < 4; ++q) { pa[q] = pack2(av[2 * q], av[2 * q + 1]); pr[q] = pack2(rv[2 * q], rv[2 * q + 1]); pb[q] = pack2(bv[2 * q], bv[2 * q + 1]); pk[q] = pack2(kv[2 * q], kv[2 * q + 1]); }
            *(LAS u32x4*)AT(0, t, 8 * jg) = pa; *(LAS u32x4*)AT(2, t, 8 * jg) = pr; *(LAS u32x4*)AT(3, t, 8 * jg) = pb; *(LAS u32x4*)AT(5, t, 8 * jg) = pk; *(LAS u32x4*)AT(7, t, 8 * jg) = vr;
        }
        __syncthreads();
#define LF2(dst, k, r0) do { dst[0] = *(const LAS bf16x8*)AT(k, (r0) + fr, fq * 8); dst[1] = *(const LAS bf16x8*)AT(k, (r0) + fr, 32 + fq * 8); } while (0)
#define TR2(dst, k, c0) do { const LAS bf16_t* b_ = AT(k, 8 * fq + (fr >> 2), (c0) + 4 * (fr & 3)); \
            const s16x4 t0_ = __builtin_amdgcn_ds_read_tr16_b64_v4i16((LAS s16x4*)(b_)), t1_ = __builtin_amdgcn_ds_read_tr16_b64_v4i16((LAS s16x4*)(b_ + 4 * MS)); \
            const s16x4 t2_ = __builtin_amdgcn_ds_read_tr16_b64_v4i16((LAS s16x4*)(b_ + 32 * MS)), t3_ = __builtin_amdgcn_ds_read_tr16_b64_v4i16((LAS s16x4*)(b_ + 36 * MS)); \
            dst[0] = __builtin_bit_cast(bf16x8, __builtin_shufflevector(t0_, t1_, 0, 1, 2, 3, 4, 5, 6, 7)); dst[1] = __builtin_bit_cast(bf16x8, __builtin_shufflevector(t2_, t3_, 0, 1, 2, 3, 4, 5, 6, 7)); } while (0)
#define MMA2(acc, xf, yf) do { acc = __builtin_amdgcn_mfma_f32_16x16x32_bf16(xf[0], yf[0], acc, 0, 0, 0); acc = __builtin_amdgcn_mfma_f32_16x16x32_bf16(xf[1], yf[1], acc, 0, 0, 0); } while (0)
        {
            bf16x8 xa[2], xr[2]; LF2(xa, 0, 16 * mt); LF2(xr, 2, 16 * mt);
#pragma unroll
            for (int q2 = 0; q2 < 2; ++q2) {
                const int nt = ntb + q2;
                bf16x8 yb[2], yk[2]; LF2(yb, 3, 16 * nt); LF2(yk, 5, 16 * nt);
                const int tt = 16 * mt + fr, s0 = 16 * nt + 4 * fq;
                { f32x4 acc = {0.f, 0.f, 0.f, 0.f}; MMA2(acc, yb, xa);
#pragma unroll
                  for (int e = 0; e < 4; ++e) if (!(s0 + e < tt)) acc[e] = 0.f;
                  st4_lds(AT(8, tt, s0), acc); }
                { f32x4 acc = {0.f, 0.f, 0.f, 0.f}; MMA2(acc, yk, xa);
#pragma unroll
                  for (int e = 0; e < 4; ++e) if (!(s0 + e < tt)) acc[e] = 0.f;
                  st4_lds(AT(10, tt, s0), acc); }
                { f32x4 acc = {0.f, 0.f, 0.f, 0.f}; MMA2(acc, yb, xr);
#pragma unroll
                  for (int e = 0; e < 4; ++e) if (!(s0 + e <= tt)) acc[e] = 0.f;
                  st4_lds(AT(11, tt, s0), acc); }
                { f32x4 acc = {0.f, 0.f, 0.f, 0.f}; MMA2(acc, yk, xr);
#pragma unroll
                  for (int e = 0; e < 4; ++e) if (!(s0 + e <= tt)) acc[e] = 0.f;
                  st4_lds(AT(12, tt, s0), acc); }
            }
        }
        __syncthreads();
#define WKV_SQ(xi, xo) do { bf16x8 xl[2]; LF2(xl, xi, 16 * mt); _Pragma("unroll") for (int q2 = 0; q2 < 2; ++q2) { const int nt = ntb + q2; bf16x8 yl[2]; TR2(yl, xi, 16 * nt); \
            f32x4 acc = {0.f, 0.f, 0.f, 0.f}; MMA2(acc, yl, xl); st4_lds(AT(xo, 16 * mt + fr, 16 * nt + 4 * fq), acc); } } while (0)
#define WKV_PM(pi, xi, po) do { bf16x8 xp[2]; LF2(xp, pi, 16 * mt); _Pragma("unroll") for (int q2 = 0; q2 < 2; ++q2) { const int nt = ntb + q2; bf16x8 yl[2]; TR2(yl, xi, 16 * nt); \
            const int m_ = 16 * mt + fr, n0_ = 16 * nt + 4 * fq; f32x4 acc = ld4_lds(AT(pi, m_, n0_)); MMA2(acc, yl, xp); st4_lds(AT(po, m_, n0_), acc); } } while (0)
#define WKV_PMSQ(pi, xi, po, xo) do { bf16x8 xp[2], xl[2]; LF2(xp, pi, 16 * mt); LF2(xl, xi, 16 * mt); _Pragma("unroll") for (int q2 = 0; q2 < 2; ++q2) { const int nt = ntb + q2; bf16x8 yl[2]; TR2(yl, xi, 16 * nt); \
            const int m_ = 16 * mt + fr, n0_ = 16 * nt + 4 * fq; \
            { f32x4 acc = ld4_lds(AT(pi, m_, n0_)); MMA2(acc, yl, xp); st4_lds(AT(po, m_, n0_), acc); } \
            { f32x4 acc = {0.f, 0.f, 0.f, 0.f}; MMA2(acc, yl, xl); st4_lds(AT(xo, m_, n0_), acc); } } } while (0)
        WKV_SQ(8, 1);
        for (int idx = F.tid; idx < 64 * 16; idx += NTHREADS) { const int t = idx >> 4, s4 = (idx & 15) * 4; u32x2 v = *(const LAS u32x2*)AT(8, t, s4);
            if ((t >> 2) == (s4 >> 2)) { const unsigned one = 0x3F80u; const int e = t & 3; if (e == 0) v.x = (v.x & 0xffff0000u) | one; else if (e == 1) v.x = (v.x & 0xffffu) | (one << 16); else if (e == 2) v.y = (v.y & 0xffff0000u) | one; else v.y = (v.y & 0xffffu) | (one << 16); }
            *(LAS u32x2*)AT(13, t, s4) = v; }
        { bf16x8 xm[2]; LF2(xm, 10, 16 * mt);
#pragma unroll
          for (int q2 = 0; q2 < 2; ++q2) { const int nt = ntb + q2, n_ = 16 * nt + fr, m0_ = 16 * mt + 4 * fq; bf16x8 yv[2]; TR2(yv, 7, 16 * nt);
              f32x4 acc = {0.f, 0.f, 0.f, 0.f}; MMA2(acc, xm, yv); st4_lds(AT(6, n_, m0_), acc); } }
        __syncthreads();
        WKV_PMSQ(13, 1, 14, 8); __syncthreads();
        WKV_PMSQ(14, 8, 13, 1); __syncthreads();
        WKV_PMSQ(13, 1, 14, 8); __syncthreads();
        WKV_PMSQ(14, 8, 13, 1); __syncthreads();
        WKV_PM(13, 1, 14); __syncthreads();
        {
            bf16x8 xt[2]; LF2(xt, 14, 16 * mt);
#pragma unroll
            for (int q2 = 0; q2 < 2; ++q2) {
                const int nt = ntb + q2, n_ = 16 * nt + fr, m0_ = 16 * mt + 4 * fq;
                bf16x8 ya[2], yz[2]; TR2(ya, 0, 16 * nt); LF2(yz, 6, 16 * nt);
                { f32x4 acc = {0.f, 0.f, 0.f, 0.f}; MMA2(acc, xt, ya); st4_lds(AT(9, n_, m0_), acc); }
                { f32x4 acc = {0.f, 0.f, 0.f, 0.f}; MMA2(acc, xt, yz); st4_lds(AT(8, n_, m0_), acc); }
            }
        }
        __syncthreads();
        if (cid + F.G < NB * NH * (SEQ / 64)) W1_ISSUE(cid + F.G);
        {
            bf16x8 xb[2]; LF2(xb, 11, 16 * mt);
#pragma unroll
            for (int q2 = 0; q2 < 2; ++q2) {
                const int nt = ntb + q2;
                bf16x8 yp[2]; LF2(yp, 9, 16 * nt);
                { const int m_ = 16 * mt + fr, n0_ = 16 * nt + 4 * fq; f32x4 acc = ld4_lds(AT(2, m_, n0_)); MMA2(acc, yp, xb);
                  st_bf4(RP + (size_t)cid * 4096 + (unsigned)((mt * 2 + (nt >> 1)) * 512 + (fr * 4 + 2 * (nt & 1) + (fq >> 1)) * 8 + 4 * (fq & 1)), acc); }
            }
        }
        {
            bf16x8 xb[2], xk[2], xp[2], xu[2], xv[2]; LF2(xb, 11, 16 * mt); LF2(xk, 12, 16 * mt); LF2(xp, 9, 16 * mt); LF2(xu, 8, 16 * mt); TR2(xv, 7, 16 * mt);
#pragma unroll
            for (int q2 = 0; q2 < 2; ++q2) {
                const int nt = ntb + q2;
                bf16x8 yu[2], yv[2], yb[2], yk[2]; LF2(yu, 8, 16 * nt); TR2(yv, 7, 16 * nt); TR2(yb, 3, 16 * nt); TR2(yk, 5, 16 * nt);
                { f32x4 acc = {0.f, 0.f, 0.f, 0.f}; MMA2(acc, yu, xb); MMA2(acc, yv, xk);
                  st_bf4(OL + (size_t)cid * 4096 + (unsigned)((16 * mt + fr) * 64 + 16 * nt + 4 * fq), acc); }
                { const int jp = 16 * nt + fr, j0 = 16 * mt + 4 * fq; f32x4 acc = {0.f, 0.f, 0.f, 0.f}; MMA2(acc, xp, yb);
                  const float wc = WCs[jp];
#pragma unroll
                  for (int e = 0; e < 4; ++e) acc[e] = (acc[e] + ((j0 + e == jp) ? 1.0f : 0.0f)) * wc;
                  st_bf4(G2 + (size_t)cid * 4096 + (unsigned)((nt * 2 + (mt >> 1)) * 512 + lane * 8 + (mt & 1) * 4), acc); }
                { const int i_ = 16 * mt + fr, jp0 = 16 * nt + 4 * fq; f32x4 acc = {0.f, 0.f, 0.f, 0.f}; MMA2(acc, yb, xu); MMA2(acc, yk, xv);
#pragma unroll
                  for (int e = 0; e < 4; ++e) acc[e] *= WCs[jp0 + e];
                  st_bf4(DM + (size_t)cid * 4096 + (unsigned)(i_ * 64 + jp0), acc); }
            }
        }
        SBARL();
    }
#undef W1_ISSUE
#undef LF2
#undef TR2
#undef MMA2
#undef WKV_PMSQ
#undef WKV_SQ
#undef WKV_PM
#undef AT
#undef SL
}

__device__ __forceinline__ void ph_wkv_carry(const Frame& F) {
    const bf16_t* G2 = (const bf16_t*)(F.ws + WS_G2); const bf16_t* DM = (const bf16_t*)(F.ws + WS_DM); bf16_t* ST = (bf16_t*)(F.ws + WS_ST);
    const int lane = F.lane, fr = lane & 15, fq = lane >> 4;
    const bool loader = F.wave >= 4; const int lw = F.wave - 4, i = 16 * (F.wave & 3) + fr;
    constexpr int NC = SEQ / 64;
    for (int ch = F.bid; ch < NB * NH; ch += F.G) {
        const size_t cbase = (size_t)ch * NC;
#define CARRY_ISSUE(c_) do { const int cc_ = (c_) < NC ? (c_) : NC - 1; const size_t cid_ = cbase + cc_; \
        _Pragma("unroll") for (int q_ = 0; q_ < 4; ++q_) { const int j_ = lw * 4 + q_; \
            const bf16_t* src_ = (j_ < 8 ? G2 + cid_ * 4096 + j_ * 512 : DM + cid_ * 4096 + (j_ - 8) * 512) + lane * 8; \
            __builtin_amdgcn_global_load_lds((const unsigned*)src_, (LAS unsigned*)(F.lds + ((c_) & 7) * 16384 + j_ * 1024), 16, 0, 0); } } while (0)
        f32x4 st[4];
#pragma unroll
        for (int r = 0; r < 4; ++r) st[r] = (f32x4){0.f, 0.f, 0.f, 0.f};
        bf16x8 gc[8]; u32x2 dc[4];
#define CARRY_RING_READ(c_) do { const LAS unsigned char* slot_ = F.lds + ((c_) & 7) * 16384; \
        _Pragma("unroll") for (int f = 0; f < 8; ++f) gc[f] = *(const LAS bf16x8*)(slot_ + f * 1024 + lane * 16); \
        _Pragma("unroll") for (int r = 0; r < 4; ++r) dc[r] = *(const LAS u32x2*)(slot_ + 8192 + (i * 64 + 16 * r + 4 * fq) * 2); } while (0)
        if (loader) {
#pragma unroll
            for (int c = 0; c < 7; ++c) CARRY_ISSUE(c);
            WAIT_V(20);
        }
        SBAR();
        if (!loader) CARRY_RING_READ(0);
#pragma unroll 1
        for (int c = 0; c < NC; ++c) {
            if (loader) {
                CARRY_ISSUE(c + 7);
                WAIT_V(20);
            } else {
                const size_t cid = cbase + c;
                union { bf16x8 v; unsigned u[4]; } b0, b1;
                b0.u[0] = pack2(st[0][0], st[0][1]); b0.u[1] = pack2(st[0][2], st[0][3]); b0.u[2] = pack2(st[1][0], st[1][1]); b0.u[3] = pack2(st[1][2], st[1][3]);
                b1.u[0] = pack2(st[2][0], st[2][1]); b1.u[1] = pack2(st[2][2], st[2][3]); b1.u[2] = pack2(st[3][0], st[3][1]); b1.u[3] = pack2(st[3][2], st[3][3]);
                f32x4 acc[4];
#pragma unroll
                for (int r = 0; r < 4; ++r) { acc[r] = (f32x4){lo2f(dc[r].x), hi2f(dc[r].x), lo2f(dc[r].y), hi2f(dc[r].y)};
                    acc[r] = __builtin_amdgcn_mfma_f32_16x16x32_bf16(gc[r * 2 + 0], b0.v, acc[r], 0, 0, 0); }
#pragma unroll
                for (int r = 0; r < 4; ++r) acc[r] = __builtin_amdgcn_mfma_f32_16x16x32_bf16(gc[r * 2 + 1], b1.v, acc[r], 0, 0, 0);
                { const unsigned wsl = (unsigned)(F.wave & 3);
                  bf16_t* stp = ST + cid * 4096;
                  const unsigned ob = (unsigned)(((fr >> 2) * 2) * 512 + ((4 * wsl + (fr & 3)) * 4 + (fq >> 1)) * 8 + 4 * (fq & 1));
                  u32x2 w0; w0.x = b0.u[0]; w0.y = b0.u[1]; *(u32x2*)(stp + ob) = w0;
                  u32x2 w1; w1.x = b0.u[2]; w1.y = b0.u[3]; *(u32x2*)(stp + ob + 16) = w1;
                  u32x2 w2; w2.x = b1.u[0]; w2.y = b1.u[1]; *(u32x2*)(stp + ob + 512) = w2;
                  u32x2 w3; w3.x = b1.u[2]; w3.y = b1.u[3]; *(u32x2*)(stp + ob + 512 + 16) = w3; }
                if (c + 1 < NC) CARRY_RING_READ(c + 1);
#pragma unroll
                for (int r = 0; r < 4; ++r) st[r] = acc[r];
            }
            SBAR();
        }
        if (loader) WAIT_V(0);
        SBAR();
#undef CARRY_RING_READ
#undef CARRY_ISSUE
    }
}

__device__ __forceinline__ void ph_wkv_out(const Frame& F) {
    const bf16_t* RP = (const bf16_t*)(F.ws + WS_RP); const bf16_t* OL = (const bf16_t*)(F.ws + WS_OL); const bf16_t* ST = (const bf16_t*)(F.ws + WS_ST);
    const bf16_t* Vb = (const bf16_t*)(F.ws + WS_RKV) + (size_t)2 * T * D; const bf16_t* GG = (const bf16_t*)(F.ws + WS_GG); const float* BONUS = (const float*)(F.ws + WS_BONUS);
    bf16_t* OG = (bf16_t*)(F.ws + WS_OG);
    const int lane = F.lane, fr = lane & 15, fq = lane >> 4;
    const int nunits = NB * NH * (SEQ / 64) * 4;
    for (int u0 = F.bid * NWAVES + F.wave; u0 < nunits; u0 += 2 * F.G * NWAVES) {
        bf16x8 rf[2][2], sf[2][4][2]; u32x4 ol0[2], ol1[2], v0[2], v1[2], g0[2], g1[2]; float bon[2]; f32x4 lg[2][4], lb[2][4];
        size_t tokv[2]; int chnv[2]; bool live[2];
#pragma unroll
        for (int j = 0; j < 2; ++j) {
            const int uj = u0 + j * F.G * NWAVES; live[j] = uj < nunits; const int u = live[j] ? uj : u0;
            const int cid = u >> 2, tt = u & 3, bh = cid / (SEQ / 64), c = cid % (SEQ / 64), b = bh / NH, h = bh % NH;
            const int t = 16 * tt + fr; const size_t tok = (size_t)b * SEQ + (size_t)c * 64 + t;
            const size_t oh = ((size_t)bh * SEQ + (size_t)c * 64 + t) * 64 + 16 * fq;
#pragma unroll
            for (int ks = 0; ks < 2; ++ks) rf[j][ks] = *(const bf16x8*)(RP + (size_t)cid * 4096 + (tt * 2 + ks) * 512 + (fr * 4 + fq) * 8);
#pragma unroll
            for (int n = 0; n < 4; ++n)
#pragma unroll
                for (int ks = 0; ks < 2; ++ks) sf[j][n][ks] = *(const bf16x8*)(ST + (size_t)cid * 4096 + (n * 2 + ks) * 512 + (fr * 4 + fq) * 8);
            ol0[j] = *(const u32x4*)(OL + (size_t)cid * 4096 + t * 64 + 16 * fq); ol1[j] = *(const u32x4*)(OL + (size_t)cid * 4096 + t * 64 + 16 * fq + 8);
            v0[j] = *(const u32x4*)(Vb + oh); v1[j] = *(const u32x4*)(Vb + oh + 8); g0[j] = *(const u32x4*)(GG + oh); g1[j] = *(const u32x4*)(GG + oh + 8);
            bon[j] = BONUS[tok * NH + h];
            tokv[j] = tok; chnv[j] = h * 64 + 16 * fq;
#pragma unroll
            for (int n = 0; n < 4; ++n) { lg[j][n] = *(const f32x4*)(F.in[I_LNG] + chnv[j] + 4 * n); lb[j][n] = *(const f32x4*)(F.in[I_LNB] + chnv[j] + 4 * n); }
        }
#pragma unroll
        for (int j = 0; j < 2; ++j) {
            f32x4 acc[4];
            acc[0] = (f32x4){lo2f(ol0[j][0]), hi2f(ol0[j][0]), lo2f(ol0[j][1]), hi2f(ol0[j][1])}; acc[1] = (f32x4){lo2f(ol0[j][2]), hi2f(ol0[j][2]), lo2f(ol0[j][3]), hi2f(ol0[j][3])};
            acc[2] = (f32x4){lo2f(ol1[j][0]), hi2f(ol1[j][0]), lo2f(ol1[j][1]), hi2f(ol1[j][1])}; acc[3] = (f32x4){lo2f(ol1[j][2]), hi2f(ol1[j][2]), lo2f(ol1[j][3]), hi2f(ol1[j][3])};
#pragma unroll
            for (int n = 0; n < 4; ++n)
#pragma unroll
                for (int ks = 0; ks < 2; ++ks) acc[n] = __builtin_amdgcn_mfma_f32_16x16x32_bf16(sf[j][n][ks], rf[j][ks], acc[n], 0, 0, 0);
            float s = 0.f;
#pragma unroll
            for (int n = 0; n < 4; ++n) s += (acc[n][0] + acc[n][1]) + (acc[n][2] + acc[n][3]);
            s += __shfl_xor(s, 16); s += __shfl_xor(s, 32);
            const float mean = s * (1.0f / 64.0f);
            float q = 0.f;
#pragma unroll
            for (int n = 0; n < 4; ++n)
#pragma unroll
                for (int e = 0; e < 4; ++e) { const float d = acc[n][e] - mean; q += d * d; }
            q += __shfl_xor(q, 16); q += __shfl_xor(q, 32);
            const float rstd = rsqrtf(q * (1.0f / 64.0f) + 64e-5f);
            u32x4 o0, o1;
#pragma unroll
            for (int n = 0; n < 4; ++n) {
                const unsigned vw0 = n < 2 ? v0[j][2 * n] : v1[j][2 * n - 4], vw1 = n < 2 ? v0[j][2 * n + 1] : v1[j][2 * n - 3], gw0 = n < 2 ? g0[j][2 * n] : g1[j][2 * n - 4], gw1 = n < 2 ? g0[j][2 * n + 1] : g1[j][2 * n - 3];
                const f32x4 vv = {lo2f(vw0), hi2f(vw0), lo2f(vw1), hi2f(vw1)}, gg = {lo2f(gw0), hi2f(gw0), lo2f(gw1), hi2f(gw1)};
                const f32x4 res = (((acc[n] - mean) * rstd) * lg[j][n] + lb[j][n] + vv * bon[j]) * gg;
                const unsigned w0 = pack2(res[0], res[1]), w1 = pack2(res[2], res[3]);
                if (n == 0) { o0[0] = w0; o0[1] = w1; } else if (n == 1) { o0[2] = w0; o0[3] = w1; } else if (n == 2) { o1[0] = w0; o1[1] = w1; } else { o1[2] = w0; o1[3] = w1; }
            }
            if (live[j]) { *(u32x4*)(OG + tokv[j] * D + chnv[j]) = o0; *(u32x4*)(OG + tokv[j] * D + chnv[j] + 8) = o1; }
        }
    }
}

struct AttnTile { bf16x8 k[4][2]; bf16x8 v[4][2]; };
__device__ __forceinline__ void attn_load(AttnTile& tl, const bf16_t* kbase  , const bf16_t* vbase  ) {
#pragma unroll
    for (int kt = 0; kt < 4; ++kt)
#pragma unroll
        for (int ks = 0; ks < 2; ++ks) tl.k[kt][ks] = *(const bf16x8*)(kbase + (kt * 2 + ks) * 512);
#pragma unroll
    for (int dt = 0; dt < 4; ++dt)
#pragma unroll
        for (int ks = 0; ks < 2; ++ks) tl.v[dt][ks] = *(const bf16x8*)(vbase + (dt * 2 + ks) * 512);
}
template <bool MASK>
__device__ __forceinline__ void attn_tile(const AttnTile& tl, const bf16x8 (&qf)[2], f32x4 (&o)[4], float& R, int key0, int qpos, int fq) {
    constexpr float C2 = 0.125f * 1.4426950408889634f;
    f32x4 z[4];
#pragma unroll
    for (int kt = 0; kt < 4; ++kt) { z[kt] = (f32x4){0.f, 0.f, 0.f, 0.f};
#pragma unroll
        for (int ks = 0; ks < 2; ++ks) z[kt] = __builtin_amdgcn_mfma_f32_16x16x32_bf16(tl.k[kt][ks], qf[ks], z[kt], 0, 0, 0); }
    float sp[4][4], G[4];
#pragma unroll
    for (int kt = 0; kt < 4; ++kt) { G[kt] = 0.f;
#pragma unroll
        for (int e = 0; e < 4; ++e) { const float z2 = z[kt][e] * C2; z[kt][e] = z2;
            const float l2 = __builtin_amdgcn_logf(1.0f + __builtin_amdgcn_exp2f(z2));
            float spv = z2 > 30.f ? z2 : l2;
            if (MASK) spv = ((key0 + 16 * kt + 4 * fq + e) < qpos) ? spv : 0.f;
            sp[kt][e] = spv; G[kt] += spv; } }
    float sufg[4], tot[4];
#pragma unroll
    for (int kt = 0; kt < 4; ++kt) {
        const float g1 = __shfl_xor(G[kt], 16), g2 = __shfl_xor(G[kt], 32), g3 = __shfl_xor(G[kt], 48);
        tot[kt] = G[kt] + g1 + g2 + g3;
        sufg[kt] = (((fq ^ 1) > fq) ? g1 : 0.f) + (((fq ^ 2) > fq) ? g2 : 0.f) + (((fq ^ 3) > fq) ? g3 : 0.f);
    }
    float later = 0.f;
    union { bf16x8 v; unsigned w[4]; } p0, p1;
#pragma unroll
    for (int kt = 3; kt >= 0; --kt) {
        float run = R + later + sufg[kt];
        float wv[4];
#pragma unroll
        for (int e = 3; e >= 0; --e) { float w = __builtin_amdgcn_exp2f(z[kt][e] - sp[kt][e] - run);
            if (MASK) w = ((key0 + 16 * kt + 4 * fq + e) < qpos) ? w : 0.f;
            wv[e] = w; run += sp[kt][e]; }
        const unsigned w01 = pgx::cvt_pk_bf16(wv[0], wv[1]), w23 = pgx::cvt_pk_bf16(wv[2], wv[3]);
        if (kt == 0) { p0.w[0] = w01; p0.w[1] = w23; } else if (kt == 1) { p0.w[2] = w01; p0.w[3] = w23; } else if (kt == 2) { p1.w[0] = w01; p1.w[1] = w23; } else { p1.w[2] = w01; p1.w[3] = w23; }
        later += tot[kt];
    }
    R += later;
#pragma unroll
    for (int dt = 0; dt < 4; ++dt) {
        o[dt] = __builtin_amdgcn_mfma_f32_16x16x32_bf16(tl.v[dt][0], p0.v, o[dt], 0, 0, 0);
        o[dt] = __builtin_amdgcn_mfma_f32_16x16x32_bf16(tl.v[dt][1], p1.v, o[dt], 0, 0, 0);
    }
}
__device__ __forceinline__ void attn_unit(const Frame& F, const int bh, const int qt) {
    const bf16_t* Q = (const bf16_t*)(F.ws + WS_Q); const bf16_t* Kb = Q + (size_t)T * D; const bf16_t* VT = Q + (size_t)2 * T * D;
    bf16_t* AO = (bf16_t*)(F.ws + WS_AO);
    const int lane = F.lane, fr = lane & 15, fq = lane >> 4;
    constexpr float EXIT2 = SB_EXIT * 1.4426950408889634f;
    const int b = bh / NH, h = bh % NH;
    const int q0 = qt * 16, qpos = q0 + fr;
    const size_t tb = (size_t)b * SEQ;
    bf16x8 qf[2];
#pragma unroll
    for (int ks = 0; ks < 2; ++ks) qf[ks] = *(const bf16x8*)(Q + (tb + qpos) * D + h * 64 + ks * 32 + fq * 8);
    f32x4 o[4];
#pragma unroll
    for (int dt = 0; dt < 4; ++dt) o[dt] = (f32x4){0.f, 0.f, 0.f, 0.f};
    float R = 0.f;
    const bf16_t* kb = Kb + (size_t)bh * SEQ * 64 + (fr * 4 + fq) * 8;
    const bf16_t* vb = VT + (size_t)bh * SEQ * 64 + (fr * 4 + fq) * 8;
    int kt0 = (q0 + 15) / 64;
    AttnTile ta, tc;
    attn_load(ta, kb + (size_t)kt0 * 4096, vb + (size_t)kt0 * 4096);
    if (kt0 > 0) attn_load(tc, kb + (size_t)(kt0 - 1) * 4096, vb + (size_t)(kt0 - 1) * 4096);
    attn_tile<true>(ta, qf, o, R, kt0 * 64, qpos, fq);
    --kt0;
    while (kt0 >= 0 && !__all(R > EXIT2)) {
        if (kt0 > 0) attn_load(ta, kb + (size_t)(kt0 - 1) * 4096, vb + (size_t)(kt0 - 1) * 4096);
        attn_tile<false>(tc, qf, o, R, kt0 * 64, qpos, fq);
        --kt0;
        if (kt0 < 0 || __all(R > EXIT2)) break;
        if (kt0 > 0) attn_load(tc, kb + (size_t)(kt0 - 1) * 4096, vb + (size_t)(kt0 - 1) * 4096);
        attn_tile<false>(ta, qf, o, R, kt0 * 64, qpos, fq);
        --kt0;
    }
#pragma unroll
    for (int dt = 0; dt < 4; ++dt) st_bf4(AO + (tb + qpos) * D + h * 64 + 16 * dt + 4 * fq, o[dt]);
}
__device__ __forceinline__ void ph_attn(const Frame& F) {
    if (F.G == 256) {
        const int xq = F.bid & 7, lb = F.bid >> 3;
#pragma unroll 1
        for (int it = 0; it < 8; ++it) { const int ck = it * 32 + lb; attn_unit(F, xq + 8 * (ck >> 6), (ck & 63) * 8 + F.wave); }
    } else {
        unsigned* aq = F.ctl + CW_AQ;
        LAS unsigned* chunk_s = (LAS unsigned*)(F.lds + 1024);
        const unsigned myx = xb_xcc_id() & 7u;
        for (int qi = 0; qi < 8; ++qi) {
            const unsigned xq = (myx + (unsigned)qi) & 7u;
            for (;;) {
                __syncthreads();
                if (F.tid == 0) *chunk_s = atomicAdd(&aq[xq * 64], 1u);
                __syncthreads();
                const unsigned ck = *chunk_s;
                if (ck >= 256u) break;
                attn_unit(F, (int)xq + 8 * (int)(ck >> 6), (int)(ck & 63u) * 8 + F.wave);
            }
        }
    }
}

#ifndef USE_PGX
#define USE_PGX 0x1f
#endif
__device__ __forceinline__ int px_unit_index(int i, int G, int c, int nwg) {
    const long L = (long)i * G + c; if (L >= nwg) return -1;
    const int w = (int)L, q = nwg / 8, r = nwg % 8, xcd = w % 8, off = w / 8;
    return (xcd < r ? xcd * (q + 1) : r * (q + 1) + (xcd - r) * q) + off;
}
struct PxDense {
    const char* A; const char* B; int nM, nN, K, G, c; unsigned lda; int a_div; size_t a_stride;
    __device__ __forceinline__ bool next(int i, pgx::Unit& u) const {
        const int w = px_unit_index(i, G, c, nM * nN); if (w < 0) return false;
        const int pm = w / nN, pn = w % nN;
        u.A = A + (size_t)(pn / a_div) * a_stride + (size_t)pm * 256 * lda; u.tok = nullptr; u.B = B + (size_t)pn * 256 * K * 2; u.r0 = pm * 256; u.c0 = pn * 256; u.aux = 0; return true;
    }
};
__device__ __forceinline__ void px_store_bf16_perm(bf16_t* rowp, const f32x4& v0, const f32x4& v1) {
    u32x4 w; w.x = pgx::cvt_pk_bf16(v0[0], v0[1]); w.y = pgx::cvt_pk_bf16(v0[2], v0[3]); w.z = pgx::cvt_pk_bf16(v1[0], v1[1]); w.w = pgx::cvt_pk_bf16(v1[2], v1[3]); *(u32x4*)rowp = w;
}
__device__ __forceinline__ void ph_rkv_px(const Frame& F) {
    bf16_t* RKV = (bf16_t*)(F.ws + WS_RKV);
    PxDense S{(const char*)(F.ws + WS_XS), (const char*)(F.ws + WS_WRKV), 64, 12, D, F.G, F.bid, (unsigned)(D * 2), 4, (size_t)T * D * 2};
    pgx::gemm_phase<true, true>(F.lds, D, D * 2, S, [&](const f32x4 (&acc)[2][2][4][2], const pgx::Unit& u, int wr, int wc, int fr, int fq) {
        bf16_t* base = RKV + (size_t)(u.c0 / D) * T * D;
#pragma unroll
        for (int ai = 0; ai < 2; ++ai)
#pragma unroll
            for (int m = 0; m < 4; ++m) { const int t = u.r0 + ai * 128 + wr * 64 + m * 16 + fr;
#pragma unroll
                for (int bj = 0; bj < 2; ++bj) px_store_bf16_perm(base + hm_off(t, (u.c0 % D) + bj * 128 + wc * 32 + 8 * fq), acc[ai][bj][m][0], acc[ai][bj][m][1]); }
    });
}
__device__ __forceinline__ void ph_lora_dn_sg(const Frame& F) {
    const bf16_t* XS = (const bf16_t*)(F.ws + WS_XS); const bf16_t* WLDN = (const bf16_t*)(F.ws + WS_WLDN); bf16_t* LORA = (bf16_t*)(F.ws + WS_LORA);
    for (int u = F.bid; u < 64 * 4; u += F.G) {
        const int mt = u / 4, j = u % 4, n = (j == 0) ? 3 : (j == 1 ? 4 : 5);
        ASeg A; A.p[0] = XS + ((size_t)n * T + mt * 256) * D; A.p[1] = A.p[0]; A.p[2] = A.p[0]; A.segTiles = 16;
        bf16_t* out = LORA + (size_t)mt * 256 * 256 + j * 64;
        sg_tile<64>(F.lds, A, [](int R) { return (unsigned)R * (D * 2); }, WLDN + (size_t)(j * 64) * D, D, 16,
            [&](auto& acc, int r0, int c0, int fr, int fq) {
#pragma unroll
                for (int m = 0; m < EPI_MT(acc); ++m)
#pragma unroll
                    for (int q = 0; q < 4; ++q) { f32x4 v = acc[m][q];
                        if (j == 0) {
#pragma unroll
                            for (int e = 0; e < 4; ++e) v[e] = tanhf_(v[e]); }
                        else if (j >= 2) {
#pragma unroll
                            for (int e = 0; e < 4; ++e) v[e] = sigmoidf_(v[e]); }
                        st_bf4(out + (size_t)(r0 + 16 * m + fr) * 256 + c0 + 16 * q + 4 * fq, v); }
            });
    }
}
__device__ __forceinline__ void ph_dense_bf16_px(const Frame& F, const bf16_t* Ain, const bf16_t* Wt, bf16_t* out) {
    PxDense S{(const char*)Ain, (const char*)Wt, 64, 4, D, F.G, F.bid, (unsigned)(D * 2), 4, 0};
    pgx::gemm_phase<true, true>(F.lds, D, D * 2, S, [&](const f32x4 (&acc)[2][2][4][2], const pgx::Unit& u, int wr, int wc, int fr, int fq) {
        bf16_t* base = out + u.c0 + wc * 32 + 8 * fq;
#pragma unroll
        for (int ai = 0; ai < 2; ++ai)
#pragma unroll
            for (int m = 0; m < 4; ++m) { bf16_t* rowp = base + (size_t)(u.r0 + ai * 128 + wr * 64 + m * 16 + fr) * D;
#pragma unroll
                for (int bj = 0; bj < 2; ++bj) px_store_bf16_perm(rowp + bj * 128, acc[ai][bj][m][0], acc[ai][bj][m][1]); }
    });
}
__device__ __forceinline__ void ph_qkv_px(const Frame& F) {
    bf16_t* QK = (bf16_t*)(F.ws + WS_Q); bf16_t* VT = QK + (size_t)2 * T * D;
    { PxDense S{(const char*)(F.ws + WS_H3), (const char*)(F.ws + WS_WQKV), 64, 8, D, F.G, F.bid, (unsigned)(D * 2), 8, 0};
      pgx::gemm_phase<true, true>(F.lds, D, D * 2, S, [&](const f32x4 (&acc)[2][2][4][2], const pgx::Unit& u, int wr, int wc, int fr, int fq) {
        const bool isk = u.c0 >= D;
#pragma unroll
        for (int ai = 0; ai < 2; ++ai)
#pragma unroll
            for (int m = 0; m < 4; ++m) { const int t = u.r0 + ai * 128 + wr * 64 + m * 16 + fr;
#pragma unroll
                for (int bj = 0; bj < 2; ++bj) { const int c = (u.c0 % D) + bj * 128 + wc * 32 + 8 * fq;
                    const int sq = t % SEQ, dd = c & 63;
                    bf16_t* dst = isk ? QK + (size_t)T * D + (((size_t)((t / SEQ) * NH + (c >> 6)) * (SEQ / 16) + (sq >> 4)) * 2 + (dd >> 5)) * 512 + (sq & 15) * 32 + (dd & 31) : QK + (size_t)t * D + c;
                    px_store_bf16_perm(dst, acc[ai][bj][m][0], acc[ai][bj][m][1]); } }
      }); }
    { PxDense S{(const char*)(F.ws + WS_H3), (const char*)(F.ws + WS_WQKV) + (size_t)2 * D * D * 2, 64, 4, D, F.G, F.bid, (unsigned)(D * 2), 4, 0};
      pgx::gemm_phase<false, false>(F.lds, D, D * 2, S, [&](const f32x4 (&acc)[2][2][4][2], const pgx::Unit& u, int wr, int wc, int fr, int fq) {
#pragma unroll
        for (int ai = 0; ai < 2; ++ai)
#pragma unroll
            for (int m = 0; m < 4; ++m) { const int t = u.r0 + ai * 128 + wr * 64 + m * 16 + 4 * fq, b = t / SEQ, sidx = t % SEQ;
#pragma unroll
                for (int bj = 0; bj < 2; ++bj)
#pragma unroll
                    for (int n = 0; n < 2; ++n) { const int c = u.c0 + bj * 128 + wc * 32 + n * 16 + fr, h = c >> 6, d = c & 63;
                        const int k6 = sidx & 63, kk = k6 & 31;
                        st_bf4(VT + ((size_t)(b * NH + h) * (SEQ / 64) + (sidx >> 6)) * 4096 + ((d >> 4) * 2 + (k6 >> 5)) * 512 + ((d & 15) * 4 + ((kk & 15) >> 2)) * 8 + (kk >> 4) * 4, acc[ai][bj][m][n]); } }
      }); }
}
struct PxMoe {
    const char* Asrc; const int* TOK; const int* TILEE; const char* W; const char* Wsh; int routed, nmt, nN, K, G, c; unsigned lda; size_t wexp; bool gather;
    __device__ __forceinline__ bool next(int i, pgx::Unit& u) const {
        const int w = px_unit_index(i, G, c, nmt * nN); if (w < 0) return false;
        const int mt = w / nN, pn = w % nN, row0 = mt * 256; const bool sh = row0 >= routed; const int e = sh ? 64 : TILEE[mt];
        if (gather) { if (sh) { u.A = Asrc + (size_t)(row0 - routed) * lda; u.tok = nullptr; } else { u.A = Asrc; u.tok = TOK + row0; } }
        else { u.A = Asrc + (size_t)row0 * lda; u.tok = nullptr; }
        u.B = (sh ? Wsh : W + (size_t)e * wexp) + (size_t)pn * 256 * K * 2; u.r0 = row0; u.c0 = pn * 256; u.aux = 0; return true;
    }
};
__device__ __forceinline__ void ph_gateup_px(const Frame& F, int layer) {
    bf16_t* HB = (bf16_t*)(F.ws + WS_HB); const int* START = (const int*)(F.ws + WS_START);
    const int routed = START[65], nmt = (routed + T) / 256;
    PxMoe S{(const char*)(F.ws + WS_H2), (const int*)(F.ws + WS_TOK), (const int*)(F.ws + WS_TILEE), (const char*)(F.ws + (layer == 0 ? WS_WGU : WS_WGU1)), (const char*)(F.ws + WS_WGU) + (size_t)64 * 512 * D * 2, routed, nmt, 2, D, F.G, F.bid, (unsigned)(D * 2), (size_t)512 * D * 2, true};
    pgx::gemm_phase<true, true>(F.lds, D, D * 2, S, [&](const f32x4 (&acc)[2][2][4][2], const pgx::Unit& u, int wr, int wc, int fr, int fq) {
        bf16_t* base = HB + (u.c0 >> 1) + wc * 32 + 8 * fq;
#pragma unroll
        for (int ai = 0; ai < 2; ++ai)
#pragma unroll
            for (int m = 0; m < 4; ++m) { f32x4 v[2];
#pragma unroll
                for (int n = 0; n < 2; ++n)
#pragma unroll
                    for (int e = 0; e < 4; ++e) { const float g = acc[ai][0][m][n][e]; v[n][e] = g * sigmoidf_(g) * acc[ai][1][m][n][e]; }
                px_store_bf16_perm(base + (size_t)(u.r0 + ai * 128 + wr * 64 + m * 16 + fr) * DE, v[0], v[1]); }
    });
}
__device__ __forceinline__ void ph_down_px(const Frame& F) {
    bf16_t* YB = (bf16_t*)(F.ws + WS_YB); const int* START = (const int*)(F.ws + WS_START);
    const int routed = START[65], nmt = (routed + T) / 256;
    PxMoe S{(const char*)(F.ws + WS_HB), nullptr, (const int*)(F.ws + WS_TILEE), (const char*)(F.ws + WS_WDN), (const char*)(F.ws + WS_WDN) + (size_t)64 * D * DE * 2, routed, nmt, 4, DE, F.G, F.bid, (unsigned)(DE * 2), (size_t)D * DE * 2, false};
    pgx::gemm_phase<true, true>(F.lds, DE, DE * 2, S, [&](const f32x4 (&acc)[2][2][4][2], const pgx::Unit& u, int wr, int wc, int fr, int fq) {
        unsigned char* base = (unsigned char*)YB + u.c0 + wc * 32 + 8 * fq;
#pragma unroll
        for (int ai = 0; ai < 2; ++ai)
#pragma unroll
            for (int m = 0; m < 4; ++m) { unsigned char* rowp = base + (size_t)(u.r0 + ai * 128 + wr * 64 + m * 16 + fr) * D;
#pragma unroll
                for (int bj = 0; bj < 2; ++bj) { u32x2 w;
                    w.x = pack_fp8x4(acc[ai][bj][m][0]); w.y = pack_fp8x4(acc[ai][bj][m][1]);
                    *(u32x2*)(rowp + bj * 128) = w; }
                asm volatile("" ::: "memory"); }
    });
}

__global__ void __launch_bounds__(NTHREADS, 2) mega(Args args) {
    extern __shared__ __attribute__((aligned(16))) unsigned char lds[];
    Frame F;
    F.in = args.in; F.out = args.out; F.ws = args.ws; F.ctl = (unsigned*)(args.ws + WS_CTL);
    F.ldsf = (float*)lds; F.lds = (LAS unsigned char*)lds;
    F.tid = threadIdx.x; F.lane = F.tid & 63; F.wave = __builtin_amdgcn_readfirstlane(F.tid >> 6); F.bid = blockIdx.x; F.G = gridDim.x;
    if (F.tid < 4) ((unsigned*)(lds + LDS_BYTES - 64))[F.tid] = 0u;
    __syncthreads();
    XcdBarrier bar; bar.bar = F.ctl + CW_BAR; bar.x = 0; bar.st = (volatile LAS unsigned*)(lds + LDS_BYTES - 64);
#if MK_N_LAUNCHES == 1
    bar = xcd_barrier_post(F.ctl + CW_BAR, (volatile LAS unsigned*)(lds + LDS_BYTES - 64));
#endif
    const int lo = args.ph_lo, hi = args.ph_hi;
#define IN(k) (lo <= (k) && (k) < hi)
#define SEAM(k) do { if (IN(k) && IN((k) + 1)) xcd_barrier(bar); } while (0)
    bf16_t* const wsb = (bf16_t*)args.ws;
    (void)wsb;
    if (IN(0)) { ph_mod(F); conv_dense(F, 0, F.bid, F.G); if (F.G <= 2 * NB * NH) { conv_dense(F, 1, F.bid, F.G); conv_moe(F, 0, 3, F.bid, F.G); } } SEAM(0);
    if (IN(1)) { ph_prenorm_rwkv(F); } SEAM(1);
    if (IN(2)) { ph_rkv_px(F); ph_lora_dn_sg(F); } SEAM(2);
    if (IN(3)) { ph_lora_up_sg(F); } SEAM(3);
    if (IN(4)) { ph_wkv_chunk(F); } SEAM(4);
    if (IN(5)) { if (F.bid < NB * NH || F.G <= 2 * NB * NH) { ph_wkv_carry(F); } else { conv_dense(F, 1, F.bid - NB * NH, F.G - NB * NH); conv_moe(F, 0, 3, F.bid - NB * NH, F.G - NB * NH); conv_moe(F, 1, 1, F.bid - NB * NH, F.G - NB * NH); } } SEAM(5);
    if (IN(6)) { ph_wkv_out(F); } SEAM(6);
    if (IN(7)) { ph_dense_bf16_px(F, (const bf16_t*)(F.ws + WS_OG), (const bf16_t*)(F.ws + WS_WO), (bf16_t*)(F.ws + WS_Y1)); } SEAM(7);
    if (IN(8)) { ph_postmix_preffn<false>(F, 0, F.in[I_X], (const bf16_t*)(F.ws + WS_Y1)); } SEAM(8);
    if (IN(9)) { ph_router_sg(F, 0); } SEAM(9);
    if (IN(10)) { ph_topk(F, 0); } SEAM(10);
    if (IN(11)) { ph_offsets(F, 0); } SEAM(11);
    if (IN(12)) { ph_gateup_px(F, 0); } SEAM(12);
    if (IN(13)) { ph_down_px(F); } SEAM(13);
    if (IN(14)) { ph_combine(F, 0, true); conv_moe(F, 1, (F.G <= 2 * NB * NH) ? 3 : 2, F.bid, F.G); } SEAM(14);
    if (IN(15)) { ph_qkv_px(F); } SEAM(15);
    if (IN(16)) { ph_attn(F); } SEAM(16);
    if (IN(17)) { ph_dense_bf16_px(F, (const bf16_t*)(F.ws + WS_AO), (const bf16_t*)(F.ws + WS_WSBO), (bf16_t*)(F.ws + WS_Y1B)); } SEAM(17);
    if (IN(18)) { ph_postmix_preffn<true>(F, 1, nullptr, (const bf16_t*)(F.ws + WS_Y1B)); } SEAM(18);
    if (IN(19)) { ph_router_sg(F, 1); } SEAM(19);
    if (IN(20)) { ph_topk(F, 1); } SEAM(20);
    if (IN(21)) { ph_offsets(F, 1); } SEAM(21);
    if (IN(22)) { ph_gateup_px(F, 1); } SEAM(22);
    if (IN(23)) { ph_down_px(F); } SEAM(23);
    if (IN(24)) { ph_combine(F, 1, false); }
#undef IN
#undef SEAM
}

extern "C" void kernel_launch(void* const* d_in, const int* in_sizes, int n_in, void* d_out, int out_size, void* d_ws, size_t ws_size, hipStream_t stream) {
    static int grid = 0;
    if (grid == 0) {
        if (n_in != 34 || in_sizes[0] != T * D || out_size != T * D || ws_size < WS_END) {
            fprintf(stderr, "kernel_launch: unexpected shapes: n_in %d in0 %d out %d ws %zu (need %zu)\n", n_in, n_in > 0 ? in_sizes[0] : -1, out_size, ws_size, (size_t)WS_END);
            grid = -1; return;
        }
        int dev = 0, cus = 0, per_cu = 0;
        if (hipGetDevice(&dev) != hipSuccess || hipDeviceGetAttribute(&cus, hipDeviceAttributeMultiprocessorCount, dev) != hipSuccess) { grid = -1; return; }
        if (hipFuncSetAttribute((const void*)mega, hipFuncAttributeMaxDynamicSharedMemorySize, LDS_BYTES) != hipSuccess) { fprintf(stderr, "kernel_launch: hipFuncSetAttribute failed\n"); grid = -1; return; }
        if (hipOccupancyMaxActiveBlocksPerMultiprocessor(&per_cu, (const void*)mega, NTHREADS, LDS_BYTES) != hipSuccess || per_cu < 1)
            fprintf(stderr, "kernel_launch: occupancy query reports %d blocks per CU\n", per_cu);
        (void)hipGetLastError();
        grid = cus;
    }
    if (grid < 0) return;
    if (hipMemsetAsync((char*)d_ws + WS_CTL, 0, CTL_BYTES, stream) != hipSuccess) { fprintf(stderr, "kernel_launch: memset failed\n"); return; }
    Args a{};
    for (int i = 0; i < 34; ++i) a.in[i] = (const float*)d_in[i];
    a.out = (float*)d_out; a.ws = (unsigned char*)d_ws;
#if MK_N_LAUNCHES == 1
    a.ph_lo = 0; a.ph_hi = NPHASES;
    hipLaunchKernelGGL(mega, dim3(grid), dim3(NTHREADS), LDS_BYTES, stream, a);
#else
    for (int p = 0; p < NPHASES; ++p) { a.ph_lo = p; a.ph_hi = p + 1; hipLaunchKernelGGL(mega, dim3(grid), dim3(NTHREADS), LDS_BYTES, stream, a); }
#endif
    const hipError_t le = hipPeekAtLastError();
    if (le != hipSuccess) fprintf(stderr, "kernel_launch: launch failed: %s\n", hipGetErrorName(le));
}
```

```cpp
#include <hip/hip_runtime.h>
#include <cstdio>
#include <cstdint>

#ifndef MK_N_LAUNCHES
#define MK_N_LAUNCHES 1
#endif

constexpr int T = 16384, D = 1024, SEQ = 8192, NB = 2, NH = 16, HD = 64;
constexpr int NE = 64, TOPK = 8, DE = 256;
constexpr int RP = 256;
constexpr int MAXROUTED = 147456;
constexpr int MAXROWS = MAXROUTED + T;
constexpr int NTHREADS = 512, NWAVES = 8;
constexpr int NPHASES = 25;
constexpr int LDS_BYTES = 144 * 1024;
constexpr float YB_SCALE = 16.0f;

typedef unsigned short bf16_t;
typedef float f32x4 __attribute__((ext_vector_type(4)));
typedef unsigned u32x4 __attribute__((ext_vector_type(4)));
typedef unsigned u32x2 __attribute__((ext_vector_type(2)));

__device__ __forceinline__ float bf2f(bf16_t b) { return __uint_as_float(((unsigned)b) << 16); }
typedef __bf16 bf16x2_t __attribute__((ext_vector_type(2)));
typedef float f32x2 __attribute__((ext_vector_type(2)));
__device__ __forceinline__ unsigned pack2(float a, float b) { const f32x2 v = {a, b}; const bf16x2_t r = __builtin_convertvector(v, bf16x2_t); return __builtin_bit_cast(unsigned, r); }
__device__ __forceinline__ bf16_t f2bf(float f) { return (bf16_t)(pack2(f, 0.f) & 0xffffu); }
__device__ __forceinline__ float lo2f(unsigned u) { return __uint_as_float(u << 16); }
__device__ __forceinline__ float hi2f(unsigned u) { return __uint_as_float(u & 0xffff0000u); }
__device__ __forceinline__ f32x4 ld4_g(const bf16_t* p) { const u32x2 w = *(const u32x2*)p; return (f32x4){lo2f(w.x), hi2f(w.x), lo2f(w.y), hi2f(w.y)}; }
__device__ __forceinline__ float fexp_(float x) { return __builtin_amdgcn_exp2f(x * 1.4426950408889634f); }
__device__ __forceinline__ float sigmoidf_(float x) { return __builtin_amdgcn_rcpf(1.0f + fexp_(-x)); }
__device__ __forceinline__ float tanhf_(float x) { return 1.0f - 2.0f * __builtin_amdgcn_rcpf(1.0f + fexp_(2.0f * x)); }
__device__ __forceinline__ float softplusf_(float x) { const float e = fexp_(x); const float l = __builtin_amdgcn_logf(1.0f + e) * 0.6931471805599453f; return x > 15.f ? x : (x < -8.f ? e : l); }
__device__ __forceinline__ float wave_sum(float v) {
#pragma unroll
    for (int o = 32; o >= 1; o >>= 1) v += __shfl_xor(v, o);
    return v;
}

constexpr size_t MiB = 1024 * 1024;
constexpr size_t WS_CTL    = 0;
constexpr size_t CTL_BYTES = 64 * 1024;
constexpr size_t WS_MOD    = 64 * 1024;
constexpr size_t WS_IDX    = 256 * 1024;
constexpr size_t WS_GATE   = WS_IDX + 512 * 1024;
constexpr size_t WS_RANK   = WS_GATE + 512 * 1024;
constexpr size_t WS_POS    = WS_RANK + 512 * 1024;
constexpr size_t WS_TOK    = WS_POS + 512 * 1024;
constexpr size_t WS_TILEE  = WS_TOK + 704 * 1024;
constexpr size_t WS_START  = WS_TILEE + 4096;
constexpr size_t WS_LOGITS = 8 * MiB + 64 * MiB;
constexpr size_t WS_BC     = 4 * MiB;
constexpr size_t WS_BIG    = 8 * MiB;
constexpr size_t WS_XS   = WS_BIG;
constexpr size_t WS_RKV  = WS_BIG + 192 * MiB;
constexpr size_t WS_LORA = WS_BIG + 288 * MiB;
constexpr size_t WS_LD   = WS_BIG;
constexpr size_t WS_AA   = WS_BIG + 64 * MiB;
constexpr size_t WS_GG   = WS_BIG + 96 * MiB;
constexpr size_t WS_O    = WS_BIG + 128 * MiB;
constexpr size_t WS_OG   = WS_BIG + 296 * MiB;
constexpr size_t WS_Y1   = WS_BIG + 328 * MiB;
constexpr size_t WS_H2   = WS_BIG;
constexpr size_t WS_H2LO = WS_BIG + 32 * MiB;
constexpr size_t WS_YB   = WS_BIG;
constexpr size_t WS_HB   = WS_BIG + 320 * MiB;
constexpr size_t WS_H3   = WS_BIG + 320 * MiB;
constexpr size_t WS_Q    = WS_BIG;
constexpr size_t WS_AO   = WS_BIG + 96 * MiB;
constexpr size_t WS_XR   = WS_BIG + 256 * MiB;
constexpr size_t WS_Y1B  = WS_BIG + 128 * MiB;
constexpr size_t WS_W     = WS_BIG + 400 * MiB;
constexpr size_t WS_WGU1  = WS_BIG + 192 * MiB;
constexpr size_t WS_WGU   = WS_W;
constexpr size_t WS_WDN   = WS_WGU + (size_t)65 * 512 * 1024 * 2;
constexpr size_t WS_WRKV  = WS_WDN + (size_t)65 * 1024 * 256 * 2;
constexpr size_t WS_WO    = WS_WRKV + (size_t)3072 * 1024 * 2;
constexpr size_t WS_WQKV  = WS_WO + (size_t)1024 * 1024 * 2;
constexpr size_t WS_WSBO  = WS_WQKV + (size_t)3072 * 1024 * 2;
constexpr size_t WS_WLDN  = WS_WSBO + (size_t)1024 * 1024 * 2;
constexpr size_t WS_WLUP  = WS_WLDN + (size_t)256 * 1024 * 2;
constexpr size_t WS_WRT   = WS_WLUP + (size_t)1024 * 256 * 2;
constexpr size_t WS_END   = WS_WRT + (size_t)2 * 64 * 3072 * 2;

constexpr int CW_BAR = 0;
constexpr int CW_CNT = 4096;
constexpr int CW_AQ = 4608;

#define XB_TMO      128
#define XB_XCNT(j)  (256  + 64 * (j))
#define XB_XSUB(j)  (1280 + 64 * (j))
#define XB_XGEN(j)  (2304 + 64 * (j))
#define XB_TOP      3328
#define XB_TOPGEN   3392
#define XCD_BAR_WORDS 3456
#define XB_SPIN_CAP (1u << 22)
#define LAS __attribute__((address_space(3)))

__device__ __forceinline__ unsigned xb_ld(unsigned* p)              { return __hip_atomic_load(p, __ATOMIC_RELAXED, __HIP_MEMORY_SCOPE_AGENT); }
__device__ __forceinline__ unsigned xb_add(unsigned* p, unsigned v) { return __hip_atomic_fetch_add(p, v, __ATOMIC_RELAXED, __HIP_MEMORY_SCOPE_AGENT); }
__device__ __forceinline__ unsigned xb_xcc_id() { return (unsigned)__builtin_amdgcn_s_getreg((3 << 11) | 20) & 0xFu; }
#define XB_SPIN(cond, bar) do { unsigned _sp = 0; while (cond) { __builtin_amdgcn_s_sleep(1); \
    if ((++_sp & 255u) == 0u) { if (xb_ld(&(bar)[XB_TMO])) break; if (_sp > XB_SPIN_CAP) { atomicAdd(&(bar)[XB_TMO], 1u); break; } } } } while (0)

struct XcdBarrier { unsigned* bar; unsigned x; volatile LAS unsigned* st; };

__device__ __forceinline__ XcdBarrier xcd_barrier_post(unsigned* bar, volatile LAS unsigned* st) {
    XcdBarrier b; b.bar = bar; b.x = xb_xcc_id(); b.st = st;
    if (threadIdx.x == 0) (void)xb_add(&bar[XB_XCNT(b.x)], 1u);
    return b;
}
__device__ __forceinline__ void xcd_barrier_complete(unsigned* bar, unsigned x, unsigned& nloc, unsigned& nx) {
    const unsigned G = gridDim.x * gridDim.y * gridDim.z;
    unsigned sum, cnt, mine, sp = 0u;
    for (;;) {
        sum = 0u; cnt = 0u; mine = 0u;
#pragma unroll
        for (unsigned j = 0; j < 16; ++j) { const unsigned c = xb_ld(&bar[XB_XCNT(j)]); sum += c; cnt += (c > 0u) ? 1u : 0u; mine = (j == x) ? c : mine; }
        if (sum == G) break;
        __builtin_amdgcn_s_sleep(1);
        if ((++sp & 255u) == 0u) { if (xb_ld(&bar[XB_TMO])) break; if (sp > XB_SPIN_CAP) { atomicAdd(&bar[XB_TMO], 1u); break; } }
    }
    nloc = mine > 0u ? mine : 1u; nx = cnt > 0u ? cnt : 1u;
}
__device__ __forceinline__ void xcd_barrier(const XcdBarrier& b) {
    asm volatile("s_waitcnt vmcnt(0)" ::: "memory");
    __syncthreads();
    if (threadIdx.x == 0) {
        unsigned* bar = b.bar;
        __builtin_amdgcn_s_waitcnt(0);
        unsigned nloc = b.st[0], nx = b.st[1];
        if (nloc == 0u) { xcd_barrier_complete(bar, b.x, nloc, nx); b.st[0] = nloc; b.st[1] = nx; }
        const unsigned old = xb_add(&bar[XB_XSUB(b.x)], 1u);
        const unsigned gen = old / nloc;
        if (old + 1u == (gen + 1u) * nloc) {
            __builtin_amdgcn_fence(__ATOMIC_RELEASE, "agent");
            asm volatile("s_waitcnt vmcnt(0)" ::: "memory");
            const unsigned og = xb_add(&bar[XB_TOP], 1u);
            const unsigned tg = og / nx;
            if (og + 1u == (tg + 1u) * nx) xb_add(&bar[XB_TOPGEN], 1u);
            else XB_SPIN(xb_ld(&bar[XB_TOPGEN]) == tg, bar);
            __builtin_amdgcn_fence(__ATOMIC_ACQUIRE, "agent");
            xb_add(&bar[XB_XGEN(b.x)], 1u);
            asm volatile("s_waitcnt vmcnt(0)" ::: "memory");
        } else {
            XB_SPIN(xb_ld(&bar[XB_XGEN(b.x)]) == gen, bar);
            __builtin_amdgcn_fence(__ATOMIC_ACQUIRE, "agent");
            asm volatile("s_waitcnt vmcnt(0)" ::: "memory");
        }
    }
    __syncthreads();
}

struct Args { const float* in[34]; float* out; unsigned char* ws; int ph_lo, ph_hi; };

struct Frame {
    const float* const* in; float* out; unsigned char* ws; unsigned* ctl;
    float* ldsf; LAS unsigned char* lds; int tid, lane, wave, bid, G;
};

enum { I_X = 0, I_C, I_ADAW, I_ADAB, I_NPM, I_NPOM, I_NPF, I_NPOF, I_MU, I_WRKV, I_WW1, I_WW2, I_W0, I_WA1, I_WA2, I_A0, I_WG1, I_WG2,
       I_KK, I_KA, I_RK, I_LNG, I_LNB, I_WO, I_SBQKV, I_SBO, I_ROUTER, I_RBIAS, I_MG, I_MU_, I_MD, I_SG, I_SU, I_SD };


typedef short bf16x8 __attribute__((ext_vector_type(8)));
typedef short s16x4 __attribute__((ext_vector_type(4)));
constexpr int HTB = 128 * 64 * 2;
__device__ __forceinline__ int lds_byte(int r, int c) { const int st = (r >> 4) * 2 + (c >> 5), rr = r & 15, cc = c & 31, ob = rr * 64 + cc * 2; return st * 1024 + (ob ^ (((ob >> 9) & 1) << 5)); }
__device__ __forceinline__ void stage_rc(int b, int& R, int& C) { const int st = b / 1024, sb = b % 1024, swz = sb ^ (((sb >> 9) & 1) << 5); R = (st >> 1) * 16 + swz / 64; C = (st & 1) * 32 + (swz % 64) / 2; }
#define WAIT_V(n) asm volatile("s_waitcnt vmcnt(" #n ")" ::: "memory")
#define SBAR() do { asm volatile("" ::: "memory"); __builtin_amdgcn_s_barrier(); asm volatile("" ::: "memory"); } while (0)

struct ASeg { const bf16_t* p[3]; int segTiles; };

struct BRowId { __device__ __forceinline__ int operator()(int R) const { return R; } };
struct SgChain { int ph; bool pre; bool nvalid; ASeg nA; const bf16_t* nBt; int nldb; };
template <int BN, bool NSW = false, class ARow, class Epi, class BRow = BRowId>
__device__ __forceinline__ void sg_tile(LAS unsigned char* lds, const ASeg& A, const ARow& arow, const bf16_t* Bt, int ldb, int nt, const Epi& epi, const BRow& brow = BRow(), SgChain* ch = nullptr) {
    constexpr int WN = BN / 64, WM = 8 / WN, WR = 256 / WM, MT = WR / 16;
    int tid_ = threadIdx.x; asm volatile("" : "+v"(tid_));
    const int tid = tid_, wid = __builtin_amdgcn_readfirstlane(tid >> 6), lane = tid & 63, fr = lane & 15, fq = lane >> 4;
    const int wm = wid / WN, wn = wid % WN;
    unsigned aoffs[2][2], boffs[2];
#pragma unroll
    for (int i = 0; i < 2; ++i) { int R, C; stage_rc(tid * 16 + i * 8192, R, C);
        aoffs[0][i] = arow(R) + (unsigned)C * 2u; aoffs[1][i] = arow(128 + R) + (unsigned)C * 2u; boffs[i] = (unsigned)(brow(R) * ldb + C) * 2u; }
    const unsigned ldsw = (unsigned)wid * 1024u;
    f32x4 acc[MT][4];
#pragma unroll
    for (int m = 0; m < MT; ++m)
#pragma unroll
        for (int n = 0; n < 4; ++n) acc[m][n] = (f32x4){0.f, 0.f, 0.f, 0.f};
    const int arow0 = wm * WR, ah = arow0 >> 7, ar = arow0 & 127;
    const int aoff = ah * HTB + lds_byte(ar + fr, fq * 8), boff = 2 * HTB + lds_byte(wn * 64 + fr, fq * 8);
#define SG_STAGE_X(AX, BX, BO, kt, s) do { const int sg_ = (kt) / (AX).segTiles; const char* ab_ = (const char*)(sg_ == 0 ? (AX).p[0] : (sg_ == 1 ? (AX).p[1] : (AX).p[2])) + (size_t)((kt) - sg_ * (AX).segTiles) * 128; const char* bb_ = (const char*)(BX) + (size_t)(kt) * 128; \
        _Pragma("unroll") for (int h_ = 0; h_ < 2; ++h_) _Pragma("unroll") for (int i_ = 0; i_ < 2; ++i_) \
            __builtin_amdgcn_global_load_lds((const unsigned*)(ab_ + aoffs[h_][i_]), (LAS unsigned*)(lds + ((s) * 3 + h_) * HTB + ldsw + i_ * 8192), 16, 0, 0); \
        _Pragma("unroll") for (int i_ = 0; i_ < WN; ++i_) \
            __builtin_amdgcn_global_load_lds((const unsigned*)(bb_ + (BO)[i_]), (LAS unsigned*)(lds + ((s) * 3 + 2) * HTB + ldsw + i_ * 8192), 16, 0, 0); } while (0)
#define SG_STAGE(kt, s) SG_STAGE_X(A, Bt, boffs, kt, s)
    const int ph0 = ch ? ch->ph : 0;
    if (!(ch && ch->pre)) SG_STAGE(0, ph0);
    for (int t = 0; t < nt; ++t) {
        const int s = (ph0 + t) & 1;
        if (t + 1 < nt) { SG_STAGE(t + 1, s ^ 1); if (WN == 2) WAIT_V(6); else WAIT_V(5); }
        else if (ch && ch->nvalid) { unsigned nbo[2];
#pragma unroll
            for (int i = 0; i < 2; ++i) { int R, C; stage_rc(tid * 16 + i * 8192, R, C); nbo[i] = (unsigned)(brow(R) * ch->nldb + C) * 2u; }
            SG_STAGE_X(ch->nA, ch->nBt, nbo, 0, s ^ 1); if (WN == 2) WAIT_V(6); else WAIT_V(5); }
        else { WAIT_V(0); }
        SBAR();
        LAS unsigned char* base = lds + s * 3 * HTB;
#pragma unroll
        for (int k = 0; k < 2; ++k) {
            bf16x8 af[MT], bfr[4];
#pragma unroll
            for (int m = 0; m < MT; ++m) af[m] = *(const LAS bf16x8*)(base + aoff + m * 2048 + k * 1024);
#pragma unroll
            for (int n = 0; n < 4; ++n) bfr[n] = *(const LAS bf16x8*)(base + boff + n * 2048 + k * 1024);
#pragma unroll
            for (int m = 0; m < MT; ++m)
#pragma unroll
                for (int n = 0; n < 4; ++n) acc[m][n] = NSW ? __builtin_amdgcn_mfma_f32_16x16x32_bf16(af[m], bfr[n], acc[m][n], 0, 0, 0) : __builtin_amdgcn_mfma_f32_16x16x32_bf16(bfr[n], af[m], acc[m][n], 0, 0, 0);
        }
        SBAR();
    }
#undef SG_STAGE
#undef SG_STAGE_X
    if (ch) { ch->ph = (ph0 + nt) & 1; ch->pre = ch->nvalid; }
    epi(acc, arow0, wn * 64, fr, fq);
}

struct CTile { bf16_t* dst; const float* src; int dld, sld, ncols; float scale; };
template <class TF>
__device__ __forceinline__ void conv_tiles(const Frame& F, int ntiles, int u0, int ustride, const TF& tf) {
    unsigned* tl = (unsigned*)F.ldsf;
    const int i = F.tid & 31, kp0 = F.tid >> 5;
    if (u0 >= ntiles) return;
    CTile ct = tf(u0);
    f32x4 a[4], b[4];
#define CV_LOAD() do { _Pragma("unroll") for (int q = 0; q < 4; ++q) { const int kp = kp0 + 16 * q; \
        if (4 * i < ct.ncols) { a[q] = *(const f32x4*)(ct.src + (size_t)(2 * kp) * ct.sld + 4 * i); b[q] = *(const f32x4*)(ct.src + (size_t)(2 * kp + 1) * ct.sld + 4 * i); } } } while (0)
    CV_LOAD();
    for (int u = u0; u < ntiles; u += ustride) {
        const CTile cur = ct;
        if (4 * i < cur.ncols) {
#pragma unroll
            for (int q = 0; q < 4; ++q) { const int kp = kp0 + 16 * q;
#pragma unroll
                for (int e = 0; e < 4; ++e) tl[(4 * i + e) * 65 + kp] = pack2(a[q][e] * cur.scale, b[q][e] * cur.scale); }
        }
        __syncthreads();
        if (u + ustride < ntiles) { ct = tf(u + ustride); CV_LOAD(); }
        const int nb = F.tid >> 4, sgm = F.tid & 15;
#pragma unroll
        for (int q = 0; q < 4; ++q) { const int n = nb + 32 * q;
            if (n < cur.ncols) { u32x4 v;
#pragma unroll
                for (int e = 0; e < 4; ++e) v[e] = tl[n * 65 + sgm * 4 + e];
                *(u32x4*)(cur.dst + (size_t)n * cur.dld + sgm * 8) = v; } }
        __syncthreads();
    }
#undef CV_LOAD
}
__device__ __forceinline__ void conv_moe(const Frame& F, int layer, int parts, int u0, int ustride) {
    bf16_t* WGUr = (bf16_t*)(F.ws + (layer == 0 ? WS_WGU : WS_WGU1)); bf16_t* WGUs = (bf16_t*)(F.ws + WS_WGU) + (size_t)64 * 512 * D; bf16_t* WDN = (bf16_t*)(F.ws + WS_WDN);
    const float* const* in = F.in;
    const int nA = (parts & 1) ? 64 * 32 : 0, nB = (parts & 2) ? 32 + 65 * 16 : 0;
    conv_tiles(F, nA + nB, u0, ustride, [=](int u) {
        CTile c; c.ncols = 128;
        if (u < nA) { const int e = u >> 5, r = u & 31, up = r >> 4, kt = (r >> 1) & 7, nt = r & 1;
            const float* W = (up ? in[I_MU_] : in[I_MG]) + ((size_t)layer * NE + e) * D * DE;
            c.src = W + (size_t)kt * 128 * DE + nt * 128; c.sld = DE; c.dst = WGUr + ((size_t)e * 512 + nt * 256 + up * 128) * D + kt * 128; c.dld = D; c.scale = 1.0f; }
        else { const int v0 = u - nA;
            if (v0 < 32) { const int up = v0 >> 4, kt = (v0 >> 1) & 7, nt = v0 & 1;
                const float* W = (up ? in[I_SU] : in[I_SG]) + (size_t)layer * D * DE;
                c.src = W + (size_t)kt * 128 * DE + nt * 128; c.sld = DE; c.dst = WGUs + ((size_t)nt * 256 + up * 128) * D + kt * 128; c.dld = D; c.scale = 1.0f; }
            else { const int v1 = v0 - 32, e = v1 >> 4, v = v1 & 15, kt = v >> 3, nt = v & 7;
                const float* W = (e < 64) ? in[I_MD] + ((size_t)layer * NE + e) * DE * D : in[I_SD] + (size_t)layer * DE * D;
                c.src = W + (size_t)kt * 128 * D + nt * 128; c.sld = D; c.dst = WDN + ((size_t)e * D + nt * 128) * DE + kt * 128; c.dld = DE; c.scale = YB_SCALE; } }
        return c; });
}
__device__ __forceinline__ void conv_dense(const Frame& F, int part, int u0, int ustride) {
    bf16_t* WRKV = (bf16_t*)(F.ws + WS_WRKV); bf16_t* WO = (bf16_t*)(F.ws + WS_WO); bf16_t* WQKV = (bf16_t*)(F.ws + WS_WQKV); bf16_t* WSBO = (bf16_t*)(F.ws + WS_WSBO); bf16_t* WLDN = (bf16_t*)(F.ws + WS_WLDN);
    const float* const* in = F.in;
    const int gtid = u0 * NTHREADS + F.tid, gstride = ustride * NTHREADS;
    if (part == 0) {
        conv_tiles(F, 192 + 24, u0, ustride, [=](int u) {
            CTile c; c.dld = D; c.ncols = 128; c.scale = 1.0f;
            if (u < 192) { const int n = u / 64, kt = (u >> 3) & 7, nt = u & 7; c.src = in[I_WRKV] + (size_t)n * D * D + (size_t)kt * 128 * D + nt * 128; c.sld = D; c.dst = WRKV + ((size_t)n * D + nt * 128) * D + kt * 128; }
            else { const int v = u - 192, kt = v / 3, j = v % 3;
                if (j == 0) { c.src = in[I_WW1] + (size_t)kt * 128 * 64; c.sld = 64; c.dst = WLDN + kt * 128; c.ncols = 64; }
                else if (j == 1) { c.src = in[I_WA1] + (size_t)kt * 128 * 64; c.sld = 64; c.dst = WLDN + (size_t)64 * D + kt * 128; c.ncols = 64; }
                else { c.src = in[I_WG1] + (size_t)kt * 128 * 128; c.sld = 128; c.dst = WLDN + (size_t)128 * D + kt * 128; } }
            return c; });
        bf16_t* WLUP = (bf16_t*)(F.ws + WS_WLUP);
        for (int i = gtid; i < 1024 * 256; i += gstride) {
            float v;
            if (i < 1024 * 64) { const int n = i / 64, k = i % 64; v = F.in[I_WW2][k * D + n]; }
            else if (i < 2 * 1024 * 64) { const int j = i - 1024 * 64, n = j / 64, k = j % 64; v = F.in[I_WA2][k * D + n]; }
            else { const int j = i - 2 * 1024 * 64, n = j / 128, k = j % 128; v = F.in[I_WG2][k * D + n]; }
            WLUP[i] = f2bf(v);
        }
    } else {
        conv_tiles(F, 64 + 192 + 64, u0, ustride, [=](int u) {
            CTile c; c.dld = D; c.ncols = 128; c.scale = 1.0f;
            if (u < 64) { const int kt = u >> 3, nt = u & 7; c.src = in[I_WO] + (size_t)kt * 128 * D + nt * 128; c.sld = D; c.dst = WO + (size_t)nt * 128 * D + kt * 128; }
            else if (u < 256) { const int v = u - 64, kt = v / 24, nt = v % 24; c.src = in[I_SBQKV] + (size_t)kt * 128 * 3 * D + nt * 128; c.sld = 3 * D; c.dst = WQKV + (size_t)nt * 128 * D + kt * 128; }
            else { const int v = u - 256, kt = v >> 3, nt = v & 7; c.src = in[I_SBO] + (size_t)kt * 128 * D + nt * 128; c.sld = D; c.dst = WSBO + (size_t)nt * 128 * D + kt * 128; }
            return c; });
        bf16_t* WRT = (bf16_t*)(F.ws + WS_WRT);
        for (int i = gtid; i < 2 * 64 * 1024; i += gstride) {
            const int l = i / (64 * 1024), j = i % (64 * 1024), e = j / 1024, k = j % 1024;
            const float w = F.in[I_ROUTER][((size_t)l * D + k) * NE + e]; const bf16_t hi = f2bf(w), lo = f2bf(w - bf2f(hi));
            bf16_t* row = WRT + ((size_t)l * 64 + e) * 3072; row[k] = hi; row[1024 + k] = lo; row[2048 + k] = hi;
        }
    }
}

__device__ __forceinline__ unsigned pack_fp8x4(const f32x4& v) {
    const float lim = 440.0f;
    const float a = __builtin_amdgcn_fmed3f(v[0], -lim, lim), b = __builtin_amdgcn_fmed3f(v[1], -lim, lim), c = __builtin_amdgcn_fmed3f(v[2], -lim, lim), d = __builtin_amdgcn_fmed3f(v[3], -lim, lim);
    int w = __builtin_amdgcn_cvt_pk_fp8_f32(a, b, 0, false); w = __builtin_amdgcn_cvt_pk_fp8_f32(c, d, w, true); return (unsigned)w;
}
__device__ __forceinline__ void acc_fp8x16(float (&y)[16], const u32x4& w, float g) {
#pragma unroll
    for (int q = 0; q < 4; ++q) { const f32x2 lo = __builtin_amdgcn_cvt_pk_f32_fp8((int)w[q], false), hi = __builtin_amdgcn_cvt_pk_f32_fp8((int)w[q], true);
        y[4 * q] += g * lo.x; y[4 * q + 1] += g * lo.y; y[4 * q + 2] += g * hi.x; y[4 * q + 3] += g * hi.y; }
}
__device__ __forceinline__ void ph_mod(const Frame& F) {
    const float* c = F.in[I_C]; const float* W = F.in[I_ADAW]; const float* bias = F.in[I_ADAB];
    float* MOD = (float*)(F.ws + WS_MOD);
    float* red = F.ldsf;
    float* sc = F.ldsf + 1024;
    for (int i = F.tid; i < 2 * D; i += NTHREADS) { const float v = c[i]; sc[i] = v * sigmoidf_(v); }
    __syncthreads();
    for (int u = F.bid; u < 192; u += F.G) {
        const int l = u / 96, cg = u % 96, col = cg * 64 + F.lane;
        float s0 = 0.f, s1 = 0.f;
        const float* wp = W + ((size_t)l * D + F.wave * 128) * 6144 + col;
#pragma unroll 1
        for (int d0 = 0; d0 < 128; d0 += 32) {
            float wv[32];
#pragma unroll
            for (int d = 0; d < 32; ++d) wv[d] = wp[(size_t)(d0 + d) * 6144];
#pragma unroll
            for (int d = 0; d < 32; ++d) { const int dd = F.wave * 128 + d0 + d; s0 += sc[dd] * wv[d]; s1 += sc[D + dd] * wv[d]; }
        }
        red[(F.wave * 2 + 0) * 64 + F.lane] = s0; red[(F.wave * 2 + 1) * 64 + F.lane] = s1;
        __syncthreads();
        if (F.tid < 128) {
            const int b = F.tid >> 6, cc = F.tid & 63; float s = 0.f;
#pragma unroll
            for (int w = 0; w < 8; ++w) s += red[(w * 2 + b) * 64 + cc];
            MOD[(l * 2 + b) * 6144 + cg * 64 + cc] = s + bias[l * 6144 + cg * 64 + cc];
        }
        __syncthreads();
    }
}

__device__ __forceinline__ void ph_prenorm_rwkv(const Frame& F) {
    const float* x = F.in[I_X]; const float* g = F.in[I_NPM]; const float* mu = F.in[I_MU];
    const float* MOD = (const float*)(F.ws + WS_MOD);
    bf16_t* XS = (bf16_t*)(F.ws + WS_XS);
    constexpr int RUN_T = 8;
    const int nunits = T / RUN_T, c0 = 16 * F.lane;
    f32x4 m[6][4];
#pragma unroll
    for (int n = 0; n < 6; ++n)
#pragma unroll
        for (int i = 0; i < 4; ++i) m[n][i] = *(const f32x4*)(mu + n * D + c0 + 4 * i);
    for (int u = F.bid * NWAVES + F.wave; u < nunits; u += F.G * NWAVES) {
        const int t0 = u * RUN_T, b = t0 / SEQ;
        const float* shift = MOD + (0 * 2 + b) * 6144; const float* scale = shift + 1024;
        f32x4 gm[4], sh[4];
#pragma unroll
        for (int i = 0; i < 4; ++i) { const int c = c0 + 4 * i; const f32x4 gv = *(const f32x4*)(g + c), sc = *(const f32x4*)(scale + c); gm[i] = gv * (sc + 1.0f); sh[i] = *(const f32x4*)(shift + c); }
        f32x4 hp[4];
#pragma unroll
        for (int i = 0; i < 4; ++i) hp[i] = (f32x4){0.f, 0.f, 0.f, 0.f};
        const int tstart = (t0 % SEQ == 0) ? t0 : t0 - 1;
        for (int t = tstart; t < t0 + RUN_T; ++t) {
            f32x4 xv[4]; float ss = 0.f;
#pragma unroll
            for (int i = 0; i < 4; ++i) { xv[i] = *(const f32x4*)(x + (size_t)t * D + c0 + 4 * i); ss += xv[i][0] * xv[i][0] + xv[i][1] * xv[i][1] + xv[i][2] * xv[i][2] + xv[i][3] * xv[i][3]; }
            ss = wave_sum(ss);
            const float rs = rsqrtf(ss * (1.0f / D) + 1e-6f);
            f32x4 h[4];
#pragma unroll
            for (int i = 0; i < 4; ++i) h[i] = xv[i] * rs * gm[i] + sh[i];
            if (t >= t0) {
#pragma unroll
                for (int n = 0; n < 6; ++n) {
                    u32x4 w0, w1;
#pragma unroll
                    for (int i = 0; i < 4; ++i) {
                        const f32x4 v = h[i] + (hp[i] - h[i]) * m[n][i];
                        const unsigned a0 = pack2(v[0], v[1]), a1 = pack2(v[2], v[3]);
                        if (i == 0) { w0[0] = a0; w0[1] = a1; } else if (i == 1) { w0[2] = a0; w0[3] = a1; } else if (i == 2) { w1[0] = a0; w1[1] = a1; } else { w1[2] = a0; w1[3] = a1; }
                    }
                    bf16_t* dst = XS + ((size_t)n * T + t) * D + c0;
                    *(u32x4*)dst = w0; *(u32x4*)(dst + 8) = w1;
                }
            }
#pragma unroll
            for (int i = 0; i < 4; ++i) hp[i] = h[i];
        }
    }
}


template <bool XBF>
__device__ __forceinline__ void ph_postmix_preffn(const Frame& F, int layer, const float* xin, const bf16_t* Y) {
    const float* MOD = (const float*)(F.ws + WS_MOD);
    const float* gpo = F.in[I_NPOM] + layer * D; const float* gpf = F.in[I_NPF] + layer * D;
    bf16_t* H2 = (bf16_t*)(F.ws + WS_H2); bf16_t* H2LO = (bf16_t*)(F.ws + WS_H2LO); bf16_t* XR = (bf16_t*)(F.ws + WS_XR);
    const int c0 = 16 * F.lane;
    f32x4 gmp[4], gfs[4], shf[4]; int bcur = -1;
    for (int t = F.bid * NWAVES + F.wave; t < T; t += F.G * NWAVES) {
        const int b = t / SEQ;
        if (b != bcur) { bcur = b; const float* m = MOD + (layer * 2 + b) * 6144;
#pragma unroll
            for (int i = 0; i < 4; ++i) { const int c = c0 + 4 * i;
                gmp[i] = *(const f32x4*)(m + 2048 + c) * *(const f32x4*)(gpo + c);
                gfs[i] = *(const f32x4*)(gpf + c) * (*(const f32x4*)(m + 4096 + c) + 1.0f);
                shf[i] = *(const f32x4*)(m + 3072 + c); } }
        const u32x4 y0 = *(const u32x4*)(Y + (size_t)t * D + c0), y1 = *(const u32x4*)(Y + (size_t)t * D + c0 + 8);
        f32x4 xv[4];
        if (XBF) { const u32x4 a0 = *(const u32x4*)(XR + (size_t)t * D + c0), a1 = *(const u32x4*)(XR + (size_t)t * D + c0 + 8);
            xv[0] = (f32x4){lo2f(a0[0]), hi2f(a0[0]), lo2f(a0[1]), hi2f(a0[1])}; xv[1] = (f32x4){lo2f(a0[2]), hi2f(a0[2]), lo2f(a0[3]), hi2f(a0[3])};
            xv[2] = (f32x4){lo2f(a1[0]), hi2f(a1[0]), lo2f(a1[1]), hi2f(a1[1])}; xv[3] = (f32x4){lo2f(a1[2]), hi2f(a1[2]), lo2f(a1[3]), hi2f(a1[3])}; }
        else {
#pragma unroll
            for (int i = 0; i < 4; ++i) xv[i] = *(const f32x4*)(xin + (size_t)t * D + c0 + 4 * i); }
        f32x4 y[4];
        y[0] = (f32x4){lo2f(y0[0]), hi2f(y0[0]), lo2f(y0[1]), hi2f(y0[1])}; y[1] = (f32x4){lo2f(y0[2]), hi2f(y0[2]), lo2f(y0[3]), hi2f(y0[3])};
        y[2] = (f32x4){lo2f(y1[0]), hi2f(y1[0]), lo2f(y1[1]), hi2f(y1[1])}; y[3] = (f32x4){lo2f(y1[2]), hi2f(y1[2]), lo2f(y1[3]), hi2f(y1[3])};
        float ss = 0.f;
#pragma unroll
        for (int i = 0; i < 4; ++i) ss += y[i][0] * y[i][0] + y[i][1] * y[i][1] + y[i][2] * y[i][2] + y[i][3] * y[i][3];
        ss = wave_sum(ss);
        const float rs = rsqrtf(ss * (1.0f / D) + 1e-6f);
        f32x4 x1[4]; float s2 = 0.f;
#pragma unroll
        for (int i = 0; i < 4; ++i) { const int c = c0 + 4 * i;
            x1[i] = xv[i] + gmp[i] * (y[i] * rs);
            s2 += x1[i][0] * x1[i][0] + x1[i][1] * x1[i][1] + x1[i][2] * x1[i][2] + x1[i][3] * x1[i][3]; }
        { u32x4 r0, r1;
          r0[0] = pack2(x1[0][0], x1[0][1]); r0[1] = pack2(x1[0][2], x1[0][3]); r0[2] = pack2(x1[1][0], x1[1][1]); r0[3] = pack2(x1[1][2], x1[1][3]);
          r1[0] = pack2(x1[2][0], x1[2][1]); r1[1] = pack2(x1[2][2], x1[2][3]); r1[2] = pack2(x1[3][0], x1[3][1]); r1[3] = pack2(x1[3][2], x1[3][3]);
          *(u32x4*)(XR + (size_t)t * D + c0) = r0; *(u32x4*)(XR + (size_t)t * D + c0 + 8) = r1; }
        s2 = wave_sum(s2);
        const float rs2 = rsqrtf(s2 * (1.0f / D) + 1e-6f);
        u32x4 h0, h1, l0, l1;
#pragma unroll
        for (int i = 0; i < 4; ++i) {
            const f32x4 h = x1[i] * rs2 * gfs[i] + shf[i];
            const unsigned w0 = pack2(h[0], h[1]), w1 = pack2(h[2], h[3]);
            const unsigned v0 = pack2(h[0] - lo2f(w0), h[1] - hi2f(w0)), v1 = pack2(h[2] - lo2f(w1), h[3] - hi2f(w1));
            if (i == 0) { h0[0] = w0; h0[1] = w1; l0[0] = v0; l0[1] = v1; } else if (i == 1) { h0[2] = w0; h0[3] = w1; l0[2] = v0; l0[3] = v1; }
            else if (i == 2) { h1[0] = w0; h1[1] = w1; l1[0] = v0; l1[1] = v1; } else { h1[2] = w0; h1[3] = w1; l1[2] = v0; l1[3] = v1; }
        }
        *(u32x4*)(H2 + (size_t)t * D + c0) = h0; *(u32x4*)(H2 + (size_t)t * D + c0 + 8) = h1;
        *(u32x4*)(H2LO + (size_t)t * D + c0) = l0; *(u32x4*)(H2LO + (size_t)t * D + c0 + 8) = l1;
    }
}


template <bool XBF>
__device__ __forceinline__ void ph_postmix_route(const Frame& F, int layer, const float* xin, const bf16_t* Y) {
    const float* MOD = (const float*)(F.ws + WS_MOD);
    const float* gpo = F.in[I_NPOM] + layer * D; const float* gpf = F.in[I_NPF] + layer * D;
    bf16_t* H2 = (bf16_t*)(F.ws + WS_H2); bf16_t* XR = (bf16_t*)(F.ws + WS_XR);
    const bf16_t* WRT = (const bf16_t*)(F.ws + WS_WRT) + (size_t)layer * 64 * 3072;
    const float* rb = F.in[I_RBIAS] + layer * NE;
    int* IDX = (int*)(F.ws + WS_IDX); float* GATE = (float*)(F.ws + WS_GATE); int* RANK = (int*)(F.ws + WS_RANK); unsigned* BC = (unsigned*)(F.ws + WS_BC);
    constexpr int RS = 2064;
    LAS unsigned char* AH = F.lds; LAS unsigned char* AL = F.lds + 16 * RS;
    LAS float* PART = (LAS float*)(F.lds + 2 * 16 * RS);
    LAS float* VEC = PART + 8 * 16 * 64;
    LAS float* SL = VEC + 3 * 1024;
    LAS unsigned* lcnt = (LAS unsigned*)(SL + 8 * 8 * 64);
    const int lane = F.lane, w = F.wave, fr = lane & 15, fq = lane >> 4, c0 = 16 * lane;
    const bf16_t* const wfrag = WRT + (size_t)fr * 3072 + 128 * w + 8 * fq;
    const float bias = rb[lane];
    int bcur = -1;
    for (int g = F.bid; g < T / 64; g += F.G) {
        const int b = (g * 64) / SEQ;
        __syncthreads();
        if (b != bcur) { bcur = b; const float* m = MOD + (layer * 2 + b) * 6144;
            for (int c = F.tid; c < D; c += NTHREADS) { VEC[c] = m[2048 + c] * gpo[c]; VEC[1024 + c] = gpf[c] * (m[4096 + c] + 1.0f); VEC[2048 + c] = m[3072 + c]; } }
        if (F.tid < 64) lcnt[F.tid] = 0u;
        __syncthreads();
        bf16x8 bh[4][4];
        { const bf16_t* pw = wfrag; asm volatile("" : "+v"(pw));
#pragma unroll
          for (int n = 0; n < 4; ++n)
#pragma unroll
            for (int ks = 0; ks < 4; ++ks) bh[n][ks] = *(const bf16x8*)(pw + (size_t)n * 16 * 3072 + 32 * ks); }
#pragma unroll 1
        for (int sg = 0; sg < 4; ++sg) {
            const int tw = g * 64 + sg * 16 + 2 * w;
            u32x4 y0v[2], y1v[2], a0v[2], a1v[2]; f32x4 xvv[2][4];
#pragma unroll
            for (int j = 0; j < 2; ++j) { const size_t ro = (size_t)(tw + j) * D + c0;
                y0v[j] = *(const u32x4*)(Y + ro); y1v[j] = *(const u32x4*)(Y + ro + 8);
                if (XBF) { a0v[j] = *(const u32x4*)(XR + ro); a1v[j] = *(const u32x4*)(XR + ro + 8); }
                else {
#pragma unroll
                    for (int i = 0; i < 4; ++i) xvv[j][i] = *(const f32x4*)(xin + ro + 4 * i); } }
#pragma unroll
            for (int j = 0; j < 2; ++j) {
                const int t = tw + j;
                const u32x4 y0 = y0v[j], y1 = y1v[j];
                f32x4 xv[4], y[4];
                if (XBF) { const u32x4 a0 = a0v[j], a1 = a1v[j];
                    xv[0] = (f32x4){lo2f(a0[0]), hi2f(a0[0]), lo2f(a0[1]), hi2f(a0[1])}; xv[1] = (f32x4){lo2f(a0[2]), hi2f(a0[2]), lo2f(a0[3]), hi2f(a0[3])};
                    xv[2] = (f32x4){lo2f(a1[0]), hi2f(a1[0]), lo2f(a1[1]), hi2f(a1[1])}; xv[3] = (f32x4){lo2f(a1[2]), hi2f(a1[2]), lo2f(a1[3]), hi2f(a1[3])}; }
                else {
#pragma unroll
                    for (int i = 0; i < 4; ++i) xv[i] = xvv[j][i]; }
                y[0] = (f32x4){lo2f(y0[0]), hi2f(y0[0]), lo2f(y0[1]), hi2f(y0[1])}; y[1] = (f32x4){lo2f(y0[2]), hi2f(y0[2]), lo2f(y0[3]), hi2f(y0[3])};
                y[2] = (f32x4){lo2f(y1[0]), hi2f(y1[0]), lo2f(y1[1]), hi2f(y1[1])}; y[3] = (f32x4){lo2f(y1[2]), hi2f(y1[2]), lo2f(y1[3]), hi2f(y1[3])};
                float ss = 0.f;
#pragma unroll
                for (int i = 0; i < 4; ++i) ss += y[i][0] * y[i][0] + y[i][1] * y[i][1] + y[i][2] * y[i][2] + y[i][3] * y[i][3];
                ss = wave_sum(ss);
                const float rs = rsqrtf(ss * (1.0f / D) + 1e-6f);
                f32x4 x1[4]; float s2 = 0.f;
#pragma unroll
                for (int i = 0; i < 4; ++i) { const f32x4 gmp = *(const LAS f32x4*)(VEC + c0 + 4 * i);
                    x1[i] = xv[i] + gmp * (y[i] * rs);
                    s2 += x1[i][0] * x1[i][0] + x1[i][1] * x1[i][1] + x1[i][2] * x1[i][2] + x1[i][3] * x1[i][3]; }
                { u32x4 r0, r1;
                  r0[0] = pack2(x1[0][0], x1[0][1]); r0[1] = pack2(x1[0][2], x1[0][3]); r0[2] = pack2(x1[1][0], x1[1][1]); r0[3] = pack2(x1[1][2], x1[1][3]);
                  r1[0] = pack2(x1[2][0], x1[2][1]); r1[1] = pack2(x1[2][2], x1[2][3]); r1[2] = pack2(x1[3][0], x1[3][1]); r1[3] = pack2(x1[3][2], x1[3][3]);
                  *(u32x4*)(XR + (size_t)t * D + c0) = r0; *(u32x4*)(XR + (size_t)t * D + c0 + 8) = r1; }
                s2 = wave_sum(s2);
                const float rs2 = rsqrtf(s2 * (1.0f / D) + 1e-6f);
                u32x4 h0, h1, l0, l1;
#pragma unroll
                for (int i = 0; i < 4; ++i) { const f32x4 gfs = *(const LAS f32x4*)(VEC + 1024 + c0 + 4 * i), shf = *(const LAS f32x4*)(VEC + 2048 + c0 + 4 * i);
                    const f32x4 h = x1[i] * rs2 * gfs + shf;
                    const unsigned w0 = pack2(h[0], h[1]), w1 = pack2(h[2], h[3]);
                    const unsigned v0 = pack2(h[0] - lo2f(w0), h[1] - hi2f(w0)), v1 = pack2(h[2] - lo2f(w1), h[3] - hi2f(w1));
                    if (i == 0) { h0[0] = w0; h0[1] = w1; l0[0] = v0; l0[1] = v1; } else if (i == 1) { h0[2] = w0; h0[3] = w1; l0[2] = v0; l0[3] = v1; }
                    else if (i == 2) { h1[0] = w0; h1[1] = w1; l1[0] = v0; l1[1] = v1; } else { h1[2] = w0; h1[3] = w1; l1[2] = v0; l1[3] = v1; } }
                *(u32x4*)(H2 + (size_t)t * D + c0) = h0; *(u32x4*)(H2 + (size_t)t * D + c0 + 8) = h1;
                LAS unsigned char* rh = AH + (2 * w + j) * RS + lane * 32; LAS unsigned char* rl = AL + (2 * w + j) * RS + lane * 32;
                *(LAS u32x4*)rh = h0; *(LAS u32x4*)(rh + 16) = h1; *(LAS u32x4*)rl = l0; *(LAS u32x4*)(rl + 16) = l1;
            }
            __syncthreads();
            {
                f32x4 acc[4]; bf16x8 bl[4][4], ahf[4];
                { const bf16_t* pw = wfrag + 1024; asm volatile("" : "+v"(pw));
#pragma unroll
                  for (int n = 0; n < 4; ++n)
#pragma unroll
                    for (int ks = 0; ks < 4; ++ks) bl[n][ks] = *(const bf16x8*)(pw + (size_t)n * 16 * 3072 + 32 * ks); }
#pragma unroll
                for (int n = 0; n < 4; ++n) acc[n] = (f32x4){0.f, 0.f, 0.f, 0.f};
#pragma unroll
                for (int ks = 0; ks < 4; ++ks) { const int ko = fr * RS + (128 * w + 32 * ks + 8 * fq) * 2;
                    const bf16x8 ah = *(const LAS bf16x8*)(AH + ko), al = *(const LAS bf16x8*)(AL + ko); ahf[ks] = ah;
#pragma unroll
                    for (int n = 0; n < 4; ++n) { acc[n] = __builtin_amdgcn_mfma_f32_16x16x32_bf16(bh[n][ks], ah, acc[n], 0, 0, 0);
                        acc[n] = __builtin_amdgcn_mfma_f32_16x16x32_bf16(bh[n][ks], al, acc[n], 0, 0, 0); } }
#pragma unroll
                for (int ks = 0; ks < 4; ++ks)
#pragma unroll
                    for (int n = 0; n < 4; ++n) acc[n] = __builtin_amdgcn_mfma_f32_16x16x32_bf16(bl[n][ks], ahf[ks], acc[n], 0, 0, 0);
#pragma unroll
                for (int n = 0; n < 4; ++n) *(LAS f32x4*)(PART + (w * 16 + fr) * 64 + 16 * n + 4 * fq) = acc[n];
            }
            __syncthreads();
#pragma unroll
            for (int j = 0; j < 2; ++j) { float v = 0.f;
#pragma unroll
                for (int ww = 0; ww < 8; ++ww) v += PART[(ww * 16 + 2 * w + j) * 64 + lane];
                SL[(w * 8 + 2 * sg + j) * 64 + lane] = sigmoidf_(v); }
        }
        float s[8], sel[8], tot[8], mysc[8]; int myidx[8]; unsigned lrank[8];
#pragma unroll
        for (int j = 0; j < 8; ++j) { s[j] = SL[(w * 8 + j) * 64 + lane]; sel[j] = s[j] + bias; tot[j] = 0.f; mysc[j] = 0.f; myidx[j] = 0; }
#pragma unroll
        for (int k = 0; k < TOPK; ++k) {
            float bv[8]; int bi[8];
#pragma unroll
            for (int j = 0; j < 8; ++j) { bv[j] = sel[j]; bi[j] = lane; }
#pragma unroll
            for (int o = 32; o >= 1; o >>= 1) {
#pragma unroll
                for (int j = 0; j < 8; ++j) { const float ov = __shfl_xor(bv[j], o); const int oi = __shfl_xor(bi[j], o); const bool take = (ov > bv[j]) | ((ov == bv[j]) & (oi < bi[j])); bv[j] = take ? ov : bv[j]; bi[j] = take ? oi : bi[j]; }
            }
#pragma unroll
            for (int j = 0; j < 8; ++j) { const float sc = __shfl(s[j], bi[j]); tot[j] += sc; const bool me = (lane == k); myidx[j] = me ? bi[j] : myidx[j]; mysc[j] = me ? sc : mysc[j]; sel[j] = (lane == bi[j]) ? -1e30f : sel[j]; }
        }
#pragma unroll
        for (int j = 0; j < 8; ++j) { const int t = g * 64 + 16 * (j >> 1) + 2 * w + (j & 1); lrank[j] = 0u;
            if (lane < TOPK) { IDX[t * TOPK + lane] = myidx[j]; GATE[t * TOPK + lane] = 2.5f * mysc[j] / tot[j]; lrank[j] = atomicAdd((unsigned*)&lcnt[myidx[j]], 1u); } }
        __syncthreads();
        if (F.tid < 64) BC[g * 64 + F.tid] = lcnt[F.tid];
#pragma unroll
        for (int j = 0; j < 8; ++j) { const int t = g * 64 + 16 * (j >> 1) + 2 * w + (j & 1); if (lane < TOPK) RANK[t * TOPK + lane] = (int)lrank[j]; }
    }
}

__device__ __forceinline__ void ph_topk(const Frame& F, int layer) {
    const float* LOG = (const float*)(F.ws + WS_LOGITS); const float* rb = F.in[I_RBIAS] + layer * NE;
    int* IDX = (int*)(F.ws + WS_IDX); float* GATE = (float*)(F.ws + WS_GATE); int* RANK = (int*)(F.ws + WS_RANK);
    unsigned* BC = (unsigned*)(F.ws + WS_BC);
    unsigned* lcnt = (unsigned*)F.ldsf;
    const float bias = rb[F.lane];
    for (int base = F.bid * 64; base < T; base += F.G * 64) {
        if (F.tid < 64) lcnt[F.tid] = 0u;
        __syncthreads();
        float s[8], sel[8], tot[8], mysc[8]; int myidx[8]; unsigned lrank[8];
#pragma unroll
        for (int j = 0; j < 8; ++j) { const size_t o = (size_t)(base + F.wave * 8 + j) * NE + F.lane;
            s[j] = sigmoidf_(LOG[o] + LOG[(size_t)T * NE + o] + LOG[(size_t)2 * T * NE + o]); sel[j] = s[j] + bias; tot[j] = 0.f; mysc[j] = 0.f; myidx[j] = 0; }
#pragma unroll
        for (int k = 0; k < TOPK; ++k) {
            float bv[8]; int bi[8];
#pragma unroll
            for (int j = 0; j < 8; ++j) { bv[j] = sel[j]; bi[j] = F.lane; }
#pragma unroll
            for (int o = 32; o >= 1; o >>= 1) {
#pragma unroll
                for (int j = 0; j < 8; ++j) { const float ov = __shfl_xor(bv[j], o); const int oi = __shfl_xor(bi[j], o); const bool take = (ov > bv[j]) | ((ov == bv[j]) & (oi < bi[j]));     bv[j] = take ? ov : bv[j]; bi[j] = take ? oi : bi[j]; }
            }
#pragma unroll
            for (int j = 0; j < 8; ++j) { const float sc = __shfl(s[j], bi[j]); tot[j] += sc; const bool me = (F.lane == k); myidx[j] = me ? bi[j] : myidx[j]; mysc[j] = me ? sc : mysc[j]; sel[j] = (F.lane == bi[j]) ? -1e30f : sel[j]; }
        }
#pragma unroll
        for (int j = 0; j < 8; ++j) { const int t = base + F.wave * 8 + j; lrank[j] = 0u;
            if (F.lane < TOPK) { IDX[t * TOPK + F.lane] = myidx[j]; GATE[t * TOPK + F.lane] = 2.5f * mysc[j] / tot[j]; lrank[j] = atomicAdd(&lcnt[myidx[j]], 1u); } }
        __syncthreads();
        if (F.tid < 64) BC[(base >> 6) * 64 + F.tid] = lcnt[F.tid];
#pragma unroll
        for (int j = 0; j < 8; ++j) { const int t = base + F.wave * 8 + j; if (F.lane < TOPK) RANK[t * TOPK + F.lane] = (int)lrank[j]; }
        __syncthreads();
    }
}

__device__ __forceinline__ void ph_offsets(const Frame& F, int layer) {
    const unsigned* BC = (const unsigned*)(F.ws + WS_BC);
    const int* IDX = (const int*)(F.ws + WS_IDX); const int* RANK = (const int*)(F.ws + WS_RANK);
    int* POS = (int*)(F.ws + WS_POS); int* TOK = (int*)(F.ws + WS_TOK); int* TILEE = (int*)(F.ws + WS_TILEE); int* START = (int*)(F.ws + WS_START);
    int* sst = (int*)F.ldsf;
    constexpr int NG = T / 64;
    for (int g = F.bid; g < NG; g += F.G) {
        { const int e = F.tid & 63, part = F.tid >> 6; int tot = 0, pre = 0;
          for (int gg = part; gg < NG; gg += 8) { const int v = (int)BC[gg * 64 + e]; tot += v; if (gg < g) pre += v; }
          sst[512 + part * 64 + e] = tot; sst[1024 + part * 64 + e] = pre; }
        __syncthreads();
        if (F.tid < 64) { int tot = 0, pre = 0;
#pragma unroll
            for (int q = 0; q < 8; ++q) { tot += sst[512 + q * 64 + F.tid]; pre += sst[1024 + q * 64 + F.tid]; }
            sst[128 + F.tid] = tot; sst[256 + F.tid] = pre; }
        __syncthreads();
        if (F.tid == 0) { int acc = 0; for (int e = 0; e < NE; ++e) { const int c = sst[128 + e]; sst[e] = acc; acc += ((c + RP - 1) / RP) * RP; } sst[64] = acc; }
        __syncthreads();
        if (g == 0) {
            if (F.tid <= 64) START[F.tid] = sst[F.tid];
            if (F.tid == 65) START[65] = sst[64];
        }
        if (g == (NG > 1 ? 1 : 0)) { if (F.tid < NE) for (int i = sst[F.tid] / RP; i < sst[F.tid + 1] / RP; ++i) TILEE[i] = F.tid; }
        for (int e = (g + NG - 2) % NG; e < NE; e += NG) { const int c = sst[128 + e], lo = sst[e] + c, hi = sst[e + 1]; for (int r = lo + F.tid; r < hi; r += NTHREADS) TOK[r] = 0; }
        { const int sl = g * 64 * TOPK + F.tid;
          const int e = IDX[sl], p = sst[e] + sst[256 + e] + RANK[sl];
          POS[sl] = p; TOK[p] = sl / TOPK; }
        __syncthreads();
    }
}

__device__ __forceinline__ void ph_combine(const Frame& F, int layer, bool next) {
    const unsigned char* YB = (const unsigned char*)(F.ws + WS_YB); const int* POS = (const int*)(F.ws + WS_POS); const float* GATE = (const float*)(F.ws + WS_GATE);
    const int* START = (const int*)(F.ws + WS_START); const float* MOD = (const float*)(F.ws + WS_MOD);
    const float* gpo = F.in[I_NPOF] + layer * D;
    bf16_t* H3 = (bf16_t*)(F.ws + WS_H3); bf16_t* XR = (bf16_t*)(F.ws + WS_XR);
    const int routed = START[65], c0 = 16 * F.lane;
    f32x4 gmp[4], gfs[4], shf[4]; int bcur = -1;
    for (int t = F.bid * NWAVES + F.wave; t < T; t += F.G * NWAVES) {
        const int b = t / SEQ;
        if (b != bcur) { bcur = b; const float* m = MOD + (layer * 2 + b) * 6144;
#pragma unroll
            for (int i = 0; i < 4; ++i) { const int c = c0 + 4 * i; gmp[i] = *(const f32x4*)(m + 5120 + c) * *(const f32x4*)(gpo + c);
                if (next) { const float* m1 = MOD + ((layer + 1) * 2 + b) * 6144; const float* g1 = F.in[I_NPM] + (layer + 1) * D;
                    gfs[i] = *(const f32x4*)(g1 + c) * (*(const f32x4*)(m1 + 1024 + c) + 1.0f); shf[i] = *(const f32x4*)(m1 + c); } } }
        int pos[TOPK]; float gk[TOPK];
        { const u32x4 p0 = *(const u32x4*)(POS + t * TOPK), p1 = *(const u32x4*)(POS + t * TOPK + 4); const f32x4 g0 = *(const f32x4*)(GATE + t * TOPK), g1 = *(const f32x4*)(GATE + t * TOPK + 4);
#pragma unroll
          for (int k = 0; k < 4; ++k) { pos[k] = (int)p0[k]; pos[4 + k] = (int)p1[k]; gk[k] = g0[k]; gk[4 + k] = g1[k]; } }
        u32x4 rw[TOPK + 1];
        rw[TOPK] = *(const u32x4*)(YB + (size_t)(routed + t) * D + c0);
#pragma unroll
        for (int k = 0; k < TOPK; ++k) rw[k] = *(const u32x4*)(YB + (size_t)pos[k] * D + c0);
        float y[16];
#pragma unroll
        for (int e = 0; e < 16; ++e) y[e] = 0.f;
        acc_fp8x16(y, rw[TOPK], 1.0f / YB_SCALE);
#pragma unroll
        for (int k = 0; k < TOPK; ++k) acc_fp8x16(y, rw[k], gk[k] * (1.0f / YB_SCALE));
        float ss = 0.f;
#pragma unroll
        for (int e = 0; e < 16; ++e) ss += y[e] * y[e];
        ss = wave_sum(ss);
        const float rs = rsqrtf(ss * (1.0f / D) + 1e-6f);
        f32x4 x2[4]; float s2 = 0.f;
        const u32x4 a0 = *(const u32x4*)(XR + (size_t)t * D + c0), a1 = *(const u32x4*)(XR + (size_t)t * D + c0 + 8);
#pragma unroll
        for (int i = 0; i < 4; ++i) { const int c = c0 + 4 * i;
            const unsigned wa = (i < 2) ? a0[2 * (i & 1)] : a1[2 * (i & 1)], wb = (i < 2) ? a0[2 * (i & 1) + 1] : a1[2 * (i & 1) + 1];
            const f32x4 xv = {lo2f(wa), hi2f(wa), lo2f(wb), hi2f(wb)};
            const f32x4 yv = {y[4 * i], y[4 * i + 1], y[4 * i + 2], y[4 * i + 3]};
            x2[i] = xv + gmp[i] * (yv * rs);
            if (!next) *(f32x4*)(F.out + (size_t)t * D + c) = x2[i];
            s2 += x2[i][0] * x2[i][0] + x2[i][1] * x2[i][1] + x2[i][2] * x2[i][2] + x2[i][3] * x2[i][3]; }
        if (next) {
            { u32x4 r0, r1;
              r0[0] = pack2(x2[0][0], x2[0][1]); r0[1] = pack2(x2[0][2], x2[0][3]); r0[2] = pack2(x2[1][0], x2[1][1]); r0[3] = pack2(x2[1][2], x2[1][3]);
              r1[0] = pack2(x2[2][0], x2[2][1]); r1[1] = pack2(x2[2][2], x2[2][3]); r1[2] = pack2(x2[3][0], x2[3][1]); r1[3] = pack2(x2[3][2], x2[3][3]);
              *(u32x4*)(XR + (size_t)t * D + c0) = r0; *(u32x4*)(XR + (size_t)t * D + c0 + 8) = r1; }
            s2 = wave_sum(s2);
            const float rs2 = rsqrtf(s2 * (1.0f / D) + 1e-6f);
            u32x4 h0, h1;
#pragma unroll
            for (int i = 0; i < 4; ++i) {
                const f32x4 h = x2[i] * rs2 * gfs[i] + shf[i];
                const unsigned w0 = pack2(h[0], h[1]), w1 = pack2(h[2], h[3]);
                if (i == 0) { h0[0] = w0; h0[1] = w1; } else if (i == 1) { h0[2] = w0; h0[3] = w1; } else if (i == 2) { h1[0] = w0; h1[1] = w1; } else { h1[2] = w0; h1[3] = w1; } }
            *(u32x4*)(H3 + (size_t)t * D + c0) = h0; *(u32x4*)(H3 + (size_t)t * D + c0 + 8) = h1;
        }
    }
}

#define SB_EXIT 110.0f

namespace pgx {
__device__ __forceinline__ int perm32(int rho) { const int n = rho >> 4, i = rho & 15; return 8 * (i >> 2) + 4 * n + (i & 3); }
struct Unit { const char* A; const int* tok; const char* B; int r0, c0, aux; };
template <bool SW, bool PERM, class Sched, class Epi>
__device__ __forceinline__ void gemm_phase(LAS unsigned char* lds, const int K, const unsigned lda  , const Sched& S, const Epi& E) {
    int tid_ = threadIdx.x; asm volatile("" : "+v"(tid_));
    const int tid = tid_, wid = __builtin_amdgcn_readfirstlane(tid >> 6), lane = tid & 63, wr = wid >> 2, wc = wid & 3, fr = lane & 15, fq = lane >> 4;
    const int nt = K / 64;
    int Rr[2], Cc[2]; unsigned voffB[2];
#pragma unroll
    for (int i = 0; i < 2; ++i) { stage_rc(tid * 16 + i * 8192, Rr[i], Cc[i]); const int Rb = PERM ? ((Rr[i] & ~31) + perm32(Rr[i] & 31)) : Rr[i]; voffB[i] = (unsigned)(Rb * K + Cc[i]) * 2u; }
    const size_t kstep = 128, hstepB = (size_t)128 * K * 2;
    const unsigned ldsw = (unsigned)wid * 1024u;
    const int aoff = lds_byte(wr * 64 + fr, fq * 8), boff = lds_byte(wc * 32 + fr, fq * 8);
#define PX_SA(b, h) (((b) * 2 + (h)) * HTB)
#define PX_SB(b, h) ((4 + (b) * 2 + (h)) * HTB)
#define PX_STAGE(bufoff, gbase, voff) do { _Pragma("unroll") for (int _i = 0; _i < 2; ++_i) \
        __builtin_amdgcn_global_load_lds((const unsigned*)((const char*)(gbase) + (voff)[_i]), (LAS unsigned*)(lds + (bufoff) + ldsw + _i * 8192), 16, 0, 0); } while (0)
#define PX_LDA(dst, b, h) do { _Pragma("unroll") for (int m = 0; m < 4; ++m) _Pragma("unroll") for (int k = 0; k < 2; ++k) dst[m][k] = *(const LAS bf16x8*)(lds + PX_SA(b, h) + aoff + m * 2048 + k * 1024); } while (0)
#define PX_LDB(dst, b, h) do { _Pragma("unroll") for (int n = 0; n < 2; ++n) _Pragma("unroll") for (int k = 0; k < 2; ++k) dst[n][k] = *(const LAS bf16x8*)(lds + PX_SB(b, h) + boff + n * 2048 + k * 1024); } while (0)
#define PX_MMA(ai, bj, At, Bt) do { __builtin_amdgcn_s_setprio(1); _Pragma("unroll") for (int m = 0; m < 4; ++m) _Pragma("unroll") for (int n = 0; n < 2; ++n) _Pragma("unroll") for (int k = 0; k < 2; ++k) \
        acc[ai][bj][m][n] = SW ? __builtin_amdgcn_mfma_f32_16x16x32_bf16(Bt[n][k], At[m][k], acc[ai][bj][m][n], 0, 0, 0) : __builtin_amdgcn_mfma_f32_16x16x32_bf16(At[m][k], Bt[n][k], acc[ai][bj][m][n], 0, 0, 0); __builtin_amdgcn_s_setprio(0); } while (0)
#define PX_WAIT_L(n) asm volatile("s_waitcnt lgkmcnt(" #n ")" ::: "memory")
#define PX_BAR __builtin_amdgcn_s_barrier()
#define PX_SCHED __builtin_amdgcn_sched_barrier(0)
#define PX_OFFS(dst, un) do { _Pragma("unroll") for (int h_ = 0; h_ < 2; ++h_) _Pragma("unroll") for (int i_ = 0; i_ < 2; ++i_) { \
        const int row_ = h_ * 128 + Rr[i_]; const unsigned rid_ = (un).tok ? (unsigned)(un).tok[row_] : (unsigned)row_; dst[h_][i_] = rid_ * lda + (unsigned)Cc[i_] * 2u; } } while (0)
    Unit cur, nxt; int ui = 0;
    if (!S.next(0, cur)) return;
    f32x4 acc[2][2][4][2];
#pragma unroll
    for (int a = 0; a < 2; ++a)
#pragma unroll
        for (int b = 0; b < 2; ++b)
#pragma unroll
            for (int m = 0; m < 4; ++m)
#pragma unroll
                for (int n = 0; n < 2; ++n) acc[a][b][m][n] = (f32x4){0.f, 0.f, 0.f, 0.f};
    bf16x8 At[4][2], B0[2][2], B1[2][2];
    unsigned oc[2][2], on[2][2];
    PX_OFFS(oc, cur); asm volatile("" : "+v"(oc[0][0]), "+v"(oc[0][1]), "+v"(oc[1][0]), "+v"(oc[1][1]));
    const char* cA = cur.A; const char* cB = cur.B;
    PX_STAGE(PX_SB(0, 0), cB, voffB); PX_STAGE(PX_SA(0, 0), cA, oc[0]); PX_STAGE(PX_SB(0, 1), cB + hstepB, voffB); PX_STAGE(PX_SA(0, 1), cA, oc[1]);
    if (wr == 1) PX_BAR;
    WAIT_V(4); PX_BAR;
    PX_STAGE(PX_SB(1, 0), cB + kstep, voffB); PX_STAGE(PX_SA(1, 0), cA + kstep, oc[0]); PX_STAGE(PX_SB(1, 1), cB + hstepB + kstep, voffB);
    WAIT_V(6); PX_BAR;
    for (;;) {
        const bool has_next = S.next(ui + 1, nxt);
        const char* nA = has_next ? nxt.A : cA; const char* nB = has_next ? nxt.B : cB;
        if (has_next) { PX_OFFS(on, nxt); asm volatile("" : "+v"(on[0][0]), "+v"(on[0][1]), "+v"(on[1][0]), "+v"(on[1][1])); } else {
#pragma unroll
            for (int h_ = 0; h_ < 2; ++h_)
#pragma unroll
                for (int i_ = 0; i_ < 2; ++i_) on[h_][i_] = oc[h_][i_]; }
#pragma unroll 1
        for (int t = 0; t < nt; t += 2) {
            const bool last = (t == nt - 2);
            const char* a1 = cA + (size_t)(t + 1) * kstep;
            const char* a2 = last ? nA : cA + (size_t)(t + 2) * kstep; const char* b2 = last ? nB : cB + (size_t)(t + 2) * kstep;
            const char* a3 = a2 + kstep; const char* b3 = b2 + kstep;
            unsigned o2[2][2];
#pragma unroll
            for (int h_ = 0; h_ < 2; ++h_)
#pragma unroll
                for (int i_ = 0; i_ < 2; ++i_) o2[h_][i_] = last ? on[h_][i_] : oc[h_][i_];
            PX_LDB(B0, 0, 0); PX_SCHED; PX_LDA(At, 0, 0); PX_STAGE(PX_SA(1, 1), a1, oc[1]);
            PX_WAIT_L(8); PX_BAR; PX_WAIT_L(0); PX_MMA(0, 0, At, B0); PX_BAR; PX_SCHED;
            PX_LDB(B1, 0, 1); PX_STAGE(PX_SB(0, 0), b2, voffB);
            PX_BAR; PX_WAIT_L(0); PX_MMA(0, 1, At, B1); PX_BAR;
            PX_LDA(At, 0, 1); PX_STAGE(PX_SA(0, 0), a2, o2[0]);
            PX_BAR; PX_WAIT_L(0); PX_MMA(1, 0, At, B0); PX_BAR; PX_SCHED;
            PX_STAGE(PX_SB(0, 1), b2 + hstepB, voffB);
            WAIT_V(6); PX_BAR; PX_MMA(1, 1, At, B1); PX_BAR;
            PX_LDB(B0, 1, 0); PX_SCHED; PX_LDA(At, 1, 0); PX_STAGE(PX_SA(0, 1), a2, o2[1]);
            PX_WAIT_L(8); PX_BAR; PX_WAIT_L(0); PX_MMA(0, 0, At, B0); PX_BAR; PX_SCHED;
            PX_LDB(B1, 1, 1); PX_STAGE(PX_SB(1, 0), b3, voffB);
            PX_BAR; PX_WAIT_L(0); PX_MMA(0, 1, At, B1); PX_BAR;
            PX_LDA(At, 1, 1); PX_STAGE(PX_SA(1, 0), a3, o2[0]);
            PX_BAR; PX_WAIT_L(0); PX_MMA(1, 0, At, B0); PX_BAR; PX_SCHED;
            PX_STAGE(PX_SB(1, 1), b3 + hstepB, voffB);
            WAIT_V(6); PX_BAR; PX_MMA(1, 1, At, B1); PX_BAR;
        }
        E(acc, cur, wr, wc, fr, fq);
        if (!has_next) break;
#pragma unroll
        for (int a = 0; a < 2; ++a)
#pragma unroll
            for (int b = 0; b < 2; ++b)
#pragma unroll
                for (int m = 0; m < 4; ++m)
#pragma unroll
                    for (int n = 0; n < 2; ++n) acc[a][b][m][n] = (f32x4){0.f, 0.f, 0.f, 0.f};
        cur = nxt; cA = nA; cB = nB; ++ui;
#pragma unroll
        for (int h_ = 0; h_ < 2; ++h_)
#pragma unroll
            for (int i_ = 0; i_ < 2; ++i_) oc[h_][i_] = on[h_][i_];
    }
    WAIT_V(0);
    if (wr == 0) PX_BAR;
    PX_BAR;
#undef PX_SA
#undef PX_SB
#undef PX_STAGE
#undef PX_LDA
#undef PX_LDB
#undef PX_MMA
#undef PX_WAIT_L
#undef PX_BAR
#undef PX_SCHED
#undef PX_OFFS
}
__device__ __forceinline__ unsigned cvt_pk_bf16(float lo, float hi) { return pack2(lo, hi); }
}

__device__ __forceinline__ size_t hm_off(int t, int c) { return ((size_t)((t / SEQ) * NH + (c >> 6)) * SEQ + (t % SEQ)) * 64 + (c & 63); }
#define EPI_MT(acc) (int)(sizeof(acc) / sizeof(acc[0]))
__device__ __forceinline__ void st_bf4(bf16_t* p, const f32x4& v) { u32x2 w; w.x = pack2(v[0], v[1]); w.y = pack2(v[2], v[3]); *(u32x2*)p = w; }

__device__ __forceinline__ void ph_lora_up_sg(const Frame& F) {
    const bf16_t* LORA = (const bf16_t*)(F.ws + WS_LORA); const bf16_t* WLUP = (const bf16_t*)(F.ws + WS_WLUP);
    bf16_t* LD = (bf16_t*)(F.ws + WS_LD); bf16_t* AA = (bf16_t*)(F.ws + WS_AA); bf16_t* GG = (bf16_t*)(F.ws + WS_GG);
    f32x4 w0v[4], a0v[4]; int pcol = -1;
    SgChain ch; ch.ph = 0; ch.pre = false;
    for (int u = F.bid; u < 3 * 64 * 8; u += F.G) {
        const int which = u / 512, v = u % 512, mt = v / 8, col0 = (v % 8) * 128;
        if (col0 != pcol) { pcol = col0;
#pragma unroll
            for (int q = 0; q < 4; ++q) { const int c = (F.wave & 1) * 64 + 16 * q + 4 * (F.lane >> 4); w0v[q] = *(const f32x4*)(F.in[I_W0] + col0 + c); a0v[q] = *(const f32x4*)(F.in[I_A0] + col0 + c); } }
        const int K = which == 2 ? 128 : 64, koff = which * 64;
        ASeg A; A.p[0] = LORA + (size_t)mt * 256 * 256 + koff; A.p[1] = A.p[0]; A.p[2] = A.p[0]; A.segTiles = 4;
        const bf16_t* Bt = WLUP + (which == 0 ? 0 : (which == 1 ? 1024 * 64 : 2 * 1024 * 64)) + (size_t)col0 * K;
        bf16_t* const outp = which == 0 ? LD : (which == 1 ? AA : GG);
        { const int un = u + F.G; ch.nvalid = un < 3 * 64 * 8;
          const int wn_ = un / 512, vn = un % 512, mn = vn / 8, cn = (vn % 8) * 128, Kn = wn_ == 2 ? 128 : 64;
          ch.nA.p[0] = LORA + (size_t)mn * 256 * 256 + wn_ * 64; ch.nA.p[1] = ch.nA.p[0]; ch.nA.p[2] = ch.nA.p[0]; ch.nA.segTiles = 4;
          ch.nBt = WLUP + (wn_ == 0 ? 0 : (wn_ == 1 ? 1024 * 64 : 2 * 1024 * 64)) + (size_t)cn * Kn; ch.nldb = Kn; }
        sg_tile<128>(F.lds, A, [](int R) { return (unsigned)R * 512u; }, Bt, K, K / 64,
            [&](auto& acc, int r0, int c0, int fr, int fq) {
                bf16_t* const ob = outp + hm_off(mt * 256 + r0 + fr, col0 + c0 + 4 * fq);
                if (which == 0) {
#pragma unroll
                    for (int m = 0; m < EPI_MT(acc); ++m)
#pragma unroll
                        for (int q = 0; q < 4; ++q) { f32x4 r;
#pragma unroll
                            for (int e = 0; e < 4; ++e) r[e] = -0.6065306597126334f * sigmoidf_(w0v[q][e] + acc[m][q][e]);
                            st_bf4(ob + m * 1024 + q * 16, r); }
                } else if (which == 1) {
#pragma unroll
                    for (int m = 0; m < EPI_MT(acc); ++m)
#pragma unroll
                        for (int q = 0; q < 4; ++q) { f32x4 r;
#pragma unroll
                            for (int e = 0; e < 4; ++e) r[e] = sigmoidf_(a0v[q][e] + acc[m][q][e]);
                            st_bf4(ob + m * 1024 + q * 16, r); }
                } else {
#pragma unroll
                    for (int m = 0; m < EPI_MT(acc); ++m)
#pragma unroll
                        for (int q = 0; q < 4; ++q) st_bf4(ob + m * 1024 + q * 16, acc[m][q]);
                }
            }, BRowId(), &ch);
    }
}
__device__ __forceinline__ void ph_router_sg(const Frame& F, int layer) {
    const bf16_t* H2 = (const bf16_t*)(F.ws + WS_H2); const bf16_t* H2LO = (const bf16_t*)(F.ws + WS_H2LO);
    const bf16_t* WRT = (const bf16_t*)(F.ws + WS_WRT) + (size_t)layer * 64 * 3072; float* LOG = (float*)(F.ws + WS_LOGITS);
    for (int u = F.bid; u < 64 * 3; u += F.G) {
        const int mt = u / 3, sgi = u % 3;
        ASeg A; A.p[0] = (sgi == 2 ? H2LO : H2) + (size_t)mt * 256 * D; A.p[1] = A.p[0]; A.p[2] = A.p[0]; A.segTiles = 16;
        float* out = LOG + (size_t)sgi * T * NE;
        sg_tile<64>(F.lds, A, [](int R) { return (unsigned)R * (D * 2); }, WRT + sgi * 1024, 3072, 16,
            [&](auto& acc, int r0, int c0, int fr, int fq) {
#pragma unroll
                for (int m = 0; m < EPI_MT(acc); ++m)
#pragma unroll
                    for (int q = 0; q < 4; ++q) *(f32x4*)(out + (size_t)(mt * 256 + r0 + 16 * m + fr) * NE + c0 + 16 * q + 4 * fq) = acc[m][q];
            });
    }
}

constexpr int MS = 72;
constexpr int SLOT = 64 * MS * 2;
__device__ __forceinline__ int ms_off(int row, int col) { return row * MS + col; }
constexpr size_t WS_BONUS = 3 * MiB;
constexpr size_t WS_RP = WS_BIG + 128 * MiB;
constexpr size_t WS_OL = WS_BIG + 160 * MiB;
constexpr size_t WS_G2 = WS_BIG + 296 * MiB;
constexpr size_t WS_DM = WS_BIG + 328 * MiB;
constexpr size_t WS_ST = WS_BIG + 360 * MiB;

__device__ __forceinline__ void st4_lds(LAS bf16_t* p, const f32x4& v) { u32x2 w; w.x = pack2(v[0], v[1]); w.y = pack2(v[2], v[3]); *(LAS u32x2*)p = w; }
__device__ __forceinline__ f32x4 ld4_lds(const LAS bf16_t* p) { const u32x2 w = *(const LAS u32x2*)p; return (f32x4){lo2f(w.x), hi2f(w.x), lo2f(w.y), hi2f(w.y)}; }

__device__ __forceinline__ void ph_wkv_chunk(const Frame& F) {
    const bf16_t* RKV = (const bf16_t*)(F.ws + WS_RKV); const bf16_t* LD = (const bf16_t*)(F.ws + WS_LD); const bf16_t* AA = (const bf16_t*)(F.ws + WS_AA);
    const bf16_t* Rb = RKV; const bf16_t* Kb = RKV + (size_t)T * D; const bf16_t* Vb = RKV + (size_t)2 * T * D;
    bf16_t* RP = (bf16_t*)(F.ws + WS_RP); bf16_t* OL = (bf16_t*)(F.ws + WS_OL); bf16_t* G2 = (bf16_t*)(F.ws + WS_G2); bf16_t* DM = (bf16_t*)(F.ws + WS_DM);
    float* BONUS = (float*)(F.ws + WS_BONUS);
#define SL(k) ((LAS bf16_t*)(F.lds + (k) * SLOT))
#define AT(k, r, c) (SL(k) + ms_off((r), (c)))
    LAS float* segtot = (LAS float*)(F.lds + 15 * SLOT);
    LAS float* WCs = segtot + 512;
    const int w = F.wave, lane = F.lane, fr = lane & 15, fq = lane >> 4, mt = w >> 1, ntb = 2 * (w & 1);
#define W1_ISSUE(cn_) do { const size_t on_ = (size_t)(cn_) * 4096 + (size_t)F.tid * 8; const unsigned lw_ = (unsigned)w * 1024u; \
        __builtin_amdgcn_global_load_lds((const unsigned*)(Rb + on_), (LAS unsigned*)(F.lds + 1 * SLOT + lw_), 16, 0, 0); \
        __builtin_amdgcn_global_load_lds((const unsigned*)(Kb + on_), (LAS unsigned*)(F.lds + 4 * SLOT + lw_), 16, 0, 0); \
        __builtin_amdgcn_global_load_lds((const unsigned*)(Vb + on_), (LAS unsigned*)(F.lds + 6 * SLOT + lw_), 16, 0, 0); \
        __builtin_amdgcn_global_load_lds((const unsigned*)(AA + on_), (LAS unsigned*)(F.lds + 10 * SLOT + lw_), 16, 0, 0); \
        __builtin_amdgcn_global_load_lds((const unsigned*)(LD + on_), (LAS unsigned*)(F.lds + 13 * SLOT + lw_), 16, 0, 0); } while (0)
#define SBARL() do { asm volatile("s_waitcnt lgkmcnt(0)" ::: "memory"); __builtin_amdgcn_s_barrier(); asm volatile("" ::: "memory"); } while (0)
    if (F.bid < NB * NH * (SEQ / 64)) W1_ISSUE(F.bid);
    for (int cid = F.bid; cid < NB * NH * (SEQ / 64); cid += F.G) {
        const int bh = cid / (SEQ / 64), c = cid % (SEQ / 64), b = bh / NH, h = bh % NH;
        const size_t tok0 = (size_t)b * SEQ + (size_t)c * 64;
        {
            const int t = F.tid >> 3, jg = lane & 7, tl = lane >> 3, ch0 = h * 64 + 8 * jg;
            WAIT_V(0);
            const unsigned ro = (unsigned)F.tid * 16u;
            const u32x4 rr = *(const LAS u32x4*)(F.lds + 1 * SLOT + ro), kr = *(const LAS u32x4*)(F.lds + 4 * SLOT + ro), vr = *(const LAS u32x4*)(F.lds + 6 * SLOT + ro), ar = *(const LAS u32x4*)(F.lds + 10 * SLOT + ro);
            const u32x4 lr = *(const LAS u32x4*)(F.lds + 13 * SLOT + ro);
            float r[8], k[8], a[8], ld[8], cum[8];
#pragma unroll
            for (int q = 0; q < 4; ++q) { r[2 * q] = lo2f(rr[q]); r[2 * q + 1] = hi2f(rr[q]); k[2 * q] = lo2f(kr[q]); k[2 * q + 1] = hi2f(kr[q]); a[2 * q] = lo2f(ar[q]); a[2 * q + 1] = hi2f(ar[q]); ld[2 * q] = lo2f(lr[q]); ld[2 * q + 1] = hi2f(lr[q]); }
#pragma unroll
            for (int e = 0; e < 8; ++e) { float v = ld[e];
                float u1 = __shfl_up(v, 8);  if (tl >= 1) v += u1;
                float u2 = __shfl_up(v, 16); if (tl >= 2) v += u2;
                float u4 = __shfl_up(v, 32); if (tl >= 4) v += u4;
                cum[e] = v; }
            if (tl == 7) {
#pragma unroll
                for (int e = 0; e < 8; ++e) segtot[w * 64 + 8 * jg + e] = cum[e]; }
            __syncthreads();
            float tot[8];
#pragma unroll
            for (int e = 0; e < 8; ++e) tot[e] = 0.f;
#pragma unroll
            for (int ww = 0; ww < 8; ++ww) {
                const f32x4 s0 = *(const LAS f32x4*)(segtot + ww * 64 + 8 * jg), s1 = *(const LAS f32x4*)(segtot + ww * 64 + 8 * jg + 4);
#pragma unroll
                for (int q = 0; q < 4; ++q) { tot[q] += s0[q]; tot[4 + q] += s1[q]; if (ww < w) { cum[q] += s0[q]; cum[4 + q] += s1[q]; } }
            }
            if (t == 0) {
#pragma unroll
                for (int e = 0; e < 8; ++e) WCs[8 * jg + e] = fexp_(tot[e]); }
            float kkr[8], kf[8], ss = 0.f, bon = 0.f;
#pragma unroll
            for (int e = 0; e < 8; ++e) { kkr[e] = k[e] * F.in[I_KK][ch0 + e]; ss += kkr[e] * kkr[e]; kf[e] = k[e] * (1.0f + (a[e] - 1.0f) * F.in[I_KA][ch0 + e]); bon += r[e] * kf[e] * F.in[I_RK][ch0 + e]; }
            ss += __shfl_xor(ss, 1); ss += __shfl_xor(ss, 2); ss += __shfl_xor(ss, 4);
            bon += __shfl_xor(bon, 1); bon += __shfl_xor(bon, 2); bon += __shfl_xor(bon, 4);
            if (jg == 0) BONUS[(tok0 + t) * NH + h] = bon;
            const float inv = 1.0f / fmaxf(sqrtf(ss), 1e-12f);
            float av[8], bv[8], kv[8], rv[8];
#pragma unroll
            for (int e = 0; e < 8; ++e) { const float kk = kkr[e] * inv, en = fexp_(-cum[e]);
                av[e] = -kk * fexp_(cum[e] - ld[e]); bv[e] = kk * a[e] * en; kv[e] = kf[e] * en; rv[e] = r[e] * fexp_(cum[e]); }
            u32x4 pa, pr, pb, pk;
#pragma unroll
            for (int q = 0; q < 4; ++q) { pa[q] = pack2(av[2 * q], av[2 * q + 1]); pr[q] = pack2(rv[2 * q], rv[2 * q + 1]); pb[q] = pack2(bv[2 * q], bv[2 * q + 1]); pk[q] = pack2(kv[2 * q], kv[2 * q + 1]); }
            *(LAS u32x4*)AT(0, t, 8 * jg) = pa; *(LAS u32x4*)AT(2, t, 8 * jg) = pr; *(LAS u32x4*)AT(3, t, 8 * jg) = pb; *(LAS u32x4*)AT(5, t, 8 * jg) = pk; *(LAS u32x4*)AT(7, t, 8 * jg) = vr;
        }
        __syncthreads();
#define LF2(dst, k, r0) do { dst[0] = *(const LAS bf16x8*)AT(k, (r0) + fr, fq * 8); dst[1] = *(const LAS bf16x8*)AT(k, (r0) + fr, 32 + fq * 8); } while (0)
#define TR2(dst, k, c0) do { const LAS bf16_t* b_ = AT(k, 8 * fq + (fr >> 2), (c0) + 4 * (fr & 3)); \
            const s16x4 t0_ = __builtin_amdgcn_ds_read_tr16_b64_v4i16((LAS s16x4*)(b_)), t1_ = __builtin_amdgcn_ds_read_tr16_b64_v4i16((LAS s16x4*)(b_ + 4 * MS)); \
            const s16x4 t2_ = __builtin_amdgcn_ds_read_tr16_b64_v4i16((LAS s16x4*)(b_ + 32 * MS)), t3_ = __builtin_amdgcn_ds_read_tr16_b64_v4i16((LAS s16x4*)(b_ + 36 * MS)); \
            dst[0] = __builtin_bit_cast(bf16x8, __builtin_shufflevector(t0_, t1_, 0, 1, 2, 3, 4, 5, 6, 7)); dst[1] = __builtin_bit_cast(bf16x8, __builtin_shufflevector(t2_, t3_, 0, 1, 2, 3, 4, 5, 6, 7)); } while (0)
#define MMA2(acc, xf, yf) do { acc = __builtin_amdgcn_mfma_f32_16x16x32_bf16(xf[0], yf[0], acc, 0, 0, 0); acc = __builtin_amdgcn_mfma_f32_16x16x32_bf16(xf[1], yf[1], acc, 0, 0, 0); } while (0)
        {
            bf16x8 xa[2], xr[2]; LF2(xa, 0, 16 * mt); LF2(xr, 2, 16 * mt);
#pragma unroll
            for (int q2 = 0; q2 < 2; ++q2) {
                const int nt = ntb + q2;
                bf16x8 yb[2], yk[2]; LF2(yb, 3, 16 * nt); LF2(yk, 5, 16 * nt);
                const int tt = 16 * mt + fr, s0 = 16 * nt + 4 * fq;
                { f32x4 acc = {0.f, 0.f, 0.f, 0.f}; MMA2(acc, yb, xa);
#pragma unroll
                  for (int e = 0; e < 4; ++e) if (!(s0 + e < tt)) acc[e] = 0.f;
                  st4_lds(AT(8, tt, s0), acc); }
                { f32x4 acc = {0.f, 0.f, 0.f, 0.f}; MMA2(acc, yk, xa);
#pragma unroll
                  for (int e = 0; e < 4; ++e) if (!(s0 + e < tt)) acc[e] = 0.f;
                  st4_lds(AT(10, tt, s0), acc); }
                { f32x4 acc = {0.f, 0.f, 0.f, 0.f}; MMA2(acc, yb, xr);
#pragma unroll
                  for (int e = 0; e < 4; ++e) if (!(s0 + e <= tt)) acc[e] = 0.f;
                  st4_lds(AT(11, tt, s0), acc); }
                { f32x4 acc = {0.f, 0.f, 0.f, 0.f}; MMA2(acc, yk, xr);
#pragma unroll
                  for (int e = 0; e < 4; ++e) if (!(s0 + e <= tt)) acc[e] = 0.f;
                  st4_lds(AT(12, tt, s0), acc); }
            }
        }
        __syncthreads();
#define WKV_SQ(xi, xo) do { bf16x8 xl[2]; LF2(xl, xi, 16 * mt); _Pragma("unroll") for (int q2 = 0; q2 < 2; ++q2) { const int nt = ntb + q2; bf16x8 yl[2]; TR2(yl, xi, 16 * nt); \
            f32x4 acc = {0.f, 0.f, 0.f, 0.f}; MMA2(acc, yl, xl); st4_lds(AT(xo, 16 * mt + fr, 16 * nt + 4 * fq), acc); } } while (0)
#define WKV_PM(pi, xi, po) do { bf16x8 xp[2]; LF2(xp, pi, 16 * mt); _Pragma("unroll") for (int q2 = 0; q2 < 2; ++q2) { const int nt = ntb + q2; bf16x8 yl[2]; TR2(yl, xi, 16 * nt); \
            const int m_ = 16 * mt + fr, n0_ = 16 * nt + 4 * fq; f32x4 acc = ld4_lds(AT(pi, m_, n0_)); MMA2(acc, yl, xp); st4_lds(AT(po, m_, n0_), acc); } } while (0)
#define WKV_PMSQ(pi, xi, po, xo) do { bf16x8 xp[2], xl[2]; LF2(xp, pi, 16 * mt); LF2(xl, xi, 16 * mt); _Pragma("unroll") for (int q2 = 0; q2 < 2; ++q2) { const int nt = ntb + q2; bf16x8 yl[2]; TR2(yl, xi, 16 * nt); \
            const int m_ = 16 * mt + fr, n0_ = 16 * nt + 4 * fq; \
            { f32x4 acc = ld4_lds(AT(pi, m_, n0_)); MMA2(acc, yl, xp); st4_lds(AT(po, m_, n0_), acc); } \
            { f32x4 acc = {0.f, 0.f, 0.f, 0.f}; MMA2(acc, yl, xl); st4_lds(AT(xo, m_, n0_), acc); } } } while (0)
        WKV_SQ(8, 1);
        for (int idx = F.tid; idx < 64 * 16; idx += NTHREADS) { const int t = idx >> 4, s4 = (idx & 15) * 4; u32x2 v = *(const LAS u32x2*)AT(8, t, s4);
            if ((t >> 2) == (s4 >> 2)) { const unsigned one = 0x3F80u; const int e = t & 3; if (e == 0) v.x = (v.x & 0xffff0000u) | one; else if (e == 1) v.x = (v.x & 0xffffu) | (one << 16); else if (e == 2) v.y = (v.y & 0xffff0000u) | one; else v.y = (v.y & 0xffffu) | (one << 16); }
            *(LAS u32x2*)AT(13, t, s4) = v; }
        { bf16x8 xm[2]; LF2(xm, 10, 16 * mt);
#pragma unroll
          for (int q2 = 0; q2 < 2; ++q2) { const int nt = ntb + q2, n_ = 16 * nt + fr, m0_ = 16 * mt + 4 * fq; bf16x8 yv[2]; TR2(yv, 7, 16 * nt);
              f32x4 acc = {0.f, 0.f, 0.f, 0.f}; MMA2(acc, xm, yv); st4_lds(AT(6, n_, m0_), acc); } }
        __syncthreads();
        WKV_PMSQ(13, 1, 14, 8); __syncthreads();
        WKV_PMSQ(14, 8, 13, 1); __syncthreads();
        WKV_PMSQ(13, 1, 14, 8); __syncthreads();
        WKV_PMSQ(14, 8, 13, 1); __syncthreads();
        WKV_PM(13, 1, 14); __syncthreads();
        {
            bf16x8 xt[2]; LF2(xt, 14, 16 * mt);
#pragma unroll
            for (int q2 = 0; q2 < 2; ++q2) {
                const int nt = ntb + q2, n_ = 16 * nt + fr, m0_ = 16 * mt + 4 * fq;
                bf16x8 ya[2], yz[2]; TR2(ya, 0, 16 * nt); LF2(yz, 6, 16 * nt);
                { f32x4 acc = {0.f, 0.f, 0.f, 0.f}; MMA2(acc, xt, ya); st4_lds(AT(9, n_, m0_), acc); }
                { f32x4 acc = {0.f, 0.f, 0.f, 0.f}; MMA2(acc, xt, yz); st4_lds(AT(8, n_, m0_), acc); }
            }
        }
        __syncthreads();
        if (cid + F.G < NB * NH * (SEQ / 64)) W1_ISSUE(cid + F.G);
        {
            bf16x8 xb[2]; LF2(xb, 11, 16 * mt);
#pragma unroll
            for (int q2 = 0; q2 < 2; ++q2) {
                const int nt = ntb + q2;
                bf16x8 yp[2]; LF2(yp, 9, 16 * nt);
                { const int m_ = 16 * mt + fr, n0_ = 16 * nt + 4 * fq; f32x4 acc = ld4_lds(AT(2, m_, n0_)); MMA2(acc, yp, xb);
                  st_bf4(RP + (size_t)cid * 4096 + (unsigned)((mt * 2 + (nt >> 1)) * 512 + (fr * 4 + 2 * (nt & 1) + (fq >> 1)) * 8 + 4 * (fq & 1)), acc); }
            }
        }
        {
            bf16x8 xb[2], xk[2], xp[2], xu[2], xv[2]; LF2(xb, 11, 16 * mt); LF2(xk, 12, 16 * mt); LF2(xp, 9, 16 * mt); LF2(xu, 8, 16 * mt); TR2(xv, 7, 16 * mt);
#pragma unroll
            for (int q2 = 0; q2 < 2; ++q2) {
                const int nt = ntb + q2;
                bf16x8 yu[2], yv[2], yb[2], yk[2]; LF2(yu, 8, 16 * nt); TR2(yv, 7, 16 * nt); TR2(yb, 3, 16 * nt); TR2(yk, 5, 16 * nt);
                { f32x4 acc = {0.f, 0.f, 0.f, 0.f}; MMA2(acc, yu, xb); MMA2(acc, yv, xk);
                  st_bf4(OL + (size_t)cid * 4096 + (unsigned)((16 * mt + fr) * 64 + 16 * nt + 4 * fq), acc); }
                { const int jp = 16 * nt + fr, j0 = 16 * mt + 4 * fq; f32x4 acc = {0.f, 0.f, 0.f, 0.f}; MMA2(acc, xp, yb);
                  const float wc = WCs[jp];
#pragma unroll
                  for (int e = 0; e < 4; ++e) acc[e] = (acc[e] + ((j0 + e == jp) ? 1.0f : 0.0f)) * wc;
                  st_bf4(G2 + (size_t)cid * 4096 + (unsigned)((nt * 2 + (mt >> 1)) * 512 + lane * 8 + (mt & 1) * 4), acc); }
                { const int i_ = 16 * mt + fr, jp0 = 16 * nt + 4 * fq; f32x4 acc = {0.f, 0.f, 0.f, 0.f}; MMA2(acc, yb, xu); MMA2(acc, yk, xv);
#pragma unroll
                  for (int e = 0; e < 4; ++e) acc[e] *= WCs[jp0 + e];
                  st_bf4(DM + (size_t)cid * 4096 + (unsigned)(i_ * 64 + jp0), acc); }
            }
        }
        SBARL();
    }
#undef W1_ISSUE
#undef LF2
#undef TR2
#undef MMA2
#undef WKV_PMSQ
#undef WKV_SQ
#undef WKV_PM
#undef AT
#undef SL
}

__device__ __forceinline__ void ph_wkv_carry(const Frame& F) {
    const bf16_t* G2 = (const bf16_t*)(F.ws + WS_G2); const bf16_t* DM = (const bf16_t*)(F.ws + WS_DM); bf16_t* ST = (bf16_t*)(F.ws + WS_ST);
    const int lane = F.lane, fr = lane & 15, fq = lane >> 4;
    const bool loader = F.wave >= 4; const int lw = F.wave - 4, i = 16 * (F.wave & 3) + fr;
    constexpr int NC = SEQ / 64;
    for (int ch = F.bid; ch < NB * NH; ch += F.G) {
        const size_t cbase = (size_t)ch * NC;
#define CARRY_ISSUE(c_) do { const int cc_ = (c_) < NC ? (c_) : NC - 1; const size_t cid_ = cbase + cc_; \
        _Pragma("unroll") for (int q_ = 0; q_ < 4; ++q_) { const int j_ = lw * 4 + q_; \
            const bf16_t* src_ = (j_ < 8 ? G2 + cid_ * 4096 + j_ * 512 : DM + cid_ * 4096 + (j_ - 8) * 512) + lane * 8; \
            __builtin_amdgcn_global_load_lds((const unsigned*)src_, (LAS unsigned*)(F.lds + ((c_) & 7) * 16384 + j_ * 1024), 16, 0, 0); } } while (0)
        f32x4 st[4];
#pragma unroll
        for (int r = 0; r < 4; ++r) st[r] = (f32x4){0.f, 0.f, 0.f, 0.f};
        bf16x8 gc[8]; u32x2 dc[4];
#define CARRY_RING_READ(c_) do { const LAS unsigned char* slot_ = F.lds + ((c_) & 7) * 16384; \
        _Pragma("unroll") for (int f = 0; f < 8; ++f) gc[f] = *(const LAS bf16x8*)(slot_ + f * 1024 + lane * 16); \
        _Pragma("unroll") for (int r = 0; r < 4; ++r) dc[r] = *(const LAS u32x2*)(slot_ + 8192 + (i * 64 + 16 * r + 4 * fq) * 2); } while (0)
        if (loader) {
#pragma unroll
            for (int c = 0; c < 7; ++c) CARRY_ISSUE(c);
            WAIT_V(20);
        }
        SBAR();
        if (!loader) CARRY_RING_READ(0);
#pragma unroll 1
        for (int c = 0; c < NC; ++c) {
            if (loader) {
                CARRY_ISSUE(c + 7);
                WAIT_V(20);
            } else {
                const size_t cid = cbase + c;
                union { bf16x8 v; unsigned u[4]; } b0, b1;
                b0.u[0] = pack2(st[0][0], st[0][1]); b0.u[1] = pack2(st[0][2], st[0][3]); b0.u[2] = pack2(st[1][0], st[1][1]); b0.u[3] = pack2(st[1][2], st[1][3]);
                b1.u[0] = pack2(st[2][0], st[2][1]); b1.u[1] = pack2(st[2][2], st[2][3]); b1.u[2] = pack2(st[3][0], st[3][1]); b1.u[3] = pack2(st[3][2], st[3][3]);
                f32x4 acc[4];
#pragma unroll
                for (int r = 0; r < 4; ++r) { acc[r] = (f32x4){lo2f(dc[r].x), hi2f(dc[r].x), lo2f(dc[r].y), hi2f(dc[r].y)};
                    acc[r] = __builtin_amdgcn_mfma_f32_16x16x32_bf16(gc[r * 2 + 0], b0.v, acc[r], 0, 0, 0); }
#pragma unroll
                for (int r = 0; r < 4; ++r) acc[r] = __builtin_amdgcn_mfma_f32_16x16x32_bf16(gc[r * 2 + 1], b1.v, acc[r], 0, 0, 0);
                { const unsigned wsl = (unsigned)(F.wave & 3);
                  bf16_t* stp = ST + cid * 4096;
                  const unsigned ob = (unsigned)(((fr >> 2) * 2) * 512 + ((4 * wsl + (fr & 3)) * 4 + (fq >> 1)) * 8 + 4 * (fq & 1));
                  u32x2 w0; w0.x = b0.u[0]; w0.y = b0.u[1]; *(u32x2*)(stp + ob) = w0;
                  u32x2 w1; w1.x = b0.u[2]; w1.y = b0.u[3]; *(u32x2*)(stp + ob + 16) = w1;
                  u32x2 w2; w2.x = b1.u[0]; w2.y = b1.u[1]; *(u32x2*)(stp + ob + 512) = w2;
                  u32x2 w3; w3.x = b1.u[2]; w3.y = b1.u[3]; *(u32x2*)(stp + ob + 512 + 16) = w3; }
                if (c + 1 < NC) CARRY_RING_READ(c + 1);
#pragma unroll
                for (int r = 0; r < 4; ++r) st[r] = acc[r];
            }
            SBAR();
        }
        if (loader) WAIT_V(0);
        SBAR();
#undef CARRY_RING_READ
#undef CARRY_ISSUE
    }
}

__device__ __forceinline__ void ph_wkv_out(const Frame& F) {
    const bf16_t* RP = (const bf16_t*)(F.ws + WS_RP); const bf16_t* OL = (const bf16_t*)(F.ws + WS_OL); const bf16_t* ST = (const bf16_t*)(F.ws + WS_ST);
    const bf16_t* Vb = (const bf16_t*)(F.ws + WS_RKV) + (size_t)2 * T * D; const bf16_t* GG = (const bf16_t*)(F.ws + WS_GG); const float* BONUS = (const float*)(F.ws + WS_BONUS);
    bf16_t* OG = (bf16_t*)(F.ws + WS_OG);
    const int lane = F.lane, fr = lane & 15, fq = lane >> 4;
    const int nunits = NB * NH * (SEQ / 64) * 4;
    for (int u0 = F.bid * NWAVES + F.wave; u0 < nunits; u0 += 2 * F.G * NWAVES) {
        bf16x8 rf[2][2], sf[2][4][2]; u32x4 ol0[2], ol1[2], v0[2], v1[2], g0[2], g1[2]; float bon[2]; f32x4 lg[2][4], lb[2][4];
        size_t tokv[2]; int chnv[2]; bool live[2];
#pragma unroll
        for (int j = 0; j < 2; ++j) {
            const int uj = u0 + j * F.G * NWAVES; live[j] = uj < nunits; const int u = live[j] ? uj : u0;
            const int cid = u >> 2, tt = u & 3, bh = cid / (SEQ / 64), c = cid % (SEQ / 64), b = bh / NH, h = bh % NH;
            const int t = 16 * tt + fr; const size_t tok = (size_t)b * SEQ + (size_t)c * 64 + t;
            const size_t oh = ((size_t)bh * SEQ + (size_t)c * 64 + t) * 64 + 16 * fq;
#pragma unroll
            for (int ks = 0; ks < 2; ++ks) rf[j][ks] = *(const bf16x8*)(RP + (size_t)cid * 4096 + (tt * 2 + ks) * 512 + (fr * 4 + fq) * 8);
#pragma unroll
            for (int n = 0; n < 4; ++n)
#pragma unroll
                for (int ks = 0; ks < 2; ++ks) sf[j][n][ks] = *(const bf16x8*)(ST + (size_t)cid * 4096 + (n * 2 + ks) * 512 + (fr * 4 + fq) * 8);
            ol0[j] = *(const u32x4*)(OL + (size_t)cid * 4096 + t * 64 + 16 * fq); ol1[j] = *(const u32x4*)(OL + (size_t)cid * 4096 + t * 64 + 16 * fq + 8);
            v0[j] = *(const u32x4*)(Vb + oh); v1[j] = *(const u32x4*)(Vb + oh + 8); g0[j] = *(const u32x4*)(GG + oh); g1[j] = *(const u32x4*)(GG + oh + 8);
            bon[j] = BONUS[tok * NH + h];
            tokv[j] = tok; chnv[j] = h * 64 + 16 * fq;
#pragma unroll
            for (int n = 0; n < 4; ++n) { lg[j][n] = *(const f32x4*)(F.in[I_LNG] + chnv[j] + 4 * n); lb[j][n] = *(const f32x4*)(F.in[I_LNB] + chnv[j] + 4 * n); }
        }
#pragma unroll
        for (int j = 0; j < 2; ++j) {
            f32x4 acc[4];
            acc[0] = (f32x4){lo2f(ol0[j][0]), hi2f(ol0[j][0]), lo2f(ol0[j][1]), hi2f(ol0[j][1])}; acc[1] = (f32x4){lo2f(ol0[j][2]), hi2f(ol0[j][2]), lo2f(ol0[j][3]), hi2f(ol0[j][3])};
            acc[2] = (f32x4){lo2f(ol1[j][0]), hi2f(ol1[j][0]), lo2f(ol1[j][1]), hi2f(ol1[j][1])}; acc[3] = (f32x4){lo2f(ol1[j][2]), hi2f(ol1[j][2]), lo2f(ol1[j][3]), hi2f(ol1[j][3])};
#pragma unroll
            for (int n = 0; n < 4; ++n)
#pragma unroll
                for (int ks = 0; ks < 2; ++ks) acc[n] = __builtin_amdgcn_mfma_f32_16x16x32_bf16(sf[j][n][ks], rf[j][ks], acc[n], 0, 0, 0);
            float s = 0.f;
#pragma unroll
            for (int n = 0; n < 4; ++n) s += (acc[n][0] + acc[n][1]) + (acc[n][2] + acc[n][3]);
            s += __shfl_xor(s, 16); s += __shfl_xor(s, 32);
            const float mean = s * (1.0f / 64.0f);
            float q = 0.f;
#pragma unroll
            for (int n = 0; n < 4; ++n)
#pragma unroll
                for (int e = 0; e < 4; ++e) { const float d = acc[n][e] - mean; q += d * d; }
            q += __shfl_xor(q, 16); q += __shfl_xor(q, 32);
            const float rstd = rsqrtf(q * (1.0f / 64.0f) + 64e-5f);
            u32x4 o0, o1;
#pragma unroll
            for (int n = 0; n < 4; ++n) {
                const unsigned vw0 = n < 2 ? v0[j][2 * n] : v1[j][2 * n - 4], vw1 = n < 2 ? v0[j][2 * n + 1] : v1[j][2 * n - 3], gw0 = n < 2 ? g0[j][2 * n] : g1[j][2 * n - 4], gw1 = n < 2 ? g0[j][2 * n + 1] : g1[j][2 * n - 3];
                const f32x4 vv = {lo2f(vw0), hi2f(vw0), lo2f(vw1), hi2f(vw1)}, gg = {lo2f(gw0), hi2f(gw0), lo2f(gw1), hi2f(gw1)};
                const f32x4 res = (((acc[n] - mean) * rstd) * lg[j][n] + lb[j][n] + vv * bon[j]) * gg;
                const unsigned w0 = pack2(res[0], res[1]), w1 = pack2(res[2], res[3]);
                if (n == 0) { o0[0] = w0; o0[1] = w1; } else if (n == 1) { o0[2] = w0; o0[3] = w1; } else if (n == 2) { o1[0] = w0; o1[1] = w1; } else { o1[2] = w0; o1[3] = w1; }
            }
            if (live[j]) { *(u32x4*)(OG + tokv[j] * D + chnv[j]) = o0; *(u32x4*)(OG + tokv[j] * D + chnv[j] + 8) = o1; }
        }
    }
}

struct AttnTile { bf16x8 k[4][2]; bf16x8 v[4][2]; };
__device__ __forceinline__ void attn_load(AttnTile& tl, const bf16_t* kbase  , const bf16_t* vbase  ) {
#pragma unroll
    for (int kt = 0; kt < 4; ++kt)
#pragma unroll
        for (int ks = 0; ks < 2; ++ks) tl.k[kt][ks] = *(const bf16x8*)(kbase + (kt * 2 + ks) * 512);
#pragma unroll
    for (int dt = 0; dt < 4; ++dt)
#pragma unroll
        for (int ks = 0; ks < 2; ++ks) tl.v[dt][ks] = *(const bf16x8*)(vbase + (dt * 2 + ks) * 512);
}
template <bool MASK>
__device__ __forceinline__ void attn_tile(const AttnTile& tl, const bf16x8 (&qf)[2], f32x4 (&o)[4], float& R, int key0, int qpos, int fq) {
    constexpr float C2 = 0.125f * 1.4426950408889634f;
    f32x4 z[4];
#pragma unroll
    for (int kt = 0; kt < 4; ++kt) { z[kt] = (f32x4){0.f, 0.f, 0.f, 0.f};
#pragma unroll
        for (int ks = 0; ks < 2; ++ks) z[kt] = __builtin_amdgcn_mfma_f32_16x16x32_bf16(tl.k[kt][ks], qf[ks], z[kt], 0, 0, 0); }
    float sp[4][4], G[4];
#pragma unroll
    for (int kt = 0; kt < 4; ++kt) { G[kt] = 0.f;
#pragma unroll
        for (int e = 0; e < 4; ++e) { const float z2 = z[kt][e] * C2; z[kt][e] = z2;
            const float l2 = __builtin_amdgcn_logf(1.0f + __builtin_amdgcn_exp2f(z2));
            float spv = z2 > 30.f ? z2 : l2;
            if (MASK) spv = ((key0 + 16 * kt + 4 * fq + e) < qpos) ? spv : 0.f;
            sp[kt][e] = spv; G[kt] += spv; } }
    float sufg[4], tot[4];
#pragma unroll
    for (int kt = 0; kt < 4; ++kt) {
        const float g1 = __shfl_xor(G[kt], 16), g2 = __shfl_xor(G[kt], 32), g3 = __shfl_xor(G[kt], 48);
        tot[kt] = G[kt] + g1 + g2 + g3;
        sufg[kt] = (((fq ^ 1) > fq) ? g1 : 0.f) + (((fq ^ 2) > fq) ? g2 : 0.f) + (((fq ^ 3) > fq) ? g3 : 0.f);
    }
    float later = 0.f;
    union { bf16x8 v; unsigned w[4]; } p0, p1;
#pragma unroll
    for (int kt = 3; kt >= 0; --kt) {
        float run = R + later + sufg[kt];
        float wv[4];
#pragma unroll
        for (int e = 3; e >= 0; --e) { float w = __builtin_amdgcn_exp2f(z[kt][e] - sp[kt][e] - run);
            if (MASK) w = ((key0 + 16 * kt + 4 * fq + e) < qpos) ? w : 0.f;
            wv[e] = w; run += sp[kt][e]; }
        const unsigned w01 = pgx::cvt_pk_bf16(wv[0], wv[1]), w23 = pgx::cvt_pk_bf16(wv[2], wv[3]);
        if (kt == 0) { p0.w[0] = w01; p0.w[1] = w23; } else if (kt == 1) { p0.w[2] = w01; p0.w[3] = w23; } else if (kt == 2) { p1.w[0] = w01; p1.w[1] = w23; } else { p1.w[2] = w01; p1.w[3] = w23; }
        later += tot[kt];
    }
    R += later;
#pragma unroll
    for (int dt = 0; dt < 4; ++dt) {
        o[dt] = __builtin_amdgcn_mfma_f32_16x16x32_bf16(tl.v[dt][0], p0.v, o[dt], 0, 0, 0);
        o[dt] = __builtin_amdgcn_mfma_f32_16x16x32_bf16(tl.v[dt][1], p1.v, o[dt], 0, 0, 0);
    }
}
__device__ __forceinline__ void attn_unit(const Frame& F, const int bh, const int qt) {
    const bf16_t* Q = (const bf16_t*)(F.ws + WS_Q); const bf16_t* Kb = Q + (size_t)T * D; const bf16_t* VT = Q + (size_t)2 * T * D;
    bf16_t* AO = (bf16_t*)(F.ws + WS_AO);
    const int lane = F.lane, fr = lane & 15, fq = lane >> 4;
    constexpr float EXIT2 = SB_EXIT * 1.4426950408889634f;
    const int b = bh / NH, h = bh % NH;
    const int q0 = qt * 16, qpos = q0 + fr;
    const size_t tb = (size_t)b * SEQ;
    bf16x8 qf[2];
#pragma unroll
    for (int ks = 0; ks < 2; ++ks) qf[ks] = *(const bf16x8*)(Q + (tb + qpos) * D + h * 64 + ks * 32 + fq * 8);
    f32x4 o[4];
#pragma unroll
    for (int dt = 0; dt < 4; ++dt) o[dt] = (f32x4){0.f, 0.f, 0.f, 0.f};
    float R = 0.f;
    const bf16_t* kb = Kb + (size_t)bh * SEQ * 64 + (fr * 4 + fq) * 8;
    const bf16_t* vb = VT + (size_t)bh * SEQ * 64 + (fr * 4 + fq) * 8;
    int kt0 = (q0 + 15) / 64;
    AttnTile ta, tc;
    attn_load(ta, kb + (size_t)kt0 * 4096, vb + (size_t)kt0 * 4096);
    if (kt0 > 0) attn_load(tc, kb + (size_t)(kt0 - 1) * 4096, vb + (size_t)(kt0 - 1) * 4096);
    attn_tile<true>(ta, qf, o, R, kt0 * 64, qpos, fq);
    --kt0;
    while (kt0 >= 0 && !__all(R > EXIT2)) {
        if (kt0 > 0) attn_load(ta, kb + (size_t)(kt0 - 1) * 4096, vb + (size_t)(kt0 - 1) * 4096);
        attn_tile<false>(tc, qf, o, R, kt0 * 64, qpos, fq);
        --kt0;
        if (kt0 < 0 || __all(R > EXIT2)) break;
        if (kt0 > 0) attn_load(tc, kb + (size_t)(kt0 - 1) * 4096, vb + (size_t)(kt0 - 1) * 4096);
        attn_tile<false>(ta, qf, o, R, kt0 * 64, qpos, fq);
        --kt0;
    }
#pragma unroll
    for (int dt = 0; dt < 4; ++dt) st_bf4(AO + (tb + qpos) * D + h * 64 + 16 * dt + 4 * fq, o[dt]);
}
__device__ __forceinline__ void ph_attn(const Frame& F) {
    if (F.G == 256) {
        const int xq = F.bid & 7, lb = F.bid >> 3;
#pragma unroll 1
        for (int it = 0; it < 8; ++it) { const int ck = it * 32 + lb; attn_unit(F, xq + 8 * (ck >> 6), (ck & 63) * 8 + F.wave); }
    } else {
        unsigned* aq = F.ctl + CW_AQ;
        LAS unsigned* chunk_s = (LAS unsigned*)(F.lds + 1024);
        const unsigned myx = xb_xcc_id() & 7u;
        for (int qi = 0; qi < 8; ++qi) {
            const unsigned xq = (myx + (unsigned)qi) & 7u;
            for (;;) {
                __syncthreads();
                if (F.tid == 0) *chunk_s = atomicAdd(&aq[xq * 64], 1u);
                __syncthreads();
                const unsigned ck = *chunk_s;
                if (ck >= 256u) break;
                attn_unit(F, (int)xq + 8 * (int)(ck >> 6), (int)(ck & 63u) * 8 + F.wave);
            }
        }
    }
}

#ifndef USE_PGX
#define USE_PGX 0x1f
#endif
__device__ __forceinline__ int px_unit_index(int i, int G, int c, int nwg) {
    const long L = (long)i * G + c; if (L >= nwg) return -1;
    const int w = (int)L, q = nwg / 8, r = nwg % 8, xcd = w % 8, off = w / 8;
    return (xcd < r ? xcd * (q + 1) : r * (q + 1) + (xcd - r) * q) + off;
}
struct PxDense {
    const char* A; const char* B; int nM, nN, K, G, c; unsigned lda; int a_div; size_t a_stride;
    __device__ __forceinline__ bool next(int i, pgx::Unit& u) const {
        const int w = px_unit_index(i, G, c, nM * nN); if (w < 0) return false;
        const int pm = w / nN, pn = w % nN;
        u.A = A + (size_t)(pn / a_div) * a_stride + (size_t)pm * 256 * lda; u.tok = nullptr; u.B = B + (size_t)pn * 256 * K * 2; u.r0 = pm * 256; u.c0 = pn * 256; u.aux = 0; return true;
    }
};
__device__ __forceinline__ void px_store_bf16_perm(bf16_t* rowp, const f32x4& v0, const f32x4& v1) {
    u32x4 w; w.x = pgx::cvt_pk_bf16(v0[0], v0[1]); w.y = pgx::cvt_pk_bf16(v0[2], v0[3]); w.z = pgx::cvt_pk_bf16(v1[0], v1[1]); w.w = pgx::cvt_pk_bf16(v1[2], v1[3]); *(u32x4*)rowp = w;
}
__device__ __forceinline__ void ph_rkv_px(const Frame& F) {
    bf16_t* RKV = (bf16_t*)(F.ws + WS_RKV);
    PxDense S{(const char*)(F.ws + WS_XS), (const char*)(F.ws + WS_WRKV), 64, 12, D, F.G, F.bid, (unsigned)(D * 2), 4, (size_t)T * D * 2};
    pgx::gemm_phase<true, true>(F.lds, D, D * 2, S, [&](const f32x4 (&acc)[2][2][4][2], const pgx::Unit& u, int wr, int wc, int fr, int fq) {
        bf16_t* base = RKV + (size_t)(u.c0 / D) * T * D;
#pragma unroll
        for (int ai = 0; ai < 2; ++ai)
#pragma unroll
            for (int m = 0; m < 4; ++m) { const int t = u.r0 + ai * 128 + wr * 64 + m * 16 + fr;
#pragma unroll
                for (int bj = 0; bj < 2; ++bj) px_store_bf16_perm(base + hm_off(t, (u.c0 % D) + bj * 128 + wc * 32 + 8 * fq), acc[ai][bj][m][0], acc[ai][bj][m][1]); }
    });
}
__device__ __forceinline__ void ph_lora_dn_sg(const Frame& F) {
    const bf16_t* XS = (const bf16_t*)(F.ws + WS_XS); const bf16_t* WLDN = (const bf16_t*)(F.ws + WS_WLDN); bf16_t* LORA = (bf16_t*)(F.ws + WS_LORA);
    for (int u = F.bid; u < 64 * 4; u += F.G) {
        const int mt = u / 4, j = u % 4, n = (j == 0) ? 3 : (j == 1 ? 4 : 5);
        ASeg A; A.p[0] = XS + ((size_t)n * T + mt * 256) * D; A.p[1] = A.p[0]; A.p[2] = A.p[0]; A.segTiles = 16;
        bf16_t* out = LORA + (size_t)mt * 256 * 256 + j * 64;
        sg_tile<64>(F.lds, A, [](int R) { return (unsigned)R * (D * 2); }, WLDN + (size_t)(j * 64) * D, D, 16,
            [&](auto& acc, int r0, int c0, int fr, int fq) {
#pragma unroll
                for (int m = 0; m < EPI_MT(acc); ++m)
#pragma unroll
                    for (int q = 0; q < 4; ++q) { f32x4 v = acc[m][q];
                        if (j == 0) {
#pragma unroll
                            for (int e = 0; e < 4; ++e) v[e] = tanhf_(v[e]); }
                        else if (j >= 2) {
#pragma unroll
                            for (int e = 0; e < 4; ++e) v[e] = sigmoidf_(v[e]); }
                        st_bf4(out + (size_t)(r0 + 16 * m + fr) * 256 + c0 + 16 * q + 4 * fq, v); }
            });
    }
}
__device__ __forceinline__ void ph_dense_bf16_px(const Frame& F, const bf16_t* Ain, const bf16_t* Wt, bf16_t* out) {
    PxDense S{(const char*)Ain, (const char*)Wt, 64, 4, D, F.G, F.bid, (unsigned)(D * 2), 4, 0};
    pgx::gemm_phase<true, true>(F.lds, D, D * 2, S, [&](const f32x4 (&acc)[2][2][4][2], const pgx::Unit& u, int wr, int wc, int fr, int fq) {
        bf16_t* base = out + u.c0 + wc * 32 + 8 * fq;
#pragma unroll
        for (int ai = 0; ai < 2; ++ai)
#pragma unroll
            for (int m = 0; m < 4; ++m) { bf16_t* rowp = base + (size_t)(u.r0 + ai * 128 + wr * 64 + m * 16 + fr) * D;
#pragma unroll
                for (int bj = 0; bj < 2; ++bj) px_store_bf16_perm(rowp + bj * 128, acc[ai][bj][m][0], acc[ai][bj][m][1]); }
    });
}
__device__ __forceinline__ void ph_qkv_px(const Frame& F) {
    bf16_t* QK = (bf16_t*)(F.ws + WS_Q); bf16_t* VT = QK + (size_t)2 * T * D;
    { PxDense S{(const char*)(F.ws + WS_H3), (const char*)(F.ws + WS_WQKV), 64, 8, D, F.G, F.bid, (unsigned)(D * 2), 8, 0};
      pgx::gemm_phase<true, true>(F.lds, D, D * 2, S, [&](const f32x4 (&acc)[2][2][4][2], const pgx::Unit& u, int wr, int wc, int fr, int fq) {
        const bool isk = u.c0 >= D;
#pragma unroll
        for (int ai = 0; ai < 2; ++ai)
#pragma unroll
            for (int m = 0; m < 4; ++m) { const int t = u.r0 + ai * 128 + wr * 64 + m * 16 + fr;
#pragma unroll
                for (int bj = 0; bj < 2; ++bj) { const int c = (u.c0 % D) + bj * 128 + wc * 32 + 8 * fq;
                    const int sq = t % SEQ, dd = c & 63;
                    bf16_t* dst = isk ? QK + (size_t)T * D + (((size_t)((t / SEQ) * NH + (c >> 6)) * (SEQ / 16) + (sq >> 4)) * 2 + (dd >> 5)) * 512 + (sq & 15) * 32 + (dd & 31) : QK + (size_t)t * D + c;
                    px_store_bf16_perm(dst, acc[ai][bj][m][0], acc[ai][bj][m][1]); } }
      }); }
    { PxDense S{(const char*)(F.ws + WS_H3), (const char*)(F.ws + WS_WQKV) + (size_t)2 * D * D * 2, 64, 4, D, F.G, F.bid, (unsigned)(D * 2), 4, 0};
      pgx::gemm_phase<false, false>(F.lds, D, D * 2, S, [&](const f32x4 (&acc)[2][2][4][2], const pgx::Unit& u, int wr, int wc, int fr, int fq) {
#pragma unroll
        for (int ai = 0; ai < 2; ++ai)
#pragma unroll
            for (int m = 0; m < 4; ++m) { const int t = u.r0 + ai * 128 + wr * 64 + m * 16 + 4 * fq, b = t / SEQ, sidx = t % SEQ;
#pragma unroll
                for (int bj = 0; bj < 2; ++bj)
#pragma unroll
                    for (int n = 0; n < 2; ++n) { const int c = u.c0 + bj * 128 + wc * 32 + n * 16 + fr, h = c >> 6, d = c & 63;
                        const int k6 = sidx & 63, kk = k6 & 31;
                        st_bf4(VT + ((size_t)(b * NH + h) * (SEQ / 64) + (sidx >> 6)) * 4096 + ((d >> 4) * 2 + (k6 >> 5)) * 512 + ((d & 15) * 4 + ((kk & 15) >> 2)) * 8 + (kk >> 4) * 4, acc[ai][bj][m][n]); } }
      }); }
}
struct PxMoe {
    const char* Asrc; const int* TOK; const int* TILEE; const char* W; const char* Wsh; int routed, nmt, nN, K, G, c; unsigned lda; size_t wexp; bool gather;
    __device__ __forceinline__ bool next(int i, pgx::Unit& u) const {
        const int w = px_unit_index(i, G, c, nmt * nN); if (w < 0) return false;
        const int mt = w / nN, pn = w % nN, row0 = mt * 256; const bool sh = row0 >= routed; const int e = sh ? 64 : TILEE[mt];
        if (gather) { if (sh) { u.A = Asrc + (size_t)(row0 - routed) * lda; u.tok = nullptr; } else { u.A = Asrc; u.tok = TOK + row0; } }
        else { u.A = Asrc + (size_t)row0 * lda; u.tok = nullptr; }
        u.B = (sh ? Wsh : W + (size_t)e * wexp) + (size_t)pn * 256 * K * 2; u.r0 = row0; u.c0 = pn * 256; u.aux = 0; return true;
    }
};
__device__ __forceinline__ void ph_gateup_px(const Frame& F, int layer) {
    bf16_t* HB = (bf16_t*)(F.ws + WS_HB); const int* START = (const int*)(F.ws + WS_START);
    const int routed = START[65], nmt = (routed + T) / 256;
    PxMoe S{(const char*)(F.ws + WS_H2), (const int*)(F.ws + WS_TOK), (const int*)(F.ws + WS_TILEE), (const char*)(F.ws + (layer == 0 ? WS_WGU : WS_WGU1)), (const char*)(F.ws + WS_WGU) + (size_t)64 * 512 * D * 2, routed, nmt, 2, D, F.G, F.bid, (unsigned)(D * 2), (size_t)512 * D * 2, true};
    pgx::gemm_phase<true, true>(F.lds, D, D * 2, S, [&](const f32x4 (&acc)[2][2][4][2], const pgx::Unit& u, int wr, int wc, int fr, int fq) {
        bf16_t* base = HB + (u.c0 >> 1) + wc * 32 + 8 * fq;
#pragma unroll
        for (int ai = 0; ai < 2; ++ai)
#pragma unroll
            for (int m = 0; m < 4; ++m) { f32x4 v[2];
#pragma unroll
                for (int n = 0; n < 2; ++n)
#pragma unroll
                    for (int e = 0; e < 4; ++e) { const float g = acc[ai][0][m][n][e]; v[n][e] = g * sigmoidf_(g) * acc[ai][1][m][n][e]; }
                px_store_bf16_perm(base + (size_t)(u.r0 + ai * 128 + wr * 64 + m * 16 + fr) * DE, v[0], v[1]); }
    });
}
__device__ __forceinline__ void ph_down_px(const Frame& F) {
    bf16_t* YB = (bf16_t*)(F.ws + WS_YB); const int* START = (const int*)(F.ws + WS_START);
    const int routed = START[65], nmt = (routed + T) / 256;
    PxMoe S{(const char*)(F.ws + WS_HB), nullptr, (const int*)(F.ws + WS_TILEE), (const char*)(F.ws + WS_WDN), (const char*)(F.ws + WS_WDN) + (size_t)64 * D * DE * 2, routed, nmt, 4, DE, F.G, F.bid, (unsigned)(DE * 2), (size_t)D * DE * 2, false};
    pgx::gemm_phase<true, true>(F.lds, DE, DE * 2, S, [&](const f32x4 (&acc)[2][2][4][2], const pgx::Unit& u, int wr, int wc, int fr, int fq) {
        unsigned char* base = (unsigned char*)YB + u.c0 + wc * 32 + 8 * fq;
#pragma unroll
        for (int ai = 0; ai < 2; ++ai)
#pragma unroll
            for (int m = 0; m < 4; ++m) { unsigned char* rowp = base + (size_t)(u.r0 + ai * 128 + wr * 64 + m * 16 + fr) * D;
#pragma unroll
                for (int bj = 0; bj < 2; ++bj) { u32x2 w;
                    w.x = pack_fp8x4(acc[ai][bj][m][0]); w.y = pack_fp8x4(acc[ai][bj][m][1]);
                    *(u32x2*)(rowp + bj * 128) = w; }
                asm volatile("" ::: "memory"); }
    });
}

__global__ void __launch_bounds__(NTHREADS, 2) mega(Args args) {
    extern __shared__ __attribute__((aligned(16))) unsigned char lds[];
    Frame F;
    F.in = args.in; F.out = args.out; F.ws = args.ws; F.ctl = (unsigned*)(args.ws + WS_CTL);
    F.ldsf = (float*)lds; F.lds = (LAS unsigned char*)lds;
    F.tid = threadIdx.x; F.lane = F.tid & 63; F.wave = __builtin_amdgcn_readfirstlane(F.tid >> 6); F.bid = blockIdx.x; F.G = gridDim.x;
    if (F.tid < 4) ((unsigned*)(lds + LDS_BYTES - 64))[F.tid] = 0u;
    __syncthreads();
    XcdBarrier bar; bar.bar = F.ctl + CW_BAR; bar.x = 0; bar.st = (volatile LAS unsigned*)(lds + LDS_BYTES - 64);
#if MK_N_LAUNCHES == 1
    bar = xcd_barrier_post(F.ctl + CW_BAR, (volatile LAS unsigned*)(lds + LDS_BYTES - 64));
#endif
    const int lo = args.ph_lo, hi = args.ph_hi;
#define IN(k) (lo <= (k) && (k) < hi)
#define SEAM(k) do { if (IN(k) && IN((k) + 1)) xcd_barrier(bar); } while (0)
    bf16_t* const wsb = (bf16_t*)args.ws;
    (void)wsb;
    if (IN(0)) { ph_mod(F); conv_dense(F, 0, F.bid, F.G); if (F.G <= 2 * NB * NH) { conv_dense(F, 1, F.bid, F.G); conv_moe(F, 0, 3, F.bid, F.G); } } SEAM(0);
    if (IN(1)) { ph_prenorm_rwkv(F); } SEAM(1);
    if (IN(2)) { ph_rkv_px(F); ph_lora_dn_sg(F); } SEAM(2);
    if (IN(3)) { ph_lora_up_sg(F); } SEAM(3);
    if (IN(4)) { ph_wkv_chunk(F); } SEAM(4);
    if (IN(5)) { if (F.bid < NB * NH || F.G <= 2 * NB * NH) { ph_wkv_carry(F); } else { conv_dense(F, 1, F.bid - NB * NH, F.G - NB * NH); conv_moe(F, 0, 3, F.bid - NB * NH, F.G - NB * NH); conv_moe(F, 1, 1, F.bid - NB * NH, F.G - NB * NH); } } SEAM(5);
    if (IN(6)) { ph_wkv_out(F); } SEAM(6);
    if (IN(7)) { ph_dense_bf16_px(F, (const bf16_t*)(F.ws + WS_OG), (const bf16_t*)(F.ws + WS_WO), (bf16_t*)(F.ws + WS_Y1)); } SEAM(7);
    if (IN(8)) { ph_postmix_route<false>(F, 0, F.in[I_X], (const bf16_t*)(F.ws + WS_Y1)); } SEAM(8);
    if (IN(11)) { ph_offsets(F, 0); } SEAM(11);
    if (IN(12)) { ph_gateup_px(F, 0); } SEAM(12);
    if (IN(13)) { ph_down_px(F); } SEAM(13);
    if (IN(14)) { ph_combine(F, 0, true); conv_moe(F, 1, (F.G <= 2 * NB * NH) ? 3 : 2, F.bid, F.G); } SEAM(14);
    if (IN(15)) { ph_qkv_px(F); } SEAM(15);
    if (IN(16)) { ph_attn(F); } SEAM(16);
    if (IN(17)) { ph_dense_bf16_px(F, (const bf16_t*)(F.ws + WS_AO), (const bf16_t*)(F.ws + WS_WSBO), (bf16_t*)(F.ws + WS_Y1B)); } SEAM(17);
    if (IN(18)) { ph_postmix_route<true>(F, 1, nullptr, (const bf16_t*)(F.ws + WS_Y1B)); } SEAM(18);
    if (IN(21)) { ph_offsets(F, 1); } SEAM(21);
    if (IN(22)) { ph_gateup_px(F, 1); } SEAM(22);
    if (IN(23)) { ph_down_px(F); } SEAM(23);
    if (IN(24)) { ph_combine(F, 1, false); }
#undef IN
#undef SEAM
}

extern "C" void kernel_launch(void* const* d_in, const int* in_sizes, int n_in, void* d_out, int out_size, void* d_ws, size_t ws_size, hipStream_t stream) {
    static int grid = 0;
    if (grid == 0) {
        if (n_in != 34 || in_sizes[0] != T * D || out_size != T * D || ws_size < WS_END) {
            fprintf(stderr, "kernel_launch: unexpected shapes: n_in %d in0 %d out %d ws %zu (need %zu)\n", n_in, n_in > 0 ? in_sizes[0] : -1, out_size, ws_size, (size_t)WS_END);
            grid = -1; return;
        }
        int dev = 0, cus = 0, per_cu = 0;
        if (hipGetDevice(&dev) != hipSuccess || hipDeviceGetAttribute(&cus, hipDeviceAttributeMultiprocessorCount, dev) != hipSuccess) { grid = -1; return; }
        if (hipFuncSetAttribute((const void*)mega, hipFuncAttributeMaxDynamicSharedMemorySize, LDS_BYTES) != hipSuccess) { fprintf(stderr, "kernel_launch: hipFuncSetAttribute failed\n"); grid = -1; return; }
        if (hipOccupancyMaxActiveBlocksPerMultiprocessor(&per_cu, (const void*)mega, NTHREADS, LDS_BYTES) != hipSuccess || per_cu < 1)
            fprintf(stderr, "kernel_launch: occupancy query reports %d blocks per CU\n", per_cu);
        (void)hipGetLastError();
        grid = cus;
    }
    if (grid < 0) return;
    if (hipMemsetAsync((char*)d_ws + WS_CTL, 0, CTL_BYTES, stream) != hipSuccess) { fprintf(stderr, "kernel_launch: memset failed\n"); return; }
    Args a{};
    for (int i = 0; i < 34; ++i) a.in[i] = (const float*)d_in[i];
    a.out = (float*)d_out; a.ws = (unsigned char*)d_ws;
#if MK_N_LAUNCHES == 1
    a.ph_lo = 0; a.ph_hi = NPHASES;
    hipLaunchKernelGGL(mega, dim3(grid), dim3(NTHREADS), LDS_BYTES, stream, a);
#else
    for (int p = 0; p < NPHASES; ++p) { a.ph_lo = p; a.ph_hi = p + 1; hipLaunchKernelGGL(mega, dim3(grid), dim3(NTHREADS), LDS_BYTES, stream, a); }
#endif
    const hipError_t le = hipPeekAtLastError();
    if (le != hipSuccess) fprintf(stderr, "kernel_launch: launch failed: %s\n", hipGetErrorName(le));
}
```

```cpp
#include <hip/hip_runtime.h>
#include <cstdio>
#include <cstdint>

#ifndef MK_N_LAUNCHES
#define MK_N_LAUNCHES 1
#endif

constexpr int T = 16384, D = 1024, SEQ = 8192, NB = 2, NH = 16, HD = 64;
constexpr int NE = 64, TOPK = 8, DE = 256;
constexpr int RP = 256;
constexpr int MAXROUTED = 147456;
constexpr int MAXROWS = MAXROUTED + T;
constexpr int NTHREADS = 512, NWAVES = 8;
constexpr int NPHASES = 25;
constexpr int LDS_BYTES = 144 * 1024;
constexpr float YB_SCALE = 16.0f;

typedef unsigned short bf16_t;
typedef float f32x4 __attribute__((ext_vector_type(4)));
typedef unsigned u32x4 __attribute__((ext_vector_type(4)));
typedef unsigned u32x2 __attribute__((ext_vector_type(2)));

__device__ __forceinline__ float bf2f(bf16_t b) { return __uint_as_float(((unsigned)b) << 16); }
typedef __bf16 bf16x2_t __attribute__((ext_vector_type(2)));
typedef float f32x2 __attribute__((ext_vector_type(2)));
__device__ __forceinline__ unsigned pack2(float a, float b) { const f32x2 v = {a, b}; const bf16x2_t r = __builtin_convertvector(v, bf16x2_t); return __builtin_bit_cast(unsigned, r); }
__device__ __forceinline__ bf16_t f2bf(float f) { return (bf16_t)(pack2(f, 0.f) & 0xffffu); }
__device__ __forceinline__ float lo2f(unsigned u) { return __uint_as_float(u << 16); }
__device__ __forceinline__ float hi2f(unsigned u) { return __uint_as_float(u & 0xffff0000u); }
__device__ __forceinline__ f32x4 ld4_g(const bf16_t* p) { const u32x2 w = *(const u32x2*)p; return (f32x4){lo2f(w.x), hi2f(w.x), lo2f(w.y), hi2f(w.y)}; }
__device__ __forceinline__ float fexp_(float x) { return __builtin_amdgcn_exp2f(x * 1.4426950408889634f); }
__device__ __forceinline__ float sigmoidf_(float x) { return __builtin_amdgcn_rcpf(1.0f + fexp_(-x)); }
__device__ __forceinline__ float tanhf_(float x) { return 1.0f - 2.0f * __builtin_amdgcn_rcpf(1.0f + fexp_(2.0f * x)); }
__device__ __forceinline__ float softplusf_(float x) { const float e = fexp_(x); const float l = __builtin_amdgcn_logf(1.0f + e) * 0.6931471805599453f; return x > 15.f ? x : (x < -8.f ? e : l); }
__device__ __forceinline__ float wave_sum(float v) {
#pragma unroll
    for (int o = 32; o >= 1; o >>= 1) v += __shfl_xor(v, o);
    return v;
}

constexpr size_t MiB = 1024 * 1024;
constexpr size_t WS_CTL    = 0;
constexpr size_t CTL_BYTES = 64 * 1024;
constexpr size_t WS_MOD    = 64 * 1024;
constexpr size_t WS_IDX    = 256 * 1024;
constexpr size_t WS_GATE   = WS_IDX + 512 * 1024;
constexpr size_t WS_RANK   = WS_GATE + 512 * 1024;
constexpr size_t WS_POS    = WS_RANK + 512 * 1024;
constexpr size_t WS_TOK    = WS_POS + 512 * 1024;
constexpr size_t WS_TILEE  = WS_TOK + 704 * 1024;
constexpr size_t WS_START  = WS_TILEE + 4096;
constexpr size_t WS_LOGITS = 8 * MiB + 64 * MiB;
constexpr size_t WS_BC     = 4 * MiB;
constexpr size_t WS_BIG    = 8 * MiB;
constexpr size_t WS_XS   = WS_BIG;
constexpr size_t WS_RKV  = WS_BIG + 192 * MiB;
constexpr size_t WS_LORA = WS_BIG + 288 * MiB;
constexpr size_t WS_LD   = WS_BIG;
constexpr size_t WS_AA   = WS_BIG + 64 * MiB;
constexpr size_t WS_GG   = WS_BIG + 96 * MiB;
constexpr size_t WS_O    = WS_BIG + 128 * MiB;
constexpr size_t WS_OG   = WS_BIG + 296 * MiB;
constexpr size_t WS_Y1   = WS_BIG + 328 * MiB;
constexpr size_t WS_H2   = WS_BIG;
constexpr size_t WS_H2LO = WS_BIG + 32 * MiB;
constexpr size_t WS_YB   = WS_BIG;
constexpr size_t WS_HB   = WS_BIG + 320 * MiB;
constexpr size_t WS_H3   = WS_BIG + 320 * MiB;
constexpr size_t WS_Q    = WS_BIG;
constexpr size_t WS_AO   = WS_BIG + 96 * MiB;
constexpr size_t WS_XR   = WS_BIG + 256 * MiB;
constexpr size_t WS_Y1B  = WS_BIG + 128 * MiB;
constexpr size_t WS_W     = WS_BIG + 400 * MiB;
constexpr size_t WS_WGU1  = WS_BIG + 192 * MiB;
constexpr size_t WS_WGU   = WS_W;
constexpr size_t WS_WDN   = WS_WGU + (size_t)65 * 512 * 1024 * 2;
constexpr size_t WS_WRKV  = WS_WDN + (size_t)65 * 1024 * 256 * 2;
constexpr size_t WS_WO    = WS_WRKV + (size_t)3072 * 1024 * 2;
constexpr size_t WS_WQKV  = WS_WO + (size_t)1024 * 1024 * 2;
constexpr size_t WS_WSBO  = WS_WQKV + (size_t)3072 * 1024 * 2;
constexpr size_t WS_WLDN  = WS_WSBO + (size_t)1024 * 1024 * 2;
constexpr size_t WS_WLUP  = WS_WLDN + (size_t)256 * 1024 * 2;
constexpr size_t WS_WRT   = WS_WLUP + (size_t)1024 * 256 * 2;
constexpr size_t WS_END   = WS_WRT + (size_t)2 * 64 * 3072 * 2;

constexpr int CW_BAR = 0;
constexpr int CW_CNT = 4096;
constexpr int CW_AQ = 4608;

#define XB_TMO      128
#define XB_XCNT(j)  (256  + 64 * (j))
#define XB_XSUB(j)  (1280 + 64 * (j))
#define XB_XGEN(j)  (2304 + 64 * (j))
#define XB_TOP      3328
#define XB_TOPGEN   3392
#define XCD_BAR_WORDS 3456
#define XB_SPIN_CAP (1u << 22)
#define LAS __attribute__((address_space(3)))

__device__ __forceinline__ unsigned xb_ld(unsigned* p)              { return __hip_atomic_load(p, __ATOMIC_RELAXED, __HIP_MEMORY_SCOPE_AGENT); }
__device__ __forceinline__ unsigned xb_add(unsigned* p, unsigned v) { return __hip_atomic_fetch_add(p, v, __ATOMIC_RELAXED, __HIP_MEMORY_SCOPE_AGENT); }
__device__ __forceinline__ unsigned xb_xcc_id() { return (unsigned)__builtin_amdgcn_s_getreg((3 << 11) | 20) & 0xFu; }
#define XB_SPIN(cond, bar) do { unsigned _sp = 0; while (cond) { __builtin_amdgcn_s_sleep(1); \
    if ((++_sp & 255u) == 0u) { if (xb_ld(&(bar)[XB_TMO])) break; if (_sp > XB_SPIN_CAP) { atomicAdd(&(bar)[XB_TMO], 1u); break; } } } } while (0)

struct XcdBarrier { unsigned* bar; unsigned x; volatile LAS unsigned* st; };

__device__ __forceinline__ XcdBarrier xcd_barrier_post(unsigned* bar, volatile LAS unsigned* st) {
    XcdBarrier b; b.bar = bar; b.x = xb_xcc_id(); b.st = st;
    if (threadIdx.x == 0) (void)xb_add(&bar[XB_XCNT(b.x)], 1u);
    return b;
}
__device__ __forceinline__ void xcd_barrier_complete(unsigned* bar, unsigned x, unsigned& nloc, unsigned& nx) {
    const unsigned G = gridDim.x * gridDim.y * gridDim.z;
    unsigned sum, cnt, mine, sp = 0u;
    for (;;) {
        sum = 0u; cnt = 0u; mine = 0u;
#pragma unroll
        for (unsigned j = 0; j < 16; ++j) { const unsigned c = xb_ld(&bar[XB_XCNT(j)]); sum += c; cnt += (c > 0u) ? 1u : 0u; mine = (j == x) ? c : mine; }
        if (sum == G) break;
        __builtin_amdgcn_s_sleep(1);
        if ((++sp & 255u) == 0u) { if (xb_ld(&bar[XB_TMO])) break; if (sp > XB_SPIN_CAP) { atomicAdd(&bar[XB_TMO], 1u); break; } }
    }
    nloc = mine > 0u ? mine : 1u; nx = cnt > 0u ? cnt : 1u;
}
__device__ __forceinline__ void xcd_barrier(const XcdBarrier& b) {
    asm volatile("s_waitcnt vmcnt(0)" ::: "memory");
    __syncthreads();
    if (threadIdx.x == 0) {
        unsigned* bar = b.bar;
        __builtin_amdgcn_s_waitcnt(0);
        unsigned nloc = b.st[0], nx = b.st[1];
        if (nloc == 0u) { xcd_barrier_complete(bar, b.x, nloc, nx); b.st[0] = nloc; b.st[1] = nx; }
        const unsigned old = xb_add(&bar[XB_XSUB(b.x)], 1u);
        const unsigned gen = old / nloc;
        if (old + 1u == (gen + 1u) * nloc) {
            __builtin_amdgcn_fence(__ATOMIC_RELEASE, "agent");
            asm volatile("s_waitcnt vmcnt(0)" ::: "memory");
            const unsigned og = xb_add(&bar[XB_TOP], 1u);
            const unsigned tg = og / nx;
            if (og + 1u == (tg + 1u) * nx) xb_add(&bar[XB_TOPGEN], 1u);
            else XB_SPIN(xb_ld(&bar[XB_TOPGEN]) == tg, bar);
            __builtin_amdgcn_fence(__ATOMIC_ACQUIRE, "agent");
            xb_add(&bar[XB_XGEN(b.x)], 1u);
            asm volatile("s_waitcnt vmcnt(0)" ::: "memory");
        } else {
            XB_SPIN(xb_ld(&bar[XB_XGEN(b.x)]) == gen, bar);
            __builtin_amdgcn_fence(__ATOMIC_ACQUIRE, "agent");
            asm volatile("s_waitcnt vmcnt(0)" ::: "memory");
        }
    }
    __syncthreads();
}

struct Args { const float* in[34]; float* out; unsigned char* ws; int ph_lo, ph_hi; };

struct Frame {
    const float* const* in; float* out; unsigned char* ws; unsigned* ctl;
    float* ldsf; LAS unsigned char* lds; int tid, lane, wave, bid, G;
};

enum { I_X = 0, I_C, I_ADAW, I_ADAB, I_NPM, I_NPOM, I_NPF, I_NPOF, I_MU, I_WRKV, I_WW1, I_WW2, I_W0, I_WA1, I_WA2, I_A0, I_WG1, I_WG2,
       I_KK, I_KA, I_RK, I_LNG, I_LNB, I_WO, I_SBQKV, I_SBO, I_ROUTER, I_RBIAS, I_MG, I_MU_, I_MD, I_SG, I_SU, I_SD };


typedef short bf16x8 __attribute__((ext_vector_type(8)));
typedef short s16x4 __attribute__((ext_vector_type(4)));
constexpr int HTB = 128 * 64 * 2;
__device__ __forceinline__ int lds_byte(int r, int c) { const int st = (r >> 4) * 2 + (c >> 5), rr = r & 15, cc = c & 31, ob = rr * 64 + cc * 2; return st * 1024 + (ob ^ (((ob >> 9) & 1) << 5)); }
__device__ __forceinline__ void stage_rc(int b, int& R, int& C) { const int st = b / 1024, sb = b % 1024, swz = sb ^ (((sb >> 9) & 1) << 5); R = (st >> 1) * 16 + swz / 64; C = (st & 1) * 32 + (swz % 64) / 2; }
#define WAIT_V(n) asm volatile("s_waitcnt vmcnt(" #n ")" ::: "memory")
#define SBAR() do { asm volatile("" ::: "memory"); __builtin_amdgcn_s_barrier(); asm volatile("" ::: "memory"); } while (0)

struct ASeg { const bf16_t* p[3]; int segTiles; };

struct BRowId { __device__ __forceinline__ int operator()(int R) const { return R; } };
struct SgChain { int ph; bool pre; bool nvalid; ASeg nA; const bf16_t* nBt; int nldb; };
template <int BN, bool NSW = false, class ARow, class Epi, class BRow = BRowId>
__device__ __forceinline__ void sg_tile(LAS unsigned char* lds, const ASeg& A, const ARow& arow, const bf16_t* Bt, int ldb, int nt, const Epi& epi, const BRow& brow = BRow(), SgChain* ch = nullptr) {
    constexpr int WN = BN / 64, WM = 8 / WN, WR = 256 / WM, MT = WR / 16;
    int tid_ = threadIdx.x; asm volatile("" : "+v"(tid_));
    const int tid = tid_, wid = __builtin_amdgcn_readfirstlane(tid >> 6), lane = tid & 63, fr = lane & 15, fq = lane >> 4;
    const int wm = wid / WN, wn = wid % WN;
    unsigned aoffs[2][2], boffs[2];
#pragma unroll
    for (int i = 0; i < 2; ++i) { int R, C; stage_rc(tid * 16 + i * 8192, R, C);
        aoffs[0][i] = arow(R) + (unsigned)C * 2u; aoffs[1][i] = arow(128 + R) + (unsigned)C * 2u; boffs[i] = (unsigned)(brow(R) * ldb + C) * 2u; }
    const unsigned ldsw = (unsigned)wid * 1024u;
    f32x4 acc[MT][4];
#pragma unroll
    for (int m = 0; m < MT; ++m)
#pragma unroll
        for (int n = 0; n < 4; ++n) acc[m][n] = (f32x4){0.f, 0.f, 0.f, 0.f};
    const int arow0 = wm * WR, ah = arow0 >> 7, ar = arow0 & 127;
    const int aoff = ah * HTB + lds_byte(ar + fr, fq * 8), boff = 2 * HTB + lds_byte(wn * 64 + fr, fq * 8);
#define SG_STAGE_X(AX, BX, BO, kt, s) do { const int sg_ = (kt) / (AX).segTiles; const char* ab_ = (const char*)(sg_ == 0 ? (AX).p[0] : (sg_ == 1 ? (AX).p[1] : (AX).p[2])) + (size_t)((kt) - sg_ * (AX).segTiles) * 128; const char* bb_ = (const char*)(BX) + (size_t)(kt) * 128; \
        _Pragma("unroll") for (int h_ = 0; h_ < 2; ++h_) _Pragma("unroll") for (int i_ = 0; i_ < 2; ++i_) \
            __builtin_amdgcn_global_load_lds((const unsigned*)(ab_ + aoffs[h_][i_]), (LAS unsigned*)(lds + ((s) * 3 + h_) * HTB + ldsw + i_ * 8192), 16, 0, 0); \
        _Pragma("unroll") for (int i_ = 0; i_ < WN; ++i_) \
            __builtin_amdgcn_global_load_lds((const unsigned*)(bb_ + (BO)[i_]), (LAS unsigned*)(lds + ((s) * 3 + 2) * HTB + ldsw + i_ * 8192), 16, 0, 0); } while (0)
#define SG_STAGE(kt, s) SG_STAGE_X(A, Bt, boffs, kt, s)
    const int ph0 = ch ? ch->ph : 0;
    if (!(ch && ch->pre)) SG_STAGE(0, ph0);
    for (int t = 0; t < nt; ++t) {
        const int s = (ph0 + t) & 1;
        if (t + 1 < nt) { SG_STAGE(t + 1, s ^ 1); if (WN == 2) WAIT_V(6); else WAIT_V(5); }
        else if (ch && ch->nvalid) { unsigned nbo[2];
#pragma unroll
            for (int i = 0; i < 2; ++i) { int R, C; stage_rc(tid * 16 + i * 8192, R, C); nbo[i] = (unsigned)(brow(R) * ch->nldb + C) * 2u; }
            SG_STAGE_X(ch->nA, ch->nBt, nbo, 0, s ^ 1); if (WN == 2) WAIT_V(6); else WAIT_V(5); }
        else { WAIT_V(0); }
        SBAR();
        LAS unsigned char* base = lds + s * 3 * HTB;
#pragma unroll
        for (int k = 0; k < 2; ++k) {
            bf16x8 af[MT], bfr[4];
#pragma unroll
            for (int m = 0; m < MT; ++m) af[m] = *(const LAS bf16x8*)(base + aoff + m * 2048 + k * 1024);
#pragma unroll
            for (int n = 0; n < 4; ++n) bfr[n] = *(const LAS bf16x8*)(base + boff + n * 2048 + k * 1024);
#pragma unroll
            for (int m = 0; m < MT; ++m)
#pragma unroll
                for (int n = 0; n < 4; ++n) acc[m][n] = NSW ? __builtin_amdgcn_mfma_f32_16x16x32_bf16(af[m], bfr[n], acc[m][n], 0, 0, 0) : __builtin_amdgcn_mfma_f32_16x16x32_bf16(bfr[n], af[m], acc[m][n], 0, 0, 0);
        }
        SBAR();
    }
#undef SG_STAGE
#undef SG_STAGE_X
    if (ch) { ch->ph = (ph0 + nt) & 1; ch->pre = ch->nvalid; }
    epi(acc, arow0, wn * 64, fr, fq);
}

struct CTile { bf16_t* dst; const float* src; int dld, sld, ncols; float scale; };
template <class TF>
__device__ __forceinline__ void conv_tiles(const Frame& F, int ntiles, int u0, int ustride, const TF& tf) {
    unsigned* tl = (unsigned*)F.ldsf;
    const int i = F.tid & 31, kp0 = F.tid >> 5;
    if (u0 >= ntiles) return;
    CTile ct = tf(u0);
    f32x4 a[4], b[4];
#define CV_LOAD() do { _Pragma("unroll") for (int q = 0; q < 4; ++q) { const int kp = kp0 + 16 * q; \
        if (4 * i < ct.ncols) { a[q] = *(const f32x4*)(ct.src + (size_t)(2 * kp) * ct.sld + 4 * i); b[q] = *(const f32x4*)(ct.src + (size_t)(2 * kp + 1) * ct.sld + 4 * i); } } } while (0)
    CV_LOAD();
    for (int u = u0; u < ntiles; u += ustride) {
        const CTile cur = ct;
        if (4 * i < cur.ncols) {
#pragma unroll
            for (int q = 0; q < 4; ++q) { const int kp = kp0 + 16 * q;
#pragma unroll
                for (int e = 0; e < 4; ++e) tl[(4 * i + e) * 65 + kp] = pack2(a[q][e] * cur.scale, b[q][e] * cur.scale); }
        }
        __syncthreads();
        if (u + ustride < ntiles) { ct = tf(u + ustride); CV_LOAD(); }
        const int nb = F.tid >> 4, sgm = F.tid & 15;
#pragma unroll
        for (int q = 0; q < 4; ++q) { const int n = nb + 32 * q;
            if (n < cur.ncols) { u32x4 v;
#pragma unroll
                for (int e = 0; e < 4; ++e) v[e] = tl[n * 65 + sgm * 4 + e];
                *(u32x4*)(cur.dst + (size_t)n * cur.dld + sgm * 8) = v; } }
        __syncthreads();
    }
#undef CV_LOAD
}
__device__ __forceinline__ void conv_moe(const Frame& F, int layer, int parts, int u0, int ustride) {
    bf16_t* WGUr = (bf16_t*)(F.ws + (layer == 0 ? WS_WGU : WS_WGU1)); bf16_t* WGUs = (bf16_t*)(F.ws + WS_WGU) + (size_t)64 * 512 * D; bf16_t* WDN = (bf16_t*)(F.ws + WS_WDN);
    const float* const* in = F.in;
    const int nA = (parts & 1) ? 64 * 32 : 0, nB = (parts & 2) ? 32 + 65 * 16 : 0;
    conv_tiles(F, nA + nB, u0, ustride, [=](int u) {
        CTile c; c.ncols = 128;
        if (u < nA) { const int e = u >> 5, r = u & 31, up = r >> 4, kt = (r >> 1) & 7, nt = r & 1;
            const float* W = (up ? in[I_MU_] : in[I_MG]) + ((size_t)layer * NE + e) * D * DE;
            c.src = W + (size_t)kt * 128 * DE + nt * 128; c.sld = DE; c.dst = WGUr + ((size_t)e * 512 + nt * 256 + up * 128) * D + kt * 128; c.dld = D; c.scale = 1.0f; }
        else { const int v0 = u - nA;
            if (v0 < 32) { const int up = v0 >> 4, kt = (v0 >> 1) & 7, nt = v0 & 1;
                const float* W = (up ? in[I_SU] : in[I_SG]) + (size_t)layer * D * DE;
                c.src = W + (size_t)kt * 128 * DE + nt * 128; c.sld = DE; c.dst = WGUs + ((size_t)nt * 256 + up * 128) * D + kt * 128; c.dld = D; c.scale = 1.0f; }
            else { const int v1 = v0 - 32, e = v1 >> 4, v = v1 & 15, kt = v >> 3, nt = v & 7;
                const float* W = (e < 64) ? in[I_MD] + ((size_t)layer * NE + e) * DE * D : in[I_SD] + (size_t)layer * DE * D;
                c.src = W + (size_t)kt * 128 * D + nt * 128; c.sld = D; c.dst = WDN + ((size_t)e * D + nt * 128) * DE + kt * 128; c.dld = DE; c.scale = YB_SCALE; } }
        return c; });
}
__device__ __forceinline__ void conv_dense(const Frame& F, int part, int u0, int ustride) {
    bf16_t* WRKV = (bf16_t*)(F.ws + WS_WRKV); bf16_t* WO = (bf16_t*)(F.ws + WS_WO); bf16_t* WQKV = (bf16_t*)(F.ws + WS_WQKV); bf16_t* WSBO = (bf16_t*)(F.ws + WS_WSBO); bf16_t* WLDN = (bf16_t*)(F.ws + WS_WLDN);
    const float* const* in = F.in;
    const int gtid = u0 * NTHREADS + F.tid, gstride = ustride * NTHREADS;
    if (part == 0) {
        conv_tiles(F, 192 + 24, u0, ustride, [=](int u) {
            CTile c; c.dld = D; c.ncols = 128; c.scale = 1.0f;
            if (u < 192) { const int n = u / 64, kt = (u >> 3) & 7, nt = u & 7; c.src = in[I_WRKV] + (size_t)n * D * D + (size_t)kt * 128 * D + nt * 128; c.sld = D; c.dst = WRKV + ((size_t)n * D + nt * 128) * D + kt * 128; }
            else { const int v = u - 192, kt = v / 3, j = v % 3;
                if (j == 0) { c.src = in[I_WW1] + (size_t)kt * 128 * 64; c.sld = 64; c.dst = WLDN + kt * 128; c.ncols = 64; }
                else if (j == 1) { c.src = in[I_WA1] + (size_t)kt * 128 * 64; c.sld = 64; c.dst = WLDN + (size_t)64 * D + kt * 128; c.ncols = 64; }
                else { c.src = in[I_WG1] + (size_t)kt * 128 * 128; c.sld = 128; c.dst = WLDN + (size_t)128 * D + kt * 128; } }
            return c; });
        bf16_t* WLUP = (bf16_t*)(F.ws + WS_WLUP);
        for (int i = gtid; i < 1024 * 256; i += gstride) {
            float v;
            if (i < 1024 * 64) { const int n = i / 64, k = i % 64; v = F.in[I_WW2][k * D + n]; }
            else if (i < 2 * 1024 * 64) { const int j = i - 1024 * 64, n = j / 64, k = j % 64; v = F.in[I_WA2][k * D + n]; }
            else { const int j = i - 2 * 1024 * 64, n = j / 128, k = j % 128; v = F.in[I_WG2][k * D + n]; }
            WLUP[i] = f2bf(v);
        }
    } else {
        conv_tiles(F, 64 + 192 + 64, u0, ustride, [=](int u) {
            CTile c; c.dld = D; c.ncols = 128; c.scale = 1.0f;
            if (u < 64) { const int kt = u >> 3, nt = u & 7; c.src = in[I_WO] + (size_t)kt * 128 * D + nt * 128; c.sld = D; c.dst = WO + (size_t)nt * 128 * D + kt * 128; }
            else if (u < 256) { const int v = u - 64, kt = v / 24, nt = v % 24; c.src = in[I_SBQKV] + (size_t)kt * 128 * 3 * D + nt * 128; c.sld = 3 * D; c.dst = WQKV + (size_t)nt * 128 * D + kt * 128; }
            else { const int v = u - 256, kt = v >> 3, nt = v & 7; c.src = in[I_SBO] + (size_t)kt * 128 * D + nt * 128; c.sld = D; c.dst = WSBO + (size_t)nt * 128 * D + kt * 128; }
            return c; });
        bf16_t* WRT = (bf16_t*)(F.ws + WS_WRT);
        for (int i = gtid; i < 2 * 64 * 1024; i += gstride) {
            const int l = i / (64 * 1024), j = i % (64 * 1024), e = j / 1024, k = j % 1024;
            const float w = F.in[I_ROUTER][((size_t)l * D + k) * NE + e]; const bf16_t hi = f2bf(w), lo = f2bf(w - bf2f(hi));
            bf16_t* row = WRT + ((size_t)l * 64 + e) * 3072; row[k] = hi; row[1024 + k] = lo; row[2048 + k] = hi;
        }
    }
}

__device__ __forceinline__ unsigned pack_fp8x4(const f32x4& v) {
    const float lim = 440.0f;
    const float a = __builtin_amdgcn_fmed3f(v[0], -lim, lim), b = __builtin_amdgcn_fmed3f(v[1], -lim, lim), c = __builtin_amdgcn_fmed3f(v[2], -lim, lim), d = __builtin_amdgcn_fmed3f(v[3], -lim, lim);
    int w = __builtin_amdgcn_cvt_pk_fp8_f32(a, b, 0, false); w = __builtin_amdgcn_cvt_pk_fp8_f32(c, d, w, true); return (unsigned)w;
}
__device__ __forceinline__ void acc_fp8x16(float (&y)[16], const u32x4& w, float g) {
#pragma unroll
    for (int q = 0; q < 4; ++q) { const f32x2 lo = __builtin_amdgcn_cvt_pk_f32_fp8((int)w[q], false), hi = __builtin_amdgcn_cvt_pk_f32_fp8((int)w[q], true);
        y[4 * q] += g * lo.x; y[4 * q + 1] += g * lo.y; y[4 * q + 2] += g * hi.x; y[4 * q + 3] += g * hi.y; }
}
__device__ __forceinline__ void ph_mod(const Frame& F) {
    const float* c = F.in[I_C]; const float* W = F.in[I_ADAW]; const float* bias = F.in[I_ADAB];
    float* MOD = (float*)(F.ws + WS_MOD);
    float* red = F.ldsf;
    float* sc = F.ldsf + 1024;
    for (int i = F.tid; i < 2 * D; i += NTHREADS) { const float v = c[i]; sc[i] = v * sigmoidf_(v); }
    __syncthreads();
    for (int u = F.bid; u < 192; u += F.G) {
        const int l = u / 96, cg = u % 96, col = cg * 64 + F.lane;
        float s0 = 0.f, s1 = 0.f;
        const float* wp = W + ((size_t)l * D + F.wave * 128) * 6144 + col;
#pragma unroll 1
        for (int d0 = 0; d0 < 128; d0 += 32) {
            float wv[32];
#pragma unroll
            for (int d = 0; d < 32; ++d) wv[d] = wp[(size_t)(d0 + d) * 6144];
#pragma unroll
            for (int d = 0; d < 32; ++d) { const int dd = F.wave * 128 + d0 + d; s0 += sc[dd] * wv[d]; s1 += sc[D + dd] * wv[d]; }
        }
        red[(F.wave * 2 + 0) * 64 + F.lane] = s0; red[(F.wave * 2 + 1) * 64 + F.lane] = s1;
        __syncthreads();
        if (F.tid < 128) {
            const int b = F.tid >> 6, cc = F.tid & 63; float s = 0.f;
#pragma unroll
            for (int w = 0; w < 8; ++w) s += red[(w * 2 + b) * 64 + cc];
            MOD[(l * 2 + b) * 6144 + cg * 64 + cc] = s + bias[l * 6144 + cg * 64 + cc];
        }
        __syncthreads();
    }
}

__device__ __forceinline__ void ph_prenorm_rwkv(const Frame& F) {
    const float* x = F.in[I_X]; const float* g = F.in[I_NPM]; const float* mu = F.in[I_MU];
    const float* MOD = (const float*)(F.ws + WS_MOD);
    bf16_t* XS = (bf16_t*)(F.ws + WS_XS);
    constexpr int RUN_T = 8;
    const int nunits = T / RUN_T, c0 = 16 * F.lane;
    f32x4 m[6][4];
#pragma unroll
    for (int n = 0; n < 6; ++n)
#pragma unroll
        for (int i = 0; i < 4; ++i) m[n][i] = *(const f32x4*)(mu + n * D + c0 + 4 * i);
    for (int u = F.bid * NWAVES + F.wave; u < nunits; u += F.G * NWAVES) {
        const int t0 = u * RUN_T, b = t0 / SEQ;
        const float* shift = MOD + (0 * 2 + b) * 6144; const float* scale = shift + 1024;
        f32x4 gm[4], sh[4];
#pragma unroll
        for (int i = 0; i < 4; ++i) { const int c = c0 + 4 * i; const f32x4 gv = *(const f32x4*)(g + c), sc = *(const f32x4*)(scale + c); gm[i] = gv * (sc + 1.0f); sh[i] = *(const f32x4*)(shift + c); }
        f32x4 hp[4];
#pragma unroll
        for (int i = 0; i < 4; ++i) hp[i] = (f32x4){0.f, 0.f, 0.f, 0.f};
        const int tstart = (t0 % SEQ == 0) ? t0 : t0 - 1;
        for (int t = tstart; t < t0 + RUN_T; ++t) {
            f32x4 xv[4]; float ss = 0.f;
#pragma unroll
            for (int i = 0; i < 4; ++i) { xv[i] = *(const f32x4*)(x + (size_t)t * D + c0 + 4 * i); ss += xv[i][0] * xv[i][0] + xv[i][1] * xv[i][1] + xv[i][2] * xv[i][2] + xv[i][3] * xv[i][3]; }
            ss = wave_sum(ss);
            const float rs = rsqrtf(ss * (1.0f / D) + 1e-6f);
            f32x4 h[4];
#pragma unroll
            for (int i = 0; i < 4; ++i) h[i] = xv[i] * rs * gm[i] + sh[i];
            if (t >= t0) {
#pragma unroll
                for (int n = 0; n < 6; ++n) {
                    u32x4 w0, w1;
#pragma unroll
                    for (int i = 0; i < 4; ++i) {
                        const f32x4 v = h[i] + (hp[i] - h[i]) * m[n][i];
                        const unsigned a0 = pack2(v[0], v[1]), a1 = pack2(v[2], v[3]);
                        if (i == 0) { w0[0] = a0; w0[1] = a1; } else if (i == 1) { w0[2] = a0; w0[3] = a1; } else if (i == 2) { w1[0] = a0; w1[1] = a1; } else { w1[2] = a0; w1[3] = a1; }
                    }
                    bf16_t* dst = XS + ((size_t)n * T + t) * D + c0;
                    *(u32x4*)dst = w0; *(u32x4*)(dst + 8) = w1;
                }
            }
#pragma unroll
            for (int i = 0; i < 4; ++i) hp[i] = h[i];
        }
    }
}


template <bool XBF>
__device__ __forceinline__ void ph_postmix_preffn(const Frame& F, int layer, const float* xin, const bf16_t* Y) {
    const float* MOD = (const float*)(F.ws + WS_MOD);
    const float* gpo = F.in[I_NPOM] + layer * D; const float* gpf = F.in[I_NPF] + layer * D;
    bf16_t* H2 = (bf16_t*)(F.ws + WS_H2); bf16_t* H2LO = (bf16_t*)(F.ws + WS_H2LO); bf16_t* XR = (bf16_t*)(F.ws + WS_XR);
    const int c0 = 16 * F.lane;
    f32x4 gmp[4], gfs[4], shf[4]; int bcur = -1;
    for (int t = F.bid * NWAVES + F.wave; t < T; t += F.G * NWAVES) {
        const int b = t / SEQ;
        if (b != bcur) { bcur = b; const float* m = MOD + (layer * 2 + b) * 6144;
#pragma unroll
            for (int i = 0; i < 4; ++i) { const int c = c0 + 4 * i;
                gmp[i] = *(const f32x4*)(m + 2048 + c) * *(const f32x4*)(gpo + c);
                gfs[i] = *(const f32x4*)(gpf + c) * (*(const f32x4*)(m + 4096 + c) + 1.0f);
                shf[i] = *(const f32x4*)(m + 3072 + c); } }
        const u32x4 y0 = *(const u32x4*)(Y + (size_t)t * D + c0), y1 = *(const u32x4*)(Y + (size_t)t * D + c0 + 8);
        f32x4 xv[4];
        if (XBF) { const u32x4 a0 = *(const u32x4*)(XR + (size_t)t * D + c0), a1 = *(const u32x4*)(XR + (size_t)t * D + c0 + 8);
            xv[0] = (f32x4){lo2f(a0[0]), hi2f(a0[0]), lo2f(a0[1]), hi2f(a0[1])}; xv[1] = (f32x4){lo2f(a0[2]), hi2f(a0[2]), lo2f(a0[3]), hi2f(a0[3])};
            xv[2] = (f32x4){lo2f(a1[0]), hi2f(a1[0]), lo2f(a1[1]), hi2f(a1[1])}; xv[3] = (f32x4){lo2f(a1[2]), hi2f(a1[2]), lo2f(a1[3]), hi2f(a1[3])}; }
        else {
#pragma unroll
            for (int i = 0; i < 4; ++i) xv[i] = *(const f32x4*)(xin + (size_t)t * D + c0 + 4 * i); }
        f32x4 y[4];
        y[0] = (f32x4){lo2f(y0[0]), hi2f(y0[0]), lo2f(y0[1]), hi2f(y0[1])}; y[1] = (f32x4){lo2f(y0[2]), hi2f(y0[2]), lo2f(y0[3]), hi2f(y0[3])};
        y[2] = (f32x4){lo2f(y1[0]), hi2f(y1[0]), lo2f(y1[1]), hi2f(y1[1])}; y[3] = (f32x4){lo2f(y1[2]), hi2f(y1[2]), lo2f(y1[3]), hi2f(y1[3])};
        float ss = 0.f;
#pragma unroll
        for (int i = 0; i < 4; ++i) ss += y[i][0] * y[i][0] + y[i][1] * y[i][1] + y[i][2] * y[i][2] + y[i][3] * y[i][3];
        ss = wave_sum(ss);
        const float rs = rsqrtf(ss * (1.0f / D) + 1e-6f);
        f32x4 x1[4]; float s2 = 0.f;
#pragma unroll
        for (int i = 0; i < 4; ++i) { const int c = c0 + 4 * i;
            x1[i] = xv[i] + gmp[i] * (y[i] * rs);
            s2 += x1[i][0] * x1[i][0] + x1[i][1] * x1[i][1] + x1[i][2] * x1[i][2] + x1[i][3] * x1[i][3]; }
        { u32x4 r0, r1;
          r0[0] = pack2(x1[0][0], x1[0][1]); r0[1] = pack2(x1[0][2], x1[0][3]); r0[2] = pack2(x1[1][0], x1[1][1]); r0[3] = pack2(x1[1][2], x1[1][3]);
          r1[0] = pack2(x1[2][0], x1[2][1]); r1[1] = pack2(x1[2][2], x1[2][3]); r1[2] = pack2(x1[3][0], x1[3][1]); r1[3] = pack2(x1[3][2], x1[3][3]);
          *(u32x4*)(XR + (size_t)t * D + c0) = r0; *(u32x4*)(XR + (size_t)t * D + c0 + 8) = r1; }
        s2 = wave_sum(s2);
        const float rs2 = rsqrtf(s2 * (1.0f / D) + 1e-6f);
        u32x4 h0, h1, l0, l1;
#pragma unroll
        for (int i = 0; i < 4; ++i) {
            const f32x4 h = x1[i] * rs2 * gfs[i] + shf[i];
            const unsigned w0 = pack2(h[0], h[1]), w1 = pack2(h[2], h[3]);
            const unsigned v0 = pack2(h[0] - lo2f(w0), h[1] - hi2f(w0)), v1 = pack2(h[2] - lo2f(w1), h[3] - hi2f(w1));
            if (i == 0) { h0[0] = w0; h0[1] = w1; l0[0] = v0; l0[1] = v1; } else if (i == 1) { h0[2] = w0; h0[3] = w1; l0[2] = v0; l0[3] = v1; }
            else if (i == 2) { h1[0] = w0; h1[1] = w1; l1[0] = v0; l1[1] = v1; } else { h1[2] = w0; h1[3] = w1; l1[2] = v0; l1[3] = v1; }
        }
        *(u32x4*)(H2 + (size_t)t * D + c0) = h0; *(u32x4*)(H2 + (size_t)t * D + c0 + 8) = h1;
        *(u32x4*)(H2LO + (size_t)t * D + c0) = l0; *(u32x4*)(H2LO + (size_t)t * D + c0 + 8) = l1;
    }
}


template <bool XBF>
__device__ __forceinline__ void ph_postmix_route(const Frame& F, int layer, const float* xin, const bf16_t* Y) {
    const float* MOD = (const float*)(F.ws + WS_MOD);
    const float* gpo = F.in[I_NPOM] + layer * D; const float* gpf = F.in[I_NPF] + layer * D;
    bf16_t* H2 = (bf16_t*)(F.ws + WS_H2); bf16_t* XR = (bf16_t*)(F.ws + WS_XR);
    const bf16_t* WRT = (const bf16_t*)(F.ws + WS_WRT) + (size_t)layer * 64 * 3072;
    const float* rb = F.in[I_RBIAS] + layer * NE;
    int* IDX = (int*)(F.ws + WS_IDX); float* GATE = (float*)(F.ws + WS_GATE); int* RANK = (int*)(F.ws + WS_RANK); unsigned* BC = (unsigned*)(F.ws + WS_BC);
    constexpr int RS = 2064;
    LAS unsigned char* AH = F.lds; LAS unsigned char* AL = F.lds + 16 * RS;
    LAS float* PART = (LAS float*)(F.lds + 2 * 16 * RS);
    LAS float* VEC = PART + 8 * 16 * 64;
    LAS float* SL = VEC + 3 * 1024;
    LAS unsigned* lcnt = (LAS unsigned*)(SL + 8 * 8 * 64);
    const int lane = F.lane, w = F.wave, fr = lane & 15, fq = lane >> 4, c0 = 16 * lane;
    const bf16_t* const wfrag = WRT + (size_t)fr * 3072 + 128 * w + 8 * fq;
    const float bias = rb[lane];
    int bcur = -1;
    for (int g = F.bid; g < T / 64; g += F.G) {
        const int b = (g * 64) / SEQ;
        __syncthreads();
        if (b != bcur) { bcur = b; const float* m = MOD + (layer * 2 + b) * 6144;
            for (int c = F.tid; c < D; c += NTHREADS) { VEC[c] = m[2048 + c] * gpo[c]; VEC[1024 + c] = gpf[c] * (m[4096 + c] + 1.0f); VEC[2048 + c] = m[3072 + c]; } }
        if (F.tid < 64) lcnt[F.tid] = 0u;
        __syncthreads();
        bf16x8 bh[4][4];
        { const bf16_t* pw = wfrag; asm volatile("" : "+v"(pw));
#pragma unroll
          for (int n = 0; n < 4; ++n)
#pragma unroll
            for (int ks = 0; ks < 4; ++ks) bh[n][ks] = *(const bf16x8*)(pw + (size_t)n * 16 * 3072 + 32 * ks); }
        u32x4 y0v[2], y1v[2], a0v[2], a1v[2]; f32x4 xvv[2][4];
#define PR_LOAD_ROWS(tw_) do { _Pragma("unroll") for (int j = 0; j < 2; ++j) { const size_t ro = (size_t)((tw_) + j) * D + c0; \
            y0v[j] = *(const u32x4*)(Y + ro); y1v[j] = *(const u32x4*)(Y + ro + 8); \
            if (XBF) { a0v[j] = *(const u32x4*)(XR + ro); a1v[j] = *(const u32x4*)(XR + ro + 8); } \
            else { _Pragma("unroll") for (int i = 0; i < 4; ++i) xvv[j][i] = *(const f32x4*)(xin + ro + 4 * i); } } } while (0)
        PR_LOAD_ROWS(g * 64 + 2 * w);
#pragma unroll 1
        for (int sg = 0; sg < 4; ++sg) {
            const int tw = g * 64 + sg * 16 + 2 * w;
#pragma unroll
            for (int j = 0; j < 2; ++j) {
                const int t = tw + j;
                const u32x4 y0 = y0v[j], y1 = y1v[j];
                f32x4 xv[4], y[4];
                if (XBF) { const u32x4 a0 = a0v[j], a1 = a1v[j];
                    xv[0] = (f32x4){lo2f(a0[0]), hi2f(a0[0]), lo2f(a0[1]), hi2f(a0[1])}; xv[1] = (f32x4){lo2f(a0[2]), hi2f(a0[2]), lo2f(a0[3]), hi2f(a0[3])};
                    xv[2] = (f32x4){lo2f(a1[0]), hi2f(a1[0]), lo2f(a1[1]), hi2f(a1[1])}; xv[3] = (f32x4){lo2f(a1[2]), hi2f(a1[2]), lo2f(a1[3]), hi2f(a1[3])}; }
                else {
#pragma unroll
                    for (int i = 0; i < 4; ++i) xv[i] = xvv[j][i]; }
                y[0] = (f32x4){lo2f(y0[0]), hi2f(y0[0]), lo2f(y0[1]), hi2f(y0[1])}; y[1] = (f32x4){lo2f(y0[2]), hi2f(y0[2]), lo2f(y0[3]), hi2f(y0[3])};
                y[2] = (f32x4){lo2f(y1[0]), hi2f(y1[0]), lo2f(y1[1]), hi2f(y1[1])}; y[3] = (f32x4){lo2f(y1[2]), hi2f(y1[2]), lo2f(y1[3]), hi2f(y1[3])};
                float ss = 0.f;
#pragma unroll
                for (int i = 0; i < 4; ++i) ss += y[i][0] * y[i][0] + y[i][1] * y[i][1] + y[i][2] * y[i][2] + y[i][3] * y[i][3];
                ss = wave_sum(ss);
                const float rs = rsqrtf(ss * (1.0f / D) + 1e-6f);
                f32x4 x1[4]; float s2 = 0.f;
#pragma unroll
                for (int i = 0; i < 4; ++i) { const f32x4 gmp = *(const LAS f32x4*)(VEC + c0 + 4 * i);
                    x1[i] = xv[i] + gmp * (y[i] * rs);
                    s2 += x1[i][0] * x1[i][0] + x1[i][1] * x1[i][1] + x1[i][2] * x1[i][2] + x1[i][3] * x1[i][3]; }
                { u32x4 r0, r1;
                  r0[0] = pack2(x1[0][0], x1[0][1]); r0[1] = pack2(x1[0][2], x1[0][3]); r0[2] = pack2(x1[1][0], x1[1][1]); r0[3] = pack2(x1[1][2], x1[1][3]);
                  r1[0] = pack2(x1[2][0], x1[2][1]); r1[1] = pack2(x1[2][2], x1[2][3]); r1[2] = pack2(x1[3][0], x1[3][1]); r1[3] = pack2(x1[3][2], x1[3][3]);
                  *(u32x4*)(XR + (size_t)t * D + c0) = r0; *(u32x4*)(XR + (size_t)t * D + c0 + 8) = r1; }
                s2 = wave_sum(s2);
                const float rs2 = rsqrtf(s2 * (1.0f / D) + 1e-6f);
                u32x4 h0, h1, l0, l1;
#pragma unroll
                for (int i = 0; i < 4; ++i) { const f32x4 gfs = *(const LAS f32x4*)(VEC + 1024 + c0 + 4 * i), shf = *(const LAS f32x4*)(VEC + 2048 + c0 + 4 * i);
                    const f32x4 h = x1[i] * rs2 * gfs + shf;
                    const unsigned w0 = pack2(h[0], h[1]), w1 = pack2(h[2], h[3]);
                    const unsigned v0 = pack2(h[0] - lo2f(w0), h[1] - hi2f(w0)), v1 = pack2(h[2] - lo2f(w1), h[3] - hi2f(w1));
                    if (i == 0) { h0[0] = w0; h0[1] = w1; l0[0] = v0; l0[1] = v1; } else if (i == 1) { h0[2] = w0; h0[3] = w1; l0[2] = v0; l0[3] = v1; }
                    else if (i == 2) { h1[0] = w0; h1[1] = w1; l1[0] = v0; l1[1] = v1; } else { h1[2] = w0; h1[3] = w1; l1[2] = v0; l1[3] = v1; } }
                *(u32x4*)(H2 + (size_t)t * D + c0) = h0; *(u32x4*)(H2 + (size_t)t * D + c0 + 8) = h1;
                LAS unsigned char* rh = AH + (2 * w + j) * RS + lane * 32; LAS unsigned char* rl = AL + (2 * w + j) * RS + lane * 32;
                *(LAS u32x4*)rh = h0; *(LAS u32x4*)(rh + 16) = h1; *(LAS u32x4*)rl = l0; *(LAS u32x4*)(rl + 16) = l1;
            }
            __syncthreads();
            {
                f32x4 acc[4]; bf16x8 bl[4][4], ahf[4];
                { const bf16_t* pw = wfrag + 1024; asm volatile("" : "+v"(pw));
#pragma unroll
                  for (int n = 0; n < 4; ++n)
#pragma unroll
                    for (int ks = 0; ks < 4; ++ks) bl[n][ks] = *(const bf16x8*)(pw + (size_t)n * 16 * 3072 + 32 * ks); }
                { const int twn = g * 64 + (sg < 3 ? sg + 1 : sg) * 16 + 2 * w; PR_LOAD_ROWS(twn); }
#pragma unroll
                for (int n = 0; n < 4; ++n) acc[n] = (f32x4){0.f, 0.f, 0.f, 0.f};
#pragma unroll
                for (int ks = 0; ks < 4; ++ks) { const int ko = fr * RS + (128 * w + 32 * ks + 8 * fq) * 2;
                    const bf16x8 ah = *(const LAS bf16x8*)(AH + ko), al = *(const LAS bf16x8*)(AL + ko); ahf[ks] = ah;
#pragma unroll
                    for (int n = 0; n < 4; ++n) { acc[n] = __builtin_amdgcn_mfma_f32_16x16x32_bf16(bh[n][ks], ah, acc[n], 0, 0, 0);
                        acc[n] = __builtin_amdgcn_mfma_f32_16x16x32_bf16(bh[n][ks], al, acc[n], 0, 0, 0); } }
#pragma unroll
                for (int ks = 0; ks < 4; ++ks)
#pragma unroll
                    for (int n = 0; n < 4; ++n) acc[n] = __builtin_amdgcn_mfma_f32_16x16x32_bf16(bl[n][ks], ahf[ks], acc[n], 0, 0, 0);
#pragma unroll
                for (int n = 0; n < 4; ++n) *(LAS f32x4*)(PART + (w * 16 + fr) * 64 + 16 * n + 4 * fq) = acc[n];
            }
            __syncthreads();
#pragma unroll
            for (int j = 0; j < 2; ++j) { float v = 0.f;
#pragma unroll
                for (int ww = 0; ww < 8; ++ww) v += PART[(ww * 16 + 2 * w + j) * 64 + lane];
                SL[(w * 8 + 2 * sg + j) * 64 + lane] = sigmoidf_(v); }
        }
#undef PR_LOAD_ROWS
        float s[8], sel[8], tot[8], mysc[8]; int myidx[8]; unsigned lrank[8];
#pragma unroll
        for (int j = 0; j < 8; ++j) { s[j] = SL[(w * 8 + j) * 64 + lane]; sel[j] = s[j] + bias; tot[j] = 0.f; mysc[j] = 0.f; myidx[j] = 0; }
#pragma unroll
        for (int k = 0; k < TOPK; ++k) {
            float bv[8]; int bi[8];
#pragma unroll
            for (int j = 0; j < 8; ++j) { bv[j] = sel[j]; bi[j] = lane; }
#pragma unroll
            for (int o = 32; o >= 1; o >>= 1) {
#pragma unroll
                for (int j = 0; j < 8; ++j) { const float ov = __shfl_xor(bv[j], o); const int oi = __shfl_xor(bi[j], o); const bool take = (ov > bv[j]) | ((ov == bv[j]) & (oi < bi[j])); bv[j] = take ? ov : bv[j]; bi[j] = take ? oi : bi[j]; }
            }
#pragma unroll
            for (int j = 0; j < 8; ++j) { const float sc = __shfl(s[j], bi[j]); tot[j] += sc; const bool me = (lane == k); myidx[j] = me ? bi[j] : myidx[j]; mysc[j] = me ? sc : mysc[j]; sel[j] = (lane == bi[j]) ? -1e30f : sel[j]; }
        }
#pragma unroll
        for (int j = 0; j < 8; ++j) { const int t = g * 64 + 16 * (j >> 1) + 2 * w + (j & 1); lrank[j] = 0u;
            if (lane < TOPK) { IDX[t * TOPK + lane] = myidx[j]; GATE[t * TOPK + lane] = 2.5f * mysc[j] / tot[j]; lrank[j] = atomicAdd((unsigned*)&lcnt[myidx[j]], 1u); } }
        __syncthreads();
        if (F.tid < 64) BC[g * 64 + F.tid] = lcnt[F.tid];
#pragma unroll
        for (int j = 0; j < 8; ++j) { const int t = g * 64 + 16 * (j >> 1) + 2 * w + (j & 1); if (lane < TOPK) RANK[t * TOPK + lane] = (int)lrank[j]; }
    }
}

__device__ __forceinline__ void ph_topk(const Frame& F, int layer) {
    const float* LOG = (const float*)(F.ws + WS_LOGITS); const float* rb = F.in[I_RBIAS] + layer * NE;
    int* IDX = (int*)(F.ws + WS_IDX); float* GATE = (float*)(F.ws + WS_GATE); int* RANK = (int*)(F.ws + WS_RANK);
    unsigned* BC = (unsigned*)(F.ws + WS_BC);
    unsigned* lcnt = (unsigned*)F.ldsf;
    const float bias = rb[F.lane];
    for (int base = F.bid * 64; base < T; base += F.G * 64) {
        if (F.tid < 64) lcnt[F.tid] = 0u;
        __syncthreads();
        float s[8], sel[8], tot[8], mysc[8]; int myidx[8]; unsigned lrank[8];
#pragma unroll
        for (int j = 0; j < 8; ++j) { const size_t o = (size_t)(base + F.wave * 8 + j) * NE + F.lane;
            s[j] = sigmoidf_(LOG[o] + LOG[(size_t)T * NE + o] + LOG[(size_t)2 * T * NE + o]); sel[j] = s[j] + bias; tot[j] = 0.f; mysc[j] = 0.f; myidx[j] = 0; }
#pragma unroll
        for (int k = 0; k < TOPK; ++k) {
            float bv[8]; int bi[8];
#pragma unroll
            for (int j = 0; j < 8; ++j) { bv[j] = sel[j]; bi[j] = F.lane; }
#pragma unroll
            for (int o = 32; o >= 1; o >>= 1) {
#pragma unroll
                for (int j = 0; j < 8; ++j) { const float ov = __shfl_xor(bv[j], o); const int oi = __shfl_xor(bi[j], o); const bool take = (ov > bv[j]) | ((ov == bv[j]) & (oi < bi[j]));     bv[j] = take ? ov : bv[j]; bi[j] = take ? oi : bi[j]; }
            }
#pragma unroll
            for (int j = 0; j < 8; ++j) { const float sc = __shfl(s[j], bi[j]); tot[j] += sc; const bool me = (F.lane == k); myidx[j] = me ? bi[j] : myidx[j]; mysc[j] = me ? sc : mysc[j]; sel[j] = (F.lane == bi[j]) ? -1e30f : sel[j]; }
        }
#pragma unroll
        for (int j = 0; j < 8; ++j) { const int t = base + F.wave * 8 + j; lrank[j] = 0u;
            if (F.lane < TOPK) { IDX[t * TOPK + F.lane] = myidx[j]; GATE[t * TOPK + F.lane] = 2.5f * mysc[j] / tot[j]; lrank[j] = atomicAdd(&lcnt[myidx[j]], 1u); } }
        __syncthreads();
        if (F.tid < 64) BC[(base >> 6) * 64 + F.tid] = lcnt[F.tid];
#pragma unroll
        for (int j = 0; j < 8; ++j) { const int t = base + F.wave * 8 + j; if (F.lane < TOPK) RANK[t * TOPK + F.lane] = (int)lrank[j]; }
        __syncthreads();
    }
}

__device__ __forceinline__ void ph_offsets(const Frame& F, int layer) {
    const unsigned* BC = (const unsigned*)(F.ws + WS_BC);
    const int* IDX = (const int*)(F.ws + WS_IDX); const int* RANK = (const int*)(F.ws + WS_RANK);
    int* POS = (int*)(F.ws + WS_POS); int* TOK = (int*)(F.ws + WS_TOK); int* TILEE = (int*)(F.ws + WS_TILEE); int* START = (int*)(F.ws + WS_START);
    int* sst = (int*)F.ldsf;
    constexpr int NG = T / 64;
    for (int g = F.bid; g < NG; g += F.G) {
        { const int e = F.tid & 63, part = F.tid >> 6; int tot = 0, pre = 0;
          for (int gg = part; gg < NG; gg += 8) { const int v = (int)BC[gg * 64 + e]; tot += v; if (gg < g) pre += v; }
          sst[512 + part * 64 + e] = tot; sst[1024 + part * 64 + e] = pre; }
        __syncthreads();
        if (F.tid < 64) { int tot = 0, pre = 0;
#pragma unroll
            for (int q = 0; q < 8; ++q) { tot += sst[512 + q * 64 + F.tid]; pre += sst[1024 + q * 64 + F.tid]; }
            sst[128 + F.tid] = tot; sst[256 + F.tid] = pre; }
        __syncthreads();
        if (F.tid == 0) { int acc = 0; for (int e = 0; e < NE; ++e) { const int c = sst[128 + e]; sst[e] = acc; acc += ((c + RP - 1) / RP) * RP; } sst[64] = acc; }
        __syncthreads();
        if (g == 0) {
            if (F.tid <= 64) START[F.tid] = sst[F.tid];
            if (F.tid == 65) START[65] = sst[64];
        }
        if (g == (NG > 1 ? 1 : 0)) { if (F.tid < NE) for (int i = sst[F.tid] / RP; i < sst[F.tid + 1] / RP; ++i) TILEE[i] = F.tid; }
        for (int e = (g + NG - 2) % NG; e < NE; e += NG) { const int c = sst[128 + e], lo = sst[e] + c, hi = sst[e + 1]; for (int r = lo + F.tid; r < hi; r += NTHREADS) TOK[r] = 0; }
        { const int sl = g * 64 * TOPK + F.tid;
          const int e = IDX[sl], p = sst[e] + sst[256 + e] + RANK[sl];
          POS[sl] = p; TOK[p] = sl / TOPK; }
        __syncthreads();
    }
}

__device__ __forceinline__ void ph_combine(const Frame& F, int layer, bool next) {
    const unsigned char* YB = (const unsigned char*)(F.ws + WS_YB); const int* POS = (const int*)(F.ws + WS_POS); const float* GATE = (const float*)(F.ws + WS_GATE);
    const int* START = (const int*)(F.ws + WS_START); const float* MOD = (const float*)(F.ws + WS_MOD);
    const float* gpo = F.in[I_NPOF] + layer * D;
    bf16_t* H3 = (bf16_t*)(F.ws + WS_H3); bf16_t* XR = (bf16_t*)(F.ws + WS_XR);
    const int routed = START[65], c0 = 16 * F.lane;
    f32x4 gmp[4], gfs[4], shf[4]; int bcur = -1;
    for (int t = F.bid * NWAVES + F.wave; t < T; t += F.G * NWAVES) {
        const int b = t / SEQ;
        if (b != bcur) { bcur = b; const float* m = MOD + (layer * 2 + b) * 6144;
#pragma unroll
            for (int i = 0; i < 4; ++i) { const int c = c0 + 4 * i; gmp[i] = *(const f32x4*)(m + 5120 + c) * *(const f32x4*)(gpo + c);
                if (next) { const float* m1 = MOD + ((layer + 1) * 2 + b) * 6144; const float* g1 = F.in[I_NPM] + (layer + 1) * D;
                    gfs[i] = *(const f32x4*)(g1 + c) * (*(const f32x4*)(m1 + 1024 + c) + 1.0f); shf[i] = *(const f32x4*)(m1 + c); } } }
        int pos[TOPK]; float gk[TOPK];
        { const u32x4 p0 = *(const u32x4*)(POS + t * TOPK), p1 = *(const u32x4*)(POS + t * TOPK + 4); const f32x4 g0 = *(const f32x4*)(GATE + t * TOPK), g1 = *(const f32x4*)(GATE + t * TOPK + 4);
#pragma unroll
          for (int k = 0; k < 4; ++k) { pos[k] = (int)p0[k]; pos[4 + k] = (int)p1[k]; gk[k] = g0[k]; gk[4 + k] = g1[k]; } }
        u32x4 rw[TOPK + 1];
        rw[TOPK] = *(const u32x4*)(YB + (size_t)(routed + t) * D + c0);
#pragma unroll
        for (int k = 0; k < TOPK; ++k) rw[k] = *(const u32x4*)(YB + (size_t)pos[k] * D + c0);
        float y[16];
#pragma unroll
        for (int e = 0; e < 16; ++e) y[e] = 0.f;
        acc_fp8x16(y, rw[TOPK], 1.0f / YB_SCALE);
#pragma unroll
        for (int k = 0; k < TOPK; ++k) acc_fp8x16(y, rw[k], gk[k] * (1.0f / YB_SCALE));
        float ss = 0.f;
#pragma unroll
        for (int e = 0; e < 16; ++e) ss += y[e] * y[e];
        ss = wave_sum(ss);
        const float rs = rsqrtf(ss * (1.0f / D) + 1e-6f);
        f32x4 x2[4]; float s2 = 0.f;
        const u32x4 a0 = *(const u32x4*)(XR + (size_t)t * D + c0), a1 = *(const u32x4*)(XR + (size_t)t * D + c0 + 8);
#pragma unroll
        for (int i = 0; i < 4; ++i) { const int c = c0 + 4 * i;
            const unsigned wa = (i < 2) ? a0[2 * (i & 1)] : a1[2 * (i & 1)], wb = (i < 2) ? a0[2 * (i & 1) + 1] : a1[2 * (i & 1) + 1];
            const f32x4 xv = {lo2f(wa), hi2f(wa), lo2f(wb), hi2f(wb)};
            const f32x4 yv = {y[4 * i], y[4 * i + 1], y[4 * i + 2], y[4 * i + 3]};
            x2[i] = xv + gmp[i] * (yv * rs);
            if (!next) *(f32x4*)(F.out + (size_t)t * D + c) = x2[i];
            s2 += x2[i][0] * x2[i][0] + x2[i][1] * x2[i][1] + x2[i][2] * x2[i][2] + x2[i][3] * x2[i][3]; }
        if (next) {
            { u32x4 r0, r1;
              r0[0] = pack2(x2[0][0], x2[0][1]); r0[1] = pack2(x2[0][2], x2[0][3]); r0[2] = pack2(x2[1][0], x2[1][1]); r0[3] = pack2(x2[1][2], x2[1][3]);
              r1[0] = pack2(x2[2][0], x2[2][1]); r1[1] = pack2(x2[2][2], x2[2][3]); r1[2] = pack2(x2[3][0], x2[3][1]); r1[3] = pack2(x2[3][2], x2[3][3]);
              *(u32x4*)(XR + (size_t)t * D + c0) = r0; *(u32x4*)(XR + (size_t)t * D + c0 + 8) = r1; }
            s2 = wave_sum(s2);
            const float rs2 = rsqrtf(s2 * (1.0f / D) + 1e-6f);
            u32x4 h0, h1;
#pragma unroll
            for (int i = 0; i < 4; ++i) {
                const f32x4 h = x2[i] * rs2 * gfs[i] + shf[i];
                const unsigned w0 = pack2(h[0], h[1]), w1 = pack2(h[2], h[3]);
                if (i == 0) { h0[0] = w0; h0[1] = w1; } else if (i == 1) { h0[2] = w0; h0[3] = w1; } else if (i == 2) { h1[0] = w0; h1[1] = w1; } else { h1[2] = w0; h1[3] = w1; } }
            *(u32x4*)(H3 + (size_t)t * D + c0) = h0; *(u32x4*)(H3 + (size_t)t * D + c0 + 8) = h1;
        }
    }
}

#define SB_EXIT 110.0f

namespace pgx {
__device__ __forceinline__ int perm32(int rho) { const int n = rho >> 4, i = rho & 15; return 8 * (i >> 2) + 4 * n + (i & 3); }
struct Unit { const char* A; const int* tok; const char* B; int r0, c0, aux; };
template <bool SW, bool PERM, class Sched, class Epi>
__device__ __forceinline__ void gemm_phase(LAS unsigned char* lds, const int K, const unsigned lda  , const Sched& S, const Epi& E) {
    int tid_ = threadIdx.x; asm volatile("" : "+v"(tid_));
    const int tid = tid_, wid = __builtin_amdgcn_readfirstlane(tid >> 6), lane = tid & 63, wr = wid >> 2, wc = wid & 3, fr = lane & 15, fq = lane >> 4;
    const int nt = K / 64;
    int Rr[2], Cc[2]; unsigned voffB[2];
#pragma unroll
    for (int i = 0; i < 2; ++i) { stage_rc(tid * 16 + i * 8192, Rr[i], Cc[i]); const int Rb = PERM ? ((Rr[i] & ~31) + perm32(Rr[i] & 31)) : Rr[i]; voffB[i] = (unsigned)(Rb * K + Cc[i]) * 2u; }
    const size_t kstep = 128, hstepB = (size_t)128 * K * 2;
    const unsigned ldsw = (unsigned)wid * 1024u;
    const int aoff = lds_byte(wr * 64 + fr, fq * 8), boff = lds_byte(wc * 32 + fr, fq * 8);
#define PX_SA(b, h) (((b) * 2 + (h)) * HTB)
#define PX_SB(b, h) ((4 + (b) * 2 + (h)) * HTB)
#define PX_STAGE(bufoff, gbase, voff) do { _Pragma("unroll") for (int _i = 0; _i < 2; ++_i) \
        __builtin_amdgcn_global_load_lds((const unsigned*)((const char*)(gbase) + (voff)[_i]), (LAS unsigned*)(lds + (bufoff) + ldsw + _i * 8192), 16, 0, 0); } while (0)
#define PX_LDA(dst, b, h) do { _Pragma("unroll") for (int m = 0; m < 4; ++m) _Pragma("unroll") for (int k = 0; k < 2; ++k) dst[m][k] = *(const LAS bf16x8*)(lds + PX_SA(b, h) + aoff + m * 2048 + k * 1024); } while (0)
#define PX_LDB(dst, b, h) do { _Pragma("unroll") for (int n = 0; n < 2; ++n) _Pragma("unroll") for (int k = 0; k < 2; ++k) dst[n][k] = *(const LAS bf16x8*)(lds + PX_SB(b, h) + boff + n * 2048 + k * 1024); } while (0)
#define PX_MMA(ai, bj, At, Bt) do { __builtin_amdgcn_s_setprio(1); _Pragma("unroll") for (int m = 0; m < 4; ++m) _Pragma("unroll") for (int n = 0; n < 2; ++n) _Pragma("unroll") for (int k = 0; k < 2; ++k) \
        acc[ai][bj][m][n] = SW ? __builtin_amdgcn_mfma_f32_16x16x32_bf16(Bt[n][k], At[m][k], acc[ai][bj][m][n], 0, 0, 0) : __builtin_amdgcn_mfma_f32_16x16x32_bf16(At[m][k], Bt[n][k], acc[ai][bj][m][n], 0, 0, 0); __builtin_amdgcn_s_setprio(0); } while (0)
#define PX_WAIT_L(n) asm volatile("s_waitcnt lgkmcnt(" #n ")" ::: "memory")
#define PX_BAR __builtin_amdgcn_s_barrier()
#define PX_SCHED __builtin_amdgcn_sched_barrier(0)
#define PX_OFFS(dst, un) do { _Pragma("unroll") for (int h_ = 0; h_ < 2; ++h_) _Pragma("unroll") for (int i_ = 0; i_ < 2; ++i_) { \
        const int row_ = h_ * 128 + Rr[i_]; const unsigned rid_ = (un).tok ? (unsigned)(un).tok[row_] : (unsigned)row_; dst[h_][i_] = rid_ * lda + (unsigned)Cc[i_] * 2u; } } while (0)
    Unit cur, nxt; int ui = 0;
    if (!S.next(0, cur)) return;
    f32x4 acc[2][2][4][2];
#pragma unroll
    for (int a = 0; a < 2; ++a)
#pragma unroll
        for (int b = 0; b < 2; ++b)
#pragma unroll
            for (int m = 0; m < 4; ++m)
#pragma unroll
                for (int n = 0; n < 2; ++n) acc[a][b][m][n] = (f32x4){0.f, 0.f, 0.f, 0.f};
    bf16x8 At[4][2], B0[2][2], B1[2][2];
    unsigned oc[2][2], on[2][2];
    PX_OFFS(oc, cur); asm volatile("" : "+v"(oc[0][0]), "+v"(oc[0][1]), "+v"(oc[1][0]), "+v"(oc[1][1]));
    const char* cA = cur.A; const char* cB = cur.B;
    PX_STAGE(PX_SB(0, 0), cB, voffB); PX_STAGE(PX_SA(0, 0), cA, oc[0]); PX_STAGE(PX_SB(0, 1), cB + hstepB, voffB); PX_STAGE(PX_SA(0, 1), cA, oc[1]);
    if (wr == 1) PX_BAR;
    WAIT_V(4); PX_BAR;
    PX_STAGE(PX_SB(1, 0), cB + kstep, voffB); PX_STAGE(PX_SA(1, 0), cA + kstep, oc[0]); PX_STAGE(PX_SB(1, 1), cB + hstepB + kstep, voffB);
    WAIT_V(6); PX_BAR;
    for (;;) {
        const bool has_next = S.next(ui + 1, nxt);
        const char* nA = has_next ? nxt.A : cA; const char* nB = has_next ? nxt.B : cB;
        if (has_next) { PX_OFFS(on, nxt); asm volatile("" : "+v"(on[0][0]), "+v"(on[0][1]), "+v"(on[1][0]), "+v"(on[1][1])); } else {
#pragma unroll
            for (int h_ = 0; h_ < 2; ++h_)
#pragma unroll
                for (int i_ = 0; i_ < 2; ++i_) on[h_][i_] = oc[h_][i_]; }
#pragma unroll 1
        for (int t = 0; t < nt; t += 2) {
            const bool last = (t == nt - 2);
            const char* a1 = cA + (size_t)(t + 1) * kstep;
            const char* a2 = last ? nA : cA + (size_t)(t + 2) * kstep; const char* b2 = last ? nB : cB + (size_t)(t + 2) * kstep;
            const char* a3 = a2 + kstep; const char* b3 = b2 + kstep;
            unsigned o2[2][2];
#pragma unroll
            for (int h_ = 0; h_ < 2; ++h_)
#pragma unroll
                for (int i_ = 0; i_ < 2; ++i_) o2[h_][i_] = last ? on[h_][i_] : oc[h_][i_];
            PX_LDB(B0, 0, 0); PX_SCHED; PX_LDA(At, 0, 0); PX_STAGE(PX_SA(1, 1), a1, oc[1]);
            PX_WAIT_L(8); PX_BAR; PX_WAIT_L(0); PX_MMA(0, 0, At, B0); PX_BAR; PX_SCHED;
            PX_LDB(B1, 0, 1); PX_STAGE(PX_SB(0, 0), b2, voffB);
            PX_BAR; PX_WAIT_L(0); PX_MMA(0, 1, At, B1); PX_BAR;
            PX_LDA(At, 0, 1); PX_STAGE(PX_SA(0, 0), a2, o2[0]);
            PX_BAR; PX_WAIT_L(0); PX_MMA(1, 0, At, B0); PX_BAR; PX_SCHED;
            PX_STAGE(PX_SB(0, 1), b2 + hstepB, voffB);
            WAIT_V(6); PX_BAR; PX_MMA(1, 1, At, B1); PX_BAR;
            PX_LDB(B0, 1, 0); PX_SCHED; PX_LDA(At, 1, 0); PX_STAGE(PX_SA(0, 1), a2, o2[1]);
            PX_WAIT_L(8); PX_BAR; PX_WAIT_L(0); PX_MMA(0, 0, At, B0); PX_BAR; PX_SCHED;
            PX_LDB(B1, 1, 1); PX_STAGE(PX_SB(1, 0), b3, voffB);
            PX_BAR; PX_WAIT_L(0); PX_MMA(0, 1, At, B1); PX_BAR;
            PX_LDA(At, 1, 1); PX_STAGE(PX_SA(1, 0), a3, o2[0]);
            PX_BAR; PX_WAIT_L(0); PX_MMA(1, 0, At, B0); PX_BAR; PX_SCHED;
            PX_STAGE(PX_SB(1, 1), b3 + hstepB, voffB);
            WAIT_V(6); PX_BAR; PX_MMA(1, 1, At, B1); PX_BAR;
        }
        E(acc, cur, wr, wc, fr, fq);
        if (!has_next) break;
#pragma unroll
        for (int a = 0; a < 2; ++a)
#pragma unroll
            for (int b = 0; b < 2; ++b)
#pragma unroll
                for (int m = 0; m < 4; ++m)
#pragma unroll
                    for (int n = 0; n < 2; ++n) acc[a][b][m][n] = (f32x4){0.f, 0.f, 0.f, 0.f};
        cur = nxt; cA = nA; cB = nB; ++ui;
#pragma unroll
        for (int h_ = 0; h_ < 2; ++h_)
#pragma unroll
            for (int i_ = 0; i_ < 2; ++i_) oc[h_][i_] = on[h_][i_];
    }
    WAIT_V(0);
    if (wr == 0) PX_BAR;
    PX_BAR;
#undef PX_SA
#undef PX_SB
#undef PX_STAGE
#undef PX_LDA
#undef PX_LDB
#undef PX_MMA
#undef PX_WAIT_L
#undef PX_BAR
#undef PX_SCHED
#undef PX_OFFS
}
__device__ __forceinline__ unsigned cvt_pk_bf16(float lo, float hi) { return pack2(lo, hi); }
}

__device__ __forceinline__ size_t hm_off(int t, int c) { return ((size_t)((t / SEQ) * NH + (c >> 6)) * SEQ + (t % SEQ)) * 64 + (c & 63); }
#define EPI_MT(acc) (int)(sizeof(acc) / sizeof(acc[0]))
__device__ __forceinline__ void st_bf4(bf16_t* p, const f32x4& v) { u32x2 w; w.x = pack2(v[0], v[1]); w.y = pack2(v[2], v[3]); *(u32x2*)p = w; }

__device__ __forceinline__ void ph_lora_up_sg(const Frame& F) {
    const bf16_t* LORA = (const bf16_t*)(F.ws + WS_LORA); const bf16_t* WLUP = (const bf16_t*)(F.ws + WS_WLUP);
    bf16_t* LD = (bf16_t*)(F.ws + WS_LD); bf16_t* AA = (bf16_t*)(F.ws + WS_AA); bf16_t* GG = (bf16_t*)(F.ws + WS_GG);
    f32x4 w0v[4], a0v[4]; int pcol = -1;
    SgChain ch; ch.ph = 0; ch.pre = false;
    for (int u = F.bid; u < 3 * 64 * 8; u += F.G) {
        const int which = u / 512, v = u % 512, mt = v / 8, col0 = (v % 8) * 128;
        if (col0 != pcol) { pcol = col0;
#pragma unroll
            for (int q = 0; q < 4; ++q) { const int c = (F.wave & 1) * 64 + 16 * q + 4 * (F.lane >> 4); w0v[q] = *(const f32x4*)(F.in[I_W0] + col0 + c); a0v[q] = *(const f32x4*)(F.in[I_A0] + col0 + c); } }
        const int K = which == 2 ? 128 : 64, koff = which * 64;
        ASeg A; A.p[0] = LORA + (size_t)mt * 256 * 256 + koff; A.p[1] = A.p[0]; A.p[2] = A.p[0]; A.segTiles = 4;
        const bf16_t* Bt = WLUP + (which == 0 ? 0 : (which == 1 ? 1024 * 64 : 2 * 1024 * 64)) + (size_t)col0 * K;
        bf16_t* const outp = which == 0 ? LD : (which == 1 ? AA : GG);
        { const int un = u + F.G; ch.nvalid = un < 3 * 64 * 8;
          const int wn_ = un / 512, vn = un % 512, mn = vn / 8, cn = (vn % 8) * 128, Kn = wn_ == 2 ? 128 : 64;
          ch.nA.p[0] = LORA + (size_t)mn * 256 * 256 + wn_ * 64; ch.nA.p[1] = ch.nA.p[0]; ch.nA.p[2] = ch.nA.p[0]; ch.nA.segTiles = 4;
          ch.nBt = WLUP + (wn_ == 0 ? 0 : (wn_ == 1 ? 1024 * 64 : 2 * 1024 * 64)) + (size_t)cn * Kn; ch.nldb = Kn; }
        sg_tile<128>(F.lds, A, [](int R) { return (unsigned)R * 512u; }, Bt, K, K / 64,
            [&](auto& acc, int r0, int c0, int fr, int fq) {
                bf16_t* const ob = outp + hm_off(mt * 256 + r0 + fr, col0 + c0 + 4 * fq);
                if (which == 0) {
#pragma unroll
                    for (int m = 0; m < EPI_MT(acc); ++m)
#pragma unroll
                        for (int q = 0; q < 4; ++q) { f32x4 r;
#pragma unroll
                            for (int e = 0; e < 4; ++e) r[e] = -0.6065306597126334f * sigmoidf_(w0v[q][e] + acc[m][q][e]);
                            st_bf4(ob + m * 1024 + q * 16, r); }
                } else if (which == 1) {
#pragma unroll
                    for (int m = 0; m < EPI_MT(acc); ++m)
#pragma unroll
                        for (int q = 0; q < 4; ++q) { f32x4 r;
#pragma unroll
                            for (int e = 0; e < 4; ++e) r[e] = sigmoidf_(a0v[q][e] + acc[m][q][e]);
                            st_bf4(ob + m * 1024 + q * 16, r); }
                } else {
#pragma unroll
                    for (int m = 0; m < EPI_MT(acc); ++m)
#pragma unroll
                        for (int q = 0; q < 4; ++q) st_bf4(ob + m * 1024 + q * 16, acc[m][q]);
                }
            }, BRowId(), &ch);
    }
}
__device__ __forceinline__ void ph_router_sg(const Frame& F, int layer) {
    const bf16_t* H2 = (const bf16_t*)(F.ws + WS_H2); const bf16_t* H2LO = (const bf16_t*)(F.ws + WS_H2LO);
    const bf16_t* WRT = (const bf16_t*)(F.ws + WS_WRT) + (size_t)layer * 64 * 3072; float* LOG = (float*)(F.ws + WS_LOGITS);
    for (int u = F.bid; u < 64 * 3; u += F.G) {
        const int mt = u / 3, sgi = u % 3;
        ASeg A; A.p[0] = (sgi == 2 ? H2LO : H2) + (size_t)mt * 256 * D; A.p[1] = A.p[0]; A.p[2] = A.p[0]; A.segTiles = 16;
        float* out = LOG + (size_t)sgi * T * NE;
        sg_tile<64>(F.lds, A, [](int R) { return (unsigned)R * (D * 2); }, WRT + sgi * 1024, 3072, 16,
            [&](auto& acc, int r0, int c0, int fr, int fq) {
#pragma unroll
                for (int m = 0; m < EPI_MT(acc); ++m)
#pragma unroll
                    for (int q = 0; q < 4; ++q) *(f32x4*)(out + (size_t)(mt * 256 + r0 + 16 * m + fr) * NE + c0 + 16 * q + 4 * fq) = acc[m][q];
            });
    }
}

constexpr int MS = 72;
constexpr int SLOT = 64 * MS * 2;
__device__ __forceinline__ int ms_off(int row, int col) { return row * MS + col; }
constexpr size_t WS_BONUS = 3 * MiB;
constexpr size_t WS_RP = WS_BIG + 128 * MiB;
constexpr size_t WS_OL = WS_BIG + 160 * MiB;
constexpr size_t WS_G2 = WS_BIG + 296 * MiB;
constexpr size_t WS_DM = WS_BIG + 328 * MiB;
constexpr size_t WS_ST = WS_BIG + 360 * MiB;

__device__ __forceinline__ void st4_lds(LAS bf16_t* p, const f32x4& v) { u32x2 w; w.x = pack2(v[0], v[1]); w.y = pack2(v[2], v[3]); *(LAS u32x2*)p = w; }
__device__ __forceinline__ f32x4 ld4_lds(const LAS bf16_t* p) { const u32x2 w = *(const LAS u32x2*)p; return (f32x4){lo2f(w.x), hi2f(w.x), lo2f(w.y), hi2f(w.y)}; }

__device__ __forceinline__ void ph_wkv_chunk(const Frame& F) {
    const bf16_t* RKV = (const bf16_t*)(F.ws + WS_RKV); const bf16_t* LD = (const bf16_t*)(F.ws + WS_LD); const bf16_t* AA = (const bf16_t*)(F.ws + WS_AA);
    const bf16_t* Rb = RKV; const bf16_t* Kb = RKV + (size_t)T * D; const bf16_t* Vb = RKV + (size_t)2 * T * D;
    bf16_t* RP = (bf16_t*)(F.ws + WS_RP); bf16_t* OL = (bf16_t*)(F.ws + WS_OL); bf16_t* G2 = (bf16_t*)(F.ws + WS_G2); bf16_t* DM = (bf16_t*)(F.ws + WS_DM);
    float* BONUS = (float*)(F.ws + WS_BONUS);
#define SL(k) ((LAS bf16_t*)(F.lds + (k) * SLOT))
#define AT(k, r, c) (SL(k) + ms_off((r), (c)))
    LAS float* segtot = (LAS float*)(F.lds + 15 * SLOT);
    LAS float* WCs = segtot + 512;
    const int w = F.wave, lane = F.lane, fr = lane & 15, fq = lane >> 4, mt = w >> 1, ntb = 2 * (w & 1);
#define W1_ISSUE(cn_) do { const size_t on_ = (size_t)(cn_) * 4096 + (size_t)F.tid * 8; const unsigned lw_ = (unsigned)w * 1024u; \
        __builtin_amdgcn_global_load_lds((const unsigned*)(Rb + on_), (LAS unsigned*)(F.lds + 1 * SLOT + lw_), 16, 0, 0); \
        __builtin_amdgcn_global_load_lds((const unsigned*)(Kb + on_), (LAS unsigned*)(F.lds + 4 * SLOT + lw_), 16, 0, 0); \
        __builtin_amdgcn_global_load_lds((const unsigned*)(Vb + on_), (LAS unsigned*)(F.lds + 6 * SLOT + lw_), 16, 0, 0); \
        __builtin_amdgcn_global_load_lds((const unsigned*)(AA + on_), (LAS unsigned*)(F.lds + 10 * SLOT + lw_), 16, 0, 0); \
        __builtin_amdgcn_global_load_lds((const unsigned*)(LD + on_), (LAS unsigned*)(F.lds + 13 * SLOT + lw_), 16, 0, 0); } while (0)
#define SBARL() do { asm volatile("s_waitcnt lgkmcnt(0)" ::: "memory"); __builtin_amdgcn_s_barrier(); asm volatile("" ::: "memory"); } while (0)
    if (F.bid < NB * NH * (SEQ / 64)) W1_ISSUE(F.bid);
    for (int cid = F.bid; cid < NB * NH * (SEQ / 64); cid += F.G) {
        const int bh = cid / (SEQ / 64), c = cid % (SEQ / 64), b = bh / NH, h = bh % NH;
        const size_t tok0 = (size_t)b * SEQ + (size_t)c * 64;
        {
            const int t = F.tid >> 3, jg = lane & 7, tl = lane >> 3, ch0 = h * 64 + 8 * jg;
            WAIT_V(0);
            const unsigned ro = (unsigned)F.tid * 16u;
            const u32x4 rr = *(const LAS u32x4*)(F.lds + 1 * SLOT + ro), kr = *(const LAS u32x4*)(F.lds + 4 * SLOT + ro), vr = *(const LAS u32x4*)(F.lds + 6 * SLOT + ro), ar = *(const LAS u32x4*)(F.lds + 10 * SLOT + ro);
            const u32x4 lr = *(const LAS u32x4*)(F.lds + 13 * SLOT + ro);
            float r[8], k[8], a[8], ld[8], cum[8];
#pragma unroll
            for (int q = 0; q < 4; ++q) { r[2 * q] = lo2f(rr[q]); r[2 * q + 1] = hi2f(rr[q]); k[2 * q] = lo2f(kr[q]); k[2 * q + 1] = hi2f(kr[q]); a[2 * q] = lo2f(ar[q]); a[2 * q + 1] = hi2f(ar[q]); ld[2 * q] = lo2f(lr[q]); ld[2 * q + 1] = hi2f(lr[q]); }
#pragma unroll
            for (int e = 0; e < 8; ++e) { float v = ld[e];
                float u1 = __shfl_up(v, 8);  if (tl >= 1) v += u1;
                float u2 = __shfl_up(v, 16); if (tl >= 2) v += u2;
                float u4 = __shfl_up(v, 32); if (tl >= 4) v += u4;
                cum[e] = v; }
            if (tl == 7) {
#pragma unroll
                for (int e = 0; e < 8; ++e) segtot[w * 64 + 8 * jg + e] = cum[e]; }
            __syncthreads();
            float tot[8];
#pragma unroll
            for (int e = 0; e < 8; ++e) tot[e] = 0.f;
#pragma unroll
            for (int ww = 0; ww < 8; ++ww) {
                const f32x4 s0 = *(const LAS f32x4*)(segtot + ww * 64 + 8 * jg), s1 = *(const LAS f32x4*)(segtot + ww * 64 + 8 * jg + 4);
#pragma unroll
                for (int q = 0; q < 4; ++q) { tot[q] += s0[q]; tot[4 + q] += s1[q]; if (ww < w) { cum[q] += s0[q]; cum[4 + q] += s1[q]; } }
            }
            if (t == 0) {
#pragma unroll
                for (int e = 0; e < 8; ++e) WCs[8 * jg + e] = fexp_(tot[e]); }
            float kkr[8], kf[8], ss = 0.f, bon = 0.f;
#pragma unroll
            for (int e = 0; e < 8; ++e) { kkr[e] = k[e] * F.in[I_KK][ch0 + e]; ss += kkr[e] * kkr[e]; kf[e] = k[e] * (1.0f + (a[e] - 1.0f) * F.in[I_KA][ch0 + e]); bon += r[e] * kf[e] * F.in[I_RK][ch0 + e]; }
            ss += __shfl_xor(ss, 1); ss += __shfl_xor(ss, 2); ss += __shfl_xor(ss, 4);
            bon += __shfl_xor(bon, 1); bon += __shfl_xor(bon, 2); bon += __shfl_xor(bon, 4);
            if (jg == 0) BONUS[(tok0 + t) * NH + h] = bon;
            const float inv = 1.0f / fmaxf(sqrtf(ss), 1e-12f);
            float av[8], bv[8], kv[8], rv[8];
#pragma unroll
            for (int e = 0; e < 8; ++e) { const float kk = kkr[e] * inv, en = fexp_(-cum[e]);
                av[e] = -kk * fexp_(cum[e] - ld[e]); bv[e] = kk * a[e] * en; kv[e] = kf[e] * en; rv[e] = r[e] * fexp_(cum[e]); }
            u32x4 pa, pr, pb, pk;
#pragma unroll
            for (int q = 0; q < 4; ++q) { pa[q] = pack2(av[2 * q], av[2 * q + 1]); pr[q] = pack2(rv[2 * q], rv[2 * q + 1]); pb[q] = pack2(bv[2 * q], bv[2 * q + 1]); pk[q] = pack2(kv[2 * q], kv[2 * q + 1]); }
            *(LAS u32x4*)AT(0, t, 8 * jg) = pa; *(LAS u32x4*)AT(2, t, 8 * jg) = pr; *(LAS u32x4*)AT(3, t, 8 * jg) = pb; *(LAS u32x4*)AT(5, t, 8 * jg) = pk; *(LAS u32x4*)AT(7, t, 8 * jg) = vr;
        }
        __syncthreads();
#define LF2(dst, k, r0) do { dst[0] = *(const LAS bf16x8*)AT(k, (r0) + fr, fq * 8); dst[1] = *(const LAS bf16x8*)AT(k, (r0) + fr, 32 + fq * 8); } while (0)
#define TR2(dst, k, c0) do { const LAS bf16_t* b_ = AT(k, 8 * fq + (fr >> 2), (c0) + 4 * (fr & 3)); \
            const s16x4 t0_ = __builtin_amdgcn_ds_read_tr16_b64_v4i16((LAS s16x4*)(b_)), t1_ = __builtin_amdgcn_ds_read_tr16_b64_v4i16((LAS s16x4*)(b_ + 4 * MS)); \
            const s16x4 t2_ = __builtin_amdgcn_ds_read_tr16_b64_v4i16((LAS s16x4*)(b_ + 32 * MS)), t3_ = __builtin_amdgcn_ds_read_tr16_b64_v4i16((LAS s16x4*)(b_ + 36 * MS)); \
            dst[0] = __builtin_bit_cast(bf16x8, __builtin_shufflevector(t0_, t1_, 0, 1, 2, 3, 4, 5, 6, 7)); dst[1] = __builtin_bit_cast(bf16x8, __builtin_shufflevector(t2_, t3_, 0, 1, 2, 3, 4, 5, 6, 7)); } while (0)
#define MMA2(acc, xf, yf) do { acc = __builtin_amdgcn_mfma_f32_16x16x32_bf16(xf[0], yf[0], acc, 0, 0, 0); acc = __builtin_amdgcn_mfma_f32_16x16x32_bf16(xf[1], yf[1], acc, 0, 0, 0); } while (0)
        {
            bf16x8 xa[2], xr[2]; LF2(xa, 0, 16 * mt); LF2(xr, 2, 16 * mt);
#pragma unroll
            for (int q2 = 0; q2 < 2; ++q2) {
                const int nt = ntb + q2;
                bf16x8 yb[2], yk[2]; LF2(yb, 3, 16 * nt); LF2(yk, 5, 16 * nt);
                const int tt = 16 * mt + fr, s0 = 16 * nt + 4 * fq;
                { f32x4 acc = {0.f, 0.f, 0.f, 0.f}; MMA2(acc, yb, xa);
#pragma unroll
                  for (int e = 0; e < 4; ++e) if (!(s0 + e < tt)) acc[e] = 0.f;
                  st4_lds(AT(8, tt, s0), acc); }
                { f32x4 acc = {0.f, 0.f, 0.f, 0.f}; MMA2(acc, yk, xa);
#pragma unroll
                  for (int e = 0; e < 4; ++e) if (!(s0 + e < tt)) acc[e] = 0.f;
                  st4_lds(AT(10, tt, s0), acc); }
                { f32x4 acc = {0.f, 0.f, 0.f, 0.f}; MMA2(acc, yb, xr);
#pragma unroll
                  for (int e = 0; e < 4; ++e) if (!(s0 + e <= tt)) acc[e] = 0.f;
                  st4_lds(AT(11, tt, s0), acc); }
                { f32x4 acc = {0.f, 0.f, 0.f, 0.f}; MMA2(acc, yk, xr);
#pragma unroll
                  for (int e = 0; e < 4; ++e) if (!(s0 + e <= tt)) acc[e] = 0.f;
                  st4_lds(AT(12, tt, s0), acc); }
            }
        }
        __syncthreads();
#define WKV_SQ(xi, xo) do { bf16x8 xl[2]; LF2(xl, xi, 16 * mt); _Pragma("unroll") for (int q2 = 0; q2 < 2; ++q2) { const int nt = ntb + q2; bf16x8 yl[2]; TR2(yl, xi, 16 * nt); \
            f32x4 acc = {0.f, 0.f, 0.f, 0.f}; MMA2(acc, yl, xl); st4_lds(AT(xo, 16 * mt + fr, 16 * nt + 4 * fq), acc); } } while (0)
#define WKV_PM(pi, xi, po) do { bf16x8 xp[2]; LF2(xp, pi, 16 * mt); _Pragma("unroll") for (int q2 = 0; q2 < 2; ++q2) { const int nt = ntb + q2; bf16x8 yl[2]; TR2(yl, xi, 16 * nt); \
            const int m_ = 16 * mt + fr, n0_ = 16 * nt + 4 * fq; f32x4 acc = ld4_lds(AT(pi, m_, n0_)); MMA2(acc, yl, xp); st4_lds(AT(po, m_, n0_), acc); } } while (0)
#define WKV_PMSQ(pi, xi, po, xo) do { bf16x8 xp[2], xl[2]; LF2(xp, pi, 16 * mt); LF2(xl, xi, 16 * mt); _Pragma("unroll") for (int q2 = 0; q2 < 2; ++q2) { const int nt = ntb + q2; bf16x8 yl[2]; TR2(yl, xi, 16 * nt); \
            const int m_ = 16 * mt + fr, n0_ = 16 * nt + 4 * fq; \
            { f32x4 acc = ld4_lds(AT(pi, m_, n0_)); MMA2(acc, yl, xp); st4_lds(AT(po, m_, n0_), acc); } \
            { f32x4 acc = {0.f, 0.f, 0.f, 0.f}; MMA2(acc, yl, xl); st4_lds(AT(xo, m_, n0_), acc); } } } while (0)
        WKV_SQ(8, 1);
        for (int idx = F.tid; idx < 64 * 16; idx += NTHREADS) { const int t = idx >> 4, s4 = (idx & 15) * 4; u32x2 v = *(const LAS u32x2*)AT(8, t, s4);
            if ((t >> 2) == (s4 >> 2)) { const unsigned one = 0x3F80u; const int e = t & 3; if (e == 0) v.x = (v.x & 0xffff0000u) | one; else if (e == 1) v.x = (v.x & 0xffffu) | (one << 16); else if (e == 2) v.y = (v.y & 0xffff0000u) | one; else v.y = (v.y & 0xffffu) | (one << 16); }
            *(LAS u32x2*)AT(13, t, s4) = v; }
        { bf16x8 xm[2]; LF2(xm, 10, 16 * mt);
#pragma unroll
          for (int q2 = 0; q2 < 2; ++q2) { const int nt = ntb + q2, n_ = 16 * nt + fr, m0_ = 16 * mt + 4 * fq; bf16x8 yv[2]; TR2(yv, 7, 16 * nt);
              f32x4 acc = {0.f, 0.f, 0.f, 0.f}; MMA2(acc, xm, yv); st4_lds(AT(6, n_, m0_), acc); } }
        __syncthreads();
        WKV_PMSQ(13, 1, 14, 8); __syncthreads();
        WKV_PMSQ(14, 8, 13, 1); __syncthreads();
        WKV_PMSQ(13, 1, 14, 8); __syncthreads();
        WKV_PMSQ(14, 8, 13, 1); __syncthreads();
        WKV_PM(13, 1, 14); __syncthreads();
        {
            bf16x8 xt[2]; LF2(xt, 14, 16 * mt);
#pragma unroll
            for (int q2 = 0; q2 < 2; ++q2) {
                const int nt = ntb + q2, n_ = 16 * nt + fr, m0_ = 16 * mt + 4 * fq;
                bf16x8 ya[2], yz[2]; TR2(ya, 0, 16 * nt); LF2(yz, 6, 16 * nt);
                { f32x4 acc = {0.f, 0.f, 0.f, 0.f}; MMA2(acc, xt, ya); st4_lds(AT(9, n_, m0_), acc); }
                { f32x4 acc = {0.f, 0.f, 0.f, 0.f}; MMA2(acc, xt, yz); st4_lds(AT(8, n_, m0_), acc); }
            }
        }
        __syncthreads();
        if (cid + F.G < NB * NH * (SEQ / 64)) W1_ISSUE(cid + F.G);
        {
            bf16x8 xb[2]; LF2(xb, 11, 16 * mt);
#pragma unroll
            for (int q2 = 0; q2 < 2; ++q2) {
                const int nt = ntb + q2;
                bf16x8 yp[2]; LF2(yp, 9, 16 * nt);
                { const int m_ = 16 * mt + fr, n0_ = 16 * nt + 4 * fq; f32x4 acc = ld4_lds(AT(2, m_, n0_)); MMA2(acc, yp, xb);
                  st_bf4(RP + (size_t)cid * 4096 + (unsigned)((mt * 2 + (nt >> 1)) * 512 + (fr * 4 + 2 * (nt & 1) + (fq >> 1)) * 8 + 4 * (fq & 1)), acc); }
            }
        }
        {
            bf16x8 xb[2], xk[2], xp[2], xu[2], xv[2]; LF2(xb, 11, 16 * mt); LF2(xk, 12, 16 * mt); LF2(xp, 9, 16 * mt); LF2(xu, 8, 16 * mt); TR2(xv, 7, 16 * mt);
#pragma unroll
            for (int q2 = 0; q2 < 2; ++q2) {
                const int nt = ntb + q2;
                bf16x8 yu[2], yv[2], yb[2], yk[2]; LF2(yu, 8, 16 * nt); TR2(yv, 7, 16 * nt); TR2(yb, 3, 16 * nt); TR2(yk, 5, 16 * nt);
                { f32x4 acc = {0.f, 0.f, 0.f, 0.f}; MMA2(acc, yu, xb); MMA2(acc, yv, xk);
                  st_bf4(OL + (size_t)cid * 4096 + (unsigned)((16 * mt + fr) * 64 + 16 * nt + 4 * fq), acc); }
                { const int jp = 16 * nt + fr, j0 = 16 * mt + 4 * fq; f32x4 acc = {0.f, 0.f, 0.f, 0.f}; MMA2(acc, xp, yb);
                  const float wc = WCs[jp];
#pragma unroll
                  for (int e = 0; e < 4; ++e) acc[e] = (acc[e] + ((j0 + e == jp) ? 1.0f : 0.0f)) * wc;
                  st_bf4(G2 + (size_t)cid * 4096 + (unsigned)((nt * 2 + (mt >> 1)) * 512 + lane * 8 + (mt & 1) * 4), acc); }
                { const int i_ = 16 * mt + fr, jp0 = 16 * nt + 4 * fq; f32x4 acc = {0.f, 0.f, 0.f, 0.f}; MMA2(acc, yb, xu); MMA2(acc, yk, xv);
#pragma unroll
                  for (int e = 0; e < 4; ++e) acc[e] *= WCs[jp0 + e];
                  st_bf4(DM + (size_t)cid * 4096 + (unsigned)(i_ * 64 + jp0), acc); }
            }
        }
        SBARL();
    }
#undef W1_ISSUE
#undef LF2
#undef TR2
#undef MMA2
#undef WKV_PMSQ
#undef WKV_SQ
#undef WKV_PM
#undef AT
#undef SL
}

__device__ __forceinline__ void ph_wkv_carry(const Frame& F) {
    const bf16_t* G2 = (const bf16_t*)(F.ws + WS_G2); const bf16_t* DM = (const bf16_t*)(F.ws + WS_DM); bf16_t* ST = (bf16_t*)(F.ws + WS_ST);
    const int lane = F.lane, fr = lane & 15, fq = lane >> 4;
    const bool loader = F.wave >= 4; const int lw = F.wave - 4, i = 16 * (F.wave & 3) + fr;
    constexpr int NC = SEQ / 64;
    for (int ch = F.bid; ch < NB * NH; ch += F.G) {
        const size_t cbase = (size_t)ch * NC;
#define CARRY_ISSUE(c_) do { const int cc_ = (c_) < NC ? (c_) : NC - 1; const size_t cid_ = cbase + cc_; \
        _Pragma("unroll") for (int q_ = 0; q_ < 4; ++q_) { const int j_ = lw * 4 + q_; \
            const bf16_t* src_ = (j_ < 8 ? G2 + cid_ * 4096 + j_ * 512 : DM + cid_ * 4096 + (j_ - 8) * 512) + lane * 8; \
            __builtin_amdgcn_global_load_lds((const unsigned*)src_, (LAS unsigned*)(F.lds + ((c_) & 7) * 16384 + j_ * 1024), 16, 0, 0); } } while (0)
        f32x4 st[4];
#pragma unroll
        for (int r = 0; r < 4; ++r) st[r] = (f32x4){0.f, 0.f, 0.f, 0.f};
        bf16x8 gc[8]; u32x2 dc[4];
#define CARRY_RING_READ(c_) do { const LAS unsigned char* slot_ = F.lds + ((c_) & 7) * 16384; \
        _Pragma("unroll") for (int f = 0; f < 8; ++f) gc[f] = *(const LAS bf16x8*)(slot_ + f * 1024 + lane * 16); \
        _Pragma("unroll") for (int r = 0; r < 4; ++r) dc[r] = *(const LAS u32x2*)(slot_ + 8192 + (i * 64 + 16 * r + 4 * fq) * 2); } while (0)
        if (loader) {
#pragma unroll
            for (int c = 0; c < 7; ++c) CARRY_ISSUE(c);
            WAIT_V(20);
        }
        SBAR();
        if (!loader) CARRY_RING_READ(0);
#pragma unroll 1
        for (int c = 0; c < NC; ++c) {
            if (loader) {
                CARRY_ISSUE(c + 7);
                WAIT_V(20);
            } else {
                const size_t cid = cbase + c;
                union { bf16x8 v; unsigned u[4]; } b0, b1;
                b0.u[0] = pack2(st[0][0], st[0][1]); b0.u[1] = pack2(st[0][2], st[0][3]); b0.u[2] = pack2(st[1][0], st[1][1]); b0.u[3] = pack2(st[1][2], st[1][3]);
                b1.u[0] = pack2(st[2][0], st[2][1]); b1.u[1] = pack2(st[2][2], st[2][3]); b1.u[2] = pack2(st[3][0], st[3][1]); b1.u[3] = pack2(st[3][2], st[3][3]);
                f32x4 acc[4];
#pragma unroll
                for (int r = 0; r < 4; ++r) { acc[r] = (f32x4){lo2f(dc[r].x), hi2f(dc[r].x), lo2f(dc[r].y), hi2f(dc[r].y)};
                    acc[r] = __builtin_amdgcn_mfma_f32_16x16x32_bf16(gc[r * 2 + 0], b0.v, acc[r], 0, 0, 0); }
#pragma unroll
                for (int r = 0; r < 4; ++r) acc[r] = __builtin_amdgcn_mfma_f32_16x16x32_bf16(gc[r * 2 + 1], b1.v, acc[r], 0, 0, 0);
                { const unsigned wsl = (unsigned)(F.wave & 3);
                  bf16_t* stp = ST + cid * 4096;
                  const unsigned ob = (unsigned)(((fr >> 2) * 2) * 512 + ((4 * wsl + (fr & 3)) * 4 + (fq >> 1)) * 8 + 4 * (fq & 1));
                  u32x2 w0; w0.x = b0.u[0]; w0.y = b0.u[1]; *(u32x2*)(stp + ob) = w0;
                  u32x2 w1; w1.x = b0.u[2]; w1.y = b0.u[3]; *(u32x2*)(stp + ob + 16) = w1;
                  u32x2 w2; w2.x = b1.u[0]; w2.y = b1.u[1]; *(u32x2*)(stp + ob + 512) = w2;
                  u32x2 w3; w3.x = b1.u[2]; w3.y = b1.u[3]; *(u32x2*)(stp + ob + 512 + 16) = w3; }
                if (c + 1 < NC) CARRY_RING_READ(c + 1);
#pragma unroll
                for (int r = 0; r < 4; ++r) st[r] = acc[r];
            }
            SBAR();
        }
        if (loader) WAIT_V(0);
        SBAR();
#undef CARRY_RING_READ
#undef CARRY_ISSUE
    }
}

__device__ __forceinline__ void ph_wkv_out(const Frame& F) {
    const bf16_t* RP = (const bf16_t*)(F.ws + WS_RP); const bf16_t* OL = (const bf16_t*)(F.ws + WS_OL); const bf16_t* ST = (const bf16_t*)(F.ws + WS_ST);
    const bf16_t* Vb = (const bf16_t*)(F.ws + WS_RKV) + (size_t)2 * T * D; const bf16_t* GG = (const bf16_t*)(F.ws + WS_GG); const float* BONUS = (const float*)(F.ws + WS_BONUS);
    bf16_t* OG = (bf16_t*)(F.ws + WS_OG);
    const int lane = F.lane, fr = lane & 15, fq = lane >> 4;
    const int nunits = NB * NH * (SEQ / 64) * 4;
    for (int u0 = F.bid * NWAVES + F.wave; u0 < nunits; u0 += 2 * F.G * NWAVES) {
        bf16x8 rf[2][2], sf[2][4][2]; u32x4 ol0[2], ol1[2], v0[2], v1[2], g0[2], g1[2]; float bon[2]; f32x4 lg[2][4], lb[2][4];
        size_t tokv[2]; int chnv[2]; bool live[2];
#pragma unroll
        for (int j = 0; j < 2; ++j) {
            const int uj = u0 + j * F.G * NWAVES; live[j] = uj < nunits; const int u = live[j] ? uj : u0;
            const int cid = u >> 2, tt = u & 3, bh = cid / (SEQ / 64), c = cid % (SEQ / 64), b = bh / NH, h = bh % NH;
            const int t = 16 * tt + fr; const size_t tok = (size_t)b * SEQ + (size_t)c * 64 + t;
            const size_t oh = ((size_t)bh * SEQ + (size_t)c * 64 + t) * 64 + 16 * fq;
#pragma unroll
            for (int ks = 0; ks < 2; ++ks) rf[j][ks] = *(const bf16x8*)(RP + (size_t)cid * 4096 + (tt * 2 + ks) * 512 + (fr * 4 + fq) * 8);
#pragma unroll
            for (int n = 0; n < 4; ++n)
#pragma unroll
                for (int ks = 0; ks < 2; ++ks) sf[j][n][ks] = *(const bf16x8*)(ST + (size_t)cid * 4096 + (n * 2 + ks) * 512 + (fr * 4 + fq) * 8);
            ol0[j] = *(const u32x4*)(OL + (size_t)cid * 4096 + t * 64 + 16 * fq); ol1[j] = *(const u32x4*)(OL + (size_t)cid * 4096 + t * 64 + 16 * fq + 8);
            v0[j] = *(const u32x4*)(Vb + oh); v1[j] = *(const u32x4*)(Vb + oh + 8); g0[j] = *(const u32x4*)(GG + oh); g1[j] = *(const u32x4*)(GG + oh + 8);
            bon[j] = BONUS[tok * NH + h];
            tokv[j] = tok; chnv[j] = h * 64 + 16 * fq;
#pragma unroll
            for (int n = 0; n < 4; ++n) { lg[j][n] = *(const f32x4*)(F.in[I_LNG] + chnv[j] + 4 * n); lb[j][n] = *(const f32x4*)(F.in[I_LNB] + chnv[j] + 4 * n); }
        }
#pragma unroll
        for (int j = 0; j < 2; ++j) {
            f32x4 acc[4];
            acc[0] = (f32x4){lo2f(ol0[j][0]), hi2f(ol0[j][0]), lo2f(ol0[j][1]), hi2f(ol0[j][1])}; acc[1] = (f32x4){lo2f(ol0[j][2]), hi2f(ol0[j][2]), lo2f(ol0[j][3]), hi2f(ol0[j][3])};
            acc[2] = (f32x4){lo2f(ol1[j][0]), hi2f(ol1[j][0]), lo2f(ol1[j][1]), hi2f(ol1[j][1])}; acc[3] = (f32x4){lo2f(ol1[j][2]), hi2f(ol1[j][2]), lo2f(ol1[j][3]), hi2f(ol1[j][3])};
#pragma unroll
            for (int n = 0; n < 4; ++n)
#pragma unroll
                for (int ks = 0; ks < 2; ++ks) acc[n] = __builtin_amdgcn_mfma_f32_16x16x32_bf16(sf[j][n][ks], rf[j][ks], acc[n], 0, 0, 0);
            float s = 0.f;
#pragma unroll
            for (int n = 0; n < 4; ++n) s += (acc[n][0] + acc[n][1]) + (acc[n][2] + acc[n][3]);
            s += __shfl_xor(s, 16); s += __shfl_xor(s, 32);
            const float mean = s * (1.0f / 64.0f);
            float q = 0.f;
#pragma unroll
            for (int n = 0; n < 4; ++n)
#pragma unroll
                for (int e = 0; e < 4; ++e) { const float d = acc[n][e] - mean; q += d * d; }
            q += __shfl_xor(q, 16); q += __shfl_xor(q, 32);
            const float rstd = rsqrtf(q * (1.0f / 64.0f) + 64e-5f);
            u32x4 o0, o1;
#pragma unroll
            for (int n = 0; n < 4; ++n) {
                const unsigned vw0 = n < 2 ? v0[j][2 * n] : v1[j][2 * n - 4], vw1 = n < 2 ? v0[j][2 * n + 1] : v1[j][2 * n - 3], gw0 = n < 2 ? g0[j][2 * n] : g1[j][2 * n - 4], gw1 = n < 2 ? g0[j][2 * n + 1] : g1[j][2 * n - 3];
                const f32x4 vv = {lo2f(vw0), hi2f(vw0), lo2f(vw1), hi2f(vw1)}, gg = {lo2f(gw0), hi2f(gw0), lo2f(gw1), hi2f(gw1)};
                const f32x4 res = (((acc[n] - mean) * rstd) * lg[j][n] + lb[j][n] + vv * bon[j]) * gg;
                const unsigned w0 = pack2(res[0], res[1]), w1 = pack2(res[2], res[3]);
                if (n == 0) { o0[0] = w0; o0[1] = w1; } else if (n == 1) { o0[2] = w0; o0[3] = w1; } else if (n == 2) { o1[0] = w0; o1[1] = w1; } else { o1[2] = w0; o1[3] = w1; }
            }
            if (live[j]) { *(u32x4*)(OG + tokv[j] * D + chnv[j]) = o0; *(u32x4*)(OG + tokv[j] * D + chnv[j] + 8) = o1; }
        }
    }
}

struct AttnTile { bf16x8 k[4][2]; bf16x8 v[4][2]; };
__device__ __forceinline__ void attn_load(AttnTile& tl, const bf16_t* kbase  , const bf16_t* vbase  ) {
#pragma unroll
    for (int kt = 0; kt < 4; ++kt)
#pragma unroll
        for (int ks = 0; ks < 2; ++ks) tl.k[kt][ks] = *(const bf16x8*)(kbase + (kt * 2 + ks) * 512);
#pragma unroll
    for (int dt = 0; dt < 4; ++dt)
#pragma unroll
        for (int ks = 0; ks < 2; ++ks) tl.v[dt][ks] = *(const bf16x8*)(vbase + (dt * 2 + ks) * 512);
}
template <bool MASK>
__device__ __forceinline__ void attn_tile(const AttnTile& tl, const bf16x8 (&qf)[2], f32x4 (&o)[4], float& R, int key0, int qpos, int fq) {
    constexpr float C2 = 0.125f * 1.4426950408889634f;
    f32x4 z[4];
#pragma unroll
    for (int kt = 0; kt < 4; ++kt) { z[kt] = (f32x4){0.f, 0.f, 0.f, 0.f};
#pragma unroll
        for (int ks = 0; ks < 2; ++ks) z[kt] = __builtin_amdgcn_mfma_f32_16x16x32_bf16(tl.k[kt][ks], qf[ks], z[kt], 0, 0, 0); }
    float sp[4][4], G[4];
#pragma unroll
    for (int kt = 0; kt < 4; ++kt) { G[kt] = 0.f;
#pragma unroll
        for (int e = 0; e < 4; ++e) { const float z2 = z[kt][e] * C2; z[kt][e] = z2;
            const float l2 = __builtin_amdgcn_logf(1.0f + __builtin_amdgcn_exp2f(z2));
            float spv = z2 > 30.f ? z2 : l2;
            if (MASK) spv = ((key0 + 16 * kt + 4 * fq + e) < qpos) ? spv : 0.f;
            sp[kt][e] = spv; G[kt] += spv; } }
    float sufg[4], tot[4];
#pragma unroll
    for (int kt = 0; kt < 4; ++kt) {
        const float g1 = __shfl_xor(G[kt], 16), g2 = __shfl_xor(G[kt], 32), g3 = __shfl_xor(G[kt], 48);
        tot[kt] = G[kt] + g1 + g2 + g3;
        sufg[kt] = (((fq ^ 1) > fq) ? g1 : 0.f) + (((fq ^ 2) > fq) ? g2 : 0.f) + (((fq ^ 3) > fq) ? g3 : 0.f);
    }
    float later = 0.f;
    union { bf16x8 v; unsigned w[4]; } p0, p1;
#pragma unroll
    for (int kt = 3; kt >= 0; --kt) {
        float run = R + later + sufg[kt];
        float wv[4];
#pragma unroll
        for (int e = 3; e >= 0; --e) { float w = __builtin_amdgcn_exp2f(z[kt][e] - sp[kt][e] - run);
            if (MASK) w = ((key0 + 16 * kt + 4 * fq + e) < qpos) ? w : 0.f;
            wv[e] = w; run += sp[kt][e]; }
        const unsigned w01 = pgx::cvt_pk_bf16(wv[0], wv[1]), w23 = pgx::cvt_pk_bf16(wv[2], wv[3]);
        if (kt == 0) { p0.w[0] = w01; p0.w[1] = w23; } else if (kt == 1) { p0.w[2] = w01; p0.w[3] = w23; } else if (kt == 2) { p1.w[0] = w01; p1.w[1] = w23; } else { p1.w[2] = w01; p1.w[3] = w23; }
        later += tot[kt];
    }
    R += later;
#pragma unroll
    for (int dt = 0; dt < 4; ++dt) {
        o[dt] = __builtin_amdgcn_mfma_f32_16x16x32_bf16(tl.v[dt][0], p0.v, o[dt], 0, 0, 0);
        o[dt] = __builtin_amdgcn_mfma_f32_16x16x32_bf16(tl.v[dt][1], p1.v, o[dt], 0, 0, 0);
    }
}
__device__ __forceinline__ void attn_unit(const Frame& F, const int bh, const int qt) {
    const bf16_t* Q = (const bf16_t*)(F.ws + WS_Q); const bf16_t* Kb = Q + (size_t)T * D; const bf16_t* VT = Q + (size_t)2 * T * D;
    bf16_t* AO = (bf16_t*)(F.ws + WS_AO);
    const int lane = F.lane, fr = lane & 15, fq = lane >> 4;
    constexpr float EXIT2 = SB_EXIT * 1.4426950408889634f;
    const int b = bh / NH, h = bh % NH;
    const int q0 = qt * 16, qpos = q0 + fr;
    const size_t tb = (size_t)b * SEQ;
    bf16x8 qf[2];
#pragma unroll
    for (int ks = 0; ks < 2; ++ks) qf[ks] = *(const bf16x8*)(Q + (tb + qpos) * D + h * 64 + ks * 32 + fq * 8);
    f32x4 o[4];
#pragma unroll
    for (int dt = 0; dt < 4; ++dt) o[dt] = (f32x4){0.f, 0.f, 0.f, 0.f};
    float R = 0.f;
    const bf16_t* kb = Kb + (size_t)bh * SEQ * 64 + (fr * 4 + fq) * 8;
    const bf16_t* vb = VT + (size_t)bh * SEQ * 64 + (fr * 4 + fq) * 8;
    int kt0 = (q0 + 15) / 64;
    AttnTile ta, tc;
    attn_load(ta, kb + (size_t)kt0 * 4096, vb + (size_t)kt0 * 4096);
    if (kt0 > 0) attn_load(tc, kb + (size_t)(kt0 - 1) * 4096, vb + (size_t)(kt0 - 1) * 4096);
    attn_tile<true>(ta, qf, o, R, kt0 * 64, qpos, fq);
    --kt0;
    while (kt0 >= 0 && !__all(R > EXIT2)) {
        if (kt0 > 0) attn_load(ta, kb + (size_t)(kt0 - 1) * 4096, vb + (size_t)(kt0 - 1) * 4096);
        attn_tile<false>(tc, qf, o, R, kt0 * 64, qpos, fq);
        --kt0;
        if (kt0 < 0 || __all(R > EXIT2)) break;
        if (kt0 > 0) attn_load(tc, kb + (size_t)(kt0 - 1) * 4096, vb + (size_t)(kt0 - 1) * 4096);
        attn_tile<false>(ta, qf, o, R, kt0 * 64, qpos, fq);
        --kt0;
    }
#pragma unroll
    for (int dt = 0; dt < 4; ++dt) st_bf4(AO + (tb + qpos) * D + h * 64 + 16 * dt + 4 * fq, o[dt]);
}
__device__ __forceinline__ void ph_attn(const Frame& F) {
    if (F.G == 256) {
        const int xq = F.bid & 7, lb = F.bid >> 3;
#pragma unroll 1
        for (int it = 0; it < 8; ++it) { const int ck = it * 32 + lb; attn_unit(F, xq + 8 * (ck >> 6), (ck & 63) * 8 + F.wave); }
    } else {
        unsigned* aq = F.ctl + CW_AQ;
        LAS unsigned* chunk_s = (LAS unsigned*)(F.lds + 1024);
        const unsigned myx = xb_xcc_id() & 7u;
        for (int qi = 0; qi < 8; ++qi) {
            const unsigned xq = (myx + (unsigned)qi) & 7u;
            for (;;) {
                __syncthreads();
                if (F.tid == 0) *chunk_s = atomicAdd(&aq[xq * 64], 1u);
                __syncthreads();
                const unsigned ck = *chunk_s;
                if (ck >= 256u) break;
                attn_unit(F, (int)xq + 8 * (int)(ck >> 6), (int)(ck & 63u) * 8 + F.wave);
            }
        }
    }
}

#ifndef USE_PGX
#define USE_PGX 0x1f
#endif
__device__ __forceinline__ int px_unit_index(int i, int G, int c, int nwg) {
    const long L = (long)i * G + c; if (L >= nwg) return -1;
    const int w = (int)L, q = nwg / 8, r = nwg % 8, xcd = w % 8, off = w / 8;
    return (xcd < r ? xcd * (q + 1) : r * (q + 1) + (xcd - r) * q) + off;
}
struct PxDense {
    const char* A; const char* B; int nM, nN, K, G, c; unsigned lda; int a_div; size_t a_stride;
    __device__ __forceinline__ bool next(int i, pgx::Unit& u) const {
        const int w = px_unit_index(i, G, c, nM * nN); if (w < 0) return false;
        const int pm = w / nN, pn = w % nN;
        u.A = A + (size_t)(pn / a_div) * a_stride + (size_t)pm * 256 * lda; u.tok = nullptr; u.B = B + (size_t)pn * 256 * K * 2; u.r0 = pm * 256; u.c0 = pn * 256; u.aux = 0; return true;
    }
};
__device__ __forceinline__ void px_store_bf16_perm(bf16_t* rowp, const f32x4& v0, const f32x4& v1) {
    u32x4 w; w.x = pgx::cvt_pk_bf16(v0[0], v0[1]); w.y = pgx::cvt_pk_bf16(v0[2], v0[3]); w.z = pgx::cvt_pk_bf16(v1[0], v1[1]); w.w = pgx::cvt_pk_bf16(v1[2], v1[3]); *(u32x4*)rowp = w;
}
__device__ __forceinline__ void ph_rkv_px(const Frame& F) {
    bf16_t* RKV = (bf16_t*)(F.ws + WS_RKV);
    PxDense S{(const char*)(F.ws + WS_XS), (const char*)(F.ws + WS_WRKV), 64, 12, D, F.G, F.bid, (unsigned)(D * 2), 4, (size_t)T * D * 2};
    pgx::gemm_phase<true, true>(F.lds, D, D * 2, S, [&](const f32x4 (&acc)[2][2][4][2], const pgx::Unit& u, int wr, int wc, int fr, int fq) {
        bf16_t* base = RKV + (size_t)(u.c0 / D) * T * D;
#pragma unroll
        for (int ai = 0; ai < 2; ++ai)
#pragma unroll
            for (int m = 0; m < 4; ++m) { const int t = u.r0 + ai * 128 + wr * 64 + m * 16 + fr;
#pragma unroll
                for (int bj = 0; bj < 2; ++bj) px_store_bf16_perm(base + hm_off(t, (u.c0 % D) + bj * 128 + wc * 32 + 8 * fq), acc[ai][bj][m][0], acc[ai][bj][m][1]); }
    });
}
__device__ __forceinline__ void ph_lora_dn_sg(const Frame& F) {
    const bf16_t* XS = (const bf16_t*)(F.ws + WS_XS); const bf16_t* WLDN = (const bf16_t*)(F.ws + WS_WLDN); bf16_t* LORA = (bf16_t*)(F.ws + WS_LORA);
    for (int u = F.bid; u < 64 * 4; u += F.G) {
        const int mt = u / 4, j = u % 4, n = (j == 0) ? 3 : (j == 1 ? 4 : 5);
        ASeg A; A.p[0] = XS + ((size_t)n * T + mt * 256) * D; A.p[1] = A.p[0]; A.p[2] = A.p[0]; A.segTiles = 16;
        bf16_t* out = LORA + (size_t)mt * 256 * 256 + j * 64;
        sg_tile<64>(F.lds, A, [](int R) { return (unsigned)R * (D * 2); }, WLDN + (size_t)(j * 64) * D, D, 16,
            [&](auto& acc, int r0, int c0, int fr, int fq) {
#pragma unroll
                for (int m = 0; m < EPI_MT(acc); ++m)
#pragma unroll
                    for (int q = 0; q < 4; ++q) { f32x4 v = acc[m][q];
                        if (j == 0) {
#pragma unroll
                            for (int e = 0; e < 4; ++e) v[e] = tanhf_(v[e]); }
                        else if (j >= 2) {
#pragma unroll
                            for (int e = 0; e < 4; ++e) v[e] = sigmoidf_(v[e]); }
                        st_bf4(out + (size_t)(r0 + 16 * m + fr) * 256 + c0 + 16 * q + 4 * fq, v); }
            });
    }
}
__device__ __forceinline__ void ph_dense_bf16_px(const Frame& F, const bf16_t* Ain, const bf16_t* Wt, bf16_t* out) {
    PxDense S{(const char*)Ain, (const char*)Wt, 64, 4, D, F.G, F.bid, (unsigned)(D * 2), 4, 0};
    pgx::gemm_phase<true, true>(F.lds, D, D * 2, S, [&](const f32x4 (&acc)[2][2][4][2], const pgx::Unit& u, int wr, int wc, int fr, int fq) {
        bf16_t* base = out + u.c0 + wc * 32 + 8 * fq;
#pragma unroll
        for (int ai = 0; ai < 2; ++ai)
#pragma unroll
            for (int m = 0; m < 4; ++m) { bf16_t* rowp = base + (size_t)(u.r0 + ai * 128 + wr * 64 + m * 16 + fr) * D;
#pragma unroll
                for (int bj = 0; bj < 2; ++bj) px_store_bf16_perm(rowp + bj * 128, acc[ai][bj][m][0], acc[ai][bj][m][1]); }
    });
}
__device__ __forceinline__ void ph_qkv_px(const Frame& F) {
    bf16_t* QK = (bf16_t*)(F.ws + WS_Q); bf16_t* VT = QK + (size_t)2 * T * D;
    { PxDense S{(const char*)(F.ws + WS_H3), (const char*)(F.ws + WS_WQKV), 64, 8, D, F.G, F.bid, (unsigned)(D * 2), 8, 0};
      pgx::gemm_phase<true, true>(F.lds, D, D * 2, S, [&](const f32x4 (&acc)[2][2][4][2], const pgx::Unit& u, int wr, int wc, int fr, int fq) {
        const bool isk = u.c0 >= D;
#pragma unroll
        for (int ai = 0; ai < 2; ++ai)
#pragma unroll
            for (int m = 0; m < 4; ++m) { const int t = u.r0 + ai * 128 + wr * 64 + m * 16 + fr;
#pragma unroll
                for (int bj = 0; bj < 2; ++bj) { const int c = (u.c0 % D) + bj * 128 + wc * 32 + 8 * fq;
                    const int sq = t % SEQ, dd = c & 63;
                    bf16_t* dst = isk ? QK + (size_t)T * D + (((size_t)((t / SEQ) * NH + (c >> 6)) * (SEQ / 16) + (sq >> 4)) * 2 + (dd >> 5)) * 512 + (sq & 15) * 32 + (dd & 31) : QK + (size_t)t * D + c;
                    px_store_bf16_perm(dst, acc[ai][bj][m][0], acc[ai][bj][m][1]); } }
      }); }
    { PxDense S{(const char*)(F.ws + WS_H3), (const char*)(F.ws + WS_WQKV) + (size_t)2 * D * D * 2, 64, 4, D, F.G, F.bid, (unsigned)(D * 2), 4, 0};
      pgx::gemm_phase<false, false>(F.lds, D, D * 2, S, [&](const f32x4 (&acc)[2][2][4][2], const pgx::Unit& u, int wr, int wc, int fr, int fq) {
#pragma unroll
        for (int ai = 0; ai < 2; ++ai)
#pragma unroll
            for (int m = 0; m < 4; ++m) { const int t = u.r0 + ai * 128 + wr * 64 + m * 16 + 4 * fq, b = t / SEQ, sidx = t % SEQ;
#pragma unroll
                for (int bj = 0; bj < 2; ++bj)
#pragma unroll
                    for (int n = 0; n < 2; ++n) { const int c = u.c0 + bj * 128 + wc * 32 + n * 16 + fr, h = c >> 6, d = c & 63;
                        const int k6 = sidx & 63, kk = k6 & 31;
                        st_bf4(VT + ((size_t)(b * NH + h) * (SEQ / 64) + (sidx >> 6)) * 4096 + ((d >> 4) * 2 + (k6 >> 5)) * 512 + ((d & 15) * 4 + ((kk & 15) >> 2)) * 8 + (kk >> 4) * 4, acc[ai][bj][m][n]); } }
      }); }
}
struct PxMoe {
    const char* Asrc; const int* TOK; const int* TILEE; const char* W; const char* Wsh; int routed, nmt, nN, K, G, c; unsigned lda; size_t wexp; bool gather;
    __device__ __forceinline__ bool next(int i, pgx::Unit& u) const {
        const int w = px_unit_index(i, G, c, nmt * nN); if (w < 0) return false;
        const int mt = w / nN, pn = w % nN, row0 = mt * 256; const bool sh = row0 >= routed; const int e = sh ? 64 : TILEE[mt];
        if (gather) { if (sh) { u.A = Asrc + (size_t)(row0 - routed) * lda; u.tok = nullptr; } else { u.A = Asrc; u.tok = TOK + row0; } }
        else { u.A = Asrc + (size_t)row0 * lda; u.tok = nullptr; }
        u.B = (sh ? Wsh : W + (size_t)e * wexp) + (size_t)pn * 256 * K * 2; u.r0 = row0; u.c0 = pn * 256; u.aux = 0; return true;
    }
};
__device__ __forceinline__ void ph_gateup_px(const Frame& F, int layer) {
    bf16_t* HB = (bf16_t*)(F.ws + WS_HB); const int* START = (const int*)(F.ws + WS_START);
    const int routed = START[65], nmt = (routed + T) / 256;
    PxMoe S{(const char*)(F.ws + WS_H2), (const int*)(F.ws + WS_TOK), (const int*)(F.ws + WS_TILEE), (const char*)(F.ws + (layer == 0 ? WS_WGU : WS_WGU1)), (const char*)(F.ws + WS_WGU) + (size_t)64 * 512 * D * 2, routed, nmt, 2, D, F.G, F.bid, (unsigned)(D * 2), (size_t)512 * D * 2, true};
    pgx::gemm_phase<true, true>(F.lds, D, D * 2, S, [&](const f32x4 (&acc)[2][2][4][2], const pgx::Unit& u, int wr, int wc, int fr, int fq) {
        bf16_t* base = HB + (u.c0 >> 1) + wc * 32 + 8 * fq;
#pragma unroll
        for (int ai = 0; ai < 2; ++ai)
#pragma unroll
            for (int m = 0; m < 4; ++m) { f32x4 v[2];
#pragma unroll
                for (int n = 0; n < 2; ++n)
#pragma unroll
                    for (int e = 0; e < 4; ++e) { const float g = acc[ai][0][m][n][e]; v[n][e] = g * sigmoidf_(g) * acc[ai][1][m][n][e]; }
                px_store_bf16_perm(base + (size_t)(u.r0 + ai * 128 + wr * 64 + m * 16 + fr) * DE, v[0], v[1]); }
    });
}
__device__ __forceinline__ void ph_down_px(const Frame& F) {
    bf16_t* YB = (bf16_t*)(F.ws + WS_YB); const int* START = (const int*)(F.ws + WS_START);
    const int routed = START[65], nmt = (routed + T) / 256;
    PxMoe S{(const char*)(F.ws + WS_HB), nullptr, (const int*)(F.ws + WS_TILEE), (const char*)(F.ws + WS_WDN), (const char*)(F.ws + WS_WDN) + (size_t)64 * D * DE * 2, routed, nmt, 4, DE, F.G, F.bid, (unsigned)(DE * 2), (size_t)D * DE * 2, false};
    pgx::gemm_phase<true, true>(F.lds, DE, DE * 2, S, [&](const f32x4 (&acc)[2][2][4][2], const pgx::Unit& u, int wr, int wc, int fr, int fq) {
        unsigned char* base = (unsigned char*)YB + u.c0 + wc * 32 + 8 * fq;
#pragma unroll
        for (int ai = 0; ai < 2; ++ai)
#pragma unroll
            for (int m = 0; m < 4; ++m) { unsigned char* rowp = base + (size_t)(u.r0 + ai * 128 + wr * 64 + m * 16 + fr) * D;
#pragma unroll
                for (int bj = 0; bj < 2; ++bj) { u32x2 w;
                    w.x = pack_fp8x4(acc[ai][bj][m][0]); w.y = pack_fp8x4(acc[ai][bj][m][1]);
                    *(u32x2*)(rowp + bj * 128) = w; }
                asm volatile("" ::: "memory"); }
    });
}

__global__ void __launch_bounds__(NTHREADS, 2) mega(Args args) {
    extern __shared__ __attribute__((aligned(16))) unsigned char lds[];
    Frame F;
    F.in = args.in; F.out = args.out; F.ws = args.ws; F.ctl = (unsigned*)(args.ws + WS_CTL);
    F.ldsf = (float*)lds; F.lds = (LAS unsigned char*)lds;
    F.tid = threadIdx.x; F.lane = F.tid & 63; F.wave = __builtin_amdgcn_readfirstlane(F.tid >> 6); F.bid = blockIdx.x; F.G = gridDim.x;
    if (F.tid < 4) ((unsigned*)(lds + LDS_BYTES - 64))[F.tid] = 0u;
    __syncthreads();
    XcdBarrier bar; bar.bar = F.ctl + CW_BAR; bar.x = 0; bar.st = (volatile LAS unsigned*)(lds + LDS_BYTES - 64);
#if MK_N_LAUNCHES == 1
    bar = xcd_barrier_post(F.ctl + CW_BAR, (volatile LAS unsigned*)(lds + LDS_BYTES - 64));
#endif
    const int lo = args.ph_lo, hi = args.ph_hi;
#define IN(k) (lo <= (k) && (k) < hi)
#define SEAM(k) do { if (IN(k) && IN((k) + 1)) xcd_barrier(bar); } while (0)
    bf16_t* const wsb = (bf16_t*)args.ws;
    (void)wsb;
    if (IN(0)) { ph_mod(F); conv_dense(F, 0, F.bid, F.G); if (F.G <= 2 * NB * NH) { conv_dense(F, 1, F.bid, F.G); conv_moe(F, 0, 3, F.bid, F.G); } } SEAM(0);
    if (IN(1)) { ph_prenorm_rwkv(F); } SEAM(1);
    if (IN(2)) { ph_rkv_px(F); ph_lora_dn_sg(F); } SEAM(2);
    if (IN(3)) { ph_lora_up_sg(F); } SEAM(3);
    if (IN(4)) { ph_wkv_chunk(F); } SEAM(4);
    if (IN(5)) { if (F.bid < NB * NH || F.G <= 2 * NB * NH) { ph_wkv_carry(F); } else { conv_dense(F, 1, F.bid - NB * NH, F.G - NB * NH); conv_moe(F, 0, 3, F.bid - NB * NH, F.G - NB * NH); conv_moe(F, 1, 1, F.bid - NB * NH, F.G - NB * NH); } } SEAM(5);
    if (IN(6)) { ph_wkv_out(F); } SEAM(6);
    if (IN(7)) { ph_dense_bf16_px(F, (const bf16_t*)(F.ws + WS_OG), (const bf16_t*)(F.ws + WS_WO), (bf16_t*)(F.ws + WS_Y1)); } SEAM(7);
    if (IN(8)) { ph_postmix_route<false>(F, 0, F.in[I_X], (const bf16_t*)(F.ws + WS_Y1)); } SEAM(8);
    if (IN(11)) { ph_offsets(F, 0); } SEAM(11);
    if (IN(12)) { ph_gateup_px(F, 0); } SEAM(12);
    if (IN(13)) { ph_down_px(F); } SEAM(13);
    if (IN(14)) { ph_combine(F, 0, true); conv_moe(F, 1, (F.G <= 2 * NB * NH) ? 3 : 2, F.bid, F.G); } SEAM(14);
    if (IN(15)) { ph_qkv_px(F); } SEAM(15);
    if (IN(16)) { ph_attn(F); } SEAM(16);
    if (IN(17)) { ph_dense_bf16_px(F, (const bf16_t*)(F.ws + WS_AO), (const bf16_t*)(F.ws + WS_WSBO), (bf16_t*)(F.ws + WS_Y1B)); } SEAM(17);
    if (IN(18)) { ph_postmix_route<true>(F, 1, nullptr, (const bf16_t*)(F.ws + WS_Y1B)); } SEAM(18);
    if (IN(21)) { ph_offsets(F, 1); } SEAM(21);
    if (IN(22)) { ph_gateup_px(F, 1); } SEAM(22);
    if (IN(23)) { ph_down_px(F); } SEAM(23);
    if (IN(24)) { ph_combine(F, 1, false); }
#undef IN
#undef SEAM
}

extern "C" void kernel_launch(void* const* d_in, const int* in_sizes, int n_in, void* d_out, int out_size, void* d_ws, size_t ws_size, hipStream_t stream) {
    static int grid = 0;
    if (grid == 0) {
        if (n_in != 34 || in_sizes[0] != T * D || out_size != T * D || ws_size < WS_END) {
            fprintf(stderr, "kernel_launch: unexpected shapes: n_in %d in0 %d out %d ws %zu (need %zu)\n", n_in, n_in > 0 ? in_sizes[0] : -1, out_size, ws_size, (size_t)WS_END);
            grid = -1; return;
        }
        int dev = 0, cus = 0, per_cu = 0;
        if (hipGetDevice(&dev) != hipSuccess || hipDeviceGetAttribute(&cus, hipDeviceAttributeMultiprocessorCount, dev) != hipSuccess) { grid = -1; return; }
        if (hipFuncSetAttribute((const void*)mega, hipFuncAttributeMaxDynamicSharedMemorySize, LDS_BYTES) != hipSuccess) { fprintf(stderr, "kernel_launch: hipFuncSetAttribute failed\n"); grid = -1; return; }
        if (hipOccupancyMaxActiveBlocksPerMultiprocessor(&per_cu, (const void*)mega, NTHREADS, LDS_BYTES) != hipSuccess || per_cu < 1)
            fprintf(stderr, "kernel_launch: occupancy query reports %d blocks per CU\n", per_cu);
        (void)hipGetLastError();
        grid = cus;
    }
    if (grid < 0) return;
    if (hipMemsetAsync((char*)d_ws + WS_CTL, 0, CTL_BYTES, stream) != hipSuccess) { fprintf(stderr, "kernel_launch: memset failed\n"); return; }
    Args a{};
    for (int i = 0; i < 34; ++i) a.in[i] = (const float*)d_in[i];
    a.out = (float*)d_out; a.ws = (unsigned char*)d_ws;
#if MK_N_LAUNCHES == 1
    a.ph_lo = 0; a.ph_hi = NPHASES;
    hipLaunchKernelGGL(mega, dim3(grid), dim3(NTHREADS), LDS_BYTES, stream, a);
#else
    for (int p = 0; p < NPHASES; ++p) { a.ph_lo = p; a.ph_hi = p + 1; hipLaunchKernelGGL(mega, dim3(grid), dim3(NTHREADS), LDS_BYTES, stream, a); }
#endif
    const hipError_t le = hipPeekAtLastError();
    if (le != hipSuccess) fprintf(stderr, "kernel_launch: launch failed: %s\n", hipGetErrorName(le));
}
```

```cpp
#include <hip/hip_runtime.h>
#include <cstdio>
#include <cstdint>

#ifndef MK_N_LAUNCHES
#define MK_N_LAUNCHES 1
#endif

constexpr int T = 16384, D = 1024, SEQ = 8192, NB = 2, NH = 16, HD = 64;
constexpr int NE = 64, TOPK = 8, DE = 256;
constexpr int RP = 256;
constexpr int MAXROUTED = 147456;
constexpr int MAXROWS = MAXROUTED + T;
constexpr int NTHREADS = 512, NWAVES = 8;
constexpr int NPHASES = 25;
constexpr int LDS_BYTES = 144 * 1024;
constexpr float YB_SCALE = 16.0f;

typedef unsigned short bf16_t;
typedef float f32x4 __attribute__((ext_vector_type(4)));
typedef unsigned u32x4 __attribute__((ext_vector_type(4)));
typedef unsigned u32x2 __attribute__((ext_vector_type(2)));

__device__ __forceinline__ float bf2f(bf16_t b) { return __uint_as_float(((unsigned)b) << 16); }
typedef __bf16 bf16x2_t __attribute__((ext_vector_type(2)));
typedef float f32x2 __attribute__((ext_vector_type(2)));
__device__ __forceinline__ unsigned pack2(float a, float b) { const f32x2 v = {a, b}; const bf16x2_t r = __builtin_convertvector(v, bf16x2_t); return __builtin_bit_cast(unsigned, r); }
__device__ __forceinline__ bf16_t f2bf(float f) { return (bf16_t)(pack2(f, 0.f) & 0xffffu); }
__device__ __forceinline__ float lo2f(unsigned u) { return __uint_as_float(u << 16); }
__device__ __forceinline__ float hi2f(unsigned u) { return __uint_as_float(u & 0xffff0000u); }
__device__ __forceinline__ f32x4 ld4_g(const bf16_t* p) { const u32x2 w = *(const u32x2*)p; return (f32x4){lo2f(w.x), hi2f(w.x), lo2f(w.y), hi2f(w.y)}; }
__device__ __forceinline__ float fexp_(float x) { return __builtin_amdgcn_exp2f(x * 1.4426950408889634f); }
__device__ __forceinline__ float sigmoidf_(float x) { return __builtin_amdgcn_rcpf(1.0f + fexp_(-x)); }
__device__ __forceinline__ float tanhf_(float x) { return 1.0f - 2.0f * __builtin_amdgcn_rcpf(1.0f + fexp_(2.0f * x)); }
__device__ __forceinline__ float softplusf_(float x) { const float e = fexp_(x); const float l = __builtin_amdgcn_logf(1.0f + e) * 0.6931471805599453f; return x > 15.f ? x : (x < -8.f ? e : l); }
__device__ __forceinline__ float wave_sum(float v) {
#pragma unroll
    for (int o = 32; o >= 1; o >>= 1) v += __shfl_xor(v, o);
    return v;
}

constexpr size_t MiB = 1024 * 1024;
constexpr size_t WS_CTL    = 0;
constexpr size_t CTL_BYTES = 64 * 1024;
constexpr size_t WS_MOD    = 64 * 1024;
constexpr size_t WS_IDX    = 256 * 1024;
constexpr size_t WS_GATE   = WS_IDX + 512 * 1024;
constexpr size_t WS_RANK   = WS_GATE + 512 * 1024;
constexpr size_t WS_POS    = WS_RANK + 512 * 1024;
constexpr size_t WS_TOK    = WS_POS + 512 * 1024;
constexpr size_t WS_TILEE  = WS_TOK + 704 * 1024;
constexpr size_t WS_START  = WS_TILEE + 4096;
constexpr size_t WS_LOGITS = 8 * MiB + 64 * MiB;
constexpr size_t WS_BC     = 4 * MiB;
constexpr size_t WS_BIG    = 8 * MiB;
constexpr size_t WS_XS   = WS_BIG;
constexpr size_t WS_RKV  = WS_BIG + 192 * MiB;
constexpr size_t WS_LORA = WS_BIG + 288 * MiB;
constexpr size_t WS_LD   = WS_BIG;
constexpr size_t WS_AA   = WS_BIG + 64 * MiB;
constexpr size_t WS_GG   = WS_BIG + 96 * MiB;
constexpr size_t WS_O    = WS_BIG + 128 * MiB;
constexpr size_t WS_OG   = WS_BIG + 296 * MiB;
constexpr size_t WS_Y1   = WS_BIG + 328 * MiB;
constexpr size_t WS_H2   = WS_BIG;
constexpr size_t WS_H2LO = WS_BIG + 32 * MiB;
constexpr size_t WS_YB   = WS_BIG;
constexpr size_t WS_HB   = WS_BIG + 320 * MiB;
constexpr size_t WS_H3   = WS_BIG + 320 * MiB;
constexpr size_t WS_Q    = WS_BIG;
constexpr size_t WS_AO   = WS_BIG + 96 * MiB;
constexpr size_t WS_XR   = WS_BIG + 256 * MiB;
constexpr size_t WS_Y1B  = WS_BIG + 128 * MiB;
constexpr size_t WS_W     = WS_BIG + 400 * MiB;
constexpr size_t WS_WGU1  = WS_BIG + 192 * MiB;
constexpr size_t WS_WGU   = WS_W;
constexpr size_t WS_WDN   = WS_WGU + (size_t)65 * 512 * 1024 * 2;
constexpr size_t WS_WRKV  = WS_WDN + (size_t)65 * 1024 * 256 * 2;
constexpr size_t WS_WO    = WS_WRKV + (size_t)3072 * 1024 * 2;
constexpr size_t WS_WQKV  = WS_WO + (size_t)1024 * 1024 * 2;
constexpr size_t WS_WSBO  = WS_WQKV + (size_t)3072 * 1024 * 2;
constexpr size_t WS_WLDN  = WS_WSBO + (size_t)1024 * 1024 * 2;
constexpr size_t WS_WLUP  = WS_WLDN + (size_t)256 * 1024 * 2;
constexpr size_t WS_WRT   = WS_WLUP + (size_t)1024 * 256 * 2;
constexpr size_t WS_END   = WS_WRT + (size_t)2 * 64 * 3072 * 2;

constexpr int CW_BAR = 0;
constexpr int CW_CNT = 4096;
constexpr int CW_AQ = 4608;

#define XB_TMO      128
#define XB_XCNT(j)  (256  + 64 * (j))
#define XB_XSUB(j)  (1280 + 64 * (j))
#define XB_XGEN(j)  (2304 + 64 * (j))
#define XB_TOP      3328
#define XB_TOPGEN   3392
#define XCD_BAR_WORDS 3456
#define XB_SPIN_CAP (1u << 22)
#define LAS __attribute__((address_space(3)))

__device__ __forceinline__ unsigned xb_ld(unsigned* p)              { return __hip_atomic_load(p, __ATOMIC_RELAXED, __HIP_MEMORY_SCOPE_AGENT); }
__device__ __forceinline__ unsigned xb_add(unsigned* p, unsigned v) { return __hip_atomic_fetch_add(p, v, __ATOMIC_RELAXED, __HIP_MEMORY_SCOPE_AGENT); }
__device__ __forceinline__ unsigned xb_xcc_id() { return (unsigned)__builtin_amdgcn_s_getreg((3 << 11) | 20) & 0xFu; }
#define XB_SPIN(cond, bar) do { unsigned _sp = 0; while (cond) { __builtin_amdgcn_s_sleep(1); \
    if ((++_sp & 255u) == 0u) { if (xb_ld(&(bar)[XB_TMO])) break; if (_sp > XB_SPIN_CAP) { atomicAdd(&(bar)[XB_TMO], 1u); break; } } } } while (0)

struct XcdBarrier { unsigned* bar; unsigned x; volatile LAS unsigned* st; };

__device__ __forceinline__ XcdBarrier xcd_barrier_post(unsigned* bar, volatile LAS unsigned* st) {
    XcdBarrier b; b.bar = bar; b.x = xb_xcc_id(); b.st = st;
    if (threadIdx.x == 0) (void)xb_add(&bar[XB_XCNT(b.x)], 1u);
    return b;
}
__device__ __forceinline__ void xcd_barrier_complete(unsigned* bar, unsigned x, unsigned& nloc, unsigned& nx) {
    const unsigned G = gridDim.x * gridDim.y * gridDim.z;
    unsigned sum, cnt, mine, sp = 0u;
    for (;;) {
        sum = 0u; cnt = 0u; mine = 0u;
#pragma unroll
        for (unsigned j = 0; j < 16; ++j) { const unsigned c = xb_ld(&bar[XB_XCNT(j)]); sum += c; cnt += (c > 0u) ? 1u : 0u; mine = (j == x) ? c : mine; }
        if (sum == G) break;
        __builtin_amdgcn_s_sleep(1);
        if ((++sp & 255u) == 0u) { if (xb_ld(&bar[XB_TMO])) break; if (sp > XB_SPIN_CAP) { atomicAdd(&bar[XB_TMO], 1u); break; } }
    }
    nloc = mine > 0u ? mine : 1u; nx = cnt > 0u ? cnt : 1u;
}
__device__ __forceinline__ void xcd_barrier(const XcdBarrier& b) {
    asm volatile("s_waitcnt vmcnt(0)" ::: "memory");
    __syncthreads();
    if (threadIdx.x == 0) {
        unsigned* bar = b.bar;
        __builtin_amdgcn_s_waitcnt(0);
        unsigned nloc = b.st[0], nx = b.st[1];
        if (nloc == 0u) { xcd_barrier_complete(bar, b.x, nloc, nx); b.st[0] = nloc; b.st[1] = nx; }
        const unsigned old = xb_add(&bar[XB_XSUB(b.x)], 1u);
        const unsigned gen = old / nloc;
        if (old + 1u == (gen + 1u) * nloc) {
            __builtin_amdgcn_fence(__ATOMIC_RELEASE, "agent");
            asm volatile("s_waitcnt vmcnt(0)" ::: "memory");
            const unsigned og = xb_add(&bar[XB_TOP], 1u);
            const unsigned tg = og / nx;
            if (og + 1u == (tg + 1u) * nx) xb_add(&bar[XB_TOPGEN], 1u);
            else XB_SPIN(xb_ld(&bar[XB_TOPGEN]) == tg, bar);
            __builtin_amdgcn_fence(__ATOMIC_ACQUIRE, "agent");
            xb_add(&bar[XB_XGEN(b.x)], 1u);
            asm volatile("s_waitcnt vmcnt(0)" ::: "memory");
        } else {
            XB_SPIN(xb_ld(&bar[XB_XGEN(b.x)]) == gen, bar);
            __builtin_amdgcn_fence(__ATOMIC_ACQUIRE, "agent");
            asm volatile("s_waitcnt vmcnt(0)" ::: "memory");
        }
    }
    __syncthreads();
}

struct Args { const float* in[34]; float* out; unsigned char* ws; int ph_lo, ph_hi; };

struct Frame {
    const float* const* in; float* out; unsigned char* ws; unsigned* ctl;
    float* ldsf; LAS unsigned char* lds; int tid, lane, wave, bid, G;
};

enum { I_X = 0, I_C, I_ADAW, I_ADAB, I_NPM, I_NPOM, I_NPF, I_NPOF, I_MU, I_WRKV, I_WW1, I_WW2, I_W0, I_WA1, I_WA2, I_A0, I_WG1, I_WG2,
       I_KK, I_KA, I_RK, I_LNG, I_LNB, I_WO, I_SBQKV, I_SBO, I_ROUTER, I_RBIAS, I_MG, I_MU_, I_MD, I_SG, I_SU, I_SD };


typedef short bf16x8 __attribute__((ext_vector_type(8)));
typedef short s16x4 __attribute__((ext_vector_type(4)));
constexpr int HTB = 128 * 64 * 2;
__device__ __forceinline__ int lds_byte(int r, int c) { const int st = (r >> 4) * 2 + (c >> 5), rr = r & 15, cc = c & 31, ob = rr * 64 + cc * 2; return st * 1024 + (ob ^ (((ob >> 9) & 1) << 5)); }
__device__ __forceinline__ void stage_rc(int b, int& R, int& C) { const int st = b / 1024, sb = b % 1024, swz = sb ^ (((sb >> 9) & 1) << 5); R = (st >> 1) * 16 + swz / 64; C = (st & 1) * 32 + (swz % 64) / 2; }
#define WAIT_V(n) asm volatile("s_waitcnt vmcnt(" #n ")" ::: "memory")
#define SBAR() do { asm volatile("" ::: "memory"); __builtin_amdgcn_s_barrier(); asm volatile("" ::: "memory"); } while (0)

struct ASeg { const bf16_t* p[3]; int segTiles; };

struct BRowId { __device__ __forceinline__ int operator()(int R) const { return R; } };
struct SgChain { int ph; bool pre; bool nvalid; ASeg nA; const bf16_t* nBt; int nldb; };
template <int BN, bool NSW = false, class ARow, class Epi, class BRow = BRowId>
__device__ __forceinline__ void sg_tile(LAS unsigned char* lds, const ASeg& A, const ARow& arow, const bf16_t* Bt, int ldb, int nt, const Epi& epi, const BRow& brow = BRow(), SgChain* ch = nullptr) {
    constexpr int WN = BN / 64, WM = 8 / WN, WR = 256 / WM, MT = WR / 16;
    int tid_ = threadIdx.x; asm volatile("" : "+v"(tid_));
    const int tid = tid_, wid = __builtin_amdgcn_readfirstlane(tid >> 6), lane = tid & 63, fr = lane & 15, fq = lane >> 4;
    const int wm = wid / WN, wn = wid % WN;
    unsigned aoffs[2][2], boffs[2];
#pragma unroll
    for (int i = 0; i < 2; ++i) { int R, C; stage_rc(tid * 16 + i * 8192, R, C);
        aoffs[0][i] = arow(R) + (unsigned)C * 2u; aoffs[1][i] = arow(128 + R) + (unsigned)C * 2u; boffs[i] = (unsigned)(brow(R) * ldb + C) * 2u; }
    const unsigned ldsw = (unsigned)wid * 1024u;
    f32x4 acc[MT][4];
#pragma unroll
    for (int m = 0; m < MT; ++m)
#pragma unroll
        for (int n = 0; n < 4; ++n) acc[m][n] = (f32x4){0.f, 0.f, 0.f, 0.f};
    const int arow0 = wm * WR, ah = arow0 >> 7, ar = arow0 & 127;
    const int aoff = ah * HTB + lds_byte(ar + fr, fq * 8), boff = 2 * HTB + lds_byte(wn * 64 + fr, fq * 8);
#define SG_STAGE_X(AX, BX, BO, kt, s) do { const int sg_ = (kt) / (AX).segTiles; const char* ab_ = (const char*)(sg_ == 0 ? (AX).p[0] : (sg_ == 1 ? (AX).p[1] : (AX).p[2])) + (size_t)((kt) - sg_ * (AX).segTiles) * 128; const char* bb_ = (const char*)(BX) + (size_t)(kt) * 128; \
        _Pragma("unroll") for (int h_ = 0; h_ < 2; ++h_) _Pragma("unroll") for (int i_ = 0; i_ < 2; ++i_) \
            __builtin_amdgcn_global_load_lds((const unsigned*)(ab_ + aoffs[h_][i_]), (LAS unsigned*)(lds + ((s) * 3 + h_) * HTB + ldsw + i_ * 8192), 16, 0, 0); \
        _Pragma("unroll") for (int i_ = 0; i_ < WN; ++i_) \
            __builtin_amdgcn_global_load_lds((const unsigned*)(bb_ + (BO)[i_]), (LAS unsigned*)(lds + ((s) * 3 + 2) * HTB + ldsw + i_ * 8192), 16, 0, 0); } while (0)
#define SG_STAGE(kt, s) SG_STAGE_X(A, Bt, boffs, kt, s)
    const int ph0 = ch ? ch->ph : 0;
    if (!(ch && ch->pre)) SG_STAGE(0, ph0);
    for (int t = 0; t < nt; ++t) {
        const int s = (ph0 + t) & 1;
        if (t + 1 < nt) { SG_STAGE(t + 1, s ^ 1); if (WN == 2) WAIT_V(6); else WAIT_V(5); }
        else if (ch && ch->nvalid) { unsigned nbo[2];
#pragma unroll
            for (int i = 0; i < 2; ++i) { int R, C; stage_rc(tid * 16 + i * 8192, R, C); nbo[i] = (unsigned)(brow(R) * ch->nldb + C) * 2u; }
            SG_STAGE_X(ch->nA, ch->nBt, nbo, 0, s ^ 1); if (WN == 2) WAIT_V(6); else WAIT_V(5); }
        else { WAIT_V(0); }
        SBAR();
        LAS unsigned char* base = lds + s * 3 * HTB;
#pragma unroll
        for (int k = 0; k < 2; ++k) {
            bf16x8 af[MT], bfr[4];
#pragma unroll
            for (int m = 0; m < MT; ++m) af[m] = *(const LAS bf16x8*)(base + aoff + m * 2048 + k * 1024);
#pragma unroll
            for (int n = 0; n < 4; ++n) bfr[n] = *(const LAS bf16x8*)(base + boff + n * 2048 + k * 1024);
#pragma unroll
            for (int m = 0; m < MT; ++m)
#pragma unroll
                for (int n = 0; n < 4; ++n) acc[m][n] = NSW ? __builtin_amdgcn_mfma_f32_16x16x32_bf16(af[m], bfr[n], acc[m][n], 0, 0, 0) : __builtin_amdgcn_mfma_f32_16x16x32_bf16(bfr[n], af[m], acc[m][n], 0, 0, 0);
        }
        SBAR();
    }
#undef SG_STAGE
#undef SG_STAGE_X
    if (ch) { ch->ph = (ph0 + nt) & 1; ch->pre = ch->nvalid; }
    epi(acc, arow0, wn * 64, fr, fq);
}

struct CTile { bf16_t* dst; const float* src; int dld, sld, ncols; float scale; };
template <class TF>
__device__ __forceinline__ void conv_tiles(const Frame& F, int ntiles, int u0, int ustride, const TF& tf) {
    unsigned* tl = (unsigned*)F.ldsf;
    const int i = F.tid & 31, kp0 = F.tid >> 5;
    if (u0 >= ntiles) return;
    CTile ct = tf(u0);
    f32x4 a[4], b[4];
#define CV_LOAD() do { _Pragma("unroll") for (int q = 0; q < 4; ++q) { const int kp = kp0 + 16 * q; \
        if (4 * i < ct.ncols) { a[q] = *(const f32x4*)(ct.src + (size_t)(2 * kp) * ct.sld + 4 * i); b[q] = *(const f32x4*)(ct.src + (size_t)(2 * kp + 1) * ct.sld + 4 * i); } } } while (0)
    CV_LOAD();
    for (int u = u0; u < ntiles; u += ustride) {
        const CTile cur = ct;
        if (4 * i < cur.ncols) {
#pragma unroll
            for (int q = 0; q < 4; ++q) { const int kp = kp0 + 16 * q;
#pragma unroll
                for (int e = 0; e < 4; ++e) tl[(4 * i + e) * 65 + kp] = pack2(a[q][e] * cur.scale, b[q][e] * cur.scale); }
        }
        __syncthreads();
        if (u + ustride < ntiles) { ct = tf(u + ustride); CV_LOAD(); }
        const int nb = F.tid >> 4, sgm = F.tid & 15;
#pragma unroll
        for (int q = 0; q < 4; ++q) { const int n = nb + 32 * q;
            if (n < cur.ncols) { u32x4 v;
#pragma unroll
                for (int e = 0; e < 4; ++e) v[e] = tl[n * 65 + sgm * 4 + e];
                *(u32x4*)(cur.dst + (size_t)n * cur.dld + sgm * 8) = v; } }
        __syncthreads();
    }
#undef CV_LOAD
}
__device__ __forceinline__ void conv_moe(const Frame& F, int layer, int parts, int u0, int ustride) {
    bf16_t* WGUr = (bf16_t*)(F.ws + (layer == 0 ? WS_WGU : WS_WGU1)); bf16_t* WGUs = (bf16_t*)(F.ws + WS_WGU) + (size_t)64 * 512 * D; bf16_t* WDN = (bf16_t*)(F.ws + WS_WDN);
    const float* const* in = F.in;
    const int nA = (parts & 1) ? 64 * 32 : 0, nB = (parts & 2) ? 32 + 65 * 16 : 0;
    conv_tiles(F, nA + nB, u0, ustride, [=](int u) {
        CTile c; c.ncols = 128;
        if (u < nA) { const int e = u >> 5, r = u & 31, up = r >> 4, kt = (r >> 1) & 7, nt = r & 1;
            const float* W = (up ? in[I_MU_] : in[I_MG]) + ((size_t)layer * NE + e) * D * DE;
            c.src = W + (size_t)kt * 128 * DE + nt * 128; c.sld = DE; c.dst = WGUr + ((size_t)e * 512 + nt * 256 + up * 128) * D + kt * 128; c.dld = D; c.scale = 1.0f; }
        else { const int v0 = u - nA;
            if (v0 < 32) { const int up = v0 >> 4, kt = (v0 >> 1) & 7, nt = v0 & 1;
                const float* W = (up ? in[I_SU] : in[I_SG]) + (size_t)layer * D * DE;
                c.src = W + (size_t)kt * 128 * DE + nt * 128; c.sld = DE; c.dst = WGUs + ((size_t)nt * 256 + up * 128) * D + kt * 128; c.dld = D; c.scale = 1.0f; }
            else { const int v1 = v0 - 32, e = v1 >> 4, v = v1 & 15, kt = v >> 3, nt = v & 7;
                const float* W = (e < 64) ? in[I_MD] + ((size_t)layer * NE + e) * DE * D : in[I_SD] + (size_t)layer * DE * D;
                c.src = W + (size_t)kt * 128 * D + nt * 128; c.sld = D; c.dst = WDN + ((size_t)e * D + nt * 128) * DE + kt * 128; c.dld = DE; c.scale = YB_SCALE; } }
        return c; });
}
__device__ __forceinline__ void conv_dense(const Frame& F, int part, int u0, int ustride) {
    bf16_t* WRKV = (bf16_t*)(F.ws + WS_WRKV); bf16_t* WO = (bf16_t*)(F.ws + WS_WO); bf16_t* WQKV = (bf16_t*)(F.ws + WS_WQKV); bf16_t* WSBO = (bf16_t*)(F.ws + WS_WSBO); bf16_t* WLDN = (bf16_t*)(F.ws + WS_WLDN);
    const float* const* in = F.in;
    const int gtid = u0 * NTHREADS + F.tid, gstride = ustride * NTHREADS;
    if (part == 0) {
        conv_tiles(F, 192 + 24, u0, ustride, [=](int u) {
            CTile c; c.dld = D; c.ncols = 128; c.scale = 1.0f;
            if (u < 192) { const int n = u / 64, kt = (u >> 3) & 7, nt = u & 7; c.src = in[I_WRKV] + (size_t)n * D * D + (size_t)kt * 128 * D + nt * 128; c.sld = D; c.dst = WRKV + ((size_t)n * D + nt * 128) * D + kt * 128; }
            else { const int v = u - 192, kt = v / 3, j = v % 3;
                if (j == 0) { c.src = in[I_WW1] + (size_t)kt * 128 * 64; c.sld = 64; c.dst = WLDN + kt * 128; c.ncols = 64; }
                else if (j == 1) { c.src = in[I_WA1] + (size_t)kt * 128 * 64; c.sld = 64; c.dst = WLDN + (size_t)64 * D + kt * 128; c.ncols = 64; }
                else { c.src = in[I_WG1] + (size_t)kt * 128 * 128; c.sld = 128; c.dst = WLDN + (size_t)128 * D + kt * 128; } }
            return c; });
        bf16_t* WLUP = (bf16_t*)(F.ws + WS_WLUP);
        for (int i = gtid; i < 1024 * 256; i += gstride) {
            float v;
            if (i < 1024 * 64) { const int n = i / 64, k = i % 64; v = F.in[I_WW2][k * D + n]; }
            else if (i < 2 * 1024 * 64) { const int j = i - 1024 * 64, n = j / 64, k = j % 64; v = F.in[I_WA2][k * D + n]; }
            else { const int j = i - 2 * 1024 * 64, n = j / 128, k = j % 128; v = F.in[I_WG2][k * D + n]; }
            WLUP[i] = f2bf(v);
        }
    } else {
        conv_tiles(F, 64 + 192 + 64, u0, ustride, [=](int u) {
            CTile c; c.dld = D; c.ncols = 128; c.scale = 1.0f;
            if (u < 64) { const int kt = u >> 3, nt = u & 7; c.src = in[I_WO] + (size_t)kt * 128 * D + nt * 128; c.sld = D; c.dst = WO + (size_t)nt * 128 * D + kt * 128; }
            else if (u < 256) { const int v = u - 64, kt = v / 24, nt = v % 24; c.src = in[I_SBQKV] + (size_t)kt * 128 * 3 * D + nt * 128; c.sld = 3 * D; c.dst = WQKV + (size_t)nt * 128 * D + kt * 128; }
            else { const int v = u - 256, kt = v >> 3, nt = v & 7; c.src = in[I_SBO] + (size_t)kt * 128 * D + nt * 128; c.sld = D; c.dst = WSBO + (size_t)nt * 128 * D + kt * 128; }
            return c; });
        bf16_t* WRT = (bf16_t*)(F.ws + WS_WRT);
        for (int i = gtid; i < 2 * 64 * 1024; i += gstride) {
            const int l = i / (64 * 1024), j = i % (64 * 1024), e = j / 1024, k = j % 1024;
            const float w = F.in[I_ROUTER][((size_t)l * D + k) * NE + e]; const bf16_t hi = f2bf(w), lo = f2bf(w - bf2f(hi));
            bf16_t* row = WRT + ((size_t)l * 64 + e) * 3072; row[k] = hi; row[1024 + k] = lo; row[2048 + k] = hi;
        }
    }
}

__device__ __forceinline__ unsigned pack_fp8x4(const f32x4& v) {
    const float lim = 440.0f;
    const float a = __builtin_amdgcn_fmed3f(v[0], -lim, lim), b = __builtin_amdgcn_fmed3f(v[1], -lim, lim), c = __builtin_amdgcn_fmed3f(v[2], -lim, lim), d = __builtin_amdgcn_fmed3f(v[3], -lim, lim);
    int w = __builtin_amdgcn_cvt_pk_fp8_f32(a, b, 0, false); w = __builtin_amdgcn_cvt_pk_fp8_f32(c, d, w, true); return (unsigned)w;
}
__device__ __forceinline__ void acc_fp8x16(float (&y)[16], const u32x4& w, float g) {
#pragma unroll
    for (int q = 0; q < 4; ++q) { const f32x2 lo = __builtin_amdgcn_cvt_pk_f32_fp8((int)w[q], false), hi = __builtin_amdgcn_cvt_pk_f32_fp8((int)w[q], true);
        y[4 * q] += g * lo.x; y[4 * q + 1] += g * lo.y; y[4 * q + 2] += g * hi.x; y[4 * q + 3] += g * hi.y; }
}
__device__ __forceinline__ void ph_mod(const Frame& F) {
    const float* c = F.in[I_C]; const float* W = F.in[I_ADAW]; const float* bias = F.in[I_ADAB];
    float* MOD = (float*)(F.ws + WS_MOD);
    float* red = F.ldsf;
    float* sc = F.ldsf + 1024;
    for (int i = F.tid; i < 2 * D; i += NTHREADS) { const float v = c[i]; sc[i] = v * sigmoidf_(v); }
    __syncthreads();
    for (int u = F.bid; u < 192; u += F.G) {
        const int l = u / 96, cg = u % 96, col = cg * 64 + F.lane;
        float s0 = 0.f, s1 = 0.f;
        const float* wp = W + ((size_t)l * D + F.wave * 128) * 6144 + col;
#pragma unroll 1
        for (int d0 = 0; d0 < 128; d0 += 32) {
            float wv[32];
#pragma unroll
            for (int d = 0; d < 32; ++d) wv[d] = wp[(size_t)(d0 + d) * 6144];
#pragma unroll
            for (int d = 0; d < 32; ++d) { const int dd = F.wave * 128 + d0 + d; s0 += sc[dd] * wv[d]; s1 += sc[D + dd] * wv[d]; }
        }
        red[(F.wave * 2 + 0) * 64 + F.lane] = s0; red[(F.wave * 2 + 1) * 64 + F.lane] = s1;
        __syncthreads();
        if (F.tid < 128) {
            const int b = F.tid >> 6, cc = F.tid & 63; float s = 0.f;
#pragma unroll
            for (int w = 0; w < 8; ++w) s += red[(w * 2 + b) * 64 + cc];
            MOD[(l * 2 + b) * 6144 + cg * 64 + cc] = s + bias[l * 6144 + cg * 64 + cc];
        }
        __syncthreads();
    }
}

__device__ __forceinline__ void ph_prenorm_rwkv(const Frame& F) {
    const float* x = F.in[I_X]; const float* g = F.in[I_NPM]; const float* mu = F.in[I_MU];
    const float* MOD = (const float*)(F.ws + WS_MOD);
    bf16_t* XS = (bf16_t*)(F.ws + WS_XS);
    constexpr int RUN_T = 8;
    const int nunits = T / RUN_T, c0 = 16 * F.lane;
    f32x4 m[6][4];
#pragma unroll
    for (int n = 0; n < 6; ++n)
#pragma unroll
        for (int i = 0; i < 4; ++i) m[n][i] = *(const f32x4*)(mu + n * D + c0 + 4 * i);
    for (int u = F.bid * NWAVES + F.wave; u < nunits; u += F.G * NWAVES) {
        const int t0 = u * RUN_T, b = t0 / SEQ;
        const float* shift = MOD + (0 * 2 + b) * 6144; const float* scale = shift + 1024;
        f32x4 gm[4], sh[4];
#pragma unroll
        for (int i = 0; i < 4; ++i) { const int c = c0 + 4 * i; const f32x4 gv = *(const f32x4*)(g + c), sc = *(const f32x4*)(scale + c); gm[i] = gv * (sc + 1.0f); sh[i] = *(const f32x4*)(shift + c); }
        f32x4 hp[4];
#pragma unroll
        for (int i = 0; i < 4; ++i) hp[i] = (f32x4){0.f, 0.f, 0.f, 0.f};
        const int tstart = (t0 % SEQ == 0) ? t0 : t0 - 1;
        for (int t = tstart; t < t0 + RUN_T; ++t) {
            f32x4 xv[4]; float ss = 0.f;
#pragma unroll
            for (int i = 0; i < 4; ++i) { xv[i] = *(const f32x4*)(x + (size_t)t * D + c0 + 4 * i); ss += xv[i][0] * xv[i][0] + xv[i][1] * xv[i][1] + xv[i][2] * xv[i][2] + xv[i][3] * xv[i][3]; }
            ss = wave_sum(ss);
            const float rs = rsqrtf(ss * (1.0f / D) + 1e-6f);
            f32x4 h[4];
#pragma unroll
            for (int i = 0; i < 4; ++i) h[i] = xv[i] * rs * gm[i] + sh[i];
            if (t >= t0) {
#pragma unroll
                for (int n = 0; n < 6; ++n) {
                    u32x4 w0, w1;
#pragma unroll
                    for (int i = 0; i < 4; ++i) {
                        const f32x4 v = h[i] + (hp[i] - h[i]) * m[n][i];
                        const unsigned a0 = pack2(v[0], v[1]), a1 = pack2(v[2], v[3]);
                        if (i == 0) { w0[0] = a0; w0[1] = a1; } else if (i == 1) { w0[2] = a0; w0[3] = a1; } else if (i == 2) { w1[0] = a0; w1[1] = a1; } else { w1[2] = a0; w1[3] = a1; }
                    }
                    bf16_t* dst = XS + ((size_t)n * T + t) * D + c0;
                    *(u32x4*)dst = w0; *(u32x4*)(dst + 8) = w1;
                }
            }
#pragma unroll
            for (int i = 0; i < 4; ++i) hp[i] = h[i];
        }
    }
}


template <bool XBF>
__device__ __forceinline__ void ph_postmix_preffn(const Frame& F, int layer, const float* xin, const bf16_t* Y) {
    const float* MOD = (const float*)(F.ws + WS_MOD);
    const float* gpo = F.in[I_NPOM] + layer * D; const float* gpf = F.in[I_NPF] + layer * D;
    bf16_t* H2 = (bf16_t*)(F.ws + WS_H2); bf16_t* H2LO = (bf16_t*)(F.ws + WS_H2LO); bf16_t* XR = (bf16_t*)(F.ws + WS_XR);
    const int c0 = 16 * F.lane;
    f32x4 gmp[4], gfs[4], shf[4]; int bcur = -1;
    for (int t = F.bid * NWAVES + F.wave; t < T; t += F.G * NWAVES) {
        const int b = t / SEQ;
        if (b != bcur) { bcur = b; const float* m = MOD + (layer * 2 + b) * 6144;
#pragma unroll
            for (int i = 0; i < 4; ++i) { const int c = c0 + 4 * i;
                gmp[i] = *(const f32x4*)(m + 2048 + c) * *(const f32x4*)(gpo + c);
                gfs[i] = *(const f32x4*)(gpf + c) * (*(const f32x4*)(m + 4096 + c) + 1.0f);
                shf[i] = *(const f32x4*)(m + 3072 + c); } }
        const u32x4 y0 = *(const u32x4*)(Y + (size_t)t * D + c0), y1 = *(const u32x4*)(Y + (size_t)t * D + c0 + 8);
        f32x4 xv[4];
        if (XBF) { const u32x4 a0 = *(const u32x4*)(XR + (size_t)t * D + c0), a1 = *(const u32x4*)(XR + (size_t)t * D + c0 + 8);
            xv[0] = (f32x4){lo2f(a0[0]), hi2f(a0[0]), lo2f(a0[1]), hi2f(a0[1])}; xv[1] = (f32x4){lo2f(a0[2]), hi2f(a0[2]), lo2f(a0[3]), hi2f(a0[3])};
            xv[2] = (f32x4){lo2f(a1[0]), hi2f(a1[0]), lo2f(a1[1]), hi2f(a1[1])}; xv[3] = (f32x4){lo2f(a1[2]), hi2f(a1[2]), lo2f(a1[3]), hi2f(a1[3])}; }
        else {
#pragma unroll
            for (int i = 0; i < 4; ++i) xv[i] = *(const f32x4*)(xin + (size_t)t * D + c0 + 4 * i); }
        f32x4 y[4];
        y[0] = (f32x4){lo2f(y0[0]), hi2f(y0[0]), lo2f(y0[1]), hi2f(y0[1])}; y[1] = (f32x4){lo2f(y0[2]), hi2f(y0[2]), lo2f(y0[3]), hi2f(y0[3])};
        y[2] = (f32x4){lo2f(y1[0]), hi2f(y1[0]), lo2f(y1[1]), hi2f(y1[1])}; y[3] = (f32x4){lo2f(y1[2]), hi2f(y1[2]), lo2f(y1[3]), hi2f(y1[3])};
        float ss = 0.f;
#pragma unroll
        for (int i = 0; i < 4; ++i) ss += y[i][0] * y[i][0] + y[i][1] * y[i][1] + y[i][2] * y[i][2] + y[i][3] * y[i][3];
        ss = wave_sum(ss);
        const float rs = rsqrtf(ss * (1.0f / D) + 1e-6f);
        f32x4 x1[4]; float s2 = 0.f;
#pragma unroll
        for (int i = 0; i < 4; ++i) { const int c = c0 + 4 * i;
            x1[i] = xv[i] + gmp[i] * (y[i] * rs);
            s2 += x1[i][0] * x1[i][0] + x1[i][1] * x1[i][1] + x1[i][2] * x1[i][2] + x1[i][3] * x1[i][3]; }
        { u32x4 r0, r1;
          r0[0] = pack2(x1[0][0], x1[0][1]); r0[1] = pack2(x1[0][2], x1[0][3]); r0[2] = pack2(x1[1][0], x1[1][1]); r0[3] = pack2(x1[1][2], x1[1][3]);
          r1[0] = pack2(x1[2][0], x1[2][1]); r1[1] = pack2(x1[2][2], x1[2][3]); r1[2] = pack2(x1[3][0], x1[3][1]); r1[3] = pack2(x1[3][2], x1[3][3]);
          *(u32x4*)(XR + (size_t)t * D + c0) = r0; *(u32x4*)(XR + (size_t)t * D + c0 + 8) = r1; }
        s2 = wave_sum(s2);
        const float rs2 = rsqrtf(s2 * (1.0f / D) + 1e-6f);
        u32x4 h0, h1, l0, l1;
#pragma unroll
        for (int i = 0; i < 4; ++i) {
            const f32x4 h = x1[i] * rs2 * gfs[i] + shf[i];
            const unsigned w0 = pack2(h[0], h[1]), w1 = pack2(h[2], h[3]);
            const unsigned v0 = pack2(h[0] - lo2f(w0), h[1] - hi2f(w0)), v1 = pack2(h[2] - lo2f(w1), h[3] - hi2f(w1));
            if (i == 0) { h0[0] = w0; h0[1] = w1; l0[0] = v0; l0[1] = v1; } else if (i == 1) { h0[2] = w0; h0[3] = w1; l0[2] = v0; l0[3] = v1; }
            else if (i == 2) { h1[0] = w0; h1[1] = w1; l1[0] = v0; l1[1] = v1; } else { h1[2] = w0; h1[3] = w1; l1[2] = v0; l1[3] = v1; }
        }
        *(u32x4*)(H2 + (size_t)t * D + c0) = h0; *(u32x4*)(H2 + (size_t)t * D + c0 + 8) = h1;
        *(u32x4*)(H2LO + (size_t)t * D + c0) = l0; *(u32x4*)(H2LO + (size_t)t * D + c0 + 8) = l1;
    }
}


template <bool XBF>
__device__ __forceinline__ void ph_postmix_route(const Frame& F, int layer, const float* xin, const bf16_t* Y) {
    const float* MOD = (const float*)(F.ws + WS_MOD);
    const float* gpo = F.in[I_NPOM] + layer * D; const float* gpf = F.in[I_NPF] + layer * D;
    bf16_t* H2 = (bf16_t*)(F.ws + WS_H2); bf16_t* XR = (bf16_t*)(F.ws + WS_XR);
    const bf16_t* WRT = (const bf16_t*)(F.ws + WS_WRT) + (size_t)layer * 64 * 3072;
    const float* rb = F.in[I_RBIAS] + layer * NE;
    int* IDX = (int*)(F.ws + WS_IDX); float* GATE = (float*)(F.ws + WS_GATE); int* RANK = (int*)(F.ws + WS_RANK); unsigned* BC = (unsigned*)(F.ws + WS_BC);
    constexpr int RS = 2064;
    LAS unsigned char* AH = F.lds; LAS unsigned char* AL = F.lds + 16 * RS;
    LAS float* PART = (LAS float*)(F.lds + 2 * 16 * RS);
    LAS float* VEC = PART + 8 * 16 * 64;
    LAS float* SL = VEC + 3 * 1024;
    LAS unsigned* lcnt = (LAS unsigned*)(SL + 8 * 8 * 64);
    const int lane = F.lane, w = F.wave, fr = lane & 15, fq = lane >> 4, c0 = 16 * lane;
    const bf16_t* const wfrag = WRT + (size_t)fr * 3072 + 128 * w + 8 * fq;
    const float bias = rb[lane];
    int bcur = -1;
    for (int g = F.bid; g < T / 64; g += F.G) {
        const int b = (g * 64) / SEQ;
        __syncthreads();
        if (b != bcur) { bcur = b; const float* m = MOD + (layer * 2 + b) * 6144;
            for (int c = F.tid; c < D; c += NTHREADS) { VEC[c] = m[2048 + c] * gpo[c]; VEC[1024 + c] = gpf[c] * (m[4096 + c] + 1.0f); VEC[2048 + c] = m[3072 + c]; } }
        if (F.tid < 64) lcnt[F.tid] = 0u;
        __syncthreads();
        bf16x8 bh[4][4];
        { const bf16_t* pw = wfrag; asm volatile("" : "+v"(pw));
#pragma unroll
          for (int n = 0; n < 4; ++n)
#pragma unroll
            for (int ks = 0; ks < 4; ++ks) bh[n][ks] = *(const bf16x8*)(pw + (size_t)n * 16 * 3072 + 32 * ks); }
        u32x4 y0v[2], y1v[2], a0v[2], a1v[2]; f32x4 xvv[2][4];
#define PR_LOAD_ROWS(tw_) do { _Pragma("unroll") for (int j = 0; j < 2; ++j) { const size_t ro = (size_t)((tw_) + j) * D + c0; \
            y0v[j] = *(const u32x4*)(Y + ro); y1v[j] = *(const u32x4*)(Y + ro + 8); \
            if (XBF) { a0v[j] = *(const u32x4*)(XR + ro); a1v[j] = *(const u32x4*)(XR + ro + 8); } \
            else { _Pragma("unroll") for (int i = 0; i < 4; ++i) xvv[j][i] = *(const f32x4*)(xin + ro + 4 * i); } } } while (0)
        PR_LOAD_ROWS(g * 64 + 2 * w);
#pragma unroll 1
        for (int sg = 0; sg < 4; ++sg) {
            const int tw = g * 64 + sg * 16 + 2 * w;
#pragma unroll
            for (int j = 0; j < 2; ++j) {
                const int t = tw + j;
                const u32x4 y0 = y0v[j], y1 = y1v[j];
                f32x4 xv[4], y[4];
                if (XBF) { const u32x4 a0 = a0v[j], a1 = a1v[j];
                    xv[0] = (f32x4){lo2f(a0[0]), hi2f(a0[0]), lo2f(a0[1]), hi2f(a0[1])}; xv[1] = (f32x4){lo2f(a0[2]), hi2f(a0[2]), lo2f(a0[3]), hi2f(a0[3])};
                    xv[2] = (f32x4){lo2f(a1[0]), hi2f(a1[0]), lo2f(a1[1]), hi2f(a1[1])}; xv[3] = (f32x4){lo2f(a1[2]), hi2f(a1[2]), lo2f(a1[3]), hi2f(a1[3])}; }
                else {
#pragma unroll
                    for (int i = 0; i < 4; ++i) xv[i] = xvv[j][i]; }
                y[0] = (f32x4){lo2f(y0[0]), hi2f(y0[0]), lo2f(y0[1]), hi2f(y0[1])}; y[1] = (f32x4){lo2f(y0[2]), hi2f(y0[2]), lo2f(y0[3]), hi2f(y0[3])};
                y[2] = (f32x4){lo2f(y1[0]), hi2f(y1[0]), lo2f(y1[1]), hi2f(y1[1])}; y[3] = (f32x4){lo2f(y1[2]), hi2f(y1[2]), lo2f(y1[3]), hi2f(y1[3])};
                float ss = 0.f;
#pragma unroll
                for (int i = 0; i < 4; ++i) ss += y[i][0] * y[i][0] + y[i][1] * y[i][1] + y[i][2] * y[i][2] + y[i][3] * y[i][3];
                ss = wave_sum(ss);
                const float rs = rsqrtf(ss * (1.0f / D) + 1e-6f);
                f32x4 x1[4]; float s2 = 0.f;
#pragma unroll
                for (int i = 0; i < 4; ++i) { const f32x4 gmp = *(const LAS f32x4*)(VEC + c0 + 4 * i);
                    x1[i] = xv[i] + gmp * (y[i] * rs);
                    s2 += x1[i][0] * x1[i][0] + x1[i][1] * x1[i][1] + x1[i][2] * x1[i][2] + x1[i][3] * x1[i][3]; }
                { u32x4 r0, r1;
                  r0[0] = pack2(x1[0][0], x1[0][1]); r0[1] = pack2(x1[0][2], x1[0][3]); r0[2] = pack2(x1[1][0], x1[1][1]); r0[3] = pack2(x1[1][2], x1[1][3]);
                  r1[0] = pack2(x1[2][0], x1[2][1]); r1[1] = pack2(x1[2][2], x1[2][3]); r1[2] = pack2(x1[3][0], x1[3][1]); r1[3] = pack2(x1[3][2], x1[3][3]);
                  *(u32x4*)(XR + (size_t)t * D + c0) = r0; *(u32x4*)(XR + (size_t)t * D + c0 + 8) = r1; }
                s2 = wave_sum(s2);
                const float rs2 = rsqrtf(s2 * (1.0f / D) + 1e-6f);
                u32x4 h0, h1, l0, l1;
#pragma unroll
                for (int i = 0; i < 4; ++i) { const f32x4 gfs = *(const LAS f32x4*)(VEC + 1024 + c0 + 4 * i), shf = *(const LAS f32x4*)(VEC + 2048 + c0 + 4 * i);
                    const f32x4 h = x1[i] * rs2 * gfs + shf;
                    const unsigned w0 = pack2(h[0], h[1]), w1 = pack2(h[2], h[3]);
                    const unsigned v0 = pack2(h[0] - lo2f(w0), h[1] - hi2f(w0)), v1 = pack2(h[2] - lo2f(w1), h[3] - hi2f(w1));
                    if (i == 0) { h0[0] = w0; h0[1] = w1; l0[0] = v0; l0[1] = v1; } else if (i == 1) { h0[2] = w0; h0[3] = w1; l0[2] = v0; l0[3] = v1; }
                    else if (i == 2) { h1[0] = w0; h1[1] = w1; l1[0] = v0; l1[1] = v1; } else { h1[2] = w0; h1[3] = w1; l1[2] = v0; l1[3] = v1; } }
                *(u32x4*)(H2 + (size_t)t * D + c0) = h0; *(u32x4*)(H2 + (size_t)t * D + c0 + 8) = h1;
                LAS unsigned char* rh = AH + (2 * w + j) * RS + lane * 32; LAS unsigned char* rl = AL + (2 * w + j) * RS + lane * 32;
                *(LAS u32x4*)rh = h0; *(LAS u32x4*)(rh + 16) = h1; *(LAS u32x4*)rl = l0; *(LAS u32x4*)(rl + 16) = l1;
            }
            __syncthreads();
            {
                f32x4 acc[4]; bf16x8 bl[4][4], ahf[4];
                { const bf16_t* pw = wfrag + 1024; asm volatile("" : "+v"(pw));
#pragma unroll
                  for (int n = 0; n < 4; ++n)
#pragma unroll
                    for (int ks = 0; ks < 4; ++ks) bl[n][ks] = *(const bf16x8*)(pw + (size_t)n * 16 * 3072 + 32 * ks); }
                { const int twn = g * 64 + (sg < 3 ? sg + 1 : sg) * 16 + 2 * w; PR_LOAD_ROWS(twn); }
#pragma unroll
                for (int n = 0; n < 4; ++n) acc[n] = (f32x4){0.f, 0.f, 0.f, 0.f};
#pragma unroll
                for (int ks = 0; ks < 4; ++ks) { const int ko = fr * RS + (128 * w + 32 * ks + 8 * fq) * 2;
                    const bf16x8 ah = *(const LAS bf16x8*)(AH + ko), al = *(const LAS bf16x8*)(AL + ko); ahf[ks] = ah;
#pragma unroll
                    for (int n = 0; n < 4; ++n) { acc[n] = __builtin_amdgcn_mfma_f32_16x16x32_bf16(bh[n][ks], ah, acc[n], 0, 0, 0);
                        acc[n] = __builtin_amdgcn_mfma_f32_16x16x32_bf16(bh[n][ks], al, acc[n], 0, 0, 0); } }
#pragma unroll
                for (int ks = 0; ks < 4; ++ks)
#pragma unroll
                    for (int n = 0; n < 4; ++n) acc[n] = __builtin_amdgcn_mfma_f32_16x16x32_bf16(bl[n][ks], ahf[ks], acc[n], 0, 0, 0);
#pragma unroll
                for (int n = 0; n < 4; ++n) *(LAS f32x4*)(PART + (w * 16 + fr) * 64 + 16 * n + 4 * fq) = acc[n];
            }
            __syncthreads();
#pragma unroll
            for (int j = 0; j < 2; ++j) { float v = 0.f;
#pragma unroll
                for (int ww = 0; ww < 8; ++ww) v += PART[(ww * 16 + 2 * w + j) * 64 + lane];
                SL[(w * 8 + 2 * sg + j) * 64 + lane] = sigmoidf_(v); }
        }
#undef PR_LOAD_ROWS
        float sv[8], bv[8]; int bi[8]; unsigned lrank[8];
#pragma unroll
        for (int j = 0; j < 8; ++j) { sv[j] = SL[(w * 8 + j) * 64 + lane]; bv[j] = sv[j] + bias; bi[j] = lane; }
#pragma unroll
        for (int k = 2; k <= 64; k <<= 1)
#pragma unroll
            for (int o = k >> 1; o >= 1; o >>= 1) {
                const bool keep_better = (((lane & o) == 0) == ((lane & k) == 0));
#pragma unroll
                for (int j = 0; j < 8; ++j) { const float ov = __shfl_xor(bv[j], o); const int oi = __shfl_xor(bi[j], o);
                    const bool other_better = (ov > bv[j]) | ((ov == bv[j]) & (oi < bi[j])); const bool take = (keep_better == other_better);
                    bv[j] = take ? ov : bv[j]; bi[j] = take ? oi : bi[j]; }
            }
#pragma unroll
        for (int j = 0; j < 8; ++j) { const int t = g * 64 + 16 * (j >> 1) + 2 * w + (j & 1);
            const float sc = __shfl(sv[j], bi[j]);
            float tot = (lane < TOPK) ? sc : 0.f; tot += __shfl_xor(tot, 1); tot += __shfl_xor(tot, 2); tot += __shfl_xor(tot, 4);
            lrank[j] = 0u;
            if (lane < TOPK) { IDX[t * TOPK + lane] = bi[j]; GATE[t * TOPK + lane] = 2.5f * sc / tot; lrank[j] = atomicAdd((unsigned*)&lcnt[bi[j]], 1u); } }
        __syncthreads();
        if (F.tid < 64) BC[g * 64 + F.tid] = lcnt[F.tid];
#pragma unroll
        for (int j = 0; j < 8; ++j) { const int t = g * 64 + 16 * (j >> 1) + 2 * w + (j & 1); if (lane < TOPK) RANK[t * TOPK + lane] = (int)lrank[j]; }
    }
}

__device__ __forceinline__ void ph_topk(const Frame& F, int layer) {
    const float* LOG = (const float*)(F.ws + WS_LOGITS); const float* rb = F.in[I_RBIAS] + layer * NE;
    int* IDX = (int*)(F.ws + WS_IDX); float* GATE = (float*)(F.ws + WS_GATE); int* RANK = (int*)(F.ws + WS_RANK);
    unsigned* BC = (unsigned*)(F.ws + WS_BC);
    unsigned* lcnt = (unsigned*)F.ldsf;
    const float bias = rb[F.lane];
    for (int base = F.bid * 64; base < T; base += F.G * 64) {
        if (F.tid < 64) lcnt[F.tid] = 0u;
        __syncthreads();
        float s[8], sel[8], tot[8], mysc[8]; int myidx[8]; unsigned lrank[8];
#pragma unroll
        for (int j = 0; j < 8; ++j) { const size_t o = (size_t)(base + F.wave * 8 + j) * NE + F.lane;
            s[j] = sigmoidf_(LOG[o] + LOG[(size_t)T * NE + o] + LOG[(size_t)2 * T * NE + o]); sel[j] = s[j] + bias; tot[j] = 0.f; mysc[j] = 0.f; myidx[j] = 0; }
#pragma unroll
        for (int k = 0; k < TOPK; ++k) {
            float bv[8]; int bi[8];
#pragma unroll
            for (int j = 0; j < 8; ++j) { bv[j] = sel[j]; bi[j] = F.lane; }
#pragma unroll
            for (int o = 32; o >= 1; o >>= 1) {
#pragma unroll
                for (int j = 0; j < 8; ++j) { const float ov = __shfl_xor(bv[j], o); const int oi = __shfl_xor(bi[j], o); const bool take = (ov > bv[j]) | ((ov == bv[j]) & (oi < bi[j]));     bv[j] = take ? ov : bv[j]; bi[j] = take ? oi : bi[j]; }
            }
#pragma unroll
            for (int j = 0; j < 8; ++j) { const float sc = __shfl(s[j], bi[j]); tot[j] += sc; const bool me = (F.lane == k); myidx[j] = me ? bi[j] : myidx[j]; mysc[j] = me ? sc : mysc[j]; sel[j] = (F.lane == bi[j]) ? -1e30f : sel[j]; }
        }
#pragma unroll
        for (int j = 0; j < 8; ++j) { const int t = base + F.wave * 8 + j; lrank[j] = 0u;
            if (F.lane < TOPK) { IDX[t * TOPK + F.lane] = myidx[j]; GATE[t * TOPK + F.lane] = 2.5f * mysc[j] / tot[j]; lrank[j] = atomicAdd(&lcnt[myidx[j]], 1u); } }
        __syncthreads();
        if (F.tid < 64) BC[(base >> 6) * 64 + F.tid] = lcnt[F.tid];
#pragma unroll
        for (int j = 0; j < 8; ++j) { const int t = base + F.wave * 8 + j; if (F.lane < TOPK) RANK[t * TOPK + F.lane] = (int)lrank[j]; }
        __syncthreads();
    }
}

__device__ __forceinline__ void ph_offsets(const Frame& F, int layer) {
    const unsigned* BC = (const unsigned*)(F.ws + WS_BC);
    const int* IDX = (const int*)(F.ws + WS_IDX); const int* RANK = (const int*)(F.ws + WS_RANK);
    int* POS = (int*)(F.ws + WS_POS); int* TOK = (int*)(F.ws + WS_TOK); int* TILEE = (int*)(F.ws + WS_TILEE); int* START = (int*)(F.ws + WS_START);
    int* sst = (int*)F.ldsf;
    constexpr int NG = T / 64;
    for (int g = F.bid; g < NG; g += F.G) {
        { const int e = F.tid & 63, part = F.tid >> 6; int tot = 0, pre = 0;
          for (int gg = part; gg < NG; gg += 8) { const int v = (int)BC[gg * 64 + e]; tot += v; if (gg < g) pre += v; }
          sst[512 + part * 64 + e] = tot; sst[1024 + part * 64 + e] = pre; }
        __syncthreads();
        if (F.tid < 64) { int tot = 0, pre = 0;
#pragma unroll
            for (int q = 0; q < 8; ++q) { tot += sst[512 + q * 64 + F.tid]; pre += sst[1024 + q * 64 + F.tid]; }
            sst[128 + F.tid] = tot; sst[256 + F.tid] = pre; }
        __syncthreads();
        if (F.tid == 0) { int acc = 0; for (int e = 0; e < NE; ++e) { const int c = sst[128 + e]; sst[e] = acc; acc += ((c + RP - 1) / RP) * RP; } sst[64] = acc; }
        __syncthreads();
        if (g == 0) {
            if (F.tid <= 64) START[F.tid] = sst[F.tid];
            if (F.tid == 65) START[65] = sst[64];
        }
        if (g == (NG > 1 ? 1 : 0)) { if (F.tid < NE) for (int i = sst[F.tid] / RP; i < sst[F.tid + 1] / RP; ++i) TILEE[i] = F.tid; }
        for (int e = (g + NG - 2) % NG; e < NE; e += NG) { const int c = sst[128 + e], lo = sst[e] + c, hi = sst[e + 1]; for (int r = lo + F.tid; r < hi; r += NTHREADS) TOK[r] = 0; }
        { const int sl = g * 64 * TOPK + F.tid;
          const int e = IDX[sl], p = sst[e] + sst[256 + e] + RANK[sl];
          POS[sl] = p; TOK[p] = sl / TOPK; }
        __syncthreads();
    }
}

__device__ __forceinline__ void ph_combine(const Frame& F, int layer, bool next) {
    const unsigned char* YB = (const unsigned char*)(F.ws + WS_YB); const int* POS = (const int*)(F.ws + WS_POS); const float* GATE = (const float*)(F.ws + WS_GATE);
    const int* START = (const int*)(F.ws + WS_START); const float* MOD = (const float*)(F.ws + WS_MOD);
    const float* gpo = F.in[I_NPOF] + layer * D;
    bf16_t* H3 = (bf16_t*)(F.ws + WS_H3); bf16_t* XR = (bf16_t*)(F.ws + WS_XR);
    const int routed = START[65], c0 = 16 * F.lane;
    f32x4 gmp[4], gfs[4], shf[4]; int bcur = -1;
    for (int t = F.bid * NWAVES + F.wave; t < T; t += F.G * NWAVES) {
        const int b = t / SEQ;
        if (b != bcur) { bcur = b; const float* m = MOD + (layer * 2 + b) * 6144;
#pragma unroll
            for (int i = 0; i < 4; ++i) { const int c = c0 + 4 * i; gmp[i] = *(const f32x4*)(m + 5120 + c) * *(const f32x4*)(gpo + c);
                if (next) { const float* m1 = MOD + ((layer + 1) * 2 + b) * 6144; const float* g1 = F.in[I_NPM] + (layer + 1) * D;
                    gfs[i] = *(const f32x4*)(g1 + c) * (*(const f32x4*)(m1 + 1024 + c) + 1.0f); shf[i] = *(const f32x4*)(m1 + c); } } }
        int pos[TOPK]; float gk[TOPK];
        { const u32x4 p0 = *(const u32x4*)(POS + t * TOPK), p1 = *(const u32x4*)(POS + t * TOPK + 4); const f32x4 g0 = *(const f32x4*)(GATE + t * TOPK), g1 = *(const f32x4*)(GATE + t * TOPK + 4);
#pragma unroll
          for (int k = 0; k < 4; ++k) { pos[k] = (int)p0[k]; pos[4 + k] = (int)p1[k]; gk[k] = g0[k]; gk[4 + k] = g1[k]; } }
        u32x4 rw[TOPK + 1];
        rw[TOPK] = *(const u32x4*)(YB + (size_t)(routed + t) * D + c0);
#pragma unroll
        for (int k = 0; k < TOPK; ++k) rw[k] = *(const u32x4*)(YB + (size_t)pos[k] * D + c0);
        float y[16];
#pragma unroll
        for (int e = 0; e < 16; ++e) y[e] = 0.f;
        acc_fp8x16(y, rw[TOPK], 1.0f / YB_SCALE);
#pragma unroll
        for (int k = 0; k < TOPK; ++k) acc_fp8x16(y, rw[k], gk[k] * (1.0f / YB_SCALE));
        float ss = 0.f;
#pragma unroll
        for (int e = 0; e < 16; ++e) ss += y[e] * y[e];
        ss = wave_sum(ss);
        const float rs = rsqrtf(ss * (1.0f / D) + 1e-6f);
        f32x4 x2[4]; float s2 = 0.f;
        const u32x4 a0 = *(const u32x4*)(XR + (size_t)t * D + c0), a1 = *(const u32x4*)(XR + (size_t)t * D + c0 + 8);
#pragma unroll
        for (int i = 0; i < 4; ++i) { const int c = c0 + 4 * i;
            const unsigned wa = (i < 2) ? a0[2 * (i & 1)] : a1[2 * (i & 1)], wb = (i < 2) ? a0[2 * (i & 1) + 1] : a1[2 * (i & 1) + 1];
            const f32x4 xv = {lo2f(wa), hi2f(wa), lo2f(wb), hi2f(wb)};
            const f32x4 yv = {y[4 * i], y[4 * i + 1], y[4 * i + 2], y[4 * i + 3]};
            x2[i] = xv + gmp[i] * (yv * rs);
            if (!next) *(f32x4*)(F.out + (size_t)t * D + c) = x2[i];
            s2 += x2[i][0] * x2[i][0] + x2[i][1] * x2[i][1] + x2[i][2] * x2[i][2] + x2[i][3] * x2[i][3]; }
        if (next) {
            { u32x4 r0, r1;
              r0[0] = pack2(x2[0][0], x2[0][1]); r0[1] = pack2(x2[0][2], x2[0][3]); r0[2] = pack2(x2[1][0], x2[1][1]); r0[3] = pack2(x2[1][2], x2[1][3]);
              r1[0] = pack2(x2[2][0], x2[2][1]); r1[1] = pack2(x2[2][2], x2[2][3]); r1[2] = pack2(x2[3][0], x2[3][1]); r1[3] = pack2(x2[3][2], x2[3][3]);
              *(u32x4*)(XR + (size_t)t * D + c0) = r0; *(u32x4*)(XR + (size_t)t * D + c0 + 8) = r1; }
            s2 = wave_sum(s2);
            const float rs2 = rsqrtf(s2 * (1.0f / D) + 1e-6f);
            u32x4 h0, h1;
#pragma unroll
            for (int i = 0; i < 4; ++i) {
                const f32x4 h = x2[i] * rs2 * gfs[i] + shf[i];
                const unsigned w0 = pack2(h[0], h[1]), w1 = pack2(h[2], h[3]);
                if (i == 0) { h0[0] = w0; h0[1] = w1; } else if (i == 1) { h0[2] = w0; h0[3] = w1; } else if (i == 2) { h1[0] = w0; h1[1] = w1; } else { h1[2] = w0; h1[3] = w1; } }
            *(u32x4*)(H3 + (size_t)t * D + c0) = h0; *(u32x4*)(H3 + (size_t)t * D + c0 + 8) = h1;
        }
    }
}

#define SB_EXIT 110.0f

namespace pgx {
__device__ __forceinline__ int perm32(int rho) { const int n = rho >> 4, i = rho & 15; return 8 * (i >> 2) + 4 * n + (i & 3); }
struct Unit { const char* A; const int* tok; const char* B; int r0, c0, aux; };
template <bool SW, bool PERM, class Sched, class Epi>
__device__ __forceinline__ void gemm_phase(LAS unsigned char* lds, const int K, const unsigned lda  , const Sched& S, const Epi& E) {
    int tid_ = threadIdx.x; asm volatile("" : "+v"(tid_));
    const int tid = tid_, wid = __builtin_amdgcn_readfirstlane(tid >> 6), lane = tid & 63, wr = wid >> 2, wc = wid & 3, fr = lane & 15, fq = lane >> 4;
    const int nt = K / 64;
    int Rr[2], Cc[2]; unsigned voffB[2];
#pragma unroll
    for (int i = 0; i < 2; ++i) { stage_rc(tid * 16 + i * 8192, Rr[i], Cc[i]); const int Rb = PERM ? ((Rr[i] & ~31) + perm32(Rr[i] & 31)) : Rr[i]; voffB[i] = (unsigned)(Rb * K + Cc[i]) * 2u; }
    const size_t kstep = 128, hstepB = (size_t)128 * K * 2;
    const unsigned ldsw = (unsigned)wid * 1024u;
    const int aoff = lds_byte(wr * 64 + fr, fq * 8), boff = lds_byte(wc * 32 + fr, fq * 8);
#define PX_SA(b, h) (((b) * 2 + (h)) * HTB)
#define PX_SB(b, h) ((4 + (b) * 2 + (h)) * HTB)
#define PX_STAGE(bufoff, gbase, voff) do { _Pragma("unroll") for (int _i = 0; _i < 2; ++_i) \
        __builtin_amdgcn_global_load_lds((const unsigned*)((const char*)(gbase) + (voff)[_i]), (LAS unsigned*)(lds + (bufoff) + ldsw + _i * 8192), 16, 0, 0); } while (0)
#define PX_LDA(dst, b, h) do { _Pragma("unroll") for (int m = 0; m < 4; ++m) _Pragma("unroll") for (int k = 0; k < 2; ++k) dst[m][k] = *(const LAS bf16x8*)(lds + PX_SA(b, h) + aoff + m * 2048 + k * 1024); } while (0)
#define PX_LDB(dst, b, h) do { _Pragma("unroll") for (int n = 0; n < 2; ++n) _Pragma("unroll") for (int k = 0; k < 2; ++k) dst[n][k] = *(const LAS bf16x8*)(lds + PX_SB(b, h) + boff + n * 2048 + k * 1024); } while (0)
#define PX_MMA(ai, bj, At, Bt) do { __builtin_amdgcn_s_setprio(1); _Pragma("unroll") for (int m = 0; m < 4; ++m) _Pragma("unroll") for (int n = 0; n < 2; ++n) _Pragma("unroll") for (int k = 0; k < 2; ++k) \
        acc[ai][bj][m][n] = SW ? __builtin_amdgcn_mfma_f32_16x16x32_bf16(Bt[n][k], At[m][k], acc[ai][bj][m][n], 0, 0, 0) : __builtin_amdgcn_mfma_f32_16x16x32_bf16(At[m][k], Bt[n][k], acc[ai][bj][m][n], 0, 0, 0); __builtin_amdgcn_s_setprio(0); } while (0)
#define PX_WAIT_L(n) asm volatile("s_waitcnt lgkmcnt(" #n ")" ::: "memory")
#define PX_BAR __builtin_amdgcn_s_barrier()
#define PX_SCHED __builtin_amdgcn_sched_barrier(0)
#define PX_OFFS(dst, un) do { _Pragma("unroll") for (int h_ = 0; h_ < 2; ++h_) _Pragma("unroll") for (int i_ = 0; i_ < 2; ++i_) { \
        const int row_ = h_ * 128 + Rr[i_]; const unsigned rid_ = (un).tok ? (unsigned)(un).tok[row_] : (unsigned)row_; dst[h_][i_] = rid_ * lda + (unsigned)Cc[i_] * 2u; } } while (0)
    Unit cur, nxt; int ui = 0;
    if (!S.next(0, cur)) return;
    f32x4 acc[2][2][4][2];
#pragma unroll
    for (int a = 0; a < 2; ++a)
#pragma unroll
        for (int b = 0; b < 2; ++b)
#pragma unroll
            for (int m = 0; m < 4; ++m)
#pragma unroll
                for (int n = 0; n < 2; ++n) acc[a][b][m][n] = (f32x4){0.f, 0.f, 0.f, 0.f};
    bf16x8 At[4][2], B0[2][2], B1[2][2];
    unsigned oc[2][2], on[2][2];
    PX_OFFS(oc, cur); asm volatile("" : "+v"(oc[0][0]), "+v"(oc[0][1]), "+v"(oc[1][0]), "+v"(oc[1][1]));
    const char* cA = cur.A; const char* cB = cur.B;
    PX_STAGE(PX_SB(0, 0), cB, voffB); PX_STAGE(PX_SA(0, 0), cA, oc[0]); PX_STAGE(PX_SB(0, 1), cB + hstepB, voffB); PX_STAGE(PX_SA(0, 1), cA, oc[1]);
    if (wr == 1) PX_BAR;
    WAIT_V(4); PX_BAR;
    PX_STAGE(PX_SB(1, 0), cB + kstep, voffB); PX_STAGE(PX_SA(1, 0), cA + kstep, oc[0]); PX_STAGE(PX_SB(1, 1), cB + hstepB + kstep, voffB);
    WAIT_V(6); PX_BAR;
    for (;;) {
        const bool has_next = S.next(ui + 1, nxt);
        const char* nA = has_next ? nxt.A : cA; const char* nB = has_next ? nxt.B : cB;
        if (has_next) { PX_OFFS(on, nxt); asm volatile("" : "+v"(on[0][0]), "+v"(on[0][1]), "+v"(on[1][0]), "+v"(on[1][1])); } else {
#pragma unroll
            for (int h_ = 0; h_ < 2; ++h_)
#pragma unroll
                for (int i_ = 0; i_ < 2; ++i_) on[h_][i_] = oc[h_][i_]; }
#pragma unroll 1
        for (int t = 0; t < nt; t += 2) {
            const bool last = (t == nt - 2);
            const char* a1 = cA + (size_t)(t + 1) * kstep;
            const char* a2 = last ? nA : cA + (size_t)(t + 2) * kstep; const char* b2 = last ? nB : cB + (size_t)(t + 2) * kstep;
            const char* a3 = a2 + kstep; const char* b3 = b2 + kstep;
            unsigned o2[2][2];
#pragma unroll
            for (int h_ = 0; h_ < 2; ++h_)
#pragma unroll
                for (int i_ = 0; i_ < 2; ++i_) o2[h_][i_] = last ? on[h_][i_] : oc[h_][i_];
            PX_LDB(B0, 0, 0); PX_SCHED; PX_LDA(At, 0, 0); PX_STAGE(PX_SA(1, 1), a1, oc[1]);
            PX_WAIT_L(8); PX_BAR; PX_WAIT_L(0); PX_MMA(0, 0, At, B0); PX_BAR; PX_SCHED;
            PX_LDB(B1, 0, 1); PX_STAGE(PX_SB(0, 0), b2, voffB);
            PX_BAR; PX_WAIT_L(0); PX_MMA(0, 1, At, B1); PX_BAR;
            PX_LDA(At, 0, 1); PX_STAGE(PX_SA(0, 0), a2, o2[0]);
            PX_BAR; PX_WAIT_L(0); PX_MMA(1, 0, At, B0); PX_BAR; PX_SCHED;
            PX_STAGE(PX_SB(0, 1), b2 + hstepB, voffB);
            WAIT_V(6); PX_BAR; PX_MMA(1, 1, At, B1); PX_BAR;
            PX_LDB(B0, 1, 0); PX_SCHED; PX_LDA(At, 1, 0); PX_STAGE(PX_SA(0, 1), a2, o2[1]);
            PX_WAIT_L(8); PX_BAR; PX_WAIT_L(0); PX_MMA(0, 0, At, B0); PX_BAR; PX_SCHED;
            PX_LDB(B1, 1, 1); PX_STAGE(PX_SB(1, 0), b3, voffB);
            PX_BAR; PX_WAIT_L(0); PX_MMA(0, 1, At, B1); PX_BAR;
            PX_LDA(At, 1, 1); PX_STAGE(PX_SA(1, 0), a3, o2[0]);
            PX_BAR; PX_WAIT_L(0); PX_MMA(1, 0, At, B0); PX_BAR; PX_SCHED;
            PX_STAGE(PX_SB(1, 1), b3 + hstepB, voffB);
            WAIT_V(6); PX_BAR; PX_MMA(1, 1, At, B1); PX_BAR;
        }
        E(acc, cur, wr, wc, fr, fq);
        if (!has_next) break;
#pragma unroll
        for (int a = 0; a < 2; ++a)
#pragma unroll
            for (int b = 0; b < 2; ++b)
#pragma unroll
                for (int m = 0; m < 4; ++m)
#pragma unroll
                    for (int n = 0; n < 2; ++n) acc[a][b][m][n] = (f32x4){0.f, 0.f, 0.f, 0.f};
        cur = nxt; cA = nA; cB = nB; ++ui;
#pragma unroll
        for (int h_ = 0; h_ < 2; ++h_)
#pragma unroll
            for (int i_ = 0; i_ < 2; ++i_) oc[h_][i_] = on[h_][i_];
    }
    WAIT_V(0);
    if (wr == 0) PX_BAR;
    PX_BAR;
#undef PX_SA
#undef PX_SB
#undef PX_STAGE
#undef PX_LDA
#undef PX_LDB
#undef PX_MMA
#undef PX_WAIT_L
#undef PX_BAR
#undef PX_SCHED
#undef PX_OFFS
}
__device__ __forceinline__ unsigned cvt_pk_bf16(float lo, float hi) { return pack2(lo, hi); }
}

__device__ __forceinline__ size_t hm_off(int t, int c) { return ((size_t)((t / SEQ) * NH + (c >> 6)) * SEQ + (t % SEQ)) * 64 + (c & 63); }
#define EPI_MT(acc) (int)(sizeof(acc) / sizeof(acc[0]))
__device__ __forceinline__ void st_bf4(bf16_t* p, const f32x4& v) { u32x2 w; w.x = pack2(v[0], v[1]); w.y = pack2(v[2], v[3]); *(u32x2*)p = w; }

__device__ __forceinline__ void ph_lora_up_sg(const Frame& F) {
    const bf16_t* LORA = (const bf16_t*)(F.ws + WS_LORA); const bf16_t* WLUP = (const bf16_t*)(F.ws + WS_WLUP);
    bf16_t* LD = (bf16_t*)(F.ws + WS_LD); bf16_t* AA = (bf16_t*)(F.ws + WS_AA); bf16_t* GG = (bf16_t*)(F.ws + WS_GG);
    f32x4 w0v[4], a0v[4]; int pcol = -1;
    SgChain ch; ch.ph = 0; ch.pre = false;
    for (int u = F.bid; u < 3 * 64 * 8; u += F.G) {
        const int which = u / 512, v = u % 512, mt = v / 8, col0 = (v % 8) * 128;
        if (col0 != pcol) { pcol = col0;
#pragma unroll
            for (int q = 0; q < 4; ++q) { const int c = (F.wave & 1) * 64 + 16 * q + 4 * (F.lane >> 4); w0v[q] = *(const f32x4*)(F.in[I_W0] + col0 + c); a0v[q] = *(const f32x4*)(F.in[I_A0] + col0 + c); } }
        const int K = which == 2 ? 128 : 64, koff = which * 64;
        ASeg A; A.p[0] = LORA + (size_t)mt * 256 * 256 + koff; A.p[1] = A.p[0]; A.p[2] = A.p[0]; A.segTiles = 4;
        const bf16_t* Bt = WLUP + (which == 0 ? 0 : (which == 1 ? 1024 * 64 : 2 * 1024 * 64)) + (size_t)col0 * K;
        bf16_t* const outp = which == 0 ? LD : (which == 1 ? AA : GG);
        { const int un = u + F.G; ch.nvalid = un < 3 * 64 * 8;
          const int wn_ = un / 512, vn = un % 512, mn = vn / 8, cn = (vn % 8) * 128, Kn = wn_ == 2 ? 128 : 64;
          ch.nA.p[0] = LORA + (size_t)mn * 256 * 256 + wn_ * 64; ch.nA.p[1] = ch.nA.p[0]; ch.nA.p[2] = ch.nA.p[0]; ch.nA.segTiles = 4;
          ch.nBt = WLUP + (wn_ == 0 ? 0 : (wn_ == 1 ? 1024 * 64 : 2 * 1024 * 64)) + (size_t)cn * Kn; ch.nldb = Kn; }
        sg_tile<128>(F.lds, A, [](int R) { return (unsigned)R * 512u; }, Bt, K, K / 64,
            [&](auto& acc, int r0, int c0, int fr, int fq) {
                bf16_t* const ob = outp + hm_off(mt * 256 + r0 + fr, col0 + c0 + 4 * fq);
                if (which == 0) {
#pragma unroll
                    for (int m = 0; m < EPI_MT(acc); ++m)
#pragma unroll
                        for (int q = 0; q < 4; ++q) { f32x4 r;
#pragma unroll
                            for (int e = 0; e < 4; ++e) r[e] = -0.6065306597126334f * sigmoidf_(w0v[q][e] + acc[m][q][e]);
                            st_bf4(ob + m * 1024 + q * 16, r); }
                } else if (which == 1) {
#pragma unroll
                    for (int m = 0; m < EPI_MT(acc); ++m)
#pragma unroll
                        for (int q = 0; q < 4; ++q) { f32x4 r;
#pragma unroll
                            for (int e = 0; e < 4; ++e) r[e] = sigmoidf_(a0v[q][e] + acc[m][q][e]);
                            st_bf4(ob + m * 1024 + q * 16, r); }
                } else {
#pragma unroll
                    for (int m = 0; m < EPI_MT(acc); ++m)
#pragma unroll
                        for (int q = 0; q < 4; ++q) st_bf4(ob + m * 1024 + q * 16, acc[m][q]);
                }
            }, BRowId(), &ch);
    }
}
__device__ __forceinline__ void ph_router_sg(const Frame& F, int layer) {
    const bf16_t* H2 = (const bf16_t*)(F.ws + WS_H2); const bf16_t* H2LO = (const bf16_t*)(F.ws + WS_H2LO);
    const bf16_t* WRT = (const bf16_t*)(F.ws + WS_WRT) + (size_t)layer * 64 * 3072; float* LOG = (float*)(F.ws + WS_LOGITS);
    for (int u = F.bid; u < 64 * 3; u += F.G) {
        const int mt = u / 3, sgi = u % 3;
        ASeg A; A.p[0] = (sgi == 2 ? H2LO : H2) + (size_t)mt * 256 * D; A.p[1] = A.p[0]; A.p[2] = A.p[0]; A.segTiles = 16;
        float* out = LOG + (size_t)sgi * T * NE;
        sg_tile<64>(F.lds, A, [](int R) { return (unsigned)R * (D * 2); }, WRT + sgi * 1024, 3072, 16,
            [&](auto& acc, int r0, int c0, int fr, int fq) {
#pragma unroll
                for (int m = 0; m < EPI_MT(acc); ++m)
#pragma unroll
                    for (int q = 0; q < 4; ++q) *(f32x4*)(out + (size_t)(mt * 256 + r0 + 16 * m + fr) * NE + c0 + 16 * q + 4 * fq) = acc[m][q];
            });
    }
}

constexpr int MS = 72;
constexpr int SLOT = 64 * MS * 2;
__device__ __forceinline__ int ms_off(int row, int col) { return row * MS + col; }
constexpr size_t WS_BONUS = 3 * MiB;
constexpr size_t WS_RP = WS_BIG + 128 * MiB;
constexpr size_t WS_OL = WS_BIG + 160 * MiB;
constexpr size_t WS_G2 = WS_BIG + 296 * MiB;
constexpr size_t WS_DM = WS_BIG + 328 * MiB;
constexpr size_t WS_ST = WS_BIG + 360 * MiB;

__device__ __forceinline__ void st4_lds(LAS bf16_t* p, const f32x4& v) { u32x2 w; w.x = pack2(v[0], v[1]); w.y = pack2(v[2], v[3]); *(LAS u32x2*)p = w; }
__device__ __forceinline__ f32x4 ld4_lds(const LAS bf16_t* p) { const u32x2 w = *(const LAS u32x2*)p; return (f32x4){lo2f(w.x), hi2f(w.x), lo2f(w.y), hi2f(w.y)}; }

__device__ __forceinline__ void ph_wkv_chunk(const Frame& F) {
    const bf16_t* RKV = (const bf16_t*)(F.ws + WS_RKV); const bf16_t* LD = (const bf16_t*)(F.ws + WS_LD); const bf16_t* AA = (const bf16_t*)(F.ws + WS_AA);
    const bf16_t* Rb = RKV; const bf16_t* Kb = RKV + (size_t)T * D; const bf16_t* Vb = RKV + (size_t)2 * T * D;
    bf16_t* RP = (bf16_t*)(F.ws + WS_RP); bf16_t* OL = (bf16_t*)(F.ws + WS_OL); bf16_t* G2 = (bf16_t*)(F.ws + WS_G2); bf16_t* DM = (bf16_t*)(F.ws + WS_DM);
    float* BONUS = (float*)(F.ws + WS_BONUS);
#define SL(k) ((LAS bf16_t*)(F.lds + (k) * SLOT))
#define AT(k, r, c) (SL(k) + ms_off((r), (c)))
    LAS float* segtot = (LAS float*)(F.lds + 15 * SLOT);
    LAS float* WCs = segtot + 512;
    const int w = F.wave, lane = F.lane, fr = lane & 15, fq = lane >> 4, mt = w >> 1, ntb = 2 * (w & 1);
#define W1_ISSUE(cn_) do { const size_t on_ = (size_t)(cn_) * 4096 + (size_t)F.tid * 8; const unsigned lw_ = (unsigned)w * 1024u; \
        __builtin_amdgcn_global_load_lds((const unsigned*)(Rb + on_), (LAS unsigned*)(F.lds + 1 * SLOT + lw_), 16, 0, 0); \
        __builtin_amdgcn_global_load_lds((const unsigned*)(Kb + on_), (LAS unsigned*)(F.lds + 4 * SLOT + lw_), 16, 0, 0); \
        __builtin_amdgcn_global_load_lds((const unsigned*)(Vb + on_), (LAS unsigned*)(F.lds + 6 * SLOT + lw_), 16, 0, 0); \
        __builtin_amdgcn_global_load_lds((const unsigned*)(AA + on_), (LAS unsigned*)(F.lds + 10 * SLOT + lw_), 16, 0, 0); \
        __builtin_amdgcn_global_load_lds((const unsigned*)(LD + on_), (LAS unsigned*)(F.lds + 13 * SLOT + lw_), 16, 0, 0); } while (0)
#define SBARL() do { asm volatile("s_waitcnt lgkmcnt(0)" ::: "memory"); __builtin_amdgcn_s_barrier(); asm volatile("" ::: "memory"); } while (0)
    if (F.bid < NB * NH * (SEQ / 64)) W1_ISSUE(F.bid);
    for (int cid = F.bid; cid < NB * NH * (SEQ / 64); cid += F.G) {
        const int bh = cid / (SEQ / 64), c = cid % (SEQ / 64), b = bh / NH, h = bh % NH;
        const size_t tok0 = (size_t)b * SEQ + (size_t)c * 64;
        {
            const int t = F.tid >> 3, jg = lane & 7, tl = lane >> 3, ch0 = h * 64 + 8 * jg;
            WAIT_V(0);
            const unsigned ro = (unsigned)F.tid * 16u;
            const u32x4 rr = *(const LAS u32x4*)(F.lds + 1 * SLOT + ro), kr = *(const LAS u32x4*)(F.lds + 4 * SLOT + ro), vr = *(const LAS u32x4*)(F.lds + 6 * SLOT + ro), ar = *(const LAS u32x4*)(F.lds + 10 * SLOT + ro);
            const u32x4 lr = *(const LAS u32x4*)(F.lds + 13 * SLOT + ro);
            float r[8], k[8], a[8], ld[8], cum[8];
#pragma unroll
            for (int q = 0; q < 4; ++q) { r[2 * q] = lo2f(rr[q]); r[2 * q + 1] = hi2f(rr[q]); k[2 * q] = lo2f(kr[q]); k[2 * q + 1] = hi2f(kr[q]); a[2 * q] = lo2f(ar[q]); a[2 * q + 1] = hi2f(ar[q]); ld[2 * q] = lo2f(lr[q]); ld[2 * q + 1] = hi2f(lr[q]); }
#pragma unroll
            for (int e = 0; e < 8; ++e) { float v = ld[e];
                float u1 = __shfl_up(v, 8);  if (tl >= 1) v += u1;
                float u2 = __shfl_up(v, 16); if (tl >= 2) v += u2;
                float u4 = __shfl_up(v, 32); if (tl >= 4) v += u4;
                cum[e] = v; }
            if (tl == 7) {
#pragma unroll
                for (int e = 0; e < 8; ++e) segtot[w * 64 + 8 * jg + e] = cum[e]; }
            __syncthreads();
            float tot[8];
#pragma unroll
            for (int e = 0; e < 8; ++e) tot[e] = 0.f;
#pragma unroll
            for (int ww = 0; ww < 8; ++ww) {
                const f32x4 s0 = *(const LAS f32x4*)(segtot + ww * 64 + 8 * jg), s1 = *(const LAS f32x4*)(segtot + ww * 64 + 8 * jg + 4);
#pragma unroll
                for (int q = 0; q < 4; ++q) { tot[q] += s0[q]; tot[4 + q] += s1[q]; if (ww < w) { cum[q] += s0[q]; cum[4 + q] += s1[q]; } }
            }
            if (t == 0) {
#pragma unroll
                for (int e = 0; e < 8; ++e) WCs[8 * jg + e] = fexp_(tot[e]); }
            float kkr[8], kf[8], ss = 0.f, bon = 0.f;
#pragma unroll
            for (int e = 0; e < 8; ++e) { kkr[e] = k[e] * F.in[I_KK][ch0 + e]; ss += kkr[e] * kkr[e]; kf[e] = k[e] * (1.0f + (a[e] - 1.0f) * F.in[I_KA][ch0 + e]); bon += r[e] * kf[e] * F.in[I_RK][ch0 + e]; }
            ss += __shfl_xor(ss, 1); ss += __shfl_xor(ss, 2); ss += __shfl_xor(ss, 4);
            bon += __shfl_xor(bon, 1); bon += __shfl_xor(bon, 2); bon += __shfl_xor(bon, 4);
            if (jg == 0) BONUS[(tok0 + t) * NH + h] = bon;
            const float inv = 1.0f / fmaxf(sqrtf(ss), 1e-12f);
            float av[8], bv[8], kv[8], rv[8];
#pragma unroll
            for (int e = 0; e < 8; ++e) { const float kk = kkr[e] * inv, en = fexp_(-cum[e]);
                av[e] = -kk * fexp_(cum[e] - ld[e]); bv[e] = kk * a[e] * en; kv[e] = kf[e] * en; rv[e] = r[e] * fexp_(cum[e]); }
            u32x4 pa, pr, pb, pk;
#pragma unroll
            for (int q = 0; q < 4; ++q) { pa[q] = pack2(av[2 * q], av[2 * q + 1]); pr[q] = pack2(rv[2 * q], rv[2 * q + 1]); pb[q] = pack2(bv[2 * q], bv[2 * q + 1]); pk[q] = pack2(kv[2 * q], kv[2 * q + 1]); }
            *(LAS u32x4*)AT(0, t, 8 * jg) = pa; *(LAS u32x4*)AT(2, t, 8 * jg) = pr; *(LAS u32x4*)AT(3, t, 8 * jg) = pb; *(LAS u32x4*)AT(5, t, 8 * jg) = pk; *(LAS u32x4*)AT(7, t, 8 * jg) = vr;
        }
        __syncthreads();
#define LF2(dst, k, r0) do { dst[0] = *(const LAS bf16x8*)AT(k, (r0) + fr, fq * 8); dst[1] = *(const LAS bf16x8*)AT(k, (r0) + fr, 32 + fq * 8); } while (0)
#define TR2(dst, k, c0) do { const LAS bf16_t* b_ = AT(k, 8 * fq + (fr >> 2), (c0) + 4 * (fr & 3)); \
            const s16x4 t0_ = __builtin_amdgcn_ds_read_tr16_b64_v4i16((LAS s16x4*)(b_)), t1_ = __builtin_amdgcn_ds_read_tr16_b64_v4i16((LAS s16x4*)(b_ + 4 * MS)); \
            const s16x4 t2_ = __builtin_amdgcn_ds_read_tr16_b64_v4i16((LAS s16x4*)(b_ + 32 * MS)), t3_ = __builtin_amdgcn_ds_read_tr16_b64_v4i16((LAS s16x4*)(b_ + 36 * MS)); \
            dst[0] = __builtin_bit_cast(bf16x8, __builtin_shufflevector(t0_, t1_, 0, 1, 2, 3, 4, 5, 6, 7)); dst[1] = __builtin_bit_cast(bf16x8, __builtin_shufflevector(t2_, t3_, 0, 1, 2, 3, 4, 5, 6, 7)); } while (0)
#define MMA2(acc, xf, yf) do { acc = __builtin_amdgcn_mfma_f32_16x16x32_bf16(xf[0], yf[0], acc, 0, 0, 0); acc = __builtin_amdgcn_mfma_f32_16x16x32_bf16(xf[1], yf[1], acc, 0, 0, 0); } while (0)
        {
            bf16x8 xa[2], xr[2]; LF2(xa, 0, 16 * mt); LF2(xr, 2, 16 * mt);
#pragma unroll
            for (int q2 = 0; q2 < 2; ++q2) {
                const int nt = ntb + q2;
                bf16x8 yb[2], yk[2]; LF2(yb, 3, 16 * nt); LF2(yk, 5, 16 * nt);
                const int tt = 16 * mt + fr, s0 = 16 * nt + 4 * fq;
                { f32x4 acc = {0.f, 0.f, 0.f, 0.f}; MMA2(acc, yb, xa);
#pragma unroll
                  for (int e = 0; e < 4; ++e) if (!(s0 + e < tt)) acc[e] = 0.f;
                  st4_lds(AT(8, tt, s0), acc); }
                { f32x4 acc = {0.f, 0.f, 0.f, 0.f}; MMA2(acc, yk, xa);
#pragma unroll
                  for (int e = 0; e < 4; ++e) if (!(s0 + e < tt)) acc[e] = 0.f;
                  st4_lds(AT(10, tt, s0), acc); }
                { f32x4 acc = {0.f, 0.f, 0.f, 0.f}; MMA2(acc, yb, xr);
#pragma unroll
                  for (int e = 0; e < 4; ++e) if (!(s0 + e <= tt)) acc[e] = 0.f;
                  st4_lds(AT(11, tt, s0), acc); }
                { f32x4 acc = {0.f, 0.f, 0.f, 0.f}; MMA2(acc, yk, xr);
#pragma unroll
                  for (int e = 0; e < 4; ++e) if (!(s0 + e <= tt)) acc[e] = 0.f;
                  st4_lds(AT(12, tt, s0), acc); }
            }
        }
        __syncthreads();
#define WKV_SQ(xi, xo) do { bf16x8 xl[2]; LF2(xl, xi, 16 * mt); _Pragma("unroll") for (int q2 = 0; q2 < 2; ++q2) { const int nt = ntb + q2; bf16x8 yl[2]; TR2(yl, xi, 16 * nt); \
            f32x4 acc = {0.f, 0.f, 0.f, 0.f}; MMA2(acc, yl, xl); st4_lds(AT(xo, 16 * mt + fr, 16 * nt + 4 * fq), acc); } } while (0)
#define WKV_PM(pi, xi, po) do { bf16x8 xp[2]; LF2(xp, pi, 16 * mt); _Pragma("unroll") for (int q2 = 0; q2 < 2; ++q2) { const int nt = ntb + q2; bf16x8 yl[2]; TR2(yl, xi, 16 * nt); \
            const int m_ = 16 * mt + fr, n0_ = 16 * nt + 4 * fq; f32x4 acc = ld4_lds(AT(pi, m_, n0_)); MMA2(acc, yl, xp); st4_lds(AT(po, m_, n0_), acc); } } while (0)
#define WKV_PMSQ(pi, xi, po, xo) do { bf16x8 xp[2], xl[2]; LF2(xp, pi, 16 * mt); LF2(xl, xi, 16 * mt); _Pragma("unroll") for (int q2 = 0; q2 < 2; ++q2) { const int nt = ntb + q2; bf16x8 yl[2]; TR2(yl, xi, 16 * nt); \
            const int m_ = 16 * mt + fr, n0_ = 16 * nt + 4 * fq; \
            { f32x4 acc = ld4_lds(AT(pi, m_, n0_)); MMA2(acc, yl, xp); st4_lds(AT(po, m_, n0_), acc); } \
            { f32x4 acc = {0.f, 0.f, 0.f, 0.f}; MMA2(acc, yl, xl); st4_lds(AT(xo, m_, n0_), acc); } } } while (0)
        WKV_SQ(8, 1);
        for (int idx = F.tid; idx < 64 * 16; idx += NTHREADS) { const int t = idx >> 4, s4 = (idx & 15) * 4; u32x2 v = *(const LAS u32x2*)AT(8, t, s4);
            if ((t >> 2) == (s4 >> 2)) { const unsigned one = 0x3F80u; const int e = t & 3; if (e == 0) v.x = (v.x & 0xffff0000u) | one; else if (e == 1) v.x = (v.x & 0xffffu) | (one << 16); else if (e == 2) v.y = (v.y & 0xffff0000u) | one; else v.y = (v.y & 0xffffu) | (one << 16); }
            *(LAS u32x2*)AT(13, t, s4) = v; }
        { bf16x8 xm[2]; LF2(xm, 10, 16 * mt);
#pragma unroll
          for (int q2 = 0; q2 < 2; ++q2) { const int nt = ntb + q2, n_ = 16 * nt + fr, m0_ = 16 * mt + 4 * fq; bf16x8 yv[2]; TR2(yv, 7, 16 * nt);
              f32x4 acc = {0.f, 0.f, 0.f, 0.f}; MMA2(acc, xm, yv); st4_lds(AT(6, n_, m0_), acc); } }
        __syncthreads();
        WKV_PMSQ(13, 1, 14, 8); __syncthreads();
        WKV_PMSQ(14, 8, 13, 1); __syncthreads();
        WKV_PMSQ(13, 1, 14, 8); __syncthreads();
        WKV_PMSQ(14, 8, 13, 1); __syncthreads();
        WKV_PM(13, 1, 14); __syncthreads();
        {
            bf16x8 xt[2]; LF2(xt, 14, 16 * mt);
#pragma unroll
            for (int q2 = 0; q2 < 2; ++q2) {
                const int nt = ntb + q2, n_ = 16 * nt + fr, m0_ = 16 * mt + 4 * fq;
                bf16x8 ya[2], yz[2]; TR2(ya, 0, 16 * nt); LF2(yz, 6, 16 * nt);
                { f32x4 acc = {0.f, 0.f, 0.f, 0.f}; MMA2(acc, xt, ya); st4_lds(AT(9, n_, m0_), acc); }
                { f32x4 acc = {0.f, 0.f, 0.f, 0.f}; MMA2(acc, xt, yz); st4_lds(AT(8, n_, m0_), acc); }
            }
        }
        __syncthreads();
        if (cid + F.G < NB * NH * (SEQ / 64)) W1_ISSUE(cid + F.G);
        {
            bf16x8 xb[2]; LF2(xb, 11, 16 * mt);
#pragma unroll
            for (int q2 = 0; q2 < 2; ++q2) {
                const int nt = ntb + q2;
                bf16x8 yp[2]; LF2(yp, 9, 16 * nt);
                { const int m_ = 16 * mt + fr, n0_ = 16 * nt + 4 * fq; f32x4 acc = ld4_lds(AT(2, m_, n0_)); MMA2(acc, yp, xb);
                  st_bf4(RP + (size_t)cid * 4096 + (unsigned)((mt * 2 + (nt >> 1)) * 512 + (fr * 4 + 2 * (nt & 1) + (fq >> 1)) * 8 + 4 * (fq & 1)), acc); }
            }
        }
        {
            bf16x8 xb[2], xk[2], xp[2], xu[2], xv[2]; LF2(xb, 11, 16 * mt); LF2(xk, 12, 16 * mt); LF2(xp, 9, 16 * mt); LF2(xu, 8, 16 * mt); TR2(xv, 7, 16 * mt);
#pragma unroll
            for (int q2 = 0; q2 < 2; ++q2) {
                const int nt = ntb + q2;
                bf16x8 yu[2], yv[2], yb[2], yk[2]; LF2(yu, 8, 16 * nt); TR2(yv, 7, 16 * nt); TR2(yb, 3, 16 * nt); TR2(yk, 5, 16 * nt);
                { f32x4 acc = {0.f, 0.f, 0.f, 0.f}; MMA2(acc, yu, xb); MMA2(acc, yv, xk);
                  st_bf4(OL + (size_t)cid * 4096 + (unsigned)((16 * mt + fr) * 64 + 16 * nt + 4 * fq), acc); }
                { const int jp = 16 * nt + fr, j0 = 16 * mt + 4 * fq; f32x4 acc = {0.f, 0.f, 0.f, 0.f}; MMA2(acc, xp, yb);
                  const float wc = WCs[jp];
#pragma unroll
                  for (int e = 0; e < 4; ++e) acc[e] = (acc[e] + ((j0 + e == jp) ? 1.0f : 0.0f)) * wc;
                  st_bf4(G2 + (size_t)cid * 4096 + (unsigned)((nt * 2 + (mt >> 1)) * 512 + lane * 8 + (mt & 1) * 4), acc); }
                { const int i_ = 16 * mt + fr, jp0 = 16 * nt + 4 * fq; f32x4 acc = {0.f, 0.f, 0.f, 0.f}; MMA2(acc, yb, xu); MMA2(acc, yk, xv);
#pragma unroll
                  for (int e = 0; e < 4; ++e) acc[e] *= WCs[jp0 + e];
                  st_bf4(DM + (size_t)cid * 4096 + (unsigned)(i_ * 64 + jp0), acc); }
            }
        }
        SBARL();
    }
#undef W1_ISSUE
#undef LF2
#undef TR2
#undef MMA2
#undef WKV_PMSQ
#undef WKV_SQ
#undef WKV_PM
#undef AT
#undef SL
}

__device__ __forceinline__ void ph_wkv_carry(const Frame& F) {
    const bf16_t* G2 = (const bf16_t*)(F.ws + WS_G2); const bf16_t* DM = (const bf16_t*)(F.ws + WS_DM); bf16_t* ST = (bf16_t*)(F.ws + WS_ST);
    const int lane = F.lane, fr = lane & 15, fq = lane >> 4;
    const bool loader = F.wave >= 4; const int lw = F.wave - 4, i = 16 * (F.wave & 3) + fr;
    constexpr int NC = SEQ / 64;
    for (int ch = F.bid; ch < NB * NH; ch += F.G) {
        const size_t cbase = (size_t)ch * NC;
#define CARRY_ISSUE(c_) do { const int cc_ = (c_) < NC ? (c_) : NC - 1; const size_t cid_ = cbase + cc_; \
        _Pragma("unroll") for (int q_ = 0; q_ < 4; ++q_) { const int j_ = lw * 4 + q_; \
            const bf16_t* src_ = (j_ < 8 ? G2 + cid_ * 4096 + j_ * 512 : DM + cid_ * 4096 + (j_ - 8) * 512) + lane * 8; \
            __builtin_amdgcn_global_load_lds((const unsigned*)src_, (LAS unsigned*)(F.lds + ((c_) & 7) * 16384 + j_ * 1024), 16, 0, 0); } } while (0)
        f32x4 st[4];
#pragma unroll
        for (int r = 0; r < 4; ++r) st[r] = (f32x4){0.f, 0.f, 0.f, 0.f};
        bf16x8 gc[8]; u32x2 dc[4];
#define CARRY_RING_READ(c_) do { const LAS unsigned char* slot_ = F.lds + ((c_) & 7) * 16384; \
        _Pragma("unroll") for (int f = 0; f < 8; ++f) gc[f] = *(const LAS bf16x8*)(slot_ + f * 1024 + lane * 16); \
        _Pragma("unroll") for (int r = 0; r < 4; ++r) dc[r] = *(const LAS u32x2*)(slot_ + 8192 + (i * 64 + 16 * r + 4 * fq) * 2); } while (0)
        if (loader) {
#pragma unroll
            for (int c = 0; c < 7; ++c) CARRY_ISSUE(c);
            WAIT_V(20);
        }
        SBAR();
        if (!loader) CARRY_RING_READ(0);
#pragma unroll 1
        for (int c = 0; c < NC; ++c) {
            if (loader) {
                CARRY_ISSUE(c + 7);
                WAIT_V(20);
            } else {
                const size_t cid = cbase + c;
                union { bf16x8 v; unsigned u[4]; } b0, b1;
                b0.u[0] = pack2(st[0][0], st[0][1]); b0.u[1] = pack2(st[0][2], st[0][3]); b0.u[2] = pack2(st[1][0], st[1][1]); b0.u[3] = pack2(st[1][2], st[1][3]);
                b1.u[0] = pack2(st[2][0], st[2][1]); b1.u[1] = pack2(st[2][2], st[2][3]); b1.u[2] = pack2(st[3][0], st[3][1]); b1.u[3] = pack2(st[3][2], st[3][3]);
                f32x4 acc[4];
#pragma unroll
                for (int r = 0; r < 4; ++r) { acc[r] = (f32x4){lo2f(dc[r].x), hi2f(dc[r].x), lo2f(dc[r].y), hi2f(dc[r].y)};
                    acc[r] = __builtin_amdgcn_mfma_f32_16x16x32_bf16(gc[r * 2 + 0], b0.v, acc[r], 0, 0, 0); }
#pragma unroll
                for (int r = 0; r < 4; ++r) acc[r] = __builtin_amdgcn_mfma_f32_16x16x32_bf16(gc[r * 2 + 1], b1.v, acc[r], 0, 0, 0);
                { const unsigned wsl = (unsigned)(F.wave & 3);
                  bf16_t* stp = ST + cid * 4096;
                  const unsigned ob = (unsigned)(((fr >> 2) * 2) * 512 + ((4 * wsl + (fr & 3)) * 4 + (fq >> 1)) * 8 + 4 * (fq & 1));
                  u32x2 w0; w0.x = b0.u[0]; w0.y = b0.u[1]; *(u32x2*)(stp + ob) = w0;
                  u32x2 w1; w1.x = b0.u[2]; w1.y = b0.u[3]; *(u32x2*)(stp + ob + 16) = w1;
                  u32x2 w2; w2.x = b1.u[0]; w2.y = b1.u[1]; *(u32x2*)(stp + ob + 512) = w2;
                  u32x2 w3; w3.x = b1.u[2]; w3.y = b1.u[3]; *(u32x2*)(stp + ob + 512 + 16) = w3; }
                if (c + 1 < NC) CARRY_RING_READ(c + 1);
#pragma unroll
                for (int r = 0; r < 4; ++r) st[r] = acc[r];
            }
            SBAR();
        }
        if (loader) WAIT_V(0);
        SBAR();
#undef CARRY_RING_READ
#undef CARRY_ISSUE
    }
}

__device__ __forceinline__ void ph_wkv_out(const Frame& F) {
    const bf16_t* RP = (const bf16_t*)(F.ws + WS_RP); const bf16_t* OL = (const bf16_t*)(F.ws + WS_OL); const bf16_t* ST = (const bf16_t*)(F.ws + WS_ST);
    const bf16_t* Vb = (const bf16_t*)(F.ws + WS_RKV) + (size_t)2 * T * D; const bf16_t* GG = (const bf16_t*)(F.ws + WS_GG); const float* BONUS = (const float*)(F.ws + WS_BONUS);
    bf16_t* OG = (bf16_t*)(F.ws + WS_OG);
    const int lane = F.lane, fr = lane & 15, fq = lane >> 4;
    const int nunits = NB * NH * (SEQ / 64) * 4;
    for (int u0 = F.bid * NWAVES + F.wave; u0 < nunits; u0 += 2 * F.G * NWAVES) {
        bf16x8 rf[2][2], sf[2][4][2]; u32x4 ol0[2], ol1[2], v0[2], v1[2], g0[2], g1[2]; float bon[2]; f32x4 lg[2][4], lb[2][4];
        size_t tokv[2]; int chnv[2]; bool live[2];
#pragma unroll
        for (int j = 0; j < 2; ++j) {
            const int uj = u0 + j * F.G * NWAVES; live[j] = uj < nunits; const int u = live[j] ? uj : u0;
            const int cid = u >> 2, tt = u & 3, bh = cid / (SEQ / 64), c = cid % (SEQ / 64), b = bh / NH, h = bh % NH;
            const int t = 16 * tt + fr; const size_t tok = (size_t)b * SEQ + (size_t)c * 64 + t;
            const size_t oh = ((size_t)bh * SEQ + (size_t)c * 64 + t) * 64 + 16 * fq;
#pragma unroll
            for (int ks = 0; ks < 2; ++ks) rf[j][ks] = *(const bf16x8*)(RP + (size_t)cid * 4096 + (tt * 2 + ks) * 512 + (fr * 4 + fq) * 8);
#pragma unroll
            for (int n = 0; n < 4; ++n)
#pragma unroll
                for (int ks = 0; ks < 2; ++ks) sf[j][n][ks] = *(const bf16x8*)(ST + (size_t)cid * 4096 + (n * 2 + ks) * 512 + (fr * 4 + fq) * 8);
            ol0[j] = *(const u32x4*)(OL + (size_t)cid * 4096 + t * 64 + 16 * fq); ol1[j] = *(const u32x4*)(OL + (size_t)cid * 4096 + t * 64 + 16 * fq + 8);
            v0[j] = *(const u32x4*)(Vb + oh); v1[j] = *(const u32x4*)(Vb + oh + 8); g0[j] = *(const u32x4*)(GG + oh); g1[j] = *(const u32x4*)(GG + oh + 8);
            bon[j] = BONUS[tok * NH + h];
            tokv[j] = tok; chnv[j] = h * 64 + 16 * fq;
#pragma unroll
            for (int n = 0; n < 4; ++n) { lg[j][n] = *(const f32x4*)(F.in[I_LNG] + chnv[j] + 4 * n); lb[j][n] = *(const f32x4*)(F.in[I_LNB] + chnv[j] + 4 * n); }
        }
#pragma unroll
        for (int j = 0; j < 2; ++j) {
            f32x4 acc[4];
            acc[0] = (f32x4){lo2f(ol0[j][0]), hi2f(ol0[j][0]), lo2f(ol0[j][1]), hi2f(ol0[j][1])}; acc[1] = (f32x4){lo2f(ol0[j][2]), hi2f(ol0[j][2]), lo2f(ol0[j][3]), hi2f(ol0[j][3])};
            acc[2] = (f32x4){lo2f(ol1[j][0]), hi2f(ol1[j][0]), lo2f(ol1[j][1]), hi2f(ol1[j][1])}; acc[3] = (f32x4){lo2f(ol1[j][2]), hi2f(ol1[j][2]), lo2f(ol1[j][3]), hi2f(ol1[j][3])};
#pragma unroll
            for (int n = 0; n < 4; ++n)
#pragma unroll
                for (int ks = 0; ks < 2; ++ks) acc[n] = __builtin_amdgcn_mfma_f32_16x16x32_bf16(sf[j][n][ks], rf[j][ks], acc[n], 0, 0, 0);
            float s = 0.f;
#pragma unroll
            for (int n = 0; n < 4; ++n) s += (acc[n][0] + acc[n][1]) + (acc[n][2] + acc[n][3]);
            s += __shfl_xor(s, 16); s += __shfl_xor(s, 32);
            const float mean = s * (1.0f / 64.0f);
            float q = 0.f;
#pragma unroll
            for (int n = 0; n < 4; ++n)
#pragma unroll
                for (int e = 0; e < 4; ++e) { const float d = acc[n][e] - mean; q += d * d; }
            q += __shfl_xor(q, 16); q += __shfl_xor(q, 32);
            const float rstd = rsqrtf(q * (1.0f / 64.0f) + 64e-5f);
            u32x4 o0, o1;
#pragma unroll
            for (int n = 0; n < 4; ++n) {
                const unsigned vw0 = n < 2 ? v0[j][2 * n] : v1[j][2 * n - 4], vw1 = n < 2 ? v0[j][2 * n + 1] : v1[j][2 * n - 3], gw0 = n < 2 ? g0[j][2 * n] : g1[j][2 * n - 4], gw1 = n < 2 ? g0[j][2 * n + 1] : g1[j][2 * n - 3];
                const f32x4 vv = {lo2f(vw0), hi2f(vw0), lo2f(vw1), hi2f(vw1)}, gg = {lo2f(gw0), hi2f(gw0), lo2f(gw1), hi2f(gw1)};
                const f32x4 res = (((acc[n] - mean) * rstd) * lg[j][n] + lb[j][n] + vv * bon[j]) * gg;
                const unsigned w0 = pack2(res[0], res[1]), w1 = pack2(res[2], res[3]);
                if (n == 0) { o0[0] = w0; o0[1] = w1; } else if (n == 1) { o0[2] = w0; o0[3] = w1; } else if (n == 2) { o1[0] = w0; o1[1] = w1; } else { o1[2] = w0; o1[3] = w1; }
            }
            if (live[j]) { *(u32x4*)(OG + tokv[j] * D + chnv[j]) = o0; *(u32x4*)(OG + tokv[j] * D + chnv[j] + 8) = o1; }
        }
    }
}

struct AttnTile { bf16x8 k[4][2]; bf16x8 v[4][2]; };
__device__ __forceinline__ void attn_load(AttnTile& tl, const bf16_t* kbase  , const bf16_t* vbase  ) {
#pragma unroll
    for (int kt = 0; kt < 4; ++kt)
#pragma unroll
        for (int ks = 0; ks < 2; ++ks) tl.k[kt][ks] = *(const bf16x8*)(kbase + (kt * 2 + ks) * 512);
#pragma unroll
    for (int dt = 0; dt < 4; ++dt)
#pragma unroll
        for (int ks = 0; ks < 2; ++ks) tl.v[dt][ks] = *(const bf16x8*)(vbase + (dt * 2 + ks) * 512);
}
template <bool MASK>
__device__ __forceinline__ void attn_tile(const AttnTile& tl, const bf16x8 (&qf)[2], f32x4 (&o)[4], float& R, int key0, int qpos, int fq) {
    constexpr float C2 = 0.125f * 1.4426950408889634f;
    f32x4 z[4];
#pragma unroll
    for (int kt = 0; kt < 4; ++kt) { z[kt] = (f32x4){0.f, 0.f, 0.f, 0.f};
#pragma unroll
        for (int ks = 0; ks < 2; ++ks) z[kt] = __builtin_amdgcn_mfma_f32_16x16x32_bf16(tl.k[kt][ks], qf[ks], z[kt], 0, 0, 0); }
    float sp[4][4], G[4];
#pragma unroll
    for (int kt = 0; kt < 4; ++kt) { G[kt] = 0.f;
#pragma unroll
        for (int e = 0; e < 4; ++e) { const float z2 = z[kt][e] * C2; z[kt][e] = z2;
            const float l2 = __builtin_amdgcn_logf(1.0f + __builtin_amdgcn_exp2f(z2));
            float spv = z2 > 30.f ? z2 : l2;
            if (MASK) spv = ((key0 + 16 * kt + 4 * fq + e) < qpos) ? spv : 0.f;
            sp[kt][e] = spv; G[kt] += spv; } }
    float sufg[4], tot[4];
#pragma unroll
    for (int kt = 0; kt < 4; ++kt) {
        const float g1 = __shfl_xor(G[kt], 16), g2 = __shfl_xor(G[kt], 32), g3 = __shfl_xor(G[kt], 48);
        tot[kt] = G[kt] + g1 + g2 + g3;
        sufg[kt] = (((fq ^ 1) > fq) ? g1 : 0.f) + (((fq ^ 2) > fq) ? g2 : 0.f) + (((fq ^ 3) > fq) ? g3 : 0.f);
    }
    float later = 0.f;
    union { bf16x8 v; unsigned w[4]; } p0, p1;
#pragma unroll
    for (int kt = 3; kt >= 0; --kt) {
        float run = R + later + sufg[kt];
        float wv[4];
#pragma unroll
        for (int e = 3; e >= 0; --e) { float w = __builtin_amdgcn_exp2f(z[kt][e] - sp[kt][e] - run);
            if (MASK) w = ((key0 + 16 * kt + 4 * fq + e) < qpos) ? w : 0.f;
            wv[e] = w; run += sp[kt][e]; }
        const unsigned w01 = pgx::cvt_pk_bf16(wv[0], wv[1]), w23 = pgx::cvt_pk_bf16(wv[2], wv[3]);
        if (kt == 0) { p0.w[0] = w01; p0.w[1] = w23; } else if (kt == 1) { p0.w[2] = w01; p0.w[3] = w23; } else if (kt == 2) { p1.w[0] = w01; p1.w[1] = w23; } else { p1.w[2] = w01; p1.w[3] = w23; }
        later += tot[kt];
    }
    R += later;
#pragma unroll
    for (int dt = 0; dt < 4; ++dt) {
        o[dt] = __builtin_amdgcn_mfma_f32_16x16x32_bf16(tl.v[dt][0], p0.v, o[dt], 0, 0, 0);
        o[dt] = __builtin_amdgcn_mfma_f32_16x16x32_bf16(tl.v[dt][1], p1.v, o[dt], 0, 0, 0);
    }
}
__device__ __forceinline__ void attn_unit(const Frame& F, const int bh, const int qt) {
    const bf16_t* Q = (const bf16_t*)(F.ws + WS_Q); const bf16_t* Kb = Q + (size_t)T * D; const bf16_t* VT = Q + (size_t)2 * T * D;
    bf16_t* AO = (bf16_t*)(F.ws + WS_AO);
    const int lane = F.lane, fr = lane & 15, fq = lane >> 4;
    constexpr float EXIT2 = SB_EXIT * 1.4426950408889634f;
    const int b = bh / NH, h = bh % NH;
    const int q0 = qt * 16, qpos = q0 + fr;
    const size_t tb = (size_t)b * SEQ;
    bf16x8 qf[2];
#pragma unroll
    for (int ks = 0; ks < 2; ++ks) qf[ks] = *(const bf16x8*)(Q + (tb + qpos) * D + h * 64 + ks * 32 + fq * 8);
    f32x4 o[4];
#pragma unroll
    for (int dt = 0; dt < 4; ++dt) o[dt] = (f32x4){0.f, 0.f, 0.f, 0.f};
    float R = 0.f;
    const bf16_t* kb = Kb + (size_t)bh * SEQ * 64 + (fr * 4 + fq) * 8;
    const bf16_t* vb = VT + (size_t)bh * SEQ * 64 + (fr * 4 + fq) * 8;
    int kt0 = (q0 + 15) / 64;
    AttnTile ta, tc;
    attn_load(ta, kb + (size_t)kt0 * 4096, vb + (size_t)kt0 * 4096);
    if (kt0 > 0) attn_load(tc, kb + (size_t)(kt0 - 1) * 4096, vb + (size_t)(kt0 - 1) * 4096);
    attn_tile<true>(ta, qf, o, R, kt0 * 64, qpos, fq);
    --kt0;
    while (kt0 >= 0 && !__all(R > EXIT2)) {
        if (kt0 > 0) attn_load(ta, kb + (size_t)(kt0 - 1) * 4096, vb + (size_t)(kt0 - 1) * 4096);
        attn_tile<false>(tc, qf, o, R, kt0 * 64, qpos, fq);
        --kt0;
        if (kt0 < 0 || __all(R > EXIT2)) break;
        if (kt0 > 0) attn_load(tc, kb + (size_t)(kt0 - 1) * 4096, vb + (size_t)(kt0 - 1) * 4096);
        attn_tile<false>(ta, qf, o, R, kt0 * 64, qpos, fq);
        --kt0;
    }
#pragma unroll
    for (int dt = 0; dt < 4; ++dt) st_bf4(AO + (tb + qpos) * D + h * 64 + 16 * dt + 4 * fq, o[dt]);
}
__device__ __forceinline__ void ph_attn(const Frame& F) {
    if (F.G == 256) {
        const int xq = F.bid & 7, lb = F.bid >> 3;
#pragma unroll 1
        for (int it = 0; it < 8; ++it) { const int ck = it * 32 + lb; attn_unit(F, xq + 8 * (ck >> 6), (ck & 63) * 8 + F.wave); }
    } else {
        unsigned* aq = F.ctl + CW_AQ;
        LAS unsigned* chunk_s = (LAS unsigned*)(F.lds + 1024);
        const unsigned myx = xb_xcc_id() & 7u;
        for (int qi = 0; qi < 8; ++qi) {
            const unsigned xq = (myx + (unsigned)qi) & 7u;
            for (;;) {
                __syncthreads();
                if (F.tid == 0) *chunk_s = atomicAdd(&aq[xq * 64], 1u);
                __syncthreads();
                const unsigned ck = *chunk_s;
                if (ck >= 256u) break;
                attn_unit(F, (int)xq + 8 * (int)(ck >> 6), (int)(ck & 63u) * 8 + F.wave);
            }
        }
    }
}

#ifndef USE_PGX
#define USE_PGX 0x1f
#endif
__device__ __forceinline__ int px_unit_index(int i, int G, int c, int nwg) {
    const long L = (long)i * G + c; if (L >= nwg) return -1;
    const int w = (int)L, q = nwg / 8, r = nwg % 8, xcd = w % 8, off = w / 8;
    return (xcd < r ? xcd * (q + 1) : r * (q + 1) + (xcd - r) * q) + off;
}
struct PxDense {
    const char* A; const char* B; int nM, nN, K, G, c; unsigned lda; int a_div; size_t a_stride;
    __device__ __forceinline__ bool next(int i, pgx::Unit& u) const {
        const int w = px_unit_index(i, G, c, nM * nN); if (w < 0) return false;
        const int pm = w / nN, pn = w % nN;
        u.A = A + (size_t)(pn / a_div) * a_stride + (size_t)pm * 256 * lda; u.tok = nullptr; u.B = B + (size_t)pn * 256 * K * 2; u.r0 = pm * 256; u.c0 = pn * 256; u.aux = 0; return true;
    }
};
__device__ __forceinline__ void px_store_bf16_perm(bf16_t* rowp, const f32x4& v0, const f32x4& v1) {
    u32x4 w; w.x = pgx::cvt_pk_bf16(v0[0], v0[1]); w.y = pgx::cvt_pk_bf16(v0[2], v0[3]); w.z = pgx::cvt_pk_bf16(v1[0], v1[1]); w.w = pgx::cvt_pk_bf16(v1[2], v1[3]); *(u32x4*)rowp = w;
}
__device__ __forceinline__ void ph_rkv_px(const Frame& F) {
    bf16_t* RKV = (bf16_t*)(F.ws + WS_RKV);
    PxDense S{(const char*)(F.ws + WS_XS), (const char*)(F.ws + WS_WRKV), 64, 12, D, F.G, F.bid, (unsigned)(D * 2), 4, (size_t)T * D * 2};
    pgx::gemm_phase<true, true>(F.lds, D, D * 2, S, [&](const f32x4 (&acc)[2][2][4][2], const pgx::Unit& u, int wr, int wc, int fr, int fq) {
        bf16_t* base = RKV + (size_t)(u.c0 / D) * T * D;
#pragma unroll
        for (int ai = 0; ai < 2; ++ai)
#pragma unroll
            for (int m = 0; m < 4; ++m) { const int t = u.r0 + ai * 128 + wr * 64 + m * 16 + fr;
#pragma unroll
                for (int bj = 0; bj < 2; ++bj) px_store_bf16_perm(base + hm_off(t, (u.c0 % D) + bj * 128 + wc * 32 + 8 * fq), acc[ai][bj][m][0], acc[ai][bj][m][1]); }
    });
}
__device__ __forceinline__ void ph_lora_dn_sg(const Frame& F) {
    const bf16_t* XS = (const bf16_t*)(F.ws + WS_XS); const bf16_t* WLDN = (const bf16_t*)(F.ws + WS_WLDN); bf16_t* LORA = (bf16_t*)(F.ws + WS_LORA);
    for (int u = F.bid; u < 64 * 4; u += F.G) {
        const int mt = u / 4, j = u % 4, n = (j == 0) ? 3 : (j == 1 ? 4 : 5);
        ASeg A; A.p[0] = XS + ((size_t)n * T + mt * 256) * D; A.p[1] = A.p[0]; A.p[2] = A.p[0]; A.segTiles = 16;
        bf16_t* out = LORA + (size_t)mt * 256 * 256 + j * 64;
        sg_tile<64>(F.lds, A, [](int R) { return (unsigned)R * (D * 2); }, WLDN + (size_t)(j * 64) * D, D, 16,
            [&](auto& acc, int r0, int c0, int fr, int fq) {
#pragma unroll
                for (int m = 0; m < EPI_MT(acc); ++m)
#pragma unroll
                    for (int q = 0; q < 4; ++q) { f32x4 v = acc[m][q];
                        if (j == 0) {
#pragma unroll
                            for (int e = 0; e < 4; ++e) v[e] = tanhf_(v[e]); }
                        else if (j >= 2) {
#pragma unroll
                            for (int e = 0; e < 4; ++e) v[e] = sigmoidf_(v[e]); }
                        st_bf4(out + (size_t)(r0 + 16 * m + fr) * 256 + c0 + 16 * q + 4 * fq, v); }
            });
    }
}
__device__ __forceinline__ void ph_dense_bf16_px(const Frame& F, const bf16_t* Ain, const bf16_t* Wt, bf16_t* out) {
    PxDense S{(const char*)Ain, (const char*)Wt, 64, 4, D, F.G, F.bid, (unsigned)(D * 2), 4, 0};
    pgx::gemm_phase<true, true>(F.lds, D, D * 2, S, [&](const f32x4 (&acc)[2][2][4][2], const pgx::Unit& u, int wr, int wc, int fr, int fq) {
        bf16_t* base = out + u.c0 + wc * 32 + 8 * fq;
#pragma unroll
        for (int ai = 0; ai < 2; ++ai)
#pragma unroll
            for (int m = 0; m < 4; ++m) { bf16_t* rowp = base + (size_t)(u.r0 + ai * 128 + wr * 64 + m * 16 + fr) * D;
#pragma unroll
                for (int bj = 0; bj < 2; ++bj) px_store_bf16_perm(rowp + bj * 128, acc[ai][bj][m][0], acc[ai][bj][m][1]); }
    });
}
__device__ __forceinline__ void ph_qkv_px(const Frame& F) {
    bf16_t* QK = (bf16_t*)(F.ws + WS_Q); bf16_t* VT = QK + (size_t)2 * T * D;
    { PxDense S{(const char*)(F.ws + WS_H3), (const char*)(F.ws + WS_WQKV), 64, 8, D, F.G, F.bid, (unsigned)(D * 2), 8, 0};
      pgx::gemm_phase<true, true>(F.lds, D, D * 2, S, [&](const f32x4 (&acc)[2][2][4][2], const pgx::Unit& u, int wr, int wc, int fr, int fq) {
        const bool isk = u.c0 >= D;
#pragma unroll
        for (int ai = 0; ai < 2; ++ai)
#pragma unroll
            for (int m = 0; m < 4; ++m) { const int t = u.r0 + ai * 128 + wr * 64 + m * 16 + fr;
#pragma unroll
                for (int bj = 0; bj < 2; ++bj) { const int c = (u.c0 % D) + bj * 128 + wc * 32 + 8 * fq;
                    const int sq = t % SEQ, dd = c & 63;
                    bf16_t* dst = isk ? QK + (size_t)T * D + (((size_t)((t / SEQ) * NH + (c >> 6)) * (SEQ / 16) + (sq >> 4)) * 2 + (dd >> 5)) * 512 + (sq & 15) * 32 + (dd & 31) : QK + (size_t)t * D + c;
                    px_store_bf16_perm(dst, acc[ai][bj][m][0], acc[ai][bj][m][1]); } }
      }); }
    { PxDense S{(const char*)(F.ws + WS_H3), (const char*)(F.ws + WS_WQKV) + (size_t)2 * D * D * 2, 64, 4, D, F.G, F.bid, (unsigned)(D * 2), 4, 0};
      pgx::gemm_phase<false, false>(F.lds, D, D * 2, S, [&](const f32x4 (&acc)[2][2][4][2], const pgx::Unit& u, int wr, int wc, int fr, int fq) {
#pragma unroll
        for (int ai = 0; ai < 2; ++ai)
#pragma unroll
            for (int m = 0; m < 4; ++m) { const int t = u.r0 + ai * 128 + wr * 64 + m * 16 + 4 * fq, b = t / SEQ, sidx = t % SEQ;
#pragma unroll
                for (int bj = 0; bj < 2; ++bj)
#pragma unroll
                    for (int n = 0; n < 2; ++n) { const int c = u.c0 + bj * 128 + wc * 32 + n * 16 + fr, h = c >> 6, d = c & 63;
                        const int k6 = sidx & 63, kk = k6 & 31;
                        st_bf4(VT + ((size_t)(b * NH + h) * (SEQ / 64) + (sidx >> 6)) * 4096 + ((d >> 4) * 2 + (k6 >> 5)) * 512 + ((d & 15) * 4 + ((kk & 15) >> 2)) * 8 + (kk >> 4) * 4, acc[ai][bj][m][n]); } }
      }); }
}
struct PxMoe {
    const char* Asrc; const int* TOK; const int* TILEE; const char* W; const char* Wsh; int routed, nmt, nN, K, G, c; unsigned lda; size_t wexp; bool gather;
    __device__ __forceinline__ bool next(int i, pgx::Unit& u) const {
        const int w = px_unit_index(i, G, c, nmt * nN); if (w < 0) return false;
        const int mt = w / nN, pn = w % nN, row0 = mt * 256; const bool sh = row0 >= routed; const int e = sh ? 64 : TILEE[mt];
        if (gather) { if (sh) { u.A = Asrc + (size_t)(row0 - routed) * lda; u.tok = nullptr; } else { u.A = Asrc; u.tok = TOK + row0; } }
        else { u.A = Asrc + (size_t)row0 * lda; u.tok = nullptr; }
        u.B = (sh ? Wsh : W + (size_t)e * wexp) + (size_t)pn * 256 * K * 2; u.r0 = row0; u.c0 = pn * 256; u.aux = 0; return true;
    }
};
__device__ __forceinline__ void ph_gateup_px(const Frame& F, int layer) {
    bf16_t* HB = (bf16_t*)(F.ws + WS_HB); const int* START = (const int*)(F.ws + WS_START);
    const int routed = START[65], nmt = (routed + T) / 256;
    PxMoe S{(const char*)(F.ws + WS_H2), (const int*)(F.ws + WS_TOK), (const int*)(F.ws + WS_TILEE), (const char*)(F.ws + (layer == 0 ? WS_WGU : WS_WGU1)), (const char*)(F.ws + WS_WGU) + (size_t)64 * 512 * D * 2, routed, nmt, 2, D, F.G, F.bid, (unsigned)(D * 2), (size_t)512 * D * 2, true};
    pgx::gemm_phase<true, true>(F.lds, D, D * 2, S, [&](const f32x4 (&acc)[2][2][4][2], const pgx::Unit& u, int wr, int wc, int fr, int fq) {
        bf16_t* base = HB + (u.c0 >> 1) + wc * 32 + 8 * fq;
#pragma unroll
        for (int ai = 0; ai < 2; ++ai)
#pragma unroll
            for (int m = 0; m < 4; ++m) { f32x4 v[2];
#pragma unroll
                for (int n = 0; n < 2; ++n)
#pragma unroll
                    for (int e = 0; e < 4; ++e) { const float g = acc[ai][0][m][n][e]; v[n][e] = g * sigmoidf_(g) * acc[ai][1][m][n][e]; }
                px_store_bf16_perm(base + (size_t)(u.r0 + ai * 128 + wr * 64 + m * 16 + fr) * DE, v[0], v[1]); }
    });
}
__device__ __forceinline__ void ph_down_px(const Frame& F) {
    bf16_t* YB = (bf16_t*)(F.ws + WS_YB); const int* START = (const int*)(F.ws + WS_START);
    const int routed = START[65], nmt = (routed + T) / 256;
    PxMoe S{(const char*)(F.ws + WS_HB), nullptr, (const int*)(F.ws + WS_TILEE), (const char*)(F.ws + WS_WDN), (const char*)(F.ws + WS_WDN) + (size_t)64 * D * DE * 2, routed, nmt, 4, DE, F.G, F.bid, (unsigned)(DE * 2), (size_t)D * DE * 2, false};
    pgx::gemm_phase<true, true>(F.lds, DE, DE * 2, S, [&](const f32x4 (&acc)[2][2][4][2], const pgx::Unit& u, int wr, int wc, int fr, int fq) {
        unsigned char* base = (unsigned char*)YB + u.c0 + wc * 32 + 8 * fq;
#pragma unroll
        for (int ai = 0; ai < 2; ++ai)
#pragma unroll
            for (int m = 0; m < 4; ++m) { unsigned char* rowp = base + (size_t)(u.r0 + ai * 128 + wr * 64 + m * 16 + fr) * D;
#pragma unroll
                for (int bj = 0; bj < 2; ++bj) { u32x2 w;
                    w.x = pack_fp8x4(acc[ai][bj][m][0]); w.y = pack_fp8x4(acc[ai][bj][m][1]);
                    *(u32x2*)(rowp + bj * 128) = w; }
                asm volatile("" ::: "memory"); }
    });
}

__global__ void __launch_bounds__(NTHREADS, 2) mega(Args args) {
    extern __shared__ __attribute__((aligned(16))) unsigned char lds[];
    Frame F;
    F.in = args.in; F.out = args.out; F.ws = args.ws; F.ctl = (unsigned*)(args.ws + WS_CTL);
    F.ldsf = (float*)lds; F.lds = (LAS unsigned char*)lds;
    F.tid = threadIdx.x; F.lane = F.tid & 63; F.wave = __builtin_amdgcn_readfirstlane(F.tid >> 6); F.bid = blockIdx.x; F.G = gridDim.x;
    if (F.tid < 4) ((unsigned*)(lds + LDS_BYTES - 64))[F.tid] = 0u;
    __syncthreads();
    XcdBarrier bar; bar.bar = F.ctl + CW_BAR; bar.x = 0; bar.st = (volatile LAS unsigned*)(lds + LDS_BYTES - 64);
#if MK_N_LAUNCHES == 1
    bar = xcd_barrier_post(F.ctl + CW_BAR, (volatile LAS unsigned*)(lds + LDS_BYTES - 64));
#endif
    const int lo = args.ph_lo, hi = args.ph_hi;
#define IN(k) (lo <= (k) && (k) < hi)
#define SEAM(k) do { if (IN(k) && IN((k) + 1)) xcd_barrier(bar); } while (0)
    bf16_t* const wsb = (bf16_t*)args.ws;
    (void)wsb;
    if (IN(0)) { ph_mod(F); conv_dense(F, 0, F.bid, F.G); if (F.G <= 2 * NB * NH) { conv_dense(F, 1, F.bid, F.G); conv_moe(F, 0, 3, F.bid, F.G); } } SEAM(0);
    if (IN(1)) { ph_prenorm_rwkv(F); } SEAM(1);
    if (IN(2)) { ph_rkv_px(F); ph_lora_dn_sg(F); } SEAM(2);
    if (IN(3)) { ph_lora_up_sg(F); } SEAM(3);
    if (IN(4)) { ph_wkv_chunk(F); } SEAM(4);
    if (IN(5)) { if (F.bid < NB * NH || F.G <= 2 * NB * NH) { ph_wkv_carry(F); } else { conv_dense(F, 1, F.bid - NB * NH, F.G - NB * NH); conv_moe(F, 0, 3, F.bid - NB * NH, F.G - NB * NH); conv_moe(F, 1, 1, F.bid - NB * NH, F.G - NB * NH); } } SEAM(5);
    if (IN(6)) { ph_wkv_out(F); } SEAM(6);
    if (IN(7)) { ph_dense_bf16_px(F, (const bf16_t*)(F.ws + WS_OG), (const bf16_t*)(F.ws + WS_WO), (bf16_t*)(F.ws + WS_Y1)); } SEAM(7);
    if (IN(8)) { ph_postmix_route<false>(F, 0, F.in[I_X], (const bf16_t*)(F.ws + WS_Y1)); } SEAM(8);
    if (IN(11)) { ph_offsets(F, 0); } SEAM(11);
    if (IN(12)) { ph_gateup_px(F, 0); } SEAM(12);
    if (IN(13)) { ph_down_px(F); } SEAM(13);
    if (IN(14)) { ph_combine(F, 0, true); conv_moe(F, 1, (F.G <= 2 * NB * NH) ? 3 : 2, F.bid, F.G); } SEAM(14);
    if (IN(15)) { ph_qkv_px(F); } SEAM(15);
    if (IN(16)) { ph_attn(F); } SEAM(16);
    if (IN(17)) { ph_dense_bf16_px(F, (const bf16_t*)(F.ws + WS_AO), (const bf16_t*)(F.ws + WS_WSBO), (bf16_t*)(F.ws + WS_Y1B)); } SEAM(17);
    if (IN(18)) { ph_postmix_route<true>(F, 1, nullptr, (const bf16_t*)(F.ws + WS_Y1B)); } SEAM(18);
    if (IN(21)) { ph_offsets(F, 1); } SEAM(21);
    if (IN(22)) { ph_gateup_px(F, 1); } SEAM(22);
    if (IN(23)) { ph_down_px(F); } SEAM(23);
    if (IN(24)) { ph_combine(F, 1, false); }
#undef IN
#undef SEAM
}

extern "C" void kernel_launch(void* const* d_in, const int* in_sizes, int n_in, void* d_out, int out_size, void* d_ws, size_t ws_size, hipStream_t stream) {
    static int grid = 0;
    if (grid == 0) {
        if (n_in != 34 || in_sizes[0] != T * D || out_size != T * D || ws_size < WS_END) {
            fprintf(stderr, "kernel_launch: unexpected shapes: n_in %d in0 %d out %d ws %zu (need %zu)\n", n_in, n_in > 0 ? in_sizes[0] : -1, out_size, ws_size, (size_t)WS_END);
            grid = -1; return;
        }
        int dev = 0, cus = 0, per_cu = 0;
        if (hipGetDevice(&dev) != hipSuccess || hipDeviceGetAttribute(&cus, hipDeviceAttributeMultiprocessorCount, dev) != hipSuccess) { grid = -1; return; }
        if (hipFuncSetAttribute((const void*)mega, hipFuncAttributeMaxDynamicSharedMemorySize, LDS_BYTES) != hipSuccess) { fprintf(stderr, "kernel_launch: hipFuncSetAttribute failed\n"); grid = -1; return; }
        if (hipOccupancyMaxActiveBlocksPerMultiprocessor(&per_cu, (const void*)mega, NTHREADS, LDS_BYTES) != hipSuccess || per_cu < 1)
            fprintf(stderr, "kernel_launch: occupancy query reports %d blocks per CU\n", per_cu);
        (void)hipGetLastError();
        grid = cus;
    }
    if (grid < 0) return;
    if (hipMemsetAsync((char*)d_ws + WS_CTL, 0, CTL_BYTES, stream) != hipSuccess) { fprintf(stderr, "kernel_launch: memset failed\n"); return; }
    Args a{};
    for (int i = 0; i < 34; ++i) a.in[i] = (const float*)d_in[i];
    a.out = (float*)d_out; a.ws = (unsigned char*)d_ws;
#if MK_N_LAUNCHES == 1
    a.ph_lo = 0; a.ph_hi = NPHASES;
    hipLaunchKernelGGL(mega, dim3(grid), dim3(NTHREADS), LDS_BYTES, stream, a);
#else
    for (int p = 0; p < NPHASES; ++p) { a.ph_lo = p; a.ph_hi = p + 1; hipLaunchKernelGGL(mega, dim3(grid), dim3(NTHREADS), LDS_BYTES, stream, a); }
#endif
    const hipError_t le = hipPeekAtLastError();
    if (le != hipSuccess) fprintf(stderr, "kernel_launch: launch failed: %s\n", hipGetErrorName(le));
}
```
